# Optimizing an MI355X kernel written in HIP

```python
import jax, jax.numpy as jnp
from jax import lax
import numpy as np

D_MODEL = 1024
BATCH = 8
SEQ = 2048
DEPTH = 2

HEAD_DIM = 64
NORM_EPS = 1e-6
D_FF = 2752
A_HEADS = 6
A_WIDTH = 384
A_DECAY_LORA = 32
A_AAA_LORA = 32
A_GATE_LORA = 64
A_MV_LORA = 16
A_GN_EPS = 64e-5
A_SLAB = (384, 384, 384, 32, 32, 64)
A_IN = 1280
B_HEADS = 6
B_WIDTH = 384
B_KV_LATENT = 128
B_IDX_HEADS = 8
B_IDX_DIM = 64
B_TOPK_MAX = 256
B_QUERY_BLOCK = 128
B_SLAB = (384, 128, 512, 64, 8)
B_IN = 1096
C_HEADS = 4
C_WIDTH = 256
C_CHUNK = 128
C_ROPE_BASE = 10000.0
C_SLAB = (256, 256, 256, 256)
C_IN = 1024
D_MIX = 1024
N_IN = 3400

kernel_name = 'hybrid_rwkv7_dsa_retention_macaron'


def _split(p, widths):
    out, start = [], 0
    for w in widths:
        out.append(p[..., start:start + w])
        start += w
    return out


def rmsnorm(x, g, eps=NORM_EPS):
    xf = x.astype(jnp.float32)
    y = xf * lax.rsqrt(jnp.mean(xf * xf, axis=-1, keepdims=True) + eps)
    return y.astype(x.dtype) * g


def swiglu(h, w_gate, w_up, w_down):
    return (jax.nn.silu(h @ w_gate) * (h @ w_up)) @ w_down


def shift_lerp(p, mu):
    prev = jnp.pad(p, ((0, 0), (1, 0), (0, 0)))[:, :-1]
    return p + (prev - p) * mu


def _head_layernorm(y, eps):
    mu = jnp.mean(y, axis=-1, keepdims=True)
    var = jnp.mean(jnp.square(y - mu), axis=-1, keepdims=True)
    return (y - mu) * lax.rsqrt(var + eps)


def _rwkv7_recurrence(r, decay, k, v, a, b):
    Bsz, T, H, N = r.shape

    def step(S, inp):
        r_t, w_t, k_t, v_t, a_t, b_t = inp
        sa = jnp.einsum('bhvk,bhk->bhv', S, a_t)
        S = S * w_t[:, :, None, :] + sa[..., None] * b_t[:, :, None, :] + v_t[..., None] * k_t[:, :, None, :]
        return S, jnp.einsum('bhvk,bhk->bhv', S, r_t)

    xs = tuple(jnp.moveaxis(z, 1, 0) for z in (r, decay, k, v, a, b))
    _, y = lax.scan(step, jnp.zeros((Bsz, H, N, N), jnp.float32), xs)
    return jnp.moveaxis(y, 0, 1)


def rwkv7_mixer(r, k, v, w_lo, a_lo, g_lo, w0, w2, a0, a2, g2, k_k, k_a, r_k, ln_w, ln_b):
    Bsz, T, _ = r.shape
    dt = r.dtype
    heads = lambda z: z.astype(jnp.float32).reshape(Bsz, T, A_HEADS, HEAD_DIM)
    w = -jax.nn.softplus(-(w0 + jnp.tanh(w_lo) @ w2)) - 0.5
    a = jax.nn.sigmoid(a0 + a_lo @ a2)
    g = jax.nn.sigmoid(g_lo) @ g2
    kk = heads(k * k_k)
    kk = kk / jnp.maximum(jnp.linalg.norm(kk, axis=-1, keepdims=True), 1e-12)
    k = k * (1.0 + (a - 1.0) * k_a)
    decay = jnp.exp(-jnp.exp(heads(w)))
    rh, kh, vh, ah = heads(r), heads(k), heads(v), heads(a)
    y = _rwkv7_recurrence(rh, decay, kh, vh, -kk, kk * ah)
    y = _head_layernorm(y, A_GN_EPS) * ln_w.reshape(A_HEADS, HEAD_DIM) + ln_b.reshape(A_HEADS, HEAD_DIM)
    y = y + jnp.sum(rh * kh * r_k, axis=-1, keepdims=True) * vh
    return y.reshape(Bsz, T, A_WIDTH).astype(dt) * g


def dsa_mixer(q, c_kv, iq, ik, iw, kv_norm, w_uk, w_uv):
    Bsz, T, _ = q.shape
    n_keys = T
    topk = min(B_TOPK_MAX, n_keys // 4)
    nb = T // B_QUERY_BLOCK
    c = rmsnorm(c_kv, kv_norm)
    qh = q.reshape(Bsz, T, B_HEADS, HEAD_DIM)
    q_lat = jnp.einsum('bthd,hdc->bthc', qh, w_uk) * HEAD_DIM ** -0.5
    iqh = iq.reshape(Bsz, T, B_IDX_HEADS, B_IDX_DIM) * B_IDX_DIM ** -0.5
    iwh = iw * B_IDX_HEADS ** -0.5
    key_pos = jnp.arange(n_keys)
    blocks = lambda z: jnp.moveaxis(z.reshape((Bsz, nb, B_QUERY_BLOCK) + z.shape[2:]), 1, 0)

    def one_block(args):
        q_lat_b, iq_b, iw_b, blk = args
        q_pos = blk * B_QUERY_BLOCK + jnp.arange(B_QUERY_BLOCK)
        rel = jax.nn.relu(jnp.einsum('bqhd,bsd->bqhs', iq_b, ik))
        score = jnp.einsum('bqh,bqhs->bqs', iw_b, rel).astype(jnp.float32)
        visible = key_pos[None, :] <= q_pos[:, None]
        score = jnp.where(visible[None], score, -jnp.inf)
        _, idx = lax.top_k(score, topk)
        valid = idx <= q_pos[None, :, None]
        c_sel = jax.vmap(lambda cb, ib: cb[ib])(c, idx)
        logits = jnp.einsum('bqhc,bqkc->bqhk', q_lat_b, c_sel).astype(jnp.float32)
        logits = jnp.where(valid[:, :, None, :], logits, -jnp.inf)
        prob = jax.nn.softmax(logits, axis=-1).astype(c.dtype)
        o_lat = jnp.einsum('bqhk,bqkc->bqhc', prob, c_sel)
        return jnp.einsum('bqhc,hcd->bqhd', o_lat, w_uv)

    out = lax.map(one_block, (blocks(q_lat), blocks(iqh), blocks(iwh), jnp.arange(nb)))
    return jnp.moveaxis(out, 0, 1).reshape(Bsz, T, B_WIDTH)


def _retnet_rotate(z):
    T = z.shape[1]
    half = HEAD_DIM // 2
    theta = C_ROPE_BASE ** (-jnp.linspace(0.0, 1.0, half, dtype=jnp.float32))
    ang = jnp.arange(T, dtype=jnp.float32)[:, None] * theta[None, :]
    cos, sin = jnp.cos(ang)[None, :, None, :], jnp.sin(ang)[None, :, None, :]
    z1, z2 = z[..., :half], z[..., half:]
    return jnp.concatenate([z1 * cos - z2 * sin, z1 * sin + z2 * cos], axis=-1)


def retention_mixer(q, k, v, g):
    Bsz, T, _ = q.shape
    nc = T // C_CHUNK
    dt = q.dtype
    f32 = jnp.float32
    heads = lambda z: z.astype(f32).reshape(Bsz, T, C_HEADS, HEAD_DIM)
    qh = _retnet_rotate(heads(q))
    kh = _retnet_rotate(heads(k)) * HEAD_DIM ** -0.5
    vh = heads(v)
    log_gamma = jnp.log(1.0 - 2.0 ** (-5.0 - jnp.arange(C_HEADS, dtype=f32)))
    n = jnp.arange(C_CHUNK, dtype=f32)
    diff = n[:, None] - n[None, :]
    intra = jnp.where(diff[None] >= 0, jnp.exp(jnp.maximum(diff, 0.0)[None] * log_gamma[:, None, None]), 0.0)
    q_decay = jnp.exp((n[:, None] + 1.0) * log_gamma[None, :])
    k_decay = jnp.exp((C_CHUNK - 1.0 - n)[:, None] * log_gamma[None, :])
    chunk_decay = jnp.exp(C_CHUNK * log_gamma)
    chunks = lambda z: jnp.moveaxis(z.reshape(Bsz, nc, C_CHUNK, C_HEADS, HEAD_DIM), 1, 0)

    def step(state, inp):
        qc, kc, vc = inp
        scores = jnp.einsum('bnhd,bmhd->bhnm', qc, kc) * intra[None]
        inner = jnp.einsum('bhnm,bmhe->bnhe', scores, vc)
        cross = jnp.einsum('bnhd,bhde->bnhe', qc, state) * q_decay[None, :, :, None]
        state = state * chunk_decay[None, :, None, None] + jnp.einsum('bmhd,bmhe->bhde', kc * k_decay[None, :, :, None], vc)
        return state, inner + cross

    state0 = jnp.zeros((Bsz, C_HEADS, HEAD_DIM, HEAD_DIM), f32)
    _, y = lax.scan(step, state0, (chunks(qh), chunks(kh), chunks(vh)))
    y = jnp.moveaxis(y, 0, 1).reshape(Bsz, T, C_HEADS, HEAD_DIM)
    y = y * lax.rsqrt(jnp.mean(y * y, axis=-1, keepdims=True) + NORM_EPS)
    return jax.nn.silu(g) * y.reshape(Bsz, T, C_WIDTH).astype(dt)


def setup_inputs(seed: int = 0) -> dict:
    key = jax.random.key(seed)
    counter = [0]

    def nk():
        counter[0] += 1
        return jax.random.fold_in(key, counter[0])

    def nrm(shape, scale):
        return jax.random.normal(nk(), shape, jnp.float32) * scale

    def gain(shape):
        return 1.0 + nrm(shape, 0.02)

    L = DEPTH
    return {
        'x': nrm((BATCH, SEQ, D_MODEL), 1.0),
        'ffn1_norm': gain((L, D_MODEL)),
        'ffn1_w_gate': nrm((L, D_MODEL, D_FF), D_MODEL ** -0.5),
        'ffn1_w_up': nrm((L, D_MODEL, D_FF), D_MODEL ** -0.5),
        'ffn1_w_down': nrm((L, D_FF, D_MODEL), D_FF ** -0.5),
        'mix_norm': gain((L, D_MODEL)),
        'w_in': nrm((L, D_MODEL, N_IN), D_MODEL ** -0.5),
        'w_out': nrm((L, D_MIX, D_MODEL), D_MIX ** -0.5),
        'rwkv_mu': jax.random.uniform(nk(), (L, A_IN), jnp.float32),
        'rwkv_w0': jnp.linspace(-6.0, -1.0, A_WIDTH, dtype=jnp.float32)[None, :] + nrm((L, A_WIDTH), 0.1),
        'rwkv_w2': nrm((L, A_DECAY_LORA, A_WIDTH), 0.1),
        'rwkv_a0': nrm((L, A_WIDTH), 0.1),
        'rwkv_a2': nrm((L, A_AAA_LORA, A_WIDTH), 0.1),
        'rwkv_g2': nrm((L, A_GATE_LORA, A_WIDTH), A_GATE_LORA ** -0.5),
        'rwkv_k_k': 0.85 + nrm((L, A_WIDTH), 0.02),
        'rwkv_k_a': 1.0 + nrm((L, A_WIDTH), 0.02),
        'rwkv_r_k': nrm((L, A_HEADS, HEAD_DIM), 0.1),
        'rwkv_ln_w': gain((L, A_WIDTH)),
        'rwkv_ln_b': nrm((L, A_WIDTH), 0.01),
        'rwkv_vres_w_in': nrm((L - 1, D_MODEL, A_MV_LORA), D_MODEL ** -0.5),
        'rwkv_vres_mu': jax.random.uniform(nk(), (L - 1, A_MV_LORA), jnp.float32),
        'rwkv_v0': 0.5 + nrm((L - 1, A_WIDTH), 0.1),
        'rwkv_v2': nrm((L - 1, A_MV_LORA, A_WIDTH), 0.1),
        'dsa_kv_norm': gain((L, B_KV_LATENT)),
        'dsa_w_uk': nrm((L, B_HEADS, HEAD_DIM, B_KV_LATENT), B_KV_LATENT ** -0.5),
        'dsa_w_uv': nrm((L, B_HEADS, B_KV_LATENT, HEAD_DIM), B_KV_LATENT ** -0.5),
        'ffn2_norm': gain((L, D_MODEL)),
        'ffn2_w_gate': nrm((L, D_MODEL, D_FF), D_MODEL ** -0.5),
        'ffn2_w_up': nrm((L, D_MODEL, D_FF), D_MODEL ** -0.5),
        'ffn2_w_down': nrm((L, D_FF, D_MODEL), D_FF ** -0.5),
        'final_norm': gain((D_MODEL,)),
    }


def reference(x, ffn1_norm, ffn1_w_gate, ffn1_w_up, ffn1_w_down, mix_norm, w_in, w_out,
              rwkv_mu, rwkv_w0, rwkv_w2, rwkv_a0, rwkv_a2, rwkv_g2, rwkv_k_k, rwkv_k_a, rwkv_r_k,
              rwkv_ln_w, rwkv_ln_b, rwkv_vres_w_in, rwkv_vres_mu, rwkv_v0, rwkv_v2,
              dsa_kv_norm, dsa_w_uk, dsa_w_uv,
              ffn2_norm, ffn2_w_gate, ffn2_w_up, ffn2_w_down, final_norm):
    v_first = None
    for l in range(DEPTH):
        x = x + 0.5 * swiglu(rmsnorm(x, ffn1_norm[l]), ffn1_w_gate[l], ffn1_w_up[l], ffn1_w_down[l])
        h = rmsnorm(x, mix_norm[l])
        if l == 0:
            p_a, p_b, p_c = _split(h @ w_in[l], (A_IN, B_IN, C_IN))
        else:
            w_comb = jnp.concatenate([w_in[l], rwkv_vres_w_in[l - 1]], axis=1)
            p_a, p_b, p_c, p_mv = _split(h @ w_comb, (A_IN, B_IN, C_IN, A_MV_LORA))
        r, k, v, w_lo, a_lo, g_lo = _split(shift_lerp(p_a, rwkv_mu[l]), A_SLAB)
        if l == 0:
            v_first = v
        else:
            mv = shift_lerp(p_mv, rwkv_vres_mu[l - 1])
            v = v + (v_first - v) * jax.nn.sigmoid(rwkv_v0[l - 1] + mv @ rwkv_v2[l - 1])
        o_a = rwkv7_mixer(r, k, v, w_lo, a_lo, g_lo, rwkv_w0[l], rwkv_w2[l], rwkv_a0[l], rwkv_a2[l],
                          rwkv_g2[l], rwkv_k_k[l], rwkv_k_a[l], rwkv_r_k[l], rwkv_ln_w[l], rwkv_ln_b[l])
        q_b, c_b, iq_b, ik_b, iw_b = _split(p_b, B_SLAB)
        o_b = dsa_mixer(q_b, c_b, iq_b, ik_b, iw_b, dsa_kv_norm[l], dsa_w_uk[l], dsa_w_uv[l])
        q_c, k_c, v_c, g_c = _split(p_c, C_SLAB)
        o_c = retention_mixer(q_c, k_c, v_c, g_c)
        x = x + jnp.concatenate([o_a, o_b, o_c], axis=-1) @ w_out[l]
        x = x + 0.5 * swiglu(rmsnorm(x, ffn2_norm[l]), ffn2_w_gate[l], ffn2_w_up[l], ffn2_w_down[l])
    return rmsnorm(x, final_norm)
```

```cpp
#include <hip/hip_runtime.h>
#include <cstdio>
#include <cstdint>
#include <cmath>

namespace pg8 {
#define PG8_LAS __attribute__((address_space(3)))
typedef unsigned short bf16_t;
typedef short bf16x8 __attribute__((ext_vector_type(8)));
typedef float f32x4 __attribute__((ext_vector_type(4)));
typedef unsigned u32x4 __attribute__((ext_vector_type(4)));
constexpr int BM = 256, BK = 64, HALF = 128, HTB = HALF * BK * 2  , STAGE_BYTES = 8 * HTB, NXCD = 8, WGM = 8;

__host__ __device__ __forceinline__ int lds_byte(int r, int c) { const int st = (r >> 4) * 2 + (c >> 5), rr = r & 15, cc = c & 31, ob = rr * 64 + cc * 2; return st * 1024 + (ob ^ (((ob >> 9) & 1) << 5)); }
__host__ __device__ __forceinline__ void stage_rc(int b, int& R, int& C) { const int st = b / 1024, sb = b % 1024, swz = sb ^ (((sb >> 9) & 1) << 5); R = (st >> 1) * 16 + swz / 64; C = (st & 1) * 32 + (swz % 64) / 2; }
__host__ __device__ __forceinline__ int perm32(int rho) { const int n = rho >> 4, i = rho & 15; return 8 * (i >> 2) + 4 * n + (i & 3); }

struct Unit { int pm, pn; };
struct Gemm { const bf16_t* A; const bf16_t* Bt; int M, N, K, lda; };

struct StaticOrder {
    int nM, nN, nwg, G, c;
    __host__ __device__ void init(int M, int N, int G_, int c_) { nM = M / BM; nN = N / BM; nwg = nM * nN; G = G_; c = c_; }
    __host__ __device__ bool next(int i, Unit& u) const {
        const long L = (long)i * G + c; if (L >= nwg) return false;
        int wgid = (int)L; { const int q = nwg / NXCD, r = nwg % NXCD, xcd = wgid % NXCD, off = wgid / NXCD; wgid = (xcd < r ? xcd * (q + 1) : r * (q + 1) + (xcd - r) * q) + off; }
        const int nig = WGM * nN, gid = wgid / nig, fm = gid * WGM, gsz = (nM - fm) < WGM ? (nM - fm) : WGM;
        u.pm = fm + ((wgid % nig) % gsz); u.pn = (wgid % nig) / gsz; return true;
    }
    __device__ __forceinline__ void a_ready(const Unit&) const {}
    __device__ __forceinline__ void done(const Unit&) const {}
};

__device__ __forceinline__ unsigned cvt_pk_bf16(float lo, float hi) { unsigned r; asm volatile("v_cvt_pk_bf16_f32 %0, %1, %2" : "=v"(r) : "v"(lo), "v"(hi)); return r; }


__device__ __forceinline__ float row_rstd(const float* part, int row) {
    const f32x4* p = (const f32x4*)(part + (size_t)row * 16);
    const f32x4 a = p[0], b = p[1], c = p[2], d = p[3];
    const float s = ((a[0] + a[1]) + (a[2] + a[3])) + ((b[0] + b[1]) + (b[2] + b[3])) + ((c[0] + c[1]) + (c[2] + c[3])) + ((d[0] + d[1]) + (d[2] + d[3]));
    return 1.0f / sqrtf(s * (1.0f / 1024.0f) + 1e-6f);
}
__device__ __forceinline__ float silu_f(float x) { return x * __builtin_amdgcn_rcpf(1.0f + __expf(-x)); }

struct EpiUp {
    static constexpr bool PERM = true;
    bf16_t* H; int ldh; const float* part;
    __device__ __forceinline__ void operator()(const f32x4 (&acc)[2][2][4][2], const Unit& u, int wr, int wc, int fr, int fq) const {
        const int row0 = u.pm * BM + wr * 64 + fr, hcol = u.pn * 128 + wc * 32 + 8 * fq;
#pragma unroll
        for (int ai = 0; ai < 2; ++ai)
#pragma unroll
            for (int m = 0; m < 4; ++m) { const int row = row0 + ai * HALF + m * 16; const float rs = row_rstd(part, row);
                const f32x4 g0 = acc[ai][0][m][0] * rs, g1 = acc[ai][0][m][1] * rs, u0 = acc[ai][1][m][0] * rs, u1 = acc[ai][1][m][1] * rs;
                u32x4 w; w.x = cvt_pk_bf16(silu_f(g0[0]) * u0[0], silu_f(g0[1]) * u0[1]); w.y = cvt_pk_bf16(silu_f(g0[2]) * u0[2], silu_f(g0[3]) * u0[3]);
                w.z = cvt_pk_bf16(silu_f(g1[0]) * u1[0], silu_f(g1[1]) * u1[1]); w.w = cvt_pk_bf16(silu_f(g1[2]) * u1[2], silu_f(g1[3]) * u1[3]);
                *(u32x4*)(H + (size_t)row * ldh + hcol) = w; }
    }
};
struct EpiP {
    static constexpr bool PERM = true;
    bf16_t* P; int ldp; const float* part;
    __device__ __forceinline__ void operator()(const f32x4 (&acc)[2][2][4][2], const Unit& u, int wr, int wc, int fr, int fq) const {
        const int row0 = u.pm * BM + wr * 64 + fr, col0 = u.pn * BM + wc * 32 + 8 * fq;
#pragma unroll
        for (int ai = 0; ai < 2; ++ai)
#pragma unroll
            for (int m = 0; m < 4; ++m) { const int row = row0 + ai * HALF + m * 16; const float rs = row_rstd(part, row);
#pragma unroll
                for (int bj = 0; bj < 2; ++bj) { const f32x4 v0 = acc[ai][bj][m][0] * rs, v1 = acc[ai][bj][m][1] * rs;
                    u32x4 w; w.x = cvt_pk_bf16(v0[0], v0[1]); w.y = cvt_pk_bf16(v0[2], v0[3]); w.z = cvt_pk_bf16(v1[0], v1[1]); w.w = cvt_pk_bf16(v1[2], v1[3]);
                    *(u32x4*)(P + (size_t)row * ldp + col0 + bj * HALF) = w; } }
    }
};
struct EpiRes {
    static constexpr bool PERM = true;
    const float* base; float* out; bf16_t* xb; float* part;
    __device__ __forceinline__ void operator()(const f32x4 (&acc)[2][2][4][2], const Unit& u, int wr, int wc, int fr, int fq) const {
        const int row0 = u.pm * BM + wr * 64 + fr, col0 = u.pn * BM + wc * 32 + 8 * fq;
#pragma unroll
        for (int ai = 0; ai < 2; ++ai)
#pragma unroll
            for (int m = 0; m < 4; ++m) { const int row = row0 + ai * HALF + m * 16; float ss = 0.f;
#pragma unroll
                for (int bj = 0; bj < 2; ++bj) { const size_t off = (size_t)row * 1024 + col0 + bj * HALF;
                    const f32x4 v0 = acc[ai][bj][m][0] + *(const f32x4*)(base + off), v1 = acc[ai][bj][m][1] + *(const f32x4*)(base + off + 4);
                    *(f32x4*)(out + off) = v0; *(f32x4*)(out + off + 4) = v1;
                    u32x4 w; w.x = cvt_pk_bf16(v0[0], v0[1]); w.y = cvt_pk_bf16(v0[2], v0[3]); w.z = cvt_pk_bf16(v1[0], v1[1]); w.w = cvt_pk_bf16(v1[2], v1[3]);
                    *(u32x4*)(xb + off) = w;
                    ss += (v0[0] * v0[0] + v0[1] * v0[1]) + (v0[2] * v0[2] + v0[3] * v0[3]) + (v1[0] * v1[0] + v1[1] * v1[1]) + (v1[2] * v1[2] + v1[3] * v1[3]); }
                ss += __shfl_xor(ss, 16); ss += __shfl_xor(ss, 32);
                if (fq == 0) part[(size_t)row * 16 + u.pn * 4 + wc] = ss;
                asm volatile("" ::: "memory"); }
    }
};

template <class Epi, class Sched, bool ALIGN_EPI>
__device__ __forceinline__ void gemm_phase(PG8_LAS unsigned char* lds, const Gemm g, const Sched& S, const Epi& E, const int tid) {
    const int wid = __builtin_amdgcn_readfirstlane(tid >> 6), lane = tid & 63, wr = wid >> 2, wc = wid & 3, fr = lane & 15, fq = lane >> 4;
    const int K = g.K, nt = K / BK, lda = g.lda;
    unsigned voffA[2], voffB[2];
#pragma unroll
    for (int i = 0; i < 2; ++i) { int R, C; stage_rc(tid * 16 + i * 8192, R, C); const int Rb = Epi::PERM ? ((R & ~31) + perm32(R & 31)) : R;
        voffA[i] = (unsigned)(R * lda + C) * 2u; voffB[i] = (unsigned)(Rb * K + C) * 2u; }
    const size_t kstep = (size_t)(BK * 2);
    const size_t hstepA = (size_t)HALF * lda * 2, hstepB = (size_t)HALF * K * 2;
    const size_t tstepA = 2 * hstepA, tstepB = 2 * hstepB;
    const unsigned ldsw = (unsigned)wid * 1024u;
    const int aoff = lds_byte(wr * 64 + fr, fq * 8), boff = lds_byte(wc * 32 + fr, fq * 8);
#define PG8_SA(b, h) (((b) * 2 + (h)) * HTB)
#define PG8_SB(b, h) ((4 + (b) * 2 + (h)) * HTB)
#define PG8_STAGE(bufoff, gbase, voff) do { _Pragma("unroll") for (int _i = 0; _i < 2; ++_i) \
        __builtin_amdgcn_global_load_lds((const unsigned*)((const char*)(gbase) + (voff)[_i]), (PG8_LAS unsigned*)(lds + (bufoff) + ldsw + _i * 8192), 16, 0, 0); } while (0)
#define PG8_LDA(dst, b, h) do { _Pragma("unroll") for (int m = 0; m < 4; ++m) _Pragma("unroll") for (int k = 0; k < 2; ++k) dst[m][k] = *(const PG8_LAS bf16x8*)(lds + PG8_SA(b, h) + aoff + m * 2048 + k * 1024); } while (0)
#define PG8_LDB(dst, b, h) do { _Pragma("unroll") for (int n = 0; n < 2; ++n) _Pragma("unroll") for (int k = 0; k < 2; ++k) dst[n][k] = *(const PG8_LAS bf16x8*)(lds + PG8_SB(b, h) + boff + n * 2048 + k * 1024); } while (0)
#define PG8_MMA(ai, bj, At, Bt) do { __builtin_amdgcn_s_setprio(1); _Pragma("unroll") for (int m = 0; m < 4; ++m) _Pragma("unroll") for (int n = 0; n < 2; ++n) _Pragma("unroll") for (int k = 0; k < 2; ++k) \
        acc[ai][bj][m][n] = __builtin_amdgcn_mfma_f32_16x16x32_bf16(Bt[n][k], At[m][k], acc[ai][bj][m][n], 0, 0, 0); __builtin_amdgcn_s_setprio(0); } while (0)
#define PG8_WAIT_V(n) asm volatile("s_waitcnt vmcnt(" #n ")" ::: "memory")
#define PG8_WAIT_L(n) asm volatile("s_waitcnt lgkmcnt(" #n ")" ::: "memory")
#define PG8_BAR __builtin_amdgcn_s_barrier()
#define PG8_SCHED __builtin_amdgcn_sched_barrier(0)
    Unit cur, nxt; int ui = 0;
    if (!S.next(0, cur)) return;
    f32x4 acc[2][2][4][2];
#pragma unroll
    for (int a = 0; a < 2; ++a)
#pragma unroll
        for (int b = 0; b < 2; ++b)
#pragma unroll
            for (int m = 0; m < 4; ++m)
#pragma unroll
                for (int n = 0; n < 2; ++n) acc[a][b][m][n] = (f32x4){0.f, 0.f, 0.f, 0.f};
    bf16x8 At[4][2], B0[2][2], B1[2][2];
    const char* cA = (const char*)g.A + (size_t)cur.pm * tstepA; const char* cB = (const char*)g.Bt + (size_t)cur.pn * tstepB;
    S.a_ready(cur);
    PG8_STAGE(PG8_SB(0, 0), cB, voffB); PG8_STAGE(PG8_SB(0, 1), cB + hstepB, voffB); PG8_STAGE(PG8_SA(0, 0), cA, voffA); PG8_STAGE(PG8_SA(0, 1), cA + hstepA, voffA);
    if (wr == 1) PG8_BAR;
    PG8_WAIT_V(2); PG8_BAR;
    PG8_STAGE(PG8_SB(1, 0), cB + kstep, voffB); PG8_STAGE(PG8_SA(1, 0), cA + kstep, voffA); PG8_STAGE(PG8_SB(1, 1), cB + hstepB + kstep, voffB);
    PG8_WAIT_V(6); PG8_BAR;
    for (;;) {
        const bool has_next = S.next(ui + 1, nxt);
        const char* nA = has_next ? (const char*)g.A + (size_t)nxt.pm * tstepA : cA; const char* nB = has_next ? (const char*)g.Bt + (size_t)nxt.pn * tstepB : cB;
        for (int t = 0; t < nt; t += 2) {
            const bool last = (t == nt - 2);
            const char* a1 = cA + (size_t)(t + 1) * kstep;
            const char* a2 = last ? nA : cA + (size_t)(t + 2) * kstep; const char* b2 = last ? nB : cB + (size_t)(t + 2) * kstep;
            const char* a3 = a2 + kstep; const char* b3 = b2 + kstep;
            if (last && has_next) S.a_ready(nxt);
            PG8_LDB(B0, 0, 0); PG8_LDB(B1, 0, 1); PG8_SCHED; PG8_LDA(At, 0, 0); PG8_STAGE(PG8_SA(1, 1), a1 + hstepA, voffA);
            PG8_WAIT_V(8); PG8_WAIT_L(0); PG8_BAR; PG8_MMA(0, 0, At, B0); PG8_MMA(0, 1, At, B1); PG8_BAR; PG8_SCHED;
            PG8_LDA(At, 0, 1); PG8_STAGE(PG8_SB(0, 0), b2, voffB); PG8_STAGE(PG8_SB(0, 1), b2 + hstepB, voffB); PG8_STAGE(PG8_SA(0, 0), a2, voffA);
            PG8_WAIT_V(8); PG8_WAIT_L(0); PG8_BAR; PG8_MMA(1, 0, At, B0); PG8_MMA(1, 1, At, B1); PG8_BAR; PG8_SCHED;
            PG8_LDB(B0, 1, 0); PG8_LDB(B1, 1, 1); PG8_SCHED; PG8_LDA(At, 1, 0); PG8_STAGE(PG8_SA(0, 1), a2 + hstepA, voffA);
            PG8_WAIT_V(8); PG8_WAIT_L(0); PG8_BAR; PG8_MMA(0, 0, At, B0); PG8_MMA(0, 1, At, B1); PG8_BAR; PG8_SCHED;
            PG8_LDA(At, 1, 1); PG8_STAGE(PG8_SB(1, 0), b3, voffB); PG8_STAGE(PG8_SB(1, 1), b3 + hstepB, voffB); PG8_STAGE(PG8_SA(1, 0), a3, voffA);
            PG8_WAIT_V(8); PG8_WAIT_L(0); PG8_BAR; PG8_MMA(1, 0, At, B0); PG8_MMA(1, 1, At, B1); PG8_BAR; PG8_SCHED;
        }
        if constexpr (ALIGN_EPI) { if (wr == 0) PG8_BAR; }
        E(acc, cur, wr, wc, fr, fq); S.done(cur);
        if (!has_next) break;
#pragma unroll
        for (int a = 0; a < 2; ++a)
#pragma unroll
            for (int b = 0; b < 2; ++b)
#pragma unroll
                for (int m = 0; m < 4; ++m)
#pragma unroll
                    for (int n = 0; n < 2; ++n) acc[a][b][m][n] = (f32x4){0.f, 0.f, 0.f, 0.f};
        cur = nxt; cA = nA; cB = nB; ++ui;
        if constexpr (ALIGN_EPI) { if (wr == 1) PG8_BAR; }
    }
    PG8_WAIT_V(0);
    if constexpr (!ALIGN_EPI) { if (wr == 0) PG8_BAR; }
    PG8_BAR;
#undef PG8_SA
#undef PG8_SB
#undef PG8_STAGE
#undef PG8_LDA
#undef PG8_LDB
#undef PG8_MMA
#undef PG8_WAIT_V
#undef PG8_WAIT_L
#undef PG8_BAR
#undef PG8_SCHED
}
}

constexpr int NWAVES = 8, NTHR = 512;
constexpr int BATCH = 8, SEQ = 2048, DM = 1024, DEPTH = 2, FF = 2752, M = BATCH * SEQ;
constexpr int FFP = 2816;
constexpr int NGU = 5632;
constexpr int PP = 3584;
constexpr int NIN = 3400;
constexpr int PA = 0, PMV = 1280, PBQ = 1296, PBC = 1680, PBIQ = 1808, PBIK = 2320, PBIW = 2384, PCQ = 2392, PCK = 2648, PCV = 2904, PCG = 3160, PUSED = 3416;
constexpr int AW = 384;
constexpr int TOPK = 256;

constexpr size_t MiB = 1u << 20;
constexpr size_t WS_CTL = 0, CTL_ZERO_BYTES = 1 * MiB;
constexpr size_t WS_PART = 1 * MiB;
constexpr size_t WS_TAB = 2 * MiB;
constexpr size_t WS_BON = 2 * MiB + 512 * 1024;
constexpr size_t WS_WGU1 = 4 * MiB, WS_WD1 = 15 * MiB, WS_WIN = 21 * MiB, WS_WOUT = 28 * MiB, WS_WGU2 = 30 * MiB, WS_WD2 = 41 * MiB;
constexpr size_t WS_XB = 47 * MiB;
constexpr size_t WS_VF = 79 * MiB;
constexpr size_t WS_P = 91 * MiB;
constexpr size_t WS_H = WS_P;
constexpr size_t WS_R = 203 * MiB, WS_D = 215 * MiB, WS_K2 = 227 * MiB, WS_KK = 239 * MiB, WS_C = 251 * MiB;
constexpr size_t WS_BP = WS_XB, WS_G = WS_XB + 12 * MiB, WS_KV = WS_XB + 24 * MiB;
constexpr size_t WS_END = 256 * MiB;
static_assert(WS_WD2 + (size_t)1024 * FFP * 2 <= WS_XB && WS_P + (size_t)M * PP * 2 <= WS_R && WS_C + (size_t)M * 128 * 2 <= WS_END, "ws map");
constexpr int CW_BAR = 4096;
constexpr int CW_QUEUE = 16384;

constexpr int RING_BYTES = 131072;
constexpr int LDSCTL_OFF = RING_BYTES, MISC_OFF = LDSCTL_OFF + 320;
constexpr int LDS_BYTES = 147456;

#define GAS __attribute__((address_space(1)))
#define LAS __attribute__((address_space(3)))
typedef unsigned short bf16;
typedef unsigned v4u __attribute__((ext_vector_type(4)));
typedef float f32x4 __attribute__((ext_vector_type(4)));
typedef GAS unsigned gu32;
#define RLX_AGENT __ATOMIC_RELAXED, __HIP_MEMORY_SCOPE_AGENT
#define LDS_WAIT() asm volatile("s_waitcnt lgkmcnt(0)" ::: "memory")
__device__ __forceinline__ unsigned f2bf(float f) { unsigned u = __builtin_bit_cast(unsigned, f); return (u + 0x7fffu + ((u >> 16) & 1u)) >> 16; }
__device__ __forceinline__ unsigned pk2(float lo, float hi) { return f2bf(lo) | (f2bf(hi) << 16); }
__device__ __forceinline__ float bf2f(unsigned short v) { return __uint_as_float((unsigned)v << 16); }
__device__ __forceinline__ float bflo(unsigned w) { return __uint_as_float(w << 16); }
__device__ __forceinline__ float bfhi(unsigned w) { return __uint_as_float(w & 0xffff0000u); }
__device__ __forceinline__ void unpack8(const v4u w, float (&f)[8]) { f[0] = bflo(w.x); f[1] = bfhi(w.x); f[2] = bflo(w.y); f[3] = bfhi(w.y); f[4] = bflo(w.z); f[5] = bfhi(w.z); f[6] = bflo(w.w); f[7] = bfhi(w.w); }
__device__ __forceinline__ float sigmoid_f(float x) { return 1.0f / (1.0f + __expf(-x)); }
__device__ __forceinline__ float wave_sum(float v) {
#pragma unroll
    for (int o = 1; o < 64; o <<= 1) v += __shfl_xor(v, o);
    return v;
}

#define XB_TMO      128
#define XB_XCNT(j)  (256  + 64 * (j))
#define XB_XSUB(j)  (1280 + 64 * (j))
#define XB_XGEN(j)  (2304 + 64 * (j))
#define XB_TOP      3328
#define XB_TOPGEN   3392
#define XCD_BAR_WORDS 3456
#define XB_SPIN_CAP (1u << 22)

__device__ __forceinline__ unsigned xb_ld(unsigned* p)              { return __hip_atomic_load(p, __ATOMIC_RELAXED, __HIP_MEMORY_SCOPE_AGENT); }
__device__ __forceinline__ unsigned xb_add(unsigned* p, unsigned v) { return __hip_atomic_fetch_add(p, v, __ATOMIC_RELAXED, __HIP_MEMORY_SCOPE_AGENT); }
__device__ __forceinline__ unsigned xb_xcc_id() { return (unsigned)__builtin_amdgcn_s_getreg((3 << 11) | 20) & 0xFu; }
#define XB_SPIN(cond, bar) do { unsigned _sp = 0; while (cond) { __builtin_amdgcn_s_sleep(1); \
    if ((++_sp & 255u) == 0u) { if (xb_ld(&(bar)[XB_TMO])) break; if (_sp > XB_SPIN_CAP) { atomicAdd(&(bar)[XB_TMO], 1u); break; } } } } while (0)

struct XcdBarrier { unsigned* bar; unsigned x; volatile LAS unsigned* st; };

__device__ __forceinline__ XcdBarrier xcd_barrier_post(unsigned* bar, volatile LAS unsigned* st) {
    XcdBarrier b; b.bar = bar; b.x = xb_xcc_id(); b.st = st;
    if (threadIdx.x == 0) (void)xb_add(&bar[XB_XCNT(b.x)], 1u);
    return b;
}
__device__ __forceinline__ void xcd_barrier_complete(unsigned* bar, unsigned x, unsigned& nloc, unsigned& nx) {
    const unsigned G = gridDim.x * gridDim.y * gridDim.z;
    unsigned sum, cnt, mine, sp = 0u;
    for (;;) {
        sum = 0u; cnt = 0u; mine = 0u;
#pragma unroll
        for (unsigned j = 0; j < 16; ++j) { const unsigned c = xb_ld(&bar[XB_XCNT(j)]); sum += c; cnt += (c > 0u) ? 1u : 0u; mine = (j == x) ? c : mine; }
        if (sum == G) break;
        __builtin_amdgcn_s_sleep(1);
        if ((++sp & 255u) == 0u) { if (xb_ld(&bar[XB_TMO])) break; if (sp > XB_SPIN_CAP) { atomicAdd(&bar[XB_TMO], 1u); break; } }
    }
    nloc = mine > 0u ? mine : 1u; nx = cnt > 0u ? cnt : 1u;
}
__device__ __forceinline__ void xcd_barrier(const XcdBarrier& b) {
    asm volatile("s_waitcnt vmcnt(0)" ::: "memory");
    __syncthreads();
    if (threadIdx.x == 0) {
        unsigned* bar = b.bar;
        __builtin_amdgcn_s_waitcnt(0);
        unsigned nloc = b.st[0], nx = b.st[1];
        if (nloc == 0u) { xcd_barrier_complete(bar, b.x, nloc, nx); b.st[0] = nloc; b.st[1] = nx; }
        const unsigned old = xb_add(&bar[XB_XSUB(b.x)], 1u);
        const unsigned gen = old / nloc;
        if (old + 1u == (gen + 1u) * nloc) {
            __builtin_amdgcn_fence(__ATOMIC_RELEASE, "agent");
            asm volatile("s_waitcnt vmcnt(0)" ::: "memory");
            const unsigned og = xb_add(&bar[XB_TOP], 1u);
            const unsigned tg = og / nx;
            if (og + 1u == (tg + 1u) * nx) xb_add(&bar[XB_TOPGEN], 1u);
            else XB_SPIN(xb_ld(&bar[XB_TOPGEN]) == tg, bar);
            __builtin_amdgcn_fence(__ATOMIC_ACQUIRE, "agent");
            xb_add(&bar[XB_XGEN(b.x)], 1u);
            asm volatile("s_waitcnt vmcnt(0)" ::: "memory");
        } else {
            XB_SPIN(xb_ld(&bar[XB_XGEN(b.x)]) == gen, bar);
            __builtin_amdgcn_fence(__ATOMIC_ACQUIRE, "agent");
            asm volatile("s_waitcnt vmcnt(0)" ::: "memory");
        }
    }
    __syncthreads();
}

struct Args { const float* in[31]; float* out; unsigned char* ws; int ph_lo, ph_hi; };
struct Frame {
    LAS unsigned char* lds;
    int tid, lane, wave, vcu, G;
    const float* const* in; float* out; unsigned char* ws;
};
enum { I_X = 0, I_F1N, I_F1G, I_F1U, I_F1D, I_MIXN, I_WIN, I_WOUT, I_MU, I_W0, I_W2, I_A0, I_A2, I_G2, I_KK, I_KA, I_RK, I_LNW, I_LNB, I_VRW, I_VRMU, I_V0, I_V2, I_KVN, I_WUK, I_WUV, I_F2N, I_F2G, I_F2U, I_F2D, I_FN };

__device__ __forceinline__ void conv_item(const Frame& F, int l, int kind, int item, LAS float* scr) {
    const int lane = F.lane;
    int Kd, nkb; bf16* WT;
    if (kind == 0 || kind == 4) { Kd = 1024; WT = (bf16*)(F.ws + (kind == 0 ? WS_WGU1 : WS_WGU2)); }
    else if (kind == 1 || kind == 5) { Kd = FFP; WT = (bf16*)(F.ws + (kind == 1 ? WS_WD1 : WS_WD2)); }
    else if (kind == 2) { Kd = 1024; WT = (bf16*)(F.ws + WS_WIN); }
    else { Kd = 1024; WT = (bf16*)(F.ws + WS_WOUT); }
    nkb = Kd / 64;
    const int rb = item / nkb, kb = item % nkb, r0 = rb * 32, k0 = kb * 64;
    const int rr = r0 + (lane & 31);
    const float* src = nullptr; int ns = 0, col = 0, ksrc = 1024; const float* gain = nullptr; float scale = 1.0f;
    if (kind == 0 || kind == 4) {
        const int tile = rr >> 8, w = rr & 255, hid = tile * 128 + (w & 127);
        if (hid < FF) { const float* s1 = (w >> 7) ? F.in[I_F1U] : F.in[I_F1G]; const float* s2 = (w >> 7) ? F.in[I_F2U] : F.in[I_F2G]; src = ((kind == 0) ? s1 : s2) + (size_t)l * 1024 * FF; ns = FF; col = hid; }
        gain = ((kind == 0) ? F.in[I_F1N] : F.in[I_F2N]) + l * 1024;
    } else if (kind == 1 || kind == 5) {
        src = ((kind == 1) ? F.in[I_F1D] : F.in[I_F2D]) + (size_t)l * FF * 1024; ns = 1024; col = rr; ksrc = FF; scale = 0.5f;
    } else if (kind == 2) {
        gain = F.in[I_MIXN] + l * 1024;
        if (rr < 1280) { src = F.in[I_WIN] + (size_t)l * 1024 * NIN; ns = NIN; col = rr; }
        else if (rr < 1296) { if (l > 0) { src = F.in[I_VRW] + (size_t)(l - 1) * 1024 * 16; ns = 16; col = rr - 1280; } }
        else if (rr < PUSED) { src = F.in[I_WIN] + (size_t)l * 1024 * NIN; ns = NIN; col = rr - 16; }
    } else { src = F.in[I_WOUT] + (size_t)l * 1024 * 1024; ns = 1024; col = rr; }
#pragma unroll 8
    for (int i = 0; i < 32; ++i) { const int kk = 2 * i + (lane >> 5), k = k0 + kk; float v = 0.f;
        if (src != nullptr && k < ksrc) { v = src[(size_t)k * ns + col] * scale; if (gain) v *= gain[k]; }
        scr[kk * 33 + (lane & 31)] = v; }
    LDS_WAIT(); asm volatile("" ::: "memory");
    const int c = lane & 7;
#pragma unroll
    for (int j = 0; j < 4; ++j) { const int n = (lane >> 3) + 8 * j; const LAS float* s = scr + (8 * c) * 33 + n;
        v4u o; o.x = pk2(s[0 * 33], s[1 * 33]); o.y = pk2(s[2 * 33], s[3 * 33]); o.z = pk2(s[4 * 33], s[5 * 33]); o.w = pk2(s[6 * 33], s[7 * 33]);
        *(GAS v4u*)(WT + (size_t)(r0 + n) * Kd + k0 + 8 * c) = o; }
    LDS_WAIT(); asm volatile("" ::: "memory");
}
__host__ __device__ constexpr int conv_items(int kind) { return (kind == 0 || kind == 4) ? (NGU / 32) * 16 : (kind == 1 || kind == 5) ? 32 * (FFP / 64) : (kind == 2) ? (PP / 32) * 16 : 32 * 16; }
__device__ __forceinline__ void conv_weights(const Frame& F, int l, int k_lo, int k_hi) {
    LAS float* scr = (LAS float*)(F.lds + F.wave * 16384);
    const int gw = F.vcu * NWAVES + F.wave, NGW = F.G * NWAVES;
    for (int kind = k_lo; kind < k_hi; ++kind) { const int ni = conv_items(kind);
        for (int it = gw; it < ni; it += NGW) conv_item(F, l, kind, it, scr); }
}

__device__ __forceinline__ void p0_x(const Frame& F) {
    const int gw = F.vcu * NWAVES + F.wave, NGW = F.G * NWAVES;
    const float* x = F.in[I_X]; bf16* xb = (bf16*)(F.ws + WS_XB); float* part = (float*)(F.ws + WS_PART);
    for (int m = gw; m < M; m += NGW) {
        const GAS f32x4* xr = (const GAS f32x4*)(x + (size_t)m * DM) + F.lane; float s = 0.f;
        GAS unsigned long long* o8 = (GAS unsigned long long*)(xb + (size_t)m * DM) + F.lane;
#pragma unroll
        for (int j = 0; j < 4; ++j) { const f32x4 v = xr[64 * j]; s += (v.x * v.x + v.y * v.y) + (v.z * v.z + v.w * v.w);
            o8[64 * j] = (unsigned long long)pk2(v.x, v.y) | ((unsigned long long)pk2(v.z, v.w) << 32); }
        s = wave_sum(s);
        if (F.lane < 16) part[(size_t)m * 16 + F.lane] = (F.lane == 0) ? s : 0.f;
    }
}
__device__ __forceinline__ void p0_table(const Frame& F) {
    float* tab = (float*)(F.ws + WS_TAB);
    for (int i = F.vcu * NTHR + F.tid; i < SEQ * 32; i += F.G * NTHR) { const int t = i >> 5, f = i & 31; const float th = exp2f(-(float)f * (13.287712379549449f / 31.0f)); const float ang = (float)t * th; float s, c; sincosf(ang, &s, &c); tab[2 * i] = c; tab[2 * i + 1] = s; }
}

constexpr int PT = 16;
__device__ __forceinline__ void prep_tokens_unit(const Frame& F, int l, int unit) {
    LAS float* xs = (LAS float*)F.lds; LAS float* rn = xs + PT * 1296; LAS float* prod = rn + PT * 8;
    const int tid = F.tid, tok0 = unit * PT;
    const bf16* P = (const bf16*)(F.ws + WS_P);
    const float* mu = F.in[I_MU] + l * 1280; const float* vmu = F.in[I_VRMU] + (l > 0 ? (l - 1) * 16 : 0);
    for (int idx = tid; idx < PT * 162; idx += NTHR) { const int t = idx / 162, ch = idx - t * 162, tok = tok0 + t, c0 = ch * 8;
        const v4u cw = *(const GAS v4u*)(P + (size_t)tok * PP + c0); float cur[8], prv[8]; unpack8(cw, cur);
        if ((tok & (SEQ - 1)) != 0) { const v4u pw = *(const GAS v4u*)(P + (size_t)(tok - 1) * PP + c0); unpack8(pw, prv); }
        else {
#pragma unroll
            for (int j = 0; j < 8; ++j) prv[j] = 0.f; }
#pragma unroll
        for (int j = 0; j < 8; ++j) { const int c = c0 + j; const float m = (c < 1280) ? mu[c] : ((l > 0) ? vmu[c - 1280] : 0.f);
            float v = cur[j] + (prv[j] - cur[j]) * m;
            if (c >= 1152 && c < 1184) v = tanhf(v); else if (c >= 1216 && c < 1280) v = sigmoid_f(v);
            xs[t * 1296 + c] = v; } }
    __syncthreads();
    if (tid < PT * 6) { const int t = tid / 6, h = tid - t * 6; const float* kkw = F.in[I_KK] + l * AW + h * 64; float ss = 0.f;
        for (int j = 0; j < 64; ++j) { const float v = xs[t * 1296 + 384 + h * 64 + j] * kkw[j]; ss += v * v; }
        rn[t * 8 + h] = 1.0f / fmaxf(sqrtf(ss), 1e-12f); }
    __syncthreads();
    {
        const int cg = tid & 127, tg = tid >> 7;
        const float* w2 = F.in[I_W2] + (size_t)l * 32 * AW; const float* a2 = F.in[I_A2] + (size_t)l * 32 * AW; const float* g2 = F.in[I_G2] + (size_t)l * 64 * AW;
        const float* v2 = F.in[I_V2] + (size_t)(l > 0 ? l - 1 : 0) * 16 * AW;
        bf16* R = (bf16*)(F.ws + WS_R); bf16* Dd = (bf16*)(F.ws + WS_D); bf16* K2 = (bf16*)(F.ws + WS_K2); bf16* KK = (bf16*)(F.ws + WS_KK); bf16* BP = (bf16*)(F.ws + WS_BP); bf16* Gg = (bf16*)(F.ws + WS_G); bf16* VF = (bf16*)(F.ws + WS_VF);
        for (int ci = 0; ci < 3; ++ci) { const int j = cg + 128 * ci, h = j >> 6;
            float wacc[4], aacc[4], gacc[4], macc[4];
            const float w0 = F.in[I_W0][l * AW + j], a0 = F.in[I_A0][l * AW + j], v0 = (l > 0) ? F.in[I_V0][(l - 1) * AW + j] : 0.f;
#pragma unroll
            for (int tt = 0; tt < 4; ++tt) { wacc[tt] = w0; aacc[tt] = a0; gacc[tt] = 0.f; macc[tt] = v0; }
            for (int i = 0; i < 32; ++i) { const float ww = w2[i * AW + j], aa = a2[i * AW + j];
#pragma unroll
                for (int tt = 0; tt < 4; ++tt) { const int t = 4 * tg + tt; wacc[tt] += xs[t * 1296 + 1152 + i] * ww; aacc[tt] += xs[t * 1296 + 1184 + i] * aa; } }
            for (int i = 0; i < 64; ++i) { const float gg = g2[i * AW + j];
#pragma unroll
                for (int tt = 0; tt < 4; ++tt) { const int t = 4 * tg + tt; gacc[tt] += xs[t * 1296 + 1216 + i] * gg; } }
            if (l > 0) for (int i = 0; i < 16; ++i) { const float vv = v2[i * AW + j];
#pragma unroll
                for (int tt = 0; tt < 4; ++tt) { const int t = 4 * tg + tt; macc[tt] += xs[t * 1296 + 1280 + i] * vv; } }
            const float kkw = F.in[I_KK][l * AW + j], kaw = F.in[I_KA][l * AW + j], rkw = F.in[I_RK][l * AW + j];
#pragma unroll
            for (int tt = 0; tt < 4; ++tt) { const int t = 4 * tg + tt, tok = tok0 + t; const size_t o = (size_t)tok * AW + j;
                const float r = xs[t * 1296 + j], k = xs[t * 1296 + 384 + j]; float v = xs[t * 1296 + 768 + j];
                const float z = -wacc[tt];
                const float sp = fmaxf(z, 0.f) + log1pf(__expf(-fabsf(z)));
                const float rate = __expf(-sp - 0.5f);
                const float d = -expm1f(-rate);
                const float a = sigmoid_f(aacc[tt]);
                if (l > 0) { const float vf = bf2f(VF[o]); v = v + (vf - v) * sigmoid_f(macc[tt]); }
                VF[o] = (bf16)f2bf(v);
                const float kk = k * kkw * rn[t * 8 + h], k2 = k * (1.0f + (a - 1.0f) * kaw);
                R[o] = (bf16)f2bf(r); Dd[o] = (bf16)f2bf(d); K2[o] = (bf16)f2bf(k2); KK[o] = (bf16)f2bf(kk); BP[o] = (bf16)f2bf(kk * a); Gg[o] = (bf16)f2bf(gacc[tt]);
                prod[t * AW + j] = r * k2 * rkw; }
        }
    }
    __syncthreads();
    if (tid < PT * 6) { const int t = tid / 6, h = tid - t * 6; float s = 0.f; for (int j = 0; j < 64; ++j) s += prod[t * AW + h * 64 + j];
        ((float*)(F.ws + WS_BON))[(size_t)(tok0 + t) * 6 + h] = s; }
    {
        const float* kvn = F.in[I_KVN] + l * 128; bf16* C = (bf16*)(F.ws + WS_C);
#pragma unroll
        for (int q = 0; q < 2; ++q) { const int tok = tok0 + 2 * F.wave + q; const unsigned w = *(const GAS unsigned*)(P + (size_t)tok * PP + PBC + 2 * F.lane);
            const float c0 = bflo(w), c1 = bfhi(w); const float ss = wave_sum(c0 * c0 + c1 * c1); const float rs = 1.0f / sqrtf(ss * (1.0f / 128.0f) + 1e-6f);
            *(GAS unsigned*)(C + (size_t)tok * 128 + 2 * F.lane) = pk2(c0 * rs * kvn[2 * F.lane], c1 * rs * kvn[2 * F.lane + 1]); }
    }
    __syncthreads();
}

__device__ __forceinline__ void ret_kv_unit(const Frame& F, int unit) {
    LAS float* kr = (LAS float*)F.lds; LAS float* vv = kr + 128 * 64;
    const int tid = F.tid, c = unit & 15, h = (unit >> 4) & 3, b = unit >> 6, tok0 = b * SEQ + c * 128;
    const bf16* P = (const bf16*)(F.ws + WS_P); const float* tab = (const float*)(F.ws + WS_TAB);
    const float lg2 = log2f(1.0f - exp2f(-5.0f - (float)h));
    for (int idx = tid; idx < 128 * 32; idx += NTHR) { const int m = idx >> 5, i = idx & 31; const size_t ro = (size_t)(tok0 + m) * PP;
        const float k1 = bf2f(P[ro + PCK + h * 64 + i]), k2 = bf2f(P[ro + PCK + h * 64 + 32 + i]);
        const float cs = tab[((c * 128 + m) * 32 + i) * 2], sn = tab[((c * 128 + m) * 32 + i) * 2 + 1];
        const float sc = 0.125f * exp2f((float)(127 - m) * lg2);
        kr[m * 64 + i] = (k1 * cs - k2 * sn) * sc; kr[m * 64 + 32 + i] = (k1 * sn + k2 * cs) * sc;
        vv[m * 64 + i] = bf2f(P[ro + PCV + h * 64 + i]); vv[m * 64 + 32 + i] = bf2f(P[ro + PCV + h * 64 + 32 + i]); }
    __syncthreads();
    const int d = tid >> 3, e0 = (tid & 7) * 8; float acc[8];
#pragma unroll
    for (int e = 0; e < 8; ++e) acc[e] = 0.f;
    for (int m = 0; m < 128; ++m) { const float kd = kr[m * 64 + d];
#pragma unroll
        for (int e = 0; e < 8; ++e) acc[e] += kd * vv[m * 64 + e0 + e]; }
    float* KV = (float*)(F.ws + WS_KV) + (size_t)unit * 4096 + d * 64 + e0;
#pragma unroll
    for (int e = 0; e < 8; ++e) KV[e] = acc[e];
    __syncthreads();
}

__device__ __forceinline__ void ret_out_unit(const Frame& F, int unit) {
    LAS float* qr = (LAS float*)F.lds; LAS float* kr = qr + 8192; LAS float* vv = kr + 8192; LAS float* st = vv + 8192;
    const int tid = F.tid, c = unit & 15, h = (unit >> 4) & 3, b = unit >> 6, tok0 = b * SEQ + c * 128;
    bf16* P = (bf16*)(F.ws + WS_P); const float* tab = (const float*)(F.ws + WS_TAB);
    const float lg2 = log2f(1.0f - exp2f(-5.0f - (float)h));
    for (int idx = tid; idx < 128 * 32; idx += NTHR) { const int m = idx >> 5, i = idx & 31; const size_t ro = (size_t)(tok0 + m) * PP;
        const float cs = tab[((c * 128 + m) * 32 + i) * 2], sn = tab[((c * 128 + m) * 32 + i) * 2 + 1];
        const float q1 = bf2f(P[ro + PCQ + h * 64 + i]), q2 = bf2f(P[ro + PCQ + h * 64 + 32 + i]);
        const float k1 = bf2f(P[ro + PCK + h * 64 + i]), k2 = bf2f(P[ro + PCK + h * 64 + 32 + i]);
        qr[m * 64 + i] = q1 * cs - q2 * sn; qr[m * 64 + 32 + i] = q1 * sn + q2 * cs;
        kr[m * 64 + i] = (k1 * cs - k2 * sn) * 0.125f; kr[m * 64 + 32 + i] = (k1 * sn + k2 * cs) * 0.125f;
        vv[m * 64 + i] = bf2f(P[ro + PCV + h * 64 + i]); vv[m * 64 + 32 + i] = bf2f(P[ro + PCV + h * 64 + 32 + i]); }
    {
        const float* KV = (const float*)(F.ws + WS_KV) + (size_t)(unit - c) * 4096; float s[8];
#pragma unroll
        for (int e = 0; e < 8; ++e) s[e] = 0.f;
        const float cd = exp2f(128.0f * lg2);
        for (int j = 0; j < c; ++j) {
#pragma unroll
            for (int e = 0; e < 8; ++e) s[e] = s[e] * cd + KV[(size_t)j * 4096 + tid * 8 + e]; }
#pragma unroll
        for (int e = 0; e < 8; ++e) st[tid * 8 + e] = s[e];
    }
    __syncthreads();
    const int n = tid >> 2, e0 = (tid & 3) * 16; float acc[16], cr[16];
#pragma unroll
    for (int e = 0; e < 16; ++e) { acc[e] = 0.f; cr[e] = 0.f; }
    for (int m = 0; m <= n; ++m) { float s = 0.f;
#pragma unroll 16
        for (int d = 0; d < 64; ++d) s += qr[n * 64 + d] * kr[m * 64 + d];
        s *= exp2f((float)(n - m) * lg2);
#pragma unroll
        for (int e = 0; e < 16; ++e) acc[e] += s * vv[m * 64 + e0 + e]; }
    for (int d = 0; d < 64; ++d) { const float qd = qr[n * 64 + d];
#pragma unroll
        for (int e = 0; e < 16; ++e) cr[e] += qd * st[d * 64 + e0 + e]; }
    const float qdec = exp2f((float)(n + 1) * lg2); float ss = 0.f;
#pragma unroll
    for (int e = 0; e < 16; ++e) { acc[e] += cr[e] * qdec; ss += acc[e] * acc[e]; }
    ss += __shfl_xor(ss, 1); ss += __shfl_xor(ss, 2);
    const float rs = 1.0f / sqrtf(ss * (1.0f / 64.0f) + 1e-6f);
    const size_t ro = (size_t)(tok0 + n) * PP;
    float gv[16];
#pragma unroll
    for (int e = 0; e < 16; ++e) gv[e] = bf2f(P[ro + PCG + h * 64 + e0 + e]);
#pragma unroll
    for (int e = 0; e < 16; e += 2) { const float o0 = gv[e] * sigmoid_f(gv[e]) * acc[e] * rs, o1 = gv[e + 1] * sigmoid_f(gv[e + 1]) * acc[e + 1] * rs;
        *(GAS unsigned*)(P + ro + 768 + h * 64 + e0 + e) = pk2(o0, o1); }
    __syncthreads();
}

__device__ __forceinline__ float dpp_add8(float x) {
    x += __builtin_bit_cast(float, __builtin_amdgcn_mov_dpp(__builtin_bit_cast(int, x), 0xB1, 0xF, 0xF, true));
    x += __builtin_bit_cast(float, __builtin_amdgcn_mov_dpp(__builtin_bit_cast(int, x), 0x4E, 0xF, 0xF, true));
    x += __builtin_bit_cast(float, __builtin_amdgcn_mov_dpp(__builtin_bit_cast(int, x), 0x141, 0xF, 0xF, true));
    return x;
}
constexpr int CH = 32;
__device__ __forceinline__ void rwkv_scan_unit(const Frame& F, int l, int unit) {
    const int tid = F.tid, lane = F.lane, wave = F.wave, b = unit / 6, h = unit - b * 6, tokb = b * SEQ;
    LAS float* stg = (LAS float*)F.lds; LAS float* ybuf = stg + 2 * 6 * CH * 64;
    const bool hi8 = (tid >> 8) != 0;
    const bf16* src0 = (const bf16*)(F.ws + (hi8 ? WS_D : WS_R)); const bf16* src1 = (const bf16*)(F.ws + (hi8 ? WS_KK : WS_K2)); const bf16* src2 = (const bf16*)(F.ws + (hi8 ? WS_VF : WS_BP));
    const bf16* Gg = (const bf16*)(F.ws + WS_G); const float* BON = (const float*)(F.ws + WS_BON); bf16* P = (bf16*)(F.ws + WS_P);
    const int row = 8 * wave + (lane >> 3), ks = lane & 7;
    float S[8];
#pragma unroll
    for (int j = 0; j < 8; ++j) S[j] = 0.f;
    v4u sreg[3];
#define RW_LOAD(cc) do { const int t_ = (tid & 255) >> 3, c8_ = tid & 7; const size_t o_ = (size_t)(tokb + (cc) * CH + t_) * AW + h * 64 + c8_ * 8; \
        sreg[0] = *(const GAS v4u*)(src0 + o_); sreg[1] = *(const GAS v4u*)(src1 + o_); sreg[2] = *(const GAS v4u*)(src2 + o_); } while (0)
#define RW_STORE(bufi) do { _Pragma("unroll") for (int i = 0; i < 3; ++i) { const int q = tid + 512 * i, ar = q >> 8, t = (q & 255) >> 3, c8 = q & 7; float f[8]; unpack8(sreg[i], f); \
        LAS f32x4* dst = (LAS f32x4*)(stg + ((bufi) * 6 + ar) * CH * 64 + t * 64 + c8 * 8); dst[0] = (f32x4){f[0], f[1], f[2], f[3]}; dst[1] = (f32x4){f[4], f[5], f[6], f[7]}; } } while (0)
    RW_LOAD(0); RW_STORE(0);
    __syncthreads();
    const float lnw = F.in[I_LNW][l * AW + h * 64 + (tid & 15) * 4], lnw1 = F.in[I_LNW][l * AW + h * 64 + (tid & 15) * 4 + 1], lnw2 = F.in[I_LNW][l * AW + h * 64 + (tid & 15) * 4 + 2], lnw3 = F.in[I_LNW][l * AW + h * 64 + (tid & 15) * 4 + 3];
    const float lnb = F.in[I_LNB][l * AW + h * 64 + (tid & 15) * 4], lnb1 = F.in[I_LNB][l * AW + h * 64 + (tid & 15) * 4 + 1], lnb2 = F.in[I_LNB][l * AW + h * 64 + (tid & 15) * 4 + 2], lnb3 = F.in[I_LNB][l * AW + h * 64 + (tid & 15) * 4 + 3];
    for (int cc = 0; cc < SEQ / CH; ++cc) {
        const int bufi = cc & 1;
        if (cc + 1 < SEQ / CH) RW_LOAD(cc + 1);
        const LAS float* base = stg + bufi * 6 * CH * 64;
#pragma unroll 4
        for (int s = 0; s < CH; ++s) {
            const LAS f32x4* pr = (const LAS f32x4*)(base + 0 * CH * 64 + s * 64 + ks * 8);
            const LAS f32x4* pd = (const LAS f32x4*)(base + 1 * CH * 64 + s * 64 + ks * 8);
            const LAS f32x4* pk = (const LAS f32x4*)(base + 2 * CH * 64 + s * 64 + ks * 8);
            const LAS f32x4* pq = (const LAS f32x4*)(base + 3 * CH * 64 + s * 64 + ks * 8);
            const LAS f32x4* pb = (const LAS f32x4*)(base + 4 * CH * 64 + s * 64 + ks * 8);
            const f32x4 r0 = pr[0], r1 = pr[1], d0 = pd[0], d1 = pd[1], k0 = pk[0], k1 = pk[1], q0 = pq[0], q1 = pq[1], b0 = pb[0], b1 = pb[1];
            const float v = base[5 * CH * 64 + s * 64 + row];
            float p = (S[0] * q0[0] + S[1] * q0[1]) + (S[2] * q0[2] + S[3] * q0[3]) + (S[4] * q1[0] + S[5] * q1[1]) + (S[6] * q1[2] + S[7] * q1[3]);
            p = dpp_add8(p);
#pragma unroll
            for (int j = 0; j < 4; ++j) { S[j] = fmaf(-d0[j], S[j], S[j]); S[j] = fmaf(-p, b0[j], S[j]); S[j] = fmaf(v, k0[j], S[j]);
                S[4 + j] = fmaf(-d1[j], S[4 + j], S[4 + j]); S[4 + j] = fmaf(-p, b1[j], S[4 + j]); S[4 + j] = fmaf(v, k1[j], S[4 + j]); }
            float y = (S[0] * r0[0] + S[1] * r0[1]) + (S[2] * r0[2] + S[3] * r0[3]) + (S[4] * r1[0] + S[5] * r1[1]) + (S[6] * r1[2] + S[7] * r1[3]);
            y = dpp_add8(y);
            if (ks == 0) ybuf[s * 64 + row] = y;
        }
        __syncthreads();
        {
            const int s = tid >> 4, r4 = (tid & 15) * 4, tok = tokb + cc * CH + s;
            const f32x4 yv = *(const LAS f32x4*)(ybuf + s * 64 + r4);
            float sm = (yv[0] + yv[1]) + (yv[2] + yv[3]);
            sm += __shfl_xor(sm, 1); sm += __shfl_xor(sm, 2); sm += __shfl_xor(sm, 4); sm += __shfl_xor(sm, 8);
            const float mean = sm * (1.0f / 64.0f); const f32x4 dv = yv - mean;
            float vs = (dv[0] * dv[0] + dv[1] * dv[1]) + (dv[2] * dv[2] + dv[3] * dv[3]);
            vs += __shfl_xor(vs, 1); vs += __shfl_xor(vs, 2); vs += __shfl_xor(vs, 4); vs += __shfl_xor(vs, 8);
            const float rs = 1.0f / sqrtf(vs * (1.0f / 64.0f) + 64e-5f);
            const f32x4 vv = *(const LAS f32x4*)(base + 5 * CH * 64 + s * 64 + r4);
            const float bon = BON[(size_t)tok * 6 + h];
            const unsigned long long gw = *(const GAS unsigned long long*)(Gg + (size_t)tok * AW + h * 64 + r4);
            const float g0 = bflo((unsigned)gw), g1 = bfhi((unsigned)gw), g2 = bflo((unsigned)(gw >> 32)), g3 = bfhi((unsigned)(gw >> 32));
            const float o0 = (dv[0] * rs * lnw + lnb + bon * vv[0]) * g0, o1 = (dv[1] * rs * lnw1 + lnb1 + bon * vv[1]) * g1;
            const float o2 = (dv[2] * rs * lnw2 + lnb2 + bon * vv[2]) * g2, o3 = (dv[3] * rs * lnw3 + lnb3 + bon * vv[3]) * g3;
            *(GAS unsigned long long*)(P + (size_t)tok * PP + h * 64 + r4) = (unsigned long long)pk2(o0, o1) | ((unsigned long long)pk2(o2, o3) << 32);
        }
        if (cc + 1 < SEQ / CH) RW_STORE(bufi ^ 1);
        __syncthreads();
    }
#undef RW_LOAD
#undef RW_STORE
}

__device__ __forceinline__ unsigned fkey(float f) { const unsigned u = __float_as_uint(f); return (u & 0x80000000u) ? ~u : (u | 0x80000000u); }
__device__ __forceinline__ void dsa_query_unit(const Frame& F, int l, int gt) {
    LAS float* iq = (LAS float*)F.lds; LAS float* iw = iq + 512; LAS float* qs = iw + 8; LAS float* qlat = qs + 384; LAS unsigned* keys = (LAS unsigned*)(qlat + 768);
    LAS int* sel = (LAS int*)(keys + 2048); LAS float* prob = (LAS float*)(sel + 256); LAS float* olat = prob + 1536; LAS unsigned* hist = (LAS unsigned*)(olat + 768);
    LAS unsigned* misc = hist + 256; LAS unsigned* wcnt = misc + 16;
    const int tid = F.tid, lane = F.lane, wave = F.wave, b = gt / SEQ, t = gt - b * SEQ;
    bf16* P = (bf16*)(F.ws + WS_P); const bf16* C = (const bf16*)(F.ws + WS_C);
    const size_t qrow = (size_t)gt * PP;
    iq[tid] = bf2f(P[qrow + PBIQ + tid]) * 0.125f;
    if (tid < 8) iw[tid] = bf2f(P[qrow + PBIW + tid]) * 0.35355339059327373f;
    if (tid < 384) qs[tid] = bf2f(P[qrow + PBQ + tid]);
    __syncthreads();
    { const float* wuk = F.in[I_WUK] + (size_t)l * 6 * 64 * 128;
      for (int o = tid; o < 768; o += NTHR) { const int h = o >> 7, c = o & 127; float s = 0.f;
          for (int d = 0; d < 64; ++d) s += qs[h * 64 + d] * wuk[(h * 64 + d) * 128 + c];
          qlat[o] = s * 0.125f; } }
    unsigned mykey[4];
#pragma unroll
    for (int i = 0; i < 4; ++i) { const int s = tid + 512 * i; unsigned key = 0u;
        if (s <= t) { const bf16* kp = P + (size_t)(b * SEQ + s) * PP + PBIK; float kf[64];
#pragma unroll
            for (int c8 = 0; c8 < 8; ++c8) { const v4u w = *(const GAS v4u*)(kp + c8 * 8); float f[8]; unpack8(w, f);
#pragma unroll
                for (int j = 0; j < 8; ++j) kf[c8 * 8 + j] = f[j]; }
            float sc = 0.f;
            for (int hh = 0; hh < 8; ++hh) { float d = 0.f;
#pragma unroll
                for (int j = 0; j < 64; ++j) d += iq[hh * 64 + j] * kf[j];
                sc += iw[hh] * fmaxf(d, 0.f); }
            key = fkey(sc); }
        mykey[i] = key; keys[s] = key; }
    __syncthreads();
    const int n = t + 1; unsigned tau = 0u; int s_cut = t;
    if (n > TOPK) {
        unsigned prefix = 0u; unsigned krem = TOPK;
        for (int p = 0; p < 4; ++p) { const int shift = 24 - 8 * p;
            if (tid < 256) hist[tid] = 0u;
            __syncthreads();
#pragma unroll
            for (int i = 0; i < 4; ++i) { const int s = tid + 512 * i;
                if (s <= t && (p == 0 || (mykey[i] >> (shift + 8)) == prefix)) __hip_atomic_fetch_add(&hist[(mykey[i] >> shift) & 255u], 1u, __ATOMIC_RELAXED, __HIP_MEMORY_SCOPE_WORKGROUP); }
            __syncthreads();
            if (wave == 0) { const unsigned c0 = hist[4 * lane], c1 = hist[4 * lane + 1], c2 = hist[4 * lane + 2], c3 = hist[4 * lane + 3]; const unsigned ls = c0 + c1 + c2 + c3;
                unsigned suf = ls;
#pragma unroll
                for (int o = 1; o < 64; o <<= 1) { const unsigned v = __shfl_down(suf, o); if (lane + o < 64) suf += v; }
                const unsigned above = suf - ls;
                if (above < krem && suf >= krem) { unsigned ab = above; int dg; unsigned ce;
                    if (ab + c3 >= krem) { dg = 3; ce = c3; } else { ab += c3; if (ab + c2 >= krem) { dg = 2; ce = c2; } else { ab += c2; if (ab + c1 >= krem) { dg = 1; ce = c1; } else { ab += c1; dg = 0; ce = c0; } } }
                    misc[0] = (unsigned)(4 * lane + dg); misc[1] = krem - ab; misc[2] = ce; } }
            __syncthreads();
            prefix = (prefix << 8) | misc[0]; krem = misc[1];
        }
        tau = prefix;
        const unsigned need = krem, cnt_eq = misc[2];
        __syncthreads();
        if (cnt_eq > need) { if (tid == 0) { unsigned cnt = 0; int sc = t; for (int s = 0; s <= t; ++s) if (keys[s] == tau) { if (++cnt == need) { sc = s; break; } } misc[3] = (unsigned)sc; }
            __syncthreads(); s_cut = (int)misc[3]; }
    }
    unsigned long long bal[4];
#pragma unroll
    for (int i = 0; i < 4; ++i) { const int s = tid + 512 * i; const bool f = (s <= t) && (mykey[i] > tau || (mykey[i] == tau && s <= s_cut)); bal[i] = __ballot(f); if (lane == 0) wcnt[i * 8 + wave] = (unsigned)__popcll(bal[i]); }
    __syncthreads();
    int nsel = 0;
    { unsigned run = 0;
#pragma unroll
      for (int i = 0; i < 4; ++i) { unsigned basei = run;
          for (int w = 0; w < 8; ++w) { const unsigned c = wcnt[i * 8 + w]; if (w < wave) basei += c; run += c; }
          const unsigned long long below = bal[i] & ((1ull << lane) - 1ull);
          if ((bal[i] >> lane) & 1ull) sel[basei + (unsigned)__popcll(below)] = tid + 512 * i; }
      nsel = (int)run; }
    __syncthreads();
    { const int jj = tid & 255, hg = tid >> 8; float lg[3] = {-INFINITY, -INFINITY, -INFINITY};
      if (jj < nsel) { const bf16* cp = C + (size_t)(b * SEQ + sel[jj]) * 128; lg[0] = lg[1] = lg[2] = 0.f;
          for (int c8 = 0; c8 < 16; ++c8) { const v4u w = *(const GAS v4u*)(cp + c8 * 8); float f[8]; unpack8(w, f);
#pragma unroll
              for (int j = 0; j < 8; ++j) { lg[0] += f[j] * qlat[(hg * 3 + 0) * 128 + c8 * 8 + j]; lg[1] += f[j] * qlat[(hg * 3 + 1) * 128 + c8 * 8 + j]; lg[2] += f[j] * qlat[(hg * 3 + 2) * 128 + c8 * 8 + j]; } } }
      prob[(hg * 3 + 0) * 256 + jj] = lg[0]; prob[(hg * 3 + 1) * 256 + jj] = lg[1]; prob[(hg * 3 + 2) * 256 + jj] = lg[2]; }
    __syncthreads();
    if (wave < 6) { float v[4]; float mx = -INFINITY;
#pragma unroll
        for (int i = 0; i < 4; ++i) { v[i] = prob[wave * 256 + lane + 64 * i]; mx = fmaxf(mx, v[i]); }
#pragma unroll
        for (int o = 1; o < 64; o <<= 1) mx = fmaxf(mx, __shfl_xor(mx, o));
        float sm = 0.f;
#pragma unroll
        for (int i = 0; i < 4; ++i) { v[i] = __expf(v[i] - mx); sm += v[i]; }
        sm = wave_sum(sm); const float inv = 1.0f / sm;
#pragma unroll
        for (int i = 0; i < 4; ++i) prob[wave * 256 + lane + 64 * i] = v[i] * inv; }
    __syncthreads();
    for (int o = tid; o < 768; o += NTHR) { const int h = o >> 7, c = o & 127; float s = 0.f;
        for (int j = 0; j < nsel; ++j) s += prob[h * 256 + j] * bf2f(C[(size_t)(b * SEQ + sel[j]) * 128 + c]);
        olat[o] = s; }
    __syncthreads();
    if (tid < 384) { const int h = tid >> 6, d = tid & 63; const float* wuv = F.in[I_WUV] + (size_t)l * 6 * 128 * 64 + (size_t)h * 128 * 64; float s = 0.f;
        for (int c = 0; c < 128; ++c) s += olat[h * 128 + c] * wuv[c * 64 + d];
        P[qrow + 384 + tid] = (bf16)f2bf(s); }
    __syncthreads();
}

__device__ __forceinline__ void final_norm(const Frame& F) {
    const int gw = F.vcu * NWAVES + F.wave, NGW = F.G * NWAVES; const float* g = F.in[I_FN];
    for (int m = gw; m < M; m += NGW) { GAS f32x4* xr = (GAS f32x4*)(F.out + (size_t)m * DM) + F.lane; f32x4 v[4]; float s = 0.f;
#pragma unroll
        for (int j = 0; j < 4; ++j) { v[j] = xr[64 * j]; s += (v[j].x * v[j].x + v[j].y * v[j].y) + (v[j].z * v[j].z + v[j].w * v[j].w); }
        const float rs = 1.0f / sqrtf(wave_sum(s) * (1.0f / DM) + 1e-6f);
#pragma unroll
        for (int j = 0; j < 4; ++j) { const f32x4 gg = *(const f32x4*)(g + 4 * F.lane + 256 * j); xr[64 * j] = v[j] * rs * gg; } }
}

template <class T> __device__ __forceinline__ T* launder_ptr(T* p) {
    unsigned lo = (unsigned)(uintptr_t)p, hi = (unsigned)((uintptr_t)p >> 32);
    asm volatile("" : "+v"(lo), "+v"(hi));
    lo = __builtin_amdgcn_readfirstlane(lo); hi = __builtin_amdgcn_readfirstlane(hi);
    return (T*)(((uintptr_t)hi << 32) | (uintptr_t)lo);
}
constexpr int NPHASE = 18;
__global__ void __launch_bounds__(NTHR, 2) fwd_kernel(Args args) {
    extern __shared__ __attribute__((aligned(16))) unsigned char lds[];
    Frame F;
    F.lds = (LAS unsigned char*)lds;
    F.tid = threadIdx.x; F.lane = F.tid & 63; F.wave = __builtin_amdgcn_readfirstlane(F.tid >> 6);
    F.G = gridDim.x; { const int bx = blockIdx.x; F.vcu = (F.G % 8 == 0) ? (bx % 8) * (F.G / 8) + bx / 8 : bx; }
    F.in = args.in; F.out = args.out; F.ws = args.ws;
    volatile LAS unsigned* MISC = (volatile LAS unsigned*)(F.lds + MISC_OFF);
    for (int u = F.tid; u < (LDS_BYTES - LDSCTL_OFF) / 4; u += NTHR) ((LAS unsigned*)(F.lds + LDSCTL_OFF))[u] = 0u;
    __syncthreads();
    const int lo = args.ph_lo, hi = args.ph_hi;
    XcdBarrier bar; bar.bar = (unsigned*)(F.ws + WS_CTL) + CW_BAR; bar.x = 0; bar.st = nullptr;
    if (hi - lo > 1) bar = xcd_barrier_post((unsigned*)(F.ws + WS_CTL) + CW_BAR, MISC + 8);
    for (int ph_ = lo; ph_ < hi; ++ph_) {
        int ph = ph_; asm volatile("" : "+v"(ph)); ph = __builtin_amdgcn_readfirstlane(ph);
#define PH_ENTER() \
        { unsigned z_ = 0u; int t_ = threadIdx.x; asm volatile("" : "+v"(z_), "+v"(t_)); z_ = __builtin_amdgcn_readfirstlane(z_); F.in = args.in; F.out = args.out + z_; F.ws = args.ws + z_; \
          F.tid = t_; F.lane = t_ & 63; F.wave = __builtin_amdgcn_readfirstlane(t_ >> 6); } \
        int bx = blockIdx.x; { int g_ = gridDim.x; asm volatile("" : "+v"(bx), "+v"(g_)); bx = __builtin_amdgcn_readfirstlane(bx); g_ = __builtin_amdgcn_readfirstlane(g_); F.G = g_; F.vcu = (g_ % 8 == 0) ? (bx % 8) * (g_ / 8) + bx / 8 : bx; } \
        gu32* ctl = (gu32*)(F.ws + WS_CTL); (void)ctl; \
        bf16* XB = (bf16*)(F.ws + WS_XB); bf16* Hb = (bf16*)(F.ws + WS_H); bf16* Pb = (bf16*)(F.ws + WS_P); float* part = (float*)(F.ws + WS_PART); (void)XB; (void)Hb; (void)Pb; (void)part;
        if (ph == 0) { PH_ENTER();
            conv_weights(F, 0, 0, 6);
            p0_x(F); p0_table(F);
        } else if (ph == NPHASE - 1) { PH_ENTER();
            final_norm(F);
        } else {
            const int l = (ph - 1) >> 3, sub = (ph - 1) & 7;
            if (sub == 0 || sub == 6) { PH_ENTER();
                pg8::Gemm g{XB, (const bf16*)(F.ws + (sub == 0 ? WS_WGU1 : WS_WGU2)), M, NGU, DM, DM}; pg8::StaticOrder S; S.init(M, NGU, F.G, bx);
                pg8::EpiUp E{Hb, FFP, part};
                pg8::gemm_phase<pg8::EpiUp, pg8::StaticOrder, true>(F.lds, g, S, E, F.tid);
            } else if (sub == 1 || sub == 7 || sub == 5) { PH_ENTER();
                const bool op = (sub == 5);
                pg8::Gemm g{op ? Pb : Hb, (const bf16*)(F.ws + (op ? WS_WOUT : (sub == 1 ? WS_WD1 : WS_WD2))), M, DM, op ? DM : FFP, op ? PP : FFP}; pg8::StaticOrder S; S.init(M, DM, F.G, bx);
                const float* base = (l == 0 && sub == 1) ? F.in[I_X] : F.out;
                pg8::EpiRes E{base, F.out, XB, part};
                pg8::gemm_phase<pg8::EpiRes, pg8::StaticOrder, false>(F.lds, g, S, E, F.tid);
            } else if (sub == 2) { PH_ENTER();
                pg8::Gemm g{XB, (const bf16*)(F.ws + WS_WIN), M, PP, DM, DM}; pg8::StaticOrder S; S.init(M, PP, F.G, bx);
                pg8::EpiP E{Pb, PP, part};
                pg8::gemm_phase<pg8::EpiP, pg8::StaticOrder, true>(F.lds, g, S, E, F.tid);
            } else if (sub == 3) { PH_ENTER();
                for (int u = F.vcu; u < M / PT; u += F.G) prep_tokens_unit(F, l, u);
                for (int u = F.vcu; u < BATCH * 4 * 16; u += F.G) ret_kv_unit(F, u);
                if (l + 1 < DEPTH) conv_weights(F, l + 1, 0, 3);
                if (l > 0) conv_weights(F, l, 3, 6);
            } else if (sub == 4) { PH_ENTER();
                if (bx < BATCH * 6) rwkv_scan_unit(F, l, bx);
                else {
                    gu32* qh = ctl + CW_QUEUE + 64 * l;
                    for (;;) {
                        if (F.tid == 0) MISC[0] = __hip_atomic_fetch_add(qh, 1u, RLX_AGENT);
                        __syncthreads();
                        const int u = (int)MISC[0];
                        __syncthreads();
                        if (u >= M + BATCH * 4 * 16) break;
                        if (u < M) { const int tq = SEQ - 1 - (u >> 3), bq = u & 7; dsa_query_unit(F, l, bq * SEQ + tq); }
                        else ret_out_unit(F, u - M);
                    }
                }
            }
        }
        if (ph_ + 1 < hi) xcd_barrier(bar);
    }
}

extern "C" void kernel_launch(void* const* d_in, const int* in_sizes, int n_in, void* d_out, int out_size, void* d_ws, size_t ws_size, hipStream_t stream) {
    static int grid = 0;
    if (grid == 0) {
        if (n_in != 31 || out_size != M * DM || ws_size < WS_END) { fprintf(stderr, "kernel_launch: unexpected shapes (n_in %d, out %d, ws %zu)\n", n_in, out_size, ws_size); grid = -1; return; }
        int dev = 0, cus = 0, per_cu = 0;
        if (hipGetDevice(&dev) != hipSuccess || hipDeviceGetAttribute(&cus, hipDeviceAttributeMultiprocessorCount, dev) != hipSuccess) { grid = -1; return; }
        if (hipFuncSetAttribute((const void*)fwd_kernel, hipFuncAttributeMaxDynamicSharedMemorySize, LDS_BYTES) != hipSuccess) { fprintf(stderr, "kernel_launch: hipFuncSetAttribute failed\n"); grid = -1; return; }
        if (hipOccupancyMaxActiveBlocksPerMultiprocessor(&per_cu, (const void*)fwd_kernel, NTHR, LDS_BYTES) != hipSuccess || per_cu < 1) fprintf(stderr, "kernel_launch: occupancy query says %d\n", per_cu);
        (void)hipGetLastError();
        grid = cus;
    }
    if (grid < 0) return;
    if (hipMemsetAsync((char*)d_ws + WS_CTL, 0, CTL_ZERO_BYTES, stream) != hipSuccess) return;
    Args a{};
    for (int i = 0; i < 31; ++i) a.in[i] = (const float*)d_in[i];
    a.out = (float*)d_out; a.ws = (unsigned char*)d_ws;
#ifndef ONE_LAUNCH
#define ONE_LAUNCH 0
#endif
    if (ONE_LAUNCH) { a.ph_lo = 0; a.ph_hi = NPHASE; hipLaunchKernelGGL(fwd_kernel, dim3(grid), dim3(NTHR), LDS_BYTES, stream, a); }
    else for (int ph = 0; ph < NPHASE; ++ph) { a.ph_lo = ph; a.ph_hi = ph + 1; hipLaunchKernelGGL(fwd_kernel, dim3(grid), dim3(NTHR), LDS_BYTES, stream, a); }
}
```

```cpp
#include <hip/hip_runtime.h>
#include <cstdio>
#include <cstdint>
#include <cmath>

namespace pg8 {
#define PG8_LAS __attribute__((address_space(3)))
typedef unsigned short bf16_t;
typedef short bf16x8 __attribute__((ext_vector_type(8)));
typedef float f32x4 __attribute__((ext_vector_type(4)));
typedef unsigned u32x4 __attribute__((ext_vector_type(4)));
constexpr int BM = 256, BK = 64, HALF = 128, HTB = HALF * BK * 2  , STAGE_BYTES = 8 * HTB, NXCD = 8, WGM = 8;

__host__ __device__ __forceinline__ int lds_byte(int r, int c) { const int st = (r >> 4) * 2 + (c >> 5), rr = r & 15, cc = c & 31, ob = rr * 64 + cc * 2; return st * 1024 + (ob ^ (((ob >> 9) & 1) << 5)); }
__host__ __device__ __forceinline__ void stage_rc(int b, int& R, int& C) { const int st = b / 1024, sb = b % 1024, swz = sb ^ (((sb >> 9) & 1) << 5); R = (st >> 1) * 16 + swz / 64; C = (st & 1) * 32 + (swz % 64) / 2; }
__host__ __device__ __forceinline__ int perm32(int rho) { const int n = rho >> 4, i = rho & 15; return 8 * (i >> 2) + 4 * n + (i & 3); }

struct Unit { int pm, pn; };
struct Gemm { const bf16_t* A; const bf16_t* Bt; int M, N, K, lda; };

struct StaticOrder {
    int nM, nN, nwg, G, c;
    __host__ __device__ void init(int M, int N, int G_, int c_) { nM = M / BM; nN = N / BM; nwg = nM * nN; G = G_; c = c_; }
    __host__ __device__ bool next(int i, Unit& u) const {
        const long L = (long)i * G + c; if (L >= nwg) return false;
        int wgid = (int)L; { const int q = nwg / NXCD, r = nwg % NXCD, xcd = wgid % NXCD, off = wgid / NXCD; wgid = (xcd < r ? xcd * (q + 1) : r * (q + 1) + (xcd - r) * q) + off; }
        const int nig = WGM * nN, gid = wgid / nig, fm = gid * WGM, gsz = (nM - fm) < WGM ? (nM - fm) : WGM;
        u.pm = fm + ((wgid % nig) % gsz); u.pn = (wgid % nig) / gsz; return true;
    }
    __device__ __forceinline__ void a_ready(const Unit&) const {}
    __device__ __forceinline__ void done(const Unit&) const {}
};

__device__ __forceinline__ unsigned cvt_pk_bf16(float lo, float hi) { unsigned r; asm volatile("v_cvt_pk_bf16_f32 %0, %1, %2" : "=v"(r) : "v"(lo), "v"(hi)); return r; }


__device__ __forceinline__ float row_rstd(const float* part, int row) {
    const f32x4* p = (const f32x4*)(part + (size_t)row * 16);
    const f32x4 a = p[0], b = p[1], c = p[2], d = p[3];
    const float s = ((a[0] + a[1]) + (a[2] + a[3])) + ((b[0] + b[1]) + (b[2] + b[3])) + ((c[0] + c[1]) + (c[2] + c[3])) + ((d[0] + d[1]) + (d[2] + d[3]));
    return 1.0f / sqrtf(s * (1.0f / 1024.0f) + 1e-6f);
}
__device__ __forceinline__ float silu_f(float x) { return x * __builtin_amdgcn_rcpf(1.0f + __expf(-x)); }

struct EpiUp {
    static constexpr bool PERM = true;
    bf16_t* H; int ldh; const float* part;
    __device__ __forceinline__ void operator()(const f32x4 (&acc)[2][2][4][2], const Unit& u, int wr, int wc, int fr, int fq) const {
        const int row0 = u.pm * BM + wr * 64 + fr, hcol = u.pn * 128 + wc * 32 + 8 * fq;
#pragma unroll
        for (int ai = 0; ai < 2; ++ai)
#pragma unroll
            for (int m = 0; m < 4; ++m) { const int row = row0 + ai * HALF + m * 16; const float rs = row_rstd(part, row);
                const f32x4 g0 = acc[ai][0][m][0] * rs, g1 = acc[ai][0][m][1] * rs, u0 = acc[ai][1][m][0] * rs, u1 = acc[ai][1][m][1] * rs;
                u32x4 w; w.x = cvt_pk_bf16(silu_f(g0[0]) * u0[0], silu_f(g0[1]) * u0[1]); w.y = cvt_pk_bf16(silu_f(g0[2]) * u0[2], silu_f(g0[3]) * u0[3]);
                w.z = cvt_pk_bf16(silu_f(g1[0]) * u1[0], silu_f(g1[1]) * u1[1]); w.w = cvt_pk_bf16(silu_f(g1[2]) * u1[2], silu_f(g1[3]) * u1[3]);
                *(u32x4*)(H + (size_t)row * ldh + hcol) = w; }
    }
};
struct EpiP {
    static constexpr bool PERM = true;
    bf16_t* P; int ldp; const float* part;
    __device__ __forceinline__ void operator()(const f32x4 (&acc)[2][2][4][2], const Unit& u, int wr, int wc, int fr, int fq) const {
        const int row0 = u.pm * BM + wr * 64 + fr, col0 = u.pn * BM + wc * 32 + 8 * fq;
#pragma unroll
        for (int ai = 0; ai < 2; ++ai)
#pragma unroll
            for (int m = 0; m < 4; ++m) { const int row = row0 + ai * HALF + m * 16; const float rs = row_rstd(part, row);
#pragma unroll
                for (int bj = 0; bj < 2; ++bj) { const f32x4 v0 = acc[ai][bj][m][0] * rs, v1 = acc[ai][bj][m][1] * rs;
                    u32x4 w; w.x = cvt_pk_bf16(v0[0], v0[1]); w.y = cvt_pk_bf16(v0[2], v0[3]); w.z = cvt_pk_bf16(v1[0], v1[1]); w.w = cvt_pk_bf16(v1[2], v1[3]);
                    *(u32x4*)(P + (size_t)row * ldp + col0 + bj * HALF) = w; } }
    }
};
struct EpiRes {
    static constexpr bool PERM = true;
    const float* base; float* out; bf16_t* xb; float* part;
    __device__ __forceinline__ void operator()(const f32x4 (&acc)[2][2][4][2], const Unit& u, int wr, int wc, int fr, int fq) const {
        const int row0 = u.pm * BM + wr * 64 + fr, col0 = u.pn * BM + wc * 32 + 8 * fq;
#pragma unroll
        for (int ai = 0; ai < 2; ++ai)
#pragma unroll
            for (int m = 0; m < 4; ++m) { const int row = row0 + ai * HALF + m * 16; float ss = 0.f;
#pragma unroll
                for (int bj = 0; bj < 2; ++bj) { const size_t off = (size_t)row * 1024 + col0 + bj * HALF;
                    const f32x4 v0 = acc[ai][bj][m][0] + *(const f32x4*)(base + off), v1 = acc[ai][bj][m][1] + *(const f32x4*)(base + off + 4);
                    *(f32x4*)(out + off) = v0; *(f32x4*)(out + off + 4) = v1;
                    u32x4 w; w.x = cvt_pk_bf16(v0[0], v0[1]); w.y = cvt_pk_bf16(v0[2], v0[3]); w.z = cvt_pk_bf16(v1[0], v1[1]); w.w = cvt_pk_bf16(v1[2], v1[3]);
                    *(u32x4*)(xb + off) = w;
                    ss += (v0[0] * v0[0] + v0[1] * v0[1]) + (v0[2] * v0[2] + v0[3] * v0[3]) + (v1[0] * v1[0] + v1[1] * v1[1]) + (v1[2] * v1[2] + v1[3] * v1[3]); }
                ss += __shfl_xor(ss, 16); ss += __shfl_xor(ss, 32);
                if (fq == 0) part[(size_t)row * 16 + u.pn * 4 + wc] = ss;
                asm volatile("" ::: "memory"); }
    }
};

template <class Epi, class Sched, bool ALIGN_EPI>
__device__ __forceinline__ void gemm_phase(PG8_LAS unsigned char* lds, const Gemm g, const Sched& S, const Epi& E, const int tid) {
    const int wid = __builtin_amdgcn_readfirstlane(tid >> 6), lane = tid & 63, wr = wid >> 2, wc = wid & 3, fr = lane & 15, fq = lane >> 4;
    const int K = g.K, nt = K / BK, lda = g.lda;
    unsigned voffA[2], voffB[2];
#pragma unroll
    for (int i = 0; i < 2; ++i) { int R, C; stage_rc(tid * 16 + i * 8192, R, C); const int Rb = Epi::PERM ? ((R & ~31) + perm32(R & 31)) : R;
        voffA[i] = (unsigned)(R * lda + C) * 2u; voffB[i] = (unsigned)(Rb * K + C) * 2u; }
    const size_t kstep = (size_t)(BK * 2);
    const size_t hstepA = (size_t)HALF * lda * 2, hstepB = (size_t)HALF * K * 2;
    const size_t tstepA = 2 * hstepA, tstepB = 2 * hstepB;
    const unsigned ldsw = (unsigned)wid * 1024u;
    const int aoff = lds_byte(wr * 64 + fr, fq * 8), boff = lds_byte(wc * 32 + fr, fq * 8);
#define PG8_SA(b, h) (((b) * 2 + (h)) * HTB)
#define PG8_SB(b, h) ((4 + (b) * 2 + (h)) * HTB)
#define PG8_STAGE(bufoff, gbase, voff) do { _Pragma("unroll") for (int _i = 0; _i < 2; ++_i) \
        __builtin_amdgcn_global_load_lds((const unsigned*)((const char*)(gbase) + (voff)[_i]), (PG8_LAS unsigned*)(lds + (bufoff) + ldsw + _i * 8192), 16, 0, 0); } while (0)
#define PG8_LDA(dst, b, h) do { _Pragma("unroll") for (int m = 0; m < 4; ++m) _Pragma("unroll") for (int k = 0; k < 2; ++k) dst[m][k] = *(const PG8_LAS bf16x8*)(lds + PG8_SA(b, h) + aoff + m * 2048 + k * 1024); } while (0)
#define PG8_LDB(dst, b, h) do { _Pragma("unroll") for (int n = 0; n < 2; ++n) _Pragma("unroll") for (int k = 0; k < 2; ++k) dst[n][k] = *(const PG8_LAS bf16x8*)(lds + PG8_SB(b, h) + boff + n * 2048 + k * 1024); } while (0)
#define PG8_MMA(ai, bj, At, Bt) do { __builtin_amdgcn_s_setprio(1); _Pragma("unroll") for (int m = 0; m < 4; ++m) _Pragma("unroll") for (int n = 0; n < 2; ++n) _Pragma("unroll") for (int k = 0; k < 2; ++k) \
        acc[ai][bj][m][n] = __builtin_amdgcn_mfma_f32_16x16x32_bf16(Bt[n][k], At[m][k], acc[ai][bj][m][n], 0, 0, 0); __builtin_amdgcn_s_setprio(0); } while (0)
#define PG8_WAIT_V(n) asm volatile("s_waitcnt vmcnt(" #n ")" ::: "memory")
#define PG8_WAIT_L(n) asm volatile("s_waitcnt lgkmcnt(" #n ")" ::: "memory")
#define PG8_BAR __builtin_amdgcn_s_barrier()
#define PG8_SCHED __builtin_amdgcn_sched_barrier(0)
    Unit cur, nxt; int ui = 0;
    if (!S.next(0, cur)) return;
    f32x4 acc[2][2][4][2];
#pragma unroll
    for (int a = 0; a < 2; ++a)
#pragma unroll
        for (int b = 0; b < 2; ++b)
#pragma unroll
            for (int m = 0; m < 4; ++m)
#pragma unroll
                for (int n = 0; n < 2; ++n) acc[a][b][m][n] = (f32x4){0.f, 0.f, 0.f, 0.f};
    bf16x8 At[4][2], B0[2][2], B1[2][2];
    const char* cA = (const char*)g.A + (size_t)cur.pm * tstepA; const char* cB = (const char*)g.Bt + (size_t)cur.pn * tstepB;
    S.a_ready(cur);
    PG8_STAGE(PG8_SB(0, 0), cB, voffB); PG8_STAGE(PG8_SB(0, 1), cB + hstepB, voffB); PG8_STAGE(PG8_SA(0, 0), cA, voffA); PG8_STAGE(PG8_SA(0, 1), cA + hstepA, voffA);
    if (wr == 1) PG8_BAR;
    PG8_WAIT_V(2); PG8_BAR;
    PG8_STAGE(PG8_SB(1, 0), cB + kstep, voffB); PG8_STAGE(PG8_SA(1, 0), cA + kstep, voffA); PG8_STAGE(PG8_SB(1, 1), cB + hstepB + kstep, voffB);
    PG8_WAIT_V(6); PG8_BAR;
    for (;;) {
        const bool has_next = S.next(ui + 1, nxt);
        const char* nA = has_next ? (const char*)g.A + (size_t)nxt.pm * tstepA : cA; const char* nB = has_next ? (const char*)g.Bt + (size_t)nxt.pn * tstepB : cB;
        for (int t = 0; t < nt; t += 2) {
            const bool last = (t == nt - 2);
            const char* a1 = cA + (size_t)(t + 1) * kstep;
            const char* a2 = last ? nA : cA + (size_t)(t + 2) * kstep; const char* b2 = last ? nB : cB + (size_t)(t + 2) * kstep;
            const char* a3 = a2 + kstep; const char* b3 = b2 + kstep;
            if (last && has_next) S.a_ready(nxt);
            PG8_LDB(B0, 0, 0); PG8_LDB(B1, 0, 1); PG8_SCHED; PG8_LDA(At, 0, 0); PG8_STAGE(PG8_SA(1, 1), a1 + hstepA, voffA);
            PG8_WAIT_V(8); PG8_WAIT_L(0); PG8_BAR; PG8_MMA(0, 0, At, B0); PG8_MMA(0, 1, At, B1); PG8_BAR; PG8_SCHED;
            PG8_LDA(At, 0, 1); PG8_STAGE(PG8_SB(0, 0), b2, voffB); PG8_STAGE(PG8_SB(0, 1), b2 + hstepB, voffB); PG8_STAGE(PG8_SA(0, 0), a2, voffA);
            PG8_WAIT_V(8); PG8_WAIT_L(0); PG8_BAR; PG8_MMA(1, 0, At, B0); PG8_MMA(1, 1, At, B1); PG8_BAR; PG8_SCHED;
            PG8_LDB(B0, 1, 0); PG8_LDB(B1, 1, 1); PG8_SCHED; PG8_LDA(At, 1, 0); PG8_STAGE(PG8_SA(0, 1), a2 + hstepA, voffA);
            PG8_WAIT_V(8); PG8_WAIT_L(0); PG8_BAR; PG8_MMA(0, 0, At, B0); PG8_MMA(0, 1, At, B1); PG8_BAR; PG8_SCHED;
            PG8_LDA(At, 1, 1); PG8_STAGE(PG8_SB(1, 0), b3, voffB); PG8_STAGE(PG8_SB(1, 1), b3 + hstepB, voffB); PG8_STAGE(PG8_SA(1, 0), a3, voffA);
            PG8_WAIT_V(8); PG8_WAIT_L(0); PG8_BAR; PG8_MMA(1, 0, At, B0); PG8_MMA(1, 1, At, B1); PG8_BAR; PG8_SCHED;
        }
        if constexpr (ALIGN_EPI) { if (wr == 0) PG8_BAR; }
        E(acc, cur, wr, wc, fr, fq); S.done(cur);
        if (!has_next) break;
#pragma unroll
        for (int a = 0; a < 2; ++a)
#pragma unroll
            for (int b = 0; b < 2; ++b)
#pragma unroll
                for (int m = 0; m < 4; ++m)
#pragma unroll
                    for (int n = 0; n < 2; ++n) acc[a][b][m][n] = (f32x4){0.f, 0.f, 0.f, 0.f};
        cur = nxt; cA = nA; cB = nB; ++ui;
        if constexpr (ALIGN_EPI) { if (wr == 1) PG8_BAR; }
    }
    PG8_WAIT_V(0);
    if constexpr (!ALIGN_EPI) { if (wr == 0) PG8_BAR; }
    PG8_BAR;
#undef PG8_SA
#undef PG8_SB
#undef PG8_STAGE
#undef PG8_LDA
#undef PG8_LDB
#undef PG8_MMA
#undef PG8_WAIT_V
#undef PG8_WAIT_L
#undef PG8_BAR
#undef PG8_SCHED
}
}

constexpr int NWAVES = 8, NTHR = 512;
constexpr int BATCH = 8, SEQ = 2048, DM = 1024, DEPTH = 2, FF = 2752, M = BATCH * SEQ;
constexpr int FFP = 2816;
constexpr int NGU = 5632;
constexpr int PP = 3584;
constexpr int NIN = 3400;
constexpr int PA = 0, PMV = 1280, PBQ = 1296, PBC = 1680, PBIQ = 1808, PBIK = 2320, PBIW = 2384, PCQ = 2392, PCK = 2648, PCV = 2904, PCG = 3160, PUSED = 3416;
constexpr int AW = 384;
constexpr int TOPK = 256;

constexpr size_t MiB = 1u << 20;
constexpr size_t WS_CTL = 0, CTL_ZERO_BYTES = 1 * MiB;
constexpr size_t WS_PART = 1 * MiB;
constexpr size_t WS_TAB = 2 * MiB;
constexpr size_t WS_BON = 2 * MiB + 512 * 1024;
constexpr size_t WS_WGU1 = 4 * MiB, WS_WD1 = 15 * MiB, WS_WIN = 21 * MiB, WS_WOUT = 28 * MiB, WS_WGU2 = 30 * MiB, WS_WD2 = 41 * MiB;
constexpr size_t WS_XB = 47 * MiB;
constexpr size_t WS_VF = 79 * MiB;
constexpr size_t WS_P = 91 * MiB;
constexpr size_t WS_H = WS_P;
constexpr size_t WS_R = 203 * MiB, WS_D = 215 * MiB, WS_K2 = 227 * MiB, WS_KK = 239 * MiB, WS_C = 251 * MiB;
constexpr size_t WS_BP = WS_XB, WS_G = WS_XB + 12 * MiB, WS_KV = WS_XB + 24 * MiB;
constexpr size_t WS_END = 256 * MiB;
static_assert(WS_WD2 + (size_t)1024 * FFP * 2 <= WS_XB && WS_P + (size_t)M * PP * 2 <= WS_R && WS_C + (size_t)M * 128 * 2 <= WS_END, "ws map");
constexpr int CW_BAR = 4096;
constexpr int CW_QUEUE = 16384;

constexpr int RING_BYTES = 131072;
constexpr int LDSCTL_OFF = RING_BYTES, MISC_OFF = LDSCTL_OFF + 320;
constexpr int LDS_BYTES = 147456;

#define GAS __attribute__((address_space(1)))
#define LAS __attribute__((address_space(3)))
typedef unsigned short bf16;
typedef unsigned v4u __attribute__((ext_vector_type(4)));
typedef float f32x4 __attribute__((ext_vector_type(4)));
typedef GAS unsigned gu32;
#define RLX_AGENT __ATOMIC_RELAXED, __HIP_MEMORY_SCOPE_AGENT
#define LDS_WAIT() asm volatile("s_waitcnt lgkmcnt(0)" ::: "memory")
__device__ __forceinline__ unsigned f2bf(float f) { unsigned u = __builtin_bit_cast(unsigned, f); return (u + 0x7fffu + ((u >> 16) & 1u)) >> 16; }
__device__ __forceinline__ unsigned pk2(float lo, float hi) { return f2bf(lo) | (f2bf(hi) << 16); }
__device__ __forceinline__ float bf2f(unsigned short v) { return __uint_as_float((unsigned)v << 16); }
__device__ __forceinline__ float bflo(unsigned w) { return __uint_as_float(w << 16); }
__device__ __forceinline__ float bfhi(unsigned w) { return __uint_as_float(w & 0xffff0000u); }
__device__ __forceinline__ void unpack8(const v4u w, float (&f)[8]) { f[0] = bflo(w.x); f[1] = bfhi(w.x); f[2] = bflo(w.y); f[3] = bfhi(w.y); f[4] = bflo(w.z); f[5] = bfhi(w.z); f[6] = bflo(w.w); f[7] = bfhi(w.w); }
__device__ __forceinline__ float sigmoid_f(float x) { return 1.0f / (1.0f + __expf(-x)); }
__device__ __forceinline__ float wave_sum(float v) {
#pragma unroll
    for (int o = 1; o < 64; o <<= 1) v += __shfl_xor(v, o);
    return v;
}

#define XB_TMO      128
#define XB_XCNT(j)  (256  + 64 * (j))
#define XB_XSUB(j)  (1280 + 64 * (j))
#define XB_XGEN(j)  (2304 + 64 * (j))
#define XB_TOP      3328
#define XB_TOPGEN   3392
#define XCD_BAR_WORDS 3456
#define XB_SPIN_CAP (1u << 22)

__device__ __forceinline__ unsigned xb_ld(unsigned* p)              { return __hip_atomic_load(p, __ATOMIC_RELAXED, __HIP_MEMORY_SCOPE_AGENT); }
__device__ __forceinline__ unsigned xb_add(unsigned* p, unsigned v) { return __hip_atomic_fetch_add(p, v, __ATOMIC_RELAXED, __HIP_MEMORY_SCOPE_AGENT); }
__device__ __forceinline__ unsigned xb_xcc_id() { return (unsigned)__builtin_amdgcn_s_getreg((3 << 11) | 20) & 0xFu; }
#define XB_SPIN(cond, bar) do { unsigned _sp = 0; while (cond) { __builtin_amdgcn_s_sleep(1); \
    if ((++_sp & 255u) == 0u) { if (xb_ld(&(bar)[XB_TMO])) break; if (_sp > XB_SPIN_CAP) { atomicAdd(&(bar)[XB_TMO], 1u); break; } } } } while (0)

struct XcdBarrier { unsigned* bar; unsigned x; volatile LAS unsigned* st; };

__device__ __forceinline__ XcdBarrier xcd_barrier_post(unsigned* bar, volatile LAS unsigned* st) {
    XcdBarrier b; b.bar = bar; b.x = xb_xcc_id(); b.st = st;
    if (threadIdx.x == 0) (void)xb_add(&bar[XB_XCNT(b.x)], 1u);
    return b;
}
__device__ __forceinline__ void xcd_barrier_complete(unsigned* bar, unsigned x, unsigned& nloc, unsigned& nx) {
    const unsigned G = gridDim.x * gridDim.y * gridDim.z;
    unsigned sum, cnt, mine, sp = 0u;
    for (;;) {
        sum = 0u; cnt = 0u; mine = 0u;
#pragma unroll
        for (unsigned j = 0; j < 16; ++j) { const unsigned c = xb_ld(&bar[XB_XCNT(j)]); sum += c; cnt += (c > 0u) ? 1u : 0u; mine = (j == x) ? c : mine; }
        if (sum == G) break;
        __builtin_amdgcn_s_sleep(1);
        if ((++sp & 255u) == 0u) { if (xb_ld(&bar[XB_TMO])) break; if (sp > XB_SPIN_CAP) { atomicAdd(&bar[XB_TMO], 1u); break; } }
    }
    nloc = mine > 0u ? mine : 1u; nx = cnt > 0u ? cnt : 1u;
}
__device__ __forceinline__ void xcd_barrier(const XcdBarrier& b) {
    asm volatile("s_waitcnt vmcnt(0)" ::: "memory");
    __syncthreads();
    if (threadIdx.x == 0) {
        unsigned* bar = b.bar;
        __builtin_amdgcn_s_waitcnt(0);
        unsigned nloc = b.st[0], nx = b.st[1];
        if (nloc == 0u) { xcd_barrier_complete(bar, b.x, nloc, nx); b.st[0] = nloc; b.st[1] = nx; }
        const unsigned old = xb_add(&bar[XB_XSUB(b.x)], 1u);
        const unsigned gen = old / nloc;
        if (old + 1u == (gen + 1u) * nloc) {
            __builtin_amdgcn_fence(__ATOMIC_RELEASE, "agent");
            asm volatile("s_waitcnt vmcnt(0)" ::: "memory");
            const unsigned og = xb_add(&bar[XB_TOP], 1u);
            const unsigned tg = og / nx;
            if (og + 1u == (tg + 1u) * nx) xb_add(&bar[XB_TOPGEN], 1u);
            else XB_SPIN(xb_ld(&bar[XB_TOPGEN]) == tg, bar);
            __builtin_amdgcn_fence(__ATOMIC_ACQUIRE, "agent");
            xb_add(&bar[XB_XGEN(b.x)], 1u);
            asm volatile("s_waitcnt vmcnt(0)" ::: "memory");
        } else {
            XB_SPIN(xb_ld(&bar[XB_XGEN(b.x)]) == gen, bar);
            __builtin_amdgcn_fence(__ATOMIC_ACQUIRE, "agent");
            asm volatile("s_waitcnt vmcnt(0)" ::: "memory");
        }
    }
    __syncthreads();
}

struct Args { const float* in[31]; float* out; unsigned char* ws; int ph_lo, ph_hi; };
struct Frame {
    LAS unsigned char* lds;
    int tid, lane, wave, vcu, G;
    const float* const* in; float* out; unsigned char* ws;
};
enum { I_X = 0, I_F1N, I_F1G, I_F1U, I_F1D, I_MIXN, I_WIN, I_WOUT, I_MU, I_W0, I_W2, I_A0, I_A2, I_G2, I_KK, I_KA, I_RK, I_LNW, I_LNB, I_VRW, I_VRMU, I_V0, I_V2, I_KVN, I_WUK, I_WUV, I_F2N, I_F2G, I_F2U, I_F2D, I_FN };

__device__ __forceinline__ void conv_item(const Frame& F, int l, int kind, int item, LAS float* scr) {
    const int lane = F.lane;
    int Kd, nkb; bf16* WT;
    if (kind == 0 || kind == 4) { Kd = 1024; WT = (bf16*)(F.ws + (kind == 0 ? WS_WGU1 : WS_WGU2)); }
    else if (kind == 1 || kind == 5) { Kd = FFP; WT = (bf16*)(F.ws + (kind == 1 ? WS_WD1 : WS_WD2)); }
    else if (kind == 2) { Kd = 1024; WT = (bf16*)(F.ws + WS_WIN); }
    else { Kd = 1024; WT = (bf16*)(F.ws + WS_WOUT); }
    nkb = Kd / 64;
    const int rb = item / nkb, kb = item % nkb, r0 = rb * 32, k0 = kb * 64;
    const int rr = r0 + (lane & 31);
    const float* src = nullptr; int ns = 0, col = 0, ksrc = 1024; const float* gain = nullptr; float scale = 1.0f;
    if (kind == 0 || kind == 4) {
        const int tile = rr >> 8, w = rr & 255, hid = tile * 128 + (w & 127);
        if (hid < FF) { const float* s1 = (w >> 7) ? F.in[I_F1U] : F.in[I_F1G]; const float* s2 = (w >> 7) ? F.in[I_F2U] : F.in[I_F2G]; src = ((kind == 0) ? s1 : s2) + (size_t)l * 1024 * FF; ns = FF; col = hid; }
        gain = ((kind == 0) ? F.in[I_F1N] : F.in[I_F2N]) + l * 1024;
    } else if (kind == 1 || kind == 5) {
        src = ((kind == 1) ? F.in[I_F1D] : F.in[I_F2D]) + (size_t)l * FF * 1024; ns = 1024; col = rr; ksrc = FF; scale = 0.5f;
    } else if (kind == 2) {
        gain = F.in[I_MIXN] + l * 1024;
        if (rr < 1280) { src = F.in[I_WIN] + (size_t)l * 1024 * NIN; ns = NIN; col = rr; }
        else if (rr < 1296) { if (l > 0) { src = F.in[I_VRW] + (size_t)(l - 1) * 1024 * 16; ns = 16; col = rr - 1280; } }
        else if (rr < PUSED) { src = F.in[I_WIN] + (size_t)l * 1024 * NIN; ns = NIN; col = rr - 16; }
    } else { src = F.in[I_WOUT] + (size_t)l * 1024 * 1024; ns = 1024; col = rr; }
#pragma unroll 8
    for (int i = 0; i < 32; ++i) { const int kk = 2 * i + (lane >> 5), k = k0 + kk; float v = 0.f;
        if (src != nullptr && k < ksrc) { v = src[(size_t)k * ns + col] * scale; if (gain) v *= gain[k]; }
        scr[kk * 33 + (lane & 31)] = v; }
    LDS_WAIT(); asm volatile("" ::: "memory");
    const int c = lane & 7;
#pragma unroll
    for (int j = 0; j < 4; ++j) { const int n = (lane >> 3) + 8 * j; const LAS float* s = scr + (8 * c) * 33 + n;
        v4u o; o.x = pk2(s[0 * 33], s[1 * 33]); o.y = pk2(s[2 * 33], s[3 * 33]); o.z = pk2(s[4 * 33], s[5 * 33]); o.w = pk2(s[6 * 33], s[7 * 33]);
        *(GAS v4u*)(WT + (size_t)(r0 + n) * Kd + k0 + 8 * c) = o; }
    LDS_WAIT(); asm volatile("" ::: "memory");
}
__host__ __device__ constexpr int conv_items(int kind) { return (kind == 0 || kind == 4) ? (NGU / 32) * 16 : (kind == 1 || kind == 5) ? 32 * (FFP / 64) : (kind == 2) ? (PP / 32) * 16 : 32 * 16; }
__device__ __forceinline__ void conv_weights(const Frame& F, int l, int k_lo, int k_hi) {
    LAS float* scr = (LAS float*)(F.lds + F.wave * 16384);
    const int gw = F.vcu * NWAVES + F.wave, NGW = F.G * NWAVES;
    for (int kind = k_lo; kind < k_hi; ++kind) { const int ni = conv_items(kind);
        for (int it = gw; it < ni; it += NGW) conv_item(F, l, kind, it, scr); }
}

__device__ __forceinline__ void p0_x(const Frame& F) {
    const int gw = F.vcu * NWAVES + F.wave, NGW = F.G * NWAVES;
    const float* x = F.in[I_X]; bf16* xb = (bf16*)(F.ws + WS_XB); float* part = (float*)(F.ws + WS_PART);
    for (int m = gw; m < M; m += NGW) {
        const GAS f32x4* xr = (const GAS f32x4*)(x + (size_t)m * DM) + F.lane; float s = 0.f;
        GAS unsigned long long* o8 = (GAS unsigned long long*)(xb + (size_t)m * DM) + F.lane;
#pragma unroll
        for (int j = 0; j < 4; ++j) { const f32x4 v = xr[64 * j]; s += (v.x * v.x + v.y * v.y) + (v.z * v.z + v.w * v.w);
            o8[64 * j] = (unsigned long long)pk2(v.x, v.y) | ((unsigned long long)pk2(v.z, v.w) << 32); }
        s = wave_sum(s);
        if (F.lane < 16) part[(size_t)m * 16 + F.lane] = (F.lane == 0) ? s : 0.f;
    }
}
__device__ __forceinline__ void p0_table(const Frame& F) {
    float* tab = (float*)(F.ws + WS_TAB);
    for (int i = F.vcu * NTHR + F.tid; i < SEQ * 32; i += F.G * NTHR) { const int t = i >> 5, f = i & 31; const float th = exp2f(-(float)f * (13.287712379549449f / 31.0f)); const float ang = (float)t * th; float s, c; sincosf(ang, &s, &c); tab[2 * i] = c; tab[2 * i + 1] = s; }
}

constexpr int PT = 16;
__device__ __forceinline__ void prep_tokens_unit(const Frame& F, int l, int unit) {
    LAS float* xs = (LAS float*)F.lds; LAS float* rn = xs + PT * 1296; LAS float* prod = rn + PT * 8;
    const int tid = F.tid, tok0 = unit * PT;
    const bf16* P = (const bf16*)(F.ws + WS_P);
    const float* mu = F.in[I_MU] + l * 1280; const float* vmu = F.in[I_VRMU] + (l > 0 ? (l - 1) * 16 : 0);
    for (int idx = tid; idx < PT * 162; idx += NTHR) { const int t = idx / 162, ch = idx - t * 162, tok = tok0 + t, c0 = ch * 8;
        const v4u cw = *(const GAS v4u*)(P + (size_t)tok * PP + c0); float cur[8], prv[8]; unpack8(cw, cur);
        if ((tok & (SEQ - 1)) != 0) { const v4u pw = *(const GAS v4u*)(P + (size_t)(tok - 1) * PP + c0); unpack8(pw, prv); }
        else {
#pragma unroll
            for (int j = 0; j < 8; ++j) prv[j] = 0.f; }
#pragma unroll
        for (int j = 0; j < 8; ++j) { const int c = c0 + j; const float m = (c < 1280) ? mu[c] : ((l > 0) ? vmu[c - 1280] : 0.f);
            float v = cur[j] + (prv[j] - cur[j]) * m;
            if (c >= 1152 && c < 1184) v = tanhf(v); else if (c >= 1216 && c < 1280) v = sigmoid_f(v);
            xs[t * 1296 + c] = v; } }
    __syncthreads();
    if (tid < PT * 6) { const int t = tid / 6, h = tid - t * 6; const float* kkw = F.in[I_KK] + l * AW + h * 64; float ss = 0.f;
        for (int j = 0; j < 64; ++j) { const float v = xs[t * 1296 + 384 + h * 64 + j] * kkw[j]; ss += v * v; }
        rn[t * 8 + h] = 1.0f / fmaxf(sqrtf(ss), 1e-12f); }
    __syncthreads();
    {
        const int cg = tid & 127, tg = tid >> 7;
        const float* w2 = F.in[I_W2] + (size_t)l * 32 * AW; const float* a2 = F.in[I_A2] + (size_t)l * 32 * AW; const float* g2 = F.in[I_G2] + (size_t)l * 64 * AW;
        const float* v2 = F.in[I_V2] + (size_t)(l > 0 ? l - 1 : 0) * 16 * AW;
        bf16* R = (bf16*)(F.ws + WS_R); bf16* Dd = (bf16*)(F.ws + WS_D); bf16* K2 = (bf16*)(F.ws + WS_K2); bf16* KK = (bf16*)(F.ws + WS_KK); bf16* BP = (bf16*)(F.ws + WS_BP); bf16* Gg = (bf16*)(F.ws + WS_G); bf16* VF = (bf16*)(F.ws + WS_VF);
        for (int ci = 0; ci < 3; ++ci) { const int j = cg + 128 * ci, h = j >> 6;
            float wacc[4], aacc[4], gacc[4], macc[4];
            const float w0 = F.in[I_W0][l * AW + j], a0 = F.in[I_A0][l * AW + j], v0 = (l > 0) ? F.in[I_V0][(l - 1) * AW + j] : 0.f;
#pragma unroll
            for (int tt = 0; tt < 4; ++tt) { wacc[tt] = w0; aacc[tt] = a0; gacc[tt] = 0.f; macc[tt] = v0; }
            for (int i = 0; i < 32; ++i) { const float ww = w2[i * AW + j], aa = a2[i * AW + j];
#pragma unroll
                for (int tt = 0; tt < 4; ++tt) { const int t = 4 * tg + tt; wacc[tt] += xs[t * 1296 + 1152 + i] * ww; aacc[tt] += xs[t * 1296 + 1184 + i] * aa; } }
            for (int i = 0; i < 64; ++i) { const float gg = g2[i * AW + j];
#pragma unroll
                for (int tt = 0; tt < 4; ++tt) { const int t = 4 * tg + tt; gacc[tt] += xs[t * 1296 + 1216 + i] * gg; } }
            if (l > 0) for (int i = 0; i < 16; ++i) { const float vv = v2[i * AW + j];
#pragma unroll
                for (int tt = 0; tt < 4; ++tt) { const int t = 4 * tg + tt; macc[tt] += xs[t * 1296 + 1280 + i] * vv; } }
            const float kkw = F.in[I_KK][l * AW + j], kaw = F.in[I_KA][l * AW + j], rkw = F.in[I_RK][l * AW + j];
#pragma unroll
            for (int tt = 0; tt < 4; ++tt) { const int t = 4 * tg + tt, tok = tok0 + t; const size_t o = (size_t)tok * AW + j;
                const float r = xs[t * 1296 + j], k = xs[t * 1296 + 384 + j]; float v = xs[t * 1296 + 768 + j];
                const float z = -wacc[tt];
                const float sp = fmaxf(z, 0.f) + log1pf(__expf(-fabsf(z)));
                const float rate = __expf(-sp - 0.5f);
                const float d = -expm1f(-rate);
                const float a = sigmoid_f(aacc[tt]);
                if (l > 0) { const float vf = bf2f(VF[o]); v = v + (vf - v) * sigmoid_f(macc[tt]); }
                VF[o] = (bf16)f2bf(v);
                const float kk = k * kkw * rn[t * 8 + h], k2 = k * (1.0f + (a - 1.0f) * kaw);
                R[o] = (bf16)f2bf(r); Dd[o] = (bf16)f2bf(d); K2[o] = (bf16)f2bf(k2); KK[o] = (bf16)f2bf(kk); BP[o] = (bf16)f2bf(kk * a); Gg[o] = (bf16)f2bf(gacc[tt]);
                prod[t * AW + j] = r * k2 * rkw; }
        }
    }
    __syncthreads();
    if (tid < PT * 6) { const int t = tid / 6, h = tid - t * 6; float s = 0.f; for (int j = 0; j < 64; ++j) s += prod[t * AW + h * 64 + j];
        ((float*)(F.ws + WS_BON))[(size_t)(tok0 + t) * 6 + h] = s; }
    {
        const float* kvn = F.in[I_KVN] + l * 128; bf16* C = (bf16*)(F.ws + WS_C);
#pragma unroll
        for (int q = 0; q < 2; ++q) { const int tok = tok0 + 2 * F.wave + q; const unsigned w = *(const GAS unsigned*)(P + (size_t)tok * PP + PBC + 2 * F.lane);
            const float c0 = bflo(w), c1 = bfhi(w); const float ss = wave_sum(c0 * c0 + c1 * c1); const float rs = 1.0f / sqrtf(ss * (1.0f / 128.0f) + 1e-6f);
            *(GAS unsigned*)(C + (size_t)tok * 128 + 2 * F.lane) = pk2(c0 * rs * kvn[2 * F.lane], c1 * rs * kvn[2 * F.lane + 1]); }
    }
    __syncthreads();
}

__device__ __forceinline__ void ret_kv_unit(const Frame& F, int unit) {
    LAS float* kr = (LAS float*)F.lds; LAS float* vv = kr + 128 * 64;
    const int tid = F.tid, c = unit & 15, h = (unit >> 4) & 3, b = unit >> 6, tok0 = b * SEQ + c * 128;
    const bf16* P = (const bf16*)(F.ws + WS_P); const float* tab = (const float*)(F.ws + WS_TAB);
    const float lg2 = log2f(1.0f - exp2f(-5.0f - (float)h));
    for (int idx = tid; idx < 128 * 32; idx += NTHR) { const int m = idx >> 5, i = idx & 31; const size_t ro = (size_t)(tok0 + m) * PP;
        const float k1 = bf2f(P[ro + PCK + h * 64 + i]), k2 = bf2f(P[ro + PCK + h * 64 + 32 + i]);
        const float cs = tab[((c * 128 + m) * 32 + i) * 2], sn = tab[((c * 128 + m) * 32 + i) * 2 + 1];
        const float sc = 0.125f * exp2f((float)(127 - m) * lg2);
        kr[m * 64 + i] = (k1 * cs - k2 * sn) * sc; kr[m * 64 + 32 + i] = (k1 * sn + k2 * cs) * sc;
        vv[m * 64 + i] = bf2f(P[ro + PCV + h * 64 + i]); vv[m * 64 + 32 + i] = bf2f(P[ro + PCV + h * 64 + 32 + i]); }
    __syncthreads();
    const int d = tid >> 3, e0 = (tid & 7) * 8; float acc[8];
#pragma unroll
    for (int e = 0; e < 8; ++e) acc[e] = 0.f;
    for (int m = 0; m < 128; ++m) { const float kd = kr[m * 64 + d];
#pragma unroll
        for (int e = 0; e < 8; ++e) acc[e] += kd * vv[m * 64 + e0 + e]; }
    float* KV = (float*)(F.ws + WS_KV) + (size_t)unit * 4096 + d * 64 + e0;
#pragma unroll
    for (int e = 0; e < 8; ++e) KV[e] = acc[e];
    __syncthreads();
}

__device__ __forceinline__ void ret_out_unit(const Frame& F, int unit) {
    LAS float* qr = (LAS float*)F.lds; LAS float* kr = qr + 8192; LAS float* vv = kr + 8192; LAS float* st = vv + 8192;
    const int tid = F.tid, c = unit & 15, h = (unit >> 4) & 3, b = unit >> 6, tok0 = b * SEQ + c * 128;
    bf16* P = (bf16*)(F.ws + WS_P); const float* tab = (const float*)(F.ws + WS_TAB);
    const float lg2 = log2f(1.0f - exp2f(-5.0f - (float)h));
    for (int idx = tid; idx < 128 * 32; idx += NTHR) { const int m = idx >> 5, i = idx & 31; const size_t ro = (size_t)(tok0 + m) * PP;
        const float cs = tab[((c * 128 + m) * 32 + i) * 2], sn = tab[((c * 128 + m) * 32 + i) * 2 + 1];
        const float q1 = bf2f(P[ro + PCQ + h * 64 + i]), q2 = bf2f(P[ro + PCQ + h * 64 + 32 + i]);
        const float k1 = bf2f(P[ro + PCK + h * 64 + i]), k2 = bf2f(P[ro + PCK + h * 64 + 32 + i]);
        qr[m * 64 + i] = q1 * cs - q2 * sn; qr[m * 64 + 32 + i] = q1 * sn + q2 * cs;
        kr[m * 64 + i] = (k1 * cs - k2 * sn) * 0.125f; kr[m * 64 + 32 + i] = (k1 * sn + k2 * cs) * 0.125f;
        vv[m * 64 + i] = bf2f(P[ro + PCV + h * 64 + i]); vv[m * 64 + 32 + i] = bf2f(P[ro + PCV + h * 64 + 32 + i]); }
    {
        const float* KV = (const float*)(F.ws + WS_KV) + (size_t)(unit - c) * 4096; float s[8];
#pragma unroll
        for (int e = 0; e < 8; ++e) s[e] = 0.f;
        const float cd = exp2f(128.0f * lg2);
        for (int j = 0; j < c; ++j) {
#pragma unroll
            for (int e = 0; e < 8; ++e) s[e] = s[e] * cd + KV[(size_t)j * 4096 + tid * 8 + e]; }
#pragma unroll
        for (int e = 0; e < 8; ++e) st[tid * 8 + e] = s[e];
    }
    __syncthreads();
    const int n = tid >> 2, e0 = (tid & 3) * 16; float acc[16], cr[16];
#pragma unroll
    for (int e = 0; e < 16; ++e) { acc[e] = 0.f; cr[e] = 0.f; }
    for (int m = 0; m <= n; ++m) { float s = 0.f;
#pragma unroll 16
        for (int d = 0; d < 64; ++d) s += qr[n * 64 + d] * kr[m * 64 + d];
        s *= exp2f((float)(n - m) * lg2);
#pragma unroll
        for (int e = 0; e < 16; ++e) acc[e] += s * vv[m * 64 + e0 + e]; }
    for (int d = 0; d < 64; ++d) { const float qd = qr[n * 64 + d];
#pragma unroll
        for (int e = 0; e < 16; ++e) cr[e] += qd * st[d * 64 + e0 + e]; }
    const float qdec = exp2f((float)(n + 1) * lg2); float ss = 0.f;
#pragma unroll
    for (int e = 0; e < 16; ++e) { acc[e] += cr[e] * qdec; ss += acc[e] * acc[e]; }
    ss += __shfl_xor(ss, 1); ss += __shfl_xor(ss, 2);
    const float rs = 1.0f / sqrtf(ss * (1.0f / 64.0f) + 1e-6f);
    const size_t ro = (size_t)(tok0 + n) * PP;
    float gv[16];
#pragma unroll
    for (int e = 0; e < 16; ++e) gv[e] = bf2f(P[ro + PCG + h * 64 + e0 + e]);
#pragma unroll
    for (int e = 0; e < 16; e += 2) { const float o0 = gv[e] * sigmoid_f(gv[e]) * acc[e] * rs, o1 = gv[e + 1] * sigmoid_f(gv[e + 1]) * acc[e + 1] * rs;
        *(GAS unsigned*)(P + ro + 768 + h * 64 + e0 + e) = pk2(o0, o1); }
    __syncthreads();
}

__device__ __forceinline__ float dpp_add8(float x) {
    x += __builtin_bit_cast(float, __builtin_amdgcn_mov_dpp(__builtin_bit_cast(int, x), 0xB1, 0xF, 0xF, true));
    x += __builtin_bit_cast(float, __builtin_amdgcn_mov_dpp(__builtin_bit_cast(int, x), 0x4E, 0xF, 0xF, true));
    x += __builtin_bit_cast(float, __builtin_amdgcn_mov_dpp(__builtin_bit_cast(int, x), 0x141, 0xF, 0xF, true));
    return x;
}
constexpr int CH = 32;
__device__ __forceinline__ void rwkv_scan_unit(const Frame& F, int l, int unit) {
    const int tid = F.tid, lane = F.lane, wave = F.wave, b = unit / 6, h = unit - b * 6, tokb = b * SEQ;
    LAS float* stg = (LAS float*)F.lds; LAS float* ybuf = stg + 2 * 6 * CH * 64;
    const bool hi8 = (tid >> 8) != 0;
    const bf16* src0 = (const bf16*)(F.ws + (hi8 ? WS_D : WS_R)); const bf16* src1 = (const bf16*)(F.ws + (hi8 ? WS_KK : WS_K2)); const bf16* src2 = (const bf16*)(F.ws + (hi8 ? WS_VF : WS_BP));
    const bf16* Gg = (const bf16*)(F.ws + WS_G); const float* BON = (const float*)(F.ws + WS_BON); bf16* P = (bf16*)(F.ws + WS_P);
    const int row = 8 * wave + (lane >> 3), ks = lane & 7;
    float S[8];
#pragma unroll
    for (int j = 0; j < 8; ++j) S[j] = 0.f;
    v4u sreg[3];
#define RW_LOAD(cc) do { const int t_ = (tid & 255) >> 3, c8_ = tid & 7; const size_t o_ = (size_t)(tokb + (cc) * CH + t_) * AW + h * 64 + c8_ * 8; \
        sreg[0] = *(const GAS v4u*)(src0 + o_); sreg[1] = *(const GAS v4u*)(src1 + o_); sreg[2] = *(const GAS v4u*)(src2 + o_); } while (0)
#define RW_STORE(bufi) do { _Pragma("unroll") for (int i = 0; i < 3; ++i) { const int q = tid + 512 * i, ar = q >> 8, t = (q & 255) >> 3, c8 = q & 7; float f[8]; unpack8(sreg[i], f); \
        LAS f32x4* dst = (LAS f32x4*)(stg + ((bufi) * 6 + ar) * CH * 64 + t * 64 + c8 * 8); dst[0] = (f32x4){f[0], f[1], f[2], f[3]}; dst[1] = (f32x4){f[4], f[5], f[6], f[7]}; } } while (0)
    RW_LOAD(0); RW_STORE(0);
    __syncthreads();
    const float lnw = F.in[I_LNW][l * AW + h * 64 + (tid & 15) * 4], lnw1 = F.in[I_LNW][l * AW + h * 64 + (tid & 15) * 4 + 1], lnw2 = F.in[I_LNW][l * AW + h * 64 + (tid & 15) * 4 + 2], lnw3 = F.in[I_LNW][l * AW + h * 64 + (tid & 15) * 4 + 3];
    const float lnb = F.in[I_LNB][l * AW + h * 64 + (tid & 15) * 4], lnb1 = F.in[I_LNB][l * AW + h * 64 + (tid & 15) * 4 + 1], lnb2 = F.in[I_LNB][l * AW + h * 64 + (tid & 15) * 4 + 2], lnb3 = F.in[I_LNB][l * AW + h * 64 + (tid & 15) * 4 + 3];
    for (int cc = 0; cc < SEQ / CH; ++cc) {
        const int bufi = cc & 1;
        if (cc + 1 < SEQ / CH) RW_LOAD(cc + 1);
        const LAS float* base = stg + bufi * 6 * CH * 64;
#pragma unroll 4
        for (int s = 0; s < CH; ++s) {
            const LAS f32x4* pr = (const LAS f32x4*)(base + 0 * CH * 64 + s * 64 + ks * 8);
            const LAS f32x4* pd = (const LAS f32x4*)(base + 1 * CH * 64 + s * 64 + ks * 8);
            const LAS f32x4* pk = (const LAS f32x4*)(base + 2 * CH * 64 + s * 64 + ks * 8);
            const LAS f32x4* pq = (const LAS f32x4*)(base + 3 * CH * 64 + s * 64 + ks * 8);
            const LAS f32x4* pb = (const LAS f32x4*)(base + 4 * CH * 64 + s * 64 + ks * 8);
            const f32x4 r0 = pr[0], r1 = pr[1], d0 = pd[0], d1 = pd[1], k0 = pk[0], k1 = pk[1], q0 = pq[0], q1 = pq[1], b0 = pb[0], b1 = pb[1];
            const float v = base[5 * CH * 64 + s * 64 + row];
            float p = (S[0] * q0[0] + S[1] * q0[1]) + (S[2] * q0[2] + S[3] * q0[3]) + (S[4] * q1[0] + S[5] * q1[1]) + (S[6] * q1[2] + S[7] * q1[3]);
            p = dpp_add8(p);
#pragma unroll
            for (int j = 0; j < 4; ++j) { S[j] = fmaf(-d0[j], S[j], S[j]); S[j] = fmaf(-p, b0[j], S[j]); S[j] = fmaf(v, k0[j], S[j]);
                S[4 + j] = fmaf(-d1[j], S[4 + j], S[4 + j]); S[4 + j] = fmaf(-p, b1[j], S[4 + j]); S[4 + j] = fmaf(v, k1[j], S[4 + j]); }
            float y = (S[0] * r0[0] + S[1] * r0[1]) + (S[2] * r0[2] + S[3] * r0[3]) + (S[4] * r1[0] + S[5] * r1[1]) + (S[6] * r1[2] + S[7] * r1[3]);
            y = dpp_add8(y);
            if (ks == 0) ybuf[s * 64 + row] = y;
        }
        __syncthreads();
        {
            const int s = tid >> 4, r4 = (tid & 15) * 4, tok = tokb + cc * CH + s;
            const f32x4 yv = *(const LAS f32x4*)(ybuf + s * 64 + r4);
            float sm = (yv[0] + yv[1]) + (yv[2] + yv[3]);
            sm += __shfl_xor(sm, 1); sm += __shfl_xor(sm, 2); sm += __shfl_xor(sm, 4); sm += __shfl_xor(sm, 8);
            const float mean = sm * (1.0f / 64.0f); const f32x4 dv = yv - mean;
            float vs = (dv[0] * dv[0] + dv[1] * dv[1]) + (dv[2] * dv[2] + dv[3] * dv[3]);
            vs += __shfl_xor(vs, 1); vs += __shfl_xor(vs, 2); vs += __shfl_xor(vs, 4); vs += __shfl_xor(vs, 8);
            const float rs = 1.0f / sqrtf(vs * (1.0f / 64.0f) + 64e-5f);
            const f32x4 vv = *(const LAS f32x4*)(base + 5 * CH * 64 + s * 64 + r4);
            const float bon = BON[(size_t)tok * 6 + h];
            const unsigned long long gw = *(const GAS unsigned long long*)(Gg + (size_t)tok * AW + h * 64 + r4);
            const float g0 = bflo((unsigned)gw), g1 = bfhi((unsigned)gw), g2 = bflo((unsigned)(gw >> 32)), g3 = bfhi((unsigned)(gw >> 32));
            const float o0 = (dv[0] * rs * lnw + lnb + bon * vv[0]) * g0, o1 = (dv[1] * rs * lnw1 + lnb1 + bon * vv[1]) * g1;
            const float o2 = (dv[2] * rs * lnw2 + lnb2 + bon * vv[2]) * g2, o3 = (dv[3] * rs * lnw3 + lnb3 + bon * vv[3]) * g3;
            *(GAS unsigned long long*)(P + (size_t)tok * PP + h * 64 + r4) = (unsigned long long)pk2(o0, o1) | ((unsigned long long)pk2(o2, o3) << 32);
        }
        if (cc + 1 < SEQ / CH) RW_STORE(bufi ^ 1);
        __syncthreads();
    }
#undef RW_LOAD
#undef RW_STORE
}

__device__ __forceinline__ unsigned fkey(float f) { const unsigned u = __float_as_uint(f); return (u & 0x80000000u) ? ~u : (u | 0x80000000u); }
__device__ __forceinline__ void dsa_query_unit(const Frame& F, int l, int gt) {
    LAS float* iq = (LAS float*)F.lds; LAS float* iw = iq + 512; LAS float* qs = iw + 8; LAS float* qlat = qs + 384; LAS unsigned* keys = (LAS unsigned*)(qlat + 768);
    LAS int* sel = (LAS int*)(keys + 2048); LAS float* prob = (LAS float*)(sel + 256); LAS float* olat = prob + 1536; LAS unsigned* hist = (LAS unsigned*)(olat + 768);
    LAS unsigned* misc = hist + 256; LAS unsigned* wcnt = misc + 16;
    const int tid = F.tid, lane = F.lane, wave = F.wave, b = gt / SEQ, t = gt - b * SEQ;
    bf16* P = (bf16*)(F.ws + WS_P); const bf16* C = (const bf16*)(F.ws + WS_C);
    const size_t qrow = (size_t)gt * PP;
    iq[tid] = bf2f(P[qrow + PBIQ + tid]) * 0.125f;
    if (tid < 8) iw[tid] = bf2f(P[qrow + PBIW + tid]) * 0.35355339059327373f;
    if (tid < 384) qs[tid] = bf2f(P[qrow + PBQ + tid]);
    __syncthreads();
    { const float* wuk = F.in[I_WUK] + (size_t)l * 6 * 64 * 128;
      for (int o = tid; o < 768; o += NTHR) { const int h = o >> 7, c = o & 127; float s = 0.f;
          for (int d = 0; d < 64; ++d) s += qs[h * 64 + d] * wuk[(h * 64 + d) * 128 + c];
          qlat[o] = s * 0.125f; } }
    unsigned mykey[4];
#pragma unroll
    for (int i = 0; i < 4; ++i) { const int s = tid + 512 * i; unsigned key = 0u;
        if (s <= t) { const bf16* kp = P + (size_t)(b * SEQ + s) * PP + PBIK; float kf[64];
#pragma unroll
            for (int c8 = 0; c8 < 8; ++c8) { const v4u w = *(const GAS v4u*)(kp + c8 * 8); float f[8]; unpack8(w, f);
#pragma unroll
                for (int j = 0; j < 8; ++j) kf[c8 * 8 + j] = f[j]; }
            float sc = 0.f;
            for (int hh = 0; hh < 8; ++hh) { float d = 0.f;
#pragma unroll
                for (int j = 0; j < 64; ++j) d += iq[hh * 64 + j] * kf[j];
                sc += iw[hh] * fmaxf(d, 0.f); }
            key = fkey(sc); }
        mykey[i] = key; keys[s] = key; }
    __syncthreads();
    const int n = t + 1; unsigned tau = 0u; int s_cut = t;
    if (n > TOPK) {
        unsigned prefix = 0u; unsigned krem = TOPK;
        for (int p = 0; p < 4; ++p) { const int shift = 24 - 8 * p;
            if (tid < 256) hist[tid] = 0u;
            __syncthreads();
#pragma unroll
            for (int i = 0; i < 4; ++i) { const int s = tid + 512 * i;
                if (s <= t && (p == 0 || (mykey[i] >> (shift + 8)) == prefix)) __hip_atomic_fetch_add(&hist[(mykey[i] >> shift) & 255u], 1u, __ATOMIC_RELAXED, __HIP_MEMORY_SCOPE_WORKGROUP); }
            __syncthreads();
            if (wave == 0) { const unsigned c0 = hist[4 * lane], c1 = hist[4 * lane + 1], c2 = hist[4 * lane + 2], c3 = hist[4 * lane + 3]; const unsigned ls = c0 + c1 + c2 + c3;
                unsigned suf = ls;
#pragma unroll
                for (int o = 1; o < 64; o <<= 1) { const unsigned v = __shfl_down(suf, o); if (lane + o < 64) suf += v; }
                const unsigned above = suf - ls;
                if (above < krem && suf >= krem) { unsigned ab = above; int dg; unsigned ce;
                    if (ab + c3 >= krem) { dg = 3; ce = c3; } else { ab += c3; if (ab + c2 >= krem) { dg = 2; ce = c2; } else { ab += c2; if (ab + c1 >= krem) { dg = 1; ce = c1; } else { ab += c1; dg = 0; ce = c0; } } }
                    misc[0] = (unsigned)(4 * lane + dg); misc[1] = krem - ab; misc[2] = ce; } }
            __syncthreads();
            prefix = (prefix << 8) | misc[0]; krem = misc[1];
        }
        tau = prefix;
        const unsigned need = krem, cnt_eq = misc[2];
        __syncthreads();
        if (cnt_eq > need) { if (tid == 0) { unsigned cnt = 0; int sc = t; for (int s = 0; s <= t; ++s) if (keys[s] == tau) { if (++cnt == need) { sc = s; break; } } misc[3] = (unsigned)sc; }
            __syncthreads(); s_cut = (int)misc[3]; }
    }
    unsigned long long bal[4];
#pragma unroll
    for (int i = 0; i < 4; ++i) { const int s = tid + 512 * i; const bool f = (s <= t) && (mykey[i] > tau || (mykey[i] == tau && s <= s_cut)); bal[i] = __ballot(f); if (lane == 0) wcnt[i * 8 + wave] = (unsigned)__popcll(bal[i]); }
    __syncthreads();
    int nsel = 0;
    { unsigned run = 0;
#pragma unroll
      for (int i = 0; i < 4; ++i) { unsigned basei = run;
          for (int w = 0; w < 8; ++w) { const unsigned c = wcnt[i * 8 + w]; if (w < wave) basei += c; run += c; }
          const unsigned long long below = bal[i] & ((1ull << lane) - 1ull);
          if ((bal[i] >> lane) & 1ull) sel[basei + (unsigned)__popcll(below)] = tid + 512 * i; }
      nsel = (int)run; }
    __syncthreads();
    { const int jj = tid & 255, hg = tid >> 8; float lg[3] = {-INFINITY, -INFINITY, -INFINITY};
      if (jj < nsel) { const bf16* cp = C + (size_t)(b * SEQ + sel[jj]) * 128; lg[0] = lg[1] = lg[2] = 0.f;
          for (int c8 = 0; c8 < 16; ++c8) { const v4u w = *(const GAS v4u*)(cp + c8 * 8); float f[8]; unpack8(w, f);
#pragma unroll
              for (int j = 0; j < 8; ++j) { lg[0] += f[j] * qlat[(hg * 3 + 0) * 128 + c8 * 8 + j]; lg[1] += f[j] * qlat[(hg * 3 + 1) * 128 + c8 * 8 + j]; lg[2] += f[j] * qlat[(hg * 3 + 2) * 128 + c8 * 8 + j]; } } }
      prob[(hg * 3 + 0) * 256 + jj] = lg[0]; prob[(hg * 3 + 1) * 256 + jj] = lg[1]; prob[(hg * 3 + 2) * 256 + jj] = lg[2]; }
    __syncthreads();
    if (wave < 6) { float v[4]; float mx = -INFINITY;
#pragma unroll
        for (int i = 0; i < 4; ++i) { v[i] = prob[wave * 256 + lane + 64 * i]; mx = fmaxf(mx, v[i]); }
#pragma unroll
        for (int o = 1; o < 64; o <<= 1) mx = fmaxf(mx, __shfl_xor(mx, o));
        float sm = 0.f;
#pragma unroll
        for (int i = 0; i < 4; ++i) { v[i] = __expf(v[i] - mx); sm += v[i]; }
        sm = wave_sum(sm); const float inv = 1.0f / sm;
#pragma unroll
        for (int i = 0; i < 4; ++i) prob[wave * 256 + lane + 64 * i] = v[i] * inv; }
    __syncthreads();
    for (int o = tid; o < 768; o += NTHR) { const int h = o >> 7, c = o & 127; float s = 0.f;
        for (int j = 0; j < nsel; ++j) s += prob[h * 256 + j] * bf2f(C[(size_t)(b * SEQ + sel[j]) * 128 + c]);
        olat[o] = s; }
    __syncthreads();
    if (tid < 384) { const int h = tid >> 6, d = tid & 63; const float* wuv = F.in[I_WUV] + (size_t)l * 6 * 128 * 64 + (size_t)h * 128 * 64; float s = 0.f;
        for (int c = 0; c < 128; ++c) s += olat[h * 128 + c] * wuv[c * 64 + d];
        P[qrow + 384 + tid] = (bf16)f2bf(s); }
    __syncthreads();
}

__device__ __forceinline__ void final_norm(const Frame& F) {
    const int gw = F.vcu * NWAVES + F.wave, NGW = F.G * NWAVES; const float* g = F.in[I_FN];
    for (int m = gw; m < M; m += NGW) { GAS f32x4* xr = (GAS f32x4*)(F.out + (size_t)m * DM) + F.lane; f32x4 v[4]; float s = 0.f;
#pragma unroll
        for (int j = 0; j < 4; ++j) { v[j] = xr[64 * j]; s += (v[j].x * v[j].x + v[j].y * v[j].y) + (v[j].z * v[j].z + v[j].w * v[j].w); }
        const float rs = 1.0f / sqrtf(wave_sum(s) * (1.0f / DM) + 1e-6f);
#pragma unroll
        for (int j = 0; j < 4; ++j) { const f32x4 gg = *(const f32x4*)(g + 4 * F.lane + 256 * j); xr[64 * j] = v[j] * rs * gg; } }
}

template <class T> __device__ __forceinline__ T* launder_ptr(T* p) {
    unsigned lo = (unsigned)(uintptr_t)p, hi = (unsigned)((uintptr_t)p >> 32);
    asm volatile("" : "+v"(lo), "+v"(hi));
    lo = __builtin_amdgcn_readfirstlane(lo); hi = __builtin_amdgcn_readfirstlane(hi);
    return (T*)(((uintptr_t)hi << 32) | (uintptr_t)lo);
}
constexpr int NPHASE = 18;
__global__ void __launch_bounds__(NTHR, 2) fwd_kernel(Args args) {
    extern __shared__ __attribute__((aligned(16))) unsigned char lds[];
    Frame F;
    F.lds = (LAS unsigned char*)lds;
    F.tid = threadIdx.x; F.lane = F.tid & 63; F.wave = __builtin_amdgcn_readfirstlane(F.tid >> 6);
    F.G = gridDim.x; { const int bx = blockIdx.x; F.vcu = (F.G % 8 == 0) ? (bx % 8) * (F.G / 8) + bx / 8 : bx; }
    F.in = args.in; F.out = args.out; F.ws = args.ws;
    volatile LAS unsigned* MISC = (volatile LAS unsigned*)(F.lds + MISC_OFF);
    for (int u = F.tid; u < (LDS_BYTES - LDSCTL_OFF) / 4; u += NTHR) ((LAS unsigned*)(F.lds + LDSCTL_OFF))[u] = 0u;
    __syncthreads();
    const int lo = args.ph_lo, hi = args.ph_hi;
    XcdBarrier bar; bar.bar = (unsigned*)(F.ws + WS_CTL) + CW_BAR; bar.x = 0; bar.st = nullptr;
    if (hi - lo > 1) bar = xcd_barrier_post((unsigned*)(F.ws + WS_CTL) + CW_BAR, MISC + 8);
    for (int ph_ = lo; ph_ < hi; ++ph_) {
        int ph = ph_; asm volatile("" : "+v"(ph)); ph = __builtin_amdgcn_readfirstlane(ph);
#define PH_ENTER() \
        { unsigned z_ = 0u; int t_ = threadIdx.x; asm volatile("" : "+v"(z_), "+v"(t_)); z_ = __builtin_amdgcn_readfirstlane(z_); F.in = args.in; F.out = args.out + z_; F.ws = args.ws + z_; \
          F.tid = t_; F.lane = t_ & 63; F.wave = __builtin_amdgcn_readfirstlane(t_ >> 6); } \
        int bx = blockIdx.x; { int g_ = gridDim.x; asm volatile("" : "+v"(bx), "+v"(g_)); bx = __builtin_amdgcn_readfirstlane(bx); g_ = __builtin_amdgcn_readfirstlane(g_); F.G = g_; F.vcu = (g_ % 8 == 0) ? (bx % 8) * (g_ / 8) + bx / 8 : bx; } \
        gu32* ctl = (gu32*)(F.ws + WS_CTL); (void)ctl; \
        bf16* XB = (bf16*)(F.ws + WS_XB); bf16* Hb = (bf16*)(F.ws + WS_H); bf16* Pb = (bf16*)(F.ws + WS_P); float* part = (float*)(F.ws + WS_PART); (void)XB; (void)Hb; (void)Pb; (void)part;
        if (ph == 0) { PH_ENTER();
            conv_weights(F, 0, 0, 6);
            p0_x(F); p0_table(F);
        } else if (ph == NPHASE - 1) { PH_ENTER();
            final_norm(F);
        } else {
            const int l = (ph - 1) >> 3, sub = (ph - 1) & 7;
            if (sub == 0 || sub == 6) { PH_ENTER();
                pg8::Gemm g{XB, (const bf16*)(F.ws + (sub == 0 ? WS_WGU1 : WS_WGU2)), M, NGU, DM, DM}; pg8::StaticOrder S; S.init(M, NGU, F.G, bx);
                pg8::EpiUp E{Hb, FFP, part};
                pg8::gemm_phase<pg8::EpiUp, pg8::StaticOrder, true>(F.lds, g, S, E, F.tid);
            } else if (sub == 1 || sub == 7 || sub == 5) { PH_ENTER();
                const bool op = (sub == 5);
                pg8::Gemm g{op ? Pb : Hb, (const bf16*)(F.ws + (op ? WS_WOUT : (sub == 1 ? WS_WD1 : WS_WD2))), M, DM, op ? DM : FFP, op ? PP : FFP}; pg8::StaticOrder S; S.init(M, DM, F.G, bx);
                const float* base = (l == 0 && sub == 1) ? F.in[I_X] : F.out;
                pg8::EpiRes E{base, F.out, XB, part};
                pg8::gemm_phase<pg8::EpiRes, pg8::StaticOrder, false>(F.lds, g, S, E, F.tid);
            } else if (sub == 2) { PH_ENTER();
                pg8::Gemm g{XB, (const bf16*)(F.ws + WS_WIN), M, PP, DM, DM}; pg8::StaticOrder S; S.init(M, PP, F.G, bx);
                pg8::EpiP E{Pb, PP, part};
                pg8::gemm_phase<pg8::EpiP, pg8::StaticOrder, true>(F.lds, g, S, E, F.tid);
            } else if (sub == 3) { PH_ENTER();
                for (int u = F.vcu; u < M / PT; u += F.G) prep_tokens_unit(F, l, u);
                for (int u = F.vcu; u < BATCH * 4 * 16; u += F.G) ret_kv_unit(F, u);
                if (l + 1 < DEPTH) conv_weights(F, l + 1, 0, 3);
                if (l > 0) conv_weights(F, l, 3, 6);
            } else if (sub == 4) { PH_ENTER();
                if (bx < BATCH * 6) rwkv_scan_unit(F, l, bx);
                else {
                    gu32* qh = ctl + CW_QUEUE + 64 * l;
                    for (;;) {
                        if (F.tid == 0) MISC[0] = __hip_atomic_fetch_add(qh, 1u, RLX_AGENT);
                        __syncthreads();
                        const int u = (int)MISC[0];
                        __syncthreads();
                        if (u >= M + BATCH * 4 * 16) break;
                        if (u < M) { const int tq = SEQ - 1 - (u >> 3), bq = u & 7; dsa_query_unit(F, l, bq * SEQ + tq); }
                        else ret_out_unit(F, u - M);
                    }
                }
            }
        }
        if (ph_ + 1 < hi) xcd_barrier(bar);
    }
}

extern "C" void kernel_launch(void* const* d_in, const int* in_sizes, int n_in, void* d_out, int out_size, void* d_ws, size_t ws_size, hipStream_t stream) {
    static int grid = 0;
    if (grid == 0) {
        if (n_in != 31 || out_size != M * DM || ws_size < WS_END) { fprintf(stderr, "kernel_launch: unexpected shapes (n_in %d, out %d, ws %zu)\n", n_in, out_size, ws_size); grid = -1; return; }
        int dev = 0, cus = 0, per_cu = 0;
        if (hipGetDevice(&dev) != hipSuccess || hipDeviceGetAttribute(&cus, hipDeviceAttributeMultiprocessorCount, dev) != hipSuccess) { grid = -1; return; }
        if (hipFuncSetAttribute((const void*)fwd_kernel, hipFuncAttributeMaxDynamicSharedMemorySize, LDS_BYTES) != hipSuccess) { fprintf(stderr, "kernel_launch: hipFuncSetAttribute failed\n"); grid = -1; return; }
        if (hipOccupancyMaxActiveBlocksPerMultiprocessor(&per_cu, (const void*)fwd_kernel, NTHR, LDS_BYTES) != hipSuccess || per_cu < 1) fprintf(stderr, "kernel_launch: occupancy query says %d\n", per_cu);
        (void)hipGetLastError();
        grid = cus;
    }
    if (grid < 0) return;
    if (hipMemsetAsync((char*)d_ws + WS_CTL, 0, CTL_ZERO_BYTES, stream) != hipSuccess) return;
    Args a{};
    for (int i = 0; i < 31; ++i) a.in[i] = (const float*)d_in[i];
    a.out = (float*)d_out; a.ws = (unsigned char*)d_ws;
#ifndef ONE_LAUNCH
#define ONE_LAUNCH 1
#endif
    if (ONE_LAUNCH) { a.ph_lo = 0; a.ph_hi = NPHASE; hipLaunchKernelGGL(fwd_kernel, dim3(grid), dim3(NTHR), LDS_BYTES, stream, a); }
    else for (int ph = 0; ph < NPHASE; ++ph) { a.ph_lo = ph; a.ph_hi = ph + 1; hipLaunchKernelGGL(fwd_kernel, dim3(grid), dim3(NTHR), LDS_BYTES, stream, a); }
}
```

```cpp
#include <hip/hip_runtime.h>
#include <cstdio>
#include <cstdint>
#include <cmath>

namespace pg8 {
#define PG8_LAS __attribute__((address_space(3)))
typedef unsigned short bf16_t;
typedef short bf16x8 __attribute__((ext_vector_type(8)));
typedef float f32x4 __attribute__((ext_vector_type(4)));
typedef unsigned u32x4 __attribute__((ext_vector_type(4)));
constexpr int BM = 256, BK = 64, HALF = 128, HTB = HALF * BK * 2  , STAGE_BYTES = 8 * HTB, NXCD = 8, WGM = 8;

__host__ __device__ __forceinline__ int lds_byte(int r, int c) { const int st = (r >> 4) * 2 + (c >> 5), rr = r & 15, cc = c & 31, ob = rr * 64 + cc * 2; return st * 1024 + (ob ^ (((ob >> 9) & 1) << 5)); }
__host__ __device__ __forceinline__ void stage_rc(int b, int& R, int& C) { const int st = b / 1024, sb = b % 1024, swz = sb ^ (((sb >> 9) & 1) << 5); R = (st >> 1) * 16 + swz / 64; C = (st & 1) * 32 + (swz % 64) / 2; }
__host__ __device__ __forceinline__ int perm32(int rho) { const int n = rho >> 4, i = rho & 15; return 8 * (i >> 2) + 4 * n + (i & 3); }

struct Unit { int pm, pn; };
struct Gemm { const bf16_t* A; const bf16_t* Bt; int M, N, K, lda; };

struct StaticOrder {
    int nM, nN, nwg, G, c;
    __host__ __device__ void init(int M, int N, int G_, int c_) { nM = M / BM; nN = N / BM; nwg = nM * nN; G = G_; c = c_; }
    __host__ __device__ bool next(int i, Unit& u) const {
        const long L = (long)i * G + c; if (L >= nwg) return false;
        int wgid = (int)L; { const int q = nwg / NXCD, r = nwg % NXCD, xcd = wgid % NXCD, off = wgid / NXCD; wgid = (xcd < r ? xcd * (q + 1) : r * (q + 1) + (xcd - r) * q) + off; }
        const int nig = WGM * nN, gid = wgid / nig, fm = gid * WGM, gsz = (nM - fm) < WGM ? (nM - fm) : WGM;
        u.pm = fm + ((wgid % nig) % gsz); u.pn = (wgid % nig) / gsz; return true;
    }
    __device__ __forceinline__ void a_ready(const Unit&) const {}
    __device__ __forceinline__ void done(const Unit&) const {}
};

__device__ __forceinline__ unsigned cvt_pk_bf16(float lo, float hi) { unsigned r; asm volatile("v_cvt_pk_bf16_f32 %0, %1, %2" : "=v"(r) : "v"(lo), "v"(hi)); return r; }


__device__ __forceinline__ float row_rstd(const float* part, int row) {
    const f32x4* p = (const f32x4*)(part + (size_t)row * 16);
    const f32x4 a = p[0], b = p[1], c = p[2], d = p[3];
    const float s = ((a[0] + a[1]) + (a[2] + a[3])) + ((b[0] + b[1]) + (b[2] + b[3])) + ((c[0] + c[1]) + (c[2] + c[3])) + ((d[0] + d[1]) + (d[2] + d[3]));
    return 1.0f / sqrtf(s * (1.0f / 1024.0f) + 1e-6f);
}
__device__ __forceinline__ float silu_f(float x) { return x * __builtin_amdgcn_rcpf(1.0f + __expf(-x)); }

struct EpiUp {
    static constexpr bool PERM = true;
    bf16_t* H; int ldh; const float* part;
    __device__ __forceinline__ void operator()(const f32x4 (&acc)[2][2][4][2], const Unit& u, int wr, int wc, int fr, int fq) const {
        const int row0 = u.pm * BM + wr * 64 + fr, hcol = u.pn * 128 + wc * 32 + 8 * fq;
#pragma unroll
        for (int ai = 0; ai < 2; ++ai)
#pragma unroll
            for (int m = 0; m < 4; ++m) { const int row = row0 + ai * HALF + m * 16; const float rs = row_rstd(part, row);
                const f32x4 g0 = acc[ai][0][m][0] * rs, g1 = acc[ai][0][m][1] * rs, u0 = acc[ai][1][m][0] * rs, u1 = acc[ai][1][m][1] * rs;
                u32x4 w; w.x = cvt_pk_bf16(silu_f(g0[0]) * u0[0], silu_f(g0[1]) * u0[1]); w.y = cvt_pk_bf16(silu_f(g0[2]) * u0[2], silu_f(g0[3]) * u0[3]);
                w.z = cvt_pk_bf16(silu_f(g1[0]) * u1[0], silu_f(g1[1]) * u1[1]); w.w = cvt_pk_bf16(silu_f(g1[2]) * u1[2], silu_f(g1[3]) * u1[3]);
                *(u32x4*)(H + (size_t)row * ldh + hcol) = w; }
    }
};
struct EpiP {
    static constexpr bool PERM = true;
    bf16_t* P; int ldp; const float* part;
    __device__ __forceinline__ void operator()(const f32x4 (&acc)[2][2][4][2], const Unit& u, int wr, int wc, int fr, int fq) const {
        const int row0 = u.pm * BM + wr * 64 + fr, col0 = u.pn * BM + wc * 32 + 8 * fq;
#pragma unroll
        for (int ai = 0; ai < 2; ++ai)
#pragma unroll
            for (int m = 0; m < 4; ++m) { const int row = row0 + ai * HALF + m * 16; const float rs = row_rstd(part, row);
#pragma unroll
                for (int bj = 0; bj < 2; ++bj) { const f32x4 v0 = acc[ai][bj][m][0] * rs, v1 = acc[ai][bj][m][1] * rs;
                    u32x4 w; w.x = cvt_pk_bf16(v0[0], v0[1]); w.y = cvt_pk_bf16(v0[2], v0[3]); w.z = cvt_pk_bf16(v1[0], v1[1]); w.w = cvt_pk_bf16(v1[2], v1[3]);
                    *(u32x4*)(P + (size_t)row * ldp + col0 + bj * HALF) = w; } }
    }
};
struct EpiRes {
    static constexpr bool PERM = true;
    const float* base; float* out; bf16_t* xb; float* part;
    __device__ __forceinline__ void operator()(const f32x4 (&acc)[2][2][4][2], const Unit& u, int wr, int wc, int fr, int fq) const {
        const int row0 = u.pm * BM + wr * 64 + fr, col0 = u.pn * BM + wc * 32 + 8 * fq;
#pragma unroll
        for (int ai = 0; ai < 2; ++ai)
#pragma unroll
            for (int m = 0; m < 4; ++m) { const int row = row0 + ai * HALF + m * 16; float ss = 0.f;
#pragma unroll
                for (int bj = 0; bj < 2; ++bj) { const size_t off = (size_t)row * 1024 + col0 + bj * HALF;
                    const f32x4 v0 = acc[ai][bj][m][0] + *(const f32x4*)(base + off), v1 = acc[ai][bj][m][1] + *(const f32x4*)(base + off + 4);
                    *(f32x4*)(out + off) = v0; *(f32x4*)(out + off + 4) = v1;
                    u32x4 w; w.x = cvt_pk_bf16(v0[0], v0[1]); w.y = cvt_pk_bf16(v0[2], v0[3]); w.z = cvt_pk_bf16(v1[0], v1[1]); w.w = cvt_pk_bf16(v1[2], v1[3]);
                    *(u32x4*)(xb + off) = w;
                    ss += (v0[0] * v0[0] + v0[1] * v0[1]) + (v0[2] * v0[2] + v0[3] * v0[3]) + (v1[0] * v1[0] + v1[1] * v1[1]) + (v1[2] * v1[2] + v1[3] * v1[3]); }
                ss += __shfl_xor(ss, 16); ss += __shfl_xor(ss, 32);
                if (fq == 0) part[(size_t)row * 16 + u.pn * 4 + wc] = ss;
                asm volatile("" ::: "memory"); }
    }
};

template <class Epi, class Sched, bool ALIGN_EPI>
__device__ __forceinline__ void gemm_phase(PG8_LAS unsigned char* lds, const Gemm g, const Sched& S, const Epi& E, const int tid) {
    const int wid = __builtin_amdgcn_readfirstlane(tid >> 6), lane = tid & 63, wr = wid >> 2, wc = wid & 3, fr = lane & 15, fq = lane >> 4;
    const int K = g.K, nt = K / BK, lda = g.lda;
    unsigned voffA[2], voffB[2];
#pragma unroll
    for (int i = 0; i < 2; ++i) { int R, C; stage_rc(tid * 16 + i * 8192, R, C); const int Rb = Epi::PERM ? ((R & ~31) + perm32(R & 31)) : R;
        voffA[i] = (unsigned)(R * lda + C) * 2u; voffB[i] = (unsigned)(Rb * K + C) * 2u; }
    const size_t kstep = (size_t)(BK * 2);
    const size_t hstepA = (size_t)HALF * lda * 2, hstepB = (size_t)HALF * K * 2;
    const size_t tstepA = 2 * hstepA, tstepB = 2 * hstepB;
    const unsigned ldsw = (unsigned)wid * 1024u;
    const int aoff = lds_byte(wr * 64 + fr, fq * 8), boff = lds_byte(wc * 32 + fr, fq * 8);
#define PG8_SA(b, h) (((b) * 2 + (h)) * HTB)
#define PG8_SB(b, h) ((4 + (b) * 2 + (h)) * HTB)
#define PG8_STAGE(bufoff, gbase, voff) do { _Pragma("unroll") for (int _i = 0; _i < 2; ++_i) \
        __builtin_amdgcn_global_load_lds((const unsigned*)((const char*)(gbase) + (voff)[_i]), (PG8_LAS unsigned*)(lds + (bufoff) + ldsw + _i * 8192), 16, 0, 0); } while (0)
#define PG8_LDA(dst, b, h) do { _Pragma("unroll") for (int m = 0; m < 4; ++m) _Pragma("unroll") for (int k = 0; k < 2; ++k) dst[m][k] = *(const PG8_LAS bf16x8*)(lds + PG8_SA(b, h) + aoff + m * 2048 + k * 1024); } while (0)
#define PG8_LDB(dst, b, h) do { _Pragma("unroll") for (int n = 0; n < 2; ++n) _Pragma("unroll") for (int k = 0; k < 2; ++k) dst[n][k] = *(const PG8_LAS bf16x8*)(lds + PG8_SB(b, h) + boff + n * 2048 + k * 1024); } while (0)
#define PG8_MMA(ai, bj, At, Bt) do { __builtin_amdgcn_s_setprio(1); _Pragma("unroll") for (int m = 0; m < 4; ++m) _Pragma("unroll") for (int n = 0; n < 2; ++n) _Pragma("unroll") for (int k = 0; k < 2; ++k) \
        acc[ai][bj][m][n] = __builtin_amdgcn_mfma_f32_16x16x32_bf16(Bt[n][k], At[m][k], acc[ai][bj][m][n], 0, 0, 0); __builtin_amdgcn_s_setprio(0); } while (0)
#define PG8_WAIT_V(n) asm volatile("s_waitcnt vmcnt(" #n ")" ::: "memory")
#define PG8_WAIT_L(n) asm volatile("s_waitcnt lgkmcnt(" #n ")" ::: "memory")
#define PG8_BAR __builtin_amdgcn_s_barrier()
#define PG8_SCHED __builtin_amdgcn_sched_barrier(0)
    Unit cur, nxt; int ui = 0;
    if (!S.next(0, cur)) return;
    f32x4 acc[2][2][4][2];
#pragma unroll
    for (int a = 0; a < 2; ++a)
#pragma unroll
        for (int b = 0; b < 2; ++b)
#pragma unroll
            for (int m = 0; m < 4; ++m)
#pragma unroll
                for (int n = 0; n < 2; ++n) acc[a][b][m][n] = (f32x4){0.f, 0.f, 0.f, 0.f};
    bf16x8 At[4][2], B0[2][2], B1[2][2];
    const char* cA = (const char*)g.A + (size_t)cur.pm * tstepA; const char* cB = (const char*)g.Bt + (size_t)cur.pn * tstepB;
    S.a_ready(cur);
    PG8_STAGE(PG8_SB(0, 0), cB, voffB); PG8_STAGE(PG8_SB(0, 1), cB + hstepB, voffB); PG8_STAGE(PG8_SA(0, 0), cA, voffA); PG8_STAGE(PG8_SA(0, 1), cA + hstepA, voffA);
    if (wr == 1) PG8_BAR;
    PG8_WAIT_V(2); PG8_BAR;
    PG8_STAGE(PG8_SB(1, 0), cB + kstep, voffB); PG8_STAGE(PG8_SA(1, 0), cA + kstep, voffA); PG8_STAGE(PG8_SB(1, 1), cB + hstepB + kstep, voffB);
    PG8_WAIT_V(6); PG8_BAR;
    for (;;) {
        const bool has_next = S.next(ui + 1, nxt);
        const char* nA = has_next ? (const char*)g.A + (size_t)nxt.pm * tstepA : cA; const char* nB = has_next ? (const char*)g.Bt + (size_t)nxt.pn * tstepB : cB;
        for (int t = 0; t < nt; t += 2) {
            const bool last = (t == nt - 2);
            const char* a1 = cA + (size_t)(t + 1) * kstep;
            const char* a2 = last ? nA : cA + (size_t)(t + 2) * kstep; const char* b2 = last ? nB : cB + (size_t)(t + 2) * kstep;
            const char* a3 = a2 + kstep; const char* b3 = b2 + kstep;
            if (last && has_next) S.a_ready(nxt);
            PG8_LDB(B0, 0, 0); PG8_LDB(B1, 0, 1); PG8_SCHED; PG8_LDA(At, 0, 0); PG8_STAGE(PG8_SA(1, 1), a1 + hstepA, voffA);
            PG8_WAIT_V(8); PG8_WAIT_L(0); PG8_BAR; PG8_MMA(0, 0, At, B0); PG8_MMA(0, 1, At, B1); PG8_BAR; PG8_SCHED;
            PG8_LDA(At, 0, 1); PG8_STAGE(PG8_SB(0, 0), b2, voffB); PG8_STAGE(PG8_SB(0, 1), b2 + hstepB, voffB); PG8_STAGE(PG8_SA(0, 0), a2, voffA);
            PG8_WAIT_V(8); PG8_WAIT_L(0); PG8_BAR; PG8_MMA(1, 0, At, B0); PG8_MMA(1, 1, At, B1); PG8_BAR; PG8_SCHED;
            PG8_LDB(B0, 1, 0); PG8_LDB(B1, 1, 1); PG8_SCHED; PG8_LDA(At, 1, 0); PG8_STAGE(PG8_SA(0, 1), a2 + hstepA, voffA);
            PG8_WAIT_V(8); PG8_WAIT_L(0); PG8_BAR; PG8_MMA(0, 0, At, B0); PG8_MMA(0, 1, At, B1); PG8_BAR; PG8_SCHED;
            PG8_LDA(At, 1, 1); PG8_STAGE(PG8_SB(1, 0), b3, voffB); PG8_STAGE(PG8_SB(1, 1), b3 + hstepB, voffB); PG8_STAGE(PG8_SA(1, 0), a3, voffA);
            PG8_WAIT_V(8); PG8_WAIT_L(0); PG8_BAR; PG8_MMA(1, 0, At, B0); PG8_MMA(1, 1, At, B1); PG8_BAR; PG8_SCHED;
        }
        if constexpr (ALIGN_EPI) { if (wr == 0) PG8_BAR; }
        E(acc, cur, wr, wc, fr, fq); S.done(cur);
        if (!has_next) break;
#pragma unroll
        for (int a = 0; a < 2; ++a)
#pragma unroll
            for (int b = 0; b < 2; ++b)
#pragma unroll
                for (int m = 0; m < 4; ++m)
#pragma unroll
                    for (int n = 0; n < 2; ++n) acc[a][b][m][n] = (f32x4){0.f, 0.f, 0.f, 0.f};
        cur = nxt; cA = nA; cB = nB; ++ui;
        if constexpr (ALIGN_EPI) { if (wr == 1) PG8_BAR; }
    }
    PG8_WAIT_V(0);
    if constexpr (!ALIGN_EPI) { if (wr == 0) PG8_BAR; }
    PG8_BAR;
#undef PG8_SA
#undef PG8_SB
#undef PG8_STAGE
#undef PG8_LDA
#undef PG8_LDB
#undef PG8_MMA
#undef PG8_WAIT_V
#undef PG8_WAIT_L
#undef PG8_BAR
#undef PG8_SCHED
}
}

constexpr int NWAVES = 8, NTHR = 512;
constexpr int BATCH = 8, SEQ = 2048, DM = 1024, DEPTH = 2, FF = 2752, M = BATCH * SEQ;
constexpr int FFP = 2816;
constexpr int NGU = 5632;
constexpr int PP = 3584;
constexpr int NIN = 3400;
constexpr int PA = 0, PMV = 1280, PBQ = 1296, PBC = 1680, PBIQ = 1808, PBIK = 2320, PBIW = 2384, PCQ = 2392, PCK = 2648, PCV = 2904, PCG = 3160, PUSED = 3416;
constexpr int AW = 384;
constexpr int TOPK = 256;

constexpr size_t MiB = 1u << 20;
constexpr size_t WS_CTL = 0, CTL_ZERO_BYTES = 1 * MiB;
constexpr size_t WS_PART = 1 * MiB;
constexpr size_t WS_TAB = 2 * MiB;
constexpr size_t WS_BON = 2 * MiB + 512 * 1024;
constexpr size_t WS_WUKT = 3 * MiB, WS_WUVT = 3 * MiB + 128 * 1024;
constexpr size_t WS_THR = 3 * MiB + 256 * 1024, WS_SCUT = 3 * MiB + 320 * 1024;
constexpr size_t WS_WGU1 = 4 * MiB, WS_WD1 = 15 * MiB, WS_WIN = 21 * MiB, WS_WOUT = 28 * MiB, WS_WGU2 = 30 * MiB, WS_WD2 = 41 * MiB;
constexpr size_t WS_XB = 47 * MiB;
constexpr size_t WS_VF = 79 * MiB;
constexpr size_t WS_P = 91 * MiB;
constexpr size_t WS_H = WS_P;
constexpr size_t WS_R = 203 * MiB, WS_D = 215 * MiB, WS_K2 = 227 * MiB, WS_KK = 239 * MiB, WS_C = 251 * MiB;
constexpr size_t WS_BP = WS_XB, WS_G = WS_XB + 12 * MiB, WS_KV = WS_XB + 24 * MiB;
constexpr size_t WS_END = 256 * MiB;
static_assert(WS_WD2 + (size_t)1024 * FFP * 2 <= WS_XB && WS_P + (size_t)M * PP * 2 <= WS_R && WS_C + (size_t)M * 128 * 2 <= WS_END, "ws map");
constexpr int CW_BAR = 4096;
constexpr int CW_QUEUE = 16384;

constexpr int RING_BYTES = 131072;
constexpr int LDSCTL_OFF = RING_BYTES, MISC_OFF = LDSCTL_OFF + 320;
constexpr int LDS_BYTES = 147456;

#define GAS __attribute__((address_space(1)))
#define LAS __attribute__((address_space(3)))
typedef unsigned short bf16;
typedef unsigned v4u __attribute__((ext_vector_type(4)));
typedef float f32x4 __attribute__((ext_vector_type(4)));
typedef GAS unsigned gu32;
#define RLX_AGENT __ATOMIC_RELAXED, __HIP_MEMORY_SCOPE_AGENT
#define LDS_WAIT() asm volatile("s_waitcnt lgkmcnt(0)" ::: "memory")
__device__ __forceinline__ unsigned f2bf(float f) { unsigned u = __builtin_bit_cast(unsigned, f); return (u + 0x7fffu + ((u >> 16) & 1u)) >> 16; }
__device__ __forceinline__ unsigned pk2(float lo, float hi) { return f2bf(lo) | (f2bf(hi) << 16); }
__device__ __forceinline__ float bf2f(unsigned short v) { return __uint_as_float((unsigned)v << 16); }
__device__ __forceinline__ float bflo(unsigned w) { return __uint_as_float(w << 16); }
__device__ __forceinline__ float bfhi(unsigned w) { return __uint_as_float(w & 0xffff0000u); }
__device__ __forceinline__ void unpack8(const v4u w, float (&f)[8]) { f[0] = bflo(w.x); f[1] = bfhi(w.x); f[2] = bflo(w.y); f[3] = bfhi(w.y); f[4] = bflo(w.z); f[5] = bfhi(w.z); f[6] = bflo(w.w); f[7] = bfhi(w.w); }
__device__ __forceinline__ float sigmoid_f(float x) { return 1.0f / (1.0f + __expf(-x)); }
__device__ __forceinline__ float wave_sum(float v) {
#pragma unroll
    for (int o = 1; o < 64; o <<= 1) v += __shfl_xor(v, o);
    return v;
}

#define XB_TMO      128
#define XB_XCNT(j)  (256  + 64 * (j))
#define XB_XSUB(j)  (1280 + 64 * (j))
#define XB_XGEN(j)  (2304 + 64 * (j))
#define XB_TOP      3328
#define XB_TOPGEN   3392
#define XCD_BAR_WORDS 3456
#define XB_SPIN_CAP (1u << 22)

__device__ __forceinline__ unsigned xb_ld(unsigned* p)              { return __hip_atomic_load(p, __ATOMIC_RELAXED, __HIP_MEMORY_SCOPE_AGENT); }
__device__ __forceinline__ unsigned xb_add(unsigned* p, unsigned v) { return __hip_atomic_fetch_add(p, v, __ATOMIC_RELAXED, __HIP_MEMORY_SCOPE_AGENT); }
__device__ __forceinline__ unsigned xb_xcc_id() { return (unsigned)__builtin_amdgcn_s_getreg((3 << 11) | 20) & 0xFu; }
#define XB_SPIN(cond, bar) do { unsigned _sp = 0; while (cond) { __builtin_amdgcn_s_sleep(1); \
    if ((++_sp & 255u) == 0u) { if (xb_ld(&(bar)[XB_TMO])) break; if (_sp > XB_SPIN_CAP) { atomicAdd(&(bar)[XB_TMO], 1u); break; } } } } while (0)

struct XcdBarrier { unsigned* bar; unsigned x; volatile LAS unsigned* st; };

__device__ __forceinline__ XcdBarrier xcd_barrier_post(unsigned* bar, volatile LAS unsigned* st) {
    XcdBarrier b; b.bar = bar; b.x = xb_xcc_id(); b.st = st;
    if (threadIdx.x == 0) (void)xb_add(&bar[XB_XCNT(b.x)], 1u);
    return b;
}
__device__ __forceinline__ void xcd_barrier_complete(unsigned* bar, unsigned x, unsigned& nloc, unsigned& nx) {
    const unsigned G = gridDim.x * gridDim.y * gridDim.z;
    unsigned sum, cnt, mine, sp = 0u;
    for (;;) {
        sum = 0u; cnt = 0u; mine = 0u;
#pragma unroll
        for (unsigned j = 0; j < 16; ++j) { const unsigned c = xb_ld(&bar[XB_XCNT(j)]); sum += c; cnt += (c > 0u) ? 1u : 0u; mine = (j == x) ? c : mine; }
        if (sum == G) break;
        __builtin_amdgcn_s_sleep(1);
        if ((++sp & 255u) == 0u) { if (xb_ld(&bar[XB_TMO])) break; if (sp > XB_SPIN_CAP) { atomicAdd(&bar[XB_TMO], 1u); break; } }
    }
    nloc = mine > 0u ? mine : 1u; nx = cnt > 0u ? cnt : 1u;
}
__device__ __forceinline__ void xcd_barrier(const XcdBarrier& b) {
    asm volatile("s_waitcnt vmcnt(0)" ::: "memory");
    __syncthreads();
    if (threadIdx.x == 0) {
        unsigned* bar = b.bar;
        __builtin_amdgcn_s_waitcnt(0);
        unsigned nloc = b.st[0], nx = b.st[1];
        if (nloc == 0u) { xcd_barrier_complete(bar, b.x, nloc, nx); b.st[0] = nloc; b.st[1] = nx; }
        const unsigned old = xb_add(&bar[XB_XSUB(b.x)], 1u);
        const unsigned gen = old / nloc;
        if (old + 1u == (gen + 1u) * nloc) {
            __builtin_amdgcn_fence(__ATOMIC_RELEASE, "agent");
            asm volatile("s_waitcnt vmcnt(0)" ::: "memory");
            const unsigned og = xb_add(&bar[XB_TOP], 1u);
            const unsigned tg = og / nx;
            if (og + 1u == (tg + 1u) * nx) xb_add(&bar[XB_TOPGEN], 1u);
            else XB_SPIN(xb_ld(&bar[XB_TOPGEN]) == tg, bar);
            __builtin_amdgcn_fence(__ATOMIC_ACQUIRE, "agent");
            xb_add(&bar[XB_XGEN(b.x)], 1u);
            asm volatile("s_waitcnt vmcnt(0)" ::: "memory");
        } else {
            XB_SPIN(xb_ld(&bar[XB_XGEN(b.x)]) == gen, bar);
            __builtin_amdgcn_fence(__ATOMIC_ACQUIRE, "agent");
            asm volatile("s_waitcnt vmcnt(0)" ::: "memory");
        }
    }
    __syncthreads();
}

struct Args { const float* in[31]; float* out; unsigned char* ws; int ph_lo, ph_hi; };
struct Frame {
    LAS unsigned char* lds;
    int tid, lane, wave, vcu, G;
    const float* const* in; float* out; unsigned char* ws;
};
enum { I_X = 0, I_F1N, I_F1G, I_F1U, I_F1D, I_MIXN, I_WIN, I_WOUT, I_MU, I_W0, I_W2, I_A0, I_A2, I_G2, I_KK, I_KA, I_RK, I_LNW, I_LNB, I_VRW, I_VRMU, I_V0, I_V2, I_KVN, I_WUK, I_WUV, I_F2N, I_F2G, I_F2U, I_F2D, I_FN };

__device__ __forceinline__ void conv_item(const Frame& F, int l, int kind, int item, LAS float* scr) {
    const int lane = F.lane;
    int Kd, nkb; bf16* WT;
    if (kind == 0 || kind == 4) { Kd = 1024; WT = (bf16*)(F.ws + (kind == 0 ? WS_WGU1 : WS_WGU2)); }
    else if (kind == 1 || kind == 5) { Kd = FFP; WT = (bf16*)(F.ws + (kind == 1 ? WS_WD1 : WS_WD2)); }
    else if (kind == 2) { Kd = 1024; WT = (bf16*)(F.ws + WS_WIN); }
    else { Kd = 1024; WT = (bf16*)(F.ws + WS_WOUT); }
    nkb = Kd / 64;
    const int rb = item / nkb, kb = item % nkb, r0 = rb * 32, k0 = kb * 64;
    const int rr = r0 + (lane & 31);
    const float* src = nullptr; int ns = 0, col = 0, ksrc = 1024; const float* gain = nullptr; float scale = 1.0f;
    if (kind == 0 || kind == 4) {
        const int tile = rr >> 8, w = rr & 255, hid = tile * 128 + (w & 127);
        if (hid < FF) { const float* s1 = (w >> 7) ? F.in[I_F1U] : F.in[I_F1G]; const float* s2 = (w >> 7) ? F.in[I_F2U] : F.in[I_F2G]; src = ((kind == 0) ? s1 : s2) + (size_t)l * 1024 * FF; ns = FF; col = hid; }
        gain = ((kind == 0) ? F.in[I_F1N] : F.in[I_F2N]) + l * 1024;
    } else if (kind == 1 || kind == 5) {
        src = ((kind == 1) ? F.in[I_F1D] : F.in[I_F2D]) + (size_t)l * FF * 1024; ns = 1024; col = rr; ksrc = FF; scale = 0.5f;
    } else if (kind == 2) {
        gain = F.in[I_MIXN] + l * 1024;
        if (rr < 1280) { src = F.in[I_WIN] + (size_t)l * 1024 * NIN; ns = NIN; col = rr; }
        else if (rr < 1296) { if (l > 0) { src = F.in[I_VRW] + (size_t)(l - 1) * 1024 * 16; ns = 16; col = rr - 1280; } }
        else if (rr < PUSED) { src = F.in[I_WIN] + (size_t)l * 1024 * NIN; ns = NIN; col = rr - 16; }
    } else { src = F.in[I_WOUT] + (size_t)l * 1024 * 1024; ns = 1024; col = rr; }
#pragma unroll 8
    for (int i = 0; i < 32; ++i) { const int kk = 2 * i + (lane >> 5), k = k0 + kk; float v = 0.f;
        if (src != nullptr && k < ksrc) { v = src[(size_t)k * ns + col] * scale; if (gain) v *= gain[k]; }
        scr[kk * 33 + (lane & 31)] = v; }
    LDS_WAIT(); asm volatile("" ::: "memory");
    const int c = lane & 7;
#pragma unroll
    for (int j = 0; j < 4; ++j) { const int n = (lane >> 3) + 8 * j; const LAS float* s = scr + (8 * c) * 33 + n;
        v4u o; o.x = pk2(s[0 * 33], s[1 * 33]); o.y = pk2(s[2 * 33], s[3 * 33]); o.z = pk2(s[4 * 33], s[5 * 33]); o.w = pk2(s[6 * 33], s[7 * 33]);
        *(GAS v4u*)(WT + (size_t)(r0 + n) * Kd + k0 + 8 * c) = o; }
    LDS_WAIT(); asm volatile("" ::: "memory");
}
__host__ __device__ constexpr int conv_items(int kind) { return (kind == 0 || kind == 4) ? (NGU / 32) * 16 : (kind == 1 || kind == 5) ? 32 * (FFP / 64) : (kind == 2) ? (PP / 32) * 16 : 32 * 16; }
__device__ __forceinline__ void conv_weights(const Frame& F, int l, int k_lo, int k_hi) {
    LAS float* scr = (LAS float*)(F.lds + F.wave * 16384);
    const int gw = F.vcu * NWAVES + F.wave, NGW = F.G * NWAVES;
    for (int kind = k_lo; kind < k_hi; ++kind) { const int ni = conv_items(kind);
        for (int it = gw; it < ni; it += NGW) conv_item(F, l, kind, it, scr); }
}

__device__ __forceinline__ void p0_x(const Frame& F) {
    const int gw = F.vcu * NWAVES + F.wave, NGW = F.G * NWAVES;
    const float* x = F.in[I_X]; bf16* xb = (bf16*)(F.ws + WS_XB); float* part = (float*)(F.ws + WS_PART);
    for (int m = gw; m < M; m += NGW) {
        const GAS f32x4* xr = (const GAS f32x4*)(x + (size_t)m * DM) + F.lane; float s = 0.f;
        GAS unsigned long long* o8 = (GAS unsigned long long*)(xb + (size_t)m * DM) + F.lane;
#pragma unroll
        for (int j = 0; j < 4; ++j) { const f32x4 v = xr[64 * j]; s += (v.x * v.x + v.y * v.y) + (v.z * v.z + v.w * v.w);
            o8[64 * j] = (unsigned long long)pk2(v.x, v.y) | ((unsigned long long)pk2(v.z, v.w) << 32); }
        s = wave_sum(s);
        if (F.lane < 16) part[(size_t)m * 16 + F.lane] = (F.lane == 0) ? s : 0.f;
    }
}
__device__ __forceinline__ void p0_table(const Frame& F) {
    float* tab = (float*)(F.ws + WS_TAB);
    for (int i = F.vcu * NTHR + F.tid; i < SEQ * 32; i += F.G * NTHR) { const int t = i >> 5, f = i & 31; const float th = exp2f(-(float)f * (13.287712379549449f / 31.0f)); const float ang = (float)t * th; float s, c; sincosf(ang, &s, &c); tab[2 * i] = c; tab[2 * i + 1] = s; }
}

constexpr int PT = 16;
__device__ __forceinline__ void prep_tokens_unit(const Frame& F, int l, int unit) {
    LAS float* xs = (LAS float*)F.lds; LAS float* rn = xs + PT * 1296; LAS float* prod = rn + PT * 8;
    const int tid = F.tid, tok0 = unit * PT;
    const bf16* P = (const bf16*)(F.ws + WS_P);
    const float* mu = F.in[I_MU] + l * 1280; const float* vmu = F.in[I_VRMU] + (l > 0 ? (l - 1) * 16 : 0);
    for (int idx = tid; idx < PT * 162; idx += NTHR) { const int t = idx / 162, ch = idx - t * 162, tok = tok0 + t, c0 = ch * 8;
        const v4u cw = *(const GAS v4u*)(P + (size_t)tok * PP + c0); float cur[8], prv[8]; unpack8(cw, cur);
        if ((tok & (SEQ - 1)) != 0) { const v4u pw = *(const GAS v4u*)(P + (size_t)(tok - 1) * PP + c0); unpack8(pw, prv); }
        else {
#pragma unroll
            for (int j = 0; j < 8; ++j) prv[j] = 0.f; }
#pragma unroll
        for (int j = 0; j < 8; ++j) { const int c = c0 + j; const float m = (c < 1280) ? mu[c] : ((l > 0) ? vmu[c - 1280] : 0.f);
            float v = cur[j] + (prv[j] - cur[j]) * m;
            if (c >= 1152 && c < 1184) v = tanhf(v); else if (c >= 1216 && c < 1280) v = sigmoid_f(v);
            xs[t * 1296 + c] = v; } }
    __syncthreads();
    if (tid < PT * 6) { const int t = tid / 6, h = tid - t * 6; const float* kkw = F.in[I_KK] + l * AW + h * 64; float ss = 0.f;
        for (int j = 0; j < 64; ++j) { const float v = xs[t * 1296 + 384 + h * 64 + j] * kkw[j]; ss += v * v; }
        rn[t * 8 + h] = 1.0f / fmaxf(sqrtf(ss), 1e-12f); }
    __syncthreads();
    {
        const int cg = tid & 127, tg = tid >> 7;
        const float* w2 = F.in[I_W2] + (size_t)l * 32 * AW; const float* a2 = F.in[I_A2] + (size_t)l * 32 * AW; const float* g2 = F.in[I_G2] + (size_t)l * 64 * AW;
        const float* v2 = F.in[I_V2] + (size_t)(l > 0 ? l - 1 : 0) * 16 * AW;
        bf16* R = (bf16*)(F.ws + WS_R); bf16* Dd = (bf16*)(F.ws + WS_D); bf16* K2 = (bf16*)(F.ws + WS_K2); bf16* KK = (bf16*)(F.ws + WS_KK); bf16* BP = (bf16*)(F.ws + WS_BP); bf16* Gg = (bf16*)(F.ws + WS_G); bf16* VF = (bf16*)(F.ws + WS_VF);
        for (int ci = 0; ci < 3; ++ci) { const int j = cg + 128 * ci, h = j >> 6;
            float wacc[4], aacc[4], gacc[4], macc[4];
            const float w0 = F.in[I_W0][l * AW + j], a0 = F.in[I_A0][l * AW + j], v0 = (l > 0) ? F.in[I_V0][(l - 1) * AW + j] : 0.f;
#pragma unroll
            for (int tt = 0; tt < 4; ++tt) { wacc[tt] = w0; aacc[tt] = a0; gacc[tt] = 0.f; macc[tt] = v0; }
            for (int i = 0; i < 32; ++i) { const float ww = w2[i * AW + j], aa = a2[i * AW + j];
#pragma unroll
                for (int tt = 0; tt < 4; ++tt) { const int t = 4 * tg + tt; wacc[tt] += xs[t * 1296 + 1152 + i] * ww; aacc[tt] += xs[t * 1296 + 1184 + i] * aa; } }
            for (int i = 0; i < 64; ++i) { const float gg = g2[i * AW + j];
#pragma unroll
                for (int tt = 0; tt < 4; ++tt) { const int t = 4 * tg + tt; gacc[tt] += xs[t * 1296 + 1216 + i] * gg; } }
            if (l > 0) for (int i = 0; i < 16; ++i) { const float vv = v2[i * AW + j];
#pragma unroll
                for (int tt = 0; tt < 4; ++tt) { const int t = 4 * tg + tt; macc[tt] += xs[t * 1296 + 1280 + i] * vv; } }
            const float kkw = F.in[I_KK][l * AW + j], kaw = F.in[I_KA][l * AW + j], rkw = F.in[I_RK][l * AW + j];
#pragma unroll
            for (int tt = 0; tt < 4; ++tt) { const int t = 4 * tg + tt, tok = tok0 + t; const size_t o = (size_t)tok * AW + j;
                const float r = xs[t * 1296 + j], k = xs[t * 1296 + 384 + j]; float v = xs[t * 1296 + 768 + j];
                const float z = -wacc[tt];
                const float sp = fmaxf(z, 0.f) + log1pf(__expf(-fabsf(z)));
                const float rate = __expf(-sp - 0.5f);
                const float d = -expm1f(-rate);
                const float a = sigmoid_f(aacc[tt]);
                if (l > 0) { const float vf = bf2f(VF[o]); v = v + (vf - v) * sigmoid_f(macc[tt]); }
                VF[o] = (bf16)f2bf(v);
                const float kk = k * kkw * rn[t * 8 + h], k2 = k * (1.0f + (a - 1.0f) * kaw);
                R[o] = (bf16)f2bf(r); Dd[o] = (bf16)f2bf(d); K2[o] = (bf16)f2bf(k2); KK[o] = (bf16)f2bf(kk); BP[o] = (bf16)f2bf(kk * a); Gg[o] = (bf16)f2bf(gacc[tt]);
                prod[t * AW + j] = r * k2 * rkw; }
        }
    }
    __syncthreads();
    if (tid < PT * 6) { const int t = tid / 6, h = tid - t * 6; float s = 0.f; for (int j = 0; j < 64; ++j) s += prod[t * AW + h * 64 + j];
        ((float*)(F.ws + WS_BON))[(size_t)(tok0 + t) * 6 + h] = s; }
    {
        const float* kvn = F.in[I_KVN] + l * 128; bf16* C = (bf16*)(F.ws + WS_C);
#pragma unroll
        for (int q = 0; q < 2; ++q) { const int tok = tok0 + 2 * F.wave + q; const unsigned w = *(const GAS unsigned*)(P + (size_t)tok * PP + PBC + 2 * F.lane);
            const float c0 = bflo(w), c1 = bfhi(w); const float ss = wave_sum(c0 * c0 + c1 * c1); const float rs = 1.0f / sqrtf(ss * (1.0f / 128.0f) + 1e-6f);
            *(GAS unsigned*)(C + (size_t)tok * 128 + 2 * F.lane) = pk2(c0 * rs * kvn[2 * F.lane], c1 * rs * kvn[2 * F.lane + 1]); }
    }
    __syncthreads();
}

__device__ __forceinline__ void ret_kv_unit(const Frame& F, int unit) {
    LAS float* kr = (LAS float*)F.lds; LAS float* vv = kr + 128 * 64;
    const int tid = F.tid, c = unit & 15, h = (unit >> 4) & 3, b = unit >> 6, tok0 = b * SEQ + c * 128;
    const bf16* P = (const bf16*)(F.ws + WS_P); const float* tab = (const float*)(F.ws + WS_TAB);
    const float lg2 = log2f(1.0f - exp2f(-5.0f - (float)h));
    for (int idx = tid; idx < 128 * 32; idx += NTHR) { const int m = idx >> 5, i = idx & 31; const size_t ro = (size_t)(tok0 + m) * PP;
        const float k1 = bf2f(P[ro + PCK + h * 64 + i]), k2 = bf2f(P[ro + PCK + h * 64 + 32 + i]);
        const float cs = tab[((c * 128 + m) * 32 + i) * 2], sn = tab[((c * 128 + m) * 32 + i) * 2 + 1];
        const float sc = 0.125f * exp2f((float)(127 - m) * lg2);
        kr[m * 64 + i] = (k1 * cs - k2 * sn) * sc; kr[m * 64 + 32 + i] = (k1 * sn + k2 * cs) * sc;
        vv[m * 64 + i] = bf2f(P[ro + PCV + h * 64 + i]); vv[m * 64 + 32 + i] = bf2f(P[ro + PCV + h * 64 + 32 + i]); }
    __syncthreads();
    const int d = tid >> 3, e0 = (tid & 7) * 8; float acc[8];
#pragma unroll
    for (int e = 0; e < 8; ++e) acc[e] = 0.f;
    for (int m = 0; m < 128; ++m) { const float kd = kr[m * 64 + d];
#pragma unroll
        for (int e = 0; e < 8; ++e) acc[e] += kd * vv[m * 64 + e0 + e]; }
    float* KV = (float*)(F.ws + WS_KV) + (size_t)unit * 4096 + d * 64 + e0;
#pragma unroll
    for (int e = 0; e < 8; ++e) KV[e] = acc[e];
    __syncthreads();
}

__device__ __forceinline__ void ret_out_unit(const Frame& F, int unit) {
    LAS float* qr = (LAS float*)F.lds; LAS float* kr = qr + 8192; LAS float* vv = kr + 8192; LAS float* st = vv + 8192;
    const int tid = F.tid, c = unit & 15, h = (unit >> 4) & 3, b = unit >> 6, tok0 = b * SEQ + c * 128;
    bf16* P = (bf16*)(F.ws + WS_P); const float* tab = (const float*)(F.ws + WS_TAB);
    const float lg2 = log2f(1.0f - exp2f(-5.0f - (float)h));
    for (int idx = tid; idx < 128 * 32; idx += NTHR) { const int m = idx >> 5, i = idx & 31; const size_t ro = (size_t)(tok0 + m) * PP;
        const float cs = tab[((c * 128 + m) * 32 + i) * 2], sn = tab[((c * 128 + m) * 32 + i) * 2 + 1];
        const float q1 = bf2f(P[ro + PCQ + h * 64 + i]), q2 = bf2f(P[ro + PCQ + h * 64 + 32 + i]);
        const float k1 = bf2f(P[ro + PCK + h * 64 + i]), k2 = bf2f(P[ro + PCK + h * 64 + 32 + i]);
        qr[m * 64 + i] = q1 * cs - q2 * sn; qr[m * 64 + 32 + i] = q1 * sn + q2 * cs;
        kr[m * 64 + i] = (k1 * cs - k2 * sn) * 0.125f; kr[m * 64 + 32 + i] = (k1 * sn + k2 * cs) * 0.125f;
        vv[m * 64 + i] = bf2f(P[ro + PCV + h * 64 + i]); vv[m * 64 + 32 + i] = bf2f(P[ro + PCV + h * 64 + 32 + i]); }
    {
        const float* KV = (const float*)(F.ws + WS_KV) + (size_t)(unit - c) * 4096; float s[8];
#pragma unroll
        for (int e = 0; e < 8; ++e) s[e] = 0.f;
        const float cd = exp2f(128.0f * lg2);
        for (int j = 0; j < c; ++j) {
#pragma unroll
            for (int e = 0; e < 8; ++e) s[e] = s[e] * cd + KV[(size_t)j * 4096 + tid * 8 + e]; }
#pragma unroll
        for (int e = 0; e < 8; ++e) st[tid * 8 + e] = s[e];
    }
    __syncthreads();
    const int n = tid >> 2, e0 = (tid & 3) * 16; float acc[16], cr[16];
#pragma unroll
    for (int e = 0; e < 16; ++e) { acc[e] = 0.f; cr[e] = 0.f; }
    for (int m = 0; m <= n; ++m) { float s = 0.f;
#pragma unroll 16
        for (int d = 0; d < 64; ++d) s += qr[n * 64 + d] * kr[m * 64 + d];
        s *= exp2f((float)(n - m) * lg2);
#pragma unroll
        for (int e = 0; e < 16; ++e) acc[e] += s * vv[m * 64 + e0 + e]; }
    for (int d = 0; d < 64; ++d) { const float qd = qr[n * 64 + d];
#pragma unroll
        for (int e = 0; e < 16; ++e) cr[e] += qd * st[d * 64 + e0 + e]; }
    const float qdec = exp2f((float)(n + 1) * lg2); float ss = 0.f;
#pragma unroll
    for (int e = 0; e < 16; ++e) { acc[e] += cr[e] * qdec; ss += acc[e] * acc[e]; }
    ss += __shfl_xor(ss, 1); ss += __shfl_xor(ss, 2);
    const float rs = 1.0f / sqrtf(ss * (1.0f / 64.0f) + 1e-6f);
    const size_t ro = (size_t)(tok0 + n) * PP;
    float gv[16];
#pragma unroll
    for (int e = 0; e < 16; ++e) gv[e] = bf2f(P[ro + PCG + h * 64 + e0 + e]);
#pragma unroll
    for (int e = 0; e < 16; e += 2) { const float o0 = gv[e] * sigmoid_f(gv[e]) * acc[e] * rs, o1 = gv[e + 1] * sigmoid_f(gv[e + 1]) * acc[e + 1] * rs;
        *(GAS unsigned*)(P + ro + 768 + h * 64 + e0 + e) = pk2(o0, o1); }
    __syncthreads();
}

__device__ __forceinline__ float dpp_add8(float x) {
    x += __builtin_bit_cast(float, __builtin_amdgcn_mov_dpp(__builtin_bit_cast(int, x), 0xB1, 0xF, 0xF, true));
    x += __builtin_bit_cast(float, __builtin_amdgcn_mov_dpp(__builtin_bit_cast(int, x), 0x4E, 0xF, 0xF, true));
    x += __builtin_bit_cast(float, __builtin_amdgcn_mov_dpp(__builtin_bit_cast(int, x), 0x141, 0xF, 0xF, true));
    return x;
}
constexpr int CH = 32;
__device__ __forceinline__ void rwkv_scan_unit(const Frame& F, int l, int unit) {
    const int tid = F.tid, lane = F.lane, wave = F.wave, b = unit / 6, h = unit - b * 6, tokb = b * SEQ;
    LAS float* stg = (LAS float*)F.lds; LAS float* ybuf = stg + 2 * 6 * CH * 64;
    const bool hi8 = (tid >> 8) != 0;
    const bf16* src0 = (const bf16*)(F.ws + (hi8 ? WS_D : WS_R)); const bf16* src1 = (const bf16*)(F.ws + (hi8 ? WS_KK : WS_K2)); const bf16* src2 = (const bf16*)(F.ws + (hi8 ? WS_VF : WS_BP));
    const bf16* Gg = (const bf16*)(F.ws + WS_G); const float* BON = (const float*)(F.ws + WS_BON); bf16* P = (bf16*)(F.ws + WS_P);
    const int row = 8 * wave + (lane >> 3), ks = lane & 7;
    float S[8];
#pragma unroll
    for (int j = 0; j < 8; ++j) S[j] = 0.f;
    v4u sreg[3];
#define RW_LOAD(cc) do { const int t_ = (tid & 255) >> 3, c8_ = tid & 7; const size_t o_ = (size_t)(tokb + (cc) * CH + t_) * AW + h * 64 + c8_ * 8; \
        sreg[0] = *(const GAS v4u*)(src0 + o_); sreg[1] = *(const GAS v4u*)(src1 + o_); sreg[2] = *(const GAS v4u*)(src2 + o_); } while (0)
#define RW_STORE(bufi) do { _Pragma("unroll") for (int i = 0; i < 3; ++i) { const int q = tid + 512 * i, ar = q >> 8, t = (q & 255) >> 3, c8 = q & 7; float f[8]; unpack8(sreg[i], f); \
        LAS f32x4* dst = (LAS f32x4*)(stg + ((bufi) * 6 + ar) * CH * 64 + t * 64 + c8 * 8); dst[0] = (f32x4){f[0], f[1], f[2], f[3]}; dst[1] = (f32x4){f[4], f[5], f[6], f[7]}; } } while (0)
    RW_LOAD(0); RW_STORE(0);
    __syncthreads();
    const float lnw = F.in[I_LNW][l * AW + h * 64 + (tid & 15) * 4], lnw1 = F.in[I_LNW][l * AW + h * 64 + (tid & 15) * 4 + 1], lnw2 = F.in[I_LNW][l * AW + h * 64 + (tid & 15) * 4 + 2], lnw3 = F.in[I_LNW][l * AW + h * 64 + (tid & 15) * 4 + 3];
    const float lnb = F.in[I_LNB][l * AW + h * 64 + (tid & 15) * 4], lnb1 = F.in[I_LNB][l * AW + h * 64 + (tid & 15) * 4 + 1], lnb2 = F.in[I_LNB][l * AW + h * 64 + (tid & 15) * 4 + 2], lnb3 = F.in[I_LNB][l * AW + h * 64 + (tid & 15) * 4 + 3];
    for (int cc = 0; cc < SEQ / CH; ++cc) {
        const int bufi = cc & 1;
        if (cc + 1 < SEQ / CH) RW_LOAD(cc + 1);
        const LAS float* base = stg + bufi * 6 * CH * 64;
#pragma unroll 4
        for (int s = 0; s < CH; ++s) {
            const LAS f32x4* pr = (const LAS f32x4*)(base + 0 * CH * 64 + s * 64 + ks * 8);
            const LAS f32x4* pd = (const LAS f32x4*)(base + 1 * CH * 64 + s * 64 + ks * 8);
            const LAS f32x4* pk = (const LAS f32x4*)(base + 2 * CH * 64 + s * 64 + ks * 8);
            const LAS f32x4* pq = (const LAS f32x4*)(base + 3 * CH * 64 + s * 64 + ks * 8);
            const LAS f32x4* pb = (const LAS f32x4*)(base + 4 * CH * 64 + s * 64 + ks * 8);
            const f32x4 r0 = pr[0], r1 = pr[1], d0 = pd[0], d1 = pd[1], k0 = pk[0], k1 = pk[1], q0 = pq[0], q1 = pq[1], b0 = pb[0], b1 = pb[1];
            const float v = base[5 * CH * 64 + s * 64 + row];
            float p = (S[0] * q0[0] + S[1] * q0[1]) + (S[2] * q0[2] + S[3] * q0[3]) + (S[4] * q1[0] + S[5] * q1[1]) + (S[6] * q1[2] + S[7] * q1[3]);
            p = dpp_add8(p);
#pragma unroll
            for (int j = 0; j < 4; ++j) { S[j] = fmaf(-d0[j], S[j], S[j]); S[j] = fmaf(-p, b0[j], S[j]); S[j] = fmaf(v, k0[j], S[j]);
                S[4 + j] = fmaf(-d1[j], S[4 + j], S[4 + j]); S[4 + j] = fmaf(-p, b1[j], S[4 + j]); S[4 + j] = fmaf(v, k1[j], S[4 + j]); }
            float y = (S[0] * r0[0] + S[1] * r0[1]) + (S[2] * r0[2] + S[3] * r0[3]) + (S[4] * r1[0] + S[5] * r1[1]) + (S[6] * r1[2] + S[7] * r1[3]);
            y = dpp_add8(y);
            if (ks == 0) ybuf[s * 64 + row] = y;
        }
        __syncthreads();
        {
            const int s = tid >> 4, r4 = (tid & 15) * 4, tok = tokb + cc * CH + s;
            const f32x4 yv = *(const LAS f32x4*)(ybuf + s * 64 + r4);
            float sm = (yv[0] + yv[1]) + (yv[2] + yv[3]);
            sm += __shfl_xor(sm, 1); sm += __shfl_xor(sm, 2); sm += __shfl_xor(sm, 4); sm += __shfl_xor(sm, 8);
            const float mean = sm * (1.0f / 64.0f); const f32x4 dv = yv - mean;
            float vs = (dv[0] * dv[0] + dv[1] * dv[1]) + (dv[2] * dv[2] + dv[3] * dv[3]);
            vs += __shfl_xor(vs, 1); vs += __shfl_xor(vs, 2); vs += __shfl_xor(vs, 4); vs += __shfl_xor(vs, 8);
            const float rs = 1.0f / sqrtf(vs * (1.0f / 64.0f) + 64e-5f);
            const f32x4 vv = *(const LAS f32x4*)(base + 5 * CH * 64 + s * 64 + r4);
            const float bon = BON[(size_t)tok * 6 + h];
            const unsigned long long gw = *(const GAS unsigned long long*)(Gg + (size_t)tok * AW + h * 64 + r4);
            const float g0 = bflo((unsigned)gw), g1 = bfhi((unsigned)gw), g2 = bflo((unsigned)(gw >> 32)), g3 = bfhi((unsigned)(gw >> 32));
            const float o0 = (dv[0] * rs * lnw + lnb + bon * vv[0]) * g0, o1 = (dv[1] * rs * lnw1 + lnb1 + bon * vv[1]) * g1;
            const float o2 = (dv[2] * rs * lnw2 + lnb2 + bon * vv[2]) * g2, o3 = (dv[3] * rs * lnw3 + lnb3 + bon * vv[3]) * g3;
            *(GAS unsigned long long*)(P + (size_t)tok * PP + h * 64 + r4) = (unsigned long long)pk2(o0, o1) | ((unsigned long long)pk2(o2, o3) << 32);
        }
        if (cc + 1 < SEQ / CH) RW_STORE(bufi ^ 1);
        __syncthreads();
    }
#undef RW_LOAD
#undef RW_STORE
}

typedef short bf16x8_t __attribute__((ext_vector_type(8)));
typedef short s16x4_t __attribute__((ext_vector_type(4)));
typedef float f32x16_t __attribute__((ext_vector_type(16)));
__device__ __forceinline__ unsigned fkey(float f) { const unsigned u = __float_as_uint(f); return (u & 0x80000000u) ? ~u : (u | 0x80000000u); }
__device__ __forceinline__ int crow32(int r, int hi) { return (r & 3) + 8 * (r >> 2) + 4 * hi; }
__device__ __forceinline__ unsigned off_a(unsigned row, unsigned ch) { return 2048u * (row >> 3) + 512u * (ch >> 2) + 64u * (row & 7) + 16u * ((ch & 3) ^ ((row >> 2) & 3)); }

__device__ __forceinline__ void idx_scores(const bf16x8_t (&Af)[2], const bf16x8_t (&Bf)[8][2], const float (&iwf)[8], float (&sc)[4]) {
    sc[0] = sc[1] = sc[2] = sc[3] = 0.f;
#pragma unroll
    for (int h = 0; h < 8; ++h) { f32x4 a = (f32x4){0.f, 0.f, 0.f, 0.f};
        a = __builtin_amdgcn_mfma_f32_16x16x32_bf16(Af[0], Bf[h][0], a, 0, 0, 0);
        a = __builtin_amdgcn_mfma_f32_16x16x32_bf16(Af[1], Bf[h][1], a, 0, 0, 0);
#pragma unroll
        for (int r = 0; r < 4; ++r) sc[r] = fmaf(iwf[h], fmaxf(a[r], 0.f), sc[r]); }
}
__device__ __forceinline__ void idx_load_q(const bf16* P, int tokq, bf16x8_t (&Bf)[8][2], float (&iwf)[8], int fq) {
    const bf16* row = P + (size_t)tokq * PP;
#pragma unroll
    for (int h = 0; h < 8; ++h)
#pragma unroll
        for (int ks = 0; ks < 2; ++ks) Bf[h][ks] = *(const GAS bf16x8_t*)(row + PBIQ + h * 64 + ks * 32 + fq * 8);
    const v4u w = *(const GAS v4u*)(row + PBIW); float f[8]; unpack8(w, f);
#pragma unroll
    for (int h = 0; h < 8; ++h) iwf[h] = f[h] * (0.35355339059327373f * 0.125f);
}

__device__ __forceinline__ void dsa_thr_unit(const Frame& F, int unit) {
    LAS unsigned* sk = (LAS unsigned*)F.lds;
    const int lane = F.lane, wave = F.wave, fr = lane & 15, fq = lane >> 4;
    const int b = unit & 7, qb = 127 - (unit >> 3), t0 = qb * 16, tok0 = b * SEQ + t0;
    const bf16* P = (const bf16*)(F.ws + WS_P);
    {
        bf16x8_t Bf[8][2]; float iwf[8];
        idx_load_q(P, tok0 + fr, Bf, iwf, fq);
        for (int kt = wave; kt <= qb; kt += 8) {
            bf16x8_t Af[2]; const bf16* krow = P + (size_t)(b * SEQ + kt * 16 + fr) * PP + PBIK + fq * 8;
            Af[0] = *(const GAS bf16x8_t*)(krow); Af[1] = *(const GAS bf16x8_t*)(krow + 32);
            float sc[4]; idx_scores(Af, Bf, iwf, sc);
            v4u kv;
            const int s0 = kt * 16 + 4 * fq, t = t0 + fr;
            kv.x = (s0 + 0 <= t) ? fkey(sc[0]) : 0u; kv.y = (s0 + 1 <= t) ? fkey(sc[1]) : 0u; kv.z = (s0 + 2 <= t) ? fkey(sc[2]) : 0u; kv.w = (s0 + 3 <= t) ? fkey(sc[3]) : 0u;
            *(LAS v4u*)(sk + fr * 2048 + s0) = kv;
        }
    }
    __syncthreads();
    unsigned* THR = (unsigned*)(F.ws + WS_THR); int* SCUT = (int*)(F.ws + WS_SCUT);
    for (int qi = 0; qi < 2; ++qi) { const int q = 2 * wave + qi, t = t0 + q, n = t + 1;
        unsigned thr = 0u; int scut = SEQ - 1;
        if (n > TOPK) {
            unsigned keys[32];
#pragma unroll
            for (int i = 0; i < 32; ++i) keys[i] = (64 * i + lane <= t) ? sk[q * 2048 + 64 * i + lane] : 0u;
            unsigned prefix = 0u; bool done = false;
            for (int bit = 31; bit >= 0; --bit) { const unsigned cand = prefix | (1u << bit); int cnt = 0;
#pragma unroll
                for (int i = 0; i < 32; ++i) cnt += __popcll(__ballot(keys[i] >= cand));
                if (cnt >= TOPK) prefix = cand;
                if (cnt == TOPK) { thr = cand - 1u; scut = -1; done = true; break; } }
            if (!done) {
                int cgt = 0;
#pragma unroll
                for (int i = 0; i < 32; ++i) cgt += __popcll(__ballot(keys[i] > prefix));
                int need = TOPK - cgt, run = 0; thr = prefix; scut = SEQ - 1; bool found = false;
#pragma unroll
                for (int i = 0; i < 32; ++i) { unsigned long long mk = __ballot(keys[i] == prefix); const int c = __popcll(mk);
                    if (!found && run + c >= need) { int k = need - run; while (k > 1) { mk &= mk - 1ull; --k; } scut = 64 * i + (int)__builtin_ctzll(mk); found = true; }
                    run += c; }
            }
        }
        if (lane == 0) { THR[tok0 + q] = thr; SCUT[tok0 + q] = scut; }
    }
    __syncthreads();
}

constexpr int QLP = 136;
constexpr int DA_MASK = 0, DA_QL = 8192, DA_CT = DA_QL + 6 * 32 * QLP * 2;
__device__ __forceinline__ void dsa_attn_unit(const Frame& F, int l, int unit) {
    const int tid = F.tid, lane = F.lane, wave = F.wave, r32 = lane & 31, hi = lane >> 5;
    const int b = unit & 7, qb = 63 - (unit >> 3), t0 = qb * 32, tok0 = b * SEQ + t0, ntile = qb + 1;
    bf16* P = (bf16*)(F.ws + WS_P); const bf16* C = (const bf16*)(F.ws + WS_C);
    LAS unsigned* MASK = (LAS unsigned*)(F.lds + DA_MASK); LAS unsigned char* QLb = F.lds + DA_QL; LAS unsigned char* CT = F.lds + DA_CT;
    for (int i = tid; i < 2048; i += NTHR) MASK[i] = 0u;
    const int crow_ = tid >> 4, cch = tid & 15; const unsigned cdst = off_a((unsigned)crow_, (unsigned)cch);
    v4u cpre = *(const GAS v4u*)(C + (size_t)(b * SEQ + crow_) * 128 + cch * 8);
    __syncthreads();
    {
        const int fr = lane & 15, fq = lane >> 4;
        const unsigned* THR = (const unsigned*)(F.ws + WS_THR); const int* SCUT = (const int*)(F.ws + WS_SCUT);
        for (int qh = 0; qh < 2; ++qh) {
            bf16x8_t Bf[8][2]; float iwf[8];
            const int tq = tok0 + 16 * qh + fr, t = t0 + 16 * qh + fr;
            idx_load_q(P, tq, Bf, iwf, fq);
            const unsigned thr = THR[tq]; const int scut = SCUT[tq];
            for (int kt = wave; kt <= 2 * qb + qh; kt += 8) {
                bf16x8_t Af[2]; const bf16* krow = P + (size_t)(b * SEQ + kt * 16 + fr) * PP + PBIK + fq * 8;
                Af[0] = *(const GAS bf16x8_t*)(krow); Af[1] = *(const GAS bf16x8_t*)(krow + 32);
                float sc[4]; idx_scores(Af, Bf, iwf, sc);
                const int s0 = kt * 16 + 4 * fq; unsigned nib = 0u;
#pragma unroll
                for (int r = 0; r < 4; ++r) { const unsigned key = fkey(sc[r]); const int s = s0 + r;
                    if (s <= t && (key > thr || (key == thr && s <= scut))) nib |= (1u << r); }
                if (nib) __hip_atomic_fetch_or(&MASK[(kt >> 1) * 32 + 16 * qh + fr], nib << ((kt & 1) * 16 + 4 * fq), __ATOMIC_RELAXED, __HIP_MEMORY_SCOPE_WORKGROUP);
            }
        }
    }
    *(LAS v4u*)(CT + cdst) = cpre;
    const int h = wave;
    LAS unsigned char* QLh = QLb + h * (32 * QLP * 2);
    if (wave < 6) {
        unsigned zo_ = 0u; asm volatile("" : "+v"(zo_));
        const bf16* wukT = (const bf16*)(F.ws + WS_WUKT) + (size_t)h * 128 * 64 + zo_;
        bf16x8_t qf[4];
#pragma unroll
        for (int ks = 0; ks < 4; ++ks) qf[ks] = *(const GAS bf16x8_t*)(P + (size_t)(tok0 + r32) * PP + PBQ + h * 64 + ks * 16 + hi * 8);
#pragma unroll
        for (int blk = 0; blk < 4; ++blk) { f32x16_t x;
#pragma unroll
            for (int i = 0; i < 16; ++i) x[i] = 0.f;
#pragma unroll
            for (int ks = 0; ks < 4; ++ks) { const bf16x8_t a = *(const GAS bf16x8_t*)(wukT + (size_t)(blk * 32 + r32) * 64 + ks * 16 + hi * 8); x = __builtin_amdgcn_mfma_f32_32x32x16_bf16(a, qf[ks], x, 0, 0, 0); }
#pragma unroll
            for (int g = 0; g < 4; ++g) { const float sc = 0.125f * 1.4426950408889634f;
                const unsigned long long w = (unsigned long long)pk2(x[4 * g] * sc, x[4 * g + 1] * sc) | ((unsigned long long)pk2(x[4 * g + 2] * sc, x[4 * g + 3] * sc) << 32);
                *(LAS unsigned long long*)(QLh + (r32 * QLP + blk * 32 + 8 * g + 4 * hi) * 2) = w; } }
    }
    __syncthreads();
    f32x16_t o[4]; float m_run = -1e30f, l_run = 0.f;
    const LAS unsigned char* qlrow = QLh + (r32 * QLP + 8 * hi) * 2;
    if (wave < 6) {
#pragma unroll
        for (int c = 0; c < 4; ++c)
#pragma unroll
            for (int i = 0; i < 16; ++i) o[c][i] = 0.f;
    }
    const unsigned rr_ = ((unsigned)r32 >> 2) & 3u, rb_ = 2048u * ((unsigned)r32 >> 3) + 64u * ((unsigned)r32 & 7u);
    const unsigned rbase0 = rb_ + 16u * ((unsigned)hi ^ rr_), rbase1 = rb_ + 16u * ((2u + (unsigned)hi) ^ rr_);
    const unsigned blk_ = (lane >> 4) & 1, q_ = (lane & 15) >> 2, p_ = lane & 3;
    for (int j = 0; j < ntile; ++j) {
        LAS unsigned char* kb = CT + (j & 1) * 8192;
        if (j + 1 < ntile) cpre = *(const GAS v4u*)(C + (size_t)(b * SEQ + (j + 1) * 32 + crow_) * 128 + cch * 8);
        if (wave < 6) {
            f32x16_t S;
#pragma unroll
            for (int i = 0; i < 16; ++i) S[i] = 0.f;
#pragma unroll
            for (int s = 0; s < 8; ++s) { const bf16x8_t a = *(const LAS bf16x8_t*)(kb + ((s & 1) ? rbase1 : rbase0) + 512 * (s >> 1)); const bf16x8_t bq = *(const LAS bf16x8_t*)(qlrow + 32 * s);
                S = __builtin_amdgcn_mfma_f32_32x32x16_bf16(a, bq, S, 0, 0, 0); }
            const unsigned word = MASK[j * 32 + r32];
            float tmax = -1e30f;
#pragma unroll
            for (int r = 0; r < 16; ++r) { const bool bit = (word >> crow32(r, hi)) & 1u; S[r] = bit ? S[r] : -1e30f; tmax = fmaxf(tmax, S[r]); }
            tmax = fmaxf(tmax, __shfl_xor(tmax, 32));
            const float m_new = fmaxf(m_run, tmax), alpha = __builtin_amdgcn_exp2f(m_run - m_new);
            float psum = 0.f; float e[16];
#pragma unroll
            for (int r = 0; r < 16; ++r) { e[r] = (S[r] > -1e29f) ? __builtin_amdgcn_exp2f(S[r] - m_new) : 0.f; psum += e[r]; }
            l_run = l_run * alpha + psum; m_run = m_new;
            if (__any(alpha != 1.0f)) {
#pragma unroll
                for (int c = 0; c < 4; ++c)
#pragma unroll
                    for (int i = 0; i < 16; ++i) o[c][i] *= alpha; }
            bf16x8_t xs[2];
#pragma unroll
            for (int s = 0; s < 2; ++s) { v4u w; w.x = pk2(e[8 * s], e[8 * s + 1]); w.y = pk2(e[8 * s + 2], e[8 * s + 3]); w.z = pk2(e[8 * s + 4], e[8 * s + 5]); w.w = pk2(e[8 * s + 6], e[8 * s + 7]); xs[s] = __builtin_bit_cast(bf16x8_t, w); }
#pragma unroll
            for (int c = 0; c < 4; ++c)
#pragma unroll
                for (int s = 0; s < 2; ++s) {
                    const unsigned a0 = off_a((unsigned)(16 * s + 4 * hi + q_), (unsigned)(4 * c + 2 * blk_ + (p_ >> 1))) + 8u * (p_ & 1);
                    const unsigned a1 = off_a((unsigned)(16 * s + 8 + 4 * hi + q_), (unsigned)(4 * c + 2 * blk_ + (p_ >> 1))) + 8u * (p_ & 1);
                    const s16x4_t lo = __builtin_bit_cast(s16x4_t, __builtin_amdgcn_ds_read_tr16_b64_v4i16((LAS s16x4_t*)(kb + a0)));
                    const s16x4_t hh = __builtin_bit_cast(s16x4_t, __builtin_amdgcn_ds_read_tr16_b64_v4i16((LAS s16x4_t*)(kb + a1)));
                    const bf16x8_t a = (bf16x8_t){lo[0], lo[1], lo[2], lo[3], hh[0], hh[1], hh[2], hh[3]};
                    o[c] = __builtin_amdgcn_mfma_f32_32x32x16_bf16(a, xs[s], o[c], 0, 0, 0); }
        }
        if (j + 1 < ntile) *(LAS v4u*)(CT + ((j + 1) & 1) * 8192 + cdst) = cpre;
        __syncthreads();
    }
    if (wave < 6) {
        const float lt = l_run + __shfl_xor(l_run, 32); const float inv = 1.0f / lt;
#pragma unroll
        for (int c = 0; c < 4; ++c)
#pragma unroll
            for (int g = 0; g < 4; ++g) { const unsigned long long w = (unsigned long long)pk2(o[c][4 * g] * inv, o[c][4 * g + 1] * inv) | ((unsigned long long)pk2(o[c][4 * g + 2] * inv, o[c][4 * g + 3] * inv) << 32);
                *(LAS unsigned long long*)(QLh + (r32 * QLP + c * 32 + 8 * g + 4 * hi) * 2) = w; }
        unsigned zo2_ = 0u; asm volatile("" : "+v"(zo2_));
        const bf16* wuvT = (const bf16*)(F.ws + WS_WUVT) + (size_t)h * 64 * 128 + zo2_;
        bf16x8_t Bo[8];
#pragma unroll
        for (int s = 0; s < 8; ++s) Bo[s] = *(const LAS bf16x8_t*)(QLh + (r32 * QLP + 16 * s + 8 * hi) * 2);
#pragma unroll
        for (int mb = 0; mb < 2; ++mb) { f32x16_t y;
#pragma unroll
            for (int i = 0; i < 16; ++i) y[i] = 0.f;
#pragma unroll
            for (int s = 0; s < 8; ++s) { const bf16x8_t a = *(const GAS bf16x8_t*)(wuvT + (size_t)(mb * 32 + r32) * 128 + 16 * s + 8 * hi); y = __builtin_amdgcn_mfma_f32_32x32x16_bf16(a, Bo[s], y, 0, 0, 0); }
#pragma unroll
            for (int g = 0; g < 4; ++g) { const unsigned long long w = (unsigned long long)pk2(y[4 * g], y[4 * g + 1]) | ((unsigned long long)pk2(y[4 * g + 2], y[4 * g + 3]) << 32);
                *(GAS unsigned long long*)(P + (size_t)(tok0 + r32) * PP + 384 + h * 64 + mb * 32 + 8 * g + 4 * hi) = w; } }
    }
    __syncthreads();
}
__device__ __forceinline__ void dsa_weights(const Frame& F, int l) {
    const float* wuk = F.in[I_WUK] + (size_t)l * 6 * 64 * 128; const float* wuv = F.in[I_WUV] + (size_t)l * 6 * 128 * 64;
    bf16* wukT = (bf16*)(F.ws + WS_WUKT); bf16* wuvT = (bf16*)(F.ws + WS_WUVT);
    for (int i = F.vcu * NTHR + F.tid; i < 6 * 64 * 128; i += F.G * NTHR) {
        { const int hh = i / 8192, rem = i - hh * 8192, c = rem >> 6, d = rem & 63; wukT[i] = (bf16)f2bf(wuk[(hh * 64 + d) * 128 + c]); }
        { const int hh = i / 8192, rem = i - hh * 8192, d = rem >> 7, c = rem & 127; wuvT[i] = (bf16)f2bf(wuv[(hh * 128 + c) * 64 + d]); } }
}

__device__ __forceinline__ void final_norm(const Frame& F) {
    const int gw = F.vcu * NWAVES + F.wave, NGW = F.G * NWAVES; const float* g = F.in[I_FN];
    for (int m = gw; m < M; m += NGW) { GAS f32x4* xr = (GAS f32x4*)(F.out + (size_t)m * DM) + F.lane; f32x4 v[4]; float s = 0.f;
#pragma unroll
        for (int j = 0; j < 4; ++j) { v[j] = xr[64 * j]; s += (v[j].x * v[j].x + v[j].y * v[j].y) + (v[j].z * v[j].z + v[j].w * v[j].w); }
        const float rs = 1.0f / sqrtf(wave_sum(s) * (1.0f / DM) + 1e-6f);
#pragma unroll
        for (int j = 0; j < 4; ++j) { const f32x4 gg = *(const f32x4*)(g + 4 * F.lane + 256 * j); xr[64 * j] = v[j] * rs * gg; } }
}

template <class T> __device__ __forceinline__ T* launder_ptr(T* p) {
    unsigned lo = (unsigned)(uintptr_t)p, hi = (unsigned)((uintptr_t)p >> 32);
    asm volatile("" : "+v"(lo), "+v"(hi));
    lo = __builtin_amdgcn_readfirstlane(lo); hi = __builtin_amdgcn_readfirstlane(hi);
    return (T*)(((uintptr_t)hi << 32) | (uintptr_t)lo);
}
constexpr int NPHASE = 18;
__global__ void __launch_bounds__(NTHR, 2) fwd_kernel(Args args) {
    extern __shared__ __attribute__((aligned(16))) unsigned char lds[];
    Frame F;
    F.lds = (LAS unsigned char*)lds;
    F.tid = threadIdx.x; F.lane = F.tid & 63; F.wave = __builtin_amdgcn_readfirstlane(F.tid >> 6);
    F.G = gridDim.x; { const int bx = blockIdx.x; F.vcu = (F.G % 8 == 0) ? (bx % 8) * (F.G / 8) + bx / 8 : bx; }
    F.in = args.in; F.out = args.out; F.ws = args.ws;
    volatile LAS unsigned* MISC = (volatile LAS unsigned*)(F.lds + MISC_OFF);
    for (int u = F.tid; u < (LDS_BYTES - LDSCTL_OFF) / 4; u += NTHR) ((LAS unsigned*)(F.lds + LDSCTL_OFF))[u] = 0u;
    __syncthreads();
    const int lo = args.ph_lo, hi = args.ph_hi;
    XcdBarrier bar; bar.bar = (unsigned*)(F.ws + WS_CTL) + CW_BAR; bar.x = 0; bar.st = nullptr;
    if (hi - lo > 1) bar = xcd_barrier_post((unsigned*)(F.ws + WS_CTL) + CW_BAR, MISC + 8);
    for (int ph_ = lo; ph_ < hi; ++ph_) {
        int ph = ph_; asm volatile("" : "+v"(ph)); ph = __builtin_amdgcn_readfirstlane(ph);
#define PH_ENTER() \
        { unsigned z_ = 0u; int t_ = threadIdx.x; asm volatile("" : "+v"(z_), "+v"(t_)); z_ = __builtin_amdgcn_readfirstlane(z_); F.in = args.in; F.out = args.out + z_; F.ws = args.ws + z_; \
          F.tid = t_; F.lane = t_ & 63; F.wave = __builtin_amdgcn_readfirstlane(t_ >> 6); } \
        int bx = blockIdx.x; { int g_ = gridDim.x; asm volatile("" : "+v"(bx), "+v"(g_)); bx = __builtin_amdgcn_readfirstlane(bx); g_ = __builtin_amdgcn_readfirstlane(g_); F.G = g_; F.vcu = (g_ % 8 == 0) ? (bx % 8) * (g_ / 8) + bx / 8 : bx; } \
        gu32* ctl = (gu32*)(F.ws + WS_CTL); (void)ctl; \
        bf16* XB = (bf16*)(F.ws + WS_XB); bf16* Hb = (bf16*)(F.ws + WS_H); bf16* Pb = (bf16*)(F.ws + WS_P); float* part = (float*)(F.ws + WS_PART); (void)XB; (void)Hb; (void)Pb; (void)part;
        if (ph == 0) { PH_ENTER();
            conv_weights(F, 0, 0, 6);
            p0_x(F); p0_table(F);
        } else if (ph == NPHASE - 1) { PH_ENTER();
            final_norm(F);
        } else {
            const int l = (ph - 1) >> 3, sub = (ph - 1) & 7;
            if (sub == 0 || sub == 6) { PH_ENTER();
                pg8::Gemm g{XB, (const bf16*)(F.ws + (sub == 0 ? WS_WGU1 : WS_WGU2)), M, NGU, DM, DM}; pg8::StaticOrder S; S.init(M, NGU, F.G, bx);
                pg8::EpiUp E{Hb, FFP, part};
                pg8::gemm_phase<pg8::EpiUp, pg8::StaticOrder, true>(F.lds, g, S, E, F.tid);
            } else if (sub == 1 || sub == 7 || sub == 5) { PH_ENTER();
                const bool op = (sub == 5);
                pg8::Gemm g{op ? Pb : Hb, (const bf16*)(F.ws + (op ? WS_WOUT : (sub == 1 ? WS_WD1 : WS_WD2))), M, DM, op ? DM : FFP, op ? PP : FFP}; pg8::StaticOrder S; S.init(M, DM, F.G, bx);
                const float* base = (l == 0 && sub == 1) ? F.in[I_X] : F.out;
                pg8::EpiRes E{base, F.out, XB, part};
                pg8::gemm_phase<pg8::EpiRes, pg8::StaticOrder, false>(F.lds, g, S, E, F.tid);
            } else if (sub == 2) { PH_ENTER();
                pg8::Gemm g{XB, (const bf16*)(F.ws + WS_WIN), M, PP, DM, DM}; pg8::StaticOrder S; S.init(M, PP, F.G, bx);
                pg8::EpiP E{Pb, PP, part};
                pg8::gemm_phase<pg8::EpiP, pg8::StaticOrder, true>(F.lds, g, S, E, F.tid);
            } else if (sub == 3) { PH_ENTER();
                dsa_weights(F, l);
                for (int u = F.vcu; u < M / 16; u += F.G) dsa_thr_unit(F, u);
                for (int u = F.vcu; u < M / PT; u += F.G) prep_tokens_unit(F, l, u);
                for (int u = F.vcu; u < BATCH * 4 * 16; u += F.G) ret_kv_unit(F, u);
                if (l + 1 < DEPTH) conv_weights(F, l + 1, 0, 3);
                if (l > 0) conv_weights(F, l, 3, 6);
            } else if (sub == 4) { PH_ENTER();
                if (bx < BATCH * 6) rwkv_scan_unit(F, l, bx);
                else {
                    gu32* qh = ctl + CW_QUEUE + 64 * l;
                    for (;;) {
                        if (F.tid == 0) MISC[0] = __hip_atomic_fetch_add(qh, 1u, RLX_AGENT);
                        __syncthreads();
                        const int u = (int)MISC[0];
                        __syncthreads();
                        if (u >= M / 32 + BATCH * 4 * 16) break;
                        if (u < M / 32) dsa_attn_unit(F, l, u);
                        else ret_out_unit(F, u - M / 32);
                    }
                }
            }
        }
        if (ph_ + 1 < hi) xcd_barrier(bar);
    }
}

extern "C" void kernel_launch(void* const* d_in, const int* in_sizes, int n_in, void* d_out, int out_size, void* d_ws, size_t ws_size, hipStream_t stream) {
    static int grid = 0;
    if (grid == 0) {
        if (n_in != 31 || out_size != M * DM || ws_size < WS_END) { fprintf(stderr, "kernel_launch: unexpected shapes (n_in %d, out %d, ws %zu)\n", n_in, out_size, ws_size); grid = -1; return; }
        int dev = 0, cus = 0, per_cu = 0;
        if (hipGetDevice(&dev) != hipSuccess || hipDeviceGetAttribute(&cus, hipDeviceAttributeMultiprocessorCount, dev) != hipSuccess) { grid = -1; return; }
        if (hipFuncSetAttribute((const void*)fwd_kernel, hipFuncAttributeMaxDynamicSharedMemorySize, LDS_BYTES) != hipSuccess) { fprintf(stderr, "kernel_launch: hipFuncSetAttribute failed\n"); grid = -1; return; }
        if (hipOccupancyMaxActiveBlocksPerMultiprocessor(&per_cu, (const void*)fwd_kernel, NTHR, LDS_BYTES) != hipSuccess || per_cu < 1) fprintf(stderr, "kernel_launch: occupancy query says %d\n", per_cu);
        (void)hipGetLastError();
        grid = cus;
    }
    if (grid < 0) return;
    if (hipMemsetAsync((char*)d_ws + WS_CTL, 0, CTL_ZERO_BYTES, stream) != hipSuccess) return;
    Args a{};
    for (int i = 0; i < 31; ++i) a.in[i] = (const float*)d_in[i];
    a.out = (float*)d_out; a.ws = (unsigned char*)d_ws;
#ifndef ONE_LAUNCH
#define ONE_LAUNCH 1
#endif
    if (ONE_LAUNCH) { a.ph_lo = 0; a.ph_hi = NPHASE; hipLaunchKernelGGL(fwd_kernel, dim3(grid), dim3(NTHR), LDS_BYTES, stream, a); }
    else for (int ph = 0; ph < NPHASE; ++ph) { a.ph_lo = ph; a.ph_hi = ph + 1; hipLaunchKernelGGL(fwd_kernel, dim3(grid), dim3(NTHR), LDS_BYTES, stream, a); }
}
```

```cpp
#include <hip/hip_runtime.h>
#include <cstdio>
#include <cstdint>
#include <cmath>

namespace pg8 {
#define PG8_LAS __attribute__((address_space(3)))
typedef unsigned short bf16_t;
typedef short bf16x8 __attribute__((ext_vector_type(8)));
typedef float f32x4 __attribute__((ext_vector_type(4)));
typedef unsigned u32x4 __attribute__((ext_vector_type(4)));
constexpr int BM = 256, BK = 64, HALF = 128, HTB = HALF * BK * 2  , STAGE_BYTES = 8 * HTB, NXCD = 8, WGM = 8;

__host__ __device__ __forceinline__ int lds_byte(int r, int c) { const int st = (r >> 4) * 2 + (c >> 5), rr = r & 15, cc = c & 31, ob = rr * 64 + cc * 2; return st * 1024 + (ob ^ (((ob >> 9) & 1) << 5)); }
__host__ __device__ __forceinline__ void stage_rc(int b, int& R, int& C) { const int st = b / 1024, sb = b % 1024, swz = sb ^ (((sb >> 9) & 1) << 5); R = (st >> 1) * 16 + swz / 64; C = (st & 1) * 32 + (swz % 64) / 2; }
__host__ __device__ __forceinline__ int perm32(int rho) { const int n = rho >> 4, i = rho & 15; return 8 * (i >> 2) + 4 * n + (i & 3); }

struct Unit { int pm, pn; };
struct Gemm { const bf16_t* A; const bf16_t* Bt; int M, N, K, lda; };

struct StaticOrder {
    int nM, nN, nwg, G, c;
    __host__ __device__ void init(int M, int N, int G_, int c_) { nM = M / BM; nN = N / BM; nwg = nM * nN; G = G_; c = c_; }
    __host__ __device__ bool next(int i, Unit& u) const {
        const long L = (long)i * G + c; if (L >= nwg) return false;
        int wgid = (int)L; { const int q = nwg / NXCD, r = nwg % NXCD, xcd = wgid % NXCD, off = wgid / NXCD; wgid = (xcd < r ? xcd * (q + 1) : r * (q + 1) + (xcd - r) * q) + off; }
        const int nig = WGM * nN, gid = wgid / nig, fm = gid * WGM, gsz = (nM - fm) < WGM ? (nM - fm) : WGM;
        u.pm = fm + ((wgid % nig) % gsz); u.pn = (wgid % nig) / gsz; return true;
    }
    __device__ __forceinline__ void a_ready(const Unit&) const {}
    __device__ __forceinline__ void done(const Unit&) const {}
};

__device__ __forceinline__ unsigned cvt_pk_bf16(float lo, float hi) { unsigned r; asm volatile("v_cvt_pk_bf16_f32 %0, %1, %2" : "=v"(r) : "v"(lo), "v"(hi)); return r; }


__device__ __forceinline__ float row_rstd(const float* part, int row) {
    const f32x4* p = (const f32x4*)(part + (size_t)row * 16);
    const f32x4 a = p[0], b = p[1], c = p[2], d = p[3];
    const float s = ((a[0] + a[1]) + (a[2] + a[3])) + ((b[0] + b[1]) + (b[2] + b[3])) + ((c[0] + c[1]) + (c[2] + c[3])) + ((d[0] + d[1]) + (d[2] + d[3]));
    return 1.0f / sqrtf(s * (1.0f / 1024.0f) + 1e-6f);
}
__device__ __forceinline__ float silu_f(float x) { return x * __builtin_amdgcn_rcpf(1.0f + __expf(-x)); }

struct EpiUp {
    static constexpr bool PERM = true;
    bf16_t* H; int ldh; const float* part;
    __device__ __forceinline__ void operator()(const f32x4 (&acc)[2][2][4][2], const Unit& u, int wr, int wc, int fr, int fq) const {
        const int row0 = u.pm * BM + wr * 64 + fr, hcol = u.pn * 128 + wc * 32 + 8 * fq;
#pragma unroll
        for (int ai = 0; ai < 2; ++ai)
#pragma unroll
            for (int m = 0; m < 4; ++m) { const int row = row0 + ai * HALF + m * 16; const float rs = row_rstd(part, row);
                const f32x4 g0 = acc[ai][0][m][0] * rs, g1 = acc[ai][0][m][1] * rs, u0 = acc[ai][1][m][0] * rs, u1 = acc[ai][1][m][1] * rs;
                u32x4 w; w.x = cvt_pk_bf16(silu_f(g0[0]) * u0[0], silu_f(g0[1]) * u0[1]); w.y = cvt_pk_bf16(silu_f(g0[2]) * u0[2], silu_f(g0[3]) * u0[3]);
                w.z = cvt_pk_bf16(silu_f(g1[0]) * u1[0], silu_f(g1[1]) * u1[1]); w.w = cvt_pk_bf16(silu_f(g1[2]) * u1[2], silu_f(g1[3]) * u1[3]);
                *(u32x4*)(H + (size_t)row * ldh + hcol) = w; }
    }
};
struct EpiP {
    static constexpr bool PERM = true;
    bf16_t* P; int ldp; const float* part;
    __device__ __forceinline__ void operator()(const f32x4 (&acc)[2][2][4][2], const Unit& u, int wr, int wc, int fr, int fq) const {
        const int row0 = u.pm * BM + wr * 64 + fr, col0 = u.pn * BM + wc * 32 + 8 * fq;
#pragma unroll
        for (int ai = 0; ai < 2; ++ai)
#pragma unroll
            for (int m = 0; m < 4; ++m) { const int row = row0 + ai * HALF + m * 16; const float rs = row_rstd(part, row);
#pragma unroll
                for (int bj = 0; bj < 2; ++bj) { const f32x4 v0 = acc[ai][bj][m][0] * rs, v1 = acc[ai][bj][m][1] * rs;
                    u32x4 w; w.x = cvt_pk_bf16(v0[0], v0[1]); w.y = cvt_pk_bf16(v0[2], v0[3]); w.z = cvt_pk_bf16(v1[0], v1[1]); w.w = cvt_pk_bf16(v1[2], v1[3]);
                    *(u32x4*)(P + (size_t)row * ldp + col0 + bj * HALF) = w; } }
    }
};
struct EpiRes {
    static constexpr bool PERM = true;
    const float* base; float* out; bf16_t* xb; float* part;
    __device__ __forceinline__ void operator()(const f32x4 (&acc)[2][2][4][2], const Unit& u, int wr, int wc, int fr, int fq) const {
        const int row0 = u.pm * BM + wr * 64 + fr, col0 = u.pn * BM + wc * 32 + 8 * fq;
#pragma unroll
        for (int ai = 0; ai < 2; ++ai)
#pragma unroll
            for (int m = 0; m < 4; ++m) { const int row = row0 + ai * HALF + m * 16; float ss = 0.f;
#pragma unroll
                for (int bj = 0; bj < 2; ++bj) { const size_t off = (size_t)row * 1024 + col0 + bj * HALF;
                    const f32x4 v0 = acc[ai][bj][m][0] + *(const f32x4*)(base + off), v1 = acc[ai][bj][m][1] + *(const f32x4*)(base + off + 4);
                    *(f32x4*)(out + off) = v0; *(f32x4*)(out + off + 4) = v1;
                    u32x4 w; w.x = cvt_pk_bf16(v0[0], v0[1]); w.y = cvt_pk_bf16(v0[2], v0[3]); w.z = cvt_pk_bf16(v1[0], v1[1]); w.w = cvt_pk_bf16(v1[2], v1[3]);
                    *(u32x4*)(xb + off) = w;
                    ss += (v0[0] * v0[0] + v0[1] * v0[1]) + (v0[2] * v0[2] + v0[3] * v0[3]) + (v1[0] * v1[0] + v1[1] * v1[1]) + (v1[2] * v1[2] + v1[3] * v1[3]); }
                ss += __shfl_xor(ss, 16); ss += __shfl_xor(ss, 32);
                if (fq == 0) part[(size_t)row * 16 + u.pn * 4 + wc] = ss;
                asm volatile("" ::: "memory"); }
    }
};

template <class Epi, class Sched, bool ALIGN_EPI>
__device__ __forceinline__ void gemm_phase(PG8_LAS unsigned char* lds, const Gemm g, const Sched& S, const Epi& E, const int tid) {
    const int wid = __builtin_amdgcn_readfirstlane(tid >> 6), lane = tid & 63, wr = wid >> 2, wc = wid & 3, fr = lane & 15, fq = lane >> 4;
    const int K = g.K, nt = K / BK, lda = g.lda;
    unsigned voffA[2], voffB[2];
#pragma unroll
    for (int i = 0; i < 2; ++i) { int R, C; stage_rc(tid * 16 + i * 8192, R, C); const int Rb = Epi::PERM ? ((R & ~31) + perm32(R & 31)) : R;
        voffA[i] = (unsigned)(R * lda + C) * 2u; voffB[i] = (unsigned)(Rb * K + C) * 2u; }
    const size_t kstep = (size_t)(BK * 2);
    const size_t hstepA = (size_t)HALF * lda * 2, hstepB = (size_t)HALF * K * 2;
    const size_t tstepA = 2 * hstepA, tstepB = 2 * hstepB;
    const unsigned ldsw = (unsigned)wid * 1024u;
    const int aoff = lds_byte(wr * 64 + fr, fq * 8), boff = lds_byte(wc * 32 + fr, fq * 8);
#define PG8_SA(b, h) (((b) * 2 + (h)) * HTB)
#define PG8_SB(b, h) ((4 + (b) * 2 + (h)) * HTB)
#define PG8_STAGE(bufoff, gbase, voff) do { _Pragma("unroll") for (int _i = 0; _i < 2; ++_i) \
        __builtin_amdgcn_global_load_lds((const unsigned*)((const char*)(gbase) + (voff)[_i]), (PG8_LAS unsigned*)(lds + (bufoff) + ldsw + _i * 8192), 16, 0, 0); } while (0)
#define PG8_LDA(dst, b, h) do { _Pragma("unroll") for (int m = 0; m < 4; ++m) _Pragma("unroll") for (int k = 0; k < 2; ++k) dst[m][k] = *(const PG8_LAS bf16x8*)(lds + PG8_SA(b, h) + aoff + m * 2048 + k * 1024); } while (0)
#define PG8_LDB(dst, b, h) do { _Pragma("unroll") for (int n = 0; n < 2; ++n) _Pragma("unroll") for (int k = 0; k < 2; ++k) dst[n][k] = *(const PG8_LAS bf16x8*)(lds + PG8_SB(b, h) + boff + n * 2048 + k * 1024); } while (0)
#define PG8_MMA(ai, bj, At, Bt) do { __builtin_amdgcn_s_setprio(1); _Pragma("unroll") for (int m = 0; m < 4; ++m) _Pragma("unroll") for (int n = 0; n < 2; ++n) _Pragma("unroll") for (int k = 0; k < 2; ++k) \
        acc[ai][bj][m][n] = __builtin_amdgcn_mfma_f32_16x16x32_bf16(Bt[n][k], At[m][k], acc[ai][bj][m][n], 0, 0, 0); __builtin_amdgcn_s_setprio(0); } while (0)
#define PG8_WAIT_V(n) asm volatile("s_waitcnt vmcnt(" #n ")" ::: "memory")
#define PG8_WAIT_L(n) asm volatile("s_waitcnt lgkmcnt(" #n ")" ::: "memory")
#define PG8_BAR __builtin_amdgcn_s_barrier()
#define PG8_SCHED __builtin_amdgcn_sched_barrier(0)
    Unit cur, nxt; int ui = 0;
    if (!S.next(0, cur)) return;
    f32x4 acc[2][2][4][2];
#pragma unroll
    for (int a = 0; a < 2; ++a)
#pragma unroll
        for (int b = 0; b < 2; ++b)
#pragma unroll
            for (int m = 0; m < 4; ++m)
#pragma unroll
                for (int n = 0; n < 2; ++n) acc[a][b][m][n] = (f32x4){0.f, 0.f, 0.f, 0.f};
    bf16x8 At[4][2], B0[2][2], B1[2][2];
    const char* cA = (const char*)g.A + (size_t)cur.pm * tstepA; const char* cB = (const char*)g.Bt + (size_t)cur.pn * tstepB;
    S.a_ready(cur);
    PG8_STAGE(PG8_SB(0, 0), cB, voffB); PG8_STAGE(PG8_SB(0, 1), cB + hstepB, voffB); PG8_STAGE(PG8_SA(0, 0), cA, voffA); PG8_STAGE(PG8_SA(0, 1), cA + hstepA, voffA);
    if (wr == 1) PG8_BAR;
    PG8_WAIT_V(2); PG8_BAR;
    PG8_STAGE(PG8_SB(1, 0), cB + kstep, voffB); PG8_STAGE(PG8_SA(1, 0), cA + kstep, voffA); PG8_STAGE(PG8_SB(1, 1), cB + hstepB + kstep, voffB);
    PG8_WAIT_V(6); PG8_BAR;
    for (;;) {
        const bool has_next = S.next(ui + 1, nxt);
        const char* nA = has_next ? (const char*)g.A + (size_t)nxt.pm * tstepA : cA; const char* nB = has_next ? (const char*)g.Bt + (size_t)nxt.pn * tstepB : cB;
        for (int t = 0; t < nt; t += 2) {
            const bool last = (t == nt - 2);
            const char* a1 = cA + (size_t)(t + 1) * kstep;
            const char* a2 = last ? nA : cA + (size_t)(t + 2) * kstep; const char* b2 = last ? nB : cB + (size_t)(t + 2) * kstep;
            const char* a3 = a2 + kstep; const char* b3 = b2 + kstep;
            if (last && has_next) S.a_ready(nxt);
            PG8_LDB(B0, 0, 0); PG8_LDB(B1, 0, 1); PG8_SCHED; PG8_LDA(At, 0, 0); PG8_STAGE(PG8_SA(1, 1), a1 + hstepA, voffA);
            PG8_WAIT_V(8); PG8_WAIT_L(0); PG8_BAR; PG8_MMA(0, 0, At, B0); PG8_MMA(0, 1, At, B1); PG8_BAR; PG8_SCHED;
            PG8_LDA(At, 0, 1); PG8_STAGE(PG8_SB(0, 0), b2, voffB); PG8_STAGE(PG8_SB(0, 1), b2 + hstepB, voffB); PG8_STAGE(PG8_SA(0, 0), a2, voffA);
            PG8_WAIT_V(8); PG8_WAIT_L(0); PG8_BAR; PG8_MMA(1, 0, At, B0); PG8_MMA(1, 1, At, B1); PG8_BAR; PG8_SCHED;
            PG8_LDB(B0, 1, 0); PG8_LDB(B1, 1, 1); PG8_SCHED; PG8_LDA(At, 1, 0); PG8_STAGE(PG8_SA(0, 1), a2 + hstepA, voffA);
            PG8_WAIT_V(8); PG8_WAIT_L(0); PG8_BAR; PG8_MMA(0, 0, At, B0); PG8_MMA(0, 1, At, B1); PG8_BAR; PG8_SCHED;
            PG8_LDA(At, 1, 1); PG8_STAGE(PG8_SB(1, 0), b3, voffB); PG8_STAGE(PG8_SB(1, 1), b3 + hstepB, voffB); PG8_STAGE(PG8_SA(1, 0), a3, voffA);
            PG8_WAIT_V(8); PG8_WAIT_L(0); PG8_BAR; PG8_MMA(1, 0, At, B0); PG8_MMA(1, 1, At, B1); PG8_BAR; PG8_SCHED;
        }
        if constexpr (ALIGN_EPI) { if (wr == 0) PG8_BAR; }
        E(acc, cur, wr, wc, fr, fq); S.done(cur);
        if (!has_next) break;
#pragma unroll
        for (int a = 0; a < 2; ++a)
#pragma unroll
            for (int b = 0; b < 2; ++b)
#pragma unroll
                for (int m = 0; m < 4; ++m)
#pragma unroll
                    for (int n = 0; n < 2; ++n) acc[a][b][m][n] = (f32x4){0.f, 0.f, 0.f, 0.f};
        cur = nxt; cA = nA; cB = nB; ++ui;
        if constexpr (ALIGN_EPI) { if (wr == 1) PG8_BAR; }
    }
    PG8_WAIT_V(0);
    if constexpr (!ALIGN_EPI) { if (wr == 0) PG8_BAR; }
    PG8_BAR;
#undef PG8_SA
#undef PG8_SB
#undef PG8_STAGE
#undef PG8_LDA
#undef PG8_LDB
#undef PG8_MMA
#undef PG8_WAIT_V
#undef PG8_WAIT_L
#undef PG8_BAR
#undef PG8_SCHED
}
}

constexpr int NWAVES = 8, NTHR = 512;
constexpr int BATCH = 8, SEQ = 2048, DM = 1024, DEPTH = 2, FF = 2752, M = BATCH * SEQ;
constexpr int FFP = 2816;
constexpr int NGU = 5632;
constexpr int PP = 3584;
constexpr int NIN = 3400;
constexpr int PA = 0, PMV = 1280, PBQ = 1296, PBC = 1680, PBIQ = 1808, PBIK = 2320, PBIW = 2384, PCQ = 2392, PCK = 2648, PCV = 2904, PCG = 3160, PUSED = 3416;
constexpr int AW = 384;
constexpr int TOPK = 256;

constexpr size_t MiB = 1u << 20;
constexpr size_t WS_CTL = 0, CTL_ZERO_BYTES = 1 * MiB;
constexpr size_t WS_PART = 1 * MiB;
constexpr size_t WS_TAB = 2 * MiB;
constexpr size_t WS_BON = 2 * MiB + 512 * 1024;
constexpr size_t WS_WUKT = 3 * MiB, WS_WUVT = 3 * MiB + 192 * 1024;
constexpr size_t WS_THR = 3 * MiB + 384 * 1024, WS_SCUT = 3 * MiB + 448 * 1024;
constexpr size_t WS_LORA = 3 * MiB + 512 * 1024;
constexpr size_t WS_WGU1 = 4 * MiB, WS_WD1 = 15 * MiB, WS_WIN = 21 * MiB, WS_WOUT = 28 * MiB, WS_WGU2 = 30 * MiB, WS_WD2 = 41 * MiB;
constexpr size_t WS_XB = 47 * MiB;
constexpr size_t WS_VF = 79 * MiB;
constexpr size_t WS_P = 91 * MiB;
constexpr size_t WS_H = WS_P;
constexpr size_t WS_R = 203 * MiB, WS_D = 215 * MiB, WS_K2 = 227 * MiB, WS_KK = 239 * MiB, WS_C = 251 * MiB;
constexpr size_t WS_BP = WS_XB, WS_G = WS_XB + 12 * MiB, WS_KV = WS_XB + 24 * MiB;
constexpr size_t WS_END = 256 * MiB;
static_assert(WS_WD2 + (size_t)1024 * FFP * 2 <= WS_XB && WS_P + (size_t)M * PP * 2 <= WS_R && WS_C + (size_t)M * 128 * 2 <= WS_END, "ws map");
constexpr int CW_BAR = 4096;
constexpr int CW_QUEUE = 16384;

constexpr int RING_BYTES = 131072;
constexpr int LDSCTL_OFF = RING_BYTES, MISC_OFF = LDSCTL_OFF + 320;
constexpr int LDS_BYTES = 147456;

#define GAS __attribute__((address_space(1)))
#define LAS __attribute__((address_space(3)))
typedef unsigned short bf16;
typedef unsigned v4u __attribute__((ext_vector_type(4)));
typedef float f32x4 __attribute__((ext_vector_type(4)));
typedef GAS unsigned gu32;
#define RLX_AGENT __ATOMIC_RELAXED, __HIP_MEMORY_SCOPE_AGENT
#define LDS_WAIT() asm volatile("s_waitcnt lgkmcnt(0)" ::: "memory")
__device__ __forceinline__ unsigned f2bf(float f) { unsigned u = __builtin_bit_cast(unsigned, f); return (u + 0x7fffu + ((u >> 16) & 1u)) >> 16; }
__device__ __forceinline__ unsigned pk2(float lo, float hi) { return f2bf(lo) | (f2bf(hi) << 16); }
__device__ __forceinline__ float bf2f(unsigned short v) { return __uint_as_float((unsigned)v << 16); }
__device__ __forceinline__ float bflo(unsigned w) { return __uint_as_float(w << 16); }
__device__ __forceinline__ float bfhi(unsigned w) { return __uint_as_float(w & 0xffff0000u); }
__device__ __forceinline__ void unpack8(const v4u w, float (&f)[8]) { f[0] = bflo(w.x); f[1] = bfhi(w.x); f[2] = bflo(w.y); f[3] = bfhi(w.y); f[4] = bflo(w.z); f[5] = bfhi(w.z); f[6] = bflo(w.w); f[7] = bfhi(w.w); }
__device__ __forceinline__ float sigmoid_f(float x) { return 1.0f / (1.0f + __expf(-x)); }
__device__ __forceinline__ float wave_sum(float v) {
#pragma unroll
    for (int o = 1; o < 64; o <<= 1) v += __shfl_xor(v, o);
    return v;
}

#define XB_TMO      128
#define XB_XCNT(j)  (256  + 64 * (j))
#define XB_XSUB(j)  (1280 + 64 * (j))
#define XB_XGEN(j)  (2304 + 64 * (j))
#define XB_TOP      3328
#define XB_TOPGEN   3392
#define XCD_BAR_WORDS 3456
#define XB_SPIN_CAP (1u << 22)

__device__ __forceinline__ unsigned xb_ld(unsigned* p)              { return __hip_atomic_load(p, __ATOMIC_RELAXED, __HIP_MEMORY_SCOPE_AGENT); }
__device__ __forceinline__ unsigned xb_add(unsigned* p, unsigned v) { return __hip_atomic_fetch_add(p, v, __ATOMIC_RELAXED, __HIP_MEMORY_SCOPE_AGENT); }
__device__ __forceinline__ unsigned xb_xcc_id() { return (unsigned)__builtin_amdgcn_s_getreg((3 << 11) | 20) & 0xFu; }
#define XB_SPIN(cond, bar) do { unsigned _sp = 0; while (cond) { __builtin_amdgcn_s_sleep(1); \
    if ((++_sp & 255u) == 0u) { if (xb_ld(&(bar)[XB_TMO])) break; if (_sp > XB_SPIN_CAP) { atomicAdd(&(bar)[XB_TMO], 1u); break; } } } } while (0)

struct XcdBarrier { unsigned* bar; unsigned x; volatile LAS unsigned* st; };

__device__ __forceinline__ XcdBarrier xcd_barrier_post(unsigned* bar, volatile LAS unsigned* st) {
    XcdBarrier b; b.bar = bar; b.x = xb_xcc_id(); b.st = st;
    if (threadIdx.x == 0) (void)xb_add(&bar[XB_XCNT(b.x)], 1u);
    return b;
}
__device__ __forceinline__ void xcd_barrier_complete(unsigned* bar, unsigned x, unsigned& nloc, unsigned& nx) {
    const unsigned G = gridDim.x * gridDim.y * gridDim.z;
    unsigned sum, cnt, mine, sp = 0u;
    for (;;) {
        sum = 0u; cnt = 0u; mine = 0u;
#pragma unroll
        for (unsigned j = 0; j < 16; ++j) { const unsigned c = xb_ld(&bar[XB_XCNT(j)]); sum += c; cnt += (c > 0u) ? 1u : 0u; mine = (j == x) ? c : mine; }
        if (sum == G) break;
        __builtin_amdgcn_s_sleep(1);
        if ((++sp & 255u) == 0u) { if (xb_ld(&bar[XB_TMO])) break; if (sp > XB_SPIN_CAP) { atomicAdd(&bar[XB_TMO], 1u); break; } }
    }
    nloc = mine > 0u ? mine : 1u; nx = cnt > 0u ? cnt : 1u;
}
__device__ __forceinline__ void xcd_barrier(const XcdBarrier& b) {
    asm volatile("s_waitcnt vmcnt(0)" ::: "memory");
    __syncthreads();
    if (threadIdx.x == 0) {
        unsigned* bar = b.bar;
        __builtin_amdgcn_s_waitcnt(0);
        unsigned nloc = b.st[0], nx = b.st[1];
        if (nloc == 0u) { xcd_barrier_complete(bar, b.x, nloc, nx); b.st[0] = nloc; b.st[1] = nx; }
        const unsigned old = xb_add(&bar[XB_XSUB(b.x)], 1u);
        const unsigned gen = old / nloc;
        if (old + 1u == (gen + 1u) * nloc) {
            __builtin_amdgcn_fence(__ATOMIC_RELEASE, "agent");
            asm volatile("s_waitcnt vmcnt(0)" ::: "memory");
            const unsigned og = xb_add(&bar[XB_TOP], 1u);
            const unsigned tg = og / nx;
            if (og + 1u == (tg + 1u) * nx) xb_add(&bar[XB_TOPGEN], 1u);
            else XB_SPIN(xb_ld(&bar[XB_TOPGEN]) == tg, bar);
            __builtin_amdgcn_fence(__ATOMIC_ACQUIRE, "agent");
            xb_add(&bar[XB_XGEN(b.x)], 1u);
            asm volatile("s_waitcnt vmcnt(0)" ::: "memory");
        } else {
            XB_SPIN(xb_ld(&bar[XB_XGEN(b.x)]) == gen, bar);
            __builtin_amdgcn_fence(__ATOMIC_ACQUIRE, "agent");
            asm volatile("s_waitcnt vmcnt(0)" ::: "memory");
        }
    }
    __syncthreads();
}

struct Args { const float* in[31]; float* out; unsigned char* ws; int ph_lo, ph_hi; };
struct Frame {
    LAS unsigned char* lds;
    int tid, lane, wave, vcu, G;
    const float* const* in; float* out; unsigned char* ws;
};
enum { I_X = 0, I_F1N, I_F1G, I_F1U, I_F1D, I_MIXN, I_WIN, I_WOUT, I_MU, I_W0, I_W2, I_A0, I_A2, I_G2, I_KK, I_KA, I_RK, I_LNW, I_LNB, I_VRW, I_VRMU, I_V0, I_V2, I_KVN, I_WUK, I_WUV, I_F2N, I_F2G, I_F2U, I_F2D, I_FN };

__device__ __forceinline__ void conv_item(const Frame& F, int l, int kind, int item, LAS float* scr) {
    const int lane = F.lane;
    int Kd, nkb; bf16* WT;
    if (kind == 0 || kind == 4) { Kd = 1024; WT = (bf16*)(F.ws + (kind == 0 ? WS_WGU1 : WS_WGU2)); }
    else if (kind == 1 || kind == 5) { Kd = FFP; WT = (bf16*)(F.ws + (kind == 1 ? WS_WD1 : WS_WD2)); }
    else if (kind == 2) { Kd = 1024; WT = (bf16*)(F.ws + WS_WIN); }
    else { Kd = 1024; WT = (bf16*)(F.ws + WS_WOUT); }
    nkb = Kd / 64;
    const int rb = item / nkb, kb = item % nkb, r0 = rb * 32, k0 = kb * 64;
    const int rr = r0 + (lane & 31);
    const float* src = nullptr; int ns = 0, col = 0, ksrc = 1024; const float* gain = nullptr; float scale = 1.0f;
    if (kind == 0 || kind == 4) {
        const int tile = rr >> 8, w = rr & 255, hid = tile * 128 + (w & 127);
        if (hid < FF) { const float* s1 = (w >> 7) ? F.in[I_F1U] : F.in[I_F1G]; const float* s2 = (w >> 7) ? F.in[I_F2U] : F.in[I_F2G]; src = ((kind == 0) ? s1 : s2) + (size_t)l * 1024 * FF; ns = FF; col = hid; }
        gain = ((kind == 0) ? F.in[I_F1N] : F.in[I_F2N]) + l * 1024;
    } else if (kind == 1 || kind == 5) {
        src = ((kind == 1) ? F.in[I_F1D] : F.in[I_F2D]) + (size_t)l * FF * 1024; ns = 1024; col = rr; ksrc = FF; scale = 0.5f;
    } else if (kind == 2) {
        gain = F.in[I_MIXN] + l * 1024;
        if (rr < 1280) { src = F.in[I_WIN] + (size_t)l * 1024 * NIN; ns = NIN; col = rr; }
        else if (rr < 1296) { if (l > 0) { src = F.in[I_VRW] + (size_t)(l - 1) * 1024 * 16; ns = 16; col = rr - 1280; } }
        else if (rr < PUSED) { src = F.in[I_WIN] + (size_t)l * 1024 * NIN; ns = NIN; col = rr - 16; }
    } else { src = F.in[I_WOUT] + (size_t)l * 1024 * 1024; ns = 1024; col = rr; }
#pragma unroll 8
    for (int i = 0; i < 32; ++i) { const int kk = 2 * i + (lane >> 5), k = k0 + kk; float v = 0.f;
        if (src != nullptr && k < ksrc) { v = src[(size_t)k * ns + col] * scale; if (gain) v *= gain[k]; }
        scr[kk * 33 + (lane & 31)] = v; }
    LDS_WAIT(); asm volatile("" ::: "memory");
    const int c = lane & 7;
#pragma unroll
    for (int j = 0; j < 4; ++j) { const int n = (lane >> 3) + 8 * j; const LAS float* s = scr + (8 * c) * 33 + n;
        v4u o; o.x = pk2(s[0 * 33], s[1 * 33]); o.y = pk2(s[2 * 33], s[3 * 33]); o.z = pk2(s[4 * 33], s[5 * 33]); o.w = pk2(s[6 * 33], s[7 * 33]);
        *(GAS v4u*)(WT + (size_t)(r0 + n) * Kd + k0 + 8 * c) = o; }
    LDS_WAIT(); asm volatile("" ::: "memory");
}
__host__ __device__ constexpr int conv_items(int kind) { return (kind == 0 || kind == 4) ? (NGU / 32) * 16 : (kind == 1 || kind == 5) ? 32 * (FFP / 64) : (kind == 2) ? (PP / 32) * 16 : 32 * 16; }
__device__ __forceinline__ void conv_weights(const Frame& F, int l, int k_lo, int k_hi) {
    LAS float* scr = (LAS float*)(F.lds + F.wave * 16384);
    const int gw = F.vcu * NWAVES + F.wave, NGW = F.G * NWAVES;
    for (int kind = k_lo; kind < k_hi; ++kind) { const int ni = conv_items(kind);
        for (int it = gw; it < ni; it += NGW) conv_item(F, l, kind, it, scr); }
}

__device__ __forceinline__ void p0_x(const Frame& F) {
    const int gw = F.vcu * NWAVES + F.wave, NGW = F.G * NWAVES;
    const float* x = F.in[I_X]; bf16* xb = (bf16*)(F.ws + WS_XB); float* part = (float*)(F.ws + WS_PART);
    for (int m = gw; m < M; m += NGW) {
        const GAS f32x4* xr = (const GAS f32x4*)(x + (size_t)m * DM) + F.lane; float s = 0.f;
        GAS unsigned long long* o8 = (GAS unsigned long long*)(xb + (size_t)m * DM) + F.lane;
#pragma unroll
        for (int j = 0; j < 4; ++j) { const f32x4 v = xr[64 * j]; s += (v.x * v.x + v.y * v.y) + (v.z * v.z + v.w * v.w);
            o8[64 * j] = (unsigned long long)pk2(v.x, v.y) | ((unsigned long long)pk2(v.z, v.w) << 32); }
        s = wave_sum(s);
        if (F.lane < 16) part[(size_t)m * 16 + F.lane] = (F.lane == 0) ? s : 0.f;
    }
}
__device__ __forceinline__ void p0_table(const Frame& F) {
    float* tab = (float*)(F.ws + WS_TAB);
    for (int i = F.vcu * NTHR + F.tid; i < SEQ * 32; i += F.G * NTHR) { const int t = i >> 5, f = i & 31; const float th = exp2f(-(float)f * (13.287712379549449f / 31.0f)); const float ang = (float)t * th; float s, c; sincosf(ang, &s, &c); tab[2 * i] = c; tab[2 * i + 1] = s; }
}

__device__ __forceinline__ void ret_kv_unit(const Frame& F, int unit) {
    LAS float* kr = (LAS float*)F.lds; LAS float* vv = kr + 128 * 64;
    const int tid = F.tid, c = unit & 15, h = (unit >> 4) & 3, b = unit >> 6, tok0 = b * SEQ + c * 128;
    const bf16* P = (const bf16*)(F.ws + WS_P); const float* tab = (const float*)(F.ws + WS_TAB);
    const float lg2 = log2f(1.0f - exp2f(-5.0f - (float)h));
    for (int idx = tid; idx < 128 * 32; idx += NTHR) { const int m = idx >> 5, i = idx & 31; const size_t ro = (size_t)(tok0 + m) * PP;
        const float k1 = bf2f(P[ro + PCK + h * 64 + i]), k2 = bf2f(P[ro + PCK + h * 64 + 32 + i]);
        const float cs = tab[((c * 128 + m) * 32 + i) * 2], sn = tab[((c * 128 + m) * 32 + i) * 2 + 1];
        const float sc = 0.125f * exp2f((float)(127 - m) * lg2);
        kr[m * 64 + i] = (k1 * cs - k2 * sn) * sc; kr[m * 64 + 32 + i] = (k1 * sn + k2 * cs) * sc;
        vv[m * 64 + i] = bf2f(P[ro + PCV + h * 64 + i]); vv[m * 64 + 32 + i] = bf2f(P[ro + PCV + h * 64 + 32 + i]); }
    __syncthreads();
    const int d = tid >> 3, e0 = (tid & 7) * 8; float acc[8];
#pragma unroll
    for (int e = 0; e < 8; ++e) acc[e] = 0.f;
    for (int m = 0; m < 128; ++m) { const float kd = kr[m * 64 + d];
#pragma unroll
        for (int e = 0; e < 8; ++e) acc[e] += kd * vv[m * 64 + e0 + e]; }
    float* KV = (float*)(F.ws + WS_KV) + (size_t)unit * 4096 + d * 64 + e0;
#pragma unroll
    for (int e = 0; e < 8; ++e) KV[e] = acc[e];
    __syncthreads();
}

typedef float f32x2 __attribute__((ext_vector_type(2)));
__device__ __forceinline__ float dpp_add8(float x) {
    x += __builtin_bit_cast(float, __builtin_amdgcn_mov_dpp(__builtin_bit_cast(int, x), 0xB1, 0xF, 0xF, true));
    x += __builtin_bit_cast(float, __builtin_amdgcn_mov_dpp(__builtin_bit_cast(int, x), 0x4E, 0xF, 0xF, true));
    x += __builtin_bit_cast(float, __builtin_amdgcn_mov_dpp(__builtin_bit_cast(int, x), 0x141, 0xF, 0xF, true));
    return x;
}
constexpr int CH = 32;
struct RwOps { f32x4 r0, r1, d0, d1, k0, k1, q0, q1, b0, b1; float v; };
__device__ __forceinline__ void rw_ld(RwOps& o, const LAS float* base, int s, int ks, int row) {
    const LAS f32x4* p = (const LAS f32x4*)(base + s * 64 + ks * 8);
    o.r0 = p[0]; o.r1 = p[1]; o.d0 = p[CH * 16]; o.d1 = p[CH * 16 + 1]; o.k0 = p[2 * CH * 16]; o.k1 = p[2 * CH * 16 + 1];
    o.q0 = p[3 * CH * 16]; o.q1 = p[3 * CH * 16 + 1]; o.b0 = p[4 * CH * 16]; o.b1 = p[4 * CH * 16 + 1];
    o.v = base[5 * CH * 64 + s * 64 + row];
}
#define LO2(x) __builtin_shufflevector(x, x, 0, 1)
#define HI2(x) __builtin_shufflevector(x, x, 2, 3)
__device__ __forceinline__ float rw_step(f32x2 (&S)[4], const RwOps& o) {
    f32x2 p2 = S[0] * LO2(o.q0); p2 = S[1] * HI2(o.q0) + p2; p2 = S[2] * LO2(o.q1) + p2; p2 = S[3] * HI2(o.q1) + p2;
    const float p = dpp_add8(p2.x + p2.y);
    const f32x2 pp = (f32x2){p, p}, vv = (f32x2){o.v, o.v};
    S[0] = S[0] - LO2(o.d0) * S[0]; S[1] = S[1] - HI2(o.d0) * S[1]; S[2] = S[2] - LO2(o.d1) * S[2]; S[3] = S[3] - HI2(o.d1) * S[3];
    S[0] = S[0] - pp * LO2(o.b0); S[1] = S[1] - pp * HI2(o.b0); S[2] = S[2] - pp * LO2(o.b1); S[3] = S[3] - pp * HI2(o.b1);
    S[0] = vv * LO2(o.k0) + S[0]; S[1] = vv * HI2(o.k0) + S[1]; S[2] = vv * LO2(o.k1) + S[2]; S[3] = vv * HI2(o.k1) + S[3];
    f32x2 y2 = S[0] * LO2(o.r0); y2 = S[1] * HI2(o.r0) + y2; y2 = S[2] * LO2(o.r1) + y2; y2 = S[3] * HI2(o.r1) + y2;
    return dpp_add8(y2.x + y2.y);
}
__device__ __forceinline__ void rwkv_scan_unit(const Frame& F, int l, int unit) {
    const int tid = F.tid, lane = F.lane, wave = F.wave, b = unit / 6, h = unit - b * 6, tokb = b * SEQ;
    LAS float* stg = (LAS float*)F.lds; LAS float* ybuf = stg + 2 * 7 * CH * 64; LAS float* bonb = ybuf + CH * 64;
    const bool hi8 = (tid >> 8) != 0;
    const bf16* src0 = (const bf16*)(F.ws + (hi8 ? WS_D : WS_R)); const bf16* src1 = (const bf16*)(F.ws + (hi8 ? WS_KK : WS_K2)); const bf16* src2 = (const bf16*)(F.ws + (hi8 ? WS_VF : WS_BP));
    const bf16* Gg = (const bf16*)(F.ws + WS_G); const float* BON = (const float*)(F.ws + WS_BON); bf16* P = (bf16*)(F.ws + WS_P);
    const int row = 8 * wave + (lane >> 3), ks = lane & 7;
    f32x2 S[4];
#pragma unroll
    for (int j = 0; j < 4; ++j) S[j] = (f32x2){0.f, 0.f};
    v4u sreg[4]; float breg = 0.f;
    const int st_t = (tid & 255) >> 3, st_c = tid & 7;
#define RW_LOAD(cc) do { const size_t o_ = (size_t)(tokb + (cc) * CH + st_t) * AW + h * 64 + st_c * 8; \
        sreg[0] = *(const GAS v4u*)(src0 + o_); sreg[1] = *(const GAS v4u*)(src1 + o_); sreg[2] = *(const GAS v4u*)(src2 + o_); \
        if (!hi8) sreg[3] = *(const GAS v4u*)(Gg + o_); if (tid < CH) breg = BON[(size_t)(tokb + (cc) * CH + tid) * 6 + h]; } while (0)
#define RW_ST1(i, ar, bufi) do { float f[8]; unpack8(sreg[i], f); LAS f32x4* dst = (LAS f32x4*)(stg + ((bufi) * 7 + (ar)) * CH * 64 + st_t * 64 + st_c * 8); \
        dst[0] = (f32x4){f[0], f[1], f[2], f[3]}; dst[1] = (f32x4){f[4], f[5], f[6], f[7]}; } while (0)
#define RW_STORE(bufi) do { RW_ST1(0, hi8 ? 1 : 0, bufi); RW_ST1(1, hi8 ? 3 : 2, bufi); RW_ST1(2, hi8 ? 5 : 4, bufi); if (!hi8) RW_ST1(3, 6, bufi); if (tid < CH) bonb[(bufi) * CH + tid] = breg; } while (0)
    RW_LOAD(0); RW_STORE(0);
    __syncthreads();
    const int pr4 = (tid & 15) * 4;
    const f32x4 lnw = *(const f32x4*)(F.in[I_LNW] + l * AW + h * 64 + pr4), lnb = *(const f32x4*)(F.in[I_LNB] + l * AW + h * 64 + pr4);
    for (int cc = 0; cc < SEQ / CH; ++cc) {
        const int bufi = cc & 1;
        if (cc + 1 < SEQ / CH) RW_LOAD(cc + 1);
        const LAS float* base = stg + bufi * 7 * CH * 64;
        RwOps A, B; float ykeep = 0.f;
        rw_ld(A, base, 0, ks, row);
#pragma unroll
        for (int s = 0; s < CH; s += 2) {
            rw_ld(B, base, s + 1, ks, row);
            { const float y = rw_step(S, A); ykeep = (ks == (s & 7)) ? y : ykeep; }
            if (s + 2 < CH) rw_ld(A, base, s + 2, ks, row);
            { const float y = rw_step(S, B); ykeep = (ks == ((s + 1) & 7)) ? y : ykeep; }
            if (((s + 1) & 7) == 7) ybuf[(s - 6 + ks) * 64 + row] = ykeep;
        }
        __syncthreads();
        {
            const int s = tid >> 4, tok = tokb + cc * CH + s;
            const f32x4 yv = *(const LAS f32x4*)(ybuf + s * 64 + pr4);
            float sm = (yv[0] + yv[1]) + (yv[2] + yv[3]);
            sm += __shfl_xor(sm, 1); sm += __shfl_xor(sm, 2); sm += __shfl_xor(sm, 4); sm += __shfl_xor(sm, 8);
            const float mean = sm * (1.0f / 64.0f); const f32x4 dv = yv - mean;
            float vs = (dv[0] * dv[0] + dv[1] * dv[1]) + (dv[2] * dv[2] + dv[3] * dv[3]);
            vs += __shfl_xor(vs, 1); vs += __shfl_xor(vs, 2); vs += __shfl_xor(vs, 4); vs += __shfl_xor(vs, 8);
            const float rs = 1.0f / sqrtf(vs * (1.0f / 64.0f) + 64e-5f);
            const f32x4 vv = *(const LAS f32x4*)(base + 5 * CH * 64 + s * 64 + pr4), gg = *(const LAS f32x4*)(base + 6 * CH * 64 + s * 64 + pr4);
            const float bon = bonb[bufi * CH + s];
            const f32x4 o = (dv * rs * lnw + lnb + bon * vv) * gg;
            *(GAS unsigned long long*)(P + (size_t)tok * PP + h * 64 + pr4) = (unsigned long long)pk2(o[0], o[1]) | ((unsigned long long)pk2(o[2], o[3]) << 32);
        }
        if (cc + 1 < SEQ / CH) RW_STORE(bufi ^ 1);
        __syncthreads();
    }
#undef RW_LOAD
#undef RW_ST1
#undef RW_STORE
}

typedef short bf16x8_t __attribute__((ext_vector_type(8)));
typedef short s16x4_t __attribute__((ext_vector_type(4)));
typedef float f32x16_t __attribute__((ext_vector_type(16)));
__device__ __forceinline__ unsigned fkey(float f) { const unsigned u = __float_as_uint(f); return (u & 0x80000000u) ? ~u : (u | 0x80000000u); }
__device__ __forceinline__ int crow32(int r, int hi) { return (r & 3) + 8 * (r >> 2) + 4 * hi; }
__device__ __forceinline__ unsigned off_a(unsigned row, unsigned ch) { return 2048u * (row >> 3) + 512u * (ch >> 2) + 64u * (row & 7) + 16u * ((ch & 3) ^ ((row >> 2) & 3)); }

__device__ __forceinline__ void idx_scores(const bf16x8_t (&Af)[2], const bf16x8_t (&Bf)[8][2], const float (&iwf)[8], float (&sc)[4]) {
    sc[0] = sc[1] = sc[2] = sc[3] = 0.f;
#pragma unroll
    for (int h = 0; h < 8; ++h) { f32x4 a = (f32x4){0.f, 0.f, 0.f, 0.f};
        a = __builtin_amdgcn_mfma_f32_16x16x32_bf16(Af[0], Bf[h][0], a, 0, 0, 0);
        a = __builtin_amdgcn_mfma_f32_16x16x32_bf16(Af[1], Bf[h][1], a, 0, 0, 0);
#pragma unroll
        for (int r = 0; r < 4; ++r) sc[r] = fmaf(iwf[h], fmaxf(a[r], 0.f), sc[r]); }
}
__device__ __forceinline__ void idx_load_q(const bf16* P, int tokq, bf16x8_t (&Bf)[8][2], float (&iwf)[8], int fq) {
    const bf16* row = P + (size_t)tokq * PP;
#pragma unroll
    for (int h = 0; h < 8; ++h)
#pragma unroll
        for (int ks = 0; ks < 2; ++ks) Bf[h][ks] = *(const GAS bf16x8_t*)(row + PBIQ + h * 64 + ks * 32 + fq * 8);
    const v4u w = *(const GAS v4u*)(row + PBIW); float f[8]; unpack8(w, f);
#pragma unroll
    for (int h = 0; h < 8; ++h) iwf[h] = f[h] * (0.35355339059327373f * 0.125f);
}

__device__ __forceinline__ void dsa_thr_unit(const Frame& F, int unit) {
    LAS unsigned* sk = (LAS unsigned*)F.lds;
    const int lane = F.lane, wave = F.wave, fr = lane & 15, fq = lane >> 4;
    const int b = unit & 7, qb = 127 - (unit >> 3), t0 = qb * 16, tok0 = b * SEQ + t0;
    const bf16* P = (const bf16*)(F.ws + WS_P);
    {
        bf16x8_t Bf[8][2]; float iwf[8];
        idx_load_q(P, tok0 + fr, Bf, iwf, fq);
        for (int kt = wave; kt <= qb; kt += 8) {
            bf16x8_t Af[2]; const bf16* krow = P + (size_t)(b * SEQ + kt * 16 + fr) * PP + PBIK + fq * 8;
            Af[0] = *(const GAS bf16x8_t*)(krow); Af[1] = *(const GAS bf16x8_t*)(krow + 32);
            float sc[4]; idx_scores(Af, Bf, iwf, sc);
            v4u kv;
            const int s0 = kt * 16 + 4 * fq, t = t0 + fr;
            kv.x = (s0 + 0 <= t) ? fkey(sc[0]) : 0u; kv.y = (s0 + 1 <= t) ? fkey(sc[1]) : 0u; kv.z = (s0 + 2 <= t) ? fkey(sc[2]) : 0u; kv.w = (s0 + 3 <= t) ? fkey(sc[3]) : 0u;
            *(LAS v4u*)(sk + fr * 2048 + s0) = kv;
        }
    }
    __syncthreads();
    unsigned* THR = (unsigned*)(F.ws + WS_THR); int* SCUT = (int*)(F.ws + WS_SCUT);
    for (int qi = 0; qi < 2; ++qi) { const int q = 2 * wave + qi, t = t0 + q, n = t + 1;
        unsigned thr = 0u; int scut = SEQ - 1;
        if (n > TOPK) {
            unsigned keys[32];
#pragma unroll
            for (int i = 0; i < 32; ++i) keys[i] = (64 * i + lane <= t) ? sk[q * 2048 + 64 * i + lane] : 0u;
            unsigned prefix = 0u; bool done = false;
            for (int bit = 31; bit >= 0; --bit) { const unsigned cand = prefix | (1u << bit); int cnt = 0;
#pragma unroll
                for (int i = 0; i < 32; ++i) cnt += __popcll(__ballot(keys[i] >= cand));
                if (cnt >= TOPK) prefix = cand;
                if (cnt == TOPK) { thr = cand - 1u; scut = -1; done = true; break; } }
            if (!done) {
                int cgt = 0;
#pragma unroll
                for (int i = 0; i < 32; ++i) cgt += __popcll(__ballot(keys[i] > prefix));
                int need = TOPK - cgt, run = 0; thr = prefix; scut = SEQ - 1; bool found = false;
#pragma unroll
                for (int i = 0; i < 32; ++i) { unsigned long long mk = __ballot(keys[i] == prefix); const int c = __popcll(mk);
                    if (!found && run + c >= need) { int k = need - run; while (k > 1) { mk &= mk - 1ull; --k; } scut = 64 * i + (int)__builtin_ctzll(mk); found = true; }
                    run += c; }
            }
        }
        if (lane == 0) { THR[tok0 + q] = thr; SCUT[tok0 + q] = scut; }
    }
    __syncthreads();
}

constexpr int QLP = 136;
constexpr int DA_MASK = 0, DA_QL = 8192, DA_CT = DA_QL + 6 * 32 * QLP * 2;
__device__ __forceinline__ void dsa_attn_unit(const Frame& F, int l, int unit) {
    const int tid = F.tid, lane = F.lane, wave = F.wave, r32 = lane & 31, hi = lane >> 5;
    const int b = unit & 7, qb = 63 - (unit >> 3), t0 = qb * 32, tok0 = b * SEQ + t0, ntile = qb + 1;
    bf16* P = (bf16*)(F.ws + WS_P); const bf16* C = (const bf16*)(F.ws + WS_C);
    LAS unsigned* MASK = (LAS unsigned*)(F.lds + DA_MASK); LAS unsigned char* QLb = F.lds + DA_QL; LAS unsigned char* CT = F.lds + DA_CT;
    for (int i = tid; i < 2048; i += NTHR) MASK[i] = 0u;
    const int crow_ = tid >> 4, cch = tid & 15; const unsigned cdst = off_a((unsigned)crow_, (unsigned)cch);
    v4u cpre = *(const GAS v4u*)(C + (size_t)(b * SEQ + crow_) * 128 + cch * 8);
    __syncthreads();
    {
        const int fr = lane & 15, fq = lane >> 4;
        const unsigned* THR = (const unsigned*)(F.ws + WS_THR); const int* SCUT = (const int*)(F.ws + WS_SCUT);
        for (int qh = 0; qh < 2; ++qh) {
            bf16x8_t Bf[8][2]; float iwf[8];
            const int tq = tok0 + 16 * qh + fr, t = t0 + 16 * qh + fr;
            idx_load_q(P, tq, Bf, iwf, fq);
            const unsigned thr = THR[tq]; const int scut = SCUT[tq];
            for (int kt = wave; kt <= 2 * qb + qh; kt += 8) {
                bf16x8_t Af[2]; const bf16* krow = P + (size_t)(b * SEQ + kt * 16 + fr) * PP + PBIK + fq * 8;
                Af[0] = *(const GAS bf16x8_t*)(krow); Af[1] = *(const GAS bf16x8_t*)(krow + 32);
                float sc[4]; idx_scores(Af, Bf, iwf, sc);
                const int s0 = kt * 16 + 4 * fq; unsigned nib = 0u;
#pragma unroll
                for (int r = 0; r < 4; ++r) { const unsigned key = fkey(sc[r]); const int s = s0 + r;
                    if (s <= t && (key > thr || (key == thr && s <= scut))) nib |= (1u << r); }
                if (nib) __hip_atomic_fetch_or(&MASK[(kt >> 1) * 32 + 16 * qh + fr], nib << ((kt & 1) * 16 + 4 * fq), __ATOMIC_RELAXED, __HIP_MEMORY_SCOPE_WORKGROUP);
            }
        }
    }
    *(LAS v4u*)(CT + cdst) = cpre;
    const int h = wave;
    LAS unsigned char* QLh = QLb + h * (32 * QLP * 2);
    if (wave < 6) {
        unsigned zo_ = 0u; asm volatile("" : "+v"(zo_));
        const bf16* wukT = (const bf16*)(F.ws + WS_WUKT) + (size_t)(l * 6 + h) * 128 * 64 + zo_;
        bf16x8_t qf[4];
#pragma unroll
        for (int ks = 0; ks < 4; ++ks) qf[ks] = *(const GAS bf16x8_t*)(P + (size_t)(tok0 + r32) * PP + PBQ + h * 64 + ks * 16 + hi * 8);
#pragma unroll
        for (int blk = 0; blk < 4; ++blk) { f32x16_t x;
#pragma unroll
            for (int i = 0; i < 16; ++i) x[i] = 0.f;
#pragma unroll
            for (int ks = 0; ks < 4; ++ks) { const bf16x8_t a = *(const GAS bf16x8_t*)(wukT + (size_t)(blk * 32 + r32) * 64 + ks * 16 + hi * 8); x = __builtin_amdgcn_mfma_f32_32x32x16_bf16(a, qf[ks], x, 0, 0, 0); }
#pragma unroll
            for (int g = 0; g < 4; ++g) { const float sc = 0.125f * 1.4426950408889634f;
                const unsigned long long w = (unsigned long long)pk2(x[4 * g] * sc, x[4 * g + 1] * sc) | ((unsigned long long)pk2(x[4 * g + 2] * sc, x[4 * g + 3] * sc) << 32);
                *(LAS unsigned long long*)(QLh + (r32 * QLP + blk * 32 + 8 * g + 4 * hi) * 2) = w; } }
    }
    __syncthreads();
    f32x16_t o[4]; float m_run = -1e30f, l_run = 0.f;
    const LAS unsigned char* qlrow = QLh + (r32 * QLP + 8 * hi) * 2;
    if (wave < 6) {
#pragma unroll
        for (int c = 0; c < 4; ++c)
#pragma unroll
            for (int i = 0; i < 16; ++i) o[c][i] = 0.f;
    }
    const unsigned rr_ = ((unsigned)r32 >> 2) & 3u, rb_ = 2048u * ((unsigned)r32 >> 3) + 64u * ((unsigned)r32 & 7u);
    const unsigned rbase0 = rb_ + 16u * ((unsigned)hi ^ rr_), rbase1 = rb_ + 16u * ((2u + (unsigned)hi) ^ rr_);
    const unsigned blk_ = (lane >> 4) & 1, q_ = (lane & 15) >> 2, p_ = lane & 3;
    for (int j = 0; j < ntile; ++j) {
        LAS unsigned char* kb = CT + (j & 1) * 8192;
        if (j + 1 < ntile) cpre = *(const GAS v4u*)(C + (size_t)(b * SEQ + (j + 1) * 32 + crow_) * 128 + cch * 8);
        if (wave < 6) {
            f32x16_t S;
#pragma unroll
            for (int i = 0; i < 16; ++i) S[i] = 0.f;
#pragma unroll
            for (int s = 0; s < 8; ++s) { const bf16x8_t a = *(const LAS bf16x8_t*)(kb + ((s & 1) ? rbase1 : rbase0) + 512 * (s >> 1)); const bf16x8_t bq = *(const LAS bf16x8_t*)(qlrow + 32 * s);
                S = __builtin_amdgcn_mfma_f32_32x32x16_bf16(a, bq, S, 0, 0, 0); }
            const unsigned word = MASK[j * 32 + r32];
            float tmax = -1e30f;
#pragma unroll
            for (int r = 0; r < 16; ++r) { const bool bit = (word >> crow32(r, hi)) & 1u; S[r] = bit ? S[r] : -1e30f; tmax = fmaxf(tmax, S[r]); }
            tmax = fmaxf(tmax, __shfl_xor(tmax, 32));
            const float m_new = fmaxf(m_run, tmax), alpha = __builtin_amdgcn_exp2f(m_run - m_new);
            float psum = 0.f; float e[16];
#pragma unroll
            for (int r = 0; r < 16; ++r) { e[r] = (S[r] > -1e29f) ? __builtin_amdgcn_exp2f(S[r] - m_new) : 0.f; psum += e[r]; }
            l_run = l_run * alpha + psum; m_run = m_new;
            if (__any(alpha != 1.0f)) {
#pragma unroll
                for (int c = 0; c < 4; ++c)
#pragma unroll
                    for (int i = 0; i < 16; ++i) o[c][i] *= alpha; }
            bf16x8_t xs[2];
#pragma unroll
            for (int s = 0; s < 2; ++s) { v4u w; w.x = pk2(e[8 * s], e[8 * s + 1]); w.y = pk2(e[8 * s + 2], e[8 * s + 3]); w.z = pk2(e[8 * s + 4], e[8 * s + 5]); w.w = pk2(e[8 * s + 6], e[8 * s + 7]); xs[s] = __builtin_bit_cast(bf16x8_t, w); }
#pragma unroll
            for (int c = 0; c < 4; ++c)
#pragma unroll
                for (int s = 0; s < 2; ++s) {
                    const unsigned a0 = off_a((unsigned)(16 * s + 4 * hi + q_), (unsigned)(4 * c + 2 * blk_ + (p_ >> 1))) + 8u * (p_ & 1);
                    const unsigned a1 = off_a((unsigned)(16 * s + 8 + 4 * hi + q_), (unsigned)(4 * c + 2 * blk_ + (p_ >> 1))) + 8u * (p_ & 1);
                    const s16x4_t lo = __builtin_bit_cast(s16x4_t, __builtin_amdgcn_ds_read_tr16_b64_v4i16((LAS s16x4_t*)(kb + a0)));
                    const s16x4_t hh = __builtin_bit_cast(s16x4_t, __builtin_amdgcn_ds_read_tr16_b64_v4i16((LAS s16x4_t*)(kb + a1)));
                    const bf16x8_t a = (bf16x8_t){lo[0], lo[1], lo[2], lo[3], hh[0], hh[1], hh[2], hh[3]};
                    o[c] = __builtin_amdgcn_mfma_f32_32x32x16_bf16(a, xs[s], o[c], 0, 0, 0); }
        }
        if (j + 1 < ntile) *(LAS v4u*)(CT + ((j + 1) & 1) * 8192 + cdst) = cpre;
        __syncthreads();
    }
    if (wave < 6) {
        const float lt = l_run + __shfl_xor(l_run, 32); const float inv = 1.0f / lt;
#pragma unroll
        for (int c = 0; c < 4; ++c)
#pragma unroll
            for (int g = 0; g < 4; ++g) { const unsigned long long w = (unsigned long long)pk2(o[c][4 * g] * inv, o[c][4 * g + 1] * inv) | ((unsigned long long)pk2(o[c][4 * g + 2] * inv, o[c][4 * g + 3] * inv) << 32);
                *(LAS unsigned long long*)(QLh + (r32 * QLP + c * 32 + 8 * g + 4 * hi) * 2) = w; }
        unsigned zo2_ = 0u; asm volatile("" : "+v"(zo2_));
        const bf16* wuvT = (const bf16*)(F.ws + WS_WUVT) + (size_t)(l * 6 + h) * 64 * 128 + zo2_;
        bf16x8_t Bo[8];
#pragma unroll
        for (int s = 0; s < 8; ++s) Bo[s] = *(const LAS bf16x8_t*)(QLh + (r32 * QLP + 16 * s + 8 * hi) * 2);
#pragma unroll
        for (int mb = 0; mb < 2; ++mb) { f32x16_t y;
#pragma unroll
            for (int i = 0; i < 16; ++i) y[i] = 0.f;
#pragma unroll
            for (int s = 0; s < 8; ++s) { const bf16x8_t a = *(const GAS bf16x8_t*)(wuvT + (size_t)(mb * 32 + r32) * 128 + 16 * s + 8 * hi); y = __builtin_amdgcn_mfma_f32_32x32x16_bf16(a, Bo[s], y, 0, 0, 0); }
#pragma unroll
            for (int g = 0; g < 4; ++g) { const unsigned long long w = (unsigned long long)pk2(y[4 * g], y[4 * g + 1]) | ((unsigned long long)pk2(y[4 * g + 2], y[4 * g + 3]) << 32);
                *(GAS unsigned long long*)(P + (size_t)(tok0 + r32) * PP + 384 + h * 64 + mb * 32 + 8 * g + 4 * hi) = w; } }
    }
    __syncthreads();
}

constexpr int RP = 72;
constexpr int RT_QR = 0, RT_KR = 128 * RP * 2, RT_VV = 2 * 128 * RP * 2, RT_ST = 3 * 128 * RP * 2, RT_SS = RT_ST + 64 * RP * 2;
__device__ __forceinline__ void ret_out_unit(const Frame& F, int unit) {
    const int tid = F.tid, lane = F.lane, wave = F.wave, r32 = lane & 31, hi = lane >> 5;
    const int c = unit & 15, h = (unit >> 4) & 3, b = unit >> 6, tok0 = b * SEQ + c * 128;
    bf16* P = (bf16*)(F.ws + WS_P); const float* tab = (const float*)(F.ws + WS_TAB);
    LAS bf16* QR = (LAS bf16*)(F.lds + RT_QR); LAS bf16* KR = (LAS bf16*)(F.lds + RT_KR); LAS bf16* VV = (LAS bf16*)(F.lds + RT_VV); LAS bf16* ST = (LAS bf16*)(F.lds + RT_ST);
    LAS float* SS = (LAS float*)(F.lds + RT_SS);
    const float lg2 = log2f(1.0f - exp2f(-5.0f - (float)h));
    for (int idx = tid; idx < 1024; idx += NTHR) { const int m = idx >> 3, i4 = (idx & 7) * 4; const size_t ro = (size_t)(tok0 + m) * PP + h * 64 + i4;
        const unsigned long long q1w = *(const GAS unsigned long long*)(P + ro + PCQ), q2w = *(const GAS unsigned long long*)(P + ro + PCQ + 32);
        const unsigned long long k1w = *(const GAS unsigned long long*)(P + ro + PCK), k2w = *(const GAS unsigned long long*)(P + ro + PCK + 32);
        const unsigned long long v1w = *(const GAS unsigned long long*)(P + ro + PCV), v2w = *(const GAS unsigned long long*)(P + ro + PCV + 32);
        const f32x4 t0 = *(const GAS f32x4*)(tab + ((size_t)(c * 128 + m) * 32 + i4) * 2), t1 = *(const GAS f32x4*)(tab + ((size_t)(c * 128 + m) * 32 + i4) * 2 + 4);
        const float cs[4] = {t0[0], t0[2], t1[0], t1[2]}, sn[4] = {t0[1], t0[3], t1[1], t1[3]};
        const float q1[4] = {bflo((unsigned)q1w), bfhi((unsigned)q1w), bflo((unsigned)(q1w >> 32)), bfhi((unsigned)(q1w >> 32))}, q2[4] = {bflo((unsigned)q2w), bfhi((unsigned)q2w), bflo((unsigned)(q2w >> 32)), bfhi((unsigned)(q2w >> 32))};
        const float k1[4] = {bflo((unsigned)k1w), bfhi((unsigned)k1w), bflo((unsigned)(k1w >> 32)), bfhi((unsigned)(k1w >> 32))}, k2[4] = {bflo((unsigned)k2w), bfhi((unsigned)k2w), bflo((unsigned)(k2w >> 32)), bfhi((unsigned)(k2w >> 32))};
        float qa[4], qb[4], ka[4], kb[4];
#pragma unroll
        for (int j = 0; j < 4; ++j) { qa[j] = q1[j] * cs[j] - q2[j] * sn[j]; qb[j] = q1[j] * sn[j] + q2[j] * cs[j]; ka[j] = (k1[j] * cs[j] - k2[j] * sn[j]) * 0.125f; kb[j] = (k1[j] * sn[j] + k2[j] * cs[j]) * 0.125f; }
        *(LAS unsigned long long*)(QR + m * RP + i4) = (unsigned long long)pk2(qa[0], qa[1]) | ((unsigned long long)pk2(qa[2], qa[3]) << 32);
        *(LAS unsigned long long*)(QR + m * RP + 32 + i4) = (unsigned long long)pk2(qb[0], qb[1]) | ((unsigned long long)pk2(qb[2], qb[3]) << 32);
        *(LAS unsigned long long*)(KR + m * RP + i4) = (unsigned long long)pk2(ka[0], ka[1]) | ((unsigned long long)pk2(ka[2], ka[3]) << 32);
        *(LAS unsigned long long*)(KR + m * RP + 32 + i4) = (unsigned long long)pk2(kb[0], kb[1]) | ((unsigned long long)pk2(kb[2], kb[3]) << 32);
        *(LAS unsigned long long*)(VV + m * RP + i4) = v1w; *(LAS unsigned long long*)(VV + m * RP + 32 + i4) = v2w; }
    {
        const float* KV = (const float*)(F.ws + WS_KV) + (size_t)(unit - c) * 4096; f32x4 s0 = (f32x4){0.f, 0.f, 0.f, 0.f}, s1 = s0;
        const float cd = exp2f(128.0f * lg2);
        for (int j = 0; j < c; ++j) { const f32x4 a0 = *(const GAS f32x4*)(KV + (size_t)j * 4096 + tid * 8), a1 = *(const GAS f32x4*)(KV + (size_t)j * 4096 + tid * 8 + 4); s0 = s0 * cd + a0; s1 = s1 * cd + a1; }
        v4u w; w.x = pk2(s0[0], s0[1]); w.y = pk2(s0[2], s0[3]); w.z = pk2(s1[0], s1[1]); w.w = pk2(s1[2], s1[3]);
        *(LAS v4u*)(ST + (tid >> 3) * RP + (tid & 7) * 8) = w;
    }
    __syncthreads();
    const int nb = wave >> 1, eb = wave & 1, n = nb * 32 + r32;
    const unsigned blk_ = (lane >> 4) & 1, q_ = (lane & 15) >> 2, p_ = lane & 3;
    bf16x8_t qf[4];
#pragma unroll
    for (int ks = 0; ks < 4; ++ks) qf[ks] = *(const LAS bf16x8_t*)(QR + n * RP + ks * 16 + hi * 8);
    f32x16_t y;
#pragma unroll
    for (int i = 0; i < 16; ++i) y[i] = 0.f;
#pragma unroll
    for (int ks = 0; ks < 4; ++ks) {
        const s16x4_t lo = __builtin_bit_cast(s16x4_t, __builtin_amdgcn_ds_read_tr16_b64_v4i16((LAS s16x4_t*)(ST + (16 * ks + 8 * hi + q_) * RP + 32 * eb + 16 * blk_ + 4 * p_)));
        const s16x4_t hh = __builtin_bit_cast(s16x4_t, __builtin_amdgcn_ds_read_tr16_b64_v4i16((LAS s16x4_t*)(ST + (16 * ks + 8 * hi + 4 + q_) * RP + 32 * eb + 16 * blk_ + 4 * p_)));
        const bf16x8_t a = (bf16x8_t){lo[0], lo[1], lo[2], lo[3], hh[0], hh[1], hh[2], hh[3]};
        y = __builtin_amdgcn_mfma_f32_32x32x16_bf16(a, qf[ks], y, 0, 0, 0); }
    { const float qd = exp2f((float)(n + 1) * lg2);
#pragma unroll
      for (int i = 0; i < 16; ++i) y[i] *= qd; }
    for (int mt = 0; mt <= nb; ++mt) {
        f32x16_t S;
#pragma unroll
        for (int i = 0; i < 16; ++i) S[i] = 0.f;
#pragma unroll
        for (int ks = 0; ks < 4; ++ks) { const bf16x8_t a = *(const LAS bf16x8_t*)(KR + (mt * 32 + r32) * RP + ks * 16 + hi * 8); S = __builtin_amdgcn_mfma_f32_32x32x16_bf16(a, qf[ks], S, 0, 0, 0); }
        float e[16];
#pragma unroll
        for (int r = 0; r < 16; ++r) { const int dm = r32 - crow32(r, hi) + 32 * (nb - mt); e[r] = (dm >= 0) ? S[r] * exp2f((float)dm * lg2) : 0.f; }
#pragma unroll
        for (int s = 0; s < 2; ++s) { v4u w; w.x = pk2(e[8 * s], e[8 * s + 1]); w.y = pk2(e[8 * s + 2], e[8 * s + 3]); w.z = pk2(e[8 * s + 4], e[8 * s + 5]); w.w = pk2(e[8 * s + 6], e[8 * s + 7]);
            const bf16x8_t xs = __builtin_bit_cast(bf16x8_t, w);
            const s16x4_t lo = __builtin_bit_cast(s16x4_t, __builtin_amdgcn_ds_read_tr16_b64_v4i16((LAS s16x4_t*)(VV + (mt * 32 + 16 * s + 4 * hi + q_) * RP + 32 * eb + 16 * blk_ + 4 * p_)));
            const s16x4_t hh = __builtin_bit_cast(s16x4_t, __builtin_amdgcn_ds_read_tr16_b64_v4i16((LAS s16x4_t*)(VV + (mt * 32 + 16 * s + 8 + 4 * hi + q_) * RP + 32 * eb + 16 * blk_ + 4 * p_)));
            const bf16x8_t a = (bf16x8_t){lo[0], lo[1], lo[2], lo[3], hh[0], hh[1], hh[2], hh[3]};
            y = __builtin_amdgcn_mfma_f32_32x32x16_bf16(a, xs, y, 0, 0, 0); }
    }
    float ss = 0.f;
#pragma unroll
    for (int i = 0; i < 16; ++i) ss += y[i] * y[i];
    ss += __shfl_xor(ss, 32);
    if (hi == 0) SS[(nb * 2 + eb) * 32 + r32] = ss;
    __syncthreads();
    ss += SS[(nb * 2 + (eb ^ 1)) * 32 + r32];
    const float rs = 1.0f / sqrtf(ss * (1.0f / 64.0f) + 1e-6f);
    const size_t ro = (size_t)(tok0 + n) * PP;
#pragma unroll
    for (int g = 0; g < 4; ++g) { const int e0 = 32 * eb + 8 * g + 4 * hi;
        const unsigned long long gw = *(const GAS unsigned long long*)(P + ro + PCG + h * 64 + e0);
        const float g0 = bflo((unsigned)gw), g1 = bfhi((unsigned)gw), g2 = bflo((unsigned)(gw >> 32)), g3 = bfhi((unsigned)(gw >> 32));
        const float o0 = g0 * sigmoid_f(g0) * y[4 * g] * rs, o1 = g1 * sigmoid_f(g1) * y[4 * g + 1] * rs, o2 = g2 * sigmoid_f(g2) * y[4 * g + 2] * rs, o3 = g3 * sigmoid_f(g3) * y[4 * g + 3] * rs;
        *(GAS unsigned long long*)(P + ro + 768 + h * 64 + e0) = (unsigned long long)pk2(o0, o1) | ((unsigned long long)pk2(o2, o3) << 32); }
    __syncthreads();
}

constexpr int PT = 32, XSP = 1304;
constexpr int PR_XS = 0, PR_STG = PT * XSP * 2, PR_CONST = PR_STG + 32768;
__device__ __forceinline__ void prep_consts(const Frame& F, int l) {
    LAS float* CS = (LAS float*)(F.lds + PR_CONST);
    for (int i = F.tid; i < AW; i += NTHR) { CS[i] = F.in[I_KK][l * AW + i]; CS[AW + i] = F.in[I_KA][l * AW + i]; CS[2 * AW + i] = F.in[I_RK][l * AW + i];
        CS[3 * AW + i] = F.in[I_W0][l * AW + i]; CS[4 * AW + i] = F.in[I_A0][l * AW + i]; CS[5 * AW + i] = (l > 0) ? F.in[I_V0][(l - 1) * AW + i] : 0.f; }
}
__device__ __forceinline__ float softplus_f(float z) { return fmaxf(z, 0.f) + log1pf(__expf(-fabsf(z))); }
__device__ __forceinline__ void small_weights(const Frame& F) {
    for (int l = 0; l < DEPTH; ++l) {
        const float* w2 = F.in[I_W2] + (size_t)l * 32 * AW; const float* a2 = F.in[I_A2] + (size_t)l * 32 * AW; const float* g2 = F.in[I_G2] + (size_t)l * 64 * AW;
        const float* v2 = F.in[I_V2] + (size_t)(l > 0 ? l - 1 : 0) * 16 * AW;
        bf16* LT = (bf16*)(F.ws + WS_LORA) + (size_t)l * AW * 144;
        for (int i = F.vcu * NTHR + F.tid; i < AW * 144; i += F.G * NTHR) { const int n = i / 144, k = i - n * 144; float v;
            if (k < 32) v = w2[k * AW + n]; else if (k < 64) v = a2[(k - 32) * AW + n]; else if (k < 128) v = g2[(k - 64) * AW + n]; else v = (l > 0) ? v2[(k - 128) * AW + n] : 0.f;
            LT[i] = (bf16)f2bf(v); }
        const float* wuk = F.in[I_WUK] + (size_t)l * 6 * 64 * 128; const float* wuv = F.in[I_WUV] + (size_t)l * 6 * 128 * 64;
        bf16* wukT = (bf16*)(F.ws + WS_WUKT) + (size_t)l * 6 * 64 * 128; bf16* wuvT = (bf16*)(F.ws + WS_WUVT) + (size_t)l * 6 * 64 * 128;
        for (int i = F.vcu * NTHR + F.tid; i < 6 * 64 * 128; i += F.G * NTHR) {
            { const int hh = i / 8192, rem = i - hh * 8192, c = rem >> 6, d = rem & 63; wukT[i] = (bf16)f2bf(wuk[(hh * 64 + d) * 128 + c]); }
            { const int hh = i / 8192, rem = i - hh * 8192, d = rem >> 7, c = rem & 127; wuvT[i] = (bf16)f2bf(wuv[(hh * 128 + c) * 64 + d]); } }
    }
}
__device__ __forceinline__ void prep_tokens_unit(const Frame& F, int l, int unit) {
    LAS bf16* XS = (LAS bf16*)(F.lds + PR_XS);
    const int tid = F.tid, lane = F.lane, wave = F.wave, r32 = lane & 31, hi = lane >> 5, tok0 = unit * PT;
    const bf16* P = (const bf16*)(F.ws + WS_P);
    const float* mu = F.in[I_MU] + l * 1280; const float* vmu = F.in[I_VRMU] + (l > 0 ? (l - 1) * 16 : 0);
    for (int idx = tid; idx < PT * 162; idx += NTHR) { const int t = idx / 162, ch = idx - t * 162, tok = tok0 + t, c0 = ch * 8;
        const v4u cw = *(const GAS v4u*)(P + (size_t)tok * PP + c0); float cur[8], prv[8]; unpack8(cw, cur);
        if ((tok & (SEQ - 1)) != 0) { const v4u pw = *(const GAS v4u*)(P + (size_t)(tok - 1) * PP + c0); unpack8(pw, prv); }
        else {
#pragma unroll
            for (int j = 0; j < 8; ++j) prv[j] = 0.f; }
        float mv[8];
        if (c0 < 1280) { const f32x4 m0 = *(const GAS f32x4*)(mu + c0), m1 = *(const GAS f32x4*)(mu + c0 + 4); mv[0] = m0[0]; mv[1] = m0[1]; mv[2] = m0[2]; mv[3] = m0[3]; mv[4] = m1[0]; mv[5] = m1[1]; mv[6] = m1[2]; mv[7] = m1[3]; }
        else if (l > 0) { const f32x4 m0 = *(const GAS f32x4*)(vmu + (c0 - 1280)), m1 = *(const GAS f32x4*)(vmu + (c0 - 1280) + 4); mv[0] = m0[0]; mv[1] = m0[1]; mv[2] = m0[2]; mv[3] = m0[3]; mv[4] = m1[0]; mv[5] = m1[1]; mv[6] = m1[2]; mv[7] = m1[3]; }
        else {
#pragma unroll
            for (int j = 0; j < 8; ++j) mv[j] = 0.f; }
        float o[8];
#pragma unroll
        for (int j = 0; j < 8; ++j) { float v = cur[j] + (prv[j] - cur[j]) * mv[j];
            if (c0 >= 1152 && c0 < 1184) v = tanhf(v); else if (c0 >= 1216 && c0 < 1280) v = sigmoid_f(v);
            o[j] = v; }
        v4u w; w.x = pk2(o[0], o[1]); w.y = pk2(o[2], o[3]); w.z = pk2(o[4], o[5]); w.w = pk2(o[6], o[7]);
        *(LAS v4u*)(XS + t * XSP + c0) = w; }
    __syncthreads();
    if (wave < 6) {
        const int h = wave;
        LAS bf16* STG = (LAS bf16*)(F.lds + PR_STG + wave * 4096);
        GAS unsigned char* wsb = (GAS unsigned char*)F.ws;
        const bf16* LT = (const bf16*)(F.ws + WS_LORA) + (size_t)l * AW * 144;
        const LAS float* CS = (const LAS float*)(F.lds + PR_CONST) + h * 64;
        const LAS float* kkw = CS; const LAS float* kaw = CS + AW; const LAS float* rkw = CS + 2 * AW; const LAS float* w0p = CS + 3 * AW; const LAS float* a0p = CS + 4 * AW; const LAS float* v0p = CS + 5 * AW;
        const LAS bf16* xrow = XS + r32 * XSP;
        float rn;
        { float ss = 0.f;
#pragma unroll
          for (int cbl = 0; cbl < 2; ++cbl)
#pragma unroll
              for (int g = 0; g < 4; ++g) { const int j0 = cbl * 32 + 8 * g + 4 * hi; const unsigned long long kw = *(const LAS unsigned long long*)(xrow + 384 + h * 64 + j0); const f32x4 kk4 = *(const LAS f32x4*)(kkw + j0);
                  const float k0 = bflo((unsigned)kw) * kk4[0], k1 = bfhi((unsigned)kw) * kk4[1], k2 = bflo((unsigned)(kw >> 32)) * kk4[2], k3 = bfhi((unsigned)(kw >> 32)) * kk4[3]; ss += (k0 * k0 + k1 * k1) + (k2 * k2 + k3 * k3); }
          ss += __shfl_xor(ss, 32); rn = 1.0f / fmaxf(sqrtf(ss), 1e-12f); }
        float bonus = 0.f;
        const int srow = lane >> 2, sch = lane & 3;
#pragma unroll
        for (int cbl = 0; cbl < 2; ++cbl) {
            asm volatile("" ::: "memory");
            const int cb0 = h * 64 + cbl * 32;
            f32x16_t wv, av, gv, mvv;
#pragma unroll
            for (int i = 0; i < 16; ++i) { wv[i] = 0.f; av[i] = 0.f; gv[i] = 0.f; mvv[i] = 0.f; }
            const bf16* lrow = LT + (size_t)(cb0 + r32) * 144 + 8 * hi;
#pragma unroll
            for (int ks = 0; ks < 9; ++ks) { const bf16x8_t a = *(const GAS bf16x8_t*)(lrow + 16 * ks); const bf16x8_t bx = *(const LAS bf16x8_t*)(xrow + 1152 + 16 * ks + 8 * hi);
                if (ks < 2) wv = __builtin_amdgcn_mfma_f32_32x32x16_bf16(a, bx, wv, 0, 0, 0);
                else if (ks < 4) av = __builtin_amdgcn_mfma_f32_32x32x16_bf16(a, bx, av, 0, 0, 0);
                else if (ks < 8) gv = __builtin_amdgcn_mfma_f32_32x32x16_bf16(a, bx, gv, 0, 0, 0);
                else mvv = __builtin_amdgcn_mfma_f32_32x32x16_bf16(a, bx, mvv, 0, 0, 0); }
            if (l > 0) {
#pragma unroll
                for (int i = 0; i < 2; ++i) { const int row = srow + 16 * i; const unsigned eo = (unsigned)(((tok0 + row) * AW + cb0 + sch * 8) * 2); *(LAS v4u*)(STG + row * 32 + sch * 8) = *(const GAS v4u*)(wsb + WS_VF + eo); } }
            unsigned long long ro[4], dd[4], k2o[4], kko[4], bpo[4], vo[4], go[4];
#pragma unroll
            for (int g = 0; g < 4; ++g) { const int j0 = cbl * 32 + 8 * g + 4 * hi;
                const unsigned long long rw = *(const LAS unsigned long long*)(xrow + h * 64 + j0), kw = *(const LAS unsigned long long*)(xrow + 384 + h * 64 + j0), vw = *(const LAS unsigned long long*)(xrow + 768 + h * 64 + j0);
                unsigned long long fw = 0ull; if (l > 0) fw = *(const LAS unsigned long long*)(STG + r32 * 32 + 8 * g + 4 * hi);
                asm volatile("" : "+v"(bonus) :: "memory");
                const f32x4 kk4 = *(const LAS f32x4*)(kkw + j0), ka4 = *(const LAS f32x4*)(kaw + j0), rk4 = *(const LAS f32x4*)(rkw + j0), w04 = *(const LAS f32x4*)(w0p + j0), a04 = *(const LAS f32x4*)(a0p + j0);
                const f32x4 v04 = *(const LAS f32x4*)(v0p + j0);
                const float rr[4] = {bflo((unsigned)rw), bfhi((unsigned)rw), bflo((unsigned)(rw >> 32)), bfhi((unsigned)(rw >> 32))};
                const float kx[4] = {bflo((unsigned)kw), bfhi((unsigned)kw), bflo((unsigned)(kw >> 32)), bfhi((unsigned)(kw >> 32))};
                const float vx[4] = {bflo((unsigned)vw), bfhi((unsigned)vw), bflo((unsigned)(vw >> 32)), bfhi((unsigned)(vw >> 32))};
                const float fx[4] = {bflo((unsigned)fw), bfhi((unsigned)fw), bflo((unsigned)(fw >> 32)), bfhi((unsigned)(fw >> 32))};
                float d_[4], k2_[4], kk_[4], bp_[4], v_[4];
#pragma unroll
                for (int e = 0; e < 4; ++e) { const int i = 4 * g + e;
                    const float sp = softplus_f(-(wv[i] + w04[e])); const float rate = __expf(-sp - 0.5f); const float d = -expm1f(-rate);
                    const float a = sigmoid_f(av[i] + a04[e]);
                    float v = vx[e]; if (l > 0) v = v + (fx[e] - v) * sigmoid_f(mvv[i] + v04[e]);
                    const float kk = kx[e] * kk4[e] * rn, k2 = kx[e] * (1.0f + (a - 1.0f) * ka4[e]);
                    d_[e] = d; k2_[e] = k2; kk_[e] = kk; bp_[e] = kk * a; v_[e] = v;
                    bonus += rr[e] * k2 * rk4[e]; }
#define PK4(x) ((unsigned long long)pk2(x[0], x[1]) | ((unsigned long long)pk2(x[2], x[3]) << 32))
                ro[g] = rw; dd[g] = PK4(d_); k2o[g] = PK4(k2_); kko[g] = PK4(kk_); bpo[g] = PK4(bp_); vo[g] = PK4(v_);
                go[g] = (unsigned long long)pk2(gv[4 * g], gv[4 * g + 1]) | ((unsigned long long)pk2(gv[4 * g + 2], gv[4 * g + 3]) << 32); }
#define PR_OUT(arr, dst) do { _Pragma("unroll") for (int g = 0; g < 4; ++g) *(LAS unsigned long long*)(STG + r32 * 32 + 8 * g + 4 * hi) = arr[g]; \
            _Pragma("unroll") for (int i = 0; i < 2; ++i) { const int row = srow + 16 * i; const unsigned eo = (unsigned)(((tok0 + row) * AW + cb0 + sch * 8) * 2); *(GAS v4u*)(wsb + dst + eo) = *(const LAS v4u*)(STG + row * 32 + sch * 8); } } while (0)
            PR_OUT(ro, WS_R); PR_OUT(dd, WS_D); PR_OUT(k2o, WS_K2); PR_OUT(kko, WS_KK); PR_OUT(bpo, WS_BP); PR_OUT(vo, WS_VF); PR_OUT(go, WS_G);
#undef PR_OUT
#undef PK4
        }
        bonus += __shfl_xor(bonus, 32);
        if (hi == 0) ((float*)(F.ws + WS_BON))[(size_t)(tok0 + r32) * 6 + h] = bonus;
    } else {
        const float* kvn = F.in[I_KVN] + l * 128; bf16* C = (bf16*)(F.ws + WS_C);
        for (int q = 0; q < 16; ++q) { const int tok = tok0 + 16 * (wave - 6) + q; const unsigned w = *(const GAS unsigned*)(P + (size_t)tok * PP + PBC + 2 * lane);
            const float c0 = bflo(w), c1 = bfhi(w); const float ss = wave_sum(c0 * c0 + c1 * c1); const float rs = 1.0f / sqrtf(ss * (1.0f / 128.0f) + 1e-6f);
            *(GAS unsigned*)(C + (size_t)tok * 128 + 2 * lane) = pk2(c0 * rs * kvn[2 * lane], c1 * rs * kvn[2 * lane + 1]); }
    }
    __syncthreads();
}

__device__ __forceinline__ void final_norm(const Frame& F) {
    const int gw = F.vcu * NWAVES + F.wave, NGW = F.G * NWAVES; const float* g = F.in[I_FN];
    for (int m = gw; m < M; m += NGW) { GAS f32x4* xr = (GAS f32x4*)(F.out + (size_t)m * DM) + F.lane; f32x4 v[4]; float s = 0.f;
#pragma unroll
        for (int j = 0; j < 4; ++j) { v[j] = xr[64 * j]; s += (v[j].x * v[j].x + v[j].y * v[j].y) + (v[j].z * v[j].z + v[j].w * v[j].w); }
        const float rs = 1.0f / sqrtf(wave_sum(s) * (1.0f / DM) + 1e-6f);
#pragma unroll
        for (int j = 0; j < 4; ++j) { const f32x4 gg = *(const f32x4*)(g + 4 * F.lane + 256 * j); xr[64 * j] = v[j] * rs * gg; } }
}

template <class T> __device__ __forceinline__ T* launder_ptr(T* p) {
    unsigned lo = (unsigned)(uintptr_t)p, hi = (unsigned)((uintptr_t)p >> 32);
    asm volatile("" : "+v"(lo), "+v"(hi));
    lo = __builtin_amdgcn_readfirstlane(lo); hi = __builtin_amdgcn_readfirstlane(hi);
    return (T*)(((uintptr_t)hi << 32) | (uintptr_t)lo);
}
constexpr int NPHASE = 18;
constexpr int REP_THR = 1, REP_PTOK = 1, REP_KV = 1, REP_CONV = 1, REP_SCAN = 1, REP_DSA = 1, REP_RET = 1, REP_UP = 1;
#define REPL(n) for (int rep_ = 0; rep_ < (l == 0 ? (n) : 1); ++rep_)
__global__ void __launch_bounds__(NTHR, 2) fwd_kernel(Args args) {
    extern __shared__ __attribute__((aligned(16))) unsigned char lds[];
    Frame F;
    F.lds = (LAS unsigned char*)lds;
    F.tid = threadIdx.x; F.lane = F.tid & 63; F.wave = __builtin_amdgcn_readfirstlane(F.tid >> 6);
    F.G = gridDim.x; { const int bx = blockIdx.x; F.vcu = (F.G % 8 == 0) ? (bx % 8) * (F.G / 8) + bx / 8 : bx; }
    F.in = args.in; F.out = args.out; F.ws = args.ws;
    volatile LAS unsigned* MISC = (volatile LAS unsigned*)(F.lds + MISC_OFF);
    for (int u = F.tid; u < (LDS_BYTES - LDSCTL_OFF) / 4; u += NTHR) ((LAS unsigned*)(F.lds + LDSCTL_OFF))[u] = 0u;
    __syncthreads();
    const int lo = args.ph_lo, hi = args.ph_hi;
    XcdBarrier bar; bar.bar = (unsigned*)(F.ws + WS_CTL) + CW_BAR; bar.x = 0; bar.st = nullptr;
    if (hi - lo > 1) bar = xcd_barrier_post((unsigned*)(F.ws + WS_CTL) + CW_BAR, MISC + 8);
    for (int ph_ = lo; ph_ < hi; ++ph_) {
        int ph = ph_; asm volatile("" : "+v"(ph)); ph = __builtin_amdgcn_readfirstlane(ph);
#define PH_ENTER() \
        { unsigned z_ = 0u; int t_ = threadIdx.x; asm volatile("" : "+v"(z_), "+v"(t_)); z_ = __builtin_amdgcn_readfirstlane(z_); F.in = args.in; F.out = args.out + z_; F.ws = args.ws + z_; \
          F.tid = t_; F.lane = t_ & 63; F.wave = __builtin_amdgcn_readfirstlane(t_ >> 6); } \
        int bx = blockIdx.x; { int g_ = gridDim.x; asm volatile("" : "+v"(bx), "+v"(g_)); bx = __builtin_amdgcn_readfirstlane(bx); g_ = __builtin_amdgcn_readfirstlane(g_); F.G = g_; F.vcu = (g_ % 8 == 0) ? (bx % 8) * (g_ / 8) + bx / 8 : bx; } \
        gu32* ctl = (gu32*)(F.ws + WS_CTL); (void)ctl; \
        bf16* XB = (bf16*)(F.ws + WS_XB); bf16* Hb = (bf16*)(F.ws + WS_H); bf16* Pb = (bf16*)(F.ws + WS_P); float* part = (float*)(F.ws + WS_PART); (void)XB; (void)Hb; (void)Pb; (void)part;
        if (ph == 0) { PH_ENTER();
            conv_weights(F, 0, 0, 6);
            p0_x(F); p0_table(F); small_weights(F);
        } else if (ph == NPHASE - 1) { PH_ENTER();
            final_norm(F);
        } else {
            const int l = (ph - 1) >> 3, sub = (ph - 1) & 7;
            if (sub == 0 || sub == 6) { PH_ENTER();
                pg8::Gemm g{XB, (const bf16*)(F.ws + (sub == 0 ? WS_WGU1 : WS_WGU2)), M, NGU, DM, DM}; pg8::StaticOrder S; S.init(M, NGU, F.G, bx);
                pg8::EpiUp E{Hb, FFP, part};
                for (int rep = 0; rep < ((l == 0 && sub == 0) ? REP_UP : 1); ++rep) pg8::gemm_phase<pg8::EpiUp, pg8::StaticOrder, true>(F.lds, g, S, E, F.tid);
            } else if (sub == 1 || sub == 7 || sub == 5) { PH_ENTER();
                const bool op = (sub == 5);
                pg8::Gemm g{op ? Pb : Hb, (const bf16*)(F.ws + (op ? WS_WOUT : (sub == 1 ? WS_WD1 : WS_WD2))), M, DM, op ? DM : FFP, op ? PP : FFP}; pg8::StaticOrder S; S.init(M, DM, F.G, bx);
                const float* base = (l == 0 && sub == 1) ? F.in[I_X] : F.out;
                pg8::EpiRes E{base, F.out, XB, part};
                pg8::gemm_phase<pg8::EpiRes, pg8::StaticOrder, false>(F.lds, g, S, E, F.tid);
            } else if (sub == 2) { PH_ENTER();
                pg8::Gemm g{XB, (const bf16*)(F.ws + WS_WIN), M, PP, DM, DM}; pg8::StaticOrder S; S.init(M, PP, F.G, bx);
                pg8::EpiP E{Pb, PP, part};
                pg8::gemm_phase<pg8::EpiP, pg8::StaticOrder, true>(F.lds, g, S, E, F.tid);
            } else if (sub == 3) { PH_ENTER();
                REPL(REP_THR) for (int u = F.vcu; u < M / 16; u += F.G) dsa_thr_unit(F, u);
                prep_consts(F, l);
                REPL(REP_PTOK) for (int u = F.vcu; u < M / PT; u += F.G) prep_tokens_unit(F, l, u);
                REPL(REP_KV) for (int u = F.vcu; u < BATCH * 4 * 16; u += F.G) ret_kv_unit(F, u);
                REPL(REP_CONV) if (l + 1 < DEPTH) conv_weights(F, l + 1, 0, 3);
                if (l > 0) conv_weights(F, l, 3, 6);
            } else if (sub == 4) { PH_ENTER();
                if (bx < BATCH * 6) { REPL(REP_SCAN) rwkv_scan_unit(F, l, bx); }
                else {
                    gu32* qh = ctl + CW_QUEUE + 64 * l;
                    for (;;) {
                        if (F.tid == 0) MISC[0] = __hip_atomic_fetch_add(qh, 1u, RLX_AGENT);
                        __syncthreads();
                        const int u = (int)MISC[0];
                        __syncthreads();
                        if (u >= M / 32 + BATCH * 4 * 16) break;
                        if (u < M / 32) { REPL(REP_DSA) dsa_attn_unit(F, l, u); }
                        else { REPL(REP_RET) ret_out_unit(F, u - M / 32); }
                    }
                }
            }
        }
        if (ph_ + 1 < hi) xcd_barrier(bar);
    }
}

extern "C" void kernel_launch(void* const* d_in, const int* in_sizes, int n_in, void* d_out, int out_size, void* d_ws, size_t ws_size, hipStream_t stream) {
    static int grid = 0;
    if (grid == 0) {
        if (n_in != 31 || out_size != M * DM || ws_size < WS_END) { fprintf(stderr, "kernel_launch: unexpected shapes (n_in %d, out %d, ws %zu)\n", n_in, out_size, ws_size); grid = -1; return; }
        int dev = 0, cus = 0, per_cu = 0;
        if (hipGetDevice(&dev) != hipSuccess || hipDeviceGetAttribute(&cus, hipDeviceAttributeMultiprocessorCount, dev) != hipSuccess) { grid = -1; return; }
        if (hipFuncSetAttribute((const void*)fwd_kernel, hipFuncAttributeMaxDynamicSharedMemorySize, LDS_BYTES) != hipSuccess) { fprintf(stderr, "kernel_launch: hipFuncSetAttribute failed\n"); grid = -1; return; }
        if (hipOccupancyMaxActiveBlocksPerMultiprocessor(&per_cu, (const void*)fwd_kernel, NTHR, LDS_BYTES) != hipSuccess || per_cu < 1) fprintf(stderr, "kernel_launch: occupancy query says %d\n", per_cu);
        (void)hipGetLastError();
        grid = cus;
    }
    if (grid < 0) return;
    if (hipMemsetAsync((char*)d_ws + WS_CTL, 0, CTL_ZERO_BYTES, stream) != hipSuccess) return;
    Args a{};
    for (int i = 0; i < 31; ++i) a.in[i] = (const float*)d_in[i];
    a.out = (float*)d_out; a.ws = (unsigned char*)d_ws;
#ifndef ONE_LAUNCH
#define ONE_LAUNCH 1
#endif
    if (ONE_LAUNCH) { a.ph_lo = 0; a.ph_hi = NPHASE; hipLaunchKernelGGL(fwd_kernel, dim3(grid), dim3(NTHR), LDS_BYTES, stream, a); }
    else for (int ph = 0; ph < NPHASE; ++ph) { a.ph_lo = ph; a.ph_hi = ph + 1; hipLaunchKernelGGL(fwd_kernel, dim3(grid), dim3(NTHR), LDS_BYTES, stream, a); }
}
```

```cpp
#include <hip/hip_runtime.h>
#include <cstdio>
#include <cstdint>
#include <cmath>

namespace pg8 {
#define PG8_LAS __attribute__((address_space(3)))
typedef unsigned short bf16_t;
typedef short bf16x8 __attribute__((ext_vector_type(8)));
typedef float f32x4 __attribute__((ext_vector_type(4)));
typedef unsigned u32x4 __attribute__((ext_vector_type(4)));
constexpr int BM = 256, BK = 64, HALF = 128, HTB = HALF * BK * 2  , STAGE_BYTES = 8 * HTB, NXCD = 8, WGM = 8;

__host__ __device__ __forceinline__ int lds_byte(int r, int c) { const int st = (r >> 4) * 2 + (c >> 5), rr = r & 15, cc = c & 31, ob = rr * 64 + cc * 2; return st * 1024 + (ob ^ (((ob >> 9) & 1) << 5)); }
__host__ __device__ __forceinline__ void stage_rc(int b, int& R, int& C) { const int st = b / 1024, sb = b % 1024, swz = sb ^ (((sb >> 9) & 1) << 5); R = (st >> 1) * 16 + swz / 64; C = (st & 1) * 32 + (swz % 64) / 2; }
__host__ __device__ __forceinline__ int perm32(int rho) { const int n = rho >> 4, i = rho & 15; return 8 * (i >> 2) + 4 * n + (i & 3); }

struct Unit { int pm, pn; };
struct Gemm { const bf16_t* A; const bf16_t* Bt; int M, N, K, lda; };

struct StaticOrder {
    int nM, nN, nwg, G, c;
    __host__ __device__ void init(int M, int N, int G_, int c_) { nM = M / BM; nN = N / BM; nwg = nM * nN; G = G_; c = c_; }
    __host__ __device__ bool next(int i, Unit& u) const {
        const long L = (long)i * G + c; if (L >= nwg) return false;
        int wgid = (int)L; { const int q = nwg / NXCD, r = nwg % NXCD, xcd = wgid % NXCD, off = wgid / NXCD; wgid = (xcd < r ? xcd * (q + 1) : r * (q + 1) + (xcd - r) * q) + off; }
        const int nig = WGM * nN, gid = wgid / nig, fm = gid * WGM, gsz = (nM - fm) < WGM ? (nM - fm) : WGM;
        u.pm = fm + ((wgid % nig) % gsz); u.pn = (wgid % nig) / gsz; return true;
    }
    __device__ __forceinline__ void a_ready(const Unit&) const {}
    __device__ __forceinline__ void done(const Unit&) const {}
};

__device__ __forceinline__ unsigned cvt_pk_bf16(float lo, float hi) { unsigned r; asm volatile("v_cvt_pk_bf16_f32 %0, %1, %2" : "=v"(r) : "v"(lo), "v"(hi)); return r; }


__device__ __forceinline__ float row_rstd(const float* part, int row) {
    const f32x4* p = (const f32x4*)(part + (size_t)row * 16);
    const f32x4 a = p[0], b = p[1], c = p[2], d = p[3];
    const float s = ((a[0] + a[1]) + (a[2] + a[3])) + ((b[0] + b[1]) + (b[2] + b[3])) + ((c[0] + c[1]) + (c[2] + c[3])) + ((d[0] + d[1]) + (d[2] + d[3]));
    return 1.0f / sqrtf(s * (1.0f / 1024.0f) + 1e-6f);
}
__device__ __forceinline__ float silu_f(float x) { return x * __builtin_amdgcn_rcpf(1.0f + __expf(-x)); }

struct EpiUp {
    static constexpr bool PERM = true;
    bf16_t* H; int ldh; const float* part;
    __device__ __forceinline__ void operator()(const f32x4 (&acc)[2][2][4][2], const Unit& u, int wr, int wc, int fr, int fq) const {
        const int row0 = u.pm * BM + wr * 64 + fr, hcol = u.pn * 128 + wc * 32 + 8 * fq;
#pragma unroll
        for (int ai = 0; ai < 2; ++ai)
#pragma unroll
            for (int m = 0; m < 4; ++m) { const int row = row0 + ai * HALF + m * 16; const float rs = row_rstd(part, row);
                const f32x4 g0 = acc[ai][0][m][0] * rs, g1 = acc[ai][0][m][1] * rs, u0 = acc[ai][1][m][0] * rs, u1 = acc[ai][1][m][1] * rs;
                u32x4 w; w.x = cvt_pk_bf16(silu_f(g0[0]) * u0[0], silu_f(g0[1]) * u0[1]); w.y = cvt_pk_bf16(silu_f(g0[2]) * u0[2], silu_f(g0[3]) * u0[3]);
                w.z = cvt_pk_bf16(silu_f(g1[0]) * u1[0], silu_f(g1[1]) * u1[1]); w.w = cvt_pk_bf16(silu_f(g1[2]) * u1[2], silu_f(g1[3]) * u1[3]);
                *(u32x4*)(H + (size_t)row * ldh + hcol) = w; }
    }
};
struct EpiP {
    static constexpr bool PERM = true;
    bf16_t* P; int ldp; const float* part;
    __device__ __forceinline__ void operator()(const f32x4 (&acc)[2][2][4][2], const Unit& u, int wr, int wc, int fr, int fq) const {
        const int row0 = u.pm * BM + wr * 64 + fr, col0 = u.pn * BM + wc * 32 + 8 * fq;
#pragma unroll
        for (int ai = 0; ai < 2; ++ai)
#pragma unroll
            for (int m = 0; m < 4; ++m) { const int row = row0 + ai * HALF + m * 16; const float rs = row_rstd(part, row);
#pragma unroll
                for (int bj = 0; bj < 2; ++bj) { const f32x4 v0 = acc[ai][bj][m][0] * rs, v1 = acc[ai][bj][m][1] * rs;
                    u32x4 w; w.x = cvt_pk_bf16(v0[0], v0[1]); w.y = cvt_pk_bf16(v0[2], v0[3]); w.z = cvt_pk_bf16(v1[0], v1[1]); w.w = cvt_pk_bf16(v1[2], v1[3]);
                    *(u32x4*)(P + (size_t)row * ldp + col0 + bj * HALF) = w; } }
    }
};
struct EpiRes {
    static constexpr bool PERM = true;
    const float* base; float* out; bf16_t* xb; float* part;
    __device__ __forceinline__ void operator()(const f32x4 (&acc)[2][2][4][2], const Unit& u, int wr, int wc, int fr, int fq) const {
        const int row0 = u.pm * BM + wr * 64 + fr, col0 = u.pn * BM + wc * 32 + 8 * fq;
#pragma unroll
        for (int ai = 0; ai < 2; ++ai)
#pragma unroll
            for (int m = 0; m < 4; ++m) { const int row = row0 + ai * HALF + m * 16; float ss = 0.f;
#pragma unroll
                for (int bj = 0; bj < 2; ++bj) { const size_t off = (size_t)row * 1024 + col0 + bj * HALF;
                    const f32x4 v0 = acc[ai][bj][m][0] + *(const f32x4*)(base + off), v1 = acc[ai][bj][m][1] + *(const f32x4*)(base + off + 4);
                    *(f32x4*)(out + off) = v0; *(f32x4*)(out + off + 4) = v1;
                    u32x4 w; w.x = cvt_pk_bf16(v0[0], v0[1]); w.y = cvt_pk_bf16(v0[2], v0[3]); w.z = cvt_pk_bf16(v1[0], v1[1]); w.w = cvt_pk_bf16(v1[2], v1[3]);
                    *(u32x4*)(xb + off) = w;
                    ss += (v0[0] * v0[0] + v0[1] * v0[1]) + (v0[2] * v0[2] + v0[3] * v0[3]) + (v1[0] * v1[0] + v1[1] * v1[1]) + (v1[2] * v1[2] + v1[3] * v1[3]); }
                ss += __shfl_xor(ss, 16); ss += __shfl_xor(ss, 32);
                if (fq == 0) part[(size_t)row * 16 + u.pn * 4 + wc] = ss;
                asm volatile("" ::: "memory"); }
    }
};

template <class Epi, class Sched, bool ALIGN_EPI>
__device__ __forceinline__ void gemm_phase(PG8_LAS unsigned char* lds, const Gemm g, const Sched& S, const Epi& E, const int tid) {
    const int wid = __builtin_amdgcn_readfirstlane(tid >> 6), lane = tid & 63, wr = wid >> 2, wc = wid & 3, fr = lane & 15, fq = lane >> 4;
    const int K = g.K, nt = K / BK, lda = g.lda;
    unsigned voffA[2], voffB[2];
#pragma unroll
    for (int i = 0; i < 2; ++i) { int R, C; stage_rc(tid * 16 + i * 8192, R, C); const int Rb = Epi::PERM ? ((R & ~31) + perm32(R & 31)) : R;
        voffA[i] = (unsigned)(R * lda + C) * 2u; voffB[i] = (unsigned)(Rb * K + C) * 2u; }
    const size_t kstep = (size_t)(BK * 2);
    const size_t hstepA = (size_t)HALF * lda * 2, hstepB = (size_t)HALF * K * 2;
    const size_t tstepA = 2 * hstepA, tstepB = 2 * hstepB;
    const unsigned ldsw = (unsigned)wid * 1024u;
    const int aoff = lds_byte(wr * 64 + fr, fq * 8), boff = lds_byte(wc * 32 + fr, fq * 8);
#define PG8_SA(b, h) (((b) * 2 + (h)) * HTB)
#define PG8_SB(b, h) ((4 + (b) * 2 + (h)) * HTB)
#define PG8_STAGE(bufoff, gbase, voff) do { _Pragma("unroll") for (int _i = 0; _i < 2; ++_i) \
        __builtin_amdgcn_global_load_lds((const unsigned*)((const char*)(gbase) + (voff)[_i]), (PG8_LAS unsigned*)(lds + (bufoff) + ldsw + _i * 8192), 16, 0, 0); } while (0)
#define PG8_LDA(dst, b, h) do { _Pragma("unroll") for (int m = 0; m < 4; ++m) _Pragma("unroll") for (int k = 0; k < 2; ++k) dst[m][k] = *(const PG8_LAS bf16x8*)(lds + PG8_SA(b, h) + aoff + m * 2048 + k * 1024); } while (0)
#define PG8_LDB(dst, b, h) do { _Pragma("unroll") for (int n = 0; n < 2; ++n) _Pragma("unroll") for (int k = 0; k < 2; ++k) dst[n][k] = *(const PG8_LAS bf16x8*)(lds + PG8_SB(b, h) + boff + n * 2048 + k * 1024); } while (0)
#define PG8_MMA(ai, bj, At, Bt) do { __builtin_amdgcn_s_setprio(1); _Pragma("unroll") for (int m = 0; m < 4; ++m) _Pragma("unroll") for (int n = 0; n < 2; ++n) _Pragma("unroll") for (int k = 0; k < 2; ++k) \
        acc[ai][bj][m][n] = __builtin_amdgcn_mfma_f32_16x16x32_bf16(Bt[n][k], At[m][k], acc[ai][bj][m][n], 0, 0, 0); __builtin_amdgcn_s_setprio(0); } while (0)
#define PG8_WAIT_V(n) asm volatile("s_waitcnt vmcnt(" #n ")" ::: "memory")
#define PG8_WAIT_L(n) asm volatile("s_waitcnt lgkmcnt(" #n ")" ::: "memory")
#define PG8_BAR __builtin_amdgcn_s_barrier()
#define PG8_SCHED __builtin_amdgcn_sched_barrier(0)
    Unit cur, nxt; int ui = 0;
    if (!S.next(0, cur)) return;
    f32x4 acc[2][2][4][2];
#pragma unroll
    for (int a = 0; a < 2; ++a)
#pragma unroll
        for (int b = 0; b < 2; ++b)
#pragma unroll
            for (int m = 0; m < 4; ++m)
#pragma unroll
                for (int n = 0; n < 2; ++n) acc[a][b][m][n] = (f32x4){0.f, 0.f, 0.f, 0.f};
    bf16x8 At[4][2], B0[2][2], B1[2][2];
    const char* cA = (const char*)g.A + (size_t)cur.pm * tstepA; const char* cB = (const char*)g.Bt + (size_t)cur.pn * tstepB;
    S.a_ready(cur);
    PG8_STAGE(PG8_SB(0, 0), cB, voffB); PG8_STAGE(PG8_SB(0, 1), cB + hstepB, voffB); PG8_STAGE(PG8_SA(0, 0), cA, voffA); PG8_STAGE(PG8_SA(0, 1), cA + hstepA, voffA);
    if (wr == 1) PG8_BAR;
    PG8_WAIT_V(2); PG8_BAR;
    PG8_STAGE(PG8_SB(1, 0), cB + kstep, voffB); PG8_STAGE(PG8_SA(1, 0), cA + kstep, voffA); PG8_STAGE(PG8_SB(1, 1), cB + hstepB + kstep, voffB);
    PG8_WAIT_V(6); PG8_BAR;
    for (;;) {
        const bool has_next = S.next(ui + 1, nxt);
        const char* nA = has_next ? (const char*)g.A + (size_t)nxt.pm * tstepA : cA; const char* nB = has_next ? (const char*)g.Bt + (size_t)nxt.pn * tstepB : cB;
        for (int t = 0; t < nt; t += 2) {
            const bool last = (t == nt - 2);
            const char* a1 = cA + (size_t)(t + 1) * kstep;
            const char* a2 = last ? nA : cA + (size_t)(t + 2) * kstep; const char* b2 = last ? nB : cB + (size_t)(t + 2) * kstep;
            const char* a3 = a2 + kstep; const char* b3 = b2 + kstep;
            if (last && has_next) S.a_ready(nxt);
            PG8_LDB(B0, 0, 0); PG8_LDB(B1, 0, 1); PG8_SCHED; PG8_LDA(At, 0, 0); PG8_STAGE(PG8_SA(1, 1), a1 + hstepA, voffA);
            PG8_WAIT_V(8); PG8_WAIT_L(0); PG8_BAR; PG8_MMA(0, 0, At, B0); PG8_MMA(0, 1, At, B1); PG8_BAR; PG8_SCHED;
            PG8_LDA(At, 0, 1); PG8_STAGE(PG8_SB(0, 0), b2, voffB); PG8_STAGE(PG8_SB(0, 1), b2 + hstepB, voffB); PG8_STAGE(PG8_SA(0, 0), a2, voffA);
            PG8_WAIT_V(8); PG8_WAIT_L(0); PG8_BAR; PG8_MMA(1, 0, At, B0); PG8_MMA(1, 1, At, B1); PG8_BAR; PG8_SCHED;
            PG8_LDB(B0, 1, 0); PG8_LDB(B1, 1, 1); PG8_SCHED; PG8_LDA(At, 1, 0); PG8_STAGE(PG8_SA(0, 1), a2 + hstepA, voffA);
            PG8_WAIT_V(8); PG8_WAIT_L(0); PG8_BAR; PG8_MMA(0, 0, At, B0); PG8_MMA(0, 1, At, B1); PG8_BAR; PG8_SCHED;
            PG8_LDA(At, 1, 1); PG8_STAGE(PG8_SB(1, 0), b3, voffB); PG8_STAGE(PG8_SB(1, 1), b3 + hstepB, voffB); PG8_STAGE(PG8_SA(1, 0), a3, voffA);
            PG8_WAIT_V(8); PG8_WAIT_L(0); PG8_BAR; PG8_MMA(1, 0, At, B0); PG8_MMA(1, 1, At, B1); PG8_BAR; PG8_SCHED;
        }
        if constexpr (ALIGN_EPI) { if (wr == 0) PG8_BAR; }
        E(acc, cur, wr, wc, fr, fq); S.done(cur);
        if (!has_next) break;
#pragma unroll
        for (int a = 0; a < 2; ++a)
#pragma unroll
            for (int b = 0; b < 2; ++b)
#pragma unroll
                for (int m = 0; m < 4; ++m)
#pragma unroll
                    for (int n = 0; n < 2; ++n) acc[a][b][m][n] = (f32x4){0.f, 0.f, 0.f, 0.f};
        cur = nxt; cA = nA; cB = nB; ++ui;
        if constexpr (ALIGN_EPI) { if (wr == 1) PG8_BAR; }
    }
    PG8_WAIT_V(0);
    if constexpr (!ALIGN_EPI) { if (wr == 0) PG8_BAR; }
    PG8_BAR;
#undef PG8_SA
#undef PG8_SB
#undef PG8_STAGE
#undef PG8_LDA
#undef PG8_LDB
#undef PG8_MMA
#undef PG8_WAIT_V
#undef PG8_WAIT_L
#undef PG8_BAR
#undef PG8_SCHED
}
}

constexpr int NWAVES = 8, NTHR = 512;
constexpr int BATCH = 8, SEQ = 2048, DM = 1024, DEPTH = 2, FF = 2752, M = BATCH * SEQ;
constexpr int FFP = 2816;
constexpr int NGU = 5632;
constexpr int PP = 3584;
constexpr int NIN = 3400;
constexpr int PA = 0, PMV = 1280, PBQ = 1296, PBC = 1680, PBIQ = 1808, PBIK = 2320, PBIW = 2384, PCQ = 2392, PCK = 2648, PCV = 2904, PCG = 3160, PUSED = 3416;
constexpr int AW = 384;
constexpr int TOPK = 256;

constexpr size_t MiB = 1u << 20;
constexpr size_t WS_CTL = 0, CTL_ZERO_BYTES = 1 * MiB;
constexpr size_t WS_PART = 1 * MiB;
constexpr size_t WS_TAB = 2 * MiB;
constexpr size_t WS_BON = 2 * MiB + 512 * 1024;
constexpr size_t WS_WUKT = 3 * MiB, WS_WUVT = 3 * MiB + 192 * 1024;
constexpr size_t WS_THR = 3 * MiB + 384 * 1024, WS_SCUT = 3 * MiB + 448 * 1024;
constexpr size_t WS_LORA = 3 * MiB + 512 * 1024;
constexpr size_t WS_WGU1 = 4 * MiB, WS_WD1 = 15 * MiB, WS_WIN = 21 * MiB, WS_WOUT = 28 * MiB, WS_WGU2 = 30 * MiB, WS_WD2 = 41 * MiB;
constexpr size_t WS_XB = 47 * MiB;
constexpr size_t WS_VF = 79 * MiB;
constexpr size_t WS_P = 91 * MiB;
constexpr size_t WS_H = WS_P;
constexpr size_t WS_R = 203 * MiB, WS_D = 215 * MiB, WS_K2 = 227 * MiB, WS_KK = 239 * MiB, WS_C = 251 * MiB;
constexpr size_t WS_BP = WS_XB, WS_G = WS_XB + 12 * MiB, WS_KV = WS_XB + 24 * MiB;
constexpr size_t WS_END = 256 * MiB;
static_assert(WS_WD2 + (size_t)1024 * FFP * 2 <= WS_XB && WS_P + (size_t)M * PP * 2 <= WS_R && WS_C + (size_t)M * 128 * 2 <= WS_END, "ws map");
constexpr int CW_BAR = 4096;
constexpr int CW_QUEUE = 16384;

constexpr int RING_BYTES = 131072;
constexpr int LDSCTL_OFF = RING_BYTES, MISC_OFF = LDSCTL_OFF + 320;
constexpr int LDS_BYTES = 147456;

#define GAS __attribute__((address_space(1)))
#define LAS __attribute__((address_space(3)))
typedef unsigned short bf16;
typedef unsigned v4u __attribute__((ext_vector_type(4)));
typedef float f32x4 __attribute__((ext_vector_type(4)));
typedef GAS unsigned gu32;
#define RLX_AGENT __ATOMIC_RELAXED, __HIP_MEMORY_SCOPE_AGENT
#define LDS_WAIT() asm volatile("s_waitcnt lgkmcnt(0)" ::: "memory")
__device__ __forceinline__ unsigned f2bf(float f) { unsigned u = __builtin_bit_cast(unsigned, f); return (u + 0x7fffu + ((u >> 16) & 1u)) >> 16; }
typedef float f32x2v_ __attribute__((ext_vector_type(2))); typedef __bf16 bf16x2v_ __attribute__((ext_vector_type(2)));
__device__ __forceinline__ unsigned pk2(float lo, float hi) { const f32x2v_ v = {lo, hi}; return __builtin_bit_cast(unsigned, __builtin_convertvector(v, bf16x2v_)); }
__device__ __forceinline__ float bf2f(unsigned short v) { return __uint_as_float((unsigned)v << 16); }
__device__ __forceinline__ float bflo(unsigned w) { return __uint_as_float(w << 16); }
__device__ __forceinline__ float bfhi(unsigned w) { return __uint_as_float(w & 0xffff0000u); }
__device__ __forceinline__ void unpack8(const v4u w, float (&f)[8]) { f[0] = bflo(w.x); f[1] = bfhi(w.x); f[2] = bflo(w.y); f[3] = bfhi(w.y); f[4] = bflo(w.z); f[5] = bfhi(w.z); f[6] = bflo(w.w); f[7] = bfhi(w.w); }
__device__ __forceinline__ float sigmoid_f(float x) { return 1.0f / (1.0f + __expf(-x)); }
__device__ __forceinline__ float wave_sum(float v) {
#pragma unroll
    for (int o = 1; o < 64; o <<= 1) v += __shfl_xor(v, o);
    return v;
}

#define XB_TMO      128
#define XB_XCNT(j)  (256  + 64 * (j))
#define XB_XSUB(j)  (1280 + 64 * (j))
#define XB_XGEN(j)  (2304 + 64 * (j))
#define XB_TOP      3328
#define XB_TOPGEN   3392
#define XCD_BAR_WORDS 3456
#define XB_SPIN_CAP (1u << 22)

__device__ __forceinline__ unsigned xb_ld(unsigned* p)              { return __hip_atomic_load(p, __ATOMIC_RELAXED, __HIP_MEMORY_SCOPE_AGENT); }
__device__ __forceinline__ unsigned xb_add(unsigned* p, unsigned v) { return __hip_atomic_fetch_add(p, v, __ATOMIC_RELAXED, __HIP_MEMORY_SCOPE_AGENT); }
__device__ __forceinline__ unsigned xb_xcc_id() { return (unsigned)__builtin_amdgcn_s_getreg((3 << 11) | 20) & 0xFu; }
#define XB_SPIN(cond, bar) do { unsigned _sp = 0; while (cond) { __builtin_amdgcn_s_sleep(1); \
    if ((++_sp & 255u) == 0u) { if (xb_ld(&(bar)[XB_TMO])) break; if (_sp > XB_SPIN_CAP) { atomicAdd(&(bar)[XB_TMO], 1u); break; } } } } while (0)

struct XcdBarrier { unsigned* bar; unsigned x; volatile LAS unsigned* st; };

__device__ __forceinline__ XcdBarrier xcd_barrier_post(unsigned* bar, volatile LAS unsigned* st) {
    XcdBarrier b; b.bar = bar; b.x = xb_xcc_id(); b.st = st;
    if (threadIdx.x == 0) (void)xb_add(&bar[XB_XCNT(b.x)], 1u);
    return b;
}
__device__ __forceinline__ void xcd_barrier_complete(unsigned* bar, unsigned x, unsigned& nloc, unsigned& nx) {
    const unsigned G = gridDim.x * gridDim.y * gridDim.z;
    unsigned sum, cnt, mine, sp = 0u;
    for (;;) {
        sum = 0u; cnt = 0u; mine = 0u;
#pragma unroll
        for (unsigned j = 0; j < 16; ++j) { const unsigned c = xb_ld(&bar[XB_XCNT(j)]); sum += c; cnt += (c > 0u) ? 1u : 0u; mine = (j == x) ? c : mine; }
        if (sum == G) break;
        __builtin_amdgcn_s_sleep(1);
        if ((++sp & 255u) == 0u) { if (xb_ld(&bar[XB_TMO])) break; if (sp > XB_SPIN_CAP) { atomicAdd(&bar[XB_TMO], 1u); break; } }
    }
    nloc = mine > 0u ? mine : 1u; nx = cnt > 0u ? cnt : 1u;
}
__device__ __forceinline__ void xcd_barrier(const XcdBarrier& b) {
    asm volatile("s_waitcnt vmcnt(0)" ::: "memory");
    __syncthreads();
    if (threadIdx.x == 0) {
        unsigned* bar = b.bar;
        __builtin_amdgcn_s_waitcnt(0);
        unsigned nloc = b.st[0], nx = b.st[1];
        if (nloc == 0u) { xcd_barrier_complete(bar, b.x, nloc, nx); b.st[0] = nloc; b.st[1] = nx; }
        const unsigned old = xb_add(&bar[XB_XSUB(b.x)], 1u);
        const unsigned gen = old / nloc;
        if (old + 1u == (gen + 1u) * nloc) {
            __builtin_amdgcn_fence(__ATOMIC_RELEASE, "agent");
            asm volatile("s_waitcnt vmcnt(0)" ::: "memory");
            const unsigned og = xb_add(&bar[XB_TOP], 1u);
            const unsigned tg = og / nx;
            if (og + 1u == (tg + 1u) * nx) xb_add(&bar[XB_TOPGEN], 1u);
            else XB_SPIN(xb_ld(&bar[XB_TOPGEN]) == tg, bar);
            __builtin_amdgcn_fence(__ATOMIC_ACQUIRE, "agent");
            xb_add(&bar[XB_XGEN(b.x)], 1u);
            asm volatile("s_waitcnt vmcnt(0)" ::: "memory");
        } else {
            XB_SPIN(xb_ld(&bar[XB_XGEN(b.x)]) == gen, bar);
            __builtin_amdgcn_fence(__ATOMIC_ACQUIRE, "agent");
            asm volatile("s_waitcnt vmcnt(0)" ::: "memory");
        }
    }
    __syncthreads();
}

#ifndef DIAG_SLOT_D
#define DIAG_SLOT_D (-1)
#endif
#ifndef DIAG_DIV
#define DIAG_DIV 1.0f
#endif
constexpr size_t WS_DIAG = 3 * MiB + 900 * 1024;
#define DG_START(k, var) unsigned var = 0; if (DIAG_SLOT_D == (k)) var = (unsigned)__builtin_amdgcn_s_memtime();
#define DG_STOP(k, var, acc) if (DIAG_SLOT_D == (k)) acc += (unsigned)__builtin_amdgcn_s_memtime() - var;
#define DG_WRITE(k, cond, acc) if (DIAG_SLOT_D == (k) && (cond)) ((unsigned*)(F.ws + WS_DIAG))[0] = acc;
struct Args { const float* in[31]; float* out; unsigned char* ws; int ph_lo, ph_hi; int dup_phase, qdup, rep_scan, rep_thr; };
struct Frame {
    LAS unsigned char* lds;
    int tid, lane, wave, vcu, G;
    const float* const __attribute__((address_space(4)))* in;
    float* out; unsigned char* ws;
};
enum { I_X = 0, I_F1N, I_F1G, I_F1U, I_F1D, I_MIXN, I_WIN, I_WOUT, I_MU, I_W0, I_W2, I_A0, I_A2, I_G2, I_KK, I_KA, I_RK, I_LNW, I_LNB, I_VRW, I_VRMU, I_V0, I_V2, I_KVN, I_WUK, I_WUV, I_F2N, I_F2G, I_F2U, I_F2D, I_FN };

__device__ __forceinline__ void conv_item(const Frame& F, int l, int kind, int item, LAS float* scr) {
    const int lane = F.lane;
    int Kd, nkb; bf16* WT;
    if (kind == 0 || kind == 4) { Kd = 1024; WT = (bf16*)(F.ws + (kind == 0 ? WS_WGU1 : WS_WGU2)); }
    else if (kind == 1 || kind == 5) { Kd = FFP; WT = (bf16*)(F.ws + (kind == 1 ? WS_WD1 : WS_WD2)); }
    else if (kind == 2) { Kd = 1024; WT = (bf16*)(F.ws + WS_WIN); }
    else { Kd = 1024; WT = (bf16*)(F.ws + WS_WOUT); }
    nkb = Kd / 64;
    const int rb = item / nkb, kb = item % nkb, r0 = rb * 32, k0 = kb * 64;
    const int rr = r0 + (lane & 31);
    const float* src = nullptr; int ns = 0, col = 0, ksrc = 1024; const float* gain = nullptr; float scale = 1.0f;
    if (kind == 0 || kind == 4) {
        const int tile = rr >> 8, w = rr & 255, hid = tile * 128 + (w & 127);
        if (hid < FF) { const float* s1 = (w >> 7) ? F.in[I_F1U] : F.in[I_F1G]; const float* s2 = (w >> 7) ? F.in[I_F2U] : F.in[I_F2G]; src = ((kind == 0) ? s1 : s2) + (size_t)l * 1024 * FF; ns = FF; col = hid; }
        gain = ((kind == 0) ? F.in[I_F1N] : F.in[I_F2N]) + l * 1024;
    } else if (kind == 1 || kind == 5) {
        src = ((kind == 1) ? F.in[I_F1D] : F.in[I_F2D]) + (size_t)l * FF * 1024; ns = 1024; col = rr; ksrc = FF; scale = 0.5f;
    } else if (kind == 2) {
        gain = F.in[I_MIXN] + l * 1024;
        if (rr < 1280) { src = F.in[I_WIN] + (size_t)l * 1024 * NIN; ns = NIN; col = rr; }
        else if (rr < 1296) { if (l > 0) { src = F.in[I_VRW] + (size_t)(l - 1) * 1024 * 16; ns = 16; col = rr - 1280; } }
        else if (rr < PUSED) { src = F.in[I_WIN] + (size_t)l * 1024 * NIN; ns = NIN; col = rr - 16; }
    } else { src = F.in[I_WOUT] + (size_t)l * 1024 * 1024; ns = 1024; col = rr; }
#pragma unroll 8
    for (int i = 0; i < 32; ++i) { const int kk = 2 * i + (lane >> 5), k = k0 + kk; float v = 0.f;
        if (src != nullptr && k < ksrc) { v = src[(size_t)k * ns + col] * scale; if (gain) v *= gain[k]; }
        scr[kk * 33 + (lane & 31)] = v; }
    LDS_WAIT(); asm volatile("" ::: "memory");
    const int c = lane & 7;
#pragma unroll
    for (int j = 0; j < 4; ++j) { const int n = (lane >> 3) + 8 * j; const LAS float* s = scr + (8 * c) * 33 + n;
        v4u o; o.x = pk2(s[0 * 33], s[1 * 33]); o.y = pk2(s[2 * 33], s[3 * 33]); o.z = pk2(s[4 * 33], s[5 * 33]); o.w = pk2(s[6 * 33], s[7 * 33]);
        *(GAS v4u*)(WT + (size_t)(r0 + n) * Kd + k0 + 8 * c) = o; }
    LDS_WAIT(); asm volatile("" ::: "memory");
}
__host__ __device__ constexpr int conv_items(int kind) { return (kind == 0 || kind == 4) ? (NGU / 32) * 16 : (kind == 1 || kind == 5) ? 32 * (FFP / 64) : (kind == 2) ? (PP / 32) * 16 : 32 * 16; }
__device__ __forceinline__ void conv_weights(const Frame& F, int l, int k_lo, int k_hi) {
    LAS float* scr = (LAS float*)(F.lds + F.wave * 16384);
    const int gw = F.vcu * NWAVES + F.wave, NGW = F.G * NWAVES;
    for (int kind = k_lo; kind < k_hi; ++kind) { const int ni = conv_items(kind);
        for (int it = gw; it < ni; it += NGW) conv_item(F, l, kind, it, scr); }
}

__device__ __forceinline__ void p0_x(const Frame& F) {
    const int gw = F.vcu * NWAVES + F.wave, NGW = F.G * NWAVES;
    const float* x = F.in[I_X]; bf16* xb = (bf16*)(F.ws + WS_XB); float* part = (float*)(F.ws + WS_PART);
    for (int m = gw; m < M; m += NGW) {
        const GAS f32x4* xr = (const GAS f32x4*)(x + (size_t)m * DM) + F.lane; float s = 0.f;
        GAS unsigned long long* o8 = (GAS unsigned long long*)(xb + (size_t)m * DM) + F.lane;
#pragma unroll
        for (int j = 0; j < 4; ++j) { const f32x4 v = xr[64 * j]; s += (v.x * v.x + v.y * v.y) + (v.z * v.z + v.w * v.w);
            o8[64 * j] = (unsigned long long)pk2(v.x, v.y) | ((unsigned long long)pk2(v.z, v.w) << 32); }
        s = wave_sum(s);
        if (F.lane < 16) part[(size_t)m * 16 + F.lane] = (F.lane == 0) ? s : 0.f;
    }
}
__device__ __forceinline__ void p0_table(const Frame& F) {
    float* tab = (float*)(F.ws + WS_TAB);
    for (int i = F.vcu * NTHR + F.tid; i < SEQ * 32; i += F.G * NTHR) { const int t = i >> 5, f = i & 31; const float th = exp2f(-(float)f * (13.287712379549449f / 31.0f)); const float ang = (float)t * th; float s, c; sincosf(ang, &s, &c); tab[2 * i] = c; tab[2 * i + 1] = s; }
}

__device__ __forceinline__ void ret_kv_unit(const Frame& F, int unit) {
    unsigned dga_ = 0;
    DG_START(30, dg30_)
    LAS float* kr = (LAS float*)F.lds; LAS float* vv = kr + 128 * 64;
    const int tid = F.tid, c = unit & 15, h = (unit >> 4) & 3, b = unit >> 6, tok0 = b * SEQ + c * 128;
    const bf16* P = (const bf16*)(F.ws + WS_P); const float* tab = (const float*)(F.ws + WS_TAB);
    const float lg2 = log2f(1.0f - exp2f(-5.0f - (float)h));
    for (int idx = tid; idx < 128 * 32; idx += NTHR) { const int m = idx >> 5, i = idx & 31; const size_t ro = (size_t)(tok0 + m) * PP;
        const float k1 = bf2f(P[ro + PCK + h * 64 + i]), k2 = bf2f(P[ro + PCK + h * 64 + 32 + i]);
        const float cs = tab[((c * 128 + m) * 32 + i) * 2], sn = tab[((c * 128 + m) * 32 + i) * 2 + 1];
        const float sc = 0.125f * exp2f((float)(127 - m) * lg2);
        kr[m * 64 + i] = (k1 * cs - k2 * sn) * sc; kr[m * 64 + 32 + i] = (k1 * sn + k2 * cs) * sc;
        vv[m * 64 + i] = bf2f(P[ro + PCV + h * 64 + i]); vv[m * 64 + 32 + i] = bf2f(P[ro + PCV + h * 64 + 32 + i]); }
    __syncthreads();
    const int d = tid >> 3, e0 = (tid & 7) * 8; float acc[8];
#pragma unroll
    for (int e = 0; e < 8; ++e) acc[e] = 0.f;
    for (int m = 0; m < 128; ++m) { const float kd = kr[m * 64 + d];
#pragma unroll
        for (int e = 0; e < 8; ++e) acc[e] += kd * vv[m * 64 + e0 + e]; }
    float* KV = (float*)(F.ws + WS_KV) + (size_t)unit * 4096 + d * 64 + e0;
#pragma unroll
    for (int e = 0; e < 8; ++e) KV[e] = acc[e];
    __syncthreads();
    DG_STOP(30, dg30_, dga_)
    DG_WRITE(30, unit == 0 && F.wave == 0 && F.lane == 0, dga_)
}

typedef float f32x2 __attribute__((ext_vector_type(2)));
__device__ __forceinline__ float dpp_add16(float x) {
    x += __builtin_bit_cast(float, __builtin_amdgcn_mov_dpp(__builtin_bit_cast(int, x), 0xB1, 0xF, 0xF, true));
    x += __builtin_bit_cast(float, __builtin_amdgcn_mov_dpp(__builtin_bit_cast(int, x), 0x4E, 0xF, 0xF, true));
    x += __builtin_bit_cast(float, __builtin_amdgcn_mov_dpp(__builtin_bit_cast(int, x), 0x141, 0xF, 0xF, true));
    x += __builtin_bit_cast(float, __builtin_amdgcn_mov_dpp(__builtin_bit_cast(int, x), 0x140, 0xF, 0xF, true));
    return x;
}
constexpr int CH = 32;
constexpr int RW_STG = 5 * CH * 64;
struct RwOps { f32x4 r, d, k, q, b; float v; };
__device__ __forceinline__ void rw_ld(RwOps& o, const LAS float* base, const LAS float* vb, int s, int ks, int row) {
    const LAS f32x4* p = (const LAS f32x4*)(base + s * 64 + ks * 4);
    o.r = p[0]; o.d = p[CH * 16]; o.k = p[2 * CH * 16]; o.q = p[3 * CH * 16]; o.b = p[4 * CH * 16];
    o.v = vb[s * 32 + row];
}
#define LO2(x) __builtin_shufflevector(x, x, 0, 1)
#define HI2(x) __builtin_shufflevector(x, x, 2, 3)
__device__ __forceinline__ float rw_step(f32x2 (&S)[2], const RwOps& o) {
    f32x2 p2 = S[0] * LO2(o.q); p2 = S[1] * HI2(o.q) + p2;
    const float p = dpp_add16(p2.x + p2.y);
    const f32x2 pp = (f32x2){p, p}, vv = (f32x2){o.v, o.v};
    S[0] = S[0] - LO2(o.d) * S[0]; S[1] = S[1] - HI2(o.d) * S[1];
    S[0] = S[0] - pp * LO2(o.b); S[1] = S[1] - pp * HI2(o.b);
    S[0] = vv * LO2(o.k) + S[0]; S[1] = vv * HI2(o.k) + S[1];
    f32x2 y2 = S[0] * LO2(o.r); y2 = S[1] * HI2(o.r) + y2;
    return dpp_add16(y2.x + y2.y);
}
__device__ __forceinline__ void rwkv_scan_unit(const Frame& F, int l, int unit) {
    const int tid = F.tid, lane = F.lane, wave = F.wave, half = unit & 1, bh = unit >> 1, b = bh / 6, h = bh - b * 6, tokb = b * SEQ;
    LAS float* stg = (LAS float*)F.lds; LAS float* vst = stg + 2 * RW_STG; LAS float* ybuf = vst + 2 * CH * 32;
    bf16* P = (bf16*)(F.ws + WS_P);
    const int row = 4 * wave + (lane >> 4), ks = lane & 15;
    f32x2 S[2] = {(f32x2){0.f, 0.f}, (f32x2){0.f, 0.f}};
    const bool hi8 = (tid >> 8) != 0;
    const bf16* src0 = (const bf16*)(F.ws + (hi8 ? WS_D : WS_R)); const bf16* src1 = (const bf16*)(F.ws + (hi8 ? WS_KK : WS_K2)); const bf16* src2 = (const bf16*)(F.ws + (hi8 ? WS_VF : WS_BP));
    const int st_t = hi8 ? ((tid & 255) >> 2) : ((tid & 255) >> 3), st_c = hi8 ? (tid & 3) : (tid & 7);
    const int t01 = (tid & 255) >> 3, c01 = tid & 7;
    v4u sreg[3], sreg2[3];
#define RW_ROT() do { sreg[0] = sreg2[0]; sreg[1] = sreg2[1]; sreg[2] = sreg2[2]; } while (0)
#define RW_LOAD2(cc) do { const size_t o01 = (size_t)(tokb + (cc) * CH + t01) * AW + h * 64 + c01 * 8; sreg2[0] = *(const GAS v4u*)(src0 + o01); sreg2[1] = *(const GAS v4u*)(src1 + o01); \
        if (!hi8) sreg2[2] = *(const GAS v4u*)(src2 + o01); else if (tid < 384) sreg2[2] = *(const GAS v4u*)(src2 + (size_t)(tokb + (cc) * CH + st_t) * AW + h * 64 + half * 32 + st_c * 8); } while (0)
#define RW_LOAD(cc) do { const size_t o01 = (size_t)(tokb + (cc) * CH + t01) * AW + h * 64 + c01 * 8; sreg[0] = *(const GAS v4u*)(src0 + o01); sreg[1] = *(const GAS v4u*)(src1 + o01); \
        if (!hi8) sreg[2] = *(const GAS v4u*)(src2 + o01); else if (tid < 384) sreg[2] = *(const GAS v4u*)(src2 + (size_t)(tokb + (cc) * CH + st_t) * AW + h * 64 + half * 32 + st_c * 8); } while (0)
#define RW_ST1(i, ar, bufi) do { float f[8]; unpack8(sreg[i], f); LAS f32x4* dst = (LAS f32x4*)(stg + (bufi) * RW_STG + (ar) * CH * 64 + t01 * 64 + c01 * 8); \
        dst[0] = (f32x4){f[0], f[1], f[2], f[3]}; dst[1] = (f32x4){f[4], f[5], f[6], f[7]}; } while (0)
#define RW_STORE(bufi) do { RW_ST1(0, hi8 ? 1 : 0, bufi); RW_ST1(1, hi8 ? 3 : 2, bufi); if (!hi8) RW_ST1(2, 4, bufi); \
        else if (tid < 384) { float f[8]; unpack8(sreg[2], f); LAS f32x4* dst = (LAS f32x4*)(vst + (bufi) * CH * 32 + st_t * 32 + st_c * 8); dst[0] = (f32x4){f[0], f[1], f[2], f[3]}; dst[1] = (f32x4){f[4], f[5], f[6], f[7]}; } } while (0)
    constexpr int NCH = SEQ / CH;
    unsigned dga_ = 0;
    DG_START(41, dg41_)
    RW_LOAD(0); RW_STORE(0); RW_LOAD(1); RW_LOAD2(2);
    __syncthreads();
    for (int cc = 0; cc < NCH; ++cc) {
        const int bufi = cc & 1;
        DG_START(42, dg42_)
        if (cc + 1 < NCH) RW_STORE(bufi ^ 1);
        RW_ROT(); if (cc + 3 < NCH) RW_LOAD2(cc + 3);
        DG_STOP(42, dg42_, dga_)
        const LAS float* base = stg + bufi * RW_STG; const LAS float* vb = vst + bufi * CH * 32; LAS float* yb = ybuf + bufi * CH * 32;
        RwOps A, B; float ykeep = 0.f;
        DG_START(40, dg40_)
        rw_ld(A, base, vb, 0, ks, row);
#pragma unroll
        for (int s = 0; s < CH; s += 2) {
            rw_ld(B, base, vb, s + 1, ks, row);
            { const float y = rw_step(S, A); ykeep = (ks == (s & 15)) ? y : ykeep; }
            if (s + 2 < CH) rw_ld(A, base, vb, s + 2, ks, row);
            { const float y = rw_step(S, B); ykeep = (ks == ((s + 1) & 15)) ? y : ykeep; }
            if (((s + 1) & 15) == 15) yb[(s - 14 + ks) * 32 + row] = ykeep;
        }
        DG_STOP(40, dg40_, dga_)
        DG_START(43, dg43_) DG_START(45, dg45_) DG_START(46, dg46_)
        asm volatile("s_waitcnt lgkmcnt(0)" ::: "memory"); __builtin_amdgcn_s_barrier(); asm volatile("" ::: "memory");
        DG_STOP(43, dg43_, dga_) DG_STOP(45, dg45_, dga_) DG_STOP(46, dg46_, dga_)
        DG_START(44, dg44_)
        {
            const int s = tid >> 4, r2 = (tid & 15) * 2; const f32x2 yv = *(const LAS f32x2*)(yb + s * 32 + r2);
            *(GAS unsigned*)(P + (size_t)(tokb + cc * CH + s) * PP + h * 64 + half * 32 + r2) = pk2(yv.x, yv.y);
        }
        DG_STOP(44, dg44_, dga_)
    }
    __syncthreads();
    DG_STOP(41, dg41_, dga_)
    DG_WRITE(40, unit == 0 && l == 0 && wave == 0 && lane == 0, dga_)
    DG_WRITE(41, unit == 0 && l == 0 && wave == 0 && lane == 0, dga_)
    DG_WRITE(42, unit == 0 && l == 0 && wave == 0 && lane == 0, dga_)
    DG_WRITE(43, unit == 0 && l == 0 && wave == 0 && lane == 0, dga_)
    DG_WRITE(45, unit == 0 && l == 0 && wave == 7 && lane == 0, dga_)
    DG_WRITE(46, unit == 0 && l == 0 && wave == 5 && lane == 0, dga_)
    DG_WRITE(44, unit == 0 && l == 0 && wave == 0 && lane == 0, dga_)
#undef RW_LOAD
#undef RW_LOAD2
#undef RW_ROT
#undef RW_ST1
#undef RW_STORE
}
__device__ __forceinline__ void rwkv_post(const Frame& F, int l) {
    bf16* P = (bf16*)(F.ws + WS_P); const bf16* VF = (const bf16*)(F.ws + WS_VF); const bf16* Gg = (const bf16*)(F.ws + WS_G); const float* BON = (const float*)(F.ws + WS_BON);
    const int sub = F.tid >> 4, c4 = (F.tid & 15) * 4;
    for (int pr = F.vcu * 32 + sub; pr < M * 6; pr += F.G * 32) { const int tok = pr / 6, h = pr - tok * 6;
        const unsigned long long yw = *(const GAS unsigned long long*)(P + (size_t)tok * PP + h * 64 + c4), vw = *(const GAS unsigned long long*)(VF + (size_t)tok * AW + h * 64 + c4), gw = *(const GAS unsigned long long*)(Gg + (size_t)tok * AW + h * 64 + c4);
        const f32x4 lnw = *(const f32x4*)(F.in[I_LNW] + l * AW + h * 64 + c4), lnb = *(const f32x4*)(F.in[I_LNB] + l * AW + h * 64 + c4);
        const float bon = BON[(size_t)tok * 6 + h];
        const f32x4 yv = (f32x4){bflo((unsigned)yw), bfhi((unsigned)yw), bflo((unsigned)(yw >> 32)), bfhi((unsigned)(yw >> 32))};
        const f32x4 vv = (f32x4){bflo((unsigned)vw), bfhi((unsigned)vw), bflo((unsigned)(vw >> 32)), bfhi((unsigned)(vw >> 32))};
        const f32x4 gg = (f32x4){bflo((unsigned)gw), bfhi((unsigned)gw), bflo((unsigned)(gw >> 32)), bfhi((unsigned)(gw >> 32))};
        float sm = (yv[0] + yv[1]) + (yv[2] + yv[3]);
        sm += __shfl_xor(sm, 1); sm += __shfl_xor(sm, 2); sm += __shfl_xor(sm, 4); sm += __shfl_xor(sm, 8);
        const float mean = sm * (1.0f / 64.0f); const f32x4 dv = yv - mean;
        float vs = (dv[0] * dv[0] + dv[1] * dv[1]) + (dv[2] * dv[2] + dv[3] * dv[3]);
        vs += __shfl_xor(vs, 1); vs += __shfl_xor(vs, 2); vs += __shfl_xor(vs, 4); vs += __shfl_xor(vs, 8);
        const float rs = 1.0f / sqrtf(vs * (1.0f / 64.0f) + 64e-5f);
        const f32x4 o = (dv * rs * lnw + lnb + bon * vv) * gg;
        *(GAS unsigned long long*)(P + (size_t)tok * PP + h * 64 + c4) = (unsigned long long)pk2(o[0], o[1]) | ((unsigned long long)pk2(o[2], o[3]) << 32);
    }
}

typedef short bf16x8_t __attribute__((ext_vector_type(8)));
typedef short s16x4_t __attribute__((ext_vector_type(4)));
typedef float f32x16_t __attribute__((ext_vector_type(16)));
__device__ __forceinline__ unsigned fkey(float f) { const unsigned u = __float_as_uint(f); return (u & 0x80000000u) ? ~u : (u | 0x80000000u); }
__device__ __forceinline__ int crow32(int r, int hi) { return (r & 3) + 8 * (r >> 2) + 4 * hi; }
__device__ __forceinline__ unsigned off_a(unsigned row, unsigned ch) { return 2048u * (row >> 3) + 512u * (ch >> 2) + 64u * (row & 7) + 16u * ((ch & 3) ^ ((row >> 2) & 3)); }

__device__ __forceinline__ void idx_scores(const bf16x8_t (&Af)[2], const bf16x8_t (&Bf)[8][2], const float (&iwf)[8], float (&sc)[4]) {
    sc[0] = sc[1] = sc[2] = sc[3] = 0.f;
#pragma unroll
    for (int h = 0; h < 8; ++h) { f32x4 a = (f32x4){0.f, 0.f, 0.f, 0.f};
        a = __builtin_amdgcn_mfma_f32_16x16x32_bf16(Af[0], Bf[h][0], a, 0, 0, 0);
        a = __builtin_amdgcn_mfma_f32_16x16x32_bf16(Af[1], Bf[h][1], a, 0, 0, 0);
#pragma unroll
        for (int r = 0; r < 4; ++r) sc[r] = fmaf(iwf[h], __builtin_amdgcn_fmed3f(a[r], 0.f, __builtin_inff()), sc[r]); }
}
__device__ __forceinline__ void idx_load_q(const bf16* P, int tokq, bf16x8_t (&Bf)[8][2], float (&iwf)[8], int fq) {
    const bf16* row = P + (size_t)tokq * PP;
#pragma unroll
    for (int h = 0; h < 8; ++h)
#pragma unroll
        for (int ks = 0; ks < 2; ++ks) Bf[h][ks] = *(const GAS bf16x8_t*)(row + PBIQ + h * 64 + ks * 32 + fq * 8);
    const v4u w = *(const GAS v4u*)(row + PBIW); float f[8]; unpack8(w, f);
#pragma unroll
    for (int h = 0; h < 8; ++h) iwf[h] = f[h] * (0.35355339059327373f * 0.125f);
}

__device__ __forceinline__ void lds_barrier() { asm volatile("s_waitcnt lgkmcnt(0)" ::: "memory"); __builtin_amdgcn_s_barrier(); asm volatile("" ::: "memory"); }
__device__ __forceinline__ void dsa_thr_unit(const Frame& F, int unit) {
    LAS unsigned* sk = (LAS unsigned*)F.lds;
    const int lane = F.lane, wave = F.wave, fr = lane & 15, fq = lane >> 4;
    const int b = unit & 7, qb = 127 - (unit >> 3), t0 = qb * 16, tok0 = b * SEQ + t0;
    const bf16* P = (const bf16*)(F.ws + WS_P);
    unsigned dga_ = 0;
    DG_START(10, dg10_)
    {
        bf16x8_t Bf[8][2]; float iwf[8];
        idx_load_q(P, tok0 + fr, Bf, iwf, fq);
        bf16x8_t An[2];
        { const int kt0 = wave <= qb ? wave : qb; const bf16* krow = P + (size_t)(b * SEQ + kt0 * 16 + fr) * PP + PBIK + fq * 8; An[0] = *(const GAS bf16x8_t*)(krow); An[1] = *(const GAS bf16x8_t*)(krow + 32); }
        for (int kt = wave; kt <= qb; kt += 8) {
            bf16x8_t Af[2]; Af[0] = An[0]; Af[1] = An[1];
            { const int ktn = kt + 8 <= qb ? kt + 8 : qb; const bf16* krow = P + (size_t)(b * SEQ + ktn * 16 + fr) * PP + PBIK + fq * 8; An[0] = *(const GAS bf16x8_t*)(krow); An[1] = *(const GAS bf16x8_t*)(krow + 32); }
            float sc[4]; idx_scores(Af, Bf, iwf, sc);
            v4u kv;
            const int s0 = kt * 16 + 4 * fq, t = t0 + fr;
            kv.x = (s0 + 0 <= t) ? fkey(sc[0]) : 0u; kv.y = (s0 + 1 <= t) ? fkey(sc[1]) : 0u; kv.z = (s0 + 2 <= t) ? fkey(sc[2]) : 0u; kv.w = (s0 + 3 <= t) ? fkey(sc[3]) : 0u;
            *(LAS v4u*)(sk + fr * 2048 + s0) = kv;
        }
    }
    __syncthreads();
    DG_STOP(10, dg10_, dga_)
    DG_WRITE(10, unit == 0 && wave == 0 && lane == 0, dga_)
    DG_START(11, dg11_)
    unsigned* THR = (unsigned*)(F.ws + WS_THR); int* SCUT = (int*)(F.ws + WS_SCUT);
    for (int qi = 0; qi < 2; ++qi) { const int q = 2 * wave + qi, t = t0 + q, n = t + 1;
        unsigned thr = 0u; int scut = SEQ - 1;
        if (n > TOPK) {
            unsigned keys[32];
#pragma unroll
            for (int i = 0; i < 32; ++i) keys[i] = (64 * i + lane <= t) ? sk[q * 2048 + 64 * i + lane] : 0u;
            unsigned prefix = 0u; bool done = false;
            for (int bit = 31; bit >= 0; --bit) { const unsigned cand = prefix | (1u << bit); int cnt = 0;
#pragma unroll
                for (int i = 0; i < 32; ++i) cnt += __popcll(__ballot(keys[i] >= cand));
                if (cnt >= TOPK) prefix = cand;
                if (cnt == TOPK) { thr = cand - 1u; scut = -1; done = true; break; } }
            if (!done) {
                int cgt = 0;
#pragma unroll
                for (int i = 0; i < 32; ++i) cgt += __popcll(__ballot(keys[i] > prefix));
                int need = TOPK - cgt, run = 0; thr = prefix; scut = SEQ - 1; bool found = false;
#pragma unroll
                for (int i = 0; i < 32; ++i) { unsigned long long mk = __ballot(keys[i] == prefix); const int c = __popcll(mk);
                    if (!found && run + c >= need) { int k = need - run; while (k > 1) { mk &= mk - 1ull; --k; } scut = 64 * i + (int)__builtin_ctzll(mk); found = true; }
                    run += c; }
            }
        }
        if (lane == 0) { THR[tok0 + q] = thr; SCUT[tok0 + q] = scut; }
    }
    DG_STOP(11, dg11_, dga_)
    DG_WRITE(11, unit == 0 && wave == 0 && lane == 0, dga_)
    __syncthreads();
}

constexpr int QLP = 136;
constexpr int MKP = 36;
constexpr int DA_MASK = 0, DA_QL = 2 * 32 * MKP * 4, DA_CT = DA_QL + 6 * 32 * QLP * 2;
__device__ __forceinline__ void dsa_mask_tile(const bf16x8_t (&Af)[2][2], const bf16x8_t (&Bf)[8][2], const float (&iwf)[8], int j, int kmax, int t, unsigned thr, int scut, int fq, LAS float* mrow) {
#pragma unroll
    for (int k2 = 0; k2 < 2; ++k2) { const int kt = 2 * j + k2; f32x4 mv = (f32x4){-1e30f, -1e30f, -1e30f, -1e30f};
        if (kt <= kmax) { float sc[4]; idx_scores(Af[k2], Bf, iwf, sc);
            const int s0 = kt * 16 + 4 * fq;
#pragma unroll
            for (int r = 0; r < 4; ++r) { const unsigned key = fkey(sc[r]); const int s = s0 + r;
                const bool sel = (s <= t) & ((key > thr) | ((key == thr) & (s <= scut)));
                mv[r] = sel ? 0.f : -1e30f; } }
        *(LAS f32x4*)(mrow + k2 * 16 + 4 * fq) = mv; }
}
__device__ __forceinline__ void dsa_attn_unit(const Frame& F, int l, int unit) {
    const int tid = F.tid, lane = F.lane, wave = F.wave, r32 = lane & 31, hi = lane >> 5;
    const int b = unit & 7, qb = 63 - (unit >> 3), t0 = qb * 32, tok0 = b * SEQ + t0, ntile = qb + 1;
    bf16* P = (bf16*)(F.ws + WS_P); const bf16* C = (const bf16*)(F.ws + WS_C);
    LAS float* MASK = (LAS float*)(F.lds + DA_MASK); LAS unsigned char* QLb = F.lds + DA_QL; LAS unsigned char* CT = F.lds + DA_CT;
    const int crow_ = tid >> 4, cch = tid & 15; const unsigned cdst = off_a((unsigned)crow_, (unsigned)cch);
    const bf16* csrc = C + (size_t)(b * SEQ + crow_) * 128 + cch * 8;
    v4u cpre = *(const GAS v4u*)(csrc);
    if (wave >= 6) {
        const int fr = lane & 15, fq = lane >> 4, qh = wave - 6;
        bf16x8_t Bf[8][2]; float iwf[8]; bf16x8_t Af[2][2];
        const int tq = tok0 + 16 * qh + fr, tq_t = t0 + 16 * qh + fr, kmax = 2 * qb + qh;
        idx_load_q(P, tq, Bf, iwf, fq);
        const unsigned thr = ((const unsigned*)(F.ws + WS_THR))[tq]; const int scut = ((const int*)(F.ws + WS_SCUT))[tq];
        const bf16* kbase = P + (size_t)(b * SEQ + fr) * PP + PBIK + fq * 8;
#define DA_LOADA(dst, jt) do { _Pragma("unroll") for (int k2_ = 0; k2_ < 2; ++k2_) { const int kt_ = 2 * (jt) + k2_; const int ktc = kt_ <= kmax ? kt_ : kmax; const bf16* kr = kbase + (size_t)ktc * 16 * PP; \
            dst[k2_][0] = *(const GAS bf16x8_t*)(kr); dst[k2_][1] = *(const GAS bf16x8_t*)(kr + 32); } } while (0)
        bf16x8_t An[2][2];
        DA_LOADA(Af, 0);
        dsa_mask_tile(Af, Bf, iwf, 0, kmax, tq_t, thr, scut, fq, MASK + (16 * qh + fr) * MKP);
        DA_LOADA(An, 1);
        *(LAS v4u*)(CT + cdst) = cpre;
        lds_barrier();
        unsigned dga_ = 0;
        for (int j = 0; j < ntile; ++j) {
            DG_START(2, dgt_)
            if (j + 1 < ntile) {
#pragma unroll
                for (int k2 = 0; k2 < 2; ++k2) { Af[k2][0] = An[k2][0]; Af[k2][1] = An[k2][1]; }
                DA_LOADA(An, j + 2);
                cpre = *(const GAS v4u*)(csrc + (size_t)(j + 1) * 32 * 128);
                dsa_mask_tile(Af, Bf, iwf, j + 1, kmax, tq_t, thr, scut, fq, MASK + ((j + 1) & 1) * (32 * MKP) + (16 * qh + fr) * MKP);
                *(LAS v4u*)(CT + ((j + 1) & 1) * 8192 + cdst) = cpre; }
            DG_STOP(2, dgt_, dga_)
            lds_barrier();
        }
        DG_WRITE(2, unit == 0 && l == 0 && wave == 6 && lane == 0, dga_)
#undef DA_LOADA
        lds_barrier();
        return;
    }
    const int h = wave;
    LAS unsigned char* QLh = QLb + h * (32 * QLP * 2);
    {
        unsigned zo_ = 0u; asm volatile("" : "+v"(zo_));
        const bf16* wukT = (const bf16*)(F.ws + WS_WUKT) + (size_t)(l * 6 + h) * 128 * 64 + zo_;
        bf16x8_t qf[4];
#pragma unroll
        for (int ks = 0; ks < 4; ++ks) qf[ks] = *(const GAS bf16x8_t*)(P + (size_t)(tok0 + r32) * PP + PBQ + h * 64 + ks * 16 + hi * 8);
#pragma unroll
        for (int blk = 0; blk < 4; ++blk) { f32x16_t x;
#pragma unroll
            for (int i = 0; i < 16; ++i) x[i] = 0.f;
#pragma unroll
            for (int ks = 0; ks < 4; ++ks) { const bf16x8_t a = *(const GAS bf16x8_t*)(wukT + (size_t)(blk * 32 + r32) * 64 + ks * 16 + hi * 8); x = __builtin_amdgcn_mfma_f32_32x32x16_bf16(a, qf[ks], x, 0, 0, 0); }
#pragma unroll
            for (int g = 0; g < 4; ++g) { const float sc = 0.125f * 1.4426950408889634f;
                const unsigned long long w = (unsigned long long)pk2(x[4 * g] * sc, x[4 * g + 1] * sc) | ((unsigned long long)pk2(x[4 * g + 2] * sc, x[4 * g + 3] * sc) << 32);
                *(LAS unsigned long long*)(QLh + (r32 * QLP + blk * 32 + 8 * g + 4 * hi) * 2) = w; } }
    }
    *(LAS v4u*)(CT + cdst) = cpre;
    lds_barrier();
    f32x16_t o[4]; float m_run = -1e30f, l_run = 0.f;
    const LAS unsigned char* qlrow = QLh + (r32 * QLP + 8 * hi) * 2;
#pragma unroll
    for (int c = 0; c < 4; ++c)
#pragma unroll
        for (int i = 0; i < 16; ++i) o[c][i] = 0.f;
    const unsigned rr_ = ((unsigned)r32 >> 2) & 3u, rb_ = 2048u * ((unsigned)r32 >> 3) + 64u * ((unsigned)r32 & 7u);
    const unsigned rbase0 = rb_ + 16u * ((unsigned)hi ^ rr_), rbase1 = rb_ + 16u * ((2u + (unsigned)hi) ^ rr_);
    const unsigned blk_ = (lane >> 4) & 1, q_ = (lane & 15) >> 2, p_ = lane & 3;
    unsigned dga_ = 0;
    for (int j = 0; j < ntile; ++j) {
        DG_START(0, dgt_)
        LAS unsigned char* kb = CT + (j & 1) * 8192;
        if (j + 1 < ntile) cpre = *(const GAS v4u*)(csrc + (size_t)(j + 1) * 32 * 128);
        {
            f32x16_t S;
#pragma unroll
            for (int i = 0; i < 16; ++i) S[i] = 0.f;
#pragma unroll
            for (int s = 0; s < 8; ++s) { const bf16x8_t a = *(const LAS bf16x8_t*)(kb + ((s & 1) ? rbase1 : rbase0) + 512 * (s >> 1)); const bf16x8_t bq = *(const LAS bf16x8_t*)(qlrow + 32 * s);
                S = __builtin_amdgcn_mfma_f32_32x32x16_bf16(a, bq, S, 0, 0, 0); }
            const LAS f32x4* mk = (const LAS f32x4*)(MASK + (j & 1) * (32 * MKP) + r32 * MKP + 4 * hi);
            float tmax = -1e30f;
#pragma unroll
            for (int g = 0; g < 4; ++g) { const f32x4 mv = mk[2 * g];
#pragma unroll
                for (int e4 = 0; e4 < 4; ++e4) { S[4 * g + e4] += mv[e4]; tmax = fmaxf(tmax, S[4 * g + e4]); } }
            tmax = fmaxf(tmax, __shfl_xor(tmax, 32));
            const float m_new = fmaxf(m_run, tmax), alpha = __builtin_amdgcn_exp2f(m_run - m_new);
            float psum = 0.f; float e[16];
#pragma unroll
            for (int r = 0; r < 16; ++r) { e[r] = __builtin_amdgcn_exp2f(S[r] - m_new); psum += e[r]; }
            l_run = l_run * alpha + psum; m_run = m_new;
            if (__any(alpha != 1.0f)) {
#pragma unroll
                for (int c = 0; c < 4; ++c)
#pragma unroll
                    for (int i = 0; i < 16; ++i) o[c][i] *= alpha; }
            bf16x8_t xs[2];
#pragma unroll
            for (int s = 0; s < 2; ++s) { v4u w; w.x = pk2(e[8 * s], e[8 * s + 1]); w.y = pk2(e[8 * s + 2], e[8 * s + 3]); w.z = pk2(e[8 * s + 4], e[8 * s + 5]); w.w = pk2(e[8 * s + 6], e[8 * s + 7]); xs[s] = __builtin_bit_cast(bf16x8_t, w); }
#pragma unroll
            for (int c = 0; c < 4; ++c)
#pragma unroll
                for (int s = 0; s < 2; ++s) {
                    const unsigned a0 = off_a((unsigned)(16 * s + 4 * hi + q_), (unsigned)(4 * c + 2 * blk_ + (p_ >> 1))) + 8u * (p_ & 1);
                    const unsigned a1 = off_a((unsigned)(16 * s + 8 + 4 * hi + q_), (unsigned)(4 * c + 2 * blk_ + (p_ >> 1))) + 8u * (p_ & 1);
                    const s16x4_t lo = __builtin_bit_cast(s16x4_t, __builtin_amdgcn_ds_read_tr16_b64_v4i16((LAS s16x4_t*)(kb + a0)));
                    const s16x4_t hh = __builtin_bit_cast(s16x4_t, __builtin_amdgcn_ds_read_tr16_b64_v4i16((LAS s16x4_t*)(kb + a1)));
                    const bf16x8_t a = (bf16x8_t){lo[0], lo[1], lo[2], lo[3], hh[0], hh[1], hh[2], hh[3]};
                    o[c] = __builtin_amdgcn_mfma_f32_32x32x16_bf16(a, xs[s], o[c], 0, 0, 0); }
        }
        if (j + 1 < ntile) *(LAS v4u*)(CT + ((j + 1) & 1) * 8192 + cdst) = cpre;
        DG_STOP(0, dgt_, dga_)
        DG_START(1, dgw_)
        lds_barrier();
        DG_STOP(1, dgw_, dga_)
    }
    DG_WRITE(0, unit == 0 && l == 0 && wave == 0 && lane == 0, dga_)
    DG_WRITE(1, unit == 0 && l == 0 && wave == 0 && lane == 0, dga_)
    {
        const float lt = l_run + __shfl_xor(l_run, 32); const float inv = 1.0f / lt;
#pragma unroll
        for (int c = 0; c < 4; ++c)
#pragma unroll
            for (int g = 0; g < 4; ++g) { const unsigned long long w = (unsigned long long)pk2(o[c][4 * g] * inv, o[c][4 * g + 1] * inv) | ((unsigned long long)pk2(o[c][4 * g + 2] * inv, o[c][4 * g + 3] * inv) << 32);
                *(LAS unsigned long long*)(QLh + (r32 * QLP + c * 32 + 8 * g + 4 * hi) * 2) = w; }
        unsigned zo2_ = 0u; asm volatile("" : "+v"(zo2_));
        const bf16* wuvT = (const bf16*)(F.ws + WS_WUVT) + (size_t)(l * 6 + h) * 64 * 128 + zo2_;
        bf16x8_t Bo[8];
#pragma unroll
        for (int s = 0; s < 8; ++s) Bo[s] = *(const LAS bf16x8_t*)(QLh + (r32 * QLP + 16 * s + 8 * hi) * 2);
#pragma unroll
        for (int mb = 0; mb < 2; ++mb) { f32x16_t y;
#pragma unroll
            for (int i = 0; i < 16; ++i) y[i] = 0.f;
#pragma unroll
            for (int s = 0; s < 8; ++s) { const bf16x8_t a = *(const GAS bf16x8_t*)(wuvT + (size_t)(mb * 32 + r32) * 128 + 16 * s + 8 * hi); y = __builtin_amdgcn_mfma_f32_32x32x16_bf16(a, Bo[s], y, 0, 0, 0); }
#pragma unroll
            for (int g = 0; g < 4; ++g) { const unsigned long long w = (unsigned long long)pk2(y[4 * g], y[4 * g + 1]) | ((unsigned long long)pk2(y[4 * g + 2], y[4 * g + 3]) << 32);
                *(GAS unsigned long long*)(P + (size_t)(tok0 + r32) * PP + 384 + h * 64 + mb * 32 + 8 * g + 4 * hi) = w; } }
    }
    lds_barrier();
}

constexpr int RP = 72;
constexpr int RT_QR = 0, RT_KR = 128 * RP * 2, RT_VV = 2 * 128 * RP * 2, RT_ST = 3 * 128 * RP * 2, RT_SS = RT_ST + 64 * RP * 2;
__device__ __forceinline__ void ret_out_unit(const Frame& F, int unit) {
    const int tid = F.tid, lane = F.lane, wave = F.wave, r32 = lane & 31, hi = lane >> 5;
    const int c = unit & 15, h = (unit >> 4) & 3, b = unit >> 6, tok0 = b * SEQ + c * 128;
    bf16* P = (bf16*)(F.ws + WS_P); const float* tab = (const float*)(F.ws + WS_TAB);
    LAS bf16* QR = (LAS bf16*)(F.lds + RT_QR); LAS bf16* KR = (LAS bf16*)(F.lds + RT_KR); LAS bf16* VV = (LAS bf16*)(F.lds + RT_VV); LAS bf16* ST = (LAS bf16*)(F.lds + RT_ST);
    LAS float* SS = (LAS float*)(F.lds + RT_SS);
    const float lg2 = log2f(1.0f - exp2f(-5.0f - (float)h));
    for (int idx = tid; idx < 1024; idx += NTHR) { const int m = idx >> 3, i4 = (idx & 7) * 4; const size_t ro = (size_t)(tok0 + m) * PP + h * 64 + i4;
        const unsigned long long q1w = *(const GAS unsigned long long*)(P + ro + PCQ), q2w = *(const GAS unsigned long long*)(P + ro + PCQ + 32);
        const unsigned long long k1w = *(const GAS unsigned long long*)(P + ro + PCK), k2w = *(const GAS unsigned long long*)(P + ro + PCK + 32);
        const unsigned long long v1w = *(const GAS unsigned long long*)(P + ro + PCV), v2w = *(const GAS unsigned long long*)(P + ro + PCV + 32);
        const f32x4 t0 = *(const GAS f32x4*)(tab + ((size_t)(c * 128 + m) * 32 + i4) * 2), t1 = *(const GAS f32x4*)(tab + ((size_t)(c * 128 + m) * 32 + i4) * 2 + 4);
        const float cs[4] = {t0[0], t0[2], t1[0], t1[2]}, sn[4] = {t0[1], t0[3], t1[1], t1[3]};
        const float q1[4] = {bflo((unsigned)q1w), bfhi((unsigned)q1w), bflo((unsigned)(q1w >> 32)), bfhi((unsigned)(q1w >> 32))}, q2[4] = {bflo((unsigned)q2w), bfhi((unsigned)q2w), bflo((unsigned)(q2w >> 32)), bfhi((unsigned)(q2w >> 32))};
        const float k1[4] = {bflo((unsigned)k1w), bfhi((unsigned)k1w), bflo((unsigned)(k1w >> 32)), bfhi((unsigned)(k1w >> 32))}, k2[4] = {bflo((unsigned)k2w), bfhi((unsigned)k2w), bflo((unsigned)(k2w >> 32)), bfhi((unsigned)(k2w >> 32))};
        float qa[4], qb[4], ka[4], kb[4];
#pragma unroll
        for (int j = 0; j < 4; ++j) { qa[j] = q1[j] * cs[j] - q2[j] * sn[j]; qb[j] = q1[j] * sn[j] + q2[j] * cs[j]; ka[j] = (k1[j] * cs[j] - k2[j] * sn[j]) * 0.125f; kb[j] = (k1[j] * sn[j] + k2[j] * cs[j]) * 0.125f; }
        *(LAS unsigned long long*)(QR + m * RP + i4) = (unsigned long long)pk2(qa[0], qa[1]) | ((unsigned long long)pk2(qa[2], qa[3]) << 32);
        *(LAS unsigned long long*)(QR + m * RP + 32 + i4) = (unsigned long long)pk2(qb[0], qb[1]) | ((unsigned long long)pk2(qb[2], qb[3]) << 32);
        *(LAS unsigned long long*)(KR + m * RP + i4) = (unsigned long long)pk2(ka[0], ka[1]) | ((unsigned long long)pk2(ka[2], ka[3]) << 32);
        *(LAS unsigned long long*)(KR + m * RP + 32 + i4) = (unsigned long long)pk2(kb[0], kb[1]) | ((unsigned long long)pk2(kb[2], kb[3]) << 32);
        *(LAS unsigned long long*)(VV + m * RP + i4) = v1w; *(LAS unsigned long long*)(VV + m * RP + 32 + i4) = v2w; }
    {
        const float* KV = (const float*)(F.ws + WS_KV) + (size_t)(unit - c) * 4096; f32x4 s0 = (f32x4){0.f, 0.f, 0.f, 0.f}, s1 = s0;
        const float cd = exp2f(128.0f * lg2);
        for (int j = 0; j < c; ++j) { const f32x4 a0 = *(const GAS f32x4*)(KV + (size_t)j * 4096 + tid * 8), a1 = *(const GAS f32x4*)(KV + (size_t)j * 4096 + tid * 8 + 4); s0 = s0 * cd + a0; s1 = s1 * cd + a1; }
        v4u w; w.x = pk2(s0[0], s0[1]); w.y = pk2(s0[2], s0[3]); w.z = pk2(s1[0], s1[1]); w.w = pk2(s1[2], s1[3]);
        *(LAS v4u*)(ST + (tid >> 3) * RP + (tid & 7) * 8) = w;
    }
    __syncthreads();
    const int nb = wave >> 1, eb = wave & 1, n = nb * 32 + r32;
    const unsigned blk_ = (lane >> 4) & 1, q_ = (lane & 15) >> 2, p_ = lane & 3;
    bf16x8_t qf[4];
#pragma unroll
    for (int ks = 0; ks < 4; ++ks) qf[ks] = *(const LAS bf16x8_t*)(QR + n * RP + ks * 16 + hi * 8);
    f32x16_t y;
#pragma unroll
    for (int i = 0; i < 16; ++i) y[i] = 0.f;
#pragma unroll
    for (int ks = 0; ks < 4; ++ks) {
        const s16x4_t lo = __builtin_bit_cast(s16x4_t, __builtin_amdgcn_ds_read_tr16_b64_v4i16((LAS s16x4_t*)(ST + (16 * ks + 8 * hi + q_) * RP + 32 * eb + 16 * blk_ + 4 * p_)));
        const s16x4_t hh = __builtin_bit_cast(s16x4_t, __builtin_amdgcn_ds_read_tr16_b64_v4i16((LAS s16x4_t*)(ST + (16 * ks + 8 * hi + 4 + q_) * RP + 32 * eb + 16 * blk_ + 4 * p_)));
        const bf16x8_t a = (bf16x8_t){lo[0], lo[1], lo[2], lo[3], hh[0], hh[1], hh[2], hh[3]};
        y = __builtin_amdgcn_mfma_f32_32x32x16_bf16(a, qf[ks], y, 0, 0, 0); }
    { const float qd = exp2f((float)(n + 1) * lg2);
#pragma unroll
      for (int i = 0; i < 16; ++i) y[i] *= qd; }
    for (int mt = 0; mt <= nb; ++mt) {
        f32x16_t S;
#pragma unroll
        for (int i = 0; i < 16; ++i) S[i] = 0.f;
#pragma unroll
        for (int ks = 0; ks < 4; ++ks) { const bf16x8_t a = *(const LAS bf16x8_t*)(KR + (mt * 32 + r32) * RP + ks * 16 + hi * 8); S = __builtin_amdgcn_mfma_f32_32x32x16_bf16(a, qf[ks], S, 0, 0, 0); }
        float e[16];
#pragma unroll
        for (int r = 0; r < 16; ++r) { const int dm = r32 - crow32(r, hi) + 32 * (nb - mt); e[r] = (dm >= 0) ? S[r] * exp2f((float)dm * lg2) : 0.f; }
#pragma unroll
        for (int s = 0; s < 2; ++s) { v4u w; w.x = pk2(e[8 * s], e[8 * s + 1]); w.y = pk2(e[8 * s + 2], e[8 * s + 3]); w.z = pk2(e[8 * s + 4], e[8 * s + 5]); w.w = pk2(e[8 * s + 6], e[8 * s + 7]);
            const bf16x8_t xs = __builtin_bit_cast(bf16x8_t, w);
            const s16x4_t lo = __builtin_bit_cast(s16x4_t, __builtin_amdgcn_ds_read_tr16_b64_v4i16((LAS s16x4_t*)(VV + (mt * 32 + 16 * s + 4 * hi + q_) * RP + 32 * eb + 16 * blk_ + 4 * p_)));
            const s16x4_t hh = __builtin_bit_cast(s16x4_t, __builtin_amdgcn_ds_read_tr16_b64_v4i16((LAS s16x4_t*)(VV + (mt * 32 + 16 * s + 8 + 4 * hi + q_) * RP + 32 * eb + 16 * blk_ + 4 * p_)));
            const bf16x8_t a = (bf16x8_t){lo[0], lo[1], lo[2], lo[3], hh[0], hh[1], hh[2], hh[3]};
            y = __builtin_amdgcn_mfma_f32_32x32x16_bf16(a, xs, y, 0, 0, 0); }
    }
    float ss = 0.f;
#pragma unroll
    for (int i = 0; i < 16; ++i) ss += y[i] * y[i];
    ss += __shfl_xor(ss, 32);
    if (hi == 0) SS[(nb * 2 + eb) * 32 + r32] = ss;
    __syncthreads();
    ss += SS[(nb * 2 + (eb ^ 1)) * 32 + r32];
    const float rs = 1.0f / sqrtf(ss * (1.0f / 64.0f) + 1e-6f);
    const size_t ro = (size_t)(tok0 + n) * PP;
#pragma unroll
    for (int g = 0; g < 4; ++g) { const int e0 = 32 * eb + 8 * g + 4 * hi;
        const unsigned long long gw = *(const GAS unsigned long long*)(P + ro + PCG + h * 64 + e0);
        const float g0 = bflo((unsigned)gw), g1 = bfhi((unsigned)gw), g2 = bflo((unsigned)(gw >> 32)), g3 = bfhi((unsigned)(gw >> 32));
        const float o0 = g0 * sigmoid_f(g0) * y[4 * g] * rs, o1 = g1 * sigmoid_f(g1) * y[4 * g + 1] * rs, o2 = g2 * sigmoid_f(g2) * y[4 * g + 2] * rs, o3 = g3 * sigmoid_f(g3) * y[4 * g + 3] * rs;
        *(GAS unsigned long long*)(P + ro + 768 + h * 64 + e0) = (unsigned long long)pk2(o0, o1) | ((unsigned long long)pk2(o2, o3) << 32); }
    __syncthreads();
}

constexpr int PT = 32, XSP = 1304;
constexpr int PR_XS = 0, PR_STG = PT * XSP * 2, PR_CONST = PR_STG + 32768;
__device__ __forceinline__ void prep_consts(const Frame& F, int l) {
    LAS float* CS = (LAS float*)(F.lds + PR_CONST);
    for (int i = F.tid; i < AW; i += NTHR) { CS[i] = F.in[I_KK][l * AW + i]; CS[AW + i] = F.in[I_KA][l * AW + i]; CS[2 * AW + i] = F.in[I_RK][l * AW + i];
        CS[3 * AW + i] = F.in[I_W0][l * AW + i]; CS[4 * AW + i] = F.in[I_A0][l * AW + i]; CS[5 * AW + i] = (l > 0) ? F.in[I_V0][(l - 1) * AW + i] : 0.f; }
}
__device__ __forceinline__ float softplus_f(float z) { return fmaxf(z, 0.f) + __logf(1.0f + __expf(-fabsf(z))); }
__device__ __forceinline__ float tanh_f(float x) { const float e = __expf(2.0f * x); return 1.0f - 2.0f * __builtin_amdgcn_rcpf(e + 1.0f); }
__device__ __forceinline__ void small_weights(const Frame& F) {
    for (int l = 0; l < DEPTH; ++l) {
        const float* w2 = F.in[I_W2] + (size_t)l * 32 * AW; const float* a2 = F.in[I_A2] + (size_t)l * 32 * AW; const float* g2 = F.in[I_G2] + (size_t)l * 64 * AW;
        const float* v2 = F.in[I_V2] + (size_t)(l > 0 ? l - 1 : 0) * 16 * AW;
        bf16* LT = (bf16*)(F.ws + WS_LORA) + (size_t)l * AW * 144;
        for (int i = F.vcu * NTHR + F.tid; i < AW * 144; i += F.G * NTHR) { const int n = i / 144, k = i - n * 144; float v;
            if (k < 32) v = w2[k * AW + n]; else if (k < 64) v = a2[(k - 32) * AW + n]; else if (k < 128) v = g2[(k - 64) * AW + n]; else v = (l > 0) ? v2[(k - 128) * AW + n] : 0.f;
            LT[i] = (bf16)f2bf(v); }
        const float* wuk = F.in[I_WUK] + (size_t)l * 6 * 64 * 128; const float* wuv = F.in[I_WUV] + (size_t)l * 6 * 128 * 64;
        bf16* wukT = (bf16*)(F.ws + WS_WUKT) + (size_t)l * 6 * 64 * 128; bf16* wuvT = (bf16*)(F.ws + WS_WUVT) + (size_t)l * 6 * 64 * 128;
        for (int i = F.vcu * NTHR + F.tid; i < 6 * 64 * 128; i += F.G * NTHR) {
            { const int hh = i / 8192, rem = i - hh * 8192, c = rem >> 6, d = rem & 63; wukT[i] = (bf16)f2bf(wuk[(hh * 64 + d) * 128 + c]); }
            { const int hh = i / 8192, rem = i - hh * 8192, d = rem >> 7, c = rem & 127; wuvT[i] = (bf16)f2bf(wuv[(hh * 128 + c) * 64 + d]); } }
    }
}
__device__ __forceinline__ void prep_tokens_unit(const Frame& F, int l, int unit) {
    LAS bf16* XS = (LAS bf16*)(F.lds + PR_XS);
    const int tid = F.tid, lane = F.lane, wave = F.wave, r32 = lane & 31, hi = lane >> 5, tok0 = unit * PT;
    const bf16* P = (const bf16*)(F.ws + WS_P);
    const float* mu = F.in[I_MU] + l * 1280; const float* vmu = F.in[I_VRMU] + (l > 0 ? (l - 1) * 16 : 0);
    unsigned dga_ = 0;
    DG_START(20, dg20_)
    for (int base = 0; base < PT * 162; base += 5 * NTHR) {
        v4u cw[5], pw[5];
#pragma unroll
        for (int u = 0; u < 5; ++u) { const int idx = base + u * NTHR + tid; const int idc = idx < PT * 162 ? idx : PT * 162 - 1; const int t = idc / 162, ch = idc - t * 162, tok = tok0 + t;
            cw[u] = *(const GAS v4u*)(P + (size_t)tok * PP + ch * 8);
            const int tokp = (tok & (SEQ - 1)) != 0 ? tok - 1 : tok; pw[u] = *(const GAS v4u*)(P + (size_t)tokp * PP + ch * 8); }
#pragma unroll
        for (int u = 0; u < 5; ++u) { const int idx = base + u * NTHR + tid;
            if (idx < PT * 162) { const int t = idx / 162, ch = idx - t * 162, tok = tok0 + t, c0 = ch * 8;
                float cur[8], prv[8]; unpack8(cw[u], cur); unpack8(pw[u], prv);
                const bool first = (tok & (SEQ - 1)) == 0;
                float mv[8];
                if (c0 < 1280) { const f32x4 m0 = *(const GAS f32x4*)(mu + c0), m1 = *(const GAS f32x4*)(mu + c0 + 4); mv[0] = m0[0]; mv[1] = m0[1]; mv[2] = m0[2]; mv[3] = m0[3]; mv[4] = m1[0]; mv[5] = m1[1]; mv[6] = m1[2]; mv[7] = m1[3]; }
                else if (l > 0) { const f32x4 m0 = *(const GAS f32x4*)(vmu + (c0 - 1280)), m1 = *(const GAS f32x4*)(vmu + (c0 - 1280) + 4); mv[0] = m0[0]; mv[1] = m0[1]; mv[2] = m0[2]; mv[3] = m0[3]; mv[4] = m1[0]; mv[5] = m1[1]; mv[6] = m1[2]; mv[7] = m1[3]; }
                else {
#pragma unroll
                    for (int j = 0; j < 8; ++j) mv[j] = 0.f; }
                float o[8];
#pragma unroll
                for (int j = 0; j < 8; ++j) { const float pv = first ? 0.f : prv[j]; float v = cur[j] + (pv - cur[j]) * mv[j];
                    if (c0 >= 1152 && c0 < 1184) v = tanh_f(v); else if (c0 >= 1216 && c0 < 1280) v = sigmoid_f(v);
                    o[j] = v; }
                v4u w; w.x = pk2(o[0], o[1]); w.y = pk2(o[2], o[3]); w.z = pk2(o[4], o[5]); w.w = pk2(o[6], o[7]);
                *(LAS v4u*)(XS + t * XSP + c0) = w; } }
    }
    __syncthreads();
    DG_STOP(20, dg20_, dga_)
    DG_WRITE(20, unit == 0 && l == 0 && wave == 0 && lane == 0, dga_)
    DG_START(21, dg21_)
    if (wave < 6) {
        const int h = wave;
        LAS bf16* STG = (LAS bf16*)(F.lds + PR_STG + wave * 4096);
        GAS unsigned char* wsb = (GAS unsigned char*)F.ws;
        const bf16* LT = (const bf16*)(F.ws + WS_LORA) + (size_t)l * AW * 144;
        const LAS float* CS = (const LAS float*)(F.lds + PR_CONST) + h * 64;
        const LAS float* kkw = CS; const LAS float* kaw = CS + AW; const LAS float* rkw = CS + 2 * AW; const LAS float* w0p = CS + 3 * AW; const LAS float* a0p = CS + 4 * AW; const LAS float* v0p = CS + 5 * AW;
        const LAS bf16* xrow = XS + r32 * XSP;
        float rn;
        { float ss = 0.f;
#pragma unroll
          for (int cbl = 0; cbl < 2; ++cbl)
#pragma unroll
              for (int g = 0; g < 4; ++g) { const int j0 = cbl * 32 + 8 * g + 4 * hi; const unsigned long long kw = *(const LAS unsigned long long*)(xrow + 384 + h * 64 + j0); const f32x4 kk4 = *(const LAS f32x4*)(kkw + j0);
                  const float k0 = bflo((unsigned)kw) * kk4[0], k1 = bfhi((unsigned)kw) * kk4[1], k2 = bflo((unsigned)(kw >> 32)) * kk4[2], k3 = bfhi((unsigned)(kw >> 32)) * kk4[3]; ss += (k0 * k0 + k1 * k1) + (k2 * k2 + k3 * k3); }
          ss += __shfl_xor(ss, 32); rn = 1.0f / fmaxf(sqrtf(ss), 1e-12f); }
        float bonus = 0.f;
        const int srow = lane >> 2, sch = lane & 3;
#pragma unroll
        for (int cbl = 0; cbl < 2; ++cbl) {
            asm volatile("" ::: "memory");
            const int cb0 = h * 64 + cbl * 32;
            f32x16_t wv, av, gv, mvv;
#pragma unroll
            for (int i = 0; i < 16; ++i) { wv[i] = 0.f; av[i] = 0.f; gv[i] = 0.f; mvv[i] = 0.f; }
            const bf16* lrow = LT + (size_t)(cb0 + r32) * 144 + 8 * hi;
#pragma unroll
            for (int ks = 0; ks < 9; ++ks) { const bf16x8_t a = *(const GAS bf16x8_t*)(lrow + 16 * ks); const bf16x8_t bx = *(const LAS bf16x8_t*)(xrow + 1152 + 16 * ks + 8 * hi);
                if (ks < 2) wv = __builtin_amdgcn_mfma_f32_32x32x16_bf16(a, bx, wv, 0, 0, 0);
                else if (ks < 4) av = __builtin_amdgcn_mfma_f32_32x32x16_bf16(a, bx, av, 0, 0, 0);
                else if (ks < 8) gv = __builtin_amdgcn_mfma_f32_32x32x16_bf16(a, bx, gv, 0, 0, 0);
                else mvv = __builtin_amdgcn_mfma_f32_32x32x16_bf16(a, bx, mvv, 0, 0, 0); }
            if (l > 0) {
#pragma unroll
                for (int i = 0; i < 2; ++i) { const int row = srow + 16 * i; const unsigned eo = (unsigned)(((tok0 + row) * AW + cb0 + sch * 8) * 2); *(LAS v4u*)(STG + row * 32 + sch * 8) = *(const GAS v4u*)(wsb + WS_VF + eo); } }
            unsigned long long ro[4], dd[4], k2o[4], kko[4], bpo[4], vo[4], go[4];
#pragma unroll
            for (int g = 0; g < 4; ++g) { const int j0 = cbl * 32 + 8 * g + 4 * hi;
                const unsigned long long rw = *(const LAS unsigned long long*)(xrow + h * 64 + j0), kw = *(const LAS unsigned long long*)(xrow + 384 + h * 64 + j0), vw = *(const LAS unsigned long long*)(xrow + 768 + h * 64 + j0);
                unsigned long long fw = 0ull; if (l > 0) fw = *(const LAS unsigned long long*)(STG + r32 * 32 + 8 * g + 4 * hi);
                asm volatile("" : "+v"(bonus) :: "memory");
                const f32x4 kk4 = *(const LAS f32x4*)(kkw + j0), ka4 = *(const LAS f32x4*)(kaw + j0), rk4 = *(const LAS f32x4*)(rkw + j0), w04 = *(const LAS f32x4*)(w0p + j0), a04 = *(const LAS f32x4*)(a0p + j0);
                const f32x4 v04 = *(const LAS f32x4*)(v0p + j0);
                const float rr[4] = {bflo((unsigned)rw), bfhi((unsigned)rw), bflo((unsigned)(rw >> 32)), bfhi((unsigned)(rw >> 32))};
                const float kx[4] = {bflo((unsigned)kw), bfhi((unsigned)kw), bflo((unsigned)(kw >> 32)), bfhi((unsigned)(kw >> 32))};
                const float vx[4] = {bflo((unsigned)vw), bfhi((unsigned)vw), bflo((unsigned)(vw >> 32)), bfhi((unsigned)(vw >> 32))};
                const float fx[4] = {bflo((unsigned)fw), bfhi((unsigned)fw), bflo((unsigned)(fw >> 32)), bfhi((unsigned)(fw >> 32))};
                float d_[4], k2_[4], kk_[4], bp_[4], v_[4];
#pragma unroll
                for (int e = 0; e < 4; ++e) { const int i = 4 * g + e;
                    const float sp = softplus_f(-(wv[i] + w04[e])); const float rate = __expf(-sp - 0.5f); const float d = 1.0f - __expf(-rate);
                    const float a = sigmoid_f(av[i] + a04[e]);
                    float v = vx[e]; if (l > 0) v = v + (fx[e] - v) * sigmoid_f(mvv[i] + v04[e]);
                    const float kk = kx[e] * kk4[e] * rn, k2 = kx[e] * (1.0f + (a - 1.0f) * ka4[e]);
                    d_[e] = d; k2_[e] = k2; kk_[e] = kk; bp_[e] = kk * a; v_[e] = v;
                    bonus += rr[e] * k2 * rk4[e]; }
#define PK4(x) ((unsigned long long)pk2(x[0], x[1]) | ((unsigned long long)pk2(x[2], x[3]) << 32))
                ro[g] = rw; dd[g] = PK4(d_); k2o[g] = PK4(k2_); kko[g] = PK4(kk_); bpo[g] = PK4(bp_); vo[g] = PK4(v_);
                go[g] = (unsigned long long)pk2(gv[4 * g], gv[4 * g + 1]) | ((unsigned long long)pk2(gv[4 * g + 2], gv[4 * g + 3]) << 32); }
#define PR_OUT(arr, dst) do { _Pragma("unroll") for (int g = 0; g < 4; ++g) *(LAS unsigned long long*)(STG + r32 * 32 + 8 * g + 4 * hi) = arr[g]; \
            _Pragma("unroll") for (int i = 0; i < 2; ++i) { const int row = srow + 16 * i; const unsigned eo = (unsigned)(((tok0 + row) * AW + cb0 + sch * 8) * 2); *(GAS v4u*)(wsb + dst + eo) = *(const LAS v4u*)(STG + row * 32 + sch * 8); } } while (0)
            PR_OUT(ro, WS_R); PR_OUT(dd, WS_D); PR_OUT(k2o, WS_K2); PR_OUT(kko, WS_KK); PR_OUT(bpo, WS_BP); PR_OUT(vo, WS_VF); PR_OUT(go, WS_G);
#undef PR_OUT
#undef PK4
        }
        bonus += __shfl_xor(bonus, 32);
        if (hi == 0) ((float*)(F.ws + WS_BON))[(size_t)(tok0 + r32) * 6 + h] = bonus;
    } else {
        const float* kvn = F.in[I_KVN] + l * 128; bf16* C = (bf16*)(F.ws + WS_C);
        for (int q = 0; q < 16; ++q) { const int tok = tok0 + 16 * (wave - 6) + q; const unsigned w = *(const GAS unsigned*)(P + (size_t)tok * PP + PBC + 2 * lane);
            const float c0 = bflo(w), c1 = bfhi(w); const float ss = wave_sum(c0 * c0 + c1 * c1); const float rs = 1.0f / sqrtf(ss * (1.0f / 128.0f) + 1e-6f);
            *(GAS unsigned*)(C + (size_t)tok * 128 + 2 * lane) = pk2(c0 * rs * kvn[2 * lane], c1 * rs * kvn[2 * lane + 1]); }
    }
    DG_STOP(21, dg21_, dga_)
    DG_WRITE(21, unit == 0 && l == 0 && wave == 0 && lane == 0, dga_)
    __syncthreads();
}

__device__ __forceinline__ void final_norm(const Frame& F) {
    const int gw = F.vcu * NWAVES + F.wave, NGW = F.G * NWAVES; const float* g = F.in[I_FN];
    for (int m = gw; m < M; m += NGW) { GAS f32x4* xr = (GAS f32x4*)(F.out + (size_t)m * DM) + F.lane; f32x4 v[4]; float s = 0.f;
#pragma unroll
        for (int j = 0; j < 4; ++j) { v[j] = xr[64 * j]; s += (v[j].x * v[j].x + v[j].y * v[j].y) + (v[j].z * v[j].z + v[j].w * v[j].w); }
        const float rs = 1.0f / sqrtf(wave_sum(s) * (1.0f / DM) + 1e-6f);
#pragma unroll
        for (int j = 0; j < 4; ++j) { const f32x4 gg = *(const f32x4*)(g + 4 * F.lane + 256 * j); xr[64 * j] = v[j] * rs * gg; } }
}

template <class T> __device__ __forceinline__ T* launder_ptr(T* p) {
    unsigned lo = (unsigned)(uintptr_t)p, hi = (unsigned)((uintptr_t)p >> 32);
    asm volatile("" : "+v"(lo), "+v"(hi));
    lo = __builtin_amdgcn_readfirstlane(lo); hi = __builtin_amdgcn_readfirstlane(hi);
    return (T*)(((uintptr_t)hi << 32) | (uintptr_t)lo);
}
constexpr int NPHASE = 20;
constexpr int DUP_PHASE = -1;
constexpr int QDUP = 1;
constexpr int REP_SCAN_K = 1, REP_THR_K = 1;
constexpr int NSTEP = NPHASE + (DUP_PHASE >= 0 ? 1 : 0);
constexpr int REP_THR = 1, REP_PTOK = 1, REP_KV = 1, REP_CONV = 1, REP_SCAN = 1, REP_DSA = 1, REP_RET = 1, REP_UP = 1;
#define REPL(n) for (int rep_ = 0; rep_ < (l == 0 ? (n) : 1); ++rep_)
__global__ void __launch_bounds__(NTHR, 2) fwd_kernel(Args args) {
    extern __shared__ __attribute__((aligned(16))) unsigned char lds[];
    Frame F;
    F.lds = (LAS unsigned char*)lds;
    F.tid = threadIdx.x; F.lane = F.tid & 63; F.wave = __builtin_amdgcn_readfirstlane(F.tid >> 6);
    F.G = gridDim.x; { const int bx = blockIdx.x; F.vcu = (F.G % 8 == 0) ? (bx % 8) * (F.G / 8) + bx / 8 : bx; }
    F.in = (const float* const __attribute__((address_space(4)))*)__builtin_amdgcn_kernarg_segment_ptr(); F.out = args.out; F.ws = args.ws;
    volatile LAS unsigned* MISC = (volatile LAS unsigned*)(F.lds + MISC_OFF);
    for (int u = F.tid; u < (LDS_BYTES - LDSCTL_OFF) / 4; u += NTHR) ((LAS unsigned*)(F.lds + LDSCTL_OFF))[u] = 0u;
    __syncthreads();
    const int lo = args.ph_lo, hi = args.ph_hi;
    XcdBarrier bar; bar.bar = (unsigned*)(F.ws + WS_CTL) + CW_BAR; bar.x = 0; bar.st = nullptr;
    if (hi - lo > 1) bar = xcd_barrier_post((unsigned*)(F.ws + WS_CTL) + CW_BAR, MISC + 8);
    for (int ph_ = lo; ph_ < hi; ++ph_) {
        int ph = (args.dup_phase >= 0 && ph_ > args.dup_phase) ? ph_ - 1 : ph_; asm volatile("" : "+v"(ph)); ph = __builtin_amdgcn_readfirstlane(ph);
#define PH_ENTER() \
        { unsigned z_ = 0u; int t_ = threadIdx.x; asm volatile("" : "+v"(z_), "+v"(t_)); z_ = __builtin_amdgcn_readfirstlane(z_); F.in = (const float* const __attribute__((address_space(4)))*)((const char __attribute__((address_space(4)))*)__builtin_amdgcn_kernarg_segment_ptr() + z_); F.out = args.out + z_; F.ws = args.ws + z_; \
          F.tid = t_; F.lane = t_ & 63; F.wave = __builtin_amdgcn_readfirstlane(t_ >> 6); } \
        int bx = blockIdx.x; { int g_ = gridDim.x; asm volatile("" : "+v"(bx), "+v"(g_)); bx = __builtin_amdgcn_readfirstlane(bx); g_ = __builtin_amdgcn_readfirstlane(g_); F.G = g_; F.vcu = (g_ % 8 == 0) ? (bx % 8) * (g_ / 8) + bx / 8 : bx; } \
        gu32* ctl = (gu32*)(F.ws + WS_CTL); (void)ctl; \
        bf16* XB = (bf16*)(F.ws + WS_XB); bf16* Hb = (bf16*)(F.ws + WS_H); bf16* Pb = (bf16*)(F.ws + WS_P); float* part = (float*)(F.ws + WS_PART); (void)XB; (void)Hb; (void)Pb; (void)part;
        if (ph == 0) { PH_ENTER();
            conv_weights(F, 0, 0, 6);
            p0_x(F); p0_table(F); small_weights(F);
        } else if (ph == NPHASE - 1) { PH_ENTER();
            if (DIAG_SLOT_D >= 0) {
                const unsigned* D = (const unsigned*)(F.ws + WS_DIAG); const float x0 = (float)D[0] * (1.0f / (100.0f * DIAG_DIV)); const float kq = floorf(log2f(fmaxf(x0, 1.0f)) * 2.0f); const float x = exp2f(kq * 0.5f) * 1.19f; const float c = sqrtf(fmaxf(x - 1.0f, 0.01f));
                for (size_t i = (size_t)F.vcu * NTHR + F.tid; i < (size_t)M * DM; i += (size_t)F.G * NTHR) F.out[i] = c;
            } else
            final_norm(F);
        } else {
            const int l = (ph - 1) / 9, sub = (ph - 1) - 9 * l;
            if (sub == 0 || sub == 7) { PH_ENTER();
                pg8::Gemm g{XB, (const bf16*)(F.ws + (sub == 0 ? WS_WGU1 : WS_WGU2)), M, NGU, DM, DM}; pg8::StaticOrder S; S.init(M, NGU, F.G, bx);
                pg8::EpiUp E{Hb, FFP, part};
                for (int rep = 0; rep < ((l == 0 && sub == 0) ? REP_UP : 1); ++rep) pg8::gemm_phase<pg8::EpiUp, pg8::StaticOrder, true>(F.lds, g, S, E, F.tid);
            } else if (sub == 1 || sub == 8 || sub == 6) { PH_ENTER();
                const bool op = (sub == 6);
                pg8::Gemm g{op ? Pb : Hb, (const bf16*)(F.ws + (op ? WS_WOUT : (sub == 1 ? WS_WD1 : WS_WD2))), M, DM, op ? DM : FFP, op ? PP : FFP}; pg8::StaticOrder S; S.init(M, DM, F.G, bx);
                const float* base = (l == 0 && sub == 1) ? F.in[I_X] : F.out;
                pg8::EpiRes E{base, F.out, XB, part};
                pg8::gemm_phase<pg8::EpiRes, pg8::StaticOrder, false>(F.lds, g, S, E, F.tid);
            } else if (sub == 2) { PH_ENTER();
                pg8::Gemm g{XB, (const bf16*)(F.ws + WS_WIN), M, PP, DM, DM}; pg8::StaticOrder S; S.init(M, PP, F.G, bx);
                pg8::EpiP E{Pb, PP, part};
                pg8::gemm_phase<pg8::EpiP, pg8::StaticOrder, true>(F.lds, g, S, E, F.tid);
            } else if (sub == 3) { PH_ENTER();
                for (int rep_ = 0; rep_ < (l == 0 ? args.rep_thr : 1); ++rep_) for (int u = F.vcu; u < M / 16; u += F.G) dsa_thr_unit(F, u);
                prep_consts(F, l);
                REPL(REP_PTOK) for (int u = F.vcu; u < M / PT; u += F.G) prep_tokens_unit(F, l, u);
                REPL(REP_KV) for (int u = F.vcu; u < BATCH * 4 * 16; u += F.G) ret_kv_unit(F, u);
                REPL(REP_CONV) if (l + 1 < DEPTH) conv_weights(F, l + 1, 0, 3);
                if (l > 0) conv_weights(F, l, 3, 6);
            } else if (sub == 5) { PH_ENTER();
                rwkv_post(F, l);
            } else if (sub == 4) { PH_ENTER();
                if (bx < BATCH * 12) { for (int rep_ = 0; rep_ < (l == 0 ? args.rep_scan : 1); ++rep_) rwkv_scan_unit(F, l, bx); }
                else {
                    gu32* qh = ctl + CW_QUEUE + 64 * l;
                    for (;;) {
                        if (F.tid == 0) MISC[0] = __hip_atomic_fetch_add(qh, 1u, RLX_AGENT);
                        __syncthreads();
                        const int u = (int)MISC[0];
                        __syncthreads();
                        const int nd = (l == 0 ? args.qdup : 1) * (M / 32);
                        if (u >= nd + BATCH * 4 * 16) break;
                        if (u < nd) dsa_attn_unit(F, l, u % (M / 32));
                        else { REPL(REP_RET) ret_out_unit(F, u - nd); }
                    }
                }
            }
        }
        if (ph_ + 1 < hi) xcd_barrier(bar);
    }
}

extern "C" void kernel_launch(void* const* d_in, const int* in_sizes, int n_in, void* d_out, int out_size, void* d_ws, size_t ws_size, hipStream_t stream) {
    static int grid = 0;
    if (grid == 0) {
        if (n_in != 31 || out_size != M * DM || ws_size < WS_END) { fprintf(stderr, "kernel_launch: unexpected shapes (n_in %d, out %d, ws %zu)\n", n_in, out_size, ws_size); grid = -1; return; }
        int dev = 0, cus = 0, per_cu = 0;
        if (hipGetDevice(&dev) != hipSuccess || hipDeviceGetAttribute(&cus, hipDeviceAttributeMultiprocessorCount, dev) != hipSuccess) { grid = -1; return; }
        if (hipFuncSetAttribute((const void*)fwd_kernel, hipFuncAttributeMaxDynamicSharedMemorySize, LDS_BYTES) != hipSuccess) { fprintf(stderr, "kernel_launch: hipFuncSetAttribute failed\n"); grid = -1; return; }
        if (hipOccupancyMaxActiveBlocksPerMultiprocessor(&per_cu, (const void*)fwd_kernel, NTHR, LDS_BYTES) != hipSuccess || per_cu < 1) fprintf(stderr, "kernel_launch: occupancy query says %d\n", per_cu);
        (void)hipGetLastError();
        grid = cus;
    }
    if (grid < 0) return;
    if (hipMemsetAsync((char*)d_ws + WS_CTL, 0, CTL_ZERO_BYTES, stream) != hipSuccess) return;
    Args a{};
    for (int i = 0; i < 31; ++i) a.in[i] = (const float*)d_in[i];
    a.out = (float*)d_out; a.ws = (unsigned char*)d_ws; a.dup_phase = DUP_PHASE; a.qdup = QDUP; a.rep_scan = REP_SCAN_K; a.rep_thr = REP_THR_K;
#ifndef ONE_LAUNCH
#define ONE_LAUNCH 1
#endif
    if (ONE_LAUNCH) { a.ph_lo = 0; a.ph_hi = NSTEP; hipLaunchKernelGGL(fwd_kernel, dim3(grid), dim3(NTHR), LDS_BYTES, stream, a); }
    else for (int ph = 0; ph < NPHASE; ++ph) { a.ph_lo = ph; a.ph_hi = ph + 1; hipLaunchKernelGGL(fwd_kernel, dim3(grid), dim3(NTHR), LDS_BYTES, stream, a); }
}
```

```cpp
#include <hip/hip_runtime.h>
#include <cstdio>
#include <cstdint>
#include <cmath>

namespace pg8 {
#define PG8_LAS __attribute__((address_space(3)))
typedef unsigned short bf16_t;
typedef short bf16x8 __attribute__((ext_vector_type(8)));
typedef float f32x4 __attribute__((ext_vector_type(4)));
typedef unsigned u32x4 __attribute__((ext_vector_type(4)));
constexpr int BM = 256, BK = 64, HALF = 128, HTB = HALF * BK * 2  , STAGE_BYTES = 8 * HTB, NXCD = 8, WGM = 8;

__host__ __device__ __forceinline__ int lds_byte(int r, int c) { const int st = (r >> 4) * 2 + (c >> 5), rr = r & 15, cc = c & 31, ob = rr * 64 + cc * 2; return st * 1024 + (ob ^ (((ob >> 9) & 1) << 5)); }
__host__ __device__ __forceinline__ void stage_rc(int b, int& R, int& C) { const int st = b / 1024, sb = b % 1024, swz = sb ^ (((sb >> 9) & 1) << 5); R = (st >> 1) * 16 + swz / 64; C = (st & 1) * 32 + (swz % 64) / 2; }
__host__ __device__ __forceinline__ int perm32(int rho) { const int n = rho >> 4, i = rho & 15; return 8 * (i >> 2) + 4 * n + (i & 3); }

struct Unit { int pm, pn; };
struct Gemm { const bf16_t* A; const bf16_t* Bt; int M, N, K, lda; };

struct StaticOrder {
    int nM, nN, nwg, G, c;
    __host__ __device__ void init(int M, int N, int G_, int c_) { nM = M / BM; nN = N / BM; nwg = nM * nN; G = G_; c = c_; }
    __host__ __device__ bool next(int i, Unit& u) const {
        const long L = (long)i * G + c; if (L >= nwg) return false;
        int wgid = (int)L; { const int q = nwg / NXCD, r = nwg % NXCD, xcd = wgid % NXCD, off = wgid / NXCD; wgid = (xcd < r ? xcd * (q + 1) : r * (q + 1) + (xcd - r) * q) + off; }
        const int nig = WGM * nN, gid = wgid / nig, fm = gid * WGM, gsz = (nM - fm) < WGM ? (nM - fm) : WGM;
        u.pm = fm + ((wgid % nig) % gsz); u.pn = (wgid % nig) / gsz; return true;
    }
    __device__ __forceinline__ void a_ready(const Unit&) const {}
    __device__ __forceinline__ void done(const Unit&) const {}
};

__device__ __forceinline__ unsigned cvt_pk_bf16(float lo, float hi) { unsigned r; asm volatile("v_cvt_pk_bf16_f32 %0, %1, %2" : "=v"(r) : "v"(lo), "v"(hi)); return r; }


__device__ __forceinline__ float row_rstd(const float* part, int row) {
    const f32x4* p = (const f32x4*)(part + (size_t)row * 16);
    const f32x4 a = p[0], b = p[1], c = p[2], d = p[3];
    const float s = ((a[0] + a[1]) + (a[2] + a[3])) + ((b[0] + b[1]) + (b[2] + b[3])) + ((c[0] + c[1]) + (c[2] + c[3])) + ((d[0] + d[1]) + (d[2] + d[3]));
    return 1.0f / sqrtf(s * (1.0f / 1024.0f) + 1e-6f);
}
__device__ __forceinline__ float silu_f(float x) { return x * __builtin_amdgcn_rcpf(1.0f + __expf(-x)); }

struct EpiUp {
    static constexpr bool PERM = true;
    bf16_t* H; int ldh; const float* part;
    __device__ __forceinline__ void operator()(const f32x4 (&acc)[2][2][4][2], const Unit& u, int wr, int wc, int fr, int fq) const {
        const int row0 = u.pm * BM + wr * 64 + fr, hcol = u.pn * 128 + wc * 32 + 8 * fq;
#pragma unroll
        for (int ai = 0; ai < 2; ++ai)
#pragma unroll
            for (int m = 0; m < 4; ++m) { const int row = row0 + ai * HALF + m * 16; const float rs = row_rstd(part, row);
                const f32x4 g0 = acc[ai][0][m][0] * rs, g1 = acc[ai][0][m][1] * rs, u0 = acc[ai][1][m][0] * rs, u1 = acc[ai][1][m][1] * rs;
                u32x4 w; w.x = cvt_pk_bf16(silu_f(g0[0]) * u0[0], silu_f(g0[1]) * u0[1]); w.y = cvt_pk_bf16(silu_f(g0[2]) * u0[2], silu_f(g0[3]) * u0[3]);
                w.z = cvt_pk_bf16(silu_f(g1[0]) * u1[0], silu_f(g1[1]) * u1[1]); w.w = cvt_pk_bf16(silu_f(g1[2]) * u1[2], silu_f(g1[3]) * u1[3]);
                *(u32x4*)(H + (size_t)row * ldh + hcol) = w; }
    }
};
struct EpiP {
    static constexpr bool PERM = true;
    bf16_t* P; int ldp; const float* part;
    __device__ __forceinline__ void operator()(const f32x4 (&acc)[2][2][4][2], const Unit& u, int wr, int wc, int fr, int fq) const {
        const int row0 = u.pm * BM + wr * 64 + fr, col0 = u.pn * BM + wc * 32 + 8 * fq;
#pragma unroll
        for (int ai = 0; ai < 2; ++ai)
#pragma unroll
            for (int m = 0; m < 4; ++m) { const int row = row0 + ai * HALF + m * 16; const float rs = row_rstd(part, row);
#pragma unroll
                for (int bj = 0; bj < 2; ++bj) { const f32x4 v0 = acc[ai][bj][m][0] * rs, v1 = acc[ai][bj][m][1] * rs;
                    u32x4 w; w.x = cvt_pk_bf16(v0[0], v0[1]); w.y = cvt_pk_bf16(v0[2], v0[3]); w.z = cvt_pk_bf16(v1[0], v1[1]); w.w = cvt_pk_bf16(v1[2], v1[3]);
                    *(u32x4*)(P + (size_t)row * ldp + col0 + bj * HALF) = w; } }
    }
};
struct EpiRes {
    static constexpr bool PERM = true;
    const float* base; float* out; bf16_t* xb; float* part;
    __device__ __forceinline__ void operator()(const f32x4 (&acc)[2][2][4][2], const Unit& u, int wr, int wc, int fr, int fq) const {
        const int row0 = u.pm * BM + wr * 64 + fr, col0 = u.pn * BM + wc * 32 + 8 * fq;
#pragma unroll
        for (int ai = 0; ai < 2; ++ai)
#pragma unroll
            for (int m = 0; m < 4; ++m) { const int row = row0 + ai * HALF + m * 16; float ss = 0.f;
#pragma unroll
                for (int bj = 0; bj < 2; ++bj) { const size_t off = (size_t)row * 1024 + col0 + bj * HALF;
                    const f32x4 v0 = acc[ai][bj][m][0] + *(const f32x4*)(base + off), v1 = acc[ai][bj][m][1] + *(const f32x4*)(base + off + 4);
                    *(f32x4*)(out + off) = v0; *(f32x4*)(out + off + 4) = v1;
                    u32x4 w; w.x = cvt_pk_bf16(v0[0], v0[1]); w.y = cvt_pk_bf16(v0[2], v0[3]); w.z = cvt_pk_bf16(v1[0], v1[1]); w.w = cvt_pk_bf16(v1[2], v1[3]);
                    *(u32x4*)(xb + off) = w;
                    ss += (v0[0] * v0[0] + v0[1] * v0[1]) + (v0[2] * v0[2] + v0[3] * v0[3]) + (v1[0] * v1[0] + v1[1] * v1[1]) + (v1[2] * v1[2] + v1[3] * v1[3]); }
                ss += __shfl_xor(ss, 16); ss += __shfl_xor(ss, 32);
                if (fq == 0) part[(size_t)row * 16 + u.pn * 4 + wc] = ss;
                asm volatile("" ::: "memory"); }
    }
};

template <class Epi, class Sched, bool ALIGN_EPI>
__device__ __forceinline__ void gemm_phase(PG8_LAS unsigned char* lds, const Gemm g, const Sched& S, const Epi& E, const int tid) {
    const int wid = __builtin_amdgcn_readfirstlane(tid >> 6), lane = tid & 63, wr = wid >> 2, wc = wid & 3, fr = lane & 15, fq = lane >> 4;
    const int K = g.K, nt = K / BK, lda = g.lda;
    unsigned voffA[2], voffB[2];
#pragma unroll
    for (int i = 0; i < 2; ++i) { int R, C; stage_rc(tid * 16 + i * 8192, R, C); const int Rb = Epi::PERM ? ((R & ~31) + perm32(R & 31)) : R;
        voffA[i] = (unsigned)(R * lda + C) * 2u; voffB[i] = (unsigned)(Rb * K + C) * 2u; }
    const size_t kstep = (size_t)(BK * 2);
    const size_t hstepA = (size_t)HALF * lda * 2, hstepB = (size_t)HALF * K * 2;
    const size_t tstepA = 2 * hstepA, tstepB = 2 * hstepB;
    const unsigned ldsw = (unsigned)wid * 1024u;
    const int aoff = lds_byte(wr * 64 + fr, fq * 8), boff = lds_byte(wc * 32 + fr, fq * 8);
#define PG8_SA(b, h) (((b) * 2 + (h)) * HTB)
#define PG8_SB(b, h) ((4 + (b) * 2 + (h)) * HTB)
#define PG8_STAGE(bufoff, gbase, voff) do { _Pragma("unroll") for (int _i = 0; _i < 2; ++_i) \
        __builtin_amdgcn_global_load_lds((const unsigned*)((const char*)(gbase) + (voff)[_i]), (PG8_LAS unsigned*)(lds + (bufoff) + ldsw + _i * 8192), 16, 0, 0); } while (0)
#define PG8_LDA(dst, b, h) do { _Pragma("unroll") for (int m = 0; m < 4; ++m) _Pragma("unroll") for (int k = 0; k < 2; ++k) dst[m][k] = *(const PG8_LAS bf16x8*)(lds + PG8_SA(b, h) + aoff + m * 2048 + k * 1024); } while (0)
#define PG8_LDB(dst, b, h) do { _Pragma("unroll") for (int n = 0; n < 2; ++n) _Pragma("unroll") for (int k = 0; k < 2; ++k) dst[n][k] = *(const PG8_LAS bf16x8*)(lds + PG8_SB(b, h) + boff + n * 2048 + k * 1024); } while (0)
#define PG8_MMA(ai, bj, At, Bt) do { __builtin_amdgcn_s_setprio(1); _Pragma("unroll") for (int m = 0; m < 4; ++m) _Pragma("unroll") for (int n = 0; n < 2; ++n) _Pragma("unroll") for (int k = 0; k < 2; ++k) \
        acc[ai][bj][m][n] = __builtin_amdgcn_mfma_f32_16x16x32_bf16(Bt[n][k], At[m][k], acc[ai][bj][m][n], 0, 0, 0); __builtin_amdgcn_s_setprio(0); } while (0)
#define PG8_WAIT_V(n) asm volatile("s_waitcnt vmcnt(" #n ")" ::: "memory")
#define PG8_WAIT_L(n) asm volatile("s_waitcnt lgkmcnt(" #n ")" ::: "memory")
#define PG8_BAR __builtin_amdgcn_s_barrier()
#define PG8_SCHED __builtin_amdgcn_sched_barrier(0)
    Unit cur, nxt; int ui = 0;
    if (!S.next(0, cur)) return;
    f32x4 acc[2][2][4][2];
#pragma unroll
    for (int a = 0; a < 2; ++a)
#pragma unroll
        for (int b = 0; b < 2; ++b)
#pragma unroll
            for (int m = 0; m < 4; ++m)
#pragma unroll
                for (int n = 0; n < 2; ++n) acc[a][b][m][n] = (f32x4){0.f, 0.f, 0.f, 0.f};
    bf16x8 At[4][2], B0[2][2], B1[2][2];
    const char* cA = (const char*)g.A + (size_t)cur.pm * tstepA; const char* cB = (const char*)g.Bt + (size_t)cur.pn * tstepB;
    S.a_ready(cur);
    PG8_STAGE(PG8_SB(0, 0), cB, voffB); PG8_STAGE(PG8_SB(0, 1), cB + hstepB, voffB); PG8_STAGE(PG8_SA(0, 0), cA, voffA); PG8_STAGE(PG8_SA(0, 1), cA + hstepA, voffA);
    if (wr == 1) PG8_BAR;
    PG8_WAIT_V(2); PG8_BAR;
    PG8_STAGE(PG8_SB(1, 0), cB + kstep, voffB); PG8_STAGE(PG8_SA(1, 0), cA + kstep, voffA); PG8_STAGE(PG8_SB(1, 1), cB + hstepB + kstep, voffB);
    PG8_WAIT_V(6); PG8_BAR;
    for (;;) {
        const bool has_next = S.next(ui + 1, nxt);
        const char* nA = has_next ? (const char*)g.A + (size_t)nxt.pm * tstepA : cA; const char* nB = has_next ? (const char*)g.Bt + (size_t)nxt.pn * tstepB : cB;
        for (int t = 0; t < nt; t += 2) {
            const bool last = (t == nt - 2);
            const char* a1 = cA + (size_t)(t + 1) * kstep;
            const char* a2 = last ? nA : cA + (size_t)(t + 2) * kstep; const char* b2 = last ? nB : cB + (size_t)(t + 2) * kstep;
            const char* a3 = a2 + kstep; const char* b3 = b2 + kstep;
            if (last && has_next) S.a_ready(nxt);
            PG8_LDB(B0, 0, 0); PG8_LDB(B1, 0, 1); PG8_SCHED; PG8_LDA(At, 0, 0); PG8_STAGE(PG8_SA(1, 1), a1 + hstepA, voffA);
            PG8_WAIT_V(8); PG8_WAIT_L(0); PG8_BAR; PG8_MMA(0, 0, At, B0); PG8_MMA(0, 1, At, B1); PG8_BAR; PG8_SCHED;
            PG8_LDA(At, 0, 1); PG8_STAGE(PG8_SB(0, 0), b2, voffB); PG8_STAGE(PG8_SB(0, 1), b2 + hstepB, voffB); PG8_STAGE(PG8_SA(0, 0), a2, voffA);
            PG8_WAIT_V(8); PG8_WAIT_L(0); PG8_BAR; PG8_MMA(1, 0, At, B0); PG8_MMA(1, 1, At, B1); PG8_BAR; PG8_SCHED;
            PG8_LDB(B0, 1, 0); PG8_LDB(B1, 1, 1); PG8_SCHED; PG8_LDA(At, 1, 0); PG8_STAGE(PG8_SA(0, 1), a2 + hstepA, voffA);
            PG8_WAIT_V(8); PG8_WAIT_L(0); PG8_BAR; PG8_MMA(0, 0, At, B0); PG8_MMA(0, 1, At, B1); PG8_BAR; PG8_SCHED;
            PG8_LDA(At, 1, 1); PG8_STAGE(PG8_SB(1, 0), b3, voffB); PG8_STAGE(PG8_SB(1, 1), b3 + hstepB, voffB); PG8_STAGE(PG8_SA(1, 0), a3, voffA);
            PG8_WAIT_V(8); PG8_WAIT_L(0); PG8_BAR; PG8_MMA(1, 0, At, B0); PG8_MMA(1, 1, At, B1); PG8_BAR; PG8_SCHED;
        }
        if constexpr (ALIGN_EPI) { if (wr == 0) PG8_BAR; }
        E(acc, cur, wr, wc, fr, fq); S.done(cur);
        if (!has_next) break;
#pragma unroll
        for (int a = 0; a < 2; ++a)
#pragma unroll
            for (int b = 0; b < 2; ++b)
#pragma unroll
                for (int m = 0; m < 4; ++m)
#pragma unroll
                    for (int n = 0; n < 2; ++n) acc[a][b][m][n] = (f32x4){0.f, 0.f, 0.f, 0.f};
        cur = nxt; cA = nA; cB = nB; ++ui;
        if constexpr (ALIGN_EPI) { if (wr == 1) PG8_BAR; }
    }
    PG8_WAIT_V(0);
    if constexpr (!ALIGN_EPI) { if (wr == 0) PG8_BAR; }
    PG8_BAR;
#undef PG8_SA
#undef PG8_SB
#undef PG8_STAGE
#undef PG8_LDA
#undef PG8_LDB
#undef PG8_MMA
#undef PG8_WAIT_V
#undef PG8_WAIT_L
#undef PG8_BAR
#undef PG8_SCHED
}
}

constexpr int NWAVES = 8, NTHR = 512;
constexpr int BATCH = 8, SEQ = 2048, DM = 1024, DEPTH = 2, FF = 2752, M = BATCH * SEQ;
constexpr int FFP = 2816;
constexpr int NGU = 5632;
constexpr int PP = 3584;
constexpr int NIN = 3400;
constexpr int PA = 0, PMV = 1280, PBQ = 1296, PBC = 1680, PBIQ = 1808, PBIK = 2320, PBIW = 2384, PCQ = 2392, PCK = 2648, PCV = 2904, PCG = 3160, PUSED = 3416;
constexpr int AW = 384;
constexpr int TOPK = 256;

constexpr size_t MiB = 1u << 20;
constexpr size_t WS_CTL = 0, CTL_ZERO_BYTES = 1 * MiB;
constexpr size_t WS_PART = 1 * MiB;
constexpr size_t WS_TAB = 2 * MiB;
constexpr size_t WS_BON = 2 * MiB + 512 * 1024;
constexpr size_t WS_WUKT = 3 * MiB, WS_WUVT = 3 * MiB + 192 * 1024;
constexpr size_t WS_THR = 3 * MiB + 384 * 1024, WS_SCUT = 3 * MiB + 448 * 1024;
constexpr size_t WS_LORA = 3 * MiB + 512 * 1024;
constexpr size_t WS_WGU1 = 4 * MiB, WS_WD1 = 15 * MiB, WS_WIN = 21 * MiB, WS_WOUT = 28 * MiB, WS_WGU2 = 30 * MiB, WS_WD2 = 41 * MiB;
constexpr size_t WS_XB = 47 * MiB;
constexpr size_t WS_VF = 79 * MiB;
constexpr size_t WS_P = 91 * MiB;
constexpr size_t WS_H = WS_P;
constexpr size_t WS_R = 203 * MiB, WS_D = 215 * MiB, WS_K2 = 227 * MiB, WS_KK = 239 * MiB, WS_C = 251 * MiB;
constexpr size_t WS_BP = WS_XB, WS_G = WS_XB + 12 * MiB, WS_KV = WS_XB + 24 * MiB;
constexpr size_t WS_END = 256 * MiB;
static_assert(WS_WD2 + (size_t)1024 * FFP * 2 <= WS_XB && WS_P + (size_t)M * PP * 2 <= WS_R && WS_C + (size_t)M * 128 * 2 <= WS_END, "ws map");
constexpr int CW_BAR = 4096;
constexpr int CW_QUEUE = 16384;

constexpr int RING_BYTES = 131072;
constexpr int LDSCTL_OFF = RING_BYTES, MISC_OFF = LDSCTL_OFF + 320;
constexpr int LDS_BYTES = 147456;

#define GAS __attribute__((address_space(1)))
#define LAS __attribute__((address_space(3)))
typedef unsigned short bf16;
typedef unsigned v4u __attribute__((ext_vector_type(4)));
typedef float f32x4 __attribute__((ext_vector_type(4)));
typedef GAS unsigned gu32;
#define RLX_AGENT __ATOMIC_RELAXED, __HIP_MEMORY_SCOPE_AGENT
#define LDS_WAIT() asm volatile("s_waitcnt lgkmcnt(0)" ::: "memory")
__device__ __forceinline__ unsigned f2bf(float f) { unsigned u = __builtin_bit_cast(unsigned, f); return (u + 0x7fffu + ((u >> 16) & 1u)) >> 16; }
typedef float f32x2v_ __attribute__((ext_vector_type(2))); typedef __bf16 bf16x2v_ __attribute__((ext_vector_type(2)));
__device__ __forceinline__ unsigned pk2(float lo, float hi) { const f32x2v_ v = {lo, hi}; return __builtin_bit_cast(unsigned, __builtin_convertvector(v, bf16x2v_)); }
__device__ __forceinline__ float bf2f(unsigned short v) { return __uint_as_float((unsigned)v << 16); }
__device__ __forceinline__ float bflo(unsigned w) { return __uint_as_float(w << 16); }
__device__ __forceinline__ float bfhi(unsigned w) { return __uint_as_float(w & 0xffff0000u); }
__device__ __forceinline__ void unpack8(const v4u w, float (&f)[8]) { f[0] = bflo(w.x); f[1] = bfhi(w.x); f[2] = bflo(w.y); f[3] = bfhi(w.y); f[4] = bflo(w.z); f[5] = bfhi(w.z); f[6] = bflo(w.w); f[7] = bfhi(w.w); }
__device__ __forceinline__ float sigmoid_f(float x) { return 1.0f / (1.0f + __expf(-x)); }
__device__ __forceinline__ float wave_sum(float v) {
#pragma unroll
    for (int o = 1; o < 64; o <<= 1) v += __shfl_xor(v, o);
    return v;
}

#define XB_TMO      128
#define XB_XCNT(j)  (256  + 64 * (j))
#define XB_XSUB(j)  (1280 + 64 * (j))
#define XB_XGEN(j)  (2304 + 64 * (j))
#define XB_TOP      3328
#define XB_TOPGEN   3392
#define XCD_BAR_WORDS 3456
#define XB_SPIN_CAP (1u << 22)

__device__ __forceinline__ unsigned xb_ld(unsigned* p)              { return __hip_atomic_load(p, __ATOMIC_RELAXED, __HIP_MEMORY_SCOPE_AGENT); }
__device__ __forceinline__ unsigned xb_add(unsigned* p, unsigned v) { return __hip_atomic_fetch_add(p, v, __ATOMIC_RELAXED, __HIP_MEMORY_SCOPE_AGENT); }
__device__ __forceinline__ unsigned xb_xcc_id() { return (unsigned)__builtin_amdgcn_s_getreg((3 << 11) | 20) & 0xFu; }
#define XB_SPIN(cond, bar) do { unsigned _sp = 0; while (cond) { __builtin_amdgcn_s_sleep(1); \
    if ((++_sp & 255u) == 0u) { if (xb_ld(&(bar)[XB_TMO])) break; if (_sp > XB_SPIN_CAP) { atomicAdd(&(bar)[XB_TMO], 1u); break; } } } } while (0)

struct XcdBarrier { unsigned* bar; unsigned x; volatile LAS unsigned* st; };

__device__ __forceinline__ XcdBarrier xcd_barrier_post(unsigned* bar, volatile LAS unsigned* st) {
    XcdBarrier b; b.bar = bar; b.x = xb_xcc_id(); b.st = st;
    if (threadIdx.x == 0) (void)xb_add(&bar[XB_XCNT(b.x)], 1u);
    return b;
}
__device__ __forceinline__ void xcd_barrier_complete(unsigned* bar, unsigned x, unsigned& nloc, unsigned& nx) {
    const unsigned G = gridDim.x * gridDim.y * gridDim.z;
    unsigned sum, cnt, mine, sp = 0u;
    for (;;) {
        sum = 0u; cnt = 0u; mine = 0u;
#pragma unroll
        for (unsigned j = 0; j < 16; ++j) { const unsigned c = xb_ld(&bar[XB_XCNT(j)]); sum += c; cnt += (c > 0u) ? 1u : 0u; mine = (j == x) ? c : mine; }
        if (sum == G) break;
        __builtin_amdgcn_s_sleep(1);
        if ((++sp & 255u) == 0u) { if (xb_ld(&bar[XB_TMO])) break; if (sp > XB_SPIN_CAP) { atomicAdd(&bar[XB_TMO], 1u); break; } }
    }
    nloc = mine > 0u ? mine : 1u; nx = cnt > 0u ? cnt : 1u;
}
__device__ __forceinline__ void xcd_barrier(const XcdBarrier& b) {
    asm volatile("s_waitcnt vmcnt(0)" ::: "memory");
    __syncthreads();
    if (threadIdx.x == 0) {
        unsigned* bar = b.bar;
        __builtin_amdgcn_s_waitcnt(0);
        unsigned nloc = b.st[0], nx = b.st[1];
        if (nloc == 0u) { xcd_barrier_complete(bar, b.x, nloc, nx); b.st[0] = nloc; b.st[1] = nx; }
        const unsigned old = xb_add(&bar[XB_XSUB(b.x)], 1u);
        const unsigned gen = old / nloc;
        if (old + 1u == (gen + 1u) * nloc) {
            __builtin_amdgcn_fence(__ATOMIC_RELEASE, "agent");
            asm volatile("s_waitcnt vmcnt(0)" ::: "memory");
            const unsigned og = xb_add(&bar[XB_TOP], 1u);
            const unsigned tg = og / nx;
            if (og + 1u == (tg + 1u) * nx) xb_add(&bar[XB_TOPGEN], 1u);
            else XB_SPIN(xb_ld(&bar[XB_TOPGEN]) == tg, bar);
            __builtin_amdgcn_fence(__ATOMIC_ACQUIRE, "agent");
            xb_add(&bar[XB_XGEN(b.x)], 1u);
            asm volatile("s_waitcnt vmcnt(0)" ::: "memory");
        } else {
            XB_SPIN(xb_ld(&bar[XB_XGEN(b.x)]) == gen, bar);
            __builtin_amdgcn_fence(__ATOMIC_ACQUIRE, "agent");
            asm volatile("s_waitcnt vmcnt(0)" ::: "memory");
        }
    }
    __syncthreads();
}

#ifndef DIAG_SLOT_D
#define DIAG_SLOT_D (-1)
#endif
#ifndef DIAG_DIV
#define DIAG_DIV 1.0f
#endif
constexpr size_t WS_DIAG = 3 * MiB + 900 * 1024;
#define DG_START(k, var) unsigned var = 0; if (DIAG_SLOT_D == (k)) var = (unsigned)__builtin_amdgcn_s_memtime();
#define DG_STOP(k, var, acc) if (DIAG_SLOT_D == (k)) acc += (unsigned)__builtin_amdgcn_s_memtime() - var;
#define DG_WRITE(k, cond, acc) if (DIAG_SLOT_D == (k) && (cond)) ((unsigned*)(F.ws + WS_DIAG))[0] = acc;
struct Args { const float* in[31]; float* out; unsigned char* ws; int ph_lo, ph_hi; int dup_phase, qdup, rep_scan, rep_thr; };
struct Frame {
    LAS unsigned char* lds;
    int tid, lane, wave, vcu, G;
    const float* const __attribute__((address_space(4)))* in;
    float* out; unsigned char* ws;
};
enum { I_X = 0, I_F1N, I_F1G, I_F1U, I_F1D, I_MIXN, I_WIN, I_WOUT, I_MU, I_W0, I_W2, I_A0, I_A2, I_G2, I_KK, I_KA, I_RK, I_LNW, I_LNB, I_VRW, I_VRMU, I_V0, I_V2, I_KVN, I_WUK, I_WUV, I_F2N, I_F2G, I_F2U, I_F2D, I_FN };

__device__ __forceinline__ void conv_item(const Frame& F, int l, int kind, int item, LAS float* scr) {
    const int lane = F.lane;
    int Kd, nkb; bf16* WT;
    if (kind == 0 || kind == 4) { Kd = 1024; WT = (bf16*)(F.ws + (kind == 0 ? WS_WGU1 : WS_WGU2)); }
    else if (kind == 1 || kind == 5) { Kd = FFP; WT = (bf16*)(F.ws + (kind == 1 ? WS_WD1 : WS_WD2)); }
    else if (kind == 2) { Kd = 1024; WT = (bf16*)(F.ws + WS_WIN); }
    else { Kd = 1024; WT = (bf16*)(F.ws + WS_WOUT); }
    nkb = Kd / 64;
    const int rb = item / nkb, kb = item % nkb, r0 = rb * 32, k0 = kb * 64;
    const int rr = r0 + (lane & 31);
    const float* src = nullptr; int ns = 0, col = 0, ksrc = 1024; const float* gain = nullptr; float scale = 1.0f;
    if (kind == 0 || kind == 4) {
        const int tile = rr >> 8, w = rr & 255, hid = tile * 128 + (w & 127);
        if (hid < FF) { const float* s1 = (w >> 7) ? F.in[I_F1U] : F.in[I_F1G]; const float* s2 = (w >> 7) ? F.in[I_F2U] : F.in[I_F2G]; src = ((kind == 0) ? s1 : s2) + (size_t)l * 1024 * FF; ns = FF; col = hid; }
        gain = ((kind == 0) ? F.in[I_F1N] : F.in[I_F2N]) + l * 1024;
    } else if (kind == 1 || kind == 5) {
        src = ((kind == 1) ? F.in[I_F1D] : F.in[I_F2D]) + (size_t)l * FF * 1024; ns = 1024; col = rr; ksrc = FF; scale = 0.5f;
    } else if (kind == 2) {
        gain = F.in[I_MIXN] + l * 1024;
        if (rr < 1280) { src = F.in[I_WIN] + (size_t)l * 1024 * NIN; ns = NIN; col = rr; }
        else if (rr < 1296) { if (l > 0) { src = F.in[I_VRW] + (size_t)(l - 1) * 1024 * 16; ns = 16; col = rr - 1280; } }
        else if (rr < PUSED) { src = F.in[I_WIN] + (size_t)l * 1024 * NIN; ns = NIN; col = rr - 16; }
    } else { src = F.in[I_WOUT] + (size_t)l * 1024 * 1024; ns = 1024; col = rr; }
#pragma unroll 8
    for (int i = 0; i < 32; ++i) { const int kk = 2 * i + (lane >> 5), k = k0 + kk; float v = 0.f;
        if (src != nullptr && k < ksrc) { v = src[(size_t)k * ns + col] * scale; if (gain) v *= gain[k]; }
        scr[kk * 33 + (lane & 31)] = v; }
    LDS_WAIT(); asm volatile("" ::: "memory");
    const int c = lane & 7;
#pragma unroll
    for (int j = 0; j < 4; ++j) { const int n = (lane >> 3) + 8 * j; const LAS float* s = scr + (8 * c) * 33 + n;
        v4u o; o.x = pk2(s[0 * 33], s[1 * 33]); o.y = pk2(s[2 * 33], s[3 * 33]); o.z = pk2(s[4 * 33], s[5 * 33]); o.w = pk2(s[6 * 33], s[7 * 33]);
        *(GAS v4u*)(WT + (size_t)(r0 + n) * Kd + k0 + 8 * c) = o; }
    LDS_WAIT(); asm volatile("" ::: "memory");
}
__host__ __device__ constexpr int conv_items(int kind) { return (kind == 0 || kind == 4) ? (NGU / 32) * 16 : (kind == 1 || kind == 5) ? 32 * (FFP / 64) : (kind == 2) ? (PP / 32) * 16 : 32 * 16; }
__device__ __forceinline__ void conv_weights(const Frame& F, int l, int k_lo, int k_hi) {
    LAS float* scr = (LAS float*)(F.lds + F.wave * 16384);
    const int gw = F.vcu * NWAVES + F.wave, NGW = F.G * NWAVES;
    for (int kind = k_lo; kind < k_hi; ++kind) { const int ni = conv_items(kind);
        for (int it = gw; it < ni; it += NGW) conv_item(F, l, kind, it, scr); }
}

__host__ __device__ constexpr int conv_flat_items(bool has_next) { return conv_items(3) + conv_items(4) + conv_items(5) + (has_next ? conv_items(0) + conv_items(1) + conv_items(2) : 0); }
__device__ __forceinline__ void conv_unit(const Frame& F, int l, int u) {
    LAS float* scr = (LAS float*)(F.lds + F.wave * 16384);
    int it = u * NWAVES + F.wave; const bool has_next = (l + 1 < DEPTH);
    if (it >= conv_flat_items(has_next)) return;
    int layer = l, kind = 3;
    if (it >= conv_items(3)) { it -= conv_items(3); kind = 4;
        if (it >= conv_items(4)) { it -= conv_items(4); kind = 5;
            if (it >= conv_items(5)) { it -= conv_items(5); kind = 0; layer = l + 1;
                if (it >= conv_items(0)) { it -= conv_items(0); kind = 1;
                    if (it >= conv_items(1)) { it -= conv_items(1); kind = 2; } } } } }
    conv_item(F, layer, kind, it, scr);
}
__device__ __forceinline__ void p0_x(const Frame& F) {
    const int gw = F.vcu * NWAVES + F.wave, NGW = F.G * NWAVES;
    const float* x = F.in[I_X]; bf16* xb = (bf16*)(F.ws + WS_XB); float* part = (float*)(F.ws + WS_PART);
    for (int m = gw; m < M; m += NGW) {
        const GAS f32x4* xr = (const GAS f32x4*)(x + (size_t)m * DM) + F.lane; float s = 0.f;
        GAS unsigned long long* o8 = (GAS unsigned long long*)(xb + (size_t)m * DM) + F.lane;
#pragma unroll
        for (int j = 0; j < 4; ++j) { const f32x4 v = xr[64 * j]; s += (v.x * v.x + v.y * v.y) + (v.z * v.z + v.w * v.w);
            o8[64 * j] = (unsigned long long)pk2(v.x, v.y) | ((unsigned long long)pk2(v.z, v.w) << 32); }
        s = wave_sum(s);
        if (F.lane < 16) part[(size_t)m * 16 + F.lane] = (F.lane == 0) ? s : 0.f;
    }
}
__device__ __forceinline__ void p0_table(const Frame& F) {
    float* tab = (float*)(F.ws + WS_TAB);
    for (int i = F.vcu * NTHR + F.tid; i < SEQ * 32; i += F.G * NTHR) { const int t = i >> 5, f = i & 31; const float th = exp2f(-(float)f * (13.287712379549449f / 31.0f)); const float ang = (float)t * th; float s, c; sincosf(ang, &s, &c); tab[2 * i] = c; tab[2 * i + 1] = s; }
}

__device__ __forceinline__ void ret_kv_unit(const Frame& F, int unit) {
    unsigned dga_ = 0;
    DG_START(30, dg30_)
    LAS float* kr = (LAS float*)F.lds; LAS float* vv = kr + 128 * 64;
    const int tid = F.tid, c = unit & 15, h = (unit >> 4) & 3, b = unit >> 6, tok0 = b * SEQ + c * 128;
    const bf16* P = (const bf16*)(F.ws + WS_P); const float* tab = (const float*)(F.ws + WS_TAB);
    const float lg2 = log2f(1.0f - exp2f(-5.0f - (float)h));
    for (int idx = tid; idx < 128 * 32; idx += NTHR) { const int m = idx >> 5, i = idx & 31; const size_t ro = (size_t)(tok0 + m) * PP;
        const float k1 = bf2f(P[ro + PCK + h * 64 + i]), k2 = bf2f(P[ro + PCK + h * 64 + 32 + i]);
        const float cs = tab[((c * 128 + m) * 32 + i) * 2], sn = tab[((c * 128 + m) * 32 + i) * 2 + 1];
        const float sc = 0.125f * exp2f((float)(127 - m) * lg2);
        kr[m * 64 + i] = (k1 * cs - k2 * sn) * sc; kr[m * 64 + 32 + i] = (k1 * sn + k2 * cs) * sc;
        vv[m * 64 + i] = bf2f(P[ro + PCV + h * 64 + i]); vv[m * 64 + 32 + i] = bf2f(P[ro + PCV + h * 64 + 32 + i]); }
    __syncthreads();
    const int d = tid >> 3, e0 = (tid & 7) * 8; float acc[8];
#pragma unroll
    for (int e = 0; e < 8; ++e) acc[e] = 0.f;
    for (int m = 0; m < 128; ++m) { const float kd = kr[m * 64 + d];
#pragma unroll
        for (int e = 0; e < 8; ++e) acc[e] += kd * vv[m * 64 + e0 + e]; }
    float* KV = (float*)(F.ws + WS_KV) + (size_t)unit * 4096 + d * 64 + e0;
#pragma unroll
    for (int e = 0; e < 8; ++e) KV[e] = acc[e];
    __syncthreads();
    DG_STOP(30, dg30_, dga_)
    DG_WRITE(30, unit == 0 && F.wave == 0 && F.lane == 0, dga_)
}

typedef float f32x2 __attribute__((ext_vector_type(2)));
__device__ __forceinline__ float dpp_add16(float x) {
    x += __builtin_bit_cast(float, __builtin_amdgcn_mov_dpp(__builtin_bit_cast(int, x), 0xB1, 0xF, 0xF, true));
    x += __builtin_bit_cast(float, __builtin_amdgcn_mov_dpp(__builtin_bit_cast(int, x), 0x4E, 0xF, 0xF, true));
    x += __builtin_bit_cast(float, __builtin_amdgcn_mov_dpp(__builtin_bit_cast(int, x), 0x141, 0xF, 0xF, true));
    x += __builtin_bit_cast(float, __builtin_amdgcn_mov_dpp(__builtin_bit_cast(int, x), 0x140, 0xF, 0xF, true));
    return x;
}
constexpr int CH = 32;
constexpr int RW_STG = 5 * CH * 64;
struct RwOps { f32x4 r, d, k, q, b; float v; };
__device__ __forceinline__ void rw_ld(RwOps& o, const LAS float* base, const LAS float* vb, int s, int ks, int row) {
    const LAS f32x4* p = (const LAS f32x4*)(base + s * 64 + ks * 4);
    o.r = p[0]; o.d = p[CH * 16]; o.k = p[2 * CH * 16]; o.q = p[3 * CH * 16]; o.b = p[4 * CH * 16];
    o.v = vb[s * 32 + row];
}
#define LO2(x) __builtin_shufflevector(x, x, 0, 1)
#define HI2(x) __builtin_shufflevector(x, x, 2, 3)
__device__ __forceinline__ float rw_step(f32x2 (&S)[2], const RwOps& o) {
    f32x2 p2 = S[0] * LO2(o.q); p2 = S[1] * HI2(o.q) + p2;
    const float p = dpp_add16(p2.x + p2.y);
    const f32x2 pp = (f32x2){p, p}, vv = (f32x2){o.v, o.v};
    S[0] = S[0] - LO2(o.d) * S[0]; S[1] = S[1] - HI2(o.d) * S[1];
    S[0] = S[0] - pp * LO2(o.b); S[1] = S[1] - pp * HI2(o.b);
    S[0] = vv * LO2(o.k) + S[0]; S[1] = vv * HI2(o.k) + S[1];
    f32x2 y2 = S[0] * LO2(o.r); y2 = S[1] * HI2(o.r) + y2;
    return dpp_add16(y2.x + y2.y);
}
__device__ __forceinline__ void rwkv_scan_unit(const Frame& F, int l, int unit) {
    const int tid = F.tid, lane = F.lane, wave = F.wave, half = unit & 1, bh = unit >> 1, b = bh / 6, h = bh - b * 6, tokb = b * SEQ;
    LAS float* stg = (LAS float*)F.lds; LAS float* vst = stg + 2 * RW_STG; LAS float* ybuf = vst + 2 * CH * 32;
    bf16* P = (bf16*)(F.ws + WS_P);
    const int row = 4 * wave + (lane >> 4), ks = lane & 15;
    f32x2 S[2] = {(f32x2){0.f, 0.f}, (f32x2){0.f, 0.f}};
    const bool hi8 = (tid >> 8) != 0;
    const bf16* src0 = (const bf16*)(F.ws + (hi8 ? WS_D : WS_R)); const bf16* src1 = (const bf16*)(F.ws + (hi8 ? WS_KK : WS_K2)); const bf16* src2 = (const bf16*)(F.ws + (hi8 ? WS_VF : WS_BP));
    const int st_t = hi8 ? ((tid & 255) >> 2) : ((tid & 255) >> 3), st_c = hi8 ? (tid & 3) : (tid & 7);
    const int t01 = (tid & 255) >> 3, c01 = tid & 7;
    v4u sreg[3], sreg2[3];
#define RW_ROT() do { sreg[0] = sreg2[0]; sreg[1] = sreg2[1]; sreg[2] = sreg2[2]; } while (0)
#define RW_LOAD2(cc) do { const size_t o01 = (size_t)(tokb + (cc) * CH + t01) * AW + h * 64 + c01 * 8; sreg2[0] = *(const GAS v4u*)(src0 + o01); sreg2[1] = *(const GAS v4u*)(src1 + o01); \
        if (!hi8) sreg2[2] = *(const GAS v4u*)(src2 + o01); else if (tid < 384) sreg2[2] = *(const GAS v4u*)(src2 + (size_t)(tokb + (cc) * CH + st_t) * AW + h * 64 + half * 32 + st_c * 8); } while (0)
#define RW_LOAD(cc) do { const size_t o01 = (size_t)(tokb + (cc) * CH + t01) * AW + h * 64 + c01 * 8; sreg[0] = *(const GAS v4u*)(src0 + o01); sreg[1] = *(const GAS v4u*)(src1 + o01); \
        if (!hi8) sreg[2] = *(const GAS v4u*)(src2 + o01); else if (tid < 384) sreg[2] = *(const GAS v4u*)(src2 + (size_t)(tokb + (cc) * CH + st_t) * AW + h * 64 + half * 32 + st_c * 8); } while (0)
#define RW_ST1(i, ar, bufi) do { float f[8]; unpack8(sreg[i], f); LAS f32x4* dst = (LAS f32x4*)(stg + (bufi) * RW_STG + (ar) * CH * 64 + t01 * 64 + c01 * 8); \
        dst[0] = (f32x4){f[0], f[1], f[2], f[3]}; dst[1] = (f32x4){f[4], f[5], f[6], f[7]}; } while (0)
#define RW_STORE(bufi) do { RW_ST1(0, hi8 ? 1 : 0, bufi); RW_ST1(1, hi8 ? 3 : 2, bufi); if (!hi8) RW_ST1(2, 4, bufi); \
        else if (tid < 384) { float f[8]; unpack8(sreg[2], f); LAS f32x4* dst = (LAS f32x4*)(vst + (bufi) * CH * 32 + st_t * 32 + st_c * 8); dst[0] = (f32x4){f[0], f[1], f[2], f[3]}; dst[1] = (f32x4){f[4], f[5], f[6], f[7]}; } } while (0)
    constexpr int NCH = SEQ / CH;
    unsigned dga_ = 0;
    DG_START(41, dg41_)
    RW_LOAD(0); RW_STORE(0); RW_LOAD(1); RW_LOAD2(2);
    __syncthreads();
    for (int cc = 0; cc < NCH; ++cc) {
        const int bufi = cc & 1;
        DG_START(42, dg42_)
        if (cc + 1 < NCH) RW_STORE(bufi ^ 1);
        RW_ROT(); if (cc + 3 < NCH) RW_LOAD2(cc + 3);
        DG_STOP(42, dg42_, dga_)
        const LAS float* base = stg + bufi * RW_STG; const LAS float* vb = vst + bufi * CH * 32; LAS float* yb = ybuf + bufi * CH * 32;
        RwOps A, B; float ykeep = 0.f;
        DG_START(40, dg40_)
        rw_ld(A, base, vb, 0, ks, row);
#pragma unroll
        for (int s = 0; s < CH; s += 2) {
            rw_ld(B, base, vb, s + 1, ks, row);
            { const float y = rw_step(S, A); ykeep = (ks == (s & 15)) ? y : ykeep; }
            if (s + 2 < CH) rw_ld(A, base, vb, s + 2, ks, row);
            { const float y = rw_step(S, B); ykeep = (ks == ((s + 1) & 15)) ? y : ykeep; }
            if (((s + 1) & 15) == 15) yb[(s - 14 + ks) * 32 + row] = ykeep;
        }
        DG_STOP(40, dg40_, dga_)
        DG_START(43, dg43_) DG_START(45, dg45_) DG_START(46, dg46_)
        asm volatile("s_waitcnt lgkmcnt(0)" ::: "memory"); __builtin_amdgcn_s_barrier(); asm volatile("" ::: "memory");
        DG_STOP(43, dg43_, dga_) DG_STOP(45, dg45_, dga_) DG_STOP(46, dg46_, dga_)
        DG_START(44, dg44_)
        {
            const int s = tid >> 4, r2 = (tid & 15) * 2; const f32x2 yv = *(const LAS f32x2*)(yb + s * 32 + r2);
            *(GAS unsigned*)(P + (size_t)(tokb + cc * CH + s) * PP + h * 64 + half * 32 + r2) = pk2(yv.x, yv.y);
        }
        DG_STOP(44, dg44_, dga_)
    }
    __syncthreads();
    DG_STOP(41, dg41_, dga_)
    DG_WRITE(40, unit == 0 && l == 0 && wave == 0 && lane == 0, dga_)
    DG_WRITE(41, unit == 0 && l == 0 && wave == 0 && lane == 0, dga_)
    DG_WRITE(42, unit == 0 && l == 0 && wave == 0 && lane == 0, dga_)
    DG_WRITE(43, unit == 0 && l == 0 && wave == 0 && lane == 0, dga_)
    DG_WRITE(45, unit == 0 && l == 0 && wave == 7 && lane == 0, dga_)
    DG_WRITE(46, unit == 0 && l == 0 && wave == 5 && lane == 0, dga_)
    DG_WRITE(44, unit == 0 && l == 0 && wave == 0 && lane == 0, dga_)
#undef RW_LOAD
#undef RW_LOAD2
#undef RW_ROT
#undef RW_ST1
#undef RW_STORE
}
__device__ __forceinline__ void rwkv_post(const Frame& F, int l) {
    bf16* P = (bf16*)(F.ws + WS_P); const bf16* VF = (const bf16*)(F.ws + WS_VF); const bf16* Gg = (const bf16*)(F.ws + WS_G); const float* BON = (const float*)(F.ws + WS_BON);
    const int sub = F.tid >> 4, c4 = (F.tid & 15) * 4;
    for (int pr = F.vcu * 32 + sub; pr < M * 6; pr += F.G * 32) { const int tok = pr / 6, h = pr - tok * 6;
        const unsigned long long yw = *(const GAS unsigned long long*)(P + (size_t)tok * PP + h * 64 + c4), vw = *(const GAS unsigned long long*)(VF + (size_t)tok * AW + h * 64 + c4), gw = *(const GAS unsigned long long*)(Gg + (size_t)tok * AW + h * 64 + c4);
        const f32x4 lnw = *(const f32x4*)(F.in[I_LNW] + l * AW + h * 64 + c4), lnb = *(const f32x4*)(F.in[I_LNB] + l * AW + h * 64 + c4);
        const float bon = BON[(size_t)tok * 6 + h];
        const f32x4 yv = (f32x4){bflo((unsigned)yw), bfhi((unsigned)yw), bflo((unsigned)(yw >> 32)), bfhi((unsigned)(yw >> 32))};
        const f32x4 vv = (f32x4){bflo((unsigned)vw), bfhi((unsigned)vw), bflo((unsigned)(vw >> 32)), bfhi((unsigned)(vw >> 32))};
        const f32x4 gg = (f32x4){bflo((unsigned)gw), bfhi((unsigned)gw), bflo((unsigned)(gw >> 32)), bfhi((unsigned)(gw >> 32))};
        float sm = (yv[0] + yv[1]) + (yv[2] + yv[3]);
        sm += __shfl_xor(sm, 1); sm += __shfl_xor(sm, 2); sm += __shfl_xor(sm, 4); sm += __shfl_xor(sm, 8);
        const float mean = sm * (1.0f / 64.0f); const f32x4 dv = yv - mean;
        float vs = (dv[0] * dv[0] + dv[1] * dv[1]) + (dv[2] * dv[2] + dv[3] * dv[3]);
        vs += __shfl_xor(vs, 1); vs += __shfl_xor(vs, 2); vs += __shfl_xor(vs, 4); vs += __shfl_xor(vs, 8);
        const float rs = 1.0f / sqrtf(vs * (1.0f / 64.0f) + 64e-5f);
        const f32x4 o = (dv * rs * lnw + lnb + bon * vv) * gg;
        *(GAS unsigned long long*)(P + (size_t)tok * PP + h * 64 + c4) = (unsigned long long)pk2(o[0], o[1]) | ((unsigned long long)pk2(o[2], o[3]) << 32);
    }
}

typedef short bf16x8_t __attribute__((ext_vector_type(8)));
typedef short s16x4_t __attribute__((ext_vector_type(4)));
typedef float f32x16_t __attribute__((ext_vector_type(16)));
__device__ __forceinline__ unsigned fkey(float f) { const unsigned u = __float_as_uint(f); return (u & 0x80000000u) ? ~u : (u | 0x80000000u); }
__device__ __forceinline__ int crow32(int r, int hi) { return (r & 3) + 8 * (r >> 2) + 4 * hi; }
__device__ __forceinline__ unsigned off_a(unsigned row, unsigned ch) { return 2048u * (row >> 3) + 512u * (ch >> 2) + 64u * (row & 7) + 16u * ((ch & 3) ^ ((row >> 2) & 3)); }

__device__ __forceinline__ void idx_scores(const bf16x8_t (&Af)[2], const bf16x8_t (&Bf)[8][2], const float (&iwf)[8], float (&sc)[4]) {
    sc[0] = sc[1] = sc[2] = sc[3] = 0.f;
#pragma unroll
    for (int h = 0; h < 8; ++h) { f32x4 a = (f32x4){0.f, 0.f, 0.f, 0.f};
        a = __builtin_amdgcn_mfma_f32_16x16x32_bf16(Af[0], Bf[h][0], a, 0, 0, 0);
        a = __builtin_amdgcn_mfma_f32_16x16x32_bf16(Af[1], Bf[h][1], a, 0, 0, 0);
#pragma unroll
        for (int r = 0; r < 4; ++r) sc[r] = fmaf(iwf[h], __builtin_amdgcn_fmed3f(a[r], 0.f, __builtin_inff()), sc[r]); }
}
__device__ __forceinline__ void idx_load_q(const bf16* P, int tokq, bf16x8_t (&Bf)[8][2], float (&iwf)[8], int fq) {
    const bf16* row = P + (size_t)tokq * PP;
#pragma unroll
    for (int h = 0; h < 8; ++h)
#pragma unroll
        for (int ks = 0; ks < 2; ++ks) Bf[h][ks] = *(const GAS bf16x8_t*)(row + PBIQ + h * 64 + ks * 32 + fq * 8);
    const v4u w = *(const GAS v4u*)(row + PBIW); float f[8]; unpack8(w, f);
#pragma unroll
    for (int h = 0; h < 8; ++h) iwf[h] = f[h] * (0.35355339059327373f * 0.125f);
}

__device__ __forceinline__ void lds_barrier() { asm volatile("s_waitcnt lgkmcnt(0)" ::: "memory"); __builtin_amdgcn_s_barrier(); asm volatile("" ::: "memory"); }
__device__ __forceinline__ void dsa_thr_unit(const Frame& F, int unit) {
    LAS unsigned* sk = (LAS unsigned*)F.lds;
    const int lane = F.lane, wave = F.wave, fr = lane & 15, fq = lane >> 4;
    const int b = unit & 7, qb = 127 - (unit >> 3), t0 = qb * 16, tok0 = b * SEQ + t0;
    const bf16* P = (const bf16*)(F.ws + WS_P);
    unsigned dga_ = 0;
    DG_START(10, dg10_)
    {
        bf16x8_t Bf[8][2]; float iwf[8];
        idx_load_q(P, tok0 + fr, Bf, iwf, fq);
        bf16x8_t An[2];
        { const int kt0 = wave <= qb ? wave : qb; const bf16* krow = P + (size_t)(b * SEQ + kt0 * 16 + fr) * PP + PBIK + fq * 8; An[0] = *(const GAS bf16x8_t*)(krow); An[1] = *(const GAS bf16x8_t*)(krow + 32); }
        for (int kt = wave; kt <= qb; kt += 8) {
            bf16x8_t Af[2]; Af[0] = An[0]; Af[1] = An[1];
            { const int ktn = kt + 8 <= qb ? kt + 8 : qb; const bf16* krow = P + (size_t)(b * SEQ + ktn * 16 + fr) * PP + PBIK + fq * 8; An[0] = *(const GAS bf16x8_t*)(krow); An[1] = *(const GAS bf16x8_t*)(krow + 32); }
            float sc[4]; idx_scores(Af, Bf, iwf, sc);
            v4u kv;
            const int s0 = kt * 16 + 4 * fq, t = t0 + fr;
            kv.x = (s0 + 0 <= t) ? fkey(sc[0]) : 0u; kv.y = (s0 + 1 <= t) ? fkey(sc[1]) : 0u; kv.z = (s0 + 2 <= t) ? fkey(sc[2]) : 0u; kv.w = (s0 + 3 <= t) ? fkey(sc[3]) : 0u;
            *(LAS v4u*)(sk + fr * 2048 + s0) = kv;
        }
    }
    __syncthreads();
    DG_STOP(10, dg10_, dga_)
    DG_WRITE(10, unit == 0 && wave == 0 && lane == 0, dga_)
    DG_START(11, dg11_)
    unsigned* THR = (unsigned*)(F.ws + WS_THR); int* SCUT = (int*)(F.ws + WS_SCUT);
    for (int qi = 0; qi < 2; ++qi) { const int q = 2 * wave + qi, t = t0 + q, n = t + 1;
        unsigned thr = 0u; int scut = SEQ - 1;
        if (n > TOPK) {
            unsigned keys[32];
#pragma unroll
            for (int i = 0; i < 32; ++i) keys[i] = (64 * i + lane <= t) ? sk[q * 2048 + 64 * i + lane] : 0u;
            unsigned prefix = 0u; bool done = false;
            const int ng = (t >> 9) + 1;
            for (int bit = 31; bit >= 0; --bit) { const unsigned cand = prefix | (1u << bit); int cnt = 0;
#pragma unroll
                for (int g = 0; g < 4; ++g) if (g < ng) {
#pragma unroll
                    for (int i = 8 * g; i < 8 * g + 8; ++i) cnt += __popcll(__ballot(keys[i] >= cand)); }
                if (cnt >= TOPK) prefix = cand;
                if (cnt == TOPK) { thr = cand - 1u; scut = -1; done = true; break; } }
            if (!done) {
                int cgt = 0;
#pragma unroll
                for (int i = 0; i < 32; ++i) cgt += __popcll(__ballot(keys[i] > prefix));
                int need = TOPK - cgt, run = 0; thr = prefix; scut = SEQ - 1; bool found = false;
#pragma unroll
                for (int i = 0; i < 32; ++i) { unsigned long long mk = __ballot(keys[i] == prefix); const int c = __popcll(mk);
                    if (!found && run + c >= need) { int k = need - run; while (k > 1) { mk &= mk - 1ull; --k; } scut = 64 * i + (int)__builtin_ctzll(mk); found = true; }
                    run += c; }
            }
        }
        if (lane == 0) { THR[tok0 + q] = thr; SCUT[tok0 + q] = scut; }
    }
    DG_STOP(11, dg11_, dga_)
    DG_WRITE(11, unit == 0 && wave == 0 && lane == 0, dga_)
    __syncthreads();
}

constexpr int QLP = 136;
constexpr int MKP = 36;
constexpr int DA_MASK = 0, DA_QL = 2 * 32 * MKP * 4, DA_CT = DA_QL + 6 * 32 * QLP * 2;
__device__ __forceinline__ void dsa_mask_tile(const bf16x8_t (&Af)[2][2], const bf16x8_t (&Bf)[8][2], const float (&iwf)[8], int j, int kmax, int t, unsigned thr, int scut, int fq, LAS float* mrow) {
#pragma unroll
    for (int k2 = 0; k2 < 2; ++k2) { const int kt = 2 * j + k2; f32x4 mv = (f32x4){-1e30f, -1e30f, -1e30f, -1e30f};
        if (kt <= kmax) { float sc[4]; idx_scores(Af[k2], Bf, iwf, sc);
            const int s0 = kt * 16 + 4 * fq;
#pragma unroll
            for (int r = 0; r < 4; ++r) { const unsigned key = fkey(sc[r]); const int s = s0 + r;
                const bool sel = (s <= t) & ((key > thr) | ((key == thr) & (s <= scut)));
                mv[r] = sel ? 0.f : -1e30f; } }
        *(LAS f32x4*)(mrow + k2 * 16 + 4 * fq) = mv; }
}
__device__ __forceinline__ void dsa_attn_unit(const Frame& F, int l, int unit) {
    const int tid = F.tid, lane = F.lane, wave = F.wave, r32 = lane & 31, hi = lane >> 5;
    const int b = unit & 7, qb = 63 - (unit >> 3), t0 = qb * 32, tok0 = b * SEQ + t0, ntile = qb + 1;
    bf16* P = (bf16*)(F.ws + WS_P); const bf16* C = (const bf16*)(F.ws + WS_C);
    LAS float* MASK = (LAS float*)(F.lds + DA_MASK); LAS unsigned char* QLb = F.lds + DA_QL; LAS unsigned char* CT = F.lds + DA_CT;
    const int crow_ = tid >> 4, cch = tid & 15; const unsigned cdst = off_a((unsigned)crow_, (unsigned)cch);
    const bf16* csrc = C + (size_t)(b * SEQ + crow_) * 128 + cch * 8;
    v4u cpre = *(const GAS v4u*)(csrc);
    if (wave >= 6) {
        const int fr = lane & 15, fq = lane >> 4, qh = wave - 6;
        bf16x8_t Bf[8][2]; float iwf[8]; bf16x8_t Af[2][2];
        const int tq = tok0 + 16 * qh + fr, tq_t = t0 + 16 * qh + fr, kmax = 2 * qb + qh;
        idx_load_q(P, tq, Bf, iwf, fq);
        const unsigned thr = ((const unsigned*)(F.ws + WS_THR))[tq]; const int scut = ((const int*)(F.ws + WS_SCUT))[tq];
        const bf16* kbase = P + (size_t)(b * SEQ + fr) * PP + PBIK + fq * 8;
#define DA_LOADA(dst, jt) do { _Pragma("unroll") for (int k2_ = 0; k2_ < 2; ++k2_) { const int kt_ = 2 * (jt) + k2_; const int ktc = kt_ <= kmax ? kt_ : kmax; const bf16* kr = kbase + (size_t)ktc * 16 * PP; \
            dst[k2_][0] = *(const GAS bf16x8_t*)(kr); dst[k2_][1] = *(const GAS bf16x8_t*)(kr + 32); } } while (0)
        bf16x8_t An[2][2];
        DA_LOADA(Af, 0);
        dsa_mask_tile(Af, Bf, iwf, 0, kmax, tq_t, thr, scut, fq, MASK + (16 * qh + fr) * MKP);
        DA_LOADA(An, 1);
        *(LAS v4u*)(CT + cdst) = cpre;
        lds_barrier();
        unsigned dga_ = 0;
        for (int j = 0; j < ntile; ++j) {
            DG_START(2, dgt_)
            if (j + 1 < ntile) {
#pragma unroll
                for (int k2 = 0; k2 < 2; ++k2) { Af[k2][0] = An[k2][0]; Af[k2][1] = An[k2][1]; }
                DA_LOADA(An, j + 2);
                cpre = *(const GAS v4u*)(csrc + (size_t)(j + 1) * 32 * 128);
                dsa_mask_tile(Af, Bf, iwf, j + 1, kmax, tq_t, thr, scut, fq, MASK + ((j + 1) & 1) * (32 * MKP) + (16 * qh + fr) * MKP);
                *(LAS v4u*)(CT + ((j + 1) & 1) * 8192 + cdst) = cpre; }
            DG_STOP(2, dgt_, dga_)
            lds_barrier();
        }
        DG_WRITE(2, unit == 0 && l == 0 && wave == 6 && lane == 0, dga_)
#undef DA_LOADA
        lds_barrier();
        return;
    }
    const int h = wave;
    LAS unsigned char* QLh = QLb + h * (32 * QLP * 2);
    {
        unsigned zo_ = 0u; asm volatile("" : "+v"(zo_));
        const bf16* wukT = (const bf16*)(F.ws + WS_WUKT) + (size_t)(l * 6 + h) * 128 * 64 + zo_;
        bf16x8_t qf[4];
#pragma unroll
        for (int ks = 0; ks < 4; ++ks) qf[ks] = *(const GAS bf16x8_t*)(P + (size_t)(tok0 + r32) * PP + PBQ + h * 64 + ks * 16 + hi * 8);
#pragma unroll
        for (int blk = 0; blk < 4; ++blk) { f32x16_t x;
#pragma unroll
            for (int i = 0; i < 16; ++i) x[i] = 0.f;
#pragma unroll
            for (int ks = 0; ks < 4; ++ks) { const bf16x8_t a = *(const GAS bf16x8_t*)(wukT + (size_t)(blk * 32 + r32) * 64 + ks * 16 + hi * 8); x = __builtin_amdgcn_mfma_f32_32x32x16_bf16(a, qf[ks], x, 0, 0, 0); }
#pragma unroll
            for (int g = 0; g < 4; ++g) { const float sc = 0.125f * 1.4426950408889634f;
                const unsigned long long w = (unsigned long long)pk2(x[4 * g] * sc, x[4 * g + 1] * sc) | ((unsigned long long)pk2(x[4 * g + 2] * sc, x[4 * g + 3] * sc) << 32);
                *(LAS unsigned long long*)(QLh + (r32 * QLP + blk * 32 + 8 * g + 4 * hi) * 2) = w; } }
    }
    *(LAS v4u*)(CT + cdst) = cpre;
    lds_barrier();
    f32x16_t o[4]; float m_run = -1e30f, l_run = 0.f;
    const LAS unsigned char* qlrow = QLh + (r32 * QLP + 8 * hi) * 2;
#pragma unroll
    for (int c = 0; c < 4; ++c)
#pragma unroll
        for (int i = 0; i < 16; ++i) o[c][i] = 0.f;
    const unsigned rr_ = ((unsigned)r32 >> 2) & 3u, rb_ = 2048u * ((unsigned)r32 >> 3) + 64u * ((unsigned)r32 & 7u);
    const unsigned rbase0 = rb_ + 16u * ((unsigned)hi ^ rr_), rbase1 = rb_ + 16u * ((2u + (unsigned)hi) ^ rr_);
    const unsigned blk_ = (lane >> 4) & 1, q_ = (lane & 15) >> 2, p_ = lane & 3;
    unsigned dga_ = 0;
    for (int j = 0; j < ntile; ++j) {
        DG_START(0, dgt_)
        LAS unsigned char* kb = CT + (j & 1) * 8192;
        if (j + 1 < ntile) cpre = *(const GAS v4u*)(csrc + (size_t)(j + 1) * 32 * 128);
        {
            f32x16_t S;
#pragma unroll
            for (int i = 0; i < 16; ++i) S[i] = 0.f;
#pragma unroll
            for (int s = 0; s < 8; ++s) { const bf16x8_t a = *(const LAS bf16x8_t*)(kb + ((s & 1) ? rbase1 : rbase0) + 512 * (s >> 1)); const bf16x8_t bq = *(const LAS bf16x8_t*)(qlrow + 32 * s);
                S = __builtin_amdgcn_mfma_f32_32x32x16_bf16(a, bq, S, 0, 0, 0); }
            const LAS f32x4* mk = (const LAS f32x4*)(MASK + (j & 1) * (32 * MKP) + r32 * MKP + 4 * hi);
            float tmax = -1e30f;
#pragma unroll
            for (int g = 0; g < 4; ++g) { const f32x4 mv = mk[2 * g];
#pragma unroll
                for (int e4 = 0; e4 < 4; ++e4) { S[4 * g + e4] += mv[e4]; tmax = fmaxf(tmax, S[4 * g + e4]); } }
            tmax = fmaxf(tmax, __shfl_xor(tmax, 32));
            const float m_new = fmaxf(m_run, tmax), alpha = __builtin_amdgcn_exp2f(m_run - m_new);
            float psum = 0.f; float e[16];
#pragma unroll
            for (int r = 0; r < 16; ++r) { e[r] = __builtin_amdgcn_exp2f(S[r] - m_new); psum += e[r]; }
            l_run = l_run * alpha + psum; m_run = m_new;
            if (__any(alpha != 1.0f)) {
#pragma unroll
                for (int c = 0; c < 4; ++c)
#pragma unroll
                    for (int i = 0; i < 16; ++i) o[c][i] *= alpha; }
            bf16x8_t xs[2];
#pragma unroll
            for (int s = 0; s < 2; ++s) { v4u w; w.x = pk2(e[8 * s], e[8 * s + 1]); w.y = pk2(e[8 * s + 2], e[8 * s + 3]); w.z = pk2(e[8 * s + 4], e[8 * s + 5]); w.w = pk2(e[8 * s + 6], e[8 * s + 7]); xs[s] = __builtin_bit_cast(bf16x8_t, w); }
#pragma unroll
            for (int c = 0; c < 4; ++c)
#pragma unroll
                for (int s = 0; s < 2; ++s) {
                    const unsigned a0 = off_a((unsigned)(16 * s + 4 * hi + q_), (unsigned)(4 * c + 2 * blk_ + (p_ >> 1))) + 8u * (p_ & 1);
                    const unsigned a1 = off_a((unsigned)(16 * s + 8 + 4 * hi + q_), (unsigned)(4 * c + 2 * blk_ + (p_ >> 1))) + 8u * (p_ & 1);
                    const s16x4_t lo = __builtin_bit_cast(s16x4_t, __builtin_amdgcn_ds_read_tr16_b64_v4i16((LAS s16x4_t*)(kb + a0)));
                    const s16x4_t hh = __builtin_bit_cast(s16x4_t, __builtin_amdgcn_ds_read_tr16_b64_v4i16((LAS s16x4_t*)(kb + a1)));
                    const bf16x8_t a = (bf16x8_t){lo[0], lo[1], lo[2], lo[3], hh[0], hh[1], hh[2], hh[3]};
                    o[c] = __builtin_amdgcn_mfma_f32_32x32x16_bf16(a, xs[s], o[c], 0, 0, 0); }
        }
        if (j + 1 < ntile) *(LAS v4u*)(CT + ((j + 1) & 1) * 8192 + cdst) = cpre;
        DG_STOP(0, dgt_, dga_)
        DG_START(1, dgw_)
        lds_barrier();
        DG_STOP(1, dgw_, dga_)
    }
    DG_WRITE(0, unit == 0 && l == 0 && wave == 0 && lane == 0, dga_)
    DG_WRITE(1, unit == 0 && l == 0 && wave == 0 && lane == 0, dga_)
    {
        const float lt = l_run + __shfl_xor(l_run, 32); const float inv = 1.0f / lt;
#pragma unroll
        for (int c = 0; c < 4; ++c)
#pragma unroll
            for (int g = 0; g < 4; ++g) { const unsigned long long w = (unsigned long long)pk2(o[c][4 * g] * inv, o[c][4 * g + 1] * inv) | ((unsigned long long)pk2(o[c][4 * g + 2] * inv, o[c][4 * g + 3] * inv) << 32);
                *(LAS unsigned long long*)(QLh + (r32 * QLP + c * 32 + 8 * g + 4 * hi) * 2) = w; }
        unsigned zo2_ = 0u; asm volatile("" : "+v"(zo2_));
        const bf16* wuvT = (const bf16*)(F.ws + WS_WUVT) + (size_t)(l * 6 + h) * 64 * 128 + zo2_;
        bf16x8_t Bo[8];
#pragma unroll
        for (int s = 0; s < 8; ++s) Bo[s] = *(const LAS bf16x8_t*)(QLh + (r32 * QLP + 16 * s + 8 * hi) * 2);
#pragma unroll
        for (int mb = 0; mb < 2; ++mb) { f32x16_t y;
#pragma unroll
            for (int i = 0; i < 16; ++i) y[i] = 0.f;
#pragma unroll
            for (int s = 0; s < 8; ++s) { const bf16x8_t a = *(const GAS bf16x8_t*)(wuvT + (size_t)(mb * 32 + r32) * 128 + 16 * s + 8 * hi); y = __builtin_amdgcn_mfma_f32_32x32x16_bf16(a, Bo[s], y, 0, 0, 0); }
#pragma unroll
            for (int g = 0; g < 4; ++g) { const unsigned long long w = (unsigned long long)pk2(y[4 * g], y[4 * g + 1]) | ((unsigned long long)pk2(y[4 * g + 2], y[4 * g + 3]) << 32);
                *(GAS unsigned long long*)(P + (size_t)(tok0 + r32) * PP + 384 + h * 64 + mb * 32 + 8 * g + 4 * hi) = w; } }
    }
    lds_barrier();
}

constexpr int RP = 72;
constexpr int RT_QR = 0, RT_KR = 128 * RP * 2, RT_VV = 2 * 128 * RP * 2, RT_ST = 3 * 128 * RP * 2, RT_SS = RT_ST + 64 * RP * 2, RT_KD = RT_SS + 1024;
__device__ __forceinline__ void ret_out_unit(const Frame& F, int unit) {
    const int tid = F.tid, lane = F.lane, wave = F.wave, r32 = lane & 31, hi = lane >> 5;
    const int h = unit & 3, b = unit >> 2;
    bf16* P = (bf16*)(F.ws + WS_P); const float* tab = (const float*)(F.ws + WS_TAB);
    LAS bf16* QR = (LAS bf16*)(F.lds + RT_QR); LAS bf16* KR = (LAS bf16*)(F.lds + RT_KR); LAS bf16* VV = (LAS bf16*)(F.lds + RT_VV); LAS bf16* ST = (LAS bf16*)(F.lds + RT_ST);
    LAS float* SS = (LAS float*)(F.lds + RT_SS); LAS bf16* KD = (LAS bf16*)(F.lds + RT_KD);
    const float lg2 = log2f(1.0f - exp2f(-5.0f - (float)h));
    f32x16_t st;
#pragma unroll
    for (int i = 0; i < 16; ++i) st[i] = 0.f;
    const float cdec = exp2f(128.0f * lg2);
    for (int c = 0; c < 16; ++c) {
    const int tok0 = b * SEQ + c * 128;
    for (int idx = tid; idx < 1024; idx += NTHR) { const int m = idx >> 3, i4 = (idx & 7) * 4; const size_t ro = (size_t)(tok0 + m) * PP + h * 64 + i4;
        const unsigned long long q1w = *(const GAS unsigned long long*)(P + ro + PCQ), q2w = *(const GAS unsigned long long*)(P + ro + PCQ + 32);
        const unsigned long long k1w = *(const GAS unsigned long long*)(P + ro + PCK), k2w = *(const GAS unsigned long long*)(P + ro + PCK + 32);
        const unsigned long long v1w = *(const GAS unsigned long long*)(P + ro + PCV), v2w = *(const GAS unsigned long long*)(P + ro + PCV + 32);
        const f32x4 t0 = *(const GAS f32x4*)(tab + ((size_t)(c * 128 + m) * 32 + i4) * 2), t1 = *(const GAS f32x4*)(tab + ((size_t)(c * 128 + m) * 32 + i4) * 2 + 4);
        const float cs[4] = {t0[0], t0[2], t1[0], t1[2]}, sn[4] = {t0[1], t0[3], t1[1], t1[3]};
        const float q1[4] = {bflo((unsigned)q1w), bfhi((unsigned)q1w), bflo((unsigned)(q1w >> 32)), bfhi((unsigned)(q1w >> 32))}, q2[4] = {bflo((unsigned)q2w), bfhi((unsigned)q2w), bflo((unsigned)(q2w >> 32)), bfhi((unsigned)(q2w >> 32))};
        const float k1[4] = {bflo((unsigned)k1w), bfhi((unsigned)k1w), bflo((unsigned)(k1w >> 32)), bfhi((unsigned)(k1w >> 32))}, k2[4] = {bflo((unsigned)k2w), bfhi((unsigned)k2w), bflo((unsigned)(k2w >> 32)), bfhi((unsigned)(k2w >> 32))};
        float qa[4], qb[4], ka[4], kb[4];
#pragma unroll
        for (int j = 0; j < 4; ++j) { qa[j] = q1[j] * cs[j] - q2[j] * sn[j]; qb[j] = q1[j] * sn[j] + q2[j] * cs[j]; ka[j] = (k1[j] * cs[j] - k2[j] * sn[j]) * 0.125f; kb[j] = (k1[j] * sn[j] + k2[j] * cs[j]) * 0.125f; }
        *(LAS unsigned long long*)(QR + m * RP + i4) = (unsigned long long)pk2(qa[0], qa[1]) | ((unsigned long long)pk2(qa[2], qa[3]) << 32);
        *(LAS unsigned long long*)(QR + m * RP + 32 + i4) = (unsigned long long)pk2(qb[0], qb[1]) | ((unsigned long long)pk2(qb[2], qb[3]) << 32);
        *(LAS unsigned long long*)(KR + m * RP + i4) = (unsigned long long)pk2(ka[0], ka[1]) | ((unsigned long long)pk2(ka[2], ka[3]) << 32);
        *(LAS unsigned long long*)(KR + m * RP + 32 + i4) = (unsigned long long)pk2(kb[0], kb[1]) | ((unsigned long long)pk2(kb[2], kb[3]) << 32);
        { const float kd = exp2f((float)(127 - m) * lg2);
          *(LAS unsigned long long*)(KD + m * RP + i4) = (unsigned long long)pk2(ka[0] * kd, ka[1] * kd) | ((unsigned long long)pk2(ka[2] * kd, ka[3] * kd) << 32);
          *(LAS unsigned long long*)(KD + m * RP + 32 + i4) = (unsigned long long)pk2(kb[0] * kd, kb[1] * kd) | ((unsigned long long)pk2(kb[2] * kd, kb[3] * kd) << 32); }
        *(LAS unsigned long long*)(VV + m * RP + i4) = v1w; *(LAS unsigned long long*)(VV + m * RP + 32 + i4) = v2w; }
    if (wave < 4) {
        const int db = wave >> 1, ebs = wave & 1;
#pragma unroll
        for (int i = 0; i < 16; ++i) ST[(32 * db + crow32(i, hi)) * RP + 32 * ebs + r32] = (bf16)(pk2(st[i], 0.f) & 0xffffu);
    }
    __syncthreads();
    const int nb = wave >> 1, eb = wave & 1, n = nb * 32 + r32;
    const unsigned blk_ = (lane >> 4) & 1, q_ = (lane & 15) >> 2, p_ = lane & 3;
    bf16x8_t qf[4];
#pragma unroll
    for (int ks = 0; ks < 4; ++ks) qf[ks] = *(const LAS bf16x8_t*)(QR + n * RP + ks * 16 + hi * 8);
    f32x16_t y;
#pragma unroll
    for (int i = 0; i < 16; ++i) y[i] = 0.f;
#pragma unroll
    for (int ks = 0; ks < 4; ++ks) {
        const s16x4_t lo = __builtin_bit_cast(s16x4_t, __builtin_amdgcn_ds_read_tr16_b64_v4i16((LAS s16x4_t*)(ST + (16 * ks + 8 * hi + q_) * RP + 32 * eb + 16 * blk_ + 4 * p_)));
        const s16x4_t hh = __builtin_bit_cast(s16x4_t, __builtin_amdgcn_ds_read_tr16_b64_v4i16((LAS s16x4_t*)(ST + (16 * ks + 8 * hi + 4 + q_) * RP + 32 * eb + 16 * blk_ + 4 * p_)));
        const bf16x8_t a = (bf16x8_t){lo[0], lo[1], lo[2], lo[3], hh[0], hh[1], hh[2], hh[3]};
        y = __builtin_amdgcn_mfma_f32_32x32x16_bf16(a, qf[ks], y, 0, 0, 0); }
    { const float qd = exp2f((float)(n + 1) * lg2);
#pragma unroll
      for (int i = 0; i < 16; ++i) y[i] *= qd; }
    for (int mt = 0; mt <= nb; ++mt) {
        f32x16_t S;
#pragma unroll
        for (int i = 0; i < 16; ++i) S[i] = 0.f;
#pragma unroll
        for (int ks = 0; ks < 4; ++ks) { const bf16x8_t a = *(const LAS bf16x8_t*)(KR + (mt * 32 + r32) * RP + ks * 16 + hi * 8); S = __builtin_amdgcn_mfma_f32_32x32x16_bf16(a, qf[ks], S, 0, 0, 0); }
        float e[16];
#pragma unroll
        for (int r = 0; r < 16; ++r) { const int dm = r32 - crow32(r, hi) + 32 * (nb - mt); e[r] = (dm >= 0) ? S[r] * exp2f((float)dm * lg2) : 0.f; }
#pragma unroll
        for (int s = 0; s < 2; ++s) { v4u w; w.x = pk2(e[8 * s], e[8 * s + 1]); w.y = pk2(e[8 * s + 2], e[8 * s + 3]); w.z = pk2(e[8 * s + 4], e[8 * s + 5]); w.w = pk2(e[8 * s + 6], e[8 * s + 7]);
            const bf16x8_t xs = __builtin_bit_cast(bf16x8_t, w);
            const s16x4_t lo = __builtin_bit_cast(s16x4_t, __builtin_amdgcn_ds_read_tr16_b64_v4i16((LAS s16x4_t*)(VV + (mt * 32 + 16 * s + 4 * hi + q_) * RP + 32 * eb + 16 * blk_ + 4 * p_)));
            const s16x4_t hh = __builtin_bit_cast(s16x4_t, __builtin_amdgcn_ds_read_tr16_b64_v4i16((LAS s16x4_t*)(VV + (mt * 32 + 16 * s + 8 + 4 * hi + q_) * RP + 32 * eb + 16 * blk_ + 4 * p_)));
            const bf16x8_t a = (bf16x8_t){lo[0], lo[1], lo[2], lo[3], hh[0], hh[1], hh[2], hh[3]};
            y = __builtin_amdgcn_mfma_f32_32x32x16_bf16(a, xs, y, 0, 0, 0); }
    }
    float ss = 0.f;
#pragma unroll
    for (int i = 0; i < 16; ++i) ss += y[i] * y[i];
    ss += __shfl_xor(ss, 32);
    if (hi == 0) SS[(nb * 2 + eb) * 32 + r32] = ss;
    __syncthreads();
    ss += SS[(nb * 2 + (eb ^ 1)) * 32 + r32];
    const float rs = 1.0f / sqrtf(ss * (1.0f / 64.0f) + 1e-6f);
    const size_t ro = (size_t)(tok0 + n) * PP;
#pragma unroll
    for (int g = 0; g < 4; ++g) { const int e0 = 32 * eb + 8 * g + 4 * hi;
        const unsigned long long gw = *(const GAS unsigned long long*)(P + ro + PCG + h * 64 + e0);
        const float g0 = bflo((unsigned)gw), g1 = bfhi((unsigned)gw), g2 = bflo((unsigned)(gw >> 32)), g3 = bfhi((unsigned)(gw >> 32));
        const float o0 = g0 * sigmoid_f(g0) * y[4 * g] * rs, o1 = g1 * sigmoid_f(g1) * y[4 * g + 1] * rs, o2 = g2 * sigmoid_f(g2) * y[4 * g + 2] * rs, o3 = g3 * sigmoid_f(g3) * y[4 * g + 3] * rs;
        *(GAS unsigned long long*)(P + ro + 768 + h * 64 + e0) = (unsigned long long)pk2(o0, o1) | ((unsigned long long)pk2(o2, o3) << 32); }
    if (wave < 4) {
        const int db = wave >> 1, ebs = wave & 1;
#pragma unroll
        for (int i = 0; i < 16; ++i) st[i] *= cdec;
#pragma unroll
        for (int ks = 0; ks < 8; ++ks) {
            const s16x4_t alo = __builtin_bit_cast(s16x4_t, __builtin_amdgcn_ds_read_tr16_b64_v4i16((LAS s16x4_t*)(KD + (16 * ks + 8 * hi + q_) * RP + 32 * db + 16 * blk_ + 4 * p_)));
            const s16x4_t ahi = __builtin_bit_cast(s16x4_t, __builtin_amdgcn_ds_read_tr16_b64_v4i16((LAS s16x4_t*)(KD + (16 * ks + 8 * hi + 4 + q_) * RP + 32 * db + 16 * blk_ + 4 * p_)));
            const s16x4_t blo = __builtin_bit_cast(s16x4_t, __builtin_amdgcn_ds_read_tr16_b64_v4i16((LAS s16x4_t*)(VV + (16 * ks + 8 * hi + q_) * RP + 32 * ebs + 16 * blk_ + 4 * p_)));
            const s16x4_t bhi = __builtin_bit_cast(s16x4_t, __builtin_amdgcn_ds_read_tr16_b64_v4i16((LAS s16x4_t*)(VV + (16 * ks + 8 * hi + 4 + q_) * RP + 32 * ebs + 16 * blk_ + 4 * p_)));
            const bf16x8_t a = (bf16x8_t){alo[0], alo[1], alo[2], alo[3], ahi[0], ahi[1], ahi[2], ahi[3]}, bb = (bf16x8_t){blo[0], blo[1], blo[2], blo[3], bhi[0], bhi[1], bhi[2], bhi[3]};
            st = __builtin_amdgcn_mfma_f32_32x32x16_bf16(a, bb, st, 0, 0, 0); }
    }
    __syncthreads();
    }
}

constexpr int PT = 32, XSP = 1304;
constexpr int PR_XS = 0, PR_STG = PT * XSP * 2, PR_CONST = PR_STG + 32768, PR_MU = PR_CONST + 6 * 384 * 4;
__device__ __forceinline__ void prep_consts(const Frame& F, int l) {
    LAS float* CS = (LAS float*)(F.lds + PR_CONST);
    for (int i = F.tid; i < AW; i += NTHR) { CS[i] = F.in[I_KK][l * AW + i]; CS[AW + i] = F.in[I_KA][l * AW + i]; CS[2 * AW + i] = F.in[I_RK][l * AW + i];
        CS[3 * AW + i] = F.in[I_W0][l * AW + i]; CS[4 * AW + i] = F.in[I_A0][l * AW + i]; CS[5 * AW + i] = (l > 0) ? F.in[I_V0][(l - 1) * AW + i] : 0.f; }
    LAS float* MU = (LAS float*)(F.lds + PR_MU);
    for (int i = F.tid; i < 1296; i += NTHR) MU[i] = (i < 1280) ? F.in[I_MU][l * 1280 + i] : ((l > 0) ? F.in[I_VRMU][(l - 1) * 16 + i - 1280] : 0.f);
    __syncthreads();
}
__device__ __forceinline__ float softplus_f(float z) { return fmaxf(z, 0.f) + __logf(1.0f + __expf(-fabsf(z))); }
__device__ __forceinline__ float tanh_f(float x) { const float e = __expf(2.0f * x); return 1.0f - 2.0f * __builtin_amdgcn_rcpf(e + 1.0f); }
__device__ __forceinline__ void small_weights(const Frame& F) {
    for (int l = 0; l < DEPTH; ++l) {
        const float* w2 = F.in[I_W2] + (size_t)l * 32 * AW; const float* a2 = F.in[I_A2] + (size_t)l * 32 * AW; const float* g2 = F.in[I_G2] + (size_t)l * 64 * AW;
        const float* v2 = F.in[I_V2] + (size_t)(l > 0 ? l - 1 : 0) * 16 * AW;
        bf16* LT = (bf16*)(F.ws + WS_LORA) + (size_t)l * AW * 144;
        for (int i = F.vcu * NTHR + F.tid; i < AW * 144; i += F.G * NTHR) { const int n = i / 144, k = i - n * 144; float v;
            if (k < 32) v = w2[k * AW + n]; else if (k < 64) v = a2[(k - 32) * AW + n]; else if (k < 128) v = g2[(k - 64) * AW + n]; else v = (l > 0) ? v2[(k - 128) * AW + n] : 0.f;
            LT[i] = (bf16)f2bf(v); }
        const float* wuk = F.in[I_WUK] + (size_t)l * 6 * 64 * 128; const float* wuv = F.in[I_WUV] + (size_t)l * 6 * 128 * 64;
        bf16* wukT = (bf16*)(F.ws + WS_WUKT) + (size_t)l * 6 * 64 * 128; bf16* wuvT = (bf16*)(F.ws + WS_WUVT) + (size_t)l * 6 * 64 * 128;
        for (int i = F.vcu * NTHR + F.tid; i < 6 * 64 * 128; i += F.G * NTHR) {
            { const int hh = i / 8192, rem = i - hh * 8192, c = rem >> 6, d = rem & 63; wukT[i] = (bf16)f2bf(wuk[(hh * 64 + d) * 128 + c]); }
            { const int hh = i / 8192, rem = i - hh * 8192, d = rem >> 7, c = rem & 127; wuvT[i] = (bf16)f2bf(wuv[(hh * 128 + c) * 64 + d]); } }
    }
}
__device__ __forceinline__ void prep_tokens_unit(const Frame& F, int l, int unit) {
    LAS bf16* XS = (LAS bf16*)(F.lds + PR_XS);
    const int tid = F.tid, lane = F.lane, wave = F.wave, r32 = lane & 31, hi = lane >> 5, tok0 = unit * PT;
    const bf16* P = (const bf16*)(F.ws + WS_P);
    unsigned dga_ = 0;
    DG_START(20, dg20_)
    for (int base = 0; base < PT * 162; base += 5 * NTHR) {
        v4u cw[5], pw[5];
#pragma unroll
        for (int u = 0; u < 5; ++u) { const int idx = base + u * NTHR + tid; const int idc = idx < PT * 162 ? idx : PT * 162 - 1; const int t = idc / 162, ch = idc - t * 162, tok = tok0 + t;
            cw[u] = *(const GAS v4u*)(P + (size_t)tok * PP + ch * 8);
            const int tokp = (tok & (SEQ - 1)) != 0 ? tok - 1 : tok; pw[u] = *(const GAS v4u*)(P + (size_t)tokp * PP + ch * 8); }
#pragma unroll
        for (int u = 0; u < 5; ++u) { const int idx = base + u * NTHR + tid;
            if (idx < PT * 162) { const int t = idx / 162, ch = idx - t * 162, tok = tok0 + t, c0 = ch * 8;
                float cur[8], prv[8]; unpack8(cw[u], cur); unpack8(pw[u], prv);
                const bool first = (tok & (SEQ - 1)) == 0;
                float mv[8];
                { const LAS f32x4* mp = (const LAS f32x4*)((const LAS float*)(F.lds + PR_MU) + c0); const f32x4 m0 = mp[0], m1 = mp[1]; mv[0] = m0[0]; mv[1] = m0[1]; mv[2] = m0[2]; mv[3] = m0[3]; mv[4] = m1[0]; mv[5] = m1[1]; mv[6] = m1[2]; mv[7] = m1[3]; }
                float o[8];
#pragma unroll
                for (int j = 0; j < 8; ++j) { const float pv = first ? 0.f : prv[j]; float v = cur[j] + (pv - cur[j]) * mv[j];
                    if (c0 >= 1152 && c0 < 1184) v = tanh_f(v); else if (c0 >= 1216 && c0 < 1280) v = sigmoid_f(v);
                    o[j] = v; }
                v4u w; w.x = pk2(o[0], o[1]); w.y = pk2(o[2], o[3]); w.z = pk2(o[4], o[5]); w.w = pk2(o[6], o[7]);
                *(LAS v4u*)(XS + t * XSP + c0) = w; } }
    }
    __syncthreads();
    DG_STOP(20, dg20_, dga_)
    DG_WRITE(20, unit == 0 && l == 0 && wave == 0 && lane == 0, dga_)
    DG_START(21, dg21_)
    if (wave < 6) {
        const int h = wave;
        LAS bf16* STG = (LAS bf16*)(F.lds + PR_STG + wave * 4096);
        GAS unsigned char* wsb = (GAS unsigned char*)F.ws;
        const bf16* LT = (const bf16*)(F.ws + WS_LORA) + (size_t)l * AW * 144;
        const LAS float* CS = (const LAS float*)(F.lds + PR_CONST) + h * 64;
        const LAS float* kkw = CS; const LAS float* kaw = CS + AW; const LAS float* rkw = CS + 2 * AW; const LAS float* w0p = CS + 3 * AW; const LAS float* a0p = CS + 4 * AW; const LAS float* v0p = CS + 5 * AW;
        const LAS bf16* xrow = XS + r32 * XSP;
        float rn;
        { float ss = 0.f;
#pragma unroll
          for (int cbl = 0; cbl < 2; ++cbl)
#pragma unroll
              for (int g = 0; g < 4; ++g) { const int j0 = cbl * 32 + 8 * g + 4 * hi; const unsigned long long kw = *(const LAS unsigned long long*)(xrow + 384 + h * 64 + j0); const f32x4 kk4 = *(const LAS f32x4*)(kkw + j0);
                  const float k0 = bflo((unsigned)kw) * kk4[0], k1 = bfhi((unsigned)kw) * kk4[1], k2 = bflo((unsigned)(kw >> 32)) * kk4[2], k3 = bfhi((unsigned)(kw >> 32)) * kk4[3]; ss += (k0 * k0 + k1 * k1) + (k2 * k2 + k3 * k3); }
          ss += __shfl_xor(ss, 32); rn = 1.0f / fmaxf(sqrtf(ss), 1e-12f); }
        float bonus = 0.f;
        const int srow = lane >> 2, sch = lane & 3;
#pragma unroll
        for (int cbl = 0; cbl < 2; ++cbl) {
            asm volatile("" ::: "memory");
            const int cb0 = h * 64 + cbl * 32;
            f32x16_t wv, av, gv, mvv;
#pragma unroll
            for (int i = 0; i < 16; ++i) { wv[i] = 0.f; av[i] = 0.f; gv[i] = 0.f; mvv[i] = 0.f; }
            const bf16* lrow = LT + (size_t)(cb0 + r32) * 144 + 8 * hi;
#pragma unroll
            for (int ks = 0; ks < 9; ++ks) { const bf16x8_t a = *(const GAS bf16x8_t*)(lrow + 16 * ks); const bf16x8_t bx = *(const LAS bf16x8_t*)(xrow + 1152 + 16 * ks + 8 * hi);
                if (ks < 2) wv = __builtin_amdgcn_mfma_f32_32x32x16_bf16(a, bx, wv, 0, 0, 0);
                else if (ks < 4) av = __builtin_amdgcn_mfma_f32_32x32x16_bf16(a, bx, av, 0, 0, 0);
                else if (ks < 8) gv = __builtin_amdgcn_mfma_f32_32x32x16_bf16(a, bx, gv, 0, 0, 0);
                else mvv = __builtin_amdgcn_mfma_f32_32x32x16_bf16(a, bx, mvv, 0, 0, 0); }
            if (l > 0) {
#pragma unroll
                for (int i = 0; i < 2; ++i) { const int row = srow + 16 * i; const unsigned eo = (unsigned)(((tok0 + row) * AW + cb0 + sch * 8) * 2); *(LAS v4u*)(STG + row * 32 + sch * 8) = *(const GAS v4u*)(wsb + WS_VF + eo); } }
            unsigned long long ro[4], dd[4], k2o[4], kko[4], bpo[4], vo[4], go[4];
#pragma unroll
            for (int g = 0; g < 4; ++g) { const int j0 = cbl * 32 + 8 * g + 4 * hi;
                const unsigned long long rw = *(const LAS unsigned long long*)(xrow + h * 64 + j0), kw = *(const LAS unsigned long long*)(xrow + 384 + h * 64 + j0), vw = *(const LAS unsigned long long*)(xrow + 768 + h * 64 + j0);
                unsigned long long fw = 0ull; if (l > 0) fw = *(const LAS unsigned long long*)(STG + r32 * 32 + 8 * g + 4 * hi);
                asm volatile("" : "+v"(bonus) :: "memory");
                const f32x4 kk4 = *(const LAS f32x4*)(kkw + j0), ka4 = *(const LAS f32x4*)(kaw + j0), rk4 = *(const LAS f32x4*)(rkw + j0), w04 = *(const LAS f32x4*)(w0p + j0), a04 = *(const LAS f32x4*)(a0p + j0);
                const f32x4 v04 = *(const LAS f32x4*)(v0p + j0);
                const float rr[4] = {bflo((unsigned)rw), bfhi((unsigned)rw), bflo((unsigned)(rw >> 32)), bfhi((unsigned)(rw >> 32))};
                const float kx[4] = {bflo((unsigned)kw), bfhi((unsigned)kw), bflo((unsigned)(kw >> 32)), bfhi((unsigned)(kw >> 32))};
                const float vx[4] = {bflo((unsigned)vw), bfhi((unsigned)vw), bflo((unsigned)(vw >> 32)), bfhi((unsigned)(vw >> 32))};
                const float fx[4] = {bflo((unsigned)fw), bfhi((unsigned)fw), bflo((unsigned)(fw >> 32)), bfhi((unsigned)(fw >> 32))};
                float d_[4], k2_[4], kk_[4], bp_[4], v_[4];
#pragma unroll
                for (int e = 0; e < 4; ++e) { const int i = 4 * g + e;
                    const float sp = softplus_f(-(wv[i] + w04[e])); const float rate = __expf(-sp - 0.5f); const float d = 1.0f - __expf(-rate);
                    const float a = sigmoid_f(av[i] + a04[e]);
                    float v = vx[e]; if (l > 0) v = v + (fx[e] - v) * sigmoid_f(mvv[i] + v04[e]);
                    const float kk = kx[e] * kk4[e] * rn, k2 = kx[e] * (1.0f + (a - 1.0f) * ka4[e]);
                    d_[e] = d; k2_[e] = k2; kk_[e] = kk; bp_[e] = kk * a; v_[e] = v;
                    bonus += rr[e] * k2 * rk4[e]; }
#define PK4(x) ((unsigned long long)pk2(x[0], x[1]) | ((unsigned long long)pk2(x[2], x[3]) << 32))
                ro[g] = rw; dd[g] = PK4(d_); k2o[g] = PK4(k2_); kko[g] = PK4(kk_); bpo[g] = PK4(bp_); vo[g] = PK4(v_);
                go[g] = (unsigned long long)pk2(gv[4 * g], gv[4 * g + 1]) | ((unsigned long long)pk2(gv[4 * g + 2], gv[4 * g + 3]) << 32); }
#define PR_OUT(arr, dst) do { _Pragma("unroll") for (int g = 0; g < 4; ++g) *(LAS unsigned long long*)(STG + r32 * 32 + 8 * g + 4 * hi) = arr[g]; \
            _Pragma("unroll") for (int i = 0; i < 2; ++i) { const int row = srow + 16 * i; const unsigned eo = (unsigned)(((tok0 + row) * AW + cb0 + sch * 8) * 2); *(GAS v4u*)(wsb + dst + eo) = *(const LAS v4u*)(STG + row * 32 + sch * 8); } } while (0)
            PR_OUT(ro, WS_R); PR_OUT(dd, WS_D); PR_OUT(k2o, WS_K2); PR_OUT(kko, WS_KK); PR_OUT(bpo, WS_BP); PR_OUT(vo, WS_VF); PR_OUT(go, WS_G);
#undef PR_OUT
#undef PK4
        }
        bonus += __shfl_xor(bonus, 32);
        if (hi == 0) ((float*)(F.ws + WS_BON))[(size_t)(tok0 + r32) * 6 + h] = bonus;
    } else {
        const float* kvn = F.in[I_KVN] + l * 128; bf16* C = (bf16*)(F.ws + WS_C);
        for (int q = 0; q < 16; ++q) { const int tok = tok0 + 16 * (wave - 6) + q; const unsigned w = *(const GAS unsigned*)(P + (size_t)tok * PP + PBC + 2 * lane);
            const float c0 = bflo(w), c1 = bfhi(w); const float ss = wave_sum(c0 * c0 + c1 * c1); const float rs = 1.0f / sqrtf(ss * (1.0f / 128.0f) + 1e-6f);
            *(GAS unsigned*)(C + (size_t)tok * 128 + 2 * lane) = pk2(c0 * rs * kvn[2 * lane], c1 * rs * kvn[2 * lane + 1]); }
    }
    DG_STOP(21, dg21_, dga_)
    DG_WRITE(21, unit == 0 && l == 0 && wave == 0 && lane == 0, dga_)
    __syncthreads();
}

__device__ __forceinline__ void final_norm(const Frame& F) {
    const int gw = F.vcu * NWAVES + F.wave, NGW = F.G * NWAVES; const float* g = F.in[I_FN];
    for (int m = gw; m < M; m += NGW) { GAS f32x4* xr = (GAS f32x4*)(F.out + (size_t)m * DM) + F.lane; f32x4 v[4]; float s = 0.f;
#pragma unroll
        for (int j = 0; j < 4; ++j) { v[j] = xr[64 * j]; s += (v[j].x * v[j].x + v[j].y * v[j].y) + (v[j].z * v[j].z + v[j].w * v[j].w); }
        const float rs = 1.0f / sqrtf(wave_sum(s) * (1.0f / DM) + 1e-6f);
#pragma unroll
        for (int j = 0; j < 4; ++j) { const f32x4 gg = *(const f32x4*)(g + 4 * F.lane + 256 * j); xr[64 * j] = v[j] * rs * gg; } }
}

template <class T> __device__ __forceinline__ T* launder_ptr(T* p) {
    unsigned lo = (unsigned)(uintptr_t)p, hi = (unsigned)((uintptr_t)p >> 32);
    asm volatile("" : "+v"(lo), "+v"(hi));
    lo = __builtin_amdgcn_readfirstlane(lo); hi = __builtin_amdgcn_readfirstlane(hi);
    return (T*)(((uintptr_t)hi << 32) | (uintptr_t)lo);
}
constexpr int NPHASE = 20;
constexpr int DUP_PHASE = -1;
constexpr int QDUP = 1;
constexpr int REP_SCAN_K = 1, REP_THR_K = 1;
constexpr int NSTEP = NPHASE + (DUP_PHASE >= 0 ? 1 : 0);
constexpr int REP_THR = 1, REP_PTOK = 1, REP_KV = 1, REP_CONV = 1, REP_SCAN = 1, REP_DSA = 1, REP_RET = 1, REP_UP = 1;
#define REPL(n) for (int rep_ = 0; rep_ < (l == 0 ? (n) : 1); ++rep_)
__global__ void __launch_bounds__(NTHR, 2) fwd_kernel(Args args) {
    extern __shared__ __attribute__((aligned(16))) unsigned char lds[];
    Frame F;
    F.lds = (LAS unsigned char*)lds;
    F.tid = threadIdx.x; F.lane = F.tid & 63; F.wave = __builtin_amdgcn_readfirstlane(F.tid >> 6);
    F.G = gridDim.x; { const int bx = blockIdx.x; F.vcu = (F.G % 8 == 0) ? (bx % 8) * (F.G / 8) + bx / 8 : bx; }
    F.in = (const float* const __attribute__((address_space(4)))*)__builtin_amdgcn_kernarg_segment_ptr(); F.out = args.out; F.ws = args.ws;
    volatile LAS unsigned* MISC = (volatile LAS unsigned*)(F.lds + MISC_OFF);
    for (int u = F.tid; u < (LDS_BYTES - LDSCTL_OFF) / 4; u += NTHR) ((LAS unsigned*)(F.lds + LDSCTL_OFF))[u] = 0u;
    __syncthreads();
    const int lo = args.ph_lo, hi = args.ph_hi;
    XcdBarrier bar; bar.bar = (unsigned*)(F.ws + WS_CTL) + CW_BAR; bar.x = 0; bar.st = nullptr;
    if (hi - lo > 1) bar = xcd_barrier_post((unsigned*)(F.ws + WS_CTL) + CW_BAR, MISC + 8);
    for (int ph_ = lo; ph_ < hi; ++ph_) {
        int ph = (args.dup_phase >= 0 && ph_ > args.dup_phase) ? ph_ - 1 : ph_; asm volatile("" : "+v"(ph)); ph = __builtin_amdgcn_readfirstlane(ph);
#define PH_ENTER() \
        { unsigned z_ = 0u; int t_ = threadIdx.x; asm volatile("" : "+v"(z_), "+v"(t_)); z_ = __builtin_amdgcn_readfirstlane(z_); F.in = (const float* const __attribute__((address_space(4)))*)((const char __attribute__((address_space(4)))*)__builtin_amdgcn_kernarg_segment_ptr() + z_); F.out = args.out + z_; F.ws = args.ws + z_; \
          F.tid = t_; F.lane = t_ & 63; F.wave = __builtin_amdgcn_readfirstlane(t_ >> 6); } \
        int bx = blockIdx.x; { int g_ = gridDim.x; asm volatile("" : "+v"(bx), "+v"(g_)); bx = __builtin_amdgcn_readfirstlane(bx); g_ = __builtin_amdgcn_readfirstlane(g_); F.G = g_; F.vcu = (g_ % 8 == 0) ? (bx % 8) * (g_ / 8) + bx / 8 : bx; } \
        gu32* ctl = (gu32*)(F.ws + WS_CTL); (void)ctl; \
        bf16* XB = (bf16*)(F.ws + WS_XB); bf16* Hb = (bf16*)(F.ws + WS_H); bf16* Pb = (bf16*)(F.ws + WS_P); float* part = (float*)(F.ws + WS_PART); (void)XB; (void)Hb; (void)Pb; (void)part;
        if (ph == 0) { PH_ENTER();
            conv_weights(F, 0, 0, 3);
            p0_x(F); p0_table(F); small_weights(F);
        } else if (ph == NPHASE - 1) { PH_ENTER();
            if (DIAG_SLOT_D >= 0) {
                const unsigned* D = (const unsigned*)(F.ws + WS_DIAG); const float x0 = (float)D[0] * (1.0f / (100.0f * DIAG_DIV)); const float kq = floorf(log2f(fmaxf(x0, 1.0f)) * 2.0f); const float x = exp2f(kq * 0.5f) * 1.19f; const float c = sqrtf(fmaxf(x - 1.0f, 0.01f));
                for (size_t i = (size_t)F.vcu * NTHR + F.tid; i < (size_t)M * DM; i += (size_t)F.G * NTHR) F.out[i] = c;
            } else
            final_norm(F);
        } else {
            const int l = (ph - 1) / 9, sub = (ph - 1) - 9 * l;
            if (sub == 0 || sub == 7) { PH_ENTER();
                pg8::Gemm g{XB, (const bf16*)(F.ws + (sub == 0 ? WS_WGU1 : WS_WGU2)), M, NGU, DM, DM}; pg8::StaticOrder S; S.init(M, NGU, F.G, bx);
                pg8::EpiUp E{Hb, FFP, part};
                for (int rep = 0; rep < ((l == 0 && sub == 0) ? REP_UP : 1); ++rep) pg8::gemm_phase<pg8::EpiUp, pg8::StaticOrder, true>(F.lds, g, S, E, F.tid);
            } else if (sub == 1 || sub == 8 || sub == 6) { PH_ENTER();
                const bool op = (sub == 6);
                pg8::Gemm g{op ? Pb : Hb, (const bf16*)(F.ws + (op ? WS_WOUT : (sub == 1 ? WS_WD1 : WS_WD2))), M, DM, op ? DM : FFP, op ? PP : FFP}; pg8::StaticOrder S; S.init(M, DM, F.G, bx);
                const float* base = (l == 0 && sub == 1) ? F.in[I_X] : F.out;
                pg8::EpiRes E{base, F.out, XB, part};
                pg8::gemm_phase<pg8::EpiRes, pg8::StaticOrder, false>(F.lds, g, S, E, F.tid);
            } else if (sub == 2) { PH_ENTER();
                pg8::Gemm g{XB, (const bf16*)(F.ws + WS_WIN), M, PP, DM, DM}; pg8::StaticOrder S; S.init(M, PP, F.G, bx);
                pg8::EpiP E{Pb, PP, part};
                pg8::gemm_phase<pg8::EpiP, pg8::StaticOrder, true>(F.lds, g, S, E, F.tid);
            } else if (sub == 3) { PH_ENTER();
                for (int rep_ = 0; rep_ < (l == 0 ? args.rep_thr : 1); ++rep_) for (int u = F.vcu; u < M / 16; u += F.G) dsa_thr_unit(F, u);
                prep_consts(F, l);
                REPL(REP_PTOK) for (int u = F.vcu; u < M / PT; u += F.G) prep_tokens_unit(F, l, u);

            } else if (sub == 5) { PH_ENTER();
                rwkv_post(F, l);
            } else if (sub == 4) { PH_ENTER();
                if (bx < BATCH * 12) { for (int rep_ = 0; rep_ < (l == 0 ? args.rep_scan : 1); ++rep_) rwkv_scan_unit(F, l, bx); }
                else {
                    gu32* qh = ctl + CW_QUEUE + 64 * l;
                    for (;;) {
                        if (F.tid == 0) MISC[0] = __hip_atomic_fetch_add(qh, 1u, RLX_AGENT);
                        __syncthreads();
                        const int u = (int)MISC[0];
                        __syncthreads();
                        const int nd = (l == 0 ? args.qdup : 1) * (M / 32);
                        { unsigned z_ = 0u; int t_ = threadIdx.x; asm volatile("" : "+v"(z_), "+v"(t_)); z_ = __builtin_amdgcn_readfirstlane(z_); F.ws = args.ws + z_; F.tid = t_; F.lane = t_ & 63; F.wave = __builtin_amdgcn_readfirstlane(t_ >> 6); }
                        const int ncv = (conv_flat_items(l + 1 < DEPTH) + NWAVES - 1) / NWAVES;
                        if (u >= nd + BATCH * 4 + ncv) break;
                        if (u < BATCH * 4) ret_out_unit(F, u);
                        else if (u < nd + BATCH * 4) dsa_attn_unit(F, l, (u - BATCH * 4) % (M / 32));
                        else { conv_unit(F, l, u - nd - BATCH * 4); __syncthreads(); }
                    }
                }
            }
        }
        if (ph_ + 1 < hi) xcd_barrier(bar);
    }
}

extern "C" void kernel_launch(void* const* d_in, const int* in_sizes, int n_in, void* d_out, int out_size, void* d_ws, size_t ws_size, hipStream_t stream) {
    static int grid = 0;
    if (grid == 0) {
        if (n_in != 31 || out_size != M * DM || ws_size < WS_END) { fprintf(stderr, "kernel_launch: unexpected shapes (n_in %d, out %d, ws %zu)\n", n_in, out_size, ws_size); grid = -1; return; }
        int dev = 0, cus = 0, per_cu = 0;
        if (hipGetDevice(&dev) != hipSuccess || hipDeviceGetAttribute(&cus, hipDeviceAttributeMultiprocessorCount, dev) != hipSuccess) { grid = -1; return; }
        if (hipFuncSetAttribute((const void*)fwd_kernel, hipFuncAttributeMaxDynamicSharedMemorySize, LDS_BYTES) != hipSuccess) { fprintf(stderr, "kernel_launch: hipFuncSetAttribute failed\n"); grid = -1; return; }
        if (hipOccupancyMaxActiveBlocksPerMultiprocessor(&per_cu, (const void*)fwd_kernel, NTHR, LDS_BYTES) != hipSuccess || per_cu < 1) fprintf(stderr, "kernel_launch: occupancy query says %d\n", per_cu);
        (void)hipGetLastError();
        grid = cus;
    }
    if (grid < 0) return;
    if (hipMemsetAsync((char*)d_ws + WS_CTL, 0, CTL_ZERO_BYTES, stream) != hipSuccess) return;
    Args a{};
    for (int i = 0; i < 31; ++i) a.in[i] = (const float*)d_in[i];
    a.out = (float*)d_out; a.ws = (unsigned char*)d_ws; a.dup_phase = DUP_PHASE; a.qdup = QDUP; a.rep_scan = REP_SCAN_K; a.rep_thr = REP_THR_K;
#ifndef ONE_LAUNCH
#define ONE_LAUNCH 1
#endif
    if (ONE_LAUNCH) { a.ph_lo = 0; a.ph_hi = NSTEP; hipLaunchKernelGGL(fwd_kernel, dim3(grid), dim3(NTHR), LDS_BYTES, stream, a); }
    else for (int ph = 0; ph < NPHASE; ++ph) { a.ph_lo = ph; a.ph_hi = ph + 1; hipLaunchKernelGGL(fwd_kernel, dim3(grid), dim3(NTHR), LDS_BYTES, stream, a); }
}
```

```cpp
#include <hip/hip_runtime.h>
#include <cstdio>
#include <cstdint>
#include <cmath>

namespace pg8 {
#define PG8_LAS __attribute__((address_space(3)))
typedef unsigned short bf16_t;
typedef short bf16x8 __attribute__((ext_vector_type(8)));
typedef float f32x4 __attribute__((ext_vector_type(4)));
typedef unsigned u32x4 __attribute__((ext_vector_type(4)));
constexpr int BM = 256, BK = 64, HALF = 128, HTB = HALF * BK * 2  , STAGE_BYTES = 8 * HTB, NXCD = 8, WGM = 8;

__host__ __device__ __forceinline__ int lds_byte(int r, int c) { const int st = (r >> 4) * 2 + (c >> 5), rr = r & 15, cc = c & 31, ob = rr * 64 + cc * 2; return st * 1024 + (ob ^ (((ob >> 9) & 1) << 5)); }
__host__ __device__ __forceinline__ void stage_rc(int b, int& R, int& C) { const int st = b / 1024, sb = b % 1024, swz = sb ^ (((sb >> 9) & 1) << 5); R = (st >> 1) * 16 + swz / 64; C = (st & 1) * 32 + (swz % 64) / 2; }
__host__ __device__ __forceinline__ int perm32(int rho) { const int n = rho >> 4, i = rho & 15; return 8 * (i >> 2) + 4 * n + (i & 3); }

struct Unit { int pm, pn; };
struct Gemm { const bf16_t* A; const bf16_t* Bt; int M, N, K, lda; };

struct StaticOrder {
    int nM, nN, nwg, G, c;
    __host__ __device__ void init(int M, int N, int G_, int c_) { nM = M / BM; nN = N / BM; nwg = nM * nN; G = G_; c = c_; }
    __host__ __device__ bool next(int i, Unit& u) const {
        const long L = (long)i * G + c; if (L >= nwg) return false;
        int wgid = (int)L; { const int q = nwg / NXCD, r = nwg % NXCD, xcd = wgid % NXCD, off = wgid / NXCD; wgid = (xcd < r ? xcd * (q + 1) : r * (q + 1) + (xcd - r) * q) + off; }
        const int nig = WGM * nN, gid = wgid / nig, fm = gid * WGM, gsz = (nM - fm) < WGM ? (nM - fm) : WGM;
        u.pm = fm + ((wgid % nig) % gsz); u.pn = (wgid % nig) / gsz; return true;
    }
    __device__ __forceinline__ void a_ready(const Unit&) const {}
    __device__ __forceinline__ void done(const Unit&) const {}
};

__device__ __forceinline__ unsigned cvt_pk_bf16(float lo, float hi) { unsigned r; asm volatile("v_cvt_pk_bf16_f32 %0, %1, %2" : "=v"(r) : "v"(lo), "v"(hi)); return r; }


__device__ __forceinline__ float row_rstd(const float* part, int row) {
    const f32x4* p = (const f32x4*)(part + (size_t)row * 16);
    const f32x4 a = p[0], b = p[1], c = p[2], d = p[3];
    const float s = ((a[0] + a[1]) + (a[2] + a[3])) + ((b[0] + b[1]) + (b[2] + b[3])) + ((c[0] + c[1]) + (c[2] + c[3])) + ((d[0] + d[1]) + (d[2] + d[3]));
    return 1.0f / sqrtf(s * (1.0f / 1024.0f) + 1e-6f);
}
__device__ __forceinline__ float silu_f(float x) { return x * __builtin_amdgcn_rcpf(1.0f + __expf(-x)); }

struct EpiUp {
    static constexpr bool PERM = true;
    bf16_t* H; int ldh; const float* part;
    __device__ __forceinline__ void operator()(const f32x4 (&acc)[2][2][4][2], const Unit& u, int wr, int wc, int fr, int fq) const {
        const int row0 = u.pm * BM + wr * 64 + fr, hcol = u.pn * 128 + wc * 32 + 8 * fq;
#pragma unroll
        for (int ai = 0; ai < 2; ++ai)
#pragma unroll
            for (int m = 0; m < 4; ++m) { const int row = row0 + ai * HALF + m * 16; const float rs = row_rstd(part, row);
                const f32x4 g0 = acc[ai][0][m][0] * rs, g1 = acc[ai][0][m][1] * rs, u0 = acc[ai][1][m][0] * rs, u1 = acc[ai][1][m][1] * rs;
                u32x4 w; w.x = cvt_pk_bf16(silu_f(g0[0]) * u0[0], silu_f(g0[1]) * u0[1]); w.y = cvt_pk_bf16(silu_f(g0[2]) * u0[2], silu_f(g0[3]) * u0[3]);
                w.z = cvt_pk_bf16(silu_f(g1[0]) * u1[0], silu_f(g1[1]) * u1[1]); w.w = cvt_pk_bf16(silu_f(g1[2]) * u1[2], silu_f(g1[3]) * u1[3]);
                *(u32x4*)(H + (size_t)row * ldh + hcol) = w; }
    }
};
struct EpiP {
    static constexpr bool PERM = true;
    bf16_t* P; int ldp; const float* part;
    __device__ __forceinline__ void operator()(const f32x4 (&acc)[2][2][4][2], const Unit& u, int wr, int wc, int fr, int fq) const {
        const int row0 = u.pm * BM + wr * 64 + fr, col0 = u.pn * BM + wc * 32 + 8 * fq;
#pragma unroll
        for (int ai = 0; ai < 2; ++ai)
#pragma unroll
            for (int m = 0; m < 4; ++m) { const int row = row0 + ai * HALF + m * 16; const float rs = row_rstd(part, row);
#pragma unroll
                for (int bj = 0; bj < 2; ++bj) { const f32x4 v0 = acc[ai][bj][m][0] * rs, v1 = acc[ai][bj][m][1] * rs;
                    u32x4 w; w.x = cvt_pk_bf16(v0[0], v0[1]); w.y = cvt_pk_bf16(v0[2], v0[3]); w.z = cvt_pk_bf16(v1[0], v1[1]); w.w = cvt_pk_bf16(v1[2], v1[3]);
                    *(u32x4*)(P + (size_t)row * ldp + col0 + bj * HALF) = w; } }
    }
};
struct EpiRes {
    static constexpr bool PERM = true;
    const float* base; float* out; bf16_t* xb; float* part;
    __device__ __forceinline__ void operator()(const f32x4 (&acc)[2][2][4][2], const Unit& u, int wr, int wc, int fr, int fq) const {
        const int row0 = u.pm * BM + wr * 64 + fr, col0 = u.pn * BM + wc * 32 + 8 * fq;
#pragma unroll
        for (int ai = 0; ai < 2; ++ai)
#pragma unroll
            for (int m = 0; m < 4; ++m) { const int row = row0 + ai * HALF + m * 16; float ss = 0.f;
#pragma unroll
                for (int bj = 0; bj < 2; ++bj) { const size_t off = (size_t)row * 1024 + col0 + bj * HALF;
                    const f32x4 v0 = acc[ai][bj][m][0] + *(const f32x4*)(base + off), v1 = acc[ai][bj][m][1] + *(const f32x4*)(base + off + 4);
                    *(f32x4*)(out + off) = v0; *(f32x4*)(out + off + 4) = v1;
                    u32x4 w; w.x = cvt_pk_bf16(v0[0], v0[1]); w.y = cvt_pk_bf16(v0[2], v0[3]); w.z = cvt_pk_bf16(v1[0], v1[1]); w.w = cvt_pk_bf16(v1[2], v1[3]);
                    *(u32x4*)(xb + off) = w;
                    ss += (v0[0] * v0[0] + v0[1] * v0[1]) + (v0[2] * v0[2] + v0[3] * v0[3]) + (v1[0] * v1[0] + v1[1] * v1[1]) + (v1[2] * v1[2] + v1[3] * v1[3]); }
                ss += __shfl_xor(ss, 16); ss += __shfl_xor(ss, 32);
                if (fq == 0) part[(size_t)row * 16 + u.pn * 4 + wc] = ss;
                asm volatile("" ::: "memory"); }
    }
};

template <class Epi, class Sched, bool ALIGN_EPI>
__device__ __forceinline__ void gemm_phase(PG8_LAS unsigned char* lds, const Gemm g, const Sched& S, const Epi& E, const int tid) {
    const int wid = __builtin_amdgcn_readfirstlane(tid >> 6), lane = tid & 63, wr = wid >> 2, wc = wid & 3, fr = lane & 15, fq = lane >> 4;
    const int K = g.K, nt = K / BK, lda = g.lda;
    unsigned voffA[2], voffB[2];
#pragma unroll
    for (int i = 0; i < 2; ++i) { int R, C; stage_rc(tid * 16 + i * 8192, R, C); const int Rb = Epi::PERM ? ((R & ~31) + perm32(R & 31)) : R;
        voffA[i] = (unsigned)(R * lda + C) * 2u; voffB[i] = (unsigned)(Rb * K + C) * 2u; }
    const size_t kstep = (size_t)(BK * 2);
    const size_t hstepA = (size_t)HALF * lda * 2, hstepB = (size_t)HALF * K * 2;
    const size_t tstepA = 2 * hstepA, tstepB = 2 * hstepB;
    const unsigned ldsw = (unsigned)wid * 1024u;
    const int aoff = lds_byte(wr * 64 + fr, fq * 8), boff = lds_byte(wc * 32 + fr, fq * 8);
#define PG8_SA(b, h) (((b) * 2 + (h)) * HTB)
#define PG8_SB(b, h) ((4 + (b) * 2 + (h)) * HTB)
#define PG8_STAGE(bufoff, gbase, voff) do { _Pragma("unroll") for (int _i = 0; _i < 2; ++_i) \
        __builtin_amdgcn_global_load_lds((const unsigned*)((const char*)(gbase) + (voff)[_i]), (PG8_LAS unsigned*)(lds + (bufoff) + ldsw + _i * 8192), 16, 0, 0); } while (0)
#define PG8_LDA(dst, b, h) do { _Pragma("unroll") for (int m = 0; m < 4; ++m) _Pragma("unroll") for (int k = 0; k < 2; ++k) dst[m][k] = *(const PG8_LAS bf16x8*)(lds + PG8_SA(b, h) + aoff + m * 2048 + k * 1024); } while (0)
#define PG8_LDB(dst, b, h) do { _Pragma("unroll") for (int n = 0; n < 2; ++n) _Pragma("unroll") for (int k = 0; k < 2; ++k) dst[n][k] = *(const PG8_LAS bf16x8*)(lds + PG8_SB(b, h) + boff + n * 2048 + k * 1024); } while (0)
#define PG8_MMA(ai, bj, At, Bt) do { __builtin_amdgcn_s_setprio(1); _Pragma("unroll") for (int m = 0; m < 4; ++m) _Pragma("unroll") for (int n = 0; n < 2; ++n) _Pragma("unroll") for (int k = 0; k < 2; ++k) \
        acc[ai][bj][m][n] = __builtin_amdgcn_mfma_f32_16x16x32_bf16(Bt[n][k], At[m][k], acc[ai][bj][m][n], 0, 0, 0); __builtin_amdgcn_s_setprio(0); } while (0)
#define PG8_WAIT_V(n) asm volatile("s_waitcnt vmcnt(" #n ")" ::: "memory")
#define PG8_WAIT_L(n) asm volatile("s_waitcnt lgkmcnt(" #n ")" ::: "memory")
#define PG8_BAR __builtin_amdgcn_s_barrier()
#define PG8_SCHED __builtin_amdgcn_sched_barrier(0)
    Unit cur, nxt; int ui = 0;
    if (!S.next(0, cur)) return;
    f32x4 acc[2][2][4][2];
#pragma unroll
    for (int a = 0; a < 2; ++a)
#pragma unroll
        for (int b = 0; b < 2; ++b)
#pragma unroll
            for (int m = 0; m < 4; ++m)
#pragma unroll
                for (int n = 0; n < 2; ++n) acc[a][b][m][n] = (f32x4){0.f, 0.f, 0.f, 0.f};
    bf16x8 At[4][2], B0[2][2], B1[2][2];
    const char* cA = (const char*)g.A + (size_t)cur.pm * tstepA; const char* cB = (const char*)g.Bt + (size_t)cur.pn * tstepB;
    S.a_ready(cur);
    PG8_STAGE(PG8_SB(0, 0), cB, voffB); PG8_STAGE(PG8_SB(0, 1), cB + hstepB, voffB); PG8_STAGE(PG8_SA(0, 0), cA, voffA); PG8_STAGE(PG8_SA(0, 1), cA + hstepA, voffA);
    if (wr == 1) PG8_BAR;
    PG8_WAIT_V(2); PG8_BAR;
    PG8_STAGE(PG8_SB(1, 0), cB + kstep, voffB); PG8_STAGE(PG8_SA(1, 0), cA + kstep, voffA); PG8_STAGE(PG8_SB(1, 1), cB + hstepB + kstep, voffB);
    PG8_WAIT_V(6); PG8_BAR;
    for (;;) {
        const bool has_next = S.next(ui + 1, nxt);
        const char* nA = has_next ? (const char*)g.A + (size_t)nxt.pm * tstepA : cA; const char* nB = has_next ? (const char*)g.Bt + (size_t)nxt.pn * tstepB : cB;
        for (int t = 0; t < nt; t += 2) {
            const bool last = (t == nt - 2);
            const char* a1 = cA + (size_t)(t + 1) * kstep;
            const char* a2 = last ? nA : cA + (size_t)(t + 2) * kstep; const char* b2 = last ? nB : cB + (size_t)(t + 2) * kstep;
            const char* a3 = a2 + kstep; const char* b3 = b2 + kstep;
            if (last && has_next) S.a_ready(nxt);
            PG8_LDB(B0, 0, 0); PG8_LDB(B1, 0, 1); PG8_SCHED; PG8_LDA(At, 0, 0); PG8_STAGE(PG8_SA(1, 1), a1 + hstepA, voffA);
            PG8_WAIT_V(8); PG8_WAIT_L(0); PG8_BAR; PG8_MMA(0, 0, At, B0); PG8_MMA(0, 1, At, B1); PG8_BAR; PG8_SCHED;
            PG8_LDA(At, 0, 1); PG8_STAGE(PG8_SB(0, 0), b2, voffB); PG8_STAGE(PG8_SB(0, 1), b2 + hstepB, voffB); PG8_STAGE(PG8_SA(0, 0), a2, voffA);
            PG8_WAIT_V(8); PG8_WAIT_L(0); PG8_BAR; PG8_MMA(1, 0, At, B0); PG8_MMA(1, 1, At, B1); PG8_BAR; PG8_SCHED;
            PG8_LDB(B0, 1, 0); PG8_LDB(B1, 1, 1); PG8_SCHED; PG8_LDA(At, 1, 0); PG8_STAGE(PG8_SA(0, 1), a2 + hstepA, voffA);
            PG8_WAIT_V(8); PG8_WAIT_L(0); PG8_BAR; PG8_MMA(0, 0, At, B0); PG8_MMA(0, 1, At, B1); PG8_BAR; PG8_SCHED;
            PG8_LDA(At, 1, 1); PG8_STAGE(PG8_SB(1, 0), b3, voffB); PG8_STAGE(PG8_SB(1, 1), b3 + hstepB, voffB); PG8_STAGE(PG8_SA(1, 0), a3, voffA);
            PG8_WAIT_V(8); PG8_WAIT_L(0); PG8_BAR; PG8_MMA(1, 0, At, B0); PG8_MMA(1, 1, At, B1); PG8_BAR; PG8_SCHED;
        }
        if constexpr (ALIGN_EPI) { if (wr == 0) PG8_BAR; }
        E(acc, cur, wr, wc, fr, fq); S.done(cur);
        if (!has_next) break;
#pragma unroll
        for (int a = 0; a < 2; ++a)
#pragma unroll
            for (int b = 0; b < 2; ++b)
#pragma unroll
                for (int m = 0; m < 4; ++m)
#pragma unroll
                    for (int n = 0; n < 2; ++n) acc[a][b][m][n] = (f32x4){0.f, 0.f, 0.f, 0.f};
        cur = nxt; cA = nA; cB = nB; ++ui;
        if constexpr (ALIGN_EPI) { if (wr == 1) PG8_BAR; }
    }
    PG8_WAIT_V(0);
    if constexpr (!ALIGN_EPI) { if (wr == 0) PG8_BAR; }
    PG8_BAR;
#undef PG8_SA
#undef PG8_SB
#undef PG8_STAGE
#undef PG8_LDA
#undef PG8_LDB
#undef PG8_MMA
#undef PG8_WAIT_V
#undef PG8_WAIT_L
#undef PG8_BAR
#undef PG8_SCHED
}
}

constexpr int NWAVES = 8, NTHR = 512;
constexpr int BATCH = 8, SEQ = 2048, DM = 1024, DEPTH = 2, FF = 2752, M = BATCH * SEQ;
constexpr int FFP = 2816;
constexpr int NGU = 5632;
constexpr int PP = 3584;
constexpr int NIN = 3400;
constexpr int PA = 0, PMV = 1280, PBQ = 1296, PBC = 1680, PBIQ = 1808, PBIK = 2320, PBIW = 2384, PCQ = 2392, PCK = 2648, PCV = 2904, PCG = 3160, PUSED = 3416;
constexpr int AW = 384;
constexpr int TOPK = 256;

constexpr size_t MiB = 1u << 20;
constexpr size_t WS_CTL = 0, CTL_ZERO_BYTES = 1 * MiB;
constexpr size_t WS_PART = 1 * MiB;
constexpr size_t WS_TAB = 2 * MiB;
constexpr size_t WS_BON = 2 * MiB + 512 * 1024;
constexpr size_t WS_WUKT = 3 * MiB, WS_WUVT = 3 * MiB + 192 * 1024;
constexpr size_t WS_THR = 3 * MiB + 384 * 1024, WS_SCUT = 3 * MiB + 448 * 1024;
constexpr size_t WS_LORA = 3 * MiB + 512 * 1024;
constexpr size_t WS_WGU1 = 4 * MiB, WS_WD1 = 15 * MiB, WS_WIN = 21 * MiB, WS_WOUT = 28 * MiB, WS_WGU2 = 30 * MiB, WS_WD2 = 41 * MiB;
constexpr size_t WS_XB = 47 * MiB;
constexpr size_t WS_VF = 79 * MiB;
constexpr size_t WS_P = 91 * MiB;
constexpr size_t WS_H = WS_P;
constexpr size_t WS_R = 203 * MiB, WS_D = 215 * MiB, WS_K2 = 227 * MiB, WS_KK = 239 * MiB, WS_C = 251 * MiB;
constexpr size_t WS_BP = WS_XB, WS_G = WS_XB + 12 * MiB, WS_KV = WS_XB + 24 * MiB;
constexpr size_t WS_END = 256 * MiB;
static_assert(WS_WD2 + (size_t)1024 * FFP * 2 <= WS_XB && WS_P + (size_t)M * PP * 2 <= WS_R && WS_C + (size_t)M * 128 * 2 <= WS_END, "ws map");
constexpr int CW_BAR = 4096;
constexpr int CW_QUEUE = 16384;

constexpr int RING_BYTES = 131072;
constexpr int LDSCTL_OFF = RING_BYTES, MISC_OFF = LDSCTL_OFF + 320;
constexpr int LDS_BYTES = 147456;

#define GAS __attribute__((address_space(1)))
#define LAS __attribute__((address_space(3)))
typedef unsigned short bf16;
typedef unsigned v4u __attribute__((ext_vector_type(4)));
typedef float f32x4 __attribute__((ext_vector_type(4)));
typedef GAS unsigned gu32;
#define RLX_AGENT __ATOMIC_RELAXED, __HIP_MEMORY_SCOPE_AGENT
#define LDS_WAIT() asm volatile("s_waitcnt lgkmcnt(0)" ::: "memory")
__device__ __forceinline__ unsigned f2bf(float f) { unsigned u = __builtin_bit_cast(unsigned, f); return (u + 0x7fffu + ((u >> 16) & 1u)) >> 16; }
typedef float f32x2v_ __attribute__((ext_vector_type(2))); typedef __bf16 bf16x2v_ __attribute__((ext_vector_type(2)));
__device__ __forceinline__ unsigned pk2(float lo, float hi) { const f32x2v_ v = {lo, hi}; return __builtin_bit_cast(unsigned, __builtin_convertvector(v, bf16x2v_)); }
__device__ __forceinline__ float bf2f(unsigned short v) { return __uint_as_float((unsigned)v << 16); }
__device__ __forceinline__ float bflo(unsigned w) { return __uint_as_float(w << 16); }
__device__ __forceinline__ float bfhi(unsigned w) { return __uint_as_float(w & 0xffff0000u); }
__device__ __forceinline__ void unpack8(const v4u w, float (&f)[8]) { f[0] = bflo(w.x); f[1] = bfhi(w.x); f[2] = bflo(w.y); f[3] = bfhi(w.y); f[4] = bflo(w.z); f[5] = bfhi(w.z); f[6] = bflo(w.w); f[7] = bfhi(w.w); }
__device__ __forceinline__ float sigmoid_f(float x) { return 1.0f / (1.0f + __expf(-x)); }
__device__ __forceinline__ float wave_sum(float v) {
#pragma unroll
    for (int o = 1; o < 64; o <<= 1) v += __shfl_xor(v, o);
    return v;
}

#define XB_TMO      128
#define XB_XCNT(j)  (256  + 64 * (j))
#define XB_XSUB(j)  (1280 + 64 * (j))
#define XB_XGEN(j)  (2304 + 64 * (j))
#define XB_TOP      3328
#define XB_TOPGEN   3392
#define XCD_BAR_WORDS 3456
#define XB_SPIN_CAP (1u << 22)

__device__ __forceinline__ unsigned xb_ld(unsigned* p)              { return __hip_atomic_load(p, __ATOMIC_RELAXED, __HIP_MEMORY_SCOPE_AGENT); }
__device__ __forceinline__ unsigned xb_add(unsigned* p, unsigned v) { return __hip_atomic_fetch_add(p, v, __ATOMIC_RELAXED, __HIP_MEMORY_SCOPE_AGENT); }
__device__ __forceinline__ unsigned xb_xcc_id() { return (unsigned)__builtin_amdgcn_s_getreg((3 << 11) | 20) & 0xFu; }
#define XB_SPIN(cond, bar) do { unsigned _sp = 0; while (cond) { __builtin_amdgcn_s_sleep(1); \
    if ((++_sp & 255u) == 0u) { if (xb_ld(&(bar)[XB_TMO])) break; if (_sp > XB_SPIN_CAP) { atomicAdd(&(bar)[XB_TMO], 1u); break; } } } } while (0)

struct XcdBarrier { unsigned* bar; unsigned x; volatile LAS unsigned* st; };

__device__ __forceinline__ XcdBarrier xcd_barrier_post(unsigned* bar, volatile LAS unsigned* st) {
    XcdBarrier b; b.bar = bar; b.x = xb_xcc_id(); b.st = st;
    if (threadIdx.x == 0) (void)xb_add(&bar[XB_XCNT(b.x)], 1u);
    return b;
}
__device__ __forceinline__ void xcd_barrier_complete(unsigned* bar, unsigned x, unsigned& nloc, unsigned& nx) {
    const unsigned G = gridDim.x * gridDim.y * gridDim.z;
    unsigned sum, cnt, mine, sp = 0u;
    for (;;) {
        sum = 0u; cnt = 0u; mine = 0u;
#pragma unroll
        for (unsigned j = 0; j < 16; ++j) { const unsigned c = xb_ld(&bar[XB_XCNT(j)]); sum += c; cnt += (c > 0u) ? 1u : 0u; mine = (j == x) ? c : mine; }
        if (sum == G) break;
        __builtin_amdgcn_s_sleep(1);
        if ((++sp & 255u) == 0u) { if (xb_ld(&bar[XB_TMO])) break; if (sp > XB_SPIN_CAP) { atomicAdd(&bar[XB_TMO], 1u); break; } }
    }
    nloc = mine > 0u ? mine : 1u; nx = cnt > 0u ? cnt : 1u;
}
__device__ __forceinline__ void xcd_barrier(const XcdBarrier& b) {
    asm volatile("s_waitcnt vmcnt(0)" ::: "memory");
    __syncthreads();
    if (threadIdx.x == 0) {
        unsigned* bar = b.bar;
        __builtin_amdgcn_s_waitcnt(0);
        unsigned nloc = b.st[0], nx = b.st[1];
        if (nloc == 0u) { xcd_barrier_complete(bar, b.x, nloc, nx); b.st[0] = nloc; b.st[1] = nx; }
        const unsigned old = xb_add(&bar[XB_XSUB(b.x)], 1u);
        const unsigned gen = old / nloc;
        if (old + 1u == (gen + 1u) * nloc) {
            __builtin_amdgcn_fence(__ATOMIC_RELEASE, "agent");
            asm volatile("s_waitcnt vmcnt(0)" ::: "memory");
            const unsigned og = xb_add(&bar[XB_TOP], 1u);
            const unsigned tg = og / nx;
            if (og + 1u == (tg + 1u) * nx) xb_add(&bar[XB_TOPGEN], 1u);
            else XB_SPIN(xb_ld(&bar[XB_TOPGEN]) == tg, bar);
            __builtin_amdgcn_fence(__ATOMIC_ACQUIRE, "agent");
            xb_add(&bar[XB_XGEN(b.x)], 1u);
            asm volatile("s_waitcnt vmcnt(0)" ::: "memory");
        } else {
            XB_SPIN(xb_ld(&bar[XB_XGEN(b.x)]) == gen, bar);
            __builtin_amdgcn_fence(__ATOMIC_ACQUIRE, "agent");
            asm volatile("s_waitcnt vmcnt(0)" ::: "memory");
        }
    }
    __syncthreads();
}

#ifndef DIAG_SLOT_D
#define DIAG_SLOT_D (-1)
#endif
#ifndef DIAG_DIV
#define DIAG_DIV 1.0f
#endif
constexpr size_t WS_DIAG = 3 * MiB + 900 * 1024;
#define DG_START(k, var) unsigned var = 0; if (DIAG_SLOT_D == (k)) var = (unsigned)__builtin_amdgcn_s_memtime();
#define DG_STOP(k, var, acc) if (DIAG_SLOT_D == (k)) acc += (unsigned)__builtin_amdgcn_s_memtime() - var;
#define DG_WRITE(k, cond, acc) if (DIAG_SLOT_D == (k) && (cond)) ((unsigned*)(F.ws + WS_DIAG))[0] = acc;
struct Args { const float* in[31]; float* out; unsigned char* ws; int ph_lo, ph_hi; int dup_phase, qdup, rep_scan, rep_thr; };
struct Frame {
    LAS unsigned char* lds;
    int tid, lane, wave, vcu, G;
    const float* const __attribute__((address_space(4)))* in;
    float* out; unsigned char* ws;
};
enum { I_X = 0, I_F1N, I_F1G, I_F1U, I_F1D, I_MIXN, I_WIN, I_WOUT, I_MU, I_W0, I_W2, I_A0, I_A2, I_G2, I_KK, I_KA, I_RK, I_LNW, I_LNB, I_VRW, I_VRMU, I_V0, I_V2, I_KVN, I_WUK, I_WUV, I_F2N, I_F2G, I_F2U, I_F2D, I_FN };

__device__ __forceinline__ void conv_item(const Frame& F, int l, int kind, int item, LAS float* scr) {
    const int lane = F.lane;
    int Kd, nkb; bf16* WT;
    if (kind == 0 || kind == 4) { Kd = 1024; WT = (bf16*)(F.ws + (kind == 0 ? WS_WGU1 : WS_WGU2)); }
    else if (kind == 1 || kind == 5) { Kd = FFP; WT = (bf16*)(F.ws + (kind == 1 ? WS_WD1 : WS_WD2)); }
    else if (kind == 2) { Kd = 1024; WT = (bf16*)(F.ws + WS_WIN); }
    else { Kd = 1024; WT = (bf16*)(F.ws + WS_WOUT); }
    nkb = Kd / 64;
    const int rb = item / nkb, kb = item % nkb, r0 = rb * 32, k0 = kb * 64;
    const int rr = r0 + (lane & 31);
    const float* src = nullptr; int ns = 0, col = 0, ksrc = 1024; const float* gain = nullptr; float scale = 1.0f;
    if (kind == 0 || kind == 4) {
        const int tile = rr >> 8, w = rr & 255, hid = tile * 128 + (w & 127);
        if (hid < FF) { const float* s1 = (w >> 7) ? F.in[I_F1U] : F.in[I_F1G]; const float* s2 = (w >> 7) ? F.in[I_F2U] : F.in[I_F2G]; src = ((kind == 0) ? s1 : s2) + (size_t)l * 1024 * FF; ns = FF; col = hid; }
        gain = ((kind == 0) ? F.in[I_F1N] : F.in[I_F2N]) + l * 1024;
    } else if (kind == 1 || kind == 5) {
        src = ((kind == 1) ? F.in[I_F1D] : F.in[I_F2D]) + (size_t)l * FF * 1024; ns = 1024; col = rr; ksrc = FF; scale = 0.5f;
    } else if (kind == 2) {
        gain = F.in[I_MIXN] + l * 1024;
        if (rr < 1280) { src = F.in[I_WIN] + (size_t)l * 1024 * NIN; ns = NIN; col = rr; }
        else if (rr < 1296) { if (l > 0) { src = F.in[I_VRW] + (size_t)(l - 1) * 1024 * 16; ns = 16; col = rr - 1280; } }
        else if (rr < PUSED) { src = F.in[I_WIN] + (size_t)l * 1024 * NIN; ns = NIN; col = rr - 16; }
    } else { src = F.in[I_WOUT] + (size_t)l * 1024 * 1024; ns = 1024; col = rr; }
    {
        const bool has = (src != nullptr); const float* sp = has ? src : F.in[I_FN]; const int nss = has ? ns : 0, cols = has ? col : 0;
        float vals[32];
#pragma unroll
        for (int i = 0; i < 32; ++i) { const int k = k0 + 2 * i + (lane >> 5); const int kc = k < ksrc ? k : ksrc - 1; vals[i] = sp[(size_t)kc * nss + cols]; }
#pragma unroll
        for (int i = 0; i < 32; ++i) { const int kk = 2 * i + (lane >> 5), k = k0 + kk; float v = (has && k < ksrc) ? vals[i] * scale : 0.f; if (gain) v *= gain[k < 1024 ? k : 1023];
            scr[kk * 33 + (lane & 31)] = v; }
    }
    LDS_WAIT(); asm volatile("" ::: "memory");
    const int c = lane & 7;
#pragma unroll
    for (int j = 0; j < 4; ++j) { const int n = (lane >> 3) + 8 * j; const LAS float* s = scr + (8 * c) * 33 + n;
        v4u o; o.x = pk2(s[0 * 33], s[1 * 33]); o.y = pk2(s[2 * 33], s[3 * 33]); o.z = pk2(s[4 * 33], s[5 * 33]); o.w = pk2(s[6 * 33], s[7 * 33]);
        *(GAS v4u*)(WT + (size_t)(r0 + n) * Kd + k0 + 8 * c) = o; }
    LDS_WAIT(); asm volatile("" ::: "memory");
}
__host__ __device__ constexpr int conv_items(int kind) { return (kind == 0 || kind == 4) ? (NGU / 32) * 16 : (kind == 1 || kind == 5) ? 32 * (FFP / 64) : (kind == 2) ? (PP / 32) * 16 : 32 * 16; }
__device__ __forceinline__ void conv_weights(const Frame& F, int l, int k_lo, int k_hi) {
    LAS float* scr = (LAS float*)(F.lds + F.wave * 16384);
    const int gw = F.vcu * NWAVES + F.wave, NGW = F.G * NWAVES;
    for (int kind = k_lo; kind < k_hi; ++kind) { const int ni = conv_items(kind);
        for (int it = gw; it < ni; it += NGW) conv_item(F, l, kind, it, scr); }
}

__host__ __device__ constexpr int conv_flat_items(bool has_next) { return conv_items(3) + conv_items(4) + conv_items(5) + (has_next ? conv_items(0) + conv_items(1) + conv_items(2) : 0); }
constexpr int CONV_PER_WAVE = 2;
__device__ __forceinline__ void conv_unit(const Frame& F, int l, int u) {
    LAS float* scr = (LAS float*)(F.lds + F.wave * 16384);
    const bool has_next = (l + 1 < DEPTH);
#pragma unroll 1
    for (int rep = 0; rep < CONV_PER_WAVE; ++rep) {
    int it = (u * CONV_PER_WAVE + rep) * NWAVES + F.wave;
    if (it >= conv_flat_items(has_next)) return;
    int layer = l, kind = 3;
    if (it >= conv_items(3)) { it -= conv_items(3); kind = 4;
        if (it >= conv_items(4)) { it -= conv_items(4); kind = 5;
            if (it >= conv_items(5)) { it -= conv_items(5); kind = 0; layer = l + 1;
                if (it >= conv_items(0)) { it -= conv_items(0); kind = 1;
                    if (it >= conv_items(1)) { it -= conv_items(1); kind = 2; } } } } }
    conv_item(F, layer, kind, it, scr);
    }
}
__device__ __forceinline__ void p0_x(const Frame& F) {
    const int gw = F.vcu * NWAVES + F.wave, NGW = F.G * NWAVES;
    const float* x = F.in[I_X]; bf16* xb = (bf16*)(F.ws + WS_XB); float* part = (float*)(F.ws + WS_PART);
    for (int m = gw; m < M; m += NGW) {
        const GAS f32x4* xr = (const GAS f32x4*)(x + (size_t)m * DM) + F.lane; float s = 0.f;
        GAS unsigned long long* o8 = (GAS unsigned long long*)(xb + (size_t)m * DM) + F.lane;
#pragma unroll
        for (int j = 0; j < 4; ++j) { const f32x4 v = xr[64 * j]; s += (v.x * v.x + v.y * v.y) + (v.z * v.z + v.w * v.w);
            o8[64 * j] = (unsigned long long)pk2(v.x, v.y) | ((unsigned long long)pk2(v.z, v.w) << 32); }
        s = wave_sum(s);
        if (F.lane < 16) part[(size_t)m * 16 + F.lane] = (F.lane == 0) ? s : 0.f;
    }
}
__device__ __forceinline__ void p0_table(const Frame& F) {
    float* tab = (float*)(F.ws + WS_TAB);
    for (int i = F.vcu * NTHR + F.tid; i < SEQ * 32; i += F.G * NTHR) { const int t = i >> 5, f = i & 31; const float th = exp2f(-(float)f * (13.287712379549449f / 31.0f)); const float ang = (float)t * th; float s, c; sincosf(ang, &s, &c); tab[2 * i] = c; tab[2 * i + 1] = s; }
}

__device__ __forceinline__ void ret_kv_unit(const Frame& F, int unit) {
    unsigned dga_ = 0;
    DG_START(30, dg30_)
    LAS float* kr = (LAS float*)F.lds; LAS float* vv = kr + 128 * 64;
    const int tid = F.tid, c = unit & 15, h = (unit >> 4) & 3, b = unit >> 6, tok0 = b * SEQ + c * 128;
    const bf16* P = (const bf16*)(F.ws + WS_P); const float* tab = (const float*)(F.ws + WS_TAB);
    const float lg2 = log2f(1.0f - exp2f(-5.0f - (float)h));
    for (int idx = tid; idx < 128 * 32; idx += NTHR) { const int m = idx >> 5, i = idx & 31; const size_t ro = (size_t)(tok0 + m) * PP;
        const float k1 = bf2f(P[ro + PCK + h * 64 + i]), k2 = bf2f(P[ro + PCK + h * 64 + 32 + i]);
        const float cs = tab[((c * 128 + m) * 32 + i) * 2], sn = tab[((c * 128 + m) * 32 + i) * 2 + 1];
        const float sc = 0.125f * exp2f((float)(127 - m) * lg2);
        kr[m * 64 + i] = (k1 * cs - k2 * sn) * sc; kr[m * 64 + 32 + i] = (k1 * sn + k2 * cs) * sc;
        vv[m * 64 + i] = bf2f(P[ro + PCV + h * 64 + i]); vv[m * 64 + 32 + i] = bf2f(P[ro + PCV + h * 64 + 32 + i]); }
    __syncthreads();
    const int d = tid >> 3, e0 = (tid & 7) * 8; float acc[8];
#pragma unroll
    for (int e = 0; e < 8; ++e) acc[e] = 0.f;
    for (int m = 0; m < 128; ++m) { const float kd = kr[m * 64 + d];
#pragma unroll
        for (int e = 0; e < 8; ++e) acc[e] += kd * vv[m * 64 + e0 + e]; }
    float* KV = (float*)(F.ws + WS_KV) + (size_t)unit * 4096 + d * 64 + e0;
#pragma unroll
    for (int e = 0; e < 8; ++e) KV[e] = acc[e];
    __syncthreads();
    DG_STOP(30, dg30_, dga_)
    DG_WRITE(30, unit == 0 && F.wave == 0 && F.lane == 0, dga_)
}

typedef float f32x2 __attribute__((ext_vector_type(2)));
__device__ __forceinline__ float dpp_add16(float x) {
    x += __builtin_bit_cast(float, __builtin_amdgcn_mov_dpp(__builtin_bit_cast(int, x), 0xB1, 0xF, 0xF, true));
    x += __builtin_bit_cast(float, __builtin_amdgcn_mov_dpp(__builtin_bit_cast(int, x), 0x4E, 0xF, 0xF, true));
    x += __builtin_bit_cast(float, __builtin_amdgcn_mov_dpp(__builtin_bit_cast(int, x), 0x141, 0xF, 0xF, true));
    x += __builtin_bit_cast(float, __builtin_amdgcn_mov_dpp(__builtin_bit_cast(int, x), 0x140, 0xF, 0xF, true));
    return x;
}
constexpr int CH = 32;
constexpr int RW_STG = 5 * CH * 64;
struct RwOps { f32x4 r, d, k, q, b; float v0, v1; };
__device__ __forceinline__ void rw_ld(RwOps& o, const LAS float* base, const LAS float* vb, int s, int ks, int row0) {
    const LAS f32x4* p = (const LAS f32x4*)(base + s * 64 + ks * 4);
    o.r = p[0]; o.d = p[CH * 16]; o.k = p[2 * CH * 16]; o.q = p[3 * CH * 16]; o.b = p[4 * CH * 16];
    o.v0 = vb[s * 32 + row0]; o.v1 = vb[s * 32 + row0 + 4];
}
#define LO2(x) __builtin_shufflevector(x, x, 0, 1)
#define HI2(x) __builtin_shufflevector(x, x, 2, 3)
__device__ __forceinline__ float rw_step1(f32x2 (&S)[2], const RwOps& o, float v) {
    f32x2 p2 = S[0] * LO2(o.q); p2 = S[1] * HI2(o.q) + p2;
    const float p = dpp_add16(p2.x + p2.y);
    const f32x2 pp = (f32x2){p, p}, vv = (f32x2){v, v};
    S[0] = S[0] - LO2(o.d) * S[0]; S[1] = S[1] - HI2(o.d) * S[1];
    S[0] = S[0] - pp * LO2(o.b); S[1] = S[1] - pp * HI2(o.b);
    S[0] = vv * LO2(o.k) + S[0]; S[1] = vv * HI2(o.k) + S[1];
    f32x2 y2 = S[0] * LO2(o.r); y2 = S[1] * HI2(o.r) + y2;
    return dpp_add16(y2.x + y2.y);
}
__device__ __forceinline__ void rwkv_scan_unit(const Frame& F, int l, int unit) {
    const int tid = F.tid, lane = F.lane, wave = F.wave, half = unit & 1, bh = unit >> 1, b = bh / 6, h = bh - b * 6, tokb = b * SEQ;
    LAS float* stg = (LAS float*)F.lds; LAS float* vst = stg + 2 * RW_STG; LAS float* ybuf = vst + 2 * CH * 32;
    bf16* P = (bf16*)(F.ws + WS_P);
    constexpr int NCH = SEQ / CH;
    unsigned dga_ = 0;
    if (wave >= 4) {
        const int st = tid - 256;
        const int t01 = st >> 3, c01 = st & 7, tv = st >> 2, cv = st & 3;
        const bf16* a0 = (const bf16*)(F.ws + WS_R); const bf16* a1 = (const bf16*)(F.ws + WS_D); const bf16* a2 = (const bf16*)(F.ws + WS_K2); const bf16* a3 = (const bf16*)(F.ws + WS_KK);
        const bf16* a4 = (const bf16*)(F.ws + WS_BP); const bf16* a5 = (const bf16*)(F.ws + WS_VF);
        v4u sreg[6];
#define RW_LOAD(cc) do { const size_t o_ = (size_t)(tokb + (cc) * CH + t01) * AW + h * 64 + c01 * 8; sreg[0] = *(const GAS v4u*)(a0 + o_); sreg[1] = *(const GAS v4u*)(a1 + o_); sreg[2] = *(const GAS v4u*)(a2 + o_); \
            sreg[3] = *(const GAS v4u*)(a3 + o_); sreg[4] = *(const GAS v4u*)(a4 + o_); if (st < 128) sreg[5] = *(const GAS v4u*)(a5 + (size_t)(tokb + (cc) * CH + tv) * AW + h * 64 + half * 32 + cv * 8); } while (0)
#define RW_ST1(i, dstp) do { float f[8]; unpack8(sreg[i], f); LAS f32x4* dst = (LAS f32x4*)(dstp); dst[0] = (f32x4){f[0], f[1], f[2], f[3]}; dst[1] = (f32x4){f[4], f[5], f[6], f[7]}; } while (0)
#define RW_STORE(bufi) do { _Pragma("unroll") for (int i = 0; i < 5; ++i) RW_ST1(i, stg + (bufi) * RW_STG + i * CH * 64 + t01 * 64 + c01 * 8); if (st < 128) RW_ST1(5, vst + (bufi) * CH * 32 + tv * 32 + cv * 8); } while (0)
#define RW_OUT(cc) do { const LAS float* yb_ = ybuf + ((cc) & 1) * CH * 32; const int s_ = st >> 3, r4_ = (st & 7) * 4; const f32x4 yv = *(const LAS f32x4*)(yb_ + s_ * 32 + r4_); \
            *(GAS unsigned long long*)(P + (size_t)(tokb + (cc) * CH + s_) * PP + h * 64 + half * 32 + r4_) = (unsigned long long)pk2(yv[0], yv[1]) | ((unsigned long long)pk2(yv[2], yv[3]) << 32); } while (0)
        RW_LOAD(0); RW_STORE(0); RW_LOAD(1);
        __syncthreads();
        for (int cc = 0; cc < NCH; ++cc) {
            if (cc + 1 < NCH) RW_STORE((cc + 1) & 1);
            if (cc + 2 < NCH) RW_LOAD(cc + 2);
            if (cc > 0) RW_OUT(cc - 1);
            asm volatile("s_waitcnt lgkmcnt(0)" ::: "memory"); __builtin_amdgcn_s_barrier(); asm volatile("" ::: "memory");
        }
        RW_OUT(NCH - 1);
#undef RW_LOAD
#undef RW_ST1
#undef RW_STORE
#undef RW_OUT
        return;
    }
    const int row0 = 8 * wave + (lane >> 4), ks = lane & 15;
    f32x2 Sa[2] = {(f32x2){0.f, 0.f}, (f32x2){0.f, 0.f}}, Sb[2] = {(f32x2){0.f, 0.f}, (f32x2){0.f, 0.f}};
    __syncthreads();
    for (int cc = 0; cc < NCH; ++cc) {
        const int bufi = cc & 1;
        const LAS float* base = stg + bufi * RW_STG; const LAS float* vb = vst + bufi * CH * 32; LAS float* yb = ybuf + bufi * CH * 32;
        RwOps A, B; float yk0 = 0.f, yk1 = 0.f;
        DG_START(40, dg40_)
        rw_ld(A, base, vb, 0, ks, row0);
#pragma unroll
        for (int s = 0; s < CH; s += 2) {
            rw_ld(B, base, vb, s + 1, ks, row0);
            { const float y0 = rw_step1(Sa, A, A.v0), y1 = rw_step1(Sb, A, A.v1); const bool m = (ks == (s & 15)); yk0 = m ? y0 : yk0; yk1 = m ? y1 : yk1; }
            if (s + 2 < CH) rw_ld(A, base, vb, s + 2, ks, row0);
            { const float y0 = rw_step1(Sa, B, B.v0), y1 = rw_step1(Sb, B, B.v1); const bool m = (ks == ((s + 1) & 15)); yk0 = m ? y0 : yk0; yk1 = m ? y1 : yk1; }
            if (((s + 1) & 15) == 15) { yb[(s - 14 + ks) * 32 + row0] = yk0; yb[(s - 14 + ks) * 32 + row0 + 4] = yk1; }
        }
        DG_STOP(40, dg40_, dga_)
        DG_START(43, dg43_)
        asm volatile("s_waitcnt lgkmcnt(0)" ::: "memory"); __builtin_amdgcn_s_barrier(); asm volatile("" ::: "memory");
        DG_STOP(43, dg43_, dga_)
    }
    DG_WRITE(40, unit == 0 && l == 0 && wave == 0 && lane == 0, dga_)
    DG_WRITE(43, unit == 0 && l == 0 && wave == 0 && lane == 0, dga_)
}
__device__ __forceinline__ void rwkv_post(const Frame& F, int l) {
    bf16* P = (bf16*)(F.ws + WS_P); const bf16* VF = (const bf16*)(F.ws + WS_VF); const bf16* Gg = (const bf16*)(F.ws + WS_G); const float* BON = (const float*)(F.ws + WS_BON);
    const int sub = F.tid >> 4, c4 = (F.tid & 15) * 4;
    for (int pr = F.vcu * 32 + sub; pr < M * 6; pr += F.G * 32) { const int tok = pr / 6, h = pr - tok * 6;
        const unsigned long long yw = *(const GAS unsigned long long*)(P + (size_t)tok * PP + h * 64 + c4), vw = *(const GAS unsigned long long*)(VF + (size_t)tok * AW + h * 64 + c4), gw = *(const GAS unsigned long long*)(Gg + (size_t)tok * AW + h * 64 + c4);
        const f32x4 lnw = *(const f32x4*)(F.in[I_LNW] + l * AW + h * 64 + c4), lnb = *(const f32x4*)(F.in[I_LNB] + l * AW + h * 64 + c4);
        const float bon = BON[(size_t)tok * 6 + h];
        const f32x4 yv = (f32x4){bflo((unsigned)yw), bfhi((unsigned)yw), bflo((unsigned)(yw >> 32)), bfhi((unsigned)(yw >> 32))};
        const f32x4 vv = (f32x4){bflo((unsigned)vw), bfhi((unsigned)vw), bflo((unsigned)(vw >> 32)), bfhi((unsigned)(vw >> 32))};
        const f32x4 gg = (f32x4){bflo((unsigned)gw), bfhi((unsigned)gw), bflo((unsigned)(gw >> 32)), bfhi((unsigned)(gw >> 32))};
        float sm = (yv[0] + yv[1]) + (yv[2] + yv[3]);
        sm += __shfl_xor(sm, 1); sm += __shfl_xor(sm, 2); sm += __shfl_xor(sm, 4); sm += __shfl_xor(sm, 8);
        const float mean = sm * (1.0f / 64.0f); const f32x4 dv = yv - mean;
        float vs = (dv[0] * dv[0] + dv[1] * dv[1]) + (dv[2] * dv[2] + dv[3] * dv[3]);
        vs += __shfl_xor(vs, 1); vs += __shfl_xor(vs, 2); vs += __shfl_xor(vs, 4); vs += __shfl_xor(vs, 8);
        const float rs = 1.0f / sqrtf(vs * (1.0f / 64.0f) + 64e-5f);
        const f32x4 o = (dv * rs * lnw + lnb + bon * vv) * gg;
        *(GAS unsigned long long*)(P + (size_t)tok * PP + h * 64 + c4) = (unsigned long long)pk2(o[0], o[1]) | ((unsigned long long)pk2(o[2], o[3]) << 32);
    }
}

typedef short bf16x8_t __attribute__((ext_vector_type(8)));
typedef short s16x4_t __attribute__((ext_vector_type(4)));
typedef float f32x16_t __attribute__((ext_vector_type(16)));
__device__ __forceinline__ unsigned fkey(float f) { const unsigned u = __float_as_uint(f); return (u & 0x80000000u) ? ~u : (u | 0x80000000u); }
__device__ __forceinline__ int crow32(int r, int hi) { return (r & 3) + 8 * (r >> 2) + 4 * hi; }
__device__ __forceinline__ unsigned off_a(unsigned row, unsigned ch) { return 2048u * (row >> 3) + 512u * (ch >> 2) + 64u * (row & 7) + 16u * ((ch & 3) ^ ((row >> 2) & 3)); }

__device__ __forceinline__ void idx_scores(const bf16x8_t (&Af)[2], const bf16x8_t (&Bf)[8][2], const float (&iwf)[8], float (&sc)[4]) {
    sc[0] = sc[1] = sc[2] = sc[3] = 0.f;
#pragma unroll
    for (int h = 0; h < 8; ++h) { f32x4 a = (f32x4){0.f, 0.f, 0.f, 0.f};
        a = __builtin_amdgcn_mfma_f32_16x16x32_bf16(Af[0], Bf[h][0], a, 0, 0, 0);
        a = __builtin_amdgcn_mfma_f32_16x16x32_bf16(Af[1], Bf[h][1], a, 0, 0, 0);
#pragma unroll
        for (int r = 0; r < 4; ++r) sc[r] = fmaf(iwf[h], __builtin_amdgcn_fmed3f(a[r], 0.f, __builtin_inff()), sc[r]); }
}
__device__ __forceinline__ void idx_load_q(const bf16* P, int tokq, bf16x8_t (&Bf)[8][2], float (&iwf)[8], int fq) {
    const bf16* row = P + (size_t)tokq * PP;
#pragma unroll
    for (int h = 0; h < 8; ++h)
#pragma unroll
        for (int ks = 0; ks < 2; ++ks) Bf[h][ks] = *(const GAS bf16x8_t*)(row + PBIQ + h * 64 + ks * 32 + fq * 8);
    const v4u w = *(const GAS v4u*)(row + PBIW); float f[8]; unpack8(w, f);
#pragma unroll
    for (int h = 0; h < 8; ++h) iwf[h] = f[h] * (0.35355339059327373f * 0.125f);
}

__device__ __forceinline__ void lds_barrier() { asm volatile("s_waitcnt lgkmcnt(0)" ::: "memory"); __builtin_amdgcn_s_barrier(); asm volatile("" ::: "memory"); }
__device__ __forceinline__ void dsa_thr_unit(const Frame& F, int unit) {
    LAS unsigned* sk = (LAS unsigned*)F.lds;
    const int lane = F.lane, wave = F.wave, fr = lane & 15, fq = lane >> 4;
    const int b = unit & 7, qb = 127 - (unit >> 3), t0 = qb * 16, tok0 = b * SEQ + t0;
    const bf16* P = (const bf16*)(F.ws + WS_P);
    unsigned dga_ = 0;
    DG_START(10, dg10_)
    {
        bf16x8_t Bf[8][2]; float iwf[8];
        idx_load_q(P, tok0 + fr, Bf, iwf, fq);
        bf16x8_t An[2];
        { const int kt0 = wave <= qb ? wave : qb; const bf16* krow = P + (size_t)(b * SEQ + kt0 * 16 + fr) * PP + PBIK + fq * 8; An[0] = *(const GAS bf16x8_t*)(krow); An[1] = *(const GAS bf16x8_t*)(krow + 32); }
        for (int kt = wave; kt <= qb; kt += 8) {
            bf16x8_t Af[2]; Af[0] = An[0]; Af[1] = An[1];
            { const int ktn = kt + 8 <= qb ? kt + 8 : qb; const bf16* krow = P + (size_t)(b * SEQ + ktn * 16 + fr) * PP + PBIK + fq * 8; An[0] = *(const GAS bf16x8_t*)(krow); An[1] = *(const GAS bf16x8_t*)(krow + 32); }
            float sc[4]; idx_scores(Af, Bf, iwf, sc);
            v4u kv;
            const int s0 = kt * 16 + 4 * fq, t = t0 + fr;
            kv.x = (s0 + 0 <= t) ? fkey(sc[0]) : 0u; kv.y = (s0 + 1 <= t) ? fkey(sc[1]) : 0u; kv.z = (s0 + 2 <= t) ? fkey(sc[2]) : 0u; kv.w = (s0 + 3 <= t) ? fkey(sc[3]) : 0u;
            *(LAS v4u*)(sk + fr * 2048 + s0) = kv;
        }
    }
    __syncthreads();
    DG_STOP(10, dg10_, dga_)
    DG_WRITE(10, unit == 0 && wave == 0 && lane == 0, dga_)
    DG_START(11, dg11_)
    unsigned* THR = (unsigned*)(F.ws + WS_THR); int* SCUT = (int*)(F.ws + WS_SCUT);
    for (int qi = 0; qi < 2; ++qi) { const int q = 2 * wave + qi, t = t0 + q, n = t + 1;
        unsigned thr = 0u; int scut = SEQ - 1;
        if (n > TOPK) {
            unsigned keys[32];
#pragma unroll
            for (int i = 0; i < 32; ++i) keys[i] = (64 * i + lane <= t) ? sk[q * 2048 + 64 * i + lane] : 0u;
            unsigned prefix = 0u; bool done = false;
            const int ng = (t >> 9) + 1;
            for (int bit = 31; bit >= 0; --bit) { const unsigned cand = prefix | (1u << bit); int cnt = 0;
#pragma unroll
                for (int g = 0; g < 4; ++g) if (g < ng) {
#pragma unroll
                    for (int i = 8 * g; i < 8 * g + 8; ++i) cnt += __popcll(__ballot(keys[i] >= cand)); }
                if (cnt >= TOPK) prefix = cand;
                if (cnt == TOPK) { thr = cand - 1u; scut = -1; done = true; break; } }
            if (!done) {
                int cgt = 0;
#pragma unroll
                for (int i = 0; i < 32; ++i) cgt += __popcll(__ballot(keys[i] > prefix));
                int need = TOPK - cgt, run = 0; thr = prefix; scut = SEQ - 1; bool found = false;
#pragma unroll
                for (int i = 0; i < 32; ++i) { unsigned long long mk = __ballot(keys[i] == prefix); const int c = __popcll(mk);
                    if (!found && run + c >= need) { int k = need - run; while (k > 1) { mk &= mk - 1ull; --k; } scut = 64 * i + (int)__builtin_ctzll(mk); found = true; }
                    run += c; }
            }
        }
        if (lane == 0) { THR[tok0 + q] = thr; SCUT[tok0 + q] = scut; }
    }
    DG_STOP(11, dg11_, dga_)
    DG_WRITE(11, unit == 0 && wave == 0 && lane == 0, dga_)
    __syncthreads();
}

constexpr int QLP = 136;
constexpr int MKP = 36;
constexpr int DA_MASK = 0, DA_QL = 2 * 32 * MKP * 4, DA_CT = DA_QL + 6 * 32 * QLP * 2;
__device__ __forceinline__ void dsa_mask_tile(const bf16x8_t (&Af)[2][2], const bf16x8_t (&Bf)[8][2], const float (&iwf)[8], int j, int kmax, int t, unsigned thr, int scut, int fq, LAS float* mrow) {
#pragma unroll
    for (int k2 = 0; k2 < 2; ++k2) { const int kt = 2 * j + k2; f32x4 mv = (f32x4){-1e30f, -1e30f, -1e30f, -1e30f};
        if (kt <= kmax) { float sc[4]; idx_scores(Af[k2], Bf, iwf, sc);
            const int s0 = kt * 16 + 4 * fq;
#pragma unroll
            for (int r = 0; r < 4; ++r) { const unsigned key = fkey(sc[r]); const int s = s0 + r;
                const bool sel = (s <= t) & ((key > thr) | ((key == thr) & (s <= scut)));
                mv[r] = sel ? 0.f : -1e30f; } }
        *(LAS f32x4*)(mrow + k2 * 16 + 4 * fq) = mv; }
}
__device__ __forceinline__ void dsa_attn_unit(const Frame& F, int l, int unit) {
    const int tid = F.tid, lane = F.lane, wave = F.wave, r32 = lane & 31, hi = lane >> 5;
    const int b = unit & 7, qb = 63 - (unit >> 3), t0 = qb * 32, tok0 = b * SEQ + t0, ntile = qb + 1;
    bf16* P = (bf16*)(F.ws + WS_P); const bf16* C = (const bf16*)(F.ws + WS_C);
    LAS float* MASK = (LAS float*)(F.lds + DA_MASK); LAS unsigned char* QLb = F.lds + DA_QL; LAS unsigned char* CT = F.lds + DA_CT;
    const int crow_ = tid >> 4, cch = tid & 15; const unsigned cdst = off_a((unsigned)crow_, (unsigned)cch);
    const bf16* csrc = C + (size_t)(b * SEQ + crow_) * 128 + cch * 8;
    v4u cpre = *(const GAS v4u*)(csrc);
    if (wave >= 6) {
        const int fr = lane & 15, fq = lane >> 4, qh = wave - 6;
        bf16x8_t Bf[8][2]; float iwf[8]; bf16x8_t Af[2][2];
        const int tq = tok0 + 16 * qh + fr, tq_t = t0 + 16 * qh + fr, kmax = 2 * qb + qh;
        idx_load_q(P, tq, Bf, iwf, fq);
        const unsigned thr = ((const unsigned*)(F.ws + WS_THR))[tq]; const int scut = ((const int*)(F.ws + WS_SCUT))[tq];
        const bf16* kbase = P + (size_t)(b * SEQ + fr) * PP + PBIK + fq * 8;
#define DA_LOADA(dst, jt) do { _Pragma("unroll") for (int k2_ = 0; k2_ < 2; ++k2_) { const int kt_ = 2 * (jt) + k2_; const int ktc = kt_ <= kmax ? kt_ : kmax; const bf16* kr = kbase + (size_t)ktc * 16 * PP; \
            dst[k2_][0] = *(const GAS bf16x8_t*)(kr); dst[k2_][1] = *(const GAS bf16x8_t*)(kr + 32); } } while (0)
        bf16x8_t An[2][2];
        DA_LOADA(Af, 0);
        dsa_mask_tile(Af, Bf, iwf, 0, kmax, tq_t, thr, scut, fq, MASK + (16 * qh + fr) * MKP);
        DA_LOADA(An, 1);
        *(LAS v4u*)(CT + cdst) = cpre;
        lds_barrier();
        unsigned dga_ = 0;
        for (int j = 0; j < ntile; ++j) {
            DG_START(2, dgt_)
            if (j + 1 < ntile) {
#pragma unroll
                for (int k2 = 0; k2 < 2; ++k2) { Af[k2][0] = An[k2][0]; Af[k2][1] = An[k2][1]; }
                DA_LOADA(An, j + 2);
                cpre = *(const GAS v4u*)(csrc + (size_t)(j + 1) * 32 * 128);
                dsa_mask_tile(Af, Bf, iwf, j + 1, kmax, tq_t, thr, scut, fq, MASK + ((j + 1) & 1) * (32 * MKP) + (16 * qh + fr) * MKP);
                *(LAS v4u*)(CT + ((j + 1) & 1) * 8192 + cdst) = cpre; }
            DG_STOP(2, dgt_, dga_)
            lds_barrier();
        }
        DG_WRITE(2, unit == 0 && l == 0 && wave == 6 && lane == 0, dga_)
#undef DA_LOADA
        lds_barrier();
        return;
    }
    const int h = wave;
    LAS unsigned char* QLh = QLb + h * (32 * QLP * 2);
    {
        unsigned zo_ = 0u; asm volatile("" : "+v"(zo_));
        const bf16* wukT = (const bf16*)(F.ws + WS_WUKT) + (size_t)(l * 6 + h) * 128 * 64 + zo_;
        bf16x8_t qf[4];
#pragma unroll
        for (int ks = 0; ks < 4; ++ks) qf[ks] = *(const GAS bf16x8_t*)(P + (size_t)(tok0 + r32) * PP + PBQ + h * 64 + ks * 16 + hi * 8);
#pragma unroll
        for (int blk = 0; blk < 4; ++blk) { f32x16_t x;
#pragma unroll
            for (int i = 0; i < 16; ++i) x[i] = 0.f;
#pragma unroll
            for (int ks = 0; ks < 4; ++ks) { const bf16x8_t a = *(const GAS bf16x8_t*)(wukT + (size_t)(blk * 32 + r32) * 64 + ks * 16 + hi * 8); x = __builtin_amdgcn_mfma_f32_32x32x16_bf16(a, qf[ks], x, 0, 0, 0); }
#pragma unroll
            for (int g = 0; g < 4; ++g) { const float sc = 0.125f * 1.4426950408889634f;
                const unsigned long long w = (unsigned long long)pk2(x[4 * g] * sc, x[4 * g + 1] * sc) | ((unsigned long long)pk2(x[4 * g + 2] * sc, x[4 * g + 3] * sc) << 32);
                *(LAS unsigned long long*)(QLh + (r32 * QLP + blk * 32 + 8 * g + 4 * hi) * 2) = w; } }
    }
    *(LAS v4u*)(CT + cdst) = cpre;
    lds_barrier();
    f32x16_t o[4]; float m_run = -1e30f, l_run = 0.f;
    const LAS unsigned char* qlrow = QLh + (r32 * QLP + 8 * hi) * 2;
#pragma unroll
    for (int c = 0; c < 4; ++c)
#pragma unroll
        for (int i = 0; i < 16; ++i) o[c][i] = 0.f;
    const unsigned rr_ = ((unsigned)r32 >> 2) & 3u, rb_ = 2048u * ((unsigned)r32 >> 3) + 64u * ((unsigned)r32 & 7u);
    const unsigned rbase0 = rb_ + 16u * ((unsigned)hi ^ rr_), rbase1 = rb_ + 16u * ((2u + (unsigned)hi) ^ rr_);
    const unsigned blk_ = (lane >> 4) & 1, q_ = (lane & 15) >> 2, p_ = lane & 3;
    unsigned dga_ = 0;
    for (int j = 0; j < ntile; ++j) {
        DG_START(0, dgt_)
        LAS unsigned char* kb = CT + (j & 1) * 8192;
        if (j + 1 < ntile) cpre = *(const GAS v4u*)(csrc + (size_t)(j + 1) * 32 * 128);
        {
            f32x16_t S;
#pragma unroll
            for (int i = 0; i < 16; ++i) S[i] = 0.f;
#pragma unroll
            for (int s = 0; s < 8; ++s) { const bf16x8_t a = *(const LAS bf16x8_t*)(kb + ((s & 1) ? rbase1 : rbase0) + 512 * (s >> 1)); const bf16x8_t bq = *(const LAS bf16x8_t*)(qlrow + 32 * s);
                S = __builtin_amdgcn_mfma_f32_32x32x16_bf16(a, bq, S, 0, 0, 0); }
            const LAS f32x4* mk = (const LAS f32x4*)(MASK + (j & 1) * (32 * MKP) + r32 * MKP + 4 * hi);
            float tmax = -1e30f;
#pragma unroll
            for (int g = 0; g < 4; ++g) { const f32x4 mv = mk[2 * g];
#pragma unroll
                for (int e4 = 0; e4 < 4; ++e4) { S[4 * g + e4] += mv[e4]; tmax = fmaxf(tmax, S[4 * g + e4]); } }
            tmax = fmaxf(tmax, __shfl_xor(tmax, 32));
            const float m_new = fmaxf(m_run, tmax), alpha = __builtin_amdgcn_exp2f(m_run - m_new);
            float psum = 0.f; float e[16];
#pragma unroll
            for (int r = 0; r < 16; ++r) { e[r] = __builtin_amdgcn_exp2f(S[r] - m_new); psum += e[r]; }
            l_run = l_run * alpha + psum; m_run = m_new;
            if (__any(alpha != 1.0f)) {
#pragma unroll
                for (int c = 0; c < 4; ++c)
#pragma unroll
                    for (int i = 0; i < 16; ++i) o[c][i] *= alpha; }
            bf16x8_t xs[2];
#pragma unroll
            for (int s = 0; s < 2; ++s) { v4u w; w.x = pk2(e[8 * s], e[8 * s + 1]); w.y = pk2(e[8 * s + 2], e[8 * s + 3]); w.z = pk2(e[8 * s + 4], e[8 * s + 5]); w.w = pk2(e[8 * s + 6], e[8 * s + 7]); xs[s] = __builtin_bit_cast(bf16x8_t, w); }
#pragma unroll
            for (int c = 0; c < 4; ++c)
#pragma unroll
                for (int s = 0; s < 2; ++s) {
                    const unsigned a0 = off_a((unsigned)(16 * s + 4 * hi + q_), (unsigned)(4 * c + 2 * blk_ + (p_ >> 1))) + 8u * (p_ & 1);
                    const unsigned a1 = off_a((unsigned)(16 * s + 8 + 4 * hi + q_), (unsigned)(4 * c + 2 * blk_ + (p_ >> 1))) + 8u * (p_ & 1);
                    const s16x4_t lo = __builtin_bit_cast(s16x4_t, __builtin_amdgcn_ds_read_tr16_b64_v4i16((LAS s16x4_t*)(kb + a0)));
                    const s16x4_t hh = __builtin_bit_cast(s16x4_t, __builtin_amdgcn_ds_read_tr16_b64_v4i16((LAS s16x4_t*)(kb + a1)));
                    const bf16x8_t a = (bf16x8_t){lo[0], lo[1], lo[2], lo[3], hh[0], hh[1], hh[2], hh[3]};
                    o[c] = __builtin_amdgcn_mfma_f32_32x32x16_bf16(a, xs[s], o[c], 0, 0, 0); }
        }
        if (j + 1 < ntile) *(LAS v4u*)(CT + ((j + 1) & 1) * 8192 + cdst) = cpre;
        DG_STOP(0, dgt_, dga_)
        DG_START(1, dgw_)
        lds_barrier();
        DG_STOP(1, dgw_, dga_)
    }
    DG_WRITE(0, unit == 0 && l == 0 && wave == 0 && lane == 0, dga_)
    DG_WRITE(1, unit == 0 && l == 0 && wave == 0 && lane == 0, dga_)
    {
        const float lt = l_run + __shfl_xor(l_run, 32); const float inv = 1.0f / lt;
#pragma unroll
        for (int c = 0; c < 4; ++c)
#pragma unroll
            for (int g = 0; g < 4; ++g) { const unsigned long long w = (unsigned long long)pk2(o[c][4 * g] * inv, o[c][4 * g + 1] * inv) | ((unsigned long long)pk2(o[c][4 * g + 2] * inv, o[c][4 * g + 3] * inv) << 32);
                *(LAS unsigned long long*)(QLh + (r32 * QLP + c * 32 + 8 * g + 4 * hi) * 2) = w; }
        unsigned zo2_ = 0u; asm volatile("" : "+v"(zo2_));
        const bf16* wuvT = (const bf16*)(F.ws + WS_WUVT) + (size_t)(l * 6 + h) * 64 * 128 + zo2_;
        bf16x8_t Bo[8];
#pragma unroll
        for (int s = 0; s < 8; ++s) Bo[s] = *(const LAS bf16x8_t*)(QLh + (r32 * QLP + 16 * s + 8 * hi) * 2);
#pragma unroll
        for (int mb = 0; mb < 2; ++mb) { f32x16_t y;
#pragma unroll
            for (int i = 0; i < 16; ++i) y[i] = 0.f;
#pragma unroll
            for (int s = 0; s < 8; ++s) { const bf16x8_t a = *(const GAS bf16x8_t*)(wuvT + (size_t)(mb * 32 + r32) * 128 + 16 * s + 8 * hi); y = __builtin_amdgcn_mfma_f32_32x32x16_bf16(a, Bo[s], y, 0, 0, 0); }
#pragma unroll
            for (int g = 0; g < 4; ++g) { const unsigned long long w = (unsigned long long)pk2(y[4 * g], y[4 * g + 1]) | ((unsigned long long)pk2(y[4 * g + 2], y[4 * g + 3]) << 32);
                *(GAS unsigned long long*)(P + (size_t)(tok0 + r32) * PP + 384 + h * 64 + mb * 32 + 8 * g + 4 * hi) = w; } }
    }
    lds_barrier();
}

constexpr int RP = 72;
constexpr int RT_QR = 0, RT_KR = 128 * RP * 2, RT_VV = 2 * 128 * RP * 2, RT_ST = 3 * 128 * RP * 2, RT_SS = RT_ST + 64 * RP * 2, RT_KD = RT_SS + 1024;
__device__ __forceinline__ void ret_out_unit(const Frame& F, int unit) {
    const int tid = F.tid, lane = F.lane, wave = F.wave, r32 = lane & 31, hi = lane >> 5;
    const int h = unit & 3, b = unit >> 2;
    bf16* P = (bf16*)(F.ws + WS_P); const float* tab = (const float*)(F.ws + WS_TAB);
    LAS bf16* QR = (LAS bf16*)(F.lds + RT_QR); LAS bf16* KR = (LAS bf16*)(F.lds + RT_KR); LAS bf16* VV = (LAS bf16*)(F.lds + RT_VV); LAS bf16* ST = (LAS bf16*)(F.lds + RT_ST);
    LAS float* SS = (LAS float*)(F.lds + RT_SS); LAS bf16* KD = (LAS bf16*)(F.lds + RT_KD);
    const float lg2 = log2f(1.0f - exp2f(-5.0f - (float)h));
    f32x16_t st;
#pragma unroll
    for (int i = 0; i < 16; ++i) st[i] = 0.f;
    const float cdec = exp2f(128.0f * lg2);
    unsigned long long pre[2][6]; f32x4 pret[2][2];
#define RT_LOAD(cn) do { _Pragma("unroll") for (int it_ = 0; it_ < 2; ++it_) { const int idx_ = tid + it_ * NTHR, m_ = idx_ >> 3, i4_ = (idx_ & 7) * 4; const size_t ro_ = (size_t)(b * SEQ + (cn) * 128 + m_) * PP + h * 64 + i4_; \
        pre[it_][0] = *(const GAS unsigned long long*)(P + ro_ + PCQ); pre[it_][1] = *(const GAS unsigned long long*)(P + ro_ + PCQ + 32); pre[it_][2] = *(const GAS unsigned long long*)(P + ro_ + PCK); \
        pre[it_][3] = *(const GAS unsigned long long*)(P + ro_ + PCK + 32); pre[it_][4] = *(const GAS unsigned long long*)(P + ro_ + PCV); pre[it_][5] = *(const GAS unsigned long long*)(P + ro_ + PCV + 32); \
        pret[it_][0] = *(const GAS f32x4*)(tab + ((size_t)((cn) * 128 + m_) * 32 + i4_) * 2); pret[it_][1] = *(const GAS f32x4*)(tab + ((size_t)((cn) * 128 + m_) * 32 + i4_) * 2 + 4); } } while (0)
    unsigned dga_ = 0;
    DG_START(60, dg60_)
    RT_LOAD(0);
    for (int c = 0; c < 16; ++c) {
    const int tok0 = b * SEQ + c * 128;
#pragma unroll
    for (int it = 0; it < 2; ++it) { const int idx = tid + it * NTHR, m = idx >> 3, i4 = (idx & 7) * 4;
        const unsigned long long q1w = pre[it][0], q2w = pre[it][1], k1w = pre[it][2], k2w = pre[it][3], v1w = pre[it][4], v2w = pre[it][5];
        const f32x4 t0 = pret[it][0], t1 = pret[it][1];
        const float cs[4] = {t0[0], t0[2], t1[0], t1[2]}, sn[4] = {t0[1], t0[3], t1[1], t1[3]};
        const float q1[4] = {bflo((unsigned)q1w), bfhi((unsigned)q1w), bflo((unsigned)(q1w >> 32)), bfhi((unsigned)(q1w >> 32))}, q2[4] = {bflo((unsigned)q2w), bfhi((unsigned)q2w), bflo((unsigned)(q2w >> 32)), bfhi((unsigned)(q2w >> 32))};
        const float k1[4] = {bflo((unsigned)k1w), bfhi((unsigned)k1w), bflo((unsigned)(k1w >> 32)), bfhi((unsigned)(k1w >> 32))}, k2[4] = {bflo((unsigned)k2w), bfhi((unsigned)k2w), bflo((unsigned)(k2w >> 32)), bfhi((unsigned)(k2w >> 32))};
        float qa[4], qb[4], ka[4], kb[4];
#pragma unroll
        for (int j = 0; j < 4; ++j) { qa[j] = q1[j] * cs[j] - q2[j] * sn[j]; qb[j] = q1[j] * sn[j] + q2[j] * cs[j]; ka[j] = (k1[j] * cs[j] - k2[j] * sn[j]) * 0.125f; kb[j] = (k1[j] * sn[j] + k2[j] * cs[j]) * 0.125f; }
        *(LAS unsigned long long*)(QR + m * RP + i4) = (unsigned long long)pk2(qa[0], qa[1]) | ((unsigned long long)pk2(qa[2], qa[3]) << 32);
        *(LAS unsigned long long*)(QR + m * RP + 32 + i4) = (unsigned long long)pk2(qb[0], qb[1]) | ((unsigned long long)pk2(qb[2], qb[3]) << 32);
        *(LAS unsigned long long*)(KR + m * RP + i4) = (unsigned long long)pk2(ka[0], ka[1]) | ((unsigned long long)pk2(ka[2], ka[3]) << 32);
        *(LAS unsigned long long*)(KR + m * RP + 32 + i4) = (unsigned long long)pk2(kb[0], kb[1]) | ((unsigned long long)pk2(kb[2], kb[3]) << 32);
        { const float kd = exp2f((float)(127 - m) * lg2);
          *(LAS unsigned long long*)(KD + m * RP + i4) = (unsigned long long)pk2(ka[0] * kd, ka[1] * kd) | ((unsigned long long)pk2(ka[2] * kd, ka[3] * kd) << 32);
          *(LAS unsigned long long*)(KD + m * RP + 32 + i4) = (unsigned long long)pk2(kb[0] * kd, kb[1] * kd) | ((unsigned long long)pk2(kb[2] * kd, kb[3] * kd) << 32); }
        *(LAS unsigned long long*)(VV + m * RP + i4) = v1w; *(LAS unsigned long long*)(VV + m * RP + 32 + i4) = v2w; }
    if (c + 1 < 16) RT_LOAD(c + 1);
    if (wave < 4) {
        const int db = wave >> 1, ebs = wave & 1;
#pragma unroll
        for (int i = 0; i < 16; ++i) ST[(32 * db + crow32(i, hi)) * RP + 32 * ebs + r32] = (bf16)(pk2(st[i], 0.f) & 0xffffu);
    }
    lds_barrier();
    const int nb = wave >> 1, eb = wave & 1, n = nb * 32 + r32;
    const unsigned blk_ = (lane >> 4) & 1, q_ = (lane & 15) >> 2, p_ = lane & 3;
    bf16x8_t qf[4];
#pragma unroll
    for (int ks = 0; ks < 4; ++ks) qf[ks] = *(const LAS bf16x8_t*)(QR + n * RP + ks * 16 + hi * 8);
    f32x16_t y;
#pragma unroll
    for (int i = 0; i < 16; ++i) y[i] = 0.f;
#pragma unroll
    for (int ks = 0; ks < 4; ++ks) {
        const s16x4_t lo = __builtin_bit_cast(s16x4_t, __builtin_amdgcn_ds_read_tr16_b64_v4i16((LAS s16x4_t*)(ST + (16 * ks + 8 * hi + q_) * RP + 32 * eb + 16 * blk_ + 4 * p_)));
        const s16x4_t hh = __builtin_bit_cast(s16x4_t, __builtin_amdgcn_ds_read_tr16_b64_v4i16((LAS s16x4_t*)(ST + (16 * ks + 8 * hi + 4 + q_) * RP + 32 * eb + 16 * blk_ + 4 * p_)));
        const bf16x8_t a = (bf16x8_t){lo[0], lo[1], lo[2], lo[3], hh[0], hh[1], hh[2], hh[3]};
        y = __builtin_amdgcn_mfma_f32_32x32x16_bf16(a, qf[ks], y, 0, 0, 0); }
    { const float qd = exp2f((float)(n + 1) * lg2);
#pragma unroll
      for (int i = 0; i < 16; ++i) y[i] *= qd; }
    unsigned long long gpre[4];
#pragma unroll
    for (int g = 0; g < 4; ++g) gpre[g] = *(const GAS unsigned long long*)(P + (size_t)(tok0 + n) * PP + PCG + h * 64 + 32 * eb + 8 * g + 4 * hi);
    for (int mt = 0; mt <= nb; ++mt) {
        f32x16_t S;
#pragma unroll
        for (int i = 0; i < 16; ++i) S[i] = 0.f;
#pragma unroll
        for (int ks = 0; ks < 4; ++ks) { const bf16x8_t a = *(const LAS bf16x8_t*)(KR + (mt * 32 + r32) * RP + ks * 16 + hi * 8); S = __builtin_amdgcn_mfma_f32_32x32x16_bf16(a, qf[ks], S, 0, 0, 0); }
        float e[16];
#pragma unroll
        for (int r = 0; r < 16; ++r) { const int dm = r32 - crow32(r, hi) + 32 * (nb - mt); e[r] = (dm >= 0) ? S[r] * exp2f((float)dm * lg2) : 0.f; }
#pragma unroll
        for (int s = 0; s < 2; ++s) { v4u w; w.x = pk2(e[8 * s], e[8 * s + 1]); w.y = pk2(e[8 * s + 2], e[8 * s + 3]); w.z = pk2(e[8 * s + 4], e[8 * s + 5]); w.w = pk2(e[8 * s + 6], e[8 * s + 7]);
            const bf16x8_t xs = __builtin_bit_cast(bf16x8_t, w);
            const s16x4_t lo = __builtin_bit_cast(s16x4_t, __builtin_amdgcn_ds_read_tr16_b64_v4i16((LAS s16x4_t*)(VV + (mt * 32 + 16 * s + 4 * hi + q_) * RP + 32 * eb + 16 * blk_ + 4 * p_)));
            const s16x4_t hh = __builtin_bit_cast(s16x4_t, __builtin_amdgcn_ds_read_tr16_b64_v4i16((LAS s16x4_t*)(VV + (mt * 32 + 16 * s + 8 + 4 * hi + q_) * RP + 32 * eb + 16 * blk_ + 4 * p_)));
            const bf16x8_t a = (bf16x8_t){lo[0], lo[1], lo[2], lo[3], hh[0], hh[1], hh[2], hh[3]};
            y = __builtin_amdgcn_mfma_f32_32x32x16_bf16(a, xs, y, 0, 0, 0); }
    }
    float ss = 0.f;
#pragma unroll
    for (int i = 0; i < 16; ++i) ss += y[i] * y[i];
    ss += __shfl_xor(ss, 32);
    if (hi == 0) SS[(nb * 2 + eb) * 32 + r32] = ss;
    lds_barrier();
    ss += SS[(nb * 2 + (eb ^ 1)) * 32 + r32];
    const float rs = 1.0f / sqrtf(ss * (1.0f / 64.0f) + 1e-6f);
    const size_t ro = (size_t)(tok0 + n) * PP;
#pragma unroll
    for (int g = 0; g < 4; ++g) { const int e0 = 32 * eb + 8 * g + 4 * hi;
        const unsigned long long gw = gpre[g];
        const float g0 = bflo((unsigned)gw), g1 = bfhi((unsigned)gw), g2 = bflo((unsigned)(gw >> 32)), g3 = bfhi((unsigned)(gw >> 32));
        const float o0 = g0 * sigmoid_f(g0) * y[4 * g] * rs, o1 = g1 * sigmoid_f(g1) * y[4 * g + 1] * rs, o2 = g2 * sigmoid_f(g2) * y[4 * g + 2] * rs, o3 = g3 * sigmoid_f(g3) * y[4 * g + 3] * rs;
        *(GAS unsigned long long*)(P + ro + 768 + h * 64 + e0) = (unsigned long long)pk2(o0, o1) | ((unsigned long long)pk2(o2, o3) << 32); }
    if (wave < 4) {
        const int db = wave >> 1, ebs = wave & 1;
#pragma unroll
        for (int i = 0; i < 16; ++i) st[i] *= cdec;
#pragma unroll
        for (int ks = 0; ks < 8; ++ks) {
            const s16x4_t alo = __builtin_bit_cast(s16x4_t, __builtin_amdgcn_ds_read_tr16_b64_v4i16((LAS s16x4_t*)(KD + (16 * ks + 8 * hi + q_) * RP + 32 * db + 16 * blk_ + 4 * p_)));
            const s16x4_t ahi = __builtin_bit_cast(s16x4_t, __builtin_amdgcn_ds_read_tr16_b64_v4i16((LAS s16x4_t*)(KD + (16 * ks + 8 * hi + 4 + q_) * RP + 32 * db + 16 * blk_ + 4 * p_)));
            const s16x4_t blo = __builtin_bit_cast(s16x4_t, __builtin_amdgcn_ds_read_tr16_b64_v4i16((LAS s16x4_t*)(VV + (16 * ks + 8 * hi + q_) * RP + 32 * ebs + 16 * blk_ + 4 * p_)));
            const s16x4_t bhi = __builtin_bit_cast(s16x4_t, __builtin_amdgcn_ds_read_tr16_b64_v4i16((LAS s16x4_t*)(VV + (16 * ks + 8 * hi + 4 + q_) * RP + 32 * ebs + 16 * blk_ + 4 * p_)));
            const bf16x8_t a = (bf16x8_t){alo[0], alo[1], alo[2], alo[3], ahi[0], ahi[1], ahi[2], ahi[3]}, bb = (bf16x8_t){blo[0], blo[1], blo[2], blo[3], bhi[0], bhi[1], bhi[2], bhi[3]};
            st = __builtin_amdgcn_mfma_f32_32x32x16_bf16(a, bb, st, 0, 0, 0); }
    }
    lds_barrier();
    }
    DG_STOP(60, dg60_, dga_)
    DG_WRITE(60, unit == 0 && wave == 0 && lane == 0, dga_)
#undef RT_LOAD
}

constexpr int PT = 32, XSP = 1304;
constexpr int PR_XS = 0, PR_STG = PT * XSP * 2, PR_CONST = PR_STG + 32768, PR_MU = PR_CONST + 6 * 384 * 4;
__device__ __forceinline__ void prep_consts(const Frame& F, int l) {
    LAS float* CS = (LAS float*)(F.lds + PR_CONST);
    for (int i = F.tid; i < AW; i += NTHR) { CS[i] = F.in[I_KK][l * AW + i]; CS[AW + i] = F.in[I_KA][l * AW + i]; CS[2 * AW + i] = F.in[I_RK][l * AW + i];
        CS[3 * AW + i] = F.in[I_W0][l * AW + i]; CS[4 * AW + i] = F.in[I_A0][l * AW + i]; CS[5 * AW + i] = (l > 0) ? F.in[I_V0][(l - 1) * AW + i] : 0.f; }
    LAS float* MU = (LAS float*)(F.lds + PR_MU);
    for (int i = F.tid; i < 1296; i += NTHR) MU[i] = (i < 1280) ? F.in[I_MU][l * 1280 + i] : ((l > 0) ? F.in[I_VRMU][(l - 1) * 16 + i - 1280] : 0.f);
    __syncthreads();
}
__device__ __forceinline__ float softplus_f(float z) { return fmaxf(z, 0.f) + __logf(1.0f + __expf(-fabsf(z))); }
__device__ __forceinline__ float tanh_f(float x) { const float e = __expf(2.0f * x); return 1.0f - 2.0f * __builtin_amdgcn_rcpf(e + 1.0f); }
__device__ __forceinline__ void small_weights(const Frame& F) {
    for (int l = 0; l < DEPTH; ++l) {
        const float* w2 = F.in[I_W2] + (size_t)l * 32 * AW; const float* a2 = F.in[I_A2] + (size_t)l * 32 * AW; const float* g2 = F.in[I_G2] + (size_t)l * 64 * AW;
        const float* v2 = F.in[I_V2] + (size_t)(l > 0 ? l - 1 : 0) * 16 * AW;
        bf16* LT = (bf16*)(F.ws + WS_LORA) + (size_t)l * AW * 144;
        for (int i = F.vcu * NTHR + F.tid; i < AW * 144; i += F.G * NTHR) { const int n = i / 144, k = i - n * 144; float v;
            if (k < 32) v = w2[k * AW + n]; else if (k < 64) v = a2[(k - 32) * AW + n]; else if (k < 128) v = g2[(k - 64) * AW + n]; else v = (l > 0) ? v2[(k - 128) * AW + n] : 0.f;
            LT[i] = (bf16)f2bf(v); }
        const float* wuk = F.in[I_WUK] + (size_t)l * 6 * 64 * 128; const float* wuv = F.in[I_WUV] + (size_t)l * 6 * 128 * 64;
        bf16* wukT = (bf16*)(F.ws + WS_WUKT) + (size_t)l * 6 * 64 * 128; bf16* wuvT = (bf16*)(F.ws + WS_WUVT) + (size_t)l * 6 * 64 * 128;
        for (int i = F.vcu * NTHR + F.tid; i < 6 * 64 * 128; i += F.G * NTHR) {
            { const int hh = i / 8192, rem = i - hh * 8192, c = rem >> 6, d = rem & 63; wukT[i] = (bf16)f2bf(wuk[(hh * 64 + d) * 128 + c]); }
            { const int hh = i / 8192, rem = i - hh * 8192, d = rem >> 7, c = rem & 127; wuvT[i] = (bf16)f2bf(wuv[(hh * 128 + c) * 64 + d]); } }
    }
}
__device__ __forceinline__ void prep_tokens_unit(const Frame& F, int l, int unit) {
    LAS bf16* XS = (LAS bf16*)(F.lds + PR_XS);
    const int tid = F.tid, lane = F.lane, wave = F.wave, r32 = lane & 31, hi = lane >> 5, tok0 = unit * PT;
    const bf16* P = (const bf16*)(F.ws + WS_P);
    unsigned dga_ = 0;
    DG_START(20, dg20_)
    for (int base = 0; base < PT * 162; base += 5 * NTHR) {
        v4u cw[5], pw[5];
#pragma unroll
        for (int u = 0; u < 5; ++u) { const int idx = base + u * NTHR + tid; const int idc = idx < PT * 162 ? idx : PT * 162 - 1; const int t = idc / 162, ch = idc - t * 162, tok = tok0 + t;
            cw[u] = *(const GAS v4u*)(P + (size_t)tok * PP + ch * 8);
            const int tokp = (tok & (SEQ - 1)) != 0 ? tok - 1 : tok; pw[u] = *(const GAS v4u*)(P + (size_t)tokp * PP + ch * 8); }
#pragma unroll
        for (int u = 0; u < 5; ++u) { const int idx = base + u * NTHR + tid;
            if (idx < PT * 162) { const int t = idx / 162, ch = idx - t * 162, tok = tok0 + t, c0 = ch * 8;
                float cur[8], prv[8]; unpack8(cw[u], cur); unpack8(pw[u], prv);
                const bool first = (tok & (SEQ - 1)) == 0;
                float mv[8];
                { const LAS f32x4* mp = (const LAS f32x4*)((const LAS float*)(F.lds + PR_MU) + c0); const f32x4 m0 = mp[0], m1 = mp[1]; mv[0] = m0[0]; mv[1] = m0[1]; mv[2] = m0[2]; mv[3] = m0[3]; mv[4] = m1[0]; mv[5] = m1[1]; mv[6] = m1[2]; mv[7] = m1[3]; }
                float o[8];
#pragma unroll
                for (int j = 0; j < 8; ++j) { const float pv = first ? 0.f : prv[j]; float v = cur[j] + (pv - cur[j]) * mv[j];
                    if (c0 >= 1152 && c0 < 1184) v = tanh_f(v); else if (c0 >= 1216 && c0 < 1280) v = sigmoid_f(v);
                    o[j] = v; }
                v4u w; w.x = pk2(o[0], o[1]); w.y = pk2(o[2], o[3]); w.z = pk2(o[4], o[5]); w.w = pk2(o[6], o[7]);
                *(LAS v4u*)(XS + t * XSP + c0) = w; } }
    }
    __syncthreads();
    DG_STOP(20, dg20_, dga_)
    DG_WRITE(20, unit == 0 && l == 0 && wave == 0 && lane == 0, dga_)
    DG_START(21, dg21_)
    if (wave < 6) {
        const int h = wave;
        LAS bf16* STG = (LAS bf16*)(F.lds + PR_STG + wave * 4096);
        GAS unsigned char* wsb = (GAS unsigned char*)F.ws;
        const bf16* LT = (const bf16*)(F.ws + WS_LORA) + (size_t)l * AW * 144;
        const LAS float* CS = (const LAS float*)(F.lds + PR_CONST) + h * 64;
        const LAS float* kkw = CS; const LAS float* kaw = CS + AW; const LAS float* rkw = CS + 2 * AW; const LAS float* w0p = CS + 3 * AW; const LAS float* a0p = CS + 4 * AW; const LAS float* v0p = CS + 5 * AW;
        const LAS bf16* xrow = XS + r32 * XSP;
        float rn;
        { float ss = 0.f;
#pragma unroll
          for (int cbl = 0; cbl < 2; ++cbl)
#pragma unroll
              for (int g = 0; g < 4; ++g) { const int j0 = cbl * 32 + 8 * g + 4 * hi; const unsigned long long kw = *(const LAS unsigned long long*)(xrow + 384 + h * 64 + j0); const f32x4 kk4 = *(const LAS f32x4*)(kkw + j0);
                  const float k0 = bflo((unsigned)kw) * kk4[0], k1 = bfhi((unsigned)kw) * kk4[1], k2 = bflo((unsigned)(kw >> 32)) * kk4[2], k3 = bfhi((unsigned)(kw >> 32)) * kk4[3]; ss += (k0 * k0 + k1 * k1) + (k2 * k2 + k3 * k3); }
          ss += __shfl_xor(ss, 32); rn = 1.0f / fmaxf(sqrtf(ss), 1e-12f); }
        float bonus = 0.f;
        const int srow = lane >> 2, sch = lane & 3;
#pragma unroll
        for (int cbl = 0; cbl < 2; ++cbl) {
            asm volatile("" ::: "memory");
            const int cb0 = h * 64 + cbl * 32;
            f32x16_t wv, av, gv, mvv;
#pragma unroll
            for (int i = 0; i < 16; ++i) { wv[i] = 0.f; av[i] = 0.f; gv[i] = 0.f; mvv[i] = 0.f; }
            const bf16* lrow = LT + (size_t)(cb0 + r32) * 144 + 8 * hi;
#pragma unroll
            for (int ks = 0; ks < 9; ++ks) { const bf16x8_t a = *(const GAS bf16x8_t*)(lrow + 16 * ks); const bf16x8_t bx = *(const LAS bf16x8_t*)(xrow + 1152 + 16 * ks + 8 * hi);
                if (ks < 2) wv = __builtin_amdgcn_mfma_f32_32x32x16_bf16(a, bx, wv, 0, 0, 0);
                else if (ks < 4) av = __builtin_amdgcn_mfma_f32_32x32x16_bf16(a, bx, av, 0, 0, 0);
                else if (ks < 8) gv = __builtin_amdgcn_mfma_f32_32x32x16_bf16(a, bx, gv, 0, 0, 0);
                else mvv = __builtin_amdgcn_mfma_f32_32x32x16_bf16(a, bx, mvv, 0, 0, 0); }
            if (l > 0) {
#pragma unroll
                for (int i = 0; i < 2; ++i) { const int row = srow + 16 * i; const unsigned eo = (unsigned)(((tok0 + row) * AW + cb0 + sch * 8) * 2); *(LAS v4u*)(STG + row * 32 + sch * 8) = *(const GAS v4u*)(wsb + WS_VF + eo); } }
            unsigned long long ro[4], dd[4], k2o[4], kko[4], bpo[4], vo[4], go[4];
#pragma unroll
            for (int g = 0; g < 4; ++g) { const int j0 = cbl * 32 + 8 * g + 4 * hi;
                const unsigned long long rw = *(const LAS unsigned long long*)(xrow + h * 64 + j0), kw = *(const LAS unsigned long long*)(xrow + 384 + h * 64 + j0), vw = *(const LAS unsigned long long*)(xrow + 768 + h * 64 + j0);
                unsigned long long fw = 0ull; if (l > 0) fw = *(const LAS unsigned long long*)(STG + r32 * 32 + 8 * g + 4 * hi);
                asm volatile("" : "+v"(bonus) :: "memory");
                const f32x4 kk4 = *(const LAS f32x4*)(kkw + j0), ka4 = *(const LAS f32x4*)(kaw + j0), rk4 = *(const LAS f32x4*)(rkw + j0), w04 = *(const LAS f32x4*)(w0p + j0), a04 = *(const LAS f32x4*)(a0p + j0);
                const f32x4 v04 = *(const LAS f32x4*)(v0p + j0);
                const float rr[4] = {bflo((unsigned)rw), bfhi((unsigned)rw), bflo((unsigned)(rw >> 32)), bfhi((unsigned)(rw >> 32))};
                const float kx[4] = {bflo((unsigned)kw), bfhi((unsigned)kw), bflo((unsigned)(kw >> 32)), bfhi((unsigned)(kw >> 32))};
                const float vx[4] = {bflo((unsigned)vw), bfhi((unsigned)vw), bflo((unsigned)(vw >> 32)), bfhi((unsigned)(vw >> 32))};
                const float fx[4] = {bflo((unsigned)fw), bfhi((unsigned)fw), bflo((unsigned)(fw >> 32)), bfhi((unsigned)(fw >> 32))};
                float d_[4], k2_[4], kk_[4], bp_[4], v_[4];
#pragma unroll
                for (int e = 0; e < 4; ++e) { const int i = 4 * g + e;
                    const float sp = softplus_f(-(wv[i] + w04[e])); const float rate = __expf(-sp - 0.5f); const float d = 1.0f - __expf(-rate);
                    const float a = sigmoid_f(av[i] + a04[e]);
                    float v = vx[e]; if (l > 0) v = v + (fx[e] - v) * sigmoid_f(mvv[i] + v04[e]);
                    const float kk = kx[e] * kk4[e] * rn, k2 = kx[e] * (1.0f + (a - 1.0f) * ka4[e]);
                    d_[e] = d; k2_[e] = k2; kk_[e] = kk; bp_[e] = kk * a; v_[e] = v;
                    bonus += rr[e] * k2 * rk4[e]; }
#define PK4(x) ((unsigned long long)pk2(x[0], x[1]) | ((unsigned long long)pk2(x[2], x[3]) << 32))
                ro[g] = rw; dd[g] = PK4(d_); k2o[g] = PK4(k2_); kko[g] = PK4(kk_); bpo[g] = PK4(bp_); vo[g] = PK4(v_);
                go[g] = (unsigned long long)pk2(gv[4 * g], gv[4 * g + 1]) | ((unsigned long long)pk2(gv[4 * g + 2], gv[4 * g + 3]) << 32); }
#define PR_OUT(arr, dst) do { _Pragma("unroll") for (int g = 0; g < 4; ++g) *(LAS unsigned long long*)(STG + r32 * 32 + 8 * g + 4 * hi) = arr[g]; \
            _Pragma("unroll") for (int i = 0; i < 2; ++i) { const int row = srow + 16 * i; const unsigned eo = (unsigned)(((tok0 + row) * AW + cb0 + sch * 8) * 2); *(GAS v4u*)(wsb + dst + eo) = *(const LAS v4u*)(STG + row * 32 + sch * 8); } } while (0)
            PR_OUT(ro, WS_R); PR_OUT(dd, WS_D); PR_OUT(k2o, WS_K2); PR_OUT(kko, WS_KK); PR_OUT(bpo, WS_BP); PR_OUT(vo, WS_VF); PR_OUT(go, WS_G);
#undef PR_OUT
#undef PK4
        }
        bonus += __shfl_xor(bonus, 32);
        if (hi == 0) ((float*)(F.ws + WS_BON))[(size_t)(tok0 + r32) * 6 + h] = bonus;
    } else {
        const float* kvn = F.in[I_KVN] + l * 128; bf16* C = (bf16*)(F.ws + WS_C);
        for (int q = 0; q < 16; ++q) { const int tok = tok0 + 16 * (wave - 6) + q; const unsigned w = *(const GAS unsigned*)(P + (size_t)tok * PP + PBC + 2 * lane);
            const float c0 = bflo(w), c1 = bfhi(w); const float ss = wave_sum(c0 * c0 + c1 * c1); const float rs = 1.0f / sqrtf(ss * (1.0f / 128.0f) + 1e-6f);
            *(GAS unsigned*)(C + (size_t)tok * 128 + 2 * lane) = pk2(c0 * rs * kvn[2 * lane], c1 * rs * kvn[2 * lane + 1]); }
    }
    DG_STOP(21, dg21_, dga_)
    DG_WRITE(21, unit == 0 && l == 0 && wave == 0 && lane == 0, dga_)
    __syncthreads();
}

__device__ __forceinline__ void final_norm(const Frame& F) {
    const int gw = F.vcu * NWAVES + F.wave, NGW = F.G * NWAVES; const float* g = F.in[I_FN];
    for (int m = gw; m < M; m += NGW) { GAS f32x4* xr = (GAS f32x4*)(F.out + (size_t)m * DM) + F.lane; f32x4 v[4]; float s = 0.f;
#pragma unroll
        for (int j = 0; j < 4; ++j) { v[j] = xr[64 * j]; s += (v[j].x * v[j].x + v[j].y * v[j].y) + (v[j].z * v[j].z + v[j].w * v[j].w); }
        const float rs = 1.0f / sqrtf(wave_sum(s) * (1.0f / DM) + 1e-6f);
#pragma unroll
        for (int j = 0; j < 4; ++j) { const f32x4 gg = *(const f32x4*)(g + 4 * F.lane + 256 * j); xr[64 * j] = v[j] * rs * gg; } }
}

template <class T> __device__ __forceinline__ T* launder_ptr(T* p) {
    unsigned lo = (unsigned)(uintptr_t)p, hi = (unsigned)((uintptr_t)p >> 32);
    asm volatile("" : "+v"(lo), "+v"(hi));
    lo = __builtin_amdgcn_readfirstlane(lo); hi = __builtin_amdgcn_readfirstlane(hi);
    return (T*)(((uintptr_t)hi << 32) | (uintptr_t)lo);
}
constexpr int NPHASE = 20;
constexpr int DUP_PHASE = -1;
constexpr int QDUP = 1;
constexpr int REP_SCAN_K = 1, REP_THR_K = 1;
constexpr int NSTEP = NPHASE + (DUP_PHASE >= 0 ? 1 : 0);
constexpr int REP_THR = 1, REP_PTOK = 1, REP_KV = 1, REP_CONV = 1, REP_SCAN = 1, REP_DSA = 1, REP_RET = 1, REP_UP = 1;
#define REPL(n) for (int rep_ = 0; rep_ < (l == 0 ? (n) : 1); ++rep_)
__global__ void __launch_bounds__(NTHR, 2) fwd_kernel(Args args) {
    extern __shared__ __attribute__((aligned(16))) unsigned char lds[];
    Frame F;
    F.lds = (LAS unsigned char*)lds;
    F.tid = threadIdx.x; F.lane = F.tid & 63; F.wave = __builtin_amdgcn_readfirstlane(F.tid >> 6);
    F.G = gridDim.x; { const int bx = blockIdx.x; F.vcu = (F.G % 8 == 0) ? (bx % 8) * (F.G / 8) + bx / 8 : bx; }
    F.in = (const float* const __attribute__((address_space(4)))*)__builtin_amdgcn_kernarg_segment_ptr(); F.out = args.out; F.ws = args.ws;
    volatile LAS unsigned* MISC = (volatile LAS unsigned*)(F.lds + MISC_OFF);
    for (int u = F.tid; u < (LDS_BYTES - LDSCTL_OFF) / 4; u += NTHR) ((LAS unsigned*)(F.lds + LDSCTL_OFF))[u] = 0u;
    __syncthreads();
    const int lo = args.ph_lo, hi = args.ph_hi;
    XcdBarrier bar; bar.bar = (unsigned*)(F.ws + WS_CTL) + CW_BAR; bar.x = 0; bar.st = nullptr;
    if (hi - lo > 1) bar = xcd_barrier_post((unsigned*)(F.ws + WS_CTL) + CW_BAR, MISC + 8);
    for (int ph_ = lo; ph_ < hi; ++ph_) {
        unsigned dgp0_ = 0; if (DIAG_SLOT_D >= 100) dgp0_ = (unsigned)__builtin_amdgcn_s_memtime();
        int ph = (args.dup_phase >= 0 && ph_ > args.dup_phase) ? ph_ - 1 : ph_; asm volatile("" : "+v"(ph)); ph = __builtin_amdgcn_readfirstlane(ph);
#define PH_ENTER() \
        { unsigned z_ = 0u; int t_ = threadIdx.x; asm volatile("" : "+v"(z_), "+v"(t_)); z_ = __builtin_amdgcn_readfirstlane(z_); F.in = (const float* const __attribute__((address_space(4)))*)((const char __attribute__((address_space(4)))*)__builtin_amdgcn_kernarg_segment_ptr() + z_); F.out = args.out + z_; F.ws = args.ws + z_; \
          F.tid = t_; F.lane = t_ & 63; F.wave = __builtin_amdgcn_readfirstlane(t_ >> 6); } \
        int bx = blockIdx.x; { int g_ = gridDim.x; asm volatile("" : "+v"(bx), "+v"(g_)); bx = __builtin_amdgcn_readfirstlane(bx); g_ = __builtin_amdgcn_readfirstlane(g_); F.G = g_; F.vcu = (g_ % 8 == 0) ? (bx % 8) * (g_ / 8) + bx / 8 : bx; } \
        gu32* ctl = (gu32*)(F.ws + WS_CTL); (void)ctl; \
        bf16* XB = (bf16*)(F.ws + WS_XB); bf16* Hb = (bf16*)(F.ws + WS_H); bf16* Pb = (bf16*)(F.ws + WS_P); float* part = (float*)(F.ws + WS_PART); (void)XB; (void)Hb; (void)Pb; (void)part;
        if (ph == 0) { PH_ENTER();
            if (DIAG_SLOT_D >= 0 && bx == 0 && threadIdx.x == 0) { ((unsigned*)(args.ws + WS_DIAG))[0] = 0u; ((unsigned*)(args.ws + WS_DIAG))[1] = 0u; }
            conv_weights(F, 0, 0, 3);
            p0_x(F); p0_table(F); small_weights(F);
        } else if (ph == NPHASE - 1) { PH_ENTER();
            if (DIAG_SLOT_D >= 0) {
                const unsigned* D = (const unsigned*)(F.ws + WS_DIAG); const float x0 = (float)D[0] * (1.0f / (100.0f * DIAG_DIV)); const float gq = (DIAG_SLOT_D >= 100) ? 4.0f : 2.0f; const float kq = floorf(log2f(fmaxf(x0, 1.0f)) * gq); const float x = exp2f((kq + 0.5f) / gq); const float c = sqrtf(fmaxf(x - 1.0f, 0.01f));
                for (size_t i = (size_t)F.vcu * NTHR + F.tid; i < (size_t)M * DM; i += (size_t)F.G * NTHR) F.out[i] = c;
            } else
            final_norm(F);
        } else {
            const int l = (ph - 1) / 9, sub = (ph - 1) - 9 * l;
            if (sub == 0 || sub == 7) { PH_ENTER();
                pg8::Gemm g{XB, (const bf16*)(F.ws + (sub == 0 ? WS_WGU1 : WS_WGU2)), M, NGU, DM, DM}; pg8::StaticOrder S; S.init(M, NGU, F.G, bx);
                pg8::EpiUp E{Hb, FFP, part};
                for (int rep = 0; rep < ((l == 0 && sub == 0) ? REP_UP : 1); ++rep) pg8::gemm_phase<pg8::EpiUp, pg8::StaticOrder, true>(F.lds, g, S, E, F.tid);
            } else if (sub == 1 || sub == 8 || sub == 6) { PH_ENTER();
                const bool op = (sub == 6);
                pg8::Gemm g{op ? Pb : Hb, (const bf16*)(F.ws + (op ? WS_WOUT : (sub == 1 ? WS_WD1 : WS_WD2))), M, DM, op ? DM : FFP, op ? PP : FFP}; pg8::StaticOrder S; S.init(M, DM, F.G, bx);
                const float* base = (l == 0 && sub == 1) ? F.in[I_X] : F.out;
                pg8::EpiRes E{base, F.out, XB, part};
                pg8::gemm_phase<pg8::EpiRes, pg8::StaticOrder, false>(F.lds, g, S, E, F.tid);
            } else if (sub == 2) { PH_ENTER();
                pg8::Gemm g{XB, (const bf16*)(F.ws + WS_WIN), M, PP, DM, DM}; pg8::StaticOrder S; S.init(M, PP, F.G, bx);
                pg8::EpiP E{Pb, PP, part};
                pg8::gemm_phase<pg8::EpiP, pg8::StaticOrder, true>(F.lds, g, S, E, F.tid);
            } else if (sub == 3) { PH_ENTER();
                for (int rep_ = 0; rep_ < (l == 0 ? args.rep_thr : 1); ++rep_)
                    for (int k = 0, u0 = F.vcu; u0 < M / 16; ++k, u0 += F.G) {
                        const int base = k * F.G, span = (M / 16 - base) < F.G ? (M / 16 - base) : F.G; const int u = (k & 1) ? base + span - 1 - F.vcu : u0;
                        if (u >= base && u < M / 16) dsa_thr_unit(F, u); }
                prep_consts(F, l);
                REPL(REP_PTOK) for (int u = F.vcu; u < M / PT; u += F.G) prep_tokens_unit(F, l, u);

            } else if (sub == 5) { PH_ENTER();
                rwkv_post(F, l);
            } else if (sub == 4) { PH_ENTER();
                unsigned dgm_ = 0; if (DIAG_SLOT_D >= 50 && DIAG_SLOT_D < 60) dgm_ = (unsigned)__builtin_amdgcn_s_memtime();
                if (bx < BATCH * 12) { for (int rep_ = 0; rep_ < (l == 0 ? args.rep_scan : 1); ++rep_) { rwkv_scan_unit(F, l, bx); __syncthreads(); } }
                if (DIAG_SLOT_D == 54 && l == 0 && bx < BATCH * 12 && threadIdx.x == 0) atomicMax((unsigned*)(args.ws + WS_DIAG), (unsigned)__builtin_amdgcn_s_memtime() - dgm_);
                if (DIAG_SLOT_D == 50 && l == 0 && bx == 0 && threadIdx.x == 0) ((unsigned*)(args.ws + WS_DIAG))[0] = (unsigned)__builtin_amdgcn_s_memtime() - dgm_;
                {
                    gu32* qh = ctl + CW_QUEUE + 64 * l;
                    for (;;) {
                        if (F.tid == 0) MISC[0] = __hip_atomic_fetch_add(qh, 1u, RLX_AGENT);
                        __syncthreads();
                        const int u = (int)MISC[0];
                        __syncthreads();
                        const int nd = (l == 0 ? args.qdup : 1) * (M / 32);
                        { unsigned z_ = 0u; int t_ = threadIdx.x; asm volatile("" : "+v"(z_), "+v"(t_)); z_ = __builtin_amdgcn_readfirstlane(z_); F.ws = args.ws + z_; F.tid = t_; F.lane = t_ & 63; F.wave = __builtin_amdgcn_readfirstlane(t_ >> 6); }
                        const int ncv = (conv_flat_items(l + 1 < DEPTH) + NWAVES * CONV_PER_WAVE - 1) / (NWAVES * CONV_PER_WAVE);
                        if (DIAG_SLOT_D == 53 && l == 0 && bx == 200 && threadIdx.x == 0 && u >= BATCH * 4 + nd) { unsigned* D_ = (unsigned*)(args.ws + WS_DIAG); if (D_[1] != 0x600Du) { D_[1] = 0x600Du; D_[0] = (unsigned)__builtin_amdgcn_s_memtime() - dgm_; } }
                        if (u >= nd + BATCH * 4 + ncv) { if (DIAG_SLOT_D == 51 && l == 0 && bx == 0 && threadIdx.x == 0) ((unsigned*)(args.ws + WS_DIAG))[0] = (unsigned)__builtin_amdgcn_s_memtime() - dgm_;
                            if (DIAG_SLOT_D == 52 && l == 0 && bx == 200 && threadIdx.x == 0) ((unsigned*)(args.ws + WS_DIAG))[0] = (unsigned)__builtin_amdgcn_s_memtime() - dgm_; }
                        if (DIAG_SLOT_D == 55 && l == 0 && u >= nd + BATCH * 4 + ncv && threadIdx.x == 0) atomicMax((unsigned*)(args.ws + WS_DIAG), (unsigned)__builtin_amdgcn_s_memtime() - dgm_);
                        if (DIAG_SLOT_D == 56 && l == 0 && u >= BATCH * 4 && u < nd + BATCH * 4 && threadIdx.x == 0) atomicMax((unsigned*)(args.ws + WS_DIAG), (unsigned)__builtin_amdgcn_s_memtime() - dgm_);
                        if (u >= nd + BATCH * 4 + ncv) break;
                        if (u < BATCH * 4) ret_out_unit(F, u);
                        else if (u < nd + BATCH * 4) dsa_attn_unit(F, l, (u - BATCH * 4) % (M / 32));
                        else { conv_unit(F, l, u - nd - BATCH * 4); __syncthreads(); }
                    }
                }
            }
        }
        if (ph_ + 1 < hi) xcd_barrier(bar);
        if (DIAG_SLOT_D >= 100 && ph_ == DIAG_SLOT_D - 100 && blockIdx.x == 0 && threadIdx.x == 0) ((unsigned*)(args.ws + WS_DIAG))[0] = (unsigned)__builtin_amdgcn_s_memtime() - dgp0_;
    }
}

extern "C" void kernel_launch(void* const* d_in, const int* in_sizes, int n_in, void* d_out, int out_size, void* d_ws, size_t ws_size, hipStream_t stream) {
    static int grid = 0;
    if (grid == 0) {
        if (n_in != 31 || out_size != M * DM || ws_size < WS_END) { fprintf(stderr, "kernel_launch: unexpected shapes (n_in %d, out %d, ws %zu)\n", n_in, out_size, ws_size); grid = -1; return; }
        int dev = 0, cus = 0, per_cu = 0;
        if (hipGetDevice(&dev) != hipSuccess || hipDeviceGetAttribute(&cus, hipDeviceAttributeMultiprocessorCount, dev) != hipSuccess) { grid = -1; return; }
        if (hipFuncSetAttribute((const void*)fwd_kernel, hipFuncAttributeMaxDynamicSharedMemorySize, LDS_BYTES) != hipSuccess) { fprintf(stderr, "kernel_launch: hipFuncSetAttribute failed\n"); grid = -1; return; }
        if (hipOccupancyMaxActiveBlocksPerMultiprocessor(&per_cu, (const void*)fwd_kernel, NTHR, LDS_BYTES) != hipSuccess || per_cu < 1) fprintf(stderr, "kernel_launch: occupancy query says %d\n", per_cu);
        (void)hipGetLastError();
        grid = cus;
    }
    if (grid < 0) return;
    if (hipMemsetAsync((char*)d_ws + WS_CTL, 0, CTL_ZERO_BYTES, stream) != hipSuccess) return;
    Args a{};
    for (int i = 0; i < 31; ++i) a.in[i] = (const float*)d_in[i];
    a.out = (float*)d_out; a.ws = (unsigned char*)d_ws; a.dup_phase = DUP_PHASE; a.qdup = QDUP; a.rep_scan = REP_SCAN_K; a.rep_thr = REP_THR_K;
#ifndef ONE_LAUNCH
#define ONE_LAUNCH 1
#endif
    if (ONE_LAUNCH) { a.ph_lo = 0; a.ph_hi = NSTEP; hipLaunchKernelGGL(fwd_kernel, dim3(grid), dim3(NTHR), LDS_BYTES, stream, a); }
    else for (int ph = 0; ph < NPHASE; ++ph) { a.ph_lo = ph; a.ph_hi = ph + 1; hipLaunchKernelGGL(fwd_kernel, dim3(grid), dim3(NTHR), LDS_BYTES, stream, a); }
}
```

```cpp
#include <hip/hip_runtime.h>
#include <cstdio>
#include <cstdint>
#include <cmath>

namespace pg8 {
#define PG8_LAS __attribute__((address_space(3)))
typedef unsigned short bf16_t;
typedef short bf16x8 __attribute__((ext_vector_type(8)));
typedef float f32x4 __attribute__((ext_vector_type(4)));
typedef unsigned u32x4 __attribute__((ext_vector_type(4)));
constexpr int BM = 256, BK = 64, HALF = 128, HTB = HALF * BK * 2  , STAGE_BYTES = 8 * HTB, NXCD = 8, WGM = 8;

__host__ __device__ __forceinline__ int lds_byte(int r, int c) { const int st = (r >> 4) * 2 + (c >> 5), rr = r & 15, cc = c & 31, ob = rr * 64 + cc * 2; return st * 1024 + (ob ^ (((ob >> 9) & 1) << 5)); }
__host__ __device__ __forceinline__ void stage_rc(int b, int& R, int& C) { const int st = b / 1024, sb = b % 1024, swz = sb ^ (((sb >> 9) & 1) << 5); R = (st >> 1) * 16 + swz / 64; C = (st & 1) * 32 + (swz % 64) / 2; }
__host__ __device__ __forceinline__ int perm32(int rho) { const int n = rho >> 4, i = rho & 15; return 8 * (i >> 2) + 4 * n + (i & 3); }

struct Unit { int pm, pn; };
struct Gemm { const bf16_t* A; const bf16_t* Bt; int M, N, K, lda; };

struct StaticOrder {
    int nM, nN, nwg, G, c;
    __host__ __device__ void init(int M, int N, int G_, int c_) { nM = M / BM; nN = N / BM; nwg = nM * nN; G = G_; c = c_; }
    __host__ __device__ bool next(int i, Unit& u) const {
        const long L = (long)i * G + c; if (L >= nwg) return false;
        int wgid = (int)L; { const int q = nwg / NXCD, r = nwg % NXCD, xcd = wgid % NXCD, off = wgid / NXCD; wgid = (xcd < r ? xcd * (q + 1) : r * (q + 1) + (xcd - r) * q) + off; }
        const int nig = WGM * nN, gid = wgid / nig, fm = gid * WGM, gsz = (nM - fm) < WGM ? (nM - fm) : WGM;
        u.pm = fm + ((wgid % nig) % gsz); u.pn = (wgid % nig) / gsz; return true;
    }
    __device__ __forceinline__ void a_ready(const Unit&) const {}
    __device__ __forceinline__ void done(const Unit&) const {}
};

__device__ __forceinline__ unsigned cvt_pk_bf16(float lo, float hi) { unsigned r; asm volatile("v_cvt_pk_bf16_f32 %0, %1, %2" : "=v"(r) : "v"(lo), "v"(hi)); return r; }


__device__ __forceinline__ float row_rstd(const float* part, int row) {
    const f32x4* p = (const f32x4*)(part + (size_t)row * 16);
    const f32x4 a = p[0], b = p[1], c = p[2], d = p[3];
    const float s = ((a[0] + a[1]) + (a[2] + a[3])) + ((b[0] + b[1]) + (b[2] + b[3])) + ((c[0] + c[1]) + (c[2] + c[3])) + ((d[0] + d[1]) + (d[2] + d[3]));
    return 1.0f / sqrtf(s * (1.0f / 1024.0f) + 1e-6f);
}
__device__ __forceinline__ float silu_f(float x) { return x * __builtin_amdgcn_rcpf(1.0f + __expf(-x)); }

struct EpiUp {
    static constexpr bool PERM = true;
    bf16_t* H; int ldh; const float* part;
    __device__ __forceinline__ void operator()(const f32x4 (&acc)[2][2][4][2], const Unit& u, int wr, int wc, int fr, int fq) const {
        const int row0 = u.pm * BM + wr * 64 + fr, hcol = u.pn * 128 + wc * 32 + 8 * fq;
#pragma unroll
        for (int ai = 0; ai < 2; ++ai)
#pragma unroll
            for (int m = 0; m < 4; ++m) { const int row = row0 + ai * HALF + m * 16; const float rs = row_rstd(part, row);
                const f32x4 g0 = acc[ai][0][m][0] * rs, g1 = acc[ai][0][m][1] * rs, u0 = acc[ai][1][m][0] * rs, u1 = acc[ai][1][m][1] * rs;
                u32x4 w; w.x = cvt_pk_bf16(silu_f(g0[0]) * u0[0], silu_f(g0[1]) * u0[1]); w.y = cvt_pk_bf16(silu_f(g0[2]) * u0[2], silu_f(g0[3]) * u0[3]);
                w.z = cvt_pk_bf16(silu_f(g1[0]) * u1[0], silu_f(g1[1]) * u1[1]); w.w = cvt_pk_bf16(silu_f(g1[2]) * u1[2], silu_f(g1[3]) * u1[3]);
                *(u32x4*)(H + (size_t)row * ldh + hcol) = w; }
    }
};
struct EpiP {
    static constexpr bool PERM = true;
    bf16_t* P; int ldp; const float* part;
    __device__ __forceinline__ void operator()(const f32x4 (&acc)[2][2][4][2], const Unit& u, int wr, int wc, int fr, int fq) const {
        const int row0 = u.pm * BM + wr * 64 + fr, col0 = u.pn * BM + wc * 32 + 8 * fq;
#pragma unroll
        for (int ai = 0; ai < 2; ++ai)
#pragma unroll
            for (int m = 0; m < 4; ++m) { const int row = row0 + ai * HALF + m * 16; const float rs = row_rstd(part, row);
#pragma unroll
                for (int bj = 0; bj < 2; ++bj) { const f32x4 v0 = acc[ai][bj][m][0] * rs, v1 = acc[ai][bj][m][1] * rs;
                    u32x4 w; w.x = cvt_pk_bf16(v0[0], v0[1]); w.y = cvt_pk_bf16(v0[2], v0[3]); w.z = cvt_pk_bf16(v1[0], v1[1]); w.w = cvt_pk_bf16(v1[2], v1[3]);
                    *(u32x4*)(P + (size_t)row * ldp + col0 + bj * HALF) = w; } }
    }
};
struct EpiRes {
    static constexpr bool PERM = true;
    const float* base; float* out; bf16_t* xb; float* part;
    __device__ __forceinline__ void operator()(const f32x4 (&acc)[2][2][4][2], const Unit& u, int wr, int wc, int fr, int fq) const {
        const int row0 = u.pm * BM + wr * 64 + fr, col0 = u.pn * BM + wc * 32 + 8 * fq;
#pragma unroll
        for (int ai = 0; ai < 2; ++ai)
#pragma unroll
            for (int m = 0; m < 4; ++m) { const int row = row0 + ai * HALF + m * 16; float ss = 0.f;
#pragma unroll
                for (int bj = 0; bj < 2; ++bj) { const size_t off = (size_t)row * 1024 + col0 + bj * HALF;
                    const f32x4 v0 = acc[ai][bj][m][0] + *(const f32x4*)(base + off), v1 = acc[ai][bj][m][1] + *(const f32x4*)(base + off + 4);
                    *(f32x4*)(out + off) = v0; *(f32x4*)(out + off + 4) = v1;
                    u32x4 w; w.x = cvt_pk_bf16(v0[0], v0[1]); w.y = cvt_pk_bf16(v0[2], v0[3]); w.z = cvt_pk_bf16(v1[0], v1[1]); w.w = cvt_pk_bf16(v1[2], v1[3]);
                    *(u32x4*)(xb + off) = w;
                    ss += (v0[0] * v0[0] + v0[1] * v0[1]) + (v0[2] * v0[2] + v0[3] * v0[3]) + (v1[0] * v1[0] + v1[1] * v1[1]) + (v1[2] * v1[2] + v1[3] * v1[3]); }
                ss += __shfl_xor(ss, 16); ss += __shfl_xor(ss, 32);
                if (fq == 0) part[(size_t)row * 16 + u.pn * 4 + wc] = ss;
                asm volatile("" ::: "memory"); }
    }
};

template <class Epi, class Sched, bool ALIGN_EPI>
__device__ __forceinline__ void gemm_phase(PG8_LAS unsigned char* lds, const Gemm g, const Sched& S, const Epi& E, const int tid) {
    const int wid = __builtin_amdgcn_readfirstlane(tid >> 6), lane = tid & 63, wr = wid >> 2, wc = wid & 3, fr = lane & 15, fq = lane >> 4;
    const int K = g.K, nt = K / BK, lda = g.lda;
    unsigned voffA[2], voffB[2];
#pragma unroll
    for (int i = 0; i < 2; ++i) { int R, C; stage_rc(tid * 16 + i * 8192, R, C); const int Rb = Epi::PERM ? ((R & ~31) + perm32(R & 31)) : R;
        voffA[i] = (unsigned)(R * lda + C) * 2u; voffB[i] = (unsigned)(Rb * K + C) * 2u; }
    const size_t kstep = (size_t)(BK * 2);
    const size_t hstepA = (size_t)HALF * lda * 2, hstepB = (size_t)HALF * K * 2;
    const size_t tstepA = 2 * hstepA, tstepB = 2 * hstepB;
    const unsigned ldsw = (unsigned)wid * 1024u;
    const int aoff = lds_byte(wr * 64 + fr, fq * 8), boff = lds_byte(wc * 32 + fr, fq * 8);
#define PG8_SA(b, h) (((b) * 2 + (h)) * HTB)
#define PG8_SB(b, h) ((4 + (b) * 2 + (h)) * HTB)
#define PG8_STAGE(bufoff, gbase, voff) do { _Pragma("unroll") for (int _i = 0; _i < 2; ++_i) \
        __builtin_amdgcn_global_load_lds((const unsigned*)((const char*)(gbase) + (voff)[_i]), (PG8_LAS unsigned*)(lds + (bufoff) + ldsw + _i * 8192), 16, 0, 0); } while (0)
#define PG8_LDA(dst, b, h) do { _Pragma("unroll") for (int m = 0; m < 4; ++m) _Pragma("unroll") for (int k = 0; k < 2; ++k) dst[m][k] = *(const PG8_LAS bf16x8*)(lds + PG8_SA(b, h) + aoff + m * 2048 + k * 1024); } while (0)
#define PG8_LDB(dst, b, h) do { _Pragma("unroll") for (int n = 0; n < 2; ++n) _Pragma("unroll") for (int k = 0; k < 2; ++k) dst[n][k] = *(const PG8_LAS bf16x8*)(lds + PG8_SB(b, h) + boff + n * 2048 + k * 1024); } while (0)
#define PG8_MMA(ai, bj, At, Bt) do { __builtin_amdgcn_s_setprio(1); _Pragma("unroll") for (int m = 0; m < 4; ++m) _Pragma("unroll") for (int n = 0; n < 2; ++n) _Pragma("unroll") for (int k = 0; k < 2; ++k) \
        acc[ai][bj][m][n] = __builtin_amdgcn_mfma_f32_16x16x32_bf16(Bt[n][k], At[m][k], acc[ai][bj][m][n], 0, 0, 0); __builtin_amdgcn_s_setprio(0); } while (0)
#define PG8_WAIT_V(n) asm volatile("s_waitcnt vmcnt(" #n ")" ::: "memory")
#define PG8_WAIT_L(n) asm volatile("s_waitcnt lgkmcnt(" #n ")" ::: "memory")
#define PG8_BAR __builtin_amdgcn_s_barrier()
#define PG8_SCHED __builtin_amdgcn_sched_barrier(0)
    Unit cur, nxt; int ui = 0;
    if (!S.next(0, cur)) return;
    f32x4 acc[2][2][4][2];
#pragma unroll
    for (int a = 0; a < 2; ++a)
#pragma unroll
        for (int b = 0; b < 2; ++b)
#pragma unroll
            for (int m = 0; m < 4; ++m)
#pragma unroll
                for (int n = 0; n < 2; ++n) acc[a][b][m][n] = (f32x4){0.f, 0.f, 0.f, 0.f};
    bf16x8 At[4][2], B0[2][2], B1[2][2];
    const char* cA = (const char*)g.A + (size_t)cur.pm * tstepA; const char* cB = (const char*)g.Bt + (size_t)cur.pn * tstepB;
    S.a_ready(cur);
    PG8_STAGE(PG8_SB(0, 0), cB, voffB); PG8_STAGE(PG8_SB(0, 1), cB + hstepB, voffB); PG8_STAGE(PG8_SA(0, 0), cA, voffA); PG8_STAGE(PG8_SA(0, 1), cA + hstepA, voffA);
    if (wr == 1) PG8_BAR;
    PG8_WAIT_V(2); PG8_BAR;
    PG8_STAGE(PG8_SB(1, 0), cB + kstep, voffB); PG8_STAGE(PG8_SA(1, 0), cA + kstep, voffA); PG8_STAGE(PG8_SB(1, 1), cB + hstepB + kstep, voffB);
    PG8_WAIT_V(6); PG8_BAR;
    for (;;) {
        const bool has_next = S.next(ui + 1, nxt);
        const char* nA = has_next ? (const char*)g.A + (size_t)nxt.pm * tstepA : cA; const char* nB = has_next ? (const char*)g.Bt + (size_t)nxt.pn * tstepB : cB;
        for (int t = 0; t < nt; t += 2) {
            const bool last = (t == nt - 2);
            const char* a1 = cA + (size_t)(t + 1) * kstep;
            const char* a2 = last ? nA : cA + (size_t)(t + 2) * kstep; const char* b2 = last ? nB : cB + (size_t)(t + 2) * kstep;
            const char* a3 = a2 + kstep; const char* b3 = b2 + kstep;
            if (last && has_next) S.a_ready(nxt);
            PG8_LDB(B0, 0, 0); PG8_LDB(B1, 0, 1); PG8_SCHED; PG8_LDA(At, 0, 0); PG8_STAGE(PG8_SA(1, 1), a1 + hstepA, voffA);
            PG8_WAIT_V(8); PG8_WAIT_L(0); PG8_BAR; PG8_MMA(0, 0, At, B0); PG8_MMA(0, 1, At, B1); PG8_BAR; PG8_SCHED;
            PG8_LDA(At, 0, 1); PG8_STAGE(PG8_SB(0, 0), b2, voffB); PG8_STAGE(PG8_SB(0, 1), b2 + hstepB, voffB); PG8_STAGE(PG8_SA(0, 0), a2, voffA);
            PG8_WAIT_V(8); PG8_WAIT_L(0); PG8_BAR; PG8_MMA(1, 0, At, B0); PG8_MMA(1, 1, At, B1); PG8_BAR; PG8_SCHED;
            PG8_LDB(B0, 1, 0); PG8_LDB(B1, 1, 1); PG8_SCHED; PG8_LDA(At, 1, 0); PG8_STAGE(PG8_SA(0, 1), a2 + hstepA, voffA);
            PG8_WAIT_V(8); PG8_WAIT_L(0); PG8_BAR; PG8_MMA(0, 0, At, B0); PG8_MMA(0, 1, At, B1); PG8_BAR; PG8_SCHED;
            PG8_LDA(At, 1, 1); PG8_STAGE(PG8_SB(1, 0), b3, voffB); PG8_STAGE(PG8_SB(1, 1), b3 + hstepB, voffB); PG8_STAGE(PG8_SA(1, 0), a3, voffA);
            PG8_WAIT_V(8); PG8_WAIT_L(0); PG8_BAR; PG8_MMA(1, 0, At, B0); PG8_MMA(1, 1, At, B1); PG8_BAR; PG8_SCHED;
        }
        if constexpr (ALIGN_EPI) { if (wr == 0) PG8_BAR; }
        E(acc, cur, wr, wc, fr, fq); S.done(cur);
        if (!has_next) break;
#pragma unroll
        for (int a = 0; a < 2; ++a)
#pragma unroll
            for (int b = 0; b < 2; ++b)
#pragma unroll
                for (int m = 0; m < 4; ++m)
#pragma unroll
                    for (int n = 0; n < 2; ++n) acc[a][b][m][n] = (f32x4){0.f, 0.f, 0.f, 0.f};
        cur = nxt; cA = nA; cB = nB; ++ui;
        if constexpr (ALIGN_EPI) { if (wr == 1) PG8_BAR; }
    }
    PG8_WAIT_V(0);
    if constexpr (!ALIGN_EPI) { if (wr == 0) PG8_BAR; }
    PG8_BAR;
#undef PG8_SA
#undef PG8_SB
#undef PG8_STAGE
#undef PG8_LDA
#undef PG8_LDB
#undef PG8_MMA
#undef PG8_WAIT_V
#undef PG8_WAIT_L
#undef PG8_BAR
#undef PG8_SCHED
}
}

constexpr int NWAVES = 8, NTHR = 512;
constexpr int BATCH = 8, SEQ = 2048, DM = 1024, DEPTH = 2, FF = 2752, M = BATCH * SEQ;
constexpr int FFP = 2816;
constexpr int NGU = 5632;
constexpr int PP = 3584;
constexpr int NIN = 3400;
constexpr int PA = 0, PMV = 1280, PBQ = 1296, PBC = 1680, PBIQ = 1808, PBIK = 2320, PBIW = 2384, PCQ = 2392, PCK = 2648, PCV = 2904, PCG = 3160, PUSED = 3416;
constexpr int AW = 384;
constexpr int TOPK = 256;

constexpr size_t MiB = 1u << 20;
constexpr size_t WS_CTL = 0, CTL_ZERO_BYTES = 1 * MiB;
constexpr size_t WS_PART = 1 * MiB;
constexpr size_t WS_TAB = 2 * MiB;
constexpr size_t WS_BON = 2 * MiB + 512 * 1024;
constexpr size_t WS_WUKT = 3 * MiB, WS_WUVT = 3 * MiB + 192 * 1024;
constexpr size_t WS_THR = 3 * MiB + 384 * 1024, WS_SCUT = 3 * MiB + 448 * 1024;
constexpr size_t WS_LORA = 3 * MiB + 512 * 1024;
constexpr size_t WS_WGU1 = 4 * MiB, WS_WD1 = 15 * MiB, WS_WIN = 21 * MiB, WS_WOUT = 28 * MiB, WS_WGU2 = 30 * MiB, WS_WD2 = 41 * MiB;
constexpr size_t WS_XB = 47 * MiB;
constexpr size_t WS_VF = 79 * MiB;
constexpr size_t WS_P = 91 * MiB;
constexpr size_t WS_H = WS_P;
constexpr size_t WS_R = 203 * MiB, WS_D = 215 * MiB, WS_K2 = 227 * MiB, WS_KK = 239 * MiB, WS_C = 251 * MiB;
constexpr size_t WS_BP = WS_XB, WS_G = WS_XB + 12 * MiB, WS_KV = WS_XB + 24 * MiB;
constexpr size_t WS_MASK = WS_KV;
constexpr size_t WS_END = 256 * MiB;
static_assert(WS_WD2 + (size_t)1024 * FFP * 2 <= WS_XB && WS_P + (size_t)M * PP * 2 <= WS_R && WS_C + (size_t)M * 128 * 2 <= WS_END, "ws map");
constexpr int CW_BAR = 4096;
constexpr int CW_QUEUE = 16384;

constexpr int RING_BYTES = 131072;
constexpr int LDSCTL_OFF = RING_BYTES, MISC_OFF = LDSCTL_OFF + 320;
constexpr int LDS_BYTES = 147456;

#define GAS __attribute__((address_space(1)))
#define LAS __attribute__((address_space(3)))
typedef unsigned short bf16;
typedef unsigned v4u __attribute__((ext_vector_type(4)));
typedef float f32x4 __attribute__((ext_vector_type(4)));
typedef GAS unsigned gu32;
#define RLX_AGENT __ATOMIC_RELAXED, __HIP_MEMORY_SCOPE_AGENT
#define LDS_WAIT() asm volatile("s_waitcnt lgkmcnt(0)" ::: "memory")
__device__ __forceinline__ unsigned f2bf(float f) { unsigned u = __builtin_bit_cast(unsigned, f); return (u + 0x7fffu + ((u >> 16) & 1u)) >> 16; }
typedef float f32x2v_ __attribute__((ext_vector_type(2))); typedef __bf16 bf16x2v_ __attribute__((ext_vector_type(2)));
__device__ __forceinline__ unsigned pk2(float lo, float hi) { const f32x2v_ v = {lo, hi}; return __builtin_bit_cast(unsigned, __builtin_convertvector(v, bf16x2v_)); }
__device__ __forceinline__ float bf2f(unsigned short v) { return __uint_as_float((unsigned)v << 16); }
__device__ __forceinline__ float bflo(unsigned w) { return __uint_as_float(w << 16); }
__device__ __forceinline__ float bfhi(unsigned w) { return __uint_as_float(w & 0xffff0000u); }
__device__ __forceinline__ void unpack8(const v4u w, float (&f)[8]) { f[0] = bflo(w.x); f[1] = bfhi(w.x); f[2] = bflo(w.y); f[3] = bfhi(w.y); f[4] = bflo(w.z); f[5] = bfhi(w.z); f[6] = bflo(w.w); f[7] = bfhi(w.w); }
__device__ __forceinline__ float sigmoid_f(float x) { return 1.0f / (1.0f + __expf(-x)); }
__device__ __forceinline__ float wave_sum(float v) {
#pragma unroll
    for (int o = 1; o < 64; o <<= 1) v += __shfl_xor(v, o);
    return v;
}

#define XB_TMO      128
#define XB_XCNT(j)  (256  + 64 * (j))
#define XB_XSUB(j)  (1280 + 64 * (j))
#define XB_XGEN(j)  (2304 + 64 * (j))
#define XB_TOP      3328
#define XB_TOPGEN   3392
#define XCD_BAR_WORDS 3456
#define XB_SPIN_CAP (1u << 22)

__device__ __forceinline__ unsigned xb_ld(unsigned* p)              { return __hip_atomic_load(p, __ATOMIC_RELAXED, __HIP_MEMORY_SCOPE_AGENT); }
__device__ __forceinline__ unsigned xb_add(unsigned* p, unsigned v) { return __hip_atomic_fetch_add(p, v, __ATOMIC_RELAXED, __HIP_MEMORY_SCOPE_AGENT); }
__device__ __forceinline__ unsigned xb_xcc_id() { return (unsigned)__builtin_amdgcn_s_getreg((3 << 11) | 20) & 0xFu; }
#define XB_SPIN(cond, bar) do { unsigned _sp = 0; while (cond) { __builtin_amdgcn_s_sleep(1); \
    if ((++_sp & 255u) == 0u) { if (xb_ld(&(bar)[XB_TMO])) break; if (_sp > XB_SPIN_CAP) { atomicAdd(&(bar)[XB_TMO], 1u); break; } } } } while (0)

struct XcdBarrier { unsigned* bar; unsigned x; volatile LAS unsigned* st; };

__device__ __forceinline__ XcdBarrier xcd_barrier_post(unsigned* bar, volatile LAS unsigned* st) {
    XcdBarrier b; b.bar = bar; b.x = xb_xcc_id(); b.st = st;
    if (threadIdx.x == 0) (void)xb_add(&bar[XB_XCNT(b.x)], 1u);
    return b;
}
__device__ __forceinline__ void xcd_barrier_complete(unsigned* bar, unsigned x, unsigned& nloc, unsigned& nx) {
    const unsigned G = gridDim.x * gridDim.y * gridDim.z;
    unsigned sum, cnt, mine, sp = 0u;
    for (;;) {
        sum = 0u; cnt = 0u; mine = 0u;
#pragma unroll
        for (unsigned j = 0; j < 16; ++j) { const unsigned c = xb_ld(&bar[XB_XCNT(j)]); sum += c; cnt += (c > 0u) ? 1u : 0u; mine = (j == x) ? c : mine; }
        if (sum == G) break;
        __builtin_amdgcn_s_sleep(1);
        if ((++sp & 255u) == 0u) { if (xb_ld(&bar[XB_TMO])) break; if (sp > XB_SPIN_CAP) { atomicAdd(&bar[XB_TMO], 1u); break; } }
    }
    nloc = mine > 0u ? mine : 1u; nx = cnt > 0u ? cnt : 1u;
}
__device__ __forceinline__ void xcd_barrier(const XcdBarrier& b) {
    asm volatile("s_waitcnt vmcnt(0)" ::: "memory");
    __syncthreads();
    if (threadIdx.x == 0) {
        unsigned* bar = b.bar;
        __builtin_amdgcn_s_waitcnt(0);
        unsigned nloc = b.st[0], nx = b.st[1];
        if (nloc == 0u) { xcd_barrier_complete(bar, b.x, nloc, nx); b.st[0] = nloc; b.st[1] = nx; }
        const unsigned old = xb_add(&bar[XB_XSUB(b.x)], 1u);
        const unsigned gen = old / nloc;
        if (old + 1u == (gen + 1u) * nloc) {
            __builtin_amdgcn_fence(__ATOMIC_RELEASE, "agent");
            asm volatile("s_waitcnt vmcnt(0)" ::: "memory");
            const unsigned og = xb_add(&bar[XB_TOP], 1u);
            const unsigned tg = og / nx;
            if (og + 1u == (tg + 1u) * nx) xb_add(&bar[XB_TOPGEN], 1u);
            else XB_SPIN(xb_ld(&bar[XB_TOPGEN]) == tg, bar);
            __builtin_amdgcn_fence(__ATOMIC_ACQUIRE, "agent");
            xb_add(&bar[XB_XGEN(b.x)], 1u);
            asm volatile("s_waitcnt vmcnt(0)" ::: "memory");
        } else {
            XB_SPIN(xb_ld(&bar[XB_XGEN(b.x)]) == gen, bar);
            __builtin_amdgcn_fence(__ATOMIC_ACQUIRE, "agent");
            asm volatile("s_waitcnt vmcnt(0)" ::: "memory");
        }
    }
    __syncthreads();
}

#ifndef DIAG_SLOT_D
#define DIAG_SLOT_D (-1)
#endif
#ifndef DIAG_DIV
#define DIAG_DIV 1.0f
#endif
constexpr size_t WS_DIAG = 3 * MiB + 900 * 1024;
#define DG_START(k, var) unsigned var = 0; if (DIAG_SLOT_D == (k)) var = (unsigned)__builtin_amdgcn_s_memtime();
#define DG_STOP(k, var, acc) if (DIAG_SLOT_D == (k)) acc += (unsigned)__builtin_amdgcn_s_memtime() - var;
#define DG_WRITE(k, cond, acc) if (DIAG_SLOT_D == (k) && (cond)) ((unsigned*)(F.ws + WS_DIAG))[0] = acc;
struct Args { const float* in[31]; float* out; unsigned char* ws; int ph_lo, ph_hi; int dup_phase, qdup, rep_scan, rep_thr; };
struct Frame {
    LAS unsigned char* lds;
    int tid, lane, wave, vcu, G;
    const float* const __attribute__((address_space(4)))* in;
    float* out; unsigned char* ws;
};
enum { I_X = 0, I_F1N, I_F1G, I_F1U, I_F1D, I_MIXN, I_WIN, I_WOUT, I_MU, I_W0, I_W2, I_A0, I_A2, I_G2, I_KK, I_KA, I_RK, I_LNW, I_LNB, I_VRW, I_VRMU, I_V0, I_V2, I_KVN, I_WUK, I_WUV, I_F2N, I_F2G, I_F2U, I_F2D, I_FN };

__device__ __forceinline__ void conv_item(const Frame& F, int l, int kind, int item, LAS float* scr) {
    const int lane = F.lane;
    int Kd, nkb; bf16* WT;
    if (kind == 0 || kind == 4) { Kd = 1024; WT = (bf16*)(F.ws + (kind == 0 ? WS_WGU1 : WS_WGU2)); }
    else if (kind == 1 || kind == 5) { Kd = FFP; WT = (bf16*)(F.ws + (kind == 1 ? WS_WD1 : WS_WD2)); }
    else if (kind == 2) { Kd = 1024; WT = (bf16*)(F.ws + WS_WIN); }
    else { Kd = 1024; WT = (bf16*)(F.ws + WS_WOUT); }
    nkb = Kd / 64;
    const int rb = item / nkb, kb = item % nkb, r0 = rb * 32, k0 = kb * 64;
    const int n4 = (lane & 7) * 4, kr = lane >> 3;
    const int rr = r0 + n4;
    const float* src = nullptr; int ns = 0, col = 0, ksrc = 1024; const float* gain = nullptr; float scale = 1.0f;
    if (kind == 0 || kind == 4) {
        const int tile = rr >> 8, w = rr & 255, hid = tile * 128 + (w & 127);
        if (hid < FF) { const float* s1 = (w >> 7) ? F.in[I_F1U] : F.in[I_F1G]; const float* s2 = (w >> 7) ? F.in[I_F2U] : F.in[I_F2G]; src = ((kind == 0) ? s1 : s2) + (size_t)l * 1024 * FF; ns = FF; col = hid; }
        gain = ((kind == 0) ? F.in[I_F1N] : F.in[I_F2N]) + l * 1024;
    } else if (kind == 1 || kind == 5) {
        src = ((kind == 1) ? F.in[I_F1D] : F.in[I_F2D]) + (size_t)l * FF * 1024; ns = 1024; col = rr; ksrc = FF; scale = 0.5f;
    } else if (kind == 2) {
        gain = F.in[I_MIXN] + l * 1024;
        if (rr < 1280) { src = F.in[I_WIN] + (size_t)l * 1024 * NIN; ns = NIN; col = rr; }
        else if (rr < 1296) { if (l > 0) { src = F.in[I_VRW] + (size_t)(l - 1) * 1024 * 16; ns = 16; col = rr - 1280; } }
        else if (rr < PUSED) { src = F.in[I_WIN] + (size_t)l * 1024 * NIN; ns = NIN; col = rr - 16; }
    } else { src = F.in[I_WOUT] + (size_t)l * 1024 * 1024; ns = 1024; col = rr; }
    {
        const bool has = (src != nullptr); const float* sp = has ? src : F.in[I_FN]; const int nss = has ? ns : 0, cols = has ? col : 0;
        f32x4 vals[8];
#pragma unroll
        for (int i = 0; i < 8; ++i) { const int k = k0 + 8 * i + kr; const int kc = k < ksrc ? k : ksrc - 1; vals[i] = *(const GAS f32x4*)(sp + (size_t)kc * nss + cols); }
#pragma unroll
        for (int i = 0; i < 8; ++i) { const int kk = 8 * i + kr, k = k0 + kk; float g = (has && k < ksrc) ? scale : 0.f; if (gain) g *= gain[k < 1024 ? k : 1023];
            LAS float* d = scr + kk * 33 + n4; d[0] = vals[i][0] * g; d[1] = vals[i][1] * g; d[2] = vals[i][2] * g; d[3] = vals[i][3] * g; }
    }
    LDS_WAIT(); asm volatile("" ::: "memory");
    const int c = lane & 7;
#pragma unroll
    for (int j = 0; j < 4; ++j) { const int n = (lane >> 3) + 8 * j; const LAS float* s = scr + (8 * c) * 33 + n;
        v4u o; o.x = pk2(s[0 * 33], s[1 * 33]); o.y = pk2(s[2 * 33], s[3 * 33]); o.z = pk2(s[4 * 33], s[5 * 33]); o.w = pk2(s[6 * 33], s[7 * 33]);
        *(GAS v4u*)(WT + (size_t)(r0 + n) * Kd + k0 + 8 * c) = o; }
    LDS_WAIT(); asm volatile("" ::: "memory");
}
__host__ __device__ constexpr int conv_items(int kind) { return (kind == 0 || kind == 4) ? (NGU / 32) * 16 : (kind == 1 || kind == 5) ? 32 * (FFP / 64) : (kind == 2) ? (PP / 32) * 16 : 32 * 16; }
__device__ __forceinline__ void conv_weights(const Frame& F, int l, int k_lo, int k_hi) {
    LAS float* scr = (LAS float*)(F.lds + F.wave * 16384);
    const int gw = F.vcu * NWAVES + F.wave, NGW = F.G * NWAVES;
    for (int kind = k_lo; kind < k_hi; ++kind) { const int ni = conv_items(kind);
        for (int it = gw; it < ni; it += NGW) conv_item(F, l, kind, it, scr); }
}

__host__ __device__ constexpr int conv_flat_items(bool has_next) { return conv_items(3) + conv_items(4) + conv_items(5) + (has_next ? conv_items(0) + conv_items(1) + conv_items(2) : 0); }
constexpr int CONV_PER_WAVE = 2;
__device__ __forceinline__ void conv_unit(const Frame& F, int l, int u) {
    LAS float* scr = (LAS float*)(F.lds + F.wave * 16384);
    const bool has_next = (l + 1 < DEPTH);
#pragma unroll 1
    for (int rep = 0; rep < CONV_PER_WAVE; ++rep) {
    int it = (u * CONV_PER_WAVE + rep) * NWAVES + F.wave;
    if (it >= conv_flat_items(has_next)) return;
    int layer = l, kind = 3;
    if (it >= conv_items(3)) { it -= conv_items(3); kind = 4;
        if (it >= conv_items(4)) { it -= conv_items(4); kind = 5;
            if (it >= conv_items(5)) { it -= conv_items(5); kind = 0; layer = l + 1;
                if (it >= conv_items(0)) { it -= conv_items(0); kind = 1;
                    if (it >= conv_items(1)) { it -= conv_items(1); kind = 2; } } } } }
    conv_item(F, layer, kind, it, scr);
    }
}
__device__ __forceinline__ void p0_x(const Frame& F) {
    const int gw = F.vcu * NWAVES + F.wave, NGW = F.G * NWAVES;
    const float* x = F.in[I_X]; bf16* xb = (bf16*)(F.ws + WS_XB); float* part = (float*)(F.ws + WS_PART);
    for (int m = gw; m < M; m += NGW) {
        const GAS f32x4* xr = (const GAS f32x4*)(x + (size_t)m * DM) + F.lane; float s = 0.f;
        GAS unsigned long long* o8 = (GAS unsigned long long*)(xb + (size_t)m * DM) + F.lane;
#pragma unroll
        for (int j = 0; j < 4; ++j) { const f32x4 v = xr[64 * j]; s += (v.x * v.x + v.y * v.y) + (v.z * v.z + v.w * v.w);
            o8[64 * j] = (unsigned long long)pk2(v.x, v.y) | ((unsigned long long)pk2(v.z, v.w) << 32); }
        s = wave_sum(s);
        if (F.lane < 16) part[(size_t)m * 16 + F.lane] = (F.lane == 0) ? s : 0.f;
    }
}
__device__ __forceinline__ void p0_table(const Frame& F) {
    float* tab = (float*)(F.ws + WS_TAB);
    for (int i = F.vcu * NTHR + F.tid; i < SEQ * 32; i += F.G * NTHR) { const int t = i >> 5, f = i & 31; const float th = exp2f(-(float)f * (13.287712379549449f / 31.0f)); const float ang = (float)t * th; float s, c; sincosf(ang, &s, &c); tab[2 * i] = c; tab[2 * i + 1] = s; }
}

__device__ __forceinline__ void ret_kv_unit(const Frame& F, int unit) {
    unsigned dga_ = 0;
    DG_START(30, dg30_)
    LAS float* kr = (LAS float*)F.lds; LAS float* vv = kr + 128 * 64;
    const int tid = F.tid, c = unit & 15, h = (unit >> 4) & 3, b = unit >> 6, tok0 = b * SEQ + c * 128;
    const bf16* P = (const bf16*)(F.ws + WS_P); const float* tab = (const float*)(F.ws + WS_TAB);
    const float lg2 = log2f(1.0f - exp2f(-5.0f - (float)h));
    for (int idx = tid; idx < 128 * 32; idx += NTHR) { const int m = idx >> 5, i = idx & 31; const size_t ro = (size_t)(tok0 + m) * PP;
        const float k1 = bf2f(P[ro + PCK + h * 64 + i]), k2 = bf2f(P[ro + PCK + h * 64 + 32 + i]);
        const float cs = tab[((c * 128 + m) * 32 + i) * 2], sn = tab[((c * 128 + m) * 32 + i) * 2 + 1];
        const float sc = 0.125f * exp2f((float)(127 - m) * lg2);
        kr[m * 64 + i] = (k1 * cs - k2 * sn) * sc; kr[m * 64 + 32 + i] = (k1 * sn + k2 * cs) * sc;
        vv[m * 64 + i] = bf2f(P[ro + PCV + h * 64 + i]); vv[m * 64 + 32 + i] = bf2f(P[ro + PCV + h * 64 + 32 + i]); }
    __syncthreads();
    const int d = tid >> 3, e0 = (tid & 7) * 8; float acc[8];
#pragma unroll
    for (int e = 0; e < 8; ++e) acc[e] = 0.f;
    for (int m = 0; m < 128; ++m) { const float kd = kr[m * 64 + d];
#pragma unroll
        for (int e = 0; e < 8; ++e) acc[e] += kd * vv[m * 64 + e0 + e]; }
    float* KV = (float*)(F.ws + WS_KV) + (size_t)unit * 4096 + d * 64 + e0;
#pragma unroll
    for (int e = 0; e < 8; ++e) KV[e] = acc[e];
    __syncthreads();
    DG_STOP(30, dg30_, dga_)
    DG_WRITE(30, unit == 0 && F.wave == 0 && F.lane == 0, dga_)
}

typedef float f32x2 __attribute__((ext_vector_type(2)));
__device__ __forceinline__ float dpp_add16(float x) {
    x += __builtin_bit_cast(float, __builtin_amdgcn_mov_dpp(__builtin_bit_cast(int, x), 0xB1, 0xF, 0xF, true));
    x += __builtin_bit_cast(float, __builtin_amdgcn_mov_dpp(__builtin_bit_cast(int, x), 0x4E, 0xF, 0xF, true));
    x += __builtin_bit_cast(float, __builtin_amdgcn_mov_dpp(__builtin_bit_cast(int, x), 0x141, 0xF, 0xF, true));
    x += __builtin_bit_cast(float, __builtin_amdgcn_mov_dpp(__builtin_bit_cast(int, x), 0x140, 0xF, 0xF, true));
    return x;
}
constexpr int CH = 32;
constexpr int RW_STG = 5 * CH * 64;
constexpr int RW_ROWS = 16;
struct RwOps { f32x4 r, d, k, q, b; float v; };
__device__ __forceinline__ void rw_ld(RwOps& o, const LAS float* base, const LAS float* vb, int s, int ks, int row) {
    const LAS f32x4* p = (const LAS f32x4*)(base + s * 64 + ks * 4);
    o.r = p[0]; o.d = p[CH * 16]; o.k = p[2 * CH * 16]; o.q = p[3 * CH * 16]; o.b = p[4 * CH * 16];
    o.v = vb[s * RW_ROWS + row];
}
#define LO2(x) __builtin_shufflevector(x, x, 0, 1)
#define HI2(x) __builtin_shufflevector(x, x, 2, 3)
__device__ __forceinline__ float rw_step1(f32x2 (&S)[2], const RwOps& o, float v) {
    f32x2 p2 = S[0] * LO2(o.q); p2 = S[1] * HI2(o.q) + p2;
    const float p = dpp_add16(p2.x + p2.y);
    const f32x2 pp = (f32x2){p, p}, vv = (f32x2){v, v};
    S[0] = S[0] - LO2(o.d) * S[0]; S[1] = S[1] - HI2(o.d) * S[1];
    S[0] = S[0] - pp * LO2(o.b); S[1] = S[1] - pp * HI2(o.b);
    S[0] = vv * LO2(o.k) + S[0]; S[1] = vv * HI2(o.k) + S[1];
    f32x2 y2 = S[0] * LO2(o.r); y2 = S[1] * HI2(o.r) + y2;
    return dpp_add16(y2.x + y2.y);
}
__device__ __forceinline__ void rwkv_scan_unit(const Frame& F, int l, int unit) {
    const int tid = F.tid, lane = F.lane, wave = F.wave, quarter = unit & 3, bh = unit >> 2, b = bh / 6, h = bh - b * 6, tokb = b * SEQ;
    LAS float* stg = (LAS float*)F.lds; LAS float* vst = stg + 2 * RW_STG; LAS float* ybuf = vst + 2 * CH * RW_ROWS;
    bf16* P = (bf16*)(F.ws + WS_P);
    constexpr int NCH = SEQ / CH;
    unsigned dga_ = 0;
    if (wave >= 4) {
        const int st = tid - 256;
        const int t01 = st >> 3, c01 = st & 7, tv = st >> 1, cv = st & 1;
        const bf16* a0 = (const bf16*)(F.ws + WS_R); const bf16* a1 = (const bf16*)(F.ws + WS_D); const bf16* a2 = (const bf16*)(F.ws + WS_K2); const bf16* a3 = (const bf16*)(F.ws + WS_KK);
        const bf16* a4 = (const bf16*)(F.ws + WS_BP); const bf16* a5 = (const bf16*)(F.ws + WS_VF);
        v4u sreg[6];
#define RW_LOAD(cc) do { const size_t o_ = (size_t)(tokb + (cc) * CH + t01) * AW + h * 64 + c01 * 8; sreg[0] = *(const GAS v4u*)(a0 + o_); sreg[1] = *(const GAS v4u*)(a1 + o_); sreg[2] = *(const GAS v4u*)(a2 + o_); \
            sreg[3] = *(const GAS v4u*)(a3 + o_); sreg[4] = *(const GAS v4u*)(a4 + o_); if (st < 64) sreg[5] = *(const GAS v4u*)(a5 + (size_t)(tokb + (cc) * CH + tv) * AW + h * 64 + quarter * RW_ROWS + cv * 8); } while (0)
#define RW_ST1(i, dstp) do { float f[8]; unpack8(sreg[i], f); LAS f32x4* dst = (LAS f32x4*)(dstp); dst[0] = (f32x4){f[0], f[1], f[2], f[3]}; dst[1] = (f32x4){f[4], f[5], f[6], f[7]}; } while (0)
#define RW_STORE(bufi) do { _Pragma("unroll") for (int i = 0; i < 5; ++i) RW_ST1(i, stg + (bufi) * RW_STG + i * CH * 64 + t01 * 64 + c01 * 8); if (st < 64) RW_ST1(5, vst + (bufi) * CH * RW_ROWS + tv * RW_ROWS + cv * 8); } while (0)
#define RW_OUT(cc) do { if (st < 128) { const LAS float* yb_ = ybuf + ((cc) & 1) * CH * RW_ROWS; const int s_ = st >> 2, r4_ = (st & 3) * 4; const f32x4 yv = *(const LAS f32x4*)(yb_ + s_ * RW_ROWS + r4_); \
            *(GAS unsigned long long*)(P + (size_t)(tokb + (cc) * CH + s_) * PP + h * 64 + quarter * RW_ROWS + r4_) = (unsigned long long)pk2(yv[0], yv[1]) | ((unsigned long long)pk2(yv[2], yv[3]) << 32); } } while (0)
        RW_LOAD(0); RW_STORE(0); RW_LOAD(1);
        __syncthreads();
        for (int cc = 0; cc < NCH; ++cc) {
            if (cc + 1 < NCH) RW_STORE((cc + 1) & 1);
            if (cc + 2 < NCH) RW_LOAD(cc + 2);
            if (cc > 0) RW_OUT(cc - 1);
            asm volatile("s_waitcnt lgkmcnt(0)" ::: "memory"); __builtin_amdgcn_s_barrier(); asm volatile("" ::: "memory");
        }
        RW_OUT(NCH - 1);
#undef RW_LOAD
#undef RW_ST1
#undef RW_STORE
#undef RW_OUT
        return;
    }
    const int row = 4 * wave + (lane >> 4), ks = lane & 15;
    f32x2 Sa[2] = {(f32x2){0.f, 0.f}, (f32x2){0.f, 0.f}};
    __syncthreads();
    for (int cc = 0; cc < NCH; ++cc) {
        const int bufi = cc & 1;
        const LAS float* base = stg + bufi * RW_STG; const LAS float* vb = vst + bufi * CH * RW_ROWS; LAS float* yb = ybuf + bufi * CH * RW_ROWS;
        RwOps A, B; float yk0 = 0.f;
        DG_START(40, dg40_)
        rw_ld(A, base, vb, 0, ks, row);
#pragma unroll
        for (int s = 0; s < CH; s += 2) {
            rw_ld(B, base, vb, s + 1, ks, row);
            { const float y0 = rw_step1(Sa, A, A.v); yk0 = (ks == (s & 15)) ? y0 : yk0; }
            if (s + 2 < CH) rw_ld(A, base, vb, s + 2, ks, row);
            { const float y0 = rw_step1(Sa, B, B.v); yk0 = (ks == ((s + 1) & 15)) ? y0 : yk0; }
            if (((s + 1) & 15) == 15) yb[(s - 14 + ks) * RW_ROWS + row] = yk0;
        }
        DG_STOP(40, dg40_, dga_)
        DG_START(43, dg43_)
        asm volatile("s_waitcnt lgkmcnt(0)" ::: "memory"); __builtin_amdgcn_s_barrier(); asm volatile("" ::: "memory");
        DG_STOP(43, dg43_, dga_)
    }
    DG_WRITE(40, unit == 0 && l == 0 && wave == 0 && lane == 0, dga_)
    DG_WRITE(43, unit == 0 && l == 0 && wave == 0 && lane == 0, dga_)
}
__device__ __forceinline__ void rwkv_post(const Frame& F, int l) {
    bf16* P = (bf16*)(F.ws + WS_P); const bf16* VF = (const bf16*)(F.ws + WS_VF); const bf16* Gg = (const bf16*)(F.ws + WS_G); const float* BON = (const float*)(F.ws + WS_BON);
    const int sub = F.tid >> 4, c4 = (F.tid & 15) * 4;
    for (int pr = F.vcu * 32 + sub; pr < M * 6; pr += F.G * 32) { const int tok = pr / 6, h = pr - tok * 6;
        const unsigned long long yw = *(const GAS unsigned long long*)(P + (size_t)tok * PP + h * 64 + c4), vw = *(const GAS unsigned long long*)(VF + (size_t)tok * AW + h * 64 + c4), gw = *(const GAS unsigned long long*)(Gg + (size_t)tok * AW + h * 64 + c4);
        const f32x4 lnw = *(const f32x4*)(F.in[I_LNW] + l * AW + h * 64 + c4), lnb = *(const f32x4*)(F.in[I_LNB] + l * AW + h * 64 + c4);
        const float bon = BON[(size_t)tok * 6 + h];
        const f32x4 yv = (f32x4){bflo((unsigned)yw), bfhi((unsigned)yw), bflo((unsigned)(yw >> 32)), bfhi((unsigned)(yw >> 32))};
        const f32x4 vv = (f32x4){bflo((unsigned)vw), bfhi((unsigned)vw), bflo((unsigned)(vw >> 32)), bfhi((unsigned)(vw >> 32))};
        const f32x4 gg = (f32x4){bflo((unsigned)gw), bfhi((unsigned)gw), bflo((unsigned)(gw >> 32)), bfhi((unsigned)(gw >> 32))};
        float sm = (yv[0] + yv[1]) + (yv[2] + yv[3]);
        sm += __shfl_xor(sm, 1); sm += __shfl_xor(sm, 2); sm += __shfl_xor(sm, 4); sm += __shfl_xor(sm, 8);
        const float mean = sm * (1.0f / 64.0f); const f32x4 dv = yv - mean;
        float vs = (dv[0] * dv[0] + dv[1] * dv[1]) + (dv[2] * dv[2] + dv[3] * dv[3]);
        vs += __shfl_xor(vs, 1); vs += __shfl_xor(vs, 2); vs += __shfl_xor(vs, 4); vs += __shfl_xor(vs, 8);
        const float rs = 1.0f / sqrtf(vs * (1.0f / 64.0f) + 64e-5f);
        const f32x4 o = (dv * rs * lnw + lnb + bon * vv) * gg;
        *(GAS unsigned long long*)(P + (size_t)tok * PP + h * 64 + c4) = (unsigned long long)pk2(o[0], o[1]) | ((unsigned long long)pk2(o[2], o[3]) << 32);
    }
}

typedef short bf16x8_t __attribute__((ext_vector_type(8)));
typedef short s16x4_t __attribute__((ext_vector_type(4)));
typedef float f32x16_t __attribute__((ext_vector_type(16)));
__device__ __forceinline__ unsigned fkey(float f) { const unsigned u = __float_as_uint(f); return (u & 0x80000000u) ? ~u : (u | 0x80000000u); }
__device__ __forceinline__ int crow32(int r, int hi) { return (r & 3) + 8 * (r >> 2) + 4 * hi; }
__device__ __forceinline__ unsigned off_a(unsigned row, unsigned ch) { return 2048u * (row >> 3) + 512u * (ch >> 2) + 64u * (row & 7) + 16u * ((ch & 3) ^ ((row >> 2) & 3)); }

__device__ __forceinline__ void idx_scores(const bf16x8_t (&Af)[2], const bf16x8_t (&Bf)[8][2], const float (&iwf)[8], float (&sc)[4]) {
    sc[0] = sc[1] = sc[2] = sc[3] = 0.f;
#pragma unroll
    for (int h = 0; h < 8; ++h) { f32x4 a = (f32x4){0.f, 0.f, 0.f, 0.f};
        a = __builtin_amdgcn_mfma_f32_16x16x32_bf16(Af[0], Bf[h][0], a, 0, 0, 0);
        a = __builtin_amdgcn_mfma_f32_16x16x32_bf16(Af[1], Bf[h][1], a, 0, 0, 0);
#pragma unroll
        for (int r = 0; r < 4; ++r) { const float av_ = a[r]; const int ai_ = __float_as_int(av_); const float rl = __int_as_float(ai_ > 0 ? ai_ : 0); sc[r] = fmaf(iwf[h], rl, sc[r]); } }
}
__device__ __forceinline__ void idx_load_q(const bf16* P, int tokq, bf16x8_t (&Bf)[8][2], float (&iwf)[8], int fq) {
    const bf16* row = P + (size_t)tokq * PP;
#pragma unroll
    for (int h = 0; h < 8; ++h)
#pragma unroll
        for (int ks = 0; ks < 2; ++ks) Bf[h][ks] = *(const GAS bf16x8_t*)(row + PBIQ + h * 64 + ks * 32 + fq * 8);
    const v4u w = *(const GAS v4u*)(row + PBIW); float f[8]; unpack8(w, f);
#pragma unroll
    for (int h = 0; h < 8; ++h) iwf[h] = f[h] * (0.35355339059327373f * 0.125f);
}

__device__ __forceinline__ void lds_barrier() { asm volatile("s_waitcnt lgkmcnt(0)" ::: "memory"); __builtin_amdgcn_s_barrier(); asm volatile("" ::: "memory"); }
constexpr int SKP = 2052;
__device__ __forceinline__ void dsa_thr_unit(const Frame& F, int unit) {
    LAS unsigned* sk = (LAS unsigned*)F.lds;
    const int lane = F.lane, wave = F.wave, fr = lane & 15, fq = lane >> 4;
    const int b = unit & 7, qb = 127 - (unit >> 3), t0 = qb * 16, tok0 = b * SEQ + t0;
    const bf16* P = (const bf16*)(F.ws + WS_P);
    unsigned dga_ = 0;
    DG_START(10, dg10_)
    {
        bf16x8_t Bf[8][2]; float iwf[8];
        idx_load_q(P, tok0 + fr, Bf, iwf, fq);
        bf16x8_t An[2];
        { const int kt0 = wave <= qb ? wave : qb; const bf16* krow = P + (size_t)(b * SEQ + kt0 * 16 + fr) * PP + PBIK + fq * 8; An[0] = *(const GAS bf16x8_t*)(krow); An[1] = *(const GAS bf16x8_t*)(krow + 32); }
        for (int kt = wave; kt <= qb; kt += 8) {
            bf16x8_t Af[2]; Af[0] = An[0]; Af[1] = An[1];
            { const int ktn = kt + 8 <= qb ? kt + 8 : qb; const bf16* krow = P + (size_t)(b * SEQ + ktn * 16 + fr) * PP + PBIK + fq * 8; An[0] = *(const GAS bf16x8_t*)(krow); An[1] = *(const GAS bf16x8_t*)(krow + 32); }
            float sc[4]; idx_scores(Af, Bf, iwf, sc);
            v4u kv;
            const int s0 = kt * 16 + 4 * fq, t = t0 + fr;
            kv.x = (s0 + 0 <= t) ? fkey(sc[0]) : 0u; kv.y = (s0 + 1 <= t) ? fkey(sc[1]) : 0u; kv.z = (s0 + 2 <= t) ? fkey(sc[2]) : 0u; kv.w = (s0 + 3 <= t) ? fkey(sc[3]) : 0u;
            *(LAS v4u*)(sk + fr * SKP + s0) = kv;
        }
    }
    __syncthreads();
    DG_STOP(10, dg10_, dga_)
    DG_WRITE(10, unit == 0 && wave == 0 && lane == 0, dga_)
    DG_START(11, dg11_)
    unsigned* THR = (unsigned*)(F.ws + WS_THR); int* SCUT = (int*)(F.ws + WS_SCUT);
    for (int qi = 0; qi < 2; ++qi) { const int q = 2 * wave + qi, t = t0 + q, n = t + 1;
        unsigned thr = 0u; int scut = SEQ - 1;
        if (n > TOPK) {
            unsigned keys[32];
#pragma unroll
            for (int i = 0; i < 32; ++i) keys[i] = (64 * i + lane <= t) ? sk[q * SKP + 64 * i + lane] : 0u;
            unsigned prefix = 0u; bool done = false;
            const int ng = (t >> 9) + 1;
            for (int bit = 31; bit >= 0; --bit) { const unsigned cand = prefix | (1u << bit); int cnt = 0;
#pragma unroll
                for (int g = 0; g < 4; ++g) if (g < ng) {
#pragma unroll
                    for (int i = 8 * g; i < 8 * g + 8; ++i) cnt += __popcll(__ballot(keys[i] >= cand)); }
                if (cnt >= TOPK) prefix = cand;
                if (cnt == TOPK) { thr = cand - 1u; scut = -1; done = true; break; } }
            if (!done) {
                int cgt = 0;
#pragma unroll
                for (int i = 0; i < 32; ++i) cgt += __popcll(__ballot(keys[i] > prefix));
                int need = TOPK - cgt, run = 0; thr = prefix; scut = SEQ - 1; bool found = false;
#pragma unroll
                for (int i = 0; i < 32; ++i) { unsigned long long mk = __ballot(keys[i] == prefix); const int c = __popcll(mk);
                    if (!found && run + c >= need) { int k = need - run; while (k > 1) { mk &= mk - 1ull; --k; } scut = 64 * i + (int)__builtin_ctzll(mk); found = true; }
                    run += c; }
            }
        }
        {
            unsigned* MK = (unsigned*)(F.ws + WS_MASK) + (size_t)(tok0 + q) * 64;
            if (n > TOPK) {
#pragma unroll
                for (int i = 0; i < 32; ++i) { const int s = 64 * i + lane; const unsigned key = (s <= t) ? sk[q * SKP + s] : 0u;
                    const unsigned long long bal = __ballot((s <= t) & ((key > thr) | ((key == thr) & (s <= scut))));
                    if (lane < 2 && 64 * i <= t) MK[2 * i + lane] = lane ? (unsigned)(bal >> 32) : (unsigned)bal; }
            } else {
                if (lane < 8) { const int w0 = lane; MK[w0] = (32 * w0 + 31 <= t) ? 0xffffffffu : ((32 * w0 <= t) ? ((1u << ((t & 31) + 1)) - 1u) : 0u); }
            }
        }
    }
    DG_STOP(11, dg11_, dga_)
    DG_WRITE(11, unit == 0 && wave == 0 && lane == 0, dga_)
    __syncthreads();
}

constexpr int QLP = 136;
constexpr int MKP = 36;
constexpr int DA_MASK = 0, DA_QL = 2 * 32 * MKP * 4, DA_CT = DA_QL + 6 * 32 * QLP * 2;
__device__ __forceinline__ void dsa_attn_unit(const Frame& F, int l, int unit) {
    const int tid = F.tid, lane = F.lane, wave = F.wave, r32 = lane & 31, hi = lane >> 5;
    const int b = unit & 7, qb = 63 - (unit >> 3), t0 = qb * 32, tok0 = b * SEQ + t0, ntile = qb + 1;
    bf16* P = (bf16*)(F.ws + WS_P); const bf16* C = (const bf16*)(F.ws + WS_C);
    LAS float* MASK = (LAS float*)(F.lds + DA_MASK); LAS unsigned char* QLb = F.lds + DA_QL; LAS unsigned char* CT = F.lds + DA_CT;
    const int crow_ = tid >> 4, cch = tid & 15; const unsigned cdst = off_a((unsigned)crow_, (unsigned)cch);
    const bf16* csrc = C + (size_t)(b * SEQ + crow_) * 128 + cch * 8;
    v4u cpre = *(const GAS v4u*)(csrc);
    if (wave >= 6) {
        const int fr = lane & 15, fq = lane >> 4, qh = wave - 6;
        const int tq = tok0 + 16 * qh + fr, tq_t = t0 + 16 * qh + fr, jmax = tq_t >> 5;
        const unsigned* MK = (const unsigned*)(F.ws + WS_MASK) + (size_t)tq * 64;
        LAS float* mrow = MASK + (16 * qh + fr) * MKP + 8 * fq;
#define DA_EXPAND(word, slot) do { const unsigned w_ = (word) >> (8 * fq); f32x4 m0_, m1_; \
            m0_[0] = (w_ & 1u) ? 0.f : -1e30f; m0_[1] = (w_ & 2u) ? 0.f : -1e30f; m0_[2] = (w_ & 4u) ? 0.f : -1e30f; m0_[3] = (w_ & 8u) ? 0.f : -1e30f; \
            m1_[0] = (w_ & 16u) ? 0.f : -1e30f; m1_[1] = (w_ & 32u) ? 0.f : -1e30f; m1_[2] = (w_ & 64u) ? 0.f : -1e30f; m1_[3] = (w_ & 128u) ? 0.f : -1e30f; \
            *(LAS f32x4*)(mrow + (slot) * (32 * MKP)) = m0_; *(LAS f32x4*)(mrow + (slot) * (32 * MKP) + 4) = m1_; } while (0)
        unsigned w0 = MK[0], w1 = (1 <= jmax) ? MK[1] : 0u, w2 = (2 <= jmax) ? MK[2] : 0u;
        DA_EXPAND(w0, 0);
        *(LAS v4u*)(CT + cdst) = cpre;
        lds_barrier();
        for (int j = 0; j < ntile; ++j) {
            if (j + 1 < ntile) {
                cpre = *(const GAS v4u*)(csrc + (size_t)(j + 1) * 32 * 128);
                DA_EXPAND(w1, (j + 1) & 1);
                w1 = w2; w2 = (j + 3 <= jmax) ? MK[j + 3] : 0u;
                *(LAS v4u*)(CT + ((j + 1) & 1) * 8192 + cdst) = cpre; }
            lds_barrier();
        }
#undef DA_EXPAND
        lds_barrier();
        return;
    }
    const int h = wave;
    LAS unsigned char* QLh = QLb + h * (32 * QLP * 2);
    float negb;
    {
        unsigned zo_ = 0u; asm volatile("" : "+v"(zo_));
        const bf16* wukT = (const bf16*)(F.ws + WS_WUKT) + (size_t)(l * 6 + h) * 128 * 64 + zo_;
        bf16x8_t qf[4]; float ssq = 0.f;
#pragma unroll
        for (int ks = 0; ks < 4; ++ks) qf[ks] = *(const GAS bf16x8_t*)(P + (size_t)(tok0 + r32) * PP + PBQ + h * 64 + ks * 16 + hi * 8);
#pragma unroll
        for (int blk = 0; blk < 4; ++blk) { f32x16_t x;
#pragma unroll
            for (int i = 0; i < 16; ++i) x[i] = 0.f;
#pragma unroll
            for (int ks = 0; ks < 4; ++ks) { const bf16x8_t a = *(const GAS bf16x8_t*)(wukT + (size_t)(blk * 32 + r32) * 64 + ks * 16 + hi * 8); x = __builtin_amdgcn_mfma_f32_32x32x16_bf16(a, qf[ks], x, 0, 0, 0); }
#pragma unroll
            for (int g = 0; g < 4; ++g) { const float sc = 0.125f * 1.4426950408889634f;
                const float x0 = x[4 * g] * sc, x1 = x[4 * g + 1] * sc, x2 = x[4 * g + 2] * sc, x3 = x[4 * g + 3] * sc; ssq += (x0 * x0 + x1 * x1) + (x2 * x2 + x3 * x3);
                const unsigned long long w = (unsigned long long)pk2(x0, x1) | ((unsigned long long)pk2(x2, x3) << 32);
                *(LAS unsigned long long*)(QLh + (r32 * QLP + blk * 32 + 8 * g + 4 * hi) * 2) = w; } }
        ssq += __shfl_xor(ssq, 32);
        const float* kvn = F.in[I_KVN] + l * 128; float gm = fmaxf(fabsf(kvn[2 * lane]), fabsf(kvn[2 * lane + 1]));
#pragma unroll
        for (int o_ = 1; o_ < 64; o_ <<= 1) gm = fmaxf(gm, __shfl_xor(gm, o_));
        negb = -(sqrtf(ssq) * 11.32f * gm * 1.01f + 0.01f);
    }
    *(LAS v4u*)(CT + cdst) = cpre;
    lds_barrier();
    f32x16_t o[4]; float l_run = 0.f;
    const LAS unsigned char* qlrow = QLh + (r32 * QLP + 8 * hi) * 2;
#pragma unroll
    for (int c = 0; c < 4; ++c)
#pragma unroll
        for (int i = 0; i < 16; ++i) o[c][i] = 0.f;
    const unsigned rr_ = ((unsigned)r32 >> 2) & 3u, rb_ = 2048u * ((unsigned)r32 >> 3) + 64u * ((unsigned)r32 & 7u);
    const unsigned rbase0 = rb_ + 16u * ((unsigned)hi ^ rr_), rbase1 = rb_ + 16u * ((2u + (unsigned)hi) ^ rr_);
    const unsigned blk_ = (lane >> 4) & 1, q_ = (lane & 15) >> 2, p_ = lane & 3;
    unsigned dga_ = 0;
    for (int j = 0; j < ntile; ++j) {
        DG_START(0, dgt_)
        LAS unsigned char* kb = CT + (j & 1) * 8192;
        if (j + 1 < ntile) cpre = *(const GAS v4u*)(csrc + (size_t)(j + 1) * 32 * 128);
        {
            f32x16_t S;
#pragma unroll
            for (int i = 0; i < 16; ++i) S[i] = negb;
#pragma unroll
            for (int s = 0; s < 8; ++s) { const bf16x8_t a = *(const LAS bf16x8_t*)(kb + ((s & 1) ? rbase1 : rbase0) + 512 * (s >> 1)); const bf16x8_t bq = *(const LAS bf16x8_t*)(qlrow + 32 * s);
                S = __builtin_amdgcn_mfma_f32_32x32x16_bf16(a, bq, S, 0, 0, 0); }
            const LAS f32x4* mk = (const LAS f32x4*)(MASK + (j & 1) * (32 * MKP) + r32 * MKP + 4 * hi);
            float psum = 0.f; float e[16];
#pragma unroll
            for (int g = 0; g < 4; ++g) { const f32x4 mv = mk[2 * g];
#pragma unroll
                for (int e4 = 0; e4 < 4; ++e4) { e[4 * g + e4] = __builtin_amdgcn_exp2f(S[4 * g + e4] + mv[e4]); psum += e[4 * g + e4]; } }
            l_run += psum;
            bf16x8_t xs[2];
#pragma unroll
            for (int s = 0; s < 2; ++s) { v4u w; w.x = pk2(e[8 * s], e[8 * s + 1]); w.y = pk2(e[8 * s + 2], e[8 * s + 3]); w.z = pk2(e[8 * s + 4], e[8 * s + 5]); w.w = pk2(e[8 * s + 6], e[8 * s + 7]); xs[s] = __builtin_bit_cast(bf16x8_t, w); }
#pragma unroll
            for (int c = 0; c < 4; ++c)
#pragma unroll
                for (int s = 0; s < 2; ++s) {
                    const unsigned a0 = off_a((unsigned)(16 * s + 4 * hi + q_), (unsigned)(4 * c + 2 * blk_ + (p_ >> 1))) + 8u * (p_ & 1);
                    const unsigned a1 = off_a((unsigned)(16 * s + 8 + 4 * hi + q_), (unsigned)(4 * c + 2 * blk_ + (p_ >> 1))) + 8u * (p_ & 1);
                    const s16x4_t lo = __builtin_bit_cast(s16x4_t, __builtin_amdgcn_ds_read_tr16_b64_v4i16((LAS s16x4_t*)(kb + a0)));
                    const s16x4_t hh = __builtin_bit_cast(s16x4_t, __builtin_amdgcn_ds_read_tr16_b64_v4i16((LAS s16x4_t*)(kb + a1)));
                    const bf16x8_t a = (bf16x8_t){lo[0], lo[1], lo[2], lo[3], hh[0], hh[1], hh[2], hh[3]};
                    o[c] = __builtin_amdgcn_mfma_f32_32x32x16_bf16(a, xs[s], o[c], 0, 0, 0); }
        }
        if (j + 1 < ntile) *(LAS v4u*)(CT + ((j + 1) & 1) * 8192 + cdst) = cpre;
        DG_STOP(0, dgt_, dga_)
        lds_barrier();
    }
    DG_WRITE(0, unit == 0 && l == 0 && wave == 0 && lane == 0, dga_)
    {
        const float lt = l_run + __shfl_xor(l_run, 32); const float inv = 1.0f / lt;
#pragma unroll
        for (int c = 0; c < 4; ++c)
#pragma unroll
            for (int g = 0; g < 4; ++g) { const unsigned long long w = (unsigned long long)pk2(o[c][4 * g] * inv, o[c][4 * g + 1] * inv) | ((unsigned long long)pk2(o[c][4 * g + 2] * inv, o[c][4 * g + 3] * inv) << 32);
                *(LAS unsigned long long*)(QLh + (r32 * QLP + c * 32 + 8 * g + 4 * hi) * 2) = w; }
        unsigned zo2_ = 0u; asm volatile("" : "+v"(zo2_));
        const bf16* wuvT = (const bf16*)(F.ws + WS_WUVT) + (size_t)(l * 6 + h) * 64 * 128 + zo2_;
        bf16x8_t Bo[8];
#pragma unroll
        for (int s = 0; s < 8; ++s) Bo[s] = *(const LAS bf16x8_t*)(QLh + (r32 * QLP + 16 * s + 8 * hi) * 2);
#pragma unroll
        for (int mb = 0; mb < 2; ++mb) { f32x16_t y;
#pragma unroll
            for (int i = 0; i < 16; ++i) y[i] = 0.f;
#pragma unroll
            for (int s = 0; s < 8; ++s) { const bf16x8_t a = *(const GAS bf16x8_t*)(wuvT + (size_t)(mb * 32 + r32) * 128 + 16 * s + 8 * hi); y = __builtin_amdgcn_mfma_f32_32x32x16_bf16(a, Bo[s], y, 0, 0, 0); }
#pragma unroll
            for (int g = 0; g < 4; ++g) { const unsigned long long w = (unsigned long long)pk2(y[4 * g], y[4 * g + 1]) | ((unsigned long long)pk2(y[4 * g + 2], y[4 * g + 3]) << 32);
                *(GAS unsigned long long*)(P + (size_t)(tok0 + r32) * PP + 384 + h * 64 + mb * 32 + 8 * g + 4 * hi) = w; } }
    }
    lds_barrier();
}

constexpr int RP = 72;
constexpr int RT_QR = 0, RT_KR = 128 * RP * 2, RT_VV = 2 * 128 * RP * 2, RT_ST = 3 * 128 * RP * 2, RT_SS = RT_ST + 64 * RP * 2, RT_KD = RT_SS + 1024;
__device__ __forceinline__ void ret_out_unit(const Frame& F, int unit) {
    const int tid = F.tid, lane = F.lane, wave = F.wave, r32 = lane & 31, hi = lane >> 5;
    const int h = unit & 3, b = unit >> 2;
    bf16* P = (bf16*)(F.ws + WS_P); const float* tab = (const float*)(F.ws + WS_TAB);
    LAS bf16* QR = (LAS bf16*)(F.lds + RT_QR); LAS bf16* KR = (LAS bf16*)(F.lds + RT_KR); LAS bf16* VV = (LAS bf16*)(F.lds + RT_VV); LAS bf16* ST = (LAS bf16*)(F.lds + RT_ST);
    LAS float* SS = (LAS float*)(F.lds + RT_SS); LAS bf16* KD = (LAS bf16*)(F.lds + RT_KD);
    const float lg2 = log2f(1.0f - exp2f(-5.0f - (float)h));
    f32x16_t st;
#pragma unroll
    for (int i = 0; i < 16; ++i) st[i] = 0.f;
    const float cdec = exp2f(128.0f * lg2);
    unsigned long long pre[2][6]; f32x4 pret[2][2];
#define RT_LOAD(cn) do { _Pragma("unroll") for (int it_ = 0; it_ < 2; ++it_) { const int idx_ = tid + it_ * NTHR, m_ = idx_ >> 3, i4_ = (idx_ & 7) * 4; const size_t ro_ = (size_t)(b * SEQ + (cn) * 128 + m_) * PP + h * 64 + i4_; \
        pre[it_][0] = *(const GAS unsigned long long*)(P + ro_ + PCQ); pre[it_][1] = *(const GAS unsigned long long*)(P + ro_ + PCQ + 32); pre[it_][2] = *(const GAS unsigned long long*)(P + ro_ + PCK); \
        pre[it_][3] = *(const GAS unsigned long long*)(P + ro_ + PCK + 32); pre[it_][4] = *(const GAS unsigned long long*)(P + ro_ + PCV); pre[it_][5] = *(const GAS unsigned long long*)(P + ro_ + PCV + 32); \
        pret[it_][0] = *(const GAS f32x4*)(tab + ((size_t)((cn) * 128 + m_) * 32 + i4_) * 2); pret[it_][1] = *(const GAS f32x4*)(tab + ((size_t)((cn) * 128 + m_) * 32 + i4_) * 2 + 4); } } while (0)
    unsigned dga_ = 0;
    DG_START(60, dg60_)
    RT_LOAD(0);
    for (int c = 0; c < 16; ++c) {
    const int tok0 = b * SEQ + c * 128;
#pragma unroll
    for (int it = 0; it < 2; ++it) { const int idx = tid + it * NTHR, m = idx >> 3, i4 = (idx & 7) * 4;
        const unsigned long long q1w = pre[it][0], q2w = pre[it][1], k1w = pre[it][2], k2w = pre[it][3], v1w = pre[it][4], v2w = pre[it][5];
        const f32x4 t0 = pret[it][0], t1 = pret[it][1];
        const float cs[4] = {t0[0], t0[2], t1[0], t1[2]}, sn[4] = {t0[1], t0[3], t1[1], t1[3]};
        const float q1[4] = {bflo((unsigned)q1w), bfhi((unsigned)q1w), bflo((unsigned)(q1w >> 32)), bfhi((unsigned)(q1w >> 32))}, q2[4] = {bflo((unsigned)q2w), bfhi((unsigned)q2w), bflo((unsigned)(q2w >> 32)), bfhi((unsigned)(q2w >> 32))};
        const float k1[4] = {bflo((unsigned)k1w), bfhi((unsigned)k1w), bflo((unsigned)(k1w >> 32)), bfhi((unsigned)(k1w >> 32))}, k2[4] = {bflo((unsigned)k2w), bfhi((unsigned)k2w), bflo((unsigned)(k2w >> 32)), bfhi((unsigned)(k2w >> 32))};
        float qa[4], qb[4], ka[4], kb[4];
#pragma unroll
        for (int j = 0; j < 4; ++j) { qa[j] = q1[j] * cs[j] - q2[j] * sn[j]; qb[j] = q1[j] * sn[j] + q2[j] * cs[j]; ka[j] = (k1[j] * cs[j] - k2[j] * sn[j]) * 0.125f; kb[j] = (k1[j] * sn[j] + k2[j] * cs[j]) * 0.125f; }
        *(LAS unsigned long long*)(QR + m * RP + i4) = (unsigned long long)pk2(qa[0], qa[1]) | ((unsigned long long)pk2(qa[2], qa[3]) << 32);
        *(LAS unsigned long long*)(QR + m * RP + 32 + i4) = (unsigned long long)pk2(qb[0], qb[1]) | ((unsigned long long)pk2(qb[2], qb[3]) << 32);
        *(LAS unsigned long long*)(KR + m * RP + i4) = (unsigned long long)pk2(ka[0], ka[1]) | ((unsigned long long)pk2(ka[2], ka[3]) << 32);
        *(LAS unsigned long long*)(KR + m * RP + 32 + i4) = (unsigned long long)pk2(kb[0], kb[1]) | ((unsigned long long)pk2(kb[2], kb[3]) << 32);
        { const float kd = exp2f((float)(127 - m) * lg2);
          *(LAS unsigned long long*)(KD + m * RP + i4) = (unsigned long long)pk2(ka[0] * kd, ka[1] * kd) | ((unsigned long long)pk2(ka[2] * kd, ka[3] * kd) << 32);
          *(LAS unsigned long long*)(KD + m * RP + 32 + i4) = (unsigned long long)pk2(kb[0] * kd, kb[1] * kd) | ((unsigned long long)pk2(kb[2] * kd, kb[3] * kd) << 32); }
        *(LAS unsigned long long*)(VV + m * RP + i4) = v1w; *(LAS unsigned long long*)(VV + m * RP + 32 + i4) = v2w; }
    if (c + 1 < 16) RT_LOAD(c + 1);
    if (wave < 4) {
        const int db = wave >> 1, ebs = wave & 1;
#pragma unroll
        for (int i = 0; i < 16; ++i) ST[(32 * db + crow32(i, hi)) * RP + 32 * ebs + r32] = (bf16)(pk2(st[i], 0.f) & 0xffffu);
    }
    lds_barrier();
    const int nb = wave >> 1, eb = wave & 1, n = nb * 32 + r32;
    const unsigned blk_ = (lane >> 4) & 1, q_ = (lane & 15) >> 2, p_ = lane & 3;
    bf16x8_t qf[4];
#pragma unroll
    for (int ks = 0; ks < 4; ++ks) qf[ks] = *(const LAS bf16x8_t*)(QR + n * RP + ks * 16 + hi * 8);
    f32x16_t y;
#pragma unroll
    for (int i = 0; i < 16; ++i) y[i] = 0.f;
#pragma unroll
    for (int ks = 0; ks < 4; ++ks) {
        const s16x4_t lo = __builtin_bit_cast(s16x4_t, __builtin_amdgcn_ds_read_tr16_b64_v4i16((LAS s16x4_t*)(ST + (16 * ks + 8 * hi + q_) * RP + 32 * eb + 16 * blk_ + 4 * p_)));
        const s16x4_t hh = __builtin_bit_cast(s16x4_t, __builtin_amdgcn_ds_read_tr16_b64_v4i16((LAS s16x4_t*)(ST + (16 * ks + 8 * hi + 4 + q_) * RP + 32 * eb + 16 * blk_ + 4 * p_)));
        const bf16x8_t a = (bf16x8_t){lo[0], lo[1], lo[2], lo[3], hh[0], hh[1], hh[2], hh[3]};
        y = __builtin_amdgcn_mfma_f32_32x32x16_bf16(a, qf[ks], y, 0, 0, 0); }
    { const float qd = exp2f((float)(n + 1) * lg2);
#pragma unroll
      for (int i = 0; i < 16; ++i) y[i] *= qd; }
    unsigned long long gpre[4];
#pragma unroll
    for (int g = 0; g < 4; ++g) gpre[g] = *(const GAS unsigned long long*)(P + (size_t)(tok0 + n) * PP + PCG + h * 64 + 32 * eb + 8 * g + 4 * hi);
    for (int mt = 0; mt <= nb; ++mt) {
        f32x16_t S;
#pragma unroll
        for (int i = 0; i < 16; ++i) S[i] = 0.f;
#pragma unroll
        for (int ks = 0; ks < 4; ++ks) { const bf16x8_t a = *(const LAS bf16x8_t*)(KR + (mt * 32 + r32) * RP + ks * 16 + hi * 8); S = __builtin_amdgcn_mfma_f32_32x32x16_bf16(a, qf[ks], S, 0, 0, 0); }
        float e[16];
#pragma unroll
        for (int r = 0; r < 16; ++r) { const int dm = r32 - crow32(r, hi) + 32 * (nb - mt); e[r] = (dm >= 0) ? S[r] * exp2f((float)dm * lg2) : 0.f; }
#pragma unroll
        for (int s = 0; s < 2; ++s) { v4u w; w.x = pk2(e[8 * s], e[8 * s + 1]); w.y = pk2(e[8 * s + 2], e[8 * s + 3]); w.z = pk2(e[8 * s + 4], e[8 * s + 5]); w.w = pk2(e[8 * s + 6], e[8 * s + 7]);
            const bf16x8_t xs = __builtin_bit_cast(bf16x8_t, w);
            const s16x4_t lo = __builtin_bit_cast(s16x4_t, __builtin_amdgcn_ds_read_tr16_b64_v4i16((LAS s16x4_t*)(VV + (mt * 32 + 16 * s + 4 * hi + q_) * RP + 32 * eb + 16 * blk_ + 4 * p_)));
            const s16x4_t hh = __builtin_bit_cast(s16x4_t, __builtin_amdgcn_ds_read_tr16_b64_v4i16((LAS s16x4_t*)(VV + (mt * 32 + 16 * s + 8 + 4 * hi + q_) * RP + 32 * eb + 16 * blk_ + 4 * p_)));
            const bf16x8_t a = (bf16x8_t){lo[0], lo[1], lo[2], lo[3], hh[0], hh[1], hh[2], hh[3]};
            y = __builtin_amdgcn_mfma_f32_32x32x16_bf16(a, xs, y, 0, 0, 0); }
    }
    float ss = 0.f;
#pragma unroll
    for (int i = 0; i < 16; ++i) ss += y[i] * y[i];
    ss += __shfl_xor(ss, 32);
    if (hi == 0) SS[(nb * 2 + eb) * 32 + r32] = ss;
    lds_barrier();
    ss += SS[(nb * 2 + (eb ^ 1)) * 32 + r32];
    const float rs = 1.0f / sqrtf(ss * (1.0f / 64.0f) + 1e-6f);
    const size_t ro = (size_t)(tok0 + n) * PP;
#pragma unroll
    for (int g = 0; g < 4; ++g) { const int e0 = 32 * eb + 8 * g + 4 * hi;
        const unsigned long long gw = gpre[g];
        const float g0 = bflo((unsigned)gw), g1 = bfhi((unsigned)gw), g2 = bflo((unsigned)(gw >> 32)), g3 = bfhi((unsigned)(gw >> 32));
        const float o0 = g0 * sigmoid_f(g0) * y[4 * g] * rs, o1 = g1 * sigmoid_f(g1) * y[4 * g + 1] * rs, o2 = g2 * sigmoid_f(g2) * y[4 * g + 2] * rs, o3 = g3 * sigmoid_f(g3) * y[4 * g + 3] * rs;
        *(GAS unsigned long long*)(P + ro + 768 + h * 64 + e0) = (unsigned long long)pk2(o0, o1) | ((unsigned long long)pk2(o2, o3) << 32); }
    if (wave < 4) {
        const int db = wave >> 1, ebs = wave & 1;
#pragma unroll
        for (int i = 0; i < 16; ++i) st[i] *= cdec;
#pragma unroll
        for (int ks = 0; ks < 8; ++ks) {
            const s16x4_t alo = __builtin_bit_cast(s16x4_t, __builtin_amdgcn_ds_read_tr16_b64_v4i16((LAS s16x4_t*)(KD + (16 * ks + 8 * hi + q_) * RP + 32 * db + 16 * blk_ + 4 * p_)));
            const s16x4_t ahi = __builtin_bit_cast(s16x4_t, __builtin_amdgcn_ds_read_tr16_b64_v4i16((LAS s16x4_t*)(KD + (16 * ks + 8 * hi + 4 + q_) * RP + 32 * db + 16 * blk_ + 4 * p_)));
            const s16x4_t blo = __builtin_bit_cast(s16x4_t, __builtin_amdgcn_ds_read_tr16_b64_v4i16((LAS s16x4_t*)(VV + (16 * ks + 8 * hi + q_) * RP + 32 * ebs + 16 * blk_ + 4 * p_)));
            const s16x4_t bhi = __builtin_bit_cast(s16x4_t, __builtin_amdgcn_ds_read_tr16_b64_v4i16((LAS s16x4_t*)(VV + (16 * ks + 8 * hi + 4 + q_) * RP + 32 * ebs + 16 * blk_ + 4 * p_)));
            const bf16x8_t a = (bf16x8_t){alo[0], alo[1], alo[2], alo[3], ahi[0], ahi[1], ahi[2], ahi[3]}, bb = (bf16x8_t){blo[0], blo[1], blo[2], blo[3], bhi[0], bhi[1], bhi[2], bhi[3]};
            st = __builtin_amdgcn_mfma_f32_32x32x16_bf16(a, bb, st, 0, 0, 0); }
    }
    lds_barrier();
    }
    DG_STOP(60, dg60_, dga_)
    DG_WRITE(60, unit == 0 && wave == 0 && lane == 0, dga_)
#undef RT_LOAD
}

constexpr int PT = 32, XSP = 1304;
constexpr int PR_XS = 0, PR_STG = PT * XSP * 2, PR_CONST = PR_STG + 32768, PR_MU = PR_CONST + 6 * 384 * 4;
__device__ __forceinline__ void prep_consts(const Frame& F, int l) {
    LAS float* CS = (LAS float*)(F.lds + PR_CONST);
    for (int i = F.tid; i < AW; i += NTHR) { CS[i] = F.in[I_KK][l * AW + i]; CS[AW + i] = F.in[I_KA][l * AW + i]; CS[2 * AW + i] = F.in[I_RK][l * AW + i];
        CS[3 * AW + i] = F.in[I_W0][l * AW + i]; CS[4 * AW + i] = F.in[I_A0][l * AW + i]; CS[5 * AW + i] = (l > 0) ? F.in[I_V0][(l - 1) * AW + i] : 0.f; }
    LAS float* MU = (LAS float*)(F.lds + PR_MU);
    for (int i = F.tid; i < 1296; i += NTHR) MU[i] = (i < 1280) ? F.in[I_MU][l * 1280 + i] : ((l > 0) ? F.in[I_VRMU][(l - 1) * 16 + i - 1280] : 0.f);
    __syncthreads();
}
__device__ __forceinline__ float softplus_f(float z) { return fmaxf(z, 0.f) + __logf(1.0f + __expf(-fabsf(z))); }
__device__ __forceinline__ float tanh_f(float x) { const float e = __expf(2.0f * x); return 1.0f - 2.0f * __builtin_amdgcn_rcpf(e + 1.0f); }
__device__ __forceinline__ void small_weights(const Frame& F) {
    for (int l = 0; l < DEPTH; ++l) {
        const float* w2 = F.in[I_W2] + (size_t)l * 32 * AW; const float* a2 = F.in[I_A2] + (size_t)l * 32 * AW; const float* g2 = F.in[I_G2] + (size_t)l * 64 * AW;
        const float* v2 = F.in[I_V2] + (size_t)(l > 0 ? l - 1 : 0) * 16 * AW;
        bf16* LT = (bf16*)(F.ws + WS_LORA) + (size_t)l * AW * 144;
        for (int i = F.vcu * NTHR + F.tid; i < AW * 144; i += F.G * NTHR) { const int n = i / 144, k = i - n * 144; float v;
            if (k < 32) v = w2[k * AW + n]; else if (k < 64) v = a2[(k - 32) * AW + n]; else if (k < 128) v = g2[(k - 64) * AW + n]; else v = (l > 0) ? v2[(k - 128) * AW + n] : 0.f;
            LT[i] = (bf16)f2bf(v); }
        const float* wuk = F.in[I_WUK] + (size_t)l * 6 * 64 * 128; const float* wuv = F.in[I_WUV] + (size_t)l * 6 * 128 * 64;
        bf16* wukT = (bf16*)(F.ws + WS_WUKT) + (size_t)l * 6 * 64 * 128; bf16* wuvT = (bf16*)(F.ws + WS_WUVT) + (size_t)l * 6 * 64 * 128;
        for (int i = F.vcu * NTHR + F.tid; i < 6 * 64 * 128; i += F.G * NTHR) {
            { const int hh = i / 8192, rem = i - hh * 8192, c = rem >> 6, d = rem & 63; wukT[i] = (bf16)f2bf(wuk[(hh * 64 + d) * 128 + c]); }
            { const int hh = i / 8192, rem = i - hh * 8192, d = rem >> 7, c = rem & 127; wuvT[i] = (bf16)f2bf(wuv[(hh * 128 + c) * 64 + d]); } }
    }
}
__device__ __forceinline__ void prep_tokens_unit(const Frame& F, int l, int unit) {
    LAS bf16* XS = (LAS bf16*)(F.lds + PR_XS);
    const int tid = F.tid, lane = F.lane, wave = F.wave, r32 = lane & 31, hi = lane >> 5, tok0 = unit * PT;
    const bf16* P = (const bf16*)(F.ws + WS_P);
    unsigned dga_ = 0;
    DG_START(20, dg20_)
    for (int base = 0; base < PT * 162; base += 5 * NTHR) {
        v4u cw[5], pw[5];
#pragma unroll
        for (int u = 0; u < 5; ++u) { const int idx = base + u * NTHR + tid; const int idc = idx < PT * 162 ? idx : PT * 162 - 1; const int t = idc / 162, ch = idc - t * 162, tok = tok0 + t;
            cw[u] = *(const GAS v4u*)(P + (size_t)tok * PP + ch * 8);
            const int tokp = (tok & (SEQ - 1)) != 0 ? tok - 1 : tok; pw[u] = *(const GAS v4u*)(P + (size_t)tokp * PP + ch * 8); }
#pragma unroll
        for (int u = 0; u < 5; ++u) { const int idx = base + u * NTHR + tid;
            if (idx < PT * 162) { const int t = idx / 162, ch = idx - t * 162, tok = tok0 + t, c0 = ch * 8;
                float cur[8], prv[8]; unpack8(cw[u], cur); unpack8(pw[u], prv);
                const bool first = (tok & (SEQ - 1)) == 0;
                float mv[8];
                { const LAS f32x4* mp = (const LAS f32x4*)((const LAS float*)(F.lds + PR_MU) + c0); const f32x4 m0 = mp[0], m1 = mp[1]; mv[0] = m0[0]; mv[1] = m0[1]; mv[2] = m0[2]; mv[3] = m0[3]; mv[4] = m1[0]; mv[5] = m1[1]; mv[6] = m1[2]; mv[7] = m1[3]; }
                float o[8];
#pragma unroll
                for (int j = 0; j < 8; ++j) { const float pv = first ? 0.f : prv[j]; float v = cur[j] + (pv - cur[j]) * mv[j];
                    if (c0 >= 1152 && c0 < 1184) v = tanh_f(v); else if (c0 >= 1216 && c0 < 1280) v = sigmoid_f(v);
                    o[j] = v; }
                v4u w; w.x = pk2(o[0], o[1]); w.y = pk2(o[2], o[3]); w.z = pk2(o[4], o[5]); w.w = pk2(o[6], o[7]);
                *(LAS v4u*)(XS + t * XSP + c0) = w; } }
    }
    __syncthreads();
    DG_STOP(20, dg20_, dga_)
    DG_WRITE(20, unit == 0 && l == 0 && wave == 0 && lane == 0, dga_)
    DG_START(21, dg21_)
    if (wave < 6) {
        const int h = wave;
        LAS bf16* STG = (LAS bf16*)(F.lds + PR_STG + wave * 4096);
        GAS unsigned char* wsb = (GAS unsigned char*)F.ws;
        const bf16* LT = (const bf16*)(F.ws + WS_LORA) + (size_t)l * AW * 144;
        const LAS float* CS = (const LAS float*)(F.lds + PR_CONST) + h * 64;
        const LAS float* kkw = CS; const LAS float* kaw = CS + AW; const LAS float* rkw = CS + 2 * AW; const LAS float* w0p = CS + 3 * AW; const LAS float* a0p = CS + 4 * AW; const LAS float* v0p = CS + 5 * AW;
        const LAS bf16* xrow = XS + r32 * XSP;
        float rn;
        { float ss = 0.f;
#pragma unroll
          for (int cbl = 0; cbl < 2; ++cbl)
#pragma unroll
              for (int g = 0; g < 4; ++g) { const int j0 = cbl * 32 + 8 * g + 4 * hi; const unsigned long long kw = *(const LAS unsigned long long*)(xrow + 384 + h * 64 + j0); const f32x4 kk4 = *(const LAS f32x4*)(kkw + j0);
                  const float k0 = bflo((unsigned)kw) * kk4[0], k1 = bfhi((unsigned)kw) * kk4[1], k2 = bflo((unsigned)(kw >> 32)) * kk4[2], k3 = bfhi((unsigned)(kw >> 32)) * kk4[3]; ss += (k0 * k0 + k1 * k1) + (k2 * k2 + k3 * k3); }
          ss += __shfl_xor(ss, 32); rn = 1.0f / fmaxf(sqrtf(ss), 1e-12f); }
        float bonus = 0.f;
        const int srow = lane >> 2, sch = lane & 3;
#pragma unroll
        for (int cbl = 0; cbl < 2; ++cbl) {
            asm volatile("" ::: "memory");
            const int cb0 = h * 64 + cbl * 32;
            f32x16_t wv, av, gv, mvv;
#pragma unroll
            for (int i = 0; i < 16; ++i) { wv[i] = 0.f; av[i] = 0.f; gv[i] = 0.f; mvv[i] = 0.f; }
            const bf16* lrow = LT + (size_t)(cb0 + r32) * 144 + 8 * hi;
#pragma unroll
            for (int ks = 0; ks < 9; ++ks) { const bf16x8_t a = *(const GAS bf16x8_t*)(lrow + 16 * ks); const bf16x8_t bx = *(const LAS bf16x8_t*)(xrow + 1152 + 16 * ks + 8 * hi);
                if (ks < 2) wv = __builtin_amdgcn_mfma_f32_32x32x16_bf16(a, bx, wv, 0, 0, 0);
                else if (ks < 4) av = __builtin_amdgcn_mfma_f32_32x32x16_bf16(a, bx, av, 0, 0, 0);
                else if (ks < 8) gv = __builtin_amdgcn_mfma_f32_32x32x16_bf16(a, bx, gv, 0, 0, 0);
                else mvv = __builtin_amdgcn_mfma_f32_32x32x16_bf16(a, bx, mvv, 0, 0, 0); }
            if (l > 0) {
#pragma unroll
                for (int i = 0; i < 2; ++i) { const int row = srow + 16 * i; const unsigned eo = (unsigned)(((tok0 + row) * AW + cb0 + sch * 8) * 2); *(LAS v4u*)(STG + row * 32 + sch * 8) = *(const GAS v4u*)(wsb + WS_VF + eo); } }
            unsigned long long ro[4], dd[4], k2o[4], kko[4], bpo[4], vo[4], go[4];
#pragma unroll
            for (int g = 0; g < 4; ++g) { const int j0 = cbl * 32 + 8 * g + 4 * hi;
                const unsigned long long rw = *(const LAS unsigned long long*)(xrow + h * 64 + j0), kw = *(const LAS unsigned long long*)(xrow + 384 + h * 64 + j0), vw = *(const LAS unsigned long long*)(xrow + 768 + h * 64 + j0);
                unsigned long long fw = 0ull; if (l > 0) fw = *(const LAS unsigned long long*)(STG + r32 * 32 + 8 * g + 4 * hi);
                asm volatile("" : "+v"(bonus) :: "memory");
                const f32x4 kk4 = *(const LAS f32x4*)(kkw + j0), ka4 = *(const LAS f32x4*)(kaw + j0), rk4 = *(const LAS f32x4*)(rkw + j0), w04 = *(const LAS f32x4*)(w0p + j0), a04 = *(const LAS f32x4*)(a0p + j0);
                const f32x4 v04 = *(const LAS f32x4*)(v0p + j0);
                const float rr[4] = {bflo((unsigned)rw), bfhi((unsigned)rw), bflo((unsigned)(rw >> 32)), bfhi((unsigned)(rw >> 32))};
                const float kx[4] = {bflo((unsigned)kw), bfhi((unsigned)kw), bflo((unsigned)(kw >> 32)), bfhi((unsigned)(kw >> 32))};
                const float vx[4] = {bflo((unsigned)vw), bfhi((unsigned)vw), bflo((unsigned)(vw >> 32)), bfhi((unsigned)(vw >> 32))};
                const float fx[4] = {bflo((unsigned)fw), bfhi((unsigned)fw), bflo((unsigned)(fw >> 32)), bfhi((unsigned)(fw >> 32))};
                float d_[4], k2_[4], kk_[4], bp_[4], v_[4];
#pragma unroll
                for (int e = 0; e < 4; ++e) { const int i = 4 * g + e;
                    const float sp = softplus_f(-(wv[i] + w04[e])); const float rate = __expf(-sp - 0.5f); const float d = 1.0f - __expf(-rate);
                    const float a = sigmoid_f(av[i] + a04[e]);
                    float v = vx[e]; if (l > 0) v = v + (fx[e] - v) * sigmoid_f(mvv[i] + v04[e]);
                    const float kk = kx[e] * kk4[e] * rn, k2 = kx[e] * (1.0f + (a - 1.0f) * ka4[e]);
                    d_[e] = d; k2_[e] = k2; kk_[e] = kk; bp_[e] = kk * a; v_[e] = v;
                    bonus += rr[e] * k2 * rk4[e]; }
#define PK4(x) ((unsigned long long)pk2(x[0], x[1]) | ((unsigned long long)pk2(x[2], x[3]) << 32))
                ro[g] = rw; dd[g] = PK4(d_); k2o[g] = PK4(k2_); kko[g] = PK4(kk_); bpo[g] = PK4(bp_); vo[g] = PK4(v_);
                go[g] = (unsigned long long)pk2(gv[4 * g], gv[4 * g + 1]) | ((unsigned long long)pk2(gv[4 * g + 2], gv[4 * g + 3]) << 32); }
#define PR_OUT(arr, dst) do { _Pragma("unroll") for (int g = 0; g < 4; ++g) *(LAS unsigned long long*)(STG + r32 * 32 + 8 * g + 4 * hi) = arr[g]; \
            _Pragma("unroll") for (int i = 0; i < 2; ++i) { const int row = srow + 16 * i; const unsigned eo = (unsigned)(((tok0 + row) * AW + cb0 + sch * 8) * 2); *(GAS v4u*)(wsb + dst + eo) = *(const LAS v4u*)(STG + row * 32 + sch * 8); } } while (0)
            PR_OUT(ro, WS_R); PR_OUT(dd, WS_D); PR_OUT(k2o, WS_K2); PR_OUT(kko, WS_KK); PR_OUT(bpo, WS_BP); PR_OUT(vo, WS_VF); PR_OUT(go, WS_G);
#undef PR_OUT
#undef PK4
        }
        bonus += __shfl_xor(bonus, 32);
        if (hi == 0) ((float*)(F.ws + WS_BON))[(size_t)(tok0 + r32) * 6 + h] = bonus;
    } else {
        const float* kvn = F.in[I_KVN] + l * 128; bf16* C = (bf16*)(F.ws + WS_C);
        for (int q = 0; q < 16; ++q) { const int tok = tok0 + 16 * (wave - 6) + q; const unsigned w = *(const GAS unsigned*)(P + (size_t)tok * PP + PBC + 2 * lane);
            const float c0 = bflo(w), c1 = bfhi(w); const float ss = wave_sum(c0 * c0 + c1 * c1); const float rs = 1.0f / sqrtf(ss * (1.0f / 128.0f) + 1e-6f);
            *(GAS unsigned*)(C + (size_t)tok * 128 + 2 * lane) = pk2(c0 * rs * kvn[2 * lane], c1 * rs * kvn[2 * lane + 1]); }
    }
    DG_STOP(21, dg21_, dga_)
    DG_WRITE(21, unit == 0 && l == 0 && wave == 0 && lane == 0, dga_)
    __syncthreads();
}

__device__ __forceinline__ void final_norm(const Frame& F) {
    const int gw = F.vcu * NWAVES + F.wave, NGW = F.G * NWAVES; const float* g = F.in[I_FN];
    float dgc_ = 0.f;
    if (DIAG_SLOT_D >= 0) { const unsigned* D = (const unsigned*)(F.ws + WS_DIAG); const float x0 = (float)D[0] * (1.0f / (100.0f * DIAG_DIV)); const float gq = (DIAG_SLOT_D >= 100) ? 4.0f : 2.0f;
        const float kq = floorf(log2f(fmaxf(x0, 1.0f)) * gq); dgc_ = sqrtf(fmaxf(exp2f((kq + 0.5f) / gq) - 1.0f, 0.01f)); }
    for (int m = gw; m < M; m += NGW) { GAS f32x4* xr = (GAS f32x4*)(F.out + (size_t)m * DM) + F.lane; f32x4 v[4]; float s = 0.f;
#pragma unroll
        for (int j = 0; j < 4; ++j) { v[j] = xr[64 * j]; s += (v[j].x * v[j].x + v[j].y * v[j].y) + (v[j].z * v[j].z + v[j].w * v[j].w); }
        const float rs = 1.0f / sqrtf(wave_sum(s) * (1.0f / DM) + 1e-6f);
#pragma unroll
        for (int j = 0; j < 4; ++j) { const f32x4 gg = *(const f32x4*)(g + 4 * F.lane + 256 * j); xr[64 * j] = (DIAG_SLOT_D >= 0) ? (f32x4){dgc_, dgc_, dgc_, dgc_} : v[j] * rs * gg; } }
}

template <class T> __device__ __forceinline__ T* launder_ptr(T* p) {
    unsigned lo = (unsigned)(uintptr_t)p, hi = (unsigned)((uintptr_t)p >> 32);
    asm volatile("" : "+v"(lo), "+v"(hi));
    lo = __builtin_amdgcn_readfirstlane(lo); hi = __builtin_amdgcn_readfirstlane(hi);
    return (T*)(((uintptr_t)hi << 32) | (uintptr_t)lo);
}
constexpr int NPHASE = 20;
constexpr int DUP_PHASE = -1;
constexpr int QDUP = 1;
constexpr int REP_SCAN_K = 1, REP_THR_K = 1;
constexpr int NSTEP = NPHASE + (DUP_PHASE >= 0 ? 1 : 0);
constexpr int REP_THR = 1, REP_PTOK = 1, REP_KV = 1, REP_CONV = 1, REP_SCAN = 1, REP_DSA = 1, REP_RET = 1, REP_UP = 1;
#define REPL(n) for (int rep_ = 0; rep_ < (l == 0 ? (n) : 1); ++rep_)
__global__ void __launch_bounds__(NTHR, 2) fwd_kernel(Args args) {
    extern __shared__ __attribute__((aligned(16))) unsigned char lds[];
    Frame F;
    F.lds = (LAS unsigned char*)lds;
    F.tid = threadIdx.x; F.lane = F.tid & 63; F.wave = __builtin_amdgcn_readfirstlane(F.tid >> 6);
    F.G = gridDim.x; { const int bx = blockIdx.x; F.vcu = (F.G % 8 == 0) ? (bx % 8) * (F.G / 8) + bx / 8 : bx; }
    F.in = (const float* const __attribute__((address_space(4)))*)__builtin_amdgcn_kernarg_segment_ptr(); F.out = args.out; F.ws = args.ws;
    volatile LAS unsigned* MISC = (volatile LAS unsigned*)(F.lds + MISC_OFF);
    for (int u = F.tid; u < (LDS_BYTES - LDSCTL_OFF) / 4; u += NTHR) ((LAS unsigned*)(F.lds + LDSCTL_OFF))[u] = 0u;
    __syncthreads();
    const int lo = args.ph_lo, hi = args.ph_hi;
    XcdBarrier bar; bar.bar = (unsigned*)(F.ws + WS_CTL) + CW_BAR; bar.x = 0; bar.st = nullptr;
    if (hi - lo > 1) bar = xcd_barrier_post((unsigned*)(F.ws + WS_CTL) + CW_BAR, MISC + 8);
    for (int ph_ = lo; ph_ < hi; ++ph_) {
        unsigned dgp0_ = 0; if (DIAG_SLOT_D >= 100) dgp0_ = (unsigned)__builtin_amdgcn_s_memtime();
        int ph = (args.dup_phase >= 0 && ph_ > args.dup_phase) ? ph_ - 1 : ph_; asm volatile("" : "+v"(ph)); ph = __builtin_amdgcn_readfirstlane(ph);
#define PH_ENTER() \
        { unsigned z_ = 0u; int t_ = threadIdx.x; asm volatile("" : "+v"(z_), "+v"(t_)); z_ = __builtin_amdgcn_readfirstlane(z_); F.in = (const float* const __attribute__((address_space(4)))*)((const char __attribute__((address_space(4)))*)__builtin_amdgcn_kernarg_segment_ptr() + z_); F.out = args.out + z_; F.ws = args.ws + z_; \
          F.tid = t_; F.lane = t_ & 63; F.wave = __builtin_amdgcn_readfirstlane(t_ >> 6); } \
        int bx = blockIdx.x; { int g_ = gridDim.x; asm volatile("" : "+v"(bx), "+v"(g_)); bx = __builtin_amdgcn_readfirstlane(bx); g_ = __builtin_amdgcn_readfirstlane(g_); F.G = g_; F.vcu = (g_ % 8 == 0) ? (bx % 8) * (g_ / 8) + bx / 8 : bx; } \
        gu32* ctl = (gu32*)(F.ws + WS_CTL); (void)ctl; \
        bf16* XB = (bf16*)(F.ws + WS_XB); bf16* Hb = (bf16*)(F.ws + WS_H); bf16* Pb = (bf16*)(F.ws + WS_P); float* part = (float*)(F.ws + WS_PART); (void)XB; (void)Hb; (void)Pb; (void)part;
        if (ph == 0) { PH_ENTER();
            if (DIAG_SLOT_D >= 0 && bx == 0 && threadIdx.x == 0) { ((unsigned*)(args.ws + WS_DIAG))[0] = 0u; ((unsigned*)(args.ws + WS_DIAG))[1] = 0u; }
            conv_weights(F, 0, 0, 3);
            p0_x(F); p0_table(F); small_weights(F);
        } else if (ph == NPHASE - 1) { PH_ENTER();
            final_norm(F);
        } else {
            const int l = (ph - 1) / 9, sub = (ph - 1) - 9 * l;
            if (sub == 0 || sub == 7) { PH_ENTER();
                pg8::Gemm g{XB, (const bf16*)(F.ws + (sub == 0 ? WS_WGU1 : WS_WGU2)), M, NGU, DM, DM}; pg8::StaticOrder S; S.init(M, NGU, F.G, bx);
                pg8::EpiUp E{Hb, FFP, part};
                for (int rep = 0; rep < ((l == 0 && sub == 0) ? REP_UP : 1); ++rep) pg8::gemm_phase<pg8::EpiUp, pg8::StaticOrder, true>(F.lds, g, S, E, F.tid);
            } else if (sub == 1 || sub == 8 || sub == 6) { PH_ENTER();
                const bool op = (sub == 6);
                pg8::Gemm g{op ? Pb : Hb, (const bf16*)(F.ws + (op ? WS_WOUT : (sub == 1 ? WS_WD1 : WS_WD2))), M, DM, op ? DM : FFP, op ? PP : FFP}; pg8::StaticOrder S; S.init(M, DM, F.G, bx);
                const float* base = (l == 0 && sub == 1) ? F.in[I_X] : F.out;
                pg8::EpiRes E{base, F.out, XB, part};
                pg8::gemm_phase<pg8::EpiRes, pg8::StaticOrder, false>(F.lds, g, S, E, F.tid);
            } else if (sub == 2) { PH_ENTER();
                pg8::Gemm g{XB, (const bf16*)(F.ws + WS_WIN), M, PP, DM, DM}; pg8::StaticOrder S; S.init(M, PP, F.G, bx);
                pg8::EpiP E{Pb, PP, part};
                pg8::gemm_phase<pg8::EpiP, pg8::StaticOrder, true>(F.lds, g, S, E, F.tid);
            } else if (sub == 3) { PH_ENTER();
                for (int rep_ = 0; rep_ < (l == 0 ? args.rep_thr : 1); ++rep_)
                    for (int k = 0, u0 = F.vcu; u0 < M / 16; ++k, u0 += F.G) {
                        const int base = k * F.G, span = (M / 16 - base) < F.G ? (M / 16 - base) : F.G; const int u = (k & 1) ? base + span - 1 - F.vcu : u0;
                        if (u >= base && u < M / 16) dsa_thr_unit(F, u); }
                prep_consts(F, l);
                REPL(REP_PTOK) for (int u = F.vcu; u < M / PT; u += F.G) prep_tokens_unit(F, l, u);

            } else if (sub == 5) { PH_ENTER();
                rwkv_post(F, l);
            } else if (sub == 4) { PH_ENTER();
                unsigned dgm_ = 0; if (DIAG_SLOT_D >= 50 && DIAG_SLOT_D < 60) dgm_ = (unsigned)__builtin_amdgcn_s_memtime();
                if (bx < BATCH * 24) { for (int rep_ = 0; rep_ < (l == 0 ? args.rep_scan : 1); ++rep_) { rwkv_scan_unit(F, l, bx); __syncthreads(); } }
                if (DIAG_SLOT_D == 54 && l == 0 && bx < BATCH * 24 && threadIdx.x == 0) atomicMax((unsigned*)(args.ws + WS_DIAG), (unsigned)__builtin_amdgcn_s_memtime() - dgm_);
                if (DIAG_SLOT_D == 50 && l == 0 && bx == 0 && threadIdx.x == 0) ((unsigned*)(args.ws + WS_DIAG))[0] = (unsigned)__builtin_amdgcn_s_memtime() - dgm_;
                {
                    gu32* qh = ctl + CW_QUEUE + 64 * l;
                    for (;;) {
                        if (F.tid == 0) MISC[0] = __hip_atomic_fetch_add(qh, 1u, RLX_AGENT);
                        __syncthreads();
                        const int u = (int)MISC[0];
                        __syncthreads();
                        const int nd = (l == 0 ? args.qdup : 1) * (M / 32);
                        { unsigned z_ = 0u; int t_ = threadIdx.x; asm volatile("" : "+v"(z_), "+v"(t_)); z_ = __builtin_amdgcn_readfirstlane(z_); F.ws = args.ws + z_; F.tid = t_; F.lane = t_ & 63; F.wave = __builtin_amdgcn_readfirstlane(t_ >> 6); }
                        const int ncv = (conv_flat_items(l + 1 < DEPTH) + NWAVES * CONV_PER_WAVE - 1) / (NWAVES * CONV_PER_WAVE);
                        if (DIAG_SLOT_D == 53 && l == 0 && bx == 200 && threadIdx.x == 0 && u >= BATCH * 4 + nd) { unsigned* D_ = (unsigned*)(args.ws + WS_DIAG); if (D_[1] != 0x600Du) { D_[1] = 0x600Du; D_[0] = (unsigned)__builtin_amdgcn_s_memtime() - dgm_; } }
                        if (u >= nd + BATCH * 4 + ncv) { if (DIAG_SLOT_D == 51 && l == 0 && bx == 0 && threadIdx.x == 0) ((unsigned*)(args.ws + WS_DIAG))[0] = (unsigned)__builtin_amdgcn_s_memtime() - dgm_;
                            if (DIAG_SLOT_D == 52 && l == 0 && bx == 200 && threadIdx.x == 0) ((unsigned*)(args.ws + WS_DIAG))[0] = (unsigned)__builtin_amdgcn_s_memtime() - dgm_; }
                        if (DIAG_SLOT_D == 55 && l == 0 && u >= nd + BATCH * 4 + ncv && threadIdx.x == 0) atomicMax((unsigned*)(args.ws + WS_DIAG), (unsigned)__builtin_amdgcn_s_memtime() - dgm_);
                        if (DIAG_SLOT_D == 56 && l == 0 && u >= BATCH * 4 && u < nd + BATCH * 4 && threadIdx.x == 0) atomicMax((unsigned*)(args.ws + WS_DIAG), (unsigned)__builtin_amdgcn_s_memtime() - dgm_);
                        if (u >= nd + BATCH * 4 + ncv) break;
                        if (u < BATCH * 4) ret_out_unit(F, u);
                        else if (u < nd + BATCH * 4) dsa_attn_unit(F, l, (u - BATCH * 4) % (M / 32));
                        else { conv_unit(F, l, u - nd - BATCH * 4); __syncthreads(); }
                    }
                }
            }
        }
        if (ph_ + 1 < hi) xcd_barrier(bar);
        if (DIAG_SLOT_D >= 100 && ph_ == DIAG_SLOT_D - 100 && blockIdx.x == 0 && threadIdx.x == 0) ((unsigned*)(args.ws + WS_DIAG))[0] = (unsigned)__builtin_amdgcn_s_memtime() - dgp0_;
    }
}

extern "C" void kernel_launch(void* const* d_in, const int* in_sizes, int n_in, void* d_out, int out_size, void* d_ws, size_t ws_size, hipStream_t stream) {
    static int grid = 0;
    if (grid == 0) {
        if (n_in != 31 || out_size != M * DM || ws_size < WS_END) { fprintf(stderr, "kernel_launch: unexpected shapes (n_in %d, out %d, ws %zu)\n", n_in, out_size, ws_size); grid = -1; return; }
        int dev = 0, cus = 0, per_cu = 0;
        if (hipGetDevice(&dev) != hipSuccess || hipDeviceGetAttribute(&cus, hipDeviceAttributeMultiprocessorCount, dev) != hipSuccess) { grid = -1; return; }
        if (hipFuncSetAttribute((const void*)fwd_kernel, hipFuncAttributeMaxDynamicSharedMemorySize, LDS_BYTES) != hipSuccess) { fprintf(stderr, "kernel_launch: hipFuncSetAttribute failed\n"); grid = -1; return; }
        if (hipOccupancyMaxActiveBlocksPerMultiprocessor(&per_cu, (const void*)fwd_kernel, NTHR, LDS_BYTES) != hipSuccess || per_cu < 1) fprintf(stderr, "kernel_launch: occupancy query says %d\n", per_cu);
        (void)hipGetLastError();
        grid = cus;
    }
    if (grid < 0) return;
    if (hipMemsetAsync((char*)d_ws + WS_CTL, 0, CTL_ZERO_BYTES, stream) != hipSuccess) return;
    Args a{};
    for (int i = 0; i < 31; ++i) a.in[i] = (const float*)d_in[i];
    a.out = (float*)d_out; a.ws = (unsigned char*)d_ws; a.dup_phase = DUP_PHASE; a.qdup = QDUP; a.rep_scan = REP_SCAN_K; a.rep_thr = REP_THR_K;
#ifndef ONE_LAUNCH
#define ONE_LAUNCH 1
#endif
    if (ONE_LAUNCH) { a.ph_lo = 0; a.ph_hi = NSTEP; hipLaunchKernelGGL(fwd_kernel, dim3(grid), dim3(NTHR), LDS_BYTES, stream, a); }
    else for (int ph = 0; ph < NPHASE; ++ph) { a.ph_lo = ph; a.ph_hi = ph + 1; hipLaunchKernelGGL(fwd_kernel, dim3(grid), dim3(NTHR), LDS_BYTES, stream, a); }
}
```

```cpp
#include <hip/hip_runtime.h>
#include <cstdio>
#include <cstdint>
#include <cmath>

namespace pg8 {
#define PG8_LAS __attribute__((address_space(3)))
typedef unsigned short bf16_t;
typedef short bf16x8 __attribute__((ext_vector_type(8)));
typedef float f32x4 __attribute__((ext_vector_type(4)));
typedef unsigned u32x4 __attribute__((ext_vector_type(4)));
constexpr int BM = 256, BK = 64, HALF = 128, HTB = HALF * BK * 2  , STAGE_BYTES = 8 * HTB, NXCD = 8, WGM = 8;

__host__ __device__ __forceinline__ int lds_byte(int r, int c) { const int st = (r >> 4) * 2 + (c >> 5), rr = r & 15, cc = c & 31, ob = rr * 64 + cc * 2; return st * 1024 + (ob ^ (((ob >> 9) & 1) << 5)); }
__host__ __device__ __forceinline__ void stage_rc(int b, int& R, int& C) { const int st = b / 1024, sb = b % 1024, swz = sb ^ (((sb >> 9) & 1) << 5); R = (st >> 1) * 16 + swz / 64; C = (st & 1) * 32 + (swz % 64) / 2; }
__host__ __device__ __forceinline__ int perm32(int rho) { const int n = rho >> 4, i = rho & 15; return 8 * (i >> 2) + 4 * n + (i & 3); }

struct Unit { int pm, pn; };
struct Gemm { const bf16_t* A; const bf16_t* Bt; int M, N, K, lda; };

struct StaticOrder {
    int nM, nN, nwg, G, c;
    __host__ __device__ void init(int M, int N, int G_, int c_) { nM = M / BM; nN = N / BM; nwg = nM * nN; G = G_; c = c_; }
    __host__ __device__ bool next(int i, Unit& u) const {
        const long L = (long)i * G + c; if (L >= nwg) return false;
        int wgid = (int)L; { const int q = nwg / NXCD, r = nwg % NXCD, xcd = wgid % NXCD, off = wgid / NXCD; wgid = (xcd < r ? xcd * (q + 1) : r * (q + 1) + (xcd - r) * q) + off; }
        const int nig = WGM * nN, gid = wgid / nig, fm = gid * WGM, gsz = (nM - fm) < WGM ? (nM - fm) : WGM;
        u.pm = fm + ((wgid % nig) % gsz); u.pn = (wgid % nig) / gsz; return true;
    }
    __device__ __forceinline__ void a_ready(const Unit&) const {}
    __device__ __forceinline__ void done(const Unit&) const {}
};

__device__ __forceinline__ unsigned cvt_pk_bf16(float lo, float hi) { unsigned r; asm volatile("v_cvt_pk_bf16_f32 %0, %1, %2" : "=v"(r) : "v"(lo), "v"(hi)); return r; }


__device__ __forceinline__ float row_rstd(const float* part, int row) {
    const f32x4* p = (const f32x4*)(part + (size_t)row * 16);
    const f32x4 a = p[0], b = p[1], c = p[2], d = p[3];
    const float s = ((a[0] + a[1]) + (a[2] + a[3])) + ((b[0] + b[1]) + (b[2] + b[3])) + ((c[0] + c[1]) + (c[2] + c[3])) + ((d[0] + d[1]) + (d[2] + d[3]));
    return 1.0f / sqrtf(s * (1.0f / 1024.0f) + 1e-6f);
}
__device__ __forceinline__ float silu_f(float x) { return x * __builtin_amdgcn_rcpf(1.0f + __expf(-x)); }

struct EpiUp {
    static constexpr bool PERM = true;
    bf16_t* H; int ldh; const float* part;
    __device__ __forceinline__ void operator()(const f32x4 (&acc)[2][2][4][2], const Unit& u, int wr, int wc, int fr, int fq) const {
        const int row0 = u.pm * BM + wr * 64 + fr, hcol = u.pn * 128 + wc * 32 + 8 * fq;
#pragma unroll
        for (int ai = 0; ai < 2; ++ai)
#pragma unroll
            for (int m = 0; m < 4; ++m) { const int row = row0 + ai * HALF + m * 16; const float rs = row_rstd(part, row);
                const f32x4 g0 = acc[ai][0][m][0] * rs, g1 = acc[ai][0][m][1] * rs, u0 = acc[ai][1][m][0] * rs, u1 = acc[ai][1][m][1] * rs;
                u32x4 w; w.x = cvt_pk_bf16(silu_f(g0[0]) * u0[0], silu_f(g0[1]) * u0[1]); w.y = cvt_pk_bf16(silu_f(g0[2]) * u0[2], silu_f(g0[3]) * u0[3]);
                w.z = cvt_pk_bf16(silu_f(g1[0]) * u1[0], silu_f(g1[1]) * u1[1]); w.w = cvt_pk_bf16(silu_f(g1[2]) * u1[2], silu_f(g1[3]) * u1[3]);
                *(u32x4*)(H + (size_t)row * ldh + hcol) = w; }
    }
};
struct EpiP {
    static constexpr bool PERM = true;
    bf16_t* P; int ldp; const float* part;
    __device__ __forceinline__ void operator()(const f32x4 (&acc)[2][2][4][2], const Unit& u, int wr, int wc, int fr, int fq) const {
        const int row0 = u.pm * BM + wr * 64 + fr, col0 = u.pn * BM + wc * 32 + 8 * fq;
#pragma unroll
        for (int ai = 0; ai < 2; ++ai)
#pragma unroll
            for (int m = 0; m < 4; ++m) { const int row = row0 + ai * HALF + m * 16; const float rs = row_rstd(part, row);
#pragma unroll
                for (int bj = 0; bj < 2; ++bj) { const f32x4 v0 = acc[ai][bj][m][0] * rs, v1 = acc[ai][bj][m][1] * rs;
                    u32x4 w; w.x = cvt_pk_bf16(v0[0], v0[1]); w.y = cvt_pk_bf16(v0[2], v0[3]); w.z = cvt_pk_bf16(v1[0], v1[1]); w.w = cvt_pk_bf16(v1[2], v1[3]);
                    *(u32x4*)(P + (size_t)row * ldp + col0 + bj * HALF) = w; } }
    }
};
struct EpiRes {
    static constexpr bool PERM = true;
    const float* base; bf16_t* xb; float* part;
    __device__ __forceinline__ void operator()(const f32x4 (&acc)[2][2][4][2], const Unit& u, int wr, int wc, int fr, int fq) const {
        const int row0 = u.pm * BM + wr * 64 + fr, col0 = u.pn * BM + wc * 32 + 8 * fq;
#pragma unroll
        for (int ai = 0; ai < 2; ++ai)
#pragma unroll
            for (int m = 0; m < 4; ++m) { const int row = row0 + ai * HALF + m * 16; float ss = 0.f;
#pragma unroll
                for (int bj = 0; bj < 2; ++bj) { const size_t off = (size_t)row * 1024 + col0 + bj * HALF;
                    f32x4 v0, v1;
                    if (base) { v0 = *(const f32x4*)(base + off); v1 = *(const f32x4*)(base + off + 4); }
                    else { const u32x4 xw = *(const u32x4*)(xb + off);
                        v0 = (f32x4){__builtin_bit_cast(float, xw.x << 16), __builtin_bit_cast(float, xw.x & 0xffff0000u), __builtin_bit_cast(float, xw.y << 16), __builtin_bit_cast(float, xw.y & 0xffff0000u)};
                        v1 = (f32x4){__builtin_bit_cast(float, xw.z << 16), __builtin_bit_cast(float, xw.z & 0xffff0000u), __builtin_bit_cast(float, xw.w << 16), __builtin_bit_cast(float, xw.w & 0xffff0000u)}; }
                    v0 += acc[ai][bj][m][0]; v1 += acc[ai][bj][m][1];
                    u32x4 w; w.x = cvt_pk_bf16(v0[0], v0[1]); w.y = cvt_pk_bf16(v0[2], v0[3]); w.z = cvt_pk_bf16(v1[0], v1[1]); w.w = cvt_pk_bf16(v1[2], v1[3]);
                    *(u32x4*)(xb + off) = w;
                    ss += (v0[0] * v0[0] + v0[1] * v0[1]) + (v0[2] * v0[2] + v0[3] * v0[3]) + (v1[0] * v1[0] + v1[1] * v1[1]) + (v1[2] * v1[2] + v1[3] * v1[3]); }
                ss += __shfl_xor(ss, 16); ss += __shfl_xor(ss, 32);
                if (fq == 0) part[(size_t)row * 16 + u.pn * 4 + wc] = ss;
                asm volatile("" ::: "memory"); }
    }
};

template <class Epi, class Sched, bool ALIGN_EPI>
__device__ __forceinline__ void gemm_phase(PG8_LAS unsigned char* lds, const Gemm g, const Sched& S, const Epi& E, const int tid) {
    const int wid = __builtin_amdgcn_readfirstlane(tid >> 6), lane = tid & 63, wr = wid >> 2, wc = wid & 3, fr = lane & 15, fq = lane >> 4;
    const int K = g.K, nt = K / BK, lda = g.lda;
    unsigned voffA[2], voffB[2];
#pragma unroll
    for (int i = 0; i < 2; ++i) { int R, C; stage_rc(tid * 16 + i * 8192, R, C); const int Rb = Epi::PERM ? ((R & ~31) + perm32(R & 31)) : R;
        voffA[i] = (unsigned)(R * lda + C) * 2u; voffB[i] = (unsigned)(Rb * K + C) * 2u; }
    const size_t kstep = (size_t)(BK * 2);
    const size_t hstepA = (size_t)HALF * lda * 2, hstepB = (size_t)HALF * K * 2;
    const size_t tstepA = 2 * hstepA, tstepB = 2 * hstepB;
    const unsigned ldsw = (unsigned)wid * 1024u;
    const int aoff = lds_byte(wr * 64 + fr, fq * 8), boff = lds_byte(wc * 32 + fr, fq * 8);
#define PG8_SA(b, h) (((b) * 2 + (h)) * HTB)
#define PG8_SB(b, h) ((4 + (b) * 2 + (h)) * HTB)
#define PG8_STAGE(bufoff, gbase, voff) do { _Pragma("unroll") for (int _i = 0; _i < 2; ++_i) \
        __builtin_amdgcn_global_load_lds((const unsigned*)((const char*)(gbase) + (voff)[_i]), (PG8_LAS unsigned*)(lds + (bufoff) + ldsw + _i * 8192), 16, 0, 0); } while (0)
#define PG8_LDA(dst, b, h) do { _Pragma("unroll") for (int m = 0; m < 4; ++m) _Pragma("unroll") for (int k = 0; k < 2; ++k) dst[m][k] = *(const PG8_LAS bf16x8*)(lds + PG8_SA(b, h) + aoff + m * 2048 + k * 1024); } while (0)
#define PG8_LDB(dst, b, h) do { _Pragma("unroll") for (int n = 0; n < 2; ++n) _Pragma("unroll") for (int k = 0; k < 2; ++k) dst[n][k] = *(const PG8_LAS bf16x8*)(lds + PG8_SB(b, h) + boff + n * 2048 + k * 1024); } while (0)
#define PG8_MMA(ai, bj, At, Bt) do { __builtin_amdgcn_s_setprio(1); _Pragma("unroll") for (int m = 0; m < 4; ++m) _Pragma("unroll") for (int n = 0; n < 2; ++n) _Pragma("unroll") for (int k = 0; k < 2; ++k) \
        acc[ai][bj][m][n] = __builtin_amdgcn_mfma_f32_16x16x32_bf16(Bt[n][k], At[m][k], acc[ai][bj][m][n], 0, 0, 0); __builtin_amdgcn_s_setprio(0); } while (0)
#define PG8_WAIT_V(n) asm volatile("s_waitcnt vmcnt(" #n ")" ::: "memory")
#define PG8_WAIT_L(n) asm volatile("s_waitcnt lgkmcnt(" #n ")" ::: "memory")
#define PG8_BAR __builtin_amdgcn_s_barrier()
#define PG8_SCHED __builtin_amdgcn_sched_barrier(0)
    Unit cur, nxt; int ui = 0;
    if (!S.next(0, cur)) return;
    f32x4 acc[2][2][4][2];
#pragma unroll
    for (int a = 0; a < 2; ++a)
#pragma unroll
        for (int b = 0; b < 2; ++b)
#pragma unroll
            for (int m = 0; m < 4; ++m)
#pragma unroll
                for (int n = 0; n < 2; ++n) acc[a][b][m][n] = (f32x4){0.f, 0.f, 0.f, 0.f};
    bf16x8 At[4][2], B0[2][2], B1[2][2];
    const char* cA = (const char*)g.A + (size_t)cur.pm * tstepA; const char* cB = (const char*)g.Bt + (size_t)cur.pn * tstepB;
    S.a_ready(cur);
    PG8_STAGE(PG8_SB(0, 0), cB, voffB); PG8_STAGE(PG8_SB(0, 1), cB + hstepB, voffB); PG8_STAGE(PG8_SA(0, 0), cA, voffA); PG8_STAGE(PG8_SA(0, 1), cA + hstepA, voffA);
    if (wr == 1) PG8_BAR;
    PG8_WAIT_V(2); PG8_BAR;
    PG8_STAGE(PG8_SB(1, 0), cB + kstep, voffB); PG8_STAGE(PG8_SA(1, 0), cA + kstep, voffA); PG8_STAGE(PG8_SB(1, 1), cB + hstepB + kstep, voffB);
    PG8_WAIT_V(6); PG8_BAR;
    for (;;) {
        const bool has_next = S.next(ui + 1, nxt);
        const char* nA = has_next ? (const char*)g.A + (size_t)nxt.pm * tstepA : cA; const char* nB = has_next ? (const char*)g.Bt + (size_t)nxt.pn * tstepB : cB;
        for (int t = 0; t < nt; t += 2) {
            const bool last = (t == nt - 2);
            const char* a1 = cA + (size_t)(t + 1) * kstep;
            const char* a2 = last ? nA : cA + (size_t)(t + 2) * kstep; const char* b2 = last ? nB : cB + (size_t)(t + 2) * kstep;
            const char* a3 = a2 + kstep; const char* b3 = b2 + kstep;
            if (last && has_next) S.a_ready(nxt);
            PG8_LDB(B0, 0, 0); PG8_LDB(B1, 0, 1); PG8_SCHED; PG8_LDA(At, 0, 0); PG8_STAGE(PG8_SA(1, 1), a1 + hstepA, voffA);
            PG8_WAIT_V(8); PG8_WAIT_L(0); PG8_BAR; PG8_MMA(0, 0, At, B0); PG8_MMA(0, 1, At, B1); PG8_BAR; PG8_SCHED;
            PG8_LDA(At, 0, 1); PG8_STAGE(PG8_SB(0, 0), b2, voffB); PG8_STAGE(PG8_SB(0, 1), b2 + hstepB, voffB); PG8_STAGE(PG8_SA(0, 0), a2, voffA);
            PG8_WAIT_V(8); PG8_WAIT_L(0); PG8_BAR; PG8_MMA(1, 0, At, B0); PG8_MMA(1, 1, At, B1); PG8_BAR; PG8_SCHED;
            PG8_LDB(B0, 1, 0); PG8_LDB(B1, 1, 1); PG8_SCHED; PG8_LDA(At, 1, 0); PG8_STAGE(PG8_SA(0, 1), a2 + hstepA, voffA);
            PG8_WAIT_V(8); PG8_WAIT_L(0); PG8_BAR; PG8_MMA(0, 0, At, B0); PG8_MMA(0, 1, At, B1); PG8_BAR; PG8_SCHED;
            PG8_LDA(At, 1, 1); PG8_STAGE(PG8_SB(1, 0), b3, voffB); PG8_STAGE(PG8_SB(1, 1), b3 + hstepB, voffB); PG8_STAGE(PG8_SA(1, 0), a3, voffA);
            PG8_WAIT_V(8); PG8_WAIT_L(0); PG8_BAR; PG8_MMA(1, 0, At, B0); PG8_MMA(1, 1, At, B1); PG8_BAR; PG8_SCHED;
        }
        if constexpr (ALIGN_EPI) { if (wr == 0) PG8_BAR; }
        E(acc, cur, wr, wc, fr, fq); S.done(cur);
        if (!has_next) break;
#pragma unroll
        for (int a = 0; a < 2; ++a)
#pragma unroll
            for (int b = 0; b < 2; ++b)
#pragma unroll
                for (int m = 0; m < 4; ++m)
#pragma unroll
                    for (int n = 0; n < 2; ++n) acc[a][b][m][n] = (f32x4){0.f, 0.f, 0.f, 0.f};
        cur = nxt; cA = nA; cB = nB; ++ui;
        if constexpr (ALIGN_EPI) { if (wr == 1) PG8_BAR; }
    }
    PG8_WAIT_V(0);
    if constexpr (!ALIGN_EPI) { if (wr == 0) PG8_BAR; }
    PG8_BAR;
#undef PG8_SA
#undef PG8_SB
#undef PG8_STAGE
#undef PG8_LDA
#undef PG8_LDB
#undef PG8_MMA
#undef PG8_WAIT_V
#undef PG8_WAIT_L
#undef PG8_BAR
#undef PG8_SCHED
}
}

constexpr int NWAVES = 8, NTHR = 512;
constexpr int BATCH = 8, SEQ = 2048, DM = 1024, DEPTH = 2, FF = 2752, M = BATCH * SEQ;
constexpr int FFP = 2816;
constexpr int NGU = 5632;
constexpr int PP = 3584;
constexpr int NIN = 3400;
constexpr int PA = 0, PMV = 1280, PBQ = 1296, PBC = 1680, PBIQ = 1808, PBIK = 2320, PBIW = 2384, PCQ = 2392, PCK = 2648, PCV = 2904, PCG = 3160, PUSED = 3416;
constexpr int AW = 384;
constexpr int TOPK = 256;

constexpr size_t MiB = 1u << 20;
constexpr size_t WS_CTL = 0, CTL_ZERO_BYTES = 1 * MiB;
constexpr size_t WS_PART = 1 * MiB;
constexpr size_t WS_TAB = 2 * MiB;
constexpr size_t WS_BON = 2 * MiB + 512 * 1024;
constexpr size_t WS_WUKT = 3 * MiB, WS_WUVT = 3 * MiB + 192 * 1024;
constexpr size_t WS_THR = 3 * MiB + 384 * 1024, WS_SCUT = 3 * MiB + 448 * 1024;
constexpr size_t WS_LORA = 3 * MiB + 512 * 1024;
constexpr size_t WS_WGU1 = 4 * MiB, WS_WD1 = 15 * MiB, WS_WIN = 21 * MiB, WS_WOUT = 28 * MiB, WS_WGU2 = 30 * MiB, WS_WD2 = 41 * MiB;
constexpr size_t WS_XB = 47 * MiB;
constexpr size_t WS_VF = 79 * MiB;
constexpr size_t WS_P = 91 * MiB;
constexpr size_t WS_H = WS_P;
constexpr size_t WS_R = 203 * MiB, WS_D = 215 * MiB, WS_K2 = 227 * MiB, WS_KK = 239 * MiB, WS_C = 251 * MiB;
constexpr size_t WS_KV = WS_XB + 24 * MiB;
constexpr size_t OUT_BP = 0, OUT_G = 12 * MiB, OUT_MASK = 24 * MiB;
constexpr size_t WS_END = 256 * MiB;
static_assert(WS_WD2 + (size_t)1024 * FFP * 2 <= WS_XB && WS_P + (size_t)M * PP * 2 <= WS_R && WS_C + (size_t)M * 128 * 2 <= WS_END, "ws map");
constexpr int CW_BAR = 4096;
constexpr int CW_QUEUE = 16384;

constexpr int RING_BYTES = 131072;
constexpr int LDSCTL_OFF = RING_BYTES, MISC_OFF = LDSCTL_OFF + 320;
constexpr int LDS_BYTES = 147456;

#define GAS __attribute__((address_space(1)))
#define LAS __attribute__((address_space(3)))
typedef unsigned short bf16;
typedef unsigned v4u __attribute__((ext_vector_type(4)));
typedef float f32x4 __attribute__((ext_vector_type(4)));
typedef GAS unsigned gu32;
#define RLX_AGENT __ATOMIC_RELAXED, __HIP_MEMORY_SCOPE_AGENT
#define LDS_WAIT() asm volatile("s_waitcnt lgkmcnt(0)" ::: "memory")
__device__ __forceinline__ unsigned f2bf(float f) { unsigned u = __builtin_bit_cast(unsigned, f); return (u + 0x7fffu + ((u >> 16) & 1u)) >> 16; }
typedef float f32x2v_ __attribute__((ext_vector_type(2))); typedef __bf16 bf16x2v_ __attribute__((ext_vector_type(2)));
__device__ __forceinline__ unsigned pk2(float lo, float hi) { const f32x2v_ v = {lo, hi}; return __builtin_bit_cast(unsigned, __builtin_convertvector(v, bf16x2v_)); }
__device__ __forceinline__ float bf2f(unsigned short v) { return __uint_as_float((unsigned)v << 16); }
__device__ __forceinline__ float bflo(unsigned w) { return __uint_as_float(w << 16); }
__device__ __forceinline__ float bfhi(unsigned w) { return __uint_as_float(w & 0xffff0000u); }
__device__ __forceinline__ void unpack8(const v4u w, float (&f)[8]) { f[0] = bflo(w.x); f[1] = bfhi(w.x); f[2] = bflo(w.y); f[3] = bfhi(w.y); f[4] = bflo(w.z); f[5] = bfhi(w.z); f[6] = bflo(w.w); f[7] = bfhi(w.w); }
__device__ __forceinline__ float sigmoid_f(float x) { return 1.0f / (1.0f + __expf(-x)); }
__device__ __forceinline__ float wave_sum(float v) {
#pragma unroll
    for (int o = 1; o < 64; o <<= 1) v += __shfl_xor(v, o);
    return v;
}

#define XB_TMO      128
#define XB_XCNT(j)  (256  + 64 * (j))
#define XB_XSUB(j)  (1280 + 64 * (j))
#define XB_XGEN(j)  (2304 + 64 * (j))
#define XB_TOP      3328
#define XB_TOPGEN   3392
#define XCD_BAR_WORDS 3456
#define XB_SPIN_CAP (1u << 22)

__device__ __forceinline__ unsigned xb_ld(unsigned* p)              { return __hip_atomic_load(p, __ATOMIC_RELAXED, __HIP_MEMORY_SCOPE_AGENT); }
__device__ __forceinline__ unsigned xb_add(unsigned* p, unsigned v) { return __hip_atomic_fetch_add(p, v, __ATOMIC_RELAXED, __HIP_MEMORY_SCOPE_AGENT); }
__device__ __forceinline__ unsigned xb_xcc_id() { return (unsigned)__builtin_amdgcn_s_getreg((3 << 11) | 20) & 0xFu; }
#define XB_SPIN(cond, bar) do { unsigned _sp = 0; while (cond) { __builtin_amdgcn_s_sleep(1); \
    if ((++_sp & 255u) == 0u) { if (xb_ld(&(bar)[XB_TMO])) break; if (_sp > XB_SPIN_CAP) { atomicAdd(&(bar)[XB_TMO], 1u); break; } } } } while (0)

struct XcdBarrier { unsigned* bar; unsigned x; volatile LAS unsigned* st; };

__device__ __forceinline__ XcdBarrier xcd_barrier_post(unsigned* bar, volatile LAS unsigned* st) {
    XcdBarrier b; b.bar = bar; b.x = xb_xcc_id(); b.st = st;
    if (threadIdx.x == 0) (void)xb_add(&bar[XB_XCNT(b.x)], 1u);
    return b;
}
__device__ __forceinline__ void xcd_barrier_complete(unsigned* bar, unsigned x, unsigned& nloc, unsigned& nx) {
    const unsigned G = gridDim.x * gridDim.y * gridDim.z;
    unsigned sum, cnt, mine, sp = 0u;
    for (;;) {
        sum = 0u; cnt = 0u; mine = 0u;
#pragma unroll
        for (unsigned j = 0; j < 16; ++j) { const unsigned c = xb_ld(&bar[XB_XCNT(j)]); sum += c; cnt += (c > 0u) ? 1u : 0u; mine = (j == x) ? c : mine; }
        if (sum == G) break;
        __builtin_amdgcn_s_sleep(1);
        if ((++sp & 255u) == 0u) { if (xb_ld(&bar[XB_TMO])) break; if (sp > XB_SPIN_CAP) { atomicAdd(&bar[XB_TMO], 1u); break; } }
    }
    nloc = mine > 0u ? mine : 1u; nx = cnt > 0u ? cnt : 1u;
}
__device__ __forceinline__ void xcd_barrier(const XcdBarrier& b) {
    asm volatile("s_waitcnt vmcnt(0)" ::: "memory");
    __syncthreads();
    if (threadIdx.x == 0) {
        unsigned* bar = b.bar;
        __builtin_amdgcn_s_waitcnt(0);
        unsigned nloc = b.st[0], nx = b.st[1];
        if (nloc == 0u) { xcd_barrier_complete(bar, b.x, nloc, nx); b.st[0] = nloc; b.st[1] = nx; }
        const unsigned old = xb_add(&bar[XB_XSUB(b.x)], 1u);
        const unsigned gen = old / nloc;
        if (old + 1u == (gen + 1u) * nloc) {
            __builtin_amdgcn_fence(__ATOMIC_RELEASE, "agent");
            asm volatile("s_waitcnt vmcnt(0)" ::: "memory");
            const unsigned og = xb_add(&bar[XB_TOP], 1u);
            const unsigned tg = og / nx;
            if (og + 1u == (tg + 1u) * nx) xb_add(&bar[XB_TOPGEN], 1u);
            else XB_SPIN(xb_ld(&bar[XB_TOPGEN]) == tg, bar);
            __builtin_amdgcn_fence(__ATOMIC_ACQUIRE, "agent");
            xb_add(&bar[XB_XGEN(b.x)], 1u);
            asm volatile("s_waitcnt vmcnt(0)" ::: "memory");
        } else {
            XB_SPIN(xb_ld(&bar[XB_XGEN(b.x)]) == gen, bar);
            __builtin_amdgcn_fence(__ATOMIC_ACQUIRE, "agent");
            asm volatile("s_waitcnt vmcnt(0)" ::: "memory");
        }
    }
    __syncthreads();
}

#ifndef DIAG_SLOT_D
#define DIAG_SLOT_D (-1)
#endif
#ifndef DIAG_DIV
#define DIAG_DIV 1.0f
#endif
constexpr size_t WS_DIAG = 3 * MiB + 900 * 1024;
#define DG_START(k, var) unsigned var = 0; if (DIAG_SLOT_D == (k)) var = (unsigned)__builtin_amdgcn_s_memtime();
#define DG_STOP(k, var, acc) if (DIAG_SLOT_D == (k)) acc += (unsigned)__builtin_amdgcn_s_memtime() - var;
#define DG_WRITE(k, cond, acc) if (DIAG_SLOT_D == (k) && (cond)) ((unsigned*)(F.ws + WS_DIAG))[0] = acc;
struct Args { const float* in[31]; float* out; unsigned char* ws; int ph_lo, ph_hi; int dup_phase, qdup, rep_scan, rep_thr; };
struct Frame {
    LAS unsigned char* lds;
    int tid, lane, wave, vcu, G;
    const float* const __attribute__((address_space(4)))* in;
    float* out; unsigned char* ws;
};
enum { I_X = 0, I_F1N, I_F1G, I_F1U, I_F1D, I_MIXN, I_WIN, I_WOUT, I_MU, I_W0, I_W2, I_A0, I_A2, I_G2, I_KK, I_KA, I_RK, I_LNW, I_LNB, I_VRW, I_VRMU, I_V0, I_V2, I_KVN, I_WUK, I_WUV, I_F2N, I_F2G, I_F2U, I_F2D, I_FN };

__device__ __forceinline__ void conv_item(const Frame& F, int l, int kind, int item, LAS float* scr) {
    const int lane = F.lane;
    int Kd, nkb; bf16* WT;
    if (kind == 0 || kind == 4) { Kd = 1024; WT = (bf16*)(F.ws + (kind == 0 ? WS_WGU1 : WS_WGU2)); }
    else if (kind == 1 || kind == 5) { Kd = FFP; WT = (bf16*)(F.ws + (kind == 1 ? WS_WD1 : WS_WD2)); }
    else if (kind == 2) { Kd = 1024; WT = (bf16*)(F.ws + WS_WIN); }
    else { Kd = 1024; WT = (bf16*)(F.ws + WS_WOUT); }
    nkb = Kd / 64;
    const int rb = item / nkb, kb = item % nkb, r0 = rb * 32, k0 = kb * 64;
    const int n4 = (lane & 7) * 4, kr = lane >> 3;
    const int rr = r0 + n4;
    const float* src = nullptr; int ns = 0, col = 0, ksrc = 1024; const float* gain = nullptr; float scale = 1.0f;
    if (kind == 0 || kind == 4) {
        const int tile = rr >> 8, w = rr & 255, hid = tile * 128 + (w & 127);
        if (hid < FF) { const float* s1 = (w >> 7) ? F.in[I_F1U] : F.in[I_F1G]; const float* s2 = (w >> 7) ? F.in[I_F2U] : F.in[I_F2G]; src = ((kind == 0) ? s1 : s2) + (size_t)l * 1024 * FF; ns = FF; col = hid; }
        gain = ((kind == 0) ? F.in[I_F1N] : F.in[I_F2N]) + l * 1024;
    } else if (kind == 1 || kind == 5) {
        src = ((kind == 1) ? F.in[I_F1D] : F.in[I_F2D]) + (size_t)l * FF * 1024; ns = 1024; col = rr; ksrc = FF; scale = 0.5f;
    } else if (kind == 2) {
        gain = F.in[I_MIXN] + l * 1024;
        if (rr < 1280) { src = F.in[I_WIN] + (size_t)l * 1024 * NIN; ns = NIN; col = rr; }
        else if (rr < 1296) { if (l > 0) { src = F.in[I_VRW] + (size_t)(l - 1) * 1024 * 16; ns = 16; col = rr - 1280; } }
        else if (rr < PUSED) { src = F.in[I_WIN] + (size_t)l * 1024 * NIN; ns = NIN; col = rr - 16; }
    } else { src = F.in[I_WOUT] + (size_t)l * 1024 * 1024; ns = 1024; col = rr; }
    {
        const bool has = (src != nullptr); const float* sp = has ? src : F.in[I_FN]; const int nss = has ? ns : 0, cols = has ? col : 0;
        f32x4 vals[8];
#pragma unroll
        for (int i = 0; i < 8; ++i) { const int k = k0 + 8 * i + kr; const int kc = k < ksrc ? k : ksrc - 1; vals[i] = *(const GAS f32x4*)(sp + (size_t)kc * nss + cols); }
#pragma unroll
        for (int i = 0; i < 8; ++i) { const int kk = 8 * i + kr, k = k0 + kk; float g = (has && k < ksrc) ? scale : 0.f; if (gain) g *= gain[k < 1024 ? k : 1023];
            LAS float* d = scr + kk * 33 + n4; d[0] = vals[i][0] * g; d[1] = vals[i][1] * g; d[2] = vals[i][2] * g; d[3] = vals[i][3] * g; }
    }
    LDS_WAIT(); asm volatile("" ::: "memory");
    const int c = lane & 7;
#pragma unroll
    for (int j = 0; j < 4; ++j) { const int n = (lane >> 3) + 8 * j; const LAS float* s = scr + (8 * c) * 33 + n;
        v4u o; o.x = pk2(s[0 * 33], s[1 * 33]); o.y = pk2(s[2 * 33], s[3 * 33]); o.z = pk2(s[4 * 33], s[5 * 33]); o.w = pk2(s[6 * 33], s[7 * 33]);
        *(GAS v4u*)(WT + (size_t)(r0 + n) * Kd + k0 + 8 * c) = o; }
    LDS_WAIT(); asm volatile("" ::: "memory");
}
__host__ __device__ constexpr int conv_items(int kind) { return (kind == 0 || kind == 4) ? (NGU / 32) * 16 : (kind == 1 || kind == 5) ? 32 * (FFP / 64) : (kind == 2) ? (PP / 32) * 16 : 32 * 16; }
__device__ __forceinline__ void conv_weights(const Frame& F, int l, int k_lo, int k_hi) {
    LAS float* scr = (LAS float*)(F.lds + F.wave * 16384);
    const int gw = F.vcu * NWAVES + F.wave, NGW = F.G * NWAVES;
    for (int kind = k_lo; kind < k_hi; ++kind) { const int ni = conv_items(kind);
        for (int it = gw; it < ni; it += NGW) conv_item(F, l, kind, it, scr); }
}

__host__ __device__ constexpr int conv_flat_items(bool has_next) { return conv_items(3) + conv_items(4) + conv_items(5) + (has_next ? conv_items(0) + conv_items(1) + conv_items(2) : 0); }
constexpr int CONV_PER_WAVE = 2;
__device__ __forceinline__ void conv_unit(const Frame& F, int l, int u) {
    LAS float* scr = (LAS float*)(F.lds + F.wave * 16384);
    const bool has_next = (l + 1 < DEPTH);
#pragma unroll 1
    for (int rep = 0; rep < CONV_PER_WAVE; ++rep) {
    int it = (u * CONV_PER_WAVE + rep) * NWAVES + F.wave;
    if (it >= conv_flat_items(has_next)) return;
    int layer = l, kind = 3;
    if (it >= conv_items(3)) { it -= conv_items(3); kind = 4;
        if (it >= conv_items(4)) { it -= conv_items(4); kind = 5;
            if (it >= conv_items(5)) { it -= conv_items(5); kind = 0; layer = l + 1;
                if (it >= conv_items(0)) { it -= conv_items(0); kind = 1;
                    if (it >= conv_items(1)) { it -= conv_items(1); kind = 2; } } } } }
    conv_item(F, layer, kind, it, scr);
    }
}
__device__ __forceinline__ void p0_x(const Frame& F) {
    const int gw = F.vcu * NWAVES + F.wave, NGW = F.G * NWAVES;
    const float* x = F.in[I_X]; bf16* xb = (bf16*)(F.ws + WS_XB); float* part = (float*)(F.ws + WS_PART);
    for (int m = gw; m < M; m += NGW) {
        const GAS f32x4* xr = (const GAS f32x4*)(x + (size_t)m * DM) + F.lane; float s = 0.f;
        GAS unsigned long long* o8 = (GAS unsigned long long*)(xb + (size_t)m * DM) + F.lane;
#pragma unroll
        for (int j = 0; j < 4; ++j) { const f32x4 v = xr[64 * j]; s += (v.x * v.x + v.y * v.y) + (v.z * v.z + v.w * v.w);
            o8[64 * j] = (unsigned long long)pk2(v.x, v.y) | ((unsigned long long)pk2(v.z, v.w) << 32); }
        s = wave_sum(s);
        if (F.lane < 16) part[(size_t)m * 16 + F.lane] = (F.lane == 0) ? s : 0.f;
    }
}
__device__ __forceinline__ void p0_table(const Frame& F) {
    float* tab = (float*)(F.ws + WS_TAB);
    for (int i = F.vcu * NTHR + F.tid; i < SEQ * 32; i += F.G * NTHR) { const int t = i >> 5, f = i & 31; const float th = exp2f(-(float)f * (13.287712379549449f / 31.0f)); const float ang = (float)t * th; float s, c; sincosf(ang, &s, &c); tab[2 * i] = c; tab[2 * i + 1] = s; }
}

__device__ __forceinline__ void ret_kv_unit(const Frame& F, int unit) {
    unsigned dga_ = 0;
    DG_START(30, dg30_)
    LAS float* kr = (LAS float*)F.lds; LAS float* vv = kr + 128 * 64;
    const int tid = F.tid, c = unit & 15, h = (unit >> 4) & 3, b = unit >> 6, tok0 = b * SEQ + c * 128;
    const bf16* P = (const bf16*)(F.ws + WS_P); const float* tab = (const float*)(F.ws + WS_TAB);
    const float lg2 = log2f(1.0f - exp2f(-5.0f - (float)h));
    for (int idx = tid; idx < 128 * 32; idx += NTHR) { const int m = idx >> 5, i = idx & 31; const size_t ro = (size_t)(tok0 + m) * PP;
        const float k1 = bf2f(P[ro + PCK + h * 64 + i]), k2 = bf2f(P[ro + PCK + h * 64 + 32 + i]);
        const float cs = tab[((c * 128 + m) * 32 + i) * 2], sn = tab[((c * 128 + m) * 32 + i) * 2 + 1];
        const float sc = 0.125f * exp2f((float)(127 - m) * lg2);
        kr[m * 64 + i] = (k1 * cs - k2 * sn) * sc; kr[m * 64 + 32 + i] = (k1 * sn + k2 * cs) * sc;
        vv[m * 64 + i] = bf2f(P[ro + PCV + h * 64 + i]); vv[m * 64 + 32 + i] = bf2f(P[ro + PCV + h * 64 + 32 + i]); }
    __syncthreads();
    const int d = tid >> 3, e0 = (tid & 7) * 8; float acc[8];
#pragma unroll
    for (int e = 0; e < 8; ++e) acc[e] = 0.f;
    for (int m = 0; m < 128; ++m) { const float kd = kr[m * 64 + d];
#pragma unroll
        for (int e = 0; e < 8; ++e) acc[e] += kd * vv[m * 64 + e0 + e]; }
    float* KV = (float*)(F.ws + WS_KV) + (size_t)unit * 4096 + d * 64 + e0;
#pragma unroll
    for (int e = 0; e < 8; ++e) KV[e] = acc[e];
    __syncthreads();
    DG_STOP(30, dg30_, dga_)
    DG_WRITE(30, unit == 0 && F.wave == 0 && F.lane == 0, dga_)
}

typedef float f32x2 __attribute__((ext_vector_type(2)));
__device__ __forceinline__ float dpp_add16(float x) {
    x += __builtin_bit_cast(float, __builtin_amdgcn_mov_dpp(__builtin_bit_cast(int, x), 0xB1, 0xF, 0xF, true));
    x += __builtin_bit_cast(float, __builtin_amdgcn_mov_dpp(__builtin_bit_cast(int, x), 0x4E, 0xF, 0xF, true));
    x += __builtin_bit_cast(float, __builtin_amdgcn_mov_dpp(__builtin_bit_cast(int, x), 0x141, 0xF, 0xF, true));
    x += __builtin_bit_cast(float, __builtin_amdgcn_mov_dpp(__builtin_bit_cast(int, x), 0x140, 0xF, 0xF, true));
    return x;
}
constexpr int CH = 32;
constexpr int RW_STG = 5 * CH * 64;
constexpr int RW_ROWS = 16;
struct RwOps { f32x4 r, d, k, q, b; float v; };
__device__ __forceinline__ void rw_ld(RwOps& o, const LAS float* base, const LAS float* vb, int s, int ks, int row) {
    const LAS f32x4* p = (const LAS f32x4*)(base + s * 64 + ks * 4);
    o.r = p[0]; o.d = p[CH * 16]; o.k = p[2 * CH * 16]; o.q = p[3 * CH * 16]; o.b = p[4 * CH * 16];
    o.v = vb[s * RW_ROWS + row];
}
#define LO2(x) __builtin_shufflevector(x, x, 0, 1)
#define HI2(x) __builtin_shufflevector(x, x, 2, 3)
__device__ __forceinline__ float rw_step1(f32x2 (&S)[2], const RwOps& o, float v) {
    f32x2 p2 = S[0] * LO2(o.q); p2 = S[1] * HI2(o.q) + p2;
    const float p = dpp_add16(p2.x + p2.y);
    const f32x2 pp = (f32x2){p, p}, vv = (f32x2){v, v};
    S[0] = S[0] - LO2(o.d) * S[0]; S[1] = S[1] - HI2(o.d) * S[1];
    S[0] = S[0] - pp * LO2(o.b); S[1] = S[1] - pp * HI2(o.b);
    S[0] = vv * LO2(o.k) + S[0]; S[1] = vv * HI2(o.k) + S[1];
    f32x2 y2 = S[0] * LO2(o.r); y2 = S[1] * HI2(o.r) + y2;
    return dpp_add16(y2.x + y2.y);
}
__device__ __forceinline__ void rwkv_scan_unit(const Frame& F, int l, int unit) {
    const int tid = F.tid, lane = F.lane, wave = F.wave, quarter = unit & 3, bh = unit >> 2, b = bh / 6, h = bh - b * 6, tokb = b * SEQ;
    LAS float* stg = (LAS float*)F.lds; LAS float* vst = stg + 2 * RW_STG; LAS float* ybuf = vst + 2 * CH * RW_ROWS;
    bf16* P = (bf16*)(F.ws + WS_P);
    constexpr int NCH = SEQ / CH;
    unsigned dga_ = 0;
    if (wave >= 4) {
        const int st = tid - 256;
        const int t01 = st >> 3, c01 = st & 7, tv = st >> 1, cv = st & 1;
        const bf16* a0 = (const bf16*)(F.ws + WS_R); const bf16* a1 = (const bf16*)(F.ws + WS_D); const bf16* a2 = (const bf16*)(F.ws + WS_K2); const bf16* a3 = (const bf16*)(F.ws + WS_KK);
        const bf16* a4 = (const bf16*)((const unsigned char*)F.out + OUT_BP); const bf16* a5 = (const bf16*)(F.ws + WS_VF);
        v4u sreg[6];
#define RW_LOAD(cc) do { const size_t o_ = (size_t)(tokb + (cc) * CH + t01) * AW + h * 64 + c01 * 8; sreg[0] = *(const GAS v4u*)(a0 + o_); sreg[1] = *(const GAS v4u*)(a1 + o_); sreg[2] = *(const GAS v4u*)(a2 + o_); \
            sreg[3] = *(const GAS v4u*)(a3 + o_); sreg[4] = *(const GAS v4u*)(a4 + o_); if (st < 64) sreg[5] = *(const GAS v4u*)(a5 + (size_t)(tokb + (cc) * CH + tv) * AW + h * 64 + quarter * RW_ROWS + cv * 8); } while (0)
#define RW_ST1(i, dstp) do { float f[8]; unpack8(sreg[i], f); LAS f32x4* dst = (LAS f32x4*)(dstp); dst[0] = (f32x4){f[0], f[1], f[2], f[3]}; dst[1] = (f32x4){f[4], f[5], f[6], f[7]}; } while (0)
#define RW_STORE(bufi) do { _Pragma("unroll") for (int i = 0; i < 5; ++i) RW_ST1(i, stg + (bufi) * RW_STG + i * CH * 64 + t01 * 64 + c01 * 8); if (st < 64) RW_ST1(5, vst + (bufi) * CH * RW_ROWS + tv * RW_ROWS + cv * 8); } while (0)
#define RW_OUT(cc) do { if (st < 128) { const LAS float* yb_ = ybuf + ((cc) & 1) * CH * RW_ROWS; const int s_ = st >> 2, r4_ = (st & 3) * 4; const f32x4 yv = *(const LAS f32x4*)(yb_ + s_ * RW_ROWS + r4_); \
            *(GAS unsigned long long*)(P + (size_t)(tokb + (cc) * CH + s_) * PP + h * 64 + quarter * RW_ROWS + r4_) = (unsigned long long)pk2(yv[0], yv[1]) | ((unsigned long long)pk2(yv[2], yv[3]) << 32); } } while (0)
        RW_LOAD(0); RW_STORE(0); RW_LOAD(1);
        __syncthreads();
        for (int cc = 0; cc < NCH; ++cc) {
            if (cc + 1 < NCH) RW_STORE((cc + 1) & 1);
            if (cc + 2 < NCH) RW_LOAD(cc + 2);
            if (cc > 0) RW_OUT(cc - 1);
            asm volatile("s_waitcnt lgkmcnt(0)" ::: "memory"); __builtin_amdgcn_s_barrier(); asm volatile("" ::: "memory");
        }
        RW_OUT(NCH - 1);
#undef RW_LOAD
#undef RW_ST1
#undef RW_STORE
#undef RW_OUT
        return;
    }
    const int row = 4 * wave + (lane >> 4), ks = lane & 15;
    f32x2 Sa[2] = {(f32x2){0.f, 0.f}, (f32x2){0.f, 0.f}};
    __syncthreads();
    for (int cc = 0; cc < NCH; ++cc) {
        const int bufi = cc & 1;
        const LAS float* base = stg + bufi * RW_STG; const LAS float* vb = vst + bufi * CH * RW_ROWS; LAS float* yb = ybuf + bufi * CH * RW_ROWS;
        RwOps A, B; float yk0 = 0.f;
        DG_START(40, dg40_)
        rw_ld(A, base, vb, 0, ks, row);
#pragma unroll
        for (int s = 0; s < CH; s += 2) {
            rw_ld(B, base, vb, s + 1, ks, row);
            { const float y0 = rw_step1(Sa, A, A.v); yk0 = (ks == (s & 15)) ? y0 : yk0; }
            if (s + 2 < CH) rw_ld(A, base, vb, s + 2, ks, row);
            { const float y0 = rw_step1(Sa, B, B.v); yk0 = (ks == ((s + 1) & 15)) ? y0 : yk0; }
            if (((s + 1) & 15) == 15) yb[(s - 14 + ks) * RW_ROWS + row] = yk0;
        }
        DG_STOP(40, dg40_, dga_)
        DG_START(43, dg43_)
        asm volatile("s_waitcnt lgkmcnt(0)" ::: "memory"); __builtin_amdgcn_s_barrier(); asm volatile("" ::: "memory");
        DG_STOP(43, dg43_, dga_)
    }
    DG_WRITE(40, unit == 0 && l == 0 && wave == 0 && lane == 0, dga_)
    DG_WRITE(43, unit == 0 && l == 0 && wave == 0 && lane == 0, dga_)
}
__device__ __forceinline__ void rwkv_post(const Frame& F, int l) {
    bf16* P = (bf16*)(F.ws + WS_P); const bf16* VF = (const bf16*)(F.ws + WS_VF); const bf16* Gg = (const bf16*)((const unsigned char*)F.out + OUT_G); const float* BON = (const float*)(F.ws + WS_BON);
    const int sub = F.tid >> 4, c4 = (F.tid & 15) * 4;
    for (int pr = F.vcu * 32 + sub; pr < M * 6; pr += F.G * 32) { const int tok = pr / 6, h = pr - tok * 6;
        const unsigned long long yw = *(const GAS unsigned long long*)(P + (size_t)tok * PP + h * 64 + c4), vw = *(const GAS unsigned long long*)(VF + (size_t)tok * AW + h * 64 + c4), gw = *(const GAS unsigned long long*)(Gg + (size_t)tok * AW + h * 64 + c4);
        const f32x4 lnw = *(const f32x4*)(F.in[I_LNW] + l * AW + h * 64 + c4), lnb = *(const f32x4*)(F.in[I_LNB] + l * AW + h * 64 + c4);
        const float bon = BON[(size_t)tok * 6 + h];
        const f32x4 yv = (f32x4){bflo((unsigned)yw), bfhi((unsigned)yw), bflo((unsigned)(yw >> 32)), bfhi((unsigned)(yw >> 32))};
        const f32x4 vv = (f32x4){bflo((unsigned)vw), bfhi((unsigned)vw), bflo((unsigned)(vw >> 32)), bfhi((unsigned)(vw >> 32))};
        const f32x4 gg = (f32x4){bflo((unsigned)gw), bfhi((unsigned)gw), bflo((unsigned)(gw >> 32)), bfhi((unsigned)(gw >> 32))};
        float sm = (yv[0] + yv[1]) + (yv[2] + yv[3]);
        sm += __shfl_xor(sm, 1); sm += __shfl_xor(sm, 2); sm += __shfl_xor(sm, 4); sm += __shfl_xor(sm, 8);
        const float mean = sm * (1.0f / 64.0f); const f32x4 dv = yv - mean;
        float vs = (dv[0] * dv[0] + dv[1] * dv[1]) + (dv[2] * dv[2] + dv[3] * dv[3]);
        vs += __shfl_xor(vs, 1); vs += __shfl_xor(vs, 2); vs += __shfl_xor(vs, 4); vs += __shfl_xor(vs, 8);
        const float rs = 1.0f / sqrtf(vs * (1.0f / 64.0f) + 64e-5f);
        const f32x4 o = (dv * rs * lnw + lnb + bon * vv) * gg;
        *(GAS unsigned long long*)(P + (size_t)tok * PP + h * 64 + c4) = (unsigned long long)pk2(o[0], o[1]) | ((unsigned long long)pk2(o[2], o[3]) << 32);
    }
}

typedef short bf16x8_t __attribute__((ext_vector_type(8)));
typedef short s16x4_t __attribute__((ext_vector_type(4)));
typedef float f32x16_t __attribute__((ext_vector_type(16)));
__device__ __forceinline__ unsigned fkey(float f) { const unsigned u = __float_as_uint(f); return (u & 0x80000000u) ? ~u : (u | 0x80000000u); }
__device__ __forceinline__ int crow32(int r, int hi) { return (r & 3) + 8 * (r >> 2) + 4 * hi; }
__device__ __forceinline__ unsigned off_a(unsigned row, unsigned ch) { return 2048u * (row >> 3) + 512u * (ch >> 2) + 64u * (row & 7) + 16u * ((ch & 3) ^ ((row >> 2) & 3)); }

__device__ __forceinline__ void idx_scores(const bf16x8_t (&Af)[2], const bf16x8_t (&Bf)[8][2], const float (&iwf)[8], float (&sc)[4]) {
    sc[0] = sc[1] = sc[2] = sc[3] = 0.f;
#pragma unroll
    for (int h = 0; h < 8; ++h) { f32x4 a = (f32x4){0.f, 0.f, 0.f, 0.f};
        a = __builtin_amdgcn_mfma_f32_16x16x32_bf16(Af[0], Bf[h][0], a, 0, 0, 0);
        a = __builtin_amdgcn_mfma_f32_16x16x32_bf16(Af[1], Bf[h][1], a, 0, 0, 0);
#pragma unroll
        for (int r = 0; r < 4; ++r) { const float av_ = a[r]; const int ai_ = __float_as_int(av_); const float rl = __int_as_float(ai_ > 0 ? ai_ : 0); sc[r] = fmaf(iwf[h], rl, sc[r]); } }
}
__device__ __forceinline__ void idx_load_q(const bf16* P, int tokq, bf16x8_t (&Bf)[8][2], float (&iwf)[8], int fq) {
    const bf16* row = P + (size_t)tokq * PP;
#pragma unroll
    for (int h = 0; h < 8; ++h)
#pragma unroll
        for (int ks = 0; ks < 2; ++ks) Bf[h][ks] = *(const GAS bf16x8_t*)(row + PBIQ + h * 64 + ks * 32 + fq * 8);
    const v4u w = *(const GAS v4u*)(row + PBIW); float f[8]; unpack8(w, f);
#pragma unroll
    for (int h = 0; h < 8; ++h) iwf[h] = f[h] * (0.35355339059327373f * 0.125f);
}

__device__ __forceinline__ void lds_barrier() { asm volatile("s_waitcnt lgkmcnt(0)" ::: "memory"); __builtin_amdgcn_s_barrier(); asm volatile("" ::: "memory"); }
constexpr int SKP = 2052;
__device__ __forceinline__ void dsa_thr_unit(const Frame& F, int unit) {
    LAS unsigned* sk = (LAS unsigned*)F.lds;
    const int lane = F.lane, wave = F.wave, fr = lane & 15, fq = lane >> 4;
    const int b = unit & 7, qb = 127 - (unit >> 3), t0 = qb * 16, tok0 = b * SEQ + t0;
    const bf16* P = (const bf16*)(F.ws + WS_P);
    unsigned dga_ = 0;
    DG_START(10, dg10_)
    {
        bf16x8_t Bf[8][2]; float iwf[8];
        idx_load_q(P, tok0 + fr, Bf, iwf, fq);
        bf16x8_t An[2];
        { const int kt0 = wave <= qb ? wave : qb; const bf16* krow = P + (size_t)(b * SEQ + kt0 * 16 + fr) * PP + PBIK + fq * 8; An[0] = *(const GAS bf16x8_t*)(krow); An[1] = *(const GAS bf16x8_t*)(krow + 32); }
        for (int kt = wave; kt <= qb; kt += 8) {
            bf16x8_t Af[2]; Af[0] = An[0]; Af[1] = An[1];
            { const int ktn = kt + 8 <= qb ? kt + 8 : qb; const bf16* krow = P + (size_t)(b * SEQ + ktn * 16 + fr) * PP + PBIK + fq * 8; An[0] = *(const GAS bf16x8_t*)(krow); An[1] = *(const GAS bf16x8_t*)(krow + 32); }
            float sc[4]; idx_scores(Af, Bf, iwf, sc);
            v4u kv;
            const int s0 = kt * 16 + 4 * fq, t = t0 + fr;
            kv.x = (s0 + 0 <= t) ? fkey(sc[0]) : 0u; kv.y = (s0 + 1 <= t) ? fkey(sc[1]) : 0u; kv.z = (s0 + 2 <= t) ? fkey(sc[2]) : 0u; kv.w = (s0 + 3 <= t) ? fkey(sc[3]) : 0u;
            *(LAS v4u*)(sk + fr * SKP + s0) = kv;
        }
    }
    __syncthreads();
    DG_STOP(10, dg10_, dga_)
    DG_WRITE(10, unit == 0 && wave == 0 && lane == 0, dga_)
    DG_START(11, dg11_)
    unsigned* THR = (unsigned*)(F.ws + WS_THR); int* SCUT = (int*)(F.ws + WS_SCUT);
    for (int qi = 0; qi < 2; ++qi) { const int q = 2 * wave + qi, t = t0 + q, n = t + 1;
        unsigned thr = 0u; int scut = SEQ - 1;
        if (n > TOPK) {
            unsigned keys[32];
#pragma unroll
            for (int i = 0; i < 32; ++i) keys[i] = (64 * i + lane <= t) ? sk[q * SKP + 64 * i + lane] : 0u;
            unsigned prefix = 0u; bool done = false;
            const int ng = (t >> 9) + 1;
            for (int bit = 31; bit >= 0; --bit) { const unsigned cand = prefix | (1u << bit); int cnt = 0;
#pragma unroll
                for (int g = 0; g < 4; ++g) if (g < ng) {
#pragma unroll
                    for (int i = 8 * g; i < 8 * g + 8; ++i) cnt += __popcll(__ballot(keys[i] >= cand)); }
                if (cnt >= TOPK) prefix = cand;
                if (cnt == TOPK) { thr = cand - 1u; scut = -1; done = true; break; } }
            if (!done) {
                int cgt = 0;
#pragma unroll
                for (int i = 0; i < 32; ++i) cgt += __popcll(__ballot(keys[i] > prefix));
                int need = TOPK - cgt, run = 0; thr = prefix; scut = SEQ - 1; bool found = false;
#pragma unroll
                for (int i = 0; i < 32; ++i) { unsigned long long mk = __ballot(keys[i] == prefix); const int c = __popcll(mk);
                    if (!found && run + c >= need) { int k = need - run; while (k > 1) { mk &= mk - 1ull; --k; } scut = 64 * i + (int)__builtin_ctzll(mk); found = true; }
                    run += c; }
            }
        }
        {
            unsigned* MK = (unsigned*)((unsigned char*)F.out + OUT_MASK) + (size_t)(tok0 + q) * 64;
            if (n > TOPK) {
#pragma unroll
                for (int i = 0; i < 32; ++i) { const int s = 64 * i + lane; const unsigned key = (s <= t) ? sk[q * SKP + s] : 0u;
                    const unsigned long long bal = __ballot((s <= t) & ((key > thr) | ((key == thr) & (s <= scut))));
                    if (lane < 2 && 64 * i <= t) MK[2 * i + lane] = lane ? (unsigned)(bal >> 32) : (unsigned)bal; }
            } else {
                if (lane < 8) { const int w0 = lane; MK[w0] = (32 * w0 + 31 <= t) ? 0xffffffffu : ((32 * w0 <= t) ? ((1u << ((t & 31) + 1)) - 1u) : 0u); }
            }
        }
    }
    DG_STOP(11, dg11_, dga_)
    DG_WRITE(11, unit == 0 && wave == 0 && lane == 0, dga_)
    __syncthreads();
}

constexpr int QLP = 136;
constexpr int MKP = 36;
constexpr int DA_MASK = 0, DA_QL = 2 * 32 * MKP * 4, DA_CT = DA_QL + 6 * 32 * QLP * 2;
__device__ __forceinline__ void dsa_attn_unit(const Frame& F, int l, int unit) {
    const int tid = F.tid, lane = F.lane, wave = F.wave, r32 = lane & 31, hi = lane >> 5;
    const int b = unit & 7, qb = 63 - (unit >> 3), t0 = qb * 32, tok0 = b * SEQ + t0, ntile = qb + 1;
    bf16* P = (bf16*)(F.ws + WS_P); const bf16* C = (const bf16*)(F.ws + WS_C);
    LAS float* MASK = (LAS float*)(F.lds + DA_MASK); LAS unsigned char* QLb = F.lds + DA_QL; LAS unsigned char* CT = F.lds + DA_CT;
    const int crow_ = tid >> 4, cch = tid & 15; const unsigned cdst = off_a((unsigned)crow_, (unsigned)cch);
    const bf16* csrc = C + (size_t)(b * SEQ + crow_) * 128 + cch * 8;
    v4u cpre = *(const GAS v4u*)(csrc);
    if (wave >= 6) {
        const int fr = lane & 15, fq = lane >> 4, qh = wave - 6;
        const int tq = tok0 + 16 * qh + fr, tq_t = t0 + 16 * qh + fr, jmax = tq_t >> 5;
        const unsigned* MK = (const unsigned*)((const unsigned char*)F.out + OUT_MASK) + (size_t)tq * 64;
        LAS float* mrow = MASK + (16 * qh + fr) * MKP + 8 * fq;
#define DA_EXPAND(word, slot) do { const unsigned w_ = (word) >> (8 * fq); f32x4 m0_, m1_; \
            m0_[0] = (w_ & 1u) ? 0.f : -1e30f; m0_[1] = (w_ & 2u) ? 0.f : -1e30f; m0_[2] = (w_ & 4u) ? 0.f : -1e30f; m0_[3] = (w_ & 8u) ? 0.f : -1e30f; \
            m1_[0] = (w_ & 16u) ? 0.f : -1e30f; m1_[1] = (w_ & 32u) ? 0.f : -1e30f; m1_[2] = (w_ & 64u) ? 0.f : -1e30f; m1_[3] = (w_ & 128u) ? 0.f : -1e30f; \
            *(LAS f32x4*)(mrow + (slot) * (32 * MKP)) = m0_; *(LAS f32x4*)(mrow + (slot) * (32 * MKP) + 4) = m1_; } while (0)
        unsigned w0 = MK[0], w1 = (1 <= jmax) ? MK[1] : 0u, w2 = (2 <= jmax) ? MK[2] : 0u;
        DA_EXPAND(w0, 0);
        *(LAS v4u*)(CT + cdst) = cpre;
        lds_barrier();
        for (int j = 0; j < ntile; ++j) {
            if (j + 1 < ntile) {
                cpre = *(const GAS v4u*)(csrc + (size_t)(j + 1) * 32 * 128);
                DA_EXPAND(w1, (j + 1) & 1);
                w1 = w2; w2 = (j + 3 <= jmax) ? MK[j + 3] : 0u;
                *(LAS v4u*)(CT + ((j + 1) & 1) * 8192 + cdst) = cpre; }
            lds_barrier();
        }
#undef DA_EXPAND
        lds_barrier();
        return;
    }
    const int h = wave;
    LAS unsigned char* QLh = QLb + h * (32 * QLP * 2);
    float negb;
    {
        unsigned zo_ = 0u; asm volatile("" : "+v"(zo_));
        const bf16* wukT = (const bf16*)(F.ws + WS_WUKT) + (size_t)(l * 6 + h) * 128 * 64 + zo_;
        bf16x8_t qf[4]; float ssq = 0.f;
#pragma unroll
        for (int ks = 0; ks < 4; ++ks) qf[ks] = *(const GAS bf16x8_t*)(P + (size_t)(tok0 + r32) * PP + PBQ + h * 64 + ks * 16 + hi * 8);
#pragma unroll
        for (int blk = 0; blk < 4; ++blk) { f32x16_t x;
#pragma unroll
            for (int i = 0; i < 16; ++i) x[i] = 0.f;
#pragma unroll
            for (int ks = 0; ks < 4; ++ks) { const bf16x8_t a = *(const GAS bf16x8_t*)(wukT + (size_t)(blk * 32 + r32) * 64 + ks * 16 + hi * 8); x = __builtin_amdgcn_mfma_f32_32x32x16_bf16(a, qf[ks], x, 0, 0, 0); }
#pragma unroll
            for (int g = 0; g < 4; ++g) { const float sc = 0.125f * 1.4426950408889634f;
                const float x0 = x[4 * g] * sc, x1 = x[4 * g + 1] * sc, x2 = x[4 * g + 2] * sc, x3 = x[4 * g + 3] * sc; ssq += (x0 * x0 + x1 * x1) + (x2 * x2 + x3 * x3);
                const unsigned long long w = (unsigned long long)pk2(x0, x1) | ((unsigned long long)pk2(x2, x3) << 32);
                *(LAS unsigned long long*)(QLh + (r32 * QLP + blk * 32 + 8 * g + 4 * hi) * 2) = w; } }
        ssq += __shfl_xor(ssq, 32);
        const float* kvn = F.in[I_KVN] + l * 128; float gm = fmaxf(fabsf(kvn[2 * lane]), fabsf(kvn[2 * lane + 1]));
#pragma unroll
        for (int o_ = 1; o_ < 64; o_ <<= 1) gm = fmaxf(gm, __shfl_xor(gm, o_));
        negb = -(sqrtf(ssq) * 11.32f * gm * 1.01f + 0.01f);
    }
    *(LAS v4u*)(CT + cdst) = cpre;
    lds_barrier();
    f32x16_t o[4]; float l_run = 0.f;
    const LAS unsigned char* qlrow = QLh + (r32 * QLP + 8 * hi) * 2;
#pragma unroll
    for (int c = 0; c < 4; ++c)
#pragma unroll
        for (int i = 0; i < 16; ++i) o[c][i] = 0.f;
    const unsigned rr_ = ((unsigned)r32 >> 2) & 3u, rb_ = 2048u * ((unsigned)r32 >> 3) + 64u * ((unsigned)r32 & 7u);
    const unsigned rbase0 = rb_ + 16u * ((unsigned)hi ^ rr_), rbase1 = rb_ + 16u * ((2u + (unsigned)hi) ^ rr_);
    const unsigned blk_ = (lane >> 4) & 1, q_ = (lane & 15) >> 2, p_ = lane & 3;
    unsigned dga_ = 0;
    for (int j = 0; j < ntile; ++j) {
        DG_START(0, dgt_)
        LAS unsigned char* kb = CT + (j & 1) * 8192;
        if (j + 1 < ntile) cpre = *(const GAS v4u*)(csrc + (size_t)(j + 1) * 32 * 128);
        {
            f32x16_t S;
#pragma unroll
            for (int i = 0; i < 16; ++i) S[i] = negb;
#pragma unroll
            for (int s = 0; s < 8; ++s) { const bf16x8_t a = *(const LAS bf16x8_t*)(kb + ((s & 1) ? rbase1 : rbase0) + 512 * (s >> 1)); const bf16x8_t bq = *(const LAS bf16x8_t*)(qlrow + 32 * s);
                S = __builtin_amdgcn_mfma_f32_32x32x16_bf16(a, bq, S, 0, 0, 0); }
            const LAS f32x4* mk = (const LAS f32x4*)(MASK + (j & 1) * (32 * MKP) + r32 * MKP + 4 * hi);
            float psum = 0.f; float e[16];
#pragma unroll
            for (int g = 0; g < 4; ++g) { const f32x4 mv = mk[2 * g];
#pragma unroll
                for (int e4 = 0; e4 < 4; ++e4) { e[4 * g + e4] = __builtin_amdgcn_exp2f(S[4 * g + e4] + mv[e4]); psum += e[4 * g + e4]; } }
            l_run += psum;
            bf16x8_t xs[2];
#pragma unroll
            for (int s = 0; s < 2; ++s) { v4u w; w.x = pk2(e[8 * s], e[8 * s + 1]); w.y = pk2(e[8 * s + 2], e[8 * s + 3]); w.z = pk2(e[8 * s + 4], e[8 * s + 5]); w.w = pk2(e[8 * s + 6], e[8 * s + 7]); xs[s] = __builtin_bit_cast(bf16x8_t, w); }
#pragma unroll
            for (int c = 0; c < 4; ++c)
#pragma unroll
                for (int s = 0; s < 2; ++s) {
                    const unsigned a0 = off_a((unsigned)(16 * s + 4 * hi + q_), (unsigned)(4 * c + 2 * blk_ + (p_ >> 1))) + 8u * (p_ & 1);
                    const unsigned a1 = off_a((unsigned)(16 * s + 8 + 4 * hi + q_), (unsigned)(4 * c + 2 * blk_ + (p_ >> 1))) + 8u * (p_ & 1);
                    const s16x4_t lo = __builtin_bit_cast(s16x4_t, __builtin_amdgcn_ds_read_tr16_b64_v4i16((LAS s16x4_t*)(kb + a0)));
                    const s16x4_t hh = __builtin_bit_cast(s16x4_t, __builtin_amdgcn_ds_read_tr16_b64_v4i16((LAS s16x4_t*)(kb + a1)));
                    const bf16x8_t a = (bf16x8_t){lo[0], lo[1], lo[2], lo[3], hh[0], hh[1], hh[2], hh[3]};
                    o[c] = __builtin_amdgcn_mfma_f32_32x32x16_bf16(a, xs[s], o[c], 0, 0, 0); }
        }
        if (j + 1 < ntile) *(LAS v4u*)(CT + ((j + 1) & 1) * 8192 + cdst) = cpre;
        DG_STOP(0, dgt_, dga_)
        lds_barrier();
    }
    DG_WRITE(0, unit == 0 && l == 0 && wave == 0 && lane == 0, dga_)
    {
        const float lt = l_run + __shfl_xor(l_run, 32); const float inv = 1.0f / lt;
#pragma unroll
        for (int c = 0; c < 4; ++c)
#pragma unroll
            for (int g = 0; g < 4; ++g) { const unsigned long long w = (unsigned long long)pk2(o[c][4 * g] * inv, o[c][4 * g + 1] * inv) | ((unsigned long long)pk2(o[c][4 * g + 2] * inv, o[c][4 * g + 3] * inv) << 32);
                *(LAS unsigned long long*)(QLh + (r32 * QLP + c * 32 + 8 * g + 4 * hi) * 2) = w; }
        unsigned zo2_ = 0u; asm volatile("" : "+v"(zo2_));
        const bf16* wuvT = (const bf16*)(F.ws + WS_WUVT) + (size_t)(l * 6 + h) * 64 * 128 + zo2_;
        bf16x8_t Bo[8];
#pragma unroll
        for (int s = 0; s < 8; ++s) Bo[s] = *(const LAS bf16x8_t*)(QLh + (r32 * QLP + 16 * s + 8 * hi) * 2);
#pragma unroll
        for (int mb = 0; mb < 2; ++mb) { f32x16_t y;
#pragma unroll
            for (int i = 0; i < 16; ++i) y[i] = 0.f;
#pragma unroll
            for (int s = 0; s < 8; ++s) { const bf16x8_t a = *(const GAS bf16x8_t*)(wuvT + (size_t)(mb * 32 + r32) * 128 + 16 * s + 8 * hi); y = __builtin_amdgcn_mfma_f32_32x32x16_bf16(a, Bo[s], y, 0, 0, 0); }
#pragma unroll
            for (int g = 0; g < 4; ++g) { const unsigned long long w = (unsigned long long)pk2(y[4 * g], y[4 * g + 1]) | ((unsigned long long)pk2(y[4 * g + 2], y[4 * g + 3]) << 32);
                *(GAS unsigned long long*)(P + (size_t)(tok0 + r32) * PP + 384 + h * 64 + mb * 32 + 8 * g + 4 * hi) = w; } }
    }
    lds_barrier();
}

constexpr int RP = 72;
constexpr int RT_QR = 0, RT_KR = 128 * RP * 2, RT_VV = 2 * 128 * RP * 2, RT_ST = 3 * 128 * RP * 2, RT_SS = RT_ST + 64 * RP * 2, RT_KD = RT_SS + 1024;
__device__ __forceinline__ void ret_out_unit(const Frame& F, int unit) {
    const int tid = F.tid, lane = F.lane, wave = F.wave, r32 = lane & 31, hi = lane >> 5;
    const int h = unit & 3, b = unit >> 2;
    bf16* P = (bf16*)(F.ws + WS_P); const float* tab = (const float*)(F.ws + WS_TAB);
    LAS bf16* QR = (LAS bf16*)(F.lds + RT_QR); LAS bf16* KR = (LAS bf16*)(F.lds + RT_KR); LAS bf16* VV = (LAS bf16*)(F.lds + RT_VV); LAS bf16* ST = (LAS bf16*)(F.lds + RT_ST);
    LAS float* SS = (LAS float*)(F.lds + RT_SS); LAS bf16* KD = (LAS bf16*)(F.lds + RT_KD);
    const float lg2 = log2f(1.0f - exp2f(-5.0f - (float)h));
    f32x16_t st;
#pragma unroll
    for (int i = 0; i < 16; ++i) st[i] = 0.f;
    const float cdec = exp2f(128.0f * lg2);
    unsigned long long pre[2][6]; f32x4 pret[2][2];
#define RT_LOAD(cn) do { _Pragma("unroll") for (int it_ = 0; it_ < 2; ++it_) { const int idx_ = tid + it_ * NTHR, m_ = idx_ >> 3, i4_ = (idx_ & 7) * 4; const size_t ro_ = (size_t)(b * SEQ + (cn) * 128 + m_) * PP + h * 64 + i4_; \
        pre[it_][0] = *(const GAS unsigned long long*)(P + ro_ + PCQ); pre[it_][1] = *(const GAS unsigned long long*)(P + ro_ + PCQ + 32); pre[it_][2] = *(const GAS unsigned long long*)(P + ro_ + PCK); \
        pre[it_][3] = *(const GAS unsigned long long*)(P + ro_ + PCK + 32); pre[it_][4] = *(const GAS unsigned long long*)(P + ro_ + PCV); pre[it_][5] = *(const GAS unsigned long long*)(P + ro_ + PCV + 32); \
        pret[it_][0] = *(const GAS f32x4*)(tab + ((size_t)((cn) * 128 + m_) * 32 + i4_) * 2); pret[it_][1] = *(const GAS f32x4*)(tab + ((size_t)((cn) * 128 + m_) * 32 + i4_) * 2 + 4); } } while (0)
    unsigned dga_ = 0;
    DG_START(60, dg60_)
    RT_LOAD(0);
    for (int c = 0; c < 16; ++c) {
    const int tok0 = b * SEQ + c * 128;
#pragma unroll
    for (int it = 0; it < 2; ++it) { const int idx = tid + it * NTHR, m = idx >> 3, i4 = (idx & 7) * 4;
        const unsigned long long q1w = pre[it][0], q2w = pre[it][1], k1w = pre[it][2], k2w = pre[it][3], v1w = pre[it][4], v2w = pre[it][5];
        const f32x4 t0 = pret[it][0], t1 = pret[it][1];
        const float cs[4] = {t0[0], t0[2], t1[0], t1[2]}, sn[4] = {t0[1], t0[3], t1[1], t1[3]};
        const float q1[4] = {bflo((unsigned)q1w), bfhi((unsigned)q1w), bflo((unsigned)(q1w >> 32)), bfhi((unsigned)(q1w >> 32))}, q2[4] = {bflo((unsigned)q2w), bfhi((unsigned)q2w), bflo((unsigned)(q2w >> 32)), bfhi((unsigned)(q2w >> 32))};
        const float k1[4] = {bflo((unsigned)k1w), bfhi((unsigned)k1w), bflo((unsigned)(k1w >> 32)), bfhi((unsigned)(k1w >> 32))}, k2[4] = {bflo((unsigned)k2w), bfhi((unsigned)k2w), bflo((unsigned)(k2w >> 32)), bfhi((unsigned)(k2w >> 32))};
        float qa[4], qb[4], ka[4], kb[4];
#pragma unroll
        for (int j = 0; j < 4; ++j) { qa[j] = q1[j] * cs[j] - q2[j] * sn[j]; qb[j] = q1[j] * sn[j] + q2[j] * cs[j]; ka[j] = (k1[j] * cs[j] - k2[j] * sn[j]) * 0.125f; kb[j] = (k1[j] * sn[j] + k2[j] * cs[j]) * 0.125f; }
        *(LAS unsigned long long*)(QR + m * RP + i4) = (unsigned long long)pk2(qa[0], qa[1]) | ((unsigned long long)pk2(qa[2], qa[3]) << 32);
        *(LAS unsigned long long*)(QR + m * RP + 32 + i4) = (unsigned long long)pk2(qb[0], qb[1]) | ((unsigned long long)pk2(qb[2], qb[3]) << 32);
        *(LAS unsigned long long*)(KR + m * RP + i4) = (unsigned long long)pk2(ka[0], ka[1]) | ((unsigned long long)pk2(ka[2], ka[3]) << 32);
        *(LAS unsigned long long*)(KR + m * RP + 32 + i4) = (unsigned long long)pk2(kb[0], kb[1]) | ((unsigned long long)pk2(kb[2], kb[3]) << 32);
        { const float kd = exp2f((float)(127 - m) * lg2);
          *(LAS unsigned long long*)(KD + m * RP + i4) = (unsigned long long)pk2(ka[0] * kd, ka[1] * kd) | ((unsigned long long)pk2(ka[2] * kd, ka[3] * kd) << 32);
          *(LAS unsigned long long*)(KD + m * RP + 32 + i4) = (unsigned long long)pk2(kb[0] * kd, kb[1] * kd) | ((unsigned long long)pk2(kb[2] * kd, kb[3] * kd) << 32); }
        *(LAS unsigned long long*)(VV + m * RP + i4) = v1w; *(LAS unsigned long long*)(VV + m * RP + 32 + i4) = v2w; }
    if (c + 1 < 16) RT_LOAD(c + 1);
    if (wave < 4) {
        const int db = wave >> 1, ebs = wave & 1;
#pragma unroll
        for (int i = 0; i < 16; ++i) ST[(32 * db + crow32(i, hi)) * RP + 32 * ebs + r32] = (bf16)(pk2(st[i], 0.f) & 0xffffu);
    }
    lds_barrier();
    const int nb = wave >> 1, eb = wave & 1, n = nb * 32 + r32;
    const unsigned blk_ = (lane >> 4) & 1, q_ = (lane & 15) >> 2, p_ = lane & 3;
    bf16x8_t qf[4];
#pragma unroll
    for (int ks = 0; ks < 4; ++ks) qf[ks] = *(const LAS bf16x8_t*)(QR + n * RP + ks * 16 + hi * 8);
    f32x16_t y;
#pragma unroll
    for (int i = 0; i < 16; ++i) y[i] = 0.f;
#pragma unroll
    for (int ks = 0; ks < 4; ++ks) {
        const s16x4_t lo = __builtin_bit_cast(s16x4_t, __builtin_amdgcn_ds_read_tr16_b64_v4i16((LAS s16x4_t*)(ST + (16 * ks + 8 * hi + q_) * RP + 32 * eb + 16 * blk_ + 4 * p_)));
        const s16x4_t hh = __builtin_bit_cast(s16x4_t, __builtin_amdgcn_ds_read_tr16_b64_v4i16((LAS s16x4_t*)(ST + (16 * ks + 8 * hi + 4 + q_) * RP + 32 * eb + 16 * blk_ + 4 * p_)));
        const bf16x8_t a = (bf16x8_t){lo[0], lo[1], lo[2], lo[3], hh[0], hh[1], hh[2], hh[3]};
        y = __builtin_amdgcn_mfma_f32_32x32x16_bf16(a, qf[ks], y, 0, 0, 0); }
    { const float qd = exp2f((float)(n + 1) * lg2);
#pragma unroll
      for (int i = 0; i < 16; ++i) y[i] *= qd; }
    unsigned long long gpre[4];
#pragma unroll
    for (int g = 0; g < 4; ++g) gpre[g] = *(const GAS unsigned long long*)(P + (size_t)(tok0 + n) * PP + PCG + h * 64 + 32 * eb + 8 * g + 4 * hi);
    for (int mt = 0; mt <= nb; ++mt) {
        f32x16_t S;
#pragma unroll
        for (int i = 0; i < 16; ++i) S[i] = 0.f;
#pragma unroll
        for (int ks = 0; ks < 4; ++ks) { const bf16x8_t a = *(const LAS bf16x8_t*)(KR + (mt * 32 + r32) * RP + ks * 16 + hi * 8); S = __builtin_amdgcn_mfma_f32_32x32x16_bf16(a, qf[ks], S, 0, 0, 0); }
        float e[16];
#pragma unroll
        for (int r = 0; r < 16; ++r) { const int dm = r32 - crow32(r, hi) + 32 * (nb - mt); e[r] = (dm >= 0) ? S[r] * exp2f((float)dm * lg2) : 0.f; }
#pragma unroll
        for (int s = 0; s < 2; ++s) { v4u w; w.x = pk2(e[8 * s], e[8 * s + 1]); w.y = pk2(e[8 * s + 2], e[8 * s + 3]); w.z = pk2(e[8 * s + 4], e[8 * s + 5]); w.w = pk2(e[8 * s + 6], e[8 * s + 7]);
            const bf16x8_t xs = __builtin_bit_cast(bf16x8_t, w);
            const s16x4_t lo = __builtin_bit_cast(s16x4_t, __builtin_amdgcn_ds_read_tr16_b64_v4i16((LAS s16x4_t*)(VV + (mt * 32 + 16 * s + 4 * hi + q_) * RP + 32 * eb + 16 * blk_ + 4 * p_)));
            const s16x4_t hh = __builtin_bit_cast(s16x4_t, __builtin_amdgcn_ds_read_tr16_b64_v4i16((LAS s16x4_t*)(VV + (mt * 32 + 16 * s + 8 + 4 * hi + q_) * RP + 32 * eb + 16 * blk_ + 4 * p_)));
            const bf16x8_t a = (bf16x8_t){lo[0], lo[1], lo[2], lo[3], hh[0], hh[1], hh[2], hh[3]};
            y = __builtin_amdgcn_mfma_f32_32x32x16_bf16(a, xs, y, 0, 0, 0); }
    }
    float ss = 0.f;
#pragma unroll
    for (int i = 0; i < 16; ++i) ss += y[i] * y[i];
    ss += __shfl_xor(ss, 32);
    if (hi == 0) SS[(nb * 2 + eb) * 32 + r32] = ss;
    lds_barrier();
    ss += SS[(nb * 2 + (eb ^ 1)) * 32 + r32];
    const float rs = 1.0f / sqrtf(ss * (1.0f / 64.0f) + 1e-6f);
    const size_t ro = (size_t)(tok0 + n) * PP;
#pragma unroll
    for (int g = 0; g < 4; ++g) { const int e0 = 32 * eb + 8 * g + 4 * hi;
        const unsigned long long gw = gpre[g];
        const float g0 = bflo((unsigned)gw), g1 = bfhi((unsigned)gw), g2 = bflo((unsigned)(gw >> 32)), g3 = bfhi((unsigned)(gw >> 32));
        const float o0 = g0 * sigmoid_f(g0) * y[4 * g] * rs, o1 = g1 * sigmoid_f(g1) * y[4 * g + 1] * rs, o2 = g2 * sigmoid_f(g2) * y[4 * g + 2] * rs, o3 = g3 * sigmoid_f(g3) * y[4 * g + 3] * rs;
        *(GAS unsigned long long*)(P + ro + 768 + h * 64 + e0) = (unsigned long long)pk2(o0, o1) | ((unsigned long long)pk2(o2, o3) << 32); }
    if (wave < 4) {
        const int db = wave >> 1, ebs = wave & 1;
#pragma unroll
        for (int i = 0; i < 16; ++i) st[i] *= cdec;
#pragma unroll
        for (int ks = 0; ks < 8; ++ks) {
            const s16x4_t alo = __builtin_bit_cast(s16x4_t, __builtin_amdgcn_ds_read_tr16_b64_v4i16((LAS s16x4_t*)(KD + (16 * ks + 8 * hi + q_) * RP + 32 * db + 16 * blk_ + 4 * p_)));
            const s16x4_t ahi = __builtin_bit_cast(s16x4_t, __builtin_amdgcn_ds_read_tr16_b64_v4i16((LAS s16x4_t*)(KD + (16 * ks + 8 * hi + 4 + q_) * RP + 32 * db + 16 * blk_ + 4 * p_)));
            const s16x4_t blo = __builtin_bit_cast(s16x4_t, __builtin_amdgcn_ds_read_tr16_b64_v4i16((LAS s16x4_t*)(VV + (16 * ks + 8 * hi + q_) * RP + 32 * ebs + 16 * blk_ + 4 * p_)));
            const s16x4_t bhi = __builtin_bit_cast(s16x4_t, __builtin_amdgcn_ds_read_tr16_b64_v4i16((LAS s16x4_t*)(VV + (16 * ks + 8 * hi + 4 + q_) * RP + 32 * ebs + 16 * blk_ + 4 * p_)));
            const bf16x8_t a = (bf16x8_t){alo[0], alo[1], alo[2], alo[3], ahi[0], ahi[1], ahi[2], ahi[3]}, bb = (bf16x8_t){blo[0], blo[1], blo[2], blo[3], bhi[0], bhi[1], bhi[2], bhi[3]};
            st = __builtin_amdgcn_mfma_f32_32x32x16_bf16(a, bb, st, 0, 0, 0); }
    }
    lds_barrier();
    }
    DG_STOP(60, dg60_, dga_)
    DG_WRITE(60, unit == 0 && wave == 0 && lane == 0, dga_)
#undef RT_LOAD
}

constexpr int PT = 32, XSP = 1304;
constexpr int PR_XS = 0, PR_STG = PT * XSP * 2, PR_CONST = PR_STG + 32768, PR_MU = PR_CONST + 6 * 384 * 4;
__device__ __forceinline__ void prep_consts(const Frame& F, int l) {
    LAS float* CS = (LAS float*)(F.lds + PR_CONST);
    for (int i = F.tid; i < AW; i += NTHR) { CS[i] = F.in[I_KK][l * AW + i]; CS[AW + i] = F.in[I_KA][l * AW + i]; CS[2 * AW + i] = F.in[I_RK][l * AW + i];
        CS[3 * AW + i] = F.in[I_W0][l * AW + i]; CS[4 * AW + i] = F.in[I_A0][l * AW + i]; CS[5 * AW + i] = (l > 0) ? F.in[I_V0][(l - 1) * AW + i] : 0.f; }
    LAS float* MU = (LAS float*)(F.lds + PR_MU);
    for (int i = F.tid; i < 1296; i += NTHR) MU[i] = (i < 1280) ? F.in[I_MU][l * 1280 + i] : ((l > 0) ? F.in[I_VRMU][(l - 1) * 16 + i - 1280] : 0.f);
    __syncthreads();
}
__device__ __forceinline__ float softplus_f(float z) { return fmaxf(z, 0.f) + __logf(1.0f + __expf(-fabsf(z))); }
__device__ __forceinline__ float tanh_f(float x) { const float e = __expf(2.0f * x); return 1.0f - 2.0f * __builtin_amdgcn_rcpf(e + 1.0f); }
__device__ __forceinline__ void small_weights(const Frame& F) {
    for (int l = 0; l < DEPTH; ++l) {
        const float* w2 = F.in[I_W2] + (size_t)l * 32 * AW; const float* a2 = F.in[I_A2] + (size_t)l * 32 * AW; const float* g2 = F.in[I_G2] + (size_t)l * 64 * AW;
        const float* v2 = F.in[I_V2] + (size_t)(l > 0 ? l - 1 : 0) * 16 * AW;
        bf16* LT = (bf16*)(F.ws + WS_LORA) + (size_t)l * AW * 144;
        for (int i = F.vcu * NTHR + F.tid; i < AW * 144; i += F.G * NTHR) { const int n = i / 144, k = i - n * 144; float v;
            if (k < 32) v = w2[k * AW + n]; else if (k < 64) v = a2[(k - 32) * AW + n]; else if (k < 128) v = g2[(k - 64) * AW + n]; else v = (l > 0) ? v2[(k - 128) * AW + n] : 0.f;
            LT[i] = (bf16)f2bf(v); }
        const float* wuk = F.in[I_WUK] + (size_t)l * 6 * 64 * 128; const float* wuv = F.in[I_WUV] + (size_t)l * 6 * 128 * 64;
        bf16* wukT = (bf16*)(F.ws + WS_WUKT) + (size_t)l * 6 * 64 * 128; bf16* wuvT = (bf16*)(F.ws + WS_WUVT) + (size_t)l * 6 * 64 * 128;
        for (int i = F.vcu * NTHR + F.tid; i < 6 * 64 * 128; i += F.G * NTHR) {
            { const int hh = i / 8192, rem = i - hh * 8192, c = rem >> 6, d = rem & 63; wukT[i] = (bf16)f2bf(wuk[(hh * 64 + d) * 128 + c]); }
            { const int hh = i / 8192, rem = i - hh * 8192, d = rem >> 7, c = rem & 127; wuvT[i] = (bf16)f2bf(wuv[(hh * 128 + c) * 64 + d]); } }
    }
}
__device__ __forceinline__ void prep_tokens_unit(const Frame& F, int l, int unit) {
    LAS bf16* XS = (LAS bf16*)(F.lds + PR_XS);
    const int tid = F.tid, lane = F.lane, wave = F.wave, r32 = lane & 31, hi = lane >> 5, tok0 = unit * PT;
    const bf16* P = (const bf16*)(F.ws + WS_P);
    unsigned dga_ = 0;
    DG_START(20, dg20_)
    for (int base = 0; base < PT * 162; base += 5 * NTHR) {
        v4u cw[5], pw[5];
#pragma unroll
        for (int u = 0; u < 5; ++u) { const int idx = base + u * NTHR + tid; const int idc = idx < PT * 162 ? idx : PT * 162 - 1; const int t = idc / 162, ch = idc - t * 162, tok = tok0 + t;
            cw[u] = *(const GAS v4u*)(P + (size_t)tok * PP + ch * 8);
            const int tokp = (tok & (SEQ - 1)) != 0 ? tok - 1 : tok; pw[u] = *(const GAS v4u*)(P + (size_t)tokp * PP + ch * 8); }
#pragma unroll
        for (int u = 0; u < 5; ++u) { const int idx = base + u * NTHR + tid;
            if (idx < PT * 162) { const int t = idx / 162, ch = idx - t * 162, tok = tok0 + t, c0 = ch * 8;
                float cur[8], prv[8]; unpack8(cw[u], cur); unpack8(pw[u], prv);
                const bool first = (tok & (SEQ - 1)) == 0;
                float mv[8];
                { const LAS f32x4* mp = (const LAS f32x4*)((const LAS float*)(F.lds + PR_MU) + c0); const f32x4 m0 = mp[0], m1 = mp[1]; mv[0] = m0[0]; mv[1] = m0[1]; mv[2] = m0[2]; mv[3] = m0[3]; mv[4] = m1[0]; mv[5] = m1[1]; mv[6] = m1[2]; mv[7] = m1[3]; }
                float o[8];
#pragma unroll
                for (int j = 0; j < 8; ++j) { const float pv = first ? 0.f : prv[j]; float v = cur[j] + (pv - cur[j]) * mv[j];
                    if (c0 >= 1152 && c0 < 1184) v = tanh_f(v); else if (c0 >= 1216 && c0 < 1280) v = sigmoid_f(v);
                    o[j] = v; }
                v4u w; w.x = pk2(o[0], o[1]); w.y = pk2(o[2], o[3]); w.z = pk2(o[4], o[5]); w.w = pk2(o[6], o[7]);
                *(LAS v4u*)(XS + t * XSP + c0) = w; } }
    }
    __syncthreads();
    DG_STOP(20, dg20_, dga_)
    DG_WRITE(20, unit == 0 && l == 0 && wave == 0 && lane == 0, dga_)
    DG_START(21, dg21_)
    if (wave < 6) {
        const int h = wave;
        LAS bf16* STG = (LAS bf16*)(F.lds + PR_STG + wave * 4096);
        GAS unsigned char* wsb = (GAS unsigned char*)F.ws;
        GAS unsigned char* outb = (GAS unsigned char*)F.out;
        const bf16* LT = (const bf16*)(F.ws + WS_LORA) + (size_t)l * AW * 144;
        const LAS float* CS = (const LAS float*)(F.lds + PR_CONST) + h * 64;
        const LAS float* kkw = CS; const LAS float* kaw = CS + AW; const LAS float* rkw = CS + 2 * AW; const LAS float* w0p = CS + 3 * AW; const LAS float* a0p = CS + 4 * AW; const LAS float* v0p = CS + 5 * AW;
        const LAS bf16* xrow = XS + r32 * XSP;
        float rn;
        { float ss = 0.f;
#pragma unroll
          for (int cbl = 0; cbl < 2; ++cbl)
#pragma unroll
              for (int g = 0; g < 4; ++g) { const int j0 = cbl * 32 + 8 * g + 4 * hi; const unsigned long long kw = *(const LAS unsigned long long*)(xrow + 384 + h * 64 + j0); const f32x4 kk4 = *(const LAS f32x4*)(kkw + j0);
                  const float k0 = bflo((unsigned)kw) * kk4[0], k1 = bfhi((unsigned)kw) * kk4[1], k2 = bflo((unsigned)(kw >> 32)) * kk4[2], k3 = bfhi((unsigned)(kw >> 32)) * kk4[3]; ss += (k0 * k0 + k1 * k1) + (k2 * k2 + k3 * k3); }
          ss += __shfl_xor(ss, 32); rn = 1.0f / fmaxf(sqrtf(ss), 1e-12f); }
        float bonus = 0.f;
        const int srow = lane >> 2, sch = lane & 3;
#pragma unroll
        for (int cbl = 0; cbl < 2; ++cbl) {
            asm volatile("" ::: "memory");
            const int cb0 = h * 64 + cbl * 32;
            f32x16_t wv, av, gv, mvv;
#pragma unroll
            for (int i = 0; i < 16; ++i) { wv[i] = 0.f; av[i] = 0.f; gv[i] = 0.f; mvv[i] = 0.f; }
            const bf16* lrow = LT + (size_t)(cb0 + r32) * 144 + 8 * hi;
#pragma unroll
            for (int ks = 0; ks < 9; ++ks) { const bf16x8_t a = *(const GAS bf16x8_t*)(lrow + 16 * ks); const bf16x8_t bx = *(const LAS bf16x8_t*)(xrow + 1152 + 16 * ks + 8 * hi);
                if (ks < 2) wv = __builtin_amdgcn_mfma_f32_32x32x16_bf16(a, bx, wv, 0, 0, 0);
                else if (ks < 4) av = __builtin_amdgcn_mfma_f32_32x32x16_bf16(a, bx, av, 0, 0, 0);
                else if (ks < 8) gv = __builtin_amdgcn_mfma_f32_32x32x16_bf16(a, bx, gv, 0, 0, 0);
                else mvv = __builtin_amdgcn_mfma_f32_32x32x16_bf16(a, bx, mvv, 0, 0, 0); }
            if (l > 0) {
#pragma unroll
                for (int i = 0; i < 2; ++i) { const int row = srow + 16 * i; const unsigned eo = (unsigned)(((tok0 + row) * AW + cb0 + sch * 8) * 2); *(LAS v4u*)(STG + row * 32 + sch * 8) = *(const GAS v4u*)(wsb + WS_VF + eo); } }
            unsigned long long ro[4], dd[4], k2o[4], kko[4], bpo[4], vo[4], go[4];
#pragma unroll
            for (int g = 0; g < 4; ++g) { const int j0 = cbl * 32 + 8 * g + 4 * hi;
                const unsigned long long rw = *(const LAS unsigned long long*)(xrow + h * 64 + j0), kw = *(const LAS unsigned long long*)(xrow + 384 + h * 64 + j0), vw = *(const LAS unsigned long long*)(xrow + 768 + h * 64 + j0);
                unsigned long long fw = 0ull; if (l > 0) fw = *(const LAS unsigned long long*)(STG + r32 * 32 + 8 * g + 4 * hi);
                asm volatile("" : "+v"(bonus) :: "memory");
                const f32x4 kk4 = *(const LAS f32x4*)(kkw + j0), ka4 = *(const LAS f32x4*)(kaw + j0), rk4 = *(const LAS f32x4*)(rkw + j0), w04 = *(const LAS f32x4*)(w0p + j0), a04 = *(const LAS f32x4*)(a0p + j0);
                const f32x4 v04 = *(const LAS f32x4*)(v0p + j0);
                const float rr[4] = {bflo((unsigned)rw), bfhi((unsigned)rw), bflo((unsigned)(rw >> 32)), bfhi((unsigned)(rw >> 32))};
                const float kx[4] = {bflo((unsigned)kw), bfhi((unsigned)kw), bflo((unsigned)(kw >> 32)), bfhi((unsigned)(kw >> 32))};
                const float vx[4] = {bflo((unsigned)vw), bfhi((unsigned)vw), bflo((unsigned)(vw >> 32)), bfhi((unsigned)(vw >> 32))};
                const float fx[4] = {bflo((unsigned)fw), bfhi((unsigned)fw), bflo((unsigned)(fw >> 32)), bfhi((unsigned)(fw >> 32))};
                float d_[4], k2_[4], kk_[4], bp_[4], v_[4];
#pragma unroll
                for (int e = 0; e < 4; ++e) { const int i = 4 * g + e;
                    const float sp = softplus_f(-(wv[i] + w04[e])); const float rate = __expf(-sp - 0.5f); const float d = 1.0f - __expf(-rate);
                    const float a = sigmoid_f(av[i] + a04[e]);
                    float v = vx[e]; if (l > 0) v = v + (fx[e] - v) * sigmoid_f(mvv[i] + v04[e]);
                    const float kk = kx[e] * kk4[e] * rn, k2 = kx[e] * (1.0f + (a - 1.0f) * ka4[e]);
                    d_[e] = d; k2_[e] = k2; kk_[e] = kk; bp_[e] = kk * a; v_[e] = v;
                    bonus += rr[e] * k2 * rk4[e]; }
#define PK4(x) ((unsigned long long)pk2(x[0], x[1]) | ((unsigned long long)pk2(x[2], x[3]) << 32))
                ro[g] = rw; dd[g] = PK4(d_); k2o[g] = PK4(k2_); kko[g] = PK4(kk_); bpo[g] = PK4(bp_); vo[g] = PK4(v_);
                go[g] = (unsigned long long)pk2(gv[4 * g], gv[4 * g + 1]) | ((unsigned long long)pk2(gv[4 * g + 2], gv[4 * g + 3]) << 32); }
#define PR_OUT(arr, bs_, dst) do { _Pragma("unroll") for (int g = 0; g < 4; ++g) *(LAS unsigned long long*)(STG + r32 * 32 + 8 * g + 4 * hi) = arr[g]; \
            _Pragma("unroll") for (int i = 0; i < 2; ++i) { const int row = srow + 16 * i; const unsigned eo = (unsigned)(((tok0 + row) * AW + cb0 + sch * 8) * 2); *(GAS v4u*)(bs_ + dst + eo) = *(const LAS v4u*)(STG + row * 32 + sch * 8); } } while (0)
            PR_OUT(ro, wsb, WS_R); PR_OUT(dd, wsb, WS_D); PR_OUT(k2o, wsb, WS_K2); PR_OUT(kko, wsb, WS_KK); PR_OUT(bpo, outb, OUT_BP); PR_OUT(vo, wsb, WS_VF); PR_OUT(go, outb, OUT_G);
#undef PR_OUT
#undef PK4
        }
        bonus += __shfl_xor(bonus, 32);
        if (hi == 0) ((float*)(F.ws + WS_BON))[(size_t)(tok0 + r32) * 6 + h] = bonus;
    } else {
        const float* kvn = F.in[I_KVN] + l * 128; bf16* C = (bf16*)(F.ws + WS_C);
        for (int q = 0; q < 16; ++q) { const int tok = tok0 + 16 * (wave - 6) + q; const unsigned w = *(const GAS unsigned*)(P + (size_t)tok * PP + PBC + 2 * lane);
            const float c0 = bflo(w), c1 = bfhi(w); const float ss = wave_sum(c0 * c0 + c1 * c1); const float rs = 1.0f / sqrtf(ss * (1.0f / 128.0f) + 1e-6f);
            *(GAS unsigned*)(C + (size_t)tok * 128 + 2 * lane) = pk2(c0 * rs * kvn[2 * lane], c1 * rs * kvn[2 * lane + 1]); }
    }
    DG_STOP(21, dg21_, dga_)
    DG_WRITE(21, unit == 0 && l == 0 && wave == 0 && lane == 0, dga_)
    __syncthreads();
}

__device__ __forceinline__ void final_norm(const Frame& F) {
    const int gw = F.vcu * NWAVES + F.wave, NGW = F.G * NWAVES; const float* g = F.in[I_FN];
    float dgc_ = 0.f;
    if (DIAG_SLOT_D >= 0) { const unsigned* D = (const unsigned*)(F.ws + WS_DIAG); const float x0 = (float)D[0] * (1.0f / (100.0f * DIAG_DIV)); const float gq = (DIAG_SLOT_D >= 100) ? 4.0f : 2.0f;
        const float kq = floorf(log2f(fmaxf(x0, 1.0f)) * gq); dgc_ = sqrtf(fmaxf(exp2f((kq + 0.5f) / gq) - 1.0f, 0.01f)); }
    const bf16* XBf = (const bf16*)(F.ws + WS_XB);
    for (int m = gw; m < M; m += NGW) { GAS f32x4* xr = (GAS f32x4*)(F.out + (size_t)m * DM); const GAS v4u* xs = (const GAS v4u*)(XBf + (size_t)m * DM); float v[2][8]; float s = 0.f;
#pragma unroll
        for (int j = 0; j < 2; ++j) { unpack8(xs[F.lane + 64 * j], v[j]);
#pragma unroll
            for (int e = 0; e < 8; ++e) s += v[j][e] * v[j][e]; }
        const float rs = 1.0f / sqrtf(wave_sum(s) * (1.0f / DM) + 1e-6f);
#pragma unroll
        for (int j = 0; j < 2; ++j) { const int c = 8 * (F.lane + 64 * j); const f32x4 g0 = *(const f32x4*)(g + c), g1 = *(const f32x4*)(g + c + 4);
            xr[c / 4] = (DIAG_SLOT_D >= 0) ? (f32x4){dgc_, dgc_, dgc_, dgc_} : (f32x4){v[j][0], v[j][1], v[j][2], v[j][3]} * rs * g0;
            xr[c / 4 + 1] = (DIAG_SLOT_D >= 0) ? (f32x4){dgc_, dgc_, dgc_, dgc_} : (f32x4){v[j][4], v[j][5], v[j][6], v[j][7]} * rs * g1; } }
}

template <class T> __device__ __forceinline__ T* launder_ptr(T* p) {
    unsigned lo = (unsigned)(uintptr_t)p, hi = (unsigned)((uintptr_t)p >> 32);
    asm volatile("" : "+v"(lo), "+v"(hi));
    lo = __builtin_amdgcn_readfirstlane(lo); hi = __builtin_amdgcn_readfirstlane(hi);
    return (T*)(((uintptr_t)hi << 32) | (uintptr_t)lo);
}
constexpr int NPHASE = 20;
constexpr int DUP_PHASE = -1;
constexpr int QDUP = 1;
constexpr int REP_SCAN_K = 1, REP_THR_K = 1;
constexpr int NSTEP = NPHASE + (DUP_PHASE >= 0 ? 1 : 0);
constexpr int REP_THR = 1, REP_PTOK = 1, REP_KV = 1, REP_CONV = 1, REP_SCAN = 1, REP_DSA = 1, REP_RET = 1, REP_UP = 1;
#define REPL(n) for (int rep_ = 0; rep_ < (l == 0 ? (n) : 1); ++rep_)
__global__ void __launch_bounds__(NTHR, 2) fwd_kernel(Args args) {
    extern __shared__ __attribute__((aligned(16))) unsigned char lds[];
    Frame F;
    F.lds = (LAS unsigned char*)lds;
    F.tid = threadIdx.x; F.lane = F.tid & 63; F.wave = __builtin_amdgcn_readfirstlane(F.tid >> 6);
    F.G = gridDim.x; { const int bx = blockIdx.x; F.vcu = (F.G % 8 == 0) ? (bx % 8) * (F.G / 8) + bx / 8 : bx; }
    F.in = (const float* const __attribute__((address_space(4)))*)__builtin_amdgcn_kernarg_segment_ptr(); F.out = args.out; F.ws = args.ws;
    volatile LAS unsigned* MISC = (volatile LAS unsigned*)(F.lds + MISC_OFF);
    for (int u = F.tid; u < (LDS_BYTES - LDSCTL_OFF) / 4; u += NTHR) ((LAS unsigned*)(F.lds + LDSCTL_OFF))[u] = 0u;
    __syncthreads();
    const int lo = args.ph_lo, hi = args.ph_hi;
    XcdBarrier bar; bar.bar = (unsigned*)(F.ws + WS_CTL) + CW_BAR; bar.x = 0; bar.st = nullptr;
    if (hi - lo > 1) bar = xcd_barrier_post((unsigned*)(F.ws + WS_CTL) + CW_BAR, MISC + 8);
    for (int ph_ = lo; ph_ < hi; ++ph_) {
        unsigned dgp0_ = 0; if (DIAG_SLOT_D >= 100) dgp0_ = (unsigned)__builtin_amdgcn_s_memtime();
        int ph = (args.dup_phase >= 0 && ph_ > args.dup_phase) ? ph_ - 1 : ph_; asm volatile("" : "+v"(ph)); ph = __builtin_amdgcn_readfirstlane(ph);
#define PH_ENTER() \
        { unsigned z_ = 0u; int t_ = threadIdx.x; asm volatile("" : "+v"(z_), "+v"(t_)); z_ = __builtin_amdgcn_readfirstlane(z_); F.in = (const float* const __attribute__((address_space(4)))*)((const char __attribute__((address_space(4)))*)__builtin_amdgcn_kernarg_segment_ptr() + z_); F.out = args.out + z_; F.ws = args.ws + z_; \
          F.tid = t_; F.lane = t_ & 63; F.wave = __builtin_amdgcn_readfirstlane(t_ >> 6); } \
        int bx = blockIdx.x; { int g_ = gridDim.x; asm volatile("" : "+v"(bx), "+v"(g_)); bx = __builtin_amdgcn_readfirstlane(bx); g_ = __builtin_amdgcn_readfirstlane(g_); F.G = g_; F.vcu = (g_ % 8 == 0) ? (bx % 8) * (g_ / 8) + bx / 8 : bx; } \
        gu32* ctl = (gu32*)(F.ws + WS_CTL); (void)ctl; \
        bf16* XB = (bf16*)(F.ws + WS_XB); bf16* Hb = (bf16*)(F.ws + WS_H); bf16* Pb = (bf16*)(F.ws + WS_P); float* part = (float*)(F.ws + WS_PART); (void)XB; (void)Hb; (void)Pb; (void)part;
        if (ph == 0) { PH_ENTER();
            if (DIAG_SLOT_D >= 0 && bx == 0 && threadIdx.x == 0) { ((unsigned*)(args.ws + WS_DIAG))[0] = 0u; ((unsigned*)(args.ws + WS_DIAG))[1] = 0u; }
            conv_weights(F, 0, 0, 3);
            p0_x(F); p0_table(F); small_weights(F);
        } else if (ph == NPHASE - 1) { PH_ENTER();
            final_norm(F);
        } else {
            const int l = (ph - 1) / 9, sub = (ph - 1) - 9 * l;
            if (sub == 0 || sub == 7) { PH_ENTER();
                pg8::Gemm g{XB, (const bf16*)(F.ws + (sub == 0 ? WS_WGU1 : WS_WGU2)), M, NGU, DM, DM}; pg8::StaticOrder S; S.init(M, NGU, F.G, bx);
                pg8::EpiUp E{Hb, FFP, part};
                for (int rep = 0; rep < ((l == 0 && sub == 0) ? REP_UP : 1); ++rep) pg8::gemm_phase<pg8::EpiUp, pg8::StaticOrder, true>(F.lds, g, S, E, F.tid);
            } else if (sub == 1 || sub == 8 || sub == 6) { PH_ENTER();
                const bool op = (sub == 6);
                pg8::Gemm g{op ? Pb : Hb, (const bf16*)(F.ws + (op ? WS_WOUT : (sub == 1 ? WS_WD1 : WS_WD2))), M, DM, op ? DM : FFP, op ? PP : FFP}; pg8::StaticOrder S; S.init(M, DM, F.G, bx);
                const float* base = (l == 0 && sub == 1) ? F.in[I_X] : nullptr;
                pg8::EpiRes E{base, XB, part};
                pg8::gemm_phase<pg8::EpiRes, pg8::StaticOrder, false>(F.lds, g, S, E, F.tid);
            } else if (sub == 2) { PH_ENTER();
                pg8::Gemm g{XB, (const bf16*)(F.ws + WS_WIN), M, PP, DM, DM}; pg8::StaticOrder S; S.init(M, PP, F.G, bx);
                pg8::EpiP E{Pb, PP, part};
                pg8::gemm_phase<pg8::EpiP, pg8::StaticOrder, true>(F.lds, g, S, E, F.tid);
            } else if (sub == 3) { PH_ENTER();
                for (int rep_ = 0; rep_ < (l == 0 ? args.rep_thr : 1); ++rep_)
                    for (int k = 0, u0 = F.vcu; u0 < M / 16; ++k, u0 += F.G) {
                        const int base = k * F.G, span = (M / 16 - base) < F.G ? (M / 16 - base) : F.G; const int u = (k & 1) ? base + span - 1 - F.vcu : u0;
                        if (u >= base && u < M / 16) dsa_thr_unit(F, u); }
                prep_consts(F, l);
                REPL(REP_PTOK) for (int u = F.vcu; u < M / PT; u += F.G) prep_tokens_unit(F, l, u);

            } else if (sub == 5) { PH_ENTER();
                rwkv_post(F, l);
            } else if (sub == 4) { PH_ENTER();
                unsigned dgm_ = 0; if (DIAG_SLOT_D >= 50 && DIAG_SLOT_D < 60) dgm_ = (unsigned)__builtin_amdgcn_s_memtime();
                if (bx < BATCH * 24) { for (int rep_ = 0; rep_ < (l == 0 ? args.rep_scan : 1); ++rep_) { rwkv_scan_unit(F, l, bx); __syncthreads(); } }
                if (DIAG_SLOT_D == 54 && l == 0 && bx < BATCH * 24 && threadIdx.x == 0) atomicMax((unsigned*)(args.ws + WS_DIAG), (unsigned)__builtin_amdgcn_s_memtime() - dgm_);
                if (DIAG_SLOT_D == 50 && l == 0 && bx == 0 && threadIdx.x == 0) ((unsigned*)(args.ws + WS_DIAG))[0] = (unsigned)__builtin_amdgcn_s_memtime() - dgm_;
                {
                    gu32* qh = ctl + CW_QUEUE + 64 * l;
                    for (;;) {
                        if (F.tid == 0) MISC[0] = __hip_atomic_fetch_add(qh, 1u, RLX_AGENT);
                        __syncthreads();
                        const int u = (int)MISC[0];
                        __syncthreads();
                        const int nd = (l == 0 ? args.qdup : 1) * (M / 32);
                        { unsigned z_ = 0u; int t_ = threadIdx.x; asm volatile("" : "+v"(z_), "+v"(t_)); z_ = __builtin_amdgcn_readfirstlane(z_); F.ws = args.ws + z_; F.tid = t_; F.lane = t_ & 63; F.wave = __builtin_amdgcn_readfirstlane(t_ >> 6); }
                        const int ncv = (conv_flat_items(l + 1 < DEPTH) + NWAVES * CONV_PER_WAVE - 1) / (NWAVES * CONV_PER_WAVE);
                        if (DIAG_SLOT_D == 53 && l == 0 && bx == 200 && threadIdx.x == 0 && u >= BATCH * 4 + nd) { unsigned* D_ = (unsigned*)(args.ws + WS_DIAG); if (D_[1] != 0x600Du) { D_[1] = 0x600Du; D_[0] = (unsigned)__builtin_amdgcn_s_memtime() - dgm_; } }
                        if (u >= nd + BATCH * 4 + ncv) { if (DIAG_SLOT_D == 51 && l == 0 && bx == 0 && threadIdx.x == 0) ((unsigned*)(args.ws + WS_DIAG))[0] = (unsigned)__builtin_amdgcn_s_memtime() - dgm_;
                            if (DIAG_SLOT_D == 52 && l == 0 && bx == 200 && threadIdx.x == 0) ((unsigned*)(args.ws + WS_DIAG))[0] = (unsigned)__builtin_amdgcn_s_memtime() - dgm_; }
                        if (DIAG_SLOT_D == 55 && l == 0 && u >= nd + BATCH * 4 + ncv && threadIdx.x == 0) atomicMax((unsigned*)(args.ws + WS_DIAG), (unsigned)__builtin_amdgcn_s_memtime() - dgm_);
                        if (DIAG_SLOT_D == 56 && l == 0 && u >= BATCH * 4 && u < nd + BATCH * 4 && threadIdx.x == 0) atomicMax((unsigned*)(args.ws + WS_DIAG), (unsigned)__builtin_amdgcn_s_memtime() - dgm_);
                        if (u >= nd + BATCH * 4 + ncv) break;
                        if (u < BATCH * 4) ret_out_unit(F, u);
                        else if (u < nd + BATCH * 4) dsa_attn_unit(F, l, (u - BATCH * 4) % (M / 32));
                        else { conv_unit(F, l, u - nd - BATCH * 4); __syncthreads(); }
                    }
                }
            }
        }
        if (ph_ + 1 < hi) xcd_barrier(bar);
        if (DIAG_SLOT_D >= 100 && ph_ == DIAG_SLOT_D - 100 && blockIdx.x == 0 && threadIdx.x == 0) ((unsigned*)(args.ws + WS_DIAG))[0] = (unsigned)__builtin_amdgcn_s_memtime() - dgp0_;
    }
}

extern "C" void kernel_launch(void* const* d_in, const int* in_sizes, int n_in, void* d_out, int out_size, void* d_ws, size_t ws_size, hipStream_t stream) {
    static int grid = 0;
    if (grid == 0) {
        if (n_in != 31 || out_size != M * DM || ws_size < WS_END) { fprintf(stderr, "kernel_launch: unexpected shapes (n_in %d, out %d, ws %zu)\n", n_in, out_size, ws_size); grid = -1; return; }
        int dev = 0, cus = 0, per_cu = 0;
        if (hipGetDevice(&dev) != hipSuccess || hipDeviceGetAttribute(&cus, hipDeviceAttributeMultiprocessorCount, dev) != hipSuccess) { grid = -1; return; }
        if (hipFuncSetAttribute((const void*)fwd_kernel, hipFuncAttributeMaxDynamicSharedMemorySize, LDS_BYTES) != hipSuccess) { fprintf(stderr, "kernel_launch: hipFuncSetAttribute failed\n"); grid = -1; return; }
        if (hipOccupancyMaxActiveBlocksPerMultiprocessor(&per_cu, (const void*)fwd_kernel, NTHR, LDS_BYTES) != hipSuccess || per_cu < 1) fprintf(stderr, "kernel_launch: occupancy query says %d\n", per_cu);
        (void)hipGetLastError();
        grid = cus;
    }
    if (grid < 0) return;
    if (hipMemsetAsync((char*)d_ws + WS_CTL, 0, CTL_ZERO_BYTES, stream) != hipSuccess) return;
    Args a{};
    for (int i = 0; i < 31; ++i) a.in[i] = (const float*)d_in[i];
    a.out = (float*)d_out; a.ws = (unsigned char*)d_ws; a.dup_phase = DUP_PHASE; a.qdup = QDUP; a.rep_scan = REP_SCAN_K; a.rep_thr = REP_THR_K;
#ifndef ONE_LAUNCH
#define ONE_LAUNCH 1
#endif
    if (ONE_LAUNCH) { a.ph_lo = 0; a.ph_hi = NSTEP; hipLaunchKernelGGL(fwd_kernel, dim3(grid), dim3(NTHR), LDS_BYTES, stream, a); }
    else for (int ph = 0; ph < NPHASE; ++ph) { a.ph_lo = ph; a.ph_hi = ph + 1; hipLaunchKernelGGL(fwd_kernel, dim3(grid), dim3(NTHR), LDS_BYTES, stream, a); }
}
```

```cpp
#include <hip/hip_runtime.h>
#include <cstdio>
#include <cstdint>
#include <cmath>

namespace pg8 {
#define PG8_LAS __attribute__((address_space(3)))
typedef unsigned short bf16_t;
typedef short bf16x8 __attribute__((ext_vector_type(8)));
typedef float f32x4 __attribute__((ext_vector_type(4)));
typedef unsigned u32x4 __attribute__((ext_vector_type(4)));
constexpr int BM = 256, BK = 64, HALF = 128, HTB = HALF * BK * 2  , STAGE_BYTES = 8 * HTB, NXCD = 8, WGM = 8;

__host__ __device__ __forceinline__ int lds_byte(int r, int c) { const int st = (r >> 4) * 2 + (c >> 5), rr = r & 15, cc = c & 31, ob = rr * 64 + cc * 2; return st * 1024 + (ob ^ (((ob >> 9) & 1) << 5)); }
__host__ __device__ __forceinline__ void stage_rc(int b, int& R, int& C) { const int st = b / 1024, sb = b % 1024, swz = sb ^ (((sb >> 9) & 1) << 5); R = (st >> 1) * 16 + swz / 64; C = (st & 1) * 32 + (swz % 64) / 2; }
__host__ __device__ __forceinline__ int perm32(int rho) { const int n = rho >> 4, i = rho & 15; return 8 * (i >> 2) + 4 * n + (i & 3); }

struct Unit { int pm, pn; };
struct Gemm { const bf16_t* A; const bf16_t* Bt; int M, N, K, lda; };

struct StaticOrder {
    int nM, nN, nwg, G, c;
    __host__ __device__ void init(int M, int N, int G_, int c_) { nM = M / BM; nN = N / BM; nwg = nM * nN; G = G_; c = c_; }
    __host__ __device__ bool next(int i, Unit& u) const {
        const long L = (long)i * G + c; if (L >= nwg) return false;
        int wgid = (int)L; { const int q = nwg / NXCD, r = nwg % NXCD, xcd = wgid % NXCD, off = wgid / NXCD; wgid = (xcd < r ? xcd * (q + 1) : r * (q + 1) + (xcd - r) * q) + off; }
        const int nig = WGM * nN, gid = wgid / nig, fm = gid * WGM, gsz = (nM - fm) < WGM ? (nM - fm) : WGM;
        u.pm = fm + ((wgid % nig) % gsz); u.pn = (wgid % nig) / gsz; return true;
    }
    __device__ __forceinline__ void a_ready(const Unit&) const {}
    __device__ __forceinline__ void done(const Unit&) const {}
};

__device__ __forceinline__ unsigned cvt_pk_bf16(float lo, float hi) { unsigned r; asm volatile("v_cvt_pk_bf16_f32 %0, %1, %2" : "=v"(r) : "v"(lo), "v"(hi)); return r; }


__device__ __forceinline__ float row_rstd(const float* part, int row) {
    const f32x4* p = (const f32x4*)(part + (size_t)row * 16);
    const f32x4 a = p[0], b = p[1], c = p[2], d = p[3];
    const float s = ((a[0] + a[1]) + (a[2] + a[3])) + ((b[0] + b[1]) + (b[2] + b[3])) + ((c[0] + c[1]) + (c[2] + c[3])) + ((d[0] + d[1]) + (d[2] + d[3]));
    return 1.0f / sqrtf(s * (1.0f / 1024.0f) + 1e-6f);
}
__device__ __forceinline__ float silu_f(float x) { return x * __builtin_amdgcn_rcpf(1.0f + __expf(-x)); }

struct EpiUp {
    static constexpr bool PERM = true;
    bf16_t* H; int ldh; const float* part;
    __device__ __forceinline__ void operator()(const f32x4 (&acc)[2][2][4][2], const Unit& u, int wr, int wc, int fr, int fq) const {
        const int row0 = u.pm * BM + wr * 64 + fr, hcol = u.pn * 128 + wc * 32 + 8 * fq;
#pragma unroll
        for (int ai = 0; ai < 2; ++ai)
#pragma unroll
            for (int m = 0; m < 4; ++m) { const int row = row0 + ai * HALF + m * 16; const float rs = row_rstd(part, row);
                const f32x4 g0 = acc[ai][0][m][0] * rs, g1 = acc[ai][0][m][1] * rs, u0 = acc[ai][1][m][0] * rs, u1 = acc[ai][1][m][1] * rs;
                u32x4 w; w.x = cvt_pk_bf16(silu_f(g0[0]) * u0[0], silu_f(g0[1]) * u0[1]); w.y = cvt_pk_bf16(silu_f(g0[2]) * u0[2], silu_f(g0[3]) * u0[3]);
                w.z = cvt_pk_bf16(silu_f(g1[0]) * u1[0], silu_f(g1[1]) * u1[1]); w.w = cvt_pk_bf16(silu_f(g1[2]) * u1[2], silu_f(g1[3]) * u1[3]);
                *(u32x4*)(H + (size_t)row * ldh + hcol) = w; }
    }
};
struct EpiP {
    static constexpr bool PERM = true;
    bf16_t* P; int ldp; const float* part;
    __device__ __forceinline__ void operator()(const f32x4 (&acc)[2][2][4][2], const Unit& u, int wr, int wc, int fr, int fq) const {
        const int row0 = u.pm * BM + wr * 64 + fr, col0 = u.pn * BM + wc * 32 + 8 * fq;
#pragma unroll
        for (int ai = 0; ai < 2; ++ai)
#pragma unroll
            for (int m = 0; m < 4; ++m) { const int row = row0 + ai * HALF + m * 16; const float rs = row_rstd(part, row);
#pragma unroll
                for (int bj = 0; bj < 2; ++bj) { const f32x4 v0 = acc[ai][bj][m][0] * rs, v1 = acc[ai][bj][m][1] * rs;
                    u32x4 w; w.x = cvt_pk_bf16(v0[0], v0[1]); w.y = cvt_pk_bf16(v0[2], v0[3]); w.z = cvt_pk_bf16(v1[0], v1[1]); w.w = cvt_pk_bf16(v1[2], v1[3]);
                    *(u32x4*)(P + (size_t)row * ldp + col0 + bj * HALF) = w; } }
    }
};
struct EpiRes {
    static constexpr bool PERM = true;
    const float* base; bf16_t* xb; float* part;
    __device__ __forceinline__ void operator()(const f32x4 (&acc)[2][2][4][2], const Unit& u, int wr, int wc, int fr, int fq) const {
        const int row0 = u.pm * BM + wr * 64 + fr, col0 = u.pn * BM + wc * 32 + 8 * fq;
#pragma unroll
        for (int ai = 0; ai < 2; ++ai)
#pragma unroll
            for (int m = 0; m < 4; ++m) { const int row = row0 + ai * HALF + m * 16; float ss = 0.f;
#pragma unroll
                for (int bj = 0; bj < 2; ++bj) { const size_t off = (size_t)row * 1024 + col0 + bj * HALF;
                    f32x4 v0, v1;
                    if (base) { v0 = *(const f32x4*)(base + off); v1 = *(const f32x4*)(base + off + 4); }
                    else { const u32x4 xw = *(const u32x4*)(xb + off);
                        v0 = (f32x4){__builtin_bit_cast(float, xw.x << 16), __builtin_bit_cast(float, xw.x & 0xffff0000u), __builtin_bit_cast(float, xw.y << 16), __builtin_bit_cast(float, xw.y & 0xffff0000u)};
                        v1 = (f32x4){__builtin_bit_cast(float, xw.z << 16), __builtin_bit_cast(float, xw.z & 0xffff0000u), __builtin_bit_cast(float, xw.w << 16), __builtin_bit_cast(float, xw.w & 0xffff0000u)}; }
                    v0 += acc[ai][bj][m][0]; v1 += acc[ai][bj][m][1];
                    u32x4 w; w.x = cvt_pk_bf16(v0[0], v0[1]); w.y = cvt_pk_bf16(v0[2], v0[3]); w.z = cvt_pk_bf16(v1[0], v1[1]); w.w = cvt_pk_bf16(v1[2], v1[3]);
                    *(u32x4*)(xb + off) = w;
                    ss += (v0[0] * v0[0] + v0[1] * v0[1]) + (v0[2] * v0[2] + v0[3] * v0[3]) + (v1[0] * v1[0] + v1[1] * v1[1]) + (v1[2] * v1[2] + v1[3] * v1[3]); }
                ss += __shfl_xor(ss, 16); ss += __shfl_xor(ss, 32);
                if (fq == 0) part[(size_t)row * 16 + u.pn * 4 + wc] = ss;
                asm volatile("" ::: "memory"); }
    }
};

template <class Epi, class Sched, bool ALIGN_EPI>
__device__ __forceinline__ void gemm_phase(PG8_LAS unsigned char* lds, const Gemm g, const Sched& S, const Epi& E, const int tid) {
    const int wid = __builtin_amdgcn_readfirstlane(tid >> 6), lane = tid & 63, wr = wid >> 2, wc = wid & 3, fr = lane & 15, fq = lane >> 4;
    const int K = g.K, nt = K / BK, lda = g.lda;
    unsigned voffA[2], voffB[2];
#pragma unroll
    for (int i = 0; i < 2; ++i) { int R, C; stage_rc(tid * 16 + i * 8192, R, C); const int Rb = Epi::PERM ? ((R & ~31) + perm32(R & 31)) : R;
        voffA[i] = (unsigned)(R * lda + C) * 2u; voffB[i] = (unsigned)(Rb * K + C) * 2u; }
    const size_t kstep = (size_t)(BK * 2);
    const size_t hstepA = (size_t)HALF * lda * 2, hstepB = (size_t)HALF * K * 2;
    const size_t tstepA = 2 * hstepA, tstepB = 2 * hstepB;
    const unsigned ldsw = (unsigned)wid * 1024u;
    const int aoff = lds_byte(wr * 64 + fr, fq * 8), boff = lds_byte(wc * 32 + fr, fq * 8);
#define PG8_SA(b, h) (((b) * 2 + (h)) * HTB)
#define PG8_SB(b, h) ((4 + (b) * 2 + (h)) * HTB)
#define PG8_STAGE(bufoff, gbase, voff) do { _Pragma("unroll") for (int _i = 0; _i < 2; ++_i) \
        __builtin_amdgcn_global_load_lds((const unsigned*)((const char*)(gbase) + (voff)[_i]), (PG8_LAS unsigned*)(lds + (bufoff) + ldsw + _i * 8192), 16, 0, 0); } while (0)
#define PG8_LDA(dst, b, h) do { _Pragma("unroll") for (int m = 0; m < 4; ++m) _Pragma("unroll") for (int k = 0; k < 2; ++k) dst[m][k] = *(const PG8_LAS bf16x8*)(lds + PG8_SA(b, h) + aoff + m * 2048 + k * 1024); } while (0)
#define PG8_LDB(dst, b, h) do { _Pragma("unroll") for (int n = 0; n < 2; ++n) _Pragma("unroll") for (int k = 0; k < 2; ++k) dst[n][k] = *(const PG8_LAS bf16x8*)(lds + PG8_SB(b, h) + boff + n * 2048 + k * 1024); } while (0)
#define PG8_MMA(ai, bj, At, Bt) do { __builtin_amdgcn_s_setprio(1); _Pragma("unroll") for (int m = 0; m < 4; ++m) _Pragma("unroll") for (int n = 0; n < 2; ++n) _Pragma("unroll") for (int k = 0; k < 2; ++k) \
        acc[ai][bj][m][n] = __builtin_amdgcn_mfma_f32_16x16x32_bf16(Bt[n][k], At[m][k], acc[ai][bj][m][n], 0, 0, 0); __builtin_amdgcn_s_setprio(0); } while (0)
#define PG8_WAIT_V(n) asm volatile("s_waitcnt vmcnt(" #n ")" ::: "memory")
#define PG8_WAIT_L(n) asm volatile("s_waitcnt lgkmcnt(" #n ")" ::: "memory")
#define PG8_BAR __builtin_amdgcn_s_barrier()
#define PG8_SCHED __builtin_amdgcn_sched_barrier(0)
    Unit cur, nxt; int ui = 0;
    if (!S.next(0, cur)) return;
    f32x4 acc[2][2][4][2];
#pragma unroll
    for (int a = 0; a < 2; ++a)
#pragma unroll
        for (int b = 0; b < 2; ++b)
#pragma unroll
            for (int m = 0; m < 4; ++m)
#pragma unroll
                for (int n = 0; n < 2; ++n) acc[a][b][m][n] = (f32x4){0.f, 0.f, 0.f, 0.f};
    bf16x8 At[4][2], B0[2][2], B1[2][2];
    const char* cA = (const char*)g.A + (size_t)cur.pm * tstepA; const char* cB = (const char*)g.Bt + (size_t)cur.pn * tstepB;
    S.a_ready(cur);
    PG8_STAGE(PG8_SB(0, 0), cB, voffB); PG8_STAGE(PG8_SB(0, 1), cB + hstepB, voffB); PG8_STAGE(PG8_SA(0, 0), cA, voffA); PG8_STAGE(PG8_SA(0, 1), cA + hstepA, voffA);
    if (wr == 1) PG8_BAR;
    PG8_WAIT_V(2); PG8_BAR;
    PG8_STAGE(PG8_SB(1, 0), cB + kstep, voffB); PG8_STAGE(PG8_SA(1, 0), cA + kstep, voffA); PG8_STAGE(PG8_SB(1, 1), cB + hstepB + kstep, voffB);
    PG8_WAIT_V(6); PG8_BAR;
    for (;;) {
        const bool has_next = S.next(ui + 1, nxt);
        const char* nA = has_next ? (const char*)g.A + (size_t)nxt.pm * tstepA : cA; const char* nB = has_next ? (const char*)g.Bt + (size_t)nxt.pn * tstepB : cB;
        for (int t = 0; t < nt; t += 2) {
            const bool last = (t == nt - 2);
            const char* a1 = cA + (size_t)(t + 1) * kstep;
            const char* a2 = last ? nA : cA + (size_t)(t + 2) * kstep; const char* b2 = last ? nB : cB + (size_t)(t + 2) * kstep;
            const char* a3 = a2 + kstep; const char* b3 = b2 + kstep;
            if (last && has_next) S.a_ready(nxt);
            PG8_LDB(B0, 0, 0); PG8_LDB(B1, 0, 1); PG8_SCHED; PG8_LDA(At, 0, 0); PG8_STAGE(PG8_SA(1, 1), a1 + hstepA, voffA);
            PG8_WAIT_V(8); PG8_WAIT_L(0); PG8_BAR; PG8_MMA(0, 0, At, B0); PG8_MMA(0, 1, At, B1); PG8_BAR; PG8_SCHED;
            PG8_LDA(At, 0, 1); PG8_STAGE(PG8_SB(0, 0), b2, voffB); PG8_STAGE(PG8_SB(0, 1), b2 + hstepB, voffB); PG8_STAGE(PG8_SA(0, 0), a2, voffA);
            PG8_WAIT_V(8); PG8_WAIT_L(0); PG8_BAR; PG8_MMA(1, 0, At, B0); PG8_MMA(1, 1, At, B1); PG8_BAR; PG8_SCHED;
            PG8_LDB(B0, 1, 0); PG8_LDB(B1, 1, 1); PG8_SCHED; PG8_LDA(At, 1, 0); PG8_STAGE(PG8_SA(0, 1), a2 + hstepA, voffA);
            PG8_WAIT_V(8); PG8_WAIT_L(0); PG8_BAR; PG8_MMA(0, 0, At, B0); PG8_MMA(0, 1, At, B1); PG8_BAR; PG8_SCHED;
            PG8_LDA(At, 1, 1); PG8_STAGE(PG8_SB(1, 0), b3, voffB); PG8_STAGE(PG8_SB(1, 1), b3 + hstepB, voffB); PG8_STAGE(PG8_SA(1, 0), a3, voffA);
            PG8_WAIT_V(8); PG8_WAIT_L(0); PG8_BAR; PG8_MMA(1, 0, At, B0); PG8_MMA(1, 1, At, B1); PG8_BAR; PG8_SCHED;
        }
        if constexpr (ALIGN_EPI) { if (wr == 0) PG8_BAR; }
        E(acc, cur, wr, wc, fr, fq); S.done(cur);
        if (!has_next) break;
#pragma unroll
        for (int a = 0; a < 2; ++a)
#pragma unroll
            for (int b = 0; b < 2; ++b)
#pragma unroll
                for (int m = 0; m < 4; ++m)
#pragma unroll
                    for (int n = 0; n < 2; ++n) acc[a][b][m][n] = (f32x4){0.f, 0.f, 0.f, 0.f};
        cur = nxt; cA = nA; cB = nB; ++ui;
        if constexpr (ALIGN_EPI) { if (wr == 1) PG8_BAR; }
    }
    PG8_WAIT_V(0);
    if constexpr (!ALIGN_EPI) { if (wr == 0) PG8_BAR; }
    PG8_BAR;
#undef PG8_SA
#undef PG8_SB
#undef PG8_STAGE
#undef PG8_LDA
#undef PG8_LDB
#undef PG8_MMA
#undef PG8_WAIT_V
#undef PG8_WAIT_L
#undef PG8_BAR
#undef PG8_SCHED
}
}

constexpr int NWAVES = 8, NTHR = 512;
constexpr int BATCH = 8, SEQ = 2048, DM = 1024, DEPTH = 2, FF = 2752, M = BATCH * SEQ;
constexpr int FFP = 2816;
constexpr int NGU = 5632;
constexpr int PP = 3584;
constexpr int NIN = 3400;
constexpr int PA = 0, PMV = 1280, PBQ = 1296, PBC = 1680, PBIQ = 1808, PBIK = 2320, PBIW = 2384, PCQ = 2392, PCK = 2648, PCV = 2904, PCG = 3160, PUSED = 3416;
constexpr int AW = 384;
constexpr int TOPK = 256;

constexpr size_t MiB = 1u << 20;
constexpr size_t WS_CTL = 0, CTL_ZERO_BYTES = 1 * MiB;
constexpr size_t WS_PART = 1 * MiB;
constexpr size_t WS_TAB = 2 * MiB;
constexpr size_t WS_BON = 2 * MiB + 512 * 1024;
constexpr size_t WS_WUKT = 3 * MiB, WS_WUVT = 3 * MiB + 192 * 1024;
constexpr size_t WS_THR = 3 * MiB + 384 * 1024, WS_SCUT = 3 * MiB + 448 * 1024;
constexpr size_t WS_LORA = 3 * MiB + 512 * 1024;
constexpr size_t WS_WGU1 = 4 * MiB, WS_WD1 = 15 * MiB, WS_WIN = 21 * MiB, WS_WOUT = 28 * MiB, WS_WGU2 = 30 * MiB, WS_WD2 = 41 * MiB;
constexpr size_t WS_XB = 47 * MiB;
constexpr size_t WS_VF = 79 * MiB;
constexpr size_t WS_P = 91 * MiB;
constexpr size_t WS_H = WS_P;
constexpr size_t WS_R = 203 * MiB, WS_D = 215 * MiB, WS_K2 = 227 * MiB, WS_KK = 239 * MiB, WS_C = 251 * MiB;
constexpr size_t WS_KV = WS_XB + 24 * MiB;
constexpr size_t OUT_BP = 0, OUT_G = 12 * MiB, OUT_MASK = 24 * MiB;
constexpr size_t WS_END = 256 * MiB;
static_assert(WS_WD2 + (size_t)1024 * FFP * 2 <= WS_XB && WS_P + (size_t)M * PP * 2 <= WS_R && WS_C + (size_t)M * 128 * 2 <= WS_END, "ws map");
constexpr int CW_BAR = 4096;
constexpr int CW_QUEUE = 16384;

constexpr int RING_BYTES = 131072;
constexpr int LDSCTL_OFF = RING_BYTES, MISC_OFF = LDSCTL_OFF + 320;
constexpr int LDS_BYTES = 147456;

#define GAS __attribute__((address_space(1)))
#define LAS __attribute__((address_space(3)))
typedef unsigned short bf16;
typedef unsigned v4u __attribute__((ext_vector_type(4)));
typedef float f32x4 __attribute__((ext_vector_type(4)));
typedef GAS unsigned gu32;
#define RLX_AGENT __ATOMIC_RELAXED, __HIP_MEMORY_SCOPE_AGENT
#define LDS_WAIT() asm volatile("s_waitcnt lgkmcnt(0)" ::: "memory")
__device__ __forceinline__ unsigned f2bf(float f) { unsigned u = __builtin_bit_cast(unsigned, f); return (u + 0x7fffu + ((u >> 16) & 1u)) >> 16; }
typedef float f32x2v_ __attribute__((ext_vector_type(2))); typedef __bf16 bf16x2v_ __attribute__((ext_vector_type(2)));
__device__ __forceinline__ unsigned pk2(float lo, float hi) { const f32x2v_ v = {lo, hi}; return __builtin_bit_cast(unsigned, __builtin_convertvector(v, bf16x2v_)); }
__device__ __forceinline__ float bf2f(unsigned short v) { return __uint_as_float((unsigned)v << 16); }
__device__ __forceinline__ float bflo(unsigned w) { return __uint_as_float(w << 16); }
__device__ __forceinline__ float bfhi(unsigned w) { return __uint_as_float(w & 0xffff0000u); }
__device__ __forceinline__ void unpack8(const v4u w, float (&f)[8]) { f[0] = bflo(w.x); f[1] = bfhi(w.x); f[2] = bflo(w.y); f[3] = bfhi(w.y); f[4] = bflo(w.z); f[5] = bfhi(w.z); f[6] = bflo(w.w); f[7] = bfhi(w.w); }
__device__ __forceinline__ float sigmoid_f(float x) { return 1.0f / (1.0f + __expf(-x)); }
__device__ __forceinline__ float wave_sum(float v) {
#pragma unroll
    for (int o = 1; o < 64; o <<= 1) v += __shfl_xor(v, o);
    return v;
}

#define XB_TMO      128
#define XB_XCNT(j)  (256  + 64 * (j))
#define XB_XSUB(j)  (1280 + 64 * (j))
#define XB_XGEN(j)  (2304 + 64 * (j))
#define XB_TOP      3328
#define XB_TOPGEN   3392
#define XCD_BAR_WORDS 3456
#define XB_SPIN_CAP (1u << 22)

__device__ __forceinline__ unsigned xb_ld(unsigned* p)              { return __hip_atomic_load(p, __ATOMIC_RELAXED, __HIP_MEMORY_SCOPE_AGENT); }
__device__ __forceinline__ unsigned xb_add(unsigned* p, unsigned v) { return __hip_atomic_fetch_add(p, v, __ATOMIC_RELAXED, __HIP_MEMORY_SCOPE_AGENT); }
__device__ __forceinline__ unsigned xb_xcc_id() { return (unsigned)__builtin_amdgcn_s_getreg((3 << 11) | 20) & 0xFu; }
#define XB_SPIN(cond, bar) do { unsigned _sp = 0; while (cond) { __builtin_amdgcn_s_sleep(1); \
    if ((++_sp & 255u) == 0u) { if (xb_ld(&(bar)[XB_TMO])) break; if (_sp > XB_SPIN_CAP) { atomicAdd(&(bar)[XB_TMO], 1u); break; } } } } while (0)

struct XcdBarrier { unsigned* bar; unsigned x; volatile LAS unsigned* st; };

__device__ __forceinline__ XcdBarrier xcd_barrier_post(unsigned* bar, volatile LAS unsigned* st) {
    XcdBarrier b; b.bar = bar; b.x = xb_xcc_id(); b.st = st;
    if (threadIdx.x == 0) (void)xb_add(&bar[XB_XCNT(b.x)], 1u);
    return b;
}
__device__ __forceinline__ void xcd_barrier_complete(unsigned* bar, unsigned x, unsigned& nloc, unsigned& nx) {
    const unsigned G = gridDim.x * gridDim.y * gridDim.z;
    unsigned sum, cnt, mine, sp = 0u;
    for (;;) {
        sum = 0u; cnt = 0u; mine = 0u;
#pragma unroll
        for (unsigned j = 0; j < 16; ++j) { const unsigned c = xb_ld(&bar[XB_XCNT(j)]); sum += c; cnt += (c > 0u) ? 1u : 0u; mine = (j == x) ? c : mine; }
        if (sum == G) break;
        __builtin_amdgcn_s_sleep(1);
        if ((++sp & 255u) == 0u) { if (xb_ld(&bar[XB_TMO])) break; if (sp > XB_SPIN_CAP) { atomicAdd(&bar[XB_TMO], 1u); break; } }
    }
    nloc = mine > 0u ? mine : 1u; nx = cnt > 0u ? cnt : 1u;
}
__device__ __forceinline__ void xcd_barrier(const XcdBarrier& b) {
    asm volatile("s_waitcnt vmcnt(0)" ::: "memory");
    __syncthreads();
    if (threadIdx.x == 0) {
        unsigned* bar = b.bar;
        __builtin_amdgcn_s_waitcnt(0);
        unsigned nloc = b.st[0], nx = b.st[1];
        if (nloc == 0u) { xcd_barrier_complete(bar, b.x, nloc, nx); b.st[0] = nloc; b.st[1] = nx; }
        const unsigned old = xb_add(&bar[XB_XSUB(b.x)], 1u);
        const unsigned gen = old / nloc;
        if (old + 1u == (gen + 1u) * nloc) {
            __builtin_amdgcn_fence(__ATOMIC_RELEASE, "agent");
            asm volatile("s_waitcnt vmcnt(0)" ::: "memory");
            const unsigned og = xb_add(&bar[XB_TOP], 1u);
            const unsigned tg = og / nx;
            if (og + 1u == (tg + 1u) * nx) xb_add(&bar[XB_TOPGEN], 1u);
            else XB_SPIN(xb_ld(&bar[XB_TOPGEN]) == tg, bar);
            __builtin_amdgcn_fence(__ATOMIC_ACQUIRE, "agent");
            xb_add(&bar[XB_XGEN(b.x)], 1u);
            asm volatile("s_waitcnt vmcnt(0)" ::: "memory");
        } else {
            XB_SPIN(xb_ld(&bar[XB_XGEN(b.x)]) == gen, bar);
            __builtin_amdgcn_fence(__ATOMIC_ACQUIRE, "agent");
            asm volatile("s_waitcnt vmcnt(0)" ::: "memory");
        }
    }
    __syncthreads();
}

#ifndef DIAG_SLOT_D
#define DIAG_SLOT_D (-1)
#endif
#ifndef DIAG_DIV
#define DIAG_DIV 1.0f
#endif
constexpr size_t WS_DIAG = 3 * MiB + 900 * 1024;
#define DG_START(k, var) unsigned var = 0; if (DIAG_SLOT_D == (k)) var = (unsigned)__builtin_amdgcn_s_memtime();
#define DG_STOP(k, var, acc) if (DIAG_SLOT_D == (k)) acc += (unsigned)__builtin_amdgcn_s_memtime() - var;
#define DG_WRITE(k, cond, acc) if (DIAG_SLOT_D == (k) && (cond)) ((unsigned*)(F.ws + WS_DIAG))[0] = acc;
struct Args { const float* in[31]; float* out; unsigned char* ws; int ph_lo, ph_hi; int dup_phase, qdup, rep_scan, rep_thr; int stag_up, stag_in; };
struct Frame {
    LAS unsigned char* lds;
    int tid, lane, wave, vcu, G;
    const float* const __attribute__((address_space(4)))* in;
    float* out; unsigned char* ws;
};
enum { I_X = 0, I_F1N, I_F1G, I_F1U, I_F1D, I_MIXN, I_WIN, I_WOUT, I_MU, I_W0, I_W2, I_A0, I_A2, I_G2, I_KK, I_KA, I_RK, I_LNW, I_LNB, I_VRW, I_VRMU, I_V0, I_V2, I_KVN, I_WUK, I_WUV, I_F2N, I_F2G, I_F2U, I_F2D, I_FN };

__device__ __forceinline__ void conv_item(const Frame& F, int l, int kind, int item, LAS float* scr) {
    const int lane = F.lane;
    int Kd, nkb; bf16* WT;
    if (kind == 0 || kind == 4) { Kd = 1024; WT = (bf16*)(F.ws + (kind == 0 ? WS_WGU1 : WS_WGU2)); }
    else if (kind == 1 || kind == 5) { Kd = FFP; WT = (bf16*)(F.ws + (kind == 1 ? WS_WD1 : WS_WD2)); }
    else if (kind == 2) { Kd = 1024; WT = (bf16*)(F.ws + WS_WIN); }
    else { Kd = 1024; WT = (bf16*)(F.ws + WS_WOUT); }
    nkb = Kd / 64;
    const int rb = item / nkb, kb = item % nkb, r0 = rb * 32, k0 = kb * 64;
    const int n4 = (lane & 7) * 4, kr = lane >> 3;
    const int rr = r0 + n4;
    const float* src = nullptr; int ns = 0, col = 0, ksrc = 1024; const float* gain = nullptr; float scale = 1.0f;
    if (kind == 0 || kind == 4) {
        const int tile = rr >> 8, w = rr & 255, hid = tile * 128 + (w & 127);
        if (hid < FF) { const float* s1 = (w >> 7) ? F.in[I_F1U] : F.in[I_F1G]; const float* s2 = (w >> 7) ? F.in[I_F2U] : F.in[I_F2G]; src = ((kind == 0) ? s1 : s2) + (size_t)l * 1024 * FF; ns = FF; col = hid; }
        gain = ((kind == 0) ? F.in[I_F1N] : F.in[I_F2N]) + l * 1024;
    } else if (kind == 1 || kind == 5) {
        src = ((kind == 1) ? F.in[I_F1D] : F.in[I_F2D]) + (size_t)l * FF * 1024; ns = 1024; col = rr; ksrc = FF; scale = 0.5f;
    } else if (kind == 2) {
        gain = F.in[I_MIXN] + l * 1024;
        if (rr < 1280) { src = F.in[I_WIN] + (size_t)l * 1024 * NIN; ns = NIN; col = rr; }
        else if (rr < 1296) { if (l > 0) { src = F.in[I_VRW] + (size_t)(l - 1) * 1024 * 16; ns = 16; col = rr - 1280; } }
        else if (rr < PUSED) { src = F.in[I_WIN] + (size_t)l * 1024 * NIN; ns = NIN; col = rr - 16; }
    } else { src = F.in[I_WOUT] + (size_t)l * 1024 * 1024; ns = 1024; col = rr; }
    {
        const bool has = (src != nullptr); const float* sp = has ? src : F.in[I_FN]; const int nss = has ? ns : 0, cols = has ? col : 0;
        f32x4 vals[8];
#pragma unroll
        for (int i = 0; i < 8; ++i) { const int k = k0 + 8 * i + kr; const int kc = k < ksrc ? k : ksrc - 1; vals[i] = *(const GAS f32x4*)(sp + (size_t)kc * nss + cols); }
#pragma unroll
        for (int i = 0; i < 8; ++i) { const int kk = 8 * i + kr, k = k0 + kk; float g = (has && k < ksrc) ? scale : 0.f; if (gain) g *= gain[k < 1024 ? k : 1023];
            LAS float* d = scr + kk * 33 + n4; d[0] = vals[i][0] * g; d[1] = vals[i][1] * g; d[2] = vals[i][2] * g; d[3] = vals[i][3] * g; }
    }
    LDS_WAIT(); asm volatile("" ::: "memory");
    const int c = lane & 7;
#pragma unroll
    for (int j = 0; j < 4; ++j) { const int n = (lane >> 3) + 8 * j; const LAS float* s = scr + (8 * c) * 33 + n;
        v4u o; o.x = pk2(s[0 * 33], s[1 * 33]); o.y = pk2(s[2 * 33], s[3 * 33]); o.z = pk2(s[4 * 33], s[5 * 33]); o.w = pk2(s[6 * 33], s[7 * 33]);
        *(GAS v4u*)(WT + (size_t)(r0 + n) * Kd + k0 + 8 * c) = o; }
    LDS_WAIT(); asm volatile("" ::: "memory");
}
__host__ __device__ constexpr int conv_items(int kind) { return (kind == 0 || kind == 4) ? (NGU / 32) * 16 : (kind == 1 || kind == 5) ? 32 * (FFP / 64) : (kind == 2) ? (PP / 32) * 16 : 32 * 16; }
__device__ __forceinline__ void conv_weights(const Frame& F, int l, int k_lo, int k_hi) {
    LAS float* scr = (LAS float*)(F.lds + F.wave * 16384);
    const int gw = F.vcu * NWAVES + F.wave, NGW = F.G * NWAVES;
    for (int kind = k_lo; kind < k_hi; ++kind) { const int ni = conv_items(kind);
        for (int it = gw; it < ni; it += NGW) conv_item(F, l, kind, it, scr); }
}

__host__ __device__ constexpr int conv_flat_items(bool has_next) { return conv_items(3) + conv_items(4) + conv_items(5) + (has_next ? conv_items(0) + conv_items(1) + conv_items(2) : 0); }
constexpr int CONV_PER_WAVE = 2;
__device__ __forceinline__ void conv_unit(const Frame& F, int l, int u) {
    LAS float* scr = (LAS float*)(F.lds + F.wave * 16384);
    const bool has_next = (l + 1 < DEPTH);
#pragma unroll 1
    for (int rep = 0; rep < CONV_PER_WAVE; ++rep) {
    int it = (u * CONV_PER_WAVE + rep) * NWAVES + F.wave;
    if (it >= conv_flat_items(has_next)) return;
    int layer = l, kind = 3;
    if (it >= conv_items(3)) { it -= conv_items(3); kind = 4;
        if (it >= conv_items(4)) { it -= conv_items(4); kind = 5;
            if (it >= conv_items(5)) { it -= conv_items(5); kind = 0; layer = l + 1;
                if (it >= conv_items(0)) { it -= conv_items(0); kind = 1;
                    if (it >= conv_items(1)) { it -= conv_items(1); kind = 2; } } } } }
    conv_item(F, layer, kind, it, scr);
    }
}
__device__ __forceinline__ void p0_x(const Frame& F) {
    const int gw = F.vcu * NWAVES + F.wave, NGW = F.G * NWAVES;
    const float* x = F.in[I_X]; bf16* xb = (bf16*)(F.ws + WS_XB); float* part = (float*)(F.ws + WS_PART);
    for (int m = gw; m < M; m += NGW) {
        const GAS f32x4* xr = (const GAS f32x4*)(x + (size_t)m * DM) + F.lane; float s = 0.f;
        GAS unsigned long long* o8 = (GAS unsigned long long*)(xb + (size_t)m * DM) + F.lane;
#pragma unroll
        for (int j = 0; j < 4; ++j) { const f32x4 v = xr[64 * j]; s += (v.x * v.x + v.y * v.y) + (v.z * v.z + v.w * v.w);
            o8[64 * j] = (unsigned long long)pk2(v.x, v.y) | ((unsigned long long)pk2(v.z, v.w) << 32); }
        s = wave_sum(s);
        if (F.lane < 16) part[(size_t)m * 16 + F.lane] = (F.lane == 0) ? s : 0.f;
    }
}
__device__ __forceinline__ void p0_table(const Frame& F) {
    float* tab = (float*)(F.ws + WS_TAB);
    for (int i = F.vcu * NTHR + F.tid; i < SEQ * 32; i += F.G * NTHR) { const int t = i >> 5, f = i & 31; const float th = exp2f(-(float)f * (13.287712379549449f / 31.0f)); const float ang = (float)t * th; float s, c; sincosf(ang, &s, &c); tab[2 * i] = c; tab[2 * i + 1] = s; }
}

__device__ __forceinline__ void ret_kv_unit(const Frame& F, int unit) {
    unsigned dga_ = 0;
    DG_START(30, dg30_)
    LAS float* kr = (LAS float*)F.lds; LAS float* vv = kr + 128 * 64;
    const int tid = F.tid, c = unit & 15, h = (unit >> 4) & 3, b = unit >> 6, tok0 = b * SEQ + c * 128;
    const bf16* P = (const bf16*)(F.ws + WS_P); const float* tab = (const float*)(F.ws + WS_TAB);
    const float lg2 = log2f(1.0f - exp2f(-5.0f - (float)h));
    for (int idx = tid; idx < 128 * 32; idx += NTHR) { const int m = idx >> 5, i = idx & 31; const size_t ro = (size_t)(tok0 + m) * PP;
        const float k1 = bf2f(P[ro + PCK + h * 64 + i]), k2 = bf2f(P[ro + PCK + h * 64 + 32 + i]);
        const float cs = tab[((c * 128 + m) * 32 + i) * 2], sn = tab[((c * 128 + m) * 32 + i) * 2 + 1];
        const float sc = 0.125f * exp2f((float)(127 - m) * lg2);
        kr[m * 64 + i] = (k1 * cs - k2 * sn) * sc; kr[m * 64 + 32 + i] = (k1 * sn + k2 * cs) * sc;
        vv[m * 64 + i] = bf2f(P[ro + PCV + h * 64 + i]); vv[m * 64 + 32 + i] = bf2f(P[ro + PCV + h * 64 + 32 + i]); }
    __syncthreads();
    const int d = tid >> 3, e0 = (tid & 7) * 8; float acc[8];
#pragma unroll
    for (int e = 0; e < 8; ++e) acc[e] = 0.f;
    for (int m = 0; m < 128; ++m) { const float kd = kr[m * 64 + d];
#pragma unroll
        for (int e = 0; e < 8; ++e) acc[e] += kd * vv[m * 64 + e0 + e]; }
    float* KV = (float*)(F.ws + WS_KV) + (size_t)unit * 4096 + d * 64 + e0;
#pragma unroll
    for (int e = 0; e < 8; ++e) KV[e] = acc[e];
    __syncthreads();
    DG_STOP(30, dg30_, dga_)
    DG_WRITE(30, unit == 0 && F.wave == 0 && F.lane == 0, dga_)
}

typedef float f32x2 __attribute__((ext_vector_type(2)));
__device__ __forceinline__ float dpp_add16(float x) {
    x += __builtin_bit_cast(float, __builtin_amdgcn_mov_dpp(__builtin_bit_cast(int, x), 0xB1, 0xF, 0xF, true));
    x += __builtin_bit_cast(float, __builtin_amdgcn_mov_dpp(__builtin_bit_cast(int, x), 0x4E, 0xF, 0xF, true));
    x += __builtin_bit_cast(float, __builtin_amdgcn_mov_dpp(__builtin_bit_cast(int, x), 0x141, 0xF, 0xF, true));
    x += __builtin_bit_cast(float, __builtin_amdgcn_mov_dpp(__builtin_bit_cast(int, x), 0x140, 0xF, 0xF, true));
    return x;
}
constexpr int CH = 32;
constexpr int RW_STG = 5 * CH * 64;
constexpr int RW_ROWS = 16;
struct RwOps { f32x4 r, d, k, q, b; float v; };
__device__ __forceinline__ void rw_ld(RwOps& o, const LAS float* base, const LAS float* vb, int s, int ks, int row) {
    const LAS f32x4* p = (const LAS f32x4*)(base + s * 64 + ks * 4);
    o.r = p[0]; o.d = p[CH * 16]; o.k = p[2 * CH * 16]; o.q = p[3 * CH * 16]; o.b = p[4 * CH * 16];
    o.v = vb[s * RW_ROWS + row];
}
#define LO2(x) __builtin_shufflevector(x, x, 0, 1)
#define HI2(x) __builtin_shufflevector(x, x, 2, 3)
__device__ __forceinline__ float rw_step1(f32x2 (&S)[2], const RwOps& o, float v) {
    f32x2 p2 = S[0] * LO2(o.q); p2 = S[1] * HI2(o.q) + p2;
    const float p = dpp_add16(p2.x + p2.y);
    const f32x2 pp = (f32x2){p, p}, vv = (f32x2){v, v};
    S[0] = S[0] - LO2(o.d) * S[0]; S[1] = S[1] - HI2(o.d) * S[1];
    S[0] = S[0] - pp * LO2(o.b); S[1] = S[1] - pp * HI2(o.b);
    S[0] = vv * LO2(o.k) + S[0]; S[1] = vv * HI2(o.k) + S[1];
    f32x2 y2 = S[0] * LO2(o.r); y2 = S[1] * HI2(o.r) + y2;
    return dpp_add16(y2.x + y2.y);
}
__device__ __forceinline__ void rwkv_scan_unit(const Frame& F, int l, int unit) {
    const int tid = F.tid, lane = F.lane, wave = F.wave, quarter = unit & 3, bh = unit >> 2, b = bh / 6, h = bh - b * 6, tokb = b * SEQ;
    LAS float* stg = (LAS float*)F.lds; LAS float* vst = stg + 2 * RW_STG; LAS float* ybuf = vst + 2 * CH * RW_ROWS;
    bf16* P = (bf16*)(F.ws + WS_P);
    constexpr int NCH = SEQ / CH;
    unsigned dga_ = 0;
    if (wave >= 4) {
        const int st = tid - 256;
        const int t01 = st >> 3, c01 = st & 7, tv = st >> 1, cv = st & 1;
        const bf16* a0 = (const bf16*)(F.ws + WS_R); const bf16* a1 = (const bf16*)(F.ws + WS_D); const bf16* a2 = (const bf16*)(F.ws + WS_K2); const bf16* a3 = (const bf16*)(F.ws + WS_KK);
        const bf16* a4 = (const bf16*)((const unsigned char*)F.out + OUT_BP); const bf16* a5 = (const bf16*)(F.ws + WS_VF);
        v4u sreg[6];
#define RW_LOAD(cc) do { const size_t o_ = (size_t)(tokb + (cc) * CH + t01) * AW + h * 64 + c01 * 8; sreg[0] = *(const GAS v4u*)(a0 + o_); sreg[1] = *(const GAS v4u*)(a1 + o_); sreg[2] = *(const GAS v4u*)(a2 + o_); \
            sreg[3] = *(const GAS v4u*)(a3 + o_); sreg[4] = *(const GAS v4u*)(a4 + o_); if (st < 64) sreg[5] = *(const GAS v4u*)(a5 + (size_t)(tokb + (cc) * CH + tv) * AW + h * 64 + quarter * RW_ROWS + cv * 8); } while (0)
#define RW_ST1(i, dstp) do { float f[8]; unpack8(sreg[i], f); LAS f32x4* dst = (LAS f32x4*)(dstp); dst[0] = (f32x4){f[0], f[1], f[2], f[3]}; dst[1] = (f32x4){f[4], f[5], f[6], f[7]}; } while (0)
#define RW_STORE(bufi) do { _Pragma("unroll") for (int i = 0; i < 5; ++i) RW_ST1(i, stg + (bufi) * RW_STG + i * CH * 64 + t01 * 64 + c01 * 8); if (st < 64) RW_ST1(5, vst + (bufi) * CH * RW_ROWS + tv * RW_ROWS + cv * 8); } while (0)
#define RW_OUT(cc) do { if (st < 128) { const LAS float* yb_ = ybuf + ((cc) & 1) * CH * RW_ROWS; const int s_ = st >> 2, r4_ = (st & 3) * 4; const f32x4 yv = *(const LAS f32x4*)(yb_ + s_ * RW_ROWS + r4_); \
            *(GAS unsigned long long*)(P + (size_t)(tokb + (cc) * CH + s_) * PP + h * 64 + quarter * RW_ROWS + r4_) = (unsigned long long)pk2(yv[0], yv[1]) | ((unsigned long long)pk2(yv[2], yv[3]) << 32); } } while (0)
        RW_LOAD(0); RW_STORE(0); RW_LOAD(1);
        __syncthreads();
        for (int cc = 0; cc < NCH; ++cc) {
            if (cc + 1 < NCH) RW_STORE((cc + 1) & 1);
            if (cc + 2 < NCH) RW_LOAD(cc + 2);
            if (cc > 0) RW_OUT(cc - 1);
            asm volatile("s_waitcnt lgkmcnt(0)" ::: "memory"); __builtin_amdgcn_s_barrier(); asm volatile("" ::: "memory");
        }
        RW_OUT(NCH - 1);
#undef RW_LOAD
#undef RW_ST1
#undef RW_STORE
#undef RW_OUT
        return;
    }
    const int row = 4 * wave + (lane >> 4), ks = lane & 15;
    f32x2 Sa[2] = {(f32x2){0.f, 0.f}, (f32x2){0.f, 0.f}};
    __syncthreads();
    for (int cc = 0; cc < NCH; ++cc) {
        const int bufi = cc & 1;
        const LAS float* base = stg + bufi * RW_STG; const LAS float* vb = vst + bufi * CH * RW_ROWS; LAS float* yb = ybuf + bufi * CH * RW_ROWS;
        RwOps A, B; float yk0 = 0.f;
        DG_START(40, dg40_)
        rw_ld(A, base, vb, 0, ks, row);
#pragma unroll
        for (int s = 0; s < CH; s += 2) {
            rw_ld(B, base, vb, s + 1, ks, row);
            { const float y0 = rw_step1(Sa, A, A.v); yk0 = (ks == (s & 15)) ? y0 : yk0; }
            if (s + 2 < CH) rw_ld(A, base, vb, s + 2, ks, row);
            { const float y0 = rw_step1(Sa, B, B.v); yk0 = (ks == ((s + 1) & 15)) ? y0 : yk0; }
            if (((s + 1) & 15) == 15) yb[(s - 14 + ks) * RW_ROWS + row] = yk0;
        }
        DG_STOP(40, dg40_, dga_)
        DG_START(43, dg43_)
        asm volatile("s_waitcnt lgkmcnt(0)" ::: "memory"); __builtin_amdgcn_s_barrier(); asm volatile("" ::: "memory");
        DG_STOP(43, dg43_, dga_)
    }
    DG_WRITE(40, unit == 0 && l == 0 && wave == 0 && lane == 0, dga_)
    DG_WRITE(43, unit == 0 && l == 0 && wave == 0 && lane == 0, dga_)
}
__device__ __forceinline__ void rwkv_post(const Frame& F, int l) {
    bf16* P = (bf16*)(F.ws + WS_P); const bf16* VF = (const bf16*)(F.ws + WS_VF); const bf16* Gg = (const bf16*)((const unsigned char*)F.out + OUT_G); const float* BON = (const float*)(F.ws + WS_BON);
    const int sub = F.tid >> 4, c4 = (F.tid & 15) * 4;
    for (int pr = F.vcu * 32 + sub; pr < M * 6; pr += F.G * 32) { const int tok = pr / 6, h = pr - tok * 6;
        const unsigned long long yw = *(const GAS unsigned long long*)(P + (size_t)tok * PP + h * 64 + c4), vw = *(const GAS unsigned long long*)(VF + (size_t)tok * AW + h * 64 + c4), gw = *(const GAS unsigned long long*)(Gg + (size_t)tok * AW + h * 64 + c4);
        const f32x4 lnw = *(const f32x4*)(F.in[I_LNW] + l * AW + h * 64 + c4), lnb = *(const f32x4*)(F.in[I_LNB] + l * AW + h * 64 + c4);
        const float bon = BON[(size_t)tok * 6 + h];
        const f32x4 yv = (f32x4){bflo((unsigned)yw), bfhi((unsigned)yw), bflo((unsigned)(yw >> 32)), bfhi((unsigned)(yw >> 32))};
        const f32x4 vv = (f32x4){bflo((unsigned)vw), bfhi((unsigned)vw), bflo((unsigned)(vw >> 32)), bfhi((unsigned)(vw >> 32))};
        const f32x4 gg = (f32x4){bflo((unsigned)gw), bfhi((unsigned)gw), bflo((unsigned)(gw >> 32)), bfhi((unsigned)(gw >> 32))};
        float sm = (yv[0] + yv[1]) + (yv[2] + yv[3]);
        sm += __shfl_xor(sm, 1); sm += __shfl_xor(sm, 2); sm += __shfl_xor(sm, 4); sm += __shfl_xor(sm, 8);
        const float mean = sm * (1.0f / 64.0f); const f32x4 dv = yv - mean;
        float vs = (dv[0] * dv[0] + dv[1] * dv[1]) + (dv[2] * dv[2] + dv[3] * dv[3]);
        vs += __shfl_xor(vs, 1); vs += __shfl_xor(vs, 2); vs += __shfl_xor(vs, 4); vs += __shfl_xor(vs, 8);
        const float rs = 1.0f / sqrtf(vs * (1.0f / 64.0f) + 64e-5f);
        const f32x4 o = (dv * rs * lnw + lnb + bon * vv) * gg;
        *(GAS unsigned long long*)(P + (size_t)tok * PP + h * 64 + c4) = (unsigned long long)pk2(o[0], o[1]) | ((unsigned long long)pk2(o[2], o[3]) << 32);
    }
}

typedef short bf16x8_t __attribute__((ext_vector_type(8)));
typedef short s16x4_t __attribute__((ext_vector_type(4)));
typedef float f32x16_t __attribute__((ext_vector_type(16)));
__device__ __forceinline__ unsigned fkey(float f) { const unsigned u = __float_as_uint(f); return (u & 0x80000000u) ? ~u : (u | 0x80000000u); }
__device__ __forceinline__ int crow32(int r, int hi) { return (r & 3) + 8 * (r >> 2) + 4 * hi; }
__device__ __forceinline__ unsigned off_a(unsigned row, unsigned ch) { return 2048u * (row >> 3) + 512u * (ch >> 2) + 64u * (row & 7) + 16u * ((ch & 3) ^ ((row >> 2) & 3)); }

__device__ __forceinline__ void idx_scores(const bf16x8_t (&Af)[2], const bf16x8_t (&Bf)[8][2], const float (&iwf)[8], float (&sc)[4]) {
    sc[0] = sc[1] = sc[2] = sc[3] = 0.f;
#pragma unroll
    for (int h = 0; h < 8; ++h) { f32x4 a = (f32x4){0.f, 0.f, 0.f, 0.f};
        a = __builtin_amdgcn_mfma_f32_16x16x32_bf16(Af[0], Bf[h][0], a, 0, 0, 0);
        a = __builtin_amdgcn_mfma_f32_16x16x32_bf16(Af[1], Bf[h][1], a, 0, 0, 0);
#pragma unroll
        for (int r = 0; r < 4; ++r) { const float av_ = a[r]; const int ai_ = __float_as_int(av_); const float rl = __int_as_float(ai_ > 0 ? ai_ : 0); sc[r] = fmaf(iwf[h], rl, sc[r]); } }
}
__device__ __forceinline__ void idx_load_q(const bf16* P, int tokq, bf16x8_t (&Bf)[8][2], float (&iwf)[8], int fq) {
    const bf16* row = P + (size_t)tokq * PP;
#pragma unroll
    for (int h = 0; h < 8; ++h)
#pragma unroll
        for (int ks = 0; ks < 2; ++ks) Bf[h][ks] = *(const GAS bf16x8_t*)(row + PBIQ + h * 64 + ks * 32 + fq * 8);
    const v4u w = *(const GAS v4u*)(row + PBIW); float f[8]; unpack8(w, f);
#pragma unroll
    for (int h = 0; h < 8; ++h) iwf[h] = f[h] * (0.35355339059327373f * 0.125f);
}

__device__ __forceinline__ void lds_barrier() { asm volatile("s_waitcnt lgkmcnt(0)" ::: "memory"); __builtin_amdgcn_s_barrier(); asm volatile("" ::: "memory"); }
constexpr int SKP = 2052;
__device__ __forceinline__ void dsa_thr_unit(const Frame& F, int unit) {
    LAS unsigned* sk = (LAS unsigned*)F.lds;
    const int lane = F.lane, wave = F.wave, fr = lane & 15, fq = lane >> 4;
    const int b = unit & 7, qb = 127 - (unit >> 3), t0 = qb * 16, tok0 = b * SEQ + t0;
    const bf16* P = (const bf16*)(F.ws + WS_P);
    unsigned dga_ = 0;
    DG_START(10, dg10_)
    {
        bf16x8_t Bf[8][2]; float iwf[8];
        idx_load_q(P, tok0 + fr, Bf, iwf, fq);
        bf16x8_t An[2];
        { const int kt0 = wave <= qb ? wave : qb; const bf16* krow = P + (size_t)(b * SEQ + kt0 * 16 + fr) * PP + PBIK + fq * 8; An[0] = *(const GAS bf16x8_t*)(krow); An[1] = *(const GAS bf16x8_t*)(krow + 32); }
        for (int kt = wave; kt <= qb; kt += 8) {
            bf16x8_t Af[2]; Af[0] = An[0]; Af[1] = An[1];
            { const int ktn = kt + 8 <= qb ? kt + 8 : qb; const bf16* krow = P + (size_t)(b * SEQ + ktn * 16 + fr) * PP + PBIK + fq * 8; An[0] = *(const GAS bf16x8_t*)(krow); An[1] = *(const GAS bf16x8_t*)(krow + 32); }
            float sc[4]; idx_scores(Af, Bf, iwf, sc);
            v4u kv;
            const int s0 = kt * 16 + 4 * fq, t = t0 + fr;
            kv.x = (s0 + 0 <= t) ? fkey(sc[0]) : 0u; kv.y = (s0 + 1 <= t) ? fkey(sc[1]) : 0u; kv.z = (s0 + 2 <= t) ? fkey(sc[2]) : 0u; kv.w = (s0 + 3 <= t) ? fkey(sc[3]) : 0u;
            *(LAS v4u*)(sk + fr * SKP + s0) = kv;
        }
    }
    __syncthreads();
    DG_STOP(10, dg10_, dga_)
    DG_WRITE(10, unit == 0 && wave == 0 && lane == 0, dga_)
    DG_START(11, dg11_)
    unsigned* THR = (unsigned*)(F.ws + WS_THR); int* SCUT = (int*)(F.ws + WS_SCUT);
    for (int qi = 0; qi < 2; ++qi) { const int q = 2 * wave + qi, t = t0 + q, n = t + 1;
        unsigned thr = 0u; int scut = SEQ - 1;
        if (n > TOPK) {
            unsigned keys[32];
#pragma unroll
            for (int i = 0; i < 32; ++i) keys[i] = (64 * i + lane <= t) ? sk[q * SKP + 64 * i + lane] : 0u;
            unsigned prefix = 0u; bool done = false;
            const int ng = (t >> 9) + 1;
            for (int bit = 31; bit >= 0; --bit) { const unsigned cand = prefix | (1u << bit); int cnt = 0;
#pragma unroll
                for (int g = 0; g < 4; ++g) if (g < ng) {
#pragma unroll
                    for (int i = 8 * g; i < 8 * g + 8; ++i) cnt += __popcll(__ballot(keys[i] >= cand)); }
                if (cnt >= TOPK) prefix = cand;
                if (cnt == TOPK) { thr = cand - 1u; scut = -1; done = true; break; } }
            if (!done) {
                int cgt = 0;
#pragma unroll
                for (int i = 0; i < 32; ++i) cgt += __popcll(__ballot(keys[i] > prefix));
                int need = TOPK - cgt, run = 0; thr = prefix; scut = SEQ - 1; bool found = false;
#pragma unroll
                for (int i = 0; i < 32; ++i) { unsigned long long mk = __ballot(keys[i] == prefix); const int c = __popcll(mk);
                    if (!found && run + c >= need) { int k = need - run; while (k > 1) { mk &= mk - 1ull; --k; } scut = 64 * i + (int)__builtin_ctzll(mk); found = true; }
                    run += c; }
            }
        }
        {
            unsigned* MK = (unsigned*)((unsigned char*)F.out + OUT_MASK) + (size_t)(tok0 + q) * 64;
            if (n > TOPK) {
#pragma unroll
                for (int i = 0; i < 32; ++i) { const int s = 64 * i + lane; const unsigned key = (s <= t) ? sk[q * SKP + s] : 0u;
                    const unsigned long long bal = __ballot((s <= t) & ((key > thr) | ((key == thr) & (s <= scut))));
                    if (lane < 2 && 64 * i <= t) MK[2 * i + lane] = lane ? (unsigned)(bal >> 32) : (unsigned)bal; }
            } else {
                if (lane < 8) { const int w0 = lane; MK[w0] = (32 * w0 + 31 <= t) ? 0xffffffffu : ((32 * w0 <= t) ? ((1u << ((t & 31) + 1)) - 1u) : 0u); }
            }
        }
    }
    DG_STOP(11, dg11_, dga_)
    DG_WRITE(11, unit == 0 && wave == 0 && lane == 0, dga_)
    __syncthreads();
}

constexpr int QLP = 136;
constexpr int MKP = 36;
constexpr int DA_MASK = 0, DA_QL = 2 * 32 * MKP * 4, DA_CT = DA_QL + 6 * 32 * QLP * 2;
__device__ __forceinline__ void dsa_attn_unit(const Frame& F, int l, int unit) {
    const int tid = F.tid, lane = F.lane, wave = F.wave, r32 = lane & 31, hi = lane >> 5;
    const int b = unit & 7, qb = 63 - (unit >> 3), t0 = qb * 32, tok0 = b * SEQ + t0, ntile = qb + 1;
    bf16* P = (bf16*)(F.ws + WS_P); const bf16* C = (const bf16*)(F.ws + WS_C);
    LAS float* MASK = (LAS float*)(F.lds + DA_MASK); LAS unsigned char* QLb = F.lds + DA_QL; LAS unsigned char* CT = F.lds + DA_CT;
    const int crow_ = tid >> 4, cch = tid & 15; const unsigned cdst = off_a((unsigned)crow_, (unsigned)cch);
    const bf16* csrc = C + (size_t)(b * SEQ + crow_) * 128 + cch * 8;
    v4u cpre = *(const GAS v4u*)(csrc);
    if (wave >= 6) {
        const int fr = lane & 15, fq = lane >> 4, qh = wave - 6;
        const int tq = tok0 + 16 * qh + fr, tq_t = t0 + 16 * qh + fr, jmax = tq_t >> 5;
        const unsigned* MK = (const unsigned*)((const unsigned char*)F.out + OUT_MASK) + (size_t)tq * 64;
        LAS float* mrow = MASK + (16 * qh + fr) * MKP + 8 * fq;
#define DA_EXPAND(word, slot) do { const unsigned w_ = (word) >> (8 * fq); f32x4 m0_, m1_; \
            m0_[0] = (w_ & 1u) ? 0.f : -1e30f; m0_[1] = (w_ & 2u) ? 0.f : -1e30f; m0_[2] = (w_ & 4u) ? 0.f : -1e30f; m0_[3] = (w_ & 8u) ? 0.f : -1e30f; \
            m1_[0] = (w_ & 16u) ? 0.f : -1e30f; m1_[1] = (w_ & 32u) ? 0.f : -1e30f; m1_[2] = (w_ & 64u) ? 0.f : -1e30f; m1_[3] = (w_ & 128u) ? 0.f : -1e30f; \
            *(LAS f32x4*)(mrow + (slot) * (32 * MKP)) = m0_; *(LAS f32x4*)(mrow + (slot) * (32 * MKP) + 4) = m1_; } while (0)
        unsigned w0 = MK[0], w1 = (1 <= jmax) ? MK[1] : 0u, w2 = (2 <= jmax) ? MK[2] : 0u;
        DA_EXPAND(w0, 0);
        *(LAS v4u*)(CT + cdst) = cpre;
        lds_barrier();
        for (int j = 0; j < ntile; ++j) {
            if (j + 1 < ntile) {
                cpre = *(const GAS v4u*)(csrc + (size_t)(j + 1) * 32 * 128);
                DA_EXPAND(w1, (j + 1) & 1);
                w1 = w2; w2 = (j + 3 <= jmax) ? MK[j + 3] : 0u;
                *(LAS v4u*)(CT + ((j + 1) & 1) * 8192 + cdst) = cpre; }
            lds_barrier();
        }
#undef DA_EXPAND
        lds_barrier();
        return;
    }
    const int h = wave;
    LAS unsigned char* QLh = QLb + h * (32 * QLP * 2);
    float negb;
    {
        unsigned zo_ = 0u; asm volatile("" : "+v"(zo_));
        const bf16* wukT = (const bf16*)(F.ws + WS_WUKT) + (size_t)(l * 6 + h) * 128 * 64 + zo_;
        bf16x8_t qf[4]; float ssq = 0.f;
#pragma unroll
        for (int ks = 0; ks < 4; ++ks) qf[ks] = *(const GAS bf16x8_t*)(P + (size_t)(tok0 + r32) * PP + PBQ + h * 64 + ks * 16 + hi * 8);
#pragma unroll
        for (int blk = 0; blk < 4; ++blk) { f32x16_t x;
#pragma unroll
            for (int i = 0; i < 16; ++i) x[i] = 0.f;
#pragma unroll
            for (int ks = 0; ks < 4; ++ks) { const bf16x8_t a = *(const GAS bf16x8_t*)(wukT + (size_t)(blk * 32 + r32) * 64 + ks * 16 + hi * 8); x = __builtin_amdgcn_mfma_f32_32x32x16_bf16(a, qf[ks], x, 0, 0, 0); }
#pragma unroll
            for (int g = 0; g < 4; ++g) { const float sc = 0.125f * 1.4426950408889634f;
                const float x0 = x[4 * g] * sc, x1 = x[4 * g + 1] * sc, x2 = x[4 * g + 2] * sc, x3 = x[4 * g + 3] * sc; ssq += (x0 * x0 + x1 * x1) + (x2 * x2 + x3 * x3);
                const unsigned long long w = (unsigned long long)pk2(x0, x1) | ((unsigned long long)pk2(x2, x3) << 32);
                *(LAS unsigned long long*)(QLh + (r32 * QLP + blk * 32 + 8 * g + 4 * hi) * 2) = w; } }
        ssq += __shfl_xor(ssq, 32);
        const float* kvn = F.in[I_KVN] + l * 128; float gm = fmaxf(fabsf(kvn[2 * lane]), fabsf(kvn[2 * lane + 1]));
#pragma unroll
        for (int o_ = 1; o_ < 64; o_ <<= 1) gm = fmaxf(gm, __shfl_xor(gm, o_));
        negb = -(sqrtf(ssq) * 11.32f * gm * 1.01f + 0.01f);
    }
    *(LAS v4u*)(CT + cdst) = cpre;
    lds_barrier();
    f32x16_t o[4]; float l_run = 0.f;
    const LAS unsigned char* qlrow = QLh + (r32 * QLP + 8 * hi) * 2;
#pragma unroll
    for (int c = 0; c < 4; ++c)
#pragma unroll
        for (int i = 0; i < 16; ++i) o[c][i] = 0.f;
    const unsigned rr_ = ((unsigned)r32 >> 2) & 3u, rb_ = 2048u * ((unsigned)r32 >> 3) + 64u * ((unsigned)r32 & 7u);
    const unsigned rbase0 = rb_ + 16u * ((unsigned)hi ^ rr_), rbase1 = rb_ + 16u * ((2u + (unsigned)hi) ^ rr_);
    const unsigned blk_ = (lane >> 4) & 1, q_ = (lane & 15) >> 2, p_ = lane & 3;
    unsigned dga_ = 0;
    for (int j = 0; j < ntile; ++j) {
        DG_START(0, dgt_)
        LAS unsigned char* kb = CT + (j & 1) * 8192;
        if (j + 1 < ntile) cpre = *(const GAS v4u*)(csrc + (size_t)(j + 1) * 32 * 128);
        {
            f32x16_t S;
#pragma unroll
            for (int i = 0; i < 16; ++i) S[i] = negb;
#pragma unroll
            for (int s = 0; s < 8; ++s) { const bf16x8_t a = *(const LAS bf16x8_t*)(kb + ((s & 1) ? rbase1 : rbase0) + 512 * (s >> 1)); const bf16x8_t bq = *(const LAS bf16x8_t*)(qlrow + 32 * s);
                S = __builtin_amdgcn_mfma_f32_32x32x16_bf16(a, bq, S, 0, 0, 0); }
            const LAS f32x4* mk = (const LAS f32x4*)(MASK + (j & 1) * (32 * MKP) + r32 * MKP + 4 * hi);
            float psum = 0.f; float e[16];
#pragma unroll
            for (int g = 0; g < 4; ++g) { const f32x4 mv = mk[2 * g];
#pragma unroll
                for (int e4 = 0; e4 < 4; ++e4) { e[4 * g + e4] = __builtin_amdgcn_exp2f(S[4 * g + e4] + mv[e4]); psum += e[4 * g + e4]; } }
            l_run += psum;
            bf16x8_t xs[2];
#pragma unroll
            for (int s = 0; s < 2; ++s) { v4u w; w.x = pk2(e[8 * s], e[8 * s + 1]); w.y = pk2(e[8 * s + 2], e[8 * s + 3]); w.z = pk2(e[8 * s + 4], e[8 * s + 5]); w.w = pk2(e[8 * s + 6], e[8 * s + 7]); xs[s] = __builtin_bit_cast(bf16x8_t, w); }
#pragma unroll
            for (int c = 0; c < 4; ++c)
#pragma unroll
                for (int s = 0; s < 2; ++s) {
                    const unsigned a0 = off_a((unsigned)(16 * s + 4 * hi + q_), (unsigned)(4 * c + 2 * blk_ + (p_ >> 1))) + 8u * (p_ & 1);
                    const unsigned a1 = off_a((unsigned)(16 * s + 8 + 4 * hi + q_), (unsigned)(4 * c + 2 * blk_ + (p_ >> 1))) + 8u * (p_ & 1);
                    const s16x4_t lo = __builtin_bit_cast(s16x4_t, __builtin_amdgcn_ds_read_tr16_b64_v4i16((LAS s16x4_t*)(kb + a0)));
                    const s16x4_t hh = __builtin_bit_cast(s16x4_t, __builtin_amdgcn_ds_read_tr16_b64_v4i16((LAS s16x4_t*)(kb + a1)));
                    const bf16x8_t a = (bf16x8_t){lo[0], lo[1], lo[2], lo[3], hh[0], hh[1], hh[2], hh[3]};
                    o[c] = __builtin_amdgcn_mfma_f32_32x32x16_bf16(a, xs[s], o[c], 0, 0, 0); }
        }
        if (j + 1 < ntile) *(LAS v4u*)(CT + ((j + 1) & 1) * 8192 + cdst) = cpre;
        DG_STOP(0, dgt_, dga_)
        lds_barrier();
    }
    DG_WRITE(0, unit == 0 && l == 0 && wave == 0 && lane == 0, dga_)
    {
        const float lt = l_run + __shfl_xor(l_run, 32); const float inv = 1.0f / lt;
#pragma unroll
        for (int c = 0; c < 4; ++c)
#pragma unroll
            for (int g = 0; g < 4; ++g) { const unsigned long long w = (unsigned long long)pk2(o[c][4 * g] * inv, o[c][4 * g + 1] * inv) | ((unsigned long long)pk2(o[c][4 * g + 2] * inv, o[c][4 * g + 3] * inv) << 32);
                *(LAS unsigned long long*)(QLh + (r32 * QLP + c * 32 + 8 * g + 4 * hi) * 2) = w; }
        unsigned zo2_ = 0u; asm volatile("" : "+v"(zo2_));
        const bf16* wuvT = (const bf16*)(F.ws + WS_WUVT) + (size_t)(l * 6 + h) * 64 * 128 + zo2_;
        bf16x8_t Bo[8];
#pragma unroll
        for (int s = 0; s < 8; ++s) Bo[s] = *(const LAS bf16x8_t*)(QLh + (r32 * QLP + 16 * s + 8 * hi) * 2);
#pragma unroll
        for (int mb = 0; mb < 2; ++mb) { f32x16_t y;
#pragma unroll
            for (int i = 0; i < 16; ++i) y[i] = 0.f;
#pragma unroll
            for (int s = 0; s < 8; ++s) { const bf16x8_t a = *(const GAS bf16x8_t*)(wuvT + (size_t)(mb * 32 + r32) * 128 + 16 * s + 8 * hi); y = __builtin_amdgcn_mfma_f32_32x32x16_bf16(a, Bo[s], y, 0, 0, 0); }
#pragma unroll
            for (int g = 0; g < 4; ++g) { const unsigned long long w = (unsigned long long)pk2(y[4 * g], y[4 * g + 1]) | ((unsigned long long)pk2(y[4 * g + 2], y[4 * g + 3]) << 32);
                *(GAS unsigned long long*)(P + (size_t)(tok0 + r32) * PP + 384 + h * 64 + mb * 32 + 8 * g + 4 * hi) = w; } }
    }
    lds_barrier();
}

constexpr int RP = 72;
constexpr int RT_QR = 0, RT_KR = 128 * RP * 2, RT_VV = 2 * 128 * RP * 2, RT_ST = 3 * 128 * RP * 2, RT_SS = RT_ST + 64 * RP * 2, RT_KD = RT_SS + 1024;
__device__ __forceinline__ void ret_out_unit(const Frame& F, int unit) {
    const int tid = F.tid, lane = F.lane, wave = F.wave, r32 = lane & 31, hi = lane >> 5;
    const int h = unit & 3, b = unit >> 2;
    bf16* P = (bf16*)(F.ws + WS_P); const float* tab = (const float*)(F.ws + WS_TAB);
    LAS bf16* QR = (LAS bf16*)(F.lds + RT_QR); LAS bf16* KR = (LAS bf16*)(F.lds + RT_KR); LAS bf16* VV = (LAS bf16*)(F.lds + RT_VV); LAS bf16* ST = (LAS bf16*)(F.lds + RT_ST);
    LAS float* SS = (LAS float*)(F.lds + RT_SS); LAS bf16* KD = (LAS bf16*)(F.lds + RT_KD);
    const float lg2 = log2f(1.0f - exp2f(-5.0f - (float)h));
    f32x16_t st;
#pragma unroll
    for (int i = 0; i < 16; ++i) st[i] = 0.f;
    const float cdec = exp2f(128.0f * lg2);
    unsigned long long pre[2][6]; f32x4 pret[2][2];
#define RT_LOAD(cn) do { _Pragma("unroll") for (int it_ = 0; it_ < 2; ++it_) { const int idx_ = tid + it_ * NTHR, m_ = idx_ >> 3, i4_ = (idx_ & 7) * 4; const size_t ro_ = (size_t)(b * SEQ + (cn) * 128 + m_) * PP + h * 64 + i4_; \
        pre[it_][0] = *(const GAS unsigned long long*)(P + ro_ + PCQ); pre[it_][1] = *(const GAS unsigned long long*)(P + ro_ + PCQ + 32); pre[it_][2] = *(const GAS unsigned long long*)(P + ro_ + PCK); \
        pre[it_][3] = *(const GAS unsigned long long*)(P + ro_ + PCK + 32); pre[it_][4] = *(const GAS unsigned long long*)(P + ro_ + PCV); pre[it_][5] = *(const GAS unsigned long long*)(P + ro_ + PCV + 32); \
        pret[it_][0] = *(const GAS f32x4*)(tab + ((size_t)((cn) * 128 + m_) * 32 + i4_) * 2); pret[it_][1] = *(const GAS f32x4*)(tab + ((size_t)((cn) * 128 + m_) * 32 + i4_) * 2 + 4); } } while (0)
    unsigned dga_ = 0;
    DG_START(60, dg60_)
    RT_LOAD(0);
    for (int c = 0; c < 16; ++c) {
    const int tok0 = b * SEQ + c * 128;
#pragma unroll
    for (int it = 0; it < 2; ++it) { const int idx = tid + it * NTHR, m = idx >> 3, i4 = (idx & 7) * 4;
        const unsigned long long q1w = pre[it][0], q2w = pre[it][1], k1w = pre[it][2], k2w = pre[it][3], v1w = pre[it][4], v2w = pre[it][5];
        const f32x4 t0 = pret[it][0], t1 = pret[it][1];
        const float cs[4] = {t0[0], t0[2], t1[0], t1[2]}, sn[4] = {t0[1], t0[3], t1[1], t1[3]};
        const float q1[4] = {bflo((unsigned)q1w), bfhi((unsigned)q1w), bflo((unsigned)(q1w >> 32)), bfhi((unsigned)(q1w >> 32))}, q2[4] = {bflo((unsigned)q2w), bfhi((unsigned)q2w), bflo((unsigned)(q2w >> 32)), bfhi((unsigned)(q2w >> 32))};
        const float k1[4] = {bflo((unsigned)k1w), bfhi((unsigned)k1w), bflo((unsigned)(k1w >> 32)), bfhi((unsigned)(k1w >> 32))}, k2[4] = {bflo((unsigned)k2w), bfhi((unsigned)k2w), bflo((unsigned)(k2w >> 32)), bfhi((unsigned)(k2w >> 32))};
        float qa[4], qb[4], ka[4], kb[4];
#pragma unroll
        for (int j = 0; j < 4; ++j) { qa[j] = q1[j] * cs[j] - q2[j] * sn[j]; qb[j] = q1[j] * sn[j] + q2[j] * cs[j]; ka[j] = (k1[j] * cs[j] - k2[j] * sn[j]) * 0.125f; kb[j] = (k1[j] * sn[j] + k2[j] * cs[j]) * 0.125f; }
        *(LAS unsigned long long*)(QR + m * RP + i4) = (unsigned long long)pk2(qa[0], qa[1]) | ((unsigned long long)pk2(qa[2], qa[3]) << 32);
        *(LAS unsigned long long*)(QR + m * RP + 32 + i4) = (unsigned long long)pk2(qb[0], qb[1]) | ((unsigned long long)pk2(qb[2], qb[3]) << 32);
        *(LAS unsigned long long*)(KR + m * RP + i4) = (unsigned long long)pk2(ka[0], ka[1]) | ((unsigned long long)pk2(ka[2], ka[3]) << 32);
        *(LAS unsigned long long*)(KR + m * RP + 32 + i4) = (unsigned long long)pk2(kb[0], kb[1]) | ((unsigned long long)pk2(kb[2], kb[3]) << 32);
        { const float kd = exp2f((float)(127 - m) * lg2);
          *(LAS unsigned long long*)(KD + m * RP + i4) = (unsigned long long)pk2(ka[0] * kd, ka[1] * kd) | ((unsigned long long)pk2(ka[2] * kd, ka[3] * kd) << 32);
          *(LAS unsigned long long*)(KD + m * RP + 32 + i4) = (unsigned long long)pk2(kb[0] * kd, kb[1] * kd) | ((unsigned long long)pk2(kb[2] * kd, kb[3] * kd) << 32); }
        *(LAS unsigned long long*)(VV + m * RP + i4) = v1w; *(LAS unsigned long long*)(VV + m * RP + 32 + i4) = v2w; }
    if (c + 1 < 16) RT_LOAD(c + 1);
    if (wave < 4) {
        const int db = wave >> 1, ebs = wave & 1;
#pragma unroll
        for (int i = 0; i < 16; ++i) ST[(32 * db + crow32(i, hi)) * RP + 32 * ebs + r32] = (bf16)(pk2(st[i], 0.f) & 0xffffu);
    }
    lds_barrier();
    const int nb = wave >> 1, eb = wave & 1, n = nb * 32 + r32;
    const unsigned blk_ = (lane >> 4) & 1, q_ = (lane & 15) >> 2, p_ = lane & 3;
    bf16x8_t qf[4];
#pragma unroll
    for (int ks = 0; ks < 4; ++ks) qf[ks] = *(const LAS bf16x8_t*)(QR + n * RP + ks * 16 + hi * 8);
    f32x16_t y;
#pragma unroll
    for (int i = 0; i < 16; ++i) y[i] = 0.f;
#pragma unroll
    for (int ks = 0; ks < 4; ++ks) {
        const s16x4_t lo = __builtin_bit_cast(s16x4_t, __builtin_amdgcn_ds_read_tr16_b64_v4i16((LAS s16x4_t*)(ST + (16 * ks + 8 * hi + q_) * RP + 32 * eb + 16 * blk_ + 4 * p_)));
        const s16x4_t hh = __builtin_bit_cast(s16x4_t, __builtin_amdgcn_ds_read_tr16_b64_v4i16((LAS s16x4_t*)(ST + (16 * ks + 8 * hi + 4 + q_) * RP + 32 * eb + 16 * blk_ + 4 * p_)));
        const bf16x8_t a = (bf16x8_t){lo[0], lo[1], lo[2], lo[3], hh[0], hh[1], hh[2], hh[3]};
        y = __builtin_amdgcn_mfma_f32_32x32x16_bf16(a, qf[ks], y, 0, 0, 0); }
    { const float qd = exp2f((float)(n + 1) * lg2);
#pragma unroll
      for (int i = 0; i < 16; ++i) y[i] *= qd; }
    unsigned long long gpre[4];
#pragma unroll
    for (int g = 0; g < 4; ++g) gpre[g] = *(const GAS unsigned long long*)(P + (size_t)(tok0 + n) * PP + PCG + h * 64 + 32 * eb + 8 * g + 4 * hi);
    for (int mt = 0; mt <= nb; ++mt) {
        f32x16_t S;
#pragma unroll
        for (int i = 0; i < 16; ++i) S[i] = 0.f;
#pragma unroll
        for (int ks = 0; ks < 4; ++ks) { const bf16x8_t a = *(const LAS bf16x8_t*)(KR + (mt * 32 + r32) * RP + ks * 16 + hi * 8); S = __builtin_amdgcn_mfma_f32_32x32x16_bf16(a, qf[ks], S, 0, 0, 0); }
        float e[16];
#pragma unroll
        for (int r = 0; r < 16; ++r) { const int dm = r32 - crow32(r, hi) + 32 * (nb - mt); e[r] = (dm >= 0) ? S[r] * exp2f((float)dm * lg2) : 0.f; }
#pragma unroll
        for (int s = 0; s < 2; ++s) { v4u w; w.x = pk2(e[8 * s], e[8 * s + 1]); w.y = pk2(e[8 * s + 2], e[8 * s + 3]); w.z = pk2(e[8 * s + 4], e[8 * s + 5]); w.w = pk2(e[8 * s + 6], e[8 * s + 7]);
            const bf16x8_t xs = __builtin_bit_cast(bf16x8_t, w);
            const s16x4_t lo = __builtin_bit_cast(s16x4_t, __builtin_amdgcn_ds_read_tr16_b64_v4i16((LAS s16x4_t*)(VV + (mt * 32 + 16 * s + 4 * hi + q_) * RP + 32 * eb + 16 * blk_ + 4 * p_)));
            const s16x4_t hh = __builtin_bit_cast(s16x4_t, __builtin_amdgcn_ds_read_tr16_b64_v4i16((LAS s16x4_t*)(VV + (mt * 32 + 16 * s + 8 + 4 * hi + q_) * RP + 32 * eb + 16 * blk_ + 4 * p_)));
            const bf16x8_t a = (bf16x8_t){lo[0], lo[1], lo[2], lo[3], hh[0], hh[1], hh[2], hh[3]};
            y = __builtin_amdgcn_mfma_f32_32x32x16_bf16(a, xs, y, 0, 0, 0); }
    }
    float ss = 0.f;
#pragma unroll
    for (int i = 0; i < 16; ++i) ss += y[i] * y[i];
    ss += __shfl_xor(ss, 32);
    if (hi == 0) SS[(nb * 2 + eb) * 32 + r32] = ss;
    lds_barrier();
    ss += SS[(nb * 2 + (eb ^ 1)) * 32 + r32];
    const float rs = 1.0f / sqrtf(ss * (1.0f / 64.0f) + 1e-6f);
    const size_t ro = (size_t)(tok0 + n) * PP;
#pragma unroll
    for (int g = 0; g < 4; ++g) { const int e0 = 32 * eb + 8 * g + 4 * hi;
        const unsigned long long gw = gpre[g];
        const float g0 = bflo((unsigned)gw), g1 = bfhi((unsigned)gw), g2 = bflo((unsigned)(gw >> 32)), g3 = bfhi((unsigned)(gw >> 32));
        const float o0 = g0 * sigmoid_f(g0) * y[4 * g] * rs, o1 = g1 * sigmoid_f(g1) * y[4 * g + 1] * rs, o2 = g2 * sigmoid_f(g2) * y[4 * g + 2] * rs, o3 = g3 * sigmoid_f(g3) * y[4 * g + 3] * rs;
        *(GAS unsigned long long*)(P + ro + 768 + h * 64 + e0) = (unsigned long long)pk2(o0, o1) | ((unsigned long long)pk2(o2, o3) << 32); }
    if (wave < 4) {
        const int db = wave >> 1, ebs = wave & 1;
#pragma unroll
        for (int i = 0; i < 16; ++i) st[i] *= cdec;
#pragma unroll
        for (int ks = 0; ks < 8; ++ks) {
            const s16x4_t alo = __builtin_bit_cast(s16x4_t, __builtin_amdgcn_ds_read_tr16_b64_v4i16((LAS s16x4_t*)(KD + (16 * ks + 8 * hi + q_) * RP + 32 * db + 16 * blk_ + 4 * p_)));
            const s16x4_t ahi = __builtin_bit_cast(s16x4_t, __builtin_amdgcn_ds_read_tr16_b64_v4i16((LAS s16x4_t*)(KD + (16 * ks + 8 * hi + 4 + q_) * RP + 32 * db + 16 * blk_ + 4 * p_)));
            const s16x4_t blo = __builtin_bit_cast(s16x4_t, __builtin_amdgcn_ds_read_tr16_b64_v4i16((LAS s16x4_t*)(VV + (16 * ks + 8 * hi + q_) * RP + 32 * ebs + 16 * blk_ + 4 * p_)));
            const s16x4_t bhi = __builtin_bit_cast(s16x4_t, __builtin_amdgcn_ds_read_tr16_b64_v4i16((LAS s16x4_t*)(VV + (16 * ks + 8 * hi + 4 + q_) * RP + 32 * ebs + 16 * blk_ + 4 * p_)));
            const bf16x8_t a = (bf16x8_t){alo[0], alo[1], alo[2], alo[3], ahi[0], ahi[1], ahi[2], ahi[3]}, bb = (bf16x8_t){blo[0], blo[1], blo[2], blo[3], bhi[0], bhi[1], bhi[2], bhi[3]};
            st = __builtin_amdgcn_mfma_f32_32x32x16_bf16(a, bb, st, 0, 0, 0); }
    }
    lds_barrier();
    }
    DG_STOP(60, dg60_, dga_)
    DG_WRITE(60, unit == 0 && wave == 0 && lane == 0, dga_)
#undef RT_LOAD
}

constexpr int PT = 32, XSP = 1304;
constexpr int PR_XS = 0, PR_STG = PT * XSP * 2, PR_CONST = PR_STG + 32768, PR_MU = PR_CONST + 6 * 384 * 4;
__device__ __forceinline__ void prep_consts(const Frame& F, int l) {
    LAS float* CS = (LAS float*)(F.lds + PR_CONST);
    for (int i = F.tid; i < AW; i += NTHR) { CS[i] = F.in[I_KK][l * AW + i]; CS[AW + i] = F.in[I_KA][l * AW + i]; CS[2 * AW + i] = F.in[I_RK][l * AW + i];
        CS[3 * AW + i] = F.in[I_W0][l * AW + i]; CS[4 * AW + i] = F.in[I_A0][l * AW + i]; CS[5 * AW + i] = (l > 0) ? F.in[I_V0][(l - 1) * AW + i] : 0.f; }
    LAS float* MU = (LAS float*)(F.lds + PR_MU);
    for (int i = F.tid; i < 1296; i += NTHR) MU[i] = (i < 1280) ? F.in[I_MU][l * 1280 + i] : ((l > 0) ? F.in[I_VRMU][(l - 1) * 16 + i - 1280] : 0.f);
    __syncthreads();
}
__device__ __forceinline__ float softplus_f(float z) { return fmaxf(z, 0.f) + __logf(1.0f + __expf(-fabsf(z))); }
__device__ __forceinline__ float tanh_f(float x) { const float e = __expf(2.0f * x); return 1.0f - 2.0f * __builtin_amdgcn_rcpf(e + 1.0f); }
__device__ __forceinline__ void small_weights(const Frame& F) {
    for (int l = 0; l < DEPTH; ++l) {
        const float* w2 = F.in[I_W2] + (size_t)l * 32 * AW; const float* a2 = F.in[I_A2] + (size_t)l * 32 * AW; const float* g2 = F.in[I_G2] + (size_t)l * 64 * AW;
        const float* v2 = F.in[I_V2] + (size_t)(l > 0 ? l - 1 : 0) * 16 * AW;
        bf16* LT = (bf16*)(F.ws + WS_LORA) + (size_t)l * AW * 144;
        for (int i = F.vcu * NTHR + F.tid; i < AW * 144; i += F.G * NTHR) { const int n = i / 144, k = i - n * 144; float v;
            if (k < 32) v = w2[k * AW + n]; else if (k < 64) v = a2[(k - 32) * AW + n]; else if (k < 128) v = g2[(k - 64) * AW + n]; else v = (l > 0) ? v2[(k - 128) * AW + n] : 0.f;
            LT[i] = (bf16)f2bf(v); }
        const float* wuk = F.in[I_WUK] + (size_t)l * 6 * 64 * 128; const float* wuv = F.in[I_WUV] + (size_t)l * 6 * 128 * 64;
        bf16* wukT = (bf16*)(F.ws + WS_WUKT) + (size_t)l * 6 * 64 * 128; bf16* wuvT = (bf16*)(F.ws + WS_WUVT) + (size_t)l * 6 * 64 * 128;
        for (int i = F.vcu * NTHR + F.tid; i < 6 * 64 * 128; i += F.G * NTHR) {
            { const int hh = i / 8192, rem = i - hh * 8192, c = rem >> 6, d = rem & 63; wukT[i] = (bf16)f2bf(wuk[(hh * 64 + d) * 128 + c]); }
            { const int hh = i / 8192, rem = i - hh * 8192, d = rem >> 7, c = rem & 127; wuvT[i] = (bf16)f2bf(wuv[(hh * 128 + c) * 64 + d]); } }
    }
}
__device__ __forceinline__ void prep_tokens_unit(const Frame& F, int l, int unit) {
    LAS bf16* XS = (LAS bf16*)(F.lds + PR_XS);
    const int tid = F.tid, lane = F.lane, wave = F.wave, r32 = lane & 31, hi = lane >> 5, tok0 = unit * PT;
    const bf16* P = (const bf16*)(F.ws + WS_P);
    unsigned dga_ = 0;
    DG_START(20, dg20_)
    for (int base = 0; base < PT * 162; base += 5 * NTHR) {
        v4u cw[5], pw[5];
#pragma unroll
        for (int u = 0; u < 5; ++u) { const int idx = base + u * NTHR + tid; const int idc = idx < PT * 162 ? idx : PT * 162 - 1; const int t = idc / 162, ch = idc - t * 162, tok = tok0 + t;
            cw[u] = *(const GAS v4u*)(P + (size_t)tok * PP + ch * 8);
            const int tokp = (tok & (SEQ - 1)) != 0 ? tok - 1 : tok; pw[u] = *(const GAS v4u*)(P + (size_t)tokp * PP + ch * 8); }
#pragma unroll
        for (int u = 0; u < 5; ++u) { const int idx = base + u * NTHR + tid;
            if (idx < PT * 162) { const int t = idx / 162, ch = idx - t * 162, tok = tok0 + t, c0 = ch * 8;
                float cur[8], prv[8]; unpack8(cw[u], cur); unpack8(pw[u], prv);
                const bool first = (tok & (SEQ - 1)) == 0;
                float mv[8];
                { const LAS f32x4* mp = (const LAS f32x4*)((const LAS float*)(F.lds + PR_MU) + c0); const f32x4 m0 = mp[0], m1 = mp[1]; mv[0] = m0[0]; mv[1] = m0[1]; mv[2] = m0[2]; mv[3] = m0[3]; mv[4] = m1[0]; mv[5] = m1[1]; mv[6] = m1[2]; mv[7] = m1[3]; }
                float o[8];
#pragma unroll
                for (int j = 0; j < 8; ++j) { const float pv = first ? 0.f : prv[j]; float v = cur[j] + (pv - cur[j]) * mv[j];
                    if (c0 >= 1152 && c0 < 1184) v = tanh_f(v); else if (c0 >= 1216 && c0 < 1280) v = sigmoid_f(v);
                    o[j] = v; }
                v4u w; w.x = pk2(o[0], o[1]); w.y = pk2(o[2], o[3]); w.z = pk2(o[4], o[5]); w.w = pk2(o[6], o[7]);
                *(LAS v4u*)(XS + t * XSP + c0) = w; } }
    }
    __syncthreads();
    DG_STOP(20, dg20_, dga_)
    DG_WRITE(20, unit == 0 && l == 0 && wave == 0 && lane == 0, dga_)
    DG_START(21, dg21_)
    if (wave < 6) {
        const int h = wave;
        LAS bf16* STG = (LAS bf16*)(F.lds + PR_STG + wave * 4096);
        GAS unsigned char* wsb = (GAS unsigned char*)F.ws;
        GAS unsigned char* outb = (GAS unsigned char*)F.out;
        const bf16* LT = (const bf16*)(F.ws + WS_LORA) + (size_t)l * AW * 144;
        const LAS float* CS = (const LAS float*)(F.lds + PR_CONST) + h * 64;
        const LAS float* kkw = CS; const LAS float* kaw = CS + AW; const LAS float* rkw = CS + 2 * AW; const LAS float* w0p = CS + 3 * AW; const LAS float* a0p = CS + 4 * AW; const LAS float* v0p = CS + 5 * AW;
        const LAS bf16* xrow = XS + r32 * XSP;
        float rn;
        { float ss = 0.f;
#pragma unroll
          for (int cbl = 0; cbl < 2; ++cbl)
#pragma unroll
              for (int g = 0; g < 4; ++g) { const int j0 = cbl * 32 + 8 * g + 4 * hi; const unsigned long long kw = *(const LAS unsigned long long*)(xrow + 384 + h * 64 + j0); const f32x4 kk4 = *(const LAS f32x4*)(kkw + j0);
                  const float k0 = bflo((unsigned)kw) * kk4[0], k1 = bfhi((unsigned)kw) * kk4[1], k2 = bflo((unsigned)(kw >> 32)) * kk4[2], k3 = bfhi((unsigned)(kw >> 32)) * kk4[3]; ss += (k0 * k0 + k1 * k1) + (k2 * k2 + k3 * k3); }
          ss += __shfl_xor(ss, 32); rn = 1.0f / fmaxf(sqrtf(ss), 1e-12f); }
        float bonus = 0.f;
        const int srow = lane >> 2, sch = lane & 3;
#pragma unroll
        for (int cbl = 0; cbl < 2; ++cbl) {
            asm volatile("" ::: "memory");
            const int cb0 = h * 64 + cbl * 32;
            f32x16_t wv, av, gv, mvv;
#pragma unroll
            for (int i = 0; i < 16; ++i) { wv[i] = 0.f; av[i] = 0.f; gv[i] = 0.f; mvv[i] = 0.f; }
            const bf16* lrow = LT + (size_t)(cb0 + r32) * 144 + 8 * hi;
#pragma unroll
            for (int ks = 0; ks < 9; ++ks) { const bf16x8_t a = *(const GAS bf16x8_t*)(lrow + 16 * ks); const bf16x8_t bx = *(const LAS bf16x8_t*)(xrow + 1152 + 16 * ks + 8 * hi);
                if (ks < 2) wv = __builtin_amdgcn_mfma_f32_32x32x16_bf16(a, bx, wv, 0, 0, 0);
                else if (ks < 4) av = __builtin_amdgcn_mfma_f32_32x32x16_bf16(a, bx, av, 0, 0, 0);
                else if (ks < 8) gv = __builtin_amdgcn_mfma_f32_32x32x16_bf16(a, bx, gv, 0, 0, 0);
                else mvv = __builtin_amdgcn_mfma_f32_32x32x16_bf16(a, bx, mvv, 0, 0, 0); }
            if (l > 0) {
#pragma unroll
                for (int i = 0; i < 2; ++i) { const int row = srow + 16 * i; const unsigned eo = (unsigned)(((tok0 + row) * AW + cb0 + sch * 8) * 2); *(LAS v4u*)(STG + row * 32 + sch * 8) = *(const GAS v4u*)(wsb + WS_VF + eo); } }
            unsigned long long ro[4], dd[4], k2o[4], kko[4], bpo[4], vo[4], go[4];
#pragma unroll
            for (int g = 0; g < 4; ++g) { const int j0 = cbl * 32 + 8 * g + 4 * hi;
                const unsigned long long rw = *(const LAS unsigned long long*)(xrow + h * 64 + j0), kw = *(const LAS unsigned long long*)(xrow + 384 + h * 64 + j0), vw = *(const LAS unsigned long long*)(xrow + 768 + h * 64 + j0);
                unsigned long long fw = 0ull; if (l > 0) fw = *(const LAS unsigned long long*)(STG + r32 * 32 + 8 * g + 4 * hi);
                asm volatile("" : "+v"(bonus) :: "memory");
                const f32x4 kk4 = *(const LAS f32x4*)(kkw + j0), ka4 = *(const LAS f32x4*)(kaw + j0), rk4 = *(const LAS f32x4*)(rkw + j0), w04 = *(const LAS f32x4*)(w0p + j0), a04 = *(const LAS f32x4*)(a0p + j0);
                const f32x4 v04 = *(const LAS f32x4*)(v0p + j0);
                const float rr[4] = {bflo((unsigned)rw), bfhi((unsigned)rw), bflo((unsigned)(rw >> 32)), bfhi((unsigned)(rw >> 32))};
                const float kx[4] = {bflo((unsigned)kw), bfhi((unsigned)kw), bflo((unsigned)(kw >> 32)), bfhi((unsigned)(kw >> 32))};
                const float vx[4] = {bflo((unsigned)vw), bfhi((unsigned)vw), bflo((unsigned)(vw >> 32)), bfhi((unsigned)(vw >> 32))};
                const float fx[4] = {bflo((unsigned)fw), bfhi((unsigned)fw), bflo((unsigned)(fw >> 32)), bfhi((unsigned)(fw >> 32))};
                float d_[4], k2_[4], kk_[4], bp_[4], v_[4];
#pragma unroll
                for (int e = 0; e < 4; ++e) { const int i = 4 * g + e;
                    const float sp = softplus_f(-(wv[i] + w04[e])); const float rate = __expf(-sp - 0.5f); const float d = 1.0f - __expf(-rate);
                    const float a = sigmoid_f(av[i] + a04[e]);
                    float v = vx[e]; if (l > 0) v = v + (fx[e] - v) * sigmoid_f(mvv[i] + v04[e]);
                    const float kk = kx[e] * kk4[e] * rn, k2 = kx[e] * (1.0f + (a - 1.0f) * ka4[e]);
                    d_[e] = d; k2_[e] = k2; kk_[e] = kk; bp_[e] = kk * a; v_[e] = v;
                    bonus += rr[e] * k2 * rk4[e]; }
#define PK4(x) ((unsigned long long)pk2(x[0], x[1]) | ((unsigned long long)pk2(x[2], x[3]) << 32))
                ro[g] = rw; dd[g] = PK4(d_); k2o[g] = PK4(k2_); kko[g] = PK4(kk_); bpo[g] = PK4(bp_); vo[g] = PK4(v_);
                go[g] = (unsigned long long)pk2(gv[4 * g], gv[4 * g + 1]) | ((unsigned long long)pk2(gv[4 * g + 2], gv[4 * g + 3]) << 32); }
#define PR_OUT(arr, bs_, dst) do { _Pragma("unroll") for (int g = 0; g < 4; ++g) *(LAS unsigned long long*)(STG + r32 * 32 + 8 * g + 4 * hi) = arr[g]; \
            _Pragma("unroll") for (int i = 0; i < 2; ++i) { const int row = srow + 16 * i; const unsigned eo = (unsigned)(((tok0 + row) * AW + cb0 + sch * 8) * 2); *(GAS v4u*)(bs_ + dst + eo) = *(const LAS v4u*)(STG + row * 32 + sch * 8); } } while (0)
            PR_OUT(ro, wsb, WS_R); PR_OUT(dd, wsb, WS_D); PR_OUT(k2o, wsb, WS_K2); PR_OUT(kko, wsb, WS_KK); PR_OUT(bpo, outb, OUT_BP); PR_OUT(vo, wsb, WS_VF); PR_OUT(go, outb, OUT_G);
#undef PR_OUT
#undef PK4
        }
        bonus += __shfl_xor(bonus, 32);
        if (hi == 0) ((float*)(F.ws + WS_BON))[(size_t)(tok0 + r32) * 6 + h] = bonus;
    } else {
        const float* kvn = F.in[I_KVN] + l * 128; bf16* C = (bf16*)(F.ws + WS_C);
        for (int q = 0; q < 16; ++q) { const int tok = tok0 + 16 * (wave - 6) + q; const unsigned w = *(const GAS unsigned*)(P + (size_t)tok * PP + PBC + 2 * lane);
            const float c0 = bflo(w), c1 = bfhi(w); const float ss = wave_sum(c0 * c0 + c1 * c1); const float rs = 1.0f / sqrtf(ss * (1.0f / 128.0f) + 1e-6f);
            *(GAS unsigned*)(C + (size_t)tok * 128 + 2 * lane) = pk2(c0 * rs * kvn[2 * lane], c1 * rs * kvn[2 * lane + 1]); }
    }
    DG_STOP(21, dg21_, dga_)
    DG_WRITE(21, unit == 0 && l == 0 && wave == 0 && lane == 0, dga_)
    __syncthreads();
}

__device__ __forceinline__ void final_norm(const Frame& F) {
    const int gw = F.vcu * NWAVES + F.wave, NGW = F.G * NWAVES; const float* g = F.in[I_FN];
    float dgc_ = 0.f;
    if (DIAG_SLOT_D >= 0) { const unsigned* D = (const unsigned*)(F.ws + WS_DIAG); const float x0 = (float)D[0] * (1.0f / (100.0f * DIAG_DIV)); const float gq = (DIAG_SLOT_D >= 100) ? 4.0f : 2.0f;
        const float kq = floorf(log2f(fmaxf(x0, 1.0f)) * gq); dgc_ = sqrtf(fmaxf(exp2f((kq + 0.5f) / gq) - 1.0f, 0.01f)); }
    const bf16* XBf = (const bf16*)(F.ws + WS_XB);
    for (int m = gw; m < M; m += NGW) { GAS f32x4* xr = (GAS f32x4*)(F.out + (size_t)m * DM); const GAS v4u* xs = (const GAS v4u*)(XBf + (size_t)m * DM); float v[2][8]; float s = 0.f;
#pragma unroll
        for (int j = 0; j < 2; ++j) { unpack8(xs[F.lane + 64 * j], v[j]);
#pragma unroll
            for (int e = 0; e < 8; ++e) s += v[j][e] * v[j][e]; }
        const float rs = 1.0f / sqrtf(wave_sum(s) * (1.0f / DM) + 1e-6f);
#pragma unroll
        for (int j = 0; j < 2; ++j) { const int c = 8 * (F.lane + 64 * j); const f32x4 g0 = *(const f32x4*)(g + c), g1 = *(const f32x4*)(g + c + 4);
            xr[c / 4] = (DIAG_SLOT_D >= 0) ? (f32x4){dgc_, dgc_, dgc_, dgc_} : (f32x4){v[j][0], v[j][1], v[j][2], v[j][3]} * rs * g0;
            xr[c / 4 + 1] = (DIAG_SLOT_D >= 0) ? (f32x4){dgc_, dgc_, dgc_, dgc_} : (f32x4){v[j][4], v[j][5], v[j][6], v[j][7]} * rs * g1; } }
}

template <class T> __device__ __forceinline__ T* launder_ptr(T* p) {
    unsigned lo = (unsigned)(uintptr_t)p, hi = (unsigned)((uintptr_t)p >> 32);
    asm volatile("" : "+v"(lo), "+v"(hi));
    lo = __builtin_amdgcn_readfirstlane(lo); hi = __builtin_amdgcn_readfirstlane(hi);
    return (T*)(((uintptr_t)hi << 32) | (uintptr_t)lo);
}
constexpr int NPHASE = 20;
constexpr int DUP_PHASE = -1;
constexpr int QDUP = 1;
constexpr int STAG_UP = 4, STAG_IN = 3;
constexpr int REP_SCAN_K = 1, REP_THR_K = 1;
constexpr int NSTEP = NPHASE + (DUP_PHASE >= 0 ? 1 : 0);
constexpr int REP_THR = 1, REP_PTOK = 1, REP_KV = 1, REP_CONV = 1, REP_SCAN = 1, REP_DSA = 1, REP_RET = 1, REP_UP = 1;
#define REPL(n) for (int rep_ = 0; rep_ < (l == 0 ? (n) : 1); ++rep_)
__global__ void __launch_bounds__(NTHR, 2) fwd_kernel(Args args) {
    extern __shared__ __attribute__((aligned(16))) unsigned char lds[];
    Frame F;
    F.lds = (LAS unsigned char*)lds;
    F.tid = threadIdx.x; F.lane = F.tid & 63; F.wave = __builtin_amdgcn_readfirstlane(F.tid >> 6);
    F.G = gridDim.x; { const int bx = blockIdx.x; F.vcu = (F.G % 8 == 0) ? (bx % 8) * (F.G / 8) + bx / 8 : bx; }
    F.in = (const float* const __attribute__((address_space(4)))*)__builtin_amdgcn_kernarg_segment_ptr(); F.out = args.out; F.ws = args.ws;
    volatile LAS unsigned* MISC = (volatile LAS unsigned*)(F.lds + MISC_OFF);
    for (int u = F.tid; u < (LDS_BYTES - LDSCTL_OFF) / 4; u += NTHR) ((LAS unsigned*)(F.lds + LDSCTL_OFF))[u] = 0u;
    __syncthreads();
    const int lo = args.ph_lo, hi = args.ph_hi;
    XcdBarrier bar; bar.bar = (unsigned*)(F.ws + WS_CTL) + CW_BAR; bar.x = 0; bar.st = nullptr;
    if (hi - lo > 1) bar = xcd_barrier_post((unsigned*)(F.ws + WS_CTL) + CW_BAR, MISC + 8);
    for (int ph_ = lo; ph_ < hi; ++ph_) {
        unsigned dgp0_ = 0; if (DIAG_SLOT_D >= 100) dgp0_ = (unsigned)__builtin_amdgcn_s_memtime();
        int ph = (args.dup_phase >= 0 && ph_ > args.dup_phase) ? ph_ - 1 : ph_; asm volatile("" : "+v"(ph)); ph = __builtin_amdgcn_readfirstlane(ph);
#define PH_ENTER() \
        { unsigned z_ = 0u; int t_ = threadIdx.x; asm volatile("" : "+v"(z_), "+v"(t_)); z_ = __builtin_amdgcn_readfirstlane(z_); F.in = (const float* const __attribute__((address_space(4)))*)((const char __attribute__((address_space(4)))*)__builtin_amdgcn_kernarg_segment_ptr() + z_); F.out = args.out + z_; F.ws = args.ws + z_; \
          F.tid = t_; F.lane = t_ & 63; F.wave = __builtin_amdgcn_readfirstlane(t_ >> 6); } \
        int bx = blockIdx.x; { int g_ = gridDim.x; asm volatile("" : "+v"(bx), "+v"(g_)); bx = __builtin_amdgcn_readfirstlane(bx); g_ = __builtin_amdgcn_readfirstlane(g_); F.G = g_; F.vcu = (g_ % 8 == 0) ? (bx % 8) * (g_ / 8) + bx / 8 : bx; } \
        gu32* ctl = (gu32*)(F.ws + WS_CTL); (void)ctl; \
        bf16* XB = (bf16*)(F.ws + WS_XB); bf16* Hb = (bf16*)(F.ws + WS_H); bf16* Pb = (bf16*)(F.ws + WS_P); float* part = (float*)(F.ws + WS_PART); (void)XB; (void)Hb; (void)Pb; (void)part;
        if (ph == 0) { PH_ENTER();
            if (DIAG_SLOT_D >= 0 && bx == 0 && threadIdx.x == 0) { ((unsigned*)(args.ws + WS_DIAG))[0] = 0u; ((unsigned*)(args.ws + WS_DIAG))[1] = 0u; }
            conv_weights(F, 0, 0, 3);
            p0_x(F); p0_table(F); small_weights(F);
        } else if (ph == NPHASE - 1) { PH_ENTER();
            final_norm(F);
        } else {
            const int l = (ph - 1) / 9, sub = (ph - 1) - 9 * l;
            if (sub == 0 || sub == 7) { PH_ENTER();
                pg8::Gemm g{XB, (const bf16*)(F.ws + (sub == 0 ? WS_WGU1 : WS_WGU2)), M, NGU, DM, DM}; pg8::StaticOrder S; S.init(M, NGU, F.G, bx);
                pg8::EpiUp E{Hb, FFP, part};
                if (bx >= S.nwg % F.G) for (int i = 0; i < args.stag_up; ++i) __builtin_amdgcn_s_sleep(127);
                for (int rep = 0; rep < ((l == 0 && sub == 0) ? REP_UP : 1); ++rep) pg8::gemm_phase<pg8::EpiUp, pg8::StaticOrder, true>(F.lds, g, S, E, F.tid);
            } else if (sub == 1 || sub == 8 || sub == 6) { PH_ENTER();
                const bool op = (sub == 6);
                pg8::Gemm g{op ? Pb : Hb, (const bf16*)(F.ws + (op ? WS_WOUT : (sub == 1 ? WS_WD1 : WS_WD2))), M, DM, op ? DM : FFP, op ? PP : FFP}; pg8::StaticOrder S; S.init(M, DM, F.G, bx);
                const float* base = (l == 0 && sub == 1) ? F.in[I_X] : nullptr;
                pg8::EpiRes E{base, XB, part};
                pg8::gemm_phase<pg8::EpiRes, pg8::StaticOrder, false>(F.lds, g, S, E, F.tid);
            } else if (sub == 2) { PH_ENTER();
                pg8::Gemm g{XB, (const bf16*)(F.ws + WS_WIN), M, PP, DM, DM}; pg8::StaticOrder S; S.init(M, PP, F.G, bx);
                pg8::EpiP E{Pb, PP, part};
                if (bx >= S.nwg % F.G) for (int i = 0; i < args.stag_in; ++i) __builtin_amdgcn_s_sleep(127);
                pg8::gemm_phase<pg8::EpiP, pg8::StaticOrder, true>(F.lds, g, S, E, F.tid);
            } else if (sub == 3) { PH_ENTER();
                for (int rep_ = 0; rep_ < (l == 0 ? args.rep_thr : 1); ++rep_)
                    for (int k = 0, u0 = F.vcu; u0 < M / 16; ++k, u0 += F.G) {
                        const int base = k * F.G, span = (M / 16 - base) < F.G ? (M / 16 - base) : F.G; const int u = (k & 1) ? base + span - 1 - F.vcu : u0;
                        if (u >= base && u < M / 16) dsa_thr_unit(F, u); }
                prep_consts(F, l);
                REPL(REP_PTOK) for (int u = F.vcu; u < M / PT; u += F.G) prep_tokens_unit(F, l, u);

            } else if (sub == 5) { PH_ENTER();
                rwkv_post(F, l);
            } else if (sub == 4) { PH_ENTER();
                unsigned dgm_ = 0; if (DIAG_SLOT_D >= 50 && DIAG_SLOT_D < 60) dgm_ = (unsigned)__builtin_amdgcn_s_memtime();
                if (bx < BATCH * 24) { for (int rep_ = 0; rep_ < (l == 0 ? args.rep_scan : 1); ++rep_) { rwkv_scan_unit(F, l, bx); __syncthreads(); } }
                if (DIAG_SLOT_D == 54 && l == 0 && bx < BATCH * 24 && threadIdx.x == 0) atomicMax((unsigned*)(args.ws + WS_DIAG), (unsigned)__builtin_amdgcn_s_memtime() - dgm_);
                if (DIAG_SLOT_D == 50 && l == 0 && bx == 0 && threadIdx.x == 0) ((unsigned*)(args.ws + WS_DIAG))[0] = (unsigned)__builtin_amdgcn_s_memtime() - dgm_;
                {
                    gu32* qh = ctl + CW_QUEUE + 64 * l;
                    for (;;) {
                        if (F.tid == 0) MISC[0] = __hip_atomic_fetch_add(qh, 1u, RLX_AGENT);
                        __syncthreads();
                        const int u = (int)MISC[0];
                        __syncthreads();
                        const int nd = (l == 0 ? args.qdup : 1) * (M / 32);
                        { unsigned z_ = 0u; int t_ = threadIdx.x; asm volatile("" : "+v"(z_), "+v"(t_)); z_ = __builtin_amdgcn_readfirstlane(z_); F.ws = args.ws + z_; F.tid = t_; F.lane = t_ & 63; F.wave = __builtin_amdgcn_readfirstlane(t_ >> 6); }
                        const int ncv = (conv_flat_items(l + 1 < DEPTH) + NWAVES * CONV_PER_WAVE - 1) / (NWAVES * CONV_PER_WAVE);
                        if (DIAG_SLOT_D == 53 && l == 0 && bx == 200 && threadIdx.x == 0 && u >= BATCH * 4 + nd) { unsigned* D_ = (unsigned*)(args.ws + WS_DIAG); if (D_[1] != 0x600Du) { D_[1] = 0x600Du; D_[0] = (unsigned)__builtin_amdgcn_s_memtime() - dgm_; } }
                        if (u >= nd + BATCH * 4 + ncv) { if (DIAG_SLOT_D == 51 && l == 0 && bx == 0 && threadIdx.x == 0) ((unsigned*)(args.ws + WS_DIAG))[0] = (unsigned)__builtin_amdgcn_s_memtime() - dgm_;
                            if (DIAG_SLOT_D == 52 && l == 0 && bx == 200 && threadIdx.x == 0) ((unsigned*)(args.ws + WS_DIAG))[0] = (unsigned)__builtin_amdgcn_s_memtime() - dgm_; }
                        if (DIAG_SLOT_D == 55 && l == 0 && u >= nd + BATCH * 4 + ncv && threadIdx.x == 0) atomicMax((unsigned*)(args.ws + WS_DIAG), (unsigned)__builtin_amdgcn_s_memtime() - dgm_);
                        if (DIAG_SLOT_D == 56 && l == 0 && u >= BATCH * 4 && u < nd + BATCH * 4 && threadIdx.x == 0) atomicMax((unsigned*)(args.ws + WS_DIAG), (unsigned)__builtin_amdgcn_s_memtime() - dgm_);
                        if (u >= nd + BATCH * 4 + ncv) break;
                        if (u < BATCH * 4) ret_out_unit(F, u);
                        else if (u < nd + BATCH * 4) dsa_attn_unit(F, l, (u - BATCH * 4) % (M / 32));
                        else { conv_unit(F, l, u - nd - BATCH * 4); __syncthreads(); }
                    }
                }
            }
        }
        if (ph_ + 1 < hi) xcd_barrier(bar);
        if (DIAG_SLOT_D >= 100 && ph_ == DIAG_SLOT_D - 100 && blockIdx.x == 0 && threadIdx.x == 0) ((unsigned*)(args.ws + WS_DIAG))[0] = (unsigned)__builtin_amdgcn_s_memtime() - dgp0_;
    }
}

extern "C" void kernel_launch(void* const* d_in, const int* in_sizes, int n_in, void* d_out, int out_size, void* d_ws, size_t ws_size, hipStream_t stream) {
    static int grid = 0;
    if (grid == 0) {
        if (n_in != 31 || out_size != M * DM || ws_size < WS_END) { fprintf(stderr, "kernel_launch: unexpected shapes (n_in %d, out %d, ws %zu)\n", n_in, out_size, ws_size); grid = -1; return; }
        int dev = 0, cus = 0, per_cu = 0;
        if (hipGetDevice(&dev) != hipSuccess || hipDeviceGetAttribute(&cus, hipDeviceAttributeMultiprocessorCount, dev) != hipSuccess) { grid = -1; return; }
        if (hipFuncSetAttribute((const void*)fwd_kernel, hipFuncAttributeMaxDynamicSharedMemorySize, LDS_BYTES) != hipSuccess) { fprintf(stderr, "kernel_launch: hipFuncSetAttribute failed\n"); grid = -1; return; }
        if (hipOccupancyMaxActiveBlocksPerMultiprocessor(&per_cu, (const void*)fwd_kernel, NTHR, LDS_BYTES) != hipSuccess || per_cu < 1) fprintf(stderr, "kernel_launch: occupancy query says %d\n", per_cu);
        (void)hipGetLastError();
        grid = cus;
    }
    if (grid < 0) return;
    if (hipMemsetAsync((char*)d_ws + WS_CTL, 0, CTL_ZERO_BYTES, stream) != hipSuccess) return;
    Args a{};
    for (int i = 0; i < 31; ++i) a.in[i] = (const float*)d_in[i];
    a.out = (float*)d_out; a.ws = (unsigned char*)d_ws; a.dup_phase = DUP_PHASE; a.qdup = QDUP; a.rep_scan = REP_SCAN_K; a.rep_thr = REP_THR_K; a.stag_up = STAG_UP; a.stag_in = STAG_IN;
#ifndef ONE_LAUNCH
#define ONE_LAUNCH 1
#endif
    if (ONE_LAUNCH) { a.ph_lo = 0; a.ph_hi = NSTEP; hipLaunchKernelGGL(fwd_kernel, dim3(grid), dim3(NTHR), LDS_BYTES, stream, a); }
    else for (int ph = 0; ph < NPHASE; ++ph) { a.ph_lo = ph; a.ph_hi = ph + 1; hipLaunchKernelGGL(fwd_kernel, dim3(grid), dim3(NTHR), LDS_BYTES, stream, a); }
}
```

```cpp
#include <hip/hip_runtime.h>
#include <cstdio>
#include <cstdint>
#include <cmath>

namespace pg8 {
#define PG8_LAS __attribute__((address_space(3)))
typedef unsigned short bf16_t;
typedef short bf16x8 __attribute__((ext_vector_type(8)));
typedef float f32x4 __attribute__((ext_vector_type(4)));
typedef unsigned u32x4 __attribute__((ext_vector_type(4)));
constexpr int BM = 256, BK = 64, HALF = 128, HTB = HALF * BK * 2  , STAGE_BYTES = 8 * HTB, NXCD = 8, WGM = 8;

__host__ __device__ __forceinline__ int lds_byte(int r, int c) { const int st = (r >> 4) * 2 + (c >> 5), rr = r & 15, cc = c & 31, ob = rr * 64 + cc * 2; return st * 1024 + (ob ^ (((ob >> 9) & 1) << 5)); }
__host__ __device__ __forceinline__ void stage_rc(int b, int& R, int& C) { const int st = b / 1024, sb = b % 1024, swz = sb ^ (((sb >> 9) & 1) << 5); R = (st >> 1) * 16 + swz / 64; C = (st & 1) * 32 + (swz % 64) / 2; }
__host__ __device__ __forceinline__ int perm32(int rho) { const int n = rho >> 4, i = rho & 15; return 8 * (i >> 2) + 4 * n + (i & 3); }

struct Unit { int pm, pn; };
struct Gemm { const bf16_t* A; const bf16_t* Bt; int M, N, K, lda; };

struct StaticOrder {
    int nM, nN, nwg, G, c;
    __host__ __device__ void init(int M, int N, int G_, int c_) { nM = M / BM; nN = N / BM; nwg = nM * nN; G = G_; c = c_; }
    __host__ __device__ bool next(int i, Unit& u) const {
        const long L = (long)i * G + c; if (L >= nwg) return false;
        int wgid = (int)L; { const int q = nwg / NXCD, r = nwg % NXCD, xcd = wgid % NXCD, off = wgid / NXCD; wgid = (xcd < r ? xcd * (q + 1) : r * (q + 1) + (xcd - r) * q) + off; }
        const int nig = WGM * nN, gid = wgid / nig, fm = gid * WGM, gsz = (nM - fm) < WGM ? (nM - fm) : WGM;
        u.pm = fm + ((wgid % nig) % gsz); u.pn = (wgid % nig) / gsz; return true;
    }
    __device__ __forceinline__ void a_ready(const Unit&) const {}
    __device__ __forceinline__ void done(const Unit&) const {}
};

__device__ __forceinline__ unsigned cvt_pk_bf16(float lo, float hi) { unsigned r; asm volatile("v_cvt_pk_bf16_f32 %0, %1, %2" : "=v"(r) : "v"(lo), "v"(hi)); return r; }


__device__ __forceinline__ float row_rstd(const float* part, int row) {
    const f32x4* p = (const f32x4*)(part + (size_t)row * 16);
    const f32x4 a = p[0], b = p[1], c = p[2], d = p[3];
    const float s = ((a[0] + a[1]) + (a[2] + a[3])) + ((b[0] + b[1]) + (b[2] + b[3])) + ((c[0] + c[1]) + (c[2] + c[3])) + ((d[0] + d[1]) + (d[2] + d[3]));
    return 1.0f / sqrtf(s * (1.0f / 1024.0f) + 1e-6f);
}
__device__ __forceinline__ float silu_f(float x) { return x * __builtin_amdgcn_rcpf(1.0f + __expf(-x)); }

struct EpiUp {
    static constexpr bool PERM = true;
    bf16_t* H; int ldh; const float* part;
    __device__ __forceinline__ void operator()(const f32x4 (&acc)[2][2][4][2], const Unit& u, int wr, int wc, int fr, int fq) const {
        const int row0 = u.pm * BM + wr * 64 + fr, hcol = u.pn * 128 + wc * 32 + 8 * fq;
#pragma unroll
        for (int ai = 0; ai < 2; ++ai)
#pragma unroll
            for (int m = 0; m < 4; ++m) { const int row = row0 + ai * HALF + m * 16; const float rs = row_rstd(part, row);
                const f32x4 g0 = acc[ai][0][m][0] * rs, g1 = acc[ai][0][m][1] * rs, u0 = acc[ai][1][m][0] * rs, u1 = acc[ai][1][m][1] * rs;
                u32x4 w; w.x = cvt_pk_bf16(silu_f(g0[0]) * u0[0], silu_f(g0[1]) * u0[1]); w.y = cvt_pk_bf16(silu_f(g0[2]) * u0[2], silu_f(g0[3]) * u0[3]);
                w.z = cvt_pk_bf16(silu_f(g1[0]) * u1[0], silu_f(g1[1]) * u1[1]); w.w = cvt_pk_bf16(silu_f(g1[2]) * u1[2], silu_f(g1[3]) * u1[3]);
                *(u32x4*)(H + (size_t)row * ldh + hcol) = w; }
    }
};
struct EpiP {
    static constexpr bool PERM = true;
    bf16_t* P; int ldp; const float* part;
    __device__ __forceinline__ void operator()(const f32x4 (&acc)[2][2][4][2], const Unit& u, int wr, int wc, int fr, int fq) const {
        const int row0 = u.pm * BM + wr * 64 + fr, col0 = u.pn * BM + wc * 32 + 8 * fq;
#pragma unroll
        for (int ai = 0; ai < 2; ++ai)
#pragma unroll
            for (int m = 0; m < 4; ++m) { const int row = row0 + ai * HALF + m * 16; const float rs = row_rstd(part, row);
#pragma unroll
                for (int bj = 0; bj < 2; ++bj) { const f32x4 v0 = acc[ai][bj][m][0] * rs, v1 = acc[ai][bj][m][1] * rs;
                    u32x4 w; w.x = cvt_pk_bf16(v0[0], v0[1]); w.y = cvt_pk_bf16(v0[2], v0[3]); w.z = cvt_pk_bf16(v1[0], v1[1]); w.w = cvt_pk_bf16(v1[2], v1[3]);
                    *(u32x4*)(P + (size_t)row * ldp + col0 + bj * HALF) = w; } }
    }
};
struct EpiRes {
    static constexpr bool PERM = true;
    const float* base; bf16_t* xb; float* part;
    __device__ __forceinline__ void operator()(const f32x4 (&acc)[2][2][4][2], const Unit& u, int wr, int wc, int fr, int fq) const {
        const int row0 = u.pm * BM + wr * 64 + fr, col0 = u.pn * BM + wc * 32 + 8 * fq;
#pragma unroll
        for (int ai = 0; ai < 2; ++ai)
#pragma unroll
            for (int m = 0; m < 4; ++m) { const int row = row0 + ai * HALF + m * 16; float ss = 0.f;
#pragma unroll
                for (int bj = 0; bj < 2; ++bj) { const size_t off = (size_t)row * 1024 + col0 + bj * HALF;
                    f32x4 v0, v1;
                    if (base) { v0 = *(const f32x4*)(base + off); v1 = *(const f32x4*)(base + off + 4); }
                    else { const u32x4 xw = *(const u32x4*)(xb + off);
                        v0 = (f32x4){__builtin_bit_cast(float, xw.x << 16), __builtin_bit_cast(float, xw.x & 0xffff0000u), __builtin_bit_cast(float, xw.y << 16), __builtin_bit_cast(float, xw.y & 0xffff0000u)};
                        v1 = (f32x4){__builtin_bit_cast(float, xw.z << 16), __builtin_bit_cast(float, xw.z & 0xffff0000u), __builtin_bit_cast(float, xw.w << 16), __builtin_bit_cast(float, xw.w & 0xffff0000u)}; }
                    v0 += acc[ai][bj][m][0]; v1 += acc[ai][bj][m][1];
                    u32x4 w; w.x = cvt_pk_bf16(v0[0], v0[1]); w.y = cvt_pk_bf16(v0[2], v0[3]); w.z = cvt_pk_bf16(v1[0], v1[1]); w.w = cvt_pk_bf16(v1[2], v1[3]);
                    *(u32x4*)(xb + off) = w;
                    ss += (v0[0] * v0[0] + v0[1] * v0[1]) + (v0[2] * v0[2] + v0[3] * v0[3]) + (v1[0] * v1[0] + v1[1] * v1[1]) + (v1[2] * v1[2] + v1[3] * v1[3]); }
                ss += __shfl_xor(ss, 16); ss += __shfl_xor(ss, 32);
                if (fq == 0) part[(size_t)row * 16 + u.pn * 4 + wc] = ss;
                asm volatile("" ::: "memory"); }
    }
};

template <class Epi, class Sched, bool ALIGN_EPI>
__device__ __forceinline__ void gemm_phase(PG8_LAS unsigned char* lds, const Gemm g, const Sched& S, const Epi& E, const int tid) {
    const int wid = __builtin_amdgcn_readfirstlane(tid >> 6), lane = tid & 63, wr = wid >> 2, wc = wid & 3, fr = lane & 15, fq = lane >> 4;
    const int K = g.K, nt = K / BK, lda = g.lda;
    unsigned voffA[2], voffB[2];
#pragma unroll
    for (int i = 0; i < 2; ++i) { int R, C; stage_rc(tid * 16 + i * 8192, R, C); const int Rb = Epi::PERM ? ((R & ~31) + perm32(R & 31)) : R;
        voffA[i] = (unsigned)(R * lda + C) * 2u; voffB[i] = (unsigned)(Rb * K + C) * 2u; }
    const size_t kstep = (size_t)(BK * 2);
    const size_t hstepA = (size_t)HALF * lda * 2, hstepB = (size_t)HALF * K * 2;
    const size_t tstepA = 2 * hstepA, tstepB = 2 * hstepB;
    const unsigned ldsw = (unsigned)wid * 1024u;
    const int aoff = lds_byte(wr * 64 + fr, fq * 8), boff = lds_byte(wc * 32 + fr, fq * 8);
#define PG8_SA(b, h) (((b) * 2 + (h)) * HTB)
#define PG8_SB(b, h) ((4 + (b) * 2 + (h)) * HTB)
#define PG8_STAGE(bufoff, gbase, voff) do { _Pragma("unroll") for (int _i = 0; _i < 2; ++_i) \
        __builtin_amdgcn_global_load_lds((const unsigned*)((const char*)(gbase) + (voff)[_i]), (PG8_LAS unsigned*)(lds + (bufoff) + ldsw + _i * 8192), 16, 0, 0); } while (0)
#define PG8_LDA(dst, b, h) do { _Pragma("unroll") for (int m = 0; m < 4; ++m) _Pragma("unroll") for (int k = 0; k < 2; ++k) dst[m][k] = *(const PG8_LAS bf16x8*)(lds + PG8_SA(b, h) + aoff + m * 2048 + k * 1024); } while (0)
#define PG8_LDB(dst, b, h) do { _Pragma("unroll") for (int n = 0; n < 2; ++n) _Pragma("unroll") for (int k = 0; k < 2; ++k) dst[n][k] = *(const PG8_LAS bf16x8*)(lds + PG8_SB(b, h) + boff + n * 2048 + k * 1024); } while (0)
#define PG8_MMA(ai, bj, At, Bt) do { __builtin_amdgcn_s_setprio(1); _Pragma("unroll") for (int m = 0; m < 4; ++m) _Pragma("unroll") for (int n = 0; n < 2; ++n) _Pragma("unroll") for (int k = 0; k < 2; ++k) \
        acc[ai][bj][m][n] = __builtin_amdgcn_mfma_f32_16x16x32_bf16(Bt[n][k], At[m][k], acc[ai][bj][m][n], 0, 0, 0); __builtin_amdgcn_s_setprio(0); } while (0)
#define PG8_WAIT_V(n) asm volatile("s_waitcnt vmcnt(" #n ")" ::: "memory")
#define PG8_WAIT_L(n) asm volatile("s_waitcnt lgkmcnt(" #n ")" ::: "memory")
#define PG8_BAR __builtin_amdgcn_s_barrier()
#define PG8_SCHED __builtin_amdgcn_sched_barrier(0)
    Unit cur, nxt; int ui = 0;
    if (!S.next(0, cur)) return;
    f32x4 acc[2][2][4][2];
#pragma unroll
    for (int a = 0; a < 2; ++a)
#pragma unroll
        for (int b = 0; b < 2; ++b)
#pragma unroll
            for (int m = 0; m < 4; ++m)
#pragma unroll
                for (int n = 0; n < 2; ++n) acc[a][b][m][n] = (f32x4){0.f, 0.f, 0.f, 0.f};
    bf16x8 At[4][2], B0[2][2], B1[2][2];
    const char* cA = (const char*)g.A + (size_t)cur.pm * tstepA; const char* cB = (const char*)g.Bt + (size_t)cur.pn * tstepB;
    S.a_ready(cur);
    PG8_STAGE(PG8_SB(0, 0), cB, voffB); PG8_STAGE(PG8_SB(0, 1), cB + hstepB, voffB); PG8_STAGE(PG8_SA(0, 0), cA, voffA); PG8_STAGE(PG8_SA(0, 1), cA + hstepA, voffA);
    if (wr == 1) PG8_BAR;
    PG8_WAIT_V(2); PG8_BAR;
    PG8_STAGE(PG8_SB(1, 0), cB + kstep, voffB); PG8_STAGE(PG8_SA(1, 0), cA + kstep, voffA); PG8_STAGE(PG8_SB(1, 1), cB + hstepB + kstep, voffB);
    PG8_WAIT_V(6); PG8_BAR;
    for (;;) {
        const bool has_next = S.next(ui + 1, nxt);
        const char* nA = has_next ? (const char*)g.A + (size_t)nxt.pm * tstepA : cA; const char* nB = has_next ? (const char*)g.Bt + (size_t)nxt.pn * tstepB : cB;
        for (int t = 0; t < nt; t += 2) {
            const bool last = (t == nt - 2);
            const char* a1 = cA + (size_t)(t + 1) * kstep;
            const char* a2 = last ? nA : cA + (size_t)(t + 2) * kstep; const char* b2 = last ? nB : cB + (size_t)(t + 2) * kstep;
            const char* a3 = a2 + kstep; const char* b3 = b2 + kstep;
            if (last && has_next) S.a_ready(nxt);
            PG8_LDB(B0, 0, 0); PG8_LDB(B1, 0, 1); PG8_SCHED; PG8_LDA(At, 0, 0); PG8_STAGE(PG8_SA(1, 1), a1 + hstepA, voffA);
            PG8_WAIT_V(8); PG8_WAIT_L(0); PG8_BAR; PG8_MMA(0, 0, At, B0); PG8_MMA(0, 1, At, B1); PG8_BAR; PG8_SCHED;
            PG8_LDA(At, 0, 1); PG8_STAGE(PG8_SB(0, 0), b2, voffB); PG8_STAGE(PG8_SB(0, 1), b2 + hstepB, voffB); PG8_STAGE(PG8_SA(0, 0), a2, voffA);
            PG8_WAIT_V(8); PG8_WAIT_L(0); PG8_BAR; PG8_MMA(1, 0, At, B0); PG8_MMA(1, 1, At, B1); PG8_BAR; PG8_SCHED;
            PG8_LDB(B0, 1, 0); PG8_LDB(B1, 1, 1); PG8_SCHED; PG8_LDA(At, 1, 0); PG8_STAGE(PG8_SA(0, 1), a2 + hstepA, voffA);
            PG8_WAIT_V(8); PG8_WAIT_L(0); PG8_BAR; PG8_MMA(0, 0, At, B0); PG8_MMA(0, 1, At, B1); PG8_BAR; PG8_SCHED;
            PG8_LDA(At, 1, 1); PG8_STAGE(PG8_SB(1, 0), b3, voffB); PG8_STAGE(PG8_SB(1, 1), b3 + hstepB, voffB); PG8_STAGE(PG8_SA(1, 0), a3, voffA);
            PG8_WAIT_V(8); PG8_WAIT_L(0); PG8_BAR; PG8_MMA(1, 0, At, B0); PG8_MMA(1, 1, At, B1); PG8_BAR; PG8_SCHED;
        }
        if constexpr (ALIGN_EPI) { if (wr == 0) PG8_BAR; }
        E(acc, cur, wr, wc, fr, fq); S.done(cur);
        if (!has_next) break;
#pragma unroll
        for (int a = 0; a < 2; ++a)
#pragma unroll
            for (int b = 0; b < 2; ++b)
#pragma unroll
                for (int m = 0; m < 4; ++m)
#pragma unroll
                    for (int n = 0; n < 2; ++n) acc[a][b][m][n] = (f32x4){0.f, 0.f, 0.f, 0.f};
        cur = nxt; cA = nA; cB = nB; ++ui;
        if constexpr (ALIGN_EPI) { if (wr == 1) PG8_BAR; }
    }
    PG8_WAIT_V(0);
    if constexpr (!ALIGN_EPI) { if (wr == 0) PG8_BAR; }
    PG8_BAR;
#undef PG8_SA
#undef PG8_SB
#undef PG8_STAGE
#undef PG8_LDA
#undef PG8_LDB
#undef PG8_MMA
#undef PG8_WAIT_V
#undef PG8_WAIT_L
#undef PG8_BAR
#undef PG8_SCHED
}
}

constexpr int NWAVES = 8, NTHR = 512;
constexpr int BATCH = 8, SEQ = 2048, DM = 1024, DEPTH = 2, FF = 2752, M = BATCH * SEQ;
constexpr int FFP = 2816;
constexpr int NGU = 5632;
constexpr int PP = 3584;
constexpr int NIN = 3400;
constexpr int PA = 0, PMV = 1280, PBQ = 1296, PBC = 1680, PBIQ = 1808, PBIK = 2320, PBIW = 2384, PCQ = 2392, PCK = 2648, PCV = 2904, PCG = 3160, PUSED = 3416;
constexpr int AW = 384;
constexpr int TOPK = 256;

constexpr size_t MiB = 1u << 20;
constexpr size_t WS_CTL = 0, CTL_ZERO_BYTES = 1 * MiB;
constexpr size_t WS_PART = 1 * MiB;
constexpr size_t WS_TAB = 2 * MiB;
constexpr size_t WS_BON = 2 * MiB + 512 * 1024;
constexpr size_t WS_WUKT = 3 * MiB, WS_WUVT = 3 * MiB + 192 * 1024;
constexpr size_t WS_THR = 3 * MiB + 384 * 1024, WS_SCUT = 3 * MiB + 448 * 1024;
constexpr size_t WS_LORA = 3 * MiB + 512 * 1024;
constexpr size_t WS_WGU1 = 4 * MiB, WS_WD1 = 15 * MiB, WS_WIN = 21 * MiB, WS_WOUT = 28 * MiB, WS_WGU2 = 30 * MiB, WS_WD2 = 41 * MiB;
constexpr size_t WS_XB = 47 * MiB;
constexpr size_t WS_VF = 79 * MiB;
constexpr size_t WS_P = 91 * MiB;
constexpr size_t WS_H = WS_P;
constexpr size_t WS_R = 203 * MiB, WS_D = 215 * MiB, WS_K2 = 227 * MiB, WS_KK = 239 * MiB, WS_C = 251 * MiB;
constexpr size_t WS_KV = WS_XB + 24 * MiB;
constexpr size_t OUT_BP = 0, OUT_G = 12 * MiB, OUT_MASK = 24 * MiB;
constexpr size_t WS_END = 256 * MiB;
static_assert(WS_WD2 + (size_t)1024 * FFP * 2 <= WS_XB && WS_P + (size_t)M * PP * 2 <= WS_R && WS_C + (size_t)M * 128 * 2 <= WS_END, "ws map");
constexpr int CW_BAR = 4096;
constexpr int CW_QUEUE = 16384;

constexpr int RING_BYTES = 131072;
constexpr int LDSCTL_OFF = RING_BYTES, MISC_OFF = LDSCTL_OFF + 320;
constexpr int LDS_BYTES = 147456;

#define GAS __attribute__((address_space(1)))
#define LAS __attribute__((address_space(3)))
typedef unsigned short bf16;
typedef unsigned v4u __attribute__((ext_vector_type(4)));
typedef float f32x4 __attribute__((ext_vector_type(4)));
typedef GAS unsigned gu32;
#define RLX_AGENT __ATOMIC_RELAXED, __HIP_MEMORY_SCOPE_AGENT
#define LDS_WAIT() asm volatile("s_waitcnt lgkmcnt(0)" ::: "memory")
__device__ __forceinline__ unsigned f2bf(float f) { unsigned u = __builtin_bit_cast(unsigned, f); return (u + 0x7fffu + ((u >> 16) & 1u)) >> 16; }
typedef float f32x2v_ __attribute__((ext_vector_type(2))); typedef __bf16 bf16x2v_ __attribute__((ext_vector_type(2)));
__device__ __forceinline__ unsigned pk2(float lo, float hi) { const f32x2v_ v = {lo, hi}; return __builtin_bit_cast(unsigned, __builtin_convertvector(v, bf16x2v_)); }
__device__ __forceinline__ float bf2f(unsigned short v) { return __uint_as_float((unsigned)v << 16); }
__device__ __forceinline__ float bflo(unsigned w) { return __uint_as_float(w << 16); }
__device__ __forceinline__ float bfhi(unsigned w) { return __uint_as_float(w & 0xffff0000u); }
__device__ __forceinline__ void unpack8(const v4u w, float (&f)[8]) { f[0] = bflo(w.x); f[1] = bfhi(w.x); f[2] = bflo(w.y); f[3] = bfhi(w.y); f[4] = bflo(w.z); f[5] = bfhi(w.z); f[6] = bflo(w.w); f[7] = bfhi(w.w); }
__device__ __forceinline__ float sigmoid_f(float x) { return 1.0f / (1.0f + __expf(-x)); }
__device__ __forceinline__ float wave_sum(float v) {
#pragma unroll
    for (int o = 1; o < 64; o <<= 1) v += __shfl_xor(v, o);
    return v;
}

#define XB_TMO      128
#define XB_XCNT(j)  (256  + 64 * (j))
#define XB_XSUB(j)  (1280 + 64 * (j))
#define XB_XGEN(j)  (2304 + 64 * (j))
#define XB_TOP      3328
#define XB_TOPGEN   3392
#define XCD_BAR_WORDS 3456
#define XB_SPIN_CAP (1u << 22)

__device__ __forceinline__ unsigned xb_ld(unsigned* p)              { return __hip_atomic_load(p, __ATOMIC_RELAXED, __HIP_MEMORY_SCOPE_AGENT); }
__device__ __forceinline__ unsigned xb_add(unsigned* p, unsigned v) { return __hip_atomic_fetch_add(p, v, __ATOMIC_RELAXED, __HIP_MEMORY_SCOPE_AGENT); }
__device__ __forceinline__ unsigned xb_xcc_id() { return (unsigned)__builtin_amdgcn_s_getreg((3 << 11) | 20) & 0xFu; }
#define XB_SPIN(cond, bar) do { unsigned _sp = 0; while (cond) { __builtin_amdgcn_s_sleep(1); \
    if ((++_sp & 255u) == 0u) { if (xb_ld(&(bar)[XB_TMO])) break; if (_sp > XB_SPIN_CAP) { atomicAdd(&(bar)[XB_TMO], 1u); break; } } } } while (0)

struct XcdBarrier { unsigned* bar; unsigned x; volatile LAS unsigned* st; };

__device__ __forceinline__ XcdBarrier xcd_barrier_post(unsigned* bar, volatile LAS unsigned* st) {
    XcdBarrier b; b.bar = bar; b.x = xb_xcc_id(); b.st = st;
    if (threadIdx.x == 0) (void)xb_add(&bar[XB_XCNT(b.x)], 1u);
    return b;
}
__device__ __forceinline__ void xcd_barrier_complete(unsigned* bar, unsigned x, unsigned& nloc, unsigned& nx) {
    const unsigned G = gridDim.x * gridDim.y * gridDim.z;
    unsigned sum, cnt, mine, sp = 0u;
    for (;;) {
        sum = 0u; cnt = 0u; mine = 0u;
#pragma unroll
        for (unsigned j = 0; j < 16; ++j) { const unsigned c = xb_ld(&bar[XB_XCNT(j)]); sum += c; cnt += (c > 0u) ? 1u : 0u; mine = (j == x) ? c : mine; }
        if (sum == G) break;
        __builtin_amdgcn_s_sleep(1);
        if ((++sp & 255u) == 0u) { if (xb_ld(&bar[XB_TMO])) break; if (sp > XB_SPIN_CAP) { atomicAdd(&bar[XB_TMO], 1u); break; } }
    }
    nloc = mine > 0u ? mine : 1u; nx = cnt > 0u ? cnt : 1u;
}
__device__ __forceinline__ void xcd_barrier(const XcdBarrier& b) {
    asm volatile("s_waitcnt vmcnt(0)" ::: "memory");
    __syncthreads();
    if (threadIdx.x == 0) {
        unsigned* bar = b.bar;
        __builtin_amdgcn_s_waitcnt(0);
        unsigned nloc = b.st[0], nx = b.st[1];
        if (nloc == 0u) { xcd_barrier_complete(bar, b.x, nloc, nx); b.st[0] = nloc; b.st[1] = nx; }
        const unsigned old = xb_add(&bar[XB_XSUB(b.x)], 1u);
        const unsigned gen = old / nloc;
        if (old + 1u == (gen + 1u) * nloc) {
            __builtin_amdgcn_fence(__ATOMIC_RELEASE, "agent");
            asm volatile("s_waitcnt vmcnt(0)" ::: "memory");
            const unsigned og = xb_add(&bar[XB_TOP], 1u);
            const unsigned tg = og / nx;
            if (og + 1u == (tg + 1u) * nx) xb_add(&bar[XB_TOPGEN], 1u);
            else XB_SPIN(xb_ld(&bar[XB_TOPGEN]) == tg, bar);
            __builtin_amdgcn_fence(__ATOMIC_ACQUIRE, "agent");
            xb_add(&bar[XB_XGEN(b.x)], 1u);
            asm volatile("s_waitcnt vmcnt(0)" ::: "memory");
        } else {
            XB_SPIN(xb_ld(&bar[XB_XGEN(b.x)]) == gen, bar);
            __builtin_amdgcn_fence(__ATOMIC_ACQUIRE, "agent");
            asm volatile("s_waitcnt vmcnt(0)" ::: "memory");
        }
    }
    __syncthreads();
}

#ifndef DIAG_SLOT_D
#define DIAG_SLOT_D (-1)
#endif
#ifndef DIAG_DIV
#define DIAG_DIV 1.0f
#endif
constexpr size_t WS_DIAG = 3 * MiB + 900 * 1024;
#define DG_START(k, var) unsigned var = 0; if (DIAG_SLOT_D == (k)) var = (unsigned)__builtin_amdgcn_s_memtime();
#define DG_STOP(k, var, acc) if (DIAG_SLOT_D == (k)) acc += (unsigned)__builtin_amdgcn_s_memtime() - var;
#define DG_WRITE(k, cond, acc) if (DIAG_SLOT_D == (k) && (cond)) ((unsigned*)(F.ws + WS_DIAG))[0] = acc;
struct Args { const float* in[31]; float* out; unsigned char* ws; int ph_lo, ph_hi; int dup_phase, qdup, rep_scan, rep_thr; int stag_up, stag_in; };
struct Frame {
    LAS unsigned char* lds;
    int tid, lane, wave, vcu, G;
    const float* const __attribute__((address_space(4)))* in;
    float* out; unsigned char* ws;
};
enum { I_X = 0, I_F1N, I_F1G, I_F1U, I_F1D, I_MIXN, I_WIN, I_WOUT, I_MU, I_W0, I_W2, I_A0, I_A2, I_G2, I_KK, I_KA, I_RK, I_LNW, I_LNB, I_VRW, I_VRMU, I_V0, I_V2, I_KVN, I_WUK, I_WUV, I_F2N, I_F2G, I_F2U, I_F2D, I_FN };

__device__ __forceinline__ void conv_item(const Frame& F, int l, int kind, int item, LAS float* scr) {
    const int lane = F.lane;
    int Kd, nkb; bf16* WT;
    if (kind == 0 || kind == 4) { Kd = 1024; WT = (bf16*)(F.ws + (kind == 0 ? WS_WGU1 : WS_WGU2)); }
    else if (kind == 1 || kind == 5) { Kd = FFP; WT = (bf16*)(F.ws + (kind == 1 ? WS_WD1 : WS_WD2)); }
    else if (kind == 2) { Kd = 1024; WT = (bf16*)(F.ws + WS_WIN); }
    else { Kd = 1024; WT = (bf16*)(F.ws + WS_WOUT); }
    nkb = Kd / 64;
    const int rb = item / nkb, kb = item % nkb, r0 = rb * 32, k0 = kb * 64;
    const int n4 = (lane & 7) * 4, kr = lane >> 3;
    const int rr = r0 + n4;
    const float* src = nullptr; int ns = 0, col = 0, ksrc = 1024; const float* gain = nullptr; float scale = 1.0f;
    if (kind == 0 || kind == 4) {
        const int tile = rr >> 8, w = rr & 255, hid = tile * 128 + (w & 127);
        if (hid < FF) { const float* s1 = (w >> 7) ? F.in[I_F1U] : F.in[I_F1G]; const float* s2 = (w >> 7) ? F.in[I_F2U] : F.in[I_F2G]; src = ((kind == 0) ? s1 : s2) + (size_t)l * 1024 * FF; ns = FF; col = hid; }
        gain = ((kind == 0) ? F.in[I_F1N] : F.in[I_F2N]) + l * 1024;
    } else if (kind == 1 || kind == 5) {
        src = ((kind == 1) ? F.in[I_F1D] : F.in[I_F2D]) + (size_t)l * FF * 1024; ns = 1024; col = rr; ksrc = FF; scale = 0.5f;
    } else if (kind == 2) {
        gain = F.in[I_MIXN] + l * 1024;
        if (rr < 1280) { src = F.in[I_WIN] + (size_t)l * 1024 * NIN; ns = NIN; col = rr; }
        else if (rr < 1296) { if (l > 0) { src = F.in[I_VRW] + (size_t)(l - 1) * 1024 * 16; ns = 16; col = rr - 1280; } }
        else if (rr < PUSED) { src = F.in[I_WIN] + (size_t)l * 1024 * NIN; ns = NIN; col = rr - 16; }
    } else { src = F.in[I_WOUT] + (size_t)l * 1024 * 1024; ns = 1024; col = rr; }
    {
        const bool has = (src != nullptr); const float* sp = has ? src : F.in[I_FN]; const int nss = has ? ns : 0, cols = has ? col : 0;
        f32x4 vals[8];
#pragma unroll
        for (int i = 0; i < 8; ++i) { const int k = k0 + 8 * i + kr; const int kc = k < ksrc ? k : ksrc - 1; vals[i] = *(const GAS f32x4*)(sp + (size_t)kc * nss + cols); }
#pragma unroll
        for (int i = 0; i < 8; ++i) { const int kk = 8 * i + kr, k = k0 + kk; float g = (has && k < ksrc) ? scale : 0.f; if (gain) g *= gain[k < 1024 ? k : 1023];
            LAS float* d = scr + kk * 33 + n4; d[0] = vals[i][0] * g; d[1] = vals[i][1] * g; d[2] = vals[i][2] * g; d[3] = vals[i][3] * g; }
    }
    LDS_WAIT(); asm volatile("" ::: "memory");
    const int c = lane & 7;
#pragma unroll
    for (int j = 0; j < 4; ++j) { const int n = (lane >> 3) + 8 * j; const LAS float* s = scr + (8 * c) * 33 + n;
        v4u o; o.x = pk2(s[0 * 33], s[1 * 33]); o.y = pk2(s[2 * 33], s[3 * 33]); o.z = pk2(s[4 * 33], s[5 * 33]); o.w = pk2(s[6 * 33], s[7 * 33]);
        *(GAS v4u*)(WT + (size_t)(r0 + n) * Kd + k0 + 8 * c) = o; }
    LDS_WAIT(); asm volatile("" ::: "memory");
}
__host__ __device__ constexpr int conv_items(int kind) { return (kind == 0 || kind == 4) ? (NGU / 32) * 16 : (kind == 1 || kind == 5) ? 32 * (FFP / 64) : (kind == 2) ? (PP / 32) * 16 : 32 * 16; }
__device__ __forceinline__ void conv_weights(const Frame& F, int l, int k_lo, int k_hi) {
    LAS float* scr = (LAS float*)(F.lds + F.wave * 16384);
    const int gw = F.vcu * NWAVES + F.wave, NGW = F.G * NWAVES;
    for (int kind = k_lo; kind < k_hi; ++kind) { const int ni = conv_items(kind);
        for (int it = gw; it < ni; it += NGW) conv_item(F, l, kind, it, scr); }
}

__host__ __device__ constexpr int conv_flat_items(bool has_next) { return conv_items(3) + conv_items(4) + conv_items(5) + (has_next ? conv_items(0) + conv_items(1) + conv_items(2) : 0); }
constexpr int CONV_PER_WAVE = 2;
__device__ __forceinline__ void conv_unit(const Frame& F, int l, int u) {
    LAS float* scr = (LAS float*)(F.lds + F.wave * 16384);
    const bool has_next = (l + 1 < DEPTH);
#pragma unroll 1
    for (int rep = 0; rep < CONV_PER_WAVE; ++rep) {
    int it = (u * CONV_PER_WAVE + rep) * NWAVES + F.wave;
    if (it >= conv_flat_items(has_next)) return;
    int layer = l, kind = 3;
    if (it >= conv_items(3)) { it -= conv_items(3); kind = 4;
        if (it >= conv_items(4)) { it -= conv_items(4); kind = 5;
            if (it >= conv_items(5)) { it -= conv_items(5); kind = 0; layer = l + 1;
                if (it >= conv_items(0)) { it -= conv_items(0); kind = 1;
                    if (it >= conv_items(1)) { it -= conv_items(1); kind = 2; } } } } }
    conv_item(F, layer, kind, it, scr);
    }
}
__device__ __forceinline__ void p0_x(const Frame& F) {
    const int gw = F.vcu * NWAVES + F.wave, NGW = F.G * NWAVES;
    const float* x = F.in[I_X]; bf16* xb = (bf16*)(F.ws + WS_XB); float* part = (float*)(F.ws + WS_PART);
    for (int m = gw; m < M; m += NGW) {
        const GAS f32x4* xr = (const GAS f32x4*)(x + (size_t)m * DM) + F.lane; float s = 0.f;
        GAS unsigned long long* o8 = (GAS unsigned long long*)(xb + (size_t)m * DM) + F.lane;
#pragma unroll
        for (int j = 0; j < 4; ++j) { const f32x4 v = xr[64 * j]; s += (v.x * v.x + v.y * v.y) + (v.z * v.z + v.w * v.w);
            o8[64 * j] = (unsigned long long)pk2(v.x, v.y) | ((unsigned long long)pk2(v.z, v.w) << 32); }
        s = wave_sum(s);
        if (F.lane < 16) part[(size_t)m * 16 + F.lane] = (F.lane == 0) ? s : 0.f;
    }
}
__device__ __forceinline__ void p0_table(const Frame& F) {
    float* tab = (float*)(F.ws + WS_TAB);
    for (int i = F.vcu * NTHR + F.tid; i < SEQ * 32; i += F.G * NTHR) { const int t = i >> 5, f = i & 31; const float th = exp2f(-(float)f * (13.287712379549449f / 31.0f)); const float ang = (float)t * th; float s, c; sincosf(ang, &s, &c); tab[2 * i] = c; tab[2 * i + 1] = s; }
}

__device__ __forceinline__ void ret_kv_unit(const Frame& F, int unit) {
    unsigned dga_ = 0;
    DG_START(30, dg30_)
    LAS float* kr = (LAS float*)F.lds; LAS float* vv = kr + 128 * 64;
    const int tid = F.tid, c = unit & 15, h = (unit >> 4) & 3, b = unit >> 6, tok0 = b * SEQ + c * 128;
    const bf16* P = (const bf16*)(F.ws + WS_P); const float* tab = (const float*)(F.ws + WS_TAB);
    const float lg2 = log2f(1.0f - exp2f(-5.0f - (float)h));
    for (int idx = tid; idx < 128 * 32; idx += NTHR) { const int m = idx >> 5, i = idx & 31; const size_t ro = (size_t)(tok0 + m) * PP;
        const float k1 = bf2f(P[ro + PCK + h * 64 + i]), k2 = bf2f(P[ro + PCK + h * 64 + 32 + i]);
        const float cs = tab[((c * 128 + m) * 32 + i) * 2], sn = tab[((c * 128 + m) * 32 + i) * 2 + 1];
        const float sc = 0.125f * exp2f((float)(127 - m) * lg2);
        kr[m * 64 + i] = (k1 * cs - k2 * sn) * sc; kr[m * 64 + 32 + i] = (k1 * sn + k2 * cs) * sc;
        vv[m * 64 + i] = bf2f(P[ro + PCV + h * 64 + i]); vv[m * 64 + 32 + i] = bf2f(P[ro + PCV + h * 64 + 32 + i]); }
    __syncthreads();
    const int d = tid >> 3, e0 = (tid & 7) * 8; float acc[8];
#pragma unroll
    for (int e = 0; e < 8; ++e) acc[e] = 0.f;
    for (int m = 0; m < 128; ++m) { const float kd = kr[m * 64 + d];
#pragma unroll
        for (int e = 0; e < 8; ++e) acc[e] += kd * vv[m * 64 + e0 + e]; }
    float* KV = (float*)(F.ws + WS_KV) + (size_t)unit * 4096 + d * 64 + e0;
#pragma unroll
    for (int e = 0; e < 8; ++e) KV[e] = acc[e];
    __syncthreads();
    DG_STOP(30, dg30_, dga_)
    DG_WRITE(30, unit == 0 && F.wave == 0 && F.lane == 0, dga_)
}

typedef float f32x2 __attribute__((ext_vector_type(2)));
__device__ __forceinline__ float dpp_add16(float x) {
    x += __builtin_bit_cast(float, __builtin_amdgcn_mov_dpp(__builtin_bit_cast(int, x), 0xB1, 0xF, 0xF, true));
    x += __builtin_bit_cast(float, __builtin_amdgcn_mov_dpp(__builtin_bit_cast(int, x), 0x4E, 0xF, 0xF, true));
    x += __builtin_bit_cast(float, __builtin_amdgcn_mov_dpp(__builtin_bit_cast(int, x), 0x141, 0xF, 0xF, true));
    x += __builtin_bit_cast(float, __builtin_amdgcn_mov_dpp(__builtin_bit_cast(int, x), 0x140, 0xF, 0xF, true));
    return x;
}
constexpr int CH = 32;
constexpr int RW_STG = 5 * CH * 64;
constexpr int RW_ROWS = 16;
struct RwOps { f32x4 r, d, k, q, b; float v; };
__device__ __forceinline__ void rw_ld(RwOps& o, const LAS float* base, const LAS float* vb, int s, int ks, int row) {
    const LAS f32x4* p = (const LAS f32x4*)(base + s * 64 + ks * 4);
    o.r = p[0]; o.d = p[CH * 16]; o.k = p[2 * CH * 16]; o.q = p[3 * CH * 16]; o.b = p[4 * CH * 16];
    o.v = vb[s * RW_ROWS + row];
}
#define LO2(x) __builtin_shufflevector(x, x, 0, 1)
#define HI2(x) __builtin_shufflevector(x, x, 2, 3)
__device__ __forceinline__ float rw_step1(f32x2 (&S)[2], const RwOps& o, float v) {
    f32x2 p2 = S[0] * LO2(o.q); p2 = S[1] * HI2(o.q) + p2;
    const float p = dpp_add16(p2.x + p2.y);
    const f32x2 pp = (f32x2){p, p}, vv = (f32x2){v, v};
    S[0] = S[0] - LO2(o.d) * S[0]; S[1] = S[1] - HI2(o.d) * S[1];
    S[0] = S[0] - pp * LO2(o.b); S[1] = S[1] - pp * HI2(o.b);
    S[0] = vv * LO2(o.k) + S[0]; S[1] = vv * HI2(o.k) + S[1];
    f32x2 y2 = S[0] * LO2(o.r); y2 = S[1] * HI2(o.r) + y2;
    return dpp_add16(y2.x + y2.y);
}
__device__ __forceinline__ void rwkv_scan_unit(const Frame& F, int l, int unit) {
    const int tid = F.tid, lane = F.lane, wave = F.wave, quarter = unit & 3, bh = unit >> 2, b = bh / 6, h = bh - b * 6, tokb = b * SEQ;
    LAS float* stg = (LAS float*)F.lds; LAS float* vst = stg + 2 * RW_STG; LAS float* ybuf = vst + 2 * CH * RW_ROWS;
    bf16* P = (bf16*)(F.ws + WS_P);
    constexpr int NCH = SEQ / CH;
    unsigned dga_ = 0;
    if (wave >= 4) {
        const int st = tid - 256;
        const int t01 = st >> 3, c01 = st & 7, tv = st >> 1, cv = st & 1;
        const bf16* a0 = (const bf16*)(F.ws + WS_R); const bf16* a1 = (const bf16*)(F.ws + WS_D); const bf16* a2 = (const bf16*)(F.ws + WS_K2); const bf16* a3 = (const bf16*)(F.ws + WS_KK);
        const bf16* a4 = (const bf16*)((const unsigned char*)F.out + OUT_BP); const bf16* a5 = (const bf16*)(F.ws + WS_VF);
        v4u sreg[6];
#define RW_LOAD(cc) do { const size_t o_ = (size_t)(tokb + (cc) * CH + t01) * AW + h * 64 + c01 * 8; sreg[0] = *(const GAS v4u*)(a0 + o_); sreg[1] = *(const GAS v4u*)(a1 + o_); sreg[2] = *(const GAS v4u*)(a2 + o_); \
            sreg[3] = *(const GAS v4u*)(a3 + o_); sreg[4] = *(const GAS v4u*)(a4 + o_); if (st < 64) sreg[5] = *(const GAS v4u*)(a5 + (size_t)(tokb + (cc) * CH + tv) * AW + h * 64 + quarter * RW_ROWS + cv * 8); } while (0)
#define RW_ST1(i, dstp) do { float f[8]; unpack8(sreg[i], f); LAS f32x4* dst = (LAS f32x4*)(dstp); dst[0] = (f32x4){f[0], f[1], f[2], f[3]}; dst[1] = (f32x4){f[4], f[5], f[6], f[7]}; } while (0)
#define RW_STORE(bufi) do { _Pragma("unroll") for (int i = 0; i < 5; ++i) RW_ST1(i, stg + (bufi) * RW_STG + i * CH * 64 + t01 * 64 + c01 * 8); if (st < 64) RW_ST1(5, vst + (bufi) * CH * RW_ROWS + tv * RW_ROWS + cv * 8); } while (0)
#define RW_OUT(cc) do { if (st < 128) { const LAS float* yb_ = ybuf + ((cc) & 1) * CH * RW_ROWS; const int s_ = st >> 2, r4_ = (st & 3) * 4; const f32x4 yv = *(const LAS f32x4*)(yb_ + s_ * RW_ROWS + r4_); \
            *(GAS unsigned long long*)(P + (size_t)(tokb + (cc) * CH + s_) * PP + h * 64 + quarter * RW_ROWS + r4_) = (unsigned long long)pk2(yv[0], yv[1]) | ((unsigned long long)pk2(yv[2], yv[3]) << 32); } } while (0)
        RW_LOAD(0); RW_STORE(0); RW_LOAD(1);
        __syncthreads();
        for (int cc = 0; cc < NCH; ++cc) {
            if (cc + 1 < NCH) RW_STORE((cc + 1) & 1);
            if (cc + 2 < NCH) RW_LOAD(cc + 2);
            if (cc > 0) RW_OUT(cc - 1);
            asm volatile("s_waitcnt lgkmcnt(0)" ::: "memory"); __builtin_amdgcn_s_barrier(); asm volatile("" ::: "memory");
        }
        RW_OUT(NCH - 1);
#undef RW_LOAD
#undef RW_ST1
#undef RW_STORE
#undef RW_OUT
        return;
    }
    const int row = 4 * wave + (lane >> 4), ks = lane & 15;
    f32x2 Sa[2] = {(f32x2){0.f, 0.f}, (f32x2){0.f, 0.f}};
    __syncthreads();
    for (int cc = 0; cc < NCH; ++cc) {
        const int bufi = cc & 1;
        const LAS float* base = stg + bufi * RW_STG; const LAS float* vb = vst + bufi * CH * RW_ROWS; LAS float* yb = ybuf + bufi * CH * RW_ROWS;
        RwOps A, B; float yk0 = 0.f;
        DG_START(40, dg40_)
        rw_ld(A, base, vb, 0, ks, row);
#pragma unroll
        for (int s = 0; s < CH; s += 2) {
            rw_ld(B, base, vb, s + 1, ks, row);
            { const float y0 = rw_step1(Sa, A, A.v); yk0 = (ks == (s & 15)) ? y0 : yk0; }
            if (s + 2 < CH) rw_ld(A, base, vb, s + 2, ks, row);
            { const float y0 = rw_step1(Sa, B, B.v); yk0 = (ks == ((s + 1) & 15)) ? y0 : yk0; }
            if (((s + 1) & 15) == 15) yb[(s - 14 + ks) * RW_ROWS + row] = yk0;
        }
        DG_STOP(40, dg40_, dga_)
        DG_START(43, dg43_)
        asm volatile("s_waitcnt lgkmcnt(0)" ::: "memory"); __builtin_amdgcn_s_barrier(); asm volatile("" ::: "memory");
        DG_STOP(43, dg43_, dga_)
    }
    DG_WRITE(40, unit == 0 && l == 0 && wave == 0 && lane == 0, dga_)
    DG_WRITE(43, unit == 0 && l == 0 && wave == 0 && lane == 0, dga_)
}
__device__ __forceinline__ void rwkv_post(const Frame& F, int l) {
    bf16* P = (bf16*)(F.ws + WS_P); const bf16* VF = (const bf16*)(F.ws + WS_VF); const bf16* Gg = (const bf16*)((const unsigned char*)F.out + OUT_G); const float* BON = (const float*)(F.ws + WS_BON);
    const int sub = F.tid >> 4, c4 = (F.tid & 15) * 4;
    for (int pr = F.vcu * 32 + sub; pr < M * 6; pr += F.G * 32) { const int tok = pr / 6, h = pr - tok * 6;
        const unsigned long long yw = *(const GAS unsigned long long*)(P + (size_t)tok * PP + h * 64 + c4), vw = *(const GAS unsigned long long*)(VF + (size_t)tok * AW + h * 64 + c4), gw = *(const GAS unsigned long long*)(Gg + (size_t)tok * AW + h * 64 + c4);
        const f32x4 lnw = *(const f32x4*)(F.in[I_LNW] + l * AW + h * 64 + c4), lnb = *(const f32x4*)(F.in[I_LNB] + l * AW + h * 64 + c4);
        const float bon = BON[(size_t)tok * 6 + h];
        const f32x4 yv = (f32x4){bflo((unsigned)yw), bfhi((unsigned)yw), bflo((unsigned)(yw >> 32)), bfhi((unsigned)(yw >> 32))};
        const f32x4 vv = (f32x4){bflo((unsigned)vw), bfhi((unsigned)vw), bflo((unsigned)(vw >> 32)), bfhi((unsigned)(vw >> 32))};
        const f32x4 gg = (f32x4){bflo((unsigned)gw), bfhi((unsigned)gw), bflo((unsigned)(gw >> 32)), bfhi((unsigned)(gw >> 32))};
        float sm = (yv[0] + yv[1]) + (yv[2] + yv[3]);
        sm += __shfl_xor(sm, 1); sm += __shfl_xor(sm, 2); sm += __shfl_xor(sm, 4); sm += __shfl_xor(sm, 8);
        const float mean = sm * (1.0f / 64.0f); const f32x4 dv = yv - mean;
        float vs = (dv[0] * dv[0] + dv[1] * dv[1]) + (dv[2] * dv[2] + dv[3] * dv[3]);
        vs += __shfl_xor(vs, 1); vs += __shfl_xor(vs, 2); vs += __shfl_xor(vs, 4); vs += __shfl_xor(vs, 8);
        const float rs = 1.0f / sqrtf(vs * (1.0f / 64.0f) + 64e-5f);
        const f32x4 o = (dv * rs * lnw + lnb + bon * vv) * gg;
        *(GAS unsigned long long*)(P + (size_t)tok * PP + h * 64 + c4) = (unsigned long long)pk2(o[0], o[1]) | ((unsigned long long)pk2(o[2], o[3]) << 32);
    }
}

typedef short bf16x8_t __attribute__((ext_vector_type(8)));
typedef short s16x4_t __attribute__((ext_vector_type(4)));
typedef float f32x16_t __attribute__((ext_vector_type(16)));
__device__ __forceinline__ unsigned fkey(float f) { const unsigned u = __float_as_uint(f); return (u & 0x80000000u) ? ~u : (u | 0x80000000u); }
__device__ __forceinline__ int crow32(int r, int hi) { return (r & 3) + 8 * (r >> 2) + 4 * hi; }
__device__ __forceinline__ unsigned off_a(unsigned row, unsigned ch) { return 2048u * (row >> 3) + 512u * (ch >> 2) + 64u * (row & 7) + 16u * ((ch & 3) ^ ((row >> 2) & 3)); }

__device__ __forceinline__ void idx_scores(const bf16x8_t (&Af)[2], const bf16x8_t (&Bf)[8][2], const float (&iwf)[8], float (&sc)[4]) {
    sc[0] = sc[1] = sc[2] = sc[3] = 0.f;
#pragma unroll
    for (int h = 0; h < 8; ++h) { f32x4 a = (f32x4){0.f, 0.f, 0.f, 0.f};
        a = __builtin_amdgcn_mfma_f32_16x16x32_bf16(Af[0], Bf[h][0], a, 0, 0, 0);
        a = __builtin_amdgcn_mfma_f32_16x16x32_bf16(Af[1], Bf[h][1], a, 0, 0, 0);
#pragma unroll
        for (int r = 0; r < 4; ++r) { const float av_ = a[r]; const int ai_ = __float_as_int(av_); const float rl = __int_as_float(ai_ > 0 ? ai_ : 0); sc[r] = fmaf(iwf[h], rl, sc[r]); } }
}
__device__ __forceinline__ void idx_load_q(const bf16* P, int tokq, bf16x8_t (&Bf)[8][2], float (&iwf)[8], int fq) {
    const bf16* row = P + (size_t)tokq * PP;
#pragma unroll
    for (int h = 0; h < 8; ++h)
#pragma unroll
        for (int ks = 0; ks < 2; ++ks) Bf[h][ks] = *(const GAS bf16x8_t*)(row + PBIQ + h * 64 + ks * 32 + fq * 8);
    const v4u w = *(const GAS v4u*)(row + PBIW); float f[8]; unpack8(w, f);
#pragma unroll
    for (int h = 0; h < 8; ++h) iwf[h] = f[h] * (0.35355339059327373f * 0.125f);
}

__device__ __forceinline__ void lds_barrier() { asm volatile("s_waitcnt lgkmcnt(0)" ::: "memory"); __builtin_amdgcn_s_barrier(); asm volatile("" ::: "memory"); }
constexpr int SKP = 2052;
__device__ __forceinline__ void dsa_thr_unit(const Frame& F, int unit) {
    LAS unsigned* sk = (LAS unsigned*)F.lds;
    const int lane = F.lane, wave = F.wave, fr = lane & 15, fq = lane >> 4;
    const int b = unit & 7, qb = 127 - (unit >> 3), t0 = qb * 16, tok0 = b * SEQ + t0;
    const bf16* P = (const bf16*)(F.ws + WS_P);
    unsigned dga_ = 0;
    DG_START(10, dg10_)
    {
        bf16x8_t Bf[8][2]; float iwf[8];
        idx_load_q(P, tok0 + fr, Bf, iwf, fq);
        bf16x8_t An[2];
        { const int kt0 = wave <= qb ? wave : qb; const bf16* krow = P + (size_t)(b * SEQ + kt0 * 16 + fr) * PP + PBIK + fq * 8; An[0] = *(const GAS bf16x8_t*)(krow); An[1] = *(const GAS bf16x8_t*)(krow + 32); }
        for (int kt = wave; kt <= qb; kt += 8) {
            bf16x8_t Af[2]; Af[0] = An[0]; Af[1] = An[1];
            { const int ktn = kt + 8 <= qb ? kt + 8 : qb; const bf16* krow = P + (size_t)(b * SEQ + ktn * 16 + fr) * PP + PBIK + fq * 8; An[0] = *(const GAS bf16x8_t*)(krow); An[1] = *(const GAS bf16x8_t*)(krow + 32); }
            float sc[4]; idx_scores(Af, Bf, iwf, sc);
            v4u kv;
            const int s0 = kt * 16 + 4 * fq, t = t0 + fr;
            kv.x = (s0 + 0 <= t) ? fkey(sc[0]) : 0u; kv.y = (s0 + 1 <= t) ? fkey(sc[1]) : 0u; kv.z = (s0 + 2 <= t) ? fkey(sc[2]) : 0u; kv.w = (s0 + 3 <= t) ? fkey(sc[3]) : 0u;
            *(LAS v4u*)(sk + fr * SKP + s0) = kv;
        }
    }
    __syncthreads();
    DG_STOP(10, dg10_, dga_)
    DG_WRITE(10, unit == 0 && wave == 0 && lane == 0, dga_)
    DG_START(11, dg11_)
    unsigned* THR = (unsigned*)(F.ws + WS_THR); int* SCUT = (int*)(F.ws + WS_SCUT);
    for (int qi = 0; qi < 2; ++qi) { const int q = 2 * wave + qi, t = t0 + q, n = t + 1;
        unsigned thr = 0u; int scut = SEQ - 1;
        if (n > TOPK) {
            unsigned keys[32];
#pragma unroll
            for (int i = 0; i < 32; ++i) keys[i] = (64 * i + lane <= t) ? sk[q * SKP + 64 * i + lane] : 0u;
            unsigned prefix = 0u; bool done = false;
            const int ng = (t >> 9) + 1;
            for (int bit = 31; bit >= 0; --bit) { const unsigned cand = prefix | (1u << bit); int cnt = 0;
#pragma unroll
                for (int g = 0; g < 4; ++g) if (g < ng) {
#pragma unroll
                    for (int i = 8 * g; i < 8 * g + 8; ++i) cnt += __popcll(__ballot(keys[i] >= cand)); }
                if (cnt >= TOPK) prefix = cand;
                if (cnt == TOPK) { thr = cand - 1u; scut = -1; done = true; break; } }
            if (!done) {
                int cgt = 0;
#pragma unroll
                for (int i = 0; i < 32; ++i) cgt += __popcll(__ballot(keys[i] > prefix));
                int need = TOPK - cgt, run = 0; thr = prefix; scut = SEQ - 1; bool found = false;
#pragma unroll
                for (int i = 0; i < 32; ++i) { unsigned long long mk = __ballot(keys[i] == prefix); const int c = __popcll(mk);
                    if (!found && run + c >= need) { int k = need - run; while (k > 1) { mk &= mk - 1ull; --k; } scut = 64 * i + (int)__builtin_ctzll(mk); found = true; }
                    run += c; }
            }
        }
        {
            unsigned* MK = (unsigned*)((unsigned char*)F.out + OUT_MASK) + (size_t)(tok0 + q) * 64;
            if (n > TOPK) {
#pragma unroll
                for (int i = 0; i < 32; ++i) { const int s = 64 * i + lane; const unsigned key = (s <= t) ? sk[q * SKP + s] : 0u;
                    const unsigned long long bal = __ballot((s <= t) & ((key > thr) | ((key == thr) & (s <= scut))));
                    if (lane < 2 && 64 * i <= t) MK[2 * i + lane] = lane ? (unsigned)(bal >> 32) : (unsigned)bal; }
            } else {
                if (lane < 8) { const int w0 = lane; MK[w0] = (32 * w0 + 31 <= t) ? 0xffffffffu : ((32 * w0 <= t) ? ((1u << ((t & 31) + 1)) - 1u) : 0u); }
            }
        }
    }
    DG_STOP(11, dg11_, dga_)
    DG_WRITE(11, unit == 0 && wave == 0 && lane == 0, dga_)
    __syncthreads();
}

constexpr int QLP = 136;
constexpr int MKP = 36;
constexpr int DA_MASK = 0, DA_QL = 2 * 32 * MKP * 4, DA_CT = DA_QL + 6 * 32 * QLP * 2;
__device__ __forceinline__ void dsa_attn_unit(const Frame& F, int l, int unit) {
    const int tid = F.tid, lane = F.lane, wave = F.wave, r32 = lane & 31, hi = lane >> 5;
    const int b = unit & 7, qb = 63 - (unit >> 3), t0 = qb * 32, tok0 = b * SEQ + t0, ntile = qb + 1;
    bf16* P = (bf16*)(F.ws + WS_P); const bf16* C = (const bf16*)(F.ws + WS_C);
    LAS float* MASK = (LAS float*)(F.lds + DA_MASK); LAS unsigned char* QLb = F.lds + DA_QL; LAS unsigned char* CT = F.lds + DA_CT;
    const int crow_ = tid >> 4, cch = tid & 15; const unsigned cdst = off_a((unsigned)crow_, (unsigned)cch);
    const bf16* csrc = C + (size_t)(b * SEQ + crow_) * 128 + cch * 8;
    v4u cpre = *(const GAS v4u*)(csrc);
    if (wave >= 6) {
        const int fr = lane & 15, fq = lane >> 4, qh = wave - 6;
        const int tq = tok0 + 16 * qh + fr, tq_t = t0 + 16 * qh + fr, jmax = tq_t >> 5;
        const unsigned* MK = (const unsigned*)((const unsigned char*)F.out + OUT_MASK) + (size_t)tq * 64;
        LAS float* mrow = MASK + (16 * qh + fr) * MKP + 8 * fq;
#define DA_EXPAND(word, slot) do { const unsigned w_ = (word) >> (8 * fq); f32x4 m0_, m1_; \
            m0_[0] = (w_ & 1u) ? 0.f : -1e30f; m0_[1] = (w_ & 2u) ? 0.f : -1e30f; m0_[2] = (w_ & 4u) ? 0.f : -1e30f; m0_[3] = (w_ & 8u) ? 0.f : -1e30f; \
            m1_[0] = (w_ & 16u) ? 0.f : -1e30f; m1_[1] = (w_ & 32u) ? 0.f : -1e30f; m1_[2] = (w_ & 64u) ? 0.f : -1e30f; m1_[3] = (w_ & 128u) ? 0.f : -1e30f; \
            *(LAS f32x4*)(mrow + (slot) * (32 * MKP)) = m0_; *(LAS f32x4*)(mrow + (slot) * (32 * MKP) + 4) = m1_; } while (0)
        unsigned w0 = MK[0], w1 = (1 <= jmax) ? MK[1] : 0u, w2 = (2 <= jmax) ? MK[2] : 0u;
        DA_EXPAND(w0, 0);
        *(LAS v4u*)(CT + cdst) = cpre;
        lds_barrier();
        for (int j = 0; j < ntile; ++j) {
            if (j + 1 < ntile) {
                cpre = *(const GAS v4u*)(csrc + (size_t)(j + 1) * 32 * 128);
                DA_EXPAND(w1, (j + 1) & 1);
                w1 = w2; w2 = (j + 3 <= jmax) ? MK[j + 3] : 0u;
                *(LAS v4u*)(CT + ((j + 1) & 1) * 8192 + cdst) = cpre; }
            lds_barrier();
        }
#undef DA_EXPAND
        lds_barrier();
        return;
    }
    const int h = wave;
    LAS unsigned char* QLh = QLb + h * (32 * QLP * 2);
    float negb;
    {
        unsigned zo_ = 0u; asm volatile("" : "+v"(zo_));
        const bf16* wukT = (const bf16*)(F.ws + WS_WUKT) + (size_t)(l * 6 + h) * 128 * 64 + zo_;
        bf16x8_t qf[4]; float ssq = 0.f;
#pragma unroll
        for (int ks = 0; ks < 4; ++ks) qf[ks] = *(const GAS bf16x8_t*)(P + (size_t)(tok0 + r32) * PP + PBQ + h * 64 + ks * 16 + hi * 8);
#pragma unroll
        for (int blk = 0; blk < 4; ++blk) { f32x16_t x;
#pragma unroll
            for (int i = 0; i < 16; ++i) x[i] = 0.f;
#pragma unroll
            for (int ks = 0; ks < 4; ++ks) { const bf16x8_t a = *(const GAS bf16x8_t*)(wukT + (size_t)(blk * 32 + r32) * 64 + ks * 16 + hi * 8); x = __builtin_amdgcn_mfma_f32_32x32x16_bf16(a, qf[ks], x, 0, 0, 0); }
#pragma unroll
            for (int g = 0; g < 4; ++g) { const float sc = 0.125f * 1.4426950408889634f;
                const float x0 = x[4 * g] * sc, x1 = x[4 * g + 1] * sc, x2 = x[4 * g + 2] * sc, x3 = x[4 * g + 3] * sc; ssq += (x0 * x0 + x1 * x1) + (x2 * x2 + x3 * x3);
                const unsigned long long w = (unsigned long long)pk2(x0, x1) | ((unsigned long long)pk2(x2, x3) << 32);
                *(LAS unsigned long long*)(QLh + (r32 * QLP + blk * 32 + 8 * g + 4 * hi) * 2) = w; } }
        ssq += __shfl_xor(ssq, 32);
        const float* kvn = F.in[I_KVN] + l * 128; float gm = fmaxf(fabsf(kvn[2 * lane]), fabsf(kvn[2 * lane + 1]));
#pragma unroll
        for (int o_ = 1; o_ < 64; o_ <<= 1) gm = fmaxf(gm, __shfl_xor(gm, o_));
        negb = -(sqrtf(ssq) * 11.32f * gm * 1.01f + 0.01f);
    }
    *(LAS v4u*)(CT + cdst) = cpre;
    lds_barrier();
    f32x16_t o[4]; float l_run = 0.f;
    const LAS unsigned char* qlrow = QLh + (r32 * QLP + 8 * hi) * 2;
#pragma unroll
    for (int c = 0; c < 4; ++c)
#pragma unroll
        for (int i = 0; i < 16; ++i) o[c][i] = 0.f;
    const unsigned rr_ = ((unsigned)r32 >> 2) & 3u, rb_ = 2048u * ((unsigned)r32 >> 3) + 64u * ((unsigned)r32 & 7u);
    const unsigned rbase0 = rb_ + 16u * ((unsigned)hi ^ rr_), rbase1 = rb_ + 16u * ((2u + (unsigned)hi) ^ rr_);
    const unsigned blk_ = (lane >> 4) & 1, q_ = (lane & 15) >> 2, p_ = lane & 3;
    unsigned dga_ = 0;
    for (int j = 0; j < ntile; ++j) {
        DG_START(0, dgt_)
        LAS unsigned char* kb = CT + (j & 1) * 8192;
        if (j + 1 < ntile) cpre = *(const GAS v4u*)(csrc + (size_t)(j + 1) * 32 * 128);
        {
            f32x16_t S;
#pragma unroll
            for (int i = 0; i < 16; ++i) S[i] = negb;
#pragma unroll
            for (int s = 0; s < 8; ++s) { const bf16x8_t a = *(const LAS bf16x8_t*)(kb + ((s & 1) ? rbase1 : rbase0) + 512 * (s >> 1)); const bf16x8_t bq = *(const LAS bf16x8_t*)(qlrow + 32 * s);
                S = __builtin_amdgcn_mfma_f32_32x32x16_bf16(a, bq, S, 0, 0, 0); }
            const LAS f32x4* mk = (const LAS f32x4*)(MASK + (j & 1) * (32 * MKP) + r32 * MKP + 4 * hi);
            float psum = 0.f; float e[16];
#pragma unroll
            for (int g = 0; g < 4; ++g) { const f32x4 mv = mk[2 * g];
#pragma unroll
                for (int e4 = 0; e4 < 4; ++e4) { e[4 * g + e4] = __builtin_amdgcn_exp2f(S[4 * g + e4] + mv[e4]); psum += e[4 * g + e4]; } }
            l_run += psum;
            bf16x8_t xs[2];
#pragma unroll
            for (int s = 0; s < 2; ++s) { v4u w; w.x = pk2(e[8 * s], e[8 * s + 1]); w.y = pk2(e[8 * s + 2], e[8 * s + 3]); w.z = pk2(e[8 * s + 4], e[8 * s + 5]); w.w = pk2(e[8 * s + 6], e[8 * s + 7]); xs[s] = __builtin_bit_cast(bf16x8_t, w); }
#pragma unroll
            for (int c = 0; c < 4; ++c)
#pragma unroll
                for (int s = 0; s < 2; ++s) {
                    const unsigned a0 = off_a((unsigned)(16 * s + 4 * hi + q_), (unsigned)(4 * c + 2 * blk_ + (p_ >> 1))) + 8u * (p_ & 1);
                    const unsigned a1 = off_a((unsigned)(16 * s + 8 + 4 * hi + q_), (unsigned)(4 * c + 2 * blk_ + (p_ >> 1))) + 8u * (p_ & 1);
                    const s16x4_t lo = __builtin_bit_cast(s16x4_t, __builtin_amdgcn_ds_read_tr16_b64_v4i16((LAS s16x4_t*)(kb + a0)));
                    const s16x4_t hh = __builtin_bit_cast(s16x4_t, __builtin_amdgcn_ds_read_tr16_b64_v4i16((LAS s16x4_t*)(kb + a1)));
                    const bf16x8_t a = (bf16x8_t){lo[0], lo[1], lo[2], lo[3], hh[0], hh[1], hh[2], hh[3]};
                    o[c] = __builtin_amdgcn_mfma_f32_32x32x16_bf16(a, xs[s], o[c], 0, 0, 0); }
        }
        if (j + 1 < ntile) *(LAS v4u*)(CT + ((j + 1) & 1) * 8192 + cdst) = cpre;
        DG_STOP(0, dgt_, dga_)
        lds_barrier();
    }
    DG_WRITE(0, unit == 0 && l == 0 && wave == 0 && lane == 0, dga_)
    {
        const float lt = l_run + __shfl_xor(l_run, 32); const float inv = 1.0f / lt;
#pragma unroll
        for (int c = 0; c < 4; ++c)
#pragma unroll
            for (int g = 0; g < 4; ++g) { const unsigned long long w = (unsigned long long)pk2(o[c][4 * g] * inv, o[c][4 * g + 1] * inv) | ((unsigned long long)pk2(o[c][4 * g + 2] * inv, o[c][4 * g + 3] * inv) << 32);
                *(LAS unsigned long long*)(QLh + (r32 * QLP + c * 32 + 8 * g + 4 * hi) * 2) = w; }
        unsigned zo2_ = 0u; asm volatile("" : "+v"(zo2_));
        const bf16* wuvT = (const bf16*)(F.ws + WS_WUVT) + (size_t)(l * 6 + h) * 64 * 128 + zo2_;
        bf16x8_t Bo[8];
#pragma unroll
        for (int s = 0; s < 8; ++s) Bo[s] = *(const LAS bf16x8_t*)(QLh + (r32 * QLP + 16 * s + 8 * hi) * 2);
#pragma unroll
        for (int mb = 0; mb < 2; ++mb) { f32x16_t y;
#pragma unroll
            for (int i = 0; i < 16; ++i) y[i] = 0.f;
#pragma unroll
            for (int s = 0; s < 8; ++s) { const bf16x8_t a = *(const GAS bf16x8_t*)(wuvT + (size_t)(mb * 32 + r32) * 128 + 16 * s + 8 * hi); y = __builtin_amdgcn_mfma_f32_32x32x16_bf16(a, Bo[s], y, 0, 0, 0); }
#pragma unroll
            for (int g = 0; g < 4; ++g) { const unsigned long long w = (unsigned long long)pk2(y[4 * g], y[4 * g + 1]) | ((unsigned long long)pk2(y[4 * g + 2], y[4 * g + 3]) << 32);
                *(GAS unsigned long long*)(P + (size_t)(tok0 + r32) * PP + 384 + h * 64 + mb * 32 + 8 * g + 4 * hi) = w; } }
    }
    lds_barrier();
}
constexpr int RC = 32;
constexpr int P64 = 72, P32 = 40, PTS = 36;
constexpr int RPW = 72, RAWSZ = 32 * RPW, GP = 68;
constexpr int RK_RAW = 0;
constexpr int RK_GAM = RK_RAW + 6 * RAWSZ * 2;
constexpr int RK_AL = RK_GAM + 33 * GP * 4, RK_RH = RK_AL + 32 * P64 * 2, RK_BE = RK_RH + 32 * P64 * 2, RK_KA = RK_BE + 32 * P64 * 2;
constexpr int RK_BET = RK_KA + 32 * P64 * 2, RK_KAT = RK_BET + 64 * P32 * 2, RK_VT = RK_KAT + 64 * P32 * 2;
constexpr int RK_NT = RK_VT + 64 * P32 * 2, RK_BRT = RK_NT + 32 * P32 * 2, RK_KRT = RK_BRT + 32 * P32 * 2;
constexpr int RK_PR = RK_KRT + 32 * P32 * 2, RK_PC = RK_PR + 32 * P32 * 2, RK_MR = RK_PC + 32 * P32 * 2, RK_MT = RK_MR + 32 * P32 * 2;
constexpr int RK_ZB = RK_MT + 32 * P32 * 2;
constexpr int RK_XB = RK_ZB + 2 * 64 * P64 * 2;
constexpr int RK_EB = RK_XB + 64 * P32 * 2;
constexpr int RK_BRT2 = RK_EB + 64 * P32 * 2, RK_BET2 = RK_BRT2 + 32 * P32 * 2, RK_GC = RK_BET2 + 64 * P32 * 2;
constexpr int RK_END = RK_GC + 512;
static_assert(RK_END <= RING_BYTES, "chunked RWKV unit: LDS");
template <int KS> __device__ __forceinline__ void mm_ld(bf16x8_t (&a)[KS], bf16x8_t (&b)[KS], const LAS bf16* X, int px, const LAS bf16* Y, int py, int r32, int hi) {
#pragma unroll
    for (int s = 0; s < KS; ++s) { a[s] = *(const LAS bf16x8_t*)(X + r32 * px + 16 * s + 8 * hi); b[s] = *(const LAS bf16x8_t*)(Y + r32 * py + 16 * s + 8 * hi); }
}
template <int KS> __device__ __forceinline__ void mm_do(f32x16_t& acc, const bf16x8_t (&a)[KS], const bf16x8_t (&b)[KS]) {
#pragma unroll
    for (int s = 0; s < KS; ++s) acc = __builtin_amdgcn_mfma_f32_32x32x16_bf16(a[s], b[s], acc, 0, 0, 0);
}
template <int KS> __device__ __forceinline__ void mm_abt(f32x16_t& acc, const LAS bf16* X, int px, const LAS bf16* Y, int py, int r32, int hi) {
    bf16x8_t a[KS], b[KS]; mm_ld<KS>(a, b, X, px, Y, py, r32, hi); mm_do<KS>(acc, a, b);
}
template <int K1, int K2> __device__ __forceinline__ void mm_abt2(f32x16_t& acc, const LAS bf16* X1, int px1, const LAS bf16* Y1, int py1, const LAS bf16* X2, int px2, const LAS bf16* Y2, int py2, int r32, int hi) {
    bf16x8_t a1[K1], b1[K1], a2[K2], b2[K2]; mm_ld<K1>(a1, b1, X1, px1, Y1, py1, r32, hi); mm_ld<K2>(a2, b2, X2, px2, Y2, py2, r32, hi); mm_do<K1>(acc, a1, b1); mm_do<K2>(acc, a2, b2);
}
__device__ __forceinline__ void rwkv_chunk_unit(const Frame& F, int l, int unit) {
    const int tid = F.tid, lane = F.lane, wave = F.wave, r32 = lane & 31, hi = lane >> 5;
    const int b = unit / 6, h = unit - b * 6, tokb = b * SEQ;
    LAS bf16* RAW = (LAS bf16*)(F.lds + RK_RAW); LAS float* GAM = (LAS float*)(F.lds + RK_GAM);
    LAS bf16* AL = (LAS bf16*)(F.lds + RK_AL); LAS bf16* RH = (LAS bf16*)(F.lds + RK_RH); LAS bf16* BE = (LAS bf16*)(F.lds + RK_BE); LAS bf16* KA = (LAS bf16*)(F.lds + RK_KA);
    LAS bf16* KAT = (LAS bf16*)(F.lds + RK_KAT); LAS bf16* VT = (LAS bf16*)(F.lds + RK_VT);
    LAS bf16* NT = (LAS bf16*)(F.lds + RK_NT); LAS bf16* KRT = (LAS bf16*)(F.lds + RK_KRT);
    LAS bf16* ZB = (LAS bf16*)(F.lds + RK_ZB); LAS bf16* XB = (LAS bf16*)(F.lds + RK_XB); LAS bf16* EB = (LAS bf16*)(F.lds + RK_EB);
    LAS bf16* PR = (LAS bf16*)(F.lds + RK_PR); LAS bf16* PC = (LAS bf16*)(F.lds + RK_PC); LAS bf16* MR = (LAS bf16*)(F.lds + RK_MR); LAS bf16* MT = (LAS bf16*)(F.lds + RK_MT);
    LAS float* GC = (LAS float*)(F.lds + RK_GC);
    bf16* P = (bf16*)(F.ws + WS_P);
    constexpr int NCH = SEQ / RC;
    const int half = tid >> 8, idx = tid & 255, lt = idx >> 3, lc = idx & 7;
    const bf16* s0 = (const bf16*)(F.ws + (half ? WS_KK : WS_R)); const bf16* s1 = half ? (const bf16*)((const unsigned char*)F.out + OUT_BP) : (const bf16*)(F.ws + WS_D); const bf16* s2 = (const bf16*)(F.ws + (half ? WS_VF : WS_K2));
    v4u pre[3];
#define RK_LOAD(cc) do { const size_t o_ = (size_t)(tokb + (cc) * RC + lt) * AW + h * 64 + lc * 8; pre[0] = *(const GAS v4u*)(s0 + o_); pre[1] = *(const GAS v4u*)(s1 + o_); pre[2] = *(const GAS v4u*)(s2 + o_); } while (0)
#define RK_H1() do { _Pragma("unroll") for (int j = 0; j < 3; ++j) *(LAS v4u*)(RAW + (3 * half + j) * RAWSZ + lt * RPW + lc * 8) = pre[j]; } while (0)
#define RK_PROD8(s_) ({ float w_[8]; _Pragma("unroll") for (int j = 0; j < 8; ++j) w_[j] = 1.0f - __builtin_bit_cast(float, (unsigned)RAW[RAWSZ + (8 * (s_) + j) * RPW + lane] << 16); \
        ((w_[0] * w_[1]) * (w_[2] * w_[3])) * ((w_[4] * w_[5]) * (w_[6] * w_[7])); })
#define RK_H2(cn) do { if (wave >= 4) { const int seg = wave - 4; float w_[8]; _Pragma("unroll") for (int j = 0; j < 8; ++j) w_[j] = 1.0f - __builtin_bit_cast(float, (unsigned)RAW[RAWSZ + (8 * seg + j) * RPW + lane] << 16); \
        float g = 1.f; if (seg >= 1) { const float p0 = RK_PROD8(0); g = p0; if (seg >= 2) { const float p1 = RK_PROD8(1); g *= p1; if (seg >= 3) { const float p2 = RK_PROD8(2); g *= p2; } } } \
        _Pragma("unroll") for (int j = 0; j < 8; ++j) { g *= w_[j]; GAM[(8 * seg + j + 1) * GP + lane] = g; } \
        if (seg == 3) GC[((cn) & 1) * 64 + lane] = g; } } while (0)
#define RK_H3(cn) do { LAS bf16* BETn = (LAS bf16*)(F.lds + (((cn) & 1) ? RK_BET2 : RK_BET)); \
        { \
            { const int it = tid; const int t = it & 31, k4 = (it >> 5) * 4;        \
                const f32x4 g1 = *(const LAS f32x4*)(GAM + (t + 1) * GP + k4), g0 = *(const LAS f32x4*)(GAM + t * GP + k4); \
                const unsigned long long rw = *(const LAS unsigned long long*)(RAW + 0 * RAWSZ + t * RPW + k4), kw = *(const LAS unsigned long long*)(RAW + 2 * RAWSZ + t * RPW + k4); \
                const unsigned long long qw = *(const LAS unsigned long long*)(RAW + 3 * RAWSZ + t * RPW + k4), bw = *(const LAS unsigned long long*)(RAW + 4 * RAWSZ + t * RPW + k4); \
                const f32x4 rv = (f32x4){bflo((unsigned)rw), bfhi((unsigned)rw), bflo((unsigned)(rw >> 32)), bfhi((unsigned)(rw >> 32))}, kv = (f32x4){bflo((unsigned)kw), bfhi((unsigned)kw), bflo((unsigned)(kw >> 32)), bfhi((unsigned)(kw >> 32))}; \
                const f32x4 qv = (f32x4){bflo((unsigned)qw), bfhi((unsigned)qw), bflo((unsigned)(qw >> 32)), bfhi((unsigned)(qw >> 32))}, bv = (f32x4){bflo((unsigned)bw), bfhi((unsigned)bw), bflo((unsigned)(bw >> 32)), bfhi((unsigned)(bw >> 32))}; \
                const f32x4 rg = (f32x4){__builtin_amdgcn_rcpf(g1[0]), __builtin_amdgcn_rcpf(g1[1]), __builtin_amdgcn_rcpf(g1[2]), __builtin_amdgcn_rcpf(g1[3])}; \
                const f32x4 al = -(qv * g0), rh = rv * g1, be = bv * rg, ka = kv * rg; \
                const unsigned be0 = pk2(be[0], be[1]), be1 = pk2(be[2], be[3]), ka0 = pk2(ka[0], ka[1]), ka1 = pk2(ka[2], ka[3]); \
                *(LAS unsigned long long*)(AL + t * P64 + k4) = (unsigned long long)pk2(al[0], al[1]) | ((unsigned long long)pk2(al[2], al[3]) << 32); \
                *(LAS unsigned long long*)(RH + t * P64 + k4) = (unsigned long long)pk2(rh[0], rh[1]) | ((unsigned long long)pk2(rh[2], rh[3]) << 32); \
                *(LAS unsigned long long*)(BE + t * P64 + k4) = (unsigned long long)be0 | ((unsigned long long)be1 << 32); \
                *(LAS unsigned long long*)(KA + t * P64 + k4) = (unsigned long long)ka0 | ((unsigned long long)ka1 << 32); \
                BETn[(k4 + 0) * P32 + t] = (bf16)(be0 & 0xffffu); BETn[(k4 + 1) * P32 + t] = (bf16)(be0 >> 16); BETn[(k4 + 2) * P32 + t] = (bf16)(be1 & 0xffffu); BETn[(k4 + 3) * P32 + t] = (bf16)(be1 >> 16); \
                KAT[(k4 + 0) * P32 + t] = (bf16)(ka0 & 0xffffu); KAT[(k4 + 1) * P32 + t] = (bf16)(ka0 >> 16); KAT[(k4 + 2) * P32 + t] = (bf16)(ka1 & 0xffffu); KAT[(k4 + 3) * P32 + t] = (bf16)(ka1 >> 16); } \
            if (tid >= 256) { const int ix = tid - 256, i = ix & 31, v8 = (ix >> 5) * 8; const v4u w = *(const LAS v4u*)(RAW + 5 * RAWSZ + i * RPW + v8); \
                VT[(v8 + 0) * P32 + i] = (bf16)(w.x & 0xffffu); VT[(v8 + 1) * P32 + i] = (bf16)(w.x >> 16); VT[(v8 + 2) * P32 + i] = (bf16)(w.y & 0xffffu); VT[(v8 + 3) * P32 + i] = (bf16)(w.y >> 16); \
                VT[(v8 + 4) * P32 + i] = (bf16)(w.z & 0xffffu); VT[(v8 + 5) * P32 + i] = (bf16)(w.z >> 16); VT[(v8 + 6) * P32 + i] = (bf16)(w.w & 0xffffu); VT[(v8 + 7) * P32 + i] = (bf16)(w.w >> 16); } } } while (0)
#define RK_ST_ROWS(O, acc_) do { _Pragma("unroll") for (int r = 0; r < 16; ++r) (O)[crow32(r, hi) * P32 + r32] = (bf16)(pk2((acc_)[r], 0.f) & 0xffffu); } while (0)
#define RK_ST_COLS(O, acc_) do { _Pragma("unroll") for (int g = 0; g < 4; ++g) *(LAS unsigned long long*)((O) + r32 * P32 + 8 * g + 4 * hi) = (unsigned long long)pk2((acc_)[4 * g], (acc_)[4 * g + 1]) | ((unsigned long long)pk2((acc_)[4 * g + 2], (acc_)[4 * g + 3]) << 32); } while (0)
#define RK_CH_A() do { f32x16_t acc; _Pragma("unroll") for (int i = 0; i < 16; ++i) acc[i] = 0.f; \
        mm_abt<4>(acc, BE, P64, AL, P64, r32, hi); \
        _Pragma("unroll") for (int r = 0; r < 16; ++r) { const int i = crow32(r, hi); acc[r] = (i < r32) ? acc[r] : 0.f; macc[r] = acc[r] + ((i == r32) ? 1.0f : 0.f); } \
        RK_ST_ROWS(PR, acc); RK_ST_COLS(PC, acc); \
        bf16x8_t ta[2], tb[2]; mm_ld<2>(ta, tb, PR, P32, PC, P32, r32, hi); f32x16_t p2; _Pragma("unroll") for (int i = 0; i < 16; ++i) p2[i] = 0.f; mm_do<2>(p2, ta, tb); \
        RK_ST_ROWS(PR, p2); RK_ST_COLS(PC, p2); macc += p2; \
        bf16x8_t pa[2], pb[2]; mm_ld<2>(pa, pb, PR, P32, PC, P32, r32, hi); f32x16_t p4; _Pragma("unroll") for (int i = 0; i < 16; ++i) p4[i] = 0.f; mm_do<2>(p4, pa, pb); mm_do<2>(macc, ta, pb); \
        RK_ST_ROWS(PR, p4); RK_ST_COLS(PC, p4); RK_ST_ROWS(MR, macc); } while (0)
#define RK_CH_B() do { { bf16x8_t pa[2], pb[2], ma[2]; mm_ld<2>(pa, pb, PR, P32, PC, P32, r32, hi); _Pragma("unroll") for (int s_ = 0; s_ < 2; ++s_) ma[s_] = *(const LAS bf16x8_t*)(MR + r32 * P32 + 16 * s_ + 8 * hi); \
            f32x16_t p8; _Pragma("unroll") for (int i = 0; i < 16; ++i) p8[i] = 0.f; mm_do<2>(p8, pa, pb); mm_do<2>(macc, ma, pb); \
            RK_ST_ROWS(PR, p8); RK_ST_COLS(PC, p8); RK_ST_ROWS(MR, macc); } \
        { bf16x8_t pa[2], pb[2], ma[2]; mm_ld<2>(pa, pb, PR, P32, PC, P32, r32, hi); _Pragma("unroll") for (int s_ = 0; s_ < 2; ++s_) ma[s_] = *(const LAS bf16x8_t*)(MR + r32 * P32 + 16 * s_ + 8 * hi); \
            f32x16_t p16; _Pragma("unroll") for (int i = 0; i < 16; ++i) p16[i] = 0.f; mm_do<2>(p16, pa, pb); mm_do<2>(macc, ma, pb); \
            RK_ST_COLS(PC, p16); RK_ST_ROWS(MR, macc); } \
        { bf16x8_t pb[2], ma[2]; _Pragma("unroll") for (int s_ = 0; s_ < 2; ++s_) { ma[s_] = *(const LAS bf16x8_t*)(MR + r32 * P32 + 16 * s_ + 8 * hi); pb[s_] = *(const LAS bf16x8_t*)(PC + r32 * P32 + 16 * s_ + 8 * hi); } \
            mm_do<2>(macc, ma, pb); RK_ST_COLS(MT, macc); } } while (0)
#define RK_H4(cn) do { if (wave == 0) RK_CH_A(); \
        else if (wave < 3) { LAS bf16* BRTn = (LAS bf16*)(F.lds + (((cn) & 1) ? RK_BRT2 : RK_BRT)); f32x16_t acc; \
        _Pragma("unroll") for (int i = 0; i < 16; ++i) acc[i] = 0.f; \
        if (wave == 1) { f32x16_t ac2; _Pragma("unroll") for (int i = 0; i < 16; ++i) ac2[i] = 0.f; \
            mm_abt<4>(acc, AL, P64, KA, P64, r32, hi); mm_abt<4>(ac2, RH, P64, KA, P64, r32, hi); \
            _Pragma("unroll") for (int r = 0; r < 16; ++r) { acc[r] = (r32 < crow32(r, hi)) ? acc[r] : 0.f; ac2[r] = (r32 <= crow32(r, hi)) ? ac2[r] : 0.f; } \
            RK_ST_ROWS(NT, acc); RK_ST_ROWS(KRT, ac2); } \
        else { mm_abt<4>(acc, RH, P64, BE, P64, r32, hi); \
            _Pragma("unroll") for (int r = 0; r < 16; ++r) acc[r] = (r32 <= crow32(r, hi)) ? acc[r] : 0.f; \
            RK_ST_ROWS(BRTn, acc); } } } while (0)
    RK_LOAD(0);
    for (int u = tid; u < 64 * P64 / 2; u += NTHR) ((LAS unsigned*)ZB)[u] = 0u;
    if (tid < 64) GAM[tid] = 1.f;
    f32x16_t zacc, macc;
#pragma unroll
    for (int i = 0; i < 16; ++i) { zacc[i] = 0.f; macc[i] = 0.f; }
#define RK_RELANE() int ln_ = F.lane, td_ = F.tid; asm volatile("" : "+v"(ln_), "+v"(td_)); const int lane = ln_, tid = td_, r32 = ln_ & 31, hi = ln_ >> 5; (void)lane; (void)tid; (void)r32; (void)hi;
    RK_H1(); RK_LOAD(1);
    lds_barrier();
    { RK_RELANE() RK_H2(0); }
    lds_barrier();
    { RK_RELANE() RK_H3(0); }
    lds_barrier();
    { RK_RELANE() RK_H4(0); } RK_H1(); RK_LOAD(2);
    lds_barrier();
    unsigned dga_ = 0;
    for (int c = 0; c < NCH; ++c) {
        const int tok0 = tokb + c * RC;
        int ln_ = F.lane, td_ = F.tid; asm volatile("" : "+v"(ln_), "+v"(td_));
        const int lane = ln_, tid = td_, r32 = ln_ & 31, hi = ln_ >> 5;
        const LAS bf16* Zc = ZB + (c & 1) * 64 * P64; LAS bf16* Zn = ZB + ((c + 1) & 1) * 64 * P64;
        const LAS bf16* BRTc = (const LAS bf16*)(F.lds + ((c & 1) ? RK_BRT2 : RK_BRT)); const LAS bf16* BETc = (const LAS bf16*)(F.lds + ((c & 1) ? RK_BET2 : RK_BET));
        DG_START(70, dg70_) DG_START(73, dg73_) DG_START(76, dg76_)
        f32x16_t yacc0, yacc1;
        if (wave == 0) RK_CH_B();
        else if (wave < 3) { const int vb = wave - 1; f32x16_t acc;
#pragma unroll
            for (int i = 0; i < 16; ++i) acc[i] = 0.f;
            mm_abt2<4, 2>(acc, Zc + 32 * vb * P64, P64, AL, P64, VT + 32 * vb * P32, P32, NT, P32, r32, hi);
            RK_ST_ROWS(XB + 32 * vb * P32, acc); }
        else if (wave == 3) {
#pragma unroll
            for (int i = 0; i < 16; ++i) { yacc0[i] = 0.f; yacc1[i] = 0.f; }
            mm_abt2<4, 2>(yacc0, Zc, P64, RH, P64, VT, P32, KRT, P32, r32, hi);
            mm_abt2<4, 2>(yacc1, Zc + 32 * P64, P64, RH, P64, VT + 32 * P32, P32, KRT, P32, r32, hi); }
        else { mm_abt<2>(zacc, VT + 32 * ((wave - 4) >> 1) * P32, P32, KAT + 32 * ((wave - 4) & 1) * P32, P32, r32, hi);
            if (c + 1 < NCH) RK_H2(c + 1); }
        if (DIAG_SLOT_D == 73) { asm volatile("s_waitcnt lgkmcnt(0)" ::: "memory"); DG_STOP(73, dg73_, dga_) }
        lds_barrier();
        DG_STOP(70, dg70_, dga_) DG_START(71, dg71_) DG_START(74, dg74_)
        if (wave == 1 || wave == 2) { const int vb = wave - 1; f32x16_t acc;
#pragma unroll
            for (int i = 0; i < 16; ++i) acc[i] = 0.f;
            mm_abt<2>(acc, XB + 32 * vb * P32, P32, MT, P32, r32, hi);
            RK_ST_ROWS(EB + 32 * vb * P32, acc); }
        if (c + 1 < NCH) RK_H3(c + 1);
        if (DIAG_SLOT_D == 74) { asm volatile("s_waitcnt lgkmcnt(0)" ::: "memory"); DG_STOP(74, dg74_, dga_) }
        lds_barrier();
        DG_STOP(71, dg71_, dga_) DG_START(72, dg72_) DG_START(75, dg75_)
        if (c + 2 < NCH) { RK_H1(); if (c + 3 < NCH) RK_LOAD(c + 3); }
        if (wave == 3) {
            mm_abt<2>(yacc0, EB, P32, BRTc, P32, r32, hi); mm_abt<2>(yacc1, EB + 32 * P32, P32, BRTc, P32, r32, hi);
            bf16* yo = P + (size_t)(tok0 + r32) * PP + h * 64 + 4 * hi;
#pragma unroll
            for (int g = 0; g < 4; ++g) { *(GAS unsigned long long*)(yo + 8 * g) = (unsigned long long)pk2(yacc0[4 * g], yacc0[4 * g + 1]) | ((unsigned long long)pk2(yacc0[4 * g + 2], yacc0[4 * g + 3]) << 32);
                *(GAS unsigned long long*)(yo + 32 + 8 * g) = (unsigned long long)pk2(yacc1[4 * g], yacc1[4 * g + 1]) | ((unsigned long long)pk2(yacc1[4 * g + 2], yacc1[4 * g + 3]) << 32); } }
        else if (wave >= 4) { const int vb = (wave - 4) >> 1, kb = (wave - 4) & 1;
            mm_abt<2>(zacc, EB + 32 * vb * P32, P32, BETc + 32 * kb * P32, P32, r32, hi);
            const float gc = GC[(c & 1) * 64 + 32 * kb + r32];
#pragma unroll
            for (int r = 0; r < 16; ++r) { zacc[r] *= gc; Zn[(32 * vb + crow32(r, hi)) * P64 + 32 * kb + r32] = (bf16)(pk2(zacc[r], 0.f) & 0xffffu); } }
        if (c + 1 < NCH) RK_H4(c + 1);
        if (DIAG_SLOT_D == 75) { asm volatile("s_waitcnt lgkmcnt(0)" ::: "memory"); DG_STOP(75, dg75_, dga_) }
        lds_barrier();
        DG_STOP(72, dg72_, dga_) DG_STOP(76, dg76_, dga_)
    }
    DG_WRITE(70, unit == 0 && l == 0 && F.tid == 0, dga_) DG_WRITE(71, unit == 0 && l == 0 && F.tid == 0, dga_) DG_WRITE(72, unit == 0 && l == 0 && F.tid == 0, dga_) DG_WRITE(76, unit == 0 && l == 0 && F.tid == 0, dga_)
    DG_WRITE(73, unit == 0 && l == 0 && F.tid == 448, dga_) DG_WRITE(74, unit == 0 && l == 0 && F.tid == 64, dga_) DG_WRITE(75, unit == 0 && l == 0 && F.tid == 0, dga_)
#undef RK_LOAD
#undef RK_H1
#undef RK_PROD8
#undef RK_H2
#undef RK_H3
#undef RK_H4
#undef RK_RELANE
#undef RK_CH_A
#undef RK_CH_B
#undef RK_ST_ROWS
#undef RK_ST_COLS
}

constexpr int RP = 72;
constexpr int RT_QR = 0, RT_KR = 128 * RP * 2, RT_VV = 2 * 128 * RP * 2, RT_ST = 3 * 128 * RP * 2, RT_SS = RT_ST + 64 * RP * 2, RT_KD = RT_SS + 1024;
__device__ __forceinline__ void ret_out_unit(const Frame& F, int unit) {
    const int tid = F.tid, lane = F.lane, wave = F.wave, r32 = lane & 31, hi = lane >> 5;
    const int h = unit & 3, b = unit >> 2;
    bf16* P = (bf16*)(F.ws + WS_P); const float* tab = (const float*)(F.ws + WS_TAB);
    LAS bf16* QR = (LAS bf16*)(F.lds + RT_QR); LAS bf16* KR = (LAS bf16*)(F.lds + RT_KR); LAS bf16* VV = (LAS bf16*)(F.lds + RT_VV); LAS bf16* ST = (LAS bf16*)(F.lds + RT_ST);
    LAS float* SS = (LAS float*)(F.lds + RT_SS); LAS bf16* KD = (LAS bf16*)(F.lds + RT_KD);
    const float lg2 = log2f(1.0f - exp2f(-5.0f - (float)h));
    f32x16_t st;
#pragma unroll
    for (int i = 0; i < 16; ++i) st[i] = 0.f;
    const float cdec = exp2f(128.0f * lg2);
    unsigned long long pre[2][6]; f32x4 pret[2][2];
#define RT_LOAD(cn) do { _Pragma("unroll") for (int it_ = 0; it_ < 2; ++it_) { const int idx_ = tid + it_ * NTHR, m_ = idx_ >> 3, i4_ = (idx_ & 7) * 4; const size_t ro_ = (size_t)(b * SEQ + (cn) * 128 + m_) * PP + h * 64 + i4_; \
        pre[it_][0] = *(const GAS unsigned long long*)(P + ro_ + PCQ); pre[it_][1] = *(const GAS unsigned long long*)(P + ro_ + PCQ + 32); pre[it_][2] = *(const GAS unsigned long long*)(P + ro_ + PCK); \
        pre[it_][3] = *(const GAS unsigned long long*)(P + ro_ + PCK + 32); pre[it_][4] = *(const GAS unsigned long long*)(P + ro_ + PCV); pre[it_][5] = *(const GAS unsigned long long*)(P + ro_ + PCV + 32); \
        pret[it_][0] = *(const GAS f32x4*)(tab + ((size_t)((cn) * 128 + m_) * 32 + i4_) * 2); pret[it_][1] = *(const GAS f32x4*)(tab + ((size_t)((cn) * 128 + m_) * 32 + i4_) * 2 + 4); } } while (0)
    unsigned dga_ = 0;
    DG_START(60, dg60_)
    RT_LOAD(0);
    for (int c = 0; c < 16; ++c) {
    const int tok0 = b * SEQ + c * 128;
#pragma unroll
    for (int it = 0; it < 2; ++it) { const int idx = tid + it * NTHR, m = idx >> 3, i4 = (idx & 7) * 4;
        const unsigned long long q1w = pre[it][0], q2w = pre[it][1], k1w = pre[it][2], k2w = pre[it][3], v1w = pre[it][4], v2w = pre[it][5];
        const f32x4 t0 = pret[it][0], t1 = pret[it][1];
        const float cs[4] = {t0[0], t0[2], t1[0], t1[2]}, sn[4] = {t0[1], t0[3], t1[1], t1[3]};
        const float q1[4] = {bflo((unsigned)q1w), bfhi((unsigned)q1w), bflo((unsigned)(q1w >> 32)), bfhi((unsigned)(q1w >> 32))}, q2[4] = {bflo((unsigned)q2w), bfhi((unsigned)q2w), bflo((unsigned)(q2w >> 32)), bfhi((unsigned)(q2w >> 32))};
        const float k1[4] = {bflo((unsigned)k1w), bfhi((unsigned)k1w), bflo((unsigned)(k1w >> 32)), bfhi((unsigned)(k1w >> 32))}, k2[4] = {bflo((unsigned)k2w), bfhi((unsigned)k2w), bflo((unsigned)(k2w >> 32)), bfhi((unsigned)(k2w >> 32))};
        float qa[4], qb[4], ka[4], kb[4];
#pragma unroll
        for (int j = 0; j < 4; ++j) { qa[j] = q1[j] * cs[j] - q2[j] * sn[j]; qb[j] = q1[j] * sn[j] + q2[j] * cs[j]; ka[j] = (k1[j] * cs[j] - k2[j] * sn[j]) * 0.125f; kb[j] = (k1[j] * sn[j] + k2[j] * cs[j]) * 0.125f; }
        *(LAS unsigned long long*)(QR + m * RP + i4) = (unsigned long long)pk2(qa[0], qa[1]) | ((unsigned long long)pk2(qa[2], qa[3]) << 32);
        *(LAS unsigned long long*)(QR + m * RP + 32 + i4) = (unsigned long long)pk2(qb[0], qb[1]) | ((unsigned long long)pk2(qb[2], qb[3]) << 32);
        *(LAS unsigned long long*)(KR + m * RP + i4) = (unsigned long long)pk2(ka[0], ka[1]) | ((unsigned long long)pk2(ka[2], ka[3]) << 32);
        *(LAS unsigned long long*)(KR + m * RP + 32 + i4) = (unsigned long long)pk2(kb[0], kb[1]) | ((unsigned long long)pk2(kb[2], kb[3]) << 32);
        { const float kd = exp2f((float)(127 - m) * lg2);
          *(LAS unsigned long long*)(KD + m * RP + i4) = (unsigned long long)pk2(ka[0] * kd, ka[1] * kd) | ((unsigned long long)pk2(ka[2] * kd, ka[3] * kd) << 32);
          *(LAS unsigned long long*)(KD + m * RP + 32 + i4) = (unsigned long long)pk2(kb[0] * kd, kb[1] * kd) | ((unsigned long long)pk2(kb[2] * kd, kb[3] * kd) << 32); }
        *(LAS unsigned long long*)(VV + m * RP + i4) = v1w; *(LAS unsigned long long*)(VV + m * RP + 32 + i4) = v2w; }
    if (c + 1 < 16) RT_LOAD(c + 1);
    if (wave < 4) {
        const int db = wave >> 1, ebs = wave & 1;
#pragma unroll
        for (int i = 0; i < 16; ++i) ST[(32 * db + crow32(i, hi)) * RP + 32 * ebs + r32] = (bf16)(pk2(st[i], 0.f) & 0xffffu);
    }
    lds_barrier();
    const int nb = wave >> 1, eb = wave & 1, n = nb * 32 + r32;
    const unsigned blk_ = (lane >> 4) & 1, q_ = (lane & 15) >> 2, p_ = lane & 3;
    bf16x8_t qf[4];
#pragma unroll
    for (int ks = 0; ks < 4; ++ks) qf[ks] = *(const LAS bf16x8_t*)(QR + n * RP + ks * 16 + hi * 8);
    f32x16_t y;
#pragma unroll
    for (int i = 0; i < 16; ++i) y[i] = 0.f;
#pragma unroll
    for (int ks = 0; ks < 4; ++ks) {
        const s16x4_t lo = __builtin_bit_cast(s16x4_t, __builtin_amdgcn_ds_read_tr16_b64_v4i16((LAS s16x4_t*)(ST + (16 * ks + 8 * hi + q_) * RP + 32 * eb + 16 * blk_ + 4 * p_)));
        const s16x4_t hh = __builtin_bit_cast(s16x4_t, __builtin_amdgcn_ds_read_tr16_b64_v4i16((LAS s16x4_t*)(ST + (16 * ks + 8 * hi + 4 + q_) * RP + 32 * eb + 16 * blk_ + 4 * p_)));
        const bf16x8_t a = (bf16x8_t){lo[0], lo[1], lo[2], lo[3], hh[0], hh[1], hh[2], hh[3]};
        y = __builtin_amdgcn_mfma_f32_32x32x16_bf16(a, qf[ks], y, 0, 0, 0); }
    { const float qd = exp2f((float)(n + 1) * lg2);
#pragma unroll
      for (int i = 0; i < 16; ++i) y[i] *= qd; }
    unsigned long long gpre[4];
#pragma unroll
    for (int g = 0; g < 4; ++g) gpre[g] = *(const GAS unsigned long long*)(P + (size_t)(tok0 + n) * PP + PCG + h * 64 + 32 * eb + 8 * g + 4 * hi);
    for (int mt = 0; mt <= nb; ++mt) {
        f32x16_t S;
#pragma unroll
        for (int i = 0; i < 16; ++i) S[i] = 0.f;
#pragma unroll
        for (int ks = 0; ks < 4; ++ks) { const bf16x8_t a = *(const LAS bf16x8_t*)(KR + (mt * 32 + r32) * RP + ks * 16 + hi * 8); S = __builtin_amdgcn_mfma_f32_32x32x16_bf16(a, qf[ks], S, 0, 0, 0); }
        float e[16];
#pragma unroll
        for (int r = 0; r < 16; ++r) { const int dm = r32 - crow32(r, hi) + 32 * (nb - mt); e[r] = (dm >= 0) ? S[r] * exp2f((float)dm * lg2) : 0.f; }
#pragma unroll
        for (int s = 0; s < 2; ++s) { v4u w; w.x = pk2(e[8 * s], e[8 * s + 1]); w.y = pk2(e[8 * s + 2], e[8 * s + 3]); w.z = pk2(e[8 * s + 4], e[8 * s + 5]); w.w = pk2(e[8 * s + 6], e[8 * s + 7]);
            const bf16x8_t xs = __builtin_bit_cast(bf16x8_t, w);
            const s16x4_t lo = __builtin_bit_cast(s16x4_t, __builtin_amdgcn_ds_read_tr16_b64_v4i16((LAS s16x4_t*)(VV + (mt * 32 + 16 * s + 4 * hi + q_) * RP + 32 * eb + 16 * blk_ + 4 * p_)));
            const s16x4_t hh = __builtin_bit_cast(s16x4_t, __builtin_amdgcn_ds_read_tr16_b64_v4i16((LAS s16x4_t*)(VV + (mt * 32 + 16 * s + 8 + 4 * hi + q_) * RP + 32 * eb + 16 * blk_ + 4 * p_)));
            const bf16x8_t a = (bf16x8_t){lo[0], lo[1], lo[2], lo[3], hh[0], hh[1], hh[2], hh[3]};
            y = __builtin_amdgcn_mfma_f32_32x32x16_bf16(a, xs, y, 0, 0, 0); }
    }
    float ss = 0.f;
#pragma unroll
    for (int i = 0; i < 16; ++i) ss += y[i] * y[i];
    ss += __shfl_xor(ss, 32);
    if (hi == 0) SS[(nb * 2 + eb) * 32 + r32] = ss;
    lds_barrier();
    ss += SS[(nb * 2 + (eb ^ 1)) * 32 + r32];
    const float rs = 1.0f / sqrtf(ss * (1.0f / 64.0f) + 1e-6f);
    const size_t ro = (size_t)(tok0 + n) * PP;
#pragma unroll
    for (int g = 0; g < 4; ++g) { const int e0 = 32 * eb + 8 * g + 4 * hi;
        const unsigned long long gw = gpre[g];
        const float g0 = bflo((unsigned)gw), g1 = bfhi((unsigned)gw), g2 = bflo((unsigned)(gw >> 32)), g3 = bfhi((unsigned)(gw >> 32));
        const float o0 = g0 * sigmoid_f(g0) * y[4 * g] * rs, o1 = g1 * sigmoid_f(g1) * y[4 * g + 1] * rs, o2 = g2 * sigmoid_f(g2) * y[4 * g + 2] * rs, o3 = g3 * sigmoid_f(g3) * y[4 * g + 3] * rs;
        *(GAS unsigned long long*)(P + ro + 768 + h * 64 + e0) = (unsigned long long)pk2(o0, o1) | ((unsigned long long)pk2(o2, o3) << 32); }
    if (wave < 4) {
        const int db = wave >> 1, ebs = wave & 1;
#pragma unroll
        for (int i = 0; i < 16; ++i) st[i] *= cdec;
#pragma unroll
        for (int ks = 0; ks < 8; ++ks) {
            const s16x4_t alo = __builtin_bit_cast(s16x4_t, __builtin_amdgcn_ds_read_tr16_b64_v4i16((LAS s16x4_t*)(KD + (16 * ks + 8 * hi + q_) * RP + 32 * db + 16 * blk_ + 4 * p_)));
            const s16x4_t ahi = __builtin_bit_cast(s16x4_t, __builtin_amdgcn_ds_read_tr16_b64_v4i16((LAS s16x4_t*)(KD + (16 * ks + 8 * hi + 4 + q_) * RP + 32 * db + 16 * blk_ + 4 * p_)));
            const s16x4_t blo = __builtin_bit_cast(s16x4_t, __builtin_amdgcn_ds_read_tr16_b64_v4i16((LAS s16x4_t*)(VV + (16 * ks + 8 * hi + q_) * RP + 32 * ebs + 16 * blk_ + 4 * p_)));
            const s16x4_t bhi = __builtin_bit_cast(s16x4_t, __builtin_amdgcn_ds_read_tr16_b64_v4i16((LAS s16x4_t*)(VV + (16 * ks + 8 * hi + 4 + q_) * RP + 32 * ebs + 16 * blk_ + 4 * p_)));
            const bf16x8_t a = (bf16x8_t){alo[0], alo[1], alo[2], alo[3], ahi[0], ahi[1], ahi[2], ahi[3]}, bb = (bf16x8_t){blo[0], blo[1], blo[2], blo[3], bhi[0], bhi[1], bhi[2], bhi[3]};
            st = __builtin_amdgcn_mfma_f32_32x32x16_bf16(a, bb, st, 0, 0, 0); }
    }
    lds_barrier();
    }
    DG_STOP(60, dg60_, dga_)
    DG_WRITE(60, unit == 0 && wave == 0 && lane == 0, dga_)
#undef RT_LOAD
}

constexpr int PT = 32, XSP = 1304;
constexpr int PR_XS = 0, PR_STG = PT * XSP * 2, PR_CONST = PR_STG + 32768, PR_MU = PR_CONST + 6 * 384 * 4;
__device__ __forceinline__ void prep_consts(const Frame& F, int l) {
    LAS float* CS = (LAS float*)(F.lds + PR_CONST);
    for (int i = F.tid; i < AW; i += NTHR) { CS[i] = F.in[I_KK][l * AW + i]; CS[AW + i] = F.in[I_KA][l * AW + i]; CS[2 * AW + i] = F.in[I_RK][l * AW + i];
        CS[3 * AW + i] = F.in[I_W0][l * AW + i]; CS[4 * AW + i] = F.in[I_A0][l * AW + i]; CS[5 * AW + i] = (l > 0) ? F.in[I_V0][(l - 1) * AW + i] : 0.f; }
    LAS float* MU = (LAS float*)(F.lds + PR_MU);
    for (int i = F.tid; i < 1296; i += NTHR) MU[i] = (i < 1280) ? F.in[I_MU][l * 1280 + i] : ((l > 0) ? F.in[I_VRMU][(l - 1) * 16 + i - 1280] : 0.f);
    __syncthreads();
}
__device__ __forceinline__ float softplus_f(float z) { return fmaxf(z, 0.f) + __logf(1.0f + __expf(-fabsf(z))); }
__device__ __forceinline__ float tanh_f(float x) { const float e = __expf(2.0f * x); return 1.0f - 2.0f * __builtin_amdgcn_rcpf(e + 1.0f); }
__device__ __forceinline__ void small_weights(const Frame& F) {
    for (int l = 0; l < DEPTH; ++l) {
        const float* w2 = F.in[I_W2] + (size_t)l * 32 * AW; const float* a2 = F.in[I_A2] + (size_t)l * 32 * AW; const float* g2 = F.in[I_G2] + (size_t)l * 64 * AW;
        const float* v2 = F.in[I_V2] + (size_t)(l > 0 ? l - 1 : 0) * 16 * AW;
        bf16* LT = (bf16*)(F.ws + WS_LORA) + (size_t)l * AW * 144;
        for (int i = F.vcu * NTHR + F.tid; i < AW * 144; i += F.G * NTHR) { const int n = i / 144, k = i - n * 144; float v;
            if (k < 32) v = w2[k * AW + n]; else if (k < 64) v = a2[(k - 32) * AW + n]; else if (k < 128) v = g2[(k - 64) * AW + n]; else v = (l > 0) ? v2[(k - 128) * AW + n] : 0.f;
            LT[i] = (bf16)f2bf(v); }
        const float* wuk = F.in[I_WUK] + (size_t)l * 6 * 64 * 128; const float* wuv = F.in[I_WUV] + (size_t)l * 6 * 128 * 64;
        bf16* wukT = (bf16*)(F.ws + WS_WUKT) + (size_t)l * 6 * 64 * 128; bf16* wuvT = (bf16*)(F.ws + WS_WUVT) + (size_t)l * 6 * 64 * 128;
        for (int i = F.vcu * NTHR + F.tid; i < 6 * 64 * 128; i += F.G * NTHR) {
            { const int hh = i / 8192, rem = i - hh * 8192, c = rem >> 6, d = rem & 63; wukT[i] = (bf16)f2bf(wuk[(hh * 64 + d) * 128 + c]); }
            { const int hh = i / 8192, rem = i - hh * 8192, d = rem >> 7, c = rem & 127; wuvT[i] = (bf16)f2bf(wuv[(hh * 128 + c) * 64 + d]); } }
    }
}
__device__ __forceinline__ void prep_tokens_unit(const Frame& F, int l, int unit) {
    LAS bf16* XS = (LAS bf16*)(F.lds + PR_XS);
    const int tid = F.tid, lane = F.lane, wave = F.wave, r32 = lane & 31, hi = lane >> 5, tok0 = unit * PT;
    const bf16* P = (const bf16*)(F.ws + WS_P);
    unsigned dga_ = 0;
    DG_START(20, dg20_)
    for (int base = 0; base < PT * 162; base += 5 * NTHR) {
        v4u cw[5], pw[5];
#pragma unroll
        for (int u = 0; u < 5; ++u) { const int idx = base + u * NTHR + tid; const int idc = idx < PT * 162 ? idx : PT * 162 - 1; const int t = idc / 162, ch = idc - t * 162, tok = tok0 + t;
            cw[u] = *(const GAS v4u*)(P + (size_t)tok * PP + ch * 8);
            const int tokp = (tok & (SEQ - 1)) != 0 ? tok - 1 : tok; pw[u] = *(const GAS v4u*)(P + (size_t)tokp * PP + ch * 8); }
#pragma unroll
        for (int u = 0; u < 5; ++u) { const int idx = base + u * NTHR + tid;
            if (idx < PT * 162) { const int t = idx / 162, ch = idx - t * 162, tok = tok0 + t, c0 = ch * 8;
                float cur[8], prv[8]; unpack8(cw[u], cur); unpack8(pw[u], prv);
                const bool first = (tok & (SEQ - 1)) == 0;
                float mv[8];
                { const LAS f32x4* mp = (const LAS f32x4*)((const LAS float*)(F.lds + PR_MU) + c0); const f32x4 m0 = mp[0], m1 = mp[1]; mv[0] = m0[0]; mv[1] = m0[1]; mv[2] = m0[2]; mv[3] = m0[3]; mv[4] = m1[0]; mv[5] = m1[1]; mv[6] = m1[2]; mv[7] = m1[3]; }
                float o[8];
#pragma unroll
                for (int j = 0; j < 8; ++j) { const float pv = first ? 0.f : prv[j]; float v = cur[j] + (pv - cur[j]) * mv[j];
                    if (c0 >= 1152 && c0 < 1184) v = tanh_f(v); else if (c0 >= 1216 && c0 < 1280) v = sigmoid_f(v);
                    o[j] = v; }
                v4u w; w.x = pk2(o[0], o[1]); w.y = pk2(o[2], o[3]); w.z = pk2(o[4], o[5]); w.w = pk2(o[6], o[7]);
                *(LAS v4u*)(XS + t * XSP + c0) = w; } }
    }
    __syncthreads();
    DG_STOP(20, dg20_, dga_)
    DG_WRITE(20, unit == 0 && l == 0 && wave == 0 && lane == 0, dga_)
    DG_START(21, dg21_)
    if (wave < 6) {
        const int h = wave;
        LAS bf16* STG = (LAS bf16*)(F.lds + PR_STG + wave * 4096);
        GAS unsigned char* wsb = (GAS unsigned char*)F.ws;
        GAS unsigned char* outb = (GAS unsigned char*)F.out;
        const bf16* LT = (const bf16*)(F.ws + WS_LORA) + (size_t)l * AW * 144;
        const LAS float* CS = (const LAS float*)(F.lds + PR_CONST) + h * 64;
        const LAS float* kkw = CS; const LAS float* kaw = CS + AW; const LAS float* rkw = CS + 2 * AW; const LAS float* w0p = CS + 3 * AW; const LAS float* a0p = CS + 4 * AW; const LAS float* v0p = CS + 5 * AW;
        const LAS bf16* xrow = XS + r32 * XSP;
        float rn;
        { float ss = 0.f;
#pragma unroll
          for (int cbl = 0; cbl < 2; ++cbl)
#pragma unroll
              for (int g = 0; g < 4; ++g) { const int j0 = cbl * 32 + 8 * g + 4 * hi; const unsigned long long kw = *(const LAS unsigned long long*)(xrow + 384 + h * 64 + j0); const f32x4 kk4 = *(const LAS f32x4*)(kkw + j0);
                  const float k0 = bflo((unsigned)kw) * kk4[0], k1 = bfhi((unsigned)kw) * kk4[1], k2 = bflo((unsigned)(kw >> 32)) * kk4[2], k3 = bfhi((unsigned)(kw >> 32)) * kk4[3]; ss += (k0 * k0 + k1 * k1) + (k2 * k2 + k3 * k3); }
          ss += __shfl_xor(ss, 32); rn = 1.0f / fmaxf(sqrtf(ss), 1e-12f); }
        float bonus = 0.f;
        const int srow = lane >> 2, sch = lane & 3;
#pragma unroll
        for (int cbl = 0; cbl < 2; ++cbl) {
            asm volatile("" ::: "memory");
            const int cb0 = h * 64 + cbl * 32;
            f32x16_t wv, av, gv, mvv;
#pragma unroll
            for (int i = 0; i < 16; ++i) { wv[i] = 0.f; av[i] = 0.f; gv[i] = 0.f; mvv[i] = 0.f; }
            const bf16* lrow = LT + (size_t)(cb0 + r32) * 144 + 8 * hi;
#pragma unroll
            for (int ks = 0; ks < 9; ++ks) { const bf16x8_t a = *(const GAS bf16x8_t*)(lrow + 16 * ks); const bf16x8_t bx = *(const LAS bf16x8_t*)(xrow + 1152 + 16 * ks + 8 * hi);
                if (ks < 2) wv = __builtin_amdgcn_mfma_f32_32x32x16_bf16(a, bx, wv, 0, 0, 0);
                else if (ks < 4) av = __builtin_amdgcn_mfma_f32_32x32x16_bf16(a, bx, av, 0, 0, 0);
                else if (ks < 8) gv = __builtin_amdgcn_mfma_f32_32x32x16_bf16(a, bx, gv, 0, 0, 0);
                else mvv = __builtin_amdgcn_mfma_f32_32x32x16_bf16(a, bx, mvv, 0, 0, 0); }
            if (l > 0) {
#pragma unroll
                for (int i = 0; i < 2; ++i) { const int row = srow + 16 * i; const unsigned eo = (unsigned)(((tok0 + row) * AW + cb0 + sch * 8) * 2); *(LAS v4u*)(STG + row * 32 + sch * 8) = *(const GAS v4u*)(wsb + WS_VF + eo); } }
            unsigned long long ro[4], dd[4], k2o[4], kko[4], bpo[4], vo[4], go[4];
#pragma unroll
            for (int g = 0; g < 4; ++g) { const int j0 = cbl * 32 + 8 * g + 4 * hi;
                const unsigned long long rw = *(const LAS unsigned long long*)(xrow + h * 64 + j0), kw = *(const LAS unsigned long long*)(xrow + 384 + h * 64 + j0), vw = *(const LAS unsigned long long*)(xrow + 768 + h * 64 + j0);
                unsigned long long fw = 0ull; if (l > 0) fw = *(const LAS unsigned long long*)(STG + r32 * 32 + 8 * g + 4 * hi);
                asm volatile("" : "+v"(bonus) :: "memory");
                const f32x4 kk4 = *(const LAS f32x4*)(kkw + j0), ka4 = *(const LAS f32x4*)(kaw + j0), rk4 = *(const LAS f32x4*)(rkw + j0), w04 = *(const LAS f32x4*)(w0p + j0), a04 = *(const LAS f32x4*)(a0p + j0);
                const f32x4 v04 = *(const LAS f32x4*)(v0p + j0);
                const float rr[4] = {bflo((unsigned)rw), bfhi((unsigned)rw), bflo((unsigned)(rw >> 32)), bfhi((unsigned)(rw >> 32))};
                const float kx[4] = {bflo((unsigned)kw), bfhi((unsigned)kw), bflo((unsigned)(kw >> 32)), bfhi((unsigned)(kw >> 32))};
                const float vx[4] = {bflo((unsigned)vw), bfhi((unsigned)vw), bflo((unsigned)(vw >> 32)), bfhi((unsigned)(vw >> 32))};
                const float fx[4] = {bflo((unsigned)fw), bfhi((unsigned)fw), bflo((unsigned)(fw >> 32)), bfhi((unsigned)(fw >> 32))};
                float d_[4], k2_[4], kk_[4], bp_[4], v_[4];
#pragma unroll
                for (int e = 0; e < 4; ++e) { const int i = 4 * g + e;
                    const float sp = softplus_f(-(wv[i] + w04[e])); const float rate = __expf(-sp - 0.5f); const float d = 1.0f - __expf(-rate);
                    const float a = sigmoid_f(av[i] + a04[e]);
                    float v = vx[e]; if (l > 0) v = v + (fx[e] - v) * sigmoid_f(mvv[i] + v04[e]);
                    const float kk = kx[e] * kk4[e] * rn, k2 = kx[e] * (1.0f + (a - 1.0f) * ka4[e]);
                    d_[e] = d; k2_[e] = k2; kk_[e] = kk; bp_[e] = kk * a; v_[e] = v;
                    bonus += rr[e] * k2 * rk4[e]; }
#define PK4(x) ((unsigned long long)pk2(x[0], x[1]) | ((unsigned long long)pk2(x[2], x[3]) << 32))
                ro[g] = rw; dd[g] = PK4(d_); k2o[g] = PK4(k2_); kko[g] = PK4(kk_); bpo[g] = PK4(bp_); vo[g] = PK4(v_);
                go[g] = (unsigned long long)pk2(gv[4 * g], gv[4 * g + 1]) | ((unsigned long long)pk2(gv[4 * g + 2], gv[4 * g + 3]) << 32); }
#define PR_OUT(arr, bs_, dst) do { _Pragma("unroll") for (int g = 0; g < 4; ++g) *(LAS unsigned long long*)(STG + r32 * 32 + 8 * g + 4 * hi) = arr[g]; \
            _Pragma("unroll") for (int i = 0; i < 2; ++i) { const int row = srow + 16 * i; const unsigned eo = (unsigned)(((tok0 + row) * AW + cb0 + sch * 8) * 2); *(GAS v4u*)(bs_ + dst + eo) = *(const LAS v4u*)(STG + row * 32 + sch * 8); } } while (0)
            PR_OUT(ro, wsb, WS_R); PR_OUT(dd, wsb, WS_D); PR_OUT(k2o, wsb, WS_K2); PR_OUT(kko, wsb, WS_KK); PR_OUT(bpo, outb, OUT_BP); PR_OUT(vo, wsb, WS_VF); PR_OUT(go, outb, OUT_G);
#undef PR_OUT
#undef PK4
        }
        bonus += __shfl_xor(bonus, 32);
        if (hi == 0) ((float*)(F.ws + WS_BON))[(size_t)(tok0 + r32) * 6 + h] = bonus;
    } else {
        const float* kvn = F.in[I_KVN] + l * 128; bf16* C = (bf16*)(F.ws + WS_C);
        for (int q = 0; q < 16; ++q) { const int tok = tok0 + 16 * (wave - 6) + q; const unsigned w = *(const GAS unsigned*)(P + (size_t)tok * PP + PBC + 2 * lane);
            const float c0 = bflo(w), c1 = bfhi(w); const float ss = wave_sum(c0 * c0 + c1 * c1); const float rs = 1.0f / sqrtf(ss * (1.0f / 128.0f) + 1e-6f);
            *(GAS unsigned*)(C + (size_t)tok * 128 + 2 * lane) = pk2(c0 * rs * kvn[2 * lane], c1 * rs * kvn[2 * lane + 1]); }
    }
    DG_STOP(21, dg21_, dga_)
    DG_WRITE(21, unit == 0 && l == 0 && wave == 0 && lane == 0, dga_)
    __syncthreads();
}

__device__ __forceinline__ void final_norm(const Frame& F) {
    const int gw = F.vcu * NWAVES + F.wave, NGW = F.G * NWAVES; const float* g = F.in[I_FN];
    float dgc_ = 0.f;
    if (DIAG_SLOT_D >= 0) { const unsigned* D = (const unsigned*)(F.ws + WS_DIAG); const float x0 = (float)D[0] * (1.0f / (100.0f * DIAG_DIV)); const float gq = 4.0f;
        const float kq = floorf(log2f(fmaxf(x0, 1.0f)) * gq); dgc_ = sqrtf(fmaxf(exp2f((kq + 0.5f) / gq) - 1.0f, 0.01f)); }
    const bf16* XBf = (const bf16*)(F.ws + WS_XB);
    for (int m = gw; m < M; m += NGW) { GAS f32x4* xr = (GAS f32x4*)(F.out + (size_t)m * DM); const GAS v4u* xs = (const GAS v4u*)(XBf + (size_t)m * DM); float v[2][8]; float s = 0.f;
#pragma unroll
        for (int j = 0; j < 2; ++j) { unpack8(xs[F.lane + 64 * j], v[j]);
#pragma unroll
            for (int e = 0; e < 8; ++e) s += v[j][e] * v[j][e]; }
        const float rs = 1.0f / sqrtf(wave_sum(s) * (1.0f / DM) + 1e-6f);
#pragma unroll
        for (int j = 0; j < 2; ++j) { const int c = 8 * (F.lane + 64 * j); const f32x4 g0 = *(const f32x4*)(g + c), g1 = *(const f32x4*)(g + c + 4);
            xr[c / 4] = (DIAG_SLOT_D >= 0) ? (f32x4){dgc_, dgc_, dgc_, dgc_} : (f32x4){v[j][0], v[j][1], v[j][2], v[j][3]} * rs * g0;
            xr[c / 4 + 1] = (DIAG_SLOT_D >= 0) ? (f32x4){dgc_, dgc_, dgc_, dgc_} : (f32x4){v[j][4], v[j][5], v[j][6], v[j][7]} * rs * g1; } }
}

template <class T> __device__ __forceinline__ T* launder_ptr(T* p) {
    unsigned lo = (unsigned)(uintptr_t)p, hi = (unsigned)((uintptr_t)p >> 32);
    asm volatile("" : "+v"(lo), "+v"(hi));
    lo = __builtin_amdgcn_readfirstlane(lo); hi = __builtin_amdgcn_readfirstlane(hi);
    return (T*)(((uintptr_t)hi << 32) | (uintptr_t)lo);
}
constexpr int NPHASE = 20;
constexpr int DUP_PHASE = -1;
constexpr int QDUP = 1;
constexpr int STAG_UP = 4, STAG_IN = 3;
constexpr int REP_SCAN_K = 1, REP_THR_K = 1;
constexpr int NSTEP = NPHASE + (DUP_PHASE >= 0 ? 1 : 0);
constexpr int REP_THR = 1, REP_PTOK = 1, REP_KV = 1, REP_CONV = 1, REP_SCAN = 1, REP_DSA = 1, REP_RET = 1, REP_UP = 1;
#define REPL(n) for (int rep_ = 0; rep_ < (l == 0 ? (n) : 1); ++rep_)
__global__ void __launch_bounds__(NTHR, 2) fwd_kernel(Args args) {
    extern __shared__ __attribute__((aligned(16))) unsigned char lds[];
    Frame F;
    F.lds = (LAS unsigned char*)lds;
    F.tid = threadIdx.x; F.lane = F.tid & 63; F.wave = __builtin_amdgcn_readfirstlane(F.tid >> 6);
    F.G = gridDim.x; { const int bx = blockIdx.x; F.vcu = (F.G % 8 == 0) ? (bx % 8) * (F.G / 8) + bx / 8 : bx; }
    F.in = (const float* const __attribute__((address_space(4)))*)__builtin_amdgcn_kernarg_segment_ptr(); F.out = args.out; F.ws = args.ws;
    volatile LAS unsigned* MISC = (volatile LAS unsigned*)(F.lds + MISC_OFF);
    for (int u = F.tid; u < (LDS_BYTES - LDSCTL_OFF) / 4; u += NTHR) ((LAS unsigned*)(F.lds + LDSCTL_OFF))[u] = 0u;
    __syncthreads();
    const int lo = args.ph_lo, hi = args.ph_hi;
    XcdBarrier bar; bar.bar = (unsigned*)(F.ws + WS_CTL) + CW_BAR; bar.x = 0; bar.st = nullptr;
    if (hi - lo > 1) bar = xcd_barrier_post((unsigned*)(F.ws + WS_CTL) + CW_BAR, MISC + 8);
    for (int ph_ = lo; ph_ < hi; ++ph_) {
        unsigned dgp0_ = 0; if (DIAG_SLOT_D >= 100) dgp0_ = (unsigned)__builtin_amdgcn_s_memtime();
        int ph = (args.dup_phase >= 0 && ph_ > args.dup_phase) ? ph_ - 1 : ph_; asm volatile("" : "+v"(ph)); ph = __builtin_amdgcn_readfirstlane(ph);
#define PH_ENTER() \
        { unsigned z_ = 0u; int t_ = threadIdx.x; asm volatile("" : "+v"(z_), "+v"(t_)); z_ = __builtin_amdgcn_readfirstlane(z_); F.in = (const float* const __attribute__((address_space(4)))*)((const char __attribute__((address_space(4)))*)__builtin_amdgcn_kernarg_segment_ptr() + z_); F.out = args.out + z_; F.ws = args.ws + z_; \
          F.tid = t_; F.lane = t_ & 63; F.wave = __builtin_amdgcn_readfirstlane(t_ >> 6); } \
        int bx = blockIdx.x; { int g_ = gridDim.x; asm volatile("" : "+v"(bx), "+v"(g_)); bx = __builtin_amdgcn_readfirstlane(bx); g_ = __builtin_amdgcn_readfirstlane(g_); F.G = g_; F.vcu = (g_ % 8 == 0) ? (bx % 8) * (g_ / 8) + bx / 8 : bx; } \
        gu32* ctl = (gu32*)(F.ws + WS_CTL); (void)ctl; \
        bf16* XB = (bf16*)(F.ws + WS_XB); bf16* Hb = (bf16*)(F.ws + WS_H); bf16* Pb = (bf16*)(F.ws + WS_P); float* part = (float*)(F.ws + WS_PART); (void)XB; (void)Hb; (void)Pb; (void)part;
        if (ph == 0) { PH_ENTER();
            if (DIAG_SLOT_D >= 0 && bx == 0 && threadIdx.x == 0) { ((unsigned*)(args.ws + WS_DIAG))[0] = 0u; ((unsigned*)(args.ws + WS_DIAG))[1] = 0u; }
            conv_weights(F, 0, 0, 3);
            p0_x(F); p0_table(F); small_weights(F);
        } else if (ph == NPHASE - 1) { PH_ENTER();
            final_norm(F);
        } else {
            const int l = (ph - 1) / 9, sub = (ph - 1) - 9 * l;
            if (sub == 0 || sub == 7) { PH_ENTER();
                pg8::Gemm g{XB, (const bf16*)(F.ws + (sub == 0 ? WS_WGU1 : WS_WGU2)), M, NGU, DM, DM}; pg8::StaticOrder S; S.init(M, NGU, F.G, bx);
                pg8::EpiUp E{Hb, FFP, part};
                if (bx >= S.nwg % F.G) for (int i = 0; i < args.stag_up; ++i) __builtin_amdgcn_s_sleep(127);
                for (int rep = 0; rep < ((l == 0 && sub == 0) ? REP_UP : 1); ++rep) pg8::gemm_phase<pg8::EpiUp, pg8::StaticOrder, true>(F.lds, g, S, E, F.tid);
            } else if (sub == 1 || sub == 8 || sub == 6) { PH_ENTER();
                const bool op = (sub == 6);
                pg8::Gemm g{op ? Pb : Hb, (const bf16*)(F.ws + (op ? WS_WOUT : (sub == 1 ? WS_WD1 : WS_WD2))), M, DM, op ? DM : FFP, op ? PP : FFP}; pg8::StaticOrder S; S.init(M, DM, F.G, bx);
                const float* base = (l == 0 && sub == 1) ? F.in[I_X] : nullptr;
                pg8::EpiRes E{base, XB, part};
                pg8::gemm_phase<pg8::EpiRes, pg8::StaticOrder, false>(F.lds, g, S, E, F.tid);
            } else if (sub == 2) { PH_ENTER();
                pg8::Gemm g{XB, (const bf16*)(F.ws + WS_WIN), M, PP, DM, DM}; pg8::StaticOrder S; S.init(M, PP, F.G, bx);
                pg8::EpiP E{Pb, PP, part};
                if (bx >= S.nwg % F.G) for (int i = 0; i < args.stag_in; ++i) __builtin_amdgcn_s_sleep(127);
                pg8::gemm_phase<pg8::EpiP, pg8::StaticOrder, true>(F.lds, g, S, E, F.tid);
            } else if (sub == 3) { PH_ENTER();
                for (int rep_ = 0; rep_ < (l == 0 ? args.rep_thr : 1); ++rep_)
                    for (int k = 0, u0 = F.vcu; u0 < M / 16; ++k, u0 += F.G) {
                        const int base = k * F.G, span = (M / 16 - base) < F.G ? (M / 16 - base) : F.G; const int u = (k & 1) ? base + span - 1 - F.vcu : u0;
                        if (u >= base && u < M / 16) dsa_thr_unit(F, u); }
                prep_consts(F, l);
                REPL(REP_PTOK) for (int u = F.vcu; u < M / PT; u += F.G) prep_tokens_unit(F, l, u);

            } else if (sub == 5) { PH_ENTER();
                rwkv_post(F, l);
            } else if (sub == 4) { PH_ENTER();
                unsigned dgm_ = 0; if (DIAG_SLOT_D >= 50 && DIAG_SLOT_D < 60) dgm_ = (unsigned)__builtin_amdgcn_s_memtime();
                if (bx < BATCH * 6) { for (int rep_ = 0; rep_ < (l == 0 ? args.rep_scan : 1); ++rep_) { rwkv_chunk_unit(F, l, bx); __syncthreads(); } }
                if (DIAG_SLOT_D == 54 && l == 0 && bx < BATCH * 6 && threadIdx.x == 0) atomicMax((unsigned*)(args.ws + WS_DIAG), (unsigned)__builtin_amdgcn_s_memtime() - dgm_);
                if (DIAG_SLOT_D == 50 && l == 0 && bx == 0 && threadIdx.x == 0) ((unsigned*)(args.ws + WS_DIAG))[0] = (unsigned)__builtin_amdgcn_s_memtime() - dgm_;
                if (!(DIAG_SLOT_D >= 70 && DIAG_SLOT_D < 80)) {
                    gu32* qh = ctl + CW_QUEUE + 64 * l;
                    for (;;) {
                        if (F.tid == 0) MISC[0] = __hip_atomic_fetch_add(qh, 1u, RLX_AGENT);
                        __syncthreads();
                        const int u = (int)MISC[0];
                        __syncthreads();
                        const int nd = (l == 0 ? args.qdup : 1) * (M / 32);
                        { unsigned z_ = 0u; int t_ = threadIdx.x; asm volatile("" : "+v"(z_), "+v"(t_)); z_ = __builtin_amdgcn_readfirstlane(z_); F.ws = args.ws + z_; F.tid = t_; F.lane = t_ & 63; F.wave = __builtin_amdgcn_readfirstlane(t_ >> 6); }
                        const int ncv = (conv_flat_items(l + 1 < DEPTH) + NWAVES * CONV_PER_WAVE - 1) / (NWAVES * CONV_PER_WAVE);
                        if (DIAG_SLOT_D == 53 && l == 0 && bx == 200 && threadIdx.x == 0 && u >= BATCH * 4 + nd) { unsigned* D_ = (unsigned*)(args.ws + WS_DIAG); if (D_[1] != 0x600Du) { D_[1] = 0x600Du; D_[0] = (unsigned)__builtin_amdgcn_s_memtime() - dgm_; } }
                        if (u >= nd + BATCH * 4 + ncv) { if (DIAG_SLOT_D == 51 && l == 0 && bx == 0 && threadIdx.x == 0) ((unsigned*)(args.ws + WS_DIAG))[0] = (unsigned)__builtin_amdgcn_s_memtime() - dgm_;
                            if (DIAG_SLOT_D == 52 && l == 0 && bx == 200 && threadIdx.x == 0) ((unsigned*)(args.ws + WS_DIAG))[0] = (unsigned)__builtin_amdgcn_s_memtime() - dgm_; }
                        if (DIAG_SLOT_D == 55 && l == 0 && u >= nd + BATCH * 4 + ncv && threadIdx.x == 0) atomicMax((unsigned*)(args.ws + WS_DIAG), (unsigned)__builtin_amdgcn_s_memtime() - dgm_);
                        if (DIAG_SLOT_D == 56 && l == 0 && u >= BATCH * 4 && u < nd + BATCH * 4 && threadIdx.x == 0) atomicMax((unsigned*)(args.ws + WS_DIAG), (unsigned)__builtin_amdgcn_s_memtime() - dgm_);
                        if (u >= nd + BATCH * 4 + ncv) break;
                        if (u < BATCH * 4) ret_out_unit(F, u);
                        else if (u < nd + BATCH * 4) dsa_attn_unit(F, l, (u - BATCH * 4) % (M / 32));
                        else { conv_unit(F, l, u - nd - BATCH * 4); __syncthreads(); }
                    }
                }
            }
        }
        if (ph_ + 1 < hi) xcd_barrier(bar);
        if (DIAG_SLOT_D >= 100 && ph_ == DIAG_SLOT_D - 100 && blockIdx.x == 0 && threadIdx.x == 0) ((unsigned*)(args.ws + WS_DIAG))[0] = (unsigned)__builtin_amdgcn_s_memtime() - dgp0_;
    }
}

extern "C" void kernel_launch(void* const* d_in, const int* in_sizes, int n_in, void* d_out, int out_size, void* d_ws, size_t ws_size, hipStream_t stream) {
    static int grid = 0;
    if (grid == 0) {
        if (n_in != 31 || out_size != M * DM || ws_size < WS_END) { fprintf(stderr, "kernel_launch: unexpected shapes (n_in %d, out %d, ws %zu)\n", n_in, out_size, ws_size); grid = -1; return; }
        int dev = 0, cus = 0, per_cu = 0;
        if (hipGetDevice(&dev) != hipSuccess || hipDeviceGetAttribute(&cus, hipDeviceAttributeMultiprocessorCount, dev) != hipSuccess) { grid = -1; return; }
        if (hipFuncSetAttribute((const void*)fwd_kernel, hipFuncAttributeMaxDynamicSharedMemorySize, LDS_BYTES) != hipSuccess) { fprintf(stderr, "kernel_launch: hipFuncSetAttribute failed\n"); grid = -1; return; }
        if (hipOccupancyMaxActiveBlocksPerMultiprocessor(&per_cu, (const void*)fwd_kernel, NTHR, LDS_BYTES) != hipSuccess || per_cu < 1) fprintf(stderr, "kernel_launch: occupancy query says %d\n", per_cu);
        (void)hipGetLastError();
        grid = cus;
    }
    if (grid < 0) return;
    if (hipMemsetAsync((char*)d_ws + WS_CTL, 0, CTL_ZERO_BYTES, stream) != hipSuccess) return;
    Args a{};
    for (int i = 0; i < 31; ++i) a.in[i] = (const float*)d_in[i];
    a.out = (float*)d_out; a.ws = (unsigned char*)d_ws; a.dup_phase = DUP_PHASE; a.qdup = QDUP; a.rep_scan = REP_SCAN_K; a.rep_thr = REP_THR_K; a.stag_up = STAG_UP; a.stag_in = STAG_IN;
#ifndef ONE_LAUNCH
#define ONE_LAUNCH 1
#endif
    if (ONE_LAUNCH) { a.ph_lo = 0; a.ph_hi = NSTEP; hipLaunchKernelGGL(fwd_kernel, dim3(grid), dim3(NTHR), LDS_BYTES, stream, a); }
    else for (int ph = 0; ph < NPHASE; ++ph) { a.ph_lo = ph; a.ph_hi = ph + 1; hipLaunchKernelGGL(fwd_kernel, dim3(grid), dim3(NTHR), LDS_BYTES, stream, a); }
}
```

```cpp
#include <hip/hip_runtime.h>
#include <cstdio>
#include <cstdint>
#include <cmath>

namespace pg8 {
#define PG8_LAS __attribute__((address_space(3)))
typedef unsigned short bf16_t;
typedef short bf16x8 __attribute__((ext_vector_type(8)));
typedef float f32x4 __attribute__((ext_vector_type(4)));
typedef unsigned u32x4 __attribute__((ext_vector_type(4)));
constexpr int BM = 256, BK = 64, HALF = 128, HTB = HALF * BK * 2  , STAGE_BYTES = 8 * HTB, NXCD = 8, WGM = 8;

__host__ __device__ __forceinline__ int lds_byte(int r, int c) { const int st = (r >> 4) * 2 + (c >> 5), rr = r & 15, cc = c & 31, ob = rr * 64 + cc * 2; return st * 1024 + (ob ^ (((ob >> 9) & 1) << 5)); }
__host__ __device__ __forceinline__ void stage_rc(int b, int& R, int& C) { const int st = b / 1024, sb = b % 1024, swz = sb ^ (((sb >> 9) & 1) << 5); R = (st >> 1) * 16 + swz / 64; C = (st & 1) * 32 + (swz % 64) / 2; }
__host__ __device__ __forceinline__ int perm32(int rho) { const int n = rho >> 4, i = rho & 15; return 8 * (i >> 2) + 4 * n + (i & 3); }

struct Unit { int pm, pn; };
struct Gemm { const bf16_t* A; const bf16_t* Bt; int M, N, K, lda; };

struct StaticOrder {
    int nM, nN, nwg, G, c;
    __host__ __device__ void init(int M, int N, int G_, int c_) { nM = M / BM; nN = N / BM; nwg = nM * nN; G = G_; c = c_; }
    __host__ __device__ bool next(int i, Unit& u) const {
        const long L = (long)i * G + c; if (L >= nwg) return false;
        int wgid = (int)L; { const int q = nwg / NXCD, r = nwg % NXCD, xcd = wgid % NXCD, off = wgid / NXCD; wgid = (xcd < r ? xcd * (q + 1) : r * (q + 1) + (xcd - r) * q) + off; }
        const int nig = WGM * nN, gid = wgid / nig, fm = gid * WGM, gsz = (nM - fm) < WGM ? (nM - fm) : WGM;
        u.pm = fm + ((wgid % nig) % gsz); u.pn = (wgid % nig) / gsz; return true;
    }
    __device__ __forceinline__ void a_ready(const Unit&) const {}
    __device__ __forceinline__ void done(const Unit&) const {}
};

__device__ __forceinline__ unsigned cvt_pk_bf16(float lo, float hi) { unsigned r; asm volatile("v_cvt_pk_bf16_f32 %0, %1, %2" : "=v"(r) : "v"(lo), "v"(hi)); return r; }


__device__ __forceinline__ float row_rstd(const float* part, int row) {
    const f32x4* p = (const f32x4*)(part + (size_t)row * 16);
    const f32x4 a = p[0], b = p[1], c = p[2], d = p[3];
    const float s = ((a[0] + a[1]) + (a[2] + a[3])) + ((b[0] + b[1]) + (b[2] + b[3])) + ((c[0] + c[1]) + (c[2] + c[3])) + ((d[0] + d[1]) + (d[2] + d[3]));
    return 1.0f / sqrtf(s * (1.0f / 1024.0f) + 1e-6f);
}
__device__ __forceinline__ float silu_f(float x) { return x * __builtin_amdgcn_rcpf(1.0f + __expf(-x)); }

struct EpiUp {
    static constexpr bool PERM = true;
    bf16_t* H; int ldh; const float* part;
    __device__ __forceinline__ void operator()(const f32x4 (&acc)[2][2][4][2], const Unit& u, int wr, int wc, int fr, int fq) const {
        const int row0 = u.pm * BM + wr * 64 + fr, hcol = u.pn * 128 + wc * 32 + 8 * fq;
#pragma unroll
        for (int ai = 0; ai < 2; ++ai)
#pragma unroll
            for (int m = 0; m < 4; ++m) { const int row = row0 + ai * HALF + m * 16; const float rs = row_rstd(part, row);
                const f32x4 g0 = acc[ai][0][m][0] * rs, g1 = acc[ai][0][m][1] * rs, u0 = acc[ai][1][m][0] * rs, u1 = acc[ai][1][m][1] * rs;
                u32x4 w; w.x = cvt_pk_bf16(silu_f(g0[0]) * u0[0], silu_f(g0[1]) * u0[1]); w.y = cvt_pk_bf16(silu_f(g0[2]) * u0[2], silu_f(g0[3]) * u0[3]);
                w.z = cvt_pk_bf16(silu_f(g1[0]) * u1[0], silu_f(g1[1]) * u1[1]); w.w = cvt_pk_bf16(silu_f(g1[2]) * u1[2], silu_f(g1[3]) * u1[3]);
                *(u32x4*)(H + (size_t)row * ldh + hcol) = w; }
    }
};
struct EpiP {
    static constexpr bool PERM = true;
    bf16_t* P; int ldp; const float* part;
    __device__ __forceinline__ void operator()(const f32x4 (&acc)[2][2][4][2], const Unit& u, int wr, int wc, int fr, int fq) const {
        const int row0 = u.pm * BM + wr * 64 + fr, col0 = u.pn * BM + wc * 32 + 8 * fq;
#pragma unroll
        for (int ai = 0; ai < 2; ++ai)
#pragma unroll
            for (int m = 0; m < 4; ++m) { const int row = row0 + ai * HALF + m * 16; const float rs = row_rstd(part, row);
#pragma unroll
                for (int bj = 0; bj < 2; ++bj) { const f32x4 v0 = acc[ai][bj][m][0] * rs, v1 = acc[ai][bj][m][1] * rs;
                    u32x4 w; w.x = cvt_pk_bf16(v0[0], v0[1]); w.y = cvt_pk_bf16(v0[2], v0[3]); w.z = cvt_pk_bf16(v1[0], v1[1]); w.w = cvt_pk_bf16(v1[2], v1[3]);
                    *(u32x4*)(P + (size_t)row * ldp + col0 + bj * HALF) = w; } }
    }
};
struct EpiRes {
    static constexpr bool PERM = true;
    const float* base; bf16_t* xb; float* part;
    __device__ __forceinline__ void operator()(const f32x4 (&acc)[2][2][4][2], const Unit& u, int wr, int wc, int fr, int fq) const {
        const int row0 = u.pm * BM + wr * 64 + fr, col0 = u.pn * BM + wc * 32 + 8 * fq;
#pragma unroll
        for (int ai = 0; ai < 2; ++ai)
#pragma unroll
            for (int m = 0; m < 4; ++m) { const int row = row0 + ai * HALF + m * 16; float ss = 0.f;
#pragma unroll
                for (int bj = 0; bj < 2; ++bj) { const size_t off = (size_t)row * 1024 + col0 + bj * HALF;
                    f32x4 v0, v1;
                    if (base) { v0 = *(const f32x4*)(base + off); v1 = *(const f32x4*)(base + off + 4); }
                    else { const u32x4 xw = *(const u32x4*)(xb + off);
                        v0 = (f32x4){__builtin_bit_cast(float, xw.x << 16), __builtin_bit_cast(float, xw.x & 0xffff0000u), __builtin_bit_cast(float, xw.y << 16), __builtin_bit_cast(float, xw.y & 0xffff0000u)};
                        v1 = (f32x4){__builtin_bit_cast(float, xw.z << 16), __builtin_bit_cast(float, xw.z & 0xffff0000u), __builtin_bit_cast(float, xw.w << 16), __builtin_bit_cast(float, xw.w & 0xffff0000u)}; }
                    v0 += acc[ai][bj][m][0]; v1 += acc[ai][bj][m][1];
                    u32x4 w; w.x = cvt_pk_bf16(v0[0], v0[1]); w.y = cvt_pk_bf16(v0[2], v0[3]); w.z = cvt_pk_bf16(v1[0], v1[1]); w.w = cvt_pk_bf16(v1[2], v1[3]);
                    *(u32x4*)(xb + off) = w;
                    ss += (v0[0] * v0[0] + v0[1] * v0[1]) + (v0[2] * v0[2] + v0[3] * v0[3]) + (v1[0] * v1[0] + v1[1] * v1[1]) + (v1[2] * v1[2] + v1[3] * v1[3]); }
                ss += __shfl_xor(ss, 16); ss += __shfl_xor(ss, 32);
                if (fq == 0) part[(size_t)row * 16 + u.pn * 4 + wc] = ss;
                asm volatile("" ::: "memory"); }
    }
};

template <class Epi, class Sched, bool ALIGN_EPI>
__device__ __forceinline__ void gemm_phase(PG8_LAS unsigned char* lds, const Gemm g, const Sched& S, const Epi& E, const int tid) {
    const int wid = __builtin_amdgcn_readfirstlane(tid >> 6), lane = tid & 63, wr = wid >> 2, wc = wid & 3, fr = lane & 15, fq = lane >> 4;
    const int K = g.K, nt = K / BK, lda = g.lda;
    unsigned voffA[2], voffB[2];
#pragma unroll
    for (int i = 0; i < 2; ++i) { int R, C; stage_rc(tid * 16 + i * 8192, R, C); const int Rb = Epi::PERM ? ((R & ~31) + perm32(R & 31)) : R;
        voffA[i] = (unsigned)(R * lda + C) * 2u; voffB[i] = (unsigned)(Rb * K + C) * 2u; }
    const size_t kstep = (size_t)(BK * 2);
    const size_t hstepA = (size_t)HALF * lda * 2, hstepB = (size_t)HALF * K * 2;
    const size_t tstepA = 2 * hstepA, tstepB = 2 * hstepB;
    const unsigned ldsw = (unsigned)wid * 1024u;
    const int aoff = lds_byte(wr * 64 + fr, fq * 8), boff = lds_byte(wc * 32 + fr, fq * 8);
#define PG8_SA(b, h) (((b) * 2 + (h)) * HTB)
#define PG8_SB(b, h) ((4 + (b) * 2 + (h)) * HTB)
#define PG8_STAGE(bufoff, gbase, voff) do { _Pragma("unroll") for (int _i = 0; _i < 2; ++_i) \
        __builtin_amdgcn_global_load_lds((const unsigned*)((const char*)(gbase) + (voff)[_i]), (PG8_LAS unsigned*)(lds + (bufoff) + ldsw + _i * 8192), 16, 0, 0); } while (0)
#define PG8_LDA(dst, b, h) do { _Pragma("unroll") for (int m = 0; m < 4; ++m) _Pragma("unroll") for (int k = 0; k < 2; ++k) dst[m][k] = *(const PG8_LAS bf16x8*)(lds + PG8_SA(b, h) + aoff + m * 2048 + k * 1024); } while (0)
#define PG8_LDB(dst, b, h) do { _Pragma("unroll") for (int n = 0; n < 2; ++n) _Pragma("unroll") for (int k = 0; k < 2; ++k) dst[n][k] = *(const PG8_LAS bf16x8*)(lds + PG8_SB(b, h) + boff + n * 2048 + k * 1024); } while (0)
#define PG8_MMA(ai, bj, At, Bt) do { __builtin_amdgcn_s_setprio(1); _Pragma("unroll") for (int m = 0; m < 4; ++m) _Pragma("unroll") for (int n = 0; n < 2; ++n) _Pragma("unroll") for (int k = 0; k < 2; ++k) \
        acc[ai][bj][m][n] = __builtin_amdgcn_mfma_f32_16x16x32_bf16(Bt[n][k], At[m][k], acc[ai][bj][m][n], 0, 0, 0); __builtin_amdgcn_s_setprio(0); } while (0)
#define PG8_WAIT_V(n) asm volatile("s_waitcnt vmcnt(" #n ")" ::: "memory")
#define PG8_WAIT_L(n) asm volatile("s_waitcnt lgkmcnt(" #n ")" ::: "memory")
#define PG8_BAR __builtin_amdgcn_s_barrier()
#define PG8_SCHED __builtin_amdgcn_sched_barrier(0)
    Unit cur, nxt; int ui = 0;
    if (!S.next(0, cur)) return;
    f32x4 acc[2][2][4][2];
#pragma unroll
    for (int a = 0; a < 2; ++a)
#pragma unroll
        for (int b = 0; b < 2; ++b)
#pragma unroll
            for (int m = 0; m < 4; ++m)
#pragma unroll
                for (int n = 0; n < 2; ++n) acc[a][b][m][n] = (f32x4){0.f, 0.f, 0.f, 0.f};
    bf16x8 At[4][2], B0[2][2], B1[2][2];
    const char* cA = (const char*)g.A + (size_t)cur.pm * tstepA; const char* cB = (const char*)g.Bt + (size_t)cur.pn * tstepB;
    S.a_ready(cur);
    PG8_STAGE(PG8_SB(0, 0), cB, voffB); PG8_STAGE(PG8_SB(0, 1), cB + hstepB, voffB); PG8_STAGE(PG8_SA(0, 0), cA, voffA); PG8_STAGE(PG8_SA(0, 1), cA + hstepA, voffA);
    if (wr == 1) PG8_BAR;
    PG8_WAIT_V(2); PG8_BAR;
    PG8_STAGE(PG8_SB(1, 0), cB + kstep, voffB); PG8_STAGE(PG8_SA(1, 0), cA + kstep, voffA); PG8_STAGE(PG8_SB(1, 1), cB + hstepB + kstep, voffB);
    PG8_WAIT_V(6); PG8_BAR;
    for (;;) {
        const bool has_next = S.next(ui + 1, nxt);
        const char* nA = has_next ? (const char*)g.A + (size_t)nxt.pm * tstepA : cA; const char* nB = has_next ? (const char*)g.Bt + (size_t)nxt.pn * tstepB : cB;
        for (int t = 0; t < nt; t += 2) {
            const bool last = (t == nt - 2);
            const char* a1 = cA + (size_t)(t + 1) * kstep;
            const char* a2 = last ? nA : cA + (size_t)(t + 2) * kstep; const char* b2 = last ? nB : cB + (size_t)(t + 2) * kstep;
            const char* a3 = a2 + kstep; const char* b3 = b2 + kstep;
            if (last && has_next) S.a_ready(nxt);
            PG8_LDB(B0, 0, 0); PG8_LDB(B1, 0, 1); PG8_SCHED; PG8_LDA(At, 0, 0); PG8_STAGE(PG8_SA(1, 1), a1 + hstepA, voffA);
            PG8_WAIT_V(8); PG8_WAIT_L(0); PG8_BAR; PG8_MMA(0, 0, At, B0); PG8_MMA(0, 1, At, B1); PG8_BAR; PG8_SCHED;
            PG8_LDA(At, 0, 1); PG8_STAGE(PG8_SB(0, 0), b2, voffB); PG8_STAGE(PG8_SB(0, 1), b2 + hstepB, voffB); PG8_STAGE(PG8_SA(0, 0), a2, voffA);
            PG8_WAIT_V(8); PG8_WAIT_L(0); PG8_BAR; PG8_MMA(1, 0, At, B0); PG8_MMA(1, 1, At, B1); PG8_BAR; PG8_SCHED;
            PG8_LDB(B0, 1, 0); PG8_LDB(B1, 1, 1); PG8_SCHED; PG8_LDA(At, 1, 0); PG8_STAGE(PG8_SA(0, 1), a2 + hstepA, voffA);
            PG8_WAIT_V(8); PG8_WAIT_L(0); PG8_BAR; PG8_MMA(0, 0, At, B0); PG8_MMA(0, 1, At, B1); PG8_BAR; PG8_SCHED;
            PG8_LDA(At, 1, 1); PG8_STAGE(PG8_SB(1, 0), b3, voffB); PG8_STAGE(PG8_SB(1, 1), b3 + hstepB, voffB); PG8_STAGE(PG8_SA(1, 0), a3, voffA);
            PG8_WAIT_V(8); PG8_WAIT_L(0); PG8_BAR; PG8_MMA(1, 0, At, B0); PG8_MMA(1, 1, At, B1); PG8_BAR; PG8_SCHED;
        }
        if constexpr (ALIGN_EPI) { if (wr == 0) PG8_BAR; }
        E(acc, cur, wr, wc, fr, fq); S.done(cur);
        if (!has_next) break;
#pragma unroll
        for (int a = 0; a < 2; ++a)
#pragma unroll
            for (int b = 0; b < 2; ++b)
#pragma unroll
                for (int m = 0; m < 4; ++m)
#pragma unroll
                    for (int n = 0; n < 2; ++n) acc[a][b][m][n] = (f32x4){0.f, 0.f, 0.f, 0.f};
        cur = nxt; cA = nA; cB = nB; ++ui;
        if constexpr (ALIGN_EPI) { if (wr == 1) PG8_BAR; }
    }
    PG8_WAIT_V(0);
    if constexpr (!ALIGN_EPI) { if (wr == 0) PG8_BAR; }
    PG8_BAR;
#undef PG8_SA
#undef PG8_SB
#undef PG8_STAGE
#undef PG8_LDA
#undef PG8_LDB
#undef PG8_MMA
#undef PG8_WAIT_V
#undef PG8_WAIT_L
#undef PG8_BAR
#undef PG8_SCHED
}
}

constexpr int NWAVES = 8, NTHR = 512;
constexpr int BATCH = 8, SEQ = 2048, DM = 1024, DEPTH = 2, FF = 2752, M = BATCH * SEQ;
constexpr int FFP = 2816;
constexpr int NGU = 5632;
constexpr int PP = 3584;
constexpr int NIN = 3400;
constexpr int PA = 0, PMV = 1280, PBQ = 1296, PBC = 1680, PBIQ = 1808, PBIK = 2320, PBIW = 2384, PCQ = 2392, PCK = 2648, PCV = 2904, PCG = 3160, PUSED = 3416;
constexpr int AW = 384;
constexpr int TOPK = 256;

constexpr size_t MiB = 1u << 20;
constexpr size_t WS_CTL = 0, CTL_ZERO_BYTES = 1 * MiB;
constexpr size_t WS_PART = 1 * MiB;
constexpr size_t WS_TAB = 2 * MiB;
constexpr size_t WS_BON = 2 * MiB + 512 * 1024;
constexpr size_t WS_WUKT = 3 * MiB, WS_WUVT = 3 * MiB + 192 * 1024;
constexpr size_t WS_THR = 3 * MiB + 384 * 1024, WS_SCUT = 3 * MiB + 448 * 1024;
constexpr size_t WS_LORA = 3 * MiB + 512 * 1024;
constexpr size_t WS_WGU1 = 4 * MiB, WS_WD1 = 15 * MiB, WS_WIN = 21 * MiB, WS_WOUT = 28 * MiB, WS_WGU2 = 30 * MiB, WS_WD2 = 41 * MiB;
constexpr size_t WS_XB = 47 * MiB;
constexpr size_t WS_VF = 79 * MiB;
constexpr size_t WS_P = 91 * MiB;
constexpr size_t WS_H = WS_P;
constexpr size_t WS_R = 203 * MiB, WS_D = 215 * MiB, WS_K2 = 227 * MiB, WS_KK = 239 * MiB, WS_C = 251 * MiB;
constexpr size_t WS_KV = WS_XB + 24 * MiB;
constexpr size_t OUT_BP = 0, OUT_G = 12 * MiB, OUT_MASK = 24 * MiB;
constexpr size_t WS_END = 256 * MiB;
static_assert(WS_WD2 + (size_t)1024 * FFP * 2 <= WS_XB && WS_P + (size_t)M * PP * 2 <= WS_R && WS_C + (size_t)M * 128 * 2 <= WS_END, "ws map");
constexpr int CW_BAR = 4096;
constexpr int CW_QUEUE = 16384;

constexpr int RING_BYTES = 131072;
constexpr int LDSCTL_OFF = RING_BYTES, MISC_OFF = LDSCTL_OFF + 320;
constexpr int LDS_BYTES = 147456;

#define GAS __attribute__((address_space(1)))
#define LAS __attribute__((address_space(3)))
typedef unsigned short bf16;
typedef unsigned v4u __attribute__((ext_vector_type(4)));
typedef float f32x4 __attribute__((ext_vector_type(4)));
typedef GAS unsigned gu32;
#define RLX_AGENT __ATOMIC_RELAXED, __HIP_MEMORY_SCOPE_AGENT
#define LDS_WAIT() asm volatile("s_waitcnt lgkmcnt(0)" ::: "memory")
__device__ __forceinline__ unsigned f2bf(float f) { unsigned u = __builtin_bit_cast(unsigned, f); return (u + 0x7fffu + ((u >> 16) & 1u)) >> 16; }
typedef float f32x2v_ __attribute__((ext_vector_type(2))); typedef __bf16 bf16x2v_ __attribute__((ext_vector_type(2)));
__device__ __forceinline__ unsigned pk2(float lo, float hi) { const f32x2v_ v = {lo, hi}; return __builtin_bit_cast(unsigned, __builtin_convertvector(v, bf16x2v_)); }
__device__ __forceinline__ float bf2f(unsigned short v) { return __uint_as_float((unsigned)v << 16); }
__device__ __forceinline__ float bflo(unsigned w) { return __uint_as_float(w << 16); }
__device__ __forceinline__ float bfhi(unsigned w) { return __uint_as_float(w & 0xffff0000u); }
__device__ __forceinline__ void unpack8(const v4u w, float (&f)[8]) { f[0] = bflo(w.x); f[1] = bfhi(w.x); f[2] = bflo(w.y); f[3] = bfhi(w.y); f[4] = bflo(w.z); f[5] = bfhi(w.z); f[6] = bflo(w.w); f[7] = bfhi(w.w); }
__device__ __forceinline__ float sigmoid_f(float x) { return 1.0f / (1.0f + __expf(-x)); }
__device__ __forceinline__ float wave_sum(float v) {
#pragma unroll
    for (int o = 1; o < 64; o <<= 1) v += __shfl_xor(v, o);
    return v;
}

#define XB_TMO      128
#define XB_XCNT(j)  (256  + 64 * (j))
#define XB_XSUB(j)  (1280 + 64 * (j))
#define XB_XGEN(j)  (2304 + 64 * (j))
#define XB_TOP      3328
#define XB_TOPGEN   3392
#define XCD_BAR_WORDS 3456
#define XB_SPIN_CAP (1u << 22)

__device__ __forceinline__ unsigned xb_ld(unsigned* p)              { return __hip_atomic_load(p, __ATOMIC_RELAXED, __HIP_MEMORY_SCOPE_AGENT); }
__device__ __forceinline__ unsigned xb_add(unsigned* p, unsigned v) { return __hip_atomic_fetch_add(p, v, __ATOMIC_RELAXED, __HIP_MEMORY_SCOPE_AGENT); }
__device__ __forceinline__ unsigned xb_xcc_id() { return (unsigned)__builtin_amdgcn_s_getreg((3 << 11) | 20) & 0xFu; }
#define XB_SPIN(cond, bar) do { unsigned _sp = 0; while (cond) { __builtin_amdgcn_s_sleep(1); \
    if ((++_sp & 255u) == 0u) { if (xb_ld(&(bar)[XB_TMO])) break; if (_sp > XB_SPIN_CAP) { atomicAdd(&(bar)[XB_TMO], 1u); break; } } } } while (0)

struct XcdBarrier { unsigned* bar; unsigned x; volatile LAS unsigned* st; };

__device__ __forceinline__ XcdBarrier xcd_barrier_post(unsigned* bar, volatile LAS unsigned* st) {
    XcdBarrier b; b.bar = bar; b.x = xb_xcc_id(); b.st = st;
    if (threadIdx.x == 0) (void)xb_add(&bar[XB_XCNT(b.x)], 1u);
    return b;
}
__device__ __forceinline__ void xcd_barrier_complete(unsigned* bar, unsigned x, unsigned& nloc, unsigned& nx) {
    const unsigned G = gridDim.x * gridDim.y * gridDim.z;
    unsigned sum, cnt, mine, sp = 0u;
    for (;;) {
        sum = 0u; cnt = 0u; mine = 0u;
#pragma unroll
        for (unsigned j = 0; j < 16; ++j) { const unsigned c = xb_ld(&bar[XB_XCNT(j)]); sum += c; cnt += (c > 0u) ? 1u : 0u; mine = (j == x) ? c : mine; }
        if (sum == G) break;
        __builtin_amdgcn_s_sleep(1);
        if ((++sp & 255u) == 0u) { if (xb_ld(&bar[XB_TMO])) break; if (sp > XB_SPIN_CAP) { atomicAdd(&bar[XB_TMO], 1u); break; } }
    }
    nloc = mine > 0u ? mine : 1u; nx = cnt > 0u ? cnt : 1u;
}
__device__ __forceinline__ void xcd_barrier(const XcdBarrier& b) {
    asm volatile("s_waitcnt vmcnt(0)" ::: "memory");
    __syncthreads();
    if (threadIdx.x == 0) {
        unsigned* bar = b.bar;
        __builtin_amdgcn_s_waitcnt(0);
        unsigned nloc = b.st[0], nx = b.st[1];
        if (nloc == 0u) { xcd_barrier_complete(bar, b.x, nloc, nx); b.st[0] = nloc; b.st[1] = nx; }
        const unsigned old = xb_add(&bar[XB_XSUB(b.x)], 1u);
        const unsigned gen = old / nloc;
        if (old + 1u == (gen + 1u) * nloc) {
            __builtin_amdgcn_fence(__ATOMIC_RELEASE, "agent");
            asm volatile("s_waitcnt vmcnt(0)" ::: "memory");
            const unsigned og = xb_add(&bar[XB_TOP], 1u);
            const unsigned tg = og / nx;
            if (og + 1u == (tg + 1u) * nx) xb_add(&bar[XB_TOPGEN], 1u);
            else XB_SPIN(xb_ld(&bar[XB_TOPGEN]) == tg, bar);
            __builtin_amdgcn_fence(__ATOMIC_ACQUIRE, "agent");
            xb_add(&bar[XB_XGEN(b.x)], 1u);
            asm volatile("s_waitcnt vmcnt(0)" ::: "memory");
        } else {
            XB_SPIN(xb_ld(&bar[XB_XGEN(b.x)]) == gen, bar);
            __builtin_amdgcn_fence(__ATOMIC_ACQUIRE, "agent");
            asm volatile("s_waitcnt vmcnt(0)" ::: "memory");
        }
    }
    __syncthreads();
}

#ifndef DIAG_SLOT_D
#define DIAG_SLOT_D (-1)
#endif
#ifndef DIAG_DIV
#define DIAG_DIV 1.0f
#endif
constexpr size_t WS_DIAG = 3 * MiB + 900 * 1024;
#define DG_START(k, var) unsigned var = 0; if (DIAG_SLOT_D == (k)) var = (unsigned)__builtin_amdgcn_s_memtime();
#define DG_STOP(k, var, acc) if (DIAG_SLOT_D == (k)) acc += (unsigned)__builtin_amdgcn_s_memtime() - var;
#define DG_WRITE(k, cond, acc) if (DIAG_SLOT_D == (k) && (cond)) ((unsigned*)(F.ws + WS_DIAG))[0] = acc;
struct Args { const float* in[31]; float* out; unsigned char* ws; int ph_lo, ph_hi; int dup_phase, qdup, rep_scan, rep_thr; int stag_up, stag_in; };
struct Frame {
    LAS unsigned char* lds;
    int tid, lane, wave, vcu, G;
    const float* const __attribute__((address_space(4)))* in;
    float* out; unsigned char* ws;
};
enum { I_X = 0, I_F1N, I_F1G, I_F1U, I_F1D, I_MIXN, I_WIN, I_WOUT, I_MU, I_W0, I_W2, I_A0, I_A2, I_G2, I_KK, I_KA, I_RK, I_LNW, I_LNB, I_VRW, I_VRMU, I_V0, I_V2, I_KVN, I_WUK, I_WUV, I_F2N, I_F2G, I_F2U, I_F2D, I_FN };

__device__ __forceinline__ void conv_item(const Frame& F, int l, int kind, int item, LAS float* scr) {
    const int lane = F.lane;
    int Kd, nkb; bf16* WT;
    if (kind == 0 || kind == 4) { Kd = 1024; WT = (bf16*)(F.ws + (kind == 0 ? WS_WGU1 : WS_WGU2)); }
    else if (kind == 1 || kind == 5) { Kd = FFP; WT = (bf16*)(F.ws + (kind == 1 ? WS_WD1 : WS_WD2)); }
    else if (kind == 2) { Kd = 1024; WT = (bf16*)(F.ws + WS_WIN); }
    else { Kd = 1024; WT = (bf16*)(F.ws + WS_WOUT); }
    nkb = Kd / 64;
    const int rb = item / nkb, kb = item % nkb, r0 = rb * 32, k0 = kb * 64;
    const int n4 = (lane & 7) * 4, kr = lane >> 3;
    const int rr = r0 + n4;
    const float* src = nullptr; int ns = 0, col = 0, ksrc = 1024; const float* gain = nullptr; float scale = 1.0f;
    if (kind == 0 || kind == 4) {
        const int tile = rr >> 8, w = rr & 255, hid = tile * 128 + (w & 127);
        if (hid < FF) { const float* s1 = (w >> 7) ? F.in[I_F1U] : F.in[I_F1G]; const float* s2 = (w >> 7) ? F.in[I_F2U] : F.in[I_F2G]; src = ((kind == 0) ? s1 : s2) + (size_t)l * 1024 * FF; ns = FF; col = hid; }
        gain = ((kind == 0) ? F.in[I_F1N] : F.in[I_F2N]) + l * 1024;
    } else if (kind == 1 || kind == 5) {
        src = ((kind == 1) ? F.in[I_F1D] : F.in[I_F2D]) + (size_t)l * FF * 1024; ns = 1024; col = rr; ksrc = FF; scale = 0.5f;
    } else if (kind == 2) {
        gain = F.in[I_MIXN] + l * 1024;
        if (rr < 1280) { src = F.in[I_WIN] + (size_t)l * 1024 * NIN; ns = NIN; col = rr; }
        else if (rr < 1296) { if (l > 0) { src = F.in[I_VRW] + (size_t)(l - 1) * 1024 * 16; ns = 16; col = rr - 1280; } }
        else if (rr < PUSED) { src = F.in[I_WIN] + (size_t)l * 1024 * NIN; ns = NIN; col = rr - 16; }
    } else { src = F.in[I_WOUT] + (size_t)l * 1024 * 1024; ns = 1024; col = rr; }
    {
        const bool has = (src != nullptr); const float* sp = has ? src : F.in[I_FN]; const int nss = has ? ns : 0, cols = has ? col : 0;
        f32x4 vals[8];
#pragma unroll
        for (int i = 0; i < 8; ++i) { const int k = k0 + 8 * i + kr; const int kc = k < ksrc ? k : ksrc - 1; vals[i] = *(const GAS f32x4*)(sp + (size_t)kc * nss + cols); }
#pragma unroll
        for (int i = 0; i < 8; ++i) { const int kk = 8 * i + kr, k = k0 + kk; float g = (has && k < ksrc) ? scale : 0.f; if (gain) g *= gain[k < 1024 ? k : 1023];
            LAS float* d = scr + kk * 33 + n4; d[0] = vals[i][0] * g; d[1] = vals[i][1] * g; d[2] = vals[i][2] * g; d[3] = vals[i][3] * g; }
    }
    LDS_WAIT(); asm volatile("" ::: "memory");
    const int c = lane & 7;
#pragma unroll
    for (int j = 0; j < 4; ++j) { const int n = (lane >> 3) + 8 * j; const LAS float* s = scr + (8 * c) * 33 + n;
        v4u o; o.x = pk2(s[0 * 33], s[1 * 33]); o.y = pk2(s[2 * 33], s[3 * 33]); o.z = pk2(s[4 * 33], s[5 * 33]); o.w = pk2(s[6 * 33], s[7 * 33]);
        *(GAS v4u*)(WT + (size_t)(r0 + n) * Kd + k0 + 8 * c) = o; }
    LDS_WAIT(); asm volatile("" ::: "memory");
}
__host__ __device__ constexpr int conv_items(int kind) { return (kind == 0 || kind == 4) ? (NGU / 32) * 16 : (kind == 1 || kind == 5) ? 32 * (FFP / 64) : (kind == 2) ? (PP / 32) * 16 : 32 * 16; }
__device__ __forceinline__ void conv_weights(const Frame& F, int l, int k_lo, int k_hi) {
    LAS float* scr = (LAS float*)(F.lds + F.wave * 16384);
    const int gw = F.vcu * NWAVES + F.wave, NGW = F.G * NWAVES;
    for (int kind = k_lo; kind < k_hi; ++kind) { const int ni = conv_items(kind);
        for (int it = gw; it < ni; it += NGW) conv_item(F, l, kind, it, scr); }
}

__host__ __device__ constexpr int conv_flat_items(bool has_next) { return conv_items(3) + conv_items(4) + conv_items(5) + (has_next ? conv_items(0) + conv_items(1) + conv_items(2) : 0); }
constexpr int CONV_PER_WAVE = 2;
__device__ __forceinline__ void conv_unit(const Frame& F, int l, int u) {
    LAS float* scr = (LAS float*)(F.lds + F.wave * 16384);
    const bool has_next = (l + 1 < DEPTH);
#pragma unroll 1
    for (int rep = 0; rep < CONV_PER_WAVE; ++rep) {
    int it = (u * CONV_PER_WAVE + rep) * NWAVES + F.wave;
    if (it >= conv_flat_items(has_next)) return;
    int layer = l, kind = 3;
    if (it >= conv_items(3)) { it -= conv_items(3); kind = 4;
        if (it >= conv_items(4)) { it -= conv_items(4); kind = 5;
            if (it >= conv_items(5)) { it -= conv_items(5); kind = 0; layer = l + 1;
                if (it >= conv_items(0)) { it -= conv_items(0); kind = 1;
                    if (it >= conv_items(1)) { it -= conv_items(1); kind = 2; } } } } }
    conv_item(F, layer, kind, it, scr);
    }
}
__device__ __forceinline__ void p0_x(const Frame& F) {
    const int gw = F.vcu * NWAVES + F.wave, NGW = F.G * NWAVES;
    const float* x = F.in[I_X]; bf16* xb = (bf16*)(F.ws + WS_XB); float* part = (float*)(F.ws + WS_PART);
    for (int m = gw; m < M; m += NGW) {
        const GAS f32x4* xr = (const GAS f32x4*)(x + (size_t)m * DM) + F.lane; float s = 0.f;
        GAS unsigned long long* o8 = (GAS unsigned long long*)(xb + (size_t)m * DM) + F.lane;
#pragma unroll
        for (int j = 0; j < 4; ++j) { const f32x4 v = xr[64 * j]; s += (v.x * v.x + v.y * v.y) + (v.z * v.z + v.w * v.w);
            o8[64 * j] = (unsigned long long)pk2(v.x, v.y) | ((unsigned long long)pk2(v.z, v.w) << 32); }
        s = wave_sum(s);
        if (F.lane < 16) part[(size_t)m * 16 + F.lane] = (F.lane == 0) ? s : 0.f;
    }
}
__device__ __forceinline__ void p0_table(const Frame& F) {
    float* tab = (float*)(F.ws + WS_TAB);
    for (int i = F.vcu * NTHR + F.tid; i < SEQ * 32; i += F.G * NTHR) { const int t = i >> 5, f = i & 31; const float th = exp2f(-(float)f * (13.287712379549449f / 31.0f)); const float ang = (float)t * th; float s, c; sincosf(ang, &s, &c); tab[2 * i] = c; tab[2 * i + 1] = s; }
}

__device__ __forceinline__ void ret_kv_unit(const Frame& F, int unit) {
    unsigned dga_ = 0;
    DG_START(30, dg30_)
    LAS float* kr = (LAS float*)F.lds; LAS float* vv = kr + 128 * 64;
    const int tid = F.tid, c = unit & 15, h = (unit >> 4) & 3, b = unit >> 6, tok0 = b * SEQ + c * 128;
    const bf16* P = (const bf16*)(F.ws + WS_P); const float* tab = (const float*)(F.ws + WS_TAB);
    const float lg2 = log2f(1.0f - exp2f(-5.0f - (float)h));
    for (int idx = tid; idx < 128 * 32; idx += NTHR) { const int m = idx >> 5, i = idx & 31; const size_t ro = (size_t)(tok0 + m) * PP;
        const float k1 = bf2f(P[ro + PCK + h * 64 + i]), k2 = bf2f(P[ro + PCK + h * 64 + 32 + i]);
        const float cs = tab[((c * 128 + m) * 32 + i) * 2], sn = tab[((c * 128 + m) * 32 + i) * 2 + 1];
        const float sc = 0.125f * exp2f((float)(127 - m) * lg2);
        kr[m * 64 + i] = (k1 * cs - k2 * sn) * sc; kr[m * 64 + 32 + i] = (k1 * sn + k2 * cs) * sc;
        vv[m * 64 + i] = bf2f(P[ro + PCV + h * 64 + i]); vv[m * 64 + 32 + i] = bf2f(P[ro + PCV + h * 64 + 32 + i]); }
    __syncthreads();
    const int d = tid >> 3, e0 = (tid & 7) * 8; float acc[8];
#pragma unroll
    for (int e = 0; e < 8; ++e) acc[e] = 0.f;
    for (int m = 0; m < 128; ++m) { const float kd = kr[m * 64 + d];
#pragma unroll
        for (int e = 0; e < 8; ++e) acc[e] += kd * vv[m * 64 + e0 + e]; }
    float* KV = (float*)(F.ws + WS_KV) + (size_t)unit * 4096 + d * 64 + e0;
#pragma unroll
    for (int e = 0; e < 8; ++e) KV[e] = acc[e];
    __syncthreads();
    DG_STOP(30, dg30_, dga_)
    DG_WRITE(30, unit == 0 && F.wave == 0 && F.lane == 0, dga_)
}

typedef float f32x2 __attribute__((ext_vector_type(2)));
__device__ __forceinline__ float dpp_add16(float x) {
    x += __builtin_bit_cast(float, __builtin_amdgcn_mov_dpp(__builtin_bit_cast(int, x), 0xB1, 0xF, 0xF, true));
    x += __builtin_bit_cast(float, __builtin_amdgcn_mov_dpp(__builtin_bit_cast(int, x), 0x4E, 0xF, 0xF, true));
    x += __builtin_bit_cast(float, __builtin_amdgcn_mov_dpp(__builtin_bit_cast(int, x), 0x141, 0xF, 0xF, true));
    x += __builtin_bit_cast(float, __builtin_amdgcn_mov_dpp(__builtin_bit_cast(int, x), 0x140, 0xF, 0xF, true));
    return x;
}
constexpr int CH = 32;
constexpr int RW_STG = 5 * CH * 64;
constexpr int RW_ROWS = 16;
struct RwOps { f32x4 r, d, k, q, b; float v; };
__device__ __forceinline__ void rw_ld(RwOps& o, const LAS float* base, const LAS float* vb, int s, int ks, int row) {
    const LAS f32x4* p = (const LAS f32x4*)(base + s * 64 + ks * 4);
    o.r = p[0]; o.d = p[CH * 16]; o.k = p[2 * CH * 16]; o.q = p[3 * CH * 16]; o.b = p[4 * CH * 16];
    o.v = vb[s * RW_ROWS + row];
}
#define LO2(x) __builtin_shufflevector(x, x, 0, 1)
#define HI2(x) __builtin_shufflevector(x, x, 2, 3)
__device__ __forceinline__ float rw_step1(f32x2 (&S)[2], const RwOps& o, float v) {
    f32x2 p2 = S[0] * LO2(o.q); p2 = S[1] * HI2(o.q) + p2;
    const float p = dpp_add16(p2.x + p2.y);
    const f32x2 pp = (f32x2){p, p}, vv = (f32x2){v, v};
    S[0] = S[0] - LO2(o.d) * S[0]; S[1] = S[1] - HI2(o.d) * S[1];
    S[0] = S[0] - pp * LO2(o.b); S[1] = S[1] - pp * HI2(o.b);
    S[0] = vv * LO2(o.k) + S[0]; S[1] = vv * HI2(o.k) + S[1];
    f32x2 y2 = S[0] * LO2(o.r); y2 = S[1] * HI2(o.r) + y2;
    return dpp_add16(y2.x + y2.y);
}
__device__ __forceinline__ void rwkv_scan_unit(const Frame& F, int l, int unit) {
    const int tid = F.tid, lane = F.lane, wave = F.wave, quarter = unit & 3, bh = unit >> 2, b = bh / 6, h = bh - b * 6, tokb = b * SEQ;
    LAS float* stg = (LAS float*)F.lds; LAS float* vst = stg + 2 * RW_STG; LAS float* ybuf = vst + 2 * CH * RW_ROWS;
    bf16* P = (bf16*)(F.ws + WS_P);
    constexpr int NCH = SEQ / CH;
    unsigned dga_ = 0;
    if (wave >= 4) {
        const int st = tid - 256;
        const int t01 = st >> 3, c01 = st & 7, tv = st >> 1, cv = st & 1;
        const bf16* a0 = (const bf16*)(F.ws + WS_R); const bf16* a1 = (const bf16*)(F.ws + WS_D); const bf16* a2 = (const bf16*)(F.ws + WS_K2); const bf16* a3 = (const bf16*)(F.ws + WS_KK);
        const bf16* a4 = (const bf16*)((const unsigned char*)F.out + OUT_BP); const bf16* a5 = (const bf16*)(F.ws + WS_VF);
        v4u sreg[6];
#define RW_LOAD(cc) do { const size_t o_ = (size_t)(tokb + (cc) * CH + t01) * AW + h * 64 + c01 * 8; sreg[0] = *(const GAS v4u*)(a0 + o_); sreg[1] = *(const GAS v4u*)(a1 + o_); sreg[2] = *(const GAS v4u*)(a2 + o_); \
            sreg[3] = *(const GAS v4u*)(a3 + o_); sreg[4] = *(const GAS v4u*)(a4 + o_); if (st < 64) sreg[5] = *(const GAS v4u*)(a5 + (size_t)(tokb + (cc) * CH + tv) * AW + h * 64 + quarter * RW_ROWS + cv * 8); } while (0)
#define RW_ST1(i, dstp) do { float f[8]; unpack8(sreg[i], f); LAS f32x4* dst = (LAS f32x4*)(dstp); dst[0] = (f32x4){f[0], f[1], f[2], f[3]}; dst[1] = (f32x4){f[4], f[5], f[6], f[7]}; } while (0)
#define RW_STORE(bufi) do { _Pragma("unroll") for (int i = 0; i < 5; ++i) RW_ST1(i, stg + (bufi) * RW_STG + i * CH * 64 + t01 * 64 + c01 * 8); if (st < 64) RW_ST1(5, vst + (bufi) * CH * RW_ROWS + tv * RW_ROWS + cv * 8); } while (0)
#define RW_OUT(cc) do { if (st < 128) { const LAS float* yb_ = ybuf + ((cc) & 1) * CH * RW_ROWS; const int s_ = st >> 2, r4_ = (st & 3) * 4; const f32x4 yv = *(const LAS f32x4*)(yb_ + s_ * RW_ROWS + r4_); \
            *(GAS unsigned long long*)(P + (size_t)(tokb + (cc) * CH + s_) * PP + h * 64 + quarter * RW_ROWS + r4_) = (unsigned long long)pk2(yv[0], yv[1]) | ((unsigned long long)pk2(yv[2], yv[3]) << 32); } } while (0)
        RW_LOAD(0); RW_STORE(0); RW_LOAD(1);
        __syncthreads();
        for (int cc = 0; cc < NCH; ++cc) {
            if (cc + 1 < NCH) RW_STORE((cc + 1) & 1);
            if (cc + 2 < NCH) RW_LOAD(cc + 2);
            if (cc > 0) RW_OUT(cc - 1);
            asm volatile("s_waitcnt lgkmcnt(0)" ::: "memory"); __builtin_amdgcn_s_barrier(); asm volatile("" ::: "memory");
        }
        RW_OUT(NCH - 1);
#undef RW_LOAD
#undef RW_ST1
#undef RW_STORE
#undef RW_OUT
        return;
    }
    const int row = 4 * wave + (lane >> 4), ks = lane & 15;
    f32x2 Sa[2] = {(f32x2){0.f, 0.f}, (f32x2){0.f, 0.f}};
    __syncthreads();
    for (int cc = 0; cc < NCH; ++cc) {
        const int bufi = cc & 1;
        const LAS float* base = stg + bufi * RW_STG; const LAS float* vb = vst + bufi * CH * RW_ROWS; LAS float* yb = ybuf + bufi * CH * RW_ROWS;
        RwOps A, B; float yk0 = 0.f;
        DG_START(40, dg40_)
        rw_ld(A, base, vb, 0, ks, row);
#pragma unroll
        for (int s = 0; s < CH; s += 2) {
            rw_ld(B, base, vb, s + 1, ks, row);
            { const float y0 = rw_step1(Sa, A, A.v); yk0 = (ks == (s & 15)) ? y0 : yk0; }
            if (s + 2 < CH) rw_ld(A, base, vb, s + 2, ks, row);
            { const float y0 = rw_step1(Sa, B, B.v); yk0 = (ks == ((s + 1) & 15)) ? y0 : yk0; }
            if (((s + 1) & 15) == 15) yb[(s - 14 + ks) * RW_ROWS + row] = yk0;
        }
        DG_STOP(40, dg40_, dga_)
        DG_START(43, dg43_)
        asm volatile("s_waitcnt lgkmcnt(0)" ::: "memory"); __builtin_amdgcn_s_barrier(); asm volatile("" ::: "memory");
        DG_STOP(43, dg43_, dga_)
    }
    DG_WRITE(40, unit == 0 && l == 0 && wave == 0 && lane == 0, dga_)
    DG_WRITE(43, unit == 0 && l == 0 && wave == 0 && lane == 0, dga_)
}
__device__ __forceinline__ void rwkv_post(const Frame& F, int l) {
    bf16* P = (bf16*)(F.ws + WS_P); const bf16* VF = (const bf16*)(F.ws + WS_VF); const bf16* Gg = (const bf16*)((const unsigned char*)F.out + OUT_G); const float* BON = (const float*)(F.ws + WS_BON);
    const int sub = F.tid >> 4, c4 = (F.tid & 15) * 4;
    for (int pr = F.vcu * 32 + sub; pr < M * 6; pr += F.G * 32) { const int tok = pr / 6, h = pr - tok * 6;
        const unsigned long long yw = *(const GAS unsigned long long*)(P + (size_t)tok * PP + h * 64 + c4), vw = *(const GAS unsigned long long*)(VF + (size_t)tok * AW + h * 64 + c4), gw = *(const GAS unsigned long long*)(Gg + (size_t)tok * AW + h * 64 + c4);
        const f32x4 lnw = *(const f32x4*)(F.in[I_LNW] + l * AW + h * 64 + c4), lnb = *(const f32x4*)(F.in[I_LNB] + l * AW + h * 64 + c4);
        const float bon = BON[(size_t)tok * 6 + h];
        const f32x4 yv = (f32x4){bflo((unsigned)yw), bfhi((unsigned)yw), bflo((unsigned)(yw >> 32)), bfhi((unsigned)(yw >> 32))};
        const f32x4 vv = (f32x4){bflo((unsigned)vw), bfhi((unsigned)vw), bflo((unsigned)(vw >> 32)), bfhi((unsigned)(vw >> 32))};
        const f32x4 gg = (f32x4){bflo((unsigned)gw), bfhi((unsigned)gw), bflo((unsigned)(gw >> 32)), bfhi((unsigned)(gw >> 32))};
        float sm = (yv[0] + yv[1]) + (yv[2] + yv[3]);
        sm += __shfl_xor(sm, 1); sm += __shfl_xor(sm, 2); sm += __shfl_xor(sm, 4); sm += __shfl_xor(sm, 8);
        const float mean = sm * (1.0f / 64.0f); const f32x4 dv = yv - mean;
        float vs = (dv[0] * dv[0] + dv[1] * dv[1]) + (dv[2] * dv[2] + dv[3] * dv[3]);
        vs += __shfl_xor(vs, 1); vs += __shfl_xor(vs, 2); vs += __shfl_xor(vs, 4); vs += __shfl_xor(vs, 8);
        const float rs = 1.0f / sqrtf(vs * (1.0f / 64.0f) + 64e-5f);
        const f32x4 o = (dv * rs * lnw + lnb + bon * vv) * gg;
        *(GAS unsigned long long*)(P + (size_t)tok * PP + h * 64 + c4) = (unsigned long long)pk2(o[0], o[1]) | ((unsigned long long)pk2(o[2], o[3]) << 32);
    }
}

typedef short bf16x8_t __attribute__((ext_vector_type(8)));
typedef short s16x4_t __attribute__((ext_vector_type(4)));
typedef float f32x16_t __attribute__((ext_vector_type(16)));
__device__ __forceinline__ unsigned fkey(float f) { const unsigned u = __float_as_uint(f); return (u & 0x80000000u) ? ~u : (u | 0x80000000u); }
__device__ __forceinline__ int crow32(int r, int hi) { return (r & 3) + 8 * (r >> 2) + 4 * hi; }
__device__ __forceinline__ unsigned off_a(unsigned row, unsigned ch) { return 2048u * (row >> 3) + 512u * (ch >> 2) + 64u * (row & 7) + 16u * ((ch & 3) ^ ((row >> 2) & 3)); }

__device__ __forceinline__ void idx_scores(const bf16x8_t (&Af)[2], const bf16x8_t (&Bf)[8][2], const float (&iwf)[8], float (&sc)[4]) {
    sc[0] = sc[1] = sc[2] = sc[3] = 0.f;
#pragma unroll
    for (int h = 0; h < 8; ++h) { f32x4 a = (f32x4){0.f, 0.f, 0.f, 0.f};
        a = __builtin_amdgcn_mfma_f32_16x16x32_bf16(Af[0], Bf[h][0], a, 0, 0, 0);
        a = __builtin_amdgcn_mfma_f32_16x16x32_bf16(Af[1], Bf[h][1], a, 0, 0, 0);
#pragma unroll
        for (int r = 0; r < 4; ++r) { const float av_ = a[r]; const int ai_ = __float_as_int(av_); const float rl = __int_as_float(ai_ > 0 ? ai_ : 0); sc[r] = fmaf(iwf[h], rl, sc[r]); } }
}
__device__ __forceinline__ void idx_load_q(const bf16* P, int tokq, bf16x8_t (&Bf)[8][2], float (&iwf)[8], int fq) {
    const bf16* row = P + (size_t)tokq * PP;
#pragma unroll
    for (int h = 0; h < 8; ++h)
#pragma unroll
        for (int ks = 0; ks < 2; ++ks) Bf[h][ks] = *(const GAS bf16x8_t*)(row + PBIQ + h * 64 + ks * 32 + fq * 8);
    const v4u w = *(const GAS v4u*)(row + PBIW); float f[8]; unpack8(w, f);
#pragma unroll
    for (int h = 0; h < 8; ++h) iwf[h] = f[h] * (0.35355339059327373f * 0.125f);
}

__device__ __forceinline__ void lds_barrier() { asm volatile("s_waitcnt lgkmcnt(0)" ::: "memory"); __builtin_amdgcn_s_barrier(); asm volatile("" ::: "memory"); }
constexpr int SKP = 2052;
__device__ __forceinline__ void dsa_thr_unit(const Frame& F, int unit) {
    LAS unsigned* sk = (LAS unsigned*)F.lds;
    const int lane = F.lane, wave = F.wave, fr = lane & 15, fq = lane >> 4;
    const int b = unit & 7, qb = 127 - (unit >> 3), t0 = qb * 16, tok0 = b * SEQ + t0;
    const bf16* P = (const bf16*)(F.ws + WS_P);
    unsigned dga_ = 0;
    DG_START(10, dg10_)
    {
        bf16x8_t Bf[8][2]; float iwf[8];
        idx_load_q(P, tok0 + fr, Bf, iwf, fq);
        bf16x8_t An[2];
        { const int kt0 = wave <= qb ? wave : qb; const bf16* krow = P + (size_t)(b * SEQ + kt0 * 16 + fr) * PP + PBIK + fq * 8; An[0] = *(const GAS bf16x8_t*)(krow); An[1] = *(const GAS bf16x8_t*)(krow + 32); }
        for (int kt = wave; kt <= qb; kt += 8) {
            bf16x8_t Af[2]; Af[0] = An[0]; Af[1] = An[1];
            { const int ktn = kt + 8 <= qb ? kt + 8 : qb; const bf16* krow = P + (size_t)(b * SEQ + ktn * 16 + fr) * PP + PBIK + fq * 8; An[0] = *(const GAS bf16x8_t*)(krow); An[1] = *(const GAS bf16x8_t*)(krow + 32); }
            float sc[4]; idx_scores(Af, Bf, iwf, sc);
            v4u kv;
            const int s0 = kt * 16 + 4 * fq, t = t0 + fr;
            kv.x = (s0 + 0 <= t) ? fkey(sc[0]) : 0u; kv.y = (s0 + 1 <= t) ? fkey(sc[1]) : 0u; kv.z = (s0 + 2 <= t) ? fkey(sc[2]) : 0u; kv.w = (s0 + 3 <= t) ? fkey(sc[3]) : 0u;
            *(LAS v4u*)(sk + fr * SKP + s0) = kv;
        }
    }
    __syncthreads();
    DG_STOP(10, dg10_, dga_)
    DG_WRITE(10, unit == 0 && wave == 0 && lane == 0, dga_)
    DG_START(11, dg11_)
    unsigned* THR = (unsigned*)(F.ws + WS_THR); int* SCUT = (int*)(F.ws + WS_SCUT);
    for (int qi = 0; qi < 2; ++qi) { const int q = 2 * wave + qi, t = t0 + q, n = t + 1;
        unsigned thr = 0u; int scut = SEQ - 1;
        if (n > TOPK) {
            unsigned keys[32];
#pragma unroll
            for (int i = 0; i < 32; ++i) keys[i] = (64 * i + lane <= t) ? sk[q * SKP + 64 * i + lane] : 0u;
            unsigned prefix = 0u; bool done = false;
            const int ng = (t >> 9) + 1;
            for (int bit = 31; bit >= 0; --bit) { const unsigned cand = prefix | (1u << bit); int cnt = 0;
#pragma unroll
                for (int g = 0; g < 4; ++g) if (g < ng) {
#pragma unroll
                    for (int i = 8 * g; i < 8 * g + 8; ++i) cnt += __popcll(__ballot(keys[i] >= cand)); }
                if (cnt >= TOPK) prefix = cand;
                if (cnt == TOPK) { thr = cand - 1u; scut = -1; done = true; break; } }
            if (!done) {
                int cgt = 0;
#pragma unroll
                for (int i = 0; i < 32; ++i) cgt += __popcll(__ballot(keys[i] > prefix));
                int need = TOPK - cgt, run = 0; thr = prefix; scut = SEQ - 1; bool found = false;
#pragma unroll
                for (int i = 0; i < 32; ++i) { unsigned long long mk = __ballot(keys[i] == prefix); const int c = __popcll(mk);
                    if (!found && run + c >= need) { int k = need - run; while (k > 1) { mk &= mk - 1ull; --k; } scut = 64 * i + (int)__builtin_ctzll(mk); found = true; }
                    run += c; }
            }
        }
        {
            unsigned* MK = (unsigned*)((unsigned char*)F.out + OUT_MASK) + (size_t)(tok0 + q) * 64;
            if (n > TOPK) {
#pragma unroll
                for (int i = 0; i < 32; ++i) { const int s = 64 * i + lane; const unsigned key = (s <= t) ? sk[q * SKP + s] : 0u;
                    const unsigned long long bal = __ballot((s <= t) & ((key > thr) | ((key == thr) & (s <= scut))));
                    if (lane < 2 && 64 * i <= t) MK[2 * i + lane] = lane ? (unsigned)(bal >> 32) : (unsigned)bal; }
            } else {
                if (lane < 8) { const int w0 = lane; MK[w0] = (32 * w0 + 31 <= t) ? 0xffffffffu : ((32 * w0 <= t) ? ((1u << ((t & 31) + 1)) - 1u) : 0u); }
            }
        }
    }
    DG_STOP(11, dg11_, dga_)
    DG_WRITE(11, unit == 0 && wave == 0 && lane == 0, dga_)
    __syncthreads();
}

constexpr int QLP = 136;
constexpr int MKP = 36;
constexpr int DA_MASK = 0, DA_QL = 2 * 32 * MKP * 4, DA_CT = DA_QL + 6 * 32 * QLP * 2;
__device__ __forceinline__ void dsa_attn_unit(const Frame& F, int l, int unit) {
    const int tid = F.tid, lane = F.lane, wave = F.wave, r32 = lane & 31, hi = lane >> 5;
    const int b = unit & 7, qb = 63 - (unit >> 3), t0 = qb * 32, tok0 = b * SEQ + t0, ntile = qb + 1;
    bf16* P = (bf16*)(F.ws + WS_P); const bf16* C = (const bf16*)(F.ws + WS_C);
    LAS float* MASK = (LAS float*)(F.lds + DA_MASK); LAS unsigned char* QLb = F.lds + DA_QL; LAS unsigned char* CT = F.lds + DA_CT;
    const int crow_ = tid >> 4, cch = tid & 15; const unsigned cdst = off_a((unsigned)crow_, (unsigned)cch);
    const bf16* csrc = C + (size_t)(b * SEQ + crow_) * 128 + cch * 8;
    v4u cpre = *(const GAS v4u*)(csrc);
    if (wave >= 6) {
        const int fr = lane & 15, fq = lane >> 4, qh = wave - 6;
        const int tq = tok0 + 16 * qh + fr, tq_t = t0 + 16 * qh + fr, jmax = tq_t >> 5;
        const unsigned* MK = (const unsigned*)((const unsigned char*)F.out + OUT_MASK) + (size_t)tq * 64;
        LAS float* mrow = MASK + (16 * qh + fr) * MKP + 8 * fq;
#define DA_EXPAND(word, slot) do { const unsigned w_ = (word) >> (8 * fq); f32x4 m0_, m1_; \
            m0_[0] = (w_ & 1u) ? 0.f : -1e30f; m0_[1] = (w_ & 2u) ? 0.f : -1e30f; m0_[2] = (w_ & 4u) ? 0.f : -1e30f; m0_[3] = (w_ & 8u) ? 0.f : -1e30f; \
            m1_[0] = (w_ & 16u) ? 0.f : -1e30f; m1_[1] = (w_ & 32u) ? 0.f : -1e30f; m1_[2] = (w_ & 64u) ? 0.f : -1e30f; m1_[3] = (w_ & 128u) ? 0.f : -1e30f; \
            *(LAS f32x4*)(mrow + (slot) * (32 * MKP)) = m0_; *(LAS f32x4*)(mrow + (slot) * (32 * MKP) + 4) = m1_; } while (0)
        unsigned w0 = MK[0], w1 = (1 <= jmax) ? MK[1] : 0u, w2 = (2 <= jmax) ? MK[2] : 0u;
        DA_EXPAND(w0, 0);
        *(LAS v4u*)(CT + cdst) = cpre;
        lds_barrier();
        for (int j = 0; j < ntile; ++j) {
            if (j + 1 < ntile) {
                cpre = *(const GAS v4u*)(csrc + (size_t)(j + 1) * 32 * 128);
                DA_EXPAND(w1, (j + 1) & 1);
                w1 = w2; w2 = (j + 3 <= jmax) ? MK[j + 3] : 0u;
                *(LAS v4u*)(CT + ((j + 1) & 1) * 8192 + cdst) = cpre; }
            lds_barrier();
        }
#undef DA_EXPAND
        lds_barrier();
        return;
    }
    const int h = wave;
    LAS unsigned char* QLh = QLb + h * (32 * QLP * 2);
    float negb;
    {
        unsigned zo_ = 0u; asm volatile("" : "+v"(zo_));
        const bf16* wukT = (const bf16*)(F.ws + WS_WUKT) + (size_t)(l * 6 + h) * 128 * 64 + zo_;
        bf16x8_t qf[4]; float ssq = 0.f;
#pragma unroll
        for (int ks = 0; ks < 4; ++ks) qf[ks] = *(const GAS bf16x8_t*)(P + (size_t)(tok0 + r32) * PP + PBQ + h * 64 + ks * 16 + hi * 8);
#pragma unroll
        for (int blk = 0; blk < 4; ++blk) { f32x16_t x;
#pragma unroll
            for (int i = 0; i < 16; ++i) x[i] = 0.f;
#pragma unroll
            for (int ks = 0; ks < 4; ++ks) { const bf16x8_t a = *(const GAS bf16x8_t*)(wukT + (size_t)(blk * 32 + r32) * 64 + ks * 16 + hi * 8); x = __builtin_amdgcn_mfma_f32_32x32x16_bf16(a, qf[ks], x, 0, 0, 0); }
#pragma unroll
            for (int g = 0; g < 4; ++g) { const float sc = 0.125f * 1.4426950408889634f;
                const float x0 = x[4 * g] * sc, x1 = x[4 * g + 1] * sc, x2 = x[4 * g + 2] * sc, x3 = x[4 * g + 3] * sc; ssq += (x0 * x0 + x1 * x1) + (x2 * x2 + x3 * x3);
                const unsigned long long w = (unsigned long long)pk2(x0, x1) | ((unsigned long long)pk2(x2, x3) << 32);
                *(LAS unsigned long long*)(QLh + (r32 * QLP + blk * 32 + 8 * g + 4 * hi) * 2) = w; } }
        ssq += __shfl_xor(ssq, 32);
        const float* kvn = F.in[I_KVN] + l * 128; float gm = fmaxf(fabsf(kvn[2 * lane]), fabsf(kvn[2 * lane + 1]));
#pragma unroll
        for (int o_ = 1; o_ < 64; o_ <<= 1) gm = fmaxf(gm, __shfl_xor(gm, o_));
        negb = -(sqrtf(ssq) * 11.32f * gm * 1.01f + 0.01f);
    }
    *(LAS v4u*)(CT + cdst) = cpre;
    lds_barrier();
    f32x16_t o[4]; float l_run = 0.f;
    const LAS unsigned char* qlrow = QLh + (r32 * QLP + 8 * hi) * 2;
#pragma unroll
    for (int c = 0; c < 4; ++c)
#pragma unroll
        for (int i = 0; i < 16; ++i) o[c][i] = 0.f;
    const unsigned rr_ = ((unsigned)r32 >> 2) & 3u, rb_ = 2048u * ((unsigned)r32 >> 3) + 64u * ((unsigned)r32 & 7u);
    const unsigned rbase0 = rb_ + 16u * ((unsigned)hi ^ rr_), rbase1 = rb_ + 16u * ((2u + (unsigned)hi) ^ rr_);
    const unsigned blk_ = (lane >> 4) & 1, q_ = (lane & 15) >> 2, p_ = lane & 3;
    unsigned dga_ = 0;
    for (int j = 0; j < ntile; ++j) {
        DG_START(0, dgt_)
        LAS unsigned char* kb = CT + (j & 1) * 8192;
        if (j + 1 < ntile) cpre = *(const GAS v4u*)(csrc + (size_t)(j + 1) * 32 * 128);
        {
            f32x16_t S;
#pragma unroll
            for (int i = 0; i < 16; ++i) S[i] = negb;
#pragma unroll
            for (int s = 0; s < 8; ++s) { const bf16x8_t a = *(const LAS bf16x8_t*)(kb + ((s & 1) ? rbase1 : rbase0) + 512 * (s >> 1)); const bf16x8_t bq = *(const LAS bf16x8_t*)(qlrow + 32 * s);
                S = __builtin_amdgcn_mfma_f32_32x32x16_bf16(a, bq, S, 0, 0, 0); }
            const LAS f32x4* mk = (const LAS f32x4*)(MASK + (j & 1) * (32 * MKP) + r32 * MKP + 4 * hi);
            float psum = 0.f; float e[16];
#pragma unroll
            for (int g = 0; g < 4; ++g) { const f32x4 mv = mk[2 * g];
#pragma unroll
                for (int e4 = 0; e4 < 4; ++e4) { e[4 * g + e4] = __builtin_amdgcn_exp2f(S[4 * g + e4] + mv[e4]); psum += e[4 * g + e4]; } }
            l_run += psum;
            bf16x8_t xs[2];
#pragma unroll
            for (int s = 0; s < 2; ++s) { v4u w; w.x = pk2(e[8 * s], e[8 * s + 1]); w.y = pk2(e[8 * s + 2], e[8 * s + 3]); w.z = pk2(e[8 * s + 4], e[8 * s + 5]); w.w = pk2(e[8 * s + 6], e[8 * s + 7]); xs[s] = __builtin_bit_cast(bf16x8_t, w); }
#pragma unroll
            for (int c = 0; c < 4; ++c)
#pragma unroll
                for (int s = 0; s < 2; ++s) {
                    const unsigned a0 = off_a((unsigned)(16 * s + 4 * hi + q_), (unsigned)(4 * c + 2 * blk_ + (p_ >> 1))) + 8u * (p_ & 1);
                    const unsigned a1 = off_a((unsigned)(16 * s + 8 + 4 * hi + q_), (unsigned)(4 * c + 2 * blk_ + (p_ >> 1))) + 8u * (p_ & 1);
                    const s16x4_t lo = __builtin_bit_cast(s16x4_t, __builtin_amdgcn_ds_read_tr16_b64_v4i16((LAS s16x4_t*)(kb + a0)));
                    const s16x4_t hh = __builtin_bit_cast(s16x4_t, __builtin_amdgcn_ds_read_tr16_b64_v4i16((LAS s16x4_t*)(kb + a1)));
                    const bf16x8_t a = (bf16x8_t){lo[0], lo[1], lo[2], lo[3], hh[0], hh[1], hh[2], hh[3]};
                    o[c] = __builtin_amdgcn_mfma_f32_32x32x16_bf16(a, xs[s], o[c], 0, 0, 0); }
        }
        if (j + 1 < ntile) *(LAS v4u*)(CT + ((j + 1) & 1) * 8192 + cdst) = cpre;
        DG_STOP(0, dgt_, dga_)
        lds_barrier();
    }
    DG_WRITE(0, unit == 0 && l == 0 && wave == 0 && lane == 0, dga_)
    {
        const float lt = l_run + __shfl_xor(l_run, 32); const float inv = 1.0f / lt;
#pragma unroll
        for (int c = 0; c < 4; ++c)
#pragma unroll
            for (int g = 0; g < 4; ++g) { const unsigned long long w = (unsigned long long)pk2(o[c][4 * g] * inv, o[c][4 * g + 1] * inv) | ((unsigned long long)pk2(o[c][4 * g + 2] * inv, o[c][4 * g + 3] * inv) << 32);
                *(LAS unsigned long long*)(QLh + (r32 * QLP + c * 32 + 8 * g + 4 * hi) * 2) = w; }
        unsigned zo2_ = 0u; asm volatile("" : "+v"(zo2_));
        const bf16* wuvT = (const bf16*)(F.ws + WS_WUVT) + (size_t)(l * 6 + h) * 64 * 128 + zo2_;
        bf16x8_t Bo[8];
#pragma unroll
        for (int s = 0; s < 8; ++s) Bo[s] = *(const LAS bf16x8_t*)(QLh + (r32 * QLP + 16 * s + 8 * hi) * 2);
#pragma unroll
        for (int mb = 0; mb < 2; ++mb) { f32x16_t y;
#pragma unroll
            for (int i = 0; i < 16; ++i) y[i] = 0.f;
#pragma unroll
            for (int s = 0; s < 8; ++s) { const bf16x8_t a = *(const GAS bf16x8_t*)(wuvT + (size_t)(mb * 32 + r32) * 128 + 16 * s + 8 * hi); y = __builtin_amdgcn_mfma_f32_32x32x16_bf16(a, Bo[s], y, 0, 0, 0); }
#pragma unroll
            for (int g = 0; g < 4; ++g) { const unsigned long long w = (unsigned long long)pk2(y[4 * g], y[4 * g + 1]) | ((unsigned long long)pk2(y[4 * g + 2], y[4 * g + 3]) << 32);
                *(GAS unsigned long long*)(P + (size_t)(tok0 + r32) * PP + 384 + h * 64 + mb * 32 + 8 * g + 4 * hi) = w; } }
    }
    lds_barrier();
}
constexpr int RC = 32;
constexpr int P64 = 72, P32 = 40, PTS = 36;
constexpr int RPW = 72, RAWSZ = 32 * RPW, GP = 68;
constexpr int RK_RAW = 0;
constexpr int RK_GAM = RK_RAW + 6 * RAWSZ * 2;
constexpr int RK_AL = RK_GAM + 33 * GP * 4, RK_RH = RK_AL + 32 * P64 * 2, RK_BE = RK_RH + 32 * P64 * 2, RK_KA = RK_BE + 32 * P64 * 2;
constexpr int RK_BET = RK_KA + 32 * P64 * 2, RK_KAT = RK_BET + 64 * P32 * 2, RK_VT = RK_KAT + 64 * P32 * 2;
constexpr int RK_NT = RK_VT + 64 * P32 * 2, RK_BRT = RK_NT + 32 * P32 * 2, RK_KRT = RK_BRT + 32 * P32 * 2;
constexpr int RK_ZB = RK_KRT + 32 * P32 * 2;
constexpr int RK_XB = RK_ZB + 2 * 64 * P64 * 2;
constexpr int RK_EB = RK_XB + 64 * P32 * 2;
constexpr int RK_BRT2 = RK_EB + 64 * P32 * 2, RK_BET2 = RK_BRT2 + 32 * P32 * 2, RK_GC = RK_BET2 + 64 * P32 * 2;
constexpr int RK_END = RK_GC + 512;
static_assert(RK_END <= RING_BYTES, "chunked RWKV unit: LDS");
template <int KS> __device__ __forceinline__ void mm_ld(bf16x8_t (&a)[KS], bf16x8_t (&b)[KS], const LAS bf16* X, int px, const LAS bf16* Y, int py, int r32, int hi) {
#pragma unroll
    for (int s = 0; s < KS; ++s) { a[s] = *(const LAS bf16x8_t*)(X + r32 * px + 16 * s + 8 * hi); b[s] = *(const LAS bf16x8_t*)(Y + r32 * py + 16 * s + 8 * hi); }
}
template <int KS> __device__ __forceinline__ void mm_do(f32x16_t& acc, const bf16x8_t (&a)[KS], const bf16x8_t (&b)[KS]) {
#pragma unroll
    for (int s = 0; s < KS; ++s) acc = __builtin_amdgcn_mfma_f32_32x32x16_bf16(a[s], b[s], acc, 0, 0, 0);
}
__device__ __forceinline__ bf16x8_t acc_frag(const f32x16_t& a, int s) { v4u w; w.x = pk2(a[8 * s], a[8 * s + 1]); w.y = pk2(a[8 * s + 2], a[8 * s + 3]); w.z = pk2(a[8 * s + 4], a[8 * s + 5]); w.w = pk2(a[8 * s + 6], a[8 * s + 7]); return __builtin_bit_cast(bf16x8_t, w); }
__device__ __forceinline__ void mm_acc(f32x16_t& d, const f32x16_t& at, const f32x16_t& b) {
    d = __builtin_amdgcn_mfma_f32_32x32x16_bf16(acc_frag(at, 0), acc_frag(b, 0), d, 0, 0, 0); d = __builtin_amdgcn_mfma_f32_32x32x16_bf16(acc_frag(at, 1), acc_frag(b, 1), d, 0, 0, 0);
}
template <int KS> __device__ __forceinline__ void mm_abt(f32x16_t& acc, const LAS bf16* X, int px, const LAS bf16* Y, int py, int r32, int hi) {
    bf16x8_t a[KS], b[KS]; mm_ld<KS>(a, b, X, px, Y, py, r32, hi); mm_do<KS>(acc, a, b);
}
template <int K1, int K2> __device__ __forceinline__ void mm_abt2(f32x16_t& acc, const LAS bf16* X1, int px1, const LAS bf16* Y1, int py1, const LAS bf16* X2, int px2, const LAS bf16* Y2, int py2, int r32, int hi) {
    bf16x8_t a1[K1], b1[K1], a2[K2], b2[K2]; mm_ld<K1>(a1, b1, X1, px1, Y1, py1, r32, hi); mm_ld<K2>(a2, b2, X2, px2, Y2, py2, r32, hi); mm_do<K1>(acc, a1, b1); mm_do<K2>(acc, a2, b2);
}
__device__ __forceinline__ void rwkv_chunk_unit(const Frame& F, int l, int unit) {
    const int tid = F.tid, lane = F.lane, wave = F.wave, r32 = lane & 31, hi = lane >> 5;
    const int b = unit / 6, h = unit - b * 6, tokb = b * SEQ;
    LAS bf16* RAW = (LAS bf16*)(F.lds + RK_RAW); LAS float* GAM = (LAS float*)(F.lds + RK_GAM);
    LAS bf16* AL = (LAS bf16*)(F.lds + RK_AL); LAS bf16* RH = (LAS bf16*)(F.lds + RK_RH); LAS bf16* BE = (LAS bf16*)(F.lds + RK_BE); LAS bf16* KA = (LAS bf16*)(F.lds + RK_KA);
    LAS bf16* KAT = (LAS bf16*)(F.lds + RK_KAT); LAS bf16* VT = (LAS bf16*)(F.lds + RK_VT);
    LAS bf16* NT = (LAS bf16*)(F.lds + RK_NT); LAS bf16* KRT = (LAS bf16*)(F.lds + RK_KRT);
    LAS bf16* ZB = (LAS bf16*)(F.lds + RK_ZB); LAS bf16* XB = (LAS bf16*)(F.lds + RK_XB); LAS bf16* EB = (LAS bf16*)(F.lds + RK_EB);
    LAS float* GC = (LAS float*)(F.lds + RK_GC);
    bf16* P = (bf16*)(F.ws + WS_P);
    constexpr int NCH = SEQ / RC;
    const int half = tid >> 8, idx = tid & 255, lt = idx >> 3, lc = idx & 7;
    const bf16* s0 = (const bf16*)(F.ws + (half ? WS_KK : WS_R)); const bf16* s1 = half ? (const bf16*)((const unsigned char*)F.out + OUT_BP) : (const bf16*)(F.ws + WS_D); const bf16* s2 = (const bf16*)(F.ws + (half ? WS_VF : WS_K2));
    v4u pre[3];
#define RK_LOAD(cc) do { const size_t o_ = (size_t)(tokb + (cc) * RC + lt) * AW + h * 64 + lc * 8; pre[0] = *(const GAS v4u*)(s0 + o_); pre[1] = *(const GAS v4u*)(s1 + o_); pre[2] = *(const GAS v4u*)(s2 + o_); } while (0)
#define RK_H1() do { _Pragma("unroll") for (int j = 0; j < 3; ++j) *(LAS v4u*)(RAW + (3 * half + j) * RAWSZ + lt * RPW + lc * 8) = pre[j]; } while (0)
#define RK_PROD8(s_) ({ float w_[8]; _Pragma("unroll") for (int j = 0; j < 8; ++j) w_[j] = 1.0f - __builtin_bit_cast(float, (unsigned)RAW[RAWSZ + (8 * (s_) + j) * RPW + lane] << 16); \
        ((w_[0] * w_[1]) * (w_[2] * w_[3])) * ((w_[4] * w_[5]) * (w_[6] * w_[7])); })
#define RK_H2(cn) do { if (wave >= 4) { const int seg = wave - 4; float w_[8]; _Pragma("unroll") for (int j = 0; j < 8; ++j) w_[j] = 1.0f - __builtin_bit_cast(float, (unsigned)RAW[RAWSZ + (8 * seg + j) * RPW + lane] << 16); \
        float g = 1.f; if (seg >= 1) { const float p0 = RK_PROD8(0); g = p0; if (seg >= 2) { const float p1 = RK_PROD8(1); g *= p1; if (seg >= 3) { const float p2 = RK_PROD8(2); g *= p2; } } } \
        _Pragma("unroll") for (int j = 0; j < 8; ++j) { g *= w_[j]; GAM[(8 * seg + j + 1) * GP + lane] = g; } \
        if (seg == 3) GC[((cn) & 1) * 64 + lane] = g; } } while (0)
#define RK_H3(cn) do { LAS bf16* BETn = (LAS bf16*)(F.lds + (((cn) & 1) ? RK_BET2 : RK_BET)); \
        { \
            { const int it = tid; const int t = it & 31, k4 = (it >> 5) * 4;        \
                const f32x4 g1 = *(const LAS f32x4*)(GAM + (t + 1) * GP + k4), g0 = *(const LAS f32x4*)(GAM + t * GP + k4); \
                const unsigned long long rw = *(const LAS unsigned long long*)(RAW + 0 * RAWSZ + t * RPW + k4), kw = *(const LAS unsigned long long*)(RAW + 2 * RAWSZ + t * RPW + k4); \
                const unsigned long long qw = *(const LAS unsigned long long*)(RAW + 3 * RAWSZ + t * RPW + k4), bw = *(const LAS unsigned long long*)(RAW + 4 * RAWSZ + t * RPW + k4); \
                const f32x4 rv = (f32x4){bflo((unsigned)rw), bfhi((unsigned)rw), bflo((unsigned)(rw >> 32)), bfhi((unsigned)(rw >> 32))}, kv = (f32x4){bflo((unsigned)kw), bfhi((unsigned)kw), bflo((unsigned)(kw >> 32)), bfhi((unsigned)(kw >> 32))}; \
                const f32x4 qv = (f32x4){bflo((unsigned)qw), bfhi((unsigned)qw), bflo((unsigned)(qw >> 32)), bfhi((unsigned)(qw >> 32))}, bv = (f32x4){bflo((unsigned)bw), bfhi((unsigned)bw), bflo((unsigned)(bw >> 32)), bfhi((unsigned)(bw >> 32))}; \
                const f32x4 rg = (f32x4){__builtin_amdgcn_rcpf(g1[0]), __builtin_amdgcn_rcpf(g1[1]), __builtin_amdgcn_rcpf(g1[2]), __builtin_amdgcn_rcpf(g1[3])}; \
                const f32x4 al = -(qv * g0), rh = rv * g1, be = bv * rg, ka = kv * rg; \
                const unsigned be0 = pk2(be[0], be[1]), be1 = pk2(be[2], be[3]), ka0 = pk2(ka[0], ka[1]), ka1 = pk2(ka[2], ka[3]); \
                *(LAS unsigned long long*)(AL + t * P64 + k4) = (unsigned long long)pk2(al[0], al[1]) | ((unsigned long long)pk2(al[2], al[3]) << 32); \
                *(LAS unsigned long long*)(RH + t * P64 + k4) = (unsigned long long)pk2(rh[0], rh[1]) | ((unsigned long long)pk2(rh[2], rh[3]) << 32); \
                *(LAS unsigned long long*)(BE + t * P64 + k4) = (unsigned long long)be0 | ((unsigned long long)be1 << 32); \
                *(LAS unsigned long long*)(KA + t * P64 + k4) = (unsigned long long)ka0 | ((unsigned long long)ka1 << 32); \
                BETn[(k4 + 0) * P32 + t] = (bf16)(be0 & 0xffffu); BETn[(k4 + 1) * P32 + t] = (bf16)(be0 >> 16); BETn[(k4 + 2) * P32 + t] = (bf16)(be1 & 0xffffu); BETn[(k4 + 3) * P32 + t] = (bf16)(be1 >> 16); \
                KAT[(k4 + 0) * P32 + t] = (bf16)(ka0 & 0xffffu); KAT[(k4 + 1) * P32 + t] = (bf16)(ka0 >> 16); KAT[(k4 + 2) * P32 + t] = (bf16)(ka1 & 0xffffu); KAT[(k4 + 3) * P32 + t] = (bf16)(ka1 >> 16); } \
            if (tid >= 256) { const int ix = tid - 256, i = ix & 31, v8 = (ix >> 5) * 8; const v4u w = *(const LAS v4u*)(RAW + 5 * RAWSZ + i * RPW + v8); \
                VT[(v8 + 0) * P32 + i] = (bf16)(w.x & 0xffffu); VT[(v8 + 1) * P32 + i] = (bf16)(w.x >> 16); VT[(v8 + 2) * P32 + i] = (bf16)(w.y & 0xffffu); VT[(v8 + 3) * P32 + i] = (bf16)(w.y >> 16); \
                VT[(v8 + 4) * P32 + i] = (bf16)(w.z & 0xffffu); VT[(v8 + 5) * P32 + i] = (bf16)(w.z >> 16); VT[(v8 + 6) * P32 + i] = (bf16)(w.w & 0xffffu); VT[(v8 + 7) * P32 + i] = (bf16)(w.w >> 16); } } } while (0)
#define RK_ST_ROWS(O, acc_) do { _Pragma("unroll") for (int r = 0; r < 16; ++r) (O)[crow32(r, hi) * P32 + r32] = (bf16)(pk2((acc_)[r], 0.f) & 0xffffu); } while (0)
#define RK_ST_COLS(O, acc_) do { _Pragma("unroll") for (int g = 0; g < 4; ++g) *(LAS unsigned long long*)((O) + r32 * P32 + 8 * g + 4 * hi) = (unsigned long long)pk2((acc_)[4 * g], (acc_)[4 * g + 1]) | ((unsigned long long)pk2((acc_)[4 * g + 2], (acc_)[4 * g + 3]) << 32); } while (0)
#define RK_CH_RND() do { f32x16_t pn, ptn; _Pragma("unroll") for (int i = 0; i < 16; ++i) { pn[i] = 0.f; ptn[i] = 0.f; } \
        mm_acc(pn, cpt, cp); mm_acc(ptn, cp, cpt); cp = pn; cpt = ptn; \
        f32x16_t mn = cm, mtn = cmt; mm_acc(mn, cmt, cp); mm_acc(mtn, cp, cmt); cm = mn; cmt = mtn; } while (0)
#define RK_CH_A() do { bf16x8_t fa[4], fb[4]; mm_ld<4>(fa, fb, BE, P64, AL, P64, r32, hi); \
        _Pragma("unroll") for (int i = 0; i < 16; ++i) { cp[i] = 0.f; cpt[i] = 0.f; } \
        mm_do<4>(cp, fa, fb); mm_do<4>(cpt, fb, fa);                                     \
        _Pragma("unroll") for (int r = 0; r < 16; ++r) { const int m_ = crow32(r, hi); cp[r] = (m_ < r32) ? cp[r] : 0.f; cpt[r] = (r32 < m_) ? cpt[r] : 0.f; const float id_ = (m_ == r32) ? 1.0f : 0.f; cm[r] = cp[r] + id_; cmt[r] = cpt[r] + id_; } \
        RK_CH_RND(); RK_CH_RND(); } while (0)
#define RK_CH_B() do { RK_CH_RND(); RK_CH_RND(); } while (0)
#define RK_H4(cn) do { if (wave == 0) RK_CH_A(); \
        else if (wave < 3) { LAS bf16* BRTn = (LAS bf16*)(F.lds + (((cn) & 1) ? RK_BRT2 : RK_BRT)); f32x16_t acc; \
        _Pragma("unroll") for (int i = 0; i < 16; ++i) acc[i] = 0.f; \
        if (wave == 1) { f32x16_t ac2; _Pragma("unroll") for (int i = 0; i < 16; ++i) ac2[i] = 0.f; \
            mm_abt<4>(acc, AL, P64, KA, P64, r32, hi); mm_abt<4>(ac2, RH, P64, KA, P64, r32, hi); \
            _Pragma("unroll") for (int r = 0; r < 16; ++r) { acc[r] = (r32 < crow32(r, hi)) ? acc[r] : 0.f; ac2[r] = (r32 <= crow32(r, hi)) ? ac2[r] : 0.f; } \
            RK_ST_ROWS(NT, acc); RK_ST_ROWS(KRT, ac2); } \
        else { mm_abt<4>(acc, RH, P64, BE, P64, r32, hi); \
            _Pragma("unroll") for (int r = 0; r < 16; ++r) acc[r] = (r32 <= crow32(r, hi)) ? acc[r] : 0.f; \
            RK_ST_ROWS(BRTn, acc); } } } while (0)
    RK_LOAD(0);
    for (int u = tid; u < 64 * P64 / 2; u += NTHR) ((LAS unsigned*)ZB)[u] = 0u;
    if (tid < 64) GAM[tid] = 1.f;
    f32x16_t zacc, cp, cpt, cm, cmt;
#pragma unroll
    for (int i = 0; i < 16; ++i) { zacc[i] = 0.f; cp[i] = 0.f; cpt[i] = 0.f; cm[i] = 0.f; cmt[i] = 0.f; }
#define RK_RELANE() int ln_ = F.lane, td_ = F.tid; asm volatile("" : "+v"(ln_), "+v"(td_)); const int lane = ln_, tid = td_, r32 = ln_ & 31, hi = ln_ >> 5; (void)lane; (void)tid; (void)r32; (void)hi;
    RK_H1(); RK_LOAD(1);
    lds_barrier();
    { RK_RELANE() RK_H2(0); }
    lds_barrier();
    { RK_RELANE() RK_H3(0); }
    lds_barrier();
    { RK_RELANE() RK_H4(0); } RK_H1(); RK_LOAD(2);
    lds_barrier();
    unsigned dga_ = 0;
    for (int c = 0; c < NCH; ++c) {
        const int tok0 = tokb + c * RC;
        int ln_ = F.lane, td_ = F.tid; asm volatile("" : "+v"(ln_), "+v"(td_));
        const int lane = ln_, tid = td_, r32 = ln_ & 31, hi = ln_ >> 5;
        const LAS bf16* Zc = ZB + (c & 1) * 64 * P64; LAS bf16* Zn = ZB + ((c + 1) & 1) * 64 * P64;
        const LAS bf16* BRTc = (const LAS bf16*)(F.lds + ((c & 1) ? RK_BRT2 : RK_BRT)); const LAS bf16* BETc = (const LAS bf16*)(F.lds + ((c & 1) ? RK_BET2 : RK_BET));
        DG_START(70, dg70_) DG_START(73, dg73_) DG_START(76, dg76_)
        f32x16_t yacc0, yacc1;
        if (wave == 0) RK_CH_B();
        else if (wave < 3) { const int vb = wave - 1; f32x16_t acc;
#pragma unroll
            for (int i = 0; i < 16; ++i) acc[i] = 0.f;
            mm_abt2<4, 2>(acc, Zc + 32 * vb * P64, P64, AL, P64, VT + 32 * vb * P32, P32, NT, P32, r32, hi);
            RK_ST_ROWS(XB + 32 * vb * P32, acc); }
        else if (wave == 3) {
#pragma unroll
            for (int i = 0; i < 16; ++i) { yacc0[i] = 0.f; yacc1[i] = 0.f; }
            mm_abt2<4, 2>(yacc0, Zc, P64, RH, P64, VT, P32, KRT, P32, r32, hi);
            mm_abt2<4, 2>(yacc1, Zc + 32 * P64, P64, RH, P64, VT + 32 * P32, P32, KRT, P32, r32, hi); }
        else { mm_abt<2>(zacc, VT + 32 * ((wave - 4) >> 1) * P32, P32, KAT + 32 * ((wave - 4) & 1) * P32, P32, r32, hi);
            if (c + 1 < NCH) RK_H2(c + 1); }
        if (DIAG_SLOT_D == 73) { asm volatile("s_waitcnt lgkmcnt(0)" ::: "memory"); DG_STOP(73, dg73_, dga_) }
        lds_barrier();
        DG_STOP(70, dg70_, dga_) DG_START(71, dg71_) DG_START(74, dg74_)
        if (wave == 0) {
            const bf16x8_t mb0 = acc_frag(cm, 0), mb1 = acc_frag(cm, 1);
#pragma unroll
            for (int vb = 0; vb < 2; ++vb) { f32x16_t acc;
#pragma unroll
                for (int i = 0; i < 16; ++i) acc[i] = 0.f;
                const LAS bf16* xr = XB + (32 * vb + r32) * P32 + 4 * hi;
                v4u x0, x1; { const unsigned long long u0 = *(const LAS unsigned long long*)(xr), u1 = *(const LAS unsigned long long*)(xr + 8), u2 = *(const LAS unsigned long long*)(xr + 16), u3 = *(const LAS unsigned long long*)(xr + 24);
                    x0.x = (unsigned)u0; x0.y = (unsigned)(u0 >> 32); x0.z = (unsigned)u1; x0.w = (unsigned)(u1 >> 32); x1.x = (unsigned)u2; x1.y = (unsigned)(u2 >> 32); x1.z = (unsigned)u3; x1.w = (unsigned)(u3 >> 32); }
                acc = __builtin_amdgcn_mfma_f32_32x32x16_bf16(__builtin_bit_cast(bf16x8_t, x0), mb0, acc, 0, 0, 0);
                acc = __builtin_amdgcn_mfma_f32_32x32x16_bf16(__builtin_bit_cast(bf16x8_t, x1), mb1, acc, 0, 0, 0);
                RK_ST_ROWS(EB + 32 * vb * P32, acc); } }
        if (c + 1 < NCH) RK_H3(c + 1);
        if (DIAG_SLOT_D == 74) { asm volatile("s_waitcnt lgkmcnt(0)" ::: "memory"); DG_STOP(74, dg74_, dga_) }
        lds_barrier();
        DG_STOP(71, dg71_, dga_) DG_START(72, dg72_) DG_START(75, dg75_)
        if (c + 2 < NCH) { RK_H1(); if (c + 3 < NCH) RK_LOAD(c + 3); }
        if (wave == 3) {
            mm_abt<2>(yacc0, EB, P32, BRTc, P32, r32, hi); mm_abt<2>(yacc1, EB + 32 * P32, P32, BRTc, P32, r32, hi);
            bf16* yo = P + (size_t)(tok0 + r32) * PP + h * 64 + 4 * hi;
#pragma unroll
            for (int g = 0; g < 4; ++g) { *(GAS unsigned long long*)(yo + 8 * g) = (unsigned long long)pk2(yacc0[4 * g], yacc0[4 * g + 1]) | ((unsigned long long)pk2(yacc0[4 * g + 2], yacc0[4 * g + 3]) << 32);
                *(GAS unsigned long long*)(yo + 32 + 8 * g) = (unsigned long long)pk2(yacc1[4 * g], yacc1[4 * g + 1]) | ((unsigned long long)pk2(yacc1[4 * g + 2], yacc1[4 * g + 3]) << 32); } }
        else if (wave >= 4) { const int vb = (wave - 4) >> 1, kb = (wave - 4) & 1;
            mm_abt<2>(zacc, EB + 32 * vb * P32, P32, BETc + 32 * kb * P32, P32, r32, hi);
            const float gc = GC[(c & 1) * 64 + 32 * kb + r32];
#pragma unroll
            for (int r = 0; r < 16; ++r) { zacc[r] *= gc; Zn[(32 * vb + crow32(r, hi)) * P64 + 32 * kb + r32] = (bf16)(pk2(zacc[r], 0.f) & 0xffffu); } }
        if (c + 1 < NCH) RK_H4(c + 1);
        if (DIAG_SLOT_D == 75) { asm volatile("s_waitcnt lgkmcnt(0)" ::: "memory"); DG_STOP(75, dg75_, dga_) }
        lds_barrier();
        DG_STOP(72, dg72_, dga_) DG_STOP(76, dg76_, dga_)
    }
    DG_WRITE(70, unit == 0 && l == 0 && F.tid == 0, dga_) DG_WRITE(71, unit == 0 && l == 0 && F.tid == 0, dga_) DG_WRITE(72, unit == 0 && l == 0 && F.tid == 0, dga_) DG_WRITE(76, unit == 0 && l == 0 && F.tid == 0, dga_)
    DG_WRITE(73, unit == 0 && l == 0 && F.tid == 448, dga_) DG_WRITE(74, unit == 0 && l == 0 && F.tid == 64, dga_) DG_WRITE(75, unit == 0 && l == 0 && F.tid == 0, dga_)
#undef RK_LOAD
#undef RK_H1
#undef RK_PROD8
#undef RK_H2
#undef RK_H3
#undef RK_H4
#undef RK_RELANE
#undef RK_CH_A
#undef RK_CH_RND
#undef RK_CH_B
#undef RK_ST_ROWS
#undef RK_ST_COLS
}

constexpr int RP = 72;
constexpr int RT_QR = 0, RT_KR = 128 * RP * 2, RT_VV = 2 * 128 * RP * 2, RT_ST = 3 * 128 * RP * 2, RT_SS = RT_ST + 64 * RP * 2, RT_KD = RT_SS + 1024;
__device__ __forceinline__ void ret_out_unit(const Frame& F, int unit) {
    const int tid = F.tid, lane = F.lane, wave = F.wave, r32 = lane & 31, hi = lane >> 5;
    const int h = unit & 3, b = unit >> 2;
    bf16* P = (bf16*)(F.ws + WS_P); const float* tab = (const float*)(F.ws + WS_TAB);
    LAS bf16* QR = (LAS bf16*)(F.lds + RT_QR); LAS bf16* KR = (LAS bf16*)(F.lds + RT_KR); LAS bf16* VV = (LAS bf16*)(F.lds + RT_VV); LAS bf16* ST = (LAS bf16*)(F.lds + RT_ST);
    LAS float* SS = (LAS float*)(F.lds + RT_SS); LAS bf16* KD = (LAS bf16*)(F.lds + RT_KD);
    const float lg2 = log2f(1.0f - exp2f(-5.0f - (float)h));
    f32x16_t st;
#pragma unroll
    for (int i = 0; i < 16; ++i) st[i] = 0.f;
    const float cdec = exp2f(128.0f * lg2);
    unsigned long long pre[2][6]; f32x4 pret[2][2];
#define RT_LOAD(cn) do { _Pragma("unroll") for (int it_ = 0; it_ < 2; ++it_) { const int idx_ = tid + it_ * NTHR, m_ = idx_ >> 3, i4_ = (idx_ & 7) * 4; const size_t ro_ = (size_t)(b * SEQ + (cn) * 128 + m_) * PP + h * 64 + i4_; \
        pre[it_][0] = *(const GAS unsigned long long*)(P + ro_ + PCQ); pre[it_][1] = *(const GAS unsigned long long*)(P + ro_ + PCQ + 32); pre[it_][2] = *(const GAS unsigned long long*)(P + ro_ + PCK); \
        pre[it_][3] = *(const GAS unsigned long long*)(P + ro_ + PCK + 32); pre[it_][4] = *(const GAS unsigned long long*)(P + ro_ + PCV); pre[it_][5] = *(const GAS unsigned long long*)(P + ro_ + PCV + 32); \
        pret[it_][0] = *(const GAS f32x4*)(tab + ((size_t)((cn) * 128 + m_) * 32 + i4_) * 2); pret[it_][1] = *(const GAS f32x4*)(tab + ((size_t)((cn) * 128 + m_) * 32 + i4_) * 2 + 4); } } while (0)
    unsigned dga_ = 0;
    DG_START(60, dg60_)
    RT_LOAD(0);
    for (int c = 0; c < 16; ++c) {
    const int tok0 = b * SEQ + c * 128;
#pragma unroll
    for (int it = 0; it < 2; ++it) { const int idx = tid + it * NTHR, m = idx >> 3, i4 = (idx & 7) * 4;
        const unsigned long long q1w = pre[it][0], q2w = pre[it][1], k1w = pre[it][2], k2w = pre[it][3], v1w = pre[it][4], v2w = pre[it][5];
        const f32x4 t0 = pret[it][0], t1 = pret[it][1];
        const float cs[4] = {t0[0], t0[2], t1[0], t1[2]}, sn[4] = {t0[1], t0[3], t1[1], t1[3]};
        const float q1[4] = {bflo((unsigned)q1w), bfhi((unsigned)q1w), bflo((unsigned)(q1w >> 32)), bfhi((unsigned)(q1w >> 32))}, q2[4] = {bflo((unsigned)q2w), bfhi((unsigned)q2w), bflo((unsigned)(q2w >> 32)), bfhi((unsigned)(q2w >> 32))};
        const float k1[4] = {bflo((unsigned)k1w), bfhi((unsigned)k1w), bflo((unsigned)(k1w >> 32)), bfhi((unsigned)(k1w >> 32))}, k2[4] = {bflo((unsigned)k2w), bfhi((unsigned)k2w), bflo((unsigned)(k2w >> 32)), bfhi((unsigned)(k2w >> 32))};
        float qa[4], qb[4], ka[4], kb[4];
#pragma unroll
        for (int j = 0; j < 4; ++j) { qa[j] = q1[j] * cs[j] - q2[j] * sn[j]; qb[j] = q1[j] * sn[j] + q2[j] * cs[j]; ka[j] = (k1[j] * cs[j] - k2[j] * sn[j]) * 0.125f; kb[j] = (k1[j] * sn[j] + k2[j] * cs[j]) * 0.125f; }
        *(LAS unsigned long long*)(QR + m * RP + i4) = (unsigned long long)pk2(qa[0], qa[1]) | ((unsigned long long)pk2(qa[2], qa[3]) << 32);
        *(LAS unsigned long long*)(QR + m * RP + 32 + i4) = (unsigned long long)pk2(qb[0], qb[1]) | ((unsigned long long)pk2(qb[2], qb[3]) << 32);
        *(LAS unsigned long long*)(KR + m * RP + i4) = (unsigned long long)pk2(ka[0], ka[1]) | ((unsigned long long)pk2(ka[2], ka[3]) << 32);
        *(LAS unsigned long long*)(KR + m * RP + 32 + i4) = (unsigned long long)pk2(kb[0], kb[1]) | ((unsigned long long)pk2(kb[2], kb[3]) << 32);
        { const float kd = exp2f((float)(127 - m) * lg2);
          *(LAS unsigned long long*)(KD + m * RP + i4) = (unsigned long long)pk2(ka[0] * kd, ka[1] * kd) | ((unsigned long long)pk2(ka[2] * kd, ka[3] * kd) << 32);
          *(LAS unsigned long long*)(KD + m * RP + 32 + i4) = (unsigned long long)pk2(kb[0] * kd, kb[1] * kd) | ((unsigned long long)pk2(kb[2] * kd, kb[3] * kd) << 32); }
        *(LAS unsigned long long*)(VV + m * RP + i4) = v1w; *(LAS unsigned long long*)(VV + m * RP + 32 + i4) = v2w; }
    if (c + 1 < 16) RT_LOAD(c + 1);
    if (wave < 4) {
        const int db = wave >> 1, ebs = wave & 1;
#pragma unroll
        for (int i = 0; i < 16; ++i) ST[(32 * db + crow32(i, hi)) * RP + 32 * ebs + r32] = (bf16)(pk2(st[i], 0.f) & 0xffffu);
    }
    lds_barrier();
    const int nb = wave >> 1, eb = wave & 1, n = nb * 32 + r32;
    const unsigned blk_ = (lane >> 4) & 1, q_ = (lane & 15) >> 2, p_ = lane & 3;
    bf16x8_t qf[4];
#pragma unroll
    for (int ks = 0; ks < 4; ++ks) qf[ks] = *(const LAS bf16x8_t*)(QR + n * RP + ks * 16 + hi * 8);
    f32x16_t y;
#pragma unroll
    for (int i = 0; i < 16; ++i) y[i] = 0.f;
#pragma unroll
    for (int ks = 0; ks < 4; ++ks) {
        const s16x4_t lo = __builtin_bit_cast(s16x4_t, __builtin_amdgcn_ds_read_tr16_b64_v4i16((LAS s16x4_t*)(ST + (16 * ks + 8 * hi + q_) * RP + 32 * eb + 16 * blk_ + 4 * p_)));
        const s16x4_t hh = __builtin_bit_cast(s16x4_t, __builtin_amdgcn_ds_read_tr16_b64_v4i16((LAS s16x4_t*)(ST + (16 * ks + 8 * hi + 4 + q_) * RP + 32 * eb + 16 * blk_ + 4 * p_)));
        const bf16x8_t a = (bf16x8_t){lo[0], lo[1], lo[2], lo[3], hh[0], hh[1], hh[2], hh[3]};
        y = __builtin_amdgcn_mfma_f32_32x32x16_bf16(a, qf[ks], y, 0, 0, 0); }
    { const float qd = exp2f((float)(n + 1) * lg2);
#pragma unroll
      for (int i = 0; i < 16; ++i) y[i] *= qd; }
    unsigned long long gpre[4];
#pragma unroll
    for (int g = 0; g < 4; ++g) gpre[g] = *(const GAS unsigned long long*)(P + (size_t)(tok0 + n) * PP + PCG + h * 64 + 32 * eb + 8 * g + 4 * hi);
    for (int mt = 0; mt <= nb; ++mt) {
        f32x16_t S;
#pragma unroll
        for (int i = 0; i < 16; ++i) S[i] = 0.f;
#pragma unroll
        for (int ks = 0; ks < 4; ++ks) { const bf16x8_t a = *(const LAS bf16x8_t*)(KR + (mt * 32 + r32) * RP + ks * 16 + hi * 8); S = __builtin_amdgcn_mfma_f32_32x32x16_bf16(a, qf[ks], S, 0, 0, 0); }
        float e[16];
#pragma unroll
        for (int r = 0; r < 16; ++r) { const int dm = r32 - crow32(r, hi) + 32 * (nb - mt); e[r] = (dm >= 0) ? S[r] * exp2f((float)dm * lg2) : 0.f; }
#pragma unroll
        for (int s = 0; s < 2; ++s) { v4u w; w.x = pk2(e[8 * s], e[8 * s + 1]); w.y = pk2(e[8 * s + 2], e[8 * s + 3]); w.z = pk2(e[8 * s + 4], e[8 * s + 5]); w.w = pk2(e[8 * s + 6], e[8 * s + 7]);
            const bf16x8_t xs = __builtin_bit_cast(bf16x8_t, w);
            const s16x4_t lo = __builtin_bit_cast(s16x4_t, __builtin_amdgcn_ds_read_tr16_b64_v4i16((LAS s16x4_t*)(VV + (mt * 32 + 16 * s + 4 * hi + q_) * RP + 32 * eb + 16 * blk_ + 4 * p_)));
            const s16x4_t hh = __builtin_bit_cast(s16x4_t, __builtin_amdgcn_ds_read_tr16_b64_v4i16((LAS s16x4_t*)(VV + (mt * 32 + 16 * s + 8 + 4 * hi + q_) * RP + 32 * eb + 16 * blk_ + 4 * p_)));
            const bf16x8_t a = (bf16x8_t){lo[0], lo[1], lo[2], lo[3], hh[0], hh[1], hh[2], hh[3]};
            y = __builtin_amdgcn_mfma_f32_32x32x16_bf16(a, xs, y, 0, 0, 0); }
    }
    float ss = 0.f;
#pragma unroll
    for (int i = 0; i < 16; ++i) ss += y[i] * y[i];
    ss += __shfl_xor(ss, 32);
    if (hi == 0) SS[(nb * 2 + eb) * 32 + r32] = ss;
    lds_barrier();
    ss += SS[(nb * 2 + (eb ^ 1)) * 32 + r32];
    const float rs = 1.0f / sqrtf(ss * (1.0f / 64.0f) + 1e-6f);
    const size_t ro = (size_t)(tok0 + n) * PP;
#pragma unroll
    for (int g = 0; g < 4; ++g) { const int e0 = 32 * eb + 8 * g + 4 * hi;
        const unsigned long long gw = gpre[g];
        const float g0 = bflo((unsigned)gw), g1 = bfhi((unsigned)gw), g2 = bflo((unsigned)(gw >> 32)), g3 = bfhi((unsigned)(gw >> 32));
        const float o0 = g0 * sigmoid_f(g0) * y[4 * g] * rs, o1 = g1 * sigmoid_f(g1) * y[4 * g + 1] * rs, o2 = g2 * sigmoid_f(g2) * y[4 * g + 2] * rs, o3 = g3 * sigmoid_f(g3) * y[4 * g + 3] * rs;
        *(GAS unsigned long long*)(P + ro + 768 + h * 64 + e0) = (unsigned long long)pk2(o0, o1) | ((unsigned long long)pk2(o2, o3) << 32); }
    if (wave < 4) {
        const int db = wave >> 1, ebs = wave & 1;
#pragma unroll
        for (int i = 0; i < 16; ++i) st[i] *= cdec;
#pragma unroll
        for (int ks = 0; ks < 8; ++ks) {
            const s16x4_t alo = __builtin_bit_cast(s16x4_t, __builtin_amdgcn_ds_read_tr16_b64_v4i16((LAS s16x4_t*)(KD + (16 * ks + 8 * hi + q_) * RP + 32 * db + 16 * blk_ + 4 * p_)));
            const s16x4_t ahi = __builtin_bit_cast(s16x4_t, __builtin_amdgcn_ds_read_tr16_b64_v4i16((LAS s16x4_t*)(KD + (16 * ks + 8 * hi + 4 + q_) * RP + 32 * db + 16 * blk_ + 4 * p_)));
            const s16x4_t blo = __builtin_bit_cast(s16x4_t, __builtin_amdgcn_ds_read_tr16_b64_v4i16((LAS s16x4_t*)(VV + (16 * ks + 8 * hi + q_) * RP + 32 * ebs + 16 * blk_ + 4 * p_)));
            const s16x4_t bhi = __builtin_bit_cast(s16x4_t, __builtin_amdgcn_ds_read_tr16_b64_v4i16((LAS s16x4_t*)(VV + (16 * ks + 8 * hi + 4 + q_) * RP + 32 * ebs + 16 * blk_ + 4 * p_)));
            const bf16x8_t a = (bf16x8_t){alo[0], alo[1], alo[2], alo[3], ahi[0], ahi[1], ahi[2], ahi[3]}, bb = (bf16x8_t){blo[0], blo[1], blo[2], blo[3], bhi[0], bhi[1], bhi[2], bhi[3]};
            st = __builtin_amdgcn_mfma_f32_32x32x16_bf16(a, bb, st, 0, 0, 0); }
    }
    lds_barrier();
    }
    DG_STOP(60, dg60_, dga_)
    DG_WRITE(60, unit == 0 && wave == 0 && lane == 0, dga_)
#undef RT_LOAD
}

constexpr int PT = 32, XSP = 1304;
constexpr int PR_XS = 0, PR_STG = PT * XSP * 2, PR_CONST = PR_STG + 32768, PR_MU = PR_CONST + 6 * 384 * 4;
__device__ __forceinline__ void prep_consts(const Frame& F, int l) {
    LAS float* CS = (LAS float*)(F.lds + PR_CONST);
    for (int i = F.tid; i < AW; i += NTHR) { CS[i] = F.in[I_KK][l * AW + i]; CS[AW + i] = F.in[I_KA][l * AW + i]; CS[2 * AW + i] = F.in[I_RK][l * AW + i];
        CS[3 * AW + i] = F.in[I_W0][l * AW + i]; CS[4 * AW + i] = F.in[I_A0][l * AW + i]; CS[5 * AW + i] = (l > 0) ? F.in[I_V0][(l - 1) * AW + i] : 0.f; }
    LAS float* MU = (LAS float*)(F.lds + PR_MU);
    for (int i = F.tid; i < 1296; i += NTHR) MU[i] = (i < 1280) ? F.in[I_MU][l * 1280 + i] : ((l > 0) ? F.in[I_VRMU][(l - 1) * 16 + i - 1280] : 0.f);
    __syncthreads();
}
__device__ __forceinline__ float softplus_f(float z) { return fmaxf(z, 0.f) + __logf(1.0f + __expf(-fabsf(z))); }
__device__ __forceinline__ float tanh_f(float x) { const float e = __expf(2.0f * x); return 1.0f - 2.0f * __builtin_amdgcn_rcpf(e + 1.0f); }
__device__ __forceinline__ void small_weights(const Frame& F) {
    for (int l = 0; l < DEPTH; ++l) {
        const float* w2 = F.in[I_W2] + (size_t)l * 32 * AW; const float* a2 = F.in[I_A2] + (size_t)l * 32 * AW; const float* g2 = F.in[I_G2] + (size_t)l * 64 * AW;
        const float* v2 = F.in[I_V2] + (size_t)(l > 0 ? l - 1 : 0) * 16 * AW;
        bf16* LT = (bf16*)(F.ws + WS_LORA) + (size_t)l * AW * 144;
        for (int i = F.vcu * NTHR + F.tid; i < AW * 144; i += F.G * NTHR) { const int n = i / 144, k = i - n * 144; float v;
            if (k < 32) v = w2[k * AW + n]; else if (k < 64) v = a2[(k - 32) * AW + n]; else if (k < 128) v = g2[(k - 64) * AW + n]; else v = (l > 0) ? v2[(k - 128) * AW + n] : 0.f;
            LT[i] = (bf16)f2bf(v); }
        const float* wuk = F.in[I_WUK] + (size_t)l * 6 * 64 * 128; const float* wuv = F.in[I_WUV] + (size_t)l * 6 * 128 * 64;
        bf16* wukT = (bf16*)(F.ws + WS_WUKT) + (size_t)l * 6 * 64 * 128; bf16* wuvT = (bf16*)(F.ws + WS_WUVT) + (size_t)l * 6 * 64 * 128;
        for (int i = F.vcu * NTHR + F.tid; i < 6 * 64 * 128; i += F.G * NTHR) {
            { const int hh = i / 8192, rem = i - hh * 8192, c = rem >> 6, d = rem & 63; wukT[i] = (bf16)f2bf(wuk[(hh * 64 + d) * 128 + c]); }
            { const int hh = i / 8192, rem = i - hh * 8192, d = rem >> 7, c = rem & 127; wuvT[i] = (bf16)f2bf(wuv[(hh * 128 + c) * 64 + d]); } }
    }
}
__device__ __forceinline__ void prep_tokens_unit(const Frame& F, int l, int unit) {
    LAS bf16* XS = (LAS bf16*)(F.lds + PR_XS);
    const int tid = F.tid, lane = F.lane, wave = F.wave, r32 = lane & 31, hi = lane >> 5, tok0 = unit * PT;
    const bf16* P = (const bf16*)(F.ws + WS_P);
    unsigned dga_ = 0;
    DG_START(20, dg20_)
    for (int base = 0; base < PT * 162; base += 5 * NTHR) {
        v4u cw[5], pw[5];
#pragma unroll
        for (int u = 0; u < 5; ++u) { const int idx = base + u * NTHR + tid; const int idc = idx < PT * 162 ? idx : PT * 162 - 1; const int t = idc / 162, ch = idc - t * 162, tok = tok0 + t;
            cw[u] = *(const GAS v4u*)(P + (size_t)tok * PP + ch * 8);
            const int tokp = (tok & (SEQ - 1)) != 0 ? tok - 1 : tok; pw[u] = *(const GAS v4u*)(P + (size_t)tokp * PP + ch * 8); }
#pragma unroll
        for (int u = 0; u < 5; ++u) { const int idx = base + u * NTHR + tid;
            if (idx < PT * 162) { const int t = idx / 162, ch = idx - t * 162, tok = tok0 + t, c0 = ch * 8;
                float cur[8], prv[8]; unpack8(cw[u], cur); unpack8(pw[u], prv);
                const bool first = (tok & (SEQ - 1)) == 0;
                float mv[8];
                { const LAS f32x4* mp = (const LAS f32x4*)((const LAS float*)(F.lds + PR_MU) + c0); const f32x4 m0 = mp[0], m1 = mp[1]; mv[0] = m0[0]; mv[1] = m0[1]; mv[2] = m0[2]; mv[3] = m0[3]; mv[4] = m1[0]; mv[5] = m1[1]; mv[6] = m1[2]; mv[7] = m1[3]; }
                float o[8];
#pragma unroll
                for (int j = 0; j < 8; ++j) { const float pv = first ? 0.f : prv[j]; float v = cur[j] + (pv - cur[j]) * mv[j];
                    if (c0 >= 1152 && c0 < 1184) v = tanh_f(v); else if (c0 >= 1216 && c0 < 1280) v = sigmoid_f(v);
                    o[j] = v; }
                v4u w; w.x = pk2(o[0], o[1]); w.y = pk2(o[2], o[3]); w.z = pk2(o[4], o[5]); w.w = pk2(o[6], o[7]);
                *(LAS v4u*)(XS + t * XSP + c0) = w; } }
    }
    __syncthreads();
    DG_STOP(20, dg20_, dga_)
    DG_WRITE(20, unit == 0 && l == 0 && wave == 0 && lane == 0, dga_)
    DG_START(21, dg21_)
    if (wave < 6) {
        const int h = wave;
        LAS bf16* STG = (LAS bf16*)(F.lds + PR_STG + wave * 4096);
        GAS unsigned char* wsb = (GAS unsigned char*)F.ws;
        GAS unsigned char* outb = (GAS unsigned char*)F.out;
        const bf16* LT = (const bf16*)(F.ws + WS_LORA) + (size_t)l * AW * 144;
        const LAS float* CS = (const LAS float*)(F.lds + PR_CONST) + h * 64;
        const LAS float* kkw = CS; const LAS float* kaw = CS + AW; const LAS float* rkw = CS + 2 * AW; const LAS float* w0p = CS + 3 * AW; const LAS float* a0p = CS + 4 * AW; const LAS float* v0p = CS + 5 * AW;
        const LAS bf16* xrow = XS + r32 * XSP;
        float rn;
        { float ss = 0.f;
#pragma unroll
          for (int cbl = 0; cbl < 2; ++cbl)
#pragma unroll
              for (int g = 0; g < 4; ++g) { const int j0 = cbl * 32 + 8 * g + 4 * hi; const unsigned long long kw = *(const LAS unsigned long long*)(xrow + 384 + h * 64 + j0); const f32x4 kk4 = *(const LAS f32x4*)(kkw + j0);
                  const float k0 = bflo((unsigned)kw) * kk4[0], k1 = bfhi((unsigned)kw) * kk4[1], k2 = bflo((unsigned)(kw >> 32)) * kk4[2], k3 = bfhi((unsigned)(kw >> 32)) * kk4[3]; ss += (k0 * k0 + k1 * k1) + (k2 * k2 + k3 * k3); }
          ss += __shfl_xor(ss, 32); rn = 1.0f / fmaxf(sqrtf(ss), 1e-12f); }
        float bonus = 0.f;
        const int srow = lane >> 2, sch = lane & 3;
#pragma unroll
        for (int cbl = 0; cbl < 2; ++cbl) {
            asm volatile("" ::: "memory");
            const int cb0 = h * 64 + cbl * 32;
            f32x16_t wv, av, gv, mvv;
#pragma unroll
            for (int i = 0; i < 16; ++i) { wv[i] = 0.f; av[i] = 0.f; gv[i] = 0.f; mvv[i] = 0.f; }
            const bf16* lrow = LT + (size_t)(cb0 + r32) * 144 + 8 * hi;
#pragma unroll
            for (int ks = 0; ks < 9; ++ks) { const bf16x8_t a = *(const GAS bf16x8_t*)(lrow + 16 * ks); const bf16x8_t bx = *(const LAS bf16x8_t*)(xrow + 1152 + 16 * ks + 8 * hi);
                if (ks < 2) wv = __builtin_amdgcn_mfma_f32_32x32x16_bf16(a, bx, wv, 0, 0, 0);
                else if (ks < 4) av = __builtin_amdgcn_mfma_f32_32x32x16_bf16(a, bx, av, 0, 0, 0);
                else if (ks < 8) gv = __builtin_amdgcn_mfma_f32_32x32x16_bf16(a, bx, gv, 0, 0, 0);
                else mvv = __builtin_amdgcn_mfma_f32_32x32x16_bf16(a, bx, mvv, 0, 0, 0); }
            if (l > 0) {
#pragma unroll
                for (int i = 0; i < 2; ++i) { const int row = srow + 16 * i; const unsigned eo = (unsigned)(((tok0 + row) * AW + cb0 + sch * 8) * 2); *(LAS v4u*)(STG + row * 32 + sch * 8) = *(const GAS v4u*)(wsb + WS_VF + eo); } }
            unsigned long long ro[4], dd[4], k2o[4], kko[4], bpo[4], vo[4], go[4];
#pragma unroll
            for (int g = 0; g < 4; ++g) { const int j0 = cbl * 32 + 8 * g + 4 * hi;
                const unsigned long long rw = *(const LAS unsigned long long*)(xrow + h * 64 + j0), kw = *(const LAS unsigned long long*)(xrow + 384 + h * 64 + j0), vw = *(const LAS unsigned long long*)(xrow + 768 + h * 64 + j0);
                unsigned long long fw = 0ull; if (l > 0) fw = *(const LAS unsigned long long*)(STG + r32 * 32 + 8 * g + 4 * hi);
                asm volatile("" : "+v"(bonus) :: "memory");
                const f32x4 kk4 = *(const LAS f32x4*)(kkw + j0), ka4 = *(const LAS f32x4*)(kaw + j0), rk4 = *(const LAS f32x4*)(rkw + j0), w04 = *(const LAS f32x4*)(w0p + j0), a04 = *(const LAS f32x4*)(a0p + j0);
                const f32x4 v04 = *(const LAS f32x4*)(v0p + j0);
                const float rr[4] = {bflo((unsigned)rw), bfhi((unsigned)rw), bflo((unsigned)(rw >> 32)), bfhi((unsigned)(rw >> 32))};
                const float kx[4] = {bflo((unsigned)kw), bfhi((unsigned)kw), bflo((unsigned)(kw >> 32)), bfhi((unsigned)(kw >> 32))};
                const float vx[4] = {bflo((unsigned)vw), bfhi((unsigned)vw), bflo((unsigned)(vw >> 32)), bfhi((unsigned)(vw >> 32))};
                const float fx[4] = {bflo((unsigned)fw), bfhi((unsigned)fw), bflo((unsigned)(fw >> 32)), bfhi((unsigned)(fw >> 32))};
                float d_[4], k2_[4], kk_[4], bp_[4], v_[4];
#pragma unroll
                for (int e = 0; e < 4; ++e) { const int i = 4 * g + e;
                    const float sp = softplus_f(-(wv[i] + w04[e])); const float rate = __expf(-sp - 0.5f); const float d = 1.0f - __expf(-rate);
                    const float a = sigmoid_f(av[i] + a04[e]);
                    float v = vx[e]; if (l > 0) v = v + (fx[e] - v) * sigmoid_f(mvv[i] + v04[e]);
                    const float kk = kx[e] * kk4[e] * rn, k2 = kx[e] * (1.0f + (a - 1.0f) * ka4[e]);
                    d_[e] = d; k2_[e] = k2; kk_[e] = kk; bp_[e] = kk * a; v_[e] = v;
                    bonus += rr[e] * k2 * rk4[e]; }
#define PK4(x) ((unsigned long long)pk2(x[0], x[1]) | ((unsigned long long)pk2(x[2], x[3]) << 32))
                ro[g] = rw; dd[g] = PK4(d_); k2o[g] = PK4(k2_); kko[g] = PK4(kk_); bpo[g] = PK4(bp_); vo[g] = PK4(v_);
                go[g] = (unsigned long long)pk2(gv[4 * g], gv[4 * g + 1]) | ((unsigned long long)pk2(gv[4 * g + 2], gv[4 * g + 3]) << 32); }
#define PR_OUT(arr, bs_, dst) do { _Pragma("unroll") for (int g = 0; g < 4; ++g) *(LAS unsigned long long*)(STG + r32 * 32 + 8 * g + 4 * hi) = arr[g]; \
            _Pragma("unroll") for (int i = 0; i < 2; ++i) { const int row = srow + 16 * i; const unsigned eo = (unsigned)(((tok0 + row) * AW + cb0 + sch * 8) * 2); *(GAS v4u*)(bs_ + dst + eo) = *(const LAS v4u*)(STG + row * 32 + sch * 8); } } while (0)
            PR_OUT(ro, wsb, WS_R); PR_OUT(dd, wsb, WS_D); PR_OUT(k2o, wsb, WS_K2); PR_OUT(kko, wsb, WS_KK); PR_OUT(bpo, outb, OUT_BP); PR_OUT(vo, wsb, WS_VF); PR_OUT(go, outb, OUT_G);
#undef PR_OUT
#undef PK4
        }
        bonus += __shfl_xor(bonus, 32);
        if (hi == 0) ((float*)(F.ws + WS_BON))[(size_t)(tok0 + r32) * 6 + h] = bonus;
    } else {
        const float* kvn = F.in[I_KVN] + l * 128; bf16* C = (bf16*)(F.ws + WS_C);
        for (int q = 0; q < 16; ++q) { const int tok = tok0 + 16 * (wave - 6) + q; const unsigned w = *(const GAS unsigned*)(P + (size_t)tok * PP + PBC + 2 * lane);
            const float c0 = bflo(w), c1 = bfhi(w); const float ss = wave_sum(c0 * c0 + c1 * c1); const float rs = 1.0f / sqrtf(ss * (1.0f / 128.0f) + 1e-6f);
            *(GAS unsigned*)(C + (size_t)tok * 128 + 2 * lane) = pk2(c0 * rs * kvn[2 * lane], c1 * rs * kvn[2 * lane + 1]); }
    }
    DG_STOP(21, dg21_, dga_)
    DG_WRITE(21, unit == 0 && l == 0 && wave == 0 && lane == 0, dga_)
    __syncthreads();
}

__device__ __forceinline__ void final_norm(const Frame& F) {
    const int gw = F.vcu * NWAVES + F.wave, NGW = F.G * NWAVES; const float* g = F.in[I_FN];
    float dgc_ = 0.f;
    if (DIAG_SLOT_D >= 0) { const unsigned* D = (const unsigned*)(F.ws + WS_DIAG); const float x0 = (float)D[0] * (1.0f / (100.0f * DIAG_DIV)); const float gq = 4.0f;
        const float kq = floorf(log2f(fmaxf(x0, 1.0f)) * gq); dgc_ = sqrtf(fmaxf(exp2f((kq + 0.5f) / gq) - 1.0f, 0.01f)); }
    const bf16* XBf = (const bf16*)(F.ws + WS_XB);
    for (int m = gw; m < M; m += NGW) { GAS f32x4* xr = (GAS f32x4*)(F.out + (size_t)m * DM); const GAS v4u* xs = (const GAS v4u*)(XBf + (size_t)m * DM); float v[2][8]; float s = 0.f;
#pragma unroll
        for (int j = 0; j < 2; ++j) { unpack8(xs[F.lane + 64 * j], v[j]);
#pragma unroll
            for (int e = 0; e < 8; ++e) s += v[j][e] * v[j][e]; }
        const float rs = 1.0f / sqrtf(wave_sum(s) * (1.0f / DM) + 1e-6f);
#pragma unroll
        for (int j = 0; j < 2; ++j) { const int c = 8 * (F.lane + 64 * j); const f32x4 g0 = *(const f32x4*)(g + c), g1 = *(const f32x4*)(g + c + 4);
            xr[c / 4] = (DIAG_SLOT_D >= 0) ? (f32x4){dgc_, dgc_, dgc_, dgc_} : (f32x4){v[j][0], v[j][1], v[j][2], v[j][3]} * rs * g0;
            xr[c / 4 + 1] = (DIAG_SLOT_D >= 0) ? (f32x4){dgc_, dgc_, dgc_, dgc_} : (f32x4){v[j][4], v[j][5], v[j][6], v[j][7]} * rs * g1; } }
}

template <class T> __device__ __forceinline__ T* launder_ptr(T* p) {
    unsigned lo = (unsigned)(uintptr_t)p, hi = (unsigned)((uintptr_t)p >> 32);
    asm volatile("" : "+v"(lo), "+v"(hi));
    lo = __builtin_amdgcn_readfirstlane(lo); hi = __builtin_amdgcn_readfirstlane(hi);
    return (T*)(((uintptr_t)hi << 32) | (uintptr_t)lo);
}
constexpr int NPHASE = 20;
constexpr int DUP_PHASE = -1;
constexpr int QDUP = 1;
constexpr int STAG_UP = 4, STAG_IN = 3;
constexpr int REP_SCAN_K = 1, REP_THR_K = 1;
constexpr int NSTEP = NPHASE + (DUP_PHASE >= 0 ? 1 : 0);
constexpr int REP_THR = 1, REP_PTOK = 1, REP_KV = 1, REP_CONV = 1, REP_SCAN = 1, REP_DSA = 1, REP_RET = 1, REP_UP = 1;
#define REPL(n) for (int rep_ = 0; rep_ < (l == 0 ? (n) : 1); ++rep_)
__global__ void __launch_bounds__(NTHR, 2) fwd_kernel(Args args) {
    extern __shared__ __attribute__((aligned(16))) unsigned char lds[];
    Frame F;
    F.lds = (LAS unsigned char*)lds;
    F.tid = threadIdx.x; F.lane = F.tid & 63; F.wave = __builtin_amdgcn_readfirstlane(F.tid >> 6);
    F.G = gridDim.x; { const int bx = blockIdx.x; F.vcu = (F.G % 8 == 0) ? (bx % 8) * (F.G / 8) + bx / 8 : bx; }
    F.in = (const float* const __attribute__((address_space(4)))*)__builtin_amdgcn_kernarg_segment_ptr(); F.out = args.out; F.ws = args.ws;
    volatile LAS unsigned* MISC = (volatile LAS unsigned*)(F.lds + MISC_OFF);
    for (int u = F.tid; u < (LDS_BYTES - LDSCTL_OFF) / 4; u += NTHR) ((LAS unsigned*)(F.lds + LDSCTL_OFF))[u] = 0u;
    __syncthreads();
    const int lo = args.ph_lo, hi = args.ph_hi;
    XcdBarrier bar; bar.bar = (unsigned*)(F.ws + WS_CTL) + CW_BAR; bar.x = 0; bar.st = nullptr;
    if (hi - lo > 1) bar = xcd_barrier_post((unsigned*)(F.ws + WS_CTL) + CW_BAR, MISC + 8);
    for (int ph_ = lo; ph_ < hi; ++ph_) {
        unsigned dgp0_ = 0; if (DIAG_SLOT_D >= 100) dgp0_ = (unsigned)__builtin_amdgcn_s_memtime();
        int ph = (args.dup_phase >= 0 && ph_ > args.dup_phase) ? ph_ - 1 : ph_; asm volatile("" : "+v"(ph)); ph = __builtin_amdgcn_readfirstlane(ph);
#define PH_ENTER() \
        { unsigned z_ = 0u; int t_ = threadIdx.x; asm volatile("" : "+v"(z_), "+v"(t_)); z_ = __builtin_amdgcn_readfirstlane(z_); F.in = (const float* const __attribute__((address_space(4)))*)((const char __attribute__((address_space(4)))*)__builtin_amdgcn_kernarg_segment_ptr() + z_); F.out = args.out + z_; F.ws = args.ws + z_; \
          F.tid = t_; F.lane = t_ & 63; F.wave = __builtin_amdgcn_readfirstlane(t_ >> 6); } \
        int bx = blockIdx.x; { int g_ = gridDim.x; asm volatile("" : "+v"(bx), "+v"(g_)); bx = __builtin_amdgcn_readfirstlane(bx); g_ = __builtin_amdgcn_readfirstlane(g_); F.G = g_; F.vcu = (g_ % 8 == 0) ? (bx % 8) * (g_ / 8) + bx / 8 : bx; } \
        gu32* ctl = (gu32*)(F.ws + WS_CTL); (void)ctl; \
        bf16* XB = (bf16*)(F.ws + WS_XB); bf16* Hb = (bf16*)(F.ws + WS_H); bf16* Pb = (bf16*)(F.ws + WS_P); float* part = (float*)(F.ws + WS_PART); (void)XB; (void)Hb; (void)Pb; (void)part;
        if (ph == 0) { PH_ENTER();
            if (DIAG_SLOT_D >= 0 && bx == 0 && threadIdx.x == 0) { ((unsigned*)(args.ws + WS_DIAG))[0] = 0u; ((unsigned*)(args.ws + WS_DIAG))[1] = 0u; }
            conv_weights(F, 0, 0, 3);
            p0_x(F); p0_table(F); small_weights(F);
        } else if (ph == NPHASE - 1) { PH_ENTER();
            final_norm(F);
        } else {
            const int l = (ph - 1) / 9, sub = (ph - 1) - 9 * l;
            if (sub == 0 || sub == 7) { PH_ENTER();
                pg8::Gemm g{XB, (const bf16*)(F.ws + (sub == 0 ? WS_WGU1 : WS_WGU2)), M, NGU, DM, DM}; pg8::StaticOrder S; S.init(M, NGU, F.G, bx);
                pg8::EpiUp E{Hb, FFP, part};
                if (bx >= S.nwg % F.G) for (int i = 0; i < args.stag_up; ++i) __builtin_amdgcn_s_sleep(127);
                for (int rep = 0; rep < ((l == 0 && sub == 0) ? REP_UP : 1); ++rep) pg8::gemm_phase<pg8::EpiUp, pg8::StaticOrder, true>(F.lds, g, S, E, F.tid);
            } else if (sub == 1 || sub == 8 || sub == 6) { PH_ENTER();
                const bool op = (sub == 6);
                pg8::Gemm g{op ? Pb : Hb, (const bf16*)(F.ws + (op ? WS_WOUT : (sub == 1 ? WS_WD1 : WS_WD2))), M, DM, op ? DM : FFP, op ? PP : FFP}; pg8::StaticOrder S; S.init(M, DM, F.G, bx);
                const float* base = (l == 0 && sub == 1) ? F.in[I_X] : nullptr;
                pg8::EpiRes E{base, XB, part};
                pg8::gemm_phase<pg8::EpiRes, pg8::StaticOrder, false>(F.lds, g, S, E, F.tid);
            } else if (sub == 2) { PH_ENTER();
                pg8::Gemm g{XB, (const bf16*)(F.ws + WS_WIN), M, PP, DM, DM}; pg8::StaticOrder S; S.init(M, PP, F.G, bx);
                pg8::EpiP E{Pb, PP, part};
                if (bx >= S.nwg % F.G) for (int i = 0; i < args.stag_in; ++i) __builtin_amdgcn_s_sleep(127);
                pg8::gemm_phase<pg8::EpiP, pg8::StaticOrder, true>(F.lds, g, S, E, F.tid);
            } else if (sub == 3) { PH_ENTER();
                for (int rep_ = 0; rep_ < (l == 0 ? args.rep_thr : 1); ++rep_)
                    for (int k = 0, u0 = F.vcu; u0 < M / 16; ++k, u0 += F.G) {
                        const int base = k * F.G, span = (M / 16 - base) < F.G ? (M / 16 - base) : F.G; const int u = (k & 1) ? base + span - 1 - F.vcu : u0;
                        if (u >= base && u < M / 16) dsa_thr_unit(F, u); }
                prep_consts(F, l);
                REPL(REP_PTOK) for (int u = F.vcu; u < M / PT; u += F.G) prep_tokens_unit(F, l, u);

            } else if (sub == 5) { PH_ENTER();
                rwkv_post(F, l);
            } else if (sub == 4) { PH_ENTER();
                unsigned dgm_ = 0; if (DIAG_SLOT_D >= 50 && DIAG_SLOT_D < 60) dgm_ = (unsigned)__builtin_amdgcn_s_memtime();
                if (bx < BATCH * 6) { for (int rep_ = 0; rep_ < (l == 0 ? args.rep_scan : 1); ++rep_) { rwkv_chunk_unit(F, l, bx); __syncthreads(); } }
                if (DIAG_SLOT_D == 54 && l == 0 && bx < BATCH * 6 && threadIdx.x == 0) atomicMax((unsigned*)(args.ws + WS_DIAG), (unsigned)__builtin_amdgcn_s_memtime() - dgm_);
                if (DIAG_SLOT_D == 50 && l == 0 && bx == 0 && threadIdx.x == 0) ((unsigned*)(args.ws + WS_DIAG))[0] = (unsigned)__builtin_amdgcn_s_memtime() - dgm_;
                if (!(DIAG_SLOT_D >= 70 && DIAG_SLOT_D < 80)) {
                    gu32* qh = ctl + CW_QUEUE + 64 * l;
                    for (;;) {
                        if (F.tid == 0) MISC[0] = __hip_atomic_fetch_add(qh, 1u, RLX_AGENT);
                        __syncthreads();
                        const int u = (int)MISC[0];
                        __syncthreads();
                        const int nd = (l == 0 ? args.qdup : 1) * (M / 32);
                        { unsigned z_ = 0u; int t_ = threadIdx.x; asm volatile("" : "+v"(z_), "+v"(t_)); z_ = __builtin_amdgcn_readfirstlane(z_); F.ws = args.ws + z_; F.tid = t_; F.lane = t_ & 63; F.wave = __builtin_amdgcn_readfirstlane(t_ >> 6); }
                        const int ncv = (conv_flat_items(l + 1 < DEPTH) + NWAVES * CONV_PER_WAVE - 1) / (NWAVES * CONV_PER_WAVE);
                        if (DIAG_SLOT_D == 53 && l == 0 && bx == 200 && threadIdx.x == 0 && u >= BATCH * 4 + nd) { unsigned* D_ = (unsigned*)(args.ws + WS_DIAG); if (D_[1] != 0x600Du) { D_[1] = 0x600Du; D_[0] = (unsigned)__builtin_amdgcn_s_memtime() - dgm_; } }
                        if (u >= nd + BATCH * 4 + ncv) { if (DIAG_SLOT_D == 51 && l == 0 && bx == 0 && threadIdx.x == 0) ((unsigned*)(args.ws + WS_DIAG))[0] = (unsigned)__builtin_amdgcn_s_memtime() - dgm_;
                            if (DIAG_SLOT_D == 52 && l == 0 && bx == 200 && threadIdx.x == 0) ((unsigned*)(args.ws + WS_DIAG))[0] = (unsigned)__builtin_amdgcn_s_memtime() - dgm_; }
                        if (DIAG_SLOT_D == 55 && l == 0 && u >= nd + BATCH * 4 + ncv && threadIdx.x == 0) atomicMax((unsigned*)(args.ws + WS_DIAG), (unsigned)__builtin_amdgcn_s_memtime() - dgm_);
                        if (DIAG_SLOT_D == 56 && l == 0 && u >= BATCH * 4 && u < nd + BATCH * 4 && threadIdx.x == 0) atomicMax((unsigned*)(args.ws + WS_DIAG), (unsigned)__builtin_amdgcn_s_memtime() - dgm_);
                        if (u >= nd + BATCH * 4 + ncv) break;
                        if (u < BATCH * 4) ret_out_unit(F, u);
                        else if (u < nd + BATCH * 4) dsa_attn_unit(F, l, (u - BATCH * 4) % (M / 32));
                        else { conv_unit(F, l, u - nd - BATCH * 4); __syncthreads(); }
                    }
                }
            }
        }
        if (ph_ + 1 < hi) xcd_barrier(bar);
        if (DIAG_SLOT_D >= 100 && ph_ == DIAG_SLOT_D - 100 && blockIdx.x == 0 && threadIdx.x == 0) ((unsigned*)(args.ws + WS_DIAG))[0] = (unsigned)__builtin_amdgcn_s_memtime() - dgp0_;
    }
}

extern "C" void kernel_launch(void* const* d_in, const int* in_sizes, int n_in, void* d_out, int out_size, void* d_ws, size_t ws_size, hipStream_t stream) {
    static int grid = 0;
    if (grid == 0) {
        if (n_in != 31 || out_size != M * DM || ws_size < WS_END) { fprintf(stderr, "kernel_launch: unexpected shapes (n_in %d, out %d, ws %zu)\n", n_in, out_size, ws_size); grid = -1; return; }
        int dev = 0, cus = 0, per_cu = 0;
        if (hipGetDevice(&dev) != hipSuccess || hipDeviceGetAttribute(&cus, hipDeviceAttributeMultiprocessorCount, dev) != hipSuccess) { grid = -1; return; }
        if (hipFuncSetAttribute((const void*)fwd_kernel, hipFuncAttributeMaxDynamicSharedMemorySize, LDS_BYTES) != hipSuccess) { fprintf(stderr, "kernel_launch: hipFuncSetAttribute failed\n"); grid = -1; return; }
        if (hipOccupancyMaxActiveBlocksPerMultiprocessor(&per_cu, (const void*)fwd_kernel, NTHR, LDS_BYTES) != hipSuccess || per_cu < 1) fprintf(stderr, "kernel_launch: occupancy query says %d\n", per_cu);
        (void)hipGetLastError();
        grid = cus;
    }
    if (grid < 0) return;
    if (hipMemsetAsync((char*)d_ws + WS_CTL, 0, CTL_ZERO_BYTES, stream) != hipSuccess) return;
    Args a{};
    for (int i = 0; i < 31; ++i) a.in[i] = (const float*)d_in[i];
    a.out = (float*)d_out; a.ws = (unsigned char*)d_ws; a.dup_phase = DUP_PHASE; a.qdup = QDUP; a.rep_scan = REP_SCAN_K; a.rep_thr = REP_THR_K; a.stag_up = STAG_UP; a.stag_in = STAG_IN;
#ifndef ONE_LAUNCH
#define ONE_LAUNCH 1
#endif
    if (ONE_LAUNCH) { a.ph_lo = 0; a.ph_hi = NSTEP; hipLaunchKernelGGL(fwd_kernel, dim3(grid), dim3(NTHR), LDS_BYTES, stream, a); }
    else for (int ph = 0; ph < NPHASE; ++ph) { a.ph_lo = ph; a.ph_hi = ph + 1; hipLaunchKernelGGL(fwd_kernel, dim3(grid), dim3(NTHR), LDS_BYTES, stream, a); }
}
```

```cpp
#include <hip/hip_runtime.h>
#include <cstdio>
#include <cstdint>
#include <cmath>

namespace pg8 {
#define PG8_LAS __attribute__((address_space(3)))
typedef unsigned short bf16_t;
typedef short bf16x8 __attribute__((ext_vector_type(8)));
typedef float f32x4 __attribute__((ext_vector_type(4)));
typedef unsigned u32x4 __attribute__((ext_vector_type(4)));
constexpr int BM = 256, BK = 64, HALF = 128, HTB = HALF * BK * 2  , STAGE_BYTES = 8 * HTB, NXCD = 8, WGM = 8;

__host__ __device__ __forceinline__ int lds_byte(int r, int c) { const int st = (r >> 4) * 2 + (c >> 5), rr = r & 15, cc = c & 31, ob = rr * 64 + cc * 2; return st * 1024 + (ob ^ (((ob >> 9) & 1) << 5)); }
__host__ __device__ __forceinline__ void stage_rc(int b, int& R, int& C) { const int st = b / 1024, sb = b % 1024, swz = sb ^ (((sb >> 9) & 1) << 5); R = (st >> 1) * 16 + swz / 64; C = (st & 1) * 32 + (swz % 64) / 2; }
__host__ __device__ __forceinline__ int perm32(int rho) { const int n = rho >> 4, i = rho & 15; return 8 * (i >> 2) + 4 * n + (i & 3); }

struct Unit { int pm, pn; };
struct Gemm { const bf16_t* A; const bf16_t* Bt; int M, N, K, lda; };

struct StaticOrder {
    int nM, nN, nwg, G, c;
    __host__ __device__ void init(int M, int N, int G_, int c_) { nM = M / BM; nN = N / BM; nwg = nM * nN; G = G_; c = c_; }
    __host__ __device__ bool next(int i, Unit& u) const {
        const long L = (long)i * G + c; if (L >= nwg) return false;
        int wgid = (int)L; { const int q = nwg / NXCD, r = nwg % NXCD, xcd = wgid % NXCD, off = wgid / NXCD; wgid = (xcd < r ? xcd * (q + 1) : r * (q + 1) + (xcd - r) * q) + off; }
        const int nig = WGM * nN, gid = wgid / nig, fm = gid * WGM, gsz = (nM - fm) < WGM ? (nM - fm) : WGM;
        u.pm = fm + ((wgid % nig) % gsz); u.pn = (wgid % nig) / gsz; return true;
    }
    __device__ __forceinline__ void a_ready(const Unit&) const {}
    __device__ __forceinline__ void done(const Unit&) const {}
};

__device__ __forceinline__ unsigned cvt_pk_bf16(float lo, float hi) { unsigned r; asm volatile("v_cvt_pk_bf16_f32 %0, %1, %2" : "=v"(r) : "v"(lo), "v"(hi)); return r; }


__device__ __forceinline__ float row_rstd(const float* part, int row) {
    const f32x4* p = (const f32x4*)(part + (size_t)row * 16);
    const f32x4 a = p[0], b = p[1], c = p[2], d = p[3];
    const float s = ((a[0] + a[1]) + (a[2] + a[3])) + ((b[0] + b[1]) + (b[2] + b[3])) + ((c[0] + c[1]) + (c[2] + c[3])) + ((d[0] + d[1]) + (d[2] + d[3]));
    return 1.0f / sqrtf(s * (1.0f / 1024.0f) + 1e-6f);
}
__device__ __forceinline__ float silu_f(float x) { return x * __builtin_amdgcn_rcpf(1.0f + __expf(-x)); }

struct EpiUp {
    static constexpr bool PERM = true;
    bf16_t* H; int ldh; const float* part;
    __device__ __forceinline__ void operator()(const f32x4 (&acc)[2][2][4][2], const Unit& u, int wr, int wc, int fr, int fq) const {
        const int row0 = u.pm * BM + wr * 64 + fr, hcol = u.pn * 128 + wc * 32 + 8 * fq;
#pragma unroll
        for (int ai = 0; ai < 2; ++ai)
#pragma unroll
            for (int m = 0; m < 4; ++m) { const int row = row0 + ai * HALF + m * 16; const float rs = row_rstd(part, row);
                const f32x4 g0 = acc[ai][0][m][0] * rs, g1 = acc[ai][0][m][1] * rs, u0 = acc[ai][1][m][0] * rs, u1 = acc[ai][1][m][1] * rs;
                u32x4 w; w.x = cvt_pk_bf16(silu_f(g0[0]) * u0[0], silu_f(g0[1]) * u0[1]); w.y = cvt_pk_bf16(silu_f(g0[2]) * u0[2], silu_f(g0[3]) * u0[3]);
                w.z = cvt_pk_bf16(silu_f(g1[0]) * u1[0], silu_f(g1[1]) * u1[1]); w.w = cvt_pk_bf16(silu_f(g1[2]) * u1[2], silu_f(g1[3]) * u1[3]);
                *(u32x4*)(H + (size_t)row * ldh + hcol) = w; }
    }
};
struct EpiP {
    static constexpr bool PERM = true;
    bf16_t* P; int ldp; const float* part;
    __device__ __forceinline__ void operator()(const f32x4 (&acc)[2][2][4][2], const Unit& u, int wr, int wc, int fr, int fq) const {
        const int row0 = u.pm * BM + wr * 64 + fr, col0 = u.pn * BM + wc * 32 + 8 * fq;
#pragma unroll
        for (int ai = 0; ai < 2; ++ai)
#pragma unroll
            for (int m = 0; m < 4; ++m) { const int row = row0 + ai * HALF + m * 16; const float rs = row_rstd(part, row);
#pragma unroll
                for (int bj = 0; bj < 2; ++bj) { const f32x4 v0 = acc[ai][bj][m][0] * rs, v1 = acc[ai][bj][m][1] * rs;
                    u32x4 w; w.x = cvt_pk_bf16(v0[0], v0[1]); w.y = cvt_pk_bf16(v0[2], v0[3]); w.z = cvt_pk_bf16(v1[0], v1[1]); w.w = cvt_pk_bf16(v1[2], v1[3]);
                    *(u32x4*)(P + (size_t)row * ldp + col0 + bj * HALF) = w; } }
    }
};
struct EpiRes {
    static constexpr bool PERM = true;
    const float* base; bf16_t* xb; float* part;
    __device__ __forceinline__ void operator()(const f32x4 (&acc)[2][2][4][2], const Unit& u, int wr, int wc, int fr, int fq) const {
        const int row0 = u.pm * BM + wr * 64 + fr, col0 = u.pn * BM + wc * 32 + 8 * fq;
#pragma unroll
        for (int ai = 0; ai < 2; ++ai)
#pragma unroll
            for (int m = 0; m < 4; ++m) { const int row = row0 + ai * HALF + m * 16; float ss = 0.f;
#pragma unroll
                for (int bj = 0; bj < 2; ++bj) { const size_t off = (size_t)row * 1024 + col0 + bj * HALF;
                    f32x4 v0, v1;
                    if (base) { v0 = *(const f32x4*)(base + off); v1 = *(const f32x4*)(base + off + 4); }
                    else { const u32x4 xw = *(const u32x4*)(xb + off);
                        v0 = (f32x4){__builtin_bit_cast(float, xw.x << 16), __builtin_bit_cast(float, xw.x & 0xffff0000u), __builtin_bit_cast(float, xw.y << 16), __builtin_bit_cast(float, xw.y & 0xffff0000u)};
                        v1 = (f32x4){__builtin_bit_cast(float, xw.z << 16), __builtin_bit_cast(float, xw.z & 0xffff0000u), __builtin_bit_cast(float, xw.w << 16), __builtin_bit_cast(float, xw.w & 0xffff0000u)}; }
                    v0 += acc[ai][bj][m][0]; v1 += acc[ai][bj][m][1];
                    u32x4 w; w.x = cvt_pk_bf16(v0[0], v0[1]); w.y = cvt_pk_bf16(v0[2], v0[3]); w.z = cvt_pk_bf16(v1[0], v1[1]); w.w = cvt_pk_bf16(v1[2], v1[3]);
                    *(u32x4*)(xb + off) = w;
                    ss += (v0[0] * v0[0] + v0[1] * v0[1]) + (v0[2] * v0[2] + v0[3] * v0[3]) + (v1[0] * v1[0] + v1[1] * v1[1]) + (v1[2] * v1[2] + v1[3] * v1[3]); }
                ss += __shfl_xor(ss, 16); ss += __shfl_xor(ss, 32);
                if (fq == 0) part[(size_t)row * 16 + u.pn * 4 + wc] = ss;
                asm volatile("" ::: "memory"); }
    }
};

template <class Epi, class Sched, bool ALIGN_EPI>
__device__ __forceinline__ void gemm_phase(PG8_LAS unsigned char* lds, const Gemm g, const Sched& S, const Epi& E, const int tid) {
    const int wid = __builtin_amdgcn_readfirstlane(tid >> 6), lane = tid & 63, wr = wid >> 2, wc = wid & 3, fr = lane & 15, fq = lane >> 4;
    const int K = g.K, nt = K / BK, lda = g.lda;
    unsigned voffA[2], voffB[2];
#pragma unroll
    for (int i = 0; i < 2; ++i) { int R, C; stage_rc(tid * 16 + i * 8192, R, C); const int Rb = Epi::PERM ? ((R & ~31) + perm32(R & 31)) : R;
        voffA[i] = (unsigned)(R * lda + C) * 2u; voffB[i] = (unsigned)(Rb * K + C) * 2u; }
    const size_t kstep = (size_t)(BK * 2);
    const size_t hstepA = (size_t)HALF * lda * 2, hstepB = (size_t)HALF * K * 2;
    const size_t tstepA = 2 * hstepA, tstepB = 2 * hstepB;
    const unsigned ldsw = (unsigned)wid * 1024u;
    const int aoff = lds_byte(wr * 64 + fr, fq * 8), boff = lds_byte(wc * 32 + fr, fq * 8);
#define PG8_SA(b, h) (((b) * 2 + (h)) * HTB)
#define PG8_SB(b, h) ((4 + (b) * 2 + (h)) * HTB)
#define PG8_STAGE(bufoff, gbase, voff) do { _Pragma("unroll") for (int _i = 0; _i < 2; ++_i) \
        __builtin_amdgcn_global_load_lds((const unsigned*)((const char*)(gbase) + (voff)[_i]), (PG8_LAS unsigned*)(lds + (bufoff) + ldsw + _i * 8192), 16, 0, 0); } while (0)
#define PG8_LDA(dst, b, h) do { _Pragma("unroll") for (int m = 0; m < 4; ++m) _Pragma("unroll") for (int k = 0; k < 2; ++k) dst[m][k] = *(const PG8_LAS bf16x8*)(lds + PG8_SA(b, h) + aoff + m * 2048 + k * 1024); } while (0)
#define PG8_LDB(dst, b, h) do { _Pragma("unroll") for (int n = 0; n < 2; ++n) _Pragma("unroll") for (int k = 0; k < 2; ++k) dst[n][k] = *(const PG8_LAS bf16x8*)(lds + PG8_SB(b, h) + boff + n * 2048 + k * 1024); } while (0)
#define PG8_MMA(ai, bj, At, Bt) do { __builtin_amdgcn_s_setprio(1); _Pragma("unroll") for (int m = 0; m < 4; ++m) _Pragma("unroll") for (int n = 0; n < 2; ++n) _Pragma("unroll") for (int k = 0; k < 2; ++k) \
        acc[ai][bj][m][n] = __builtin_amdgcn_mfma_f32_16x16x32_bf16(Bt[n][k], At[m][k], acc[ai][bj][m][n], 0, 0, 0); __builtin_amdgcn_s_setprio(0); } while (0)
#define PG8_WAIT_V(n) asm volatile("s_waitcnt vmcnt(" #n ")" ::: "memory")
#define PG8_WAIT_L(n) asm volatile("s_waitcnt lgkmcnt(" #n ")" ::: "memory")
#define PG8_BAR __builtin_amdgcn_s_barrier()
#define PG8_SCHED __builtin_amdgcn_sched_barrier(0)
    Unit cur, nxt; int ui = 0;
    if (!S.next(0, cur)) return;
    f32x4 acc[2][2][4][2];
#pragma unroll
    for (int a = 0; a < 2; ++a)
#pragma unroll
        for (int b = 0; b < 2; ++b)
#pragma unroll
            for (int m = 0; m < 4; ++m)
#pragma unroll
                for (int n = 0; n < 2; ++n) acc[a][b][m][n] = (f32x4){0.f, 0.f, 0.f, 0.f};
    bf16x8 At[4][2], B0[2][2], B1[2][2];
    const char* cA = (const char*)g.A + (size_t)cur.pm * tstepA; const char* cB = (const char*)g.Bt + (size_t)cur.pn * tstepB;
    S.a_ready(cur);
    PG8_STAGE(PG8_SB(0, 0), cB, voffB); PG8_STAGE(PG8_SB(0, 1), cB + hstepB, voffB); PG8_STAGE(PG8_SA(0, 0), cA, voffA); PG8_STAGE(PG8_SA(0, 1), cA + hstepA, voffA);
    if (wr == 1) PG8_BAR;
    PG8_WAIT_V(2); PG8_BAR;
    PG8_STAGE(PG8_SB(1, 0), cB + kstep, voffB); PG8_STAGE(PG8_SA(1, 0), cA + kstep, voffA); PG8_STAGE(PG8_SB(1, 1), cB + hstepB + kstep, voffB);
    PG8_WAIT_V(6); PG8_BAR;
    for (;;) {
        const bool has_next = S.next(ui + 1, nxt);
        const char* nA = has_next ? (const char*)g.A + (size_t)nxt.pm * tstepA : cA; const char* nB = has_next ? (const char*)g.Bt + (size_t)nxt.pn * tstepB : cB;
        for (int t = 0; t < nt; t += 2) {
            const bool last = (t == nt - 2);
            const char* a1 = cA + (size_t)(t + 1) * kstep;
            const char* a2 = last ? nA : cA + (size_t)(t + 2) * kstep; const char* b2 = last ? nB : cB + (size_t)(t + 2) * kstep;
            const char* a3 = a2 + kstep; const char* b3 = b2 + kstep;
            if (last && has_next) S.a_ready(nxt);
            PG8_LDB(B0, 0, 0); PG8_LDB(B1, 0, 1); PG8_SCHED; PG8_LDA(At, 0, 0); PG8_STAGE(PG8_SA(1, 1), a1 + hstepA, voffA);
            PG8_WAIT_V(8); PG8_WAIT_L(0); PG8_BAR; PG8_MMA(0, 0, At, B0); PG8_MMA(0, 1, At, B1); PG8_BAR; PG8_SCHED;
            PG8_LDA(At, 0, 1); PG8_STAGE(PG8_SB(0, 0), b2, voffB); PG8_STAGE(PG8_SB(0, 1), b2 + hstepB, voffB); PG8_STAGE(PG8_SA(0, 0), a2, voffA);
            PG8_WAIT_V(8); PG8_WAIT_L(0); PG8_BAR; PG8_MMA(1, 0, At, B0); PG8_MMA(1, 1, At, B1); PG8_BAR; PG8_SCHED;
            PG8_LDB(B0, 1, 0); PG8_LDB(B1, 1, 1); PG8_SCHED; PG8_LDA(At, 1, 0); PG8_STAGE(PG8_SA(0, 1), a2 + hstepA, voffA);
            PG8_WAIT_V(8); PG8_WAIT_L(0); PG8_BAR; PG8_MMA(0, 0, At, B0); PG8_MMA(0, 1, At, B1); PG8_BAR; PG8_SCHED;
            PG8_LDA(At, 1, 1); PG8_STAGE(PG8_SB(1, 0), b3, voffB); PG8_STAGE(PG8_SB(1, 1), b3 + hstepB, voffB); PG8_STAGE(PG8_SA(1, 0), a3, voffA);
            PG8_WAIT_V(8); PG8_WAIT_L(0); PG8_BAR; PG8_MMA(1, 0, At, B0); PG8_MMA(1, 1, At, B1); PG8_BAR; PG8_SCHED;
        }
        if constexpr (ALIGN_EPI) { if (wr == 0) PG8_BAR; }
        E(acc, cur, wr, wc, fr, fq); S.done(cur);
        if (!has_next) break;
#pragma unroll
        for (int a = 0; a < 2; ++a)
#pragma unroll
            for (int b = 0; b < 2; ++b)
#pragma unroll
                for (int m = 0; m < 4; ++m)
#pragma unroll
                    for (int n = 0; n < 2; ++n) acc[a][b][m][n] = (f32x4){0.f, 0.f, 0.f, 0.f};
        cur = nxt; cA = nA; cB = nB; ++ui;
        if constexpr (ALIGN_EPI) { if (wr == 1) PG8_BAR; }
    }
    PG8_WAIT_V(0);
    if constexpr (!ALIGN_EPI) { if (wr == 0) PG8_BAR; }
    PG8_BAR;
#undef PG8_SA
#undef PG8_SB
#undef PG8_STAGE
#undef PG8_LDA
#undef PG8_LDB
#undef PG8_MMA
#undef PG8_WAIT_V
#undef PG8_WAIT_L
#undef PG8_BAR
#undef PG8_SCHED
}
}

constexpr int NWAVES = 8, NTHR = 512;
constexpr int BATCH = 8, SEQ = 2048, DM = 1024, DEPTH = 2, FF = 2752, M = BATCH * SEQ;
constexpr int FFP = 2816;
constexpr int NGU = 5632;
constexpr int PP = 3584;
constexpr int NIN = 3400;
constexpr int PA = 0, PMV = 1280, PBQ = 1296, PBC = 1680, PBIQ = 1808, PBIK = 2320, PBIW = 2384, PCQ = 2392, PCK = 2648, PCV = 2904, PCG = 3160, PUSED = 3416;
constexpr int AW = 384;
constexpr int TOPK = 256;

constexpr size_t MiB = 1u << 20;
constexpr size_t WS_CTL = 0, CTL_ZERO_BYTES = 1 * MiB;
constexpr size_t WS_PART = 1 * MiB;
constexpr size_t WS_TAB = 2 * MiB;
constexpr size_t WS_BON = 2 * MiB + 512 * 1024;
constexpr size_t WS_WUKT = 3 * MiB, WS_WUVT = 3 * MiB + 192 * 1024;
constexpr size_t WS_THR = 3 * MiB + 384 * 1024, WS_SCUT = 3 * MiB + 448 * 1024;
constexpr size_t WS_LORA = 3 * MiB + 512 * 1024;
constexpr size_t WS_WGU1 = 4 * MiB, WS_WD1 = 15 * MiB, WS_WIN = 21 * MiB, WS_WOUT = 28 * MiB, WS_WGU2 = 30 * MiB, WS_WD2 = 41 * MiB;
constexpr size_t WS_XB = 47 * MiB;
constexpr size_t WS_VF = 79 * MiB;
constexpr size_t WS_P = 91 * MiB;
constexpr size_t WS_H = WS_P;
constexpr size_t WS_R = 203 * MiB, WS_D = 215 * MiB, WS_K2 = 227 * MiB, WS_KK = 239 * MiB, WS_C = 251 * MiB;
constexpr size_t WS_KV = WS_XB + 24 * MiB;
constexpr size_t OUT_BP = 0, OUT_G = 12 * MiB, OUT_MASK = 24 * MiB;
constexpr size_t WS_END = 256 * MiB;
static_assert(WS_WD2 + (size_t)1024 * FFP * 2 <= WS_XB && WS_P + (size_t)M * PP * 2 <= WS_R && WS_C + (size_t)M * 128 * 2 <= WS_END, "ws map");
constexpr int CW_BAR = 4096;
constexpr int CW_QUEUE = 16384;
constexpr int CW_THRD = 20480;

constexpr int RING_BYTES = 131072;
constexpr int LDSCTL_OFF = RING_BYTES, MISC_OFF = LDSCTL_OFF + 320;
constexpr int LDS_BYTES = 147456;

#define GAS __attribute__((address_space(1)))
#define LAS __attribute__((address_space(3)))
typedef unsigned short bf16;
typedef unsigned v4u __attribute__((ext_vector_type(4)));
typedef float f32x4 __attribute__((ext_vector_type(4)));
typedef GAS unsigned gu32;
#define RLX_AGENT __ATOMIC_RELAXED, __HIP_MEMORY_SCOPE_AGENT
#define LDS_WAIT() asm volatile("s_waitcnt lgkmcnt(0)" ::: "memory")
__device__ __forceinline__ unsigned f2bf(float f) { unsigned u = __builtin_bit_cast(unsigned, f); return (u + 0x7fffu + ((u >> 16) & 1u)) >> 16; }
typedef float f32x2v_ __attribute__((ext_vector_type(2))); typedef __bf16 bf16x2v_ __attribute__((ext_vector_type(2)));
__device__ __forceinline__ unsigned pk2(float lo, float hi) { const f32x2v_ v = {lo, hi}; return __builtin_bit_cast(unsigned, __builtin_convertvector(v, bf16x2v_)); }
__device__ __forceinline__ float bf2f(unsigned short v) { return __uint_as_float((unsigned)v << 16); }
__device__ __forceinline__ float bflo(unsigned w) { return __uint_as_float(w << 16); }
__device__ __forceinline__ float bfhi(unsigned w) { return __uint_as_float(w & 0xffff0000u); }
__device__ __forceinline__ void unpack8(const v4u w, float (&f)[8]) { f[0] = bflo(w.x); f[1] = bfhi(w.x); f[2] = bflo(w.y); f[3] = bfhi(w.y); f[4] = bflo(w.z); f[5] = bfhi(w.z); f[6] = bflo(w.w); f[7] = bfhi(w.w); }
__device__ __forceinline__ float sigmoid_f(float x) { return 1.0f / (1.0f + __expf(-x)); }
__device__ __forceinline__ float wave_sum(float v) {
#pragma unroll
    for (int o = 1; o < 64; o <<= 1) v += __shfl_xor(v, o);
    return v;
}

#define XB_TMO      128
#define XB_XCNT(j)  (256  + 64 * (j))
#define XB_XSUB(j)  (1280 + 64 * (j))
#define XB_XGEN(j)  (2304 + 64 * (j))
#define XB_TOP      3328
#define XB_TOPGEN   3392
#define XCD_BAR_WORDS 3456
#define XB_SPIN_CAP (1u << 22)

__device__ __forceinline__ unsigned xb_ld(unsigned* p)              { return __hip_atomic_load(p, __ATOMIC_RELAXED, __HIP_MEMORY_SCOPE_AGENT); }
__device__ __forceinline__ unsigned xb_add(unsigned* p, unsigned v) { return __hip_atomic_fetch_add(p, v, __ATOMIC_RELAXED, __HIP_MEMORY_SCOPE_AGENT); }
__device__ __forceinline__ unsigned xb_xcc_id() { return (unsigned)__builtin_amdgcn_s_getreg((3 << 11) | 20) & 0xFu; }
#define XB_SPIN(cond, bar) do { unsigned _sp = 0; while (cond) { __builtin_amdgcn_s_sleep(1); \
    if ((++_sp & 255u) == 0u) { if (xb_ld(&(bar)[XB_TMO])) break; if (_sp > XB_SPIN_CAP) { atomicAdd(&(bar)[XB_TMO], 1u); break; } } } } while (0)

struct XcdBarrier { unsigned* bar; unsigned x; volatile LAS unsigned* st; };

__device__ __forceinline__ XcdBarrier xcd_barrier_post(unsigned* bar, volatile LAS unsigned* st) {
    XcdBarrier b; b.bar = bar; b.x = xb_xcc_id(); b.st = st;
    if (threadIdx.x == 0) (void)xb_add(&bar[XB_XCNT(b.x)], 1u);
    return b;
}
__device__ __forceinline__ void xcd_barrier_complete(unsigned* bar, unsigned x, unsigned& nloc, unsigned& nx) {
    const unsigned G = gridDim.x * gridDim.y * gridDim.z;
    unsigned sum, cnt, mine, sp = 0u;
    for (;;) {
        sum = 0u; cnt = 0u; mine = 0u;
#pragma unroll
        for (unsigned j = 0; j < 16; ++j) { const unsigned c = xb_ld(&bar[XB_XCNT(j)]); sum += c; cnt += (c > 0u) ? 1u : 0u; mine = (j == x) ? c : mine; }
        if (sum == G) break;
        __builtin_amdgcn_s_sleep(1);
        if ((++sp & 255u) == 0u) { if (xb_ld(&bar[XB_TMO])) break; if (sp > XB_SPIN_CAP) { atomicAdd(&bar[XB_TMO], 1u); break; } }
    }
    nloc = mine > 0u ? mine : 1u; nx = cnt > 0u ? cnt : 1u;
}
__device__ __forceinline__ void xcd_barrier(const XcdBarrier& b) {
    asm volatile("s_waitcnt vmcnt(0)" ::: "memory");
    __syncthreads();
    if (threadIdx.x == 0) {
        unsigned* bar = b.bar;
        __builtin_amdgcn_s_waitcnt(0);
        unsigned nloc = b.st[0], nx = b.st[1];
        if (nloc == 0u) { xcd_barrier_complete(bar, b.x, nloc, nx); b.st[0] = nloc; b.st[1] = nx; }
        const unsigned old = xb_add(&bar[XB_XSUB(b.x)], 1u);
        const unsigned gen = old / nloc;
        if (old + 1u == (gen + 1u) * nloc) {
            __builtin_amdgcn_fence(__ATOMIC_RELEASE, "agent");
            asm volatile("s_waitcnt vmcnt(0)" ::: "memory");
            const unsigned og = xb_add(&bar[XB_TOP], 1u);
            const unsigned tg = og / nx;
            if (og + 1u == (tg + 1u) * nx) xb_add(&bar[XB_TOPGEN], 1u);
            else XB_SPIN(xb_ld(&bar[XB_TOPGEN]) == tg, bar);
            __builtin_amdgcn_fence(__ATOMIC_ACQUIRE, "agent");
            xb_add(&bar[XB_XGEN(b.x)], 1u);
            asm volatile("s_waitcnt vmcnt(0)" ::: "memory");
        } else {
            XB_SPIN(xb_ld(&bar[XB_XGEN(b.x)]) == gen, bar);
            __builtin_amdgcn_fence(__ATOMIC_ACQUIRE, "agent");
            asm volatile("s_waitcnt vmcnt(0)" ::: "memory");
        }
    }
    __syncthreads();
}

#ifndef DIAG_SLOT_D
#define DIAG_SLOT_D (-1)
#endif
#ifndef DIAG_DIV
#define DIAG_DIV 1.0f
#endif
constexpr size_t WS_DIAG = 3 * MiB + 900 * 1024;
#define DG_START(k, var) unsigned var = 0; if (DIAG_SLOT_D == (k)) var = (unsigned)__builtin_amdgcn_s_memtime();
#define DG_STOP(k, var, acc) if (DIAG_SLOT_D == (k)) acc += (unsigned)__builtin_amdgcn_s_memtime() - var;
#define DG_WRITE(k, cond, acc) if (DIAG_SLOT_D == (k) && (cond)) ((unsigned*)(F.ws + WS_DIAG))[0] = acc;
struct Args { const float* in[31]; float* out; unsigned char* ws; int ph_lo, ph_hi; int dup_phase, qdup, rep_scan, rep_thr; int stag_up, stag_in; };
struct Frame {
    LAS unsigned char* lds;
    int tid, lane, wave, vcu, G;
    const float* const __attribute__((address_space(4)))* in;
    float* out; unsigned char* ws;
};
enum { I_X = 0, I_F1N, I_F1G, I_F1U, I_F1D, I_MIXN, I_WIN, I_WOUT, I_MU, I_W0, I_W2, I_A0, I_A2, I_G2, I_KK, I_KA, I_RK, I_LNW, I_LNB, I_VRW, I_VRMU, I_V0, I_V2, I_KVN, I_WUK, I_WUV, I_F2N, I_F2G, I_F2U, I_F2D, I_FN };

__device__ __forceinline__ void conv_item(const Frame& F, int l, int kind, int item, LAS float* scr) {
    const int lane = F.lane;
    int Kd, nkb; bf16* WT;
    if (kind == 0 || kind == 4) { Kd = 1024; WT = (bf16*)(F.ws + (kind == 0 ? WS_WGU1 : WS_WGU2)); }
    else if (kind == 1 || kind == 5) { Kd = FFP; WT = (bf16*)(F.ws + (kind == 1 ? WS_WD1 : WS_WD2)); }
    else if (kind == 2) { Kd = 1024; WT = (bf16*)(F.ws + WS_WIN); }
    else { Kd = 1024; WT = (bf16*)(F.ws + WS_WOUT); }
    nkb = Kd / 64;
    const int rb = item / nkb, kb = item % nkb, r0 = rb * 32, k0 = kb * 64;
    const int n4 = (lane & 7) * 4, kr = lane >> 3;
    const int rr = r0 + n4;
    const float* src = nullptr; int ns = 0, col = 0, ksrc = 1024; const float* gain = nullptr; float scale = 1.0f;
    if (kind == 0 || kind == 4) {
        const int tile = rr >> 8, w = rr & 255, hid = tile * 128 + (w & 127);
        if (hid < FF) { const float* s1 = (w >> 7) ? F.in[I_F1U] : F.in[I_F1G]; const float* s2 = (w >> 7) ? F.in[I_F2U] : F.in[I_F2G]; src = ((kind == 0) ? s1 : s2) + (size_t)l * 1024 * FF; ns = FF; col = hid; }
        gain = ((kind == 0) ? F.in[I_F1N] : F.in[I_F2N]) + l * 1024;
    } else if (kind == 1 || kind == 5) {
        src = ((kind == 1) ? F.in[I_F1D] : F.in[I_F2D]) + (size_t)l * FF * 1024; ns = 1024; col = rr; ksrc = FF; scale = 0.5f;
    } else if (kind == 2) {
        gain = F.in[I_MIXN] + l * 1024;
        if (rr < 1280) { src = F.in[I_WIN] + (size_t)l * 1024 * NIN; ns = NIN; col = rr; }
        else if (rr < 1296) { if (l > 0) { src = F.in[I_VRW] + (size_t)(l - 1) * 1024 * 16; ns = 16; col = rr - 1280; } }
        else if (rr < PUSED) { src = F.in[I_WIN] + (size_t)l * 1024 * NIN; ns = NIN; col = rr - 16; }
    } else { src = F.in[I_WOUT] + (size_t)l * 1024 * 1024; ns = 1024; col = rr; }
    {
        const bool has = (src != nullptr); const float* sp = has ? src : F.in[I_FN]; const int nss = has ? ns : 0, cols = has ? col : 0;
        f32x4 vals[8];
#pragma unroll
        for (int i = 0; i < 8; ++i) { const int k = k0 + 8 * i + kr; const int kc = k < ksrc ? k : ksrc - 1; vals[i] = *(const GAS f32x4*)(sp + (size_t)kc * nss + cols); }
#pragma unroll
        for (int i = 0; i < 8; ++i) { const int kk = 8 * i + kr, k = k0 + kk; float g = (has && k < ksrc) ? scale : 0.f; if (gain) g *= gain[k < 1024 ? k : 1023];
            LAS float* d = scr + kk * 33 + n4; d[0] = vals[i][0] * g; d[1] = vals[i][1] * g; d[2] = vals[i][2] * g; d[3] = vals[i][3] * g; }
    }
    LDS_WAIT(); asm volatile("" ::: "memory");
    const int c = lane & 7;
#pragma unroll
    for (int j = 0; j < 4; ++j) { const int n = (lane >> 3) + 8 * j; const LAS float* s = scr + (8 * c) * 33 + n;
        v4u o; o.x = pk2(s[0 * 33], s[1 * 33]); o.y = pk2(s[2 * 33], s[3 * 33]); o.z = pk2(s[4 * 33], s[5 * 33]); o.w = pk2(s[6 * 33], s[7 * 33]);
        *(GAS v4u*)(WT + (size_t)(r0 + n) * Kd + k0 + 8 * c) = o; }
    LDS_WAIT(); asm volatile("" ::: "memory");
}
__host__ __device__ constexpr int conv_items(int kind) { return (kind == 0 || kind == 4) ? (NGU / 32) * 16 : (kind == 1 || kind == 5) ? 32 * (FFP / 64) : (kind == 2) ? (PP / 32) * 16 : 32 * 16; }
__device__ __forceinline__ void conv_weights(const Frame& F, int l, int k_lo, int k_hi) {
    LAS float* scr = (LAS float*)(F.lds + F.wave * 16384);
    const int gw = F.vcu * NWAVES + F.wave, NGW = F.G * NWAVES;
    for (int kind = k_lo; kind < k_hi; ++kind) { const int ni = conv_items(kind);
        for (int it = gw; it < ni; it += NGW) conv_item(F, l, kind, it, scr); }
}

__host__ __device__ constexpr int conv_flat_items(bool has_next) { return conv_items(3) + conv_items(4) + conv_items(5) + (has_next ? conv_items(0) + conv_items(1) + conv_items(2) : 0); }
constexpr int CONV_PER_WAVE = 2;
__device__ __forceinline__ void conv_unit(const Frame& F, int l, int u) {
    LAS float* scr = (LAS float*)(F.lds + F.wave * 16384);
    const bool has_next = (l + 1 < DEPTH);
#pragma unroll 1
    for (int rep = 0; rep < CONV_PER_WAVE; ++rep) {
    int it = (u * CONV_PER_WAVE + rep) * NWAVES + F.wave;
    if (it >= conv_flat_items(has_next)) return;
    int layer = l, kind = 3;
    if (it >= conv_items(3)) { it -= conv_items(3); kind = 4;
        if (it >= conv_items(4)) { it -= conv_items(4); kind = 5;
            if (it >= conv_items(5)) { it -= conv_items(5); kind = 0; layer = l + 1;
                if (it >= conv_items(0)) { it -= conv_items(0); kind = 1;
                    if (it >= conv_items(1)) { it -= conv_items(1); kind = 2; } } } } }
    conv_item(F, layer, kind, it, scr);
    }
}
__device__ __forceinline__ void p0_x(const Frame& F) {
    const int gw = F.vcu * NWAVES + F.wave, NGW = F.G * NWAVES;
    const float* x = F.in[I_X]; bf16* xb = (bf16*)(F.ws + WS_XB); float* part = (float*)(F.ws + WS_PART);
    for (int m = gw; m < M; m += NGW) {
        const GAS f32x4* xr = (const GAS f32x4*)(x + (size_t)m * DM) + F.lane; float s = 0.f;
        GAS unsigned long long* o8 = (GAS unsigned long long*)(xb + (size_t)m * DM) + F.lane;
#pragma unroll
        for (int j = 0; j < 4; ++j) { const f32x4 v = xr[64 * j]; s += (v.x * v.x + v.y * v.y) + (v.z * v.z + v.w * v.w);
            o8[64 * j] = (unsigned long long)pk2(v.x, v.y) | ((unsigned long long)pk2(v.z, v.w) << 32); }
        s = wave_sum(s);
        if (F.lane < 16) part[(size_t)m * 16 + F.lane] = (F.lane == 0) ? s : 0.f;
    }
}
__device__ __forceinline__ void p0_table(const Frame& F) {
    float* tab = (float*)(F.ws + WS_TAB);
    for (int i = F.vcu * NTHR + F.tid; i < SEQ * 32; i += F.G * NTHR) { const int t = i >> 5, f = i & 31; const float th = exp2f(-(float)f * (13.287712379549449f / 31.0f)); const float ang = (float)t * th; float s, c; sincosf(ang, &s, &c); tab[2 * i] = c; tab[2 * i + 1] = s; }
}

__device__ __forceinline__ void ret_kv_unit(const Frame& F, int unit) {
    unsigned dga_ = 0;
    DG_START(30, dg30_)
    LAS float* kr = (LAS float*)F.lds; LAS float* vv = kr + 128 * 64;
    const int tid = F.tid, c = unit & 15, h = (unit >> 4) & 3, b = unit >> 6, tok0 = b * SEQ + c * 128;
    const bf16* P = (const bf16*)(F.ws + WS_P); const float* tab = (const float*)(F.ws + WS_TAB);
    const float lg2 = log2f(1.0f - exp2f(-5.0f - (float)h));
    for (int idx = tid; idx < 128 * 32; idx += NTHR) { const int m = idx >> 5, i = idx & 31; const size_t ro = (size_t)(tok0 + m) * PP;
        const float k1 = bf2f(P[ro + PCK + h * 64 + i]), k2 = bf2f(P[ro + PCK + h * 64 + 32 + i]);
        const float cs = tab[((c * 128 + m) * 32 + i) * 2], sn = tab[((c * 128 + m) * 32 + i) * 2 + 1];
        const float sc = 0.125f * exp2f((float)(127 - m) * lg2);
        kr[m * 64 + i] = (k1 * cs - k2 * sn) * sc; kr[m * 64 + 32 + i] = (k1 * sn + k2 * cs) * sc;
        vv[m * 64 + i] = bf2f(P[ro + PCV + h * 64 + i]); vv[m * 64 + 32 + i] = bf2f(P[ro + PCV + h * 64 + 32 + i]); }
    __syncthreads();
    const int d = tid >> 3, e0 = (tid & 7) * 8; float acc[8];
#pragma unroll
    for (int e = 0; e < 8; ++e) acc[e] = 0.f;
    for (int m = 0; m < 128; ++m) { const float kd = kr[m * 64 + d];
#pragma unroll
        for (int e = 0; e < 8; ++e) acc[e] += kd * vv[m * 64 + e0 + e]; }
    float* KV = (float*)(F.ws + WS_KV) + (size_t)unit * 4096 + d * 64 + e0;
#pragma unroll
    for (int e = 0; e < 8; ++e) KV[e] = acc[e];
    __syncthreads();
    DG_STOP(30, dg30_, dga_)
    DG_WRITE(30, unit == 0 && F.wave == 0 && F.lane == 0, dga_)
}

typedef float f32x2 __attribute__((ext_vector_type(2)));
__device__ __forceinline__ float dpp_add16(float x) {
    x += __builtin_bit_cast(float, __builtin_amdgcn_mov_dpp(__builtin_bit_cast(int, x), 0xB1, 0xF, 0xF, true));
    x += __builtin_bit_cast(float, __builtin_amdgcn_mov_dpp(__builtin_bit_cast(int, x), 0x4E, 0xF, 0xF, true));
    x += __builtin_bit_cast(float, __builtin_amdgcn_mov_dpp(__builtin_bit_cast(int, x), 0x141, 0xF, 0xF, true));
    x += __builtin_bit_cast(float, __builtin_amdgcn_mov_dpp(__builtin_bit_cast(int, x), 0x140, 0xF, 0xF, true));
    return x;
}
constexpr int CH = 32;
constexpr int RW_STG = 5 * CH * 64;
constexpr int RW_ROWS = 16;
struct RwOps { f32x4 r, d, k, q, b; float v; };
__device__ __forceinline__ void rw_ld(RwOps& o, const LAS float* base, const LAS float* vb, int s, int ks, int row) {
    const LAS f32x4* p = (const LAS f32x4*)(base + s * 64 + ks * 4);
    o.r = p[0]; o.d = p[CH * 16]; o.k = p[2 * CH * 16]; o.q = p[3 * CH * 16]; o.b = p[4 * CH * 16];
    o.v = vb[s * RW_ROWS + row];
}
#define LO2(x) __builtin_shufflevector(x, x, 0, 1)
#define HI2(x) __builtin_shufflevector(x, x, 2, 3)
__device__ __forceinline__ float rw_step1(f32x2 (&S)[2], const RwOps& o, float v) {
    f32x2 p2 = S[0] * LO2(o.q); p2 = S[1] * HI2(o.q) + p2;
    const float p = dpp_add16(p2.x + p2.y);
    const f32x2 pp = (f32x2){p, p}, vv = (f32x2){v, v};
    S[0] = S[0] - LO2(o.d) * S[0]; S[1] = S[1] - HI2(o.d) * S[1];
    S[0] = S[0] - pp * LO2(o.b); S[1] = S[1] - pp * HI2(o.b);
    S[0] = vv * LO2(o.k) + S[0]; S[1] = vv * HI2(o.k) + S[1];
    f32x2 y2 = S[0] * LO2(o.r); y2 = S[1] * HI2(o.r) + y2;
    return dpp_add16(y2.x + y2.y);
}
__device__ __forceinline__ void rwkv_scan_unit(const Frame& F, int l, int unit) {
    const int tid = F.tid, lane = F.lane, wave = F.wave, quarter = unit & 3, bh = unit >> 2, b = bh / 6, h = bh - b * 6, tokb = b * SEQ;
    LAS float* stg = (LAS float*)F.lds; LAS float* vst = stg + 2 * RW_STG; LAS float* ybuf = vst + 2 * CH * RW_ROWS;
    bf16* P = (bf16*)(F.ws + WS_P);
    constexpr int NCH = SEQ / CH;
    unsigned dga_ = 0;
    if (wave >= 4) {
        const int st = tid - 256;
        const int t01 = st >> 3, c01 = st & 7, tv = st >> 1, cv = st & 1;
        const bf16* a0 = (const bf16*)(F.ws + WS_R); const bf16* a1 = (const bf16*)(F.ws + WS_D); const bf16* a2 = (const bf16*)(F.ws + WS_K2); const bf16* a3 = (const bf16*)(F.ws + WS_KK);
        const bf16* a4 = (const bf16*)((const unsigned char*)F.out + OUT_BP); const bf16* a5 = (const bf16*)(F.ws + WS_VF);
        v4u sreg[6];
#define RW_LOAD(cc) do { const size_t o_ = (size_t)(tokb + (cc) * CH + t01) * AW + h * 64 + c01 * 8; sreg[0] = *(const GAS v4u*)(a0 + o_); sreg[1] = *(const GAS v4u*)(a1 + o_); sreg[2] = *(const GAS v4u*)(a2 + o_); \
            sreg[3] = *(const GAS v4u*)(a3 + o_); sreg[4] = *(const GAS v4u*)(a4 + o_); if (st < 64) sreg[5] = *(const GAS v4u*)(a5 + (size_t)(tokb + (cc) * CH + tv) * AW + h * 64 + quarter * RW_ROWS + cv * 8); } while (0)
#define RW_ST1(i, dstp) do { float f[8]; unpack8(sreg[i], f); LAS f32x4* dst = (LAS f32x4*)(dstp); dst[0] = (f32x4){f[0], f[1], f[2], f[3]}; dst[1] = (f32x4){f[4], f[5], f[6], f[7]}; } while (0)
#define RW_STORE(bufi) do { _Pragma("unroll") for (int i = 0; i < 5; ++i) RW_ST1(i, stg + (bufi) * RW_STG + i * CH * 64 + t01 * 64 + c01 * 8); if (st < 64) RW_ST1(5, vst + (bufi) * CH * RW_ROWS + tv * RW_ROWS + cv * 8); } while (0)
#define RW_OUT(cc) do { if (st < 128) { const LAS float* yb_ = ybuf + ((cc) & 1) * CH * RW_ROWS; const int s_ = st >> 2, r4_ = (st & 3) * 4; const f32x4 yv = *(const LAS f32x4*)(yb_ + s_ * RW_ROWS + r4_); \
            *(GAS unsigned long long*)(P + (size_t)(tokb + (cc) * CH + s_) * PP + h * 64 + quarter * RW_ROWS + r4_) = (unsigned long long)pk2(yv[0], yv[1]) | ((unsigned long long)pk2(yv[2], yv[3]) << 32); } } while (0)
        RW_LOAD(0); RW_STORE(0); RW_LOAD(1);
        __syncthreads();
        for (int cc = 0; cc < NCH; ++cc) {
            if (cc + 1 < NCH) RW_STORE((cc + 1) & 1);
            if (cc + 2 < NCH) RW_LOAD(cc + 2);
            if (cc > 0) RW_OUT(cc - 1);
            asm volatile("s_waitcnt lgkmcnt(0)" ::: "memory"); __builtin_amdgcn_s_barrier(); asm volatile("" ::: "memory");
        }
        RW_OUT(NCH - 1);
#undef RW_LOAD
#undef RW_ST1
#undef RW_STORE
#undef RW_OUT
        return;
    }
    const int row = 4 * wave + (lane >> 4), ks = lane & 15;
    f32x2 Sa[2] = {(f32x2){0.f, 0.f}, (f32x2){0.f, 0.f}};
    __syncthreads();
    for (int cc = 0; cc < NCH; ++cc) {
        const int bufi = cc & 1;
        const LAS float* base = stg + bufi * RW_STG; const LAS float* vb = vst + bufi * CH * RW_ROWS; LAS float* yb = ybuf + bufi * CH * RW_ROWS;
        RwOps A, B; float yk0 = 0.f;
        DG_START(40, dg40_)
        rw_ld(A, base, vb, 0, ks, row);
#pragma unroll
        for (int s = 0; s < CH; s += 2) {
            rw_ld(B, base, vb, s + 1, ks, row);
            { const float y0 = rw_step1(Sa, A, A.v); yk0 = (ks == (s & 15)) ? y0 : yk0; }
            if (s + 2 < CH) rw_ld(A, base, vb, s + 2, ks, row);
            { const float y0 = rw_step1(Sa, B, B.v); yk0 = (ks == ((s + 1) & 15)) ? y0 : yk0; }
            if (((s + 1) & 15) == 15) yb[(s - 14 + ks) * RW_ROWS + row] = yk0;
        }
        DG_STOP(40, dg40_, dga_)
        DG_START(43, dg43_)
        asm volatile("s_waitcnt lgkmcnt(0)" ::: "memory"); __builtin_amdgcn_s_barrier(); asm volatile("" ::: "memory");
        DG_STOP(43, dg43_, dga_)
    }
    DG_WRITE(40, unit == 0 && l == 0 && wave == 0 && lane == 0, dga_)
    DG_WRITE(43, unit == 0 && l == 0 && wave == 0 && lane == 0, dga_)
}
__device__ __forceinline__ void rwkv_post(const Frame& F, int l) {
    bf16* P = (bf16*)(F.ws + WS_P); const bf16* VF = (const bf16*)(F.ws + WS_VF); const bf16* Gg = (const bf16*)((const unsigned char*)F.out + OUT_G); const float* BON = (const float*)(F.ws + WS_BON);
    const int sub = F.tid >> 4, c4 = (F.tid & 15) * 4;
    for (int pr = F.vcu * 32 + sub; pr < M * 6; pr += F.G * 32) { const int tok = pr / 6, h = pr - tok * 6;
        const unsigned long long yw = *(const GAS unsigned long long*)(P + (size_t)tok * PP + h * 64 + c4), vw = *(const GAS unsigned long long*)(VF + (size_t)tok * AW + h * 64 + c4), gw = *(const GAS unsigned long long*)(Gg + (size_t)tok * AW + h * 64 + c4);
        const f32x4 lnw = *(const f32x4*)(F.in[I_LNW] + l * AW + h * 64 + c4), lnb = *(const f32x4*)(F.in[I_LNB] + l * AW + h * 64 + c4);
        const float bon = BON[(size_t)tok * 6 + h];
        const f32x4 yv = (f32x4){bflo((unsigned)yw), bfhi((unsigned)yw), bflo((unsigned)(yw >> 32)), bfhi((unsigned)(yw >> 32))};
        const f32x4 vv = (f32x4){bflo((unsigned)vw), bfhi((unsigned)vw), bflo((unsigned)(vw >> 32)), bfhi((unsigned)(vw >> 32))};
        const f32x4 gg = (f32x4){bflo((unsigned)gw), bfhi((unsigned)gw), bflo((unsigned)(gw >> 32)), bfhi((unsigned)(gw >> 32))};
        float sm = (yv[0] + yv[1]) + (yv[2] + yv[3]);
        sm += __shfl_xor(sm, 1); sm += __shfl_xor(sm, 2); sm += __shfl_xor(sm, 4); sm += __shfl_xor(sm, 8);
        const float mean = sm * (1.0f / 64.0f); const f32x4 dv = yv - mean;
        float vs = (dv[0] * dv[0] + dv[1] * dv[1]) + (dv[2] * dv[2] + dv[3] * dv[3]);
        vs += __shfl_xor(vs, 1); vs += __shfl_xor(vs, 2); vs += __shfl_xor(vs, 4); vs += __shfl_xor(vs, 8);
        const float rs = 1.0f / sqrtf(vs * (1.0f / 64.0f) + 64e-5f);
        const f32x4 o = (dv * rs * lnw + lnb + bon * vv) * gg;
        *(GAS unsigned long long*)(P + (size_t)tok * PP + h * 64 + c4) = (unsigned long long)pk2(o[0], o[1]) | ((unsigned long long)pk2(o[2], o[3]) << 32);
    }
}

typedef short bf16x8_t __attribute__((ext_vector_type(8)));
typedef short s16x4_t __attribute__((ext_vector_type(4)));
typedef float f32x16_t __attribute__((ext_vector_type(16)));
__device__ __forceinline__ unsigned fkey(float f) { const unsigned u = __float_as_uint(f); return (u & 0x80000000u) ? ~u : (u | 0x80000000u); }
__device__ __forceinline__ int crow32(int r, int hi) { return (r & 3) + 8 * (r >> 2) + 4 * hi; }
__device__ __forceinline__ unsigned off_a(unsigned row, unsigned ch) { return 2048u * (row >> 3) + 512u * (ch >> 2) + 64u * (row & 7) + 16u * ((ch & 3) ^ ((row >> 2) & 3)); }

__device__ __forceinline__ void idx_scores(const bf16x8_t (&Af)[2], const bf16x8_t (&Bf)[8][2], const float (&iwf)[8], float (&sc)[4]) {
    sc[0] = sc[1] = sc[2] = sc[3] = 0.f;
#pragma unroll
    for (int h = 0; h < 8; ++h) { f32x4 a = (f32x4){0.f, 0.f, 0.f, 0.f};
        a = __builtin_amdgcn_mfma_f32_16x16x32_bf16(Af[0], Bf[h][0], a, 0, 0, 0);
        a = __builtin_amdgcn_mfma_f32_16x16x32_bf16(Af[1], Bf[h][1], a, 0, 0, 0);
#pragma unroll
        for (int r = 0; r < 4; ++r) { const float av_ = a[r]; const int ai_ = __float_as_int(av_); const float rl = __int_as_float(ai_ > 0 ? ai_ : 0); sc[r] = fmaf(iwf[h], rl, sc[r]); } }
}
__device__ __forceinline__ void idx_load_q(const bf16* P, int tokq, bf16x8_t (&Bf)[8][2], float (&iwf)[8], int fq) {
    const bf16* row = P + (size_t)tokq * PP;
#pragma unroll
    for (int h = 0; h < 8; ++h)
#pragma unroll
        for (int ks = 0; ks < 2; ++ks) Bf[h][ks] = *(const GAS bf16x8_t*)(row + PBIQ + h * 64 + ks * 32 + fq * 8);
    const v4u w = *(const GAS v4u*)(row + PBIW); float f[8]; unpack8(w, f);
#pragma unroll
    for (int h = 0; h < 8; ++h) iwf[h] = f[h] * (0.35355339059327373f * 0.125f);
}

__device__ __forceinline__ void lds_barrier() { asm volatile("s_waitcnt lgkmcnt(0)" ::: "memory"); __builtin_amdgcn_s_barrier(); asm volatile("" ::: "memory"); }
constexpr int SKP = 2052;
__device__ __forceinline__ void dsa_thr_unit(const Frame& F, int l, int unit) {
    LAS unsigned* sk = (LAS unsigned*)F.lds;
    const int lane = F.lane, wave = F.wave, fr = lane & 15, fq = lane >> 4;
    const int b = unit & 7, qb = 127 - (unit >> 3), t0 = qb * 16, tok0 = b * SEQ + t0;
    const bf16* P = (const bf16*)(F.ws + WS_P);
    unsigned dga_ = 0;
    DG_START(10, dg10_)
    {
        bf16x8_t Bf[8][2]; float iwf[8];
        idx_load_q(P, tok0 + fr, Bf, iwf, fq);
        bf16x8_t An[2];
        { const int kt0 = wave <= qb ? wave : qb; const bf16* krow = P + (size_t)(b * SEQ + kt0 * 16 + fr) * PP + PBIK + fq * 8; An[0] = *(const GAS bf16x8_t*)(krow); An[1] = *(const GAS bf16x8_t*)(krow + 32); }
        for (int kt = wave; kt <= qb; kt += 8) {
            bf16x8_t Af[2]; Af[0] = An[0]; Af[1] = An[1];
            { const int ktn = kt + 8 <= qb ? kt + 8 : qb; const bf16* krow = P + (size_t)(b * SEQ + ktn * 16 + fr) * PP + PBIK + fq * 8; An[0] = *(const GAS bf16x8_t*)(krow); An[1] = *(const GAS bf16x8_t*)(krow + 32); }
            float sc[4]; idx_scores(Af, Bf, iwf, sc);
            v4u kv;
            const int s0 = kt * 16 + 4 * fq, t = t0 + fr;
            kv.x = (s0 + 0 <= t) ? fkey(sc[0]) : 0u; kv.y = (s0 + 1 <= t) ? fkey(sc[1]) : 0u; kv.z = (s0 + 2 <= t) ? fkey(sc[2]) : 0u; kv.w = (s0 + 3 <= t) ? fkey(sc[3]) : 0u;
            *(LAS v4u*)(sk + fr * SKP + s0) = kv;
        }
    }
    __syncthreads();
    DG_STOP(10, dg10_, dga_)
    DG_WRITE(10, unit == 0 && wave == 0 && lane == 0, dga_)
    DG_START(11, dg11_)
    unsigned* THR = (unsigned*)(F.ws + WS_THR); int* SCUT = (int*)(F.ws + WS_SCUT);
    for (int qi = 0; qi < 2; ++qi) { const int q = 2 * wave + qi, t = t0 + q, n = t + 1;
        unsigned thr = 0u; int scut = SEQ - 1;
        if (n > TOPK) {
            unsigned keys[32];
#pragma unroll
            for (int i = 0; i < 32; ++i) keys[i] = (64 * i + lane <= t) ? sk[q * SKP + 64 * i + lane] : 0u;
            unsigned prefix = 0u; bool done = false;
            const int ng = (t >> 9) + 1;
            for (int bit = 31; bit >= 0; --bit) { const unsigned cand = prefix | (1u << bit); int cnt = 0;
#pragma unroll
                for (int g = 0; g < 4; ++g) if (g < ng) {
#pragma unroll
                    for (int i = 8 * g; i < 8 * g + 8; ++i) cnt += __popcll(__ballot(keys[i] >= cand)); }
                if (cnt >= TOPK) prefix = cand;
                if (cnt == TOPK) { thr = cand - 1u; scut = -1; done = true; break; } }
            if (!done) {
                int cgt = 0;
#pragma unroll
                for (int i = 0; i < 32; ++i) cgt += __popcll(__ballot(keys[i] > prefix));
                int need = TOPK - cgt, run = 0; thr = prefix; scut = SEQ - 1; bool found = false;
#pragma unroll
                for (int i = 0; i < 32; ++i) { unsigned long long mk = __ballot(keys[i] == prefix); const int c = __popcll(mk);
                    if (!found && run + c >= need) { int k = need - run; while (k > 1) { mk &= mk - 1ull; --k; } scut = 64 * i + (int)__builtin_ctzll(mk); found = true; }
                    run += c; }
            }
        }
        {
            unsigned* MK = (unsigned*)((unsigned char*)F.out + OUT_MASK) + (size_t)(tok0 + q) * 64;
            if (n > TOPK) {
#pragma unroll
                for (int i = 0; i < 32; ++i) { const int s = 64 * i + lane; const unsigned key = (s <= t) ? sk[q * SKP + s] : 0u;
                    const unsigned long long bal = __ballot((s <= t) & ((key > thr) | ((key == thr) & (s <= scut))));
                    if (lane < 2 && 64 * i <= t) MK[2 * i + lane] = lane ? (unsigned)(bal >> 32) : (unsigned)bal; }
            } else {
                if (lane < 8) { const int w0 = lane; MK[w0] = (32 * w0 + 31 <= t) ? 0xffffffffu : ((32 * w0 <= t) ? ((1u << ((t & 31) + 1)) - 1u) : 0u); }
            }
        }
    }
    DG_STOP(11, dg11_, dga_)
    DG_WRITE(11, unit == 0 && wave == 0 && lane == 0, dga_)
    __syncthreads();
    if (F.tid == 0) {
        __builtin_amdgcn_fence(__ATOMIC_RELEASE, "agent");
        __hip_atomic_fetch_add((unsigned*)(F.ws + WS_CTL) + CW_THRD + l * 512 + 8 * (unit >> 4) + (unit & 7), 1u, RLX_AGENT); }
}

constexpr int QLP = 136;
constexpr int MKP = 36;
constexpr int DA_MASK = 0, DA_QL = 2 * 32 * MKP * 4, DA_CT = DA_QL + 6 * 32 * QLP * 2;
__device__ __forceinline__ void dsa_attn_unit(const Frame& F, int l, int unit) {
    const int tid = F.tid, lane = F.lane, wave = F.wave, r32 = lane & 31, hi = lane >> 5;
    const int b = unit & 7, qb = 63 - (unit >> 3), t0 = qb * 32, tok0 = b * SEQ + t0, ntile = qb + 1;
    {
        if (tid == 0) { const unsigned* dn = (const unsigned*)(F.ws + WS_CTL) + CW_THRD + l * 512 + unit;
            while (__hip_atomic_load(dn, RLX_AGENT) < 2u) __builtin_amdgcn_s_sleep(8);
            __builtin_amdgcn_fence(__ATOMIC_ACQUIRE, "agent"); }
        __syncthreads(); }
    bf16* P = (bf16*)(F.ws + WS_P); const bf16* C = (const bf16*)(F.ws + WS_C);
    LAS float* MASK = (LAS float*)(F.lds + DA_MASK); LAS unsigned char* QLb = F.lds + DA_QL; LAS unsigned char* CT = F.lds + DA_CT;
    const int crow_ = tid >> 4, cch = tid & 15; const unsigned cdst = off_a((unsigned)crow_, (unsigned)cch);
    const bf16* csrc = C + (size_t)(b * SEQ + crow_) * 128 + cch * 8;
    v4u cpre = *(const GAS v4u*)(csrc);
    if (wave >= 6) {
        const int fr = lane & 15, fq = lane >> 4, qh = wave - 6;
        const int tq = tok0 + 16 * qh + fr, tq_t = t0 + 16 * qh + fr, jmax = tq_t >> 5;
        const unsigned* MK = (const unsigned*)((const unsigned char*)F.out + OUT_MASK) + (size_t)tq * 64;
        LAS float* mrow = MASK + (16 * qh + fr) * MKP + 8 * fq;
#define DA_EXPAND(word, slot) do { const unsigned w_ = (word) >> (8 * fq); f32x4 m0_, m1_; \
            m0_[0] = (w_ & 1u) ? 0.f : -1e30f; m0_[1] = (w_ & 2u) ? 0.f : -1e30f; m0_[2] = (w_ & 4u) ? 0.f : -1e30f; m0_[3] = (w_ & 8u) ? 0.f : -1e30f; \
            m1_[0] = (w_ & 16u) ? 0.f : -1e30f; m1_[1] = (w_ & 32u) ? 0.f : -1e30f; m1_[2] = (w_ & 64u) ? 0.f : -1e30f; m1_[3] = (w_ & 128u) ? 0.f : -1e30f; \
            *(LAS f32x4*)(mrow + (slot) * (32 * MKP)) = m0_; *(LAS f32x4*)(mrow + (slot) * (32 * MKP) + 4) = m1_; } while (0)
        unsigned w0 = MK[0], w1 = (1 <= jmax) ? MK[1] : 0u, w2 = (2 <= jmax) ? MK[2] : 0u;
        DA_EXPAND(w0, 0);
        *(LAS v4u*)(CT + cdst) = cpre;
        lds_barrier();
        for (int j = 0; j < ntile; ++j) {
            if (j + 1 < ntile) {
                cpre = *(const GAS v4u*)(csrc + (size_t)(j + 1) * 32 * 128);
                DA_EXPAND(w1, (j + 1) & 1);
                w1 = w2; w2 = (j + 3 <= jmax) ? MK[j + 3] : 0u;
                *(LAS v4u*)(CT + ((j + 1) & 1) * 8192 + cdst) = cpre; }
            lds_barrier();
        }
#undef DA_EXPAND
        lds_barrier();
        return;
    }
    const int h = wave;
    LAS unsigned char* QLh = QLb + h * (32 * QLP * 2);
    float negb;
    {
        unsigned zo_ = 0u; asm volatile("" : "+v"(zo_));
        const bf16* wukT = (const bf16*)(F.ws + WS_WUKT) + (size_t)(l * 6 + h) * 128 * 64 + zo_;
        bf16x8_t qf[4]; float ssq = 0.f;
#pragma unroll
        for (int ks = 0; ks < 4; ++ks) qf[ks] = *(const GAS bf16x8_t*)(P + (size_t)(tok0 + r32) * PP + PBQ + h * 64 + ks * 16 + hi * 8);
#pragma unroll
        for (int blk = 0; blk < 4; ++blk) { f32x16_t x;
#pragma unroll
            for (int i = 0; i < 16; ++i) x[i] = 0.f;
#pragma unroll
            for (int ks = 0; ks < 4; ++ks) { const bf16x8_t a = *(const GAS bf16x8_t*)(wukT + (size_t)(blk * 32 + r32) * 64 + ks * 16 + hi * 8); x = __builtin_amdgcn_mfma_f32_32x32x16_bf16(a, qf[ks], x, 0, 0, 0); }
#pragma unroll
            for (int g = 0; g < 4; ++g) { const float sc = 0.125f * 1.4426950408889634f;
                const float x0 = x[4 * g] * sc, x1 = x[4 * g + 1] * sc, x2 = x[4 * g + 2] * sc, x3 = x[4 * g + 3] * sc; ssq += (x0 * x0 + x1 * x1) + (x2 * x2 + x3 * x3);
                const unsigned long long w = (unsigned long long)pk2(x0, x1) | ((unsigned long long)pk2(x2, x3) << 32);
                *(LAS unsigned long long*)(QLh + (r32 * QLP + blk * 32 + 8 * g + 4 * hi) * 2) = w; } }
        ssq += __shfl_xor(ssq, 32);
        const float* kvn = F.in[I_KVN] + l * 128; float gm = fmaxf(fabsf(kvn[2 * lane]), fabsf(kvn[2 * lane + 1]));
#pragma unroll
        for (int o_ = 1; o_ < 64; o_ <<= 1) gm = fmaxf(gm, __shfl_xor(gm, o_));
        negb = -(sqrtf(ssq) * 11.32f * gm * 1.01f + 0.01f);
    }
    *(LAS v4u*)(CT + cdst) = cpre;
    lds_barrier();
    f32x16_t o[4]; float l_run = 0.f;
    const LAS unsigned char* qlrow = QLh + (r32 * QLP + 8 * hi) * 2;
#pragma unroll
    for (int c = 0; c < 4; ++c)
#pragma unroll
        for (int i = 0; i < 16; ++i) o[c][i] = 0.f;
    const unsigned rr_ = ((unsigned)r32 >> 2) & 3u, rb_ = 2048u * ((unsigned)r32 >> 3) + 64u * ((unsigned)r32 & 7u);
    const unsigned rbase0 = rb_ + 16u * ((unsigned)hi ^ rr_), rbase1 = rb_ + 16u * ((2u + (unsigned)hi) ^ rr_);
    const unsigned blk_ = (lane >> 4) & 1, q_ = (lane & 15) >> 2, p_ = lane & 3;
    unsigned dga_ = 0;
    for (int j = 0; j < ntile; ++j) {
        DG_START(0, dgt_)
        LAS unsigned char* kb = CT + (j & 1) * 8192;
        if (j + 1 < ntile) cpre = *(const GAS v4u*)(csrc + (size_t)(j + 1) * 32 * 128);
        {
            f32x16_t S;
#pragma unroll
            for (int i = 0; i < 16; ++i) S[i] = negb;
#pragma unroll
            for (int s = 0; s < 8; ++s) { const bf16x8_t a = *(const LAS bf16x8_t*)(kb + ((s & 1) ? rbase1 : rbase0) + 512 * (s >> 1)); const bf16x8_t bq = *(const LAS bf16x8_t*)(qlrow + 32 * s);
                S = __builtin_amdgcn_mfma_f32_32x32x16_bf16(a, bq, S, 0, 0, 0); }
            const LAS f32x4* mk = (const LAS f32x4*)(MASK + (j & 1) * (32 * MKP) + r32 * MKP + 4 * hi);
            float psum = 0.f; float e[16];
#pragma unroll
            for (int g = 0; g < 4; ++g) { const f32x4 mv = mk[2 * g];
#pragma unroll
                for (int e4 = 0; e4 < 4; ++e4) { e[4 * g + e4] = __builtin_amdgcn_exp2f(S[4 * g + e4] + mv[e4]); psum += e[4 * g + e4]; } }
            l_run += psum;
            bf16x8_t xs[2];
#pragma unroll
            for (int s = 0; s < 2; ++s) { v4u w; w.x = pk2(e[8 * s], e[8 * s + 1]); w.y = pk2(e[8 * s + 2], e[8 * s + 3]); w.z = pk2(e[8 * s + 4], e[8 * s + 5]); w.w = pk2(e[8 * s + 6], e[8 * s + 7]); xs[s] = __builtin_bit_cast(bf16x8_t, w); }
#pragma unroll
            for (int c = 0; c < 4; ++c)
#pragma unroll
                for (int s = 0; s < 2; ++s) {
                    const unsigned a0 = off_a((unsigned)(16 * s + 4 * hi + q_), (unsigned)(4 * c + 2 * blk_ + (p_ >> 1))) + 8u * (p_ & 1);
                    const unsigned a1 = off_a((unsigned)(16 * s + 8 + 4 * hi + q_), (unsigned)(4 * c + 2 * blk_ + (p_ >> 1))) + 8u * (p_ & 1);
                    const s16x4_t lo = __builtin_bit_cast(s16x4_t, __builtin_amdgcn_ds_read_tr16_b64_v4i16((LAS s16x4_t*)(kb + a0)));
                    const s16x4_t hh = __builtin_bit_cast(s16x4_t, __builtin_amdgcn_ds_read_tr16_b64_v4i16((LAS s16x4_t*)(kb + a1)));
                    const bf16x8_t a = (bf16x8_t){lo[0], lo[1], lo[2], lo[3], hh[0], hh[1], hh[2], hh[3]};
                    o[c] = __builtin_amdgcn_mfma_f32_32x32x16_bf16(a, xs[s], o[c], 0, 0, 0); }
        }
        if (j + 1 < ntile) *(LAS v4u*)(CT + ((j + 1) & 1) * 8192 + cdst) = cpre;
        DG_STOP(0, dgt_, dga_)
        lds_barrier();
    }
    DG_WRITE(0, unit == 0 && l == 0 && wave == 0 && lane == 0, dga_)
    {
        const float lt = l_run + __shfl_xor(l_run, 32); const float inv = 1.0f / lt;
#pragma unroll
        for (int c = 0; c < 4; ++c)
#pragma unroll
            for (int g = 0; g < 4; ++g) { const unsigned long long w = (unsigned long long)pk2(o[c][4 * g] * inv, o[c][4 * g + 1] * inv) | ((unsigned long long)pk2(o[c][4 * g + 2] * inv, o[c][4 * g + 3] * inv) << 32);
                *(LAS unsigned long long*)(QLh + (r32 * QLP + c * 32 + 8 * g + 4 * hi) * 2) = w; }
        unsigned zo2_ = 0u; asm volatile("" : "+v"(zo2_));
        const bf16* wuvT = (const bf16*)(F.ws + WS_WUVT) + (size_t)(l * 6 + h) * 64 * 128 + zo2_;
        bf16x8_t Bo[8];
#pragma unroll
        for (int s = 0; s < 8; ++s) Bo[s] = *(const LAS bf16x8_t*)(QLh + (r32 * QLP + 16 * s + 8 * hi) * 2);
#pragma unroll
        for (int mb = 0; mb < 2; ++mb) { f32x16_t y;
#pragma unroll
            for (int i = 0; i < 16; ++i) y[i] = 0.f;
#pragma unroll
            for (int s = 0; s < 8; ++s) { const bf16x8_t a = *(const GAS bf16x8_t*)(wuvT + (size_t)(mb * 32 + r32) * 128 + 16 * s + 8 * hi); y = __builtin_amdgcn_mfma_f32_32x32x16_bf16(a, Bo[s], y, 0, 0, 0); }
#pragma unroll
            for (int g = 0; g < 4; ++g) { const unsigned long long w = (unsigned long long)pk2(y[4 * g], y[4 * g + 1]) | ((unsigned long long)pk2(y[4 * g + 2], y[4 * g + 3]) << 32);
                *(GAS unsigned long long*)(P + (size_t)(tok0 + r32) * PP + 384 + h * 64 + mb * 32 + 8 * g + 4 * hi) = w; } }
    }
    lds_barrier();
}
constexpr int RC = 32;
constexpr int P64 = 72, P32 = 40, PTS = 36;
constexpr int RPW = 72, RAWSZ = 32 * RPW, GP = 68;
constexpr int RK_RAW = 0;
constexpr int RK_GAM = RK_RAW + 6 * RAWSZ * 2;
constexpr int RK_AL = RK_GAM + 33 * GP * 4, RK_RH = RK_AL + 32 * P64 * 2, RK_BE = RK_RH + 32 * P64 * 2, RK_KA = RK_BE + 32 * P64 * 2;
constexpr int RK_BET = RK_KA + 32 * P64 * 2, RK_KAT = RK_BET + 64 * P32 * 2, RK_VT = RK_KAT + 64 * P32 * 2;
constexpr int RK_NT = RK_VT + 64 * P32 * 2, RK_BRT = RK_NT + 32 * P32 * 2, RK_KRT = RK_BRT + 32 * P32 * 2;
constexpr int RK_ZB = RK_KRT + 32 * P32 * 2;
constexpr int RK_XB = RK_ZB + 2 * 64 * P64 * 2;
constexpr int RK_EB = RK_XB + 64 * P32 * 2;
constexpr int RK_BRT2 = RK_EB + 64 * P32 * 2, RK_BET2 = RK_BRT2 + 32 * P32 * 2, RK_GC = RK_BET2 + 64 * P32 * 2;
constexpr int RK_END = RK_GC + 512;
static_assert(RK_END <= RING_BYTES, "chunked RWKV unit: LDS");
template <int KS> __device__ __forceinline__ void mm_ld(bf16x8_t (&a)[KS], bf16x8_t (&b)[KS], const LAS bf16* X, int px, const LAS bf16* Y, int py, int r32, int hi) {
#pragma unroll
    for (int s = 0; s < KS; ++s) { a[s] = *(const LAS bf16x8_t*)(X + r32 * px + 16 * s + 8 * hi); b[s] = *(const LAS bf16x8_t*)(Y + r32 * py + 16 * s + 8 * hi); }
}
template <int KS> __device__ __forceinline__ void mm_do(f32x16_t& acc, const bf16x8_t (&a)[KS], const bf16x8_t (&b)[KS]) {
#pragma unroll
    for (int s = 0; s < KS; ++s) acc = __builtin_amdgcn_mfma_f32_32x32x16_bf16(a[s], b[s], acc, 0, 0, 0);
}
__device__ __forceinline__ bf16x8_t acc_frag(const f32x16_t& a, int s) { v4u w; w.x = pk2(a[8 * s], a[8 * s + 1]); w.y = pk2(a[8 * s + 2], a[8 * s + 3]); w.z = pk2(a[8 * s + 4], a[8 * s + 5]); w.w = pk2(a[8 * s + 6], a[8 * s + 7]); return __builtin_bit_cast(bf16x8_t, w); }
__device__ __forceinline__ void mm_acc(f32x16_t& d, const f32x16_t& at, const f32x16_t& b) {
    d = __builtin_amdgcn_mfma_f32_32x32x16_bf16(acc_frag(at, 0), acc_frag(b, 0), d, 0, 0, 0); d = __builtin_amdgcn_mfma_f32_32x32x16_bf16(acc_frag(at, 1), acc_frag(b, 1), d, 0, 0, 0);
}
template <int KS> __device__ __forceinline__ void mm_abt(f32x16_t& acc, const LAS bf16* X, int px, const LAS bf16* Y, int py, int r32, int hi) {
    bf16x8_t a[KS], b[KS]; mm_ld<KS>(a, b, X, px, Y, py, r32, hi); mm_do<KS>(acc, a, b);
}
template <int K1, int K2> __device__ __forceinline__ void mm_abt2(f32x16_t& acc, const LAS bf16* X1, int px1, const LAS bf16* Y1, int py1, const LAS bf16* X2, int px2, const LAS bf16* Y2, int py2, int r32, int hi) {
    bf16x8_t a1[K1], b1[K1], a2[K2], b2[K2]; mm_ld<K1>(a1, b1, X1, px1, Y1, py1, r32, hi); mm_ld<K2>(a2, b2, X2, px2, Y2, py2, r32, hi); mm_do<K1>(acc, a1, b1); mm_do<K2>(acc, a2, b2);
}
__device__ __forceinline__ void rwkv_chunk_unit(const Frame& F, int l, int unit) {
    const int tid = F.tid, lane = F.lane, wave = F.wave, r32 = lane & 31, hi = lane >> 5;
    const int b = unit / 6, h = unit - b * 6, tokb = b * SEQ;
    LAS bf16* RAW = (LAS bf16*)(F.lds + RK_RAW); LAS float* GAM = (LAS float*)(F.lds + RK_GAM);
    LAS bf16* AL = (LAS bf16*)(F.lds + RK_AL); LAS bf16* RH = (LAS bf16*)(F.lds + RK_RH); LAS bf16* BE = (LAS bf16*)(F.lds + RK_BE); LAS bf16* KA = (LAS bf16*)(F.lds + RK_KA);
    LAS bf16* KAT = (LAS bf16*)(F.lds + RK_KAT); LAS bf16* VT = (LAS bf16*)(F.lds + RK_VT);
    LAS bf16* NT = (LAS bf16*)(F.lds + RK_NT); LAS bf16* KRT = (LAS bf16*)(F.lds + RK_KRT);
    LAS bf16* ZB = (LAS bf16*)(F.lds + RK_ZB); LAS bf16* XB = (LAS bf16*)(F.lds + RK_XB); LAS bf16* EB = (LAS bf16*)(F.lds + RK_EB);
    LAS float* GC = (LAS float*)(F.lds + RK_GC);
    bf16* P = (bf16*)(F.ws + WS_P);
    constexpr int NCH = SEQ / RC;
    const int half = tid >> 8, idx = tid & 255, lt = idx >> 3, lc = idx & 7;
    const bf16* s0 = (const bf16*)(F.ws + (half ? WS_KK : WS_R)); const bf16* s1 = half ? (const bf16*)((const unsigned char*)F.out + OUT_BP) : (const bf16*)(F.ws + WS_D); const bf16* s2 = (const bf16*)(F.ws + (half ? WS_VF : WS_K2));
    v4u pre[3];
#define RK_LOAD(cc) do { const size_t o_ = (size_t)(tokb + (cc) * RC + lt) * AW + h * 64 + lc * 8; pre[0] = *(const GAS v4u*)(s0 + o_); pre[1] = *(const GAS v4u*)(s1 + o_); pre[2] = *(const GAS v4u*)(s2 + o_); } while (0)
#define RK_H1() do { _Pragma("unroll") for (int j = 0; j < 3; ++j) *(LAS v4u*)(RAW + (3 * half + j) * RAWSZ + lt * RPW + lc * 8) = pre[j]; } while (0)
#define RK_PROD8(s_) ({ float w_[8]; _Pragma("unroll") for (int j = 0; j < 8; ++j) w_[j] = 1.0f - __builtin_bit_cast(float, (unsigned)RAW[RAWSZ + (8 * (s_) + j) * RPW + lane] << 16); \
        ((w_[0] * w_[1]) * (w_[2] * w_[3])) * ((w_[4] * w_[5]) * (w_[6] * w_[7])); })
#define RK_H2(cn) do { if (wave >= 4) { const int seg = wave - 4; float w_[8]; _Pragma("unroll") for (int j = 0; j < 8; ++j) w_[j] = 1.0f - __builtin_bit_cast(float, (unsigned)RAW[RAWSZ + (8 * seg + j) * RPW + lane] << 16); \
        float g = 1.f; if (seg >= 1) { const float p0 = RK_PROD8(0); g = p0; if (seg >= 2) { const float p1 = RK_PROD8(1); g *= p1; if (seg >= 3) { const float p2 = RK_PROD8(2); g *= p2; } } } \
        _Pragma("unroll") for (int j = 0; j < 8; ++j) { g *= w_[j]; GAM[(8 * seg + j + 1) * GP + lane] = g; } \
        if (seg == 3) GC[((cn) & 1) * 64 + lane] = g; } } while (0)
#define RK_H3(cn) do { LAS bf16* BETn = (LAS bf16*)(F.lds + (((cn) & 1) ? RK_BET2 : RK_BET)); \
        { \
            { const int it = tid; const int t = it & 31, k4 = (it >> 5) * 4;        \
                const f32x4 g1 = *(const LAS f32x4*)(GAM + (t + 1) * GP + k4), g0 = *(const LAS f32x4*)(GAM + t * GP + k4); \
                const unsigned long long rw = *(const LAS unsigned long long*)(RAW + 0 * RAWSZ + t * RPW + k4), kw = *(const LAS unsigned long long*)(RAW + 2 * RAWSZ + t * RPW + k4); \
                const unsigned long long qw = *(const LAS unsigned long long*)(RAW + 3 * RAWSZ + t * RPW + k4), bw = *(const LAS unsigned long long*)(RAW + 4 * RAWSZ + t * RPW + k4); \
                const f32x4 rv = (f32x4){bflo((unsigned)rw), bfhi((unsigned)rw), bflo((unsigned)(rw >> 32)), bfhi((unsigned)(rw >> 32))}, kv = (f32x4){bflo((unsigned)kw), bfhi((unsigned)kw), bflo((unsigned)(kw >> 32)), bfhi((unsigned)(kw >> 32))}; \
                const f32x4 qv = (f32x4){bflo((unsigned)qw), bfhi((unsigned)qw), bflo((unsigned)(qw >> 32)), bfhi((unsigned)(qw >> 32))}, bv = (f32x4){bflo((unsigned)bw), bfhi((unsigned)bw), bflo((unsigned)(bw >> 32)), bfhi((unsigned)(bw >> 32))}; \
                const f32x4 rg = (f32x4){__builtin_amdgcn_rcpf(g1[0]), __builtin_amdgcn_rcpf(g1[1]), __builtin_amdgcn_rcpf(g1[2]), __builtin_amdgcn_rcpf(g1[3])}; \
                const f32x4 al = -(qv * g0), rh = rv * g1, be = bv * rg, ka = kv * rg; \
                const unsigned be0 = pk2(be[0], be[1]), be1 = pk2(be[2], be[3]), ka0 = pk2(ka[0], ka[1]), ka1 = pk2(ka[2], ka[3]); \
                *(LAS unsigned long long*)(AL + t * P64 + k4) = (unsigned long long)pk2(al[0], al[1]) | ((unsigned long long)pk2(al[2], al[3]) << 32); \
                *(LAS unsigned long long*)(RH + t * P64 + k4) = (unsigned long long)pk2(rh[0], rh[1]) | ((unsigned long long)pk2(rh[2], rh[3]) << 32); \
                *(LAS unsigned long long*)(BE + t * P64 + k4) = (unsigned long long)be0 | ((unsigned long long)be1 << 32); \
                *(LAS unsigned long long*)(KA + t * P64 + k4) = (unsigned long long)ka0 | ((unsigned long long)ka1 << 32); \
                BETn[(k4 + 0) * P32 + t] = (bf16)(be0 & 0xffffu); BETn[(k4 + 1) * P32 + t] = (bf16)(be0 >> 16); BETn[(k4 + 2) * P32 + t] = (bf16)(be1 & 0xffffu); BETn[(k4 + 3) * P32 + t] = (bf16)(be1 >> 16); \
                KAT[(k4 + 0) * P32 + t] = (bf16)(ka0 & 0xffffu); KAT[(k4 + 1) * P32 + t] = (bf16)(ka0 >> 16); KAT[(k4 + 2) * P32 + t] = (bf16)(ka1 & 0xffffu); KAT[(k4 + 3) * P32 + t] = (bf16)(ka1 >> 16); } \
            if (tid >= 256) { const int ix = tid - 256, i = ix & 31, v8 = (ix >> 5) * 8; const v4u w = *(const LAS v4u*)(RAW + 5 * RAWSZ + i * RPW + v8); \
                VT[(v8 + 0) * P32 + i] = (bf16)(w.x & 0xffffu); VT[(v8 + 1) * P32 + i] = (bf16)(w.x >> 16); VT[(v8 + 2) * P32 + i] = (bf16)(w.y & 0xffffu); VT[(v8 + 3) * P32 + i] = (bf16)(w.y >> 16); \
                VT[(v8 + 4) * P32 + i] = (bf16)(w.z & 0xffffu); VT[(v8 + 5) * P32 + i] = (bf16)(w.z >> 16); VT[(v8 + 6) * P32 + i] = (bf16)(w.w & 0xffffu); VT[(v8 + 7) * P32 + i] = (bf16)(w.w >> 16); } } } while (0)
#define RK_ST_ROWS(O, acc_) do { _Pragma("unroll") for (int r = 0; r < 16; ++r) (O)[crow32(r, hi) * P32 + r32] = (bf16)(pk2((acc_)[r], 0.f) & 0xffffu); } while (0)
#define RK_ST_COLS(O, acc_) do { _Pragma("unroll") for (int g = 0; g < 4; ++g) *(LAS unsigned long long*)((O) + r32 * P32 + 8 * g + 4 * hi) = (unsigned long long)pk2((acc_)[4 * g], (acc_)[4 * g + 1]) | ((unsigned long long)pk2((acc_)[4 * g + 2], (acc_)[4 * g + 3]) << 32); } while (0)
#define RK_CH_RND() do { f32x16_t pn, ptn; _Pragma("unroll") for (int i = 0; i < 16; ++i) { pn[i] = 0.f; ptn[i] = 0.f; } \
        mm_acc(pn, cpt, cp); mm_acc(ptn, cp, cpt); cp = pn; cpt = ptn; \
        f32x16_t mn = cm, mtn = cmt; mm_acc(mn, cmt, cp); mm_acc(mtn, cp, cmt); cm = mn; cmt = mtn; } while (0)
#define RK_CH_A() do { bf16x8_t fa[4], fb[4]; mm_ld<4>(fa, fb, BE, P64, AL, P64, r32, hi); \
        _Pragma("unroll") for (int i = 0; i < 16; ++i) { cp[i] = 0.f; cpt[i] = 0.f; } \
        mm_do<4>(cp, fa, fb); mm_do<4>(cpt, fb, fa);                                     \
        _Pragma("unroll") for (int r = 0; r < 16; ++r) { const int m_ = crow32(r, hi); cp[r] = (m_ < r32) ? cp[r] : 0.f; cpt[r] = (r32 < m_) ? cpt[r] : 0.f; const float id_ = (m_ == r32) ? 1.0f : 0.f; cm[r] = cp[r] + id_; cmt[r] = cpt[r] + id_; } \
        RK_CH_RND(); RK_CH_RND(); } while (0)
#define RK_CH_B() do { RK_CH_RND(); RK_CH_RND(); } while (0)
#define RK_H4(cn) do { if (wave == 0) RK_CH_A(); \
        else if (wave < 3) { LAS bf16* BRTn = (LAS bf16*)(F.lds + (((cn) & 1) ? RK_BRT2 : RK_BRT)); f32x16_t acc; \
        _Pragma("unroll") for (int i = 0; i < 16; ++i) acc[i] = 0.f; \
        if (wave == 1) { f32x16_t ac2; _Pragma("unroll") for (int i = 0; i < 16; ++i) ac2[i] = 0.f; \
            mm_abt<4>(acc, AL, P64, KA, P64, r32, hi); mm_abt<4>(ac2, RH, P64, KA, P64, r32, hi); \
            _Pragma("unroll") for (int r = 0; r < 16; ++r) { acc[r] = (r32 < crow32(r, hi)) ? acc[r] : 0.f; ac2[r] = (r32 <= crow32(r, hi)) ? ac2[r] : 0.f; } \
            RK_ST_ROWS(NT, acc); RK_ST_ROWS(KRT, ac2); } \
        else { mm_abt<4>(acc, RH, P64, BE, P64, r32, hi); \
            _Pragma("unroll") for (int r = 0; r < 16; ++r) acc[r] = (r32 <= crow32(r, hi)) ? acc[r] : 0.f; \
            RK_ST_ROWS(BRTn, acc); } } } while (0)
    RK_LOAD(0);
    for (int u = tid; u < 64 * P64 / 2; u += NTHR) ((LAS unsigned*)ZB)[u] = 0u;
    if (tid < 64) GAM[tid] = 1.f;
    f32x16_t zacc, cp, cpt, cm, cmt;
#pragma unroll
    for (int i = 0; i < 16; ++i) { zacc[i] = 0.f; cp[i] = 0.f; cpt[i] = 0.f; cm[i] = 0.f; cmt[i] = 0.f; }
#define RK_RELANE() int ln_ = F.lane, td_ = F.tid; asm volatile("" : "+v"(ln_), "+v"(td_)); const int lane = ln_, tid = td_, r32 = ln_ & 31, hi = ln_ >> 5; (void)lane; (void)tid; (void)r32; (void)hi;
    RK_H1(); RK_LOAD(1);
    lds_barrier();
    { RK_RELANE() RK_H2(0); }
    lds_barrier();
    { RK_RELANE() RK_H3(0); }
    lds_barrier();
    { RK_RELANE() RK_H4(0); } RK_H1(); RK_LOAD(2);
    lds_barrier();
    unsigned dga_ = 0;
    for (int c = 0; c < NCH; ++c) {
        const int tok0 = tokb + c * RC;
        int ln_ = F.lane, td_ = F.tid; asm volatile("" : "+v"(ln_), "+v"(td_));
        const int lane = ln_, tid = td_, r32 = ln_ & 31, hi = ln_ >> 5;
        const LAS bf16* Zc = ZB + (c & 1) * 64 * P64; LAS bf16* Zn = ZB + ((c + 1) & 1) * 64 * P64;
        const LAS bf16* BRTc = (const LAS bf16*)(F.lds + ((c & 1) ? RK_BRT2 : RK_BRT)); const LAS bf16* BETc = (const LAS bf16*)(F.lds + ((c & 1) ? RK_BET2 : RK_BET));
        DG_START(70, dg70_) DG_START(73, dg73_) DG_START(76, dg76_)
        f32x16_t yacc0, yacc1;
        if (wave == 0) RK_CH_B();
        else if (wave < 3) { const int vb = wave - 1; f32x16_t acc;
#pragma unroll
            for (int i = 0; i < 16; ++i) acc[i] = 0.f;
            mm_abt2<4, 2>(acc, Zc + 32 * vb * P64, P64, AL, P64, VT + 32 * vb * P32, P32, NT, P32, r32, hi);
            RK_ST_ROWS(XB + 32 * vb * P32, acc); }
        else if (wave == 3) {
#pragma unroll
            for (int i = 0; i < 16; ++i) { yacc0[i] = 0.f; yacc1[i] = 0.f; }
            mm_abt2<4, 2>(yacc0, Zc, P64, RH, P64, VT, P32, KRT, P32, r32, hi);
            mm_abt2<4, 2>(yacc1, Zc + 32 * P64, P64, RH, P64, VT + 32 * P32, P32, KRT, P32, r32, hi); }
        else { mm_abt<2>(zacc, VT + 32 * ((wave - 4) >> 1) * P32, P32, KAT + 32 * ((wave - 4) & 1) * P32, P32, r32, hi);
            if (c + 1 < NCH) RK_H2(c + 1); }
        if (DIAG_SLOT_D == 73) { asm volatile("s_waitcnt lgkmcnt(0)" ::: "memory"); DG_STOP(73, dg73_, dga_) }
        lds_barrier();
        DG_STOP(70, dg70_, dga_) DG_START(71, dg71_) DG_START(74, dg74_)
        if (wave == 0) {
            const bf16x8_t mb0 = acc_frag(cm, 0), mb1 = acc_frag(cm, 1);
#pragma unroll
            for (int vb = 0; vb < 2; ++vb) { f32x16_t acc;
#pragma unroll
                for (int i = 0; i < 16; ++i) acc[i] = 0.f;
                const LAS bf16* xr = XB + (32 * vb + r32) * P32 + 4 * hi;
                v4u x0, x1; { const unsigned long long u0 = *(const LAS unsigned long long*)(xr), u1 = *(const LAS unsigned long long*)(xr + 8), u2 = *(const LAS unsigned long long*)(xr + 16), u3 = *(const LAS unsigned long long*)(xr + 24);
                    x0.x = (unsigned)u0; x0.y = (unsigned)(u0 >> 32); x0.z = (unsigned)u1; x0.w = (unsigned)(u1 >> 32); x1.x = (unsigned)u2; x1.y = (unsigned)(u2 >> 32); x1.z = (unsigned)u3; x1.w = (unsigned)(u3 >> 32); }
                acc = __builtin_amdgcn_mfma_f32_32x32x16_bf16(__builtin_bit_cast(bf16x8_t, x0), mb0, acc, 0, 0, 0);
                acc = __builtin_amdgcn_mfma_f32_32x32x16_bf16(__builtin_bit_cast(bf16x8_t, x1), mb1, acc, 0, 0, 0);
                RK_ST_ROWS(EB + 32 * vb * P32, acc); } }
        if (c + 1 < NCH) RK_H3(c + 1);
        if (DIAG_SLOT_D == 74) { asm volatile("s_waitcnt lgkmcnt(0)" ::: "memory"); DG_STOP(74, dg74_, dga_) }
        lds_barrier();
        DG_STOP(71, dg71_, dga_) DG_START(72, dg72_) DG_START(75, dg75_)
        if (c + 2 < NCH) { RK_H1(); if (c + 3 < NCH) RK_LOAD(c + 3); }
        if (wave == 3) {
            mm_abt<2>(yacc0, EB, P32, BRTc, P32, r32, hi); mm_abt<2>(yacc1, EB + 32 * P32, P32, BRTc, P32, r32, hi);
            bf16* yo = P + (size_t)(tok0 + r32) * PP + h * 64 + 4 * hi;
#pragma unroll
            for (int g = 0; g < 4; ++g) { *(GAS unsigned long long*)(yo + 8 * g) = (unsigned long long)pk2(yacc0[4 * g], yacc0[4 * g + 1]) | ((unsigned long long)pk2(yacc0[4 * g + 2], yacc0[4 * g + 3]) << 32);
                *(GAS unsigned long long*)(yo + 32 + 8 * g) = (unsigned long long)pk2(yacc1[4 * g], yacc1[4 * g + 1]) | ((unsigned long long)pk2(yacc1[4 * g + 2], yacc1[4 * g + 3]) << 32); } }
        else if (wave >= 4) { const int vb = (wave - 4) >> 1, kb = (wave - 4) & 1;
            mm_abt<2>(zacc, EB + 32 * vb * P32, P32, BETc + 32 * kb * P32, P32, r32, hi);
            const float gc = GC[(c & 1) * 64 + 32 * kb + r32];
#pragma unroll
            for (int r = 0; r < 16; ++r) { zacc[r] *= gc; Zn[(32 * vb + crow32(r, hi)) * P64 + 32 * kb + r32] = (bf16)(pk2(zacc[r], 0.f) & 0xffffu); } }
        if (c + 1 < NCH) RK_H4(c + 1);
        if (DIAG_SLOT_D == 75) { asm volatile("s_waitcnt lgkmcnt(0)" ::: "memory"); DG_STOP(75, dg75_, dga_) }
        lds_barrier();
        DG_STOP(72, dg72_, dga_) DG_STOP(76, dg76_, dga_)
    }
    DG_WRITE(70, unit == 0 && l == 0 && F.tid == 0, dga_) DG_WRITE(71, unit == 0 && l == 0 && F.tid == 0, dga_) DG_WRITE(72, unit == 0 && l == 0 && F.tid == 0, dga_) DG_WRITE(76, unit == 0 && l == 0 && F.tid == 0, dga_)
    DG_WRITE(73, unit == 0 && l == 0 && F.tid == 448, dga_) DG_WRITE(74, unit == 0 && l == 0 && F.tid == 64, dga_) DG_WRITE(75, unit == 0 && l == 0 && F.tid == 0, dga_)
#undef RK_LOAD
#undef RK_H1
#undef RK_PROD8
#undef RK_H2
#undef RK_H3
#undef RK_H4
#undef RK_RELANE
#undef RK_CH_A
#undef RK_CH_RND
#undef RK_CH_B
#undef RK_ST_ROWS
#undef RK_ST_COLS
}

constexpr int RP = 72;
constexpr int RT_QR = 0, RT_KR = 128 * RP * 2, RT_VV = 2 * 128 * RP * 2, RT_ST = 3 * 128 * RP * 2, RT_SS = RT_ST + 64 * RP * 2, RT_KD = RT_SS + 1024;
__device__ __forceinline__ void ret_out_unit(const Frame& F, int unit) {
    const int tid = F.tid, lane = F.lane, wave = F.wave, r32 = lane & 31, hi = lane >> 5;
    const int h = unit & 3, b = unit >> 2;
    bf16* P = (bf16*)(F.ws + WS_P); const float* tab = (const float*)(F.ws + WS_TAB);
    LAS bf16* QR = (LAS bf16*)(F.lds + RT_QR); LAS bf16* KR = (LAS bf16*)(F.lds + RT_KR); LAS bf16* VV = (LAS bf16*)(F.lds + RT_VV); LAS bf16* ST = (LAS bf16*)(F.lds + RT_ST);
    LAS float* SS = (LAS float*)(F.lds + RT_SS); LAS bf16* KD = (LAS bf16*)(F.lds + RT_KD);
    const float lg2 = log2f(1.0f - exp2f(-5.0f - (float)h));
    f32x16_t st;
#pragma unroll
    for (int i = 0; i < 16; ++i) st[i] = 0.f;
    const float cdec = exp2f(128.0f * lg2);
    unsigned long long pre[2][6]; f32x4 pret[2][2];
#define RT_LOAD(cn) do { _Pragma("unroll") for (int it_ = 0; it_ < 2; ++it_) { const int idx_ = tid + it_ * NTHR, m_ = idx_ >> 3, i4_ = (idx_ & 7) * 4; const size_t ro_ = (size_t)(b * SEQ + (cn) * 128 + m_) * PP + h * 64 + i4_; \
        pre[it_][0] = *(const GAS unsigned long long*)(P + ro_ + PCQ); pre[it_][1] = *(const GAS unsigned long long*)(P + ro_ + PCQ + 32); pre[it_][2] = *(const GAS unsigned long long*)(P + ro_ + PCK); \
        pre[it_][3] = *(const GAS unsigned long long*)(P + ro_ + PCK + 32); pre[it_][4] = *(const GAS unsigned long long*)(P + ro_ + PCV); pre[it_][5] = *(const GAS unsigned long long*)(P + ro_ + PCV + 32); \
        pret[it_][0] = *(const GAS f32x4*)(tab + ((size_t)((cn) * 128 + m_) * 32 + i4_) * 2); pret[it_][1] = *(const GAS f32x4*)(tab + ((size_t)((cn) * 128 + m_) * 32 + i4_) * 2 + 4); } } while (0)
    unsigned dga_ = 0;
    DG_START(60, dg60_)
    RT_LOAD(0);
    for (int c = 0; c < 16; ++c) {
    const int tok0 = b * SEQ + c * 128;
#pragma unroll
    for (int it = 0; it < 2; ++it) { const int idx = tid + it * NTHR, m = idx >> 3, i4 = (idx & 7) * 4;
        const unsigned long long q1w = pre[it][0], q2w = pre[it][1], k1w = pre[it][2], k2w = pre[it][3], v1w = pre[it][4], v2w = pre[it][5];
        const f32x4 t0 = pret[it][0], t1 = pret[it][1];
        const float cs[4] = {t0[0], t0[2], t1[0], t1[2]}, sn[4] = {t0[1], t0[3], t1[1], t1[3]};
        const float q1[4] = {bflo((unsigned)q1w), bfhi((unsigned)q1w), bflo((unsigned)(q1w >> 32)), bfhi((unsigned)(q1w >> 32))}, q2[4] = {bflo((unsigned)q2w), bfhi((unsigned)q2w), bflo((unsigned)(q2w >> 32)), bfhi((unsigned)(q2w >> 32))};
        const float k1[4] = {bflo((unsigned)k1w), bfhi((unsigned)k1w), bflo((unsigned)(k1w >> 32)), bfhi((unsigned)(k1w >> 32))}, k2[4] = {bflo((unsigned)k2w), bfhi((unsigned)k2w), bflo((unsigned)(k2w >> 32)), bfhi((unsigned)(k2w >> 32))};
        float qa[4], qb[4], ka[4], kb[4];
#pragma unroll
        for (int j = 0; j < 4; ++j) { qa[j] = q1[j] * cs[j] - q2[j] * sn[j]; qb[j] = q1[j] * sn[j] + q2[j] * cs[j]; ka[j] = (k1[j] * cs[j] - k2[j] * sn[j]) * 0.125f; kb[j] = (k1[j] * sn[j] + k2[j] * cs[j]) * 0.125f; }
        *(LAS unsigned long long*)(QR + m * RP + i4) = (unsigned long long)pk2(qa[0], qa[1]) | ((unsigned long long)pk2(qa[2], qa[3]) << 32);
        *(LAS unsigned long long*)(QR + m * RP + 32 + i4) = (unsigned long long)pk2(qb[0], qb[1]) | ((unsigned long long)pk2(qb[2], qb[3]) << 32);
        *(LAS unsigned long long*)(KR + m * RP + i4) = (unsigned long long)pk2(ka[0], ka[1]) | ((unsigned long long)pk2(ka[2], ka[3]) << 32);
        *(LAS unsigned long long*)(KR + m * RP + 32 + i4) = (unsigned long long)pk2(kb[0], kb[1]) | ((unsigned long long)pk2(kb[2], kb[3]) << 32);
        { const float kd = exp2f((float)(127 - m) * lg2);
          *(LAS unsigned long long*)(KD + m * RP + i4) = (unsigned long long)pk2(ka[0] * kd, ka[1] * kd) | ((unsigned long long)pk2(ka[2] * kd, ka[3] * kd) << 32);
          *(LAS unsigned long long*)(KD + m * RP + 32 + i4) = (unsigned long long)pk2(kb[0] * kd, kb[1] * kd) | ((unsigned long long)pk2(kb[2] * kd, kb[3] * kd) << 32); }
        *(LAS unsigned long long*)(VV + m * RP + i4) = v1w; *(LAS unsigned long long*)(VV + m * RP + 32 + i4) = v2w; }
    if (c + 1 < 16) RT_LOAD(c + 1);
    if (wave < 4) {
        const int db = wave >> 1, ebs = wave & 1;
#pragma unroll
        for (int i = 0; i < 16; ++i) ST[(32 * db + crow32(i, hi)) * RP + 32 * ebs + r32] = (bf16)(pk2(st[i], 0.f) & 0xffffu);
    }
    lds_barrier();
    const int nb = wave >> 1, eb = wave & 1, n = nb * 32 + r32;
    const unsigned blk_ = (lane >> 4) & 1, q_ = (lane & 15) >> 2, p_ = lane & 3;
    bf16x8_t qf[4];
#pragma unroll
    for (int ks = 0; ks < 4; ++ks) qf[ks] = *(const LAS bf16x8_t*)(QR + n * RP + ks * 16 + hi * 8);
    f32x16_t y;
#pragma unroll
    for (int i = 0; i < 16; ++i) y[i] = 0.f;
#pragma unroll
    for (int ks = 0; ks < 4; ++ks) {
        const s16x4_t lo = __builtin_bit_cast(s16x4_t, __builtin_amdgcn_ds_read_tr16_b64_v4i16((LAS s16x4_t*)(ST + (16 * ks + 8 * hi + q_) * RP + 32 * eb + 16 * blk_ + 4 * p_)));
        const s16x4_t hh = __builtin_bit_cast(s16x4_t, __builtin_amdgcn_ds_read_tr16_b64_v4i16((LAS s16x4_t*)(ST + (16 * ks + 8 * hi + 4 + q_) * RP + 32 * eb + 16 * blk_ + 4 * p_)));
        const bf16x8_t a = (bf16x8_t){lo[0], lo[1], lo[2], lo[3], hh[0], hh[1], hh[2], hh[3]};
        y = __builtin_amdgcn_mfma_f32_32x32x16_bf16(a, qf[ks], y, 0, 0, 0); }
    { const float qd = exp2f((float)(n + 1) * lg2);
#pragma unroll
      for (int i = 0; i < 16; ++i) y[i] *= qd; }
    unsigned long long gpre[4];
#pragma unroll
    for (int g = 0; g < 4; ++g) gpre[g] = *(const GAS unsigned long long*)(P + (size_t)(tok0 + n) * PP + PCG + h * 64 + 32 * eb + 8 * g + 4 * hi);
    for (int mt = 0; mt <= nb; ++mt) {
        f32x16_t S;
#pragma unroll
        for (int i = 0; i < 16; ++i) S[i] = 0.f;
#pragma unroll
        for (int ks = 0; ks < 4; ++ks) { const bf16x8_t a = *(const LAS bf16x8_t*)(KR + (mt * 32 + r32) * RP + ks * 16 + hi * 8); S = __builtin_amdgcn_mfma_f32_32x32x16_bf16(a, qf[ks], S, 0, 0, 0); }
        float e[16];
#pragma unroll
        for (int r = 0; r < 16; ++r) { const int dm = r32 - crow32(r, hi) + 32 * (nb - mt); e[r] = (dm >= 0) ? S[r] * exp2f((float)dm * lg2) : 0.f; }
#pragma unroll
        for (int s = 0; s < 2; ++s) { v4u w; w.x = pk2(e[8 * s], e[8 * s + 1]); w.y = pk2(e[8 * s + 2], e[8 * s + 3]); w.z = pk2(e[8 * s + 4], e[8 * s + 5]); w.w = pk2(e[8 * s + 6], e[8 * s + 7]);
            const bf16x8_t xs = __builtin_bit_cast(bf16x8_t, w);
            const s16x4_t lo = __builtin_bit_cast(s16x4_t, __builtin_amdgcn_ds_read_tr16_b64_v4i16((LAS s16x4_t*)(VV + (mt * 32 + 16 * s + 4 * hi + q_) * RP + 32 * eb + 16 * blk_ + 4 * p_)));
            const s16x4_t hh = __builtin_bit_cast(s16x4_t, __builtin_amdgcn_ds_read_tr16_b64_v4i16((LAS s16x4_t*)(VV + (mt * 32 + 16 * s + 8 + 4 * hi + q_) * RP + 32 * eb + 16 * blk_ + 4 * p_)));
            const bf16x8_t a = (bf16x8_t){lo[0], lo[1], lo[2], lo[3], hh[0], hh[1], hh[2], hh[3]};
            y = __builtin_amdgcn_mfma_f32_32x32x16_bf16(a, xs, y, 0, 0, 0); }
    }
    float ss = 0.f;
#pragma unroll
    for (int i = 0; i < 16; ++i) ss += y[i] * y[i];
    ss += __shfl_xor(ss, 32);
    if (hi == 0) SS[(nb * 2 + eb) * 32 + r32] = ss;
    lds_barrier();
    ss += SS[(nb * 2 + (eb ^ 1)) * 32 + r32];
    const float rs = 1.0f / sqrtf(ss * (1.0f / 64.0f) + 1e-6f);
    const size_t ro = (size_t)(tok0 + n) * PP;
#pragma unroll
    for (int g = 0; g < 4; ++g) { const int e0 = 32 * eb + 8 * g + 4 * hi;
        const unsigned long long gw = gpre[g];
        const float g0 = bflo((unsigned)gw), g1 = bfhi((unsigned)gw), g2 = bflo((unsigned)(gw >> 32)), g3 = bfhi((unsigned)(gw >> 32));
        const float o0 = g0 * sigmoid_f(g0) * y[4 * g] * rs, o1 = g1 * sigmoid_f(g1) * y[4 * g + 1] * rs, o2 = g2 * sigmoid_f(g2) * y[4 * g + 2] * rs, o3 = g3 * sigmoid_f(g3) * y[4 * g + 3] * rs;
        *(GAS unsigned long long*)(P + ro + 768 + h * 64 + e0) = (unsigned long long)pk2(o0, o1) | ((unsigned long long)pk2(o2, o3) << 32); }
    if (wave < 4) {
        const int db = wave >> 1, ebs = wave & 1;
#pragma unroll
        for (int i = 0; i < 16; ++i) st[i] *= cdec;
#pragma unroll
        for (int ks = 0; ks < 8; ++ks) {
            const s16x4_t alo = __builtin_bit_cast(s16x4_t, __builtin_amdgcn_ds_read_tr16_b64_v4i16((LAS s16x4_t*)(KD + (16 * ks + 8 * hi + q_) * RP + 32 * db + 16 * blk_ + 4 * p_)));
            const s16x4_t ahi = __builtin_bit_cast(s16x4_t, __builtin_amdgcn_ds_read_tr16_b64_v4i16((LAS s16x4_t*)(KD + (16 * ks + 8 * hi + 4 + q_) * RP + 32 * db + 16 * blk_ + 4 * p_)));
            const s16x4_t blo = __builtin_bit_cast(s16x4_t, __builtin_amdgcn_ds_read_tr16_b64_v4i16((LAS s16x4_t*)(VV + (16 * ks + 8 * hi + q_) * RP + 32 * ebs + 16 * blk_ + 4 * p_)));
            const s16x4_t bhi = __builtin_bit_cast(s16x4_t, __builtin_amdgcn_ds_read_tr16_b64_v4i16((LAS s16x4_t*)(VV + (16 * ks + 8 * hi + 4 + q_) * RP + 32 * ebs + 16 * blk_ + 4 * p_)));
            const bf16x8_t a = (bf16x8_t){alo[0], alo[1], alo[2], alo[3], ahi[0], ahi[1], ahi[2], ahi[3]}, bb = (bf16x8_t){blo[0], blo[1], blo[2], blo[3], bhi[0], bhi[1], bhi[2], bhi[3]};
            st = __builtin_amdgcn_mfma_f32_32x32x16_bf16(a, bb, st, 0, 0, 0); }
    }
    lds_barrier();
    }
    DG_STOP(60, dg60_, dga_)
    DG_WRITE(60, unit == 0 && wave == 0 && lane == 0, dga_)
#undef RT_LOAD
}

constexpr int PT = 32, XSP = 1304;
constexpr int PR_XS = 0, PR_STG = PT * XSP * 2, PR_CONST = PR_STG + 32768, PR_MU = PR_CONST + 6 * 384 * 4;
__device__ __forceinline__ void prep_consts(const Frame& F, int l) {
    LAS float* CS = (LAS float*)(F.lds + PR_CONST);
    for (int i = F.tid; i < AW; i += NTHR) { CS[i] = F.in[I_KK][l * AW + i]; CS[AW + i] = F.in[I_KA][l * AW + i]; CS[2 * AW + i] = F.in[I_RK][l * AW + i];
        CS[3 * AW + i] = F.in[I_W0][l * AW + i]; CS[4 * AW + i] = F.in[I_A0][l * AW + i]; CS[5 * AW + i] = (l > 0) ? F.in[I_V0][(l - 1) * AW + i] : 0.f; }
    LAS float* MU = (LAS float*)(F.lds + PR_MU);
    for (int i = F.tid; i < 1296; i += NTHR) MU[i] = (i < 1280) ? F.in[I_MU][l * 1280 + i] : ((l > 0) ? F.in[I_VRMU][(l - 1) * 16 + i - 1280] : 0.f);
    __syncthreads();
}
__device__ __forceinline__ float softplus_f(float z) { return fmaxf(z, 0.f) + __logf(1.0f + __expf(-fabsf(z))); }
__device__ __forceinline__ float tanh_f(float x) { const float e = __expf(2.0f * x); return 1.0f - 2.0f * __builtin_amdgcn_rcpf(e + 1.0f); }
__device__ __forceinline__ void small_weights(const Frame& F) {
    for (int l = 0; l < DEPTH; ++l) {
        const float* w2 = F.in[I_W2] + (size_t)l * 32 * AW; const float* a2 = F.in[I_A2] + (size_t)l * 32 * AW; const float* g2 = F.in[I_G2] + (size_t)l * 64 * AW;
        const float* v2 = F.in[I_V2] + (size_t)(l > 0 ? l - 1 : 0) * 16 * AW;
        bf16* LT = (bf16*)(F.ws + WS_LORA) + (size_t)l * AW * 144;
        for (int i = F.vcu * NTHR + F.tid; i < AW * 144; i += F.G * NTHR) { const int n = i / 144, k = i - n * 144; float v;
            if (k < 32) v = w2[k * AW + n]; else if (k < 64) v = a2[(k - 32) * AW + n]; else if (k < 128) v = g2[(k - 64) * AW + n]; else v = (l > 0) ? v2[(k - 128) * AW + n] : 0.f;
            LT[i] = (bf16)f2bf(v); }
        const float* wuk = F.in[I_WUK] + (size_t)l * 6 * 64 * 128; const float* wuv = F.in[I_WUV] + (size_t)l * 6 * 128 * 64;
        bf16* wukT = (bf16*)(F.ws + WS_WUKT) + (size_t)l * 6 * 64 * 128; bf16* wuvT = (bf16*)(F.ws + WS_WUVT) + (size_t)l * 6 * 64 * 128;
        for (int i = F.vcu * NTHR + F.tid; i < 6 * 64 * 128; i += F.G * NTHR) {
            { const int hh = i / 8192, rem = i - hh * 8192, c = rem >> 6, d = rem & 63; wukT[i] = (bf16)f2bf(wuk[(hh * 64 + d) * 128 + c]); }
            { const int hh = i / 8192, rem = i - hh * 8192, d = rem >> 7, c = rem & 127; wuvT[i] = (bf16)f2bf(wuv[(hh * 128 + c) * 64 + d]); } }
    }
}
__device__ __forceinline__ void prep_tokens_unit(const Frame& F, int l, int unit) {
    LAS bf16* XS = (LAS bf16*)(F.lds + PR_XS);
    const int tid = F.tid, lane = F.lane, wave = F.wave, r32 = lane & 31, hi = lane >> 5, tok0 = unit * PT;
    const bf16* P = (const bf16*)(F.ws + WS_P);
    unsigned dga_ = 0;
    DG_START(20, dg20_)
    for (int base = 0; base < PT * 162; base += 5 * NTHR) {
        v4u cw[5], pw[5];
#pragma unroll
        for (int u = 0; u < 5; ++u) { const int idx = base + u * NTHR + tid; const int idc = idx < PT * 162 ? idx : PT * 162 - 1; const int t = idc / 162, ch = idc - t * 162, tok = tok0 + t;
            cw[u] = *(const GAS v4u*)(P + (size_t)tok * PP + ch * 8);
            const int tokp = (tok & (SEQ - 1)) != 0 ? tok - 1 : tok; pw[u] = *(const GAS v4u*)(P + (size_t)tokp * PP + ch * 8); }
#pragma unroll
        for (int u = 0; u < 5; ++u) { const int idx = base + u * NTHR + tid;
            if (idx < PT * 162) { const int t = idx / 162, ch = idx - t * 162, tok = tok0 + t, c0 = ch * 8;
                float cur[8], prv[8]; unpack8(cw[u], cur); unpack8(pw[u], prv);
                const bool first = (tok & (SEQ - 1)) == 0;
                float mv[8];
                { const LAS f32x4* mp = (const LAS f32x4*)((const LAS float*)(F.lds + PR_MU) + c0); const f32x4 m0 = mp[0], m1 = mp[1]; mv[0] = m0[0]; mv[1] = m0[1]; mv[2] = m0[2]; mv[3] = m0[3]; mv[4] = m1[0]; mv[5] = m1[1]; mv[6] = m1[2]; mv[7] = m1[3]; }
                float o[8];
#pragma unroll
                for (int j = 0; j < 8; ++j) { const float pv = first ? 0.f : prv[j]; float v = cur[j] + (pv - cur[j]) * mv[j];
                    if (c0 >= 1152 && c0 < 1184) v = tanh_f(v); else if (c0 >= 1216 && c0 < 1280) v = sigmoid_f(v);
                    o[j] = v; }
                v4u w; w.x = pk2(o[0], o[1]); w.y = pk2(o[2], o[3]); w.z = pk2(o[4], o[5]); w.w = pk2(o[6], o[7]);
                *(LAS v4u*)(XS + t * XSP + c0) = w; } }
    }
    __syncthreads();
    DG_STOP(20, dg20_, dga_)
    DG_WRITE(20, unit == 0 && l == 0 && wave == 0 && lane == 0, dga_)
    DG_START(21, dg21_)
    if (wave < 6) {
        const int h = wave;
        LAS bf16* STG = (LAS bf16*)(F.lds + PR_STG + wave * 4096);
        GAS unsigned char* wsb = (GAS unsigned char*)F.ws;
        GAS unsigned char* outb = (GAS unsigned char*)F.out;
        const bf16* LT = (const bf16*)(F.ws + WS_LORA) + (size_t)l * AW * 144;
        const LAS float* CS = (const LAS float*)(F.lds + PR_CONST) + h * 64;
        const LAS float* kkw = CS; const LAS float* kaw = CS + AW; const LAS float* rkw = CS + 2 * AW; const LAS float* w0p = CS + 3 * AW; const LAS float* a0p = CS + 4 * AW; const LAS float* v0p = CS + 5 * AW;
        const LAS bf16* xrow = XS + r32 * XSP;
        float rn;
        { float ss = 0.f;
#pragma unroll
          for (int cbl = 0; cbl < 2; ++cbl)
#pragma unroll
              for (int g = 0; g < 4; ++g) { const int j0 = cbl * 32 + 8 * g + 4 * hi; const unsigned long long kw = *(const LAS unsigned long long*)(xrow + 384 + h * 64 + j0); const f32x4 kk4 = *(const LAS f32x4*)(kkw + j0);
                  const float k0 = bflo((unsigned)kw) * kk4[0], k1 = bfhi((unsigned)kw) * kk4[1], k2 = bflo((unsigned)(kw >> 32)) * kk4[2], k3 = bfhi((unsigned)(kw >> 32)) * kk4[3]; ss += (k0 * k0 + k1 * k1) + (k2 * k2 + k3 * k3); }
          ss += __shfl_xor(ss, 32); rn = 1.0f / fmaxf(sqrtf(ss), 1e-12f); }
        float bonus = 0.f;
        const int srow = lane >> 2, sch = lane & 3;
#pragma unroll
        for (int cbl = 0; cbl < 2; ++cbl) {
            asm volatile("" ::: "memory");
            const int cb0 = h * 64 + cbl * 32;
            f32x16_t wv, av, gv, mvv;
#pragma unroll
            for (int i = 0; i < 16; ++i) { wv[i] = 0.f; av[i] = 0.f; gv[i] = 0.f; mvv[i] = 0.f; }
            const bf16* lrow = LT + (size_t)(cb0 + r32) * 144 + 8 * hi;
#pragma unroll
            for (int ks = 0; ks < 9; ++ks) { const bf16x8_t a = *(const GAS bf16x8_t*)(lrow + 16 * ks); const bf16x8_t bx = *(const LAS bf16x8_t*)(xrow + 1152 + 16 * ks + 8 * hi);
                if (ks < 2) wv = __builtin_amdgcn_mfma_f32_32x32x16_bf16(a, bx, wv, 0, 0, 0);
                else if (ks < 4) av = __builtin_amdgcn_mfma_f32_32x32x16_bf16(a, bx, av, 0, 0, 0);
                else if (ks < 8) gv = __builtin_amdgcn_mfma_f32_32x32x16_bf16(a, bx, gv, 0, 0, 0);
                else mvv = __builtin_amdgcn_mfma_f32_32x32x16_bf16(a, bx, mvv, 0, 0, 0); }
            if (l > 0) {
#pragma unroll
                for (int i = 0; i < 2; ++i) { const int row = srow + 16 * i; const unsigned eo = (unsigned)(((tok0 + row) * AW + cb0 + sch * 8) * 2); *(LAS v4u*)(STG + row * 32 + sch * 8) = *(const GAS v4u*)(wsb + WS_VF + eo); } }
            unsigned long long ro[4], dd[4], k2o[4], kko[4], bpo[4], vo[4], go[4];
#pragma unroll
            for (int g = 0; g < 4; ++g) { const int j0 = cbl * 32 + 8 * g + 4 * hi;
                const unsigned long long rw = *(const LAS unsigned long long*)(xrow + h * 64 + j0), kw = *(const LAS unsigned long long*)(xrow + 384 + h * 64 + j0), vw = *(const LAS unsigned long long*)(xrow + 768 + h * 64 + j0);
                unsigned long long fw = 0ull; if (l > 0) fw = *(const LAS unsigned long long*)(STG + r32 * 32 + 8 * g + 4 * hi);
                asm volatile("" : "+v"(bonus) :: "memory");
                const f32x4 kk4 = *(const LAS f32x4*)(kkw + j0), ka4 = *(const LAS f32x4*)(kaw + j0), rk4 = *(const LAS f32x4*)(rkw + j0), w04 = *(const LAS f32x4*)(w0p + j0), a04 = *(const LAS f32x4*)(a0p + j0);
                const f32x4 v04 = *(const LAS f32x4*)(v0p + j0);
                const float rr[4] = {bflo((unsigned)rw), bfhi((unsigned)rw), bflo((unsigned)(rw >> 32)), bfhi((unsigned)(rw >> 32))};
                const float kx[4] = {bflo((unsigned)kw), bfhi((unsigned)kw), bflo((unsigned)(kw >> 32)), bfhi((unsigned)(kw >> 32))};
                const float vx[4] = {bflo((unsigned)vw), bfhi((unsigned)vw), bflo((unsigned)(vw >> 32)), bfhi((unsigned)(vw >> 32))};
                const float fx[4] = {bflo((unsigned)fw), bfhi((unsigned)fw), bflo((unsigned)(fw >> 32)), bfhi((unsigned)(fw >> 32))};
                float d_[4], k2_[4], kk_[4], bp_[4], v_[4];
#pragma unroll
                for (int e = 0; e < 4; ++e) { const int i = 4 * g + e;
                    const float sp = softplus_f(-(wv[i] + w04[e])); const float rate = __expf(-sp - 0.5f); const float d = 1.0f - __expf(-rate);
                    const float a = sigmoid_f(av[i] + a04[e]);
                    float v = vx[e]; if (l > 0) v = v + (fx[e] - v) * sigmoid_f(mvv[i] + v04[e]);
                    const float kk = kx[e] * kk4[e] * rn, k2 = kx[e] * (1.0f + (a - 1.0f) * ka4[e]);
                    d_[e] = d; k2_[e] = k2; kk_[e] = kk; bp_[e] = kk * a; v_[e] = v;
                    bonus += rr[e] * k2 * rk4[e]; }
#define PK4(x) ((unsigned long long)pk2(x[0], x[1]) | ((unsigned long long)pk2(x[2], x[3]) << 32))
                ro[g] = rw; dd[g] = PK4(d_); k2o[g] = PK4(k2_); kko[g] = PK4(kk_); bpo[g] = PK4(bp_); vo[g] = PK4(v_);
                go[g] = (unsigned long long)pk2(gv[4 * g], gv[4 * g + 1]) | ((unsigned long long)pk2(gv[4 * g + 2], gv[4 * g + 3]) << 32); }
#define PR_OUT(arr, bs_, dst) do { _Pragma("unroll") for (int g = 0; g < 4; ++g) *(LAS unsigned long long*)(STG + r32 * 32 + 8 * g + 4 * hi) = arr[g]; \
            _Pragma("unroll") for (int i = 0; i < 2; ++i) { const int row = srow + 16 * i; const unsigned eo = (unsigned)(((tok0 + row) * AW + cb0 + sch * 8) * 2); *(GAS v4u*)(bs_ + dst + eo) = *(const LAS v4u*)(STG + row * 32 + sch * 8); } } while (0)
            PR_OUT(ro, wsb, WS_R); PR_OUT(dd, wsb, WS_D); PR_OUT(k2o, wsb, WS_K2); PR_OUT(kko, wsb, WS_KK); PR_OUT(bpo, outb, OUT_BP); PR_OUT(vo, wsb, WS_VF); PR_OUT(go, outb, OUT_G);
#undef PR_OUT
#undef PK4
        }
        bonus += __shfl_xor(bonus, 32);
        if (hi == 0) ((float*)(F.ws + WS_BON))[(size_t)(tok0 + r32) * 6 + h] = bonus;
    } else {
        const float* kvn = F.in[I_KVN] + l * 128; bf16* C = (bf16*)(F.ws + WS_C);
        for (int q = 0; q < 16; ++q) { const int tok = tok0 + 16 * (wave - 6) + q; const unsigned w = *(const GAS unsigned*)(P + (size_t)tok * PP + PBC + 2 * lane);
            const float c0 = bflo(w), c1 = bfhi(w); const float ss = wave_sum(c0 * c0 + c1 * c1); const float rs = 1.0f / sqrtf(ss * (1.0f / 128.0f) + 1e-6f);
            *(GAS unsigned*)(C + (size_t)tok * 128 + 2 * lane) = pk2(c0 * rs * kvn[2 * lane], c1 * rs * kvn[2 * lane + 1]); }
    }
    DG_STOP(21, dg21_, dga_)
    DG_WRITE(21, unit == 0 && l == 0 && wave == 0 && lane == 0, dga_)
    __syncthreads();
}

__device__ __forceinline__ void final_norm(const Frame& F) {
    const int gw = F.vcu * NWAVES + F.wave, NGW = F.G * NWAVES; const float* g = F.in[I_FN];
    float dgc_ = 0.f;
    if (DIAG_SLOT_D >= 0) { const unsigned* D = (const unsigned*)(F.ws + WS_DIAG); const float x0 = (float)D[0] * (1.0f / (100.0f * DIAG_DIV)); const float gq = 4.0f;
        const float kq = floorf(log2f(fmaxf(x0, 1.0f)) * gq); dgc_ = sqrtf(fmaxf(exp2f((kq + 0.5f) / gq) - 1.0f, 0.01f)); }
    const bf16* XBf = (const bf16*)(F.ws + WS_XB);
    for (int m = gw; m < M; m += NGW) { GAS f32x4* xr = (GAS f32x4*)(F.out + (size_t)m * DM); const GAS v4u* xs = (const GAS v4u*)(XBf + (size_t)m * DM); float v[2][8]; float s = 0.f;
#pragma unroll
        for (int j = 0; j < 2; ++j) { unpack8(xs[F.lane + 64 * j], v[j]);
#pragma unroll
            for (int e = 0; e < 8; ++e) s += v[j][e] * v[j][e]; }
        const float rs = 1.0f / sqrtf(wave_sum(s) * (1.0f / DM) + 1e-6f);
#pragma unroll
        for (int j = 0; j < 2; ++j) { const int c = 8 * (F.lane + 64 * j); const f32x4 g0 = *(const f32x4*)(g + c), g1 = *(const f32x4*)(g + c + 4);
            xr[c / 4] = (DIAG_SLOT_D >= 0) ? (f32x4){dgc_, dgc_, dgc_, dgc_} : (f32x4){v[j][0], v[j][1], v[j][2], v[j][3]} * rs * g0;
            xr[c / 4 + 1] = (DIAG_SLOT_D >= 0) ? (f32x4){dgc_, dgc_, dgc_, dgc_} : (f32x4){v[j][4], v[j][5], v[j][6], v[j][7]} * rs * g1; } }
}

template <class T> __device__ __forceinline__ T* launder_ptr(T* p) {
    unsigned lo = (unsigned)(uintptr_t)p, hi = (unsigned)((uintptr_t)p >> 32);
    asm volatile("" : "+v"(lo), "+v"(hi));
    lo = __builtin_amdgcn_readfirstlane(lo); hi = __builtin_amdgcn_readfirstlane(hi);
    return (T*)(((uintptr_t)hi << 32) | (uintptr_t)lo);
}
constexpr int NPHASE = 20;
constexpr int DUP_PHASE = -1;
constexpr int QDUP = 1;
constexpr int STAG_UP = 4, STAG_IN = 3;
constexpr int REP_SCAN_K = 1, REP_THR_K = 1;
constexpr int NSTEP = NPHASE + (DUP_PHASE >= 0 ? 1 : 0);
constexpr int REP_THR = 1, REP_PTOK = 1, REP_KV = 1, REP_CONV = 1, REP_SCAN = 1, REP_DSA = 1, REP_RET = 1, REP_UP = 1;
#define REPL(n) for (int rep_ = 0; rep_ < (l == 0 ? (n) : 1); ++rep_)
__global__ void __launch_bounds__(NTHR, 2) fwd_kernel(Args args) {
    extern __shared__ __attribute__((aligned(16))) unsigned char lds[];
    Frame F;
    F.lds = (LAS unsigned char*)lds;
    F.tid = threadIdx.x; F.lane = F.tid & 63; F.wave = __builtin_amdgcn_readfirstlane(F.tid >> 6);
    F.G = gridDim.x; { const int bx = blockIdx.x; F.vcu = (F.G % 8 == 0) ? (bx % 8) * (F.G / 8) + bx / 8 : bx; }
    F.in = (const float* const __attribute__((address_space(4)))*)__builtin_amdgcn_kernarg_segment_ptr(); F.out = args.out; F.ws = args.ws;
    volatile LAS unsigned* MISC = (volatile LAS unsigned*)(F.lds + MISC_OFF);
    for (int u = F.tid; u < (LDS_BYTES - LDSCTL_OFF) / 4; u += NTHR) ((LAS unsigned*)(F.lds + LDSCTL_OFF))[u] = 0u;
    __syncthreads();
    const int lo = args.ph_lo, hi = args.ph_hi;
    XcdBarrier bar; bar.bar = (unsigned*)(F.ws + WS_CTL) + CW_BAR; bar.x = 0; bar.st = nullptr;
    if (hi - lo > 1) bar = xcd_barrier_post((unsigned*)(F.ws + WS_CTL) + CW_BAR, MISC + 8);
    for (int ph_ = lo; ph_ < hi; ++ph_) {
        unsigned dgp0_ = 0; if (DIAG_SLOT_D >= 100) dgp0_ = (unsigned)__builtin_amdgcn_s_memtime();
        int ph = (args.dup_phase >= 0 && ph_ > args.dup_phase) ? ph_ - 1 : ph_; asm volatile("" : "+v"(ph)); ph = __builtin_amdgcn_readfirstlane(ph);
#define PH_ENTER() \
        { unsigned z_ = 0u; int t_ = threadIdx.x; asm volatile("" : "+v"(z_), "+v"(t_)); z_ = __builtin_amdgcn_readfirstlane(z_); F.in = (const float* const __attribute__((address_space(4)))*)((const char __attribute__((address_space(4)))*)__builtin_amdgcn_kernarg_segment_ptr() + z_); F.out = args.out + z_; F.ws = args.ws + z_; \
          F.tid = t_; F.lane = t_ & 63; F.wave = __builtin_amdgcn_readfirstlane(t_ >> 6); } \
        int bx = blockIdx.x; { int g_ = gridDim.x; asm volatile("" : "+v"(bx), "+v"(g_)); bx = __builtin_amdgcn_readfirstlane(bx); g_ = __builtin_amdgcn_readfirstlane(g_); F.G = g_; F.vcu = (g_ % 8 == 0) ? (bx % 8) * (g_ / 8) + bx / 8 : bx; } \
        gu32* ctl = (gu32*)(F.ws + WS_CTL); (void)ctl; \
        bf16* XB = (bf16*)(F.ws + WS_XB); bf16* Hb = (bf16*)(F.ws + WS_H); bf16* Pb = (bf16*)(F.ws + WS_P); float* part = (float*)(F.ws + WS_PART); (void)XB; (void)Hb; (void)Pb; (void)part;
        if (ph == 0) { PH_ENTER();
            if (DIAG_SLOT_D >= 0 && bx == 0 && threadIdx.x == 0) { unsigned zz_ = 0u; asm volatile("" : "+v"(zz_)); ((unsigned*)(args.ws + WS_DIAG))[0] = zz_; ((unsigned*)(args.ws + WS_DIAG))[1] = zz_; }
            conv_weights(F, 0, 0, 3);
            p0_x(F); p0_table(F); small_weights(F);
        } else if (ph == NPHASE - 1) { PH_ENTER();
            final_norm(F);
        } else {
            const int l = (ph - 1) / 9, sub = (ph - 1) - 9 * l;
            if (sub == 0 || sub == 7) { PH_ENTER();
                pg8::Gemm g{XB, (const bf16*)(F.ws + (sub == 0 ? WS_WGU1 : WS_WGU2)), M, NGU, DM, DM}; pg8::StaticOrder S; S.init(M, NGU, F.G, bx);
                pg8::EpiUp E{Hb, FFP, part};
                if (bx >= S.nwg % F.G) for (int i = 0; i < args.stag_up; ++i) __builtin_amdgcn_s_sleep(127);
                for (int rep = 0; rep < ((l == 0 && sub == 0) ? REP_UP : 1); ++rep) pg8::gemm_phase<pg8::EpiUp, pg8::StaticOrder, true>(F.lds, g, S, E, F.tid);
            } else if (sub == 1 || sub == 8 || sub == 6) { PH_ENTER();
                const bool op = (sub == 6);
                pg8::Gemm g{op ? Pb : Hb, (const bf16*)(F.ws + (op ? WS_WOUT : (sub == 1 ? WS_WD1 : WS_WD2))), M, DM, op ? DM : FFP, op ? PP : FFP}; pg8::StaticOrder S; S.init(M, DM, F.G, bx);
                const float* base = (l == 0 && sub == 1) ? F.in[I_X] : nullptr;
                pg8::EpiRes E{base, XB, part};
                pg8::gemm_phase<pg8::EpiRes, pg8::StaticOrder, false>(F.lds, g, S, E, F.tid);
            } else if (sub == 2) { PH_ENTER();
                pg8::Gemm g{XB, (const bf16*)(F.ws + WS_WIN), M, PP, DM, DM}; pg8::StaticOrder S; S.init(M, PP, F.G, bx);
                pg8::EpiP E{Pb, PP, part};
                if (bx >= S.nwg % F.G) for (int i = 0; i < args.stag_in; ++i) __builtin_amdgcn_s_sleep(127);
                pg8::gemm_phase<pg8::EpiP, pg8::StaticOrder, true>(F.lds, g, S, E, F.tid);
            } else if (sub == 3) { PH_ENTER();
                prep_consts(F, l);
                REPL(REP_PTOK) for (int u = F.vcu; u < M / PT; u += F.G) prep_tokens_unit(F, l, u);

            } else if (sub == 5) { PH_ENTER();
                rwkv_post(F, l);
            } else if (sub == 4) { PH_ENTER();
                unsigned dgm_ = 0; if (DIAG_SLOT_D >= 50 && DIAG_SLOT_D < 60) dgm_ = (unsigned)__builtin_amdgcn_s_memtime();
                if (bx < BATCH * 6) { for (int rep_ = 0; rep_ < (l == 0 ? args.rep_scan : 1); ++rep_) { rwkv_chunk_unit(F, l, bx); __syncthreads(); } }
                if (DIAG_SLOT_D == 54 && l == 0 && bx < BATCH * 6 && threadIdx.x == 0) atomicMax((unsigned*)(args.ws + WS_DIAG), (unsigned)__builtin_amdgcn_s_memtime() - dgm_);
                if (DIAG_SLOT_D == 50 && l == 0 && bx == 0 && threadIdx.x == 0) ((unsigned*)(args.ws + WS_DIAG))[0] = (unsigned)__builtin_amdgcn_s_memtime() - dgm_;
                if (!(DIAG_SLOT_D >= 70 && DIAG_SLOT_D < 80)) {
                    gu32* qh = ctl + CW_QUEUE + 64 * l;
                    for (;;) {
                        if (F.tid == 0) MISC[0] = __hip_atomic_fetch_add(qh, 1u, RLX_AGENT);
                        __syncthreads();
                        const int u = (int)MISC[0];
                        __syncthreads();
                        const int nd = (l == 0 ? args.qdup : 1) * (M / 32); constexpr int QB0 = BATCH * 4 + M / 16;
                        { unsigned z_ = 0u; int t_ = threadIdx.x; asm volatile("" : "+v"(z_), "+v"(t_)); z_ = __builtin_amdgcn_readfirstlane(z_); F.ws = args.ws + z_; F.tid = t_; F.lane = t_ & 63; F.wave = __builtin_amdgcn_readfirstlane(t_ >> 6); }
                        const int ncv = (conv_flat_items(l + 1 < DEPTH) + NWAVES * CONV_PER_WAVE - 1) / (NWAVES * CONV_PER_WAVE);
                        if (DIAG_SLOT_D == 53 && l == 0 && bx == 200 && threadIdx.x == 0 && u >= QB0 + nd) { unsigned* D_ = (unsigned*)(args.ws + WS_DIAG); if (D_[1] != 0x600Du) { D_[1] = 0x600Du; D_[0] = (unsigned)__builtin_amdgcn_s_memtime() - dgm_; } }
                        if (u >= nd + QB0 + ncv) { if (DIAG_SLOT_D == 51 && l == 0 && bx == 0 && threadIdx.x == 0) ((unsigned*)(args.ws + WS_DIAG))[0] = (unsigned)__builtin_amdgcn_s_memtime() - dgm_;
                            if (DIAG_SLOT_D == 52 && l == 0 && bx == 200 && threadIdx.x == 0) ((unsigned*)(args.ws + WS_DIAG))[0] = (unsigned)__builtin_amdgcn_s_memtime() - dgm_; }
                        if (DIAG_SLOT_D == 55 && l == 0 && u >= nd + QB0 + ncv && threadIdx.x == 0) atomicMax((unsigned*)(args.ws + WS_DIAG), (unsigned)__builtin_amdgcn_s_memtime() - dgm_);
                        if (DIAG_SLOT_D == 56 && l == 0 && u >= QB0 && u < nd + QB0 && threadIdx.x == 0) atomicMax((unsigned*)(args.ws + WS_DIAG), (unsigned)__builtin_amdgcn_s_memtime() - dgm_);
                        if (u >= nd + QB0 + ncv) break;
                        if (u < BATCH * 4) ret_out_unit(F, u);
                        else if (u < BATCH * 4 + M / 16) dsa_thr_unit(F, l, u - BATCH * 4);
                        else if (u < nd + QB0) dsa_attn_unit(F, l, (u - QB0) % (M / 32));
                        else { conv_unit(F, l, u - nd - QB0); __syncthreads(); }
                    }
                }
            }
        }
        if (ph_ + 1 < hi) xcd_barrier(bar);
        if (DIAG_SLOT_D >= 100 && ph_ == DIAG_SLOT_D - 100 && blockIdx.x == 0 && threadIdx.x == 0) ((unsigned*)(args.ws + WS_DIAG))[0] = (unsigned)__builtin_amdgcn_s_memtime() - dgp0_;
    }
}

extern "C" void kernel_launch(void* const* d_in, const int* in_sizes, int n_in, void* d_out, int out_size, void* d_ws, size_t ws_size, hipStream_t stream) {
    static int grid = 0;
    if (grid == 0) {
        if (n_in != 31 || out_size != M * DM || ws_size < WS_END) { fprintf(stderr, "kernel_launch: unexpected shapes (n_in %d, out %d, ws %zu)\n", n_in, out_size, ws_size); grid = -1; return; }
        int dev = 0, cus = 0, per_cu = 0;
        if (hipGetDevice(&dev) != hipSuccess || hipDeviceGetAttribute(&cus, hipDeviceAttributeMultiprocessorCount, dev) != hipSuccess) { grid = -1; return; }
        if (hipFuncSetAttribute((const void*)fwd_kernel, hipFuncAttributeMaxDynamicSharedMemorySize, LDS_BYTES) != hipSuccess) { fprintf(stderr, "kernel_launch: hipFuncSetAttribute failed\n"); grid = -1; return; }
        if (hipOccupancyMaxActiveBlocksPerMultiprocessor(&per_cu, (const void*)fwd_kernel, NTHR, LDS_BYTES) != hipSuccess || per_cu < 1) fprintf(stderr, "kernel_launch: occupancy query says %d\n", per_cu);
        (void)hipGetLastError();
        grid = cus;
    }
    if (grid < 0) return;
    if (hipMemsetAsync((char*)d_ws + WS_CTL, 0, CTL_ZERO_BYTES, stream) != hipSuccess) return;
    Args a{};
    for (int i = 0; i < 31; ++i) a.in[i] = (const float*)d_in[i];
    a.out = (float*)d_out; a.ws = (unsigned char*)d_ws; a.dup_phase = DUP_PHASE; a.qdup = QDUP; a.rep_scan = REP_SCAN_K; a.rep_thr = REP_THR_K; a.stag_up = STAG_UP; a.stag_in = STAG_IN;
#ifndef ONE_LAUNCH
#define ONE_LAUNCH 1
#endif
    if (ONE_LAUNCH) { a.ph_lo = 0; a.ph_hi = NSTEP; hipLaunchKernelGGL(fwd_kernel, dim3(grid), dim3(NTHR), LDS_BYTES, stream, a); }
    else for (int ph = 0; ph < NPHASE; ++ph) { a.ph_lo = ph; a.ph_hi = ph + 1; hipLaunchKernelGGL(fwd_kernel, dim3(grid), dim3(NTHR), LDS_BYTES, stream, a); }
}
```

```cpp
#include <hip/hip_runtime.h>
#include <cstdio>
#include <cstdint>
#include <cmath>

namespace pg8 {
#define PG8_LAS __attribute__((address_space(3)))
typedef unsigned short bf16_t;
typedef short bf16x8 __attribute__((ext_vector_type(8)));
typedef float f32x4 __attribute__((ext_vector_type(4)));
typedef unsigned u32x4 __attribute__((ext_vector_type(4)));
constexpr int BM = 256, BK = 64, HALF = 128, HTB = HALF * BK * 2  , STAGE_BYTES = 8 * HTB, NXCD = 8, WGM = 8;

__host__ __device__ __forceinline__ int lds_byte(int r, int c) { const int st = (r >> 4) * 2 + (c >> 5), rr = r & 15, cc = c & 31, ob = rr * 64 + cc * 2; return st * 1024 + (ob ^ (((ob >> 9) & 1) << 5)); }
__host__ __device__ __forceinline__ void stage_rc(int b, int& R, int& C) { const int st = b / 1024, sb = b % 1024, swz = sb ^ (((sb >> 9) & 1) << 5); R = (st >> 1) * 16 + swz / 64; C = (st & 1) * 32 + (swz % 64) / 2; }
__host__ __device__ __forceinline__ int perm32(int rho) { const int n = rho >> 4, i = rho & 15; return 8 * (i >> 2) + 4 * n + (i & 3); }

struct Unit { int pm, pn; };
struct Gemm { const bf16_t* A; const bf16_t* Bt; int M, N, K, lda; };

struct StaticOrder {
    int nM, nN, nwg, G, c;
    __host__ __device__ void init(int M, int N, int G_, int c_) { nM = M / BM; nN = N / BM; nwg = nM * nN; G = G_; c = c_; }
    __host__ __device__ bool next(int i, Unit& u) const {
        const long L = (long)i * G + c; if (L >= nwg) return false;
        int wgid = (int)L; { const int q = nwg / NXCD, r = nwg % NXCD, xcd = wgid % NXCD, off = wgid / NXCD; wgid = (xcd < r ? xcd * (q + 1) : r * (q + 1) + (xcd - r) * q) + off; }
        const int nig = WGM * nN, gid = wgid / nig, fm = gid * WGM, gsz = (nM - fm) < WGM ? (nM - fm) : WGM;
        u.pm = fm + ((wgid % nig) % gsz); u.pn = (wgid % nig) / gsz; return true;
    }
    __device__ __forceinline__ void a_ready(const Unit&) const {}
    __device__ __forceinline__ void done(const Unit&) const {}
};

__device__ __forceinline__ unsigned cvt_pk_bf16(float lo, float hi) { unsigned r; asm volatile("v_cvt_pk_bf16_f32 %0, %1, %2" : "=v"(r) : "v"(lo), "v"(hi)); return r; }


__device__ __forceinline__ float row_rstd(const float* part, int row) {
    const f32x4* p = (const f32x4*)(part + (size_t)row * 16);
    const f32x4 a = p[0], b = p[1], c = p[2], d = p[3];
    const float s = ((a[0] + a[1]) + (a[2] + a[3])) + ((b[0] + b[1]) + (b[2] + b[3])) + ((c[0] + c[1]) + (c[2] + c[3])) + ((d[0] + d[1]) + (d[2] + d[3]));
    return 1.0f / sqrtf(s * (1.0f / 1024.0f) + 1e-6f);
}
__device__ __forceinline__ float silu_f(float x) { return x * __builtin_amdgcn_rcpf(1.0f + __expf(-x)); }

struct EpiUp {
    static constexpr bool PERM = true;
    bf16_t* H; int ldh; const float* part;
    __device__ __forceinline__ void operator()(const f32x4 (&acc)[2][2][4][2], const Unit& u, int wr, int wc, int fr, int fq) const {
        const int row0 = u.pm * BM + wr * 64 + fr, hcol = u.pn * 128 + wc * 32 + 8 * fq;
#pragma unroll
        for (int ai = 0; ai < 2; ++ai)
#pragma unroll
            for (int m = 0; m < 4; ++m) { const int row = row0 + ai * HALF + m * 16; const float rs = row_rstd(part, row);
                const f32x4 g0 = acc[ai][0][m][0] * rs, g1 = acc[ai][0][m][1] * rs, u0 = acc[ai][1][m][0] * rs, u1 = acc[ai][1][m][1] * rs;
                u32x4 w; w.x = cvt_pk_bf16(silu_f(g0[0]) * u0[0], silu_f(g0[1]) * u0[1]); w.y = cvt_pk_bf16(silu_f(g0[2]) * u0[2], silu_f(g0[3]) * u0[3]);
                w.z = cvt_pk_bf16(silu_f(g1[0]) * u1[0], silu_f(g1[1]) * u1[1]); w.w = cvt_pk_bf16(silu_f(g1[2]) * u1[2], silu_f(g1[3]) * u1[3]);
                *(u32x4*)(H + (size_t)row * ldh + hcol) = w; }
    }
};
struct EpiP {
    static constexpr bool PERM = true;
    bf16_t* P; int ldp; const float* part;
    __device__ __forceinline__ void operator()(const f32x4 (&acc)[2][2][4][2], const Unit& u, int wr, int wc, int fr, int fq) const {
        const int row0 = u.pm * BM + wr * 64 + fr, col0 = u.pn * BM + wc * 32 + 8 * fq;
#pragma unroll
        for (int ai = 0; ai < 2; ++ai)
#pragma unroll
            for (int m = 0; m < 4; ++m) { const int row = row0 + ai * HALF + m * 16; const float rs = row_rstd(part, row);
#pragma unroll
                for (int bj = 0; bj < 2; ++bj) { const f32x4 v0 = acc[ai][bj][m][0] * rs, v1 = acc[ai][bj][m][1] * rs;
                    u32x4 w; w.x = cvt_pk_bf16(v0[0], v0[1]); w.y = cvt_pk_bf16(v0[2], v0[3]); w.z = cvt_pk_bf16(v1[0], v1[1]); w.w = cvt_pk_bf16(v1[2], v1[3]);
                    *(u32x4*)(P + (size_t)row * ldp + col0 + bj * HALF) = w; } }
    }
};
struct EpiRes {
    static constexpr bool PERM = true;
    const float* base; bf16_t* xb; float* part;
    __device__ __forceinline__ void operator()(const f32x4 (&acc)[2][2][4][2], const Unit& u, int wr, int wc, int fr, int fq) const {
        const int row0 = u.pm * BM + wr * 64 + fr, col0 = u.pn * BM + wc * 32 + 8 * fq;
#pragma unroll
        for (int ai = 0; ai < 2; ++ai)
#pragma unroll
            for (int m = 0; m < 4; ++m) { const int row = row0 + ai * HALF + m * 16; float ss = 0.f;
#pragma unroll
                for (int bj = 0; bj < 2; ++bj) { const size_t off = (size_t)row * 1024 + col0 + bj * HALF;
                    f32x4 v0, v1;
                    if (base) { v0 = *(const f32x4*)(base + off); v1 = *(const f32x4*)(base + off + 4); }
                    else { const u32x4 xw = *(const u32x4*)(xb + off);
                        v0 = (f32x4){__builtin_bit_cast(float, xw.x << 16), __builtin_bit_cast(float, xw.x & 0xffff0000u), __builtin_bit_cast(float, xw.y << 16), __builtin_bit_cast(float, xw.y & 0xffff0000u)};
                        v1 = (f32x4){__builtin_bit_cast(float, xw.z << 16), __builtin_bit_cast(float, xw.z & 0xffff0000u), __builtin_bit_cast(float, xw.w << 16), __builtin_bit_cast(float, xw.w & 0xffff0000u)}; }
                    v0 += acc[ai][bj][m][0]; v1 += acc[ai][bj][m][1];
                    u32x4 w; w.x = cvt_pk_bf16(v0[0], v0[1]); w.y = cvt_pk_bf16(v0[2], v0[3]); w.z = cvt_pk_bf16(v1[0], v1[1]); w.w = cvt_pk_bf16(v1[2], v1[3]);
                    *(u32x4*)(xb + off) = w;
                    ss += (v0[0] * v0[0] + v0[1] * v0[1]) + (v0[2] * v0[2] + v0[3] * v0[3]) + (v1[0] * v1[0] + v1[1] * v1[1]) + (v1[2] * v1[2] + v1[3] * v1[3]); }
                ss += __shfl_xor(ss, 16); ss += __shfl_xor(ss, 32);
                if (fq == 0) part[(size_t)row * 16 + u.pn * 4 + wc] = ss;
                asm volatile("" ::: "memory"); }
    }
};

template <class Epi, class Sched, bool ALIGN_EPI>
__device__ __forceinline__ void gemm_phase(PG8_LAS unsigned char* lds, const Gemm g, const Sched& S, const Epi& E, const int tid) {
    const int wid = __builtin_amdgcn_readfirstlane(tid >> 6), lane = tid & 63, wr = wid >> 2, wc = wid & 3, fr = lane & 15, fq = lane >> 4;
    const int K = g.K, nt = K / BK, lda = g.lda;
    unsigned voffA[2], voffB[2];
#pragma unroll
    for (int i = 0; i < 2; ++i) { int R, C; stage_rc(tid * 16 + i * 8192, R, C); const int Rb = Epi::PERM ? ((R & ~31) + perm32(R & 31)) : R;
        voffA[i] = (unsigned)(R * lda + C) * 2u; voffB[i] = (unsigned)(Rb * K + C) * 2u; }
    const size_t kstep = (size_t)(BK * 2);
    const size_t hstepA = (size_t)HALF * lda * 2, hstepB = (size_t)HALF * K * 2;
    const size_t tstepA = 2 * hstepA, tstepB = 2 * hstepB;
    const unsigned ldsw = (unsigned)wid * 1024u;
    const int aoff = lds_byte(wr * 64 + fr, fq * 8), boff = lds_byte(wc * 32 + fr, fq * 8);
#define PG8_SA(b, h) (((b) * 2 + (h)) * HTB)
#define PG8_SB(b, h) ((4 + (b) * 2 + (h)) * HTB)
#define PG8_STAGE(bufoff, gbase, voff) do { _Pragma("unroll") for (int _i = 0; _i < 2; ++_i) \
        __builtin_amdgcn_global_load_lds((const unsigned*)((const char*)(gbase) + (voff)[_i]), (PG8_LAS unsigned*)(lds + (bufoff) + ldsw + _i * 8192), 16, 0, 0); } while (0)
#define PG8_LDA(dst, b, h) do { _Pragma("unroll") for (int m = 0; m < 4; ++m) _Pragma("unroll") for (int k = 0; k < 2; ++k) dst[m][k] = *(const PG8_LAS bf16x8*)(lds + PG8_SA(b, h) + aoff + m * 2048 + k * 1024); } while (0)
#define PG8_LDB(dst, b, h) do { _Pragma("unroll") for (int n = 0; n < 2; ++n) _Pragma("unroll") for (int k = 0; k < 2; ++k) dst[n][k] = *(const PG8_LAS bf16x8*)(lds + PG8_SB(b, h) + boff + n * 2048 + k * 1024); } while (0)
#define PG8_MMA(ai, bj, At, Bt) do { __builtin_amdgcn_s_setprio(1); _Pragma("unroll") for (int m = 0; m < 4; ++m) _Pragma("unroll") for (int n = 0; n < 2; ++n) _Pragma("unroll") for (int k = 0; k < 2; ++k) \
        acc[ai][bj][m][n] = __builtin_amdgcn_mfma_f32_16x16x32_bf16(Bt[n][k], At[m][k], acc[ai][bj][m][n], 0, 0, 0); __builtin_amdgcn_s_setprio(0); } while (0)
#define PG8_WAIT_V(n) asm volatile("s_waitcnt vmcnt(" #n ")" ::: "memory")
#define PG8_WAIT_L(n) asm volatile("s_waitcnt lgkmcnt(" #n ")" ::: "memory")
#define PG8_BAR __builtin_amdgcn_s_barrier()
#define PG8_SCHED __builtin_amdgcn_sched_barrier(0)
    Unit cur, nxt; int ui = 0;
    if (!S.next(0, cur)) return;
    f32x4 acc[2][2][4][2];
#pragma unroll
    for (int a = 0; a < 2; ++a)
#pragma unroll
        for (int b = 0; b < 2; ++b)
#pragma unroll
            for (int m = 0; m < 4; ++m)
#pragma unroll
                for (int n = 0; n < 2; ++n) acc[a][b][m][n] = (f32x4){0.f, 0.f, 0.f, 0.f};
    bf16x8 At[4][2], B0[2][2], B1[2][2];
    const char* cA = (const char*)g.A + (size_t)cur.pm * tstepA; const char* cB = (const char*)g.Bt + (size_t)cur.pn * tstepB;
    S.a_ready(cur);
    PG8_STAGE(PG8_SB(0, 0), cB, voffB); PG8_STAGE(PG8_SB(0, 1), cB + hstepB, voffB); PG8_STAGE(PG8_SA(0, 0), cA, voffA); PG8_STAGE(PG8_SA(0, 1), cA + hstepA, voffA);
    if (wr == 1) PG8_BAR;
    PG8_WAIT_V(2); PG8_BAR;
    PG8_STAGE(PG8_SB(1, 0), cB + kstep, voffB); PG8_STAGE(PG8_SA(1, 0), cA + kstep, voffA); PG8_STAGE(PG8_SB(1, 1), cB + hstepB + kstep, voffB);
    PG8_WAIT_V(6); PG8_BAR;
    for (;;) {
        const bool has_next = S.next(ui + 1, nxt);
        const char* nA = has_next ? (const char*)g.A + (size_t)nxt.pm * tstepA : cA; const char* nB = has_next ? (const char*)g.Bt + (size_t)nxt.pn * tstepB : cB;
        for (int t = 0; t < nt; t += 2) {
            const bool last = (t == nt - 2);
            const char* a1 = cA + (size_t)(t + 1) * kstep;
            const char* a2 = last ? nA : cA + (size_t)(t + 2) * kstep; const char* b2 = last ? nB : cB + (size_t)(t + 2) * kstep;
            const char* a3 = a2 + kstep; const char* b3 = b2 + kstep;
            if (last && has_next) S.a_ready(nxt);
            PG8_LDB(B0, 0, 0); PG8_LDB(B1, 0, 1); PG8_SCHED; PG8_LDA(At, 0, 0); PG8_STAGE(PG8_SA(1, 1), a1 + hstepA, voffA);
            PG8_WAIT_V(8); PG8_WAIT_L(0); PG8_BAR; PG8_MMA(0, 0, At, B0); PG8_MMA(0, 1, At, B1); PG8_BAR; PG8_SCHED;
            PG8_LDA(At, 0, 1); PG8_STAGE(PG8_SB(0, 0), b2, voffB); PG8_STAGE(PG8_SB(0, 1), b2 + hstepB, voffB); PG8_STAGE(PG8_SA(0, 0), a2, voffA);
            PG8_WAIT_V(8); PG8_WAIT_L(0); PG8_BAR; PG8_MMA(1, 0, At, B0); PG8_MMA(1, 1, At, B1); PG8_BAR; PG8_SCHED;
            PG8_LDB(B0, 1, 0); PG8_LDB(B1, 1, 1); PG8_SCHED; PG8_LDA(At, 1, 0); PG8_STAGE(PG8_SA(0, 1), a2 + hstepA, voffA);
            PG8_WAIT_V(8); PG8_WAIT_L(0); PG8_BAR; PG8_MMA(0, 0, At, B0); PG8_MMA(0, 1, At, B1); PG8_BAR; PG8_SCHED;
            PG8_LDA(At, 1, 1); PG8_STAGE(PG8_SB(1, 0), b3, voffB); PG8_STAGE(PG8_SB(1, 1), b3 + hstepB, voffB); PG8_STAGE(PG8_SA(1, 0), a3, voffA);
            PG8_WAIT_V(8); PG8_WAIT_L(0); PG8_BAR; PG8_MMA(1, 0, At, B0); PG8_MMA(1, 1, At, B1); PG8_BAR; PG8_SCHED;
        }
        if constexpr (ALIGN_EPI) { if (wr == 0) PG8_BAR; }
        E(acc, cur, wr, wc, fr, fq); S.done(cur);
        if (!has_next) break;
#pragma unroll
        for (int a = 0; a < 2; ++a)
#pragma unroll
            for (int b = 0; b < 2; ++b)
#pragma unroll
                for (int m = 0; m < 4; ++m)
#pragma unroll
                    for (int n = 0; n < 2; ++n) acc[a][b][m][n] = (f32x4){0.f, 0.f, 0.f, 0.f};
        cur = nxt; cA = nA; cB = nB; ++ui;
        if constexpr (ALIGN_EPI) { if (wr == 1) PG8_BAR; }
    }
    PG8_WAIT_V(0);
    if constexpr (!ALIGN_EPI) { if (wr == 0) PG8_BAR; }
    PG8_BAR;
#undef PG8_SA
#undef PG8_SB
#undef PG8_STAGE
#undef PG8_LDA
#undef PG8_LDB
#undef PG8_MMA
#undef PG8_WAIT_V
#undef PG8_WAIT_L
#undef PG8_BAR
#undef PG8_SCHED
}
}

constexpr int NWAVES = 8, NTHR = 512;
constexpr int BATCH = 8, SEQ = 2048, DM = 1024, DEPTH = 2, FF = 2752, M = BATCH * SEQ;
constexpr int FFP = 2816;
constexpr int NGU = 5632;
constexpr int PP = 3584;
constexpr int NIN = 3400;
constexpr int PA = 0, PMV = 1280, PBQ = 1296, PBC = 1680, PBIQ = 1808, PBIK = 2320, PBIW = 2384, PCQ = 2392, PCK = 2648, PCV = 2904, PCG = 3160, PUSED = 3416;
constexpr int AW = 384;
constexpr int TOPK = 256;

constexpr size_t MiB = 1u << 20;
constexpr size_t WS_CTL = 0, CTL_ZERO_BYTES = 1 * MiB;
constexpr size_t WS_PART = 1 * MiB;
constexpr size_t WS_TAB = 2 * MiB;
constexpr size_t WS_BON = 2 * MiB + 512 * 1024;
constexpr size_t WS_WUKT = 3 * MiB, WS_WUVT = 3 * MiB + 192 * 1024;
constexpr size_t WS_THR = 3 * MiB + 384 * 1024, WS_SCUT = 3 * MiB + 448 * 1024;
constexpr size_t WS_LORA = 3 * MiB + 512 * 1024;
constexpr size_t WS_WGU1 = 4 * MiB, WS_WD1 = 15 * MiB, WS_WIN = 21 * MiB, WS_WOUT = 28 * MiB, WS_WGU2 = 30 * MiB, WS_WD2 = 41 * MiB;
constexpr size_t WS_XB = 47 * MiB;
constexpr size_t WS_VF = 79 * MiB;
constexpr size_t WS_P = 91 * MiB;
constexpr size_t WS_H = WS_P;
constexpr size_t WS_R = 203 * MiB, WS_D = 215 * MiB, WS_K2 = 227 * MiB, WS_KK = 239 * MiB, WS_C = 251 * MiB;
constexpr size_t WS_KV = WS_XB + 24 * MiB;
constexpr size_t OUT_BP = 0, OUT_G = 12 * MiB, OUT_MASK = 24 * MiB;
constexpr size_t WS_END = 256 * MiB;
static_assert(WS_WD2 + (size_t)1024 * FFP * 2 <= WS_XB && WS_P + (size_t)M * PP * 2 <= WS_R && WS_C + (size_t)M * 128 * 2 <= WS_END, "ws map");
constexpr int CW_BAR = 4096;
constexpr int CW_QUEUE = 16384;
constexpr int CW_THRD = 20480;

constexpr int RING_BYTES = 131072;
constexpr int LDSCTL_OFF = RING_BYTES, MISC_OFF = LDSCTL_OFF + 320;
constexpr int LDS_BYTES = 147456;

#define GAS __attribute__((address_space(1)))
#define LAS __attribute__((address_space(3)))
typedef unsigned short bf16;
typedef unsigned v4u __attribute__((ext_vector_type(4)));
typedef float f32x4 __attribute__((ext_vector_type(4)));
typedef GAS unsigned gu32;
#define RLX_AGENT __ATOMIC_RELAXED, __HIP_MEMORY_SCOPE_AGENT
#define LDS_WAIT() asm volatile("s_waitcnt lgkmcnt(0)" ::: "memory")
__device__ __forceinline__ unsigned f2bf(float f) { unsigned u = __builtin_bit_cast(unsigned, f); return (u + 0x7fffu + ((u >> 16) & 1u)) >> 16; }
typedef float f32x2v_ __attribute__((ext_vector_type(2))); typedef __bf16 bf16x2v_ __attribute__((ext_vector_type(2)));
__device__ __forceinline__ unsigned pk2(float lo, float hi) { const f32x2v_ v = {lo, hi}; return __builtin_bit_cast(unsigned, __builtin_convertvector(v, bf16x2v_)); }
__device__ __forceinline__ float bf2f(unsigned short v) { return __uint_as_float((unsigned)v << 16); }
__device__ __forceinline__ float bflo(unsigned w) { return __uint_as_float(w << 16); }
__device__ __forceinline__ float bfhi(unsigned w) { return __uint_as_float(w & 0xffff0000u); }
__device__ __forceinline__ void unpack8(const v4u w, float (&f)[8]) { f[0] = bflo(w.x); f[1] = bfhi(w.x); f[2] = bflo(w.y); f[3] = bfhi(w.y); f[4] = bflo(w.z); f[5] = bfhi(w.z); f[6] = bflo(w.w); f[7] = bfhi(w.w); }
__device__ __forceinline__ float sigmoid_f(float x) { return 1.0f / (1.0f + __expf(-x)); }
__device__ __forceinline__ float wave_sum(float v) {
#pragma unroll
    for (int o = 1; o < 64; o <<= 1) v += __shfl_xor(v, o);
    return v;
}

#define XB_TMO      128
#define XB_XCNT(j)  (256  + 64 * (j))
#define XB_XSUB(j)  (1280 + 64 * (j))
#define XB_XGEN(j)  (2304 + 64 * (j))
#define XB_TOP      3328
#define XB_TOPGEN   3392
#define XCD_BAR_WORDS 3456
#define XB_SPIN_CAP (1u << 22)

__device__ __forceinline__ unsigned xb_ld(unsigned* p)              { return __hip_atomic_load(p, __ATOMIC_RELAXED, __HIP_MEMORY_SCOPE_AGENT); }
__device__ __forceinline__ unsigned xb_add(unsigned* p, unsigned v) { return __hip_atomic_fetch_add(p, v, __ATOMIC_RELAXED, __HIP_MEMORY_SCOPE_AGENT); }
__device__ __forceinline__ unsigned xb_xcc_id() { return (unsigned)__builtin_amdgcn_s_getreg((3 << 11) | 20) & 0xFu; }
#define XB_SPIN(cond, bar) do { unsigned _sp = 0; while (cond) { __builtin_amdgcn_s_sleep(1); \
    if ((++_sp & 255u) == 0u) { if (xb_ld(&(bar)[XB_TMO])) break; if (_sp > XB_SPIN_CAP) { atomicAdd(&(bar)[XB_TMO], 1u); break; } } } } while (0)

struct XcdBarrier { unsigned* bar; unsigned x; volatile LAS unsigned* st; };

__device__ __forceinline__ XcdBarrier xcd_barrier_post(unsigned* bar, volatile LAS unsigned* st) {
    XcdBarrier b; b.bar = bar; b.x = xb_xcc_id(); b.st = st;
    if (threadIdx.x == 0) (void)xb_add(&bar[XB_XCNT(b.x)], 1u);
    return b;
}
__device__ __forceinline__ void xcd_barrier_complete(unsigned* bar, unsigned x, unsigned& nloc, unsigned& nx) {
    const unsigned G = gridDim.x * gridDim.y * gridDim.z;
    unsigned sum, cnt, mine, sp = 0u;
    for (;;) {
        sum = 0u; cnt = 0u; mine = 0u;
#pragma unroll
        for (unsigned j = 0; j < 16; ++j) { const unsigned c = xb_ld(&bar[XB_XCNT(j)]); sum += c; cnt += (c > 0u) ? 1u : 0u; mine = (j == x) ? c : mine; }
        if (sum == G) break;
        __builtin_amdgcn_s_sleep(1);
        if ((++sp & 255u) == 0u) { if (xb_ld(&bar[XB_TMO])) break; if (sp > XB_SPIN_CAP) { atomicAdd(&bar[XB_TMO], 1u); break; } }
    }
    nloc = mine > 0u ? mine : 1u; nx = cnt > 0u ? cnt : 1u;
}
__device__ __forceinline__ void xcd_barrier(const XcdBarrier& b) {
    asm volatile("s_waitcnt vmcnt(0)" ::: "memory");
    __syncthreads();
    if (threadIdx.x == 0) {
        unsigned* bar = b.bar;
        __builtin_amdgcn_s_waitcnt(0);
        unsigned nloc = b.st[0], nx = b.st[1];
        if (nloc == 0u) { xcd_barrier_complete(bar, b.x, nloc, nx); b.st[0] = nloc; b.st[1] = nx; }
        const unsigned old = xb_add(&bar[XB_XSUB(b.x)], 1u);
        const unsigned gen = old / nloc;
        if (old + 1u == (gen + 1u) * nloc) {
            __builtin_amdgcn_fence(__ATOMIC_RELEASE, "agent");
            asm volatile("s_waitcnt vmcnt(0)" ::: "memory");
            const unsigned og = xb_add(&bar[XB_TOP], 1u);
            const unsigned tg = og / nx;
            if (og + 1u == (tg + 1u) * nx) xb_add(&bar[XB_TOPGEN], 1u);
            else XB_SPIN(xb_ld(&bar[XB_TOPGEN]) == tg, bar);
            __builtin_amdgcn_fence(__ATOMIC_ACQUIRE, "agent");
            xb_add(&bar[XB_XGEN(b.x)], 1u);
            asm volatile("s_waitcnt vmcnt(0)" ::: "memory");
        } else {
            XB_SPIN(xb_ld(&bar[XB_XGEN(b.x)]) == gen, bar);
            __builtin_amdgcn_fence(__ATOMIC_ACQUIRE, "agent");
            asm volatile("s_waitcnt vmcnt(0)" ::: "memory");
        }
    }
    __syncthreads();
}

#ifndef DIAG_SLOT_D
#define DIAG_SLOT_D (-1)
#endif
#ifndef DIAG_DIV
#define DIAG_DIV 1.0f
#endif
constexpr size_t WS_DIAG = 3 * MiB + 900 * 1024;
#define DG_START(k, var) unsigned var = 0; if (DIAG_SLOT_D == (k)) var = (unsigned)__builtin_amdgcn_s_memtime();
#define DG_STOP(k, var, acc) if (DIAG_SLOT_D == (k)) acc += (unsigned)__builtin_amdgcn_s_memtime() - var;
#define DG_WRITE(k, cond, acc) if (DIAG_SLOT_D == (k) && (cond)) ((unsigned*)(F.ws + WS_DIAG))[0] = acc;
struct Args { const float* in[31]; float* out; unsigned char* ws; int ph_lo, ph_hi; int dup_phase, qdup, rep_scan, rep_thr; int stag_up, stag_in; };
struct Frame {
    LAS unsigned char* lds;
    int tid, lane, wave, vcu, G;
    const float* const __attribute__((address_space(4)))* in;
    float* out; unsigned char* ws;
};
enum { I_X = 0, I_F1N, I_F1G, I_F1U, I_F1D, I_MIXN, I_WIN, I_WOUT, I_MU, I_W0, I_W2, I_A0, I_A2, I_G2, I_KK, I_KA, I_RK, I_LNW, I_LNB, I_VRW, I_VRMU, I_V0, I_V2, I_KVN, I_WUK, I_WUV, I_F2N, I_F2G, I_F2U, I_F2D, I_FN };

__device__ __forceinline__ void conv_item(const Frame& F, int l, int kind, int item, LAS float* scr) {
    const int lane = F.lane;
    int Kd, nkb; bf16* WT;
    if (kind == 0 || kind == 4) { Kd = 1024; WT = (bf16*)(F.ws + (kind == 0 ? WS_WGU1 : WS_WGU2)); }
    else if (kind == 1 || kind == 5) { Kd = FFP; WT = (bf16*)(F.ws + (kind == 1 ? WS_WD1 : WS_WD2)); }
    else if (kind == 2) { Kd = 1024; WT = (bf16*)(F.ws + WS_WIN); }
    else { Kd = 1024; WT = (bf16*)(F.ws + WS_WOUT); }
    nkb = Kd / 64;
    const int rb = item / nkb, kb = item % nkb, r0 = rb * 32, k0 = kb * 64;
    const int n4 = (lane & 7) * 4, kr = lane >> 3;
    const int rr = r0 + n4;
    const float* src = nullptr; int ns = 0, col = 0, ksrc = 1024; const float* gain = nullptr; float scale = 1.0f;
    if (kind == 0 || kind == 4) {
        const int tile = rr >> 8, w = rr & 255, hid = tile * 128 + (w & 127);
        if (hid < FF) { const float* s1 = (w >> 7) ? F.in[I_F1U] : F.in[I_F1G]; const float* s2 = (w >> 7) ? F.in[I_F2U] : F.in[I_F2G]; src = ((kind == 0) ? s1 : s2) + (size_t)l * 1024 * FF; ns = FF; col = hid; }
        gain = ((kind == 0) ? F.in[I_F1N] : F.in[I_F2N]) + l * 1024;
    } else if (kind == 1 || kind == 5) {
        src = ((kind == 1) ? F.in[I_F1D] : F.in[I_F2D]) + (size_t)l * FF * 1024; ns = 1024; col = rr; ksrc = FF; scale = 0.5f;
    } else if (kind == 2) {
        gain = F.in[I_MIXN] + l * 1024;
        if (rr < 1280) { src = F.in[I_WIN] + (size_t)l * 1024 * NIN; ns = NIN; col = rr; }
        else if (rr < 1296) { if (l > 0) { src = F.in[I_VRW] + (size_t)(l - 1) * 1024 * 16; ns = 16; col = rr - 1280; } }
        else if (rr < PUSED) { src = F.in[I_WIN] + (size_t)l * 1024 * NIN; ns = NIN; col = rr - 16; }
    } else { src = F.in[I_WOUT] + (size_t)l * 1024 * 1024; ns = 1024; col = rr; }
    {
        const bool has = (src != nullptr); const float* sp = has ? src : F.in[I_FN]; const int nss = has ? ns : 0, cols = has ? col : 0;
        f32x4 vals[8];
#pragma unroll
        for (int i = 0; i < 8; ++i) { const int k = k0 + 8 * i + kr; const int kc = k < ksrc ? k : ksrc - 1; vals[i] = *(const GAS f32x4*)(sp + (size_t)kc * nss + cols); }
#pragma unroll
        for (int i = 0; i < 8; ++i) { const int kk = 8 * i + kr, k = k0 + kk; float g = (has && k < ksrc) ? scale : 0.f; if (gain) g *= gain[k < 1024 ? k : 1023];
            LAS float* d = scr + kk * 33 + n4; d[0] = vals[i][0] * g; d[1] = vals[i][1] * g; d[2] = vals[i][2] * g; d[3] = vals[i][3] * g; }
    }
    LDS_WAIT(); asm volatile("" ::: "memory");
    const int c = lane & 7;
#pragma unroll
    for (int j = 0; j < 4; ++j) { const int n = (lane >> 3) + 8 * j; const LAS float* s = scr + (8 * c) * 33 + n;
        v4u o; o.x = pk2(s[0 * 33], s[1 * 33]); o.y = pk2(s[2 * 33], s[3 * 33]); o.z = pk2(s[4 * 33], s[5 * 33]); o.w = pk2(s[6 * 33], s[7 * 33]);
        *(GAS v4u*)(WT + (size_t)(r0 + n) * Kd + k0 + 8 * c) = o; }
    LDS_WAIT(); asm volatile("" ::: "memory");
}
__host__ __device__ constexpr int conv_items(int kind) { return (kind == 0 || kind == 4) ? (NGU / 32) * 16 : (kind == 1 || kind == 5) ? 32 * (FFP / 64) : (kind == 2) ? (PP / 32) * 16 : 32 * 16; }
__device__ __forceinline__ void conv_weights(const Frame& F, int l, int k_lo, int k_hi) {
    LAS float* scr = (LAS float*)(F.lds + F.wave * 16384);
    const int gw = F.vcu * NWAVES + F.wave, NGW = F.G * NWAVES;
    for (int kind = k_lo; kind < k_hi; ++kind) { const int ni = conv_items(kind);
        for (int it = gw; it < ni; it += NGW) conv_item(F, l, kind, it, scr); }
}

__host__ __device__ constexpr int conv_flat_items(bool has_next) { return conv_items(3) + conv_items(4) + conv_items(5) + (has_next ? conv_items(0) + conv_items(1) + conv_items(2) : 0); }
constexpr int CONV_PER_WAVE = 2;
__device__ __forceinline__ void conv_unit(const Frame& F, int l, int u) {
    LAS float* scr = (LAS float*)(F.lds + F.wave * 16384);
    const bool has_next = (l + 1 < DEPTH);
#pragma unroll 1
    for (int rep = 0; rep < CONV_PER_WAVE; ++rep) {
    int it = (u * CONV_PER_WAVE + rep) * NWAVES + F.wave;
    if (it >= conv_flat_items(has_next)) return;
    int layer = l, kind = 3;
    if (it >= conv_items(3)) { it -= conv_items(3); kind = 4;
        if (it >= conv_items(4)) { it -= conv_items(4); kind = 5;
            if (it >= conv_items(5)) { it -= conv_items(5); kind = 0; layer = l + 1;
                if (it >= conv_items(0)) { it -= conv_items(0); kind = 1;
                    if (it >= conv_items(1)) { it -= conv_items(1); kind = 2; } } } } }
    conv_item(F, layer, kind, it, scr);
    }
}
__device__ __forceinline__ void p0_x(const Frame& F) {
    const int gw = F.vcu * NWAVES + F.wave, NGW = F.G * NWAVES;
    const float* x = F.in[I_X]; bf16* xb = (bf16*)(F.ws + WS_XB); float* part = (float*)(F.ws + WS_PART);
    for (int m = gw; m < M; m += NGW) {
        const GAS f32x4* xr = (const GAS f32x4*)(x + (size_t)m * DM) + F.lane; float s = 0.f;
        GAS unsigned long long* o8 = (GAS unsigned long long*)(xb + (size_t)m * DM) + F.lane;
#pragma unroll
        for (int j = 0; j < 4; ++j) { const f32x4 v = xr[64 * j]; s += (v.x * v.x + v.y * v.y) + (v.z * v.z + v.w * v.w);
            o8[64 * j] = (unsigned long long)pk2(v.x, v.y) | ((unsigned long long)pk2(v.z, v.w) << 32); }
        s = wave_sum(s);
        if (F.lane < 16) part[(size_t)m * 16 + F.lane] = (F.lane == 0) ? s : 0.f;
    }
}
__device__ __forceinline__ void p0_table(const Frame& F) {
    float* tab = (float*)(F.ws + WS_TAB);
    for (int i = F.vcu * NTHR + F.tid; i < SEQ * 32; i += F.G * NTHR) { const int t = i >> 5, f = i & 31; const float th = exp2f(-(float)f * (13.287712379549449f / 31.0f)); const float ang = (float)t * th; float s, c; sincosf(ang, &s, &c); tab[2 * i] = c; tab[2 * i + 1] = s; }
}

__device__ __forceinline__ void ret_kv_unit(const Frame& F, int unit) {
    unsigned dga_ = 0;
    DG_START(30, dg30_)
    LAS float* kr = (LAS float*)F.lds; LAS float* vv = kr + 128 * 64;
    const int tid = F.tid, c = unit & 15, h = (unit >> 4) & 3, b = unit >> 6, tok0 = b * SEQ + c * 128;
    const bf16* P = (const bf16*)(F.ws + WS_P); const float* tab = (const float*)(F.ws + WS_TAB);
    const float lg2 = log2f(1.0f - exp2f(-5.0f - (float)h));
    for (int idx = tid; idx < 128 * 32; idx += NTHR) { const int m = idx >> 5, i = idx & 31; const size_t ro = (size_t)(tok0 + m) * PP;
        const float k1 = bf2f(P[ro + PCK + h * 64 + i]), k2 = bf2f(P[ro + PCK + h * 64 + 32 + i]);
        const float cs = tab[((c * 128 + m) * 32 + i) * 2], sn = tab[((c * 128 + m) * 32 + i) * 2 + 1];
        const float sc = 0.125f * exp2f((float)(127 - m) * lg2);
        kr[m * 64 + i] = (k1 * cs - k2 * sn) * sc; kr[m * 64 + 32 + i] = (k1 * sn + k2 * cs) * sc;
        vv[m * 64 + i] = bf2f(P[ro + PCV + h * 64 + i]); vv[m * 64 + 32 + i] = bf2f(P[ro + PCV + h * 64 + 32 + i]); }
    __syncthreads();
    const int d = tid >> 3, e0 = (tid & 7) * 8; float acc[8];
#pragma unroll
    for (int e = 0; e < 8; ++e) acc[e] = 0.f;
    for (int m = 0; m < 128; ++m) { const float kd = kr[m * 64 + d];
#pragma unroll
        for (int e = 0; e < 8; ++e) acc[e] += kd * vv[m * 64 + e0 + e]; }
    float* KV = (float*)(F.ws + WS_KV) + (size_t)unit * 4096 + d * 64 + e0;
#pragma unroll
    for (int e = 0; e < 8; ++e) KV[e] = acc[e];
    __syncthreads();
    DG_STOP(30, dg30_, dga_)
    DG_WRITE(30, unit == 0 && F.wave == 0 && F.lane == 0, dga_)
}

typedef float f32x2 __attribute__((ext_vector_type(2)));
__device__ __forceinline__ float dpp_add16(float x) {
    x += __builtin_bit_cast(float, __builtin_amdgcn_mov_dpp(__builtin_bit_cast(int, x), 0xB1, 0xF, 0xF, true));
    x += __builtin_bit_cast(float, __builtin_amdgcn_mov_dpp(__builtin_bit_cast(int, x), 0x4E, 0xF, 0xF, true));
    x += __builtin_bit_cast(float, __builtin_amdgcn_mov_dpp(__builtin_bit_cast(int, x), 0x141, 0xF, 0xF, true));
    x += __builtin_bit_cast(float, __builtin_amdgcn_mov_dpp(__builtin_bit_cast(int, x), 0x140, 0xF, 0xF, true));
    return x;
}
constexpr int CH = 32;
constexpr int RW_STG = 5 * CH * 64;
constexpr int RW_ROWS = 16;
struct RwOps { f32x4 r, d, k, q, b; float v; };
__device__ __forceinline__ void rw_ld(RwOps& o, const LAS float* base, const LAS float* vb, int s, int ks, int row) {
    const LAS f32x4* p = (const LAS f32x4*)(base + s * 64 + ks * 4);
    o.r = p[0]; o.d = p[CH * 16]; o.k = p[2 * CH * 16]; o.q = p[3 * CH * 16]; o.b = p[4 * CH * 16];
    o.v = vb[s * RW_ROWS + row];
}
#define LO2(x) __builtin_shufflevector(x, x, 0, 1)
#define HI2(x) __builtin_shufflevector(x, x, 2, 3)
__device__ __forceinline__ float rw_step1(f32x2 (&S)[2], const RwOps& o, float v) {
    f32x2 p2 = S[0] * LO2(o.q); p2 = S[1] * HI2(o.q) + p2;
    const float p = dpp_add16(p2.x + p2.y);
    const f32x2 pp = (f32x2){p, p}, vv = (f32x2){v, v};
    S[0] = S[0] - LO2(o.d) * S[0]; S[1] = S[1] - HI2(o.d) * S[1];
    S[0] = S[0] - pp * LO2(o.b); S[1] = S[1] - pp * HI2(o.b);
    S[0] = vv * LO2(o.k) + S[0]; S[1] = vv * HI2(o.k) + S[1];
    f32x2 y2 = S[0] * LO2(o.r); y2 = S[1] * HI2(o.r) + y2;
    return dpp_add16(y2.x + y2.y);
}
__device__ __forceinline__ void rwkv_scan_unit(const Frame& F, int l, int unit) {
    const int tid = F.tid, lane = F.lane, wave = F.wave, quarter = unit & 3, bh = unit >> 2, b = bh / 6, h = bh - b * 6, tokb = b * SEQ;
    LAS float* stg = (LAS float*)F.lds; LAS float* vst = stg + 2 * RW_STG; LAS float* ybuf = vst + 2 * CH * RW_ROWS;
    bf16* P = (bf16*)(F.ws + WS_P);
    constexpr int NCH = SEQ / CH;
    unsigned dga_ = 0;
    if (wave >= 4) {
        const int st = tid - 256;
        const int t01 = st >> 3, c01 = st & 7, tv = st >> 1, cv = st & 1;
        const bf16* a0 = (const bf16*)(F.ws + WS_R); const bf16* a1 = (const bf16*)(F.ws + WS_D); const bf16* a2 = (const bf16*)(F.ws + WS_K2); const bf16* a3 = (const bf16*)(F.ws + WS_KK);
        const bf16* a4 = (const bf16*)((const unsigned char*)F.out + OUT_BP); const bf16* a5 = (const bf16*)(F.ws + WS_VF);
        v4u sreg[6];
#define RW_LOAD(cc) do { const size_t o_ = (size_t)(tokb + (cc) * CH + t01) * AW + h * 64 + c01 * 8; sreg[0] = *(const GAS v4u*)(a0 + o_); sreg[1] = *(const GAS v4u*)(a1 + o_); sreg[2] = *(const GAS v4u*)(a2 + o_); \
            sreg[3] = *(const GAS v4u*)(a3 + o_); sreg[4] = *(const GAS v4u*)(a4 + o_); if (st < 64) sreg[5] = *(const GAS v4u*)(a5 + (size_t)(tokb + (cc) * CH + tv) * AW + h * 64 + quarter * RW_ROWS + cv * 8); } while (0)
#define RW_ST1(i, dstp) do { float f[8]; unpack8(sreg[i], f); LAS f32x4* dst = (LAS f32x4*)(dstp); dst[0] = (f32x4){f[0], f[1], f[2], f[3]}; dst[1] = (f32x4){f[4], f[5], f[6], f[7]}; } while (0)
#define RW_STORE(bufi) do { _Pragma("unroll") for (int i = 0; i < 5; ++i) RW_ST1(i, stg + (bufi) * RW_STG + i * CH * 64 + t01 * 64 + c01 * 8); if (st < 64) RW_ST1(5, vst + (bufi) * CH * RW_ROWS + tv * RW_ROWS + cv * 8); } while (0)
#define RW_OUT(cc) do { if (st < 128) { const LAS float* yb_ = ybuf + ((cc) & 1) * CH * RW_ROWS; const int s_ = st >> 2, r4_ = (st & 3) * 4; const f32x4 yv = *(const LAS f32x4*)(yb_ + s_ * RW_ROWS + r4_); \
            *(GAS unsigned long long*)(P + (size_t)(tokb + (cc) * CH + s_) * PP + h * 64 + quarter * RW_ROWS + r4_) = (unsigned long long)pk2(yv[0], yv[1]) | ((unsigned long long)pk2(yv[2], yv[3]) << 32); } } while (0)
        RW_LOAD(0); RW_STORE(0); RW_LOAD(1);
        __syncthreads();
        for (int cc = 0; cc < NCH; ++cc) {
            if (cc + 1 < NCH) RW_STORE((cc + 1) & 1);
            if (cc + 2 < NCH) RW_LOAD(cc + 2);
            if (cc > 0) RW_OUT(cc - 1);
            asm volatile("s_waitcnt lgkmcnt(0)" ::: "memory"); __builtin_amdgcn_s_barrier(); asm volatile("" ::: "memory");
        }
        RW_OUT(NCH - 1);
#undef RW_LOAD
#undef RW_ST1
#undef RW_STORE
#undef RW_OUT
        return;
    }
    const int row = 4 * wave + (lane >> 4), ks = lane & 15;
    f32x2 Sa[2] = {(f32x2){0.f, 0.f}, (f32x2){0.f, 0.f}};
    __syncthreads();
    for (int cc = 0; cc < NCH; ++cc) {
        const int bufi = cc & 1;
        const LAS float* base = stg + bufi * RW_STG; const LAS float* vb = vst + bufi * CH * RW_ROWS; LAS float* yb = ybuf + bufi * CH * RW_ROWS;
        RwOps A, B; float yk0 = 0.f;
        DG_START(40, dg40_)
        rw_ld(A, base, vb, 0, ks, row);
#pragma unroll
        for (int s = 0; s < CH; s += 2) {
            rw_ld(B, base, vb, s + 1, ks, row);
            { const float y0 = rw_step1(Sa, A, A.v); yk0 = (ks == (s & 15)) ? y0 : yk0; }
            if (s + 2 < CH) rw_ld(A, base, vb, s + 2, ks, row);
            { const float y0 = rw_step1(Sa, B, B.v); yk0 = (ks == ((s + 1) & 15)) ? y0 : yk0; }
            if (((s + 1) & 15) == 15) yb[(s - 14 + ks) * RW_ROWS + row] = yk0;
        }
        DG_STOP(40, dg40_, dga_)
        DG_START(43, dg43_)
        asm volatile("s_waitcnt lgkmcnt(0)" ::: "memory"); __builtin_amdgcn_s_barrier(); asm volatile("" ::: "memory");
        DG_STOP(43, dg43_, dga_)
    }
    DG_WRITE(40, unit == 0 && l == 0 && wave == 0 && lane == 0, dga_)
    DG_WRITE(43, unit == 0 && l == 0 && wave == 0 && lane == 0, dga_)
}
__device__ __forceinline__ void rwkv_post(const Frame& F, int l) {
    bf16* P = (bf16*)(F.ws + WS_P); const bf16* VF = (const bf16*)(F.ws + WS_VF); const bf16* Gg = (const bf16*)((const unsigned char*)F.out + OUT_G); const float* BON = (const float*)(F.ws + WS_BON);
    const int sub = F.tid >> 4, c4 = (F.tid & 15) * 4;
    for (int pr = F.vcu * 32 + sub; pr < M * 6; pr += F.G * 32) { const int tok = pr / 6, h = pr - tok * 6;
        const unsigned long long yw = *(const GAS unsigned long long*)(P + (size_t)tok * PP + h * 64 + c4), vw = *(const GAS unsigned long long*)(VF + (size_t)tok * AW + h * 64 + c4), gw = *(const GAS unsigned long long*)(Gg + (size_t)tok * AW + h * 64 + c4);
        const f32x4 lnw = *(const f32x4*)(F.in[I_LNW] + l * AW + h * 64 + c4), lnb = *(const f32x4*)(F.in[I_LNB] + l * AW + h * 64 + c4);
        const float bon = BON[(size_t)tok * 6 + h];
        const f32x4 yv = (f32x4){bflo((unsigned)yw), bfhi((unsigned)yw), bflo((unsigned)(yw >> 32)), bfhi((unsigned)(yw >> 32))};
        const f32x4 vv = (f32x4){bflo((unsigned)vw), bfhi((unsigned)vw), bflo((unsigned)(vw >> 32)), bfhi((unsigned)(vw >> 32))};
        const f32x4 gg = (f32x4){bflo((unsigned)gw), bfhi((unsigned)gw), bflo((unsigned)(gw >> 32)), bfhi((unsigned)(gw >> 32))};
        float sm = (yv[0] + yv[1]) + (yv[2] + yv[3]);
        sm += __shfl_xor(sm, 1); sm += __shfl_xor(sm, 2); sm += __shfl_xor(sm, 4); sm += __shfl_xor(sm, 8);
        const float mean = sm * (1.0f / 64.0f); const f32x4 dv = yv - mean;
        float vs = (dv[0] * dv[0] + dv[1] * dv[1]) + (dv[2] * dv[2] + dv[3] * dv[3]);
        vs += __shfl_xor(vs, 1); vs += __shfl_xor(vs, 2); vs += __shfl_xor(vs, 4); vs += __shfl_xor(vs, 8);
        const float rs = 1.0f / sqrtf(vs * (1.0f / 64.0f) + 64e-5f);
        const f32x4 o = (dv * rs * lnw + lnb + bon * vv) * gg;
        *(GAS unsigned long long*)(P + (size_t)tok * PP + h * 64 + c4) = (unsigned long long)pk2(o[0], o[1]) | ((unsigned long long)pk2(o[2], o[3]) << 32);
    }
}

typedef short bf16x8_t __attribute__((ext_vector_type(8)));
typedef short s16x4_t __attribute__((ext_vector_type(4)));
typedef float f32x16_t __attribute__((ext_vector_type(16)));
__device__ __forceinline__ unsigned fkey(float f) { const unsigned u = __float_as_uint(f); return (u & 0x80000000u) ? ~u : (u | 0x80000000u); }
__device__ __forceinline__ int crow32(int r, int hi) { return (r & 3) + 8 * (r >> 2) + 4 * hi; }
__device__ __forceinline__ unsigned off_a(unsigned row, unsigned ch) { return 2048u * (row >> 3) + 512u * (ch >> 2) + 64u * (row & 7) + 16u * ((ch & 3) ^ ((row >> 2) & 3)); }

__device__ __forceinline__ void idx_scores(const bf16x8_t (&Af)[2], const bf16x8_t (&Bf)[8][2], const float (&iwf)[8], float (&sc)[4]) {
    sc[0] = sc[1] = sc[2] = sc[3] = 0.f;
#pragma unroll
    for (int h = 0; h < 8; ++h) { f32x4 a = (f32x4){0.f, 0.f, 0.f, 0.f};
        a = __builtin_amdgcn_mfma_f32_16x16x32_bf16(Af[0], Bf[h][0], a, 0, 0, 0);
        a = __builtin_amdgcn_mfma_f32_16x16x32_bf16(Af[1], Bf[h][1], a, 0, 0, 0);
#pragma unroll
        for (int r = 0; r < 4; ++r) { const float av_ = a[r]; const int ai_ = __float_as_int(av_); const float rl = __int_as_float(ai_ > 0 ? ai_ : 0); sc[r] = fmaf(iwf[h], rl, sc[r]); } }
}
__device__ __forceinline__ void idx_load_q(const bf16* P, int tokq, bf16x8_t (&Bf)[8][2], float (&iwf)[8], int fq) {
    const bf16* row = P + (size_t)tokq * PP;
#pragma unroll
    for (int h = 0; h < 8; ++h)
#pragma unroll
        for (int ks = 0; ks < 2; ++ks) Bf[h][ks] = *(const GAS bf16x8_t*)(row + PBIQ + h * 64 + ks * 32 + fq * 8);
    const v4u w = *(const GAS v4u*)(row + PBIW); float f[8]; unpack8(w, f);
#pragma unroll
    for (int h = 0; h < 8; ++h) iwf[h] = f[h] * (0.35355339059327373f * 0.125f);
}

__device__ __forceinline__ void lds_barrier() { asm volatile("s_waitcnt lgkmcnt(0)" ::: "memory"); __builtin_amdgcn_s_barrier(); asm volatile("" ::: "memory"); }
constexpr int SKP = 2052;
__device__ __forceinline__ void dsa_thr_unit(const Frame& F, int l, int unit) {
    LAS unsigned* sk = (LAS unsigned*)F.lds;
    const int lane = F.lane, wave = F.wave, fr = lane & 15, fq = lane >> 4;
    const int b = unit & 7, qb = 127 - (unit >> 3), t0 = qb * 16, tok0 = b * SEQ + t0;
    const bf16* P = (const bf16*)(F.ws + WS_P);
    unsigned dga_ = 0;
    DG_START(10, dg10_)
    {
        bf16x8_t Bf[8][2]; float iwf[8];
        idx_load_q(P, tok0 + fr, Bf, iwf, fq);
        bf16x8_t An[2];
        { const int kt0 = wave <= qb ? wave : qb; const bf16* krow = P + (size_t)(b * SEQ + kt0 * 16 + fr) * PP + PBIK + fq * 8; An[0] = *(const GAS bf16x8_t*)(krow); An[1] = *(const GAS bf16x8_t*)(krow + 32); }
        for (int kt = wave; kt <= qb; kt += 8) {
            bf16x8_t Af[2]; Af[0] = An[0]; Af[1] = An[1];
            { const int ktn = kt + 8 <= qb ? kt + 8 : qb; const bf16* krow = P + (size_t)(b * SEQ + ktn * 16 + fr) * PP + PBIK + fq * 8; An[0] = *(const GAS bf16x8_t*)(krow); An[1] = *(const GAS bf16x8_t*)(krow + 32); }
            float sc[4]; idx_scores(Af, Bf, iwf, sc);
            v4u kv;
            const int s0 = kt * 16 + 4 * fq, t = t0 + fr;
            kv.x = (s0 + 0 <= t) ? fkey(sc[0]) : 0u; kv.y = (s0 + 1 <= t) ? fkey(sc[1]) : 0u; kv.z = (s0 + 2 <= t) ? fkey(sc[2]) : 0u; kv.w = (s0 + 3 <= t) ? fkey(sc[3]) : 0u;
            *(LAS v4u*)(sk + fr * SKP + s0) = kv;
        }
    }
    __syncthreads();
    DG_STOP(10, dg10_, dga_)
    DG_WRITE(10, unit == 0 && wave == 0 && lane == 0, dga_)
    DG_START(11, dg11_)
    unsigned* THR = (unsigned*)(F.ws + WS_THR); int* SCUT = (int*)(F.ws + WS_SCUT);
    for (int qi = 0; qi < 2; ++qi) { const int q = 2 * wave + qi, t = t0 + q, n = t + 1;
        unsigned thr = 0u; int scut = SEQ - 1;
        if (n > TOPK) {
            unsigned keys[32];
#pragma unroll
            for (int i = 0; i < 32; ++i) keys[i] = (64 * i + lane <= t) ? sk[q * SKP + 64 * i + lane] : 0u;
            unsigned prefix = 0u; bool done = false;
            const int ng = (t >> 9) + 1;
            for (int bit = 31; bit >= 0; --bit) { const unsigned cand = prefix | (1u << bit); int cnt = 0;
#pragma unroll
                for (int g = 0; g < 4; ++g) if (g < ng) {
#pragma unroll
                    for (int i = 8 * g; i < 8 * g + 8; ++i) cnt += __popcll(__ballot(keys[i] >= cand)); }
                if (cnt >= TOPK) prefix = cand;
                if (cnt == TOPK) { thr = cand - 1u; scut = -1; done = true; break; } }
            if (!done) {
                int cgt = 0;
#pragma unroll
                for (int i = 0; i < 32; ++i) cgt += __popcll(__ballot(keys[i] > prefix));
                int need = TOPK - cgt, run = 0; thr = prefix; scut = SEQ - 1; bool found = false;
#pragma unroll
                for (int i = 0; i < 32; ++i) { unsigned long long mk = __ballot(keys[i] == prefix); const int c = __popcll(mk);
                    if (!found && run + c >= need) { int k = need - run; while (k > 1) { mk &= mk - 1ull; --k; } scut = 64 * i + (int)__builtin_ctzll(mk); found = true; }
                    run += c; }
            }
        }
        {
            unsigned* MK = (unsigned*)((unsigned char*)F.out + OUT_MASK) + (size_t)(tok0 + q) * 64;
            if (n > TOPK) {
#pragma unroll
                for (int i = 0; i < 32; ++i) { const int s = 64 * i + lane; const unsigned key = (s <= t) ? sk[q * SKP + s] : 0u;
                    const unsigned long long bal = __ballot((s <= t) & ((key > thr) | ((key == thr) & (s <= scut))));
                    if (lane < 2 && 64 * i <= t) MK[2 * i + lane] = lane ? (unsigned)(bal >> 32) : (unsigned)bal; }
            } else {
                if (lane < 8) { const int w0 = lane; MK[w0] = (32 * w0 + 31 <= t) ? 0xffffffffu : ((32 * w0 <= t) ? ((1u << ((t & 31) + 1)) - 1u) : 0u); }
            }
        }
    }
    DG_STOP(11, dg11_, dga_)
    DG_WRITE(11, unit == 0 && wave == 0 && lane == 0, dga_)
    __syncthreads();
    if (F.tid == 0) {
        __builtin_amdgcn_fence(__ATOMIC_RELEASE, "agent");
        __hip_atomic_fetch_add((unsigned*)(F.ws + WS_CTL) + CW_THRD + l * 512 + 8 * (unit >> 4) + (unit & 7), 1u, RLX_AGENT); }
}

constexpr int QLP = 136;
constexpr int MKP = 36;
constexpr int DA_MASK = 0, DA_QL = 2 * 32 * MKP * 4, DA_CT = DA_QL + 6 * 32 * QLP * 2;
__device__ __forceinline__ void dsa_attn_unit(const Frame& F, int l, int unit) {
    const int tid = F.tid, lane = F.lane, wave = F.wave, r32 = lane & 31, hi = lane >> 5;
    const int b = unit & 7, qb = 63 - (unit >> 3), t0 = qb * 32, tok0 = b * SEQ + t0, ntile = qb + 1;
    {
        if (tid == 0) { const unsigned* dn = (const unsigned*)(F.ws + WS_CTL) + CW_THRD + l * 512 + unit;
            while (__hip_atomic_load(dn, RLX_AGENT) < 2u) __builtin_amdgcn_s_sleep(8);
            __builtin_amdgcn_fence(__ATOMIC_ACQUIRE, "agent"); }
        __syncthreads(); }
    bf16* P = (bf16*)(F.ws + WS_P); const bf16* C = (const bf16*)(F.ws + WS_C);
    LAS float* MASK = (LAS float*)(F.lds + DA_MASK); LAS unsigned char* QLb = F.lds + DA_QL; LAS unsigned char* CT = F.lds + DA_CT;
    const int crow_ = tid >> 4, cch = tid & 15; const unsigned cdst = off_a((unsigned)crow_, (unsigned)cch);
    const bf16* csrc = C + (size_t)(b * SEQ + crow_) * 128 + cch * 8;
    v4u cpre = *(const GAS v4u*)(csrc);
    if (wave >= 6) {
        const int fr = lane & 15, fq = lane >> 4, qh = wave - 6;
        const int tq = tok0 + 16 * qh + fr, tq_t = t0 + 16 * qh + fr, jmax = tq_t >> 5;
        const unsigned* MK = (const unsigned*)((const unsigned char*)F.out + OUT_MASK) + (size_t)tq * 64;
        LAS float* mrow = MASK + (16 * qh + fr) * MKP + 8 * fq;
#define DA_EXPAND(word, slot) do { const unsigned w_ = (word) >> (8 * fq); f32x4 m0_, m1_; \
            m0_[0] = (w_ & 1u) ? 0.f : -1e30f; m0_[1] = (w_ & 2u) ? 0.f : -1e30f; m0_[2] = (w_ & 4u) ? 0.f : -1e30f; m0_[3] = (w_ & 8u) ? 0.f : -1e30f; \
            m1_[0] = (w_ & 16u) ? 0.f : -1e30f; m1_[1] = (w_ & 32u) ? 0.f : -1e30f; m1_[2] = (w_ & 64u) ? 0.f : -1e30f; m1_[3] = (w_ & 128u) ? 0.f : -1e30f; \
            *(LAS f32x4*)(mrow + (slot) * (32 * MKP)) = m0_; *(LAS f32x4*)(mrow + (slot) * (32 * MKP) + 4) = m1_; } while (0)
        unsigned w0 = MK[0], w1 = (1 <= jmax) ? MK[1] : 0u, w2 = (2 <= jmax) ? MK[2] : 0u;
        DA_EXPAND(w0, 0);
        *(LAS v4u*)(CT + cdst) = cpre;
        lds_barrier();
        for (int j = 0; j < ntile; ++j) {
            if (j + 1 < ntile) {
                cpre = *(const GAS v4u*)(csrc + (size_t)(j + 1) * 32 * 128);
                DA_EXPAND(w1, (j + 1) & 1);
                w1 = w2; w2 = (j + 3 <= jmax) ? MK[j + 3] : 0u;
                *(LAS v4u*)(CT + ((j + 1) & 1) * 8192 + cdst) = cpre; }
            lds_barrier();
        }
#undef DA_EXPAND
        lds_barrier();
        return;
    }
    const int h = wave;
    LAS unsigned char* QLh = QLb + h * (32 * QLP * 2);
    float negb;
    {
        unsigned zo_ = 0u; asm volatile("" : "+v"(zo_));
        const bf16* wukT = (const bf16*)(F.ws + WS_WUKT) + (size_t)(l * 6 + h) * 128 * 64 + zo_;
        bf16x8_t qf[4]; float ssq = 0.f;
#pragma unroll
        for (int ks = 0; ks < 4; ++ks) qf[ks] = *(const GAS bf16x8_t*)(P + (size_t)(tok0 + r32) * PP + PBQ + h * 64 + ks * 16 + hi * 8);
#pragma unroll
        for (int blk = 0; blk < 4; ++blk) { f32x16_t x;
#pragma unroll
            for (int i = 0; i < 16; ++i) x[i] = 0.f;
#pragma unroll
            for (int ks = 0; ks < 4; ++ks) { const bf16x8_t a = *(const GAS bf16x8_t*)(wukT + (size_t)(blk * 32 + r32) * 64 + ks * 16 + hi * 8); x = __builtin_amdgcn_mfma_f32_32x32x16_bf16(a, qf[ks], x, 0, 0, 0); }
#pragma unroll
            for (int g = 0; g < 4; ++g) { const float sc = 0.125f * 1.4426950408889634f;
                const float x0 = x[4 * g] * sc, x1 = x[4 * g + 1] * sc, x2 = x[4 * g + 2] * sc, x3 = x[4 * g + 3] * sc; ssq += (x0 * x0 + x1 * x1) + (x2 * x2 + x3 * x3);
                const unsigned long long w = (unsigned long long)pk2(x0, x1) | ((unsigned long long)pk2(x2, x3) << 32);
                *(LAS unsigned long long*)(QLh + (r32 * QLP + blk * 32 + 8 * g + 4 * hi) * 2) = w; } }
        ssq += __shfl_xor(ssq, 32);
        const float* kvn = F.in[I_KVN] + l * 128; float gm = fmaxf(fabsf(kvn[2 * lane]), fabsf(kvn[2 * lane + 1]));
#pragma unroll
        for (int o_ = 1; o_ < 64; o_ <<= 1) gm = fmaxf(gm, __shfl_xor(gm, o_));
        negb = -(sqrtf(ssq) * 11.32f * gm * 1.01f + 0.01f);
    }
    *(LAS v4u*)(CT + cdst) = cpre;
    lds_barrier();
    f32x16_t o[4]; float l_run = 0.f;
    const LAS unsigned char* qlrow = QLh + (r32 * QLP + 8 * hi) * 2;
#pragma unroll
    for (int c = 0; c < 4; ++c)
#pragma unroll
        for (int i = 0; i < 16; ++i) o[c][i] = 0.f;
    const unsigned rr_ = ((unsigned)r32 >> 2) & 3u, rb_ = 2048u * ((unsigned)r32 >> 3) + 64u * ((unsigned)r32 & 7u);
    const unsigned rbase0 = rb_ + 16u * ((unsigned)hi ^ rr_), rbase1 = rb_ + 16u * ((2u + (unsigned)hi) ^ rr_);
    const unsigned blk_ = (lane >> 4) & 1, q_ = (lane & 15) >> 2, p_ = lane & 3;
    unsigned dga_ = 0;
    for (int j = 0; j < ntile; ++j) {
        DG_START(0, dgt_)
        LAS unsigned char* kb = CT + (j & 1) * 8192;
        if (j + 1 < ntile) cpre = *(const GAS v4u*)(csrc + (size_t)(j + 1) * 32 * 128);
        {
            f32x16_t S;
#pragma unroll
            for (int i = 0; i < 16; ++i) S[i] = negb;
#pragma unroll
            for (int s = 0; s < 8; ++s) { const bf16x8_t a = *(const LAS bf16x8_t*)(kb + ((s & 1) ? rbase1 : rbase0) + 512 * (s >> 1)); const bf16x8_t bq = *(const LAS bf16x8_t*)(qlrow + 32 * s);
                S = __builtin_amdgcn_mfma_f32_32x32x16_bf16(a, bq, S, 0, 0, 0); }
            const LAS f32x4* mk = (const LAS f32x4*)(MASK + (j & 1) * (32 * MKP) + r32 * MKP + 4 * hi);
            float psum = 0.f; float e[16];
#pragma unroll
            for (int g = 0; g < 4; ++g) { const f32x4 mv = mk[2 * g];
#pragma unroll
                for (int e4 = 0; e4 < 4; ++e4) { e[4 * g + e4] = __builtin_amdgcn_exp2f(S[4 * g + e4] + mv[e4]); psum += e[4 * g + e4]; } }
            l_run += psum;
            bf16x8_t xs[2];
#pragma unroll
            for (int s = 0; s < 2; ++s) { v4u w; w.x = pk2(e[8 * s], e[8 * s + 1]); w.y = pk2(e[8 * s + 2], e[8 * s + 3]); w.z = pk2(e[8 * s + 4], e[8 * s + 5]); w.w = pk2(e[8 * s + 6], e[8 * s + 7]); xs[s] = __builtin_bit_cast(bf16x8_t, w); }
#pragma unroll
            for (int c = 0; c < 4; ++c)
#pragma unroll
                for (int s = 0; s < 2; ++s) {
                    const unsigned a0 = off_a((unsigned)(16 * s + 4 * hi + q_), (unsigned)(4 * c + 2 * blk_ + (p_ >> 1))) + 8u * (p_ & 1);
                    const unsigned a1 = off_a((unsigned)(16 * s + 8 + 4 * hi + q_), (unsigned)(4 * c + 2 * blk_ + (p_ >> 1))) + 8u * (p_ & 1);
                    const s16x4_t lo = __builtin_bit_cast(s16x4_t, __builtin_amdgcn_ds_read_tr16_b64_v4i16((LAS s16x4_t*)(kb + a0)));
                    const s16x4_t hh = __builtin_bit_cast(s16x4_t, __builtin_amdgcn_ds_read_tr16_b64_v4i16((LAS s16x4_t*)(kb + a1)));
                    const bf16x8_t a = (bf16x8_t){lo[0], lo[1], lo[2], lo[3], hh[0], hh[1], hh[2], hh[3]};
                    o[c] = __builtin_amdgcn_mfma_f32_32x32x16_bf16(a, xs[s], o[c], 0, 0, 0); }
        }
        if (j + 1 < ntile) *(LAS v4u*)(CT + ((j + 1) & 1) * 8192 + cdst) = cpre;
        DG_STOP(0, dgt_, dga_)
        lds_barrier();
    }
    DG_WRITE(0, unit == 0 && l == 0 && wave == 0 && lane == 0, dga_)
    {
        const float lt = l_run + __shfl_xor(l_run, 32); const float inv = 1.0f / lt;
#pragma unroll
        for (int c = 0; c < 4; ++c)
#pragma unroll
            for (int g = 0; g < 4; ++g) { const unsigned long long w = (unsigned long long)pk2(o[c][4 * g] * inv, o[c][4 * g + 1] * inv) | ((unsigned long long)pk2(o[c][4 * g + 2] * inv, o[c][4 * g + 3] * inv) << 32);
                *(LAS unsigned long long*)(QLh + (r32 * QLP + c * 32 + 8 * g + 4 * hi) * 2) = w; }
        unsigned zo2_ = 0u; asm volatile("" : "+v"(zo2_));
        const bf16* wuvT = (const bf16*)(F.ws + WS_WUVT) + (size_t)(l * 6 + h) * 64 * 128 + zo2_;
        bf16x8_t Bo[8];
#pragma unroll
        for (int s = 0; s < 8; ++s) Bo[s] = *(const LAS bf16x8_t*)(QLh + (r32 * QLP + 16 * s + 8 * hi) * 2);
#pragma unroll
        for (int mb = 0; mb < 2; ++mb) { f32x16_t y;
#pragma unroll
            for (int i = 0; i < 16; ++i) y[i] = 0.f;
#pragma unroll
            for (int s = 0; s < 8; ++s) { const bf16x8_t a = *(const GAS bf16x8_t*)(wuvT + (size_t)(mb * 32 + r32) * 128 + 16 * s + 8 * hi); y = __builtin_amdgcn_mfma_f32_32x32x16_bf16(a, Bo[s], y, 0, 0, 0); }
#pragma unroll
            for (int g = 0; g < 4; ++g) { const unsigned long long w = (unsigned long long)pk2(y[4 * g], y[4 * g + 1]) | ((unsigned long long)pk2(y[4 * g + 2], y[4 * g + 3]) << 32);
                *(GAS unsigned long long*)(P + (size_t)(tok0 + r32) * PP + 384 + h * 64 + mb * 32 + 8 * g + 4 * hi) = w; } }
    }
    lds_barrier();
}
constexpr int RC = 32;
constexpr int P64 = 72, P32 = 40, PTS = 36;
constexpr int RPW = 72, RAWSZ = 32 * RPW, GP = 68;
constexpr int RK_RAW = 0;
constexpr int RK_GAM = RK_RAW + 6 * RAWSZ * 2;
constexpr int RK_AL = RK_GAM + 33 * GP * 4, RK_RH = RK_AL + 32 * P64 * 2, RK_BE = RK_RH + 32 * P64 * 2, RK_KA = RK_BE + 32 * P64 * 2;
constexpr int RK_BET = RK_KA + 32 * P64 * 2, RK_KAT = RK_BET + 64 * P32 * 2, RK_VT = RK_KAT + 64 * P32 * 2;
constexpr int RK_NT = RK_VT + 64 * P32 * 2, RK_BRT = RK_NT + 32 * P32 * 2, RK_KRT = RK_BRT + 32 * P32 * 2;
constexpr int RK_ZB = RK_KRT + 32 * P32 * 2;
constexpr int RK_XB = RK_ZB + 2 * 64 * P64 * 2;
constexpr int RK_EB = RK_XB + 64 * P32 * 2;
constexpr int RK_BRT2 = RK_EB + 64 * P32 * 2, RK_BET2 = RK_BRT2 + 32 * P32 * 2, RK_GC = RK_BET2 + 64 * P32 * 2;
constexpr int RK_LN = RK_GC + 512;
constexpr int RK_END = RK_LN + 512;
static_assert(RK_END <= RING_BYTES, "chunked RWKV unit: LDS");
template <int KS> __device__ __forceinline__ void mm_ld(bf16x8_t (&a)[KS], bf16x8_t (&b)[KS], const LAS bf16* X, int px, const LAS bf16* Y, int py, int r32, int hi) {
#pragma unroll
    for (int s = 0; s < KS; ++s) { a[s] = *(const LAS bf16x8_t*)(X + r32 * px + 16 * s + 8 * hi); b[s] = *(const LAS bf16x8_t*)(Y + r32 * py + 16 * s + 8 * hi); }
}
template <int KS> __device__ __forceinline__ void mm_do(f32x16_t& acc, const bf16x8_t (&a)[KS], const bf16x8_t (&b)[KS]) {
#pragma unroll
    for (int s = 0; s < KS; ++s) acc = __builtin_amdgcn_mfma_f32_32x32x16_bf16(a[s], b[s], acc, 0, 0, 0);
}
__device__ __forceinline__ bf16x8_t acc_frag(const f32x16_t& a, int s) { v4u w; w.x = pk2(a[8 * s], a[8 * s + 1]); w.y = pk2(a[8 * s + 2], a[8 * s + 3]); w.z = pk2(a[8 * s + 4], a[8 * s + 5]); w.w = pk2(a[8 * s + 6], a[8 * s + 7]); return __builtin_bit_cast(bf16x8_t, w); }
__device__ __forceinline__ void mm_acc(f32x16_t& d, const f32x16_t& at, const f32x16_t& b) {
    d = __builtin_amdgcn_mfma_f32_32x32x16_bf16(acc_frag(at, 0), acc_frag(b, 0), d, 0, 0, 0); d = __builtin_amdgcn_mfma_f32_32x32x16_bf16(acc_frag(at, 1), acc_frag(b, 1), d, 0, 0, 0);
}
template <int KS> __device__ __forceinline__ void mm_abt(f32x16_t& acc, const LAS bf16* X, int px, const LAS bf16* Y, int py, int r32, int hi) {
    bf16x8_t a[KS], b[KS]; mm_ld<KS>(a, b, X, px, Y, py, r32, hi); mm_do<KS>(acc, a, b);
}
template <int K1, int K2> __device__ __forceinline__ void mm_abt2(f32x16_t& acc, const LAS bf16* X1, int px1, const LAS bf16* Y1, int py1, const LAS bf16* X2, int px2, const LAS bf16* Y2, int py2, int r32, int hi) {
    bf16x8_t a1[K1], b1[K1], a2[K2], b2[K2]; mm_ld<K1>(a1, b1, X1, px1, Y1, py1, r32, hi); mm_ld<K2>(a2, b2, X2, px2, Y2, py2, r32, hi); mm_do<K1>(acc, a1, b1); mm_do<K2>(acc, a2, b2);
}
__device__ __forceinline__ void rwkv_chunk_unit(const Frame& F, int l, int unit) {
    const int tid = F.tid, lane = F.lane, wave = F.wave, r32 = lane & 31, hi = lane >> 5;
    const int b = unit / 6, h = unit - b * 6, tokb = b * SEQ;
    LAS bf16* RAW = (LAS bf16*)(F.lds + RK_RAW); LAS float* GAM = (LAS float*)(F.lds + RK_GAM);
    LAS bf16* AL = (LAS bf16*)(F.lds + RK_AL); LAS bf16* RH = (LAS bf16*)(F.lds + RK_RH); LAS bf16* BE = (LAS bf16*)(F.lds + RK_BE); LAS bf16* KA = (LAS bf16*)(F.lds + RK_KA);
    LAS bf16* KAT = (LAS bf16*)(F.lds + RK_KAT); LAS bf16* VT = (LAS bf16*)(F.lds + RK_VT);
    LAS bf16* NT = (LAS bf16*)(F.lds + RK_NT); LAS bf16* KRT = (LAS bf16*)(F.lds + RK_KRT);
    LAS bf16* ZB = (LAS bf16*)(F.lds + RK_ZB); LAS bf16* XB = (LAS bf16*)(F.lds + RK_XB); LAS bf16* EB = (LAS bf16*)(F.lds + RK_EB);
    LAS float* GC = (LAS float*)(F.lds + RK_GC); LAS float* LNP = (LAS float*)(F.lds + RK_LN);
    const bf16* VFg = (const bf16*)(F.ws + WS_VF); const bf16* Gg = (const bf16*)((const unsigned char*)F.out + OUT_G); const float* BONg = (const float*)(F.ws + WS_BON);
    bf16* P = (bf16*)(F.ws + WS_P);
    constexpr int NCH = SEQ / RC;
    const int half = tid >> 8, idx = tid & 255, lt = idx >> 3, lc = idx & 7;
    const bf16* s0 = (const bf16*)(F.ws + (half ? WS_KK : WS_R)); const bf16* s1 = half ? (const bf16*)((const unsigned char*)F.out + OUT_BP) : (const bf16*)(F.ws + WS_D); const bf16* s2 = (const bf16*)(F.ws + (half ? WS_VF : WS_K2));
    v4u pre[3];
#define RK_LOAD(cc) do { const size_t o_ = (size_t)(tokb + (cc) * RC + lt) * AW + h * 64 + lc * 8; pre[0] = *(const GAS v4u*)(s0 + o_); pre[1] = *(const GAS v4u*)(s1 + o_); pre[2] = *(const GAS v4u*)(s2 + o_); } while (0)
#define RK_H1() do { _Pragma("unroll") for (int j = 0; j < 3; ++j) *(LAS v4u*)(RAW + (3 * half + j) * RAWSZ + lt * RPW + lc * 8) = pre[j]; } while (0)
#define RK_PROD8(s_) ({ float w_[8]; _Pragma("unroll") for (int j = 0; j < 8; ++j) w_[j] = 1.0f - __builtin_bit_cast(float, (unsigned)RAW[RAWSZ + (8 * (s_) + j) * RPW + lane] << 16); \
        ((w_[0] * w_[1]) * (w_[2] * w_[3])) * ((w_[4] * w_[5]) * (w_[6] * w_[7])); })
#define RK_H2(cn) do { if (wave >= 4) { const int seg = wave - 4; float w_[8]; _Pragma("unroll") for (int j = 0; j < 8; ++j) w_[j] = 1.0f - __builtin_bit_cast(float, (unsigned)RAW[RAWSZ + (8 * seg + j) * RPW + lane] << 16); \
        float g = 1.f; if (seg >= 1) { const float p0 = RK_PROD8(0); g = p0; if (seg >= 2) { const float p1 = RK_PROD8(1); g *= p1; if (seg >= 3) { const float p2 = RK_PROD8(2); g *= p2; } } } \
        _Pragma("unroll") for (int j = 0; j < 8; ++j) { g *= w_[j]; GAM[(8 * seg + j + 1) * GP + lane] = g; } \
        if (seg == 3) GC[((cn) & 1) * 64 + lane] = g; } } while (0)
#define RK_H3(cn) do { LAS bf16* BETn = (LAS bf16*)(F.lds + (((cn) & 1) ? RK_BET2 : RK_BET)); \
        { \
            { const int it = tid; const int t = it & 31, k4 = (it >> 5) * 4;        \
                const f32x4 g1 = *(const LAS f32x4*)(GAM + (t + 1) * GP + k4), g0 = *(const LAS f32x4*)(GAM + t * GP + k4); \
                const unsigned long long rw = *(const LAS unsigned long long*)(RAW + 0 * RAWSZ + t * RPW + k4), kw = *(const LAS unsigned long long*)(RAW + 2 * RAWSZ + t * RPW + k4); \
                const unsigned long long qw = *(const LAS unsigned long long*)(RAW + 3 * RAWSZ + t * RPW + k4), bw = *(const LAS unsigned long long*)(RAW + 4 * RAWSZ + t * RPW + k4); \
                const f32x4 rv = (f32x4){bflo((unsigned)rw), bfhi((unsigned)rw), bflo((unsigned)(rw >> 32)), bfhi((unsigned)(rw >> 32))}, kv = (f32x4){bflo((unsigned)kw), bfhi((unsigned)kw), bflo((unsigned)(kw >> 32)), bfhi((unsigned)(kw >> 32))}; \
                const f32x4 qv = (f32x4){bflo((unsigned)qw), bfhi((unsigned)qw), bflo((unsigned)(qw >> 32)), bfhi((unsigned)(qw >> 32))}, bv = (f32x4){bflo((unsigned)bw), bfhi((unsigned)bw), bflo((unsigned)(bw >> 32)), bfhi((unsigned)(bw >> 32))}; \
                const f32x4 rg = (f32x4){__builtin_amdgcn_rcpf(g1[0]), __builtin_amdgcn_rcpf(g1[1]), __builtin_amdgcn_rcpf(g1[2]), __builtin_amdgcn_rcpf(g1[3])}; \
                const f32x4 al = -(qv * g0), rh = rv * g1, be = bv * rg, ka = kv * rg; \
                const unsigned be0 = pk2(be[0], be[1]), be1 = pk2(be[2], be[3]), ka0 = pk2(ka[0], ka[1]), ka1 = pk2(ka[2], ka[3]); \
                *(LAS unsigned long long*)(AL + t * P64 + k4) = (unsigned long long)pk2(al[0], al[1]) | ((unsigned long long)pk2(al[2], al[3]) << 32); \
                *(LAS unsigned long long*)(RH + t * P64 + k4) = (unsigned long long)pk2(rh[0], rh[1]) | ((unsigned long long)pk2(rh[2], rh[3]) << 32); \
                *(LAS unsigned long long*)(BE + t * P64 + k4) = (unsigned long long)be0 | ((unsigned long long)be1 << 32); \
                *(LAS unsigned long long*)(KA + t * P64 + k4) = (unsigned long long)ka0 | ((unsigned long long)ka1 << 32); \
                BETn[(k4 + 0) * P32 + t] = (bf16)(be0 & 0xffffu); BETn[(k4 + 1) * P32 + t] = (bf16)(be0 >> 16); BETn[(k4 + 2) * P32 + t] = (bf16)(be1 & 0xffffu); BETn[(k4 + 3) * P32 + t] = (bf16)(be1 >> 16); \
                KAT[(k4 + 0) * P32 + t] = (bf16)(ka0 & 0xffffu); KAT[(k4 + 1) * P32 + t] = (bf16)(ka0 >> 16); KAT[(k4 + 2) * P32 + t] = (bf16)(ka1 & 0xffffu); KAT[(k4 + 3) * P32 + t] = (bf16)(ka1 >> 16); } \
            if (tid >= 256) { const int ix = tid - 256, i = ix & 31, v8 = (ix >> 5) * 8; const v4u w = *(const LAS v4u*)(RAW + 5 * RAWSZ + i * RPW + v8); \
                VT[(v8 + 0) * P32 + i] = (bf16)(w.x & 0xffffu); VT[(v8 + 1) * P32 + i] = (bf16)(w.x >> 16); VT[(v8 + 2) * P32 + i] = (bf16)(w.y & 0xffffu); VT[(v8 + 3) * P32 + i] = (bf16)(w.y >> 16); \
                VT[(v8 + 4) * P32 + i] = (bf16)(w.z & 0xffffu); VT[(v8 + 5) * P32 + i] = (bf16)(w.z >> 16); VT[(v8 + 6) * P32 + i] = (bf16)(w.w & 0xffffu); VT[(v8 + 7) * P32 + i] = (bf16)(w.w >> 16); } } } while (0)
#define RK_ST_ROWS(O, acc_) do { _Pragma("unroll") for (int r = 0; r < 16; ++r) (O)[crow32(r, hi) * P32 + r32] = (bf16)(pk2((acc_)[r], 0.f) & 0xffffu); } while (0)
#define RK_ST_COLS(O, acc_) do { _Pragma("unroll") for (int g = 0; g < 4; ++g) *(LAS unsigned long long*)((O) + r32 * P32 + 8 * g + 4 * hi) = (unsigned long long)pk2((acc_)[4 * g], (acc_)[4 * g + 1]) | ((unsigned long long)pk2((acc_)[4 * g + 2], (acc_)[4 * g + 3]) << 32); } while (0)
#define RK_CH_RND() do { f32x16_t pn, ptn; _Pragma("unroll") for (int i = 0; i < 16; ++i) { pn[i] = 0.f; ptn[i] = 0.f; } \
        mm_acc(pn, cpt, cp); mm_acc(ptn, cp, cpt); cp = pn; cpt = ptn; \
        f32x16_t mn = cm, mtn = cmt; mm_acc(mn, cmt, cp); mm_acc(mtn, cp, cmt); cm = mn; cmt = mtn; } while (0)
#define RK_CH_A() do { bf16x8_t fa[4], fb[4]; mm_ld<4>(fa, fb, BE, P64, AL, P64, r32, hi); \
        _Pragma("unroll") for (int i = 0; i < 16; ++i) { cp[i] = 0.f; cpt[i] = 0.f; } \
        mm_do<4>(cp, fa, fb); mm_do<4>(cpt, fb, fa);                                     \
        _Pragma("unroll") for (int r = 0; r < 16; ++r) { const int m_ = crow32(r, hi); cp[r] = (m_ < r32) ? cp[r] : 0.f; cpt[r] = (r32 < m_) ? cpt[r] : 0.f; const float id_ = (m_ == r32) ? 1.0f : 0.f; cm[r] = cp[r] + id_; cmt[r] = cpt[r] + id_; } \
        RK_CH_RND(); RK_CH_RND(); } while (0)
#define RK_CH_B() do { RK_CH_RND(); RK_CH_RND(); } while (0)
#define RK_H4(cn) do { if (wave == 0) RK_CH_A(); \
        else if (wave < 3) { LAS bf16* BRTn = (LAS bf16*)(F.lds + (((cn) & 1) ? RK_BRT2 : RK_BRT)); f32x16_t acc; \
        _Pragma("unroll") for (int i = 0; i < 16; ++i) acc[i] = 0.f; \
        if (wave == 1) { f32x16_t ac2; _Pragma("unroll") for (int i = 0; i < 16; ++i) ac2[i] = 0.f; \
            mm_abt<4>(acc, AL, P64, KA, P64, r32, hi); mm_abt<4>(ac2, RH, P64, KA, P64, r32, hi); \
            _Pragma("unroll") for (int r = 0; r < 16; ++r) { acc[r] = (r32 < crow32(r, hi)) ? acc[r] : 0.f; ac2[r] = (r32 <= crow32(r, hi)) ? ac2[r] : 0.f; } \
            RK_ST_ROWS(NT, acc); RK_ST_ROWS(KRT, ac2); } \
        else { mm_abt<4>(acc, RH, P64, BE, P64, r32, hi); \
            _Pragma("unroll") for (int r = 0; r < 16; ++r) acc[r] = (r32 <= crow32(r, hi)) ? acc[r] : 0.f; \
            RK_ST_ROWS(BRTn, acc); } } } while (0)
    RK_LOAD(0);
    for (int u = tid; u < 64 * P64 / 2; u += NTHR) ((LAS unsigned*)ZB)[u] = 0u;
    if (tid < 64) GAM[tid] = 1.f;
    if (tid >= 64 && tid < 192) { const int e_ = tid - 64; LNP[e_] = (e_ < 64 ? F.in[I_LNW] : F.in[I_LNB])[l * AW + h * 64 + (e_ & 63)]; }
    f32x16_t rg0, rg1, rg2, rg3;
#define cp rg0
#define cpt rg1
#define cm rg2
#define cmt rg3
#define zacc rg0
#define yacc0 rg0
#define yacc1 rg1
#pragma unroll
    for (int i = 0; i < 16; ++i) { rg0[i] = 0.f; rg1[i] = 0.f; rg2[i] = 0.f; rg3[i] = 0.f; }
#define RK_RELANE() int ln_ = F.lane, td_ = F.tid; asm volatile("" : "+v"(ln_), "+v"(td_)); const int lane = ln_, tid = td_, r32 = ln_ & 31, hi = ln_ >> 5; (void)lane; (void)tid; (void)r32; (void)hi;
    RK_H1(); RK_LOAD(1);
    lds_barrier();
    { RK_RELANE() RK_H2(0); }
    lds_barrier();
    { RK_RELANE() RK_H3(0); }
    lds_barrier();
    { RK_RELANE() RK_H4(0); } RK_H1(); RK_LOAD(2);
    lds_barrier();
    unsigned dga_ = 0;
    for (int c = 0; c < NCH; ++c) {
        const int tok0 = tokb + c * RC;
        int ln_ = F.lane, td_ = F.tid; asm volatile("" : "+v"(ln_), "+v"(td_));
        const int lane = ln_, tid = td_, r32 = ln_ & 31, hi = ln_ >> 5;
        const LAS bf16* Zc = ZB + (c & 1) * 64 * P64; LAS bf16* Zn = ZB + ((c + 1) & 1) * 64 * P64;
        const LAS bf16* BRTc = (const LAS bf16*)(F.lds + ((c & 1) ? RK_BRT2 : RK_BRT)); const LAS bf16* BETc = (const LAS bf16*)(F.lds + ((c & 1) ? RK_BET2 : RK_BET));
        DG_START(70, dg70_) DG_START(73, dg73_) DG_START(76, dg76_)
        float pbon = 0.f;
        if (wave == 0) RK_CH_B();
        else if (wave < 3) { const int vb = wave - 1; f32x16_t acc;
#pragma unroll
            for (int i = 0; i < 16; ++i) acc[i] = 0.f;
            mm_abt2<4, 2>(acc, Zc + 32 * vb * P64, P64, AL, P64, VT + 32 * vb * P32, P32, NT, P32, r32, hi);
            RK_ST_ROWS(XB + 32 * vb * P32, acc); }
        else if (wave == 3) {
            { const size_t po_ = (size_t)(tok0 + r32) * AW + h * 64 + 4 * hi;
#pragma unroll
                for (int g = 0; g < 8; ++g) { const unsigned long long a_ = *(const GAS unsigned long long*)(VFg + po_ + 8 * g), b_ = *(const GAS unsigned long long*)(Gg + po_ + 8 * g);
                    rg2[2 * g] = __builtin_bit_cast(float, (unsigned)a_); rg2[2 * g + 1] = __builtin_bit_cast(float, (unsigned)(a_ >> 32)); rg3[2 * g] = __builtin_bit_cast(float, (unsigned)b_); rg3[2 * g + 1] = __builtin_bit_cast(float, (unsigned)(b_ >> 32)); }
                pbon = BONg[(size_t)(tok0 + r32) * 6 + h]; }
#pragma unroll
            for (int i = 0; i < 16; ++i) { yacc0[i] = 0.f; yacc1[i] = 0.f; }
            mm_abt2<4, 2>(yacc0, Zc, P64, RH, P64, VT, P32, KRT, P32, r32, hi);
            mm_abt2<4, 2>(yacc1, Zc + 32 * P64, P64, RH, P64, VT + 32 * P32, P32, KRT, P32, r32, hi); }
        else { mm_abt<2>(zacc, VT + 32 * ((wave - 4) >> 1) * P32, P32, KAT + 32 * ((wave - 4) & 1) * P32, P32, r32, hi);
            if (c + 1 < NCH) RK_H2(c + 1); }
        if (DIAG_SLOT_D == 73) { asm volatile("s_waitcnt lgkmcnt(0)" ::: "memory"); DG_STOP(73, dg73_, dga_) }
        lds_barrier();
        DG_STOP(70, dg70_, dga_) DG_START(71, dg71_) DG_START(74, dg74_)
        if (wave == 0) {
            const bf16x8_t mb0 = acc_frag(cm, 0), mb1 = acc_frag(cm, 1);
#pragma unroll
            for (int vb = 0; vb < 2; ++vb) { f32x16_t acc;
#pragma unroll
                for (int i = 0; i < 16; ++i) acc[i] = 0.f;
                const LAS bf16* xr = XB + (32 * vb + r32) * P32 + 4 * hi;
                v4u x0, x1; { const unsigned long long u0 = *(const LAS unsigned long long*)(xr), u1 = *(const LAS unsigned long long*)(xr + 8), u2 = *(const LAS unsigned long long*)(xr + 16), u3 = *(const LAS unsigned long long*)(xr + 24);
                    x0.x = (unsigned)u0; x0.y = (unsigned)(u0 >> 32); x0.z = (unsigned)u1; x0.w = (unsigned)(u1 >> 32); x1.x = (unsigned)u2; x1.y = (unsigned)(u2 >> 32); x1.z = (unsigned)u3; x1.w = (unsigned)(u3 >> 32); }
                acc = __builtin_amdgcn_mfma_f32_32x32x16_bf16(__builtin_bit_cast(bf16x8_t, x0), mb0, acc, 0, 0, 0);
                acc = __builtin_amdgcn_mfma_f32_32x32x16_bf16(__builtin_bit_cast(bf16x8_t, x1), mb1, acc, 0, 0, 0);
                RK_ST_ROWS(EB + 32 * vb * P32, acc); } }
        if (c + 1 < NCH) RK_H3(c + 1);
        if (DIAG_SLOT_D == 74) { asm volatile("s_waitcnt lgkmcnt(0)" ::: "memory"); DG_STOP(74, dg74_, dga_) }
        lds_barrier();
        DG_STOP(71, dg71_, dga_) DG_START(72, dg72_) DG_START(75, dg75_)
        if (c + 2 < NCH) { RK_H1(); if (c + 3 < NCH) RK_LOAD(c + 3); }
        if (wave == 3) {
            mm_abt<2>(yacc0, EB, P32, BRTc, P32, r32, hi); mm_abt<2>(yacc1, EB + 32 * P32, P32, BRTc, P32, r32, hi);
            float sm = 0.f;
#pragma unroll
            for (int i = 0; i < 16; ++i) sm += yacc0[i] + yacc1[i];
            sm += __shfl_xor(sm, 32); const float mean = sm * (1.0f / 64.0f);
            float vs = 0.f;
#pragma unroll
            for (int i = 0; i < 16; ++i) { yacc0[i] -= mean; yacc1[i] -= mean; vs += yacc0[i] * yacc0[i] + yacc1[i] * yacc1[i]; }
            vs += __shfl_xor(vs, 32); const float rs = 1.0f / sqrtf(vs * (1.0f / 64.0f) + 64e-5f);
            bf16* yo = P + (size_t)(tok0 + r32) * PP + h * 64 + 4 * hi;
#pragma unroll
            for (int g = 0; g < 8; ++g) { const int v0 = 8 * g + 4 * hi;
                const f32x4 lw = *(const LAS f32x4*)(LNP + v0), lb = *(const LAS f32x4*)(LNP + 64 + v0);
                const float f0_ = rg2[2 * g], f1_ = rg2[2 * g + 1], f2_ = rg3[2 * g], f3_ = rg3[2 * g + 1];
                const unsigned v0w = __float_as_uint(f0_), v1w = __float_as_uint(f1_), g0w = __float_as_uint(f2_), g1w = __float_as_uint(f3_);
                const f32x4 vv = (f32x4){bflo(v0w), bfhi(v0w), bflo(v1w), bfhi(v1w)}, gg = (f32x4){bflo(g0w), bfhi(g0w), bflo(g1w), bfhi(g1w)};
                const f32x4 yv = (g < 4) ? (f32x4){yacc0[4 * (g & 3)], yacc0[4 * (g & 3) + 1], yacc0[4 * (g & 3) + 2], yacc0[4 * (g & 3) + 3]} : (f32x4){yacc1[4 * (g & 3)], yacc1[4 * (g & 3) + 1], yacc1[4 * (g & 3) + 2], yacc1[4 * (g & 3) + 3]};
                const f32x4 o = (yv * rs * lw + lb + pbon * vv) * gg;
                *(GAS unsigned long long*)(yo + 8 * g) = (unsigned long long)pk2(o[0], o[1]) | ((unsigned long long)pk2(o[2], o[3]) << 32); } }
        else if (wave >= 4) { const int vb = (wave - 4) >> 1, kb = (wave - 4) & 1;
            mm_abt<2>(zacc, EB + 32 * vb * P32, P32, BETc + 32 * kb * P32, P32, r32, hi);
            const float gc = GC[(c & 1) * 64 + 32 * kb + r32];
#pragma unroll
            for (int r = 0; r < 16; ++r) { zacc[r] *= gc; Zn[(32 * vb + crow32(r, hi)) * P64 + 32 * kb + r32] = (bf16)(pk2(zacc[r], 0.f) & 0xffffu); } }
        if (c + 1 < NCH) RK_H4(c + 1);
        if (DIAG_SLOT_D == 75) { asm volatile("s_waitcnt lgkmcnt(0)" ::: "memory"); DG_STOP(75, dg75_, dga_) }
        lds_barrier();
        DG_STOP(72, dg72_, dga_) DG_STOP(76, dg76_, dga_)
    }
    DG_WRITE(70, unit == 0 && l == 0 && F.tid == 0, dga_) DG_WRITE(71, unit == 0 && l == 0 && F.tid == 0, dga_) DG_WRITE(72, unit == 0 && l == 0 && F.tid == 0, dga_) DG_WRITE(76, unit == 0 && l == 0 && F.tid == 0, dga_)
    DG_WRITE(73, unit == 0 && l == 0 && F.tid == 448, dga_) DG_WRITE(74, unit == 0 && l == 0 && F.tid == 64, dga_) DG_WRITE(75, unit == 0 && l == 0 && F.tid == 0, dga_)
#undef RK_LOAD
#undef cp
#undef cpt
#undef cm
#undef cmt
#undef zacc
#undef yacc0
#undef yacc1
#undef RK_H1
#undef RK_PROD8
#undef RK_H2
#undef RK_H3
#undef RK_H4
#undef RK_RELANE
#undef RK_CH_A
#undef RK_CH_RND
#undef RK_CH_B
#undef RK_ST_ROWS
#undef RK_ST_COLS
}

constexpr int RP = 72;
constexpr int RT_QR = 0, RT_KR = 128 * RP * 2, RT_VV = 2 * 128 * RP * 2, RT_ST = 3 * 128 * RP * 2, RT_SS = RT_ST + 64 * RP * 2, RT_KD = RT_SS + 1024;
__device__ __forceinline__ void ret_out_unit(const Frame& F, int unit) {
    const int tid = F.tid, lane = F.lane, wave = F.wave, r32 = lane & 31, hi = lane >> 5;
    const int h = unit & 3, b = unit >> 2;
    bf16* P = (bf16*)(F.ws + WS_P); const float* tab = (const float*)(F.ws + WS_TAB);
    LAS bf16* QR = (LAS bf16*)(F.lds + RT_QR); LAS bf16* KR = (LAS bf16*)(F.lds + RT_KR); LAS bf16* VV = (LAS bf16*)(F.lds + RT_VV); LAS bf16* ST = (LAS bf16*)(F.lds + RT_ST);
    LAS float* SS = (LAS float*)(F.lds + RT_SS); LAS bf16* KD = (LAS bf16*)(F.lds + RT_KD);
    const float lg2 = log2f(1.0f - exp2f(-5.0f - (float)h));
    f32x16_t st;
#pragma unroll
    for (int i = 0; i < 16; ++i) st[i] = 0.f;
    const float cdec = exp2f(128.0f * lg2);
    unsigned long long pre[2][6]; f32x4 pret[2][2];
#define RT_LOAD(cn) do { _Pragma("unroll") for (int it_ = 0; it_ < 2; ++it_) { const int idx_ = tid + it_ * NTHR, m_ = idx_ >> 3, i4_ = (idx_ & 7) * 4; const size_t ro_ = (size_t)(b * SEQ + (cn) * 128 + m_) * PP + h * 64 + i4_; \
        pre[it_][0] = *(const GAS unsigned long long*)(P + ro_ + PCQ); pre[it_][1] = *(const GAS unsigned long long*)(P + ro_ + PCQ + 32); pre[it_][2] = *(const GAS unsigned long long*)(P + ro_ + PCK); \
        pre[it_][3] = *(const GAS unsigned long long*)(P + ro_ + PCK + 32); pre[it_][4] = *(const GAS unsigned long long*)(P + ro_ + PCV); pre[it_][5] = *(const GAS unsigned long long*)(P + ro_ + PCV + 32); \
        pret[it_][0] = *(const GAS f32x4*)(tab + ((size_t)((cn) * 128 + m_) * 32 + i4_) * 2); pret[it_][1] = *(const GAS f32x4*)(tab + ((size_t)((cn) * 128 + m_) * 32 + i4_) * 2 + 4); } } while (0)
    unsigned dga_ = 0;
    DG_START(60, dg60_)
    RT_LOAD(0);
    for (int c = 0; c < 16; ++c) {
    const int tok0 = b * SEQ + c * 128;
#pragma unroll
    for (int it = 0; it < 2; ++it) { const int idx = tid + it * NTHR, m = idx >> 3, i4 = (idx & 7) * 4;
        const unsigned long long q1w = pre[it][0], q2w = pre[it][1], k1w = pre[it][2], k2w = pre[it][3], v1w = pre[it][4], v2w = pre[it][5];
        const f32x4 t0 = pret[it][0], t1 = pret[it][1];
        const float cs[4] = {t0[0], t0[2], t1[0], t1[2]}, sn[4] = {t0[1], t0[3], t1[1], t1[3]};
        const float q1[4] = {bflo((unsigned)q1w), bfhi((unsigned)q1w), bflo((unsigned)(q1w >> 32)), bfhi((unsigned)(q1w >> 32))}, q2[4] = {bflo((unsigned)q2w), bfhi((unsigned)q2w), bflo((unsigned)(q2w >> 32)), bfhi((unsigned)(q2w >> 32))};
        const float k1[4] = {bflo((unsigned)k1w), bfhi((unsigned)k1w), bflo((unsigned)(k1w >> 32)), bfhi((unsigned)(k1w >> 32))}, k2[4] = {bflo((unsigned)k2w), bfhi((unsigned)k2w), bflo((unsigned)(k2w >> 32)), bfhi((unsigned)(k2w >> 32))};
        float qa[4], qb[4], ka[4], kb[4];
#pragma unroll
        for (int j = 0; j < 4; ++j) { qa[j] = q1[j] * cs[j] - q2[j] * sn[j]; qb[j] = q1[j] * sn[j] + q2[j] * cs[j]; ka[j] = (k1[j] * cs[j] - k2[j] * sn[j]) * 0.125f; kb[j] = (k1[j] * sn[j] + k2[j] * cs[j]) * 0.125f; }
        *(LAS unsigned long long*)(QR + m * RP + i4) = (unsigned long long)pk2(qa[0], qa[1]) | ((unsigned long long)pk2(qa[2], qa[3]) << 32);
        *(LAS unsigned long long*)(QR + m * RP + 32 + i4) = (unsigned long long)pk2(qb[0], qb[1]) | ((unsigned long long)pk2(qb[2], qb[3]) << 32);
        *(LAS unsigned long long*)(KR + m * RP + i4) = (unsigned long long)pk2(ka[0], ka[1]) | ((unsigned long long)pk2(ka[2], ka[3]) << 32);
        *(LAS unsigned long long*)(KR + m * RP + 32 + i4) = (unsigned long long)pk2(kb[0], kb[1]) | ((unsigned long long)pk2(kb[2], kb[3]) << 32);
        { const float kd = exp2f((float)(127 - m) * lg2);
          *(LAS unsigned long long*)(KD + m * RP + i4) = (unsigned long long)pk2(ka[0] * kd, ka[1] * kd) | ((unsigned long long)pk2(ka[2] * kd, ka[3] * kd) << 32);
          *(LAS unsigned long long*)(KD + m * RP + 32 + i4) = (unsigned long long)pk2(kb[0] * kd, kb[1] * kd) | ((unsigned long long)pk2(kb[2] * kd, kb[3] * kd) << 32); }
        *(LAS unsigned long long*)(VV + m * RP + i4) = v1w; *(LAS unsigned long long*)(VV + m * RP + 32 + i4) = v2w; }
    if (c + 1 < 16) RT_LOAD(c + 1);
    if (wave < 4) {
        const int db = wave >> 1, ebs = wave & 1;
#pragma unroll
        for (int i = 0; i < 16; ++i) ST[(32 * db + crow32(i, hi)) * RP + 32 * ebs + r32] = (bf16)(pk2(st[i], 0.f) & 0xffffu);
    }
    lds_barrier();
    const int nb = wave >> 1, eb = wave & 1, n = nb * 32 + r32;
    const unsigned blk_ = (lane >> 4) & 1, q_ = (lane & 15) >> 2, p_ = lane & 3;
    bf16x8_t qf[4];
#pragma unroll
    for (int ks = 0; ks < 4; ++ks) qf[ks] = *(const LAS bf16x8_t*)(QR + n * RP + ks * 16 + hi * 8);
    f32x16_t y;
#pragma unroll
    for (int i = 0; i < 16; ++i) y[i] = 0.f;
#pragma unroll
    for (int ks = 0; ks < 4; ++ks) {
        const s16x4_t lo = __builtin_bit_cast(s16x4_t, __builtin_amdgcn_ds_read_tr16_b64_v4i16((LAS s16x4_t*)(ST + (16 * ks + 8 * hi + q_) * RP + 32 * eb + 16 * blk_ + 4 * p_)));
        const s16x4_t hh = __builtin_bit_cast(s16x4_t, __builtin_amdgcn_ds_read_tr16_b64_v4i16((LAS s16x4_t*)(ST + (16 * ks + 8 * hi + 4 + q_) * RP + 32 * eb + 16 * blk_ + 4 * p_)));
        const bf16x8_t a = (bf16x8_t){lo[0], lo[1], lo[2], lo[3], hh[0], hh[1], hh[2], hh[3]};
        y = __builtin_amdgcn_mfma_f32_32x32x16_bf16(a, qf[ks], y, 0, 0, 0); }
    { const float qd = exp2f((float)(n + 1) * lg2);
#pragma unroll
      for (int i = 0; i < 16; ++i) y[i] *= qd; }
    unsigned long long gpre[4];
#pragma unroll
    for (int g = 0; g < 4; ++g) gpre[g] = *(const GAS unsigned long long*)(P + (size_t)(tok0 + n) * PP + PCG + h * 64 + 32 * eb + 8 * g + 4 * hi);
    for (int mt = 0; mt <= nb; ++mt) {
        f32x16_t S;
#pragma unroll
        for (int i = 0; i < 16; ++i) S[i] = 0.f;
#pragma unroll
        for (int ks = 0; ks < 4; ++ks) { const bf16x8_t a = *(const LAS bf16x8_t*)(KR + (mt * 32 + r32) * RP + ks * 16 + hi * 8); S = __builtin_amdgcn_mfma_f32_32x32x16_bf16(a, qf[ks], S, 0, 0, 0); }
        float e[16];
#pragma unroll
        for (int r = 0; r < 16; ++r) { const int dm = r32 - crow32(r, hi) + 32 * (nb - mt); e[r] = (dm >= 0) ? S[r] * exp2f((float)dm * lg2) : 0.f; }
#pragma unroll
        for (int s = 0; s < 2; ++s) { v4u w; w.x = pk2(e[8 * s], e[8 * s + 1]); w.y = pk2(e[8 * s + 2], e[8 * s + 3]); w.z = pk2(e[8 * s + 4], e[8 * s + 5]); w.w = pk2(e[8 * s + 6], e[8 * s + 7]);
            const bf16x8_t xs = __builtin_bit_cast(bf16x8_t, w);
            const s16x4_t lo = __builtin_bit_cast(s16x4_t, __builtin_amdgcn_ds_read_tr16_b64_v4i16((LAS s16x4_t*)(VV + (mt * 32 + 16 * s + 4 * hi + q_) * RP + 32 * eb + 16 * blk_ + 4 * p_)));
            const s16x4_t hh = __builtin_bit_cast(s16x4_t, __builtin_amdgcn_ds_read_tr16_b64_v4i16((LAS s16x4_t*)(VV + (mt * 32 + 16 * s + 8 + 4 * hi + q_) * RP + 32 * eb + 16 * blk_ + 4 * p_)));
            const bf16x8_t a = (bf16x8_t){lo[0], lo[1], lo[2], lo[3], hh[0], hh[1], hh[2], hh[3]};
            y = __builtin_amdgcn_mfma_f32_32x32x16_bf16(a, xs, y, 0, 0, 0); }
    }
    float ss = 0.f;
#pragma unroll
    for (int i = 0; i < 16; ++i) ss += y[i] * y[i];
    ss += __shfl_xor(ss, 32);
    if (hi == 0) SS[(nb * 2 + eb) * 32 + r32] = ss;
    lds_barrier();
    ss += SS[(nb * 2 + (eb ^ 1)) * 32 + r32];
    const float rs = 1.0f / sqrtf(ss * (1.0f / 64.0f) + 1e-6f);
    const size_t ro = (size_t)(tok0 + n) * PP;
#pragma unroll
    for (int g = 0; g < 4; ++g) { const int e0 = 32 * eb + 8 * g + 4 * hi;
        const unsigned long long gw = gpre[g];
        const float g0 = bflo((unsigned)gw), g1 = bfhi((unsigned)gw), g2 = bflo((unsigned)(gw >> 32)), g3 = bfhi((unsigned)(gw >> 32));
        const float o0 = g0 * sigmoid_f(g0) * y[4 * g] * rs, o1 = g1 * sigmoid_f(g1) * y[4 * g + 1] * rs, o2 = g2 * sigmoid_f(g2) * y[4 * g + 2] * rs, o3 = g3 * sigmoid_f(g3) * y[4 * g + 3] * rs;
        *(GAS unsigned long long*)(P + ro + 768 + h * 64 + e0) = (unsigned long long)pk2(o0, o1) | ((unsigned long long)pk2(o2, o3) << 32); }
    if (wave < 4) {
        const int db = wave >> 1, ebs = wave & 1;
#pragma unroll
        for (int i = 0; i < 16; ++i) st[i] *= cdec;
#pragma unroll
        for (int ks = 0; ks < 8; ++ks) {
            const s16x4_t alo = __builtin_bit_cast(s16x4_t, __builtin_amdgcn_ds_read_tr16_b64_v4i16((LAS s16x4_t*)(KD + (16 * ks + 8 * hi + q_) * RP + 32 * db + 16 * blk_ + 4 * p_)));
            const s16x4_t ahi = __builtin_bit_cast(s16x4_t, __builtin_amdgcn_ds_read_tr16_b64_v4i16((LAS s16x4_t*)(KD + (16 * ks + 8 * hi + 4 + q_) * RP + 32 * db + 16 * blk_ + 4 * p_)));
            const s16x4_t blo = __builtin_bit_cast(s16x4_t, __builtin_amdgcn_ds_read_tr16_b64_v4i16((LAS s16x4_t*)(VV + (16 * ks + 8 * hi + q_) * RP + 32 * ebs + 16 * blk_ + 4 * p_)));
            const s16x4_t bhi = __builtin_bit_cast(s16x4_t, __builtin_amdgcn_ds_read_tr16_b64_v4i16((LAS s16x4_t*)(VV + (16 * ks + 8 * hi + 4 + q_) * RP + 32 * ebs + 16 * blk_ + 4 * p_)));
            const bf16x8_t a = (bf16x8_t){alo[0], alo[1], alo[2], alo[3], ahi[0], ahi[1], ahi[2], ahi[3]}, bb = (bf16x8_t){blo[0], blo[1], blo[2], blo[3], bhi[0], bhi[1], bhi[2], bhi[3]};
            st = __builtin_amdgcn_mfma_f32_32x32x16_bf16(a, bb, st, 0, 0, 0); }
    }
    lds_barrier();
    }
    DG_STOP(60, dg60_, dga_)
    DG_WRITE(60, unit == 0 && wave == 0 && lane == 0, dga_)
#undef RT_LOAD
}

constexpr int PT = 32, XSP = 1304;
constexpr int PR_XS = 0, PR_STG = PT * XSP * 2, PR_CONST = PR_STG + 32768, PR_MU = PR_CONST + 6 * 384 * 4;
__device__ __forceinline__ void prep_consts(const Frame& F, int l) {
    LAS float* CS = (LAS float*)(F.lds + PR_CONST);
    for (int i = F.tid; i < AW; i += NTHR) { CS[i] = F.in[I_KK][l * AW + i]; CS[AW + i] = F.in[I_KA][l * AW + i]; CS[2 * AW + i] = F.in[I_RK][l * AW + i];
        CS[3 * AW + i] = F.in[I_W0][l * AW + i]; CS[4 * AW + i] = F.in[I_A0][l * AW + i]; CS[5 * AW + i] = (l > 0) ? F.in[I_V0][(l - 1) * AW + i] : 0.f; }
    LAS float* MU = (LAS float*)(F.lds + PR_MU);
    for (int i = F.tid; i < 1296; i += NTHR) MU[i] = (i < 1280) ? F.in[I_MU][l * 1280 + i] : ((l > 0) ? F.in[I_VRMU][(l - 1) * 16 + i - 1280] : 0.f);
    __syncthreads();
}
__device__ __forceinline__ float softplus_f(float z) { return fmaxf(z, 0.f) + __logf(1.0f + __expf(-fabsf(z))); }
__device__ __forceinline__ float tanh_f(float x) { const float e = __expf(2.0f * x); return 1.0f - 2.0f * __builtin_amdgcn_rcpf(e + 1.0f); }
__device__ __forceinline__ void small_weights(const Frame& F) {
    for (int l = 0; l < DEPTH; ++l) {
        const float* w2 = F.in[I_W2] + (size_t)l * 32 * AW; const float* a2 = F.in[I_A2] + (size_t)l * 32 * AW; const float* g2 = F.in[I_G2] + (size_t)l * 64 * AW;
        const float* v2 = F.in[I_V2] + (size_t)(l > 0 ? l - 1 : 0) * 16 * AW;
        bf16* LT = (bf16*)(F.ws + WS_LORA) + (size_t)l * AW * 144;
        for (int i = F.vcu * NTHR + F.tid; i < AW * 144; i += F.G * NTHR) { const int n = i / 144, k = i - n * 144; float v;
            if (k < 32) v = w2[k * AW + n]; else if (k < 64) v = a2[(k - 32) * AW + n]; else if (k < 128) v = g2[(k - 64) * AW + n]; else v = (l > 0) ? v2[(k - 128) * AW + n] : 0.f;
            LT[i] = (bf16)f2bf(v); }
        const float* wuk = F.in[I_WUK] + (size_t)l * 6 * 64 * 128; const float* wuv = F.in[I_WUV] + (size_t)l * 6 * 128 * 64;
        bf16* wukT = (bf16*)(F.ws + WS_WUKT) + (size_t)l * 6 * 64 * 128; bf16* wuvT = (bf16*)(F.ws + WS_WUVT) + (size_t)l * 6 * 64 * 128;
        for (int i = F.vcu * NTHR + F.tid; i < 6 * 64 * 128; i += F.G * NTHR) {
            { const int hh = i / 8192, rem = i - hh * 8192, c = rem >> 6, d = rem & 63; wukT[i] = (bf16)f2bf(wuk[(hh * 64 + d) * 128 + c]); }
            { const int hh = i / 8192, rem = i - hh * 8192, d = rem >> 7, c = rem & 127; wuvT[i] = (bf16)f2bf(wuv[(hh * 128 + c) * 64 + d]); } }
    }
}
__device__ __forceinline__ void prep_tokens_unit(const Frame& F, int l, int unit) {
    LAS bf16* XS = (LAS bf16*)(F.lds + PR_XS);
    const int tid = F.tid, lane = F.lane, wave = F.wave, r32 = lane & 31, hi = lane >> 5, tok0 = unit * PT;
    const bf16* P = (const bf16*)(F.ws + WS_P);
    unsigned dga_ = 0;
    DG_START(20, dg20_)
    for (int base = 0; base < PT * 162; base += 5 * NTHR) {
        v4u cw[5], pw[5];
#pragma unroll
        for (int u = 0; u < 5; ++u) { const int idx = base + u * NTHR + tid; const int idc = idx < PT * 162 ? idx : PT * 162 - 1; const int t = idc / 162, ch = idc - t * 162, tok = tok0 + t;
            cw[u] = *(const GAS v4u*)(P + (size_t)tok * PP + ch * 8);
            const int tokp = (tok & (SEQ - 1)) != 0 ? tok - 1 : tok; pw[u] = *(const GAS v4u*)(P + (size_t)tokp * PP + ch * 8); }
#pragma unroll
        for (int u = 0; u < 5; ++u) { const int idx = base + u * NTHR + tid;
            if (idx < PT * 162) { const int t = idx / 162, ch = idx - t * 162, tok = tok0 + t, c0 = ch * 8;
                float cur[8], prv[8]; unpack8(cw[u], cur); unpack8(pw[u], prv);
                const bool first = (tok & (SEQ - 1)) == 0;
                float mv[8];
                { const LAS f32x4* mp = (const LAS f32x4*)((const LAS float*)(F.lds + PR_MU) + c0); const f32x4 m0 = mp[0], m1 = mp[1]; mv[0] = m0[0]; mv[1] = m0[1]; mv[2] = m0[2]; mv[3] = m0[3]; mv[4] = m1[0]; mv[5] = m1[1]; mv[6] = m1[2]; mv[7] = m1[3]; }
                float o[8];
#pragma unroll
                for (int j = 0; j < 8; ++j) { const float pv = first ? 0.f : prv[j]; float v = cur[j] + (pv - cur[j]) * mv[j];
                    if (c0 >= 1152 && c0 < 1184) v = tanh_f(v); else if (c0 >= 1216 && c0 < 1280) v = sigmoid_f(v);
                    o[j] = v; }
                v4u w; w.x = pk2(o[0], o[1]); w.y = pk2(o[2], o[3]); w.z = pk2(o[4], o[5]); w.w = pk2(o[6], o[7]);
                *(LAS v4u*)(XS + t * XSP + c0) = w; } }
    }
    __syncthreads();
    DG_STOP(20, dg20_, dga_)
    DG_WRITE(20, unit == 0 && l == 0 && wave == 0 && lane == 0, dga_)
    DG_START(21, dg21_)
    if (wave < 6) {
        const int h = wave;
        LAS bf16* STG = (LAS bf16*)(F.lds + PR_STG + wave * 4096);
        GAS unsigned char* wsb = (GAS unsigned char*)F.ws;
        GAS unsigned char* outb = (GAS unsigned char*)F.out;
        const bf16* LT = (const bf16*)(F.ws + WS_LORA) + (size_t)l * AW * 144;
        const LAS float* CS = (const LAS float*)(F.lds + PR_CONST) + h * 64;
        const LAS float* kkw = CS; const LAS float* kaw = CS + AW; const LAS float* rkw = CS + 2 * AW; const LAS float* w0p = CS + 3 * AW; const LAS float* a0p = CS + 4 * AW; const LAS float* v0p = CS + 5 * AW;
        const LAS bf16* xrow = XS + r32 * XSP;
        float rn;
        { float ss = 0.f;
#pragma unroll
          for (int cbl = 0; cbl < 2; ++cbl)
#pragma unroll
              for (int g = 0; g < 4; ++g) { const int j0 = cbl * 32 + 8 * g + 4 * hi; const unsigned long long kw = *(const LAS unsigned long long*)(xrow + 384 + h * 64 + j0); const f32x4 kk4 = *(const LAS f32x4*)(kkw + j0);
                  const float k0 = bflo((unsigned)kw) * kk4[0], k1 = bfhi((unsigned)kw) * kk4[1], k2 = bflo((unsigned)(kw >> 32)) * kk4[2], k3 = bfhi((unsigned)(kw >> 32)) * kk4[3]; ss += (k0 * k0 + k1 * k1) + (k2 * k2 + k3 * k3); }
          ss += __shfl_xor(ss, 32); rn = 1.0f / fmaxf(sqrtf(ss), 1e-12f); }
        float bonus = 0.f;
        const int srow = lane >> 2, sch = lane & 3;
#pragma unroll
        for (int cbl = 0; cbl < 2; ++cbl) {
            asm volatile("" ::: "memory");
            const int cb0 = h * 64 + cbl * 32;
            f32x16_t wv, av, gv, mvv;
#pragma unroll
            for (int i = 0; i < 16; ++i) { wv[i] = 0.f; av[i] = 0.f; gv[i] = 0.f; mvv[i] = 0.f; }
            const bf16* lrow = LT + (size_t)(cb0 + r32) * 144 + 8 * hi;
#pragma unroll
            for (int ks = 0; ks < 9; ++ks) { const bf16x8_t a = *(const GAS bf16x8_t*)(lrow + 16 * ks); const bf16x8_t bx = *(const LAS bf16x8_t*)(xrow + 1152 + 16 * ks + 8 * hi);
                if (ks < 2) wv = __builtin_amdgcn_mfma_f32_32x32x16_bf16(a, bx, wv, 0, 0, 0);
                else if (ks < 4) av = __builtin_amdgcn_mfma_f32_32x32x16_bf16(a, bx, av, 0, 0, 0);
                else if (ks < 8) gv = __builtin_amdgcn_mfma_f32_32x32x16_bf16(a, bx, gv, 0, 0, 0);
                else mvv = __builtin_amdgcn_mfma_f32_32x32x16_bf16(a, bx, mvv, 0, 0, 0); }
            if (l > 0) {
#pragma unroll
                for (int i = 0; i < 2; ++i) { const int row = srow + 16 * i; const unsigned eo = (unsigned)(((tok0 + row) * AW + cb0 + sch * 8) * 2); *(LAS v4u*)(STG + row * 32 + sch * 8) = *(const GAS v4u*)(wsb + WS_VF + eo); } }
            unsigned long long ro[4], dd[4], k2o[4], kko[4], bpo[4], vo[4], go[4];
#pragma unroll
            for (int g = 0; g < 4; ++g) { const int j0 = cbl * 32 + 8 * g + 4 * hi;
                const unsigned long long rw = *(const LAS unsigned long long*)(xrow + h * 64 + j0), kw = *(const LAS unsigned long long*)(xrow + 384 + h * 64 + j0), vw = *(const LAS unsigned long long*)(xrow + 768 + h * 64 + j0);
                unsigned long long fw = 0ull; if (l > 0) fw = *(const LAS unsigned long long*)(STG + r32 * 32 + 8 * g + 4 * hi);
                asm volatile("" : "+v"(bonus) :: "memory");
                const f32x4 kk4 = *(const LAS f32x4*)(kkw + j0), ka4 = *(const LAS f32x4*)(kaw + j0), rk4 = *(const LAS f32x4*)(rkw + j0), w04 = *(const LAS f32x4*)(w0p + j0), a04 = *(const LAS f32x4*)(a0p + j0);
                const f32x4 v04 = *(const LAS f32x4*)(v0p + j0);
                const float rr[4] = {bflo((unsigned)rw), bfhi((unsigned)rw), bflo((unsigned)(rw >> 32)), bfhi((unsigned)(rw >> 32))};
                const float kx[4] = {bflo((unsigned)kw), bfhi((unsigned)kw), bflo((unsigned)(kw >> 32)), bfhi((unsigned)(kw >> 32))};
                const float vx[4] = {bflo((unsigned)vw), bfhi((unsigned)vw), bflo((unsigned)(vw >> 32)), bfhi((unsigned)(vw >> 32))};
                const float fx[4] = {bflo((unsigned)fw), bfhi((unsigned)fw), bflo((unsigned)(fw >> 32)), bfhi((unsigned)(fw >> 32))};
                float d_[4], k2_[4], kk_[4], bp_[4], v_[4];
#pragma unroll
                for (int e = 0; e < 4; ++e) { const int i = 4 * g + e;
                    const float sp = softplus_f(-(wv[i] + w04[e])); const float rate = __expf(-sp - 0.5f); const float d = 1.0f - __expf(-rate);
                    const float a = sigmoid_f(av[i] + a04[e]);
                    float v = vx[e]; if (l > 0) v = v + (fx[e] - v) * sigmoid_f(mvv[i] + v04[e]);
                    const float kk = kx[e] * kk4[e] * rn, k2 = kx[e] * (1.0f + (a - 1.0f) * ka4[e]);
                    d_[e] = d; k2_[e] = k2; kk_[e] = kk; bp_[e] = kk * a; v_[e] = v;
                    bonus += rr[e] * k2 * rk4[e]; }
#define PK4(x) ((unsigned long long)pk2(x[0], x[1]) | ((unsigned long long)pk2(x[2], x[3]) << 32))
                ro[g] = rw; dd[g] = PK4(d_); k2o[g] = PK4(k2_); kko[g] = PK4(kk_); bpo[g] = PK4(bp_); vo[g] = PK4(v_);
                go[g] = (unsigned long long)pk2(gv[4 * g], gv[4 * g + 1]) | ((unsigned long long)pk2(gv[4 * g + 2], gv[4 * g + 3]) << 32); }
#define PR_OUT(arr, bs_, dst) do { _Pragma("unroll") for (int g = 0; g < 4; ++g) *(LAS unsigned long long*)(STG + r32 * 32 + 8 * g + 4 * hi) = arr[g]; \
            _Pragma("unroll") for (int i = 0; i < 2; ++i) { const int row = srow + 16 * i; const unsigned eo = (unsigned)(((tok0 + row) * AW + cb0 + sch * 8) * 2); *(GAS v4u*)(bs_ + dst + eo) = *(const LAS v4u*)(STG + row * 32 + sch * 8); } } while (0)
            PR_OUT(ro, wsb, WS_R); PR_OUT(dd, wsb, WS_D); PR_OUT(k2o, wsb, WS_K2); PR_OUT(kko, wsb, WS_KK); PR_OUT(bpo, outb, OUT_BP); PR_OUT(vo, wsb, WS_VF); PR_OUT(go, outb, OUT_G);
#undef PR_OUT
#undef PK4
        }
        bonus += __shfl_xor(bonus, 32);
        if (hi == 0) ((float*)(F.ws + WS_BON))[(size_t)(tok0 + r32) * 6 + h] = bonus;
    } else {
        const float* kvn = F.in[I_KVN] + l * 128; bf16* C = (bf16*)(F.ws + WS_C);
        for (int q = 0; q < 16; ++q) { const int tok = tok0 + 16 * (wave - 6) + q; const unsigned w = *(const GAS unsigned*)(P + (size_t)tok * PP + PBC + 2 * lane);
            const float c0 = bflo(w), c1 = bfhi(w); const float ss = wave_sum(c0 * c0 + c1 * c1); const float rs = 1.0f / sqrtf(ss * (1.0f / 128.0f) + 1e-6f);
            *(GAS unsigned*)(C + (size_t)tok * 128 + 2 * lane) = pk2(c0 * rs * kvn[2 * lane], c1 * rs * kvn[2 * lane + 1]); }
    }
    DG_STOP(21, dg21_, dga_)
    DG_WRITE(21, unit == 0 && l == 0 && wave == 0 && lane == 0, dga_)
    __syncthreads();
}

__device__ __forceinline__ void final_norm(const Frame& F) {
    const int gw = F.vcu * NWAVES + F.wave, NGW = F.G * NWAVES; const float* g = F.in[I_FN];
    float dgc_ = 0.f;
    if (DIAG_SLOT_D >= 0) { const unsigned* D = (const unsigned*)(F.ws + WS_DIAG); const float x0 = (float)D[0] * (1.0f / (100.0f * DIAG_DIV)); const float gq = 4.0f;
        const float kq = floorf(log2f(fmaxf(x0, 1.0f)) * gq); dgc_ = sqrtf(fmaxf(exp2f((kq + 0.5f) / gq) - 1.0f, 0.01f)); }
    const bf16* XBf = (const bf16*)(F.ws + WS_XB);
    for (int m = gw; m < M; m += NGW) { GAS f32x4* xr = (GAS f32x4*)(F.out + (size_t)m * DM); const GAS v4u* xs = (const GAS v4u*)(XBf + (size_t)m * DM); float v[2][8]; float s = 0.f;
#pragma unroll
        for (int j = 0; j < 2; ++j) { unpack8(xs[F.lane + 64 * j], v[j]);
#pragma unroll
            for (int e = 0; e < 8; ++e) s += v[j][e] * v[j][e]; }
        const float rs = 1.0f / sqrtf(wave_sum(s) * (1.0f / DM) + 1e-6f);
#pragma unroll
        for (int j = 0; j < 2; ++j) { const int c = 8 * (F.lane + 64 * j); const f32x4 g0 = *(const f32x4*)(g + c), g1 = *(const f32x4*)(g + c + 4);
            xr[c / 4] = (DIAG_SLOT_D >= 0) ? (f32x4){dgc_, dgc_, dgc_, dgc_} : (f32x4){v[j][0], v[j][1], v[j][2], v[j][3]} * rs * g0;
            xr[c / 4 + 1] = (DIAG_SLOT_D >= 0) ? (f32x4){dgc_, dgc_, dgc_, dgc_} : (f32x4){v[j][4], v[j][5], v[j][6], v[j][7]} * rs * g1; } }
}

template <class T> __device__ __forceinline__ T* launder_ptr(T* p) {
    unsigned lo = (unsigned)(uintptr_t)p, hi = (unsigned)((uintptr_t)p >> 32);
    asm volatile("" : "+v"(lo), "+v"(hi));
    lo = __builtin_amdgcn_readfirstlane(lo); hi = __builtin_amdgcn_readfirstlane(hi);
    return (T*)(((uintptr_t)hi << 32) | (uintptr_t)lo);
}
constexpr int NPHASE = 18;
constexpr int DUP_PHASE = -1;
constexpr int QDUP = 1;
constexpr int STAG_UP = 4, STAG_IN = 3;
constexpr int REP_SCAN_K = 1, REP_THR_K = 1;
constexpr int NSTEP = NPHASE + (DUP_PHASE >= 0 ? 1 : 0);
constexpr int REP_THR = 1, REP_PTOK = 1, REP_KV = 1, REP_CONV = 1, REP_SCAN = 1, REP_DSA = 1, REP_RET = 1, REP_UP = 1;
#define REPL(n) for (int rep_ = 0; rep_ < (l == 0 ? (n) : 1); ++rep_)
__global__ void __launch_bounds__(NTHR, 2) fwd_kernel(Args args) {
    extern __shared__ __attribute__((aligned(16))) unsigned char lds[];
    Frame F;
    F.lds = (LAS unsigned char*)lds;
    F.tid = threadIdx.x; F.lane = F.tid & 63; F.wave = __builtin_amdgcn_readfirstlane(F.tid >> 6);
    F.G = gridDim.x; { const int bx = blockIdx.x; F.vcu = (F.G % 8 == 0) ? (bx % 8) * (F.G / 8) + bx / 8 : bx; }
    F.in = (const float* const __attribute__((address_space(4)))*)__builtin_amdgcn_kernarg_segment_ptr(); F.out = args.out; F.ws = args.ws;
    volatile LAS unsigned* MISC = (volatile LAS unsigned*)(F.lds + MISC_OFF);
    for (int u = F.tid; u < (LDS_BYTES - LDSCTL_OFF) / 4; u += NTHR) ((LAS unsigned*)(F.lds + LDSCTL_OFF))[u] = 0u;
    __syncthreads();
    const int lo = args.ph_lo, hi = args.ph_hi;
    XcdBarrier bar; bar.bar = (unsigned*)(F.ws + WS_CTL) + CW_BAR; bar.x = 0; bar.st = nullptr;
    if (hi - lo > 1) bar = xcd_barrier_post((unsigned*)(F.ws + WS_CTL) + CW_BAR, MISC + 8);
    for (int ph_ = lo; ph_ < hi; ++ph_) {
        unsigned dgp0_ = 0; if (DIAG_SLOT_D >= 100) dgp0_ = (unsigned)__builtin_amdgcn_s_memtime();
        int ph = (args.dup_phase >= 0 && ph_ > args.dup_phase) ? ph_ - 1 : ph_; asm volatile("" : "+v"(ph)); ph = __builtin_amdgcn_readfirstlane(ph);
#define PH_ENTER() \
        { unsigned z_ = 0u; int t_ = threadIdx.x; asm volatile("" : "+v"(z_), "+v"(t_)); z_ = __builtin_amdgcn_readfirstlane(z_); F.in = (const float* const __attribute__((address_space(4)))*)((const char __attribute__((address_space(4)))*)__builtin_amdgcn_kernarg_segment_ptr() + z_); F.out = args.out + z_; F.ws = args.ws + z_; \
          F.tid = t_; F.lane = t_ & 63; F.wave = __builtin_amdgcn_readfirstlane(t_ >> 6); } \
        int bx = blockIdx.x; { int g_ = gridDim.x; asm volatile("" : "+v"(bx), "+v"(g_)); bx = __builtin_amdgcn_readfirstlane(bx); g_ = __builtin_amdgcn_readfirstlane(g_); F.G = g_; F.vcu = (g_ % 8 == 0) ? (bx % 8) * (g_ / 8) + bx / 8 : bx; } \
        gu32* ctl = (gu32*)(F.ws + WS_CTL); (void)ctl; \
        bf16* XB = (bf16*)(F.ws + WS_XB); bf16* Hb = (bf16*)(F.ws + WS_H); bf16* Pb = (bf16*)(F.ws + WS_P); float* part = (float*)(F.ws + WS_PART); (void)XB; (void)Hb; (void)Pb; (void)part;
        if (ph == 0) { PH_ENTER();
            if (DIAG_SLOT_D >= 0 && bx == 0 && threadIdx.x == 0) { unsigned zz_ = 0u; asm volatile("" : "+v"(zz_)); ((unsigned*)(args.ws + WS_DIAG))[0] = zz_; ((unsigned*)(args.ws + WS_DIAG))[1] = zz_; }
            conv_weights(F, 0, 0, 3);
            p0_x(F); p0_table(F); small_weights(F);
        } else if (ph == NPHASE - 1) { PH_ENTER();
            final_norm(F);
        } else {
            const int l = (ph - 1) / 8, sub = (ph - 1) - 8 * l;
            if (sub == 0 || sub == 6) { PH_ENTER();
                pg8::Gemm g{XB, (const bf16*)(F.ws + (sub == 0 ? WS_WGU1 : WS_WGU2)), M, NGU, DM, DM}; pg8::StaticOrder S; S.init(M, NGU, F.G, bx);
                pg8::EpiUp E{Hb, FFP, part};
                if (bx >= S.nwg % F.G) for (int i = 0; i < args.stag_up; ++i) __builtin_amdgcn_s_sleep(127);
                for (int rep = 0; rep < ((l == 0 && sub == 0) ? REP_UP : 1); ++rep) pg8::gemm_phase<pg8::EpiUp, pg8::StaticOrder, true>(F.lds, g, S, E, F.tid);
            } else if (sub == 1 || sub == 7 || sub == 5) { PH_ENTER();
                const bool op = (sub == 5);
                pg8::Gemm g{op ? Pb : Hb, (const bf16*)(F.ws + (op ? WS_WOUT : (sub == 1 ? WS_WD1 : WS_WD2))), M, DM, op ? DM : FFP, op ? PP : FFP}; pg8::StaticOrder S; S.init(M, DM, F.G, bx);
                const float* base = (l == 0 && sub == 1) ? F.in[I_X] : nullptr;
                pg8::EpiRes E{base, XB, part};
                pg8::gemm_phase<pg8::EpiRes, pg8::StaticOrder, false>(F.lds, g, S, E, F.tid);
            } else if (sub == 2) { PH_ENTER();
                pg8::Gemm g{XB, (const bf16*)(F.ws + WS_WIN), M, PP, DM, DM}; pg8::StaticOrder S; S.init(M, PP, F.G, bx);
                pg8::EpiP E{Pb, PP, part};
                if (bx >= S.nwg % F.G) for (int i = 0; i < args.stag_in; ++i) __builtin_amdgcn_s_sleep(127);
                pg8::gemm_phase<pg8::EpiP, pg8::StaticOrder, true>(F.lds, g, S, E, F.tid);
            } else if (sub == 3) { PH_ENTER();
                prep_consts(F, l);
                REPL(REP_PTOK) for (int u = F.vcu; u < M / PT; u += F.G) prep_tokens_unit(F, l, u);

            } else if (sub == 4) { PH_ENTER();
                unsigned dgm_ = 0; if (DIAG_SLOT_D >= 50 && DIAG_SLOT_D < 60) dgm_ = (unsigned)__builtin_amdgcn_s_memtime();
                if (bx < BATCH * 6) { for (int rep_ = 0; rep_ < (l == 0 ? args.rep_scan : 1); ++rep_) { rwkv_chunk_unit(F, l, bx); __syncthreads(); } }
                if (DIAG_SLOT_D == 54 && l == 0 && bx < BATCH * 6 && threadIdx.x == 0) atomicMax((unsigned*)(args.ws + WS_DIAG), (unsigned)__builtin_amdgcn_s_memtime() - dgm_);
                if (DIAG_SLOT_D == 50 && l == 0 && bx == 0 && threadIdx.x == 0) ((unsigned*)(args.ws + WS_DIAG))[0] = (unsigned)__builtin_amdgcn_s_memtime() - dgm_;
                if (!(DIAG_SLOT_D >= 70 && DIAG_SLOT_D < 80)) {
                    gu32* qh = ctl + CW_QUEUE + 64 * l;
                    for (;;) {
                        if (F.tid == 0) MISC[0] = __hip_atomic_fetch_add(qh, 1u, RLX_AGENT);
                        __syncthreads();
                        const int u = (int)MISC[0];
                        __syncthreads();
                        const int nd = (l == 0 ? args.qdup : 1) * (M / 32); constexpr int QB0 = BATCH * 4 + M / 16;
                        { unsigned z_ = 0u; int t_ = threadIdx.x; asm volatile("" : "+v"(z_), "+v"(t_)); z_ = __builtin_amdgcn_readfirstlane(z_); F.ws = args.ws + z_; F.tid = t_; F.lane = t_ & 63; F.wave = __builtin_amdgcn_readfirstlane(t_ >> 6); }
                        const int ncv = (conv_flat_items(l + 1 < DEPTH) + NWAVES * CONV_PER_WAVE - 1) / (NWAVES * CONV_PER_WAVE);
                        if (DIAG_SLOT_D == 53 && l == 0 && bx == 200 && threadIdx.x == 0 && u >= QB0 + nd) { unsigned* D_ = (unsigned*)(args.ws + WS_DIAG); if (D_[1] != 0x600Du) { D_[1] = 0x600Du; D_[0] = (unsigned)__builtin_amdgcn_s_memtime() - dgm_; } }
                        if (u >= nd + QB0 + ncv) { if (DIAG_SLOT_D == 51 && l == 0 && bx == 0 && threadIdx.x == 0) ((unsigned*)(args.ws + WS_DIAG))[0] = (unsigned)__builtin_amdgcn_s_memtime() - dgm_;
                            if (DIAG_SLOT_D == 52 && l == 0 && bx == 200 && threadIdx.x == 0) ((unsigned*)(args.ws + WS_DIAG))[0] = (unsigned)__builtin_amdgcn_s_memtime() - dgm_; }
                        if (DIAG_SLOT_D == 55 && l == 0 && u >= nd + QB0 + ncv && threadIdx.x == 0) atomicMax((unsigned*)(args.ws + WS_DIAG), (unsigned)__builtin_amdgcn_s_memtime() - dgm_);
                        if (DIAG_SLOT_D == 56 && l == 0 && u >= QB0 && u < nd + QB0 && threadIdx.x == 0) atomicMax((unsigned*)(args.ws + WS_DIAG), (unsigned)__builtin_amdgcn_s_memtime() - dgm_);
                        if (u >= nd + QB0 + ncv) break;
                        if (u < BATCH * 4) ret_out_unit(F, u);
                        else if (u < BATCH * 4 + M / 16) dsa_thr_unit(F, l, u - BATCH * 4);
                        else if (u < nd + QB0) dsa_attn_unit(F, l, (u - QB0) % (M / 32));
                        else { conv_unit(F, l, u - nd - QB0); __syncthreads(); }
                    }
                }
            }
        }
        if (ph_ + 1 < hi) xcd_barrier(bar);
        if (DIAG_SLOT_D >= 100 && ph_ == DIAG_SLOT_D - 100 && blockIdx.x == 0 && threadIdx.x == 0) ((unsigned*)(args.ws + WS_DIAG))[0] = (unsigned)__builtin_amdgcn_s_memtime() - dgp0_;
    }
}

extern "C" void kernel_launch(void* const* d_in, const int* in_sizes, int n_in, void* d_out, int out_size, void* d_ws, size_t ws_size, hipStream_t stream) {
    static int grid = 0;
    if (grid == 0) {
        if (n_in != 31 || out_size != M * DM || ws_size < WS_END) { fprintf(stderr, "kernel_launch: unexpected shapes (n_in %d, out %d, ws %zu)\n", n_in, out_size, ws_size); grid = -1; return; }
        int dev = 0, cus = 0, per_cu = 0;
        if (hipGetDevice(&dev) != hipSuccess || hipDeviceGetAttribute(&cus, hipDeviceAttributeMultiprocessorCount, dev) != hipSuccess) { grid = -1; return; }
        if (hipFuncSetAttribute((const void*)fwd_kernel, hipFuncAttributeMaxDynamicSharedMemorySize, LDS_BYTES) != hipSuccess) { fprintf(stderr, "kernel_launch: hipFuncSetAttribute failed\n"); grid = -1; return; }
        if (hipOccupancyMaxActiveBlocksPerMultiprocessor(&per_cu, (const void*)fwd_kernel, NTHR, LDS_BYTES) != hipSuccess || per_cu < 1) fprintf(stderr, "kernel_launch: occupancy query says %d\n", per_cu);
        (void)hipGetLastError();
        grid = cus;
    }
    if (grid < 0) return;
    if (hipMemsetAsync((char*)d_ws + WS_CTL, 0, CTL_ZERO_BYTES, stream) != hipSuccess) return;
    Args a{};
    for (int i = 0; i < 31; ++i) a.in[i] = (const float*)d_in[i];
    a.out = (float*)d_out; a.ws = (unsigned char*)d_ws; a.dup_phase = DUP_PHASE; a.qdup = QDUP; a.rep_scan = REP_SCAN_K; a.rep_thr = REP_THR_K; a.stag_up = STAG_UP; a.stag_in = STAG_IN;
#ifndef ONE_LAUNCH
#define ONE_LAUNCH 1
#endif
    if (ONE_LAUNCH) { a.ph_lo = 0; a.ph_hi = NSTEP; hipLaunchKernelGGL(fwd_kernel, dim3(grid), dim3(NTHR), LDS_BYTES, stream, a); }
    else for (int ph = 0; ph < NPHASE; ++ph) { a.ph_lo = ph; a.ph_hi = ph + 1; hipLaunchKernelGGL(fwd_kernel, dim3(grid), dim3(NTHR), LDS_BYTES, stream, a); }
}
```

```cpp
#include <hip/hip_runtime.h>
#include <cstdio>
#include <cstdint>
#include <cmath>

namespace pg8 {
#define PG8_LAS __attribute__((address_space(3)))
typedef unsigned short bf16_t;
typedef short bf16x8 __attribute__((ext_vector_type(8)));
typedef float f32x4 __attribute__((ext_vector_type(4)));
typedef unsigned u32x4 __attribute__((ext_vector_type(4)));
constexpr int BM = 256, BK = 64, HALF = 128, HTB = HALF * BK * 2  , STAGE_BYTES = 8 * HTB, NXCD = 8, WGM = 8;

__host__ __device__ __forceinline__ int lds_byte(int r, int c) { const int st = (r >> 4) * 2 + (c >> 5), rr = r & 15, cc = c & 31, ob = rr * 64 + cc * 2; return st * 1024 + (ob ^ (((ob >> 9) & 1) << 5)); }
__host__ __device__ __forceinline__ void stage_rc(int b, int& R, int& C) { const int st = b / 1024, sb = b % 1024, swz = sb ^ (((sb >> 9) & 1) << 5); R = (st >> 1) * 16 + swz / 64; C = (st & 1) * 32 + (swz % 64) / 2; }
__host__ __device__ __forceinline__ int perm32(int rho) { const int n = rho >> 4, i = rho & 15; return 8 * (i >> 2) + 4 * n + (i & 3); }

struct Unit { int pm, pn; };
struct Gemm { const bf16_t* A; const bf16_t* Bt; int M, N, K, lda; };

struct StaticOrder {
    int nM, nN, nwg, G, c;
    __host__ __device__ void init(int M, int N, int G_, int c_) { nM = M / BM; nN = N / BM; nwg = nM * nN; G = G_; c = c_; }
    __host__ __device__ bool next(int i, Unit& u) const {
        const long L = (long)i * G + c; if (L >= nwg) return false;
        int wgid = (int)L; { const int q = nwg / NXCD, r = nwg % NXCD, xcd = wgid % NXCD, off = wgid / NXCD; wgid = (xcd < r ? xcd * (q + 1) : r * (q + 1) + (xcd - r) * q) + off; }
        const int nig = WGM * nN, gid = wgid / nig, fm = gid * WGM, gsz = (nM - fm) < WGM ? (nM - fm) : WGM;
        u.pm = fm + ((wgid % nig) % gsz); u.pn = (wgid % nig) / gsz; return true;
    }
    __device__ __forceinline__ void a_ready(const Unit&) const {}
    __device__ __forceinline__ void done(const Unit&) const {}
};

__device__ __forceinline__ unsigned cvt_pk_bf16(float lo, float hi) { unsigned r; asm volatile("v_cvt_pk_bf16_f32 %0, %1, %2" : "=v"(r) : "v"(lo), "v"(hi)); return r; }


__device__ __forceinline__ float row_rstd(const float* part, int row) {
    const f32x4* p = (const f32x4*)(part + (size_t)row * 16);
    const f32x4 a = p[0], b = p[1], c = p[2], d = p[3];
    const float s = ((a[0] + a[1]) + (a[2] + a[3])) + ((b[0] + b[1]) + (b[2] + b[3])) + ((c[0] + c[1]) + (c[2] + c[3])) + ((d[0] + d[1]) + (d[2] + d[3]));
    return 1.0f / sqrtf(s * (1.0f / 1024.0f) + 1e-6f);
}
__device__ __forceinline__ void rows_rstd(const float* part, int row0, int fq, float (&rs)[2][4]) {
    f32x4 pr[2][4];
#pragma unroll
    for (int ai = 0; ai < 2; ++ai)
#pragma unroll
        for (int m = 0; m < 4; ++m) pr[ai][m] = *(const f32x4*)(part + (size_t)(row0 + ai * HALF + m * 16) * 16 + 4 * fq);
#pragma unroll
    for (int ai = 0; ai < 2; ++ai)
#pragma unroll
        for (int m = 0; m < 4; ++m) { float s = (pr[ai][m][0] + pr[ai][m][1]) + (pr[ai][m][2] + pr[ai][m][3]); s += __shfl_xor(s, 16); s += __shfl_xor(s, 32); rs[ai][m] = 1.0f / sqrtf(s * (1.0f / 1024.0f) + 1e-6f); }
}
__device__ __forceinline__ float silu_f(float x) { return x * __builtin_amdgcn_rcpf(1.0f + __expf(-x)); }

struct EpiUp {
    static constexpr bool PERM = true;
    bf16_t* H; int ldh; const float* part;
    __device__ __forceinline__ void operator()(const f32x4 (&acc)[2][2][4][2], const Unit& u, int wr, int wc, int fr, int fq) const {
        const int row0 = u.pm * BM + wr * 64 + fr, hcol = u.pn * 128 + wc * 32 + 8 * fq;
        float rs8[2][4]; rows_rstd(part, row0, fq, rs8);
#pragma unroll
        for (int ai = 0; ai < 2; ++ai)
#pragma unroll
            for (int m = 0; m < 4; ++m) { const int row = row0 + ai * HALF + m * 16; const float rs = rs8[ai][m];
                const f32x4 g0 = acc[ai][0][m][0] * rs, g1 = acc[ai][0][m][1] * rs, u0 = acc[ai][1][m][0] * rs, u1 = acc[ai][1][m][1] * rs;
                u32x4 w; w.x = cvt_pk_bf16(silu_f(g0[0]) * u0[0], silu_f(g0[1]) * u0[1]); w.y = cvt_pk_bf16(silu_f(g0[2]) * u0[2], silu_f(g0[3]) * u0[3]);
                w.z = cvt_pk_bf16(silu_f(g1[0]) * u1[0], silu_f(g1[1]) * u1[1]); w.w = cvt_pk_bf16(silu_f(g1[2]) * u1[2], silu_f(g1[3]) * u1[3]);
                *(u32x4*)(H + (size_t)row * ldh + hcol) = w; }
    }
};
struct EpiP {
    static constexpr bool PERM = true;
    bf16_t* P; int ldp; const float* part;
    __device__ __forceinline__ void operator()(const f32x4 (&acc)[2][2][4][2], const Unit& u, int wr, int wc, int fr, int fq) const {
        const int row0 = u.pm * BM + wr * 64 + fr, col0 = u.pn * BM + wc * 32 + 8 * fq;
        float rs8[2][4]; rows_rstd(part, row0, fq, rs8);
#pragma unroll
        for (int ai = 0; ai < 2; ++ai)
#pragma unroll
            for (int m = 0; m < 4; ++m) { const int row = row0 + ai * HALF + m * 16; const float rs = rs8[ai][m];
#pragma unroll
                for (int bj = 0; bj < 2; ++bj) { const f32x4 v0 = acc[ai][bj][m][0] * rs, v1 = acc[ai][bj][m][1] * rs;
                    u32x4 w; w.x = cvt_pk_bf16(v0[0], v0[1]); w.y = cvt_pk_bf16(v0[2], v0[3]); w.z = cvt_pk_bf16(v1[0], v1[1]); w.w = cvt_pk_bf16(v1[2], v1[3]);
                    *(u32x4*)(P + (size_t)row * ldp + col0 + bj * HALF) = w; } }
    }
};
struct EpiRes {
    static constexpr bool PERM = true;
    const float* base; bf16_t* xb; float* part;
    __device__ __forceinline__ void operator()(const f32x4 (&acc)[2][2][4][2], const Unit& u, int wr, int wc, int fr, int fq) const {
        const int row0 = u.pm * BM + wr * 64 + fr, col0 = u.pn * BM + wc * 32 + 8 * fq;
        u32x4 xr[2][4][2];
        if (!base) {
#pragma unroll
            for (int ai = 0; ai < 2; ++ai)
#pragma unroll
                for (int m = 0; m < 4; ++m)
#pragma unroll
                    for (int bj = 0; bj < 2; ++bj) xr[ai][m][bj] = *(const u32x4*)(xb + (size_t)(row0 + ai * HALF + m * 16) * 1024 + col0 + bj * HALF); }
#pragma unroll
        for (int ai = 0; ai < 2; ++ai)
#pragma unroll
            for (int m = 0; m < 4; ++m) { const int row = row0 + ai * HALF + m * 16; float ss = 0.f;
#pragma unroll
                for (int bj = 0; bj < 2; ++bj) { const size_t off = (size_t)row * 1024 + col0 + bj * HALF;
                    f32x4 v0, v1;
                    if (base) { v0 = *(const f32x4*)(base + off); v1 = *(const f32x4*)(base + off + 4); }
                    else { const u32x4 xw = xr[ai][m][bj];
                        v0 = (f32x4){__builtin_bit_cast(float, xw.x << 16), __builtin_bit_cast(float, xw.x & 0xffff0000u), __builtin_bit_cast(float, xw.y << 16), __builtin_bit_cast(float, xw.y & 0xffff0000u)};
                        v1 = (f32x4){__builtin_bit_cast(float, xw.z << 16), __builtin_bit_cast(float, xw.z & 0xffff0000u), __builtin_bit_cast(float, xw.w << 16), __builtin_bit_cast(float, xw.w & 0xffff0000u)}; }
                    v0 += acc[ai][bj][m][0]; v1 += acc[ai][bj][m][1];
                    u32x4 w; w.x = cvt_pk_bf16(v0[0], v0[1]); w.y = cvt_pk_bf16(v0[2], v0[3]); w.z = cvt_pk_bf16(v1[0], v1[1]); w.w = cvt_pk_bf16(v1[2], v1[3]);
                    *(u32x4*)(xb + off) = w;
                    ss += (v0[0] * v0[0] + v0[1] * v0[1]) + (v0[2] * v0[2] + v0[3] * v0[3]) + (v1[0] * v1[0] + v1[1] * v1[1]) + (v1[2] * v1[2] + v1[3] * v1[3]); }
                ss += __shfl_xor(ss, 16); ss += __shfl_xor(ss, 32);
                if (fq == 0) part[(size_t)row * 16 + u.pn * 4 + wc] = ss;
                asm volatile("" ::: "memory"); }
    }
};

template <class Epi, class Sched, bool ALIGN_EPI>
__device__ __forceinline__ void gemm_phase(PG8_LAS unsigned char* lds, const Gemm g, const Sched& S, const Epi& E, const int tid) {
    const int wid = __builtin_amdgcn_readfirstlane(tid >> 6), lane = tid & 63, wr = wid >> 2, wc = wid & 3, fr = lane & 15, fq = lane >> 4;
    const int K = g.K, nt = K / BK, lda = g.lda;
    unsigned voffA[2], voffB[2];
#pragma unroll
    for (int i = 0; i < 2; ++i) { int R, C; stage_rc(tid * 16 + i * 8192, R, C); const int Rb = Epi::PERM ? ((R & ~31) + perm32(R & 31)) : R;
        voffA[i] = (unsigned)(R * lda + C) * 2u; voffB[i] = (unsigned)(Rb * K + C) * 2u; }
    const size_t kstep = (size_t)(BK * 2);
    const size_t hstepA = (size_t)HALF * lda * 2, hstepB = (size_t)HALF * K * 2;
    const size_t tstepA = 2 * hstepA, tstepB = 2 * hstepB;
    const unsigned ldsw = (unsigned)wid * 1024u;
    const int aoff = lds_byte(wr * 64 + fr, fq * 8), boff = lds_byte(wc * 32 + fr, fq * 8);
#define PG8_SA(b, h) (((b) * 2 + (h)) * HTB)
#define PG8_SB(b, h) ((4 + (b) * 2 + (h)) * HTB)
#define PG8_STAGE(bufoff, gbase, voff) do { _Pragma("unroll") for (int _i = 0; _i < 2; ++_i) \
        __builtin_amdgcn_global_load_lds((const unsigned*)((const char*)(gbase) + (voff)[_i]), (PG8_LAS unsigned*)(lds + (bufoff) + ldsw + _i * 8192), 16, 0, 0); } while (0)
#define PG8_LDA(dst, b, h) do { _Pragma("unroll") for (int m = 0; m < 4; ++m) _Pragma("unroll") for (int k = 0; k < 2; ++k) dst[m][k] = *(const PG8_LAS bf16x8*)(lds + PG8_SA(b, h) + aoff + m * 2048 + k * 1024); } while (0)
#define PG8_LDB(dst, b, h) do { _Pragma("unroll") for (int n = 0; n < 2; ++n) _Pragma("unroll") for (int k = 0; k < 2; ++k) dst[n][k] = *(const PG8_LAS bf16x8*)(lds + PG8_SB(b, h) + boff + n * 2048 + k * 1024); } while (0)
#define PG8_MMA(ai, bj, At, Bt) do { __builtin_amdgcn_s_setprio(1); _Pragma("unroll") for (int m = 0; m < 4; ++m) _Pragma("unroll") for (int n = 0; n < 2; ++n) _Pragma("unroll") for (int k = 0; k < 2; ++k) \
        acc[ai][bj][m][n] = __builtin_amdgcn_mfma_f32_16x16x32_bf16(Bt[n][k], At[m][k], acc[ai][bj][m][n], 0, 0, 0); __builtin_amdgcn_s_setprio(0); } while (0)
#define PG8_WAIT_V(n) asm volatile("s_waitcnt vmcnt(" #n ")" ::: "memory")
#define PG8_WAIT_L(n) asm volatile("s_waitcnt lgkmcnt(" #n ")" ::: "memory")
#define PG8_BAR __builtin_amdgcn_s_barrier()
#define PG8_SCHED __builtin_amdgcn_sched_barrier(0)
    Unit cur, nxt; int ui = 0;
    if (!S.next(0, cur)) return;
    f32x4 acc[2][2][4][2];
#pragma unroll
    for (int a = 0; a < 2; ++a)
#pragma unroll
        for (int b = 0; b < 2; ++b)
#pragma unroll
            for (int m = 0; m < 4; ++m)
#pragma unroll
                for (int n = 0; n < 2; ++n) acc[a][b][m][n] = (f32x4){0.f, 0.f, 0.f, 0.f};
    bf16x8 At[4][2], B0[2][2], B1[2][2];
    const char* cA = (const char*)g.A + (size_t)cur.pm * tstepA; const char* cB = (const char*)g.Bt + (size_t)cur.pn * tstepB;
    S.a_ready(cur);
    PG8_STAGE(PG8_SB(0, 0), cB, voffB); PG8_STAGE(PG8_SB(0, 1), cB + hstepB, voffB); PG8_STAGE(PG8_SA(0, 0), cA, voffA); PG8_STAGE(PG8_SA(0, 1), cA + hstepA, voffA);
    if (wr == 1) PG8_BAR;
    PG8_WAIT_V(2); PG8_BAR;
    PG8_STAGE(PG8_SB(1, 0), cB + kstep, voffB); PG8_STAGE(PG8_SA(1, 0), cA + kstep, voffA); PG8_STAGE(PG8_SB(1, 1), cB + hstepB + kstep, voffB);
    PG8_WAIT_V(6); PG8_BAR;
    for (;;) {
        const bool has_next = S.next(ui + 1, nxt);
        const char* nA = has_next ? (const char*)g.A + (size_t)nxt.pm * tstepA : cA; const char* nB = has_next ? (const char*)g.Bt + (size_t)nxt.pn * tstepB : cB;
        for (int t = 0; t < nt; t += 2) {
            const bool last = (t == nt - 2);
            const char* a1 = cA + (size_t)(t + 1) * kstep;
            const char* a2 = last ? nA : cA + (size_t)(t + 2) * kstep; const char* b2 = last ? nB : cB + (size_t)(t + 2) * kstep;
            const char* a3 = a2 + kstep; const char* b3 = b2 + kstep;
            if (last && has_next) S.a_ready(nxt);
            PG8_LDB(B0, 0, 0); PG8_LDB(B1, 0, 1); PG8_SCHED; PG8_LDA(At, 0, 0); PG8_STAGE(PG8_SA(1, 1), a1 + hstepA, voffA);
            PG8_WAIT_V(8); PG8_WAIT_L(0); PG8_BAR; PG8_MMA(0, 0, At, B0); PG8_MMA(0, 1, At, B1); PG8_BAR; PG8_SCHED;
            PG8_LDA(At, 0, 1); PG8_STAGE(PG8_SB(0, 0), b2, voffB); PG8_STAGE(PG8_SB(0, 1), b2 + hstepB, voffB); PG8_STAGE(PG8_SA(0, 0), a2, voffA);
            PG8_WAIT_V(8); PG8_WAIT_L(0); PG8_BAR; PG8_MMA(1, 0, At, B0); PG8_MMA(1, 1, At, B1); PG8_BAR; PG8_SCHED;
            PG8_LDB(B0, 1, 0); PG8_LDB(B1, 1, 1); PG8_SCHED; PG8_LDA(At, 1, 0); PG8_STAGE(PG8_SA(0, 1), a2 + hstepA, voffA);
            PG8_WAIT_V(8); PG8_WAIT_L(0); PG8_BAR; PG8_MMA(0, 0, At, B0); PG8_MMA(0, 1, At, B1); PG8_BAR; PG8_SCHED;
            PG8_LDA(At, 1, 1); PG8_STAGE(PG8_SB(1, 0), b3, voffB); PG8_STAGE(PG8_SB(1, 1), b3 + hstepB, voffB); PG8_STAGE(PG8_SA(1, 0), a3, voffA);
            PG8_WAIT_V(8); PG8_WAIT_L(0); PG8_BAR; PG8_MMA(1, 0, At, B0); PG8_MMA(1, 1, At, B1); PG8_BAR; PG8_SCHED;
        }
        if constexpr (ALIGN_EPI) { if (wr == 0) PG8_BAR; }
        E(acc, cur, wr, wc, fr, fq); S.done(cur);
        if (!has_next) break;
#pragma unroll
        for (int a = 0; a < 2; ++a)
#pragma unroll
            for (int b = 0; b < 2; ++b)
#pragma unroll
                for (int m = 0; m < 4; ++m)
#pragma unroll
                    for (int n = 0; n < 2; ++n) acc[a][b][m][n] = (f32x4){0.f, 0.f, 0.f, 0.f};
        cur = nxt; cA = nA; cB = nB; ++ui;
        if constexpr (ALIGN_EPI) { if (wr == 1) PG8_BAR; }
    }
    PG8_WAIT_V(0);
    if constexpr (!ALIGN_EPI) { if (wr == 0) PG8_BAR; }
    PG8_BAR;
#undef PG8_SA
#undef PG8_SB
#undef PG8_STAGE
#undef PG8_LDA
#undef PG8_LDB
#undef PG8_MMA
#undef PG8_WAIT_V
#undef PG8_WAIT_L
#undef PG8_BAR
#undef PG8_SCHED
}
}

constexpr int NWAVES = 8, NTHR = 512;
constexpr int BATCH = 8, SEQ = 2048, DM = 1024, DEPTH = 2, FF = 2752, M = BATCH * SEQ;
constexpr int FFP = 2816;
constexpr int NGU = 5632;
constexpr int PP = 3584;
constexpr int NIN = 3400;
constexpr int PA = 0, PMV = 1280, PBQ = 1296, PBC = 1680, PBIQ = 1808, PBIK = 2320, PBIW = 2384, PCQ = 2392, PCK = 2648, PCV = 2904, PCG = 3160, PUSED = 3416;
constexpr int AW = 384;
constexpr int TOPK = 256;

constexpr size_t MiB = 1u << 20;
constexpr size_t WS_CTL = 0, CTL_ZERO_BYTES = 1 * MiB;
constexpr size_t WS_PART = 1 * MiB;
constexpr size_t WS_TAB = 2 * MiB;
constexpr size_t WS_BON = 2 * MiB + 512 * 1024;
constexpr size_t WS_WUKT = 3 * MiB, WS_WUVT = 3 * MiB + 192 * 1024;
constexpr size_t WS_THR = 3 * MiB + 384 * 1024, WS_SCUT = 3 * MiB + 448 * 1024;
constexpr size_t WS_LORA = 3 * MiB + 512 * 1024;
constexpr size_t WS_WGU1 = 4 * MiB, WS_WD1 = 15 * MiB, WS_WIN = 21 * MiB, WS_WOUT = 28 * MiB, WS_WGU2 = 30 * MiB, WS_WD2 = 41 * MiB;
constexpr size_t WS_XB = 47 * MiB;
constexpr size_t WS_VF = 79 * MiB;
constexpr size_t WS_P = 91 * MiB;
constexpr size_t WS_H = WS_P;
constexpr size_t WS_R = 203 * MiB, WS_D = 215 * MiB, WS_K2 = 227 * MiB, WS_KK = 239 * MiB, WS_C = 251 * MiB;
constexpr size_t WS_KV = WS_XB + 24 * MiB;
constexpr size_t OUT_BP = 0, OUT_G = 12 * MiB, OUT_MASK = 24 * MiB, OUT_KI = 28 * MiB;
constexpr size_t WS_END = 256 * MiB;
static_assert(WS_WD2 + (size_t)1024 * FFP * 2 <= WS_XB && WS_P + (size_t)M * PP * 2 <= WS_R && WS_C + (size_t)M * 128 * 2 <= WS_END, "ws map");
constexpr int CW_BAR = 4096;
constexpr int CW_QUEUE = 16384;
constexpr int CW_THRD = 20480;

constexpr int RING_BYTES = 131072;
constexpr int LDSCTL_OFF = RING_BYTES, MISC_OFF = LDSCTL_OFF + 320;
constexpr int LDS_BYTES = 147456;

#define GAS __attribute__((address_space(1)))
#define LAS __attribute__((address_space(3)))
typedef unsigned short bf16;
typedef unsigned v4u __attribute__((ext_vector_type(4)));
typedef float f32x4 __attribute__((ext_vector_type(4)));
typedef GAS unsigned gu32;
#define RLX_AGENT __ATOMIC_RELAXED, __HIP_MEMORY_SCOPE_AGENT
#define LDS_WAIT() asm volatile("s_waitcnt lgkmcnt(0)" ::: "memory")
__device__ __forceinline__ unsigned f2bf(float f) { unsigned u = __builtin_bit_cast(unsigned, f); return (u + 0x7fffu + ((u >> 16) & 1u)) >> 16; }
typedef float f32x2v_ __attribute__((ext_vector_type(2))); typedef __bf16 bf16x2v_ __attribute__((ext_vector_type(2)));
__device__ __forceinline__ unsigned pk2(float lo, float hi) { const f32x2v_ v = {lo, hi}; return __builtin_bit_cast(unsigned, __builtin_convertvector(v, bf16x2v_)); }
__device__ __forceinline__ float bf2f(unsigned short v) { return __uint_as_float((unsigned)v << 16); }
__device__ __forceinline__ float bflo(unsigned w) { return __uint_as_float(w << 16); }
__device__ __forceinline__ float bfhi(unsigned w) { return __uint_as_float(w & 0xffff0000u); }
__device__ __forceinline__ void unpack8(const v4u w, float (&f)[8]) { f[0] = bflo(w.x); f[1] = bfhi(w.x); f[2] = bflo(w.y); f[3] = bfhi(w.y); f[4] = bflo(w.z); f[5] = bfhi(w.z); f[6] = bflo(w.w); f[7] = bfhi(w.w); }
__device__ __forceinline__ float sigmoid_f(float x) { return 1.0f / (1.0f + __expf(-x)); }
__device__ __forceinline__ float wave_sum(float v) {
#pragma unroll
    for (int o = 1; o < 64; o <<= 1) v += __shfl_xor(v, o);
    return v;
}

#define XB_TMO      128
#define XB_XCNT(j)  (256  + 64 * (j))
#define XB_XSUB(j)  (1280 + 64 * (j))
#define XB_XGEN(j)  (2304 + 64 * (j))
#define XB_TOP      3328
#define XB_TOPGEN   3392
#define XCD_BAR_WORDS 3456
#define XB_SPIN_CAP (1u << 22)

__device__ __forceinline__ unsigned xb_ld(unsigned* p)              { return __hip_atomic_load(p, __ATOMIC_RELAXED, __HIP_MEMORY_SCOPE_AGENT); }
__device__ __forceinline__ unsigned xb_add(unsigned* p, unsigned v) { return __hip_atomic_fetch_add(p, v, __ATOMIC_RELAXED, __HIP_MEMORY_SCOPE_AGENT); }
__device__ __forceinline__ unsigned xb_xcc_id() { return (unsigned)__builtin_amdgcn_s_getreg((3 << 11) | 20) & 0xFu; }
#define XB_SPIN(cond, bar) do { unsigned _sp = 0; while (cond) { __builtin_amdgcn_s_sleep(1); \
    if ((++_sp & 255u) == 0u) { if (xb_ld(&(bar)[XB_TMO])) break; if (_sp > XB_SPIN_CAP) { atomicAdd(&(bar)[XB_TMO], 1u); break; } } } } while (0)

struct XcdBarrier { unsigned* bar; unsigned x; volatile LAS unsigned* st; };

__device__ __forceinline__ XcdBarrier xcd_barrier_post(unsigned* bar, volatile LAS unsigned* st) {
    XcdBarrier b; b.bar = bar; b.x = xb_xcc_id(); b.st = st;
    if (threadIdx.x == 0) (void)xb_add(&bar[XB_XCNT(b.x)], 1u);
    return b;
}
__device__ __forceinline__ void xcd_barrier_complete(unsigned* bar, unsigned x, unsigned& nloc, unsigned& nx) {
    const unsigned G = gridDim.x * gridDim.y * gridDim.z;
    unsigned sum, cnt, mine, sp = 0u;
    for (;;) {
        sum = 0u; cnt = 0u; mine = 0u;
#pragma unroll
        for (unsigned j = 0; j < 16; ++j) { const unsigned c = xb_ld(&bar[XB_XCNT(j)]); sum += c; cnt += (c > 0u) ? 1u : 0u; mine = (j == x) ? c : mine; }
        if (sum == G) break;
        __builtin_amdgcn_s_sleep(1);
        if ((++sp & 255u) == 0u) { if (xb_ld(&bar[XB_TMO])) break; if (sp > XB_SPIN_CAP) { atomicAdd(&bar[XB_TMO], 1u); break; } }
    }
    nloc = mine > 0u ? mine : 1u; nx = cnt > 0u ? cnt : 1u;
}
__device__ __forceinline__ void xcd_barrier(const XcdBarrier& b) {
    asm volatile("s_waitcnt vmcnt(0)" ::: "memory");
    __syncthreads();
    if (threadIdx.x == 0) {
        unsigned* bar = b.bar;
        __builtin_amdgcn_s_waitcnt(0);
        unsigned nloc = b.st[0], nx = b.st[1];
        if (nloc == 0u) { xcd_barrier_complete(bar, b.x, nloc, nx); b.st[0] = nloc; b.st[1] = nx; }
        const unsigned old = xb_add(&bar[XB_XSUB(b.x)], 1u);
        const unsigned gen = old / nloc;
        if (old + 1u == (gen + 1u) * nloc) {
            __builtin_amdgcn_fence(__ATOMIC_RELEASE, "agent");
            asm volatile("s_waitcnt vmcnt(0)" ::: "memory");
            const unsigned og = xb_add(&bar[XB_TOP], 1u);
            const unsigned tg = og / nx;
            if (og + 1u == (tg + 1u) * nx) xb_add(&bar[XB_TOPGEN], 1u);
            else XB_SPIN(xb_ld(&bar[XB_TOPGEN]) == tg, bar);
            __builtin_amdgcn_fence(__ATOMIC_ACQUIRE, "agent");
            xb_add(&bar[XB_XGEN(b.x)], 1u);
            asm volatile("s_waitcnt vmcnt(0)" ::: "memory");
        } else {
            XB_SPIN(xb_ld(&bar[XB_XGEN(b.x)]) == gen, bar);
            __builtin_amdgcn_fence(__ATOMIC_ACQUIRE, "agent");
            asm volatile("s_waitcnt vmcnt(0)" ::: "memory");
        }
    }
    __syncthreads();
}

#ifndef DIAG_SLOT_D
#define DIAG_SLOT_D (-1)
#endif
#ifndef DIAG_DIV
#define DIAG_DIV 1.0f
#endif
constexpr size_t WS_DIAG = 3 * MiB + 900 * 1024;
#define DG_START(k, var) unsigned var = 0; if (DIAG_SLOT_D == (k)) var = (unsigned)__builtin_amdgcn_s_memtime();
#define DG_STOP(k, var, acc) if (DIAG_SLOT_D == (k)) acc += (unsigned)__builtin_amdgcn_s_memtime() - var;
#define DG_WRITE(k, cond, acc) if (DIAG_SLOT_D == (k) && (cond)) ((unsigned*)(F.ws + WS_DIAG))[0] = acc;
struct Args { const float* in[31]; float* out; unsigned char* ws; int ph_lo, ph_hi; int dup_phase, qdup, rep_scan, rep_thr; int stag_up, stag_in; };
struct Frame {
    LAS unsigned char* lds;
    int tid, lane, wave, vcu, G;
    const float* const __attribute__((address_space(4)))* in;
    float* out; unsigned char* ws;
};
enum { I_X = 0, I_F1N, I_F1G, I_F1U, I_F1D, I_MIXN, I_WIN, I_WOUT, I_MU, I_W0, I_W2, I_A0, I_A2, I_G2, I_KK, I_KA, I_RK, I_LNW, I_LNB, I_VRW, I_VRMU, I_V0, I_V2, I_KVN, I_WUK, I_WUV, I_F2N, I_F2G, I_F2U, I_F2D, I_FN };

struct ConvMeta { bf16* WT; const float* gain; int Kd, r0, k0, ksrc; float scale; bool has; };
__device__ __forceinline__ void conv_load(const Frame& F, int l, int kind, int item, ConvMeta& m, f32x4 (&vals)[8]) {
    const int lane = F.lane;
    int Kd, nkb; bf16* WT;
    if (kind == 0 || kind == 4) { Kd = 1024; WT = (bf16*)(F.ws + (kind == 0 ? WS_WGU1 : WS_WGU2)); }
    else if (kind == 1 || kind == 5) { Kd = FFP; WT = (bf16*)(F.ws + (kind == 1 ? WS_WD1 : WS_WD2)); }
    else if (kind == 2) { Kd = 1024; WT = (bf16*)(F.ws + WS_WIN); }
    else { Kd = 1024; WT = (bf16*)(F.ws + WS_WOUT); }
    nkb = Kd / 64;
    const int rb = item / nkb, kb = item % nkb, r0 = rb * 32, k0 = kb * 64;
    const int n4 = (lane & 7) * 4, kr = lane >> 3;
    const int rr = r0 + n4;
    const float* src = nullptr; int ns = 0, col = 0, ksrc = 1024; const float* gain = nullptr; float scale = 1.0f;
    if (kind == 0 || kind == 4) {
        const int tile = rr >> 8, w = rr & 255, hid = tile * 128 + (w & 127);
        if (hid < FF) { const float* s1 = (w >> 7) ? F.in[I_F1U] : F.in[I_F1G]; const float* s2 = (w >> 7) ? F.in[I_F2U] : F.in[I_F2G]; src = ((kind == 0) ? s1 : s2) + (size_t)l * 1024 * FF; ns = FF; col = hid; }
        gain = ((kind == 0) ? F.in[I_F1N] : F.in[I_F2N]) + l * 1024;
    } else if (kind == 1 || kind == 5) {
        src = ((kind == 1) ? F.in[I_F1D] : F.in[I_F2D]) + (size_t)l * FF * 1024; ns = 1024; col = rr; ksrc = FF; scale = 0.5f;
    } else if (kind == 2) {
        gain = F.in[I_MIXN] + l * 1024;
        if (rr < 1280) { src = F.in[I_WIN] + (size_t)l * 1024 * NIN; ns = NIN; col = rr; }
        else if (rr < 1296) { if (l > 0) { src = F.in[I_VRW] + (size_t)(l - 1) * 1024 * 16; ns = 16; col = rr - 1280; } }
        else if (rr < PUSED) { src = F.in[I_WIN] + (size_t)l * 1024 * NIN; ns = NIN; col = rr - 16; }
    } else { src = F.in[I_WOUT] + (size_t)l * 1024 * 1024; ns = 1024; col = rr; }
    const bool has = (src != nullptr); const float* sp = has ? src : F.in[I_FN]; const int nss = has ? ns : 0, cols = has ? col : 0;
#pragma unroll
    for (int i = 0; i < 8; ++i) { const int k = k0 + 8 * i + kr; const int kc = k < ksrc ? k : ksrc - 1; vals[i] = *(const GAS f32x4*)(sp + (size_t)kc * nss + cols); }
    m.WT = WT; m.gain = gain; m.Kd = Kd; m.r0 = r0; m.k0 = k0; m.ksrc = ksrc; m.scale = scale; m.has = has;
}
__device__ __forceinline__ void conv_store(const Frame& F, const ConvMeta& m, const f32x4 (&vals)[8], LAS float* scr) {
    const int lane = F.lane, n4 = (lane & 7) * 4, kr = lane >> 3;
#pragma unroll
    for (int i = 0; i < 8; ++i) { const int kk = 8 * i + kr, k = m.k0 + kk; float g = (m.has && k < m.ksrc) ? m.scale : 0.f; if (m.gain) g *= m.gain[k < 1024 ? k : 1023];
        LAS float* d = scr + kk * 33 + n4; d[0] = vals[i][0] * g; d[1] = vals[i][1] * g; d[2] = vals[i][2] * g; d[3] = vals[i][3] * g; }
    LDS_WAIT(); asm volatile("" ::: "memory");
    const int c = lane & 7;
#pragma unroll
    for (int j = 0; j < 4; ++j) { const int n = (lane >> 3) + 8 * j; const LAS float* s = scr + (8 * c) * 33 + n;
        v4u o; o.x = pk2(s[0 * 33], s[1 * 33]); o.y = pk2(s[2 * 33], s[3 * 33]); o.z = pk2(s[4 * 33], s[5 * 33]); o.w = pk2(s[6 * 33], s[7 * 33]);
        *(GAS v4u*)(m.WT + (size_t)(m.r0 + n) * m.Kd + m.k0 + 8 * c) = o; }
    LDS_WAIT(); asm volatile("" ::: "memory");
}
__device__ __forceinline__ void conv_item(const Frame& F, int l, int kind, int item, LAS float* scr) { ConvMeta m; f32x4 vals[8]; conv_load(F, l, kind, item, m, vals); conv_store(F, m, vals, scr); }
__host__ __device__ constexpr int conv_items(int kind) { return (kind == 0 || kind == 4) ? (NGU / 32) * 16 : (kind == 1 || kind == 5) ? 32 * (FFP / 64) : (kind == 2) ? (PP / 32) * 16 : 32 * 16; }
__device__ __forceinline__ void conv_weights(const Frame& F, int l, int k_lo, int k_hi) {
    LAS float* scr = (LAS float*)(F.lds + F.wave * 16384);
    const int gw = F.vcu * NWAVES + F.wave, NGW = F.G * NWAVES;
    for (int kind = k_lo; kind < k_hi; ++kind) { const int ni = conv_items(kind);
        for (int it = gw; it < ni; it += 2 * NGW) {
            ConvMeta ma; f32x4 va[8]; conv_load(F, l, kind, it, ma, va);
            if (it + NGW < ni) { ConvMeta mb; f32x4 vb[8]; conv_load(F, l, kind, it + NGW, mb, vb); conv_store(F, ma, va, scr); conv_store(F, mb, vb, scr); }
            else conv_store(F, ma, va, scr); } }
}

__host__ __device__ constexpr int conv_flat_items(bool has_next) { return conv_items(3) + conv_items(4) + conv_items(5) + (has_next ? conv_items(0) + conv_items(1) + conv_items(2) : 0); }
constexpr int CONV_PER_WAVE = 2;
__device__ __forceinline__ void conv_flat(int l, bool has_next, int it, int& layer, int& kind, int& item) {
    layer = l; kind = 3;
    if (it >= conv_items(3)) { it -= conv_items(3); kind = 4;
        if (it >= conv_items(4)) { it -= conv_items(4); kind = 5;
            if (it >= conv_items(5)) { it -= conv_items(5); kind = 0; layer = l + 1;
                if (it >= conv_items(0)) { it -= conv_items(0); kind = 1;
                    if (it >= conv_items(1)) { it -= conv_items(1); kind = 2; } } } } }
    item = it;
}
static_assert(CONV_PER_WAVE == 2, "conv_unit converts a wave's two items together");
__device__ __forceinline__ void conv_unit(const Frame& F, int l, int u) {
    LAS float* scr = (LAS float*)(F.lds + F.wave * 16384);
    const bool has_next = (l + 1 < DEPTH); const int total = conv_flat_items(has_next);
    const int it0 = (u * CONV_PER_WAVE) * NWAVES + F.wave, it1 = it0 + NWAVES;
    if (it0 >= total) return;
    int la, ka, ia; conv_flat(l, has_next, it0, la, ka, ia);
    ConvMeta ma; f32x4 va[8]; conv_load(F, la, ka, ia, ma, va);
    if (it1 < total) { int lb, kb, ib; conv_flat(l, has_next, it1, lb, kb, ib);
        ConvMeta mb; f32x4 vb[8]; conv_load(F, lb, kb, ib, mb, vb);
        conv_store(F, ma, va, scr); conv_store(F, mb, vb, scr); }
    else conv_store(F, ma, va, scr);
}
__device__ __forceinline__ void p0_x(const Frame& F) {
    const int gw = F.vcu * NWAVES + F.wave, NGW = F.G * NWAVES;
    const float* x = F.in[I_X]; bf16* xb = (bf16*)(F.ws + WS_XB); float* part = (float*)(F.ws + WS_PART);
    for (int m0 = gw; m0 < M; m0 += 2 * NGW) {
        f32x4 v[2][4];
#pragma unroll
        for (int r = 0; r < 2; ++r) { const int m = (m0 + r * NGW < M) ? m0 + r * NGW : m0; const GAS f32x4* xr = (const GAS f32x4*)(x + (size_t)m * DM) + F.lane;
#pragma unroll
            for (int j = 0; j < 4; ++j) v[r][j] = xr[64 * j]; }
#pragma unroll
        for (int r = 0; r < 2; ++r) { const int m = m0 + r * NGW;
            if (m < M) { float s = 0.f; GAS unsigned long long* o8 = (GAS unsigned long long*)(xb + (size_t)m * DM) + F.lane;
#pragma unroll
                for (int j = 0; j < 4; ++j) { const f32x4 w = v[r][j]; s += (w.x * w.x + w.y * w.y) + (w.z * w.z + w.w * w.w);
                    o8[64 * j] = (unsigned long long)pk2(w.x, w.y) | ((unsigned long long)pk2(w.z, w.w) << 32); }
                s = wave_sum(s);
                if (F.lane < 16) part[(size_t)m * 16 + F.lane] = (F.lane == 0) ? s : 0.f; } }
    }
}
__device__ __forceinline__ void p0_table(const Frame& F) {
    float* tab = (float*)(F.ws + WS_TAB);
    for (int i = F.vcu * NTHR + F.tid; i < SEQ * 32; i += F.G * NTHR) { const int t = i >> 5, f = i & 31; const float th = exp2f(-(float)f * (13.287712379549449f / 31.0f)); const float ang = (float)t * th; float s, c; sincosf(ang, &s, &c); tab[2 * i] = c; tab[2 * i + 1] = s; }
}

__device__ __forceinline__ void ret_kv_unit(const Frame& F, int unit) {
    unsigned dga_ = 0;
    DG_START(30, dg30_)
    LAS float* kr = (LAS float*)F.lds; LAS float* vv = kr + 128 * 64;
    const int tid = F.tid, c = unit & 15, h = (unit >> 4) & 3, b = unit >> 6, tok0 = b * SEQ + c * 128;
    const bf16* P = (const bf16*)(F.ws + WS_P); const float* tab = (const float*)(F.ws + WS_TAB);
    const float lg2 = log2f(1.0f - exp2f(-5.0f - (float)h));
    for (int idx = tid; idx < 128 * 32; idx += NTHR) { const int m = idx >> 5, i = idx & 31; const size_t ro = (size_t)(tok0 + m) * PP;
        const float k1 = bf2f(P[ro + PCK + h * 64 + i]), k2 = bf2f(P[ro + PCK + h * 64 + 32 + i]);
        const float cs = tab[((c * 128 + m) * 32 + i) * 2], sn = tab[((c * 128 + m) * 32 + i) * 2 + 1];
        const float sc = 0.125f * exp2f((float)(127 - m) * lg2);
        kr[m * 64 + i] = (k1 * cs - k2 * sn) * sc; kr[m * 64 + 32 + i] = (k1 * sn + k2 * cs) * sc;
        vv[m * 64 + i] = bf2f(P[ro + PCV + h * 64 + i]); vv[m * 64 + 32 + i] = bf2f(P[ro + PCV + h * 64 + 32 + i]); }
    __syncthreads();
    const int d = tid >> 3, e0 = (tid & 7) * 8; float acc[8];
#pragma unroll
    for (int e = 0; e < 8; ++e) acc[e] = 0.f;
    for (int m = 0; m < 128; ++m) { const float kd = kr[m * 64 + d];
#pragma unroll
        for (int e = 0; e < 8; ++e) acc[e] += kd * vv[m * 64 + e0 + e]; }
    float* KV = (float*)(F.ws + WS_KV) + (size_t)unit * 4096 + d * 64 + e0;
#pragma unroll
    for (int e = 0; e < 8; ++e) KV[e] = acc[e];
    __syncthreads();
    DG_STOP(30, dg30_, dga_)
    DG_WRITE(30, unit == 0 && F.wave == 0 && F.lane == 0, dga_)
}

typedef float f32x2 __attribute__((ext_vector_type(2)));
__device__ __forceinline__ float dpp_add16(float x) {
    x += __builtin_bit_cast(float, __builtin_amdgcn_mov_dpp(__builtin_bit_cast(int, x), 0xB1, 0xF, 0xF, true));
    x += __builtin_bit_cast(float, __builtin_amdgcn_mov_dpp(__builtin_bit_cast(int, x), 0x4E, 0xF, 0xF, true));
    x += __builtin_bit_cast(float, __builtin_amdgcn_mov_dpp(__builtin_bit_cast(int, x), 0x141, 0xF, 0xF, true));
    x += __builtin_bit_cast(float, __builtin_amdgcn_mov_dpp(__builtin_bit_cast(int, x), 0x140, 0xF, 0xF, true));
    return x;
}
constexpr int CH = 32;
constexpr int RW_STG = 5 * CH * 64;
constexpr int RW_ROWS = 16;
struct RwOps { f32x4 r, d, k, q, b; float v; };
__device__ __forceinline__ void rw_ld(RwOps& o, const LAS float* base, const LAS float* vb, int s, int ks, int row) {
    const LAS f32x4* p = (const LAS f32x4*)(base + s * 64 + ks * 4);
    o.r = p[0]; o.d = p[CH * 16]; o.k = p[2 * CH * 16]; o.q = p[3 * CH * 16]; o.b = p[4 * CH * 16];
    o.v = vb[s * RW_ROWS + row];
}
#define LO2(x) __builtin_shufflevector(x, x, 0, 1)
#define HI2(x) __builtin_shufflevector(x, x, 2, 3)
__device__ __forceinline__ float rw_step1(f32x2 (&S)[2], const RwOps& o, float v) {
    f32x2 p2 = S[0] * LO2(o.q); p2 = S[1] * HI2(o.q) + p2;
    const float p = dpp_add16(p2.x + p2.y);
    const f32x2 pp = (f32x2){p, p}, vv = (f32x2){v, v};
    S[0] = S[0] - LO2(o.d) * S[0]; S[1] = S[1] - HI2(o.d) * S[1];
    S[0] = S[0] - pp * LO2(o.b); S[1] = S[1] - pp * HI2(o.b);
    S[0] = vv * LO2(o.k) + S[0]; S[1] = vv * HI2(o.k) + S[1];
    f32x2 y2 = S[0] * LO2(o.r); y2 = S[1] * HI2(o.r) + y2;
    return dpp_add16(y2.x + y2.y);
}
__device__ __forceinline__ void rwkv_scan_unit(const Frame& F, int l, int unit) {
    const int tid = F.tid, lane = F.lane, wave = F.wave, quarter = unit & 3, bh = unit >> 2, b = bh / 6, h = bh - b * 6, tokb = b * SEQ;
    LAS float* stg = (LAS float*)F.lds; LAS float* vst = stg + 2 * RW_STG; LAS float* ybuf = vst + 2 * CH * RW_ROWS;
    bf16* P = (bf16*)(F.ws + WS_P);
    constexpr int NCH = SEQ / CH;
    unsigned dga_ = 0;
    if (wave >= 4) {
        const int st = tid - 256;
        const int t01 = st >> 3, c01 = st & 7, tv = st >> 1, cv = st & 1;
        const bf16* a0 = (const bf16*)(F.ws + WS_R); const bf16* a1 = (const bf16*)(F.ws + WS_D); const bf16* a2 = (const bf16*)(F.ws + WS_K2); const bf16* a3 = (const bf16*)(F.ws + WS_KK);
        const bf16* a4 = (const bf16*)((const unsigned char*)F.out + OUT_BP); const bf16* a5 = (const bf16*)(F.ws + WS_VF);
        v4u sreg[6];
#define RW_LOAD(cc) do { const size_t o_ = (size_t)(tokb + (cc) * CH + t01) * AW + h * 64 + c01 * 8; sreg[0] = *(const GAS v4u*)(a0 + o_); sreg[1] = *(const GAS v4u*)(a1 + o_); sreg[2] = *(const GAS v4u*)(a2 + o_); \
            sreg[3] = *(const GAS v4u*)(a3 + o_); sreg[4] = *(const GAS v4u*)(a4 + o_); if (st < 64) sreg[5] = *(const GAS v4u*)(a5 + (size_t)(tokb + (cc) * CH + tv) * AW + h * 64 + quarter * RW_ROWS + cv * 8); } while (0)
#define RW_ST1(i, dstp) do { float f[8]; unpack8(sreg[i], f); LAS f32x4* dst = (LAS f32x4*)(dstp); dst[0] = (f32x4){f[0], f[1], f[2], f[3]}; dst[1] = (f32x4){f[4], f[5], f[6], f[7]}; } while (0)
#define RW_STORE(bufi) do { _Pragma("unroll") for (int i = 0; i < 5; ++i) RW_ST1(i, stg + (bufi) * RW_STG + i * CH * 64 + t01 * 64 + c01 * 8); if (st < 64) RW_ST1(5, vst + (bufi) * CH * RW_ROWS + tv * RW_ROWS + cv * 8); } while (0)
#define RW_OUT(cc) do { if (st < 128) { const LAS float* yb_ = ybuf + ((cc) & 1) * CH * RW_ROWS; const int s_ = st >> 2, r4_ = (st & 3) * 4; const f32x4 yv = *(const LAS f32x4*)(yb_ + s_ * RW_ROWS + r4_); \
            *(GAS unsigned long long*)(P + (size_t)(tokb + (cc) * CH + s_) * PP + h * 64 + quarter * RW_ROWS + r4_) = (unsigned long long)pk2(yv[0], yv[1]) | ((unsigned long long)pk2(yv[2], yv[3]) << 32); } } while (0)
        RW_LOAD(0); RW_STORE(0); RW_LOAD(1);
        __syncthreads();
        for (int cc = 0; cc < NCH; ++cc) {
            if (cc + 1 < NCH) RW_STORE((cc + 1) & 1);
            if (cc + 2 < NCH) RW_LOAD(cc + 2);
            if (cc > 0) RW_OUT(cc - 1);
            asm volatile("s_waitcnt lgkmcnt(0)" ::: "memory"); __builtin_amdgcn_s_barrier(); asm volatile("" ::: "memory");
        }
        RW_OUT(NCH - 1);
#undef RW_LOAD
#undef RW_ST1
#undef RW_STORE
#undef RW_OUT
        return;
    }
    const int row = 4 * wave + (lane >> 4), ks = lane & 15;
    f32x2 Sa[2] = {(f32x2){0.f, 0.f}, (f32x2){0.f, 0.f}};
    __syncthreads();
    for (int cc = 0; cc < NCH; ++cc) {
        const int bufi = cc & 1;
        const LAS float* base = stg + bufi * RW_STG; const LAS float* vb = vst + bufi * CH * RW_ROWS; LAS float* yb = ybuf + bufi * CH * RW_ROWS;
        RwOps A, B; float yk0 = 0.f;
        DG_START(40, dg40_)
        rw_ld(A, base, vb, 0, ks, row);
#pragma unroll
        for (int s = 0; s < CH; s += 2) {
            rw_ld(B, base, vb, s + 1, ks, row);
            { const float y0 = rw_step1(Sa, A, A.v); yk0 = (ks == (s & 15)) ? y0 : yk0; }
            if (s + 2 < CH) rw_ld(A, base, vb, s + 2, ks, row);
            { const float y0 = rw_step1(Sa, B, B.v); yk0 = (ks == ((s + 1) & 15)) ? y0 : yk0; }
            if (((s + 1) & 15) == 15) yb[(s - 14 + ks) * RW_ROWS + row] = yk0;
        }
        DG_STOP(40, dg40_, dga_)
        DG_START(43, dg43_)
        asm volatile("s_waitcnt lgkmcnt(0)" ::: "memory"); __builtin_amdgcn_s_barrier(); asm volatile("" ::: "memory");
        DG_STOP(43, dg43_, dga_)
    }
    DG_WRITE(40, unit == 0 && l == 0 && wave == 0 && lane == 0, dga_)
    DG_WRITE(43, unit == 0 && l == 0 && wave == 0 && lane == 0, dga_)
}
__device__ __forceinline__ void rwkv_post(const Frame& F, int l) {
    bf16* P = (bf16*)(F.ws + WS_P); const bf16* VF = (const bf16*)(F.ws + WS_VF); const bf16* Gg = (const bf16*)((const unsigned char*)F.out + OUT_G); const float* BON = (const float*)(F.ws + WS_BON);
    const int sub = F.tid >> 4, c4 = (F.tid & 15) * 4;
    for (int pr = F.vcu * 32 + sub; pr < M * 6; pr += F.G * 32) { const int tok = pr / 6, h = pr - tok * 6;
        const unsigned long long yw = *(const GAS unsigned long long*)(P + (size_t)tok * PP + h * 64 + c4), vw = *(const GAS unsigned long long*)(VF + (size_t)tok * AW + h * 64 + c4), gw = *(const GAS unsigned long long*)(Gg + (size_t)tok * AW + h * 64 + c4);
        const f32x4 lnw = *(const f32x4*)(F.in[I_LNW] + l * AW + h * 64 + c4), lnb = *(const f32x4*)(F.in[I_LNB] + l * AW + h * 64 + c4);
        const float bon = BON[(size_t)tok * 6 + h];
        const f32x4 yv = (f32x4){bflo((unsigned)yw), bfhi((unsigned)yw), bflo((unsigned)(yw >> 32)), bfhi((unsigned)(yw >> 32))};
        const f32x4 vv = (f32x4){bflo((unsigned)vw), bfhi((unsigned)vw), bflo((unsigned)(vw >> 32)), bfhi((unsigned)(vw >> 32))};
        const f32x4 gg = (f32x4){bflo((unsigned)gw), bfhi((unsigned)gw), bflo((unsigned)(gw >> 32)), bfhi((unsigned)(gw >> 32))};
        float sm = (yv[0] + yv[1]) + (yv[2] + yv[3]);
        sm += __shfl_xor(sm, 1); sm += __shfl_xor(sm, 2); sm += __shfl_xor(sm, 4); sm += __shfl_xor(sm, 8);
        const float mean = sm * (1.0f / 64.0f); const f32x4 dv = yv - mean;
        float vs = (dv[0] * dv[0] + dv[1] * dv[1]) + (dv[2] * dv[2] + dv[3] * dv[3]);
        vs += __shfl_xor(vs, 1); vs += __shfl_xor(vs, 2); vs += __shfl_xor(vs, 4); vs += __shfl_xor(vs, 8);
        const float rs = 1.0f / sqrtf(vs * (1.0f / 64.0f) + 64e-5f);
        const f32x4 o = (dv * rs * lnw + lnb + bon * vv) * gg;
        *(GAS unsigned long long*)(P + (size_t)tok * PP + h * 64 + c4) = (unsigned long long)pk2(o[0], o[1]) | ((unsigned long long)pk2(o[2], o[3]) << 32);
    }
}

typedef short bf16x8_t __attribute__((ext_vector_type(8)));
typedef short s16x4_t __attribute__((ext_vector_type(4)));
typedef float f32x16_t __attribute__((ext_vector_type(16)));
__device__ __forceinline__ unsigned fkey(float f) { const unsigned u = __float_as_uint(f); return (u & 0x80000000u) ? ~u : (u | 0x80000000u); }
__device__ __forceinline__ int crow32(int r, int hi) { return (r & 3) + 8 * (r >> 2) + 4 * hi; }
__device__ __forceinline__ unsigned off_a(unsigned row, unsigned ch) { return 2048u * (row >> 3) + 512u * (ch >> 2) + 64u * (row & 7) + 16u * ((ch & 3) ^ ((row >> 2) & 3)); }

__device__ __forceinline__ void idx_scores(const bf16x8_t (&Af)[2], const bf16x8_t (&Bf)[8][2], const float (&iwf)[8], float (&sc)[4]) {
    sc[0] = sc[1] = sc[2] = sc[3] = 0.f;
#pragma unroll
    for (int h = 0; h < 8; ++h) { f32x4 a = (f32x4){0.f, 0.f, 0.f, 0.f};
        a = __builtin_amdgcn_mfma_f32_16x16x32_bf16(Af[0], Bf[h][0], a, 0, 0, 0);
        a = __builtin_amdgcn_mfma_f32_16x16x32_bf16(Af[1], Bf[h][1], a, 0, 0, 0);
#pragma unroll
        for (int r = 0; r < 4; ++r) { const float av_ = a[r]; const int ai_ = __float_as_int(av_); const float rl = __int_as_float(ai_ > 0 ? ai_ : 0); sc[r] = fmaf(iwf[h], rl, sc[r]); } }
}
__device__ __forceinline__ void idx_load_q(const bf16* P, int tokq, bf16x8_t (&Bf)[8][2], float (&iwf)[8], int fq) {
    const bf16* row = P + (size_t)tokq * PP;
#pragma unroll
    for (int h = 0; h < 8; ++h)
#pragma unroll
        for (int ks = 0; ks < 2; ++ks) Bf[h][ks] = *(const GAS bf16x8_t*)(row + PBIQ + h * 64 + ks * 32 + fq * 8);
    const v4u w = *(const GAS v4u*)(row + PBIW); float f[8]; unpack8(w, f);
#pragma unroll
    for (int h = 0; h < 8; ++h) iwf[h] = f[h] * (0.35355339059327373f * 0.125f);
}

__device__ __forceinline__ void lds_barrier() { asm volatile("s_waitcnt lgkmcnt(0)" ::: "memory"); __builtin_amdgcn_s_barrier(); asm volatile("" ::: "memory"); }
constexpr int SKP = 2052;
__device__ __forceinline__ void dsa_thr_unit(const Frame& F, int l, int unit) {
    LAS unsigned* sk = (LAS unsigned*)F.lds;
    const int lane = F.lane, wave = F.wave, fr = lane & 15, fq = lane >> 4;
    const int b = unit & 7, qb = 127 - (unit >> 3), t0 = qb * 16, tok0 = b * SEQ + t0;
    const bf16* P = (const bf16*)(F.ws + WS_P);
    unsigned dga_ = 0;
    DG_START(10, dg10_)
    {
        bf16x8_t Bf[8][2]; float iwf[8];
        idx_load_q(P, tok0 + fr, Bf, iwf, fq);
        const bf16* KI = (const bf16*)((const unsigned char*)F.out + OUT_KI);
#define THR_KLOAD(dst, ktx) do { const int kc_ = (ktx) <= qb ? (ktx) : qb; const bf16* krow = KI + (size_t)(b * SEQ + kc_ * 16 + fr) * 64 + fq * 8; (dst)[0] = *(const GAS bf16x8_t*)(krow); (dst)[1] = *(const GAS bf16x8_t*)(krow + 32); } while (0)
#define THR_SCORE(Abuf, ktx) do { float sc[4]; idx_scores(Abuf, Bf, iwf, sc); v4u kv; const int s0 = (ktx) * 16 + 4 * fq, t = t0 + fr; \
            kv.x = (s0 + 0 <= t) ? fkey(sc[0]) : 0u; kv.y = (s0 + 1 <= t) ? fkey(sc[1]) : 0u; kv.z = (s0 + 2 <= t) ? fkey(sc[2]) : 0u; kv.w = (s0 + 3 <= t) ? fkey(sc[3]) : 0u; \
            if ((ktx) <= qb) *(LAS v4u*)(sk + fr * SKP + s0) = kv; } while (0)
        bf16x8_t A0[2], A1[2]; THR_KLOAD(A0, wave); THR_KLOAD(A1, wave + 8);
        for (int kt = wave; kt <= qb; kt += 16) {
            { bf16x8_t Ac[2] = {A0[0], A0[1]}; asm volatile("" : "+v"(Ac[0]), "+v"(Ac[1])); THR_KLOAD(A0, kt + 16); THR_SCORE(Ac, kt); }
            { bf16x8_t Ac[2] = {A1[0], A1[1]};
              asm volatile("" : "+v"(Ac[0]), "+v"(Ac[1])); THR_KLOAD(A1, kt + 24); THR_SCORE(Ac, kt + 8); }
        }
#undef THR_KLOAD
#undef THR_SCORE
    }
    __syncthreads();
    DG_STOP(10, dg10_, dga_)
    DG_WRITE(10, unit == 0 && wave == 0 && lane == 0, dga_)
    DG_START(11, dg11_)
    unsigned* THR = (unsigned*)(F.ws + WS_THR); int* SCUT = (int*)(F.ws + WS_SCUT);
    for (int qi = 0; qi < 2; ++qi) { const int q = 2 * wave + qi, t = t0 + q, n = t + 1;
        unsigned thr = 0u; int scut = SEQ - 1;
        if (n > TOPK) {
            unsigned keys[32];
#pragma unroll
            for (int i = 0; i < 32; ++i) keys[i] = (64 * i + lane <= t) ? sk[q * SKP + 64 * i + lane] : 0u;
            unsigned prefix = 0u; bool done = false;
            const int ng = (t >> 9) + 1;
            int sbit = 31;
            { unsigned m1 = 0u, m2 = 0u, m3 = 0u, m4 = 0u;
#pragma unroll
                for (int g = 0; g < 4; ++g) if (g < ng) {
#pragma unroll
                    for (int i = 8 * g; i < 8 * g + 8; ++i) { const unsigned x = keys[i]; const unsigned x1 = m1 < x ? m1 : x; m1 = m1 < x ? x : m1; const unsigned x2 = m2 < x1 ? m2 : x1; m2 = m2 < x1 ? x1 : m2;
                        const unsigned x3 = m3 < x2 ? m3 : x2; m3 = m3 < x2 ? x2 : m3; m4 = m4 < x3 ? x3 : m4; } }
                unsigned lo_ = m4, hi_ = m4;
#pragma unroll
                for (int o = 32; o > 0; o >>= 1) { const unsigned a_ = (unsigned)__shfl_xor((int)lo_, o), b_ = (unsigned)__shfl_xor((int)hi_, o); lo_ = a_ < lo_ ? a_ : lo_; hi_ = b_ > hi_ ? b_ : hi_; }
                lo_ = (unsigned)__builtin_amdgcn_readfirstlane((int)lo_); hi_ = (unsigned)__builtin_amdgcn_readfirstlane((int)hi_);
                const unsigned df = lo_ ^ hi_;
                sbit = df ? 31 - __builtin_clz(df) : -1;
                prefix = (sbit >= 31) ? 0u : (sbit < 0 ? lo_ : (lo_ & ~((2u << sbit) - 1u))); }
            for (int bit = sbit; bit >= 0; --bit) { const unsigned cand = prefix | (1u << bit); int cnt = 0;
#pragma unroll
                for (int g = 0; g < 4; ++g) if (g < ng) {
#pragma unroll
                    for (int i = 8 * g; i < 8 * g + 8; ++i) cnt += __popcll(__ballot(keys[i] >= cand)); }
                if (cnt >= TOPK) prefix = cand;
                if (cnt == TOPK) { thr = cand - 1u; scut = -1; done = true; break; } }
            if (!done) {
                int cgt = 0;
#pragma unroll
                for (int i = 0; i < 32; ++i) cgt += __popcll(__ballot(keys[i] > prefix));
                int need = TOPK - cgt, run = 0; thr = prefix; scut = SEQ - 1; bool found = false;
#pragma unroll
                for (int i = 0; i < 32; ++i) { unsigned long long mk = __ballot(keys[i] == prefix); const int c = __popcll(mk);
                    if (!found && run + c >= need) { int k = need - run; while (k > 1) { mk &= mk - 1ull; --k; } scut = 64 * i + (int)__builtin_ctzll(mk); found = true; }
                    run += c; }
            }
        }
        {
            unsigned* MK = (unsigned*)((unsigned char*)F.out + OUT_MASK) + (size_t)(tok0 + q) * 64;
            if (n > TOPK) {
#pragma unroll
                for (int i = 0; i < 32; ++i) { const int s = 64 * i + lane; const unsigned key = (s <= t) ? sk[q * SKP + s] : 0u;
                    const unsigned long long bal = __ballot((s <= t) & ((key > thr) | ((key == thr) & (s <= scut))));
                    if (lane < 2 && 64 * i <= t) __hip_atomic_store(MK + 2 * i + lane, lane ? (unsigned)(bal >> 32) : (unsigned)bal, RLX_AGENT); }
            } else {
                if (lane < 8) { const int w0 = lane; __hip_atomic_store(MK + w0, (32 * w0 + 31 <= t) ? 0xffffffffu : ((32 * w0 <= t) ? ((1u << ((t & 31) + 1)) - 1u) : 0u), RLX_AGENT); }
            }
        }
    }
    DG_STOP(11, dg11_, dga_)
    DG_WRITE(11, unit == 0 && wave == 0 && lane == 0, dga_)
    __syncthreads();
    if (F.tid == 0) {
        asm volatile("s_waitcnt vmcnt(0)" ::: "memory");
        __hip_atomic_fetch_add((unsigned*)(F.ws + WS_CTL) + CW_THRD + l * 512 + 8 * (unit >> 4) + (unit & 7), 1u, RLX_AGENT); }
}

constexpr int QLP = 136;
constexpr int MKP = 36;
constexpr int DA_MW = 81920;
constexpr int DA_MASK = 0, DA_QL = 2 * 32 * MKP * 4, DA_CT = DA_QL + 6 * 32 * QLP * 2;
__device__ __forceinline__ void dsa_attn_unit(const Frame& F, int l, int unit) {
    const int tid = F.tid, lane = F.lane, wave = F.wave, r32 = lane & 31, hi = lane >> 5;
    const int b = unit & 7, qb = 63 - (unit >> 3), t0 = qb * 32, tok0 = b * SEQ + t0, ntile = qb + 1;
    {
        if (tid == 0) { const unsigned* dn = (const unsigned*)(F.ws + WS_CTL) + CW_THRD + l * 512 + unit;
            while (__hip_atomic_load(dn, RLX_AGENT) < 2u) __builtin_amdgcn_s_sleep(8); }
        __syncthreads(); }
    bf16* P = (bf16*)(F.ws + WS_P); const bf16* C = (const bf16*)(F.ws + WS_C);
    LAS float* MASK = (LAS float*)(F.lds + DA_MASK); LAS unsigned char* QLb = F.lds + DA_QL; LAS unsigned char* CT = F.lds + DA_CT;
    const int crow_ = tid >> 4, cch = tid & 15; const unsigned cdst = off_a((unsigned)crow_, (unsigned)cch);
    const bf16* csrc = C + (size_t)(b * SEQ + crow_) * 128 + cch * 8;
    v4u cpre = *(const GAS v4u*)(csrc);
    if (wave >= 6) {
        const int fr = lane & 15, fq = lane >> 4, qh = wave - 6;
        const int tq = tok0 + 16 * qh + fr, tq_t = t0 + 16 * qh + fr, jmax = tq_t >> 5;
        const unsigned* MK = (const unsigned*)((const unsigned char*)F.out + OUT_MASK) + (size_t)tq * 64;
        LAS float* mrow = MASK + (16 * qh + fr) * MKP + 8 * fq;
#define DA_EXPAND(word, slot) do { const unsigned w_ = (word) >> (8 * fq); f32x4 m0_, m1_; \
            m0_[0] = (w_ & 1u) ? 0.f : -1e30f; m0_[1] = (w_ & 2u) ? 0.f : -1e30f; m0_[2] = (w_ & 4u) ? 0.f : -1e30f; m0_[3] = (w_ & 8u) ? 0.f : -1e30f; \
            m1_[0] = (w_ & 16u) ? 0.f : -1e30f; m1_[1] = (w_ & 32u) ? 0.f : -1e30f; m1_[2] = (w_ & 64u) ? 0.f : -1e30f; m1_[3] = (w_ & 128u) ? 0.f : -1e30f; \
            *(LAS f32x4*)(mrow + (slot) * (32 * MKP)) = m0_; *(LAS f32x4*)(mrow + (slot) * (32 * MKP) + 4) = m1_; } while (0)
        LAS unsigned* MW = (LAS unsigned*)(F.lds + DA_MW) + (16 * qh + fr) * 64;
        { unsigned wl[16];
#pragma unroll
            for (int k = 0; k < 16; ++k) wl[k] = (16 * fq + k <= jmax) ? __hip_atomic_load(MK + 16 * fq + k, RLX_AGENT) : 0u;
#pragma unroll
            for (int k = 0; k < 4; ++k) *(LAS v4u*)(MW + 16 * fq + 4 * k) = (v4u){wl[4 * k], wl[4 * k + 1], wl[4 * k + 2], wl[4 * k + 3]}; }
        asm volatile("s_waitcnt lgkmcnt(0)" ::: "memory");
        DA_EXPAND(MW[0], 0);
        *(LAS v4u*)(CT + cdst) = cpre;
        lds_barrier();
        for (int j = 0; j < ntile; ++j) {
            if (j + 1 < ntile) {
                cpre = *(const GAS v4u*)(csrc + (size_t)(j + 1) * 32 * 128);
                { const unsigned w1 = MW[j + 1]; DA_EXPAND(w1, (j + 1) & 1); }
                *(LAS v4u*)(CT + ((j + 1) & 1) * 8192 + cdst) = cpre; }
            lds_barrier();
        }
#undef DA_EXPAND
        lds_barrier();
        return;
    }
    const int h = wave;
    LAS unsigned char* QLh = QLb + h * (32 * QLP * 2);
    float negb;
    {
        unsigned zo_ = 0u; asm volatile("" : "+v"(zo_));
        const bf16* wukT = (const bf16*)(F.ws + WS_WUKT) + (size_t)(l * 6 + h) * 128 * 64 + zo_;
        bf16x8_t qf[4]; float ssq = 0.f;
#pragma unroll
        for (int ks = 0; ks < 4; ++ks) qf[ks] = *(const GAS bf16x8_t*)(P + (size_t)(tok0 + r32) * PP + PBQ + h * 64 + ks * 16 + hi * 8);
#pragma unroll
        for (int blk = 0; blk < 4; ++blk) { f32x16_t x;
#pragma unroll
            for (int i = 0; i < 16; ++i) x[i] = 0.f;
#pragma unroll
            for (int ks = 0; ks < 4; ++ks) { const bf16x8_t a = *(const GAS bf16x8_t*)(wukT + (size_t)(blk * 32 + r32) * 64 + ks * 16 + hi * 8); x = __builtin_amdgcn_mfma_f32_32x32x16_bf16(a, qf[ks], x, 0, 0, 0); }
#pragma unroll
            for (int g = 0; g < 4; ++g) { const float sc = 0.125f * 1.4426950408889634f;
                const float x0 = x[4 * g] * sc, x1 = x[4 * g + 1] * sc, x2 = x[4 * g + 2] * sc, x3 = x[4 * g + 3] * sc; ssq += (x0 * x0 + x1 * x1) + (x2 * x2 + x3 * x3);
                const unsigned long long w = (unsigned long long)pk2(x0, x1) | ((unsigned long long)pk2(x2, x3) << 32);
                *(LAS unsigned long long*)(QLh + (r32 * QLP + blk * 32 + 8 * g + 4 * hi) * 2) = w; } }
        ssq += __shfl_xor(ssq, 32);
        const float* kvn = F.in[I_KVN] + l * 128; float gm = fmaxf(fabsf(kvn[2 * lane]), fabsf(kvn[2 * lane + 1]));
#pragma unroll
        for (int o_ = 1; o_ < 64; o_ <<= 1) gm = fmaxf(gm, __shfl_xor(gm, o_));
        negb = -(sqrtf(ssq) * 11.32f * gm * 1.01f + 0.01f);
    }
    *(LAS v4u*)(CT + cdst) = cpre;
    lds_barrier();
    f32x16_t o[4]; float l_run = 0.f;
    const LAS unsigned char* qlrow = QLh + (r32 * QLP + 8 * hi) * 2;
#pragma unroll
    for (int c = 0; c < 4; ++c)
#pragma unroll
        for (int i = 0; i < 16; ++i) o[c][i] = 0.f;
    const unsigned rr_ = ((unsigned)r32 >> 2) & 3u, rb_ = 2048u * ((unsigned)r32 >> 3) + 64u * ((unsigned)r32 & 7u);
    const unsigned rbase0 = rb_ + 16u * ((unsigned)hi ^ rr_), rbase1 = rb_ + 16u * ((2u + (unsigned)hi) ^ rr_);
    const unsigned blk_ = (lane >> 4) & 1, q_ = (lane & 15) >> 2, p_ = lane & 3;
    unsigned dga_ = 0;
    v4u bqf[8];
#pragma unroll
    for (int s = 0; s < 8; ++s) { bqf[s] = *(const LAS v4u*)(qlrow + 32 * s); asm volatile("" : "+v"(bqf[s])); }
    for (int j = 0; j < ntile; ++j) {
        DG_START(0, dgt_)
        LAS unsigned char* kb = CT + (j & 1) * 8192;
        if (j + 1 < ntile) cpre = *(const GAS v4u*)(csrc + (size_t)(j + 1) * 32 * 128);
        {
            f32x16_t S;
#pragma unroll
            for (int i = 0; i < 16; ++i) S[i] = negb;
            bf16x8_t ka[8];
#pragma unroll
            for (int s = 0; s < 8; ++s) ka[s] = *(const LAS bf16x8_t*)(kb + ((s & 1) ? rbase1 : rbase0) + 512 * (s >> 1));
#pragma unroll
            for (int s = 0; s < 8; ++s) S = __builtin_amdgcn_mfma_f32_32x32x16_bf16(ka[s], __builtin_bit_cast(bf16x8_t, bqf[s]), S, 0, 0, 0);
            const LAS f32x4* mk = (const LAS f32x4*)(MASK + (j & 1) * (32 * MKP) + r32 * MKP + 4 * hi);
            float psum = 0.f; float e[16];
#pragma unroll
            for (int g = 0; g < 4; ++g) { const f32x4 mv = mk[2 * g];
#pragma unroll
                for (int e4 = 0; e4 < 4; ++e4) { e[4 * g + e4] = __builtin_amdgcn_exp2f(S[4 * g + e4] + mv[e4]); psum += e[4 * g + e4]; } }
            l_run += psum;
            bf16x8_t xs[2];
#pragma unroll
            for (int s = 0; s < 2; ++s) { v4u w; w.x = pk2(e[8 * s], e[8 * s + 1]); w.y = pk2(e[8 * s + 2], e[8 * s + 3]); w.z = pk2(e[8 * s + 4], e[8 * s + 5]); w.w = pk2(e[8 * s + 6], e[8 * s + 7]); xs[s] = __builtin_bit_cast(bf16x8_t, w); }
            bf16x8_t pa[4][2];
#pragma unroll
            for (int c = 0; c < 4; ++c)
#pragma unroll
                for (int s = 0; s < 2; ++s) {
                    const unsigned a0 = off_a((unsigned)(16 * s + 4 * hi + q_), (unsigned)(4 * c + 2 * blk_ + (p_ >> 1))) + 8u * (p_ & 1);
                    const unsigned a1 = off_a((unsigned)(16 * s + 8 + 4 * hi + q_), (unsigned)(4 * c + 2 * blk_ + (p_ >> 1))) + 8u * (p_ & 1);
                    const s16x4_t lo = __builtin_bit_cast(s16x4_t, __builtin_amdgcn_ds_read_tr16_b64_v4i16((LAS s16x4_t*)(kb + a0)));
                    const s16x4_t hh = __builtin_bit_cast(s16x4_t, __builtin_amdgcn_ds_read_tr16_b64_v4i16((LAS s16x4_t*)(kb + a1)));
                    pa[c][s] = (bf16x8_t){lo[0], lo[1], lo[2], lo[3], hh[0], hh[1], hh[2], hh[3]}; }
#pragma unroll
            for (int c = 0; c < 4; ++c)
#pragma unroll
                for (int s = 0; s < 2; ++s) o[c] = __builtin_amdgcn_mfma_f32_32x32x16_bf16(pa[c][s], xs[s], o[c], 0, 0, 0);
        }
        if (j + 1 < ntile) *(LAS v4u*)(CT + ((j + 1) & 1) * 8192 + cdst) = cpre;
        DG_STOP(0, dgt_, dga_)
        lds_barrier();
    }
    DG_WRITE(0, unit == 0 && l == 0 && wave == 0 && lane == 0, dga_)
    {
        const float lt = l_run + __shfl_xor(l_run, 32); const float inv = 1.0f / lt;
#pragma unroll
        for (int c = 0; c < 4; ++c)
#pragma unroll
            for (int g = 0; g < 4; ++g) { const unsigned long long w = (unsigned long long)pk2(o[c][4 * g] * inv, o[c][4 * g + 1] * inv) | ((unsigned long long)pk2(o[c][4 * g + 2] * inv, o[c][4 * g + 3] * inv) << 32);
                *(LAS unsigned long long*)(QLh + (r32 * QLP + c * 32 + 8 * g + 4 * hi) * 2) = w; }
        unsigned zo2_ = 0u; asm volatile("" : "+v"(zo2_));
        const bf16* wuvT = (const bf16*)(F.ws + WS_WUVT) + (size_t)(l * 6 + h) * 64 * 128 + zo2_;
        bf16x8_t Bo[8];
#pragma unroll
        for (int s = 0; s < 8; ++s) Bo[s] = *(const LAS bf16x8_t*)(QLh + (r32 * QLP + 16 * s + 8 * hi) * 2);
#pragma unroll
        for (int mb = 0; mb < 2; ++mb) { f32x16_t y;
#pragma unroll
            for (int i = 0; i < 16; ++i) y[i] = 0.f;
#pragma unroll
            for (int s = 0; s < 8; ++s) { const bf16x8_t a = *(const GAS bf16x8_t*)(wuvT + (size_t)(mb * 32 + r32) * 128 + 16 * s + 8 * hi); y = __builtin_amdgcn_mfma_f32_32x32x16_bf16(a, Bo[s], y, 0, 0, 0); }
#pragma unroll
            for (int g = 0; g < 4; ++g) { const unsigned long long w = (unsigned long long)pk2(y[4 * g], y[4 * g + 1]) | ((unsigned long long)pk2(y[4 * g + 2], y[4 * g + 3]) << 32);
                *(GAS unsigned long long*)(P + (size_t)(tok0 + r32) * PP + 384 + h * 64 + mb * 32 + 8 * g + 4 * hi) = w; } }
    }
    lds_barrier();
}
constexpr int RC = 32;
constexpr int P64 = 72, P32 = 40, PTS = 36;
constexpr int RPW = 72, RAWSZ = 32 * RPW, GP = 68;
constexpr int RK_RAW = 0;
constexpr int RK_GAM = RK_RAW + 6 * RAWSZ * 2;
constexpr int RK_AL = RK_GAM + 33 * GP * 4, RK_RH = RK_AL + 32 * P64 * 2, RK_BE = RK_RH + 32 * P64 * 2, RK_KA = RK_BE + 32 * P64 * 2;
constexpr int RK_BET = RK_KA + 32 * P64 * 2, RK_KAT = RK_BET + 64 * P32 * 2, RK_VT = RK_KAT + 64 * P32 * 2;
constexpr int RK_NT = RK_VT + 64 * P32 * 2, RK_BRT = RK_NT + 32 * P32 * 2, RK_KRT = RK_BRT + 32 * P32 * 2;
constexpr int RK_ZB = RK_KRT + 32 * P32 * 2;
constexpr int RK_XB = RK_ZB + 2 * 64 * P64 * 2;
constexpr int RK_EB = RK_XB + 64 * P32 * 2;
constexpr int RK_BRT2 = RK_EB + 64 * P32 * 2, RK_BET2 = RK_BRT2 + 32 * P32 * 2, RK_GC = RK_BET2 + 64 * P32 * 2;
constexpr int RK_LN = RK_GC + 512;
constexpr int RK_END = RK_LN + 512;
static_assert(RK_END <= RING_BYTES, "chunked RWKV unit: LDS");
template <int KS> __device__ __forceinline__ void mm_ld(bf16x8_t (&a)[KS], bf16x8_t (&b)[KS], const LAS bf16* X, int px, const LAS bf16* Y, int py, int r32, int hi) {
#pragma unroll
    for (int s = 0; s < KS; ++s) { a[s] = *(const LAS bf16x8_t*)(X + r32 * px + 16 * s + 8 * hi); b[s] = *(const LAS bf16x8_t*)(Y + r32 * py + 16 * s + 8 * hi); }
}
template <int KS> __device__ __forceinline__ void mm_do(f32x16_t& acc, const bf16x8_t (&a)[KS], const bf16x8_t (&b)[KS]) {
#pragma unroll
    for (int s = 0; s < KS; ++s) acc = __builtin_amdgcn_mfma_f32_32x32x16_bf16(a[s], b[s], acc, 0, 0, 0);
}
__device__ __forceinline__ bf16x8_t acc_frag(const f32x16_t& a, int s) { v4u w; w.x = pk2(a[8 * s], a[8 * s + 1]); w.y = pk2(a[8 * s + 2], a[8 * s + 3]); w.z = pk2(a[8 * s + 4], a[8 * s + 5]); w.w = pk2(a[8 * s + 6], a[8 * s + 7]); return __builtin_bit_cast(bf16x8_t, w); }
__device__ __forceinline__ void mm_acc(f32x16_t& d, const f32x16_t& at, const f32x16_t& b) {
    d = __builtin_amdgcn_mfma_f32_32x32x16_bf16(acc_frag(at, 0), acc_frag(b, 0), d, 0, 0, 0); d = __builtin_amdgcn_mfma_f32_32x32x16_bf16(acc_frag(at, 1), acc_frag(b, 1), d, 0, 0, 0);
}
template <int KS> __device__ __forceinline__ void mm_abt(f32x16_t& acc, const LAS bf16* X, int px, const LAS bf16* Y, int py, int r32, int hi) {
    bf16x8_t a[KS], b[KS]; mm_ld<KS>(a, b, X, px, Y, py, r32, hi); mm_do<KS>(acc, a, b);
}
template <int K1, int K2> __device__ __forceinline__ void mm_abt2(f32x16_t& acc, const LAS bf16* X1, int px1, const LAS bf16* Y1, int py1, const LAS bf16* X2, int px2, const LAS bf16* Y2, int py2, int r32, int hi) {
    bf16x8_t a1[K1], b1[K1], a2[K2], b2[K2]; mm_ld<K1>(a1, b1, X1, px1, Y1, py1, r32, hi); mm_ld<K2>(a2, b2, X2, px2, Y2, py2, r32, hi); mm_do<K1>(acc, a1, b1); mm_do<K2>(acc, a2, b2);
}
__device__ __forceinline__ void rwkv_chunk_unit(const Frame& F, int l, int unit) {
    const int tid = F.tid, lane = F.lane, wave = F.wave, r32 = lane & 31, hi = lane >> 5;
    const int b = unit / 6, h = unit - b * 6, tokb = b * SEQ;
    LAS bf16* RAW = (LAS bf16*)(F.lds + RK_RAW); LAS float* GAM = (LAS float*)(F.lds + RK_GAM);
    LAS bf16* AL = (LAS bf16*)(F.lds + RK_AL); LAS bf16* RH = (LAS bf16*)(F.lds + RK_RH); LAS bf16* BE = (LAS bf16*)(F.lds + RK_BE); LAS bf16* KA = (LAS bf16*)(F.lds + RK_KA);
    LAS bf16* KAT = (LAS bf16*)(F.lds + RK_KAT); LAS bf16* VT = (LAS bf16*)(F.lds + RK_VT);
    LAS bf16* NT = (LAS bf16*)(F.lds + RK_NT); LAS bf16* KRT = (LAS bf16*)(F.lds + RK_KRT);
    LAS bf16* ZB = (LAS bf16*)(F.lds + RK_ZB); LAS bf16* XB = (LAS bf16*)(F.lds + RK_XB); LAS bf16* EB = (LAS bf16*)(F.lds + RK_EB);
    LAS float* GC = (LAS float*)(F.lds + RK_GC); LAS float* LNP = (LAS float*)(F.lds + RK_LN);
    const bf16* VFg = (const bf16*)(F.ws + WS_VF); const bf16* Gg = (const bf16*)((const unsigned char*)F.out + OUT_G); const float* BONg = (const float*)(F.ws + WS_BON);
    bf16* P = (bf16*)(F.ws + WS_P);
    constexpr int NCH = SEQ / RC;
    const int half = tid >> 8, idx = tid & 255, lt = idx >> 3, lc = idx & 7;
    const bf16* s0 = (const bf16*)(F.ws + (half ? WS_KK : WS_R)); const bf16* s1 = half ? (const bf16*)((const unsigned char*)F.out + OUT_BP) : (const bf16*)(F.ws + WS_D); const bf16* s2 = (const bf16*)(F.ws + (half ? WS_VF : WS_K2));
    v4u pre[3];
#define RK_LOAD(cc) do { const size_t o_ = (size_t)(tokb + (cc) * RC + lt) * AW + h * 64 + lc * 8; pre[0] = *(const GAS v4u*)(s0 + o_); pre[1] = *(const GAS v4u*)(s1 + o_); pre[2] = *(const GAS v4u*)(s2 + o_); } while (0)
#define RK_H1() do { _Pragma("unroll") for (int j = 0; j < 3; ++j) *(LAS v4u*)(RAW + (3 * half + j) * RAWSZ + lt * RPW + lc * 8) = pre[j]; } while (0)
#define RK_H2(cn) do { if (wave >= 4) { const int seg = wave - 4; float w_[8]; _Pragma("unroll") for (int j = 0; j < 8; ++j) w_[j] = 1.0f - __builtin_bit_cast(float, (unsigned)RAW[RAWSZ + (8 * seg + j) * RPW + lane] << 16); \
        float g = 1.f; _Pragma("unroll") for (int j = 0; j < 8; ++j) { g *= w_[j]; GAM[(8 * seg + j + 1) * GP + lane] = g; } } } while (0)
#define RK_H3(cn) do { LAS bf16* BETn = (LAS bf16*)(F.lds + (((cn) & 1) ? RK_BET2 : RK_BET)); \
        { \
            for (int it = tid - 64; it >= 0 && it < 512; it += 448) { const int t = it & 31, k4 = (it >> 5) * 4;        \
                        \
                const f32x4 l1_ = *(const LAS f32x4*)(GAM + (t + 1) * GP + k4), l0_ = *(const LAS f32x4*)(GAM + t * GP + k4); \
                const f32x4 t8_ = *(const LAS f32x4*)(GAM + 8 * GP + k4), t16_ = *(const LAS f32x4*)(GAM + 16 * GP + k4), t24_ = *(const LAS f32x4*)(GAM + 24 * GP + k4), p2_ = t8_ * t16_, p3_ = p2_ * t24_; \
                const int s1_ = t >> 3, s0_ = (t - 1) >> 3;        \
                const f32x4 g1 = (s1_ == 0) ? l1_ : (s1_ == 1) ? t8_ * l1_ : (s1_ == 2) ? p2_ * l1_ : p3_ * l1_; \
                const f32x4 g0 = (t == 0 || s0_ == 0) ? l0_ : (s0_ == 1) ? t8_ * l0_ : (s0_ == 2) ? p2_ * l0_ : p3_ * l0_; \
                if (t == RC - 1) *(LAS f32x4*)(GC + ((cn) & 1) * 64 + k4) = g1;        \
                const unsigned long long rw = *(const LAS unsigned long long*)(RAW + 0 * RAWSZ + t * RPW + k4), kw = *(const LAS unsigned long long*)(RAW + 2 * RAWSZ + t * RPW + k4); \
                const unsigned long long qw = *(const LAS unsigned long long*)(RAW + 3 * RAWSZ + t * RPW + k4), bw = *(const LAS unsigned long long*)(RAW + 4 * RAWSZ + t * RPW + k4); \
                const f32x4 rv = (f32x4){bflo((unsigned)rw), bfhi((unsigned)rw), bflo((unsigned)(rw >> 32)), bfhi((unsigned)(rw >> 32))}, kv = (f32x4){bflo((unsigned)kw), bfhi((unsigned)kw), bflo((unsigned)(kw >> 32)), bfhi((unsigned)(kw >> 32))}; \
                const f32x4 qv = (f32x4){bflo((unsigned)qw), bfhi((unsigned)qw), bflo((unsigned)(qw >> 32)), bfhi((unsigned)(qw >> 32))}, bv = (f32x4){bflo((unsigned)bw), bfhi((unsigned)bw), bflo((unsigned)(bw >> 32)), bfhi((unsigned)(bw >> 32))}; \
                const f32x4 rg = (f32x4){__builtin_amdgcn_rcpf(g1[0]), __builtin_amdgcn_rcpf(g1[1]), __builtin_amdgcn_rcpf(g1[2]), __builtin_amdgcn_rcpf(g1[3])}; \
                const f32x4 al = -(qv * g0), rh = rv * g1, be = bv * rg, ka = kv * rg; \
                const unsigned be0 = pk2(be[0], be[1]), be1 = pk2(be[2], be[3]), ka0 = pk2(ka[0], ka[1]), ka1 = pk2(ka[2], ka[3]); \
                *(LAS unsigned long long*)(AL + t * P64 + k4) = (unsigned long long)pk2(al[0], al[1]) | ((unsigned long long)pk2(al[2], al[3]) << 32); \
                *(LAS unsigned long long*)(RH + t * P64 + k4) = (unsigned long long)pk2(rh[0], rh[1]) | ((unsigned long long)pk2(rh[2], rh[3]) << 32); \
                *(LAS unsigned long long*)(BE + t * P64 + k4) = (unsigned long long)be0 | ((unsigned long long)be1 << 32); \
                *(LAS unsigned long long*)(KA + t * P64 + k4) = (unsigned long long)ka0 | ((unsigned long long)ka1 << 32); \
                BETn[(k4 + 0) * P32 + t] = (bf16)(be0 & 0xffffu); BETn[(k4 + 1) * P32 + t] = (bf16)(be0 >> 16); BETn[(k4 + 2) * P32 + t] = (bf16)(be1 & 0xffffu); BETn[(k4 + 3) * P32 + t] = (bf16)(be1 >> 16); \
                KAT[(k4 + 0) * P32 + t] = (bf16)(ka0 & 0xffffu); KAT[(k4 + 1) * P32 + t] = (bf16)(ka0 >> 16); KAT[(k4 + 2) * P32 + t] = (bf16)(ka1 & 0xffffu); KAT[(k4 + 3) * P32 + t] = (bf16)(ka1 >> 16); } \
            if (tid >= 256) { const int ix = tid - 256, i = ix & 31, v8 = (ix >> 5) * 8; const v4u w = *(const LAS v4u*)(RAW + 5 * RAWSZ + i * RPW + v8); \
                VT[(v8 + 0) * P32 + i] = (bf16)(w.x & 0xffffu); VT[(v8 + 1) * P32 + i] = (bf16)(w.x >> 16); VT[(v8 + 2) * P32 + i] = (bf16)(w.y & 0xffffu); VT[(v8 + 3) * P32 + i] = (bf16)(w.y >> 16); \
                VT[(v8 + 4) * P32 + i] = (bf16)(w.z & 0xffffu); VT[(v8 + 5) * P32 + i] = (bf16)(w.z >> 16); VT[(v8 + 6) * P32 + i] = (bf16)(w.w & 0xffffu); VT[(v8 + 7) * P32 + i] = (bf16)(w.w >> 16); } } } while (0)
#define RK_ST_ROWS(O, acc_) do { _Pragma("unroll") for (int r = 0; r < 16; ++r) (O)[crow32(r, hi) * P32 + r32] = (bf16)(pk2((acc_)[r], 0.f) & 0xffffu); } while (0)
#define RK_ST_COLS(O, acc_) do { _Pragma("unroll") for (int g = 0; g < 4; ++g) *(LAS unsigned long long*)((O) + r32 * P32 + 8 * g + 4 * hi) = (unsigned long long)pk2((acc_)[4 * g], (acc_)[4 * g + 1]) | ((unsigned long long)pk2((acc_)[4 * g + 2], (acc_)[4 * g + 3]) << 32); } while (0)
#define RK_CH_RND() do { f32x16_t pn, ptn; _Pragma("unroll") for (int i = 0; i < 16; ++i) { pn[i] = 0.f; ptn[i] = 0.f; } \
        mm_acc(pn, cpt, cp); mm_acc(ptn, cp, cpt); cp = pn; cpt = ptn; \
        f32x16_t mn = cm, mtn = cmt; mm_acc(mn, cmt, cp); mm_acc(mtn, cp, cmt); cm = mn; cmt = mtn; } while (0)
#define RK_CH_A() do { bf16x8_t fa[4], fb[4]; mm_ld<4>(fa, fb, BE, P64, AL, P64, r32, hi); \
        _Pragma("unroll") for (int i = 0; i < 16; ++i) { cp[i] = 0.f; cpt[i] = 0.f; } \
        mm_do<4>(cp, fa, fb); mm_do<4>(cpt, fb, fa);                                     \
        _Pragma("unroll") for (int r = 0; r < 16; ++r) { const int m_ = crow32(r, hi); cp[r] = (m_ < r32) ? cp[r] : 0.f; cpt[r] = (r32 < m_) ? cpt[r] : 0.f; const float id_ = (m_ == r32) ? 1.0f : 0.f; cm[r] = cp[r] + id_; cmt[r] = cpt[r] + id_; } \
        RK_CH_RND(); } while (0)
#define RK_CH_B() do { RK_CH_RND(); RK_CH_RND(); } while (0)
#define RK_H4(cn) do { if (wave == 0) RK_CH_A(); \
        else if (wave < 3) { LAS bf16* BRTn = (LAS bf16*)(F.lds + (((cn) & 1) ? RK_BRT2 : RK_BRT)); f32x16_t acc; \
        _Pragma("unroll") for (int i = 0; i < 16; ++i) acc[i] = 0.f; \
        if (wave == 1) { f32x16_t ac2; _Pragma("unroll") for (int i = 0; i < 16; ++i) ac2[i] = 0.f; \
            mm_abt<4>(acc, AL, P64, KA, P64, r32, hi); mm_abt<4>(ac2, RH, P64, KA, P64, r32, hi); \
            _Pragma("unroll") for (int r = 0; r < 16; ++r) { acc[r] = (r32 < crow32(r, hi)) ? acc[r] : 0.f; ac2[r] = (r32 <= crow32(r, hi)) ? ac2[r] : 0.f; } \
            RK_ST_ROWS(NT, acc); RK_ST_ROWS(KRT, ac2); } \
        else { mm_abt<4>(acc, RH, P64, BE, P64, r32, hi); \
            _Pragma("unroll") for (int r = 0; r < 16; ++r) acc[r] = (r32 <= crow32(r, hi)) ? acc[r] : 0.f; \
            RK_ST_ROWS(BRTn, acc); } } } while (0)
    RK_LOAD(0);
    for (int u = tid; u < 64 * P64 / 2; u += NTHR) ((LAS unsigned*)ZB)[u] = 0u;
    if (tid < 64) GAM[tid] = 1.f;
    if (tid >= 64 && tid < 192) { const int e_ = tid - 64; LNP[e_] = (e_ < 64 ? F.in[I_LNW] : F.in[I_LNB])[l * AW + h * 64 + (e_ & 63)]; }
    f32x16_t rg0, rg1, rg2, rg3;
#define cp rg0
#define cpt rg1
#define cm rg2
#define cmt rg3
#define zacc rg0
#define yacc0 rg0
#define yacc1 rg1
#pragma unroll
    for (int i = 0; i < 16; ++i) { rg0[i] = 0.f; rg1[i] = 0.f; rg2[i] = 0.f; rg3[i] = 0.f; }
#define RK_RELANE() int ln_ = F.lane, td_ = F.tid; asm volatile("" : "+v"(ln_), "+v"(td_)); const int lane = ln_, tid = td_, r32 = ln_ & 31, hi = ln_ >> 5; (void)lane; (void)tid; (void)r32; (void)hi;
    RK_H1(); RK_LOAD(1);
    lds_barrier();
    { RK_RELANE() RK_H2(0); }
    lds_barrier();
    { RK_RELANE() RK_H3(0); }
    lds_barrier();
    { RK_RELANE() RK_H4(0); } RK_H1(); RK_LOAD(2);
    lds_barrier();
    unsigned dga_ = 0;
    for (int c = 0; c < NCH; ++c) {
        const int tok0 = tokb + c * RC;
        int ln_ = F.lane, td_ = F.tid; asm volatile("" : "+v"(ln_), "+v"(td_));
        const int lane = ln_, tid = td_, r32 = ln_ & 31, hi = ln_ >> 5;
        const LAS bf16* Zc = ZB + (c & 1) * 64 * P64; LAS bf16* Zn = ZB + ((c + 1) & 1) * 64 * P64;
        const LAS bf16* BRTc = (const LAS bf16*)(F.lds + ((c & 1) ? RK_BRT2 : RK_BRT)); const LAS bf16* BETc = (const LAS bf16*)(F.lds + ((c & 1) ? RK_BET2 : RK_BET));
        DG_START(70, dg70_) DG_START(73, dg73_) DG_START(76, dg76_)
        float pbon = 0.f;
        if (wave == 0) RK_CH_B();
        else if (wave < 3) { const int vb = wave - 1; f32x16_t acc;
#pragma unroll
            for (int i = 0; i < 16; ++i) acc[i] = 0.f;
            mm_abt2<4, 2>(acc, Zc + 32 * vb * P64, P64, AL, P64, VT + 32 * vb * P32, P32, NT, P32, r32, hi);
            RK_ST_ROWS(XB + 32 * vb * P32, acc); }
        else if (wave == 3) {
            { const size_t po_ = (size_t)(tok0 + r32) * AW + h * 64 + 4 * hi;
#pragma unroll
                for (int g = 0; g < 8; ++g) { const unsigned long long a_ = *(const GAS unsigned long long*)(VFg + po_ + 8 * g), b_ = *(const GAS unsigned long long*)(Gg + po_ + 8 * g);
                    rg2[2 * g] = __builtin_bit_cast(float, (unsigned)a_); rg2[2 * g + 1] = __builtin_bit_cast(float, (unsigned)(a_ >> 32)); rg3[2 * g] = __builtin_bit_cast(float, (unsigned)b_); rg3[2 * g + 1] = __builtin_bit_cast(float, (unsigned)(b_ >> 32)); }
                pbon = BONg[(size_t)(tok0 + r32) * 6 + h]; }
#pragma unroll
            for (int i = 0; i < 16; ++i) { yacc0[i] = 0.f; yacc1[i] = 0.f; }
            mm_abt2<4, 2>(yacc0, Zc, P64, RH, P64, VT, P32, KRT, P32, r32, hi);
            mm_abt2<4, 2>(yacc1, Zc + 32 * P64, P64, RH, P64, VT + 32 * P32, P32, KRT, P32, r32, hi); }
        else { mm_abt<2>(zacc, VT + 32 * ((wave - 4) >> 1) * P32, P32, KAT + 32 * ((wave - 4) & 1) * P32, P32, r32, hi);
            if (c + 1 < NCH) RK_H2(c + 1); }
        if (DIAG_SLOT_D == 73) { asm volatile("s_waitcnt lgkmcnt(0)" ::: "memory"); DG_STOP(73, dg73_, dga_) }
        lds_barrier();
        DG_STOP(70, dg70_, dga_) DG_START(71, dg71_) DG_START(74, dg74_)
        if (wave == 0) {
            RK_CH_RND();
            const bf16x8_t mb0 = acc_frag(cm, 0), mb1 = acc_frag(cm, 1);
#pragma unroll
            for (int vb = 0; vb < 2; ++vb) { f32x16_t acc;
#pragma unroll
                for (int i = 0; i < 16; ++i) acc[i] = 0.f;
                const LAS bf16* xr = XB + (32 * vb + r32) * P32 + 4 * hi;
                v4u x0, x1; { const unsigned long long u0 = *(const LAS unsigned long long*)(xr), u1 = *(const LAS unsigned long long*)(xr + 8), u2 = *(const LAS unsigned long long*)(xr + 16), u3 = *(const LAS unsigned long long*)(xr + 24);
                    x0.x = (unsigned)u0; x0.y = (unsigned)(u0 >> 32); x0.z = (unsigned)u1; x0.w = (unsigned)(u1 >> 32); x1.x = (unsigned)u2; x1.y = (unsigned)(u2 >> 32); x1.z = (unsigned)u3; x1.w = (unsigned)(u3 >> 32); }
                acc = __builtin_amdgcn_mfma_f32_32x32x16_bf16(__builtin_bit_cast(bf16x8_t, x0), mb0, acc, 0, 0, 0);
                acc = __builtin_amdgcn_mfma_f32_32x32x16_bf16(__builtin_bit_cast(bf16x8_t, x1), mb1, acc, 0, 0, 0);
                RK_ST_ROWS(EB + 32 * vb * P32, acc); } }
        if (c + 1 < NCH) RK_H3(c + 1);
        if (DIAG_SLOT_D == 74) { asm volatile("s_waitcnt lgkmcnt(0)" ::: "memory"); DG_STOP(74, dg74_, dga_) }
        lds_barrier();
        DG_STOP(71, dg71_, dga_) DG_START(72, dg72_) DG_START(75, dg75_)
        if (c + 2 < NCH) { RK_H1(); if (c + 3 < NCH) RK_LOAD(c + 3); }
        if (wave == 3) {
            mm_abt<2>(yacc0, EB, P32, BRTc, P32, r32, hi); mm_abt<2>(yacc1, EB + 32 * P32, P32, BRTc, P32, r32, hi);
            float sm = 0.f;
#pragma unroll
            for (int i = 0; i < 16; ++i) sm += yacc0[i] + yacc1[i];
            sm += __shfl_xor(sm, 32); const float mean = sm * (1.0f / 64.0f);
            float vs = 0.f;
#pragma unroll
            for (int i = 0; i < 16; ++i) { yacc0[i] -= mean; yacc1[i] -= mean; vs += yacc0[i] * yacc0[i] + yacc1[i] * yacc1[i]; }
            vs += __shfl_xor(vs, 32); const float rs = 1.0f / sqrtf(vs * (1.0f / 64.0f) + 64e-5f);
            bf16* yo = P + (size_t)(tok0 + r32) * PP + h * 64 + 4 * hi;
#pragma unroll
            for (int g = 0; g < 8; ++g) { const int v0 = 8 * g + 4 * hi;
                const f32x4 lw = *(const LAS f32x4*)(LNP + v0), lb = *(const LAS f32x4*)(LNP + 64 + v0);
                const float f0_ = rg2[2 * g], f1_ = rg2[2 * g + 1], f2_ = rg3[2 * g], f3_ = rg3[2 * g + 1];
                const unsigned v0w = __float_as_uint(f0_), v1w = __float_as_uint(f1_), g0w = __float_as_uint(f2_), g1w = __float_as_uint(f3_);
                const f32x4 vv = (f32x4){bflo(v0w), bfhi(v0w), bflo(v1w), bfhi(v1w)}, gg = (f32x4){bflo(g0w), bfhi(g0w), bflo(g1w), bfhi(g1w)};
                const f32x4 yv = (g < 4) ? (f32x4){yacc0[4 * (g & 3)], yacc0[4 * (g & 3) + 1], yacc0[4 * (g & 3) + 2], yacc0[4 * (g & 3) + 3]} : (f32x4){yacc1[4 * (g & 3)], yacc1[4 * (g & 3) + 1], yacc1[4 * (g & 3) + 2], yacc1[4 * (g & 3) + 3]};
                const f32x4 o = (yv * rs * lw + lb + pbon * vv) * gg;
                *(GAS unsigned long long*)(yo + 8 * g) = (unsigned long long)pk2(o[0], o[1]) | ((unsigned long long)pk2(o[2], o[3]) << 32); } }
        else if (wave >= 4) { const int vb = (wave - 4) >> 1, kb = (wave - 4) & 1;
            mm_abt<2>(zacc, EB + 32 * vb * P32, P32, BETc + 32 * kb * P32, P32, r32, hi);
            const float gc = GC[(c & 1) * 64 + 32 * kb + r32];
#pragma unroll
            for (int r = 0; r < 16; ++r) { zacc[r] *= gc; Zn[(32 * vb + crow32(r, hi)) * P64 + 32 * kb + r32] = (bf16)(pk2(zacc[r], 0.f) & 0xffffu); } }
        if (c + 1 < NCH) RK_H4(c + 1);
        if (DIAG_SLOT_D == 75) { asm volatile("s_waitcnt lgkmcnt(0)" ::: "memory"); DG_STOP(75, dg75_, dga_) }
        lds_barrier();
        DG_STOP(72, dg72_, dga_) DG_STOP(76, dg76_, dga_)
    }
    DG_WRITE(70, unit == 0 && l == 0 && F.tid == 0, dga_) DG_WRITE(71, unit == 0 && l == 0 && F.tid == 0, dga_) DG_WRITE(72, unit == 0 && l == 0 && F.tid == 0, dga_) DG_WRITE(76, unit == 0 && l == 0 && F.tid == 0, dga_)
    DG_WRITE(73, unit == 0 && l == 0 && F.tid == 448, dga_) DG_WRITE(74, unit == 0 && l == 0 && F.tid == 64, dga_) DG_WRITE(75, unit == 0 && l == 0 && F.tid == 0, dga_)
#undef RK_LOAD
#undef cp
#undef cpt
#undef cm
#undef cmt
#undef zacc
#undef yacc0
#undef yacc1
#undef RK_H1
#undef RK_H2
#undef RK_H3
#undef RK_H4
#undef RK_RELANE
#undef RK_CH_A
#undef RK_CH_RND
#undef RK_CH_B
#undef RK_ST_ROWS
#undef RK_ST_COLS
}

constexpr int RP = 72;
constexpr int RT_QR = 0, RT_KR = 128 * RP * 2, RT_VV = 2 * 128 * RP * 2, RT_ST = 3 * 128 * RP * 2, RT_SS = RT_ST + 64 * RP * 2, RT_KD = RT_SS + 1024;
__device__ __forceinline__ void ret_out_unit(const Frame& F, int unit) {
    const int tid = F.tid, lane = F.lane, wave = F.wave, r32 = lane & 31, hi = lane >> 5;
    const int h = unit & 3, b = unit >> 2;
    bf16* P = (bf16*)(F.ws + WS_P); const float* tab = (const float*)(F.ws + WS_TAB);
    LAS bf16* QR = (LAS bf16*)(F.lds + RT_QR); LAS bf16* KR = (LAS bf16*)(F.lds + RT_KR); LAS bf16* VV = (LAS bf16*)(F.lds + RT_VV); LAS bf16* ST = (LAS bf16*)(F.lds + RT_ST);
    LAS float* SS = (LAS float*)(F.lds + RT_SS); LAS bf16* KD = (LAS bf16*)(F.lds + RT_KD);
    const float lg2 = log2f(1.0f - exp2f(-5.0f - (float)h));
    f32x16_t st;
#pragma unroll
    for (int i = 0; i < 16; ++i) st[i] = 0.f;
    const float cdec = exp2f(128.0f * lg2);
    unsigned long long pre[2][6]; f32x4 pret[2][2];
#define RT_LOAD(cn) do { _Pragma("unroll") for (int it_ = 0; it_ < 2; ++it_) { const int idx_ = tid + it_ * NTHR, m_ = idx_ >> 3, i4_ = (idx_ & 7) * 4; const size_t ro_ = (size_t)(b * SEQ + (cn) * 128 + m_) * PP + h * 64 + i4_; \
        pre[it_][0] = *(const GAS unsigned long long*)(P + ro_ + PCQ); pre[it_][1] = *(const GAS unsigned long long*)(P + ro_ + PCQ + 32); pre[it_][2] = *(const GAS unsigned long long*)(P + ro_ + PCK); \
        pre[it_][3] = *(const GAS unsigned long long*)(P + ro_ + PCK + 32); pre[it_][4] = *(const GAS unsigned long long*)(P + ro_ + PCV); pre[it_][5] = *(const GAS unsigned long long*)(P + ro_ + PCV + 32); \
        pret[it_][0] = *(const GAS f32x4*)(tab + ((size_t)((cn) * 128 + m_) * 32 + i4_) * 2); pret[it_][1] = *(const GAS f32x4*)(tab + ((size_t)((cn) * 128 + m_) * 32 + i4_) * 2 + 4); } } while (0)
    unsigned dga_ = 0;
    DG_START(60, dg60_)
    RT_LOAD(0);
    for (int c = 0; c < 16; ++c) {
    const int tok0 = b * SEQ + c * 128;
#pragma unroll
    for (int it = 0; it < 2; ++it) { const int idx = tid + it * NTHR, m = idx >> 3, i4 = (idx & 7) * 4;
        const unsigned long long q1w = pre[it][0], q2w = pre[it][1], k1w = pre[it][2], k2w = pre[it][3], v1w = pre[it][4], v2w = pre[it][5];
        const f32x4 t0 = pret[it][0], t1 = pret[it][1];
        const float cs[4] = {t0[0], t0[2], t1[0], t1[2]}, sn[4] = {t0[1], t0[3], t1[1], t1[3]};
        const float q1[4] = {bflo((unsigned)q1w), bfhi((unsigned)q1w), bflo((unsigned)(q1w >> 32)), bfhi((unsigned)(q1w >> 32))}, q2[4] = {bflo((unsigned)q2w), bfhi((unsigned)q2w), bflo((unsigned)(q2w >> 32)), bfhi((unsigned)(q2w >> 32))};
        const float k1[4] = {bflo((unsigned)k1w), bfhi((unsigned)k1w), bflo((unsigned)(k1w >> 32)), bfhi((unsigned)(k1w >> 32))}, k2[4] = {bflo((unsigned)k2w), bfhi((unsigned)k2w), bflo((unsigned)(k2w >> 32)), bfhi((unsigned)(k2w >> 32))};
        float qa[4], qb[4], ka[4], kb[4];
#pragma unroll
        for (int j = 0; j < 4; ++j) { qa[j] = q1[j] * cs[j] - q2[j] * sn[j]; qb[j] = q1[j] * sn[j] + q2[j] * cs[j]; ka[j] = (k1[j] * cs[j] - k2[j] * sn[j]) * 0.125f; kb[j] = (k1[j] * sn[j] + k2[j] * cs[j]) * 0.125f; }
        *(LAS unsigned long long*)(QR + m * RP + i4) = (unsigned long long)pk2(qa[0], qa[1]) | ((unsigned long long)pk2(qa[2], qa[3]) << 32);
        *(LAS unsigned long long*)(QR + m * RP + 32 + i4) = (unsigned long long)pk2(qb[0], qb[1]) | ((unsigned long long)pk2(qb[2], qb[3]) << 32);
        *(LAS unsigned long long*)(KR + m * RP + i4) = (unsigned long long)pk2(ka[0], ka[1]) | ((unsigned long long)pk2(ka[2], ka[3]) << 32);
        *(LAS unsigned long long*)(KR + m * RP + 32 + i4) = (unsigned long long)pk2(kb[0], kb[1]) | ((unsigned long long)pk2(kb[2], kb[3]) << 32);
        { const float kd = exp2f((float)(127 - m) * lg2);
          *(LAS unsigned long long*)(KD + m * RP + i4) = (unsigned long long)pk2(ka[0] * kd, ka[1] * kd) | ((unsigned long long)pk2(ka[2] * kd, ka[3] * kd) << 32);
          *(LAS unsigned long long*)(KD + m * RP + 32 + i4) = (unsigned long long)pk2(kb[0] * kd, kb[1] * kd) | ((unsigned long long)pk2(kb[2] * kd, kb[3] * kd) << 32); }
        *(LAS unsigned long long*)(VV + m * RP + i4) = v1w; *(LAS unsigned long long*)(VV + m * RP + 32 + i4) = v2w; }
    if (c + 1 < 16) RT_LOAD(c + 1);
    if (wave < 4) {
        const int db = wave >> 1, ebs = wave & 1;
#pragma unroll
        for (int i = 0; i < 16; ++i) ST[(32 * db + crow32(i, hi)) * RP + 32 * ebs + r32] = (bf16)(pk2(st[i], 0.f) & 0xffffu);
    }
    lds_barrier();
    const int nb = wave >> 1, eb = wave & 1, n = nb * 32 + r32;
    const unsigned blk_ = (lane >> 4) & 1, q_ = (lane & 15) >> 2, p_ = lane & 3;
    bf16x8_t qf[4];
#pragma unroll
    for (int ks = 0; ks < 4; ++ks) qf[ks] = *(const LAS bf16x8_t*)(QR + n * RP + ks * 16 + hi * 8);
    f32x16_t y;
#pragma unroll
    for (int i = 0; i < 16; ++i) y[i] = 0.f;
#pragma unroll
    for (int ks = 0; ks < 4; ++ks) {
        const s16x4_t lo = __builtin_bit_cast(s16x4_t, __builtin_amdgcn_ds_read_tr16_b64_v4i16((LAS s16x4_t*)(ST + (16 * ks + 8 * hi + q_) * RP + 32 * eb + 16 * blk_ + 4 * p_)));
        const s16x4_t hh = __builtin_bit_cast(s16x4_t, __builtin_amdgcn_ds_read_tr16_b64_v4i16((LAS s16x4_t*)(ST + (16 * ks + 8 * hi + 4 + q_) * RP + 32 * eb + 16 * blk_ + 4 * p_)));
        const bf16x8_t a = (bf16x8_t){lo[0], lo[1], lo[2], lo[3], hh[0], hh[1], hh[2], hh[3]};
        y = __builtin_amdgcn_mfma_f32_32x32x16_bf16(a, qf[ks], y, 0, 0, 0); }
    { const float qd = exp2f((float)(n + 1) * lg2);
#pragma unroll
      for (int i = 0; i < 16; ++i) y[i] *= qd; }
    unsigned long long gpre[4];
#pragma unroll
    for (int g = 0; g < 4; ++g) gpre[g] = *(const GAS unsigned long long*)(P + (size_t)(tok0 + n) * PP + PCG + h * 64 + 32 * eb + 8 * g + 4 * hi);
    for (int mt = 0; mt <= nb; ++mt) {
        f32x16_t S;
#pragma unroll
        for (int i = 0; i < 16; ++i) S[i] = 0.f;
#pragma unroll
        for (int ks = 0; ks < 4; ++ks) { const bf16x8_t a = *(const LAS bf16x8_t*)(KR + (mt * 32 + r32) * RP + ks * 16 + hi * 8); S = __builtin_amdgcn_mfma_f32_32x32x16_bf16(a, qf[ks], S, 0, 0, 0); }
        float e[16];
#pragma unroll
        for (int r = 0; r < 16; ++r) { const int dm = r32 - crow32(r, hi) + 32 * (nb - mt); e[r] = (dm >= 0) ? S[r] * exp2f((float)dm * lg2) : 0.f; }
#pragma unroll
        for (int s = 0; s < 2; ++s) { v4u w; w.x = pk2(e[8 * s], e[8 * s + 1]); w.y = pk2(e[8 * s + 2], e[8 * s + 3]); w.z = pk2(e[8 * s + 4], e[8 * s + 5]); w.w = pk2(e[8 * s + 6], e[8 * s + 7]);
            const bf16x8_t xs = __builtin_bit_cast(bf16x8_t, w);
            const s16x4_t lo = __builtin_bit_cast(s16x4_t, __builtin_amdgcn_ds_read_tr16_b64_v4i16((LAS s16x4_t*)(VV + (mt * 32 + 16 * s + 4 * hi + q_) * RP + 32 * eb + 16 * blk_ + 4 * p_)));
            const s16x4_t hh = __builtin_bit_cast(s16x4_t, __builtin_amdgcn_ds_read_tr16_b64_v4i16((LAS s16x4_t*)(VV + (mt * 32 + 16 * s + 8 + 4 * hi + q_) * RP + 32 * eb + 16 * blk_ + 4 * p_)));
            const bf16x8_t a = (bf16x8_t){lo[0], lo[1], lo[2], lo[3], hh[0], hh[1], hh[2], hh[3]};
            y = __builtin_amdgcn_mfma_f32_32x32x16_bf16(a, xs, y, 0, 0, 0); }
    }
    float ss = 0.f;
#pragma unroll
    for (int i = 0; i < 16; ++i) ss += y[i] * y[i];
    ss += __shfl_xor(ss, 32);
    if (hi == 0) SS[(nb * 2 + eb) * 32 + r32] = ss;
    lds_barrier();
    ss += SS[(nb * 2 + (eb ^ 1)) * 32 + r32];
    const float rs = 1.0f / sqrtf(ss * (1.0f / 64.0f) + 1e-6f);
    const size_t ro = (size_t)(tok0 + n) * PP;
#pragma unroll
    for (int g = 0; g < 4; ++g) { const int e0 = 32 * eb + 8 * g + 4 * hi;
        const unsigned long long gw = gpre[g];
        const float g0 = bflo((unsigned)gw), g1 = bfhi((unsigned)gw), g2 = bflo((unsigned)(gw >> 32)), g3 = bfhi((unsigned)(gw >> 32));
        const float o0 = g0 * sigmoid_f(g0) * y[4 * g] * rs, o1 = g1 * sigmoid_f(g1) * y[4 * g + 1] * rs, o2 = g2 * sigmoid_f(g2) * y[4 * g + 2] * rs, o3 = g3 * sigmoid_f(g3) * y[4 * g + 3] * rs;
        *(GAS unsigned long long*)(P + ro + 768 + h * 64 + e0) = (unsigned long long)pk2(o0, o1) | ((unsigned long long)pk2(o2, o3) << 32); }
    if (wave < 4) {
        const int db = wave >> 1, ebs = wave & 1;
#pragma unroll
        for (int i = 0; i < 16; ++i) st[i] *= cdec;
#pragma unroll
        for (int ks = 0; ks < 8; ++ks) {
            const s16x4_t alo = __builtin_bit_cast(s16x4_t, __builtin_amdgcn_ds_read_tr16_b64_v4i16((LAS s16x4_t*)(KD + (16 * ks + 8 * hi + q_) * RP + 32 * db + 16 * blk_ + 4 * p_)));
            const s16x4_t ahi = __builtin_bit_cast(s16x4_t, __builtin_amdgcn_ds_read_tr16_b64_v4i16((LAS s16x4_t*)(KD + (16 * ks + 8 * hi + 4 + q_) * RP + 32 * db + 16 * blk_ + 4 * p_)));
            const s16x4_t blo = __builtin_bit_cast(s16x4_t, __builtin_amdgcn_ds_read_tr16_b64_v4i16((LAS s16x4_t*)(VV + (16 * ks + 8 * hi + q_) * RP + 32 * ebs + 16 * blk_ + 4 * p_)));
            const s16x4_t bhi = __builtin_bit_cast(s16x4_t, __builtin_amdgcn_ds_read_tr16_b64_v4i16((LAS s16x4_t*)(VV + (16 * ks + 8 * hi + 4 + q_) * RP + 32 * ebs + 16 * blk_ + 4 * p_)));
            const bf16x8_t a = (bf16x8_t){alo[0], alo[1], alo[2], alo[3], ahi[0], ahi[1], ahi[2], ahi[3]}, bb = (bf16x8_t){blo[0], blo[1], blo[2], blo[3], bhi[0], bhi[1], bhi[2], bhi[3]};
            st = __builtin_amdgcn_mfma_f32_32x32x16_bf16(a, bb, st, 0, 0, 0); }
    }
    lds_barrier();
    }
    DG_STOP(60, dg60_, dga_)
    DG_WRITE(60, unit == 0 && wave == 0 && lane == 0, dga_)
#undef RT_LOAD
}

constexpr int PT = 32, XSP = 1304;
constexpr int PR_XS = 0, PR_STG = PT * XSP * 2, PR_CONST = PR_STG + 32768, PR_MU = PR_CONST + 6 * 384 * 4;
__device__ __forceinline__ void prep_consts(const Frame& F, int l) {
    LAS float* CS = (LAS float*)(F.lds + PR_CONST);
    for (int i = F.tid; i < AW; i += NTHR) { CS[i] = F.in[I_KK][l * AW + i]; CS[AW + i] = F.in[I_KA][l * AW + i]; CS[2 * AW + i] = F.in[I_RK][l * AW + i];
        CS[3 * AW + i] = F.in[I_W0][l * AW + i]; CS[4 * AW + i] = F.in[I_A0][l * AW + i]; CS[5 * AW + i] = (l > 0) ? F.in[I_V0][(l - 1) * AW + i] : 0.f; }
    LAS float* MU = (LAS float*)(F.lds + PR_MU);
    for (int i = F.tid; i < 1296; i += NTHR) MU[i] = (i < 1280) ? F.in[I_MU][l * 1280 + i] : ((l > 0) ? F.in[I_VRMU][(l - 1) * 16 + i - 1280] : 0.f);
    __syncthreads();
}
__device__ __forceinline__ float softplus_f(float z) { return fmaxf(z, 0.f) + __logf(1.0f + __expf(-fabsf(z))); }
__device__ __forceinline__ float tanh_f(float x) { const float e = __expf(2.0f * x); return 1.0f - 2.0f * __builtin_amdgcn_rcpf(e + 1.0f); }
__device__ __forceinline__ void small_weights(const Frame& F) {
    for (int l = 0; l < DEPTH; ++l) {
        const float* w2 = F.in[I_W2] + (size_t)l * 32 * AW; const float* a2 = F.in[I_A2] + (size_t)l * 32 * AW; const float* g2 = F.in[I_G2] + (size_t)l * 64 * AW;
        const float* v2 = F.in[I_V2] + (size_t)(l > 0 ? l - 1 : 0) * 16 * AW;
        bf16* LT = (bf16*)(F.ws + WS_LORA) + (size_t)l * AW * 144;
        for (int i = F.vcu * NTHR + F.tid; i < AW * 144; i += F.G * NTHR) { const int n = i / 144, k = i - n * 144; float v;
            if (k < 32) v = w2[k * AW + n]; else if (k < 64) v = a2[(k - 32) * AW + n]; else if (k < 128) v = g2[(k - 64) * AW + n]; else v = (l > 0) ? v2[(k - 128) * AW + n] : 0.f;
            LT[i] = (bf16)f2bf(v); }
        const float* wuk = F.in[I_WUK] + (size_t)l * 6 * 64 * 128; const float* wuv = F.in[I_WUV] + (size_t)l * 6 * 128 * 64;
        bf16* wukT = (bf16*)(F.ws + WS_WUKT) + (size_t)l * 6 * 64 * 128; bf16* wuvT = (bf16*)(F.ws + WS_WUVT) + (size_t)l * 6 * 64 * 128;
        for (int i = F.vcu * NTHR + F.tid; i < 6 * 64 * 128; i += F.G * NTHR) {
            { const int hh = i / 8192, rem = i - hh * 8192, c = rem >> 6, d = rem & 63; wukT[i] = (bf16)f2bf(wuk[(hh * 64 + d) * 128 + c]); }
            { const int hh = i / 8192, rem = i - hh * 8192, d = rem >> 7, c = rem & 127; wuvT[i] = (bf16)f2bf(wuv[(hh * 128 + c) * 64 + d]); } }
    }
}
__device__ __forceinline__ void prep_tokens_unit(const Frame& F, int l, int unit) {
    LAS bf16* XS = (LAS bf16*)(F.lds + PR_XS);
    const int tid = F.tid, lane = F.lane, wave = F.wave, r32 = lane & 31, hi = lane >> 5, tok0 = unit * PT;
    const bf16* P = (const bf16*)(F.ws + WS_P);
    unsigned dga_ = 0;
    DG_START(20, dg20_)
    if (tid < PT * 8) { const int t = tid >> 3, c8 = (tid & 7) * 8;
        *(GAS v4u*)((bf16*)((unsigned char*)F.out + OUT_KI) + (size_t)(tok0 + t) * 64 + c8) = *(const GAS v4u*)(P + (size_t)(tok0 + t) * PP + PBIK + c8); }
    for (int base = 0; base < PT * 162; base += 5 * NTHR) {
        v4u cw[5], pw[5];
#pragma unroll
        for (int u = 0; u < 5; ++u) { const int idx = base + u * NTHR + tid; const int idc = idx < PT * 162 ? idx : PT * 162 - 1; const int t = idc / 162, ch = idc - t * 162, tok = tok0 + t;
            cw[u] = *(const GAS v4u*)(P + (size_t)tok * PP + ch * 8);
            const int tokp = (tok & (SEQ - 1)) != 0 ? tok - 1 : tok; pw[u] = *(const GAS v4u*)(P + (size_t)tokp * PP + ch * 8); }
#pragma unroll
        for (int u = 0; u < 5; ++u) { const int idx = base + u * NTHR + tid;
            if (idx < PT * 162) { const int t = idx / 162, ch = idx - t * 162, tok = tok0 + t, c0 = ch * 8;
                float cur[8], prv[8]; unpack8(cw[u], cur); unpack8(pw[u], prv);
                const bool first = (tok & (SEQ - 1)) == 0;
                float mv[8];
                { const LAS f32x4* mp = (const LAS f32x4*)((const LAS float*)(F.lds + PR_MU) + c0); const f32x4 m0 = mp[0], m1 = mp[1]; mv[0] = m0[0]; mv[1] = m0[1]; mv[2] = m0[2]; mv[3] = m0[3]; mv[4] = m1[0]; mv[5] = m1[1]; mv[6] = m1[2]; mv[7] = m1[3]; }
                float o[8];
#pragma unroll
                for (int j = 0; j < 8; ++j) { const float pv = first ? 0.f : prv[j]; float v = cur[j] + (pv - cur[j]) * mv[j];
                    if (c0 >= 1152 && c0 < 1184) v = tanh_f(v); else if (c0 >= 1216 && c0 < 1280) v = sigmoid_f(v);
                    o[j] = v; }
                v4u w; w.x = pk2(o[0], o[1]); w.y = pk2(o[2], o[3]); w.z = pk2(o[4], o[5]); w.w = pk2(o[6], o[7]);
                *(LAS v4u*)(XS + t * XSP + c0) = w; } }
    }
    __syncthreads();
    DG_STOP(20, dg20_, dga_)
    DG_WRITE(20, unit == 0 && l == 0 && wave == 0 && lane == 0, dga_)
    DG_START(21, dg21_)
    if (wave < 6) {
        const int h = wave;
        LAS bf16* STG = (LAS bf16*)(F.lds + PR_STG + wave * 4096);
        GAS unsigned char* wsb = (GAS unsigned char*)F.ws;
        GAS unsigned char* outb = (GAS unsigned char*)F.out;
        const bf16* LT = (const bf16*)(F.ws + WS_LORA) + (size_t)l * AW * 144;
        const LAS float* CS = (const LAS float*)(F.lds + PR_CONST) + h * 64;
        const LAS float* kkw = CS; const LAS float* kaw = CS + AW; const LAS float* rkw = CS + 2 * AW; const LAS float* w0p = CS + 3 * AW; const LAS float* a0p = CS + 4 * AW; const LAS float* v0p = CS + 5 * AW;
        const LAS bf16* xrow = XS + r32 * XSP;
        float rn;
        { float ss = 0.f;
#pragma unroll
          for (int cbl = 0; cbl < 2; ++cbl)
#pragma unroll
              for (int g = 0; g < 4; ++g) { const int j0 = cbl * 32 + 8 * g + 4 * hi; const unsigned long long kw = *(const LAS unsigned long long*)(xrow + 384 + h * 64 + j0); const f32x4 kk4 = *(const LAS f32x4*)(kkw + j0);
                  const float k0 = bflo((unsigned)kw) * kk4[0], k1 = bfhi((unsigned)kw) * kk4[1], k2 = bflo((unsigned)(kw >> 32)) * kk4[2], k3 = bfhi((unsigned)(kw >> 32)) * kk4[3]; ss += (k0 * k0 + k1 * k1) + (k2 * k2 + k3 * k3); }
          ss += __shfl_xor(ss, 32); rn = 1.0f / fmaxf(sqrtf(ss), 1e-12f); }
        float bonus = 0.f;
        const int srow = lane >> 2, sch = lane & 3;
#pragma unroll
        for (int cbl = 0; cbl < 2; ++cbl) {
            asm volatile("" ::: "memory");
            const int cb0 = h * 64 + cbl * 32;
            f32x16_t wv, av, gv, mvv;
#pragma unroll
            for (int i = 0; i < 16; ++i) { wv[i] = 0.f; av[i] = 0.f; gv[i] = 0.f; mvv[i] = 0.f; }
            const bf16* lrow = LT + (size_t)(cb0 + r32) * 144 + 8 * hi;
            bf16x8_t la[9];
#pragma unroll
            for (int ks = 0; ks < 9; ++ks) la[ks] = *(const GAS bf16x8_t*)(lrow + 16 * ks);
#pragma unroll
            for (int ks = 0; ks < 9; ++ks) { const bf16x8_t a = la[ks]; const bf16x8_t bx = *(const LAS bf16x8_t*)(xrow + 1152 + 16 * ks + 8 * hi);
                if (ks < 2) wv = __builtin_amdgcn_mfma_f32_32x32x16_bf16(a, bx, wv, 0, 0, 0);
                else if (ks < 4) av = __builtin_amdgcn_mfma_f32_32x32x16_bf16(a, bx, av, 0, 0, 0);
                else if (ks < 8) gv = __builtin_amdgcn_mfma_f32_32x32x16_bf16(a, bx, gv, 0, 0, 0);
                else mvv = __builtin_amdgcn_mfma_f32_32x32x16_bf16(a, bx, mvv, 0, 0, 0); }
            if (l > 0) {
#pragma unroll
                for (int i = 0; i < 2; ++i) { const int row = srow + 16 * i; const unsigned eo = (unsigned)(((tok0 + row) * AW + cb0 + sch * 8) * 2); *(LAS v4u*)(STG + row * 32 + sch * 8) = *(const GAS v4u*)(wsb + WS_VF + eo); } }
            unsigned long long ro[4], dd[4], k2o[4], kko[4], bpo[4], vo[4], go[4];
#pragma unroll
            for (int g = 0; g < 4; ++g) { const int j0 = cbl * 32 + 8 * g + 4 * hi;
                const unsigned long long rw = *(const LAS unsigned long long*)(xrow + h * 64 + j0), kw = *(const LAS unsigned long long*)(xrow + 384 + h * 64 + j0), vw = *(const LAS unsigned long long*)(xrow + 768 + h * 64 + j0);
                unsigned long long fw = 0ull; if (l > 0) fw = *(const LAS unsigned long long*)(STG + r32 * 32 + 8 * g + 4 * hi);
                asm volatile("" : "+v"(bonus) :: "memory");
                const f32x4 kk4 = *(const LAS f32x4*)(kkw + j0), ka4 = *(const LAS f32x4*)(kaw + j0), rk4 = *(const LAS f32x4*)(rkw + j0), w04 = *(const LAS f32x4*)(w0p + j0), a04 = *(const LAS f32x4*)(a0p + j0);
                const f32x4 v04 = *(const LAS f32x4*)(v0p + j0);
                const float rr[4] = {bflo((unsigned)rw), bfhi((unsigned)rw), bflo((unsigned)(rw >> 32)), bfhi((unsigned)(rw >> 32))};
                const float kx[4] = {bflo((unsigned)kw), bfhi((unsigned)kw), bflo((unsigned)(kw >> 32)), bfhi((unsigned)(kw >> 32))};
                const float vx[4] = {bflo((unsigned)vw), bfhi((unsigned)vw), bflo((unsigned)(vw >> 32)), bfhi((unsigned)(vw >> 32))};
                const float fx[4] = {bflo((unsigned)fw), bfhi((unsigned)fw), bflo((unsigned)(fw >> 32)), bfhi((unsigned)(fw >> 32))};
                float d_[4], k2_[4], kk_[4], bp_[4], v_[4];
#pragma unroll
                for (int e = 0; e < 4; ++e) { const int i = 4 * g + e;
                    const float sp = softplus_f(-(wv[i] + w04[e])); const float rate = __expf(-sp - 0.5f); const float d = 1.0f - __expf(-rate);
                    const float a = sigmoid_f(av[i] + a04[e]);
                    float v = vx[e]; if (l > 0) v = v + (fx[e] - v) * sigmoid_f(mvv[i] + v04[e]);
                    const float kk = kx[e] * kk4[e] * rn, k2 = kx[e] * (1.0f + (a - 1.0f) * ka4[e]);
                    d_[e] = d; k2_[e] = k2; kk_[e] = kk; bp_[e] = kk * a; v_[e] = v;
                    bonus += rr[e] * k2 * rk4[e]; }
#define PK4(x) ((unsigned long long)pk2(x[0], x[1]) | ((unsigned long long)pk2(x[2], x[3]) << 32))
                ro[g] = rw; dd[g] = PK4(d_); k2o[g] = PK4(k2_); kko[g] = PK4(kk_); bpo[g] = PK4(bp_); vo[g] = PK4(v_);
                go[g] = (unsigned long long)pk2(gv[4 * g], gv[4 * g + 1]) | ((unsigned long long)pk2(gv[4 * g + 2], gv[4 * g + 3]) << 32); }
#define PR_OUT(arr, bs_, dst) do { _Pragma("unroll") for (int g = 0; g < 4; ++g) *(LAS unsigned long long*)(STG + r32 * 32 + 8 * g + 4 * hi) = arr[g]; \
            _Pragma("unroll") for (int i = 0; i < 2; ++i) { const int row = srow + 16 * i; const unsigned eo = (unsigned)(((tok0 + row) * AW + cb0 + sch * 8) * 2); *(GAS v4u*)(bs_ + dst + eo) = *(const LAS v4u*)(STG + row * 32 + sch * 8); } } while (0)
            PR_OUT(ro, wsb, WS_R); PR_OUT(dd, wsb, WS_D); PR_OUT(k2o, wsb, WS_K2); PR_OUT(kko, wsb, WS_KK); PR_OUT(bpo, outb, OUT_BP); PR_OUT(vo, wsb, WS_VF); PR_OUT(go, outb, OUT_G);
#undef PR_OUT
#undef PK4
        }
        bonus += __shfl_xor(bonus, 32);
        if (hi == 0) ((float*)(F.ws + WS_BON))[(size_t)(tok0 + r32) * 6 + h] = bonus;
    } else {
        const float* kvn = F.in[I_KVN] + l * 128; bf16* C = (bf16*)(F.ws + WS_C);
        unsigned cw_[16];
#pragma unroll
        for (int q = 0; q < 16; ++q) cw_[q] = *(const GAS unsigned*)(P + (size_t)(tok0 + 16 * (wave - 6) + q) * PP + PBC + 2 * lane);
        const float kv0 = kvn[2 * lane], kv1 = kvn[2 * lane + 1];
#pragma unroll
        for (int q = 0; q < 16; ++q) { const int tok = tok0 + 16 * (wave - 6) + q; const unsigned w = cw_[q];
            const float c0 = bflo(w), c1 = bfhi(w); const float ss = wave_sum(c0 * c0 + c1 * c1); const float rs = 1.0f / sqrtf(ss * (1.0f / 128.0f) + 1e-6f);
            *(GAS unsigned*)(C + (size_t)tok * 128 + 2 * lane) = pk2(c0 * rs * kv0, c1 * rs * kv1); }
    }
    DG_STOP(21, dg21_, dga_)
    DG_WRITE(21, unit == 0 && l == 0 && wave == 0 && lane == 0, dga_)
    __syncthreads();
}

__device__ __forceinline__ void final_norm(const Frame& F) {
    const int gw = F.vcu * NWAVES + F.wave, NGW = F.G * NWAVES; const float* g = F.in[I_FN];
    float dgc_ = 0.f;
    if (DIAG_SLOT_D >= 0) { const unsigned* D = (const unsigned*)(F.ws + WS_DIAG); const float x0 = (float)D[0] * (1.0f / (100.0f * DIAG_DIV)); const float gq = 4.0f;
        const float kq = floorf(log2f(fmaxf(x0, 1.0f)) * gq); dgc_ = sqrtf(fmaxf(exp2f((kq + 0.5f) / gq) - 1.0f, 0.01f)); }
    const bf16* XBf = (const bf16*)(F.ws + WS_XB);
    for (int m = gw; m < M; m += NGW) { GAS f32x4* xr = (GAS f32x4*)(F.out + (size_t)m * DM); const GAS v4u* xs = (const GAS v4u*)(XBf + (size_t)m * DM); float v[2][8]; float s = 0.f;
#pragma unroll
        for (int j = 0; j < 2; ++j) { unpack8(xs[F.lane + 64 * j], v[j]);
#pragma unroll
            for (int e = 0; e < 8; ++e) s += v[j][e] * v[j][e]; }
        const float rs = 1.0f / sqrtf(wave_sum(s) * (1.0f / DM) + 1e-6f);
#pragma unroll
        for (int j = 0; j < 2; ++j) { const int c = 8 * (F.lane + 64 * j); const f32x4 g0 = *(const f32x4*)(g + c), g1 = *(const f32x4*)(g + c + 4);
            xr[c / 4] = (DIAG_SLOT_D >= 0) ? (f32x4){dgc_, dgc_, dgc_, dgc_} : (f32x4){v[j][0], v[j][1], v[j][2], v[j][3]} * rs * g0;
            xr[c / 4 + 1] = (DIAG_SLOT_D >= 0) ? (f32x4){dgc_, dgc_, dgc_, dgc_} : (f32x4){v[j][4], v[j][5], v[j][6], v[j][7]} * rs * g1; } }
}

template <class T> __device__ __forceinline__ T* launder_ptr(T* p) {
    unsigned lo = (unsigned)(uintptr_t)p, hi = (unsigned)((uintptr_t)p >> 32);
    asm volatile("" : "+v"(lo), "+v"(hi));
    lo = __builtin_amdgcn_readfirstlane(lo); hi = __builtin_amdgcn_readfirstlane(hi);
    return (T*)(((uintptr_t)hi << 32) | (uintptr_t)lo);
}
constexpr int NPHASE = 18;
constexpr int DUP_PHASE = -1;
constexpr int QDUP = 1;
constexpr int STAG_UP = 3, STAG_IN = 2;
constexpr int REP_SCAN_K = 1, REP_THR_K = 1;
constexpr int NSTEP = NPHASE + (DUP_PHASE >= 0 ? 1 : 0);
constexpr int REP_THR = 1, REP_PTOK = 1, REP_KV = 1, REP_CONV = 1, REP_SCAN = 1, REP_DSA = 1, REP_RET = 1, REP_UP = 1;
#define REPL(n) for (int rep_ = 0; rep_ < (l == 0 ? (n) : 1); ++rep_)
__global__ void __launch_bounds__(NTHR, 2) fwd_kernel(Args args) {
    extern __shared__ __attribute__((aligned(16))) unsigned char lds[];
    Frame F;
    F.lds = (LAS unsigned char*)lds;
    F.tid = threadIdx.x; F.lane = F.tid & 63; F.wave = __builtin_amdgcn_readfirstlane(F.tid >> 6);
    F.G = gridDim.x; { const int bx = blockIdx.x; F.vcu = (F.G % 8 == 0) ? (bx % 8) * (F.G / 8) + bx / 8 : bx; }
    F.in = (const float* const __attribute__((address_space(4)))*)__builtin_amdgcn_kernarg_segment_ptr(); F.out = args.out; F.ws = args.ws;
    volatile LAS unsigned* MISC = (volatile LAS unsigned*)(F.lds + MISC_OFF);
    for (int u = F.tid; u < (LDS_BYTES - LDSCTL_OFF) / 4; u += NTHR) ((LAS unsigned*)(F.lds + LDSCTL_OFF))[u] = 0u;
    __syncthreads();
    const int lo = args.ph_lo, hi = args.ph_hi;
    XcdBarrier bar; bar.bar = (unsigned*)(F.ws + WS_CTL) + CW_BAR; bar.x = 0; bar.st = nullptr;
    if (hi - lo > 1) bar = xcd_barrier_post((unsigned*)(F.ws + WS_CTL) + CW_BAR, MISC + 8);
    for (int ph_ = lo; ph_ < hi; ++ph_) {
        unsigned dgp0_ = 0; if (DIAG_SLOT_D >= 100) dgp0_ = (unsigned)__builtin_amdgcn_s_memtime();
        int ph = (args.dup_phase >= 0 && ph_ > args.dup_phase) ? ph_ - 1 : ph_; asm volatile("" : "+v"(ph)); ph = __builtin_amdgcn_readfirstlane(ph);
#define PH_ENTER() \
        { unsigned z_ = 0u; int t_ = threadIdx.x; asm volatile("" : "+v"(z_), "+v"(t_)); z_ = __builtin_amdgcn_readfirstlane(z_); F.in = (const float* const __attribute__((address_space(4)))*)((const char __attribute__((address_space(4)))*)__builtin_amdgcn_kernarg_segment_ptr() + z_); F.out = args.out + z_; F.ws = args.ws + z_; \
          F.tid = t_; F.lane = t_ & 63; F.wave = __builtin_amdgcn_readfirstlane(t_ >> 6); } \
        int bx = blockIdx.x; { int g_ = gridDim.x; asm volatile("" : "+v"(bx), "+v"(g_)); bx = __builtin_amdgcn_readfirstlane(bx); g_ = __builtin_amdgcn_readfirstlane(g_); F.G = g_; F.vcu = (g_ % 8 == 0) ? (bx % 8) * (g_ / 8) + bx / 8 : bx; } \
        gu32* ctl = (gu32*)(F.ws + WS_CTL); (void)ctl; \
        bf16* XB = (bf16*)(F.ws + WS_XB); bf16* Hb = (bf16*)(F.ws + WS_H); bf16* Pb = (bf16*)(F.ws + WS_P); float* part = (float*)(F.ws + WS_PART); (void)XB; (void)Hb; (void)Pb; (void)part;
        if (ph == 0) { PH_ENTER();
            if (DIAG_SLOT_D >= 0 && bx == 0 && threadIdx.x == 0) { unsigned zz_ = 0u; asm volatile("" : "+v"(zz_)); ((unsigned*)(args.ws + WS_DIAG))[0] = zz_; ((unsigned*)(args.ws + WS_DIAG))[1] = zz_; }
            conv_weights(F, 0, 0, 3);
            p0_x(F); p0_table(F); small_weights(F);
        } else if (ph == NPHASE - 1) { PH_ENTER();
            final_norm(F);
        } else {
            const int l = (ph - 1) / 8, sub = (ph - 1) - 8 * l;
            if (sub == 0 || sub == 6) { PH_ENTER();
                pg8::Gemm g{XB, (const bf16*)(F.ws + (sub == 0 ? WS_WGU1 : WS_WGU2)), M, NGU, DM, DM}; pg8::StaticOrder S; S.init(M, NGU, F.G, bx);
                pg8::EpiUp E{Hb, FFP, part};
                if (bx >= S.nwg % F.G) for (int i = 0; i < args.stag_up; ++i) __builtin_amdgcn_s_sleep(127);
                for (int rep = 0; rep < ((l == 0 && sub == 0) ? REP_UP : 1); ++rep) pg8::gemm_phase<pg8::EpiUp, pg8::StaticOrder, true>(F.lds, g, S, E, F.tid);
            } else if (sub == 1 || sub == 7 || sub == 5) { PH_ENTER();
                const bool op = (sub == 5);
                pg8::Gemm g{op ? Pb : Hb, (const bf16*)(F.ws + (op ? WS_WOUT : (sub == 1 ? WS_WD1 : WS_WD2))), M, DM, op ? DM : FFP, op ? PP : FFP}; pg8::StaticOrder S; S.init(M, DM, F.G, bx);
                const float* base = (args.ph_lo < 0) ? F.in[I_X] : nullptr;
                pg8::EpiRes E{base, XB, part};
                pg8::gemm_phase<pg8::EpiRes, pg8::StaticOrder, false>(F.lds, g, S, E, F.tid);
            } else if (sub == 2) { PH_ENTER();
                pg8::Gemm g{XB, (const bf16*)(F.ws + WS_WIN), M, PP, DM, DM}; pg8::StaticOrder S; S.init(M, PP, F.G, bx);
                pg8::EpiP E{Pb, PP, part};
                if (bx >= S.nwg % F.G) for (int i = 0; i < args.stag_in; ++i) __builtin_amdgcn_s_sleep(127);
                pg8::gemm_phase<pg8::EpiP, pg8::StaticOrder, true>(F.lds, g, S, E, F.tid);
            } else if (sub == 3) { PH_ENTER();
                prep_consts(F, l);
                REPL(REP_PTOK) for (int u = F.vcu; u < M / PT; u += F.G) prep_tokens_unit(F, l, u);

            } else if (sub == 4) { PH_ENTER();
                unsigned dgm_ = 0; if (DIAG_SLOT_D >= 50 && DIAG_SLOT_D < 60) dgm_ = (unsigned)__builtin_amdgcn_s_memtime();
                if (bx < BATCH * 6) { for (int rep_ = 0; rep_ < (l == 0 ? args.rep_scan : 1); ++rep_) { rwkv_chunk_unit(F, l, bx); __syncthreads(); } }
                if (DIAG_SLOT_D == 54 && l == 0 && bx < BATCH * 6 && threadIdx.x == 0) atomicMax((unsigned*)(args.ws + WS_DIAG), (unsigned)__builtin_amdgcn_s_memtime() - dgm_);
                if (DIAG_SLOT_D == 50 && l == 0 && bx == 0 && threadIdx.x == 0) ((unsigned*)(args.ws + WS_DIAG))[0] = (unsigned)__builtin_amdgcn_s_memtime() - dgm_;
                if (!(DIAG_SLOT_D >= 70 && DIAG_SLOT_D < 80)) {
                    gu32* qh = ctl + CW_QUEUE + 64 * l;
                    for (;;) {
                        if (F.tid == 0) MISC[0] = __hip_atomic_fetch_add(qh, 1u, RLX_AGENT);
                        __syncthreads();
                        const int u = (int)MISC[0];
                        __syncthreads();
                        const int nd = (l == 0 ? args.qdup : 1) * (M / 32); constexpr int QB0 = BATCH * 4 + M / 16;
                        { unsigned z_ = 0u; int t_ = threadIdx.x; asm volatile("" : "+v"(z_), "+v"(t_)); z_ = __builtin_amdgcn_readfirstlane(z_); F.ws = args.ws + z_; F.tid = t_; F.lane = t_ & 63; F.wave = __builtin_amdgcn_readfirstlane(t_ >> 6); }
                        const int ncv = (conv_flat_items(l + 1 < DEPTH) + NWAVES * CONV_PER_WAVE - 1) / (NWAVES * CONV_PER_WAVE);
                        if (DIAG_SLOT_D == 53 && l == 0 && bx == 200 && threadIdx.x == 0 && u >= QB0 + nd) { unsigned* D_ = (unsigned*)(args.ws + WS_DIAG); if (D_[1] != 0x600Du) { D_[1] = 0x600Du; D_[0] = (unsigned)__builtin_amdgcn_s_memtime() - dgm_; } }
                        if (u >= nd + QB0 + ncv) { if (DIAG_SLOT_D == 51 && l == 0 && bx == 0 && threadIdx.x == 0) ((unsigned*)(args.ws + WS_DIAG))[0] = (unsigned)__builtin_amdgcn_s_memtime() - dgm_;
                            if (DIAG_SLOT_D == 52 && l == 0 && bx == 200 && threadIdx.x == 0) ((unsigned*)(args.ws + WS_DIAG))[0] = (unsigned)__builtin_amdgcn_s_memtime() - dgm_; }
                        if (DIAG_SLOT_D == 55 && l == 0 && u >= nd + QB0 + ncv && threadIdx.x == 0) atomicMax((unsigned*)(args.ws + WS_DIAG), (unsigned)__builtin_amdgcn_s_memtime() - dgm_);
                        if (DIAG_SLOT_D == 56 && l == 0 && u >= QB0 && u < nd + QB0 && threadIdx.x == 0) atomicMax((unsigned*)(args.ws + WS_DIAG), (unsigned)__builtin_amdgcn_s_memtime() - dgm_);
                        if (u >= nd + QB0 + ncv) break;
                        if (u < BATCH * 4) ret_out_unit(F, u);
                        else if (u < BATCH * 4 + M / 16) dsa_thr_unit(F, l, u - BATCH * 4);
                        else if (u < nd + QB0) dsa_attn_unit(F, l, (u - QB0) % (M / 32));
                        else { conv_unit(F, l, u - nd - QB0); __syncthreads(); }
                    }
                }
            }
        }
        if (ph_ + 1 < hi) xcd_barrier(bar);
        if (DIAG_SLOT_D >= 100 && ph_ == DIAG_SLOT_D - 100 && blockIdx.x == 0 && threadIdx.x == 0) ((unsigned*)(args.ws + WS_DIAG))[0] = (unsigned)__builtin_amdgcn_s_memtime() - dgp0_;
    }
}

extern "C" void kernel_launch(void* const* d_in, const int* in_sizes, int n_in, void* d_out, int out_size, void* d_ws, size_t ws_size, hipStream_t stream) {
    static int grid = 0;
    if (grid == 0) {
        if (n_in != 31 || out_size != M * DM || ws_size < WS_END) { fprintf(stderr, "kernel_launch: unexpected shapes (n_in %d, out %d, ws %zu)\n", n_in, out_size, ws_size); grid = -1; return; }
        int dev = 0, cus = 0, per_cu = 0;
        if (hipGetDevice(&dev) != hipSuccess || hipDeviceGetAttribute(&cus, hipDeviceAttributeMultiprocessorCount, dev) != hipSuccess) { grid = -1; return; }
        if (hipFuncSetAttribute((const void*)fwd_kernel, hipFuncAttributeMaxDynamicSharedMemorySize, LDS_BYTES) != hipSuccess) { fprintf(stderr, "kernel_launch: hipFuncSetAttribute failed\n"); grid = -1; return; }
        if (hipOccupancyMaxActiveBlocksPerMultiprocessor(&per_cu, (const void*)fwd_kernel, NTHR, LDS_BYTES) != hipSuccess || per_cu < 1) fprintf(stderr, "kernel_launch: occupancy query says %d\n", per_cu);
        (void)hipGetLastError();
        grid = cus;
    }
    if (grid < 0) return;
    if (hipMemsetAsync((char*)d_ws + WS_CTL, 0, CTL_ZERO_BYTES, stream) != hipSuccess) return;
    Args a{};
    for (int i = 0; i < 31; ++i) a.in[i] = (const float*)d_in[i];
    a.out = (float*)d_out; a.ws = (unsigned char*)d_ws; a.dup_phase = DUP_PHASE; a.qdup = QDUP; a.rep_scan = REP_SCAN_K; a.rep_thr = REP_THR_K; a.stag_up = STAG_UP; a.stag_in = STAG_IN;
#ifndef ONE_LAUNCH
#define ONE_LAUNCH 1
#endif
    if (ONE_LAUNCH) { a.ph_lo = 0; a.ph_hi = NSTEP; hipLaunchKernelGGL(fwd_kernel, dim3(grid), dim3(NTHR), LDS_BYTES, stream, a); }
    else for (int ph = 0; ph < NPHASE; ++ph) { a.ph_lo = ph; a.ph_hi = ph + 1; hipLaunchKernelGGL(fwd_kernel, dim3(grid), dim3(NTHR), LDS_BYTES, stream, a); }
}
```
